# Optimizing an MI355X kernel written in HIP

```python
import math
import jax
import jax.numpy as jnp
from jax import lax
import numpy as np

D_MODEL = 1024
BATCH = 8
SEQ = 4096
DEPTH = 4

N_MIXERS = 2
N_MLA_LAYERS = (DEPTH + N_MIXERS - 1) // N_MIXERS
N_LRU_LAYERS = DEPTH // N_MIXERS

MLA_HEADS = 8
QK_NOPE_DIM = 128
QK_ROPE_DIM = 64
V_HEAD_DIM = 128
Q_LORA_RANK = 768
KV_LORA_RANK = 256
MLA_LATENT_DIM = Q_LORA_RANK + KV_LORA_RANK + QK_ROPE_DIM
ROPE_THETA = 10000.0
Q_BLOCK = 128

LRU_WIDTH = D_MODEL
LRU_BLOCKS = 4
LRU_BLOCK_DIM = LRU_WIDTH // LRU_BLOCKS
CONV_WIDTH = 4
LRU_C = 8.0

N_EXPERTS = 32
TOP_K = 4
D_FF = D_MODEL
SWIGLU_LIMIT = 7.0
SWIGLU_ALPHA = 1.702
MOE_BLOCK = 256

PLE_DIM = 256

DEEPNORM_ALPHA = (2.0 * DEPTH) ** 0.25
DEEPNORM_BETA = (8.0 * DEPTH) ** -0.25
LN_EPS = 1e-5
RMS_EPS = 1e-6

kernel_name = 'hybrid_mla_rglru_moe_deepnorm'


def _layer_norm(x, g, b):
    xf = x.astype(jnp.float32)
    mu = jnp.mean(xf, axis=-1, keepdims=True)
    xc = xf - mu
    var = jnp.mean(xc * xc, axis=-1, keepdims=True)
    return (xc * lax.rsqrt(var + LN_EPS) * g.astype(jnp.float32) + b.astype(jnp.float32)).astype(x.dtype)


def _rms_norm(x, g):
    xf = x.astype(jnp.float32)
    ms = jnp.mean(xf * xf, axis=-1, keepdims=True)
    return (xf * lax.rsqrt(ms + RMS_EPS) * g.astype(jnp.float32)).astype(x.dtype)


def _rope(x, positions):
    half = x.shape[-1] // 2
    inv_freq = jnp.exp(-math.log(ROPE_THETA) * jnp.arange(half, dtype=jnp.float32) / half)
    ang = positions.astype(jnp.float32)[..., None] * inv_freq
    cos = jnp.cos(ang)[:, :, None, :]
    sin = jnp.sin(ang)[:, :, None, :]
    xf = x.astype(jnp.float32)
    x1, x2 = xf[..., :half], xf[..., half:]
    return jnp.concatenate([x1 * cos - x2 * sin, x2 * cos + x1 * sin], axis=-1).astype(x.dtype)


def _mla(x, positions, w_in, q_norm, kv_norm, w_uq, w_ukv, w_o):
    bsz, seq, _ = x.shape
    lat = x @ w_in
    c_q = _rms_norm(lat[..., :Q_LORA_RANK], q_norm)
    c_kv = _rms_norm(lat[..., Q_LORA_RANK:Q_LORA_RANK + KV_LORA_RANK], kv_norm)
    k_rope = _rope(lat[..., Q_LORA_RANK + KV_LORA_RANK:][:, :, None, :], positions)[:, :, 0, :]
    q = (c_q @ w_uq).reshape(bsz, seq, MLA_HEADS, QK_NOPE_DIM + QK_ROPE_DIM)
    q_nope = q[..., :QK_NOPE_DIM]
    q_rope = _rope(q[..., QK_NOPE_DIM:], positions)
    kv = (c_kv @ w_ukv).reshape(bsz, seq, MLA_HEADS, QK_NOPE_DIM + V_HEAD_DIM)
    k_nope = kv[..., :QK_NOPE_DIM]
    v = kv[..., QK_NOPE_DIM:]

    n_blocks = seq // Q_BLOCK

    def to_blocks(t):
        return jnp.moveaxis(t.reshape(bsz, n_blocks, Q_BLOCK, *t.shape[2:]), 1, 0)

    scale = 1.0 / math.sqrt(QK_NOPE_DIM + QK_ROPE_DIM)
    key_pos = jnp.arange(seq, dtype=jnp.int32)

    def attend(args):
        qn, qr, blk = args
        s = (jnp.einsum('bqhd,bkhd->bhqk', qn, k_nope)
             + jnp.einsum('bqhr,bkr->bhqk', qr, k_rope)).astype(jnp.float32) * scale
        q_pos = blk * Q_BLOCK + jnp.arange(Q_BLOCK, dtype=jnp.int32)
        s = jnp.where(key_pos[None, :] <= q_pos[:, None], s, -jnp.inf)
        pr = jax.nn.softmax(s, axis=-1).astype(v.dtype)
        return jnp.einsum('bhqk,bkhd->bqhd', pr, v)

    o = lax.map(attend, (to_blocks(q_nope), to_blocks(q_rope), jnp.arange(n_blocks, dtype=jnp.int32)))
    o = jnp.moveaxis(o, 0, 1).reshape(bsz, seq, MLA_HEADS * V_HEAD_DIM)
    return o @ w_o


def _linear_combine(c1, c2):
    a1, b1 = c1
    a2, b2 = c2
    return a1 * a2, a2 * b1 + b2


def _rglru_block(x, w_in, conv_w, conv_b, w_a, b_a, w_x, b_x, lam, w_out):
    bsz, seq, _ = x.shape
    gu = x @ w_in
    gate, u = gu[..., :LRU_WIDTH], gu[..., LRU_WIDTH:]
    u = lax.conv_general_dilated(u, conv_w[:, None, :], window_strides=(1,),
                                 padding=[(CONV_WIDTH - 1, 0)],
                                 dimension_numbers=('NWC', 'WIO', 'NWC'),
                                 feature_group_count=LRU_WIDTH) + conv_b
    ub = u.reshape(bsz, seq, LRU_BLOCKS, LRU_BLOCK_DIM)
    r = jax.nn.sigmoid((jnp.einsum('bsnc,ncd->bsnd', ub, w_a).reshape(bsz, seq, LRU_WIDTH) + b_a).astype(jnp.float32))
    i = jax.nn.sigmoid((jnp.einsum('bsnc,ncd->bsnd', ub, w_x).reshape(bsz, seq, LRU_WIDTH) + b_x).astype(jnp.float32))
    log_a = -LRU_C * r * jax.nn.softplus(-lam.astype(jnp.float32))
    a = jnp.exp(log_a)
    mult = jnp.sqrt(-jnp.expm1(2.0 * log_a))
    b_in = mult * i * u.astype(jnp.float32)
    _, h = lax.associative_scan(_linear_combine, (a, b_in), axis=1)
    y = jax.nn.gelu(gate, approximate=True) * h.astype(x.dtype)
    return y @ w_out


def _moe(x, w_router, b_router, w_up, b_up, w_down, b_down):
    bsz, seq, d = x.shape
    t = bsz * seq
    xf = x.reshape(t, d)
    logits = (xf @ w_router + b_router).astype(jnp.float32)
    top_logits, top_idx = lax.top_k(logits, TOP_K)
    gates = jax.nn.softmax(top_logits, axis=-1)
    n = t * TOP_K
    flat_e = top_idx.reshape(n).astype(jnp.int32)
    flat_tok = jnp.arange(n, dtype=jnp.int32) // TOP_K
    flat_g = gates.reshape(n)
    order = jnp.argsort(flat_e)
    sorted_e = flat_e[order]
    counts = jnp.zeros((N_EXPERTS,), jnp.int32).at[flat_e].add(1)
    padded = (counts + MOE_BLOCK - 1) // MOE_BLOCK * MOE_BLOCK
    starts = jnp.cumsum(counts) - counts
    pad_ends = jnp.cumsum(padded)
    pad_starts = pad_ends - padded
    rank = jnp.arange(n, dtype=jnp.int32) - starts[sorted_e]
    dest = pad_starts[sorted_e] + rank
    n_pad = n + N_EXPERTS * MOE_BLOCK
    n_blocks = n_pad // MOE_BLOCK
    row_tok = jnp.zeros((n_pad,), jnp.int32).at[dest].set(flat_tok[order])
    row_gate = jnp.zeros((n_pad,), x.dtype).at[dest].set(flat_g[order].astype(x.dtype))
    block_e = jnp.searchsorted(pad_ends, jnp.arange(n_blocks, dtype=jnp.int32) * MOE_BLOCK, side='right')
    block_e = jnp.minimum(block_e, N_EXPERTS - 1).astype(jnp.int32)
    xs = xf[row_tok].reshape(n_blocks, MOE_BLOCK, d)

    def expert_block(args):
        xb, e = args
        hb = xb @ w_up[e] + b_up[e]
        g = jnp.minimum(hb[:, :D_FF], SWIGLU_LIMIT)
        up = jnp.clip(hb[:, D_FF:], -SWIGLU_LIMIT, SWIGLU_LIMIT)
        yb = (up + 1.0) * (g * jax.nn.sigmoid(SWIGLU_ALPHA * g))
        return yb @ w_down[e] + b_down[e]

    ys = lax.map(expert_block, (xs, block_e)).reshape(n_pad, d)
    out = jax.ops.segment_sum(ys * row_gate[:, None], row_tok, num_segments=t)
    return out.reshape(bsz, seq, d)


def setup_inputs(seed: int = 0) -> dict:
    key = jax.random.key(seed)
    ks = jax.random.split(key, 30)
    na, nl = N_MLA_LAYERS, N_LRU_LAYERS
    f32 = jnp.float32

    def nrm(k, shape, scale):
        return jax.random.normal(k, shape, f32) * scale

    x = nrm(ks[0], (BATCH, SEQ, D_MODEL), 1.0)
    p = nrm(ks[1], (DEPTH, BATCH, SEQ, PLE_DIM), 1.0)
    positions = (jax.random.randint(ks[2], (BATCH, 1), 0, 1024, dtype=jnp.int32)
                 + jnp.arange(SEQ, dtype=jnp.int32)[None, :])
    mla_w_in = nrm(ks[3], (na, D_MODEL, MLA_LATENT_DIM), D_MODEL ** -0.5)
    mla_q_norm = 1.0 + nrm(ks[4], (na, Q_LORA_RANK), 0.02)
    mla_kv_norm = 1.0 + nrm(ks[5], (na, KV_LORA_RANK), 0.02)
    mla_w_uq = nrm(ks[6], (na, Q_LORA_RANK, MLA_HEADS * (QK_NOPE_DIM + QK_ROPE_DIM)), Q_LORA_RANK ** -0.5)
    mla_w_ukv = nrm(ks[7], (na, KV_LORA_RANK, MLA_HEADS * (QK_NOPE_DIM + V_HEAD_DIM)), KV_LORA_RANK ** -0.5)
    mla_w_o = nrm(ks[8], (na, MLA_HEADS * V_HEAD_DIM, D_MODEL), DEEPNORM_BETA * (MLA_HEADS * V_HEAD_DIM) ** -0.5)
    lru_w_in = nrm(ks[9], (nl, D_MODEL, 2 * LRU_WIDTH), D_MODEL ** -0.5)
    lru_conv_w = nrm(ks[10], (nl, CONV_WIDTH, LRU_WIDTH), CONV_WIDTH ** -0.5)
    lru_conv_b = nrm(ks[11], (nl, LRU_WIDTH), 0.01)
    lru_w_a = nrm(ks[12], (nl, LRU_BLOCKS, LRU_BLOCK_DIM, LRU_BLOCK_DIM), LRU_BLOCK_DIM ** -0.5)
    lru_b_a = nrm(ks[13], (nl, LRU_WIDTH), 0.01)
    lru_w_x = nrm(ks[14], (nl, LRU_BLOCKS, LRU_BLOCK_DIM, LRU_BLOCK_DIM), LRU_BLOCK_DIM ** -0.5)
    lru_b_x = nrm(ks[15], (nl, LRU_WIDTH), 0.01)
    a_c = jax.random.uniform(ks[16], (nl, LRU_WIDTH), f32, 0.9, 0.999)
    sig = a_c ** (1.0 / LRU_C)
    lru_lambda = jnp.log(sig) - jnp.log1p(-sig)
    lru_w_out = nrm(ks[17], (nl, LRU_WIDTH, D_MODEL), DEEPNORM_BETA * LRU_WIDTH ** -0.5)
    ln1_g = 1.0 + nrm(ks[18], (DEPTH, D_MODEL), 0.02)
    ln1_b = nrm(ks[19], (DEPTH, D_MODEL), 0.02)
    ln2_g = 1.0 + nrm(ks[20], (DEPTH, D_MODEL), 0.02)
    ln2_b = nrm(ks[21], (DEPTH, D_MODEL), 0.02)
    moe_w_router = nrm(ks[22], (DEPTH, D_MODEL, N_EXPERTS), D_MODEL ** -0.5)
    moe_b_router = nrm(ks[23], (DEPTH, N_EXPERTS), 0.01)
    moe_w_up = nrm(ks[24], (DEPTH, N_EXPERTS, D_MODEL, 2 * D_FF), D_MODEL ** -0.5)
    moe_b_up = nrm(ks[25], (DEPTH, N_EXPERTS, 2 * D_FF), 0.01)
    moe_w_down = nrm(ks[26], (DEPTH, N_EXPERTS, D_FF, D_MODEL), DEEPNORM_BETA * D_FF ** -0.5)
    moe_b_down = nrm(ks[27], (DEPTH, N_EXPERTS, D_MODEL), 0.01)
    ple_w_gate = nrm(ks[28], (DEPTH, D_MODEL, D_MODEL), D_MODEL ** -0.5)
    ple_w_proj = nrm(ks[29], (DEPTH, PLE_DIM, D_MODEL), DEEPNORM_BETA * PLE_DIM ** -0.5)
    return {
        'x': x, 'p': p, 'positions': positions,
        'mla_w_in': mla_w_in, 'mla_q_norm': mla_q_norm, 'mla_kv_norm': mla_kv_norm,
        'mla_w_uq': mla_w_uq, 'mla_w_ukv': mla_w_ukv, 'mla_w_o': mla_w_o,
        'lru_w_in': lru_w_in, 'lru_conv_w': lru_conv_w, 'lru_conv_b': lru_conv_b,
        'lru_w_a': lru_w_a, 'lru_b_a': lru_b_a, 'lru_w_x': lru_w_x, 'lru_b_x': lru_b_x,
        'lru_lambda': lru_lambda, 'lru_w_out': lru_w_out,
        'ln1_g': ln1_g, 'ln1_b': ln1_b, 'ln2_g': ln2_g, 'ln2_b': ln2_b,
        'moe_w_router': moe_w_router, 'moe_b_router': moe_b_router,
        'moe_w_up': moe_w_up, 'moe_b_up': moe_b_up, 'moe_w_down': moe_w_down, 'moe_b_down': moe_b_down,
        'ple_w_gate': ple_w_gate, 'ple_w_proj': ple_w_proj,
    }


def reference(x, p, positions,
              mla_w_in, mla_q_norm, mla_kv_norm, mla_w_uq, mla_w_ukv, mla_w_o,
              lru_w_in, lru_conv_w, lru_conv_b, lru_w_a, lru_b_a, lru_w_x, lru_b_x,
              lru_lambda, lru_w_out,
              ln1_g, ln1_b, ln2_g, ln2_b,
              moe_w_router, moe_b_router, moe_w_up, moe_b_up, moe_w_down, moe_b_down,
              ple_w_gate, ple_w_proj):
    for layer in range(DEPTH):
        j = layer // N_MIXERS
        if layer % N_MIXERS == 0:
            mix = _mla(x, positions, mla_w_in[j], mla_q_norm[j], mla_kv_norm[j],
                       mla_w_uq[j], mla_w_ukv[j], mla_w_o[j])
        else:
            mix = _rglru_block(x, lru_w_in[j], lru_conv_w[j], lru_conv_b[j], lru_w_a[j], lru_b_a[j],
                               lru_w_x[j], lru_b_x[j], lru_lambda[j], lru_w_out[j])
        x = _layer_norm(DEEPNORM_ALPHA * x + mix, ln1_g[layer], ln1_b[layer])
        ffn = _moe(x, moe_w_router[layer], moe_b_router[layer], moe_w_up[layer], moe_b_up[layer],
                   moe_w_down[layer], moe_b_down[layer])
        x = _layer_norm(DEEPNORM_ALPHA * x + ffn, ln2_g[layer], ln2_b[layer])
        x = x + jax.nn.sigmoid(x @ ple_w_gate[layer]) * (p[layer] @ ple_w_proj[layer])
    return x
```

```cpp
#include <hip/hip_runtime.h>
#include <hip/hip_bf16.h>
#include <cstdio>
#include <cstdint>

#ifndef PHSEL
#define PHSEL -1
#endif
#define SEL(id) (PHSEL < 0 || PHSEL == (id))
#ifndef MK_ONE_LAUNCH
#define MK_ONE_LAUNCH 0
#endif

constexpr int T = 32768, SEQ = 4096, NBATCH = 8, DM = 1024, DEPTH = 4;
constexpr int QL = 768, KVL = 256, ROPE = 64, LATD = 1088, NH = 8, DQK = 192, DV = 128;
constexpr int NE = 32, TOPK = 4, DFF = 1024, PLED = 256;
constexpr float ALPHA = 1.681792830507429f;
constexpr float LN_EPS = 1e-5f, RMS_EPS = 1e-6f;
constexpr float QSCALE = 1.4426950408889634f / 13.856406460551018f;
constexpr int NWAVES = 8;

constexpr size_t MiB = 1u << 20;
constexpr size_t WS_CTL = 0, CTL_ZERO_BYTES = 2 * MiB;
constexpr size_t WS_CS = 2 * MiB, WS_SN = 6 * MiB, WS_SPL = 10 * MiB;
constexpr size_t WS_W_MLA = 12 * MiB, W_MLA_STRIDE = 8 * MiB;
constexpr size_t OFF_MLA_WIN = 0, OFF_MLA_WUQ = 2560 * 1024, OFF_MLA_WUKV = OFF_MLA_WUQ + 2304 * 1024, OFF_MLA_WO = OFF_MLA_WUKV + 1024 * 1024;
constexpr size_t WS_W_LRU = 28 * MiB, W_LRU_STRIDE = 8 * MiB;
constexpr size_t OFF_LRU_WIN = 0, OFF_LRU_WAX = 4 * MiB, OFF_LRU_WOUT = 5 * MiB;
constexpr size_t WS_W_PLE = 44 * MiB, W_PLE_STRIDE = 3 * MiB;
constexpr size_t OFF_PLE_WG = 0, OFF_PLE_WP = 2 * MiB;
constexpr size_t WS_W_UP = 56 * MiB;
constexpr size_t WS_W_DN = 568 * MiB;
constexpr size_t WS_XB = 824 * MiB, WS_PB = 888 * MiB, WS_PP = 952 * MiB;
constexpr size_t WS_Y = 1208 * MiB, WS_X1 = 1336 * MiB, WS_X1B = 1464 * MiB, WS_X2 = 1528 * MiB, WS_X2B = 1656 * MiB;
constexpr size_t WS_LAT = 1720 * MiB, WS_KR = 1784 * MiB, WS_SSQ = 1788 * MiB, WS_Q = 1790 * MiB, WS_KN = 1886 * MiB, WS_V = 1950 * MiB, WS_O = 2014 * MiB;
constexpr size_t WS_GG = 2078 * MiB, WS_U = 2142 * MiB, WS_UC = 2206 * MiB, WS_AA = 2270 * MiB, WS_BB = 2398 * MiB, WS_CA = 2526 * MiB, WS_CH = 2528 * MiB;
constexpr size_t WS_H = 2530 * MiB, WS_YS = 2802 * MiB, WS_LIST = 3074 * MiB, WS_SLOT = 3078 * MiB, WS_GATE = 3079 * MiB, WS_END = 3080 * MiB;
constexpr int PADROWS = T * TOPK + NE * 256;
static_assert((size_t)PADROWS * DFF * 2 <= 272 * MiB, "H / YS size");
constexpr int CW_CNT = 256;
constexpr int CW_BAR = 4096;

constexpr int RING_BYTES = 139264;
constexpr int MISC_OFF = RING_BYTES;
constexpr int LDS_BYTES = 147456;

#define GAS __attribute__((address_space(1)))
#define LAS __attribute__((address_space(3)))
#define CAS __attribute__((address_space(4)))
typedef unsigned short bf16_t;
typedef short bf16x8 __attribute__((ext_vector_type(8)));
typedef short s16x4 __attribute__((ext_vector_type(4)));
typedef float f32x2 __attribute__((ext_vector_type(2)));
typedef float f32x4 __attribute__((ext_vector_type(4)));
typedef float f32x16 __attribute__((ext_vector_type(16)));
typedef unsigned u32x2 __attribute__((ext_vector_type(2)));
typedef unsigned u32x4 __attribute__((ext_vector_type(4)));

__device__ __forceinline__ unsigned cvt_pk_bf16(float lo, float hi) { unsigned r; asm volatile("v_cvt_pk_bf16_f32 %0, %1, %2" : "=v"(r) : "v"(lo), "v"(hi)); return r; }
__device__ __forceinline__ float bf_lo(unsigned w) { return __uint_as_float(w << 16); }
__device__ __forceinline__ float bf_hi(unsigned w) { return __uint_as_float(w & 0xffff0000u); }
__device__ __forceinline__ float sigmoidf_(float x) { return __builtin_amdgcn_rcpf(1.0f + __expf(-x)); }
__device__ __forceinline__ float gelu_tanh(float x) { const float u = 0.7978845608028654f * (x + 0.044715f * x * x * x); const float t = 1.0f - 2.0f * __builtin_amdgcn_rcpf(1.0f + __expf(2.0f * u)); return 0.5f * x * (1.0f + t); }
__device__ __forceinline__ u32x4 pack8(const f32x4 a, const f32x4 b) { u32x4 w; w.x = cvt_pk_bf16(a[0], a[1]); w.y = cvt_pk_bf16(a[2], a[3]); w.z = cvt_pk_bf16(b[0], b[1]); w.w = cvt_pk_bf16(b[2], b[3]); return w; }
__device__ __forceinline__ int opaque_tid() { int t = threadIdx.x; asm volatile("" : "+v"(t)); return t; }
__device__ __forceinline__ float wave_sum(float v) {
#pragma unroll
    for (int o = 1; o < 64; o <<= 1) v += __shfl_xor(v, o);
    return v;
}

namespace pg8 {
#define PG8_LAS __attribute__((address_space(3)))
constexpr int BM = 256, BK = 64, HALF = 128, HTB = HALF * BK * 2, STAGE_BYTES = 8 * HTB;
__host__ __device__ __forceinline__ int lds_byte(int r, int c) { const int st = (r >> 4) * 2 + (c >> 5), rr = r & 15, cc = c & 31, ob = rr * 64 + cc * 2; return st * 1024 + (ob ^ (((ob >> 9) & 1) << 5)); }
__host__ __device__ __forceinline__ void stage_rc(int b, int& R, int& C) { const int st = b / 1024, sb = b % 1024, swz = sb ^ (((sb >> 9) & 1) << 5); R = (st >> 1) * 16 + swz / 64; C = (st & 1) * 32 + (swz % 64) / 2; }
__host__ __device__ __forceinline__ int perm32(int rho) { const int n = rho >> 4, i = rho & 15; return 8 * (i >> 2) + 4 * n + (i & 3); }

struct Unit { const char* A; const char* B; const int* lst; int nvalid; int pm, pn, aux; };

template <class Epi, class Sched, bool GATHER>
__device__ __forceinline__ void gemm_phase(PG8_LAS unsigned char* lds, const int K, const int lda, const int ldb, const Sched& S, const Epi& E) {
    const int tid = opaque_tid(), wid = __builtin_amdgcn_readfirstlane(tid >> 6), lane = tid & 63, wr = wid >> 2, wc = wid & 3, fr = lane & 15, fq = lane >> 4;
    const int nt = K / BK;
    unsigned voffB[2], ocA[2][2], onA[2][2]; int gR[2], gC2[2];
#pragma unroll
    for (int i = 0; i < 2; ++i) { int R, C; stage_rc(tid * 16 + i * 8192, R, C); const int Rb = Epi::PERM ? ((R & ~31) + perm32(R & 31)) : R;
        voffB[i] = (unsigned)(Rb * ldb + C) * 2u; gR[i] = R; gC2[i] = C * 2;
        ocA[0][i] = (unsigned)(R * lda + C) * 2u; ocA[1][i] = (unsigned)((R + HALF) * lda + C) * 2u; onA[0][i] = ocA[0][i]; onA[1][i] = ocA[1][i]; }
    const size_t kstep = (size_t)(BK * 2);
    const size_t hstepB = (size_t)HALF * ldb * 2;
    const unsigned ldsw = (unsigned)wid * 1024u;
    const int aoff = lds_byte(wr * 64 + fr, fq * 8), boff = lds_byte(wc * 32 + fr, fq * 8);
#define PG8_SA(b, h) (((b) * 2 + (h)) * HTB)
#define PG8_SB(b, h) ((4 + (b) * 2 + (h)) * HTB)
#define PG8_STAGE(bufoff, gbase, voff) do { _Pragma("unroll") for (int _i = 0; _i < 2; ++_i) \
        __builtin_amdgcn_global_load_lds((const unsigned*)((const char*)(gbase) + (voff)[_i]), (PG8_LAS unsigned*)(lds + (bufoff) + ldsw + _i * 8192), 16, 0, 0); } while (0)
#define PG8_LDA(dst, b, h) do { _Pragma("unroll") for (int m = 0; m < 4; ++m) _Pragma("unroll") for (int k = 0; k < 2; ++k) dst[m][k] = *(const PG8_LAS bf16x8*)(lds + PG8_SA(b, h) + aoff + m * 2048 + k * 1024); } while (0)
#define PG8_LDB(dst, b, h) do { _Pragma("unroll") for (int n = 0; n < 2; ++n) _Pragma("unroll") for (int k = 0; k < 2; ++k) dst[n][k] = *(const PG8_LAS bf16x8*)(lds + PG8_SB(b, h) + boff + n * 2048 + k * 1024); } while (0)
#define PG8_MMA(ai, bj, At, Bt) do { __builtin_amdgcn_s_setprio(1); _Pragma("unroll") for (int m = 0; m < 4; ++m) _Pragma("unroll") for (int n = 0; n < 2; ++n) _Pragma("unroll") for (int k = 0; k < 2; ++k) \
        acc[ai][bj][m][n] = __builtin_amdgcn_mfma_f32_16x16x32_bf16(Bt[n][k], At[m][k], acc[ai][bj][m][n], 0, 0, 0); __builtin_amdgcn_s_setprio(0); } while (0)
#define PG8_WAIT_V(n) asm volatile("s_waitcnt vmcnt(" #n ")" ::: "memory")
#define PG8_WAIT_L(n) asm volatile("s_waitcnt lgkmcnt(" #n ")" ::: "memory")
#define PG8_BAR __builtin_amdgcn_s_barrier()
#define PG8_SCHED __builtin_amdgcn_sched_barrier(0)
#define PG8_GOFFS(u, o) do { _Pragma("unroll") for (int _h = 0; _h < 2; ++_h) _Pragma("unroll") for (int _i = 0; _i < 2; ++_i) { int _r = _h * HALF + gR[_i]; _r = _r < (u).nvalid ? _r : (u).nvalid - 1; \
        const int _tok = (u).lst[_r]; (o)[_h][_i] = (unsigned)_tok * (unsigned)(lda * 2) + (unsigned)gC2[_i]; } } while (0)
    Unit cur, nxt; int ui = 0;
    if (!S.next(0, cur)) return;
    f32x4 acc[2][2][4][2];
#pragma unroll
    for (int a = 0; a < 2; ++a)
#pragma unroll
        for (int b = 0; b < 2; ++b)
#pragma unroll
            for (int m = 0; m < 4; ++m)
#pragma unroll
                for (int n = 0; n < 2; ++n) acc[a][b][m][n] = (f32x4){0.f, 0.f, 0.f, 0.f};
    bf16x8 At[4][2], B0[2][2], B1[2][2];
    const char* cA = cur.A; const char* cB = cur.B;
    if constexpr (GATHER) { PG8_GOFFS(cur, ocA); }
    PG8_STAGE(PG8_SB(0, 0), cB, voffB); PG8_STAGE(PG8_SB(0, 1), cB + hstepB, voffB); PG8_STAGE(PG8_SA(0, 0), cA, ocA[0]); PG8_STAGE(PG8_SA(0, 1), cA, ocA[1]);
    if (wr == 1) PG8_BAR;
    PG8_WAIT_V(2); PG8_BAR;
    PG8_STAGE(PG8_SB(1, 0), cB + kstep, voffB); PG8_STAGE(PG8_SA(1, 0), cA + kstep, ocA[0]); PG8_STAGE(PG8_SB(1, 1), cB + hstepB + kstep, voffB);
    PG8_WAIT_V(6); PG8_BAR;
    for (;;) {
        const bool has_next = S.next(ui + 1, nxt);
        const char* nA = has_next ? nxt.A : cA; const char* nB = has_next ? nxt.B : cB;
        if constexpr (GATHER) {
            if (has_next) { PG8_GOFFS(nxt, onA); }
            else {
#pragma unroll
                for (int h = 0; h < 2; ++h)
#pragma unroll
                    for (int i = 0; i < 2; ++i) onA[h][i] = ocA[h][i]; }
        }
#pragma unroll 1
        for (int t = 0; t < nt; t += 2) {
            const bool last = (t == nt - 2);
            const char* a1 = cA + (size_t)(t + 1) * kstep;
            const char* a2 = last ? nA : cA + (size_t)(t + 2) * kstep; const char* b2 = last ? nB : cB + (size_t)(t + 2) * kstep;
            const char* a3 = a2 + kstep; const char* b3 = b2 + kstep;
            unsigned o2[2][2];
#pragma unroll
            for (int h = 0; h < 2; ++h)
#pragma unroll
                for (int i = 0; i < 2; ++i) o2[h][i] = (GATHER && last) ? onA[h][i] : ocA[h][i];
            PG8_LDB(B0, 0, 0); PG8_LDB(B1, 0, 1); PG8_SCHED; PG8_LDA(At, 0, 0); PG8_STAGE(PG8_SA(1, 1), a1, ocA[1]);
            PG8_WAIT_V(8); PG8_WAIT_L(0); PG8_BAR; PG8_MMA(0, 0, At, B0); PG8_MMA(0, 1, At, B1); PG8_BAR; PG8_SCHED;
            PG8_LDA(At, 0, 1); PG8_STAGE(PG8_SB(0, 0), b2, voffB); PG8_STAGE(PG8_SB(0, 1), b2 + hstepB, voffB); PG8_STAGE(PG8_SA(0, 0), a2, o2[0]);
            PG8_WAIT_V(8); PG8_WAIT_L(0); PG8_BAR; PG8_MMA(1, 0, At, B0); PG8_MMA(1, 1, At, B1); PG8_BAR; PG8_SCHED;
            PG8_LDB(B0, 1, 0); PG8_LDB(B1, 1, 1); PG8_SCHED; PG8_LDA(At, 1, 0); PG8_STAGE(PG8_SA(0, 1), a2, o2[1]);
            PG8_WAIT_V(8); PG8_WAIT_L(0); PG8_BAR; PG8_MMA(0, 0, At, B0); PG8_MMA(0, 1, At, B1); PG8_BAR; PG8_SCHED;
            PG8_LDA(At, 1, 1); PG8_STAGE(PG8_SB(1, 0), b3, voffB); PG8_STAGE(PG8_SB(1, 1), b3 + hstepB, voffB); PG8_STAGE(PG8_SA(1, 0), a3, o2[0]);
            PG8_WAIT_V(8); PG8_WAIT_L(0); PG8_BAR; PG8_MMA(1, 0, At, B0); PG8_MMA(1, 1, At, B1); PG8_BAR; PG8_SCHED;
        }
        if (wr == 0) PG8_BAR;
        E(acc, cur, wr, wc, fr, fq);
        if (!has_next) break;
#pragma unroll
        for (int a = 0; a < 2; ++a)
#pragma unroll
            for (int b = 0; b < 2; ++b)
#pragma unroll
                for (int m = 0; m < 4; ++m)
#pragma unroll
                    for (int n = 0; n < 2; ++n) acc[a][b][m][n] = (f32x4){0.f, 0.f, 0.f, 0.f};
        cur = nxt; cA = nA; cB = nB; ++ui;
        if constexpr (GATHER) {
#pragma unroll
            for (int h = 0; h < 2; ++h)
#pragma unroll
                for (int i = 0; i < 2; ++i) ocA[h][i] = onA[h][i]; }
        if (wr == 1) PG8_BAR;
    }
    PG8_WAIT_V(0);
    PG8_BAR;
#undef PG8_SA
#undef PG8_SB
#undef PG8_STAGE
#undef PG8_LDA
#undef PG8_LDB
#undef PG8_MMA
#undef PG8_WAIT_V
#undef PG8_WAIT_L
#undef PG8_BAR
#undef PG8_SCHED
#undef PG8_GOFFS
}

constexpr int NXCD = 8, WGM = 8;
struct DenseSched {
    const char* A; const char* B; int lda, ldb; int nM, nN, nwg, G, c; int apn_shift, akbytes, bpm_shift; size_t bbatch;
    __device__ __forceinline__ void init(const void* A_, const void* B_, int lda_, int ldb_, int M, int N, int G_, int c_) {
        A = (const char*)A_; B = (const char*)B_; lda = lda_; ldb = ldb_; nM = M / BM; nN = N / BM; nwg = nM * nN; G = G_; c = c_; apn_shift = -1; akbytes = 0; bpm_shift = -1; bbatch = 0; }
    __device__ __forceinline__ bool next(int i, Unit& u) const {
        const long L = (long)i * G + c; if (L >= nwg) return false;
        int wgid = (int)L; { const int q = nwg / NXCD, r = nwg % NXCD, xcd = wgid % NXCD, off = wgid / NXCD; wgid = (xcd < r ? xcd * (q + 1) : r * (q + 1) + (xcd - r) * q) + off; }
        const int nig = WGM * nN, gid = wgid / nig, fm = gid * WGM, gsz = (nM - fm) < WGM ? (nM - fm) : WGM;
        const int pm = fm + ((wgid % nig) % gsz), pn = (wgid % nig) / gsz;
        u.pm = pm; u.pn = pn; u.aux = 0; u.lst = nullptr; u.nvalid = 256;
        u.A = A + (size_t)pm * 256 * lda * 2 + (apn_shift >= 0 ? (size_t)(pn >> apn_shift) * akbytes : (size_t)0);
        u.B = B + (size_t)pn * 256 * ldb * 2 + (bpm_shift >= 0 ? (size_t)(pm >> bpm_shift) * bbatch : (size_t)0);
        return true;
    }
};
struct MoeSched {
    const char* A; const char* B; size_t bexp; int lda, ldb, nN; const int* lists; volatile LAS const int* tab; int G, c; bool gather;
    __device__ __forceinline__ bool next(int i, Unit& u) const {
        const int total = tab[32] * nN; const long L = (long)i * G + c; if (L >= total) return false;
        const int pn = (int)(L % nN), mg = (int)(L / nN);
        int e = 0;
#pragma unroll 1
        for (int j = 1; j < 32; ++j) e += (tab[j] <= mg) ? 1 : 0;
        const int mt = mg - tab[e];
        u.pm = mg; u.pn = pn; u.aux = e;
        if (gather) { u.A = A; u.lst = lists + (size_t)e * T + mt * 256; const int rem = tab[48 + e] - mt * 256; u.nvalid = rem < 256 ? rem : 256; }
        else { u.A = A + (size_t)mg * 256 * lda * 2; u.lst = nullptr; u.nvalid = 256; }
        u.B = B + (size_t)e * bexp + (size_t)pn * 256 * ldb * 2;
        return true;
    }
};

#define EPI_ROW(u, ai, m) ((u).pm * 256 + (ai) * 128 + wr * 64 + (m) * 16 + fr)
struct EpiLat {
    static constexpr bool PERM = true;
    bf16_t* LAT; float* SSQ; bf16_t* KR; const float* CS; const float* SN;
    __device__ __forceinline__ void operator()(const f32x4 (&acc)[2][2][4][2], const Unit& u, int wr, int wc, int fr, int fq) const {
        if (u.pn < 4) {
#pragma unroll
            for (int ai = 0; ai < 2; ++ai)
#pragma unroll
                for (int m = 0; m < 4; ++m) { const int row = EPI_ROW(u, ai, m); float ss = 0.f;
#pragma unroll
                    for (int bj = 0; bj < 2; ++bj) { const f32x4 v0 = acc[ai][bj][m][0], v1 = acc[ai][bj][m][1];
                        ss += (v0[0] * v0[0] + v0[1] * v0[1]) + (v0[2] * v0[2] + v0[3] * v0[3]) + (v1[0] * v1[0] + v1[1] * v1[1]) + (v1[2] * v1[2] + v1[3] * v1[3]);
                        *(u32x4*)(LAT + (size_t)row * 1024 + u.pn * 256 + bj * 128 + wc * 32 + 8 * fq) = pack8(v0, v1); }
                    ss += __shfl_xor(ss, 16); ss += __shfl_xor(ss, 32);
                    if (fq == 0) SSQ[(size_t)row * 16 + u.pn * 4 + wc] = ss; }
        } else if (wc == 0) {
#pragma unroll
            for (int ai = 0; ai < 2; ++ai)
#pragma unroll
                for (int m = 0; m < 4; ++m) { const int row = EPI_ROW(u, ai, m);
                    const f32x4 c0 = *(const f32x4*)(CS + (size_t)row * 32 + 8 * fq), c1 = *(const f32x4*)(CS + (size_t)row * 32 + 8 * fq + 4);
                    const f32x4 s0 = *(const f32x4*)(SN + (size_t)row * 32 + 8 * fq), s1 = *(const f32x4*)(SN + (size_t)row * 32 + 8 * fq + 4);
                    const f32x4 a0 = acc[ai][0][m][0], a1 = acc[ai][0][m][1], b0 = acc[ai][1][m][0], b1 = acc[ai][1][m][1];
                    *(u32x4*)(KR + (size_t)row * 64 + 8 * fq) = pack8(a0 * c0 - b0 * s0, a1 * c1 - b1 * s1);
                    *(u32x4*)(KR + (size_t)row * 64 + 32 + 8 * fq) = pack8(b0 * c0 + a0 * s0, b1 * c1 + a1 * s1); }
        }
    }
};
struct EpiQ {
    static constexpr bool PERM = true;
    bf16_t* Q; const float* SSQ; const float* CS; const float* SN;
    __device__ __forceinline__ void operator()(const f32x4 (&acc)[2][2][4][2], const Unit& u, int wr, int wc, int fr, int fq) const {
#pragma unroll
        for (int ai = 0; ai < 2; ++ai)
#pragma unroll
            for (int m = 0; m < 4; ++m) { const int row = EPI_ROW(u, ai, m);
                const f32x4 q0 = *(const f32x4*)(SSQ + (size_t)row * 16), q1 = *(const f32x4*)(SSQ + (size_t)row * 16 + 4), q2 = *(const f32x4*)(SSQ + (size_t)row * 16 + 8);
                const float ss = ((q0[0] + q0[1]) + (q0[2] + q0[3])) + ((q1[0] + q1[1]) + (q1[2] + q1[3])) + ((q2[0] + q2[1]) + (q2[2] + q2[3]));
                const float r = QSCALE / sqrtf(ss * (1.0f / QL) + RMS_EPS);
                if (u.pn < 4) {
#pragma unroll
                    for (int bj = 0; bj < 2; ++bj)
                        *(u32x4*)(Q + (size_t)row * 1536 + (2 * u.pn + bj) * 192 + wc * 32 + 8 * fq) = pack8(acc[ai][bj][m][0] * r, acc[ai][bj][m][1] * r);
                } else {
                    const int head = 4 * (u.pn - 4) + wc;
                    const f32x4 c0 = *(const f32x4*)(CS + (size_t)row * 32 + 8 * fq), c1 = *(const f32x4*)(CS + (size_t)row * 32 + 8 * fq + 4);
                    const f32x4 s0 = *(const f32x4*)(SN + (size_t)row * 32 + 8 * fq), s1 = *(const f32x4*)(SN + (size_t)row * 32 + 8 * fq + 4);
                    const f32x4 a0 = acc[ai][0][m][0] * r, a1 = acc[ai][0][m][1] * r, b0 = acc[ai][1][m][0] * r, b1 = acc[ai][1][m][1] * r;
                    *(u32x4*)(Q + (size_t)row * 1536 + head * 192 + 128 + 8 * fq) = pack8(a0 * c0 - b0 * s0, a1 * c1 - b1 * s1);
                    *(u32x4*)(Q + (size_t)row * 1536 + head * 192 + 160 + 8 * fq) = pack8(b0 * c0 + a0 * s0, b1 * c1 + a1 * s1);
                }
                asm volatile("" ::: "memory"); }
    }
};
struct EpiKV {
    static constexpr bool PERM = true;
    bf16_t* KN; bf16_t* V; const float* SSQ;
    __device__ __forceinline__ void operator()(const f32x4 (&acc)[2][2][4][2], const Unit& u, int wr, int wc, int fr, int fq) const {
#pragma unroll
        for (int ai = 0; ai < 2; ++ai)
#pragma unroll
            for (int m = 0; m < 4; ++m) { const int row = EPI_ROW(u, ai, m);
                const f32x4 q3 = *(const f32x4*)(SSQ + (size_t)row * 16 + 12);
                const float r = 1.0f / sqrtf(((q3[0] + q3[1]) + (q3[2] + q3[3])) * (1.0f / KVL) + RMS_EPS);
                *(u32x4*)(KN + (size_t)row * 1024 + u.pn * 128 + wc * 32 + 8 * fq) = pack8(acc[ai][0][m][0] * r, acc[ai][0][m][1] * r);
                *(u32x4*)(V + (size_t)row * 1024 + u.pn * 128 + wc * 32 + 8 * fq) = pack8(acc[ai][1][m][0] * r, acc[ai][1][m][1] * r); }
    }
};
struct EpiRes {
    static constexpr bool PERM = false;
    const float* X; float* Y;
    __device__ __forceinline__ void operator()(const f32x4 (&acc)[2][2][4][2], const Unit& u, int wr, int wc, int fr, int fq) const {
#pragma unroll
        for (int ai = 0; ai < 2; ++ai)
#pragma unroll
            for (int m = 0; m < 4; ++m) { const size_t off = (size_t)EPI_ROW(u, ai, m) * 1024 + u.pn * 256 + wc * 32 + 4 * fq;
#pragma unroll
                for (int bj = 0; bj < 2; ++bj)
#pragma unroll
                    for (int n = 0; n < 2; ++n) { const f32x4 xv = *(const f32x4*)(X + off + bj * 128 + n * 16); *(f32x4*)(Y + off + bj * 128 + n * 16) = xv * ALPHA + acc[ai][bj][m][n]; }
                if (m & 1) asm volatile("" ::: "memory"); }
    }
};
struct EpiGU {
    static constexpr bool PERM = true;
    bf16_t* GG; bf16_t* U;
    __device__ __forceinline__ void operator()(const f32x4 (&acc)[2][2][4][2], const Unit& u, int wr, int wc, int fr, int fq) const {
#pragma unroll
        for (int ai = 0; ai < 2; ++ai)
#pragma unroll
            for (int m = 0; m < 4; ++m) { const int row = EPI_ROW(u, ai, m);
#pragma unroll
                for (int bj = 0; bj < 2; ++bj) { f32x4 v0 = acc[ai][bj][m][0], v1 = acc[ai][bj][m][1];
                    if (u.pn < 4) {
#pragma unroll
                        for (int e = 0; e < 4; ++e) { v0[e] = gelu_tanh(v0[e]); v1[e] = gelu_tanh(v1[e]); }
                        *(u32x4*)(GG + (size_t)row * 1024 + u.pn * 256 + bj * 128 + wc * 32 + 8 * fq) = pack8(v0, v1);
                    } else *(u32x4*)(U + (size_t)row * 1024 + (u.pn - 4) * 256 + bj * 128 + wc * 32 + 8 * fq) = pack8(v0, v1); } }
    }
};
struct EpiAB {
    static constexpr bool PERM = false;
    float* AA; float* BB; const bf16_t* UC; const float* BA; const float* BX; const float* SPL;
    __device__ __forceinline__ void operator()(const f32x4 (&acc)[2][2][4][2], const Unit& u, int wr, int wc, int fr, int fq) const {
        const int ch0 = (u.pn >> 1) * 256 + (u.pn & 1) * 128 + wc * 32 + 4 * fq;
#pragma unroll
        for (int n = 0; n < 2; ++n) { const int ch = ch0 + 16 * n;
            const f32x4 ba = *(const f32x4*)(BA + ch), bx = *(const f32x4*)(BX + ch), sp = *(const f32x4*)(SPL + ch);
#pragma unroll
            for (int ai = 0; ai < 2; ++ai)
#pragma unroll
                for (int m = 0; m < 4; ++m) { const size_t off = (size_t)EPI_ROW(u, ai, m) * 1024 + ch;
                    const u32x2 uw = *(const u32x2*)(UC + off); const float uv[4] = {bf_lo(uw.x), bf_hi(uw.x), bf_lo(uw.y), bf_hi(uw.y)};
                    f32x4 av, bv;
#pragma unroll
                    for (int e = 0; e < 4; ++e) { const float r = sigmoidf_(acc[ai][0][m][n][e] + ba[e]), ig = sigmoidf_(acc[ai][1][m][n][e] + bx[e]);
                        const float la = sp[e] * r, x2 = 2.0f * la; av[e] = __expf(la);
                        const float om = x2 > -0.25f ? -x2 * (1.0f + x2 * (0.5f + x2 * (0.16666667f + x2 * (0.041666668f + x2 * 0.0083333338f)))) : 1.0f - __expf(x2);
                        bv[e] = sqrtf(om) * ig * uv[e]; }
                    *(f32x4*)(AA + off) = av; *(f32x4*)(BB + off) = bv; asm volatile("" ::: "memory"); } }
    }
};
struct EpiUp {
    static constexpr bool PERM = true;
    bf16_t* H; const float* BU;
    __device__ __forceinline__ void operator()(const f32x4 (&acc)[2][2][4][2], const Unit& u, int wr, int wc, int fr, int fq) const {
        const int gc = u.pn * 128 + wc * 32 + 8 * fq; const float* bu = BU + (size_t)u.aux * 2048;
        const f32x4 bg0 = *(const f32x4*)(bu + gc), bg1 = *(const f32x4*)(bu + gc + 4), bp0 = *(const f32x4*)(bu + 1024 + gc), bp1 = *(const f32x4*)(bu + 1024 + gc + 4);
#pragma unroll
        for (int ai = 0; ai < 2; ++ai)
#pragma unroll
            for (int m = 0; m < 4; ++m) { const int row = EPI_ROW(u, ai, m);
                f32x4 y0, y1;
#pragma unroll
                for (int e = 0; e < 4; ++e) {
                    float g = fminf(acc[ai][0][m][0][e] + bg0[e], 7.0f), up = fminf(fmaxf(acc[ai][1][m][0][e] + bp0[e], -7.0f), 7.0f); y0[e] = (up + 1.0f) * (g * sigmoidf_(1.702f * g));
                    g = fminf(acc[ai][0][m][1][e] + bg1[e], 7.0f); up = fminf(fmaxf(acc[ai][1][m][1][e] + bp1[e], -7.0f), 7.0f); y1[e] = (up + 1.0f) * (g * sigmoidf_(1.702f * g)); }
                *(u32x4*)(H + (size_t)row * 1024 + gc) = pack8(y0, y1); }
    }
};
struct EpiDown {
    static constexpr bool PERM = true;
    bf16_t* YS; const float* BD;
    __device__ __forceinline__ void operator()(const f32x4 (&acc)[2][2][4][2], const Unit& u, int wr, int wc, int fr, int fq) const {
        const float* bd = BD + (size_t)u.aux * 1024;
#pragma unroll
        for (int bj = 0; bj < 2; ++bj) { const int col = u.pn * 256 + bj * 128 + wc * 32 + 8 * fq; const f32x4 b0 = *(const f32x4*)(bd + col), b1 = *(const f32x4*)(bd + col + 4);
#pragma unroll
            for (int ai = 0; ai < 2; ++ai)
#pragma unroll
                for (int m = 0; m < 4; ++m) *(u32x4*)(YS + (size_t)EPI_ROW(u, ai, m) * 1024 + col) = pack8(acc[ai][bj][m][0] + b0, acc[ai][bj][m][1] + b1); }
    }
};
struct EpiPle {
    static constexpr bool PERM = false;
    const float* X2; const bf16_t* PP; float* XF; bf16_t* XB;
    __device__ __forceinline__ void operator()(const f32x4 (&acc)[2][2][4][2], const Unit& u, int wr, int wc, int fr, int fq) const {
#pragma unroll
        for (int ai = 0; ai < 2; ++ai)
#pragma unroll
            for (int m = 0; m < 4; ++m) { const size_t off = (size_t)EPI_ROW(u, ai, m) * 1024 + u.pn * 256 + wc * 32 + 4 * fq;
#pragma unroll
                for (int bj = 0; bj < 2; ++bj)
#pragma unroll
                    for (int n = 0; n < 2; ++n) { const size_t o = off + bj * 128 + n * 16; const f32x4 xv = *(const f32x4*)(X2 + o); const u32x2 pw = *(const u32x2*)(PP + o);
                        const f32x4 a = acc[ai][bj][m][n]; f32x4 r;
                        r[0] = xv[0] + sigmoidf_(a[0]) * bf_lo(pw.x); r[1] = xv[1] + sigmoidf_(a[1]) * bf_hi(pw.x); r[2] = xv[2] + sigmoidf_(a[2]) * bf_lo(pw.y); r[3] = xv[3] + sigmoidf_(a[3]) * bf_hi(pw.y);
                        *(f32x4*)(XF + o) = r; u32x2 w; w.x = cvt_pk_bf16(r[0], r[1]); w.y = cvt_pk_bf16(r[2], r[3]); *(u32x2*)(XB + o) = w; }
                if (m & 1) asm volatile("" ::: "memory"); }
    }
};
struct EpiPP {
    static constexpr bool PERM = true;
    bf16_t* PP;
    __device__ __forceinline__ void operator()(const f32x4 (&acc)[2][2][4][2], const Unit& u, int wr, int wc, int fr, int fq) const {
#pragma unroll
        for (int ai = 0; ai < 2; ++ai)
#pragma unroll
            for (int m = 0; m < 4; ++m)
#pragma unroll
                for (int bj = 0; bj < 2; ++bj) *(u32x4*)(PP + (size_t)EPI_ROW(u, ai, m) * 1024 + u.pn * 256 + bj * 128 + wc * 32 + 8 * fq) = pack8(acc[ai][bj][m][0], acc[ai][bj][m][1]);
    }
};
}

namespace att {
constexpr int NW = 8, QBLK = 32, KVBLK = 64, QB = 256, KPITCH = 384;
constexpr int SHM_V = KVBLK * DV * 2, SHM_K = KVBLK * KPITCH;
constexpr int OFF_V = 0, OFF_K = 2 * SHM_V, OFF_WS = OFF_K + 2 * SHM_K, LDS_BYTES = OFF_WS + NW * 64 * 4;
#define SBAR() __builtin_amdgcn_sched_barrier(0)
__device__ __forceinline__ int k_addr(int row, int chunk) { return row * KPITCH + ((chunk ^ ((row >> 1) & 7)) << 4); }
__device__ __forceinline__ int v_st(int k, int c) { const int kk = (k & ~0xC) | ((k & 4) << 1) | ((k & 8) >> 1); return ((kk >> 3) * 4 + (c >> 5)) * 512 + ((kk & 7) * 32 + (c & 31)) * 2; }
__device__ __forceinline__ int v_rd_base(int lane) { return ((lane & 3) << 3) | (((lane >> 2) & 3) << 6) | (((lane >> 4) & 1) << 5) | (((lane >> 5) & 1) << 8); }
constexpr int v_rd_off(int d0, int ks, int half) { return d0 * 512 + ks * 4096 + half * 2048; }
__device__ __forceinline__ int crow(int r, int hi) { return (r & 3) + 8 * (r >> 2) + 4 * hi; }

template <int KB>
__device__ __forceinline__ void qkt(f32x16& p0, f32x16& p1, const LAS char* K_lds, int r32, int hi, const bf16x8* qr) {
    p0 = f32x16{}; p1 = f32x16{};
    const LAS char* kb[4];
#pragma unroll
    for (int dd = 0; dd < 4; ++dd) kb[dd] = K_lds + KB * SHM_K + r32 * KPITCH + (((2 * dd + hi) ^ ((r32 >> 1) & 7)) << 4);
#pragma unroll
    for (int dg = 0; dg < 3; ++dg) {
#pragma unroll
        for (int dd = 0; dd < 4; ++dd) { const int d0 = dg * 4 + dd; const LAS char* a = kb[dd] + dg * 128;
            const bf16x8 b0 = *(const LAS bf16x8*)a;
            const bf16x8 b1 = *(const LAS bf16x8*)(a + 32 * KPITCH);
            p0 = __builtin_amdgcn_mfma_f32_32x32x16_bf16(b0, qr[d0], p0, 0, 0, 0);
            p1 = __builtin_amdgcn_mfma_f32_32x32x16_bf16(b1, qr[d0], p1, 0, 0, 0); }
        SBAR(); }
}
template <int VB>
__device__ __forceinline__ void pv_tile(f32x16* o, int vb0, bf16x8 pa0, bf16x8 pa1, bf16x8 pa2, bf16x8 pa3) {
#define TRRD(dst, off) asm volatile("ds_read_b64_tr_b16 %0, %1 offset:%2" : "=&v"(dst) : "v"(vb0), "i"(off) : "memory")
#define PV_D0(d0) do { s16x4 l0, l1, l2, l3, h0, h1, h2, h3; constexpr int b_ = OFF_V + VB * SHM_V + v_rd_off(d0, 0, 0); \
        TRRD(l0, b_); TRRD(h0, b_ + 2048); TRRD(l1, b_ + 4096); TRRD(h1, b_ + 6144); TRRD(l2, b_ + 8192); TRRD(h2, b_ + 10240); TRRD(l3, b_ + 12288); TRRD(h3, b_ + 14336); \
        asm volatile("s_waitcnt lgkmcnt(0)" ::: "memory"); SBAR(); \
        o[d0] = __builtin_amdgcn_mfma_f32_32x32x16_bf16(pa0, (bf16x8){l0[0], l0[1], l0[2], l0[3], h0[0], h0[1], h0[2], h0[3]}, o[d0], 0, 0, 0); \
        o[d0] = __builtin_amdgcn_mfma_f32_32x32x16_bf16(pa1, (bf16x8){l1[0], l1[1], l1[2], l1[3], h1[0], h1[1], h1[2], h1[3]}, o[d0], 0, 0, 0); \
        o[d0] = __builtin_amdgcn_mfma_f32_32x32x16_bf16(pa2, (bf16x8){l2[0], l2[1], l2[2], l2[3], h2[0], h2[1], h2[2], h2[3]}, o[d0], 0, 0, 0); \
        o[d0] = __builtin_amdgcn_mfma_f32_32x32x16_bf16(pa3, (bf16x8){l3[0], l3[1], l3[2], l3[3], h3[0], h3[1], h3[2], h3[3]}, o[d0], 0, 0, 0); } while (0)
    PV_D0(0); PV_D0(1); PV_D0(2); PV_D0(3);
#undef PV_D0
#undef TRRD
}
__device__ __forceinline__ void mask_tile(f32x16& p0, f32x16& p1, int dq  ) {
    const float NEG = -__builtin_inff();
#pragma unroll
    for (int r = 0; r < 16; ++r) { const int c = (r & 3) + 8 * (r >> 2);
        if (c > dq) p0[r] = NEG;
        if (c + 32 > dq) p1[r] = NEG; }
}
__device__ __forceinline__ void softmax_tile(f32x16& p0, f32x16& p1, float& m_reg, float& l_reg, float& alpha, bf16x8& pa0, bf16x8& pa1, bf16x8& pa2, bf16x8& pa3) {
    float pmax = p0[0];
#pragma unroll
    for (int r = 1; r < 16; ++r) pmax = fmaxf(pmax, p0[r]);
#pragma unroll
    for (int r = 0; r < 16; ++r) pmax = fmaxf(pmax, p1[r]);
    { auto rr = __builtin_amdgcn_permlane32_swap(__float_as_uint(pmax), __float_as_uint(pmax), false, false); pmax = fmaxf(__uint_as_float(rr[0]), __uint_as_float(rr[1])); }
    const float mn = fmaxf(m_reg, pmax); alpha = __builtin_amdgcn_exp2f(m_reg - mn); m_reg = mn;
    float ps = 0.f;
#pragma unroll
    for (int r = 0; r < 16; ++r) { p0[r] = __builtin_amdgcn_exp2f(p0[r] - mn); ps += p0[r]; }
#pragma unroll
    for (int r = 0; r < 16; ++r) { p1[r] = __builtin_amdgcn_exp2f(p1[r] - mn); ps += p1[r]; }
    { auto rr = __builtin_amdgcn_permlane32_swap(__float_as_uint(ps), __float_as_uint(ps), false, false); ps = __uint_as_float(rr[0]) + __uint_as_float(rr[1]); }
    l_reg = l_reg * alpha + ps;
#define PK4(P, B_, OUT) do { unsigned a0 = cvt_pk_bf16(P[B_+0], P[B_+1]), a1 = cvt_pk_bf16(P[B_+2], P[B_+3]); \
        unsigned b0 = cvt_pk_bf16(P[B_+4], P[B_+5]), b1 = cvt_pk_bf16(P[B_+6], P[B_+7]); \
        auto r0 = __builtin_amdgcn_permlane32_swap(a0, b0, false, false); auto r1 = __builtin_amdgcn_permlane32_swap(a1, b1, false, false); \
        u32x4 w = {r0[0], r1[0], r0[1], r1[1]}; OUT = __builtin_bit_cast(bf16x8, w); } while (0)
    PK4(p0, 0, pa0); PK4(p0, 8, pa1); PK4(p1, 0, pa2); PK4(p1, 8, pa3);
#undef PK4
}

__device__ __forceinline__ void attn_block(int b, int h, int qb, const bf16_t* Q, const bf16_t* KN, const bf16_t* KR, const bf16_t* V, bf16_t* O, LAS char* lds) {
    const int tid = opaque_tid(), wid = __builtin_amdgcn_readfirstlane(tid >> 6), lane = tid & 63, r32 = lane & 31, hi = lane >> 5;
    const size_t row0 = (size_t)b * SEQ;
    const int q0 = qb * QB + wid * QBLK;
    const int NT = (qb + 1) * (QB / KVBLK);
    LAS char* V_lds = lds + OFF_V; LAS char* K_lds = lds + OFF_K;
    LAS float* ws = (LAS float*)(lds + OFF_WS) + wid * 64; LAS float* li_l = ws; LAS float* al_l = ws + 32;
    const int sr = tid >> 4, sc = (tid & 15) * 8, kr_row = tid >> 3, kr_c = tid & 7;
    const int vst0 = v_st(sr, sc), vst1 = v_st(32 + sr, sc), kws = k_addr(sr, tid & 15), kwr = k_addr(kr_row, 16 + kr_c);
    const int vb0 = (int)(uintptr_t)lds + v_rd_base(lane);
    const bf16_t* KNh = KN + row0 * 1024 + h * 128 + sc; const bf16_t* Vh = V + row0 * 1024 + h * 128 + sc; const bf16_t* KRb = KR + row0 * 64 + kr_c * 8;
    bf16x8 st_k0, st_k1, st_kr, st_v0, st_v1;
#define SLOAD(t) do { const size_t k0_ = (size_t)(t) * KVBLK; \
        st_k0 = *(const bf16x8*)(KNh + (k0_ + sr) * 1024); st_k1 = *(const bf16x8*)(KNh + (k0_ + 32 + sr) * 1024); st_kr = *(const bf16x8*)(KRb + (k0_ + kr_row) * 64); \
        st_v0 = *(const bf16x8*)(Vh + (k0_ + sr) * 1024); st_v1 = *(const bf16x8*)(Vh + (k0_ + 32 + sr) * 1024); } while (0)
#define SWRITE(bf) do { *(LAS bf16x8*)(K_lds + (bf) * SHM_K + kws) = st_k0; *(LAS bf16x8*)(K_lds + (bf) * SHM_K + kws + 32 * KPITCH) = st_k1; *(LAS bf16x8*)(K_lds + (bf) * SHM_K + kwr) = st_kr; \
        *(LAS bf16x8*)(V_lds + (bf) * SHM_V + vst0) = st_v0; *(LAS bf16x8*)(V_lds + (bf) * SHM_V + vst1) = st_v1; } while (0)
    SLOAD(0);
    bf16x8 qr[12];
    { const bf16_t* Qw = Q + (row0 + q0 + r32) * 1536 + h * 192 + hi * 8;
#pragma unroll
      for (int d0 = 0; d0 < 12; ++d0) qr[d0] = *(const bf16x8*)(Qw + d0 * 16); }
    float m_reg = -1e30f, l_reg = 0.f; f32x16 o[4] = {};
    f32x16 p0, p1; bf16x8 pa0, pa1, pa2, pa3; float alpha;
    asm volatile("s_waitcnt vmcnt(0)" ::: "memory");
    SWRITE(0);
    __syncthreads();
#define RESC(a) do { if (__any((a) < 1.f)) { if (hi == 0) al_l[r32] = (a); asm volatile("s_waitcnt lgkmcnt(0)" ::: "memory"); \
        _Pragma("unroll") for (int d_ = 0; d_ < 4; ++d_) _Pragma("unroll") for (int r = 0; r < 16; ++r) o[d_][r] *= al_l[crow(r, hi)]; } } while (0)
#define TILE(t, BF) do { const bool more_ = ((t) + 1 < NT); if (more_) SLOAD((t) + 1); SBAR(); \
        qkt<BF>(p0, p1, K_lds, r32, hi, qr); \
        { const int kb_ = (t) * KVBLK; if (kb_ + KVBLK - 1 > q0) mask_tile(p0, p1, q0 + r32 - kb_ - 4 * hi); } \
        softmax_tile(p0, p1, m_reg, l_reg, alpha, pa0, pa1, pa2, pa3); RESC(alpha); SBAR(); \
        pv_tile<BF>(o, vb0, pa0, pa1, pa2, pa3); \
        if (more_) { asm volatile("s_waitcnt vmcnt(0)" ::: "memory"); SWRITE((BF) ^ 1); } \
        __syncthreads(); } while (0)
#pragma unroll 1
    for (int t = 0; t < NT; t += 2) { TILE(t, 0); TILE(t + 1, 1); }
    if (hi == 0) li_l[r32] = l_reg; asm volatile("s_waitcnt lgkmcnt(0)" ::: "memory");
    bf16_t* Ow = O + (row0 + q0) * 1024 + h * 128;
#pragma unroll
    for (int r = 0; r < 16; ++r) { const int orow = crow(r, hi); const float rl = __builtin_amdgcn_rcpf(li_l[orow]);
#pragma unroll
        for (int d0 = 0; d0 < 4; ++d0) { const float v = o[d0][r] * rl; const float vn = __shfl_xor(v, 1);
            if ((r32 & 1) == 0) *(unsigned*)(Ow + (size_t)orow * 1024 + d0 * 32 + r32) = cvt_pk_bf16(v, vn); } }
    __syncthreads();
#undef SLOAD
#undef SWRITE
#undef RESC
#undef TILE
}
#undef SBAR
}

#define XB_TMO      128
#define XB_XCNT(j)  (256  + 64 * (j))
#define XB_XSUB(j)  (1280 + 64 * (j))
#define XB_XGEN(j)  (2304 + 64 * (j))
#define XB_TOP      3328
#define XB_TOPGEN   3392
#define XCD_BAR_WORDS 3456
#define XB_SPIN_CAP (1u << 22)
__device__ __forceinline__ unsigned xb_ld(unsigned* p)              { return __hip_atomic_load(p, __ATOMIC_RELAXED, __HIP_MEMORY_SCOPE_AGENT); }
__device__ __forceinline__ unsigned xb_add(unsigned* p, unsigned v) { return __hip_atomic_fetch_add(p, v, __ATOMIC_RELAXED, __HIP_MEMORY_SCOPE_AGENT); }
__device__ __forceinline__ unsigned xb_xcc_id() { return (unsigned)__builtin_amdgcn_s_getreg((3 << 11) | 20) & 0xFu; }
#define XB_SPIN(cond, bar) do { unsigned _sp = 0; while (cond) { __builtin_amdgcn_s_sleep(1); \
    if ((++_sp & 255u) == 0u) { if (xb_ld(&(bar)[XB_TMO])) break; if (_sp > XB_SPIN_CAP) { atomicAdd(&(bar)[XB_TMO], 1u); break; } } } } while (0)
struct XcdBarrier { unsigned* bar; unsigned x; volatile LAS unsigned* st; };
__device__ __forceinline__ XcdBarrier xcd_barrier_post(unsigned* bar, volatile LAS unsigned* st) {
    XcdBarrier b; b.bar = bar; b.x = xb_xcc_id(); b.st = st;
    if (threadIdx.x == 0) (void)xb_add(&bar[XB_XCNT(b.x)], 1u);
    return b;
}
__device__ __forceinline__ void xcd_barrier_complete(unsigned* bar, unsigned x, unsigned& nloc, unsigned& nx) {
    const unsigned G = gridDim.x * gridDim.y * gridDim.z;
    unsigned sum, cnt, mine, sp = 0u;
    for (;;) {
        sum = 0u; cnt = 0u; mine = 0u;
#pragma unroll
        for (unsigned j = 0; j < 16; ++j) { const unsigned c = xb_ld(&bar[XB_XCNT(j)]); sum += c; cnt += (c > 0u) ? 1u : 0u; mine = (j == x) ? c : mine; }
        if (sum == G) break;
        __builtin_amdgcn_s_sleep(1);
        if ((++sp & 255u) == 0u) { if (xb_ld(&bar[XB_TMO])) break; if (sp > XB_SPIN_CAP) { atomicAdd(&bar[XB_TMO], 1u); break; } }
    }
    nloc = mine > 0u ? mine : 1u; nx = cnt > 0u ? cnt : 1u;
}
__device__ __forceinline__ void xcd_barrier(const XcdBarrier& b) {
    asm volatile("s_waitcnt vmcnt(0)" ::: "memory");
    __syncthreads();
    if (threadIdx.x == 0) {
        unsigned* bar = b.bar;
        __builtin_amdgcn_s_waitcnt(0);
        unsigned nloc = b.st[0], nx = b.st[1];
        if (nloc == 0u) { xcd_barrier_complete(bar, b.x, nloc, nx); b.st[0] = nloc; b.st[1] = nx; }
        const unsigned old = xb_add(&bar[XB_XSUB(b.x)], 1u);
        const unsigned gen = old / nloc;
        if (old + 1u == (gen + 1u) * nloc) {
            __builtin_amdgcn_fence(__ATOMIC_RELEASE, "agent");
            asm volatile("s_waitcnt vmcnt(0)" ::: "memory");
            const unsigned og = xb_add(&bar[XB_TOP], 1u);
            const unsigned tg = og / nx;
            if (og + 1u == (tg + 1u) * nx) xb_add(&bar[XB_TOPGEN], 1u);
            else XB_SPIN(xb_ld(&bar[XB_TOPGEN]) == tg, bar);
            __builtin_amdgcn_fence(__ATOMIC_ACQUIRE, "agent");
            xb_add(&bar[XB_XGEN(b.x)], 1u);
            asm volatile("s_waitcnt vmcnt(0)" ::: "memory");
        } else {
            XB_SPIN(xb_ld(&bar[XB_XGEN(b.x)]) == gen, bar);
            __builtin_amdgcn_fence(__ATOMIC_ACQUIRE, "agent");
            asm volatile("s_waitcnt vmcnt(0)" ::: "memory");
        }
    }
    __syncthreads();
}

struct Args { const void* in[30]; float* out; unsigned char* ws; int ph_lo, ph_hi, li, pad; };
struct Ctx { int tid, lane, wave, vcu, G; LAS unsigned char* lds; volatile LAS int* misc; };
typedef const CAS Args* ArgsP;
__device__ __forceinline__ const CAS Args& fresh_args(ArgsP p) { asm volatile("" : "+s"(p)); return *p; }
enum { I_X = 0, I_P, I_POS, I_MLA_WIN, I_MLA_QN, I_MLA_KVN, I_MLA_WUQ, I_MLA_WUKV, I_MLA_WO, I_LRU_WIN, I_LRU_CW, I_LRU_CB, I_LRU_WA, I_LRU_BA, I_LRU_WX, I_LRU_BX, I_LRU_LAM, I_LRU_WOUT,
       I_LN1G, I_LN1B, I_LN2G, I_LN2B, I_MOE_WR, I_MOE_BR, I_MOE_WUP, I_MOE_BUP, I_MOE_WDN, I_MOE_BDN, I_PLE_WG, I_PLE_WP };
#define INF(i) ((const float*)args.in[i])
#define WSP(T_, off) ((T_*)(args.ws + (off)))

__device__ __forceinline__ void tr_item(const float* W, int ld, int k0, int sc0, int sc1, const float* ksc, bf16_t* dst  , int K, LAS float* scr, int lane) {
    const int half = (lane & 15) >> 3, scol = half ? sc1 : sc0, c4 = (lane & 7) * 4, rsub = lane >> 4;
    f32x4 v[16];
#pragma unroll
    for (int i = 0; i < 16; ++i) { const int kk = 4 * i + rsub;
        v[i] = (scol >= 0) ? *(const f32x4*)(W + (size_t)(k0 + kk) * ld + scol + c4) : (f32x4){0.f, 0.f, 0.f, 0.f}; }
    if (ksc) {
#pragma unroll
        for (int i = 0; i < 16; ++i) v[i] = v[i] * ksc[k0 + 4 * i + rsub]; }
#pragma unroll
    for (int i = 0; i < 16; ++i) { LAS float* s = scr + (4 * i + rsub) * 65 + (lane & 15) * 4; s[0] = v[i][0]; s[1] = v[i][1]; s[2] = v[i][2]; s[3] = v[i][3]; }
    asm volatile("s_waitcnt lgkmcnt(0)" ::: "memory");
    const int c = lane & 7;
#pragma unroll
    for (int j = 0; j < 8; ++j) { const int n = (lane >> 3) + 8 * j; const LAS float* s = scr + (8 * c) * 65 + n;
        u32x4 o; o.x = cvt_pk_bf16(s[0 * 65], s[1 * 65]); o.y = cvt_pk_bf16(s[2 * 65], s[3 * 65]); o.z = cvt_pk_bf16(s[4 * 65], s[5 * 65]); o.w = cvt_pk_bf16(s[6 * 65], s[7 * 65]);
        *(u32x4*)(dst + (size_t)n * K + 8 * c) = o; }
    asm volatile("s_waitcnt lgkmcnt(0)" ::: "memory");
}
enum { J_NAT = 0, J_MLA_WIN, J_MLA_WUQ, J_LRU_WAX, J_MOE_UP };
__device__ __forceinline__ int tr_map(int job, int g) {
    switch (job) {
    case J_MLA_WIN: return g < 32 ? 32 * g : (g == 32 ? 1024 : (g == 36 ? 1056 : -1));
    case J_MLA_WUQ: if (g < 32) { const int t = g >> 3, bj = (g >> 2) & 1, cg = g & 3; return (2 * t + bj) * 192 + 32 * cg; }
                    else { const int g2 = g - 32, t2 = g2 >> 3, bj = (g2 >> 2) & 1, hh = g2 & 3; return (4 * t2 + hh) * 192 + 128 + 32 * bj; }
    case J_LRU_WAX: { const int pn = g >> 3, cg = g & 3; return 128 * pn + 32 * cg; }
    case J_MOE_UP:  { const int pn = g >> 3, bj = (g >> 2) & 1, cg = g & 3; return bj * 1024 + 128 * pn + 32 * cg; }
    default: return 32 * g;
    }
}
__device__ __forceinline__ void tr_job(const Ctx& C, int job, const float* src, size_t srcstride, int nmat, int K, int ld, int N, bf16_t* dst, size_t dststride, const float* ksc, int kscstride,
                                       const float* src2  ) {
    LAS float* scr = (LAS float*)(C.lds + C.wave * 16640);
    const int gw = C.vcu * NWAVES + C.wave, NGW = C.G * NWAVES;
    const int nkb = K / 64, nnb = N / 64, per = nkb * nnb, total = per * nmat;
    for (int it = gw; it < total; it += NGW) {
        const int mat = it / per, r = it - mat * per, kb = r / nnb, nb = r - kb * nnb;
        int s0 = tr_map(job, 2 * nb), s1 = tr_map(job, 2 * nb + 1);
        const float* W = src + (size_t)mat * srcstride;
        if (job == J_LRU_WAX && ((nb >> 1) & 1)) W = src2 + (size_t)mat * srcstride;
        tr_item(W, ld, kb * 64, s0, s1, ksc ? ksc + (size_t)mat * kscstride : nullptr, (bf16_t*)((char*)dst + (size_t)mat * dststride) + (size_t)(nb * 64) * K + kb * 64, K, scr, C.lane);
    }
}
__device__ __forceinline__ void cvt_rows(const Ctx& C, const float* src, bf16_t* dst, size_t n8  ) {
    const size_t gt = (size_t)C.vcu * 512 + C.tid, NT = (size_t)C.G * 512;
    for (size_t i = gt; i < n8; i += NT) { const f32x4 a = *(const f32x4*)(src + i * 8), b = *(const f32x4*)(src + i * 8 + 4); *(u32x4*)(dst + i * 8) = pack8(a, b); }
}
__device__ __forceinline__ void phase_prologue(const CAS Args& args, const Ctx& C) {
    tr_job(C, J_MLA_WIN, INF(I_MLA_WIN), (size_t)DM * LATD, 2, DM, LATD, 1280, WSP(bf16_t, WS_W_MLA + OFF_MLA_WIN), W_MLA_STRIDE, nullptr, 0, nullptr);
    tr_job(C, J_MLA_WUQ, INF(I_MLA_WUQ), (size_t)QL * 1536, 2, QL, 1536, 1536, WSP(bf16_t, WS_W_MLA + OFF_MLA_WUQ), W_MLA_STRIDE, INF(I_MLA_QN), QL, nullptr);
    tr_job(C, J_NAT, INF(I_MLA_WUKV), (size_t)KVL * 2048, 2, KVL, 2048, 2048, WSP(bf16_t, WS_W_MLA + OFF_MLA_WUKV), W_MLA_STRIDE, INF(I_MLA_KVN), KVL, nullptr);
    tr_job(C, J_NAT, INF(I_MLA_WO), (size_t)DM * DM, 2, DM, DM, DM, WSP(bf16_t, WS_W_MLA + OFF_MLA_WO), W_MLA_STRIDE, nullptr, 0, nullptr);
    tr_job(C, J_NAT, INF(I_LRU_WIN), (size_t)DM * 2048, 2, DM, 2048, 2048, WSP(bf16_t, WS_W_LRU + OFF_LRU_WIN), W_LRU_STRIDE, nullptr, 0, nullptr);
    for (int j = 0; j < 2; ++j)
        tr_job(C, J_LRU_WAX, INF(I_LRU_WA) + (size_t)j * 4 * 65536, (size_t)256 * 256, 4, 256, 256, 512, WSP(bf16_t, WS_W_LRU + OFF_LRU_WAX + (size_t)j * W_LRU_STRIDE), (size_t)512 * 256 * 2, nullptr, 0, INF(I_LRU_WX) + (size_t)j * 4 * 65536);
    tr_job(C, J_NAT, INF(I_LRU_WOUT), (size_t)DM * DM, 2, DM, DM, DM, WSP(bf16_t, WS_W_LRU + OFF_LRU_WOUT), W_LRU_STRIDE, nullptr, 0, nullptr);
    tr_job(C, J_NAT, INF(I_PLE_WG), (size_t)DM * DM, 4, DM, DM, DM, WSP(bf16_t, WS_W_PLE + OFF_PLE_WG), W_PLE_STRIDE, nullptr, 0, nullptr);
    tr_job(C, J_NAT, INF(I_PLE_WP), (size_t)PLED * DM, 4, PLED, DM, DM, WSP(bf16_t, WS_W_PLE + OFF_PLE_WP), W_PLE_STRIDE, nullptr, 0, nullptr);
    tr_job(C, J_MOE_UP, INF(I_MOE_WUP), (size_t)DM * 2048, DEPTH * NE, DM, 2048, 2048, WSP(bf16_t, WS_W_UP), (size_t)2048 * 1024 * 2, nullptr, 0, nullptr);
    tr_job(C, J_NAT, INF(I_MOE_WDN), (size_t)DFF * DM, DEPTH * NE, DFF, DM, DM, WSP(bf16_t, WS_W_DN), (size_t)1024 * 1024 * 2, nullptr, 0, nullptr);
    cvt_rows(C, INF(I_X), WSP(bf16_t, WS_XB), (size_t)T * DM / 8);
    cvt_rows(C, INF(I_P), WSP(bf16_t, WS_PB), (size_t)DEPTH * T * PLED / 8);
    { const int* pos = (const int*)args.in[I_POS]; float* CS = WSP(float, WS_CS); float* SN = WSP(float, WS_SN);
      const size_t gt = (size_t)C.vcu * 512 + C.tid, NT = (size_t)C.G * 512;
      for (size_t i = gt; i < (size_t)T * 32; i += NT) { const int tok = (int)(i >> 5), j = (int)(i & 31);
          const double inv = exp(-9.210340371976184 * (double)j / 32.0); const double ang = (double)pos[tok] * inv; double s, c; sincos(ang, &s, &c); CS[i] = (float)c; SN[i] = (float)s; }
      float* SPL = WSP(float, WS_SPL); const float* lam = INF(I_LRU_LAM);
      for (size_t i = gt; i < 2 * 1024; i += NT) { const double l = (double)lam[i]; SPL[i] = (float)(-8.0 * log1p(exp(-l))); } }
}

__device__ __forceinline__ void moe_table(const CAS Args& args, const Ctx& C0, int layer) {
    Ctx C = C0; C.tid = opaque_tid(); C.lane = C.tid & 63;
    const unsigned* cnt = WSP(unsigned, WS_CTL) + CW_CNT + 64 * layer;
    __syncthreads();
    if (C.tid < 32) C.misc[64 + C.tid] = (int)__hip_atomic_load(cnt + C.tid, __ATOMIC_RELAXED, __HIP_MEMORY_SCOPE_AGENT);
    __syncthreads();
    if (C.tid == 0) { int acc = 0; for (int e = 0; e < 32; ++e) { C.misc[16 + e] = acc; acc += (C.misc[64 + e] + 255) >> 8; } C.misc[16 + 32] = acc; }
    __syncthreads();
}

__device__ __forceinline__ void phase_ln_router(const CAS Args& args, const Ctx& C0, int layer) {
    Ctx C = C0; C.tid = opaque_tid(); C.lane = C.tid & 63;
    const float* Y = WSP(float, WS_Y); float* X1 = WSP(float, WS_X1); bf16_t* X1B = WSP(bf16_t, WS_X1B);
    const float* g1 = INF(I_LN1G) + layer * DM; const float* b1 = INF(I_LN1B) + layer * DM;
    const CAS float* Wr = (const CAS float*)(INF(I_MOE_WR) + (size_t)layer * DM * NE); const float* br = INF(I_MOE_BR) + layer * NE;
    unsigned* gcnt = WSP(unsigned, WS_CTL) + CW_CNT + 64 * layer;
    int* lists = WSP(int, WS_LIST); int* slot = WSP(int, WS_SLOT); float* gate = WSP(float, WS_GATE);
    LAS float* part = (LAS float*)C.lds;
    volatile LAS int* lcnt = (volatile LAS int*)(C.lds + 69632);
    volatile LAS int* lbase = lcnt + 32;
    f32x4 gv[4], bv[4];
#pragma unroll
    for (int j = 0; j < 4; ++j) { gv[j] = *(const f32x4*)(g1 + 4 * C.lane + 256 * j); bv[j] = *(const f32x4*)(b1 + 4 * C.lane + 256 * j); }
    for (int chunk = C.vcu; chunk < T / 128; chunk += C.G) {
        const int row0 = chunk * 128;
        if (C.tid < 32) lcnt[C.tid] = 0;
        for (int i = 0; i < 16; ++i) { const size_t row = (size_t)row0 + C.wave * 16 + i;
            const f32x4* yr = (const f32x4*)(Y + row * DM) + C.lane; f32x4 v[4]; float s = 0.f;
#pragma unroll
            for (int j = 0; j < 4; ++j) { v[j] = yr[64 * j]; s += (v[j][0] + v[j][1]) + (v[j][2] + v[j][3]); }
            const float mean = wave_sum(s) * (1.f / DM); float s2 = 0.f;
#pragma unroll
            for (int j = 0; j < 4; ++j) { v[j] = v[j] - mean; s2 += (v[j][0] * v[j][0] + v[j][1] * v[j][1]) + (v[j][2] * v[j][2] + v[j][3] * v[j][3]); }
            const float rstd = 1.f / sqrtf(wave_sum(s2) * (1.f / DM) + LN_EPS);
#pragma unroll
            for (int j = 0; j < 4; ++j) { const f32x4 o = v[j] * rstd * gv[j] + bv[j]; *((f32x4*)(X1 + row * DM) + C.lane + 64 * j) = o;
                u32x2 w; w.x = cvt_pk_bf16(o[0], o[1]); w.y = cvt_pk_bf16(o[2], o[3]); *((u32x2*)(X1B + row * DM) + C.lane + 64 * j) = w; } }
        asm volatile("s_waitcnt vmcnt(0)" ::: "memory");
        __syncthreads();
        { const int grp = C.wave >> 2, kq = C.wave & 3; const size_t tok = (size_t)row0 + grp * 64 + C.lane;
          float acc[32];
#pragma unroll
          for (int e = 0; e < 32; ++e) acc[e] = 0.f;
          const float* xr = X1 + tok * DM + kq * 256;
          for (int kk = 0; kk < 64; ++kk) { const f32x4 xv = *(const f32x4*)(xr + kk * 4);
#pragma unroll
              for (int i = 0; i < 4; ++i) { const CAS float* wrow = Wr + (size_t)(kq * 256 + kk * 4 + i) * NE;
#pragma unroll
                  for (int e = 0; e < 32; ++e) acc[e] = fmaf(xv[i], wrow[e], acc[e]); } }
          LAS float* pp = part + ((grp * 4 + kq) * 64 + C.lane) * 33;
#pragma unroll
          for (int e = 0; e < 32; ++e) pp[e] = acc[e]; }
        __syncthreads();
        int te[4] = {0, 0, 0, 0}, lp[4] = {0, 0, 0, 0}; float tg[4] = {0.f, 0.f, 0.f, 0.f};
        if (C.tid < 128) { const int grp = C.tid >> 6, ln = C.tid & 63; float lg[32];
#pragma unroll
            for (int e = 0; e < 32; ++e) { float s = br[e];
#pragma unroll
                for (int kq = 0; kq < 4; ++kq) s += part[((grp * 4 + kq) * 64 + ln) * 33 + e];
                lg[e] = s; }
            float tv[4];
#pragma unroll
            for (int k = 0; k < 4; ++k) { float best = -__builtin_inff(); int bi = 0;
#pragma unroll
                for (int e = 0; e < 32; ++e) { bool taken = false;
#pragma unroll
                    for (int q = 0; q < 4; ++q) if (q < k) taken = taken || (te[q] == e);
                    if (!taken && lg[e] > best) { best = lg[e]; bi = e; } }
                te[k] = bi; tv[k] = best; }
            float den = 0.f;
#pragma unroll
            for (int k = 0; k < 4; ++k) { tg[k] = __expf(tv[k] - tv[0]); den += tg[k]; }
            const float rden = 1.0f / den;
#pragma unroll
            for (int k = 0; k < 4; ++k) { tg[k] *= rden; lp[k] = __hip_atomic_fetch_add((LAS int*)&lcnt[te[k]], 1, __ATOMIC_RELAXED, __HIP_MEMORY_SCOPE_WORKGROUP); } }
        __syncthreads();
        if (C.tid < 32) lbase[C.tid] = (int)__hip_atomic_fetch_add(gcnt + C.tid, (unsigned)lcnt[C.tid], __ATOMIC_RELAXED, __HIP_MEMORY_SCOPE_AGENT);
        __syncthreads();
        if (C.tid < 128) { const int tok = row0 + C.tid;
#pragma unroll
            for (int k = 0; k < 4; ++k) { const int pos = lbase[te[k]] + lp[k]; lists[(size_t)te[k] * T + pos] = tok; slot[tok * 4 + k] = te[k] * T + pos; gate[tok * 4 + k] = tg[k]; } }
        __syncthreads();
    }
}

__device__ __forceinline__ void phase_combine_ln2(const CAS Args& args, const Ctx& C0, int layer) {
    Ctx C = C0; C.tid = opaque_tid(); C.lane = C.tid & 63;
    moe_table(args, C, layer);
    const float* X1 = WSP(float, WS_X1); const bf16_t* YS = WSP(bf16_t, WS_YS); const int* slot = WSP(int, WS_SLOT); const float* gate = WSP(float, WS_GATE);
    float* X2 = WSP(float, WS_X2); bf16_t* X2B = WSP(bf16_t, WS_X2B);
    const float* g2 = INF(I_LN2G) + layer * DM; const float* b2 = INF(I_LN2B) + layer * DM;
    f32x4 gv[4], bv[4];
#pragma unroll
    for (int j = 0; j < 4; ++j) { gv[j] = *(const f32x4*)(g2 + 4 * C.lane + 256 * j); bv[j] = *(const f32x4*)(b2 + 4 * C.lane + 256 * j); }
    const int gw = C.vcu * NWAVES + C.wave, NGW = C.G * NWAVES;
    for (int row = gw; row < T; row += NGW) {
        f32x4 v[4];
#pragma unroll
        for (int j = 0; j < 4; ++j) v[j] = *((const f32x4*)(X1 + (size_t)row * DM) + C.lane + 64 * j) * ALPHA;
#pragma unroll
        for (int k = 0; k < 4; ++k) { const int sv = slot[row * 4 + k]; const float g = gate[row * 4 + k]; const int e = sv >> 15, pos = sv & (T - 1);
            const size_t prow = (size_t)C.misc[16 + e] * 256 + pos; const u32x2* yr = (const u32x2*)(YS + prow * DM) + C.lane;
#pragma unroll
            for (int j = 0; j < 4; ++j) { const u32x2 w = yr[64 * j]; v[j][0] += g * bf_lo(w.x); v[j][1] += g * bf_hi(w.x); v[j][2] += g * bf_lo(w.y); v[j][3] += g * bf_hi(w.y); } }
        float s = 0.f;
#pragma unroll
        for (int j = 0; j < 4; ++j) s += (v[j][0] + v[j][1]) + (v[j][2] + v[j][3]);
        const float mean = wave_sum(s) * (1.f / DM); float s2 = 0.f;
#pragma unroll
        for (int j = 0; j < 4; ++j) { v[j] = v[j] - mean; s2 += (v[j][0] * v[j][0] + v[j][1] * v[j][1]) + (v[j][2] * v[j][2] + v[j][3] * v[j][3]); }
        const float rstd = 1.f / sqrtf(wave_sum(s2) * (1.f / DM) + LN_EPS);
#pragma unroll
        for (int j = 0; j < 4; ++j) { const f32x4 o = v[j] * rstd * gv[j] + bv[j]; *((f32x4*)(X2 + (size_t)row * DM) + C.lane + 64 * j) = o;
            u32x2 w; w.x = cvt_pk_bf16(o[0], o[1]); w.y = cvt_pk_bf16(o[2], o[3]); *((u32x2*)(X2B + (size_t)row * DM) + C.lane + 64 * j) = w; }
    }
}

__device__ __forceinline__ void phase_conv(const CAS Args& args, const Ctx& C0, int j) {
    Ctx C = C0; C.tid = opaque_tid(); C.lane = C.tid & 63;
    const bf16_t* U = WSP(bf16_t, WS_U); bf16_t* UC = WSP(bf16_t, WS_UC);
    const float* cw = INF(I_LRU_CW) + (size_t)j * 4 * DM; const float* cb = INF(I_LRU_CB) + (size_t)j * DM;
    const int c8 = (C.tid & 127) * 8, rsub = C.tid >> 7;
    float w[4][8], bb[8];
#pragma unroll
    for (int q = 0; q < 4; ++q)
#pragma unroll
        for (int e = 0; e < 8; ++e) w[q][e] = cw[q * DM + c8 + e];
#pragma unroll
    for (int e = 0; e < 8; ++e) bb[e] = cb[c8 + e];
    for (int chunk = C.vcu; chunk < T / 128; chunk += C.G) {
        const int r0 = chunk * 128 + rsub * 32;
        u32x4 h0, h1, h2;
        const u32x4 z = {0u, 0u, 0u, 0u};
        const int s0 = r0 & (SEQ - 1);
        h0 = s0 >= 3 ? *(const u32x4*)(U + (size_t)(r0 - 3) * DM + c8) : z; h1 = s0 >= 2 ? *(const u32x4*)(U + (size_t)(r0 - 2) * DM + c8) : z; h2 = s0 >= 1 ? *(const u32x4*)(U + (size_t)(r0 - 1) * DM + c8) : z;
#pragma unroll 4
        for (int i = 0; i < 32; ++i) { const u32x4 h3 = *(const u32x4*)(U + (size_t)(r0 + i) * DM + c8);
            float o[8];
#pragma unroll
            for (int q = 0; q < 4; ++q) { const unsigned a = h0[q], b = h1[q], c = h2[q], d = h3[q];
                o[2 * q] = bb[2 * q] + w[0][2 * q] * bf_lo(a) + w[1][2 * q] * bf_lo(b) + w[2][2 * q] * bf_lo(c) + w[3][2 * q] * bf_lo(d);
                o[2 * q + 1] = bb[2 * q + 1] + w[0][2 * q + 1] * bf_hi(a) + w[1][2 * q + 1] * bf_hi(b) + w[2][2 * q + 1] * bf_hi(c) + w[3][2 * q + 1] * bf_hi(d); }
            u32x4 ow; ow.x = cvt_pk_bf16(o[0], o[1]); ow.y = cvt_pk_bf16(o[2], o[3]); ow.z = cvt_pk_bf16(o[4], o[5]); ow.w = cvt_pk_bf16(o[6], o[7]);
            *(u32x4*)(UC + (size_t)(r0 + i) * DM + c8) = ow; h0 = h1; h1 = h2; h2 = h3; }
    }
}
__device__ __forceinline__ void phase_scan1(const CAS Args& args, const Ctx& C0) {
    Ctx C = C0; C.tid = opaque_tid(); C.lane = C.tid & 63;
    const float* AA = WSP(float, WS_AA); const float* BB = WSP(float, WS_BB); float* CA = WSP(float, WS_CA); float* CH = WSP(float, WS_CH);
    const int c2 = C.tid * 2;
    for (int item = C.vcu; item < NBATCH * 64; item += C.G) {
        const size_t r0 = (size_t)item * 64; float h0 = 0.f, h1 = 0.f, p0 = 1.f, p1 = 1.f;
#pragma unroll 8
        for (int s = 0; s < 64; ++s) { const f32x2 a = *(const f32x2*)(AA + (r0 + s) * DM + c2), b = *(const f32x2*)(BB + (r0 + s) * DM + c2);
            h0 = a[0] * h0 + b[0]; h1 = a[1] * h1 + b[1]; p0 *= a[0]; p1 *= a[1]; }
        *(f32x2*)(CA + (size_t)item * DM + c2) = (f32x2){p0, p1}; *(f32x2*)(CH + (size_t)item * DM + c2) = (f32x2){h0, h1};
    }
}
__device__ __forceinline__ void phase_scan2(const CAS Args& args, const Ctx& C0) {
    Ctx C = C0; C.tid = opaque_tid(); C.lane = C.tid & 63;
    const float* AA = WSP(float, WS_AA); const float* BB = WSP(float, WS_BB); const float* CA = WSP(float, WS_CA); const float* CH = WSP(float, WS_CH);
    const bf16_t* GG = WSP(bf16_t, WS_GG); bf16_t* YL = WSP(bf16_t, WS_O);
    const int c2 = C.tid * 2;
    for (int item = C.vcu; item < NBATCH * 64; item += C.G) {
        const int b = item >> 6, ch = item & 63; float h0 = 0.f, h1 = 0.f;
        for (int jx = 0; jx < ch; ++jx) { const f32x2 a = *(const f32x2*)(CA + (size_t)(b * 64 + jx) * DM + c2), e = *(const f32x2*)(CH + (size_t)(b * 64 + jx) * DM + c2);
            h0 = a[0] * h0 + e[0]; h1 = a[1] * h1 + e[1]; }
        const size_t r0 = (size_t)item * 64;
#pragma unroll 8
        for (int s = 0; s < 64; ++s) { const f32x2 a = *(const f32x2*)(AA + (r0 + s) * DM + c2), bq = *(const f32x2*)(BB + (r0 + s) * DM + c2); const unsigned g = *(const unsigned*)(GG + (r0 + s) * DM + c2);
            h0 = a[0] * h0 + bq[0]; h1 = a[1] * h1 + bq[1];
            *(unsigned*)(YL + (r0 + s) * DM + c2) = cvt_pk_bf16(bf_lo(g) * h0, bf_hi(g) * h1); }
    }
}

constexpr int PH_PER_LAYER = 12, PH_TOTAL = 2 + PH_PER_LAYER * DEPTH;
__global__ void __launch_bounds__(NWAVES * 64, 2) fwd_kernel(Args args_kernarg) {
    (void)args_kernarg;
    ArgsP const argp = (ArgsP)__builtin_amdgcn_kernarg_segment_ptr();
    const CAS Args& args0 = *argp;
    extern __shared__ __attribute__((aligned(16))) unsigned char lds_raw[];
    Ctx C;
    C.lds = (LAS unsigned char*)lds_raw; C.misc = (volatile LAS int*)(C.lds + MISC_OFF);
    C.tid = threadIdx.x; C.lane = C.tid & 63; C.wave = __builtin_amdgcn_readfirstlane(C.tid >> 6);
    C.G = gridDim.x; { const int bx = blockIdx.x; C.vcu = (C.G % 8 == 0) ? (bx % 8) * (C.G / 8) + bx / 8 : bx; }
    for (int u = C.tid; u < 128; u += NWAVES * 64) C.misc[u] = 0;
    __syncthreads();
    XcdBarrier bar = xcd_barrier_post((unsigned*)(args0.ws + WS_CTL) + CW_BAR + args0.li * XCD_BAR_WORDS, (volatile LAS unsigned*)C.misc);
    const int lo = args0.ph_lo, hi = args0.ph_hi;
#define IN(k) (lo <= (k) && (k) < hi)
#define PH_END(k) do { if ((k) + 1 < hi) xcd_barrier(bar); } while (0)
    const int cid = (int)blockIdx.x;

    if (SEL(0) && IN(0)) { const CAS Args& args = fresh_args(argp); phase_prologue(args, C); PH_END(0); }
    if (SEL(1) && IN(1)) { const CAS Args& args = fresh_args(argp);
        pg8::DenseSched S; S.init(WSP(bf16_t, WS_PB), WSP(bf16_t, WS_W_PLE + OFF_PLE_WP), PLED, PLED, DEPTH * T, DM, C.G, cid); S.bpm_shift = 7; S.bbatch = W_PLE_STRIDE;
        pg8::EpiPP E{WSP(bf16_t, WS_PP)};
        pg8::gemm_phase<pg8::EpiPP, pg8::DenseSched, false>(C.lds, PLED, PLED, PLED, S, E);
        PH_END(1);
    }
    for (int layer = 0; layer < DEPTH; ++layer) {
        const int base = 2 + PH_PER_LAYER * layer, j = layer >> 1;
        if ((layer & 1) == 0) {
            if (SEL(2) && IN(base + 0)) { const CAS Args& args = fresh_args(argp); const unsigned char* wm = args.ws + WS_W_MLA + (size_t)j * W_MLA_STRIDE;
                pg8::DenseSched S; S.init(WSP(bf16_t, WS_XB), wm + OFF_MLA_WIN, DM, DM, T, 1280, C.G, cid);
                pg8::EpiLat E{WSP(bf16_t, WS_LAT), WSP(float, WS_SSQ), WSP(bf16_t, WS_KR), WSP(float, WS_CS), WSP(float, WS_SN)};
                pg8::gemm_phase<pg8::EpiLat, pg8::DenseSched, false>(C.lds, DM, DM, DM, S, E);
                PH_END(base + 0);
            }
            if (SEL(3) && IN(base + 1)) { const CAS Args& args = fresh_args(argp); const unsigned char* wm = args.ws + WS_W_MLA + (size_t)j * W_MLA_STRIDE;
                { pg8::DenseSched S; S.init(WSP(bf16_t, WS_LAT), wm + OFF_MLA_WUQ, DM, QL, T, 1536, C.G, cid);
                  pg8::EpiQ E{WSP(bf16_t, WS_Q), WSP(float, WS_SSQ), WSP(float, WS_CS), WSP(float, WS_SN)};
                  pg8::gemm_phase<pg8::EpiQ, pg8::DenseSched, false>(C.lds, QL, DM, QL, S, E); }
                { pg8::DenseSched S; S.init(WSP(bf16_t, WS_LAT) + QL, wm + OFF_MLA_WUKV, DM, KVL, T, 2048, C.G, cid);
                  pg8::EpiKV E{WSP(bf16_t, WS_KN), WSP(bf16_t, WS_V), WSP(float, WS_SSQ)};
                  pg8::gemm_phase<pg8::EpiKV, pg8::DenseSched, false>(C.lds, KVL, DM, KVL, S, E); }
                PH_END(base + 1);
            }
            if (SEL(4) && IN(base + 2)) { const CAS Args& args = fresh_args(argp);
                for (int it = C.vcu; it < NBATCH * NH * 8; it += C.G) { const int bh = it >> 3, pr = it & 7;
                    att::attn_block(bh >> 3, bh & 7, pr, WSP(bf16_t, WS_Q), WSP(bf16_t, WS_KN), WSP(bf16_t, WS_KR), WSP(bf16_t, WS_V), WSP(bf16_t, WS_O), (LAS char*)C.lds);
                    att::attn_block(bh >> 3, bh & 7, 15 - pr, WSP(bf16_t, WS_Q), WSP(bf16_t, WS_KN), WSP(bf16_t, WS_KR), WSP(bf16_t, WS_V), WSP(bf16_t, WS_O), (LAS char*)C.lds); }
                PH_END(base + 2);
            }
        } else {
            if (SEL(5) && IN(base + 0)) { const CAS Args& args = fresh_args(argp); const unsigned char* wl = args.ws + WS_W_LRU + (size_t)j * W_LRU_STRIDE;
                pg8::DenseSched S; S.init(WSP(bf16_t, WS_XB), wl + OFF_LRU_WIN, DM, DM, T, 2048, C.G, cid);
                pg8::EpiGU E{WSP(bf16_t, WS_GG), WSP(bf16_t, WS_U)};
                pg8::gemm_phase<pg8::EpiGU, pg8::DenseSched, false>(C.lds, DM, DM, DM, S, E);
                PH_END(base + 0);
            }
            if (SEL(6) && IN(base + 1)) { const CAS Args& args = fresh_args(argp); phase_conv(args, C, j); PH_END(base + 1); }
            if (SEL(7) && IN(base + 2)) { const CAS Args& args = fresh_args(argp); const unsigned char* wl = args.ws + WS_W_LRU + (size_t)j * W_LRU_STRIDE;
                pg8::DenseSched S; S.init(WSP(bf16_t, WS_UC), wl + OFF_LRU_WAX, DM, 256, T, 2048, C.G, cid); S.apn_shift = 1; S.akbytes = 512;
                pg8::EpiAB E{WSP(float, WS_AA), WSP(float, WS_BB), WSP(bf16_t, WS_UC), INF(I_LRU_BA) + j * DM, INF(I_LRU_BX) + j * DM, WSP(float, WS_SPL) + j * DM};
                pg8::gemm_phase<pg8::EpiAB, pg8::DenseSched, false>(C.lds, 256, DM, 256, S, E);
                PH_END(base + 2);
            }
            if (SEL(8) && IN(base + 3)) { const CAS Args& args = fresh_args(argp); phase_scan1(args, C); PH_END(base + 3); }
            if (SEL(9) && IN(base + 4)) { const CAS Args& args = fresh_args(argp); phase_scan2(args, C); PH_END(base + 4); }
        }
        if (SEL(10) && IN(base + 5)) { const CAS Args& args = fresh_args(argp); const float* XF = layer == 0 ? INF(I_X) : (const float*)args.out;
            const unsigned char* wo = (layer & 1) ? args.ws + WS_W_LRU + (size_t)j * W_LRU_STRIDE + OFF_LRU_WOUT : args.ws + WS_W_MLA + (size_t)j * W_MLA_STRIDE + OFF_MLA_WO;
            pg8::DenseSched S; S.init(WSP(bf16_t, WS_O), wo, DM, DM, T, DM, C.G, cid);
            pg8::EpiRes E{XF, WSP(float, WS_Y)};
            pg8::gemm_phase<pg8::EpiRes, pg8::DenseSched, false>(C.lds, DM, DM, DM, S, E);
            PH_END(base + 5);
        }
        if (SEL(11) && IN(base + 6)) { const CAS Args& args = fresh_args(argp); phase_ln_router(args, C, layer); PH_END(base + 6); }
        if (SEL(12) && IN(base + 7)) { const CAS Args& args = fresh_args(argp);
            moe_table(args, C, layer);
            pg8::MoeSched S{(const char*)WSP(bf16_t, WS_X1B), (const char*)(args.ws + WS_W_UP + (size_t)layer * NE * 2048 * 1024 * 2), (size_t)2048 * 1024 * 2, DM, DM, 8, WSP(int, WS_LIST), C.misc + 16, C.G, cid, true};
            pg8::EpiUp E{WSP(bf16_t, WS_H), INF(I_MOE_BUP) + (size_t)layer * NE * 2048};
            pg8::gemm_phase<pg8::EpiUp, pg8::MoeSched, true>(C.lds, DM, DM, DM, S, E);
            PH_END(base + 7);
        }
        if (SEL(13) && IN(base + 8)) { const CAS Args& args = fresh_args(argp);
            moe_table(args, C, layer);
            pg8::MoeSched S{(const char*)WSP(bf16_t, WS_H), (const char*)(args.ws + WS_W_DN + (size_t)layer * NE * 1024 * 1024 * 2), (size_t)1024 * 1024 * 2, DFF, DFF, 4, WSP(int, WS_LIST), C.misc + 16, C.G, cid, false};
            pg8::EpiDown E{WSP(bf16_t, WS_YS), INF(I_MOE_BDN) + (size_t)layer * NE * DM};
            pg8::gemm_phase<pg8::EpiDown, pg8::MoeSched, false>(C.lds, DFF, DFF, DFF, S, E);
            PH_END(base + 8);
        }
        if (SEL(14) && IN(base + 9)) { const CAS Args& args = fresh_args(argp); phase_combine_ln2(args, C, layer); PH_END(base + 9); }
        if (SEL(15) && IN(base + 10)) { const CAS Args& args = fresh_args(argp);
            pg8::DenseSched S; S.init(WSP(bf16_t, WS_X2B), args.ws + WS_W_PLE + (size_t)layer * W_PLE_STRIDE + OFF_PLE_WG, DM, DM, T, DM, C.G, cid);
            pg8::EpiPle E{WSP(float, WS_X2), WSP(bf16_t, WS_PP) + (size_t)layer * T * DM, args.out, WSP(bf16_t, WS_XB)};
            pg8::gemm_phase<pg8::EpiPle, pg8::DenseSched, false>(C.lds, DM, DM, DM, S, E);
            if (layer + 1 < DEPTH) PH_END(base + 10);
        }
    }
#undef IN
#undef PH_END
}

extern "C" void kernel_launch(void* const* d_in, const int* in_sizes, int n_in, void* d_out, int out_size, void* d_ws, size_t ws_size, hipStream_t stream) {
    static int grid = 0;
    if (grid == 0) {
        if (n_in != 30 || in_sizes[0] != T * DM || out_size != T * DM || ws_size < WS_END) { fprintf(stderr, "kernel_launch: unexpected shapes (n_in %d, in0 %d, out %d, ws %zu)\n", n_in, n_in > 0 ? in_sizes[0] : -1, out_size, ws_size); grid = -1; return; }
        int dev = 0, cus = 0, per_cu = 0;
        if (hipGetDevice(&dev) != hipSuccess || hipDeviceGetAttribute(&cus, hipDeviceAttributeMultiprocessorCount, dev) != hipSuccess) { grid = -1; return; }
        if (hipFuncSetAttribute((const void*)fwd_kernel, hipFuncAttributeMaxDynamicSharedMemorySize, LDS_BYTES) != hipSuccess) { fprintf(stderr, "kernel_launch: hipFuncSetAttribute failed\n"); grid = -1; return; }
        if (hipOccupancyMaxActiveBlocksPerMultiprocessor(&per_cu, (const void*)fwd_kernel, NWAVES * 64, LDS_BYTES) != hipSuccess || per_cu < 1) fprintf(stderr, "kernel_launch: occupancy query reports %d\n", per_cu);
        (void)hipGetLastError();
        grid = cus;
    }
    if (grid < 0) return;
    if (hipMemsetAsync((char*)d_ws + WS_CTL, 0, CTL_ZERO_BYTES, stream) != hipSuccess) return;
    Args a{};
    for (int i = 0; i < 30; ++i) a.in[i] = d_in[i];
    a.out = (float*)d_out; a.ws = (unsigned char*)d_ws; a.pad = 0;
#if MK_ONE_LAUNCH
    a.ph_lo = 0; a.ph_hi = PH_TOTAL; a.li = 0;
    hipLaunchKernelGGL(fwd_kernel, dim3(grid), dim3(NWAVES * 64), LDS_BYTES, stream, a);
#else
    int li = 0;
    for (int ph = 0; ph < PH_TOTAL; ++ph) {
        if (ph >= 2) { const int l = (ph - 2) / PH_PER_LAYER, k = (ph - 2) % PH_PER_LAYER; if (k == 11) continue; if ((l & 1) == 0 && (k == 3 || k == 4)) continue; }
        a.ph_lo = ph; a.ph_hi = ph + 1; a.li = li++;
        hipLaunchKernelGGL(fwd_kernel, dim3(grid), dim3(NWAVES * 64), LDS_BYTES, stream, a);
    }
#endif
}
```

```cpp
#include <hip/hip_runtime.h>
#include <hip/hip_bf16.h>
#include <cstdio>
#include <cstdint>

#ifndef PHSEL
#define PHSEL -1
#endif
#define SEL(id) (PHSEL < 0 || PHSEL == (id))
#ifndef MK_ONE_LAUNCH
#define MK_ONE_LAUNCH 1
#endif

constexpr int T = 32768, SEQ = 4096, NBATCH = 8, DM = 1024, DEPTH = 4;
constexpr int QL = 768, KVL = 256, ROPE = 64, LATD = 1088, NH = 8, DQK = 192, DV = 128;
constexpr int NE = 32, TOPK = 4, DFF = 1024, PLED = 256;
constexpr float ALPHA = 1.681792830507429f;
constexpr float LN_EPS = 1e-5f, RMS_EPS = 1e-6f;
constexpr float QSCALE = 1.4426950408889634f / 13.856406460551018f;
constexpr int NWAVES = 8;

constexpr size_t MiB = 1u << 20;
constexpr size_t WS_CTL = 0, CTL_ZERO_BYTES = 2 * MiB;
constexpr size_t WS_CS = 2 * MiB, WS_SN = 6 * MiB, WS_SPL = 10 * MiB;
constexpr size_t WS_W_MLA = 12 * MiB, W_MLA_STRIDE = 8 * MiB;
constexpr size_t OFF_MLA_WIN = 0, OFF_MLA_WUQ = 2560 * 1024, OFF_MLA_WUKV = OFF_MLA_WUQ + 2304 * 1024, OFF_MLA_WO = OFF_MLA_WUKV + 1024 * 1024;
constexpr size_t WS_W_LRU = 28 * MiB, W_LRU_STRIDE = 8 * MiB;
constexpr size_t OFF_LRU_WIN = 0, OFF_LRU_WAX = 4 * MiB, OFF_LRU_WOUT = 5 * MiB;
constexpr size_t WS_W_PLE = 44 * MiB, W_PLE_STRIDE = 3 * MiB;
constexpr size_t OFF_PLE_WG = 0, OFF_PLE_WP = 2 * MiB;
constexpr size_t WS_W_UP = 56 * MiB;
constexpr size_t WS_W_DN = 568 * MiB;
constexpr size_t WS_XB = 824 * MiB, WS_PB = 888 * MiB, WS_PP = 952 * MiB;
constexpr size_t WS_Y = 1208 * MiB, WS_X1 = 1336 * MiB, WS_X1B = 1464 * MiB, WS_X2 = 1528 * MiB, WS_X2B = 1656 * MiB;
constexpr size_t WS_LAT = 1720 * MiB, WS_KR = 1784 * MiB, WS_SSQ = 1788 * MiB, WS_Q = 1790 * MiB, WS_KN = 1886 * MiB, WS_V = 1950 * MiB, WS_O = 2014 * MiB;
constexpr size_t WS_GG = 2078 * MiB, WS_U = 2142 * MiB, WS_UC = 2206 * MiB, WS_AA = 2270 * MiB, WS_BB = 2398 * MiB, WS_CA = 2526 * MiB, WS_CH = 2528 * MiB;
constexpr size_t WS_H = 2530 * MiB, WS_YS = 2802 * MiB, WS_LIST = 3074 * MiB, WS_SLOT = 3078 * MiB, WS_GATE = 3079 * MiB, WS_END = 3080 * MiB;
constexpr int PADROWS = T * TOPK + NE * 256;
static_assert((size_t)PADROWS * DFF * 2 <= 272 * MiB, "H / YS size");
constexpr int CW_CNT = 256;
constexpr int CW_BAR = 4096;

constexpr int RING_BYTES = 139264;
constexpr int MISC_OFF = RING_BYTES;
constexpr int LDS_BYTES = 147456;

#define GAS __attribute__((address_space(1)))
#define LAS __attribute__((address_space(3)))
#define CAS __attribute__((address_space(4)))
typedef unsigned short bf16_t;
typedef short bf16x8 __attribute__((ext_vector_type(8)));
typedef short s16x4 __attribute__((ext_vector_type(4)));
typedef float f32x2 __attribute__((ext_vector_type(2)));
typedef float f32x4 __attribute__((ext_vector_type(4)));
typedef float f32x16 __attribute__((ext_vector_type(16)));
typedef unsigned u32x2 __attribute__((ext_vector_type(2)));
typedef unsigned u32x4 __attribute__((ext_vector_type(4)));

__device__ __forceinline__ unsigned cvt_pk_bf16(float lo, float hi) { unsigned r; asm volatile("v_cvt_pk_bf16_f32 %0, %1, %2" : "=v"(r) : "v"(lo), "v"(hi)); return r; }
__device__ __forceinline__ float bf_lo(unsigned w) { return __uint_as_float(w << 16); }
__device__ __forceinline__ float bf_hi(unsigned w) { return __uint_as_float(w & 0xffff0000u); }
__device__ __forceinline__ float sigmoidf_(float x) { return __builtin_amdgcn_rcpf(1.0f + __expf(-x)); }
__device__ __forceinline__ float gelu_tanh(float x) { const float u = 0.7978845608028654f * (x + 0.044715f * x * x * x); const float t = 1.0f - 2.0f * __builtin_amdgcn_rcpf(1.0f + __expf(2.0f * u)); return 0.5f * x * (1.0f + t); }
__device__ __forceinline__ u32x4 pack8(const f32x4 a, const f32x4 b) { u32x4 w; w.x = cvt_pk_bf16(a[0], a[1]); w.y = cvt_pk_bf16(a[2], a[3]); w.z = cvt_pk_bf16(b[0], b[1]); w.w = cvt_pk_bf16(b[2], b[3]); return w; }
__device__ __forceinline__ int opaque_tid() { int t = threadIdx.x; asm volatile("" : "+v"(t)); return t; }
__device__ __forceinline__ float wave_sum(float v) {
#pragma unroll
    for (int o = 1; o < 64; o <<= 1) v += __shfl_xor(v, o);
    return v;
}

namespace pg8 {
#define PG8_LAS __attribute__((address_space(3)))
constexpr int BM = 256, BK = 64, HALF = 128, HTB = HALF * BK * 2, STAGE_BYTES = 8 * HTB;
__host__ __device__ __forceinline__ int lds_byte(int r, int c) { const int st = (r >> 4) * 2 + (c >> 5), rr = r & 15, cc = c & 31, ob = rr * 64 + cc * 2; return st * 1024 + (ob ^ (((ob >> 9) & 1) << 5)); }
__host__ __device__ __forceinline__ void stage_rc(int b, int& R, int& C) { const int st = b / 1024, sb = b % 1024, swz = sb ^ (((sb >> 9) & 1) << 5); R = (st >> 1) * 16 + swz / 64; C = (st & 1) * 32 + (swz % 64) / 2; }
__host__ __device__ __forceinline__ int perm32(int rho) { const int n = rho >> 4, i = rho & 15; return 8 * (i >> 2) + 4 * n + (i & 3); }

struct Unit { const char* A; const char* B; const int* lst; int nvalid; int pm, pn, aux; };

template <class Epi, class Sched, bool GATHER>
__device__ __forceinline__ void gemm_phase(PG8_LAS unsigned char* lds, const int K, const int lda, const int ldb, const Sched& S, const Epi& E) {
    const int tid = opaque_tid(), wid = __builtin_amdgcn_readfirstlane(tid >> 6), lane = tid & 63, wr = wid >> 2, wc = wid & 3, fr = lane & 15, fq = lane >> 4;
    const int nt = K / BK;
    unsigned voffB[2], ocA[2][2], onA[2][2]; int gR[2], gC2[2];
#pragma unroll
    for (int i = 0; i < 2; ++i) { int R, C; stage_rc(tid * 16 + i * 8192, R, C); const int Rb = Epi::PERM ? ((R & ~31) + perm32(R & 31)) : R;
        voffB[i] = (unsigned)(Rb * ldb + C) * 2u; gR[i] = R; gC2[i] = C * 2;
        ocA[0][i] = (unsigned)(R * lda + C) * 2u; ocA[1][i] = (unsigned)((R + HALF) * lda + C) * 2u; onA[0][i] = ocA[0][i]; onA[1][i] = ocA[1][i]; }
    const size_t kstep = (size_t)(BK * 2);
    const size_t hstepB = (size_t)HALF * ldb * 2;
    const unsigned ldsw = (unsigned)wid * 1024u;
    const int aoff = lds_byte(wr * 64 + fr, fq * 8), boff = lds_byte(wc * 32 + fr, fq * 8);
#define PG8_SA(b, h) (((b) * 2 + (h)) * HTB)
#define PG8_SB(b, h) ((4 + (b) * 2 + (h)) * HTB)
#define PG8_STAGE(bufoff, gbase, voff) do { _Pragma("unroll") for (int _i = 0; _i < 2; ++_i) \
        __builtin_amdgcn_global_load_lds((const unsigned*)((const char*)(gbase) + (voff)[_i]), (PG8_LAS unsigned*)(lds + (bufoff) + ldsw + _i * 8192), 16, 0, 0); } while (0)
#define PG8_LDA(dst, b, h) do { _Pragma("unroll") for (int m = 0; m < 4; ++m) _Pragma("unroll") for (int k = 0; k < 2; ++k) dst[m][k] = *(const PG8_LAS bf16x8*)(lds + PG8_SA(b, h) + aoff + m * 2048 + k * 1024); } while (0)
#define PG8_LDB(dst, b, h) do { _Pragma("unroll") for (int n = 0; n < 2; ++n) _Pragma("unroll") for (int k = 0; k < 2; ++k) dst[n][k] = *(const PG8_LAS bf16x8*)(lds + PG8_SB(b, h) + boff + n * 2048 + k * 1024); } while (0)
#define PG8_MMA(ai, bj, At, Bt) do { __builtin_amdgcn_s_setprio(1); _Pragma("unroll") for (int m = 0; m < 4; ++m) _Pragma("unroll") for (int n = 0; n < 2; ++n) _Pragma("unroll") for (int k = 0; k < 2; ++k) \
        acc[ai][bj][m][n] = __builtin_amdgcn_mfma_f32_16x16x32_bf16(Bt[n][k], At[m][k], acc[ai][bj][m][n], 0, 0, 0); __builtin_amdgcn_s_setprio(0); } while (0)
#define PG8_WAIT_V(n) asm volatile("s_waitcnt vmcnt(" #n ")" ::: "memory")
#define PG8_WAIT_L(n) asm volatile("s_waitcnt lgkmcnt(" #n ")" ::: "memory")
#define PG8_BAR __builtin_amdgcn_s_barrier()
#define PG8_SCHED __builtin_amdgcn_sched_barrier(0)
#define PG8_GOFFS(u, o) do { _Pragma("unroll") for (int _h = 0; _h < 2; ++_h) _Pragma("unroll") for (int _i = 0; _i < 2; ++_i) { int _r = _h * HALF + gR[_i]; _r = _r < (u).nvalid ? _r : (u).nvalid - 1; \
        const int _tok = (u).lst[_r]; (o)[_h][_i] = (unsigned)_tok * (unsigned)(lda * 2) + (unsigned)gC2[_i]; } } while (0)
    Unit cur, nxt; int ui = 0;
    if (!S.next(0, cur)) return;
    f32x4 acc[2][2][4][2];
#pragma unroll
    for (int a = 0; a < 2; ++a)
#pragma unroll
        for (int b = 0; b < 2; ++b)
#pragma unroll
            for (int m = 0; m < 4; ++m)
#pragma unroll
                for (int n = 0; n < 2; ++n) acc[a][b][m][n] = (f32x4){0.f, 0.f, 0.f, 0.f};
    bf16x8 At[4][2], B0[2][2], B1[2][2];
    const char* cA = cur.A; const char* cB = cur.B;
    if constexpr (GATHER) { PG8_GOFFS(cur, ocA); }
    PG8_STAGE(PG8_SB(0, 0), cB, voffB); PG8_STAGE(PG8_SB(0, 1), cB + hstepB, voffB); PG8_STAGE(PG8_SA(0, 0), cA, ocA[0]); PG8_STAGE(PG8_SA(0, 1), cA, ocA[1]);
    if (wr == 1) PG8_BAR;
    PG8_WAIT_V(2); PG8_BAR;
    PG8_STAGE(PG8_SB(1, 0), cB + kstep, voffB); PG8_STAGE(PG8_SA(1, 0), cA + kstep, ocA[0]); PG8_STAGE(PG8_SB(1, 1), cB + hstepB + kstep, voffB);
    PG8_WAIT_V(6); PG8_BAR;
    for (;;) {
        const bool has_next = S.next(ui + 1, nxt);
        const char* nA = has_next ? nxt.A : cA; const char* nB = has_next ? nxt.B : cB;
        if constexpr (GATHER) {
            if (has_next) { PG8_GOFFS(nxt, onA); }
            else {
#pragma unroll
                for (int h = 0; h < 2; ++h)
#pragma unroll
                    for (int i = 0; i < 2; ++i) onA[h][i] = ocA[h][i]; }
        }
#pragma unroll 1
        for (int t = 0; t < nt; t += 2) {
            const bool last = (t == nt - 2);
            const char* a1 = cA + (size_t)(t + 1) * kstep;
            const char* a2 = last ? nA : cA + (size_t)(t + 2) * kstep; const char* b2 = last ? nB : cB + (size_t)(t + 2) * kstep;
            const char* a3 = a2 + kstep; const char* b3 = b2 + kstep;
            unsigned o2[2][2];
#pragma unroll
            for (int h = 0; h < 2; ++h)
#pragma unroll
                for (int i = 0; i < 2; ++i) o2[h][i] = (GATHER && last) ? onA[h][i] : ocA[h][i];
            PG8_LDB(B0, 0, 0); PG8_LDB(B1, 0, 1); PG8_SCHED; PG8_LDA(At, 0, 0); PG8_STAGE(PG8_SA(1, 1), a1, ocA[1]);
            PG8_WAIT_V(8); PG8_WAIT_L(0); PG8_BAR; PG8_MMA(0, 0, At, B0); PG8_MMA(0, 1, At, B1); PG8_BAR; PG8_SCHED;
            PG8_LDA(At, 0, 1); PG8_STAGE(PG8_SB(0, 0), b2, voffB); PG8_STAGE(PG8_SB(0, 1), b2 + hstepB, voffB); PG8_STAGE(PG8_SA(0, 0), a2, o2[0]);
            PG8_WAIT_V(8); PG8_WAIT_L(0); PG8_BAR; PG8_MMA(1, 0, At, B0); PG8_MMA(1, 1, At, B1); PG8_BAR; PG8_SCHED;
            PG8_LDB(B0, 1, 0); PG8_LDB(B1, 1, 1); PG8_SCHED; PG8_LDA(At, 1, 0); PG8_STAGE(PG8_SA(0, 1), a2, o2[1]);
            PG8_WAIT_V(8); PG8_WAIT_L(0); PG8_BAR; PG8_MMA(0, 0, At, B0); PG8_MMA(0, 1, At, B1); PG8_BAR; PG8_SCHED;
            PG8_LDA(At, 1, 1); PG8_STAGE(PG8_SB(1, 0), b3, voffB); PG8_STAGE(PG8_SB(1, 1), b3 + hstepB, voffB); PG8_STAGE(PG8_SA(1, 0), a3, o2[0]);
            PG8_WAIT_V(8); PG8_WAIT_L(0); PG8_BAR; PG8_MMA(1, 0, At, B0); PG8_MMA(1, 1, At, B1); PG8_BAR; PG8_SCHED;
        }
        if (wr == 0) PG8_BAR;
        E(acc, cur, wr, wc, fr, fq);
        if (!has_next) break;
#pragma unroll
        for (int a = 0; a < 2; ++a)
#pragma unroll
            for (int b = 0; b < 2; ++b)
#pragma unroll
                for (int m = 0; m < 4; ++m)
#pragma unroll
                    for (int n = 0; n < 2; ++n) acc[a][b][m][n] = (f32x4){0.f, 0.f, 0.f, 0.f};
        cur = nxt; cA = nA; cB = nB; ++ui;
        if constexpr (GATHER) {
#pragma unroll
            for (int h = 0; h < 2; ++h)
#pragma unroll
                for (int i = 0; i < 2; ++i) ocA[h][i] = onA[h][i]; }
        if (wr == 1) PG8_BAR;
    }
    PG8_WAIT_V(0);
    PG8_BAR;
#undef PG8_SA
#undef PG8_SB
#undef PG8_STAGE
#undef PG8_LDA
#undef PG8_LDB
#undef PG8_MMA
#undef PG8_WAIT_V
#undef PG8_WAIT_L
#undef PG8_BAR
#undef PG8_SCHED
#undef PG8_GOFFS
}

constexpr int NXCD = 8, WGM = 8;
struct DenseSched {
    const char* A; const char* B; int lda, ldb; int nM, nN, nwg, G, c; int apn_shift, akbytes, bpm_shift; size_t bbatch;
    __device__ __forceinline__ void init(const void* A_, const void* B_, int lda_, int ldb_, int M, int N, int G_, int c_) {
        A = (const char*)A_; B = (const char*)B_; lda = lda_; ldb = ldb_; nM = M / BM; nN = N / BM; nwg = nM * nN; G = G_; c = c_; apn_shift = -1; akbytes = 0; bpm_shift = -1; bbatch = 0; }
    __device__ __forceinline__ bool next(int i, Unit& u) const {
        const long L = (long)i * G + c; if (L >= nwg) return false;
        int wgid = (int)L; { const int q = nwg / NXCD, r = nwg % NXCD, xcd = wgid % NXCD, off = wgid / NXCD; wgid = (xcd < r ? xcd * (q + 1) : r * (q + 1) + (xcd - r) * q) + off; }
        const int nig = WGM * nN, gid = wgid / nig, fm = gid * WGM, gsz = (nM - fm) < WGM ? (nM - fm) : WGM;
        const int pm = fm + ((wgid % nig) % gsz), pn = (wgid % nig) / gsz;
        u.pm = pm; u.pn = pn; u.aux = 0; u.lst = nullptr; u.nvalid = 256;
        u.A = A + (size_t)pm * 256 * lda * 2 + (apn_shift >= 0 ? (size_t)(pn >> apn_shift) * akbytes : (size_t)0);
        u.B = B + (size_t)pn * 256 * ldb * 2 + (bpm_shift >= 0 ? (size_t)(pm >> bpm_shift) * bbatch : (size_t)0);
        return true;
    }
};
struct MoeSched {
    const char* A; const char* B; size_t bexp; int lda, ldb, nN; const int* lists; volatile LAS const int* tab; int G, c; bool gather;
    __device__ __forceinline__ bool next(int i, Unit& u) const {
        const int total = tab[32] * nN; const long L = (long)i * G + c; if (L >= total) return false;
        const int pn = (int)(L % nN), mg = (int)(L / nN);
        int e = 0;
#pragma unroll 1
        for (int j = 1; j < 32; ++j) e += (tab[j] <= mg) ? 1 : 0;
        const int mt = mg - tab[e];
        u.pm = mg; u.pn = pn; u.aux = e;
        if (gather) { u.A = A; u.lst = lists + (size_t)e * T + mt * 256; const int rem = tab[48 + e] - mt * 256; u.nvalid = rem < 256 ? rem : 256; }
        else { u.A = A + (size_t)mg * 256 * lda * 2; u.lst = nullptr; u.nvalid = 256; }
        u.B = B + (size_t)e * bexp + (size_t)pn * 256 * ldb * 2;
        return true;
    }
};

#define EPI_ROW(u, ai, m) ((u).pm * 256 + (ai) * 128 + wr * 64 + (m) * 16 + fr)
struct EpiLat {
    static constexpr bool PERM = true;
    bf16_t* LAT; float* SSQ; bf16_t* KR; const float* CS; const float* SN;
    __device__ __forceinline__ void operator()(const f32x4 (&acc)[2][2][4][2], const Unit& u, int wr, int wc, int fr, int fq) const {
        if (u.pn < 4) {
#pragma unroll
            for (int ai = 0; ai < 2; ++ai)
#pragma unroll
                for (int m = 0; m < 4; ++m) { const int row = EPI_ROW(u, ai, m); float ss = 0.f;
#pragma unroll
                    for (int bj = 0; bj < 2; ++bj) { const f32x4 v0 = acc[ai][bj][m][0], v1 = acc[ai][bj][m][1];
                        ss += (v0[0] * v0[0] + v0[1] * v0[1]) + (v0[2] * v0[2] + v0[3] * v0[3]) + (v1[0] * v1[0] + v1[1] * v1[1]) + (v1[2] * v1[2] + v1[3] * v1[3]);
                        *(u32x4*)(LAT + (size_t)row * 1024 + u.pn * 256 + bj * 128 + wc * 32 + 8 * fq) = pack8(v0, v1); }
                    ss += __shfl_xor(ss, 16); ss += __shfl_xor(ss, 32);
                    if (fq == 0) SSQ[(size_t)row * 16 + u.pn * 4 + wc] = ss; }
        } else if (wc == 0) {
#pragma unroll
            for (int ai = 0; ai < 2; ++ai)
#pragma unroll
                for (int m = 0; m < 4; ++m) { const int row = EPI_ROW(u, ai, m);
                    const f32x4 c0 = *(const f32x4*)(CS + (size_t)row * 32 + 8 * fq), c1 = *(const f32x4*)(CS + (size_t)row * 32 + 8 * fq + 4);
                    const f32x4 s0 = *(const f32x4*)(SN + (size_t)row * 32 + 8 * fq), s1 = *(const f32x4*)(SN + (size_t)row * 32 + 8 * fq + 4);
                    const f32x4 a0 = acc[ai][0][m][0], a1 = acc[ai][0][m][1], b0 = acc[ai][1][m][0], b1 = acc[ai][1][m][1];
                    *(u32x4*)(KR + (size_t)row * 64 + 8 * fq) = pack8(a0 * c0 - b0 * s0, a1 * c1 - b1 * s1);
                    *(u32x4*)(KR + (size_t)row * 64 + 32 + 8 * fq) = pack8(b0 * c0 + a0 * s0, b1 * c1 + a1 * s1); }
        }
    }
};
struct EpiQ {
    static constexpr bool PERM = true;
    bf16_t* Q; const float* SSQ; const float* CS; const float* SN;
    __device__ __forceinline__ void operator()(const f32x4 (&acc)[2][2][4][2], const Unit& u, int wr, int wc, int fr, int fq) const {
#pragma unroll
        for (int ai = 0; ai < 2; ++ai)
#pragma unroll
            for (int m = 0; m < 4; ++m) { const int row = EPI_ROW(u, ai, m);
                const f32x4 q0 = *(const f32x4*)(SSQ + (size_t)row * 16), q1 = *(const f32x4*)(SSQ + (size_t)row * 16 + 4), q2 = *(const f32x4*)(SSQ + (size_t)row * 16 + 8);
                const float ss = ((q0[0] + q0[1]) + (q0[2] + q0[3])) + ((q1[0] + q1[1]) + (q1[2] + q1[3])) + ((q2[0] + q2[1]) + (q2[2] + q2[3]));
                const float r = QSCALE / sqrtf(ss * (1.0f / QL) + RMS_EPS);
                if (u.pn < 4) {
#pragma unroll
                    for (int bj = 0; bj < 2; ++bj)
                        *(u32x4*)(Q + (size_t)row * 1536 + (2 * u.pn + bj) * 192 + wc * 32 + 8 * fq) = pack8(acc[ai][bj][m][0] * r, acc[ai][bj][m][1] * r);
                } else {
                    const int head = 4 * (u.pn - 4) + wc;
                    const f32x4 c0 = *(const f32x4*)(CS + (size_t)row * 32 + 8 * fq), c1 = *(const f32x4*)(CS + (size_t)row * 32 + 8 * fq + 4);
                    const f32x4 s0 = *(const f32x4*)(SN + (size_t)row * 32 + 8 * fq), s1 = *(const f32x4*)(SN + (size_t)row * 32 + 8 * fq + 4);
                    const f32x4 a0 = acc[ai][0][m][0] * r, a1 = acc[ai][0][m][1] * r, b0 = acc[ai][1][m][0] * r, b1 = acc[ai][1][m][1] * r;
                    *(u32x4*)(Q + (size_t)row * 1536 + head * 192 + 128 + 8 * fq) = pack8(a0 * c0 - b0 * s0, a1 * c1 - b1 * s1);
                    *(u32x4*)(Q + (size_t)row * 1536 + head * 192 + 160 + 8 * fq) = pack8(b0 * c0 + a0 * s0, b1 * c1 + a1 * s1);
                }
                asm volatile("" ::: "memory"); }
    }
};
struct EpiKV {
    static constexpr bool PERM = true;
    bf16_t* KN; bf16_t* V; const float* SSQ;
    __device__ __forceinline__ void operator()(const f32x4 (&acc)[2][2][4][2], const Unit& u, int wr, int wc, int fr, int fq) const {
#pragma unroll
        for (int ai = 0; ai < 2; ++ai)
#pragma unroll
            for (int m = 0; m < 4; ++m) { const int row = EPI_ROW(u, ai, m);
                const f32x4 q3 = *(const f32x4*)(SSQ + (size_t)row * 16 + 12);
                const float r = 1.0f / sqrtf(((q3[0] + q3[1]) + (q3[2] + q3[3])) * (1.0f / KVL) + RMS_EPS);
                *(u32x4*)(KN + (size_t)row * 1024 + u.pn * 128 + wc * 32 + 8 * fq) = pack8(acc[ai][0][m][0] * r, acc[ai][0][m][1] * r);
                *(u32x4*)(V + (size_t)row * 1024 + u.pn * 128 + wc * 32 + 8 * fq) = pack8(acc[ai][1][m][0] * r, acc[ai][1][m][1] * r); }
    }
};
struct EpiRes {
    static constexpr bool PERM = false;
    const float* X; float* Y;
    __device__ __forceinline__ void operator()(const f32x4 (&acc)[2][2][4][2], const Unit& u, int wr, int wc, int fr, int fq) const {
#pragma unroll
        for (int ai = 0; ai < 2; ++ai)
#pragma unroll
            for (int m = 0; m < 4; ++m) { const size_t off = (size_t)EPI_ROW(u, ai, m) * 1024 + u.pn * 256 + wc * 32 + 4 * fq;
#pragma unroll
                for (int bj = 0; bj < 2; ++bj)
#pragma unroll
                    for (int n = 0; n < 2; ++n) { const f32x4 xv = *(const f32x4*)(X + off + bj * 128 + n * 16); *(f32x4*)(Y + off + bj * 128 + n * 16) = xv * ALPHA + acc[ai][bj][m][n]; }
                if (m & 1) asm volatile("" ::: "memory"); }
    }
};
struct EpiGU {
    static constexpr bool PERM = true;
    bf16_t* GG; bf16_t* U;
    __device__ __forceinline__ void operator()(const f32x4 (&acc)[2][2][4][2], const Unit& u, int wr, int wc, int fr, int fq) const {
#pragma unroll
        for (int ai = 0; ai < 2; ++ai)
#pragma unroll
            for (int m = 0; m < 4; ++m) { const int row = EPI_ROW(u, ai, m);
#pragma unroll
                for (int bj = 0; bj < 2; ++bj) { f32x4 v0 = acc[ai][bj][m][0], v1 = acc[ai][bj][m][1];
                    if (u.pn < 4) {
#pragma unroll
                        for (int e = 0; e < 4; ++e) { v0[e] = gelu_tanh(v0[e]); v1[e] = gelu_tanh(v1[e]); }
                        *(u32x4*)(GG + (size_t)row * 1024 + u.pn * 256 + bj * 128 + wc * 32 + 8 * fq) = pack8(v0, v1);
                    } else *(u32x4*)(U + (size_t)row * 1024 + (u.pn - 4) * 256 + bj * 128 + wc * 32 + 8 * fq) = pack8(v0, v1); } }
    }
};
struct EpiAB {
    static constexpr bool PERM = false;
    float* AA; float* BB; const bf16_t* UC; const float* BA; const float* BX; const float* SPL;
    __device__ __forceinline__ void operator()(const f32x4 (&acc)[2][2][4][2], const Unit& u, int wr, int wc, int fr, int fq) const {
        const int ch0 = (u.pn >> 1) * 256 + (u.pn & 1) * 128 + wc * 32 + 4 * fq;
#pragma unroll
        for (int n = 0; n < 2; ++n) { const int ch = ch0 + 16 * n;
            const f32x4 ba = *(const f32x4*)(BA + ch), bx = *(const f32x4*)(BX + ch), sp = *(const f32x4*)(SPL + ch);
#pragma unroll
            for (int ai = 0; ai < 2; ++ai)
#pragma unroll
                for (int m = 0; m < 4; ++m) { const size_t off = (size_t)EPI_ROW(u, ai, m) * 1024 + ch;
                    const u32x2 uw = *(const u32x2*)(UC + off); const float uv[4] = {bf_lo(uw.x), bf_hi(uw.x), bf_lo(uw.y), bf_hi(uw.y)};
                    f32x4 av, bv;
#pragma unroll
                    for (int e = 0; e < 4; ++e) { const float r = sigmoidf_(acc[ai][0][m][n][e] + ba[e]), ig = sigmoidf_(acc[ai][1][m][n][e] + bx[e]);
                        const float la = sp[e] * r, x2 = 2.0f * la; av[e] = __expf(la);
                        const float om = x2 > -0.25f ? -x2 * (1.0f + x2 * (0.5f + x2 * (0.16666667f + x2 * (0.041666668f + x2 * 0.0083333338f)))) : 1.0f - __expf(x2);
                        bv[e] = sqrtf(om) * ig * uv[e]; }
                    *(f32x4*)(AA + off) = av; *(f32x4*)(BB + off) = bv; asm volatile("" ::: "memory"); } }
    }
};
struct EpiUp {
    static constexpr bool PERM = true;
    bf16_t* H; const float* BU;
    __device__ __forceinline__ void operator()(const f32x4 (&acc)[2][2][4][2], const Unit& u, int wr, int wc, int fr, int fq) const {
        const int gc = u.pn * 128 + wc * 32 + 8 * fq; const float* bu = BU + (size_t)u.aux * 2048;
        const f32x4 bg0 = *(const f32x4*)(bu + gc), bg1 = *(const f32x4*)(bu + gc + 4), bp0 = *(const f32x4*)(bu + 1024 + gc), bp1 = *(const f32x4*)(bu + 1024 + gc + 4);
#pragma unroll
        for (int ai = 0; ai < 2; ++ai)
#pragma unroll
            for (int m = 0; m < 4; ++m) { const int row = EPI_ROW(u, ai, m);
                f32x4 y0, y1;
#pragma unroll
                for (int e = 0; e < 4; ++e) {
                    float g = fminf(acc[ai][0][m][0][e] + bg0[e], 7.0f), up = fminf(fmaxf(acc[ai][1][m][0][e] + bp0[e], -7.0f), 7.0f); y0[e] = (up + 1.0f) * (g * sigmoidf_(1.702f * g));
                    g = fminf(acc[ai][0][m][1][e] + bg1[e], 7.0f); up = fminf(fmaxf(acc[ai][1][m][1][e] + bp1[e], -7.0f), 7.0f); y1[e] = (up + 1.0f) * (g * sigmoidf_(1.702f * g)); }
                *(u32x4*)(H + (size_t)row * 1024 + gc) = pack8(y0, y1); }
    }
};
struct EpiDown {
    static constexpr bool PERM = true;
    bf16_t* YS; const float* BD;
    __device__ __forceinline__ void operator()(const f32x4 (&acc)[2][2][4][2], const Unit& u, int wr, int wc, int fr, int fq) const {
        const float* bd = BD + (size_t)u.aux * 1024;
#pragma unroll
        for (int bj = 0; bj < 2; ++bj) { const int col = u.pn * 256 + bj * 128 + wc * 32 + 8 * fq; const f32x4 b0 = *(const f32x4*)(bd + col), b1 = *(const f32x4*)(bd + col + 4);
#pragma unroll
            for (int ai = 0; ai < 2; ++ai)
#pragma unroll
                for (int m = 0; m < 4; ++m) *(u32x4*)(YS + (size_t)EPI_ROW(u, ai, m) * 1024 + col) = pack8(acc[ai][bj][m][0] + b0, acc[ai][bj][m][1] + b1); }
    }
};
struct EpiPle {
    static constexpr bool PERM = false;
    const float* X2; const bf16_t* PP; float* XF; bf16_t* XB;
    __device__ __forceinline__ void operator()(const f32x4 (&acc)[2][2][4][2], const Unit& u, int wr, int wc, int fr, int fq) const {
#pragma unroll
        for (int ai = 0; ai < 2; ++ai)
#pragma unroll
            for (int m = 0; m < 4; ++m) { const size_t off = (size_t)EPI_ROW(u, ai, m) * 1024 + u.pn * 256 + wc * 32 + 4 * fq;
#pragma unroll
                for (int bj = 0; bj < 2; ++bj)
#pragma unroll
                    for (int n = 0; n < 2; ++n) { const size_t o = off + bj * 128 + n * 16; const f32x4 xv = *(const f32x4*)(X2 + o); const u32x2 pw = *(const u32x2*)(PP + o);
                        const f32x4 a = acc[ai][bj][m][n]; f32x4 r;
                        r[0] = xv[0] + sigmoidf_(a[0]) * bf_lo(pw.x); r[1] = xv[1] + sigmoidf_(a[1]) * bf_hi(pw.x); r[2] = xv[2] + sigmoidf_(a[2]) * bf_lo(pw.y); r[3] = xv[3] + sigmoidf_(a[3]) * bf_hi(pw.y);
                        *(f32x4*)(XF + o) = r; u32x2 w; w.x = cvt_pk_bf16(r[0], r[1]); w.y = cvt_pk_bf16(r[2], r[3]); *(u32x2*)(XB + o) = w; }
                if (m & 1) asm volatile("" ::: "memory"); }
    }
};
struct EpiPP {
    static constexpr bool PERM = true;
    bf16_t* PP;
    __device__ __forceinline__ void operator()(const f32x4 (&acc)[2][2][4][2], const Unit& u, int wr, int wc, int fr, int fq) const {
#pragma unroll
        for (int ai = 0; ai < 2; ++ai)
#pragma unroll
            for (int m = 0; m < 4; ++m)
#pragma unroll
                for (int bj = 0; bj < 2; ++bj) *(u32x4*)(PP + (size_t)EPI_ROW(u, ai, m) * 1024 + u.pn * 256 + bj * 128 + wc * 32 + 8 * fq) = pack8(acc[ai][bj][m][0], acc[ai][bj][m][1]);
    }
};
}

namespace att {
constexpr int NW = 8, QBLK = 32, KVBLK = 64, QB = 256, KPITCH = 384;
constexpr int SHM_V = KVBLK * DV * 2, SHM_K = KVBLK * KPITCH;
constexpr int OFF_V = 0, OFF_K = 2 * SHM_V, OFF_WS = OFF_K + 2 * SHM_K, LDS_BYTES = OFF_WS + NW * 64 * 4;
#define SBAR() __builtin_amdgcn_sched_barrier(0)
__device__ __forceinline__ int k_addr(int row, int chunk) { return row * KPITCH + ((chunk ^ ((row >> 1) & 7)) << 4); }
__device__ __forceinline__ int v_st(int k, int c) { const int kk = (k & ~0xC) | ((k & 4) << 1) | ((k & 8) >> 1); return ((kk >> 3) * 4 + (c >> 5)) * 512 + ((kk & 7) * 32 + (c & 31)) * 2; }
__device__ __forceinline__ int v_rd_base(int lane) { return ((lane & 3) << 3) | (((lane >> 2) & 3) << 6) | (((lane >> 4) & 1) << 5) | (((lane >> 5) & 1) << 8); }
constexpr int v_rd_off(int d0, int ks, int half) { return d0 * 512 + ks * 4096 + half * 2048; }
__device__ __forceinline__ int crow(int r, int hi) { return (r & 3) + 8 * (r >> 2) + 4 * hi; }

template <int KB>
__device__ __forceinline__ void qkt(f32x16& p0, f32x16& p1, const LAS char* K_lds, int r32, int hi, const bf16x8* qr) {
    p0 = f32x16{}; p1 = f32x16{};
    const LAS char* kb[4];
#pragma unroll
    for (int dd = 0; dd < 4; ++dd) kb[dd] = K_lds + KB * SHM_K + r32 * KPITCH + (((2 * dd + hi) ^ ((r32 >> 1) & 7)) << 4);
#pragma unroll
    for (int dg = 0; dg < 3; ++dg) {
#pragma unroll
        for (int dd = 0; dd < 4; ++dd) { const int d0 = dg * 4 + dd; const LAS char* a = kb[dd] + dg * 128;
            const bf16x8 b0 = *(const LAS bf16x8*)a;
            const bf16x8 b1 = *(const LAS bf16x8*)(a + 32 * KPITCH);
            p0 = __builtin_amdgcn_mfma_f32_32x32x16_bf16(b0, qr[d0], p0, 0, 0, 0);
            p1 = __builtin_amdgcn_mfma_f32_32x32x16_bf16(b1, qr[d0], p1, 0, 0, 0); }
        SBAR(); }
}
template <int VB>
__device__ __forceinline__ void pv_tile(f32x16* o, int vb0, bf16x8 pa0, bf16x8 pa1, bf16x8 pa2, bf16x8 pa3) {
#define TRRD(dst, off) asm volatile("ds_read_b64_tr_b16 %0, %1 offset:%2" : "=&v"(dst) : "v"(vb0), "i"(off) : "memory")
#define PV_D0(d0) do { s16x4 l0, l1, l2, l3, h0, h1, h2, h3; constexpr int b_ = OFF_V + VB * SHM_V + v_rd_off(d0, 0, 0); \
        TRRD(l0, b_); TRRD(h0, b_ + 2048); TRRD(l1, b_ + 4096); TRRD(h1, b_ + 6144); TRRD(l2, b_ + 8192); TRRD(h2, b_ + 10240); TRRD(l3, b_ + 12288); TRRD(h3, b_ + 14336); \
        asm volatile("s_waitcnt lgkmcnt(0)" ::: "memory"); SBAR(); \
        o[d0] = __builtin_amdgcn_mfma_f32_32x32x16_bf16(pa0, (bf16x8){l0[0], l0[1], l0[2], l0[3], h0[0], h0[1], h0[2], h0[3]}, o[d0], 0, 0, 0); \
        o[d0] = __builtin_amdgcn_mfma_f32_32x32x16_bf16(pa1, (bf16x8){l1[0], l1[1], l1[2], l1[3], h1[0], h1[1], h1[2], h1[3]}, o[d0], 0, 0, 0); \
        o[d0] = __builtin_amdgcn_mfma_f32_32x32x16_bf16(pa2, (bf16x8){l2[0], l2[1], l2[2], l2[3], h2[0], h2[1], h2[2], h2[3]}, o[d0], 0, 0, 0); \
        o[d0] = __builtin_amdgcn_mfma_f32_32x32x16_bf16(pa3, (bf16x8){l3[0], l3[1], l3[2], l3[3], h3[0], h3[1], h3[2], h3[3]}, o[d0], 0, 0, 0); } while (0)
    PV_D0(0); PV_D0(1); PV_D0(2); PV_D0(3);
#undef PV_D0
#undef TRRD
}
__device__ __forceinline__ void mask_tile(f32x16& p0, f32x16& p1, int dq  ) {
    const float NEG = -__builtin_inff();
#pragma unroll
    for (int r = 0; r < 16; ++r) { const int c = (r & 3) + 8 * (r >> 2);
        if (c > dq) p0[r] = NEG;
        if (c + 32 > dq) p1[r] = NEG; }
}
__device__ __forceinline__ void softmax_tile(f32x16& p0, f32x16& p1, float& m_reg, float& l_reg, float& alpha, bf16x8& pa0, bf16x8& pa1, bf16x8& pa2, bf16x8& pa3) {
    float pmax = p0[0];
#pragma unroll
    for (int r = 1; r < 16; ++r) pmax = fmaxf(pmax, p0[r]);
#pragma unroll
    for (int r = 0; r < 16; ++r) pmax = fmaxf(pmax, p1[r]);
    { auto rr = __builtin_amdgcn_permlane32_swap(__float_as_uint(pmax), __float_as_uint(pmax), false, false); pmax = fmaxf(__uint_as_float(rr[0]), __uint_as_float(rr[1])); }
    const float mn = fmaxf(m_reg, pmax); alpha = __builtin_amdgcn_exp2f(m_reg - mn); m_reg = mn;
    float ps = 0.f;
#pragma unroll
    for (int r = 0; r < 16; ++r) { p0[r] = __builtin_amdgcn_exp2f(p0[r] - mn); ps += p0[r]; }
#pragma unroll
    for (int r = 0; r < 16; ++r) { p1[r] = __builtin_amdgcn_exp2f(p1[r] - mn); ps += p1[r]; }
    { auto rr = __builtin_amdgcn_permlane32_swap(__float_as_uint(ps), __float_as_uint(ps), false, false); ps = __uint_as_float(rr[0]) + __uint_as_float(rr[1]); }
    l_reg = l_reg * alpha + ps;
#define PK4(P, B_, OUT) do { unsigned a0 = cvt_pk_bf16(P[B_+0], P[B_+1]), a1 = cvt_pk_bf16(P[B_+2], P[B_+3]); \
        unsigned b0 = cvt_pk_bf16(P[B_+4], P[B_+5]), b1 = cvt_pk_bf16(P[B_+6], P[B_+7]); \
        auto r0 = __builtin_amdgcn_permlane32_swap(a0, b0, false, false); auto r1 = __builtin_amdgcn_permlane32_swap(a1, b1, false, false); \
        u32x4 w = {r0[0], r1[0], r0[1], r1[1]}; OUT = __builtin_bit_cast(bf16x8, w); } while (0)
    PK4(p0, 0, pa0); PK4(p0, 8, pa1); PK4(p1, 0, pa2); PK4(p1, 8, pa3);
#undef PK4
}

__device__ __forceinline__ void attn_block(int b, int h, int qb, const bf16_t* Q, const bf16_t* KN, const bf16_t* KR, const bf16_t* V, bf16_t* O, LAS char* lds) {
    const int tid = opaque_tid(), wid = __builtin_amdgcn_readfirstlane(tid >> 6), lane = tid & 63, r32 = lane & 31, hi = lane >> 5;
    const size_t row0 = (size_t)b * SEQ;
    const int q0 = qb * QB + wid * QBLK;
    const int NT = (qb + 1) * (QB / KVBLK);
    LAS char* V_lds = lds + OFF_V; LAS char* K_lds = lds + OFF_K;
    LAS float* ws = (LAS float*)(lds + OFF_WS) + wid * 64; LAS float* li_l = ws; LAS float* al_l = ws + 32;
    const int sr = tid >> 4, sc = (tid & 15) * 8, kr_row = tid >> 3, kr_c = tid & 7;
    const int vst0 = v_st(sr, sc), vst1 = v_st(32 + sr, sc), kws = k_addr(sr, tid & 15), kwr = k_addr(kr_row, 16 + kr_c);
    const int vb0 = (int)(uintptr_t)lds + v_rd_base(lane);
    const bf16_t* KNh = KN + row0 * 1024 + h * 128 + sc; const bf16_t* Vh = V + row0 * 1024 + h * 128 + sc; const bf16_t* KRb = KR + row0 * 64 + kr_c * 8;
    bf16x8 st_k0, st_k1, st_kr, st_v0, st_v1;
#define SLOAD(t) do { const size_t k0_ = (size_t)(t) * KVBLK; \
        st_k0 = *(const bf16x8*)(KNh + (k0_ + sr) * 1024); st_k1 = *(const bf16x8*)(KNh + (k0_ + 32 + sr) * 1024); st_kr = *(const bf16x8*)(KRb + (k0_ + kr_row) * 64); \
        st_v0 = *(const bf16x8*)(Vh + (k0_ + sr) * 1024); st_v1 = *(const bf16x8*)(Vh + (k0_ + 32 + sr) * 1024); } while (0)
#define SWRITE(bf) do { *(LAS bf16x8*)(K_lds + (bf) * SHM_K + kws) = st_k0; *(LAS bf16x8*)(K_lds + (bf) * SHM_K + kws + 32 * KPITCH) = st_k1; *(LAS bf16x8*)(K_lds + (bf) * SHM_K + kwr) = st_kr; \
        *(LAS bf16x8*)(V_lds + (bf) * SHM_V + vst0) = st_v0; *(LAS bf16x8*)(V_lds + (bf) * SHM_V + vst1) = st_v1; } while (0)
    SLOAD(0);
    bf16x8 qr[12];
    { const bf16_t* Qw = Q + (row0 + q0 + r32) * 1536 + h * 192 + hi * 8;
#pragma unroll
      for (int d0 = 0; d0 < 12; ++d0) qr[d0] = *(const bf16x8*)(Qw + d0 * 16); }
    float m_reg = -1e30f, l_reg = 0.f; f32x16 o[4] = {};
    f32x16 p0, p1; bf16x8 pa0, pa1, pa2, pa3; float alpha;
    asm volatile("s_waitcnt vmcnt(0)" ::: "memory");
    SWRITE(0);
    __syncthreads();
#define RESC(a) do { if (__any((a) < 1.f)) { if (hi == 0) al_l[r32] = (a); asm volatile("s_waitcnt lgkmcnt(0)" ::: "memory"); \
        _Pragma("unroll") for (int d_ = 0; d_ < 4; ++d_) _Pragma("unroll") for (int r = 0; r < 16; ++r) o[d_][r] *= al_l[crow(r, hi)]; } } while (0)
#define TILE(t, BF) do { const bool more_ = ((t) + 1 < NT); if (more_) SLOAD((t) + 1); SBAR(); \
        qkt<BF>(p0, p1, K_lds, r32, hi, qr); \
        { const int kb_ = (t) * KVBLK; if (kb_ + KVBLK - 1 > q0) mask_tile(p0, p1, q0 + r32 - kb_ - 4 * hi); } \
        softmax_tile(p0, p1, m_reg, l_reg, alpha, pa0, pa1, pa2, pa3); RESC(alpha); SBAR(); \
        pv_tile<BF>(o, vb0, pa0, pa1, pa2, pa3); \
        if (more_) { asm volatile("s_waitcnt vmcnt(0)" ::: "memory"); SWRITE((BF) ^ 1); } \
        __syncthreads(); } while (0)
#pragma unroll 1
    for (int t = 0; t < NT; t += 2) { TILE(t, 0); TILE(t + 1, 1); }
    if (hi == 0) li_l[r32] = l_reg; asm volatile("s_waitcnt lgkmcnt(0)" ::: "memory");
    bf16_t* Ow = O + (row0 + q0) * 1024 + h * 128;
#pragma unroll
    for (int r = 0; r < 16; ++r) { const int orow = crow(r, hi); const float rl = __builtin_amdgcn_rcpf(li_l[orow]);
#pragma unroll
        for (int d0 = 0; d0 < 4; ++d0) { const float v = o[d0][r] * rl; const float vn = __shfl_xor(v, 1);
            if ((r32 & 1) == 0) *(unsigned*)(Ow + (size_t)orow * 1024 + d0 * 32 + r32) = cvt_pk_bf16(v, vn); } }
    __syncthreads();
#undef SLOAD
#undef SWRITE
#undef RESC
#undef TILE
}
#undef SBAR
}

#define XB_TMO      128
#define XB_XCNT(j)  (256  + 64 * (j))
#define XB_XSUB(j)  (1280 + 64 * (j))
#define XB_XGEN(j)  (2304 + 64 * (j))
#define XB_TOP      3328
#define XB_TOPGEN   3392
#define XCD_BAR_WORDS 3456
#define XB_SPIN_CAP (1u << 22)
__device__ __forceinline__ unsigned xb_ld(unsigned* p)              { return __hip_atomic_load(p, __ATOMIC_RELAXED, __HIP_MEMORY_SCOPE_AGENT); }
__device__ __forceinline__ unsigned xb_add(unsigned* p, unsigned v) { return __hip_atomic_fetch_add(p, v, __ATOMIC_RELAXED, __HIP_MEMORY_SCOPE_AGENT); }
__device__ __forceinline__ unsigned xb_xcc_id() { return (unsigned)__builtin_amdgcn_s_getreg((3 << 11) | 20) & 0xFu; }
#define XB_SPIN(cond, bar) do { unsigned _sp = 0; while (cond) { __builtin_amdgcn_s_sleep(1); \
    if ((++_sp & 255u) == 0u) { if (xb_ld(&(bar)[XB_TMO])) break; if (_sp > XB_SPIN_CAP) { atomicAdd(&(bar)[XB_TMO], 1u); break; } } } } while (0)
struct XcdBarrier { unsigned* bar; unsigned x; volatile LAS unsigned* st; };
__device__ __forceinline__ XcdBarrier xcd_barrier_post(unsigned* bar, volatile LAS unsigned* st) {
    XcdBarrier b; b.bar = bar; b.x = xb_xcc_id(); b.st = st;
    if (threadIdx.x == 0) (void)xb_add(&bar[XB_XCNT(b.x)], 1u);
    return b;
}
__device__ __forceinline__ void xcd_barrier_complete(unsigned* bar, unsigned x, unsigned& nloc, unsigned& nx) {
    const unsigned G = gridDim.x * gridDim.y * gridDim.z;
    unsigned sum, cnt, mine, sp = 0u;
    for (;;) {
        sum = 0u; cnt = 0u; mine = 0u;
#pragma unroll
        for (unsigned j = 0; j < 16; ++j) { const unsigned c = xb_ld(&bar[XB_XCNT(j)]); sum += c; cnt += (c > 0u) ? 1u : 0u; mine = (j == x) ? c : mine; }
        if (sum == G) break;
        __builtin_amdgcn_s_sleep(1);
        if ((++sp & 255u) == 0u) { if (xb_ld(&bar[XB_TMO])) break; if (sp > XB_SPIN_CAP) { atomicAdd(&bar[XB_TMO], 1u); break; } }
    }
    nloc = mine > 0u ? mine : 1u; nx = cnt > 0u ? cnt : 1u;
}
__device__ __forceinline__ void xcd_barrier(const XcdBarrier& b) {
    asm volatile("s_waitcnt vmcnt(0)" ::: "memory");
    __syncthreads();
    if (threadIdx.x == 0) {
        unsigned* bar = b.bar;
        __builtin_amdgcn_s_waitcnt(0);
        unsigned nloc = b.st[0], nx = b.st[1];
        if (nloc == 0u) { xcd_barrier_complete(bar, b.x, nloc, nx); b.st[0] = nloc; b.st[1] = nx; }
        const unsigned old = xb_add(&bar[XB_XSUB(b.x)], 1u);
        const unsigned gen = old / nloc;
        if (old + 1u == (gen + 1u) * nloc) {
            __builtin_amdgcn_fence(__ATOMIC_RELEASE, "agent");
            asm volatile("s_waitcnt vmcnt(0)" ::: "memory");
            const unsigned og = xb_add(&bar[XB_TOP], 1u);
            const unsigned tg = og / nx;
            if (og + 1u == (tg + 1u) * nx) xb_add(&bar[XB_TOPGEN], 1u);
            else XB_SPIN(xb_ld(&bar[XB_TOPGEN]) == tg, bar);
            __builtin_amdgcn_fence(__ATOMIC_ACQUIRE, "agent");
            xb_add(&bar[XB_XGEN(b.x)], 1u);
            asm volatile("s_waitcnt vmcnt(0)" ::: "memory");
        } else {
            XB_SPIN(xb_ld(&bar[XB_XGEN(b.x)]) == gen, bar);
            __builtin_amdgcn_fence(__ATOMIC_ACQUIRE, "agent");
            asm volatile("s_waitcnt vmcnt(0)" ::: "memory");
        }
    }
    __syncthreads();
}

struct Args { const void* in[30]; float* out; unsigned char* ws; int ph_lo, ph_hi, li, pad; };
struct Ctx { int tid, lane, wave, vcu, G; LAS unsigned char* lds; volatile LAS int* misc; };
typedef const CAS Args* ArgsP;
__device__ __forceinline__ const CAS Args& fresh_args(ArgsP p) { asm volatile("" : "+s"(p)); return *p; }
enum { I_X = 0, I_P, I_POS, I_MLA_WIN, I_MLA_QN, I_MLA_KVN, I_MLA_WUQ, I_MLA_WUKV, I_MLA_WO, I_LRU_WIN, I_LRU_CW, I_LRU_CB, I_LRU_WA, I_LRU_BA, I_LRU_WX, I_LRU_BX, I_LRU_LAM, I_LRU_WOUT,
       I_LN1G, I_LN1B, I_LN2G, I_LN2B, I_MOE_WR, I_MOE_BR, I_MOE_WUP, I_MOE_BUP, I_MOE_WDN, I_MOE_BDN, I_PLE_WG, I_PLE_WP };
#define INF(i) ((const float*)args.in[i])
#define WSP(T_, off) ((T_*)(args.ws + (off)))

__device__ __forceinline__ void tr_item(const float* W, int ld, int k0, int sc0, int sc1, const float* ksc, bf16_t* dst  , int K, LAS float* scr, int lane) {
    const int half = (lane & 15) >> 3, scol = half ? sc1 : sc0, c4 = (lane & 7) * 4, rsub = lane >> 4;
    f32x4 v[16];
#pragma unroll
    for (int i = 0; i < 16; ++i) { const int kk = 4 * i + rsub;
        v[i] = (scol >= 0) ? *(const f32x4*)(W + (size_t)(k0 + kk) * ld + scol + c4) : (f32x4){0.f, 0.f, 0.f, 0.f}; }
    if (ksc) {
#pragma unroll
        for (int i = 0; i < 16; ++i) v[i] = v[i] * ksc[k0 + 4 * i + rsub]; }
#pragma unroll
    for (int i = 0; i < 16; ++i) { LAS float* s = scr + (4 * i + rsub) * 65 + (lane & 15) * 4; s[0] = v[i][0]; s[1] = v[i][1]; s[2] = v[i][2]; s[3] = v[i][3]; }
    asm volatile("s_waitcnt lgkmcnt(0)" ::: "memory");
    const int c = lane & 7;
#pragma unroll
    for (int j = 0; j < 8; ++j) { const int n = (lane >> 3) + 8 * j; const LAS float* s = scr + (8 * c) * 65 + n;
        u32x4 o; o.x = cvt_pk_bf16(s[0 * 65], s[1 * 65]); o.y = cvt_pk_bf16(s[2 * 65], s[3 * 65]); o.z = cvt_pk_bf16(s[4 * 65], s[5 * 65]); o.w = cvt_pk_bf16(s[6 * 65], s[7 * 65]);
        *(u32x4*)(dst + (size_t)n * K + 8 * c) = o; }
    asm volatile("s_waitcnt lgkmcnt(0)" ::: "memory");
}
enum { J_NAT = 0, J_MLA_WIN, J_MLA_WUQ, J_LRU_WAX, J_MOE_UP };
__device__ __forceinline__ int tr_map(int job, int g) {
    switch (job) {
    case J_MLA_WIN: return g < 32 ? 32 * g : (g == 32 ? 1024 : (g == 36 ? 1056 : -1));
    case J_MLA_WUQ: if (g < 32) { const int t = g >> 3, bj = (g >> 2) & 1, cg = g & 3; return (2 * t + bj) * 192 + 32 * cg; }
                    else { const int g2 = g - 32, t2 = g2 >> 3, bj = (g2 >> 2) & 1, hh = g2 & 3; return (4 * t2 + hh) * 192 + 128 + 32 * bj; }
    case J_LRU_WAX: { const int pn = g >> 3, cg = g & 3; return 128 * pn + 32 * cg; }
    case J_MOE_UP:  { const int pn = g >> 3, bj = (g >> 2) & 1, cg = g & 3; return bj * 1024 + 128 * pn + 32 * cg; }
    default: return 32 * g;
    }
}
__device__ __forceinline__ void tr_job(const Ctx& C, int job, const float* src, size_t srcstride, int nmat, int K, int ld, int N, bf16_t* dst, size_t dststride, const float* ksc, int kscstride,
                                       const float* src2  ) {
    LAS float* scr = (LAS float*)(C.lds + C.wave * 16640);
    const int gw = C.vcu * NWAVES + C.wave, NGW = C.G * NWAVES;
    const int nkb = K / 64, nnb = N / 64, per = nkb * nnb, total = per * nmat;
    for (int it = gw; it < total; it += NGW) {
        const int mat = it / per, r = it - mat * per, kb = r / nnb, nb = r - kb * nnb;
        int s0 = tr_map(job, 2 * nb), s1 = tr_map(job, 2 * nb + 1);
        const float* W = src + (size_t)mat * srcstride;
        if (job == J_LRU_WAX && ((nb >> 1) & 1)) W = src2 + (size_t)mat * srcstride;
        tr_item(W, ld, kb * 64, s0, s1, ksc ? ksc + (size_t)mat * kscstride : nullptr, (bf16_t*)((char*)dst + (size_t)mat * dststride) + (size_t)(nb * 64) * K + kb * 64, K, scr, C.lane);
    }
}
__device__ __forceinline__ void cvt_rows(const Ctx& C, const float* src, bf16_t* dst, size_t n8  ) {
    const size_t gt = (size_t)C.vcu * 512 + C.tid, NT = (size_t)C.G * 512;
    for (size_t i = gt; i < n8; i += NT) { const f32x4 a = *(const f32x4*)(src + i * 8), b = *(const f32x4*)(src + i * 8 + 4); *(u32x4*)(dst + i * 8) = pack8(a, b); }
}
__device__ __forceinline__ void phase_prologue(const CAS Args& args, const Ctx& C) {
    tr_job(C, J_MLA_WIN, INF(I_MLA_WIN), (size_t)DM * LATD, 2, DM, LATD, 1280, WSP(bf16_t, WS_W_MLA + OFF_MLA_WIN), W_MLA_STRIDE, nullptr, 0, nullptr);
    tr_job(C, J_MLA_WUQ, INF(I_MLA_WUQ), (size_t)QL * 1536, 2, QL, 1536, 1536, WSP(bf16_t, WS_W_MLA + OFF_MLA_WUQ), W_MLA_STRIDE, INF(I_MLA_QN), QL, nullptr);
    tr_job(C, J_NAT, INF(I_MLA_WUKV), (size_t)KVL * 2048, 2, KVL, 2048, 2048, WSP(bf16_t, WS_W_MLA + OFF_MLA_WUKV), W_MLA_STRIDE, INF(I_MLA_KVN), KVL, nullptr);
    tr_job(C, J_NAT, INF(I_MLA_WO), (size_t)DM * DM, 2, DM, DM, DM, WSP(bf16_t, WS_W_MLA + OFF_MLA_WO), W_MLA_STRIDE, nullptr, 0, nullptr);
    tr_job(C, J_NAT, INF(I_LRU_WIN), (size_t)DM * 2048, 2, DM, 2048, 2048, WSP(bf16_t, WS_W_LRU + OFF_LRU_WIN), W_LRU_STRIDE, nullptr, 0, nullptr);
    for (int j = 0; j < 2; ++j)
        tr_job(C, J_LRU_WAX, INF(I_LRU_WA) + (size_t)j * 4 * 65536, (size_t)256 * 256, 4, 256, 256, 512, WSP(bf16_t, WS_W_LRU + OFF_LRU_WAX + (size_t)j * W_LRU_STRIDE), (size_t)512 * 256 * 2, nullptr, 0, INF(I_LRU_WX) + (size_t)j * 4 * 65536);
    tr_job(C, J_NAT, INF(I_LRU_WOUT), (size_t)DM * DM, 2, DM, DM, DM, WSP(bf16_t, WS_W_LRU + OFF_LRU_WOUT), W_LRU_STRIDE, nullptr, 0, nullptr);
    tr_job(C, J_NAT, INF(I_PLE_WG), (size_t)DM * DM, 4, DM, DM, DM, WSP(bf16_t, WS_W_PLE + OFF_PLE_WG), W_PLE_STRIDE, nullptr, 0, nullptr);
    tr_job(C, J_NAT, INF(I_PLE_WP), (size_t)PLED * DM, 4, PLED, DM, DM, WSP(bf16_t, WS_W_PLE + OFF_PLE_WP), W_PLE_STRIDE, nullptr, 0, nullptr);
    tr_job(C, J_MOE_UP, INF(I_MOE_WUP), (size_t)DM * 2048, DEPTH * NE, DM, 2048, 2048, WSP(bf16_t, WS_W_UP), (size_t)2048 * 1024 * 2, nullptr, 0, nullptr);
    tr_job(C, J_NAT, INF(I_MOE_WDN), (size_t)DFF * DM, DEPTH * NE, DFF, DM, DM, WSP(bf16_t, WS_W_DN), (size_t)1024 * 1024 * 2, nullptr, 0, nullptr);
    cvt_rows(C, INF(I_X), WSP(bf16_t, WS_XB), (size_t)T * DM / 8);
    cvt_rows(C, INF(I_P), WSP(bf16_t, WS_PB), (size_t)DEPTH * T * PLED / 8);
    { const int* pos = (const int*)args.in[I_POS]; float* CS = WSP(float, WS_CS); float* SN = WSP(float, WS_SN);
      const size_t gt = (size_t)C.vcu * 512 + C.tid, NT = (size_t)C.G * 512;
      for (size_t i = gt; i < (size_t)T * 32; i += NT) { const int tok = (int)(i >> 5), j = (int)(i & 31);
          const double inv = exp(-9.210340371976184 * (double)j / 32.0); const double ang = (double)pos[tok] * inv; double s, c; sincos(ang, &s, &c); CS[i] = (float)c; SN[i] = (float)s; }
      float* SPL = WSP(float, WS_SPL); const float* lam = INF(I_LRU_LAM);
      for (size_t i = gt; i < 2 * 1024; i += NT) { const double l = (double)lam[i]; SPL[i] = (float)(-8.0 * log1p(exp(-l))); } }
}

__device__ __forceinline__ void moe_table(const CAS Args& args, const Ctx& C0, int layer) {
    Ctx C = C0; C.tid = opaque_tid(); C.lane = C.tid & 63;
    const unsigned* cnt = WSP(unsigned, WS_CTL) + CW_CNT + 64 * layer;
    __syncthreads();
    if (C.tid < 32) C.misc[64 + C.tid] = (int)__hip_atomic_load(cnt + C.tid, __ATOMIC_RELAXED, __HIP_MEMORY_SCOPE_AGENT);
    __syncthreads();
    if (C.tid == 0) { int acc = 0; for (int e = 0; e < 32; ++e) { C.misc[16 + e] = acc; acc += (C.misc[64 + e] + 255) >> 8; } C.misc[16 + 32] = acc; }
    __syncthreads();
}

__device__ __forceinline__ void phase_ln_router(const CAS Args& args, const Ctx& C0, int layer) {
    Ctx C = C0; C.tid = opaque_tid(); C.lane = C.tid & 63;
    const float* Y = WSP(float, WS_Y); float* X1 = WSP(float, WS_X1); bf16_t* X1B = WSP(bf16_t, WS_X1B);
    const float* g1 = INF(I_LN1G) + layer * DM; const float* b1 = INF(I_LN1B) + layer * DM;
    const CAS float* Wr = (const CAS float*)(INF(I_MOE_WR) + (size_t)layer * DM * NE); const float* br = INF(I_MOE_BR) + layer * NE;
    unsigned* gcnt = WSP(unsigned, WS_CTL) + CW_CNT + 64 * layer;
    int* lists = WSP(int, WS_LIST); int* slot = WSP(int, WS_SLOT); float* gate = WSP(float, WS_GATE);
    LAS float* part = (LAS float*)C.lds;
    volatile LAS int* lcnt = (volatile LAS int*)(C.lds + 69632);
    volatile LAS int* lbase = lcnt + 32;
    f32x4 gv[4], bv[4];
#pragma unroll
    for (int j = 0; j < 4; ++j) { gv[j] = *(const f32x4*)(g1 + 4 * C.lane + 256 * j); bv[j] = *(const f32x4*)(b1 + 4 * C.lane + 256 * j); }
    for (int chunk = C.vcu; chunk < T / 128; chunk += C.G) {
        const int row0 = chunk * 128;
        if (C.tid < 32) lcnt[C.tid] = 0;
        for (int i = 0; i < 16; ++i) { const size_t row = (size_t)row0 + C.wave * 16 + i;
            const f32x4* yr = (const f32x4*)(Y + row * DM) + C.lane; f32x4 v[4]; float s = 0.f;
#pragma unroll
            for (int j = 0; j < 4; ++j) { v[j] = yr[64 * j]; s += (v[j][0] + v[j][1]) + (v[j][2] + v[j][3]); }
            const float mean = wave_sum(s) * (1.f / DM); float s2 = 0.f;
#pragma unroll
            for (int j = 0; j < 4; ++j) { v[j] = v[j] - mean; s2 += (v[j][0] * v[j][0] + v[j][1] * v[j][1]) + (v[j][2] * v[j][2] + v[j][3] * v[j][3]); }
            const float rstd = 1.f / sqrtf(wave_sum(s2) * (1.f / DM) + LN_EPS);
#pragma unroll
            for (int j = 0; j < 4; ++j) { const f32x4 o = v[j] * rstd * gv[j] + bv[j]; *((f32x4*)(X1 + row * DM) + C.lane + 64 * j) = o;
                u32x2 w; w.x = cvt_pk_bf16(o[0], o[1]); w.y = cvt_pk_bf16(o[2], o[3]); *((u32x2*)(X1B + row * DM) + C.lane + 64 * j) = w; } }
        asm volatile("s_waitcnt vmcnt(0)" ::: "memory");
        __syncthreads();
        { const int grp = C.wave >> 2, kq = C.wave & 3; const size_t tok = (size_t)row0 + grp * 64 + C.lane;
          float acc[32];
#pragma unroll
          for (int e = 0; e < 32; ++e) acc[e] = 0.f;
          const float* xr = X1 + tok * DM + kq * 256;
          for (int kk = 0; kk < 64; ++kk) { const f32x4 xv = *(const f32x4*)(xr + kk * 4);
#pragma unroll
              for (int i = 0; i < 4; ++i) { const CAS float* wrow = Wr + (size_t)(kq * 256 + kk * 4 + i) * NE;
#pragma unroll
                  for (int e = 0; e < 32; ++e) acc[e] = fmaf(xv[i], wrow[e], acc[e]); } }
          LAS float* pp = part + ((grp * 4 + kq) * 64 + C.lane) * 33;
#pragma unroll
          for (int e = 0; e < 32; ++e) pp[e] = acc[e]; }
        __syncthreads();
        int te[4] = {0, 0, 0, 0}, lp[4] = {0, 0, 0, 0}; float tg[4] = {0.f, 0.f, 0.f, 0.f};
        if (C.tid < 128) { const int grp = C.tid >> 6, ln = C.tid & 63; float lg[32];
#pragma unroll
            for (int e = 0; e < 32; ++e) { float s = br[e];
#pragma unroll
                for (int kq = 0; kq < 4; ++kq) s += part[((grp * 4 + kq) * 64 + ln) * 33 + e];
                lg[e] = s; }
            float tv[4];
#pragma unroll
            for (int k = 0; k < 4; ++k) { float best = -__builtin_inff(); int bi = 0;
#pragma unroll
                for (int e = 0; e < 32; ++e) { bool taken = false;
#pragma unroll
                    for (int q = 0; q < 4; ++q) if (q < k) taken = taken || (te[q] == e);
                    if (!taken && lg[e] > best) { best = lg[e]; bi = e; } }
                te[k] = bi; tv[k] = best; }
            float den = 0.f;
#pragma unroll
            for (int k = 0; k < 4; ++k) { tg[k] = __expf(tv[k] - tv[0]); den += tg[k]; }
            const float rden = 1.0f / den;
#pragma unroll
            for (int k = 0; k < 4; ++k) { tg[k] *= rden; lp[k] = __hip_atomic_fetch_add((LAS int*)&lcnt[te[k]], 1, __ATOMIC_RELAXED, __HIP_MEMORY_SCOPE_WORKGROUP); } }
        __syncthreads();
        if (C.tid < 32) lbase[C.tid] = (int)__hip_atomic_fetch_add(gcnt + C.tid, (unsigned)lcnt[C.tid], __ATOMIC_RELAXED, __HIP_MEMORY_SCOPE_AGENT);
        __syncthreads();
        if (C.tid < 128) { const int tok = row0 + C.tid;
#pragma unroll
            for (int k = 0; k < 4; ++k) { const int pos = lbase[te[k]] + lp[k]; lists[(size_t)te[k] * T + pos] = tok; slot[tok * 4 + k] = te[k] * T + pos; gate[tok * 4 + k] = tg[k]; } }
        __syncthreads();
    }
}

__device__ __forceinline__ void phase_combine_ln2(const CAS Args& args, const Ctx& C0, int layer) {
    Ctx C = C0; C.tid = opaque_tid(); C.lane = C.tid & 63;
    moe_table(args, C, layer);
    const float* X1 = WSP(float, WS_X1); const bf16_t* YS = WSP(bf16_t, WS_YS); const int* slot = WSP(int, WS_SLOT); const float* gate = WSP(float, WS_GATE);
    float* X2 = WSP(float, WS_X2); bf16_t* X2B = WSP(bf16_t, WS_X2B);
    const float* g2 = INF(I_LN2G) + layer * DM; const float* b2 = INF(I_LN2B) + layer * DM;
    f32x4 gv[4], bv[4];
#pragma unroll
    for (int j = 0; j < 4; ++j) { gv[j] = *(const f32x4*)(g2 + 4 * C.lane + 256 * j); bv[j] = *(const f32x4*)(b2 + 4 * C.lane + 256 * j); }
    const int gw = C.vcu * NWAVES + C.wave, NGW = C.G * NWAVES;
    for (int row = gw; row < T; row += NGW) {
        f32x4 v[4];
#pragma unroll
        for (int j = 0; j < 4; ++j) v[j] = *((const f32x4*)(X1 + (size_t)row * DM) + C.lane + 64 * j) * ALPHA;
#pragma unroll
        for (int k = 0; k < 4; ++k) { const int sv = slot[row * 4 + k]; const float g = gate[row * 4 + k]; const int e = sv >> 15, pos = sv & (T - 1);
            const size_t prow = (size_t)C.misc[16 + e] * 256 + pos; const u32x2* yr = (const u32x2*)(YS + prow * DM) + C.lane;
#pragma unroll
            for (int j = 0; j < 4; ++j) { const u32x2 w = yr[64 * j]; v[j][0] += g * bf_lo(w.x); v[j][1] += g * bf_hi(w.x); v[j][2] += g * bf_lo(w.y); v[j][3] += g * bf_hi(w.y); } }
        float s = 0.f;
#pragma unroll
        for (int j = 0; j < 4; ++j) s += (v[j][0] + v[j][1]) + (v[j][2] + v[j][3]);
        const float mean = wave_sum(s) * (1.f / DM); float s2 = 0.f;
#pragma unroll
        for (int j = 0; j < 4; ++j) { v[j] = v[j] - mean; s2 += (v[j][0] * v[j][0] + v[j][1] * v[j][1]) + (v[j][2] * v[j][2] + v[j][3] * v[j][3]); }
        const float rstd = 1.f / sqrtf(wave_sum(s2) * (1.f / DM) + LN_EPS);
#pragma unroll
        for (int j = 0; j < 4; ++j) { const f32x4 o = v[j] * rstd * gv[j] + bv[j]; *((f32x4*)(X2 + (size_t)row * DM) + C.lane + 64 * j) = o;
            u32x2 w; w.x = cvt_pk_bf16(o[0], o[1]); w.y = cvt_pk_bf16(o[2], o[3]); *((u32x2*)(X2B + (size_t)row * DM) + C.lane + 64 * j) = w; }
    }
}

__device__ __forceinline__ void phase_conv(const CAS Args& args, const Ctx& C0, int j) {
    Ctx C = C0; C.tid = opaque_tid(); C.lane = C.tid & 63;
    const bf16_t* U = WSP(bf16_t, WS_U); bf16_t* UC = WSP(bf16_t, WS_UC);
    const float* cw = INF(I_LRU_CW) + (size_t)j * 4 * DM; const float* cb = INF(I_LRU_CB) + (size_t)j * DM;
    const int c8 = (C.tid & 127) * 8, rsub = C.tid >> 7;
    float w[4][8], bb[8];
#pragma unroll
    for (int q = 0; q < 4; ++q)
#pragma unroll
        for (int e = 0; e < 8; ++e) w[q][e] = cw[q * DM + c8 + e];
#pragma unroll
    for (int e = 0; e < 8; ++e) bb[e] = cb[c8 + e];
    for (int chunk = C.vcu; chunk < T / 128; chunk += C.G) {
        const int r0 = chunk * 128 + rsub * 32;
        u32x4 h0, h1, h2;
        const u32x4 z = {0u, 0u, 0u, 0u};
        const int s0 = r0 & (SEQ - 1);
        h0 = s0 >= 3 ? *(const u32x4*)(U + (size_t)(r0 - 3) * DM + c8) : z; h1 = s0 >= 2 ? *(const u32x4*)(U + (size_t)(r0 - 2) * DM + c8) : z; h2 = s0 >= 1 ? *(const u32x4*)(U + (size_t)(r0 - 1) * DM + c8) : z;
#pragma unroll 4
        for (int i = 0; i < 32; ++i) { const u32x4 h3 = *(const u32x4*)(U + (size_t)(r0 + i) * DM + c8);
            float o[8];
#pragma unroll
            for (int q = 0; q < 4; ++q) { const unsigned a = h0[q], b = h1[q], c = h2[q], d = h3[q];
                o[2 * q] = bb[2 * q] + w[0][2 * q] * bf_lo(a) + w[1][2 * q] * bf_lo(b) + w[2][2 * q] * bf_lo(c) + w[3][2 * q] * bf_lo(d);
                o[2 * q + 1] = bb[2 * q + 1] + w[0][2 * q + 1] * bf_hi(a) + w[1][2 * q + 1] * bf_hi(b) + w[2][2 * q + 1] * bf_hi(c) + w[3][2 * q + 1] * bf_hi(d); }
            u32x4 ow; ow.x = cvt_pk_bf16(o[0], o[1]); ow.y = cvt_pk_bf16(o[2], o[3]); ow.z = cvt_pk_bf16(o[4], o[5]); ow.w = cvt_pk_bf16(o[6], o[7]);
            *(u32x4*)(UC + (size_t)(r0 + i) * DM + c8) = ow; h0 = h1; h1 = h2; h2 = h3; }
    }
}
__device__ __forceinline__ void phase_scan1(const CAS Args& args, const Ctx& C0) {
    Ctx C = C0; C.tid = opaque_tid(); C.lane = C.tid & 63;
    const float* AA = WSP(float, WS_AA); const float* BB = WSP(float, WS_BB); float* CA = WSP(float, WS_CA); float* CH = WSP(float, WS_CH);
    const int c2 = C.tid * 2;
    for (int item = C.vcu; item < NBATCH * 64; item += C.G) {
        const size_t r0 = (size_t)item * 64; float h0 = 0.f, h1 = 0.f, p0 = 1.f, p1 = 1.f;
#pragma unroll 8
        for (int s = 0; s < 64; ++s) { const f32x2 a = *(const f32x2*)(AA + (r0 + s) * DM + c2), b = *(const f32x2*)(BB + (r0 + s) * DM + c2);
            h0 = a[0] * h0 + b[0]; h1 = a[1] * h1 + b[1]; p0 *= a[0]; p1 *= a[1]; }
        *(f32x2*)(CA + (size_t)item * DM + c2) = (f32x2){p0, p1}; *(f32x2*)(CH + (size_t)item * DM + c2) = (f32x2){h0, h1};
    }
}
__device__ __forceinline__ void phase_scan2(const CAS Args& args, const Ctx& C0) {
    Ctx C = C0; C.tid = opaque_tid(); C.lane = C.tid & 63;
    const float* AA = WSP(float, WS_AA); const float* BB = WSP(float, WS_BB); const float* CA = WSP(float, WS_CA); const float* CH = WSP(float, WS_CH);
    const bf16_t* GG = WSP(bf16_t, WS_GG); bf16_t* YL = WSP(bf16_t, WS_O);
    const int c2 = C.tid * 2;
    for (int item = C.vcu; item < NBATCH * 64; item += C.G) {
        const int b = item >> 6, ch = item & 63; float h0 = 0.f, h1 = 0.f;
        for (int jx = 0; jx < ch; ++jx) { const f32x2 a = *(const f32x2*)(CA + (size_t)(b * 64 + jx) * DM + c2), e = *(const f32x2*)(CH + (size_t)(b * 64 + jx) * DM + c2);
            h0 = a[0] * h0 + e[0]; h1 = a[1] * h1 + e[1]; }
        const size_t r0 = (size_t)item * 64;
#pragma unroll 8
        for (int s = 0; s < 64; ++s) { const f32x2 a = *(const f32x2*)(AA + (r0 + s) * DM + c2), bq = *(const f32x2*)(BB + (r0 + s) * DM + c2); const unsigned g = *(const unsigned*)(GG + (r0 + s) * DM + c2);
            h0 = a[0] * h0 + bq[0]; h1 = a[1] * h1 + bq[1];
            *(unsigned*)(YL + (r0 + s) * DM + c2) = cvt_pk_bf16(bf_lo(g) * h0, bf_hi(g) * h1); }
    }
}

constexpr int PH_PER_LAYER = 12, PH_TOTAL = 2 + PH_PER_LAYER * DEPTH;
__global__ void __launch_bounds__(NWAVES * 64, 2) fwd_kernel(Args args_kernarg) {
    (void)args_kernarg;
    ArgsP const argp = (ArgsP)__builtin_amdgcn_kernarg_segment_ptr();
    const CAS Args& args0 = *argp;
    extern __shared__ __attribute__((aligned(16))) unsigned char lds_raw[];
    Ctx C;
    C.lds = (LAS unsigned char*)lds_raw; C.misc = (volatile LAS int*)(C.lds + MISC_OFF);
    C.tid = threadIdx.x; C.lane = C.tid & 63; C.wave = __builtin_amdgcn_readfirstlane(C.tid >> 6);
    C.G = gridDim.x; { const int bx = blockIdx.x; C.vcu = (C.G % 8 == 0) ? (bx % 8) * (C.G / 8) + bx / 8 : bx; }
    for (int u = C.tid; u < 128; u += NWAVES * 64) C.misc[u] = 0;
    __syncthreads();
    XcdBarrier bar = xcd_barrier_post((unsigned*)(args0.ws + WS_CTL) + CW_BAR + args0.li * XCD_BAR_WORDS, (volatile LAS unsigned*)C.misc);
    const int lo = args0.ph_lo, hi = args0.ph_hi;
#define IN(k) (lo <= (k) && (k) < hi)
#define PH_END(k) do { if ((k) + 1 < hi) xcd_barrier(bar); } while (0)
    const int cid = (int)blockIdx.x;

    if (SEL(0) && IN(0)) { const CAS Args& args = fresh_args(argp); phase_prologue(args, C); PH_END(0); }
    if (SEL(1) && IN(1)) { const CAS Args& args = fresh_args(argp);
        pg8::DenseSched S; S.init(WSP(bf16_t, WS_PB), WSP(bf16_t, WS_W_PLE + OFF_PLE_WP), PLED, PLED, DEPTH * T, DM, C.G, cid); S.bpm_shift = 7; S.bbatch = W_PLE_STRIDE;
        pg8::EpiPP E{WSP(bf16_t, WS_PP)};
        pg8::gemm_phase<pg8::EpiPP, pg8::DenseSched, false>(C.lds, PLED, PLED, PLED, S, E);
        PH_END(1);
    }
    for (int layer = 0; layer < DEPTH; ++layer) {
        const int base = 2 + PH_PER_LAYER * layer, j = layer >> 1;
        if ((layer & 1) == 0) {
            if (SEL(2) && IN(base + 0)) { const CAS Args& args = fresh_args(argp); const unsigned char* wm = args.ws + WS_W_MLA + (size_t)j * W_MLA_STRIDE;
                pg8::DenseSched S; S.init(WSP(bf16_t, WS_XB), wm + OFF_MLA_WIN, DM, DM, T, 1280, C.G, cid);
                pg8::EpiLat E{WSP(bf16_t, WS_LAT), WSP(float, WS_SSQ), WSP(bf16_t, WS_KR), WSP(float, WS_CS), WSP(float, WS_SN)};
                pg8::gemm_phase<pg8::EpiLat, pg8::DenseSched, false>(C.lds, DM, DM, DM, S, E);
                PH_END(base + 0);
            }
            if (SEL(3) && IN(base + 1)) { const CAS Args& args = fresh_args(argp); const unsigned char* wm = args.ws + WS_W_MLA + (size_t)j * W_MLA_STRIDE;
                { pg8::DenseSched S; S.init(WSP(bf16_t, WS_LAT), wm + OFF_MLA_WUQ, DM, QL, T, 1536, C.G, cid);
                  pg8::EpiQ E{WSP(bf16_t, WS_Q), WSP(float, WS_SSQ), WSP(float, WS_CS), WSP(float, WS_SN)};
                  pg8::gemm_phase<pg8::EpiQ, pg8::DenseSched, false>(C.lds, QL, DM, QL, S, E); }
                { pg8::DenseSched S; S.init(WSP(bf16_t, WS_LAT) + QL, wm + OFF_MLA_WUKV, DM, KVL, T, 2048, C.G, cid);
                  pg8::EpiKV E{WSP(bf16_t, WS_KN), WSP(bf16_t, WS_V), WSP(float, WS_SSQ)};
                  pg8::gemm_phase<pg8::EpiKV, pg8::DenseSched, false>(C.lds, KVL, DM, KVL, S, E); }
                PH_END(base + 1);
            }
            if (SEL(4) && IN(base + 2)) { const CAS Args& args = fresh_args(argp);
                for (int it = C.vcu; it < NBATCH * NH * 8; it += C.G) { const int bh = it >> 3, pr = it & 7;
                    att::attn_block(bh >> 3, bh & 7, pr, WSP(bf16_t, WS_Q), WSP(bf16_t, WS_KN), WSP(bf16_t, WS_KR), WSP(bf16_t, WS_V), WSP(bf16_t, WS_O), (LAS char*)C.lds);
                    att::attn_block(bh >> 3, bh & 7, 15 - pr, WSP(bf16_t, WS_Q), WSP(bf16_t, WS_KN), WSP(bf16_t, WS_KR), WSP(bf16_t, WS_V), WSP(bf16_t, WS_O), (LAS char*)C.lds); }
                PH_END(base + 2);
            }
        } else {
            if (SEL(5) && IN(base + 0)) { const CAS Args& args = fresh_args(argp); const unsigned char* wl = args.ws + WS_W_LRU + (size_t)j * W_LRU_STRIDE;
                pg8::DenseSched S; S.init(WSP(bf16_t, WS_XB), wl + OFF_LRU_WIN, DM, DM, T, 2048, C.G, cid);
                pg8::EpiGU E{WSP(bf16_t, WS_GG), WSP(bf16_t, WS_U)};
                pg8::gemm_phase<pg8::EpiGU, pg8::DenseSched, false>(C.lds, DM, DM, DM, S, E);
                PH_END(base + 0);
            }
            if (SEL(6) && IN(base + 1)) { const CAS Args& args = fresh_args(argp); phase_conv(args, C, j); PH_END(base + 1); }
            if (SEL(7) && IN(base + 2)) { const CAS Args& args = fresh_args(argp); const unsigned char* wl = args.ws + WS_W_LRU + (size_t)j * W_LRU_STRIDE;
                pg8::DenseSched S; S.init(WSP(bf16_t, WS_UC), wl + OFF_LRU_WAX, DM, 256, T, 2048, C.G, cid); S.apn_shift = 1; S.akbytes = 512;
                pg8::EpiAB E{WSP(float, WS_AA), WSP(float, WS_BB), WSP(bf16_t, WS_UC), INF(I_LRU_BA) + j * DM, INF(I_LRU_BX) + j * DM, WSP(float, WS_SPL) + j * DM};
                pg8::gemm_phase<pg8::EpiAB, pg8::DenseSched, false>(C.lds, 256, DM, 256, S, E);
                PH_END(base + 2);
            }
            if (SEL(8) && IN(base + 3)) { const CAS Args& args = fresh_args(argp); phase_scan1(args, C); PH_END(base + 3); }
            if (SEL(9) && IN(base + 4)) { const CAS Args& args = fresh_args(argp); phase_scan2(args, C); PH_END(base + 4); }
        }
        if (SEL(10) && IN(base + 5)) { const CAS Args& args = fresh_args(argp); const float* XF = layer == 0 ? INF(I_X) : (const float*)args.out;
            const unsigned char* wo = (layer & 1) ? args.ws + WS_W_LRU + (size_t)j * W_LRU_STRIDE + OFF_LRU_WOUT : args.ws + WS_W_MLA + (size_t)j * W_MLA_STRIDE + OFF_MLA_WO;
            pg8::DenseSched S; S.init(WSP(bf16_t, WS_O), wo, DM, DM, T, DM, C.G, cid);
            pg8::EpiRes E{XF, WSP(float, WS_Y)};
            pg8::gemm_phase<pg8::EpiRes, pg8::DenseSched, false>(C.lds, DM, DM, DM, S, E);
            PH_END(base + 5);
        }
        if (SEL(11) && IN(base + 6)) { const CAS Args& args = fresh_args(argp); phase_ln_router(args, C, layer); PH_END(base + 6); }
        if (SEL(12) && IN(base + 7)) { const CAS Args& args = fresh_args(argp);
            moe_table(args, C, layer);
            pg8::MoeSched S{(const char*)WSP(bf16_t, WS_X1B), (const char*)(args.ws + WS_W_UP + (size_t)layer * NE * 2048 * 1024 * 2), (size_t)2048 * 1024 * 2, DM, DM, 8, WSP(int, WS_LIST), C.misc + 16, C.G, cid, true};
            pg8::EpiUp E{WSP(bf16_t, WS_H), INF(I_MOE_BUP) + (size_t)layer * NE * 2048};
            pg8::gemm_phase<pg8::EpiUp, pg8::MoeSched, true>(C.lds, DM, DM, DM, S, E);
            PH_END(base + 7);
        }
        if (SEL(13) && IN(base + 8)) { const CAS Args& args = fresh_args(argp);
            moe_table(args, C, layer);
            pg8::MoeSched S{(const char*)WSP(bf16_t, WS_H), (const char*)(args.ws + WS_W_DN + (size_t)layer * NE * 1024 * 1024 * 2), (size_t)1024 * 1024 * 2, DFF, DFF, 4, WSP(int, WS_LIST), C.misc + 16, C.G, cid, false};
            pg8::EpiDown E{WSP(bf16_t, WS_YS), INF(I_MOE_BDN) + (size_t)layer * NE * DM};
            pg8::gemm_phase<pg8::EpiDown, pg8::MoeSched, false>(C.lds, DFF, DFF, DFF, S, E);
            PH_END(base + 8);
        }
        if (SEL(14) && IN(base + 9)) { const CAS Args& args = fresh_args(argp); phase_combine_ln2(args, C, layer); PH_END(base + 9); }
        if (SEL(15) && IN(base + 10)) { const CAS Args& args = fresh_args(argp);
            pg8::DenseSched S; S.init(WSP(bf16_t, WS_X2B), args.ws + WS_W_PLE + (size_t)layer * W_PLE_STRIDE + OFF_PLE_WG, DM, DM, T, DM, C.G, cid);
            pg8::EpiPle E{WSP(float, WS_X2), WSP(bf16_t, WS_PP) + (size_t)layer * T * DM, args.out, WSP(bf16_t, WS_XB)};
            pg8::gemm_phase<pg8::EpiPle, pg8::DenseSched, false>(C.lds, DM, DM, DM, S, E);
            if (layer + 1 < DEPTH) PH_END(base + 10);
        }
    }
#undef IN
#undef PH_END
}

extern "C" void kernel_launch(void* const* d_in, const int* in_sizes, int n_in, void* d_out, int out_size, void* d_ws, size_t ws_size, hipStream_t stream) {
    static int grid = 0;
    if (grid == 0) {
        if (n_in != 30 || in_sizes[0] != T * DM || out_size != T * DM || ws_size < WS_END) { fprintf(stderr, "kernel_launch: unexpected shapes (n_in %d, in0 %d, out %d, ws %zu)\n", n_in, n_in > 0 ? in_sizes[0] : -1, out_size, ws_size); grid = -1; return; }
        int dev = 0, cus = 0, per_cu = 0;
        if (hipGetDevice(&dev) != hipSuccess || hipDeviceGetAttribute(&cus, hipDeviceAttributeMultiprocessorCount, dev) != hipSuccess) { grid = -1; return; }
        if (hipFuncSetAttribute((const void*)fwd_kernel, hipFuncAttributeMaxDynamicSharedMemorySize, LDS_BYTES) != hipSuccess) { fprintf(stderr, "kernel_launch: hipFuncSetAttribute failed\n"); grid = -1; return; }
        if (hipOccupancyMaxActiveBlocksPerMultiprocessor(&per_cu, (const void*)fwd_kernel, NWAVES * 64, LDS_BYTES) != hipSuccess || per_cu < 1) fprintf(stderr, "kernel_launch: occupancy query reports %d\n", per_cu);
        (void)hipGetLastError();
        grid = cus;
    }
    if (grid < 0) return;
    if (hipMemsetAsync((char*)d_ws + WS_CTL, 0, CTL_ZERO_BYTES, stream) != hipSuccess) return;
    Args a{};
    for (int i = 0; i < 30; ++i) a.in[i] = d_in[i];
    a.out = (float*)d_out; a.ws = (unsigned char*)d_ws; a.pad = 0;
#if MK_ONE_LAUNCH
    a.ph_lo = 0; a.ph_hi = PH_TOTAL; a.li = 0;
    hipLaunchKernelGGL(fwd_kernel, dim3(grid), dim3(NWAVES * 64), LDS_BYTES, stream, a);
#else
    int li = 0;
    for (int ph = 0; ph < PH_TOTAL; ++ph) {
        if (ph >= 2) { const int l = (ph - 2) / PH_PER_LAYER, k = (ph - 2) % PH_PER_LAYER; if (k == 11) continue; if ((l & 1) == 0 && (k == 3 || k == 4)) continue; }
        a.ph_lo = ph; a.ph_hi = ph + 1; a.li = li++;
        hipLaunchKernelGGL(fwd_kernel, dim3(grid), dim3(NWAVES * 64), LDS_BYTES, stream, a);
    }
#endif
}
```

```cpp
#include <hip/hip_runtime.h>
#include <hip/hip_bf16.h>
#include <cstdio>
#include <cstdint>

#ifndef PHSEL
#define PHSEL -1
#endif
#define SEL(id) (PHSEL < 0 || PHSEL == (id))
#ifndef HOSTDUP
#define HOSTDUP 0
#endif
#ifndef MK_ONE_LAUNCH
#define MK_ONE_LAUNCH 1
#endif

constexpr int T = 32768, SEQ = 4096, NBATCH = 8, DM = 1024, DEPTH = 4;
constexpr int QL = 768, KVL = 256, ROPE = 64, LATD = 1088, NH = 8, DQK = 192, DV = 128;
constexpr int NE = 32, TOPK = 4, DFF = 1024, PLED = 256;
constexpr float ALPHA = 1.681792830507429f;
constexpr float LN_EPS = 1e-5f, RMS_EPS = 1e-6f;
constexpr float QSCALE = 1.4426950408889634f / 13.856406460551018f;
constexpr int NWAVES = 8;

constexpr size_t MiB = 1u << 20;
constexpr size_t WS_CTL = 0, CTL_ZERO_BYTES = 2 * MiB;
constexpr size_t WS_CS = 2 * MiB, WS_SN = 6 * MiB, WS_SPL = 10 * MiB;
constexpr size_t WS_W_MLA = 12 * MiB, W_MLA_STRIDE = 8 * MiB;
constexpr size_t OFF_MLA_WIN = 0, OFF_MLA_WUQ = 2560 * 1024, OFF_MLA_WUKV = OFF_MLA_WUQ + 2304 * 1024, OFF_MLA_WO = OFF_MLA_WUKV + 1024 * 1024;
constexpr size_t WS_W_LRU = 28 * MiB, W_LRU_STRIDE = 8 * MiB;
constexpr size_t OFF_LRU_WIN = 0, OFF_LRU_WAX = 4 * MiB, OFF_LRU_WOUT = 5 * MiB;
constexpr size_t WS_W_PLE = 44 * MiB, W_PLE_STRIDE = 3 * MiB;
constexpr size_t OFF_PLE_WG = 0, OFF_PLE_WP = 2 * MiB;
constexpr size_t WS_W_UP = 56 * MiB;
constexpr size_t WS_W_DN = 568 * MiB;
constexpr size_t WS_XB = 824 * MiB, WS_PB = 888 * MiB, WS_PP = 952 * MiB;
constexpr size_t WS_Y = 1208 * MiB, WS_X1 = 1336 * MiB, WS_X1B = 1464 * MiB, WS_X2 = 1528 * MiB, WS_X2B = 1656 * MiB;
constexpr size_t WS_LAT = 1720 * MiB, WS_KR = 1784 * MiB, WS_SSQ = 1788 * MiB, WS_Q = 1790 * MiB, WS_KN = 1886 * MiB, WS_V = 1950 * MiB, WS_O = 2014 * MiB;
constexpr size_t WS_GG = 2078 * MiB, WS_U = 2142 * MiB, WS_UC = 2206 * MiB, WS_AA = 2270 * MiB, WS_BB = 2398 * MiB, WS_CA = 2526 * MiB, WS_CH = 2528 * MiB;
constexpr size_t WS_H = 2530 * MiB, WS_YS = 2802 * MiB, WS_LIST = 3074 * MiB, WS_SLOT = 3078 * MiB, WS_GATE = 3079 * MiB, WS_END = 3080 * MiB;
constexpr int PADROWS = T * TOPK + NE * 256;
static_assert((size_t)PADROWS * DFF * 2 <= 272 * MiB, "H / YS size");
constexpr int CW_CNT = 256;
constexpr int CW_BAR = 4096;

constexpr int RING_BYTES = 139264;
constexpr int MISC_OFF = RING_BYTES;
constexpr int LDS_BYTES = 147456;

#define GAS __attribute__((address_space(1)))
#define LAS __attribute__((address_space(3)))
#define CAS __attribute__((address_space(4)))
typedef unsigned short bf16_t;
typedef short bf16x8 __attribute__((ext_vector_type(8)));
typedef short s16x4 __attribute__((ext_vector_type(4)));
typedef float f32x2 __attribute__((ext_vector_type(2)));
typedef float f32x4 __attribute__((ext_vector_type(4)));
typedef float f32x16 __attribute__((ext_vector_type(16)));
typedef unsigned u32x2 __attribute__((ext_vector_type(2)));
typedef unsigned u32x4 __attribute__((ext_vector_type(4)));

__device__ __forceinline__ unsigned cvt_pk_bf16(float lo, float hi) { unsigned r; asm volatile("v_cvt_pk_bf16_f32 %0, %1, %2" : "=v"(r) : "v"(lo), "v"(hi)); return r; }
__device__ __forceinline__ float bf_lo(unsigned w) { return __uint_as_float(w << 16); }
__device__ __forceinline__ float bf_hi(unsigned w) { return __uint_as_float(w & 0xffff0000u); }
__device__ __forceinline__ float sigmoidf_(float x) { return __builtin_amdgcn_rcpf(1.0f + __expf(-x)); }
__device__ __forceinline__ float gelu_tanh(float x) { const float u = 0.7978845608028654f * (x + 0.044715f * x * x * x); const float t = 1.0f - 2.0f * __builtin_amdgcn_rcpf(1.0f + __expf(2.0f * u)); return 0.5f * x * (1.0f + t); }
__device__ __forceinline__ u32x4 pack8(const f32x4 a, const f32x4 b) { u32x4 w; w.x = cvt_pk_bf16(a[0], a[1]); w.y = cvt_pk_bf16(a[2], a[3]); w.z = cvt_pk_bf16(b[0], b[1]); w.w = cvt_pk_bf16(b[2], b[3]); return w; }
__device__ __forceinline__ int opaque_tid() { int t = threadIdx.x; asm volatile("" : "+v"(t)); return t; }
__device__ __forceinline__ float wave_sum(float v) {
#pragma unroll
    for (int o = 1; o < 64; o <<= 1) v += __shfl_xor(v, o);
    return v;
}

namespace pg8 {
#define PG8_LAS __attribute__((address_space(3)))
constexpr int BM = 256, BK = 64, HALF = 128, HTB = HALF * BK * 2, STAGE_BYTES = 8 * HTB;
__host__ __device__ __forceinline__ int lds_byte(int r, int c) { const int st = (r >> 4) * 2 + (c >> 5), rr = r & 15, cc = c & 31, ob = rr * 64 + cc * 2; return st * 1024 + (ob ^ (((ob >> 9) & 1) << 5)); }
__host__ __device__ __forceinline__ void stage_rc(int b, int& R, int& C) { const int st = b / 1024, sb = b % 1024, swz = sb ^ (((sb >> 9) & 1) << 5); R = (st >> 1) * 16 + swz / 64; C = (st & 1) * 32 + (swz % 64) / 2; }
__host__ __device__ __forceinline__ int perm32(int rho) { const int n = rho >> 4, i = rho & 15; return 8 * (i >> 2) + 4 * n + (i & 3); }

struct Unit { const char* A; const char* B; const int* lst; int nvalid; int pm, pn, aux; };

template <class Epi, class Sched, bool GATHER>
__device__ __forceinline__ void gemm_phase(PG8_LAS unsigned char* lds, const int K, const int lda, const int ldb, const Sched& S, const Epi& E) {
    const int tid = opaque_tid(), wid = __builtin_amdgcn_readfirstlane(tid >> 6), lane = tid & 63, wr = wid >> 2, wc = wid & 3, fr = lane & 15, fq = lane >> 4;
    const int nt = K / BK;
    unsigned voffB[2], ocA[2][2], onA[2][2]; int gR[2], gC2[2];
#pragma unroll
    for (int i = 0; i < 2; ++i) { int R, C; stage_rc(tid * 16 + i * 8192, R, C); const int Rb = Epi::PERM ? ((R & ~31) + perm32(R & 31)) : R;
        voffB[i] = (unsigned)(Rb * ldb + C) * 2u; gR[i] = R; gC2[i] = C * 2;
        ocA[0][i] = (unsigned)(R * lda + C) * 2u; ocA[1][i] = (unsigned)((R + HALF) * lda + C) * 2u; onA[0][i] = ocA[0][i]; onA[1][i] = ocA[1][i]; }
    const size_t kstep = (size_t)(BK * 2);
    const size_t hstepB = (size_t)HALF * ldb * 2;
    const unsigned ldsw = (unsigned)wid * 1024u;
    const int aoff = lds_byte(wr * 64 + fr, fq * 8), boff = lds_byte(wc * 32 + fr, fq * 8);
#define PG8_SA(b, h) (((b) * 2 + (h)) * HTB)
#define PG8_SB(b, h) ((4 + (b) * 2 + (h)) * HTB)
#define PG8_STAGE(bufoff, gbase, voff) do { _Pragma("unroll") for (int _i = 0; _i < 2; ++_i) \
        __builtin_amdgcn_global_load_lds((const unsigned*)((const char*)(gbase) + (voff)[_i]), (PG8_LAS unsigned*)(lds + (bufoff) + ldsw + _i * 8192), 16, 0, 0); } while (0)
#define PG8_LDA(dst, b, h) do { _Pragma("unroll") for (int m = 0; m < 4; ++m) _Pragma("unroll") for (int k = 0; k < 2; ++k) dst[m][k] = *(const PG8_LAS bf16x8*)(lds + PG8_SA(b, h) + aoff + m * 2048 + k * 1024); } while (0)
#define PG8_LDB(dst, b, h) do { _Pragma("unroll") for (int n = 0; n < 2; ++n) _Pragma("unroll") for (int k = 0; k < 2; ++k) dst[n][k] = *(const PG8_LAS bf16x8*)(lds + PG8_SB(b, h) + boff + n * 2048 + k * 1024); } while (0)
#define PG8_MMA(ai, bj, At, Bt) do { __builtin_amdgcn_s_setprio(1); _Pragma("unroll") for (int m = 0; m < 4; ++m) _Pragma("unroll") for (int n = 0; n < 2; ++n) _Pragma("unroll") for (int k = 0; k < 2; ++k) \
        acc[ai][bj][m][n] = __builtin_amdgcn_mfma_f32_16x16x32_bf16(Bt[n][k], At[m][k], acc[ai][bj][m][n], 0, 0, 0); __builtin_amdgcn_s_setprio(0); } while (0)
#define PG8_WAIT_V(n) asm volatile("s_waitcnt vmcnt(" #n ")" ::: "memory")
#define PG8_WAIT_L(n) asm volatile("s_waitcnt lgkmcnt(" #n ")" ::: "memory")
#define PG8_BAR __builtin_amdgcn_s_barrier()
#define PG8_SCHED __builtin_amdgcn_sched_barrier(0)
#define PG8_GOFFS(u, o) do { _Pragma("unroll") for (int _h = 0; _h < 2; ++_h) _Pragma("unroll") for (int _i = 0; _i < 2; ++_i) { int _r = _h * HALF + gR[_i]; _r = _r < (u).nvalid ? _r : (u).nvalid - 1; \
        const int _tok = (u).lst[_r]; (o)[_h][_i] = (unsigned)_tok * (unsigned)(lda * 2) + (unsigned)gC2[_i]; } } while (0)
    Unit cur, nxt; int ui = 0;
    if (!S.next(0, cur)) return;
    f32x4 acc[2][2][4][2];
#pragma unroll
    for (int a = 0; a < 2; ++a)
#pragma unroll
        for (int b = 0; b < 2; ++b)
#pragma unroll
            for (int m = 0; m < 4; ++m)
#pragma unroll
                for (int n = 0; n < 2; ++n) acc[a][b][m][n] = (f32x4){0.f, 0.f, 0.f, 0.f};
    bf16x8 At[4][2], B0[2][2], B1[2][2];
    const char* cA = cur.A; const char* cB = cur.B;
    if constexpr (GATHER) { PG8_GOFFS(cur, ocA); }
    PG8_STAGE(PG8_SB(0, 0), cB, voffB); PG8_STAGE(PG8_SB(0, 1), cB + hstepB, voffB); PG8_STAGE(PG8_SA(0, 0), cA, ocA[0]); PG8_STAGE(PG8_SA(0, 1), cA, ocA[1]);
    if (wr == 1) PG8_BAR;
    PG8_WAIT_V(2); PG8_BAR;
    PG8_STAGE(PG8_SB(1, 0), cB + kstep, voffB); PG8_STAGE(PG8_SA(1, 0), cA + kstep, ocA[0]); PG8_STAGE(PG8_SB(1, 1), cB + hstepB + kstep, voffB);
    PG8_WAIT_V(6); PG8_BAR;
    for (;;) {
        const bool has_next = S.next(ui + 1, nxt);
        const char* nA = has_next ? nxt.A : cA; const char* nB = has_next ? nxt.B : cB;
        if constexpr (GATHER) {
            if (has_next) { PG8_GOFFS(nxt, onA); }
            else {
#pragma unroll
                for (int h = 0; h < 2; ++h)
#pragma unroll
                    for (int i = 0; i < 2; ++i) onA[h][i] = ocA[h][i]; }
        }
#pragma unroll 1
        for (int t = 0; t < nt; t += 2) {
            const bool last = (t == nt - 2);
            const char* a1 = cA + (size_t)(t + 1) * kstep;
            const char* a2 = last ? nA : cA + (size_t)(t + 2) * kstep; const char* b2 = last ? nB : cB + (size_t)(t + 2) * kstep;
            const char* a3 = a2 + kstep; const char* b3 = b2 + kstep;
            unsigned o2[2][2];
#pragma unroll
            for (int h = 0; h < 2; ++h)
#pragma unroll
                for (int i = 0; i < 2; ++i) o2[h][i] = (GATHER && last) ? onA[h][i] : ocA[h][i];
            PG8_LDB(B0, 0, 0); PG8_LDB(B1, 0, 1); PG8_SCHED; PG8_LDA(At, 0, 0); PG8_STAGE(PG8_SA(1, 1), a1, ocA[1]);
            PG8_WAIT_V(8); PG8_WAIT_L(0); PG8_BAR; PG8_MMA(0, 0, At, B0); PG8_MMA(0, 1, At, B1); PG8_BAR; PG8_SCHED;
            PG8_LDA(At, 0, 1); PG8_STAGE(PG8_SB(0, 0), b2, voffB); PG8_STAGE(PG8_SB(0, 1), b2 + hstepB, voffB); PG8_STAGE(PG8_SA(0, 0), a2, o2[0]);
            PG8_WAIT_V(8); PG8_WAIT_L(0); PG8_BAR; PG8_MMA(1, 0, At, B0); PG8_MMA(1, 1, At, B1); PG8_BAR; PG8_SCHED;
            PG8_LDB(B0, 1, 0); PG8_LDB(B1, 1, 1); PG8_SCHED; PG8_LDA(At, 1, 0); PG8_STAGE(PG8_SA(0, 1), a2, o2[1]);
            PG8_WAIT_V(8); PG8_WAIT_L(0); PG8_BAR; PG8_MMA(0, 0, At, B0); PG8_MMA(0, 1, At, B1); PG8_BAR; PG8_SCHED;
            PG8_LDA(At, 1, 1); PG8_STAGE(PG8_SB(1, 0), b3, voffB); PG8_STAGE(PG8_SB(1, 1), b3 + hstepB, voffB); PG8_STAGE(PG8_SA(1, 0), a3, o2[0]);
            PG8_WAIT_V(8); PG8_WAIT_L(0); PG8_BAR; PG8_MMA(1, 0, At, B0); PG8_MMA(1, 1, At, B1); PG8_BAR; PG8_SCHED;
        }
        if (wr == 0) PG8_BAR;
        E(acc, cur, wr, wc, fr, fq);
        if (!has_next) break;
#pragma unroll
        for (int a = 0; a < 2; ++a)
#pragma unroll
            for (int b = 0; b < 2; ++b)
#pragma unroll
                for (int m = 0; m < 4; ++m)
#pragma unroll
                    for (int n = 0; n < 2; ++n) acc[a][b][m][n] = (f32x4){0.f, 0.f, 0.f, 0.f};
        cur = nxt; cA = nA; cB = nB; ++ui;
        if constexpr (GATHER) {
#pragma unroll
            for (int h = 0; h < 2; ++h)
#pragma unroll
                for (int i = 0; i < 2; ++i) ocA[h][i] = onA[h][i]; }
        if (wr == 1) PG8_BAR;
    }
    PG8_WAIT_V(0);
    PG8_BAR;
#undef PG8_SA
#undef PG8_SB
#undef PG8_STAGE
#undef PG8_LDA
#undef PG8_LDB
#undef PG8_MMA
#undef PG8_WAIT_V
#undef PG8_WAIT_L
#undef PG8_BAR
#undef PG8_SCHED
#undef PG8_GOFFS
}

constexpr int NXCD = 8, WGM = 8;
struct DenseSched {
    const char* A; const char* B; int lda, ldb; int nM, nN, nwg, G, c; int apn_shift, akbytes, bpm_shift; size_t bbatch;
    __device__ __forceinline__ void init(const void* A_, const void* B_, int lda_, int ldb_, int M, int N, int G_, int c_) {
        A = (const char*)A_; B = (const char*)B_; lda = lda_; ldb = ldb_; nM = M / BM; nN = N / BM; nwg = nM * nN; G = G_; c = c_; apn_shift = -1; akbytes = 0; bpm_shift = -1; bbatch = 0; }
    __device__ __forceinline__ bool next(int i, Unit& u) const {
        const long L = (long)i * G + c; if (L >= nwg) return false;
        int wgid = (int)L; { const int q = nwg / NXCD, r = nwg % NXCD, xcd = wgid % NXCD, off = wgid / NXCD; wgid = (xcd < r ? xcd * (q + 1) : r * (q + 1) + (xcd - r) * q) + off; }
        const int nig = WGM * nN, gid = wgid / nig, fm = gid * WGM, gsz = (nM - fm) < WGM ? (nM - fm) : WGM;
        const int pm = fm + ((wgid % nig) % gsz), pn = (wgid % nig) / gsz;
        u.pm = pm; u.pn = pn; u.aux = 0; u.lst = nullptr; u.nvalid = 256;
        u.A = A + (size_t)pm * 256 * lda * 2 + (apn_shift >= 0 ? (size_t)(pn >> apn_shift) * akbytes : (size_t)0);
        u.B = B + (size_t)pn * 256 * ldb * 2 + (bpm_shift >= 0 ? (size_t)(pm >> bpm_shift) * bbatch : (size_t)0);
        return true;
    }
};
struct MoeSched {
    const char* A; const char* B; size_t bexp; int lda, ldb, nN; const int* lists; volatile LAS const int* tab; int G, c; bool gather;
    __device__ __forceinline__ bool next(int i, Unit& u) const {
        const int total = tab[32] * nN; const long L = (long)i * G + c; if (L >= total) return false;
        const int pn = (int)(L % nN), mg = (int)(L / nN);
        int e = 0;
#pragma unroll 1
        for (int j = 1; j < 32; ++j) e += (tab[j] <= mg) ? 1 : 0;
        const int mt = mg - tab[e];
        u.pm = mg; u.pn = pn; u.aux = e;
        if (gather) { u.A = A; u.lst = lists + (size_t)e * T + mt * 256; const int rem = tab[48 + e] - mt * 256; u.nvalid = rem < 256 ? rem : 256; }
        else { u.A = A + (size_t)mg * 256 * lda * 2; u.lst = nullptr; u.nvalid = 256; }
        u.B = B + (size_t)e * bexp + (size_t)pn * 256 * ldb * 2;
        return true;
    }
};

#define EPI_ROW(u, ai, m) ((u).pm * 256 + (ai) * 128 + wr * 64 + (m) * 16 + fr)
struct EpiLat {
    static constexpr bool PERM = true;
    bf16_t* LAT; float* SSQ; bf16_t* KR; const float* CS; const float* SN;
    __device__ __forceinline__ void operator()(const f32x4 (&acc)[2][2][4][2], const Unit& u, int wr, int wc, int fr, int fq) const {
        if (u.pn < 4) {
#pragma unroll
            for (int ai = 0; ai < 2; ++ai)
#pragma unroll
                for (int m = 0; m < 4; ++m) { const int row = EPI_ROW(u, ai, m); float ss = 0.f;
#pragma unroll
                    for (int bj = 0; bj < 2; ++bj) { const f32x4 v0 = acc[ai][bj][m][0], v1 = acc[ai][bj][m][1];
                        ss += (v0[0] * v0[0] + v0[1] * v0[1]) + (v0[2] * v0[2] + v0[3] * v0[3]) + (v1[0] * v1[0] + v1[1] * v1[1]) + (v1[2] * v1[2] + v1[3] * v1[3]);
                        *(u32x4*)(LAT + (size_t)row * 1024 + u.pn * 256 + bj * 128 + wc * 32 + 8 * fq) = pack8(v0, v1); }
                    ss += __shfl_xor(ss, 16); ss += __shfl_xor(ss, 32);
                    if (fq == 0) SSQ[(size_t)row * 16 + u.pn * 4 + wc] = ss; }
        } else if (wc == 0) {
#pragma unroll
            for (int ai = 0; ai < 2; ++ai)
#pragma unroll
                for (int m = 0; m < 4; ++m) { const int row = EPI_ROW(u, ai, m);
                    const f32x4 c0 = *(const f32x4*)(CS + (size_t)row * 32 + 8 * fq), c1 = *(const f32x4*)(CS + (size_t)row * 32 + 8 * fq + 4);
                    const f32x4 s0 = *(const f32x4*)(SN + (size_t)row * 32 + 8 * fq), s1 = *(const f32x4*)(SN + (size_t)row * 32 + 8 * fq + 4);
                    const f32x4 a0 = acc[ai][0][m][0], a1 = acc[ai][0][m][1], b0 = acc[ai][1][m][0], b1 = acc[ai][1][m][1];
                    *(u32x4*)(KR + (size_t)row * 64 + 8 * fq) = pack8(a0 * c0 - b0 * s0, a1 * c1 - b1 * s1);
                    *(u32x4*)(KR + (size_t)row * 64 + 32 + 8 * fq) = pack8(b0 * c0 + a0 * s0, b1 * c1 + a1 * s1); }
        }
    }
};
struct EpiQ {
    static constexpr bool PERM = true;
    bf16_t* Q; const float* SSQ; const float* CS; const float* SN;
    __device__ __forceinline__ void operator()(const f32x4 (&acc)[2][2][4][2], const Unit& u, int wr, int wc, int fr, int fq) const {
#pragma unroll
        for (int ai = 0; ai < 2; ++ai)
#pragma unroll
            for (int m = 0; m < 4; ++m) { const int row = EPI_ROW(u, ai, m);
                const f32x4 q0 = *(const f32x4*)(SSQ + (size_t)row * 16), q1 = *(const f32x4*)(SSQ + (size_t)row * 16 + 4), q2 = *(const f32x4*)(SSQ + (size_t)row * 16 + 8);
                const float ss = ((q0[0] + q0[1]) + (q0[2] + q0[3])) + ((q1[0] + q1[1]) + (q1[2] + q1[3])) + ((q2[0] + q2[1]) + (q2[2] + q2[3]));
                const float r = QSCALE / sqrtf(ss * (1.0f / QL) + RMS_EPS);
                if (u.pn < 4) {
#pragma unroll
                    for (int bj = 0; bj < 2; ++bj)
                        *(u32x4*)(Q + (size_t)row * 1536 + (2 * u.pn + bj) * 192 + wc * 32 + 8 * fq) = pack8(acc[ai][bj][m][0] * r, acc[ai][bj][m][1] * r);
                } else {
                    const int head = 4 * (u.pn - 4) + wc;
                    const f32x4 c0 = *(const f32x4*)(CS + (size_t)row * 32 + 8 * fq), c1 = *(const f32x4*)(CS + (size_t)row * 32 + 8 * fq + 4);
                    const f32x4 s0 = *(const f32x4*)(SN + (size_t)row * 32 + 8 * fq), s1 = *(const f32x4*)(SN + (size_t)row * 32 + 8 * fq + 4);
                    const f32x4 a0 = acc[ai][0][m][0] * r, a1 = acc[ai][0][m][1] * r, b0 = acc[ai][1][m][0] * r, b1 = acc[ai][1][m][1] * r;
                    *(u32x4*)(Q + (size_t)row * 1536 + head * 192 + 128 + 8 * fq) = pack8(a0 * c0 - b0 * s0, a1 * c1 - b1 * s1);
                    *(u32x4*)(Q + (size_t)row * 1536 + head * 192 + 160 + 8 * fq) = pack8(b0 * c0 + a0 * s0, b1 * c1 + a1 * s1);
                }
                asm volatile("" ::: "memory"); }
    }
};
struct EpiKV {
    static constexpr bool PERM = true;
    bf16_t* KN; bf16_t* V; const float* SSQ;
    __device__ __forceinline__ void operator()(const f32x4 (&acc)[2][2][4][2], const Unit& u, int wr, int wc, int fr, int fq) const {
#pragma unroll
        for (int ai = 0; ai < 2; ++ai)
#pragma unroll
            for (int m = 0; m < 4; ++m) { const int row = EPI_ROW(u, ai, m);
                const f32x4 q3 = *(const f32x4*)(SSQ + (size_t)row * 16 + 12);
                const float r = 1.0f / sqrtf(((q3[0] + q3[1]) + (q3[2] + q3[3])) * (1.0f / KVL) + RMS_EPS);
                *(u32x4*)(KN + (size_t)row * 1024 + u.pn * 128 + wc * 32 + 8 * fq) = pack8(acc[ai][0][m][0] * r, acc[ai][0][m][1] * r);
                *(u32x4*)(V + (size_t)row * 1024 + u.pn * 128 + wc * 32 + 8 * fq) = pack8(acc[ai][1][m][0] * r, acc[ai][1][m][1] * r); }
    }
};
__device__ __forceinline__ f32x4 bf4_lo(const u32x4 w) { return (f32x4){bf_lo(w.x), bf_hi(w.x), bf_lo(w.y), bf_hi(w.y)}; }
__device__ __forceinline__ f32x4 bf4_hi(const u32x4 w) { return (f32x4){bf_lo(w.z), bf_hi(w.z), bf_lo(w.w), bf_hi(w.w)}; }
struct EpiRes {
    static constexpr bool PERM = true;
    const bf16_t* X; bf16_t* Y;
    __device__ __forceinline__ void operator()(const f32x4 (&acc)[2][2][4][2], const Unit& u, int wr, int wc, int fr, int fq) const {
#pragma unroll
        for (int ai = 0; ai < 2; ++ai)
#pragma unroll
            for (int m = 0; m < 4; ++m) { const size_t off = (size_t)EPI_ROW(u, ai, m) * 1024 + u.pn * 256 + wc * 32 + 8 * fq;
#pragma unroll
                for (int bj = 0; bj < 2; ++bj) { const u32x4 xw = *(const u32x4*)(X + off + bj * 128);
                    *(u32x4*)(Y + off + bj * 128) = pack8(bf4_lo(xw) * ALPHA + acc[ai][bj][m][0], bf4_hi(xw) * ALPHA + acc[ai][bj][m][1]); }
                if (m & 1) asm volatile("" ::: "memory"); }
    }
};
struct EpiGU {
    static constexpr bool PERM = true;
    bf16_t* GG; bf16_t* U;
    __device__ __forceinline__ void operator()(const f32x4 (&acc)[2][2][4][2], const Unit& u, int wr, int wc, int fr, int fq) const {
#pragma unroll
        for (int ai = 0; ai < 2; ++ai)
#pragma unroll
            for (int m = 0; m < 4; ++m) { const int row = EPI_ROW(u, ai, m);
#pragma unroll
                for (int bj = 0; bj < 2; ++bj) { f32x4 v0 = acc[ai][bj][m][0], v1 = acc[ai][bj][m][1];
                    if (u.pn < 4) {
#pragma unroll
                        for (int e = 0; e < 4; ++e) { v0[e] = gelu_tanh(v0[e]); v1[e] = gelu_tanh(v1[e]); }
                        *(u32x4*)(GG + (size_t)row * 1024 + u.pn * 256 + bj * 128 + wc * 32 + 8 * fq) = pack8(v0, v1);
                    } else *(u32x4*)(U + (size_t)row * 1024 + (u.pn - 4) * 256 + bj * 128 + wc * 32 + 8 * fq) = pack8(v0, v1); } }
    }
};
struct EpiAB {
    static constexpr bool PERM = false;
    float* AA; float* BB; const bf16_t* UC; const float* BA; const float* BX; const float* SPL;
    __device__ __forceinline__ void operator()(const f32x4 (&acc)[2][2][4][2], const Unit& u, int wr, int wc, int fr, int fq) const {
        const int ch0 = (u.pn >> 1) * 256 + (u.pn & 1) * 128 + wc * 32 + 4 * fq;
#pragma unroll
        for (int n = 0; n < 2; ++n) { const int ch = ch0 + 16 * n;
            const f32x4 ba = *(const f32x4*)(BA + ch), bx = *(const f32x4*)(BX + ch), sp = *(const f32x4*)(SPL + ch);
#pragma unroll
            for (int ai = 0; ai < 2; ++ai)
#pragma unroll
                for (int m = 0; m < 4; ++m) { const size_t off = (size_t)EPI_ROW(u, ai, m) * 1024 + ch;
                    const u32x2 uw = *(const u32x2*)(UC + off); const float uv[4] = {bf_lo(uw.x), bf_hi(uw.x), bf_lo(uw.y), bf_hi(uw.y)};
                    f32x4 av, bv;
#pragma unroll
                    for (int e = 0; e < 4; ++e) { const float r = sigmoidf_(acc[ai][0][m][n][e] + ba[e]), ig = sigmoidf_(acc[ai][1][m][n][e] + bx[e]);
                        const float la = sp[e] * r, x2 = 2.0f * la; av[e] = __expf(la);
                        const float om = x2 > -0.25f ? -x2 * (1.0f + x2 * (0.5f + x2 * (0.16666667f + x2 * (0.041666668f + x2 * 0.0083333338f)))) : 1.0f - __expf(x2);
                        bv[e] = sqrtf(om) * ig * uv[e]; }
                    *(f32x4*)(AA + off) = av; *(f32x4*)(BB + off) = bv; asm volatile("" ::: "memory"); } }
    }
};
struct EpiUp {
    static constexpr bool PERM = true;
    bf16_t* H; const float* BU;
    __device__ __forceinline__ void operator()(const f32x4 (&acc)[2][2][4][2], const Unit& u, int wr, int wc, int fr, int fq) const {
        const int gc = u.pn * 128 + wc * 32 + 8 * fq; const float* bu = BU + (size_t)u.aux * 2048;
        const f32x4 bg0 = *(const f32x4*)(bu + gc), bg1 = *(const f32x4*)(bu + gc + 4), bp0 = *(const f32x4*)(bu + 1024 + gc), bp1 = *(const f32x4*)(bu + 1024 + gc + 4);
#pragma unroll
        for (int ai = 0; ai < 2; ++ai)
#pragma unroll
            for (int m = 0; m < 4; ++m) { const int row = EPI_ROW(u, ai, m);
                f32x4 y0, y1;
#pragma unroll
                for (int e = 0; e < 4; ++e) {
                    float g = fminf(acc[ai][0][m][0][e] + bg0[e], 7.0f), up = fminf(fmaxf(acc[ai][1][m][0][e] + bp0[e], -7.0f), 7.0f); y0[e] = (up + 1.0f) * (g * sigmoidf_(1.702f * g));
                    g = fminf(acc[ai][0][m][1][e] + bg1[e], 7.0f); up = fminf(fmaxf(acc[ai][1][m][1][e] + bp1[e], -7.0f), 7.0f); y1[e] = (up + 1.0f) * (g * sigmoidf_(1.702f * g)); }
                *(u32x4*)(H + (size_t)row * 1024 + gc) = pack8(y0, y1); }
    }
};
struct EpiDown {
    static constexpr bool PERM = true;
    bf16_t* YS; const float* BD;
    __device__ __forceinline__ void operator()(const f32x4 (&acc)[2][2][4][2], const Unit& u, int wr, int wc, int fr, int fq) const {
        const float* bd = BD + (size_t)u.aux * 1024;
#pragma unroll
        for (int bj = 0; bj < 2; ++bj) { const int col = u.pn * 256 + bj * 128 + wc * 32 + 8 * fq; const f32x4 b0 = *(const f32x4*)(bd + col), b1 = *(const f32x4*)(bd + col + 4);
#pragma unroll
            for (int ai = 0; ai < 2; ++ai)
#pragma unroll
                for (int m = 0; m < 4; ++m) *(u32x4*)(YS + (size_t)EPI_ROW(u, ai, m) * 1024 + col) = pack8(acc[ai][bj][m][0] + b0, acc[ai][bj][m][1] + b1); }
    }
};
struct EpiPle {
    static constexpr bool PERM = true;
    const bf16_t* X2; const bf16_t* PP; float* OUT; bf16_t* XB;
    __device__ __forceinline__ void operator()(const f32x4 (&acc)[2][2][4][2], const Unit& u, int wr, int wc, int fr, int fq) const {
#pragma unroll
        for (int ai = 0; ai < 2; ++ai)
#pragma unroll
            for (int m = 0; m < 4; ++m) { const size_t off = (size_t)EPI_ROW(u, ai, m) * 1024 + u.pn * 256 + wc * 32 + 8 * fq;
#pragma unroll
                for (int bj = 0; bj < 2; ++bj) { const size_t o = off + bj * 128; const u32x4 xw = *(const u32x4*)(X2 + o), pw = *(const u32x4*)(PP + o);
                    const f32x4 a0 = acc[ai][bj][m][0], a1 = acc[ai][bj][m][1], x0 = bf4_lo(xw), x1 = bf4_hi(xw), p0 = bf4_lo(pw), p1 = bf4_hi(pw); f32x4 r0, r1;
#pragma unroll
                    for (int e = 0; e < 4; ++e) { r0[e] = x0[e] + sigmoidf_(a0[e]) * p0[e]; r1[e] = x1[e] + sigmoidf_(a1[e]) * p1[e]; }
                    *(u32x4*)(XB + o) = pack8(r0, r1);
                    if (OUT) { *(f32x4*)(OUT + o) = r0; *(f32x4*)(OUT + o + 4) = r1; } }
                if (m & 1) asm volatile("" ::: "memory"); }
    }
};
struct EpiPP {
    static constexpr bool PERM = true;
    bf16_t* PP;
    __device__ __forceinline__ void operator()(const f32x4 (&acc)[2][2][4][2], const Unit& u, int wr, int wc, int fr, int fq) const {
#pragma unroll
        for (int ai = 0; ai < 2; ++ai)
#pragma unroll
            for (int m = 0; m < 4; ++m)
#pragma unroll
                for (int bj = 0; bj < 2; ++bj) *(u32x4*)(PP + (size_t)EPI_ROW(u, ai, m) * 1024 + u.pn * 256 + bj * 128 + wc * 32 + 8 * fq) = pack8(acc[ai][bj][m][0], acc[ai][bj][m][1]);
    }
};
}

namespace att {
constexpr int NW = 8, QBLK = 32, KVBLK = 64, QB = 256, KPITCH = 384;
constexpr int SHM_V = KVBLK * DV * 2, SHM_K = KVBLK * KPITCH;
constexpr int OFF_V = 0, OFF_K = 2 * SHM_V, OFF_WS = OFF_K + 2 * SHM_K, LDS_BYTES = OFF_WS + NW * 64 * 4;
#define SBAR() __builtin_amdgcn_sched_barrier(0)
__device__ __forceinline__ int k_addr(int row, int chunk) { return row * KPITCH + ((chunk ^ ((row >> 1) & 7)) << 4); }
__device__ __forceinline__ int v_st(int k, int c) { const int kk = (k & ~0xC) | ((k & 4) << 1) | ((k & 8) >> 1); return ((kk >> 3) * 4 + (c >> 5)) * 512 + ((kk & 7) * 32 + (c & 31)) * 2; }
__device__ __forceinline__ int v_rd_base(int lane) { return ((lane & 3) << 3) | (((lane >> 2) & 3) << 6) | (((lane >> 4) & 1) << 5) | (((lane >> 5) & 1) << 8); }
constexpr int v_rd_off(int d0, int ks, int half) { return d0 * 512 + ks * 4096 + half * 2048; }
__device__ __forceinline__ int crow(int r, int hi) { return (r & 3) + 8 * (r >> 2) + 4 * hi; }

template <int KB>
__device__ __forceinline__ void qkt(f32x16& p0, f32x16& p1, const LAS char* K_lds, int r32, int hi, const bf16x8* qr) {
    p0 = f32x16{}; p1 = f32x16{};
    const LAS char* kb[4];
#pragma unroll
    for (int dd = 0; dd < 4; ++dd) kb[dd] = K_lds + KB * SHM_K + r32 * KPITCH + (((2 * dd + hi) ^ ((r32 >> 1) & 7)) << 4);
#pragma unroll
    for (int dg = 0; dg < 3; ++dg) {
#pragma unroll
        for (int dd = 0; dd < 4; ++dd) { const int d0 = dg * 4 + dd; const LAS char* a = kb[dd] + dg * 128;
            const bf16x8 b0 = *(const LAS bf16x8*)a;
            const bf16x8 b1 = *(const LAS bf16x8*)(a + 32 * KPITCH);
            p0 = __builtin_amdgcn_mfma_f32_32x32x16_bf16(b0, qr[d0], p0, 0, 0, 0);
            p1 = __builtin_amdgcn_mfma_f32_32x32x16_bf16(b1, qr[d0], p1, 0, 0, 0); }
        SBAR(); }
}
template <int VB>
__device__ __forceinline__ void pv_tile(f32x16* o, int vb0, bf16x8 pa0, bf16x8 pa1, bf16x8 pa2, bf16x8 pa3) {
#define TRRD(dst, off) asm volatile("ds_read_b64_tr_b16 %0, %1 offset:%2" : "=&v"(dst) : "v"(vb0), "i"(off) : "memory")
#define PV_D0(d0) do { s16x4 l0, l1, l2, l3, h0, h1, h2, h3; constexpr int b_ = OFF_V + VB * SHM_V + v_rd_off(d0, 0, 0); \
        TRRD(l0, b_); TRRD(h0, b_ + 2048); TRRD(l1, b_ + 4096); TRRD(h1, b_ + 6144); TRRD(l2, b_ + 8192); TRRD(h2, b_ + 10240); TRRD(l3, b_ + 12288); TRRD(h3, b_ + 14336); \
        asm volatile("s_waitcnt lgkmcnt(0)" ::: "memory"); SBAR(); \
        o[d0] = __builtin_amdgcn_mfma_f32_32x32x16_bf16(pa0, (bf16x8){l0[0], l0[1], l0[2], l0[3], h0[0], h0[1], h0[2], h0[3]}, o[d0], 0, 0, 0); \
        o[d0] = __builtin_amdgcn_mfma_f32_32x32x16_bf16(pa1, (bf16x8){l1[0], l1[1], l1[2], l1[3], h1[0], h1[1], h1[2], h1[3]}, o[d0], 0, 0, 0); \
        o[d0] = __builtin_amdgcn_mfma_f32_32x32x16_bf16(pa2, (bf16x8){l2[0], l2[1], l2[2], l2[3], h2[0], h2[1], h2[2], h2[3]}, o[d0], 0, 0, 0); \
        o[d0] = __builtin_amdgcn_mfma_f32_32x32x16_bf16(pa3, (bf16x8){l3[0], l3[1], l3[2], l3[3], h3[0], h3[1], h3[2], h3[3]}, o[d0], 0, 0, 0); } while (0)
    PV_D0(0); PV_D0(1); PV_D0(2); PV_D0(3);
#undef PV_D0
#undef TRRD
}
__device__ __forceinline__ void mask_tile(f32x16& p0, f32x16& p1, int dq  ) {
    const float NEG = -__builtin_inff();
#pragma unroll
    for (int r = 0; r < 16; ++r) { const int c = (r & 3) + 8 * (r >> 2);
        if (c > dq) p0[r] = NEG;
        if (c + 32 > dq) p1[r] = NEG; }
}
__device__ __forceinline__ void softmax_tile(f32x16& p0, f32x16& p1, float& m_reg, float& l_reg, float& alpha, bf16x8& pa0, bf16x8& pa1, bf16x8& pa2, bf16x8& pa3) {
    float pmax = p0[0];
#pragma unroll
    for (int r = 1; r < 16; ++r) pmax = fmaxf(pmax, p0[r]);
#pragma unroll
    for (int r = 0; r < 16; ++r) pmax = fmaxf(pmax, p1[r]);
    { auto rr = __builtin_amdgcn_permlane32_swap(__float_as_uint(pmax), __float_as_uint(pmax), false, false); pmax = fmaxf(__uint_as_float(rr[0]), __uint_as_float(rr[1])); }
    const float mn = fmaxf(m_reg, pmax); alpha = __builtin_amdgcn_exp2f(m_reg - mn); m_reg = mn;
    float ps = 0.f;
#pragma unroll
    for (int r = 0; r < 16; ++r) { p0[r] = __builtin_amdgcn_exp2f(p0[r] - mn); ps += p0[r]; }
#pragma unroll
    for (int r = 0; r < 16; ++r) { p1[r] = __builtin_amdgcn_exp2f(p1[r] - mn); ps += p1[r]; }
    { auto rr = __builtin_amdgcn_permlane32_swap(__float_as_uint(ps), __float_as_uint(ps), false, false); ps = __uint_as_float(rr[0]) + __uint_as_float(rr[1]); }
    l_reg = l_reg * alpha + ps;
#define PK4(P, B_, OUT) do { unsigned a0 = cvt_pk_bf16(P[B_+0], P[B_+1]), a1 = cvt_pk_bf16(P[B_+2], P[B_+3]); \
        unsigned b0 = cvt_pk_bf16(P[B_+4], P[B_+5]), b1 = cvt_pk_bf16(P[B_+6], P[B_+7]); \
        auto r0 = __builtin_amdgcn_permlane32_swap(a0, b0, false, false); auto r1 = __builtin_amdgcn_permlane32_swap(a1, b1, false, false); \
        u32x4 w = {r0[0], r1[0], r0[1], r1[1]}; OUT = __builtin_bit_cast(bf16x8, w); } while (0)
    PK4(p0, 0, pa0); PK4(p0, 8, pa1); PK4(p1, 0, pa2); PK4(p1, 8, pa3);
#undef PK4
}

__device__ __forceinline__ void attn_block(int b, int h, int qb, const bf16_t* Q, const bf16_t* KN, const bf16_t* KR, const bf16_t* V, bf16_t* O, LAS char* lds) {
    const int tid = opaque_tid(), wid = __builtin_amdgcn_readfirstlane(tid >> 6), lane = tid & 63, r32 = lane & 31, hi = lane >> 5;
    const size_t row0 = (size_t)b * SEQ;
    const int q0 = qb * QB + wid * QBLK;
    const int NT = (qb + 1) * (QB / KVBLK);
    LAS char* V_lds = lds + OFF_V; LAS char* K_lds = lds + OFF_K;
    LAS float* ws = (LAS float*)(lds + OFF_WS) + wid * 64; LAS float* li_l = ws; LAS float* al_l = ws + 32;
    const int sr = tid >> 4, sc = (tid & 15) * 8, kr_row = tid >> 3, kr_c = tid & 7;
    const int vst0 = v_st(sr, sc), vst1 = v_st(32 + sr, sc), kws = k_addr(sr, tid & 15), kwr = k_addr(kr_row, 16 + kr_c);
    const int vb0 = (int)(uintptr_t)lds + v_rd_base(lane);
    const bf16_t* KNh = KN + row0 * 1024 + h * 128 + sc; const bf16_t* Vh = V + row0 * 1024 + h * 128 + sc; const bf16_t* KRb = KR + row0 * 64 + kr_c * 8;
    bf16x8 st_k0, st_k1, st_kr, st_v0, st_v1;
#define SLOAD(t) do { const size_t k0_ = (size_t)(t) * KVBLK; \
        st_k0 = *(const bf16x8*)(KNh + (k0_ + sr) * 1024); st_k1 = *(const bf16x8*)(KNh + (k0_ + 32 + sr) * 1024); st_kr = *(const bf16x8*)(KRb + (k0_ + kr_row) * 64); \
        st_v0 = *(const bf16x8*)(Vh + (k0_ + sr) * 1024); st_v1 = *(const bf16x8*)(Vh + (k0_ + 32 + sr) * 1024); } while (0)
#define SWRITE(bf) do { *(LAS bf16x8*)(K_lds + (bf) * SHM_K + kws) = st_k0; *(LAS bf16x8*)(K_lds + (bf) * SHM_K + kws + 32 * KPITCH) = st_k1; *(LAS bf16x8*)(K_lds + (bf) * SHM_K + kwr) = st_kr; \
        *(LAS bf16x8*)(V_lds + (bf) * SHM_V + vst0) = st_v0; *(LAS bf16x8*)(V_lds + (bf) * SHM_V + vst1) = st_v1; } while (0)
    SLOAD(0);
    bf16x8 qr[12];
    { const bf16_t* Qw = Q + (row0 + q0 + r32) * 1536 + h * 192 + hi * 8;
#pragma unroll
      for (int d0 = 0; d0 < 12; ++d0) qr[d0] = *(const bf16x8*)(Qw + d0 * 16); }
    float m_reg = -1e30f, l_reg = 0.f; f32x16 o[4] = {};
    f32x16 p0, p1; bf16x8 pa0, pa1, pa2, pa3; float alpha;
    asm volatile("s_waitcnt vmcnt(0)" ::: "memory");
    SWRITE(0);
    __syncthreads();
#define RESC(a) do { if (__any((a) < 1.f)) { if (hi == 0) al_l[r32] = (a); asm volatile("s_waitcnt lgkmcnt(0)" ::: "memory"); \
        _Pragma("unroll") for (int d_ = 0; d_ < 4; ++d_) _Pragma("unroll") for (int r = 0; r < 16; ++r) o[d_][r] *= al_l[crow(r, hi)]; } } while (0)
#define TILE(t, BF) do { const bool more_ = ((t) + 1 < NT); if (more_) SLOAD((t) + 1); SBAR(); \
        qkt<BF>(p0, p1, K_lds, r32, hi, qr); \
        { const int kb_ = (t) * KVBLK; if (kb_ + KVBLK - 1 > q0) mask_tile(p0, p1, q0 + r32 - kb_ - 4 * hi); } \
        softmax_tile(p0, p1, m_reg, l_reg, alpha, pa0, pa1, pa2, pa3); RESC(alpha); SBAR(); \
        pv_tile<BF>(o, vb0, pa0, pa1, pa2, pa3); \
        if (more_) { asm volatile("s_waitcnt vmcnt(0)" ::: "memory"); SWRITE((BF) ^ 1); } \
        __syncthreads(); } while (0)
#pragma unroll 1
    for (int t = 0; t < NT; t += 2) { TILE(t, 0); TILE(t + 1, 1); }
    if (hi == 0) li_l[r32] = l_reg; asm volatile("s_waitcnt lgkmcnt(0)" ::: "memory");
    bf16_t* Ow = O + (row0 + q0) * 1024 + h * 128;
#pragma unroll
    for (int r = 0; r < 16; ++r) { const int orow = crow(r, hi); const float rl = __builtin_amdgcn_rcpf(li_l[orow]);
#pragma unroll
        for (int d0 = 0; d0 < 4; ++d0) { const float v = o[d0][r] * rl; const float vn = __shfl_xor(v, 1);
            if ((r32 & 1) == 0) *(unsigned*)(Ow + (size_t)orow * 1024 + d0 * 32 + r32) = cvt_pk_bf16(v, vn); } }
    __syncthreads();
#undef SLOAD
#undef SWRITE
#undef RESC
#undef TILE
}
#undef SBAR
}

#define XB_TMO      128
#define XB_XCNT(j)  (256  + 64 * (j))
#define XB_XSUB(j)  (1280 + 64 * (j))
#define XB_XGEN(j)  (2304 + 64 * (j))
#define XB_TOP      3328
#define XB_TOPGEN   3392
#define XCD_BAR_WORDS 3456
#define XB_SPIN_CAP (1u << 22)
__device__ __forceinline__ unsigned xb_ld(unsigned* p)              { return __hip_atomic_load(p, __ATOMIC_RELAXED, __HIP_MEMORY_SCOPE_AGENT); }
__device__ __forceinline__ unsigned xb_add(unsigned* p, unsigned v) { return __hip_atomic_fetch_add(p, v, __ATOMIC_RELAXED, __HIP_MEMORY_SCOPE_AGENT); }
__device__ __forceinline__ unsigned xb_xcc_id() { return (unsigned)__builtin_amdgcn_s_getreg((3 << 11) | 20) & 0xFu; }
#define XB_SPIN(cond, bar) do { unsigned _sp = 0; while (cond) { __builtin_amdgcn_s_sleep(1); \
    if ((++_sp & 255u) == 0u) { if (xb_ld(&(bar)[XB_TMO])) break; if (_sp > XB_SPIN_CAP) { atomicAdd(&(bar)[XB_TMO], 1u); break; } } } } while (0)
struct XcdBarrier { unsigned* bar; unsigned x; volatile LAS unsigned* st; };
__device__ __forceinline__ XcdBarrier xcd_barrier_post(unsigned* bar, volatile LAS unsigned* st) {
    XcdBarrier b; b.bar = bar; b.x = xb_xcc_id(); b.st = st;
    if (threadIdx.x == 0) (void)xb_add(&bar[XB_XCNT(b.x)], 1u);
    return b;
}
__device__ __forceinline__ void xcd_barrier_complete(unsigned* bar, unsigned x, unsigned& nloc, unsigned& nx) {
    const unsigned G = gridDim.x * gridDim.y * gridDim.z;
    unsigned sum, cnt, mine, sp = 0u;
    for (;;) {
        sum = 0u; cnt = 0u; mine = 0u;
#pragma unroll
        for (unsigned j = 0; j < 16; ++j) { const unsigned c = xb_ld(&bar[XB_XCNT(j)]); sum += c; cnt += (c > 0u) ? 1u : 0u; mine = (j == x) ? c : mine; }
        if (sum == G) break;
        __builtin_amdgcn_s_sleep(1);
        if ((++sp & 255u) == 0u) { if (xb_ld(&bar[XB_TMO])) break; if (sp > XB_SPIN_CAP) { atomicAdd(&bar[XB_TMO], 1u); break; } }
    }
    nloc = mine > 0u ? mine : 1u; nx = cnt > 0u ? cnt : 1u;
}
__device__ __forceinline__ void xcd_barrier(const XcdBarrier& b) {
    asm volatile("s_waitcnt vmcnt(0)" ::: "memory");
    __syncthreads();
    if (threadIdx.x == 0) {
        unsigned* bar = b.bar;
        __builtin_amdgcn_s_waitcnt(0);
        unsigned nloc = b.st[0], nx = b.st[1];
        if (nloc == 0u) { xcd_barrier_complete(bar, b.x, nloc, nx); b.st[0] = nloc; b.st[1] = nx; }
        const unsigned old = xb_add(&bar[XB_XSUB(b.x)], 1u);
        const unsigned gen = old / nloc;
        if (old + 1u == (gen + 1u) * nloc) {
            __builtin_amdgcn_fence(__ATOMIC_RELEASE, "agent");
            asm volatile("s_waitcnt vmcnt(0)" ::: "memory");
            const unsigned og = xb_add(&bar[XB_TOP], 1u);
            const unsigned tg = og / nx;
            if (og + 1u == (tg + 1u) * nx) xb_add(&bar[XB_TOPGEN], 1u);
            else XB_SPIN(xb_ld(&bar[XB_TOPGEN]) == tg, bar);
            __builtin_amdgcn_fence(__ATOMIC_ACQUIRE, "agent");
            xb_add(&bar[XB_XGEN(b.x)], 1u);
            asm volatile("s_waitcnt vmcnt(0)" ::: "memory");
        } else {
            XB_SPIN(xb_ld(&bar[XB_XGEN(b.x)]) == gen, bar);
            __builtin_amdgcn_fence(__ATOMIC_ACQUIRE, "agent");
            asm volatile("s_waitcnt vmcnt(0)" ::: "memory");
        }
    }
    __syncthreads();
}

struct Args { const void* in[30]; float* out; unsigned char* ws; int ph_lo, ph_hi, li, pad; };
struct Ctx { int tid, lane, wave, vcu, G; LAS unsigned char* lds; volatile LAS int* misc; };
typedef const CAS Args* ArgsP;
__device__ __forceinline__ const CAS Args& fresh_args(ArgsP p) { asm volatile("" : "+s"(p)); return *p; }
enum { I_X = 0, I_P, I_POS, I_MLA_WIN, I_MLA_QN, I_MLA_KVN, I_MLA_WUQ, I_MLA_WUKV, I_MLA_WO, I_LRU_WIN, I_LRU_CW, I_LRU_CB, I_LRU_WA, I_LRU_BA, I_LRU_WX, I_LRU_BX, I_LRU_LAM, I_LRU_WOUT,
       I_LN1G, I_LN1B, I_LN2G, I_LN2B, I_MOE_WR, I_MOE_BR, I_MOE_WUP, I_MOE_BUP, I_MOE_WDN, I_MOE_BDN, I_PLE_WG, I_PLE_WP };
#define INF(i) ((const float*)args.in[i])
#define WSP(T_, off) ((T_*)(args.ws + (off)))

__device__ __forceinline__ void tr_item(const float* W, int ld, int k0, int sc0, int sc1, const float* ksc, bf16_t* dst  , int K, LAS float* scr, int lane) {
    const int half = (lane & 15) >> 3, scol = half ? sc1 : sc0, c4 = (lane & 7) * 4, rsub = lane >> 4;
    f32x4 v[16];
#pragma unroll
    for (int i = 0; i < 16; ++i) { const int kk = 4 * i + rsub;
        v[i] = (scol >= 0) ? *(const f32x4*)(W + (size_t)(k0 + kk) * ld + scol + c4) : (f32x4){0.f, 0.f, 0.f, 0.f}; }
    if (ksc) {
#pragma unroll
        for (int i = 0; i < 16; ++i) v[i] = v[i] * ksc[k0 + 4 * i + rsub]; }
#pragma unroll
    for (int i = 0; i < 16; ++i) { LAS float* s = scr + (4 * i + rsub) * 65 + (lane & 15) * 4; s[0] = v[i][0]; s[1] = v[i][1]; s[2] = v[i][2]; s[3] = v[i][3]; }
    asm volatile("s_waitcnt lgkmcnt(0)" ::: "memory");
    const int c = lane & 7;
#pragma unroll
    for (int j = 0; j < 8; ++j) { const int n = (lane >> 3) + 8 * j; const LAS float* s = scr + (8 * c) * 65 + n;
        u32x4 o; o.x = cvt_pk_bf16(s[0 * 65], s[1 * 65]); o.y = cvt_pk_bf16(s[2 * 65], s[3 * 65]); o.z = cvt_pk_bf16(s[4 * 65], s[5 * 65]); o.w = cvt_pk_bf16(s[6 * 65], s[7 * 65]);
        *(u32x4*)(dst + (size_t)n * K + 8 * c) = o; }
    asm volatile("s_waitcnt lgkmcnt(0)" ::: "memory");
}
enum { J_NAT = 0, J_MLA_WIN, J_MLA_WUQ, J_LRU_WAX, J_MOE_UP };
__device__ __forceinline__ int tr_map(int job, int g) {
    switch (job) {
    case J_MLA_WIN: return g < 32 ? 32 * g : (g == 32 ? 1024 : (g == 36 ? 1056 : -1));
    case J_MLA_WUQ: if (g < 32) { const int t = g >> 3, bj = (g >> 2) & 1, cg = g & 3; return (2 * t + bj) * 192 + 32 * cg; }
                    else { const int g2 = g - 32, t2 = g2 >> 3, bj = (g2 >> 2) & 1, hh = g2 & 3; return (4 * t2 + hh) * 192 + 128 + 32 * bj; }
    case J_LRU_WAX: { const int pn = g >> 3, cg = g & 3; return 128 * pn + 32 * cg; }
    case J_MOE_UP:  { const int pn = g >> 3, bj = (g >> 2) & 1, cg = g & 3; return bj * 1024 + 128 * pn + 32 * cg; }
    default: return 32 * g;
    }
}
__device__ __forceinline__ void tr_job(const Ctx& C, int job, const float* src, size_t srcstride, int nmat, int K, int ld, int N, bf16_t* dst, size_t dststride, const float* ksc, int kscstride,
                                       const float* src2  ) {
    LAS float* scr = (LAS float*)(C.lds + C.wave * 16640);
    const int gw = C.vcu * NWAVES + C.wave, NGW = C.G * NWAVES;
    const int nkb = K / 64, nnb = N / 64, per = nkb * nnb, total = per * nmat;
    for (int it = gw; it < total; it += NGW) {
        const int mat = it / per, r = it - mat * per, kb = r / nnb, nb = r - kb * nnb;
        int s0 = tr_map(job, 2 * nb), s1 = tr_map(job, 2 * nb + 1);
        const float* W = src + (size_t)mat * srcstride;
        if (job == J_LRU_WAX && ((nb >> 1) & 1)) W = src2 + (size_t)mat * srcstride;
        tr_item(W, ld, kb * 64, s0, s1, ksc ? ksc + (size_t)mat * kscstride : nullptr, (bf16_t*)((char*)dst + (size_t)mat * dststride) + (size_t)(nb * 64) * K + kb * 64, K, scr, C.lane);
    }
}
__device__ __forceinline__ void cvt_rows(const Ctx& C, const float* src, bf16_t* dst, size_t n8  ) {
    const size_t gt = (size_t)C.vcu * 512 + C.tid, NT = (size_t)C.G * 512;
    for (size_t i = gt; i < n8; i += NT) { const f32x4 a = *(const f32x4*)(src + i * 8), b = *(const f32x4*)(src + i * 8 + 4); *(u32x4*)(dst + i * 8) = pack8(a, b); }
}
__device__ __forceinline__ void phase_prologue(const CAS Args& args, const Ctx& C) {
    tr_job(C, J_MLA_WIN, INF(I_MLA_WIN), (size_t)DM * LATD, 2, DM, LATD, 1280, WSP(bf16_t, WS_W_MLA + OFF_MLA_WIN), W_MLA_STRIDE, nullptr, 0, nullptr);
    tr_job(C, J_MLA_WUQ, INF(I_MLA_WUQ), (size_t)QL * 1536, 2, QL, 1536, 1536, WSP(bf16_t, WS_W_MLA + OFF_MLA_WUQ), W_MLA_STRIDE, INF(I_MLA_QN), QL, nullptr);
    tr_job(C, J_NAT, INF(I_MLA_WUKV), (size_t)KVL * 2048, 2, KVL, 2048, 2048, WSP(bf16_t, WS_W_MLA + OFF_MLA_WUKV), W_MLA_STRIDE, INF(I_MLA_KVN), KVL, nullptr);
    tr_job(C, J_NAT, INF(I_MLA_WO), (size_t)DM * DM, 2, DM, DM, DM, WSP(bf16_t, WS_W_MLA + OFF_MLA_WO), W_MLA_STRIDE, nullptr, 0, nullptr);
    tr_job(C, J_NAT, INF(I_LRU_WIN), (size_t)DM * 2048, 2, DM, 2048, 2048, WSP(bf16_t, WS_W_LRU + OFF_LRU_WIN), W_LRU_STRIDE, nullptr, 0, nullptr);
    for (int j = 0; j < 2; ++j)
        tr_job(C, J_LRU_WAX, INF(I_LRU_WA) + (size_t)j * 4 * 65536, (size_t)256 * 256, 4, 256, 256, 512, WSP(bf16_t, WS_W_LRU + OFF_LRU_WAX + (size_t)j * W_LRU_STRIDE), (size_t)512 * 256 * 2, nullptr, 0, INF(I_LRU_WX) + (size_t)j * 4 * 65536);
    tr_job(C, J_NAT, INF(I_LRU_WOUT), (size_t)DM * DM, 2, DM, DM, DM, WSP(bf16_t, WS_W_LRU + OFF_LRU_WOUT), W_LRU_STRIDE, nullptr, 0, nullptr);
    tr_job(C, J_NAT, INF(I_PLE_WG), (size_t)DM * DM, 4, DM, DM, DM, WSP(bf16_t, WS_W_PLE + OFF_PLE_WG), W_PLE_STRIDE, nullptr, 0, nullptr);
    tr_job(C, J_NAT, INF(I_PLE_WP), (size_t)PLED * DM, 4, PLED, DM, DM, WSP(bf16_t, WS_W_PLE + OFF_PLE_WP), W_PLE_STRIDE, nullptr, 0, nullptr);
    tr_job(C, J_MOE_UP, INF(I_MOE_WUP), (size_t)DM * 2048, DEPTH * NE, DM, 2048, 2048, WSP(bf16_t, WS_W_UP), (size_t)2048 * 1024 * 2, nullptr, 0, nullptr);
    tr_job(C, J_NAT, INF(I_MOE_WDN), (size_t)DFF * DM, DEPTH * NE, DFF, DM, DM, WSP(bf16_t, WS_W_DN), (size_t)1024 * 1024 * 2, nullptr, 0, nullptr);
    cvt_rows(C, INF(I_X), WSP(bf16_t, WS_XB), (size_t)T * DM / 8);
    cvt_rows(C, INF(I_P), WSP(bf16_t, WS_PB), (size_t)DEPTH * T * PLED / 8);
    { const int* pos = (const int*)args.in[I_POS]; float* CS = WSP(float, WS_CS); float* SN = WSP(float, WS_SN);
      const size_t gt = (size_t)C.vcu * 512 + C.tid, NT = (size_t)C.G * 512;
      for (size_t i = gt; i < (size_t)T * 32; i += NT) { const int tok = (int)(i >> 5), j = (int)(i & 31);
          const double inv = exp(-9.210340371976184 * (double)j / 32.0); const double ang = (double)pos[tok] * inv; double s, c; sincos(ang, &s, &c); CS[i] = (float)c; SN[i] = (float)s; }
      float* SPL = WSP(float, WS_SPL); const float* lam = INF(I_LRU_LAM);
      for (size_t i = gt; i < 2 * 1024; i += NT) { const double l = (double)lam[i]; SPL[i] = (float)(-8.0 * log1p(exp(-l))); } }
}

__device__ __forceinline__ void moe_table(const CAS Args& args, const Ctx& C0, int layer) {
    Ctx C = C0; C.tid = opaque_tid(); C.lane = C.tid & 63;
    const unsigned* cnt = WSP(unsigned, WS_CTL) + CW_CNT + 64 * layer;
    __syncthreads();
    if (C.tid < 32) C.misc[64 + C.tid] = (int)__hip_atomic_load(cnt + C.tid, __ATOMIC_RELAXED, __HIP_MEMORY_SCOPE_AGENT);
    __syncthreads();
    if (C.tid == 0) { int acc = 0; for (int e = 0; e < 32; ++e) { C.misc[16 + e] = acc; acc += (C.misc[64 + e] + 255) >> 8; } C.misc[16 + 32] = acc; }
    __syncthreads();
}

__device__ __forceinline__ void phase_ln_router(const CAS Args& args, const Ctx& C0, int layer) {
    const int cslot = layer + args.pad;
    Ctx C = C0; C.tid = opaque_tid(); C.lane = C.tid & 63;
    const bf16_t* Y = WSP(bf16_t, WS_Y); float* X1 = WSP(float, WS_X1); bf16_t* X1B = WSP(bf16_t, WS_X1B);
    const float* g1 = INF(I_LN1G) + layer * DM; const float* b1 = INF(I_LN1B) + layer * DM;
    const CAS float* Wr = (const CAS float*)(INF(I_MOE_WR) + (size_t)layer * DM * NE); const float* br = INF(I_MOE_BR) + layer * NE;
    unsigned* gcnt = WSP(unsigned, WS_CTL) + CW_CNT + 64 * cslot;
    int* lists = WSP(int, WS_LIST); int* slot = WSP(int, WS_SLOT); float* gate = WSP(float, WS_GATE);
    LAS float* part = (LAS float*)C.lds;
    volatile LAS int* lcnt = (volatile LAS int*)(C.lds + 69632);
    volatile LAS int* lbase = lcnt + 32;
    f32x4 gv[4], bv[4];
#pragma unroll
    for (int j = 0; j < 2; ++j) { gv[2 * j] = *(const f32x4*)(g1 + 8 * C.lane + 512 * j); gv[2 * j + 1] = *(const f32x4*)(g1 + 8 * C.lane + 512 * j + 4);
        bv[2 * j] = *(const f32x4*)(b1 + 8 * C.lane + 512 * j); bv[2 * j + 1] = *(const f32x4*)(b1 + 8 * C.lane + 512 * j + 4); }
    for (int chunk = C.vcu; chunk < T / 128; chunk += C.G) {
        const int row0 = chunk * 128;
        if (C.tid < 32) lcnt[C.tid] = 0;
        for (int i = 0; i < 16; ++i) { const size_t row = (size_t)row0 + C.wave * 16 + i;
            f32x4 v[4]; float s = 0.f;
#pragma unroll
            for (int j = 0; j < 2; ++j) { const u32x4 w = *(const u32x4*)(Y + row * DM + 8 * C.lane + 512 * j); v[2 * j] = pg8::bf4_lo(w); v[2 * j + 1] = pg8::bf4_hi(w); }
#pragma unroll
            for (int j = 0; j < 4; ++j) s += (v[j][0] + v[j][1]) + (v[j][2] + v[j][3]);
            const float mean = wave_sum(s) * (1.f / DM); float s2 = 0.f;
#pragma unroll
            for (int j = 0; j < 4; ++j) { v[j] = v[j] - mean; s2 += (v[j][0] * v[j][0] + v[j][1] * v[j][1]) + (v[j][2] * v[j][2] + v[j][3] * v[j][3]); }
            const float rstd = 1.f / sqrtf(wave_sum(s2) * (1.f / DM) + LN_EPS);
#pragma unroll
            for (int j = 0; j < 4; ++j) v[j] = v[j] * rstd * gv[j] + bv[j];
#pragma unroll
            for (int j = 0; j < 2; ++j) { float* xo = X1 + row * DM + 8 * C.lane + 512 * j; *(f32x4*)xo = v[2 * j]; *(f32x4*)(xo + 4) = v[2 * j + 1];
                *(u32x4*)(X1B + row * DM + 8 * C.lane + 512 * j) = pack8(v[2 * j], v[2 * j + 1]); } }
        asm volatile("s_waitcnt vmcnt(0)" ::: "memory");
        __syncthreads();
        { const int grp = C.wave >> 2, kq = C.wave & 3; const size_t tok = (size_t)row0 + grp * 64 + C.lane;
          float acc[32];
#pragma unroll
          for (int e = 0; e < 32; ++e) acc[e] = 0.f;
          const float* xr = X1 + tok * DM + kq * 256;
          for (int kk = 0; kk < 64; ++kk) { const f32x4 xv = *(const f32x4*)(xr + kk * 4);
#pragma unroll
              for (int i = 0; i < 4; ++i) { const CAS float* wrow = Wr + (size_t)(kq * 256 + kk * 4 + i) * NE;
#pragma unroll
                  for (int e = 0; e < 32; ++e) acc[e] = fmaf(xv[i], wrow[e], acc[e]); } }
          LAS float* pp = part + ((grp * 4 + kq) * 64 + C.lane) * 33;
#pragma unroll
          for (int e = 0; e < 32; ++e) pp[e] = acc[e]; }
        __syncthreads();
        int te[4] = {0, 0, 0, 0}, lp[4] = {0, 0, 0, 0}; float tg[4] = {0.f, 0.f, 0.f, 0.f};
        if (C.tid < 128) { const int grp = C.tid >> 6, ln = C.tid & 63; float lg[32];
#pragma unroll
            for (int e = 0; e < 32; ++e) { float s = br[e];
#pragma unroll
                for (int kq = 0; kq < 4; ++kq) s += part[((grp * 4 + kq) * 64 + ln) * 33 + e];
                lg[e] = s; }
            float tv[4];
#pragma unroll
            for (int k = 0; k < 4; ++k) { float best = -__builtin_inff(); int bi = 0;
#pragma unroll
                for (int e = 0; e < 32; ++e) { bool taken = false;
#pragma unroll
                    for (int q = 0; q < 4; ++q) if (q < k) taken = taken || (te[q] == e);
                    if (!taken && lg[e] > best) { best = lg[e]; bi = e; } }
                te[k] = bi; tv[k] = best; }
            float den = 0.f;
#pragma unroll
            for (int k = 0; k < 4; ++k) { tg[k] = __expf(tv[k] - tv[0]); den += tg[k]; }
            const float rden = 1.0f / den;
#pragma unroll
            for (int k = 0; k < 4; ++k) { tg[k] *= rden; lp[k] = __hip_atomic_fetch_add((LAS int*)&lcnt[te[k]], 1, __ATOMIC_RELAXED, __HIP_MEMORY_SCOPE_WORKGROUP); } }
        __syncthreads();
        if (C.tid < 32) lbase[C.tid] = (int)__hip_atomic_fetch_add(gcnt + C.tid, (unsigned)lcnt[C.tid], __ATOMIC_RELAXED, __HIP_MEMORY_SCOPE_AGENT);
        __syncthreads();
        if (C.tid < 128) { const int tok = row0 + C.tid;
#pragma unroll
            for (int k = 0; k < 4; ++k) { const int pos = lbase[te[k]] + lp[k]; lists[(size_t)te[k] * T + pos] = tok; slot[tok * 4 + k] = te[k] * T + pos; gate[tok * 4 + k] = tg[k]; } }
        __syncthreads();
    }
}

__device__ __forceinline__ void phase_combine_ln2(const CAS Args& args, const Ctx& C0, int layer) {
    Ctx C = C0; C.tid = opaque_tid(); C.lane = C.tid & 63;
    moe_table(args, C, layer);
    const bf16_t* X1B = WSP(bf16_t, WS_X1B); const bf16_t* YS = WSP(bf16_t, WS_YS); const int* slot = WSP(int, WS_SLOT); const float* gate = WSP(float, WS_GATE);
    bf16_t* X2B = WSP(bf16_t, WS_X2B);
    const float* g2 = INF(I_LN2G) + layer * DM; const float* b2 = INF(I_LN2B) + layer * DM;
    f32x4 gv[4], bv[4];
#pragma unroll
    for (int j = 0; j < 2; ++j) { gv[2 * j] = *(const f32x4*)(g2 + 8 * C.lane + 512 * j); gv[2 * j + 1] = *(const f32x4*)(g2 + 8 * C.lane + 512 * j + 4);
        bv[2 * j] = *(const f32x4*)(b2 + 8 * C.lane + 512 * j); bv[2 * j + 1] = *(const f32x4*)(b2 + 8 * C.lane + 512 * j + 4); }
    const int gw = C.vcu * NWAVES + C.wave, NGW = C.G * NWAVES;
    for (int row = gw; row < T; row += NGW) {
        f32x4 v[4];
#pragma unroll
        for (int j = 0; j < 2; ++j) { const u32x4 w = *(const u32x4*)(X1B + (size_t)row * DM + 8 * C.lane + 512 * j); v[2 * j] = pg8::bf4_lo(w) * ALPHA; v[2 * j + 1] = pg8::bf4_hi(w) * ALPHA; }
#pragma unroll
        for (int k = 0; k < 4; ++k) { const int sv = slot[row * 4 + k]; const float g = gate[row * 4 + k]; const int e = sv >> 15, pos = sv & (T - 1);
            const size_t prow = (size_t)C.misc[16 + e] * 256 + pos;
#pragma unroll
            for (int j = 0; j < 2; ++j) { const u32x4 w = *(const u32x4*)(YS + prow * DM + 8 * C.lane + 512 * j); v[2 * j] += pg8::bf4_lo(w) * g; v[2 * j + 1] += pg8::bf4_hi(w) * g; } }
        float s = 0.f;
#pragma unroll
        for (int j = 0; j < 4; ++j) s += (v[j][0] + v[j][1]) + (v[j][2] + v[j][3]);
        const float mean = wave_sum(s) * (1.f / DM); float s2 = 0.f;
#pragma unroll
        for (int j = 0; j < 4; ++j) { v[j] = v[j] - mean; s2 += (v[j][0] * v[j][0] + v[j][1] * v[j][1]) + (v[j][2] * v[j][2] + v[j][3] * v[j][3]); }
        const float rstd = 1.f / sqrtf(wave_sum(s2) * (1.f / DM) + LN_EPS);
#pragma unroll
        for (int j = 0; j < 4; ++j) v[j] = v[j] * rstd * gv[j] + bv[j];
#pragma unroll
        for (int j = 0; j < 2; ++j) *(u32x4*)(X2B + (size_t)row * DM + 8 * C.lane + 512 * j) = pack8(v[2 * j], v[2 * j + 1]);
    }
}

__device__ __forceinline__ void phase_conv(const CAS Args& args, const Ctx& C0, int j) {
    Ctx C = C0; C.tid = opaque_tid(); C.lane = C.tid & 63;
    const bf16_t* U = WSP(bf16_t, WS_U); bf16_t* UC = WSP(bf16_t, WS_UC);
    const float* cw = INF(I_LRU_CW) + (size_t)j * 4 * DM; const float* cb = INF(I_LRU_CB) + (size_t)j * DM;
    const int c8 = (C.tid & 127) * 8, rsub = C.tid >> 7;
    float w[4][8], bb[8];
#pragma unroll
    for (int q = 0; q < 4; ++q)
#pragma unroll
        for (int e = 0; e < 8; ++e) w[q][e] = cw[q * DM + c8 + e];
#pragma unroll
    for (int e = 0; e < 8; ++e) bb[e] = cb[c8 + e];
    for (int chunk = C.vcu; chunk < T / 128; chunk += C.G) {
        const int r0 = chunk * 128 + rsub * 32;
        u32x4 h0, h1, h2;
        const u32x4 z = {0u, 0u, 0u, 0u};
        const int s0 = r0 & (SEQ - 1);
        h0 = s0 >= 3 ? *(const u32x4*)(U + (size_t)(r0 - 3) * DM + c8) : z; h1 = s0 >= 2 ? *(const u32x4*)(U + (size_t)(r0 - 2) * DM + c8) : z; h2 = s0 >= 1 ? *(const u32x4*)(U + (size_t)(r0 - 1) * DM + c8) : z;
#pragma unroll 4
        for (int i = 0; i < 32; ++i) { const u32x4 h3 = *(const u32x4*)(U + (size_t)(r0 + i) * DM + c8);
            float o[8];
#pragma unroll
            for (int q = 0; q < 4; ++q) { const unsigned a = h0[q], b = h1[q], c = h2[q], d = h3[q];
                o[2 * q] = bb[2 * q] + w[0][2 * q] * bf_lo(a) + w[1][2 * q] * bf_lo(b) + w[2][2 * q] * bf_lo(c) + w[3][2 * q] * bf_lo(d);
                o[2 * q + 1] = bb[2 * q + 1] + w[0][2 * q + 1] * bf_hi(a) + w[1][2 * q + 1] * bf_hi(b) + w[2][2 * q + 1] * bf_hi(c) + w[3][2 * q + 1] * bf_hi(d); }
            u32x4 ow; ow.x = cvt_pk_bf16(o[0], o[1]); ow.y = cvt_pk_bf16(o[2], o[3]); ow.z = cvt_pk_bf16(o[4], o[5]); ow.w = cvt_pk_bf16(o[6], o[7]);
            *(u32x4*)(UC + (size_t)(r0 + i) * DM + c8) = ow; h0 = h1; h1 = h2; h2 = h3; }
    }
}
__device__ __forceinline__ void phase_scan1(const CAS Args& args, const Ctx& C0) {
    Ctx C = C0; C.tid = opaque_tid(); C.lane = C.tid & 63;
    const float* AA = WSP(float, WS_AA); const float* BB = WSP(float, WS_BB); float* CA = WSP(float, WS_CA); float* CH = WSP(float, WS_CH);
    const int c2 = C.tid * 2;
    for (int item = C.vcu; item < NBATCH * 64; item += C.G) {
        const size_t r0 = (size_t)item * 64; float h0 = 0.f, h1 = 0.f, p0 = 1.f, p1 = 1.f;
#pragma unroll 8
        for (int s = 0; s < 64; ++s) { const f32x2 a = *(const f32x2*)(AA + (r0 + s) * DM + c2), b = *(const f32x2*)(BB + (r0 + s) * DM + c2);
            h0 = a[0] * h0 + b[0]; h1 = a[1] * h1 + b[1]; p0 *= a[0]; p1 *= a[1]; }
        *(f32x2*)(CA + (size_t)item * DM + c2) = (f32x2){p0, p1}; *(f32x2*)(CH + (size_t)item * DM + c2) = (f32x2){h0, h1};
    }
}
__device__ __forceinline__ void phase_scan2(const CAS Args& args, const Ctx& C0) {
    Ctx C = C0; C.tid = opaque_tid(); C.lane = C.tid & 63;
    const float* AA = WSP(float, WS_AA); const float* BB = WSP(float, WS_BB); const float* CA = WSP(float, WS_CA); const float* CH = WSP(float, WS_CH);
    const bf16_t* GG = WSP(bf16_t, WS_GG); bf16_t* YL = WSP(bf16_t, WS_O);
    const int c2 = C.tid * 2;
    for (int item = C.vcu; item < NBATCH * 64; item += C.G) {
        const int b = item >> 6, ch = item & 63; float h0 = 0.f, h1 = 0.f;
        for (int jx = 0; jx < ch; ++jx) { const f32x2 a = *(const f32x2*)(CA + (size_t)(b * 64 + jx) * DM + c2), e = *(const f32x2*)(CH + (size_t)(b * 64 + jx) * DM + c2);
            h0 = a[0] * h0 + e[0]; h1 = a[1] * h1 + e[1]; }
        const size_t r0 = (size_t)item * 64;
#pragma unroll 8
        for (int s = 0; s < 64; ++s) { const f32x2 a = *(const f32x2*)(AA + (r0 + s) * DM + c2), bq = *(const f32x2*)(BB + (r0 + s) * DM + c2); const unsigned g = *(const unsigned*)(GG + (r0 + s) * DM + c2);
            h0 = a[0] * h0 + bq[0]; h1 = a[1] * h1 + bq[1];
            *(unsigned*)(YL + (r0 + s) * DM + c2) = cvt_pk_bf16(bf_lo(g) * h0, bf_hi(g) * h1); }
    }
}

constexpr int PH_PER_LAYER = 12, PH_TOTAL = 2 + PH_PER_LAYER * DEPTH;
__global__ void __launch_bounds__(NWAVES * 64, 2) fwd_kernel(Args args_kernarg) {
    (void)args_kernarg;
    ArgsP const argp = (ArgsP)__builtin_amdgcn_kernarg_segment_ptr();
    const CAS Args& args0 = *argp;
    extern __shared__ __attribute__((aligned(16))) unsigned char lds_raw[];
    Ctx C;
    C.lds = (LAS unsigned char*)lds_raw; C.misc = (volatile LAS int*)(C.lds + MISC_OFF);
    C.tid = threadIdx.x; C.lane = C.tid & 63; C.wave = __builtin_amdgcn_readfirstlane(C.tid >> 6);
    C.G = gridDim.x; { const int bx = blockIdx.x; C.vcu = (C.G % 8 == 0) ? (bx % 8) * (C.G / 8) + bx / 8 : bx; }
    for (int u = C.tid; u < 128; u += NWAVES * 64) C.misc[u] = 0;
    __syncthreads();
    XcdBarrier bar = xcd_barrier_post((unsigned*)(args0.ws + WS_CTL) + CW_BAR + args0.li * XCD_BAR_WORDS, (volatile LAS unsigned*)C.misc);
    const int lo = args0.ph_lo, hi = args0.ph_hi;
#define IN(k) (lo <= (k) && (k) < hi)
#define PH_END(k) do { if ((k) + 1 < hi) xcd_barrier(bar); } while (0)
    const int cid = (int)blockIdx.x;

    if (SEL(0) && IN(0)) { const CAS Args& args = fresh_args(argp); phase_prologue(args, C); PH_END(0); }
    if (SEL(1) && IN(1)) { const CAS Args& args = fresh_args(argp);
        pg8::DenseSched S; S.init(WSP(bf16_t, WS_PB), WSP(bf16_t, WS_W_PLE + OFF_PLE_WP), PLED, PLED, DEPTH * T, DM, C.G, cid); S.bpm_shift = 7; S.bbatch = W_PLE_STRIDE;
        pg8::EpiPP E{WSP(bf16_t, WS_PP)};
        pg8::gemm_phase<pg8::EpiPP, pg8::DenseSched, false>(C.lds, PLED, PLED, PLED, S, E);
        PH_END(1);
    }
    for (int layer = 0; layer < DEPTH; ++layer) {
        const int base = 2 + PH_PER_LAYER * layer, j = layer >> 1;
        if ((layer & 1) == 0) {
            if (SEL(2) && IN(base + 0)) { const CAS Args& args = fresh_args(argp); const unsigned char* wm = args.ws + WS_W_MLA + (size_t)j * W_MLA_STRIDE;
                pg8::DenseSched S; S.init(WSP(bf16_t, WS_XB), wm + OFF_MLA_WIN, DM, DM, T, 1280, C.G, cid);
                pg8::EpiLat E{WSP(bf16_t, WS_LAT), WSP(float, WS_SSQ), WSP(bf16_t, WS_KR), WSP(float, WS_CS), WSP(float, WS_SN)};
                pg8::gemm_phase<pg8::EpiLat, pg8::DenseSched, false>(C.lds, DM, DM, DM, S, E);
                PH_END(base + 0);
            }
            if (SEL(3) && IN(base + 1)) { const CAS Args& args = fresh_args(argp); const unsigned char* wm = args.ws + WS_W_MLA + (size_t)j * W_MLA_STRIDE;
                { pg8::DenseSched S; S.init(WSP(bf16_t, WS_LAT), wm + OFF_MLA_WUQ, DM, QL, T, 1536, C.G, cid);
                  pg8::EpiQ E{WSP(bf16_t, WS_Q), WSP(float, WS_SSQ), WSP(float, WS_CS), WSP(float, WS_SN)};
                  pg8::gemm_phase<pg8::EpiQ, pg8::DenseSched, false>(C.lds, QL, DM, QL, S, E); }
                { pg8::DenseSched S; S.init(WSP(bf16_t, WS_LAT) + QL, wm + OFF_MLA_WUKV, DM, KVL, T, 2048, C.G, cid);
                  pg8::EpiKV E{WSP(bf16_t, WS_KN), WSP(bf16_t, WS_V), WSP(float, WS_SSQ)};
                  pg8::gemm_phase<pg8::EpiKV, pg8::DenseSched, false>(C.lds, KVL, DM, KVL, S, E); }
                PH_END(base + 1);
            }
            if (SEL(4) && IN(base + 2)) { const CAS Args& args = fresh_args(argp);
                for (int it = C.vcu; it < NBATCH * NH * 8; it += C.G) { const int bh = it >> 3, pr = it & 7;
                    att::attn_block(bh >> 3, bh & 7, pr, WSP(bf16_t, WS_Q), WSP(bf16_t, WS_KN), WSP(bf16_t, WS_KR), WSP(bf16_t, WS_V), WSP(bf16_t, WS_O), (LAS char*)C.lds);
                    att::attn_block(bh >> 3, bh & 7, 15 - pr, WSP(bf16_t, WS_Q), WSP(bf16_t, WS_KN), WSP(bf16_t, WS_KR), WSP(bf16_t, WS_V), WSP(bf16_t, WS_O), (LAS char*)C.lds); }
                PH_END(base + 2);
            }
        } else {
            if (SEL(5) && IN(base + 0)) { const CAS Args& args = fresh_args(argp); const unsigned char* wl = args.ws + WS_W_LRU + (size_t)j * W_LRU_STRIDE;
                pg8::DenseSched S; S.init(WSP(bf16_t, WS_XB), wl + OFF_LRU_WIN, DM, DM, T, 2048, C.G, cid);
                pg8::EpiGU E{WSP(bf16_t, WS_GG), WSP(bf16_t, WS_U)};
                pg8::gemm_phase<pg8::EpiGU, pg8::DenseSched, false>(C.lds, DM, DM, DM, S, E);
                PH_END(base + 0);
            }
            if (SEL(6) && IN(base + 1)) { const CAS Args& args = fresh_args(argp); phase_conv(args, C, j); PH_END(base + 1); }
            if (SEL(7) && IN(base + 2)) { const CAS Args& args = fresh_args(argp); const unsigned char* wl = args.ws + WS_W_LRU + (size_t)j * W_LRU_STRIDE;
                pg8::DenseSched S; S.init(WSP(bf16_t, WS_UC), wl + OFF_LRU_WAX, DM, 256, T, 2048, C.G, cid); S.apn_shift = 1; S.akbytes = 512;
                pg8::EpiAB E{WSP(float, WS_AA), WSP(float, WS_BB), WSP(bf16_t, WS_UC), INF(I_LRU_BA) + j * DM, INF(I_LRU_BX) + j * DM, WSP(float, WS_SPL) + j * DM};
                pg8::gemm_phase<pg8::EpiAB, pg8::DenseSched, false>(C.lds, 256, DM, 256, S, E);
                PH_END(base + 2);
            }
            if (SEL(8) && IN(base + 3)) { const CAS Args& args = fresh_args(argp); phase_scan1(args, C); PH_END(base + 3); }
            if (SEL(9) && IN(base + 4)) { const CAS Args& args = fresh_args(argp); phase_scan2(args, C); PH_END(base + 4); }
        }
        if (SEL(10) && IN(base + 5)) { const CAS Args& args = fresh_args(argp);
            const unsigned char* wo = (layer & 1) ? args.ws + WS_W_LRU + (size_t)j * W_LRU_STRIDE + OFF_LRU_WOUT : args.ws + WS_W_MLA + (size_t)j * W_MLA_STRIDE + OFF_MLA_WO;
            pg8::DenseSched S; S.init(WSP(bf16_t, WS_O), wo, DM, DM, T, DM, C.G, cid);
            pg8::EpiRes E{WSP(bf16_t, WS_XB), WSP(bf16_t, WS_Y)};
            pg8::gemm_phase<pg8::EpiRes, pg8::DenseSched, false>(C.lds, DM, DM, DM, S, E);
            PH_END(base + 5);
        }
        if (SEL(11) && IN(base + 6)) { const CAS Args& args = fresh_args(argp); phase_ln_router(args, C, layer); PH_END(base + 6); }
        if (SEL(12) && IN(base + 7)) { const CAS Args& args = fresh_args(argp);
            moe_table(args, C, layer);
            pg8::MoeSched S{(const char*)WSP(bf16_t, WS_X1B), (const char*)(args.ws + WS_W_UP + (size_t)layer * NE * 2048 * 1024 * 2), (size_t)2048 * 1024 * 2, DM, DM, 8, WSP(int, WS_LIST), C.misc + 16, C.G, cid, true};
            pg8::EpiUp E{WSP(bf16_t, WS_H), INF(I_MOE_BUP) + (size_t)layer * NE * 2048};
            pg8::gemm_phase<pg8::EpiUp, pg8::MoeSched, true>(C.lds, DM, DM, DM, S, E);
            PH_END(base + 7);
        }
        if (SEL(13) && IN(base + 8)) { const CAS Args& args = fresh_args(argp);
            moe_table(args, C, layer);
            pg8::MoeSched S{(const char*)WSP(bf16_t, WS_H), (const char*)(args.ws + WS_W_DN + (size_t)layer * NE * 1024 * 1024 * 2), (size_t)1024 * 1024 * 2, DFF, DFF, 4, WSP(int, WS_LIST), C.misc + 16, C.G, cid, false};
            pg8::EpiDown E{WSP(bf16_t, WS_YS), INF(I_MOE_BDN) + (size_t)layer * NE * DM};
            pg8::gemm_phase<pg8::EpiDown, pg8::MoeSched, false>(C.lds, DFF, DFF, DFF, S, E);
            PH_END(base + 8);
        }
        if (SEL(14) && IN(base + 9)) { const CAS Args& args = fresh_args(argp); phase_combine_ln2(args, C, layer); PH_END(base + 9); }
        if (SEL(15) && IN(base + 10)) { const CAS Args& args = fresh_args(argp);
            pg8::DenseSched S; S.init(WSP(bf16_t, WS_X2B), args.ws + WS_W_PLE + (size_t)layer * W_PLE_STRIDE + OFF_PLE_WG, DM, DM, T, DM, C.G, cid);
            pg8::EpiPle E{WSP(bf16_t, WS_X2B), WSP(bf16_t, WS_PP) + (size_t)layer * T * DM, layer == DEPTH - 1 ? args.out : (float*)nullptr, WSP(bf16_t, WS_XB)};
            pg8::gemm_phase<pg8::EpiPle, pg8::DenseSched, false>(C.lds, DM, DM, DM, S, E);
            if (layer + 1 < DEPTH) PH_END(base + 10);
        }
    }
#undef IN
#undef PH_END
}

extern "C" void kernel_launch(void* const* d_in, const int* in_sizes, int n_in, void* d_out, int out_size, void* d_ws, size_t ws_size, hipStream_t stream) {
    static int grid = 0;
    if (grid == 0) {
        if (n_in != 30 || in_sizes[0] != T * DM || out_size != T * DM || ws_size < WS_END) { fprintf(stderr, "kernel_launch: unexpected shapes (n_in %d, in0 %d, out %d, ws %zu)\n", n_in, n_in > 0 ? in_sizes[0] : -1, out_size, ws_size); grid = -1; return; }
        int dev = 0, cus = 0, per_cu = 0;
        if (hipGetDevice(&dev) != hipSuccess || hipDeviceGetAttribute(&cus, hipDeviceAttributeMultiprocessorCount, dev) != hipSuccess) { grid = -1; return; }
        if (hipFuncSetAttribute((const void*)fwd_kernel, hipFuncAttributeMaxDynamicSharedMemorySize, LDS_BYTES) != hipSuccess) { fprintf(stderr, "kernel_launch: hipFuncSetAttribute failed\n"); grid = -1; return; }
        if (hipOccupancyMaxActiveBlocksPerMultiprocessor(&per_cu, (const void*)fwd_kernel, NWAVES * 64, LDS_BYTES) != hipSuccess || per_cu < 1) fprintf(stderr, "kernel_launch: occupancy query reports %d\n", per_cu);
        (void)hipGetLastError();
        grid = cus;
    }
    if (grid < 0) return;
    if (hipMemsetAsync((char*)d_ws + WS_CTL, 0, CTL_ZERO_BYTES, stream) != hipSuccess) return;
    Args a{};
    for (int i = 0; i < 30; ++i) a.in[i] = d_in[i];
    a.out = (float*)d_out; a.ws = (unsigned char*)d_ws; a.pad = 0;
#if MK_ONE_LAUNCH
    a.ph_lo = 0; a.ph_hi = PH_TOTAL; a.li = 0;
    hipLaunchKernelGGL(fwd_kernel, dim3(grid), dim3(NWAVES * 64), LDS_BYTES, stream, a);
#else
    int li = 0;
    for (int ph = 0; ph < PH_TOTAL; ++ph) {
        if (ph >= 2) { const int l = (ph - 2) / PH_PER_LAYER, k = (ph - 2) % PH_PER_LAYER; if (k == 11) continue; if ((l & 1) == 0 && (k == 3 || k == 4)) continue; }
        int site = ph;
        if (ph >= 2) { const int l = (ph - 2) / PH_PER_LAYER, k = (ph - 2) % PH_PER_LAYER; static const int mla[11] = {2, 3, 4, -1, -1, 10, 11, 12, 13, 14, 15}, lru[11] = {5, 6, 7, 8, 9, 10, 11, 12, 13, 14, 15}; site = (l & 1) ? lru[k] : mla[k]; }
        a.ph_lo = ph; a.ph_hi = ph + 1;
        if ((HOSTDUP >> site) & 1) { a.li = li++; a.pad = 4; hipLaunchKernelGGL(fwd_kernel, dim3(grid), dim3(NWAVES * 64), LDS_BYTES, stream, a); }
        a.li = li++; a.pad = 0;
        hipLaunchKernelGGL(fwd_kernel, dim3(grid), dim3(NWAVES * 64), LDS_BYTES, stream, a);
    }
#endif
}
```

```cpp
#include <hip/hip_runtime.h>
#include <hip/hip_bf16.h>
#include <cstdio>
#include <cstdint>

#ifndef PHSEL
#define PHSEL -1
#endif
#ifndef PHSKIP
#define PHSKIP -1
#endif
#define SEL(id) ((PHSEL < 0 || PHSEL == (id)) && PHSKIP != (id))
#ifndef HOSTDUP
#define HOSTDUP 0
#endif
#ifndef MK_ONE_LAUNCH
#define MK_ONE_LAUNCH 1
#endif

constexpr int T = 32768, SEQ = 4096, NBATCH = 8, DM = 1024, DEPTH = 4;
constexpr int QL = 768, KVL = 256, ROPE = 64, LATD = 1088, NH = 8, DQK = 192, DV = 128;
constexpr int NE = 32, TOPK = 4, DFF = 1024, PLED = 256;
constexpr float ALPHA = 1.681792830507429f;
constexpr float LN_EPS = 1e-5f, RMS_EPS = 1e-6f;
constexpr float QSCALE = 1.4426950408889634f / 13.856406460551018f;
constexpr int NWAVES = 8;

constexpr size_t MiB = 1u << 20;
constexpr size_t WS_CTL = 0, CTL_ZERO_BYTES = 2 * MiB;
constexpr size_t WS_CS = 2 * MiB, WS_SN = 6 * MiB, WS_SPL = 10 * MiB;
constexpr size_t WS_W_MLA = 12 * MiB, W_MLA_STRIDE = 8 * MiB;
constexpr size_t OFF_MLA_WIN = 0, OFF_MLA_WUQ = 2560 * 1024, OFF_MLA_WUKV = OFF_MLA_WUQ + 2304 * 1024, OFF_MLA_WO = OFF_MLA_WUKV + 1024 * 1024;
constexpr size_t WS_W_LRU = 28 * MiB, W_LRU_STRIDE = 8 * MiB;
constexpr size_t OFF_LRU_WIN = 0, OFF_LRU_WAX = 4 * MiB, OFF_LRU_WOUT = 5 * MiB;
constexpr size_t WS_W_PLE = 44 * MiB, W_PLE_STRIDE = 3 * MiB;
constexpr size_t OFF_PLE_WG = 0, OFF_PLE_WP = 2 * MiB;
constexpr size_t WS_W_UP = 56 * MiB;
constexpr size_t WS_W_DN = 568 * MiB;
constexpr size_t WS_XB = 824 * MiB, WS_PB = 888 * MiB, WS_PP = 952 * MiB;
constexpr size_t WS_Y = 1208 * MiB, WS_X1 = 1336 * MiB, WS_X1B = 1464 * MiB, WS_X2 = 1528 * MiB, WS_X2B = 1656 * MiB;
constexpr size_t WS_LAT = 1720 * MiB, WS_KR = 1784 * MiB, WS_SSQ = 1788 * MiB, WS_Q = 1790 * MiB, WS_KN = 1886 * MiB, WS_V = 1950 * MiB, WS_O = 2014 * MiB;
constexpr size_t WS_GG = 2078 * MiB, WS_U = 2142 * MiB, WS_UC = 2206 * MiB, WS_AA = 2270 * MiB, WS_BB = 2398 * MiB, WS_CA = 2526 * MiB, WS_CH = 2528 * MiB;
constexpr size_t WS_H = 2530 * MiB, WS_YS = 2802 * MiB, WS_LIST = 3074 * MiB, WS_SLOT = 3078 * MiB, WS_GATE = 3079 * MiB, WS_END = 3080 * MiB;
constexpr int PADROWS = T * TOPK + NE * 256;
static_assert((size_t)PADROWS * DFF * 2 <= 272 * MiB, "H / YS size");
constexpr int CW_CNT = 256;
constexpr int CW_BAR = 4096;

constexpr int RING_BYTES = 139264;
constexpr int MISC_OFF = RING_BYTES;
constexpr int LDS_BYTES = 147456;

#define GAS __attribute__((address_space(1)))
#define LAS __attribute__((address_space(3)))
#define CAS __attribute__((address_space(4)))
typedef unsigned short bf16_t;
typedef short bf16x8 __attribute__((ext_vector_type(8)));
typedef short s16x4 __attribute__((ext_vector_type(4)));
typedef float f32x2 __attribute__((ext_vector_type(2)));
typedef float f32x4 __attribute__((ext_vector_type(4)));
typedef float f32x16 __attribute__((ext_vector_type(16)));
typedef unsigned u32x2 __attribute__((ext_vector_type(2)));
typedef unsigned u32x4 __attribute__((ext_vector_type(4)));

__device__ __forceinline__ unsigned cvt_pk_bf16(float lo, float hi) { unsigned r; asm volatile("v_cvt_pk_bf16_f32 %0, %1, %2" : "=v"(r) : "v"(lo), "v"(hi)); return r; }
__device__ __forceinline__ float bf_lo(unsigned w) { return __uint_as_float(w << 16); }
__device__ __forceinline__ float bf_hi(unsigned w) { return __uint_as_float(w & 0xffff0000u); }
__device__ __forceinline__ float sigmoidf_(float x) { return __builtin_amdgcn_rcpf(1.0f + __expf(-x)); }
__device__ __forceinline__ float gelu_tanh(float x) { const float u = 0.7978845608028654f * (x + 0.044715f * x * x * x); const float t = 1.0f - 2.0f * __builtin_amdgcn_rcpf(1.0f + __expf(2.0f * u)); return 0.5f * x * (1.0f + t); }
__device__ __forceinline__ u32x4 pack8(const f32x4 a, const f32x4 b) { u32x4 w; w.x = cvt_pk_bf16(a[0], a[1]); w.y = cvt_pk_bf16(a[2], a[3]); w.z = cvt_pk_bf16(b[0], b[1]); w.w = cvt_pk_bf16(b[2], b[3]); return w; }
__device__ __forceinline__ int opaque_tid() { int t = threadIdx.x; asm volatile("" : "+v"(t)); return t; }
__device__ __forceinline__ float wave_sum(float v) {
#pragma unroll
    for (int o = 1; o < 64; o <<= 1) v += __shfl_xor(v, o);
    return v;
}

namespace pg8 {
#define PG8_LAS __attribute__((address_space(3)))
constexpr int BM = 256, BK = 64, HALF = 128, HTB = HALF * BK * 2, STAGE_BYTES = 8 * HTB;
__host__ __device__ __forceinline__ int lds_byte(int r, int c) { const int st = (r >> 4) * 2 + (c >> 5), rr = r & 15, cc = c & 31, ob = rr * 64 + cc * 2; return st * 1024 + (ob ^ (((ob >> 9) & 1) << 5)); }
__host__ __device__ __forceinline__ void stage_rc(int b, int& R, int& C) { const int st = b / 1024, sb = b % 1024, swz = sb ^ (((sb >> 9) & 1) << 5); R = (st >> 1) * 16 + swz / 64; C = (st & 1) * 32 + (swz % 64) / 2; }
__host__ __device__ __forceinline__ int perm32(int rho) { const int n = rho >> 4, i = rho & 15; return 8 * (i >> 2) + 4 * n + (i & 3); }

struct Unit { const char* A; const char* B; const int* lst; int nvalid; int pm, pn, aux; };

template <class Epi, class Sched, bool GATHER>
__device__ __forceinline__ void gemm_phase(PG8_LAS unsigned char* lds, const int K, const int lda, const int ldb, const Sched& S, const Epi& E) {
    const int tid = opaque_tid(), wid = __builtin_amdgcn_readfirstlane(tid >> 6), lane = tid & 63, wr = wid >> 2, wc = wid & 3, fr = lane & 15, fq = lane >> 4;
    const int nt = K / BK;
    unsigned voffB[2], ocA[2][2], onA[2][2]; int gR[2], gC2[2];
#pragma unroll
    for (int i = 0; i < 2; ++i) { int R, C; stage_rc(tid * 16 + i * 8192, R, C); const int Rb = Epi::PERM ? ((R & ~31) + perm32(R & 31)) : R;
        voffB[i] = (unsigned)(Rb * ldb + C) * 2u; gR[i] = R; gC2[i] = C * 2;
        ocA[0][i] = (unsigned)(R * lda + C) * 2u; ocA[1][i] = (unsigned)((R + HALF) * lda + C) * 2u; onA[0][i] = ocA[0][i]; onA[1][i] = ocA[1][i]; }
    constexpr unsigned kstep = BK * 2;
    const unsigned hstepB = (unsigned)HALF * ldb * 2;
    const unsigned ldsw = (unsigned)wid * 1024u;
    const int aoff = lds_byte(wr * 64 + fr, fq * 8), boff = lds_byte(wc * 32 + fr, fq * 8);
#define PG8_SA(b, h) (((b) * 2 + (h)) * HTB)
#define PG8_SB(b, h) ((4 + (b) * 2 + (h)) * HTB)
#define PG8_STAGE(bufoff, gbase, voff, kb) do { _Pragma("unroll") for (int _i = 0; _i < 2; ++_i) \
        __builtin_amdgcn_global_load_lds((const unsigned*)((const char*)(gbase) + (size_t)(unsigned)((voff)[_i] + (unsigned)(kb))), (PG8_LAS unsigned*)(lds + (bufoff) + ldsw + _i * 8192), 16, 0, 0); } while (0)
#define PG8_LDA(dst, b, h) do { _Pragma("unroll") for (int m = 0; m < 4; ++m) _Pragma("unroll") for (int k = 0; k < 2; ++k) dst[m][k] = *(const PG8_LAS bf16x8*)(lds + PG8_SA(b, h) + aoff + m * 2048 + k * 1024); } while (0)
#define PG8_LDB(dst, b, h) do { _Pragma("unroll") for (int n = 0; n < 2; ++n) _Pragma("unroll") for (int k = 0; k < 2; ++k) dst[n][k] = *(const PG8_LAS bf16x8*)(lds + PG8_SB(b, h) + boff + n * 2048 + k * 1024); } while (0)
#define PG8_MMA(ai, bj, At, Bt) do { __builtin_amdgcn_s_setprio(1); _Pragma("unroll") for (int m = 0; m < 4; ++m) _Pragma("unroll") for (int n = 0; n < 2; ++n) _Pragma("unroll") for (int k = 0; k < 2; ++k) \
        acc[ai][bj][m][n] = __builtin_amdgcn_mfma_f32_16x16x32_bf16(Bt[n][k], At[m][k], acc[ai][bj][m][n], 0, 0, 0); __builtin_amdgcn_s_setprio(0); } while (0)
#define PG8_WAIT_V(n) asm volatile("s_waitcnt vmcnt(" #n ")" ::: "memory")
#define PG8_WAIT_L(n) asm volatile("s_waitcnt lgkmcnt(" #n ")" ::: "memory")
#define PG8_BAR __builtin_amdgcn_s_barrier()
#define PG8_SCHED __builtin_amdgcn_sched_barrier(0)
#define PG8_GOFFS(u, o) do { _Pragma("unroll") for (int _h = 0; _h < 2; ++_h) _Pragma("unroll") for (int _i = 0; _i < 2; ++_i) { int _r = _h * HALF + gR[_i]; _r = _r < (u).nvalid ? _r : (u).nvalid - 1; \
        const int _tok = (u).lst[_r]; (o)[_h][_i] = (unsigned)_tok * (unsigned)(lda * 2) + (unsigned)gC2[_i]; } } while (0)
    Unit cur, nxt; int ui = 0;
    if (!S.next(0, cur)) return;
    f32x4 acc[2][2][4][2];
#pragma unroll
    for (int a = 0; a < 2; ++a)
#pragma unroll
        for (int b = 0; b < 2; ++b)
#pragma unroll
            for (int m = 0; m < 4; ++m)
#pragma unroll
                for (int n = 0; n < 2; ++n) acc[a][b][m][n] = (f32x4){0.f, 0.f, 0.f, 0.f};
    bf16x8 At[4][2], B0[2][2], B1[2][2];
    const char* cA = cur.A; const char* cB = cur.B;
    if constexpr (GATHER) { PG8_GOFFS(cur, ocA); }
    PG8_STAGE(PG8_SB(0, 0), cB, voffB, 0u); PG8_STAGE(PG8_SB(0, 1), cB, voffB, hstepB); PG8_STAGE(PG8_SA(0, 0), cA, ocA[0], 0u); PG8_STAGE(PG8_SA(0, 1), cA, ocA[1], 0u);
    if (wr == 1) PG8_BAR;
    PG8_WAIT_V(2); PG8_BAR;
    PG8_STAGE(PG8_SB(1, 0), cB, voffB, kstep); PG8_STAGE(PG8_SA(1, 0), cA, ocA[0], kstep); PG8_STAGE(PG8_SB(1, 1), cB, voffB, hstepB + kstep);
    PG8_WAIT_V(6); PG8_BAR;
    for (;;) {
        const bool has_next = S.next(ui + 1, nxt);
        const char* nA = has_next ? nxt.A : cA; const char* nB = has_next ? nxt.B : cB;
        if constexpr (GATHER) {
            if (has_next) { PG8_GOFFS(nxt, onA); }
            else {
#pragma unroll
                for (int h = 0; h < 2; ++h)
#pragma unroll
                    for (int i = 0; i < 2; ++i) onA[h][i] = ocA[h][i]; }
        }
#pragma unroll 1
        for (int t = 0; t < nt; t += 2) {
            const bool last = (t == nt - 2);
            const unsigned k1 = (unsigned)(t + 1) * kstep, k2 = last ? 0u : (unsigned)(t + 2) * kstep, k3 = k2 + kstep;
            const char* a2 = last ? nA : cA; const char* b2 = last ? nB : cB;
            unsigned o2[2][2];
#pragma unroll
            for (int h = 0; h < 2; ++h)
#pragma unroll
                for (int i = 0; i < 2; ++i) o2[h][i] = (GATHER && last) ? onA[h][i] : ocA[h][i];
            PG8_LDB(B0, 0, 0); PG8_LDB(B1, 0, 1); PG8_SCHED; PG8_LDA(At, 0, 0); PG8_STAGE(PG8_SA(1, 1), cA, ocA[1], k1);
            PG8_WAIT_V(8); PG8_WAIT_L(0); PG8_BAR; PG8_MMA(0, 0, At, B0); PG8_MMA(0, 1, At, B1); PG8_BAR; PG8_SCHED;
            PG8_LDA(At, 0, 1); PG8_STAGE(PG8_SB(0, 0), b2, voffB, k2); PG8_STAGE(PG8_SB(0, 1), b2, voffB, hstepB + k2); PG8_STAGE(PG8_SA(0, 0), a2, o2[0], k2);
            PG8_WAIT_V(8); PG8_WAIT_L(0); PG8_BAR; PG8_MMA(1, 0, At, B0); PG8_MMA(1, 1, At, B1); PG8_BAR; PG8_SCHED;
            PG8_LDB(B0, 1, 0); PG8_LDB(B1, 1, 1); PG8_SCHED; PG8_LDA(At, 1, 0); PG8_STAGE(PG8_SA(0, 1), a2, o2[1], k2);
            PG8_WAIT_V(8); PG8_WAIT_L(0); PG8_BAR; PG8_MMA(0, 0, At, B0); PG8_MMA(0, 1, At, B1); PG8_BAR; PG8_SCHED;
            PG8_LDA(At, 1, 1); PG8_STAGE(PG8_SB(1, 0), b2, voffB, k3); PG8_STAGE(PG8_SB(1, 1), b2, voffB, hstepB + k3); PG8_STAGE(PG8_SA(1, 0), a2, o2[0], k3);
            PG8_WAIT_V(8); PG8_WAIT_L(0); PG8_BAR; PG8_MMA(1, 0, At, B0); PG8_MMA(1, 1, At, B1); PG8_BAR; PG8_SCHED;
        }
        if (wr == 0) PG8_BAR;
        E(acc, cur, wr, wc, fr, fq);
        if (!has_next) break;
#pragma unroll
        for (int a = 0; a < 2; ++a)
#pragma unroll
            for (int b = 0; b < 2; ++b)
#pragma unroll
                for (int m = 0; m < 4; ++m)
#pragma unroll
                    for (int n = 0; n < 2; ++n) acc[a][b][m][n] = (f32x4){0.f, 0.f, 0.f, 0.f};
        cur = nxt; cA = nA; cB = nB; ++ui;
        if constexpr (GATHER) {
#pragma unroll
            for (int h = 0; h < 2; ++h)
#pragma unroll
                for (int i = 0; i < 2; ++i) ocA[h][i] = onA[h][i]; }
        if (wr == 1) PG8_BAR;
    }
    PG8_WAIT_V(0);
    PG8_BAR;
#undef PG8_SA
#undef PG8_SB
#undef PG8_STAGE
#undef PG8_LDA
#undef PG8_LDB
#undef PG8_MMA
#undef PG8_WAIT_V
#undef PG8_WAIT_L
#undef PG8_BAR
#undef PG8_SCHED
#undef PG8_GOFFS
}

constexpr int NXCD = 8, WGM = 8;
struct DenseSched {
    const char* A; const char* B; int lda, ldb; int nM, nN, nwg, G, c; int apn_shift, akbytes, bpm_shift; size_t bbatch;
    __device__ __forceinline__ void init(const void* A_, const void* B_, int lda_, int ldb_, int M, int N, int G_, int c_) {
        A = (const char*)A_; B = (const char*)B_; lda = lda_; ldb = ldb_; nM = M / BM; nN = N / BM; nwg = nM * nN; G = G_; c = c_; apn_shift = -1; akbytes = 0; bpm_shift = -1; bbatch = 0; }
    __device__ __forceinline__ bool next(int i, Unit& u) const {
        const long L = (long)i * G + c; if (L >= nwg) return false;
        int wgid = (int)L; { const int q = nwg / NXCD, r = nwg % NXCD, xcd = wgid % NXCD, off = wgid / NXCD; wgid = (xcd < r ? xcd * (q + 1) : r * (q + 1) + (xcd - r) * q) + off; }
        const int nig = WGM * nN, gid = wgid / nig, fm = gid * WGM, gsz = (nM - fm) < WGM ? (nM - fm) : WGM;
        const int pm = fm + ((wgid % nig) % gsz), pn = (wgid % nig) / gsz;
        u.pm = pm; u.pn = pn; u.aux = 0; u.lst = nullptr; u.nvalid = 256;
        u.A = A + (size_t)pm * 256 * lda * 2 + (apn_shift >= 0 ? (size_t)(pn >> apn_shift) * akbytes : (size_t)0);
        u.B = B + (size_t)pn * 256 * ldb * 2 + (bpm_shift >= 0 ? (size_t)(pm >> bpm_shift) * bbatch : (size_t)0);
        return true;
    }
};
struct MoeSched {
    const char* A; const char* B; size_t bexp; int lda, ldb, nN; const int* lists; volatile LAS const int* tab; int G, c; bool gather;
    __device__ __forceinline__ bool next(int i, Unit& u) const {
        int pn, mg;
        if (G == 256) {
            const int x = c & 7, jj = c >> 3, pgs = nN >> 2, mgs = 8 / pgs;
            mg = i * (8 * mgs) + 8 * (x / pgs) + (jj & 7); pn = 4 * (x % pgs) + (jj >> 3);
            if (mg >= tab[32]) return false;
        } else { const int total = tab[32] * nN; const long L = (long)i * G + c; if (L >= total) return false; pn = (int)(L % nN); mg = (int)(L / nN); }
        int e = 0;
#pragma unroll 1
        for (int j = 1; j < 32; ++j) e += (tab[j] <= mg) ? 1 : 0;
        const int mt = mg - tab[e];
        u.pm = mg; u.pn = pn; u.aux = e;
        if (gather) { u.A = A; u.lst = lists + (size_t)e * T + mt * 256; const int rem = tab[48 + e] - mt * 256; u.nvalid = rem < 256 ? rem : 256; }
        else { u.A = A + (size_t)mg * 256 * lda * 2; u.lst = nullptr; u.nvalid = 256; }
        u.B = B + (size_t)e * bexp + (size_t)pn * 256 * ldb * 2;
        return true;
    }
};

#define EPI_ROW(u, ai, m) ((u).pm * 256 + (ai) * 128 + wr * 64 + (m) * 16 + fr)
struct EpiLat {
    static constexpr bool PERM = true;
    bf16_t* LAT; float* SSQ; bf16_t* KR; const float* CS; const float* SN;
    __device__ __forceinline__ void operator()(const f32x4 (&acc)[2][2][4][2], const Unit& u, int wr, int wc, int fr, int fq) const {
        if (u.pn < 4) {
#pragma unroll
            for (int ai = 0; ai < 2; ++ai)
#pragma unroll
                for (int m = 0; m < 4; ++m) { const int row = EPI_ROW(u, ai, m); float ss = 0.f;
#pragma unroll
                    for (int bj = 0; bj < 2; ++bj) { const f32x4 v0 = acc[ai][bj][m][0], v1 = acc[ai][bj][m][1];
                        ss += (v0[0] * v0[0] + v0[1] * v0[1]) + (v0[2] * v0[2] + v0[3] * v0[3]) + (v1[0] * v1[0] + v1[1] * v1[1]) + (v1[2] * v1[2] + v1[3] * v1[3]);
                        *(u32x4*)(LAT + (size_t)row * 1024 + u.pn * 256 + bj * 128 + wc * 32 + 8 * fq) = pack8(v0, v1); }
                    ss += __shfl_xor(ss, 16); ss += __shfl_xor(ss, 32);
                    if (fq == 0) SSQ[(size_t)row * 16 + u.pn * 4 + wc] = ss; }
        } else if (wc == 0) {
#pragma unroll
            for (int ai = 0; ai < 2; ++ai)
#pragma unroll
                for (int m = 0; m < 4; ++m) { const int row = EPI_ROW(u, ai, m);
                    const f32x4 c0 = *(const f32x4*)(CS + (size_t)row * 32 + 8 * fq), c1 = *(const f32x4*)(CS + (size_t)row * 32 + 8 * fq + 4);
                    const f32x4 s0 = *(const f32x4*)(SN + (size_t)row * 32 + 8 * fq), s1 = *(const f32x4*)(SN + (size_t)row * 32 + 8 * fq + 4);
                    const f32x4 a0 = acc[ai][0][m][0], a1 = acc[ai][0][m][1], b0 = acc[ai][1][m][0], b1 = acc[ai][1][m][1];
                    *(u32x4*)(KR + (size_t)row * 64 + 8 * fq) = pack8(a0 * c0 - b0 * s0, a1 * c1 - b1 * s1);
                    *(u32x4*)(KR + (size_t)row * 64 + 32 + 8 * fq) = pack8(b0 * c0 + a0 * s0, b1 * c1 + a1 * s1); }
        }
    }
};
struct EpiQ {
    static constexpr bool PERM = true;
    bf16_t* Q; const float* SSQ; const float* CS; const float* SN;
    __device__ __forceinline__ void operator()(const f32x4 (&acc)[2][2][4][2], const Unit& u, int wr, int wc, int fr, int fq) const {
#pragma unroll
        for (int ai = 0; ai < 2; ++ai)
#pragma unroll
            for (int m = 0; m < 4; ++m) { const int row = EPI_ROW(u, ai, m);
                const f32x4 q0 = *(const f32x4*)(SSQ + (size_t)row * 16), q1 = *(const f32x4*)(SSQ + (size_t)row * 16 + 4), q2 = *(const f32x4*)(SSQ + (size_t)row * 16 + 8);
                const float ss = ((q0[0] + q0[1]) + (q0[2] + q0[3])) + ((q1[0] + q1[1]) + (q1[2] + q1[3])) + ((q2[0] + q2[1]) + (q2[2] + q2[3]));
                const float r = QSCALE / sqrtf(ss * (1.0f / QL) + RMS_EPS);
                if (u.pn < 4) {
#pragma unroll
                    for (int bj = 0; bj < 2; ++bj)
                        *(u32x4*)(Q + (size_t)row * 1536 + (2 * u.pn + bj) * 192 + wc * 32 + 8 * fq) = pack8(acc[ai][bj][m][0] * r, acc[ai][bj][m][1] * r);
                } else {
                    const int head = 4 * (u.pn - 4) + wc;
                    const f32x4 c0 = *(const f32x4*)(CS + (size_t)row * 32 + 8 * fq), c1 = *(const f32x4*)(CS + (size_t)row * 32 + 8 * fq + 4);
                    const f32x4 s0 = *(const f32x4*)(SN + (size_t)row * 32 + 8 * fq), s1 = *(const f32x4*)(SN + (size_t)row * 32 + 8 * fq + 4);
                    const f32x4 a0 = acc[ai][0][m][0] * r, a1 = acc[ai][0][m][1] * r, b0 = acc[ai][1][m][0] * r, b1 = acc[ai][1][m][1] * r;
                    *(u32x4*)(Q + (size_t)row * 1536 + head * 192 + 128 + 8 * fq) = pack8(a0 * c0 - b0 * s0, a1 * c1 - b1 * s1);
                    *(u32x4*)(Q + (size_t)row * 1536 + head * 192 + 160 + 8 * fq) = pack8(b0 * c0 + a0 * s0, b1 * c1 + a1 * s1);
                }
                asm volatile("" ::: "memory"); }
    }
};
struct EpiKV {
    static constexpr bool PERM = true;
    bf16_t* KN; bf16_t* V; const float* SSQ;
    __device__ __forceinline__ void operator()(const f32x4 (&acc)[2][2][4][2], const Unit& u, int wr, int wc, int fr, int fq) const {
#pragma unroll
        for (int ai = 0; ai < 2; ++ai)
#pragma unroll
            for (int m = 0; m < 4; ++m) { const int row = EPI_ROW(u, ai, m);
                const f32x4 q3 = *(const f32x4*)(SSQ + (size_t)row * 16 + 12);
                const float r = 1.0f / sqrtf(((q3[0] + q3[1]) + (q3[2] + q3[3])) * (1.0f / KVL) + RMS_EPS);
                *(u32x4*)(KN + (size_t)row * 1024 + u.pn * 128 + wc * 32 + 8 * fq) = pack8(acc[ai][0][m][0] * r, acc[ai][0][m][1] * r);
                *(u32x4*)(V + (size_t)row * 1024 + u.pn * 128 + wc * 32 + 8 * fq) = pack8(acc[ai][1][m][0] * r, acc[ai][1][m][1] * r); }
    }
};
__device__ __forceinline__ f32x4 bf4_lo(const u32x4 w) { return (f32x4){bf_lo(w.x), bf_hi(w.x), bf_lo(w.y), bf_hi(w.y)}; }
__device__ __forceinline__ f32x4 bf4_hi(const u32x4 w) { return (f32x4){bf_lo(w.z), bf_hi(w.z), bf_lo(w.w), bf_hi(w.w)}; }
struct EpiRes {
    static constexpr bool PERM = true;
    const bf16_t* X; bf16_t* Y;
    __device__ __forceinline__ void operator()(const f32x4 (&acc)[2][2][4][2], const Unit& u, int wr, int wc, int fr, int fq) const {
#pragma unroll
        for (int ai = 0; ai < 2; ++ai)
#pragma unroll
            for (int m = 0; m < 4; ++m) { const size_t off = (size_t)EPI_ROW(u, ai, m) * 1024 + u.pn * 256 + wc * 32 + 8 * fq;
#pragma unroll
                for (int bj = 0; bj < 2; ++bj) { const u32x4 xw = *(const u32x4*)(X + off + bj * 128);
                    *(u32x4*)(Y + off + bj * 128) = pack8(bf4_lo(xw) * ALPHA + acc[ai][bj][m][0], bf4_hi(xw) * ALPHA + acc[ai][bj][m][1]); }
                if (m & 1) asm volatile("" ::: "memory"); }
    }
};
struct EpiGU {
    static constexpr bool PERM = true;
    bf16_t* GG; bf16_t* U;
    __device__ __forceinline__ void operator()(const f32x4 (&acc)[2][2][4][2], const Unit& u, int wr, int wc, int fr, int fq) const {
#pragma unroll
        for (int ai = 0; ai < 2; ++ai)
#pragma unroll
            for (int m = 0; m < 4; ++m) { const int row = EPI_ROW(u, ai, m);
#pragma unroll
                for (int bj = 0; bj < 2; ++bj) { f32x4 v0 = acc[ai][bj][m][0], v1 = acc[ai][bj][m][1];
                    if (u.pn < 4) {
#pragma unroll
                        for (int e = 0; e < 4; ++e) { v0[e] = gelu_tanh(v0[e]); v1[e] = gelu_tanh(v1[e]); }
                        *(u32x4*)(GG + (size_t)row * 1024 + u.pn * 256 + bj * 128 + wc * 32 + 8 * fq) = pack8(v0, v1);
                    } else *(u32x4*)(U + (size_t)row * 1024 + (u.pn - 4) * 256 + bj * 128 + wc * 32 + 8 * fq) = pack8(v0, v1); } }
    }
};
struct EpiAB {
    static constexpr bool PERM = true;
    bf16_t* LA; bf16_t* BB; const bf16_t* UC; const float* BA; const float* BX; const float* SPL;
    __device__ __forceinline__ void operator()(const f32x4 (&acc)[2][2][4][2], const Unit& u, int wr, int wc, int fr, int fq) const {
        const int ch = (u.pn >> 1) * 256 + (u.pn & 1) * 128 + wc * 32 + 8 * fq;
        f32x4 ba[2], bx[2], sp[2];
#pragma unroll
        for (int n = 0; n < 2; ++n) { ba[n] = *(const f32x4*)(BA + ch + 4 * n); bx[n] = *(const f32x4*)(BX + ch + 4 * n); sp[n] = *(const f32x4*)(SPL + ch + 4 * n); }
#pragma unroll
        for (int ai = 0; ai < 2; ++ai)
#pragma unroll
            for (int m = 0; m < 4; ++m) { const size_t off = (size_t)EPI_ROW(u, ai, m) * 1024 + ch;
                const u32x4 uw = *(const u32x4*)(UC + off); f32x4 uv[2] = {bf4_lo(uw), bf4_hi(uw)}, lv[2], bv[2];
#pragma unroll
                for (int n = 0; n < 2; ++n)
#pragma unroll
                    for (int e = 0; e < 4; ++e) { const float r = sigmoidf_(acc[ai][0][m][n][e] + ba[n][e]), ig = sigmoidf_(acc[ai][1][m][n][e] + bx[n][e]);
                        const float la = sp[n][e] * r, x2 = 2.0f * la; lv[n][e] = la * 1.4426950408889634f;
                        const float om = x2 > -0.25f ? -x2 * (1.0f + x2 * (0.5f + x2 * (0.16666667f + x2 * (0.041666668f + x2 * 0.0083333338f)))) : 1.0f - __expf(x2);
                        bv[n][e] = sqrtf(om) * ig * uv[n][e]; }
                *(u32x4*)(LA + off) = pack8(lv[0], lv[1]); *(u32x4*)(BB + off) = pack8(bv[0], bv[1]); asm volatile("" ::: "memory"); }
    }
};
struct EpiUp {
    static constexpr bool PERM = true;
    bf16_t* H; const float* BU;
    __device__ __forceinline__ void operator()(const f32x4 (&acc)[2][2][4][2], const Unit& u, int wr, int wc, int fr, int fq) const {
        const int gc = u.pn * 128 + wc * 32 + 8 * fq; const float* bu = BU + (size_t)u.aux * 2048;
        const f32x4 bg0 = *(const f32x4*)(bu + gc), bg1 = *(const f32x4*)(bu + gc + 4), bp0 = *(const f32x4*)(bu + 1024 + gc), bp1 = *(const f32x4*)(bu + 1024 + gc + 4);
#pragma unroll
        for (int ai = 0; ai < 2; ++ai)
#pragma unroll
            for (int m = 0; m < 4; ++m) { const int row = EPI_ROW(u, ai, m);
                f32x4 y0, y1;
#pragma unroll
                for (int e = 0; e < 4; ++e) {
                    float g = fminf(acc[ai][0][m][0][e] + bg0[e], 7.0f), up = fminf(fmaxf(acc[ai][1][m][0][e] + bp0[e], -7.0f), 7.0f); y0[e] = (up + 1.0f) * (g * sigmoidf_(1.702f * g));
                    g = fminf(acc[ai][0][m][1][e] + bg1[e], 7.0f); up = fminf(fmaxf(acc[ai][1][m][1][e] + bp1[e], -7.0f), 7.0f); y1[e] = (up + 1.0f) * (g * sigmoidf_(1.702f * g)); }
                *(u32x4*)(H + (size_t)row * 1024 + gc) = pack8(y0, y1); }
    }
};
struct EpiDown {
    static constexpr bool PERM = true;
    bf16_t* YS; const float* BD;
    __device__ __forceinline__ void operator()(const f32x4 (&acc)[2][2][4][2], const Unit& u, int wr, int wc, int fr, int fq) const {
        const float* bd = BD + (size_t)u.aux * 1024;
#pragma unroll
        for (int bj = 0; bj < 2; ++bj) { const int col = u.pn * 256 + bj * 128 + wc * 32 + 8 * fq; const f32x4 b0 = *(const f32x4*)(bd + col), b1 = *(const f32x4*)(bd + col + 4);
#pragma unroll
            for (int ai = 0; ai < 2; ++ai)
#pragma unroll
                for (int m = 0; m < 4; ++m) *(u32x4*)(YS + (size_t)EPI_ROW(u, ai, m) * 1024 + col) = pack8(acc[ai][bj][m][0] + b0, acc[ai][bj][m][1] + b1); }
    }
};
struct EpiPle {
    static constexpr bool PERM = true;
    const bf16_t* X2; const bf16_t* PP; float* OUT; bf16_t* XB;
    __device__ __forceinline__ void operator()(const f32x4 (&acc)[2][2][4][2], const Unit& u, int wr, int wc, int fr, int fq) const {
#pragma unroll
        for (int ai = 0; ai < 2; ++ai)
#pragma unroll
            for (int m = 0; m < 4; ++m) { const size_t off = (size_t)EPI_ROW(u, ai, m) * 1024 + u.pn * 256 + wc * 32 + 8 * fq;
#pragma unroll
                for (int bj = 0; bj < 2; ++bj) { const size_t o = off + bj * 128; const u32x4 xw = *(const u32x4*)(X2 + o), pw = *(const u32x4*)(PP + o);
                    const f32x4 a0 = acc[ai][bj][m][0], a1 = acc[ai][bj][m][1], x0 = bf4_lo(xw), x1 = bf4_hi(xw), p0 = bf4_lo(pw), p1 = bf4_hi(pw); f32x4 r0, r1;
#pragma unroll
                    for (int e = 0; e < 4; ++e) { r0[e] = x0[e] + sigmoidf_(a0[e]) * p0[e]; r1[e] = x1[e] + sigmoidf_(a1[e]) * p1[e]; }
                    *(u32x4*)(XB + o) = pack8(r0, r1);
                    if (OUT) { *(f32x4*)(OUT + o) = r0; *(f32x4*)(OUT + o + 4) = r1; } }
                if (m & 1) asm volatile("" ::: "memory"); }
    }
};
struct EpiPP {
    static constexpr bool PERM = true;
    bf16_t* PP;
    __device__ __forceinline__ void operator()(const f32x4 (&acc)[2][2][4][2], const Unit& u, int wr, int wc, int fr, int fq) const {
#pragma unroll
        for (int ai = 0; ai < 2; ++ai)
#pragma unroll
            for (int m = 0; m < 4; ++m)
#pragma unroll
                for (int bj = 0; bj < 2; ++bj) *(u32x4*)(PP + (size_t)EPI_ROW(u, ai, m) * 1024 + u.pn * 256 + bj * 128 + wc * 32 + 8 * fq) = pack8(acc[ai][bj][m][0], acc[ai][bj][m][1]);
    }
};
}

namespace att {
constexpr int NW = 8, QBLK = 32, KVBLK = 64, QB = 256, KPITCH = 384;
constexpr int SHM_V = KVBLK * DV * 2, SHM_K = KVBLK * KPITCH;
constexpr int OFF_V = 0, OFF_K = 2 * SHM_V, OFF_WS = OFF_K + 2 * SHM_K, LDS_BYTES = OFF_WS + NW * 64 * 4;
#define SBAR() __builtin_amdgcn_sched_barrier(0)
__device__ __forceinline__ int k_addr(int row, int chunk) { return row * KPITCH + ((chunk ^ ((row >> 1) & 7)) << 4); }
__device__ __forceinline__ int v_st(int k, int c) { const int kk = (k & ~0xC) | ((k & 4) << 1) | ((k & 8) >> 1); return ((kk >> 3) * 4 + (c >> 5)) * 512 + ((kk & 7) * 32 + (c & 31)) * 2; }
__device__ __forceinline__ int v_rd_base(int lane) { return ((lane & 3) << 3) | (((lane >> 2) & 3) << 6) | (((lane >> 4) & 1) << 5) | (((lane >> 5) & 1) << 8); }
constexpr int v_rd_off(int d0, int ks, int half) { return d0 * 512 + ks * 4096 + half * 2048; }
__device__ __forceinline__ int crow(int r, int hi) { return (r & 3) + 8 * (r >> 2) + 4 * hi; }

template <int KB>
__device__ __forceinline__ void qkt(f32x16& p0, f32x16& p1, const LAS char* K_lds, int r32, int hi, const bf16x8* qr) {
    p0 = f32x16{}; p1 = f32x16{};
    const LAS char* kb[4];
#pragma unroll
    for (int dd = 0; dd < 4; ++dd) kb[dd] = K_lds + KB * SHM_K + r32 * KPITCH + (((2 * dd + hi) ^ ((r32 >> 1) & 7)) << 4);
#pragma unroll
    for (int dg = 0; dg < 3; ++dg) {
#pragma unroll
        for (int dd = 0; dd < 4; ++dd) { const int d0 = dg * 4 + dd; const LAS char* a = kb[dd] + dg * 128;
            const bf16x8 b0 = *(const LAS bf16x8*)a;
            const bf16x8 b1 = *(const LAS bf16x8*)(a + 32 * KPITCH);
            p0 = __builtin_amdgcn_mfma_f32_32x32x16_bf16(b0, qr[d0], p0, 0, 0, 0);
            p1 = __builtin_amdgcn_mfma_f32_32x32x16_bf16(b1, qr[d0], p1, 0, 0, 0); }
        SBAR(); }
}
template <int VB>
__device__ __forceinline__ void pv_tile(f32x16* o, int vb0, bf16x8 pa0, bf16x8 pa1, bf16x8 pa2, bf16x8 pa3) {
#define TRRD(dst, off) asm volatile("ds_read_b64_tr_b16 %0, %1 offset:%2" : "=&v"(dst) : "v"(vb0), "i"(off) : "memory")
#define PV_D0(d0) do { s16x4 l0, l1, l2, l3, h0, h1, h2, h3; constexpr int b_ = OFF_V + VB * SHM_V + v_rd_off(d0, 0, 0); \
        TRRD(l0, b_); TRRD(h0, b_ + 2048); TRRD(l1, b_ + 4096); TRRD(h1, b_ + 6144); TRRD(l2, b_ + 8192); TRRD(h2, b_ + 10240); TRRD(l3, b_ + 12288); TRRD(h3, b_ + 14336); \
        asm volatile("s_waitcnt lgkmcnt(0)" ::: "memory"); SBAR(); \
        o[d0] = __builtin_amdgcn_mfma_f32_32x32x16_bf16(pa0, (bf16x8){l0[0], l0[1], l0[2], l0[3], h0[0], h0[1], h0[2], h0[3]}, o[d0], 0, 0, 0); \
        o[d0] = __builtin_amdgcn_mfma_f32_32x32x16_bf16(pa1, (bf16x8){l1[0], l1[1], l1[2], l1[3], h1[0], h1[1], h1[2], h1[3]}, o[d0], 0, 0, 0); \
        o[d0] = __builtin_amdgcn_mfma_f32_32x32x16_bf16(pa2, (bf16x8){l2[0], l2[1], l2[2], l2[3], h2[0], h2[1], h2[2], h2[3]}, o[d0], 0, 0, 0); \
        o[d0] = __builtin_amdgcn_mfma_f32_32x32x16_bf16(pa3, (bf16x8){l3[0], l3[1], l3[2], l3[3], h3[0], h3[1], h3[2], h3[3]}, o[d0], 0, 0, 0); } while (0)
    PV_D0(0); PV_D0(1); PV_D0(2); PV_D0(3);
#undef PV_D0
#undef TRRD
}
__device__ __forceinline__ void mask_tile(f32x16& p0, f32x16& p1, int dq  ) {
    const float NEG = -__builtin_inff();
#pragma unroll
    for (int r = 0; r < 16; ++r) { const int c = (r & 3) + 8 * (r >> 2);
        if (c > dq) p0[r] = NEG;
        if (c + 32 > dq) p1[r] = NEG; }
}
__device__ __forceinline__ void softmax_tile(f32x16& p0, f32x16& p1, float& m_reg, float& l_reg, float& alpha, bf16x8& pa0, bf16x8& pa1, bf16x8& pa2, bf16x8& pa3) {
    float pmax = p0[0];
#pragma unroll
    for (int r = 1; r < 16; ++r) pmax = fmaxf(pmax, p0[r]);
#pragma unroll
    for (int r = 0; r < 16; ++r) pmax = fmaxf(pmax, p1[r]);
    { auto rr = __builtin_amdgcn_permlane32_swap(__float_as_uint(pmax), __float_as_uint(pmax), false, false); pmax = fmaxf(__uint_as_float(rr[0]), __uint_as_float(rr[1])); }
    const float mn = fmaxf(m_reg, pmax); alpha = __builtin_amdgcn_exp2f(m_reg - mn); m_reg = mn;
    float ps = 0.f;
#pragma unroll
    for (int r = 0; r < 16; ++r) { p0[r] = __builtin_amdgcn_exp2f(p0[r] - mn); ps += p0[r]; }
#pragma unroll
    for (int r = 0; r < 16; ++r) { p1[r] = __builtin_amdgcn_exp2f(p1[r] - mn); ps += p1[r]; }
    { auto rr = __builtin_amdgcn_permlane32_swap(__float_as_uint(ps), __float_as_uint(ps), false, false); ps = __uint_as_float(rr[0]) + __uint_as_float(rr[1]); }
    l_reg = l_reg * alpha + ps;
#define PK4(P, B_, OUT) do { unsigned a0 = cvt_pk_bf16(P[B_+0], P[B_+1]), a1 = cvt_pk_bf16(P[B_+2], P[B_+3]); \
        unsigned b0 = cvt_pk_bf16(P[B_+4], P[B_+5]), b1 = cvt_pk_bf16(P[B_+6], P[B_+7]); \
        auto r0 = __builtin_amdgcn_permlane32_swap(a0, b0, false, false); auto r1 = __builtin_amdgcn_permlane32_swap(a1, b1, false, false); \
        u32x4 w = {r0[0], r1[0], r0[1], r1[1]}; OUT = __builtin_bit_cast(bf16x8, w); } while (0)
    PK4(p0, 0, pa0); PK4(p0, 8, pa1); PK4(p1, 0, pa2); PK4(p1, 8, pa3);
#undef PK4
}

__device__ __forceinline__ void attn_block(int b, int h, int qb, const bf16_t* Q, const bf16_t* KN, const bf16_t* KR, const bf16_t* V, bf16_t* O, LAS char* lds) {
    const int tid = opaque_tid(), wid = __builtin_amdgcn_readfirstlane(tid >> 6), lane = tid & 63, r32 = lane & 31, hi = lane >> 5;
    const size_t row0 = (size_t)b * SEQ;
    const int q0 = qb * QB + wid * QBLK;
    const int NT = (qb + 1) * (QB / KVBLK);
    LAS char* V_lds = lds + OFF_V; LAS char* K_lds = lds + OFF_K;
    LAS float* ws = (LAS float*)(lds + OFF_WS) + wid * 64; LAS float* li_l = ws; LAS float* al_l = ws + 32;
    const int sr = tid >> 4, sc = (tid & 15) * 8, kr_row = tid >> 3, kr_c = tid & 7;
    const int vst0 = v_st(sr, sc), vst1 = v_st(32 + sr, sc), kws = k_addr(sr, tid & 15), kwr = k_addr(kr_row, 16 + kr_c);
    const int vb0 = (int)(uintptr_t)lds + v_rd_base(lane);
    const bf16_t* KNh = KN + row0 * 1024 + h * 128 + sc; const bf16_t* Vh = V + row0 * 1024 + h * 128 + sc; const bf16_t* KRb = KR + row0 * 64 + kr_c * 8;
    bf16x8 st_k0, st_k1, st_kr, st_v0, st_v1;
#define SLOAD(t) do { const size_t k0_ = (size_t)(t) * KVBLK; \
        st_k0 = *(const bf16x8*)(KNh + (k0_ + sr) * 1024); st_k1 = *(const bf16x8*)(KNh + (k0_ + 32 + sr) * 1024); st_kr = *(const bf16x8*)(KRb + (k0_ + kr_row) * 64); \
        st_v0 = *(const bf16x8*)(Vh + (k0_ + sr) * 1024); st_v1 = *(const bf16x8*)(Vh + (k0_ + 32 + sr) * 1024); } while (0)
#define SWRITE(bf) do { *(LAS bf16x8*)(K_lds + (bf) * SHM_K + kws) = st_k0; *(LAS bf16x8*)(K_lds + (bf) * SHM_K + kws + 32 * KPITCH) = st_k1; *(LAS bf16x8*)(K_lds + (bf) * SHM_K + kwr) = st_kr; \
        *(LAS bf16x8*)(V_lds + (bf) * SHM_V + vst0) = st_v0; *(LAS bf16x8*)(V_lds + (bf) * SHM_V + vst1) = st_v1; } while (0)
    SLOAD(0);
    bf16x8 qr[12];
    { const bf16_t* Qw = Q + (row0 + q0 + r32) * 1536 + h * 192 + hi * 8;
#pragma unroll
      for (int d0 = 0; d0 < 12; ++d0) qr[d0] = *(const bf16x8*)(Qw + d0 * 16); }
    float m_reg = -1e30f, l_reg = 0.f; f32x16 o[4] = {};
    f32x16 p0, p1; bf16x8 pa0, pa1, pa2, pa3; float alpha;
    asm volatile("s_waitcnt vmcnt(0)" ::: "memory");
    SWRITE(0);
    __syncthreads();
#define RESC(a) do { if (__any((a) < 1.f)) { if (hi == 0) al_l[r32] = (a); asm volatile("s_waitcnt lgkmcnt(0)" ::: "memory"); \
        _Pragma("unroll") for (int d_ = 0; d_ < 4; ++d_) _Pragma("unroll") for (int r = 0; r < 16; ++r) o[d_][r] *= al_l[crow(r, hi)]; } } while (0)
#define TILE(t, BF) do { const bool more_ = ((t) + 1 < NT); if (more_) SLOAD((t) + 1); SBAR(); \
        qkt<BF>(p0, p1, K_lds, r32, hi, qr); \
        { const int kb_ = (t) * KVBLK; if (kb_ + KVBLK - 1 > q0) mask_tile(p0, p1, q0 + r32 - kb_ - 4 * hi); } \
        softmax_tile(p0, p1, m_reg, l_reg, alpha, pa0, pa1, pa2, pa3); RESC(alpha); SBAR(); \
        pv_tile<BF>(o, vb0, pa0, pa1, pa2, pa3); \
        if (more_) { asm volatile("s_waitcnt vmcnt(0)" ::: "memory"); SWRITE((BF) ^ 1); } \
        __syncthreads(); } while (0)
#pragma unroll 1
    for (int t = 0; t < NT; t += 2) { TILE(t, 0); TILE(t + 1, 1); }
    if (hi == 0) li_l[r32] = l_reg; asm volatile("s_waitcnt lgkmcnt(0)" ::: "memory");
    bf16_t* Ow = O + (row0 + q0) * 1024 + h * 128;
#pragma unroll
    for (int r = 0; r < 16; ++r) { const int orow = crow(r, hi); const float rl = __builtin_amdgcn_rcpf(li_l[orow]);
#pragma unroll
        for (int d0 = 0; d0 < 4; ++d0) { const float v = o[d0][r] * rl; const float vn = __shfl_xor(v, 1);
            if ((r32 & 1) == 0) *(unsigned*)(Ow + (size_t)orow * 1024 + d0 * 32 + r32) = cvt_pk_bf16(v, vn); } }
    __syncthreads();
#undef SLOAD
#undef SWRITE
#undef RESC
#undef TILE
}
#undef SBAR
}

#define XB_TMO      128
#define XB_XCNT(j)  (256  + 64 * (j))
#define XB_XSUB(j)  (1280 + 64 * (j))
#define XB_XGEN(j)  (2304 + 64 * (j))
#define XB_TOP      3328
#define XB_TOPGEN   3392
#define XCD_BAR_WORDS 3456
#define XB_SPIN_CAP (1u << 22)
__device__ __forceinline__ unsigned xb_ld(unsigned* p)              { return __hip_atomic_load(p, __ATOMIC_RELAXED, __HIP_MEMORY_SCOPE_AGENT); }
__device__ __forceinline__ unsigned xb_add(unsigned* p, unsigned v) { return __hip_atomic_fetch_add(p, v, __ATOMIC_RELAXED, __HIP_MEMORY_SCOPE_AGENT); }
__device__ __forceinline__ unsigned xb_xcc_id() { return (unsigned)__builtin_amdgcn_s_getreg((3 << 11) | 20) & 0xFu; }
#define XB_SPIN(cond, bar) do { unsigned _sp = 0; while (cond) { __builtin_amdgcn_s_sleep(1); \
    if ((++_sp & 255u) == 0u) { if (xb_ld(&(bar)[XB_TMO])) break; if (_sp > XB_SPIN_CAP) { atomicAdd(&(bar)[XB_TMO], 1u); break; } } } } while (0)
struct XcdBarrier { unsigned* bar; unsigned x; volatile LAS unsigned* st; };
__device__ __forceinline__ XcdBarrier xcd_barrier_post(unsigned* bar, volatile LAS unsigned* st) {
    XcdBarrier b; b.bar = bar; b.x = xb_xcc_id(); b.st = st;
    if (threadIdx.x == 0) (void)xb_add(&bar[XB_XCNT(b.x)], 1u);
    return b;
}
__device__ __forceinline__ void xcd_barrier_complete(unsigned* bar, unsigned x, unsigned& nloc, unsigned& nx) {
    const unsigned G = gridDim.x * gridDim.y * gridDim.z;
    unsigned sum, cnt, mine, sp = 0u;
    for (;;) {
        sum = 0u; cnt = 0u; mine = 0u;
#pragma unroll
        for (unsigned j = 0; j < 16; ++j) { const unsigned c = xb_ld(&bar[XB_XCNT(j)]); sum += c; cnt += (c > 0u) ? 1u : 0u; mine = (j == x) ? c : mine; }
        if (sum == G) break;
        __builtin_amdgcn_s_sleep(1);
        if ((++sp & 255u) == 0u) { if (xb_ld(&bar[XB_TMO])) break; if (sp > XB_SPIN_CAP) { atomicAdd(&bar[XB_TMO], 1u); break; } }
    }
    nloc = mine > 0u ? mine : 1u; nx = cnt > 0u ? cnt : 1u;
}
__device__ __forceinline__ void xcd_barrier(const XcdBarrier& b) {
    asm volatile("s_waitcnt vmcnt(0)" ::: "memory");
    __syncthreads();
    if (opaque_tid() == 0) {
        unsigned* bar = b.bar; unsigned bx = b.x;
        asm volatile("" : "+s"(bar), "+s"(bx));
        __builtin_amdgcn_s_waitcnt(0);
        unsigned nloc = b.st[0], nx = b.st[1];
        if (nloc == 0u) { xcd_barrier_complete(bar, bx, nloc, nx); b.st[0] = nloc; b.st[1] = nx; }
        const unsigned old = xb_add(&bar[XB_XSUB(bx)], 1u);
        const unsigned gen = old / nloc;
        if (old + 1u == (gen + 1u) * nloc) {
            __builtin_amdgcn_fence(__ATOMIC_RELEASE, "agent");
            asm volatile("s_waitcnt vmcnt(0)" ::: "memory");
            const unsigned og = xb_add(&bar[XB_TOP], 1u);
            const unsigned tg = og / nx;
            if (og + 1u == (tg + 1u) * nx) xb_add(&bar[XB_TOPGEN], 1u);
            else XB_SPIN(xb_ld(&bar[XB_TOPGEN]) == tg, bar);
            __builtin_amdgcn_fence(__ATOMIC_ACQUIRE, "agent");
            xb_add(&bar[XB_XGEN(bx)], 1u);
            asm volatile("s_waitcnt vmcnt(0)" ::: "memory");
        } else {
            XB_SPIN(xb_ld(&bar[XB_XGEN(bx)]) == gen, bar);
            __builtin_amdgcn_fence(__ATOMIC_ACQUIRE, "agent");
            asm volatile("s_waitcnt vmcnt(0)" ::: "memory");
        }
    }
    __syncthreads();
}

struct Args { const void* in[30]; float* out; unsigned char* ws; int ph_lo, ph_hi, li, pad; };
struct Ctx { int tid, lane, wave, vcu, G, bid; LAS unsigned char* lds; volatile LAS int* misc; };
__device__ __forceinline__ Ctx fresh_ctx(const Ctx& c) {
    Ctx r = c; unsigned l = (unsigned)(uintptr_t)c.lds, m = (unsigned)(uintptr_t)c.misc;
    asm volatile("" : "+s"(r.wave), "+s"(r.vcu), "+s"(r.G), "+s"(r.bid), "+s"(l), "+s"(m));
    r.lds = (LAS unsigned char*)(uintptr_t)l; r.misc = (volatile LAS int*)(uintptr_t)m; r.tid = opaque_tid(); r.lane = r.tid & 63; return r; }
typedef const CAS Args* ArgsP;
__device__ __forceinline__ const CAS Args& fresh_args(ArgsP p) { asm volatile("" : "+s"(p)); return *p; }
enum { I_X = 0, I_P, I_POS, I_MLA_WIN, I_MLA_QN, I_MLA_KVN, I_MLA_WUQ, I_MLA_WUKV, I_MLA_WO, I_LRU_WIN, I_LRU_CW, I_LRU_CB, I_LRU_WA, I_LRU_BA, I_LRU_WX, I_LRU_BX, I_LRU_LAM, I_LRU_WOUT,
       I_LN1G, I_LN1B, I_LN2G, I_LN2B, I_MOE_WR, I_MOE_BR, I_MOE_WUP, I_MOE_BUP, I_MOE_WDN, I_MOE_BDN, I_PLE_WG, I_PLE_WP };
#define INF(i) ((const float*)args.in[i])
#define WSP(T_, off) ((T_*)(args.ws + (off)))

__device__ __forceinline__ void tr_item(const float* W, int ld, int k0, int sc0, int sc1, const float* ksc, bf16_t* dst  , int K, LAS float* scr, int lane) {
    const int half = (lane & 15) >> 3, scol = half ? sc1 : sc0, c4 = (lane & 7) * 4, rsub = lane >> 4;
    f32x4 v[16];
#pragma unroll
    for (int i = 0; i < 16; ++i) { const int kk = 4 * i + rsub;
        v[i] = (scol >= 0) ? *(const f32x4*)(W + (size_t)(k0 + kk) * ld + scol + c4) : (f32x4){0.f, 0.f, 0.f, 0.f}; }
    if (ksc) {
#pragma unroll
        for (int i = 0; i < 16; ++i) v[i] = v[i] * ksc[k0 + 4 * i + rsub]; }
#pragma unroll
    for (int i = 0; i < 16; ++i) { LAS float* s = scr + (4 * i + rsub) * 65 + (lane & 15) * 4; s[0] = v[i][0]; s[1] = v[i][1]; s[2] = v[i][2]; s[3] = v[i][3]; }
    asm volatile("s_waitcnt lgkmcnt(0)" ::: "memory");
    const int c = lane & 7;
#pragma unroll
    for (int j = 0; j < 8; ++j) { const int n = (lane >> 3) + 8 * j; const LAS float* s = scr + (8 * c) * 65 + n;
        u32x4 o; o.x = cvt_pk_bf16(s[0 * 65], s[1 * 65]); o.y = cvt_pk_bf16(s[2 * 65], s[3 * 65]); o.z = cvt_pk_bf16(s[4 * 65], s[5 * 65]); o.w = cvt_pk_bf16(s[6 * 65], s[7 * 65]);
        *(u32x4*)(dst + (size_t)n * K + 8 * c) = o; }
    asm volatile("s_waitcnt lgkmcnt(0)" ::: "memory");
}
enum { J_NAT = 0, J_MLA_WIN, J_MLA_WUQ, J_LRU_WAX, J_MOE_UP };
__device__ __forceinline__ int tr_map(int job, int g) {
    switch (job) {
    case J_MLA_WIN: return g < 32 ? 32 * g : (g == 32 ? 1024 : (g == 36 ? 1056 : -1));
    case J_MLA_WUQ: if (g < 32) { const int t = g >> 3, bj = (g >> 2) & 1, cg = g & 3; return (2 * t + bj) * 192 + 32 * cg; }
                    else { const int g2 = g - 32, t2 = g2 >> 3, bj = (g2 >> 2) & 1, hh = g2 & 3; return (4 * t2 + hh) * 192 + 128 + 32 * bj; }
    case J_LRU_WAX: { const int pn = g >> 3, cg = g & 3; return 128 * pn + 32 * cg; }
    case J_MOE_UP:  { const int pn = g >> 3, bj = (g >> 2) & 1, cg = g & 3; return bj * 1024 + 128 * pn + 32 * cg; }
    default: return 32 * g;
    }
}
__device__ __forceinline__ void tr_job(const Ctx& C, int job, const float* src, size_t srcstride, int nmat, int K, int ld, int N, bf16_t* dst, size_t dststride, const float* ksc, int kscstride,
                                       const float* src2  ) {
    LAS float* scr = (LAS float*)(C.lds + C.wave * 16640);
    const int gw = C.vcu * NWAVES + C.wave, NGW = C.G * NWAVES;
    const int nkb = K / 64, nnb = N / 64, per = nkb * nnb, total = per * nmat;
    for (int it = gw; it < total; it += NGW) {
        const int mat = it / per, r = it - mat * per, kb = r / nnb, nb = r - kb * nnb;
        int s0 = tr_map(job, 2 * nb), s1 = tr_map(job, 2 * nb + 1);
        const float* W = src + (size_t)mat * srcstride;
        if (job == J_LRU_WAX && ((nb >> 1) & 1)) W = src2 + (size_t)mat * srcstride;
        tr_item(W, ld, kb * 64, s0, s1, ksc ? ksc + (size_t)mat * kscstride : nullptr, (bf16_t*)((char*)dst + (size_t)mat * dststride) + (size_t)(nb * 64) * K + kb * 64, K, scr, C.lane);
    }
}
__device__ __forceinline__ void cvt_rows(const Ctx& C, const float* src, bf16_t* dst, size_t n8  ) {
    const size_t gt = (size_t)C.vcu * 512 + C.tid, NT = (size_t)C.G * 512;
    for (size_t i = gt; i < n8; i += NT) { const f32x4 a = *(const f32x4*)(src + i * 8), b = *(const f32x4*)(src + i * 8 + 4); *(u32x4*)(dst + i * 8) = pack8(a, b); }
}
__device__ __forceinline__ void phase_prologue(const CAS Args& args, const Ctx& C) {
    tr_job(C, J_MLA_WIN, INF(I_MLA_WIN), (size_t)DM * LATD, 2, DM, LATD, 1280, WSP(bf16_t, WS_W_MLA + OFF_MLA_WIN), W_MLA_STRIDE, nullptr, 0, nullptr);
    tr_job(C, J_MLA_WUQ, INF(I_MLA_WUQ), (size_t)QL * 1536, 2, QL, 1536, 1536, WSP(bf16_t, WS_W_MLA + OFF_MLA_WUQ), W_MLA_STRIDE, INF(I_MLA_QN), QL, nullptr);
    tr_job(C, J_NAT, INF(I_MLA_WUKV), (size_t)KVL * 2048, 2, KVL, 2048, 2048, WSP(bf16_t, WS_W_MLA + OFF_MLA_WUKV), W_MLA_STRIDE, INF(I_MLA_KVN), KVL, nullptr);
    tr_job(C, J_NAT, INF(I_MLA_WO), (size_t)DM * DM, 2, DM, DM, DM, WSP(bf16_t, WS_W_MLA + OFF_MLA_WO), W_MLA_STRIDE, nullptr, 0, nullptr);
    tr_job(C, J_NAT, INF(I_LRU_WIN), (size_t)DM * 2048, 2, DM, 2048, 2048, WSP(bf16_t, WS_W_LRU + OFF_LRU_WIN), W_LRU_STRIDE, nullptr, 0, nullptr);
    for (int j = 0; j < 2; ++j)
        tr_job(C, J_LRU_WAX, INF(I_LRU_WA) + (size_t)j * 4 * 65536, (size_t)256 * 256, 4, 256, 256, 512, WSP(bf16_t, WS_W_LRU + OFF_LRU_WAX + (size_t)j * W_LRU_STRIDE), (size_t)512 * 256 * 2, nullptr, 0, INF(I_LRU_WX) + (size_t)j * 4 * 65536);
    tr_job(C, J_NAT, INF(I_LRU_WOUT), (size_t)DM * DM, 2, DM, DM, DM, WSP(bf16_t, WS_W_LRU + OFF_LRU_WOUT), W_LRU_STRIDE, nullptr, 0, nullptr);
    tr_job(C, J_NAT, INF(I_PLE_WG), (size_t)DM * DM, 4, DM, DM, DM, WSP(bf16_t, WS_W_PLE + OFF_PLE_WG), W_PLE_STRIDE, nullptr, 0, nullptr);
    tr_job(C, J_NAT, INF(I_PLE_WP), (size_t)PLED * DM, 4, PLED, DM, DM, WSP(bf16_t, WS_W_PLE + OFF_PLE_WP), W_PLE_STRIDE, nullptr, 0, nullptr);
    tr_job(C, J_MOE_UP, INF(I_MOE_WUP), (size_t)DM * 2048, DEPTH * NE, DM, 2048, 2048, WSP(bf16_t, WS_W_UP), (size_t)2048 * 1024 * 2, nullptr, 0, nullptr);
    tr_job(C, J_NAT, INF(I_MOE_WDN), (size_t)DFF * DM, DEPTH * NE, DFF, DM, DM, WSP(bf16_t, WS_W_DN), (size_t)1024 * 1024 * 2, nullptr, 0, nullptr);
    cvt_rows(C, INF(I_X), WSP(bf16_t, WS_XB), (size_t)T * DM / 8);
    cvt_rows(C, INF(I_P), WSP(bf16_t, WS_PB), (size_t)DEPTH * T * PLED / 8);
    { const int* pos = (const int*)args.in[I_POS]; float* CS = WSP(float, WS_CS); float* SN = WSP(float, WS_SN);
      const size_t gt = (size_t)C.vcu * 512 + C.tid, NT = (size_t)C.G * 512;
      for (size_t i = gt; i < (size_t)T * 32; i += NT) { const int tok = (int)(i >> 5), j = (int)(i & 31);
          const double inv = exp(-9.210340371976184 * (double)j / 32.0); const double ang = (double)pos[tok] * inv; double s, c; sincos(ang, &s, &c); CS[i] = (float)c; SN[i] = (float)s; }
      float* SPL = WSP(float, WS_SPL); const float* lam = INF(I_LRU_LAM);
      for (size_t i = gt; i < 2 * 1024; i += NT) { const double l = (double)lam[i]; SPL[i] = (float)(-8.0 * log1p(exp(-l))); } }
}

__device__ __forceinline__ void moe_table(const CAS Args& args, const Ctx& C0, int layer) {
    Ctx C = C0; C.tid = opaque_tid(); C.lane = C.tid & 63;
    const unsigned* cnt = WSP(unsigned, WS_CTL) + CW_CNT + 64 * layer;
    __syncthreads();
    if (C.tid < 32) C.misc[64 + C.tid] = (int)__hip_atomic_load(cnt + C.tid, __ATOMIC_RELAXED, __HIP_MEMORY_SCOPE_AGENT);
    __syncthreads();
    if (C.tid == 0) { int acc = 0; for (int e = 0; e < 32; ++e) { C.misc[16 + e] = acc; acc += (C.misc[64 + e] + 255) >> 8; } C.misc[16 + 32] = acc; }
    __syncthreads();
}

__device__ __forceinline__ void phase_ln_router(const CAS Args& args, const Ctx& C0, int layer) {
    const int cslot = layer + args.pad;
    Ctx C = C0; C.tid = opaque_tid(); C.lane = C.tid & 63;
    const bf16_t* Y = WSP(bf16_t, WS_Y); float* X1 = WSP(float, WS_X1); bf16_t* X1B = WSP(bf16_t, WS_X1B);
    const float* g1 = INF(I_LN1G) + layer * DM; const float* b1 = INF(I_LN1B) + layer * DM;
    const CAS float* Wr = (const CAS float*)(INF(I_MOE_WR) + (size_t)layer * DM * NE); const float* br = INF(I_MOE_BR) + layer * NE;
    unsigned* gcnt = WSP(unsigned, WS_CTL) + CW_CNT + 64 * cslot;
    int* lists = WSP(int, WS_LIST); int* slot = WSP(int, WS_SLOT); float* gate = WSP(float, WS_GATE);
    LAS float* part = (LAS float*)C.lds;
    volatile LAS int* lcnt = (volatile LAS int*)(C.lds + 69632);
    volatile LAS int* lbase = lcnt + 32;
    f32x4 gv[4], bv[4];
#pragma unroll
    for (int j = 0; j < 2; ++j) { gv[2 * j] = *(const f32x4*)(g1 + 8 * C.lane + 512 * j); gv[2 * j + 1] = *(const f32x4*)(g1 + 8 * C.lane + 512 * j + 4);
        bv[2 * j] = *(const f32x4*)(b1 + 8 * C.lane + 512 * j); bv[2 * j + 1] = *(const f32x4*)(b1 + 8 * C.lane + 512 * j + 4); }
    for (int chunk = C.vcu; chunk < T / 128; chunk += C.G) {
        const int row0 = chunk * 128;
        if (C.tid < 32) lcnt[C.tid] = 0;
#pragma unroll 1
        for (int i = 0; i < 16; ++i) { const size_t row = (size_t)row0 + C.wave * 16 + i;
            f32x4 v[4]; float s = 0.f;
#pragma unroll
            for (int j = 0; j < 2; ++j) { const u32x4 w = *(const u32x4*)(Y + row * DM + 8 * C.lane + 512 * j); v[2 * j] = pg8::bf4_lo(w); v[2 * j + 1] = pg8::bf4_hi(w); }
#pragma unroll
            for (int j = 0; j < 4; ++j) s += (v[j][0] + v[j][1]) + (v[j][2] + v[j][3]);
            const float mean = wave_sum(s) * (1.f / DM); float s2 = 0.f;
#pragma unroll
            for (int j = 0; j < 4; ++j) { v[j] = v[j] - mean; s2 += (v[j][0] * v[j][0] + v[j][1] * v[j][1]) + (v[j][2] * v[j][2] + v[j][3] * v[j][3]); }
            const float rstd = 1.f / sqrtf(wave_sum(s2) * (1.f / DM) + LN_EPS);
#pragma unroll
            for (int j = 0; j < 4; ++j) v[j] = v[j] * rstd * gv[j] + bv[j];
#pragma unroll
            for (int j = 0; j < 2; ++j) { float* xo = X1 + row * DM + 8 * C.lane + 512 * j; *(f32x4*)xo = v[2 * j]; *(f32x4*)(xo + 4) = v[2 * j + 1];
                *(u32x4*)(X1B + row * DM + 8 * C.lane + 512 * j) = pack8(v[2 * j], v[2 * j + 1]); } }
        asm volatile("s_waitcnt vmcnt(0)" ::: "memory");
        __syncthreads();
        { const int grp = C.wave >> 2, kq = C.wave & 3; const size_t tok = (size_t)row0 + grp * 64 + C.lane;
          float acc[32];
#pragma unroll
          for (int e = 0; e < 32; ++e) acc[e] = 0.f;
          const float* xr = X1 + tok * DM + kq * 256;
          for (int kk = 0; kk < 64; ++kk) { const f32x4 xv = *(const f32x4*)(xr + kk * 4);
#pragma unroll
              for (int i = 0; i < 4; ++i) { const CAS float* wrow = Wr + (size_t)(kq * 256 + kk * 4 + i) * NE;
#pragma unroll
                  for (int e = 0; e < 32; ++e) acc[e] = fmaf(xv[i], wrow[e], acc[e]);
                  if (i & 1) __builtin_amdgcn_sched_barrier(0); } }
          LAS float* pp = part + ((grp * 4 + kq) * 64 + C.lane) * 33;
#pragma unroll
          for (int e = 0; e < 32; ++e) pp[e] = acc[e]; }
        __syncthreads();
        int te[4] = {0, 0, 0, 0}, lp[4] = {0, 0, 0, 0}; float tg[4] = {0.f, 0.f, 0.f, 0.f};
        if (C.tid < 128) { const int grp = C.tid >> 6, ln = C.tid & 63; float lg[32];
#pragma unroll
            for (int e = 0; e < 32; ++e) { float s = br[e];
#pragma unroll
                for (int kq = 0; kq < 4; ++kq) s += part[((grp * 4 + kq) * 64 + ln) * 33 + e];
                lg[e] = s; }
            float tv[4];
#pragma unroll
            for (int k = 0; k < 4; ++k) { float best = lg[0]; int bi = 0;
#pragma unroll
                for (int e = 1; e < 32; ++e) { const bool gt = lg[e] > best; best = gt ? lg[e] : best; bi = gt ? e : bi; }
                te[k] = bi; tv[k] = best;
#pragma unroll
                for (int e = 0; e < 32; ++e) lg[e] = (e == bi) ? -__builtin_inff() : lg[e]; }
            float den = 0.f;
#pragma unroll
            for (int k = 0; k < 4; ++k) { tg[k] = __expf(tv[k] - tv[0]); den += tg[k]; }
            const float rden = 1.0f / den;
#pragma unroll
            for (int k = 0; k < 4; ++k) { tg[k] *= rden; lp[k] = __hip_atomic_fetch_add((LAS int*)&lcnt[te[k]], 1, __ATOMIC_RELAXED, __HIP_MEMORY_SCOPE_WORKGROUP); } }
        __syncthreads();
        if (C.tid < 32) lbase[C.tid] = (int)__hip_atomic_fetch_add(gcnt + C.tid, (unsigned)lcnt[C.tid], __ATOMIC_RELAXED, __HIP_MEMORY_SCOPE_AGENT);
        __syncthreads();
        if (C.tid < 128) { const int tok = row0 + C.tid;
#pragma unroll
            for (int k = 0; k < 4; ++k) { const int pos = lbase[te[k]] + lp[k]; lists[(size_t)te[k] * T + pos] = tok; slot[tok * 4 + k] = te[k] * T + pos; gate[tok * 4 + k] = tg[k]; } }
        __syncthreads();
    }
}

__device__ __forceinline__ void phase_combine_ln2(const CAS Args& args, const Ctx& C0, int layer) {
    Ctx C = C0; C.tid = opaque_tid(); C.lane = C.tid & 63;
    moe_table(args, C, layer);
    const bf16_t* X1B = WSP(bf16_t, WS_X1B); const bf16_t* YS = WSP(bf16_t, WS_YS); const int* slot = WSP(int, WS_SLOT); const float* gate = WSP(float, WS_GATE);
    bf16_t* X2B = WSP(bf16_t, WS_X2B);
    const float* g2 = INF(I_LN2G) + layer * DM; const float* b2 = INF(I_LN2B) + layer * DM;
    f32x4 gv[4], bv[4];
#pragma unroll
    for (int j = 0; j < 2; ++j) { gv[2 * j] = *(const f32x4*)(g2 + 8 * C.lane + 512 * j); gv[2 * j + 1] = *(const f32x4*)(g2 + 8 * C.lane + 512 * j + 4);
        bv[2 * j] = *(const f32x4*)(b2 + 8 * C.lane + 512 * j); bv[2 * j + 1] = *(const f32x4*)(b2 + 8 * C.lane + 512 * j + 4); }
    const int gw = C.vcu * NWAVES + C.wave, NGW = C.G * NWAVES;
    for (int row = gw; row < T; row += NGW) {
        f32x4 v[4];
#pragma unroll
        for (int j = 0; j < 2; ++j) { const u32x4 w = *(const u32x4*)(X1B + (size_t)row * DM + 8 * C.lane + 512 * j); v[2 * j] = pg8::bf4_lo(w) * ALPHA; v[2 * j + 1] = pg8::bf4_hi(w) * ALPHA; }
#pragma unroll
        for (int k = 0; k < 4; ++k) { const int sv = slot[row * 4 + k]; const float g = gate[row * 4 + k]; const int e = sv >> 15, pos = sv & (T - 1);
            const size_t prow = (size_t)C.misc[16 + e] * 256 + pos;
#pragma unroll
            for (int j = 0; j < 2; ++j) { const u32x4 w = *(const u32x4*)(YS + prow * DM + 8 * C.lane + 512 * j); v[2 * j] += pg8::bf4_lo(w) * g; v[2 * j + 1] += pg8::bf4_hi(w) * g; } }
        float s = 0.f;
#pragma unroll
        for (int j = 0; j < 4; ++j) s += (v[j][0] + v[j][1]) + (v[j][2] + v[j][3]);
        const float mean = wave_sum(s) * (1.f / DM); float s2 = 0.f;
#pragma unroll
        for (int j = 0; j < 4; ++j) { v[j] = v[j] - mean; s2 += (v[j][0] * v[j][0] + v[j][1] * v[j][1]) + (v[j][2] * v[j][2] + v[j][3] * v[j][3]); }
        const float rstd = 1.f / sqrtf(wave_sum(s2) * (1.f / DM) + LN_EPS);
#pragma unroll
        for (int j = 0; j < 4; ++j) v[j] = v[j] * rstd * gv[j] + bv[j];
#pragma unroll
        for (int j = 0; j < 2; ++j) *(u32x4*)(X2B + (size_t)row * DM + 8 * C.lane + 512 * j) = pack8(v[2 * j], v[2 * j + 1]);
    }
}

__device__ __forceinline__ void phase_conv(const CAS Args& args, const Ctx& C0, int j) {
    Ctx C = C0; C.tid = opaque_tid(); C.lane = C.tid & 63;
    const bf16_t* U = WSP(bf16_t, WS_U); bf16_t* UC = WSP(bf16_t, WS_UC);
    const float* cw = INF(I_LRU_CW) + (size_t)j * 4 * DM; const float* cb = INF(I_LRU_CB) + (size_t)j * DM;
    const int c8 = (C.tid & 127) * 8, rsub = C.tid >> 7;
    float w[4][8], bb[8];
#pragma unroll
    for (int q = 0; q < 4; ++q)
#pragma unroll
        for (int e = 0; e < 8; ++e) w[q][e] = cw[q * DM + c8 + e];
#pragma unroll
    for (int e = 0; e < 8; ++e) bb[e] = cb[c8 + e];
    for (int chunk = C.vcu; chunk < T / 128; chunk += C.G) {
        const int r0 = chunk * 128 + rsub * 32;
        u32x4 h0, h1, h2;
        const u32x4 z = {0u, 0u, 0u, 0u};
        const int s0 = r0 & (SEQ - 1);
        h0 = s0 >= 3 ? *(const u32x4*)(U + (size_t)(r0 - 3) * DM + c8) : z; h1 = s0 >= 2 ? *(const u32x4*)(U + (size_t)(r0 - 2) * DM + c8) : z; h2 = s0 >= 1 ? *(const u32x4*)(U + (size_t)(r0 - 1) * DM + c8) : z;
#pragma unroll 4
        for (int i = 0; i < 32; ++i) { const u32x4 h3 = *(const u32x4*)(U + (size_t)(r0 + i) * DM + c8);
            float o[8];
#pragma unroll
            for (int q = 0; q < 4; ++q) { const unsigned a = h0[q], b = h1[q], c = h2[q], d = h3[q];
                o[2 * q] = bb[2 * q] + w[0][2 * q] * bf_lo(a) + w[1][2 * q] * bf_lo(b) + w[2][2 * q] * bf_lo(c) + w[3][2 * q] * bf_lo(d);
                o[2 * q + 1] = bb[2 * q + 1] + w[0][2 * q + 1] * bf_hi(a) + w[1][2 * q + 1] * bf_hi(b) + w[2][2 * q + 1] * bf_hi(c) + w[3][2 * q + 1] * bf_hi(d); }
            u32x4 ow; ow.x = cvt_pk_bf16(o[0], o[1]); ow.y = cvt_pk_bf16(o[2], o[3]); ow.z = cvt_pk_bf16(o[4], o[5]); ow.w = cvt_pk_bf16(o[6], o[7]);
            *(u32x4*)(UC + (size_t)(r0 + i) * DM + c8) = ow; h0 = h1; h1 = h2; h2 = h3; }
    }
}
__device__ __forceinline__ void phase_scan1(const CAS Args& args, const Ctx& C0) {
    Ctx C = C0; C.tid = opaque_tid(); C.lane = C.tid & 63;
    const bf16_t* LA = WSP(bf16_t, WS_AA); const bf16_t* BB = WSP(bf16_t, WS_BB); float* CA = WSP(float, WS_CA); float* CH = WSP(float, WS_CH);
    const int c2 = C.tid * 2;
    for (int item = C.vcu; item < NBATCH * 64; item += C.G) {
        const size_t r0 = (size_t)item * 64; float h0 = 0.f, h1 = 0.f, l0 = 0.f, l1 = 0.f;
#pragma unroll 8
        for (int s = 0; s < 64; ++s) { const unsigned aw = *(const unsigned*)(LA + (r0 + s) * DM + c2), bw = *(const unsigned*)(BB + (r0 + s) * DM + c2);
            const float la0 = bf_lo(aw), la1 = bf_hi(aw);
            h0 = __builtin_amdgcn_exp2f(la0) * h0 + bf_lo(bw); h1 = __builtin_amdgcn_exp2f(la1) * h1 + bf_hi(bw); l0 += la0; l1 += la1; }
        *(f32x2*)(CA + (size_t)item * DM + c2) = (f32x2){__builtin_amdgcn_exp2f(l0), __builtin_amdgcn_exp2f(l1)}; *(f32x2*)(CH + (size_t)item * DM + c2) = (f32x2){h0, h1};
    }
}
__device__ __forceinline__ void phase_scan2(const CAS Args& args, const Ctx& C0) {
    Ctx C = C0; C.tid = opaque_tid(); C.lane = C.tid & 63;
    const bf16_t* LA = WSP(bf16_t, WS_AA); const bf16_t* BB = WSP(bf16_t, WS_BB); const float* CA = WSP(float, WS_CA); const float* CH = WSP(float, WS_CH);
    const bf16_t* GG = WSP(bf16_t, WS_GG); bf16_t* YL = WSP(bf16_t, WS_O);
    const int c2 = C.tid * 2;
    for (int item = C.vcu; item < NBATCH * 64; item += C.G) {
        const int b = item >> 6, ch = item & 63; float h0 = 0.f, h1 = 0.f;
        for (int jx = 0; jx < ch; ++jx) { const f32x2 a = *(const f32x2*)(CA + (size_t)(b * 64 + jx) * DM + c2), e = *(const f32x2*)(CH + (size_t)(b * 64 + jx) * DM + c2);
            h0 = a[0] * h0 + e[0]; h1 = a[1] * h1 + e[1]; }
        const size_t r0 = (size_t)item * 64;
#pragma unroll 8
        for (int s = 0; s < 64; ++s) { const unsigned aw = *(const unsigned*)(LA + (r0 + s) * DM + c2), bw = *(const unsigned*)(BB + (r0 + s) * DM + c2), g = *(const unsigned*)(GG + (r0 + s) * DM + c2);
            h0 = __builtin_amdgcn_exp2f(bf_lo(aw)) * h0 + bf_lo(bw); h1 = __builtin_amdgcn_exp2f(bf_hi(aw)) * h1 + bf_hi(bw);
            *(unsigned*)(YL + (r0 + s) * DM + c2) = cvt_pk_bf16(bf_lo(g) * h0, bf_hi(g) * h1); }
    }
}

constexpr int PH_PER_LAYER = 12, PH_TOTAL = 2 + PH_PER_LAYER * DEPTH;
__global__ void __launch_bounds__(NWAVES * 64, 2) fwd_kernel(Args args_kernarg) {
    (void)args_kernarg;
    ArgsP const argp = (ArgsP)__builtin_amdgcn_kernarg_segment_ptr();
    const CAS Args& args0 = *argp;
    extern __shared__ __attribute__((aligned(16))) unsigned char lds_raw[];
    Ctx C_;
    C_.lds = (LAS unsigned char*)lds_raw; C_.misc = (volatile LAS int*)(C_.lds + MISC_OFF);
    C_.tid = threadIdx.x; C_.lane = C_.tid & 63; C_.wave = __builtin_amdgcn_readfirstlane(C_.tid >> 6);
    C_.bid = (int)blockIdx.x; C_.G = gridDim.x; { const int bx = blockIdx.x; C_.vcu = (C_.G % 8 == 0) ? (bx % 8) * (C_.G / 8) + bx / 8 : bx; }
    for (int u = C_.tid; u < 128; u += NWAVES * 64) C_.misc[u] = 0;
    __syncthreads();
    XcdBarrier bar = xcd_barrier_post((unsigned*)(args0.ws + WS_CTL) + CW_BAR + args0.li * XCD_BAR_WORDS, (volatile LAS unsigned*)C_.misc);
    const int lo = args0.ph_lo, hi = args0.ph_hi;
#define IN(k) (lo <= (k) && (k) < hi)
#define PH_END(k) do { if ((k) + 1 < hi) xcd_barrier(bar); } while (0)

    if (SEL(0) && IN(0)) { const CAS Args& args = fresh_args(argp); const Ctx C = fresh_ctx(C_); const int cid = C.bid; phase_prologue(args, C); PH_END(0); }
    if (SEL(1) && IN(1)) { const CAS Args& args = fresh_args(argp); const Ctx C = fresh_ctx(C_); const int cid = C.bid;
        pg8::DenseSched S; S.init(WSP(bf16_t, WS_PB), WSP(bf16_t, WS_W_PLE + OFF_PLE_WP), PLED, PLED, DEPTH * T, DM, C.G, cid); S.bpm_shift = 7; S.bbatch = W_PLE_STRIDE;
        pg8::EpiPP E{WSP(bf16_t, WS_PP)};
        pg8::gemm_phase<pg8::EpiPP, pg8::DenseSched, false>(C.lds, PLED, PLED, PLED, S, E);
        PH_END(1);
    }
    for (int layer = 0; layer < DEPTH; ++layer) {
        const int base = 2 + PH_PER_LAYER * layer, j = layer >> 1;
        if ((layer & 1) == 0) {
            if (SEL(2) && IN(base + 0)) { const CAS Args& args = fresh_args(argp); const Ctx C = fresh_ctx(C_); const int cid = C.bid; const unsigned char* wm = args.ws + WS_W_MLA + (size_t)j * W_MLA_STRIDE;
                pg8::DenseSched S; S.init(WSP(bf16_t, WS_XB), wm + OFF_MLA_WIN, DM, DM, T, 1280, C.G, cid);
                pg8::EpiLat E{WSP(bf16_t, WS_LAT), WSP(float, WS_SSQ), WSP(bf16_t, WS_KR), WSP(float, WS_CS), WSP(float, WS_SN)};
                pg8::gemm_phase<pg8::EpiLat, pg8::DenseSched, false>(C.lds, DM, DM, DM, S, E);
                PH_END(base + 0);
            }
            if (SEL(3) && IN(base + 1)) { const CAS Args& args = fresh_args(argp); const Ctx C = fresh_ctx(C_); const int cid = C.bid; const unsigned char* wm = args.ws + WS_W_MLA + (size_t)j * W_MLA_STRIDE;
                { pg8::DenseSched S; S.init(WSP(bf16_t, WS_LAT), wm + OFF_MLA_WUQ, DM, QL, T, 1536, C.G, cid);
                  pg8::EpiQ E{WSP(bf16_t, WS_Q), WSP(float, WS_SSQ), WSP(float, WS_CS), WSP(float, WS_SN)};
                  pg8::gemm_phase<pg8::EpiQ, pg8::DenseSched, false>(C.lds, QL, DM, QL, S, E); }
                { pg8::DenseSched S; S.init(WSP(bf16_t, WS_LAT) + QL, wm + OFF_MLA_WUKV, DM, KVL, T, 2048, C.G, cid);
                  pg8::EpiKV E{WSP(bf16_t, WS_KN), WSP(bf16_t, WS_V), WSP(float, WS_SSQ)};
                  pg8::gemm_phase<pg8::EpiKV, pg8::DenseSched, false>(C.lds, KVL, DM, KVL, S, E); }
                PH_END(base + 1);
            }
            if (SEL(4) && IN(base + 2)) { const CAS Args& args = fresh_args(argp); const Ctx C = fresh_ctx(C_); const int cid = C.bid;
                for (int it = C.vcu; it < NBATCH * NH * 8; it += C.G) { const int bh = it >> 3, pr = it & 7;
                    att::attn_block(bh >> 3, bh & 7, pr, WSP(bf16_t, WS_Q), WSP(bf16_t, WS_KN), WSP(bf16_t, WS_KR), WSP(bf16_t, WS_V), WSP(bf16_t, WS_O), (LAS char*)C.lds);
                    att::attn_block(bh >> 3, bh & 7, 15 - pr, WSP(bf16_t, WS_Q), WSP(bf16_t, WS_KN), WSP(bf16_t, WS_KR), WSP(bf16_t, WS_V), WSP(bf16_t, WS_O), (LAS char*)C.lds); }
                PH_END(base + 2);
            }
        } else {
            if (SEL(5) && IN(base + 0)) { const CAS Args& args = fresh_args(argp); const Ctx C = fresh_ctx(C_); const int cid = C.bid; const unsigned char* wl = args.ws + WS_W_LRU + (size_t)j * W_LRU_STRIDE;
                pg8::DenseSched S; S.init(WSP(bf16_t, WS_XB), wl + OFF_LRU_WIN, DM, DM, T, 2048, C.G, cid);
                pg8::EpiGU E{WSP(bf16_t, WS_GG), WSP(bf16_t, WS_U)};
                pg8::gemm_phase<pg8::EpiGU, pg8::DenseSched, false>(C.lds, DM, DM, DM, S, E);
                PH_END(base + 0);
            }
            if (SEL(6) && IN(base + 1)) { const CAS Args& args = fresh_args(argp); const Ctx C = fresh_ctx(C_); const int cid = C.bid; phase_conv(args, C, j); PH_END(base + 1); }
            if (SEL(7) && IN(base + 2)) { const CAS Args& args = fresh_args(argp); const Ctx C = fresh_ctx(C_); const int cid = C.bid; const unsigned char* wl = args.ws + WS_W_LRU + (size_t)j * W_LRU_STRIDE;
                pg8::DenseSched S; S.init(WSP(bf16_t, WS_UC), wl + OFF_LRU_WAX, DM, 256, T, 2048, C.G, cid); S.apn_shift = 1; S.akbytes = 512;
                pg8::EpiAB E{WSP(bf16_t, WS_AA), WSP(bf16_t, WS_BB), WSP(bf16_t, WS_UC), INF(I_LRU_BA) + j * DM, INF(I_LRU_BX) + j * DM, WSP(float, WS_SPL) + j * DM};
                pg8::gemm_phase<pg8::EpiAB, pg8::DenseSched, false>(C.lds, 256, DM, 256, S, E);
                PH_END(base + 2);
            }
            if (SEL(8) && IN(base + 3)) { const CAS Args& args = fresh_args(argp); const Ctx C = fresh_ctx(C_); const int cid = C.bid; phase_scan1(args, C); PH_END(base + 3); }
            if (SEL(9) && IN(base + 4)) { const CAS Args& args = fresh_args(argp); const Ctx C = fresh_ctx(C_); const int cid = C.bid; phase_scan2(args, C); PH_END(base + 4); }
        }
        if (SEL(10) && IN(base + 5)) { const CAS Args& args = fresh_args(argp); const Ctx C = fresh_ctx(C_); const int cid = C.bid;
            const unsigned char* wo = (layer & 1) ? args.ws + WS_W_LRU + (size_t)j * W_LRU_STRIDE + OFF_LRU_WOUT : args.ws + WS_W_MLA + (size_t)j * W_MLA_STRIDE + OFF_MLA_WO;
            pg8::DenseSched S; S.init(WSP(bf16_t, WS_O), wo, DM, DM, T, DM, C.G, cid);
            pg8::EpiRes E{WSP(bf16_t, WS_XB), WSP(bf16_t, WS_Y)};
            pg8::gemm_phase<pg8::EpiRes, pg8::DenseSched, false>(C.lds, DM, DM, DM, S, E);
            PH_END(base + 5);
        }
        if (SEL(11) && IN(base + 6)) { const CAS Args& args = fresh_args(argp); const Ctx C = fresh_ctx(C_); const int cid = C.bid; phase_ln_router(args, C, layer); PH_END(base + 6); }
        if (SEL(12) && IN(base + 7)) { const CAS Args& args = fresh_args(argp); const Ctx C = fresh_ctx(C_); const int cid = C.bid;
            moe_table(args, C, layer);
            pg8::MoeSched S{(const char*)WSP(bf16_t, WS_X1B), (const char*)(args.ws + WS_W_UP + (size_t)layer * NE * 2048 * 1024 * 2), (size_t)2048 * 1024 * 2, DM, DM, 8, WSP(int, WS_LIST), C.misc + 16, C.G, cid, true};
            pg8::EpiUp E{WSP(bf16_t, WS_H), INF(I_MOE_BUP) + (size_t)layer * NE * 2048};
            pg8::gemm_phase<pg8::EpiUp, pg8::MoeSched, true>(C.lds, DM, DM, DM, S, E);
            PH_END(base + 7);
        }
        if (SEL(13) && IN(base + 8)) { const CAS Args& args = fresh_args(argp); const Ctx C = fresh_ctx(C_); const int cid = C.bid;
            moe_table(args, C, layer);
            pg8::MoeSched S{(const char*)WSP(bf16_t, WS_H), (const char*)(args.ws + WS_W_DN + (size_t)layer * NE * 1024 * 1024 * 2), (size_t)1024 * 1024 * 2, DFF, DFF, 4, WSP(int, WS_LIST), C.misc + 16, C.G, cid, false};
            pg8::EpiDown E{WSP(bf16_t, WS_YS), INF(I_MOE_BDN) + (size_t)layer * NE * DM};
            pg8::gemm_phase<pg8::EpiDown, pg8::MoeSched, false>(C.lds, DFF, DFF, DFF, S, E);
            PH_END(base + 8);
        }
        if (SEL(14) && IN(base + 9)) { const CAS Args& args = fresh_args(argp); const Ctx C = fresh_ctx(C_); const int cid = C.bid; phase_combine_ln2(args, C, layer); PH_END(base + 9); }
        if (SEL(15) && IN(base + 10)) { const CAS Args& args = fresh_args(argp); const Ctx C = fresh_ctx(C_); const int cid = C.bid;
            pg8::DenseSched S; S.init(WSP(bf16_t, WS_X2B), args.ws + WS_W_PLE + (size_t)layer * W_PLE_STRIDE + OFF_PLE_WG, DM, DM, T, DM, C.G, cid);
            pg8::EpiPle E{WSP(bf16_t, WS_X2B), WSP(bf16_t, WS_PP) + (size_t)layer * T * DM, layer == DEPTH - 1 ? args.out : (float*)nullptr, WSP(bf16_t, WS_XB)};
            pg8::gemm_phase<pg8::EpiPle, pg8::DenseSched, false>(C.lds, DM, DM, DM, S, E);
            if (layer + 1 < DEPTH) PH_END(base + 10);
        }
    }
#undef IN
#undef PH_END
}

extern "C" void kernel_launch(void* const* d_in, const int* in_sizes, int n_in, void* d_out, int out_size, void* d_ws, size_t ws_size, hipStream_t stream) {
    static int grid = 0;
    if (grid == 0) {
        if (n_in != 30 || in_sizes[0] != T * DM || out_size != T * DM || ws_size < WS_END) { fprintf(stderr, "kernel_launch: unexpected shapes (n_in %d, in0 %d, out %d, ws %zu)\n", n_in, n_in > 0 ? in_sizes[0] : -1, out_size, ws_size); grid = -1; return; }
        int dev = 0, cus = 0, per_cu = 0;
        if (hipGetDevice(&dev) != hipSuccess || hipDeviceGetAttribute(&cus, hipDeviceAttributeMultiprocessorCount, dev) != hipSuccess) { grid = -1; return; }
        if (hipFuncSetAttribute((const void*)fwd_kernel, hipFuncAttributeMaxDynamicSharedMemorySize, LDS_BYTES) != hipSuccess) { fprintf(stderr, "kernel_launch: hipFuncSetAttribute failed\n"); grid = -1; return; }
        if (hipOccupancyMaxActiveBlocksPerMultiprocessor(&per_cu, (const void*)fwd_kernel, NWAVES * 64, LDS_BYTES) != hipSuccess || per_cu < 1) fprintf(stderr, "kernel_launch: occupancy query reports %d\n", per_cu);
        (void)hipGetLastError();
        grid = cus;
    }
    if (grid < 0) return;
    if (hipMemsetAsync((char*)d_ws + WS_CTL, 0, CTL_ZERO_BYTES, stream) != hipSuccess) return;
    Args a{};
    for (int i = 0; i < 30; ++i) a.in[i] = d_in[i];
    a.out = (float*)d_out; a.ws = (unsigned char*)d_ws; a.pad = 0;
#if MK_ONE_LAUNCH
    a.ph_lo = 0; a.ph_hi = PH_TOTAL; a.li = 0;
    hipLaunchKernelGGL(fwd_kernel, dim3(grid), dim3(NWAVES * 64), LDS_BYTES, stream, a);
#else
    int li = 0;
    for (int ph = 0; ph < PH_TOTAL; ++ph) {
        if (ph >= 2) { const int l = (ph - 2) / PH_PER_LAYER, k = (ph - 2) % PH_PER_LAYER; if (k == 11) continue; if ((l & 1) == 0 && (k == 3 || k == 4)) continue; }
        int site = ph;
        if (ph >= 2) { const int l = (ph - 2) / PH_PER_LAYER, k = (ph - 2) % PH_PER_LAYER; static const int mla[11] = {2, 3, 4, -1, -1, 10, 11, 12, 13, 14, 15}, lru[11] = {5, 6, 7, 8, 9, 10, 11, 12, 13, 14, 15}; site = (l & 1) ? lru[k] : mla[k]; }
        a.ph_lo = ph; a.ph_hi = ph + 1;
        if ((HOSTDUP >> site) & 1) { a.li = li++; a.pad = 4; hipLaunchKernelGGL(fwd_kernel, dim3(grid), dim3(NWAVES * 64), LDS_BYTES, stream, a); }
        a.li = li++; a.pad = 0;
        hipLaunchKernelGGL(fwd_kernel, dim3(grid), dim3(NWAVES * 64), LDS_BYTES, stream, a);
    }
#endif
}
```

```cpp
#include <hip/hip_runtime.h>
#include <hip/hip_bf16.h>
#include <cstdio>
#include <cstdint>

#ifndef PHSEL
#define PHSEL -1
#endif
#ifndef PHSKIP
#define PHSKIP -1
#endif
#define SEL(id) ((PHSEL < 0 || PHSEL == (id)) && PHSKIP != (id))
#ifndef PROBE_T
#define PROBE_T 0
#endif
#ifndef PROBE_SHIFT
#define PROBE_SHIFT 0.0f
#endif
#ifndef HOSTDUP
#define HOSTDUP 0
#endif
#ifndef MK_ONE_LAUNCH
#define MK_ONE_LAUNCH 1
#endif

constexpr int T = 32768, SEQ = 4096, NBATCH = 8, DM = 1024, DEPTH = 4;
constexpr int QL = 768, KVL = 256, ROPE = 64, LATD = 1088, NH = 8, DQK = 192, DV = 128;
constexpr int NE = 32, TOPK = 4, DFF = 1024, PLED = 256;
constexpr float ALPHA = 1.681792830507429f;
constexpr float LN_EPS = 1e-5f, RMS_EPS = 1e-6f;
constexpr float QSCALE = 1.4426950408889634f / 13.856406460551018f;
constexpr int NWAVES = 8;

constexpr size_t MiB = 1u << 20;
constexpr size_t WS_CTL = 0, CTL_ZERO_BYTES = 2 * MiB;
constexpr size_t WS_CS = 2 * MiB, WS_SN = 6 * MiB, WS_SPL = 10 * MiB;
constexpr size_t WS_W_MLA = 12 * MiB, W_MLA_STRIDE = 8 * MiB;
constexpr size_t OFF_MLA_WIN = 0, OFF_MLA_WUQ = 2560 * 1024, OFF_MLA_WUKV = OFF_MLA_WUQ + 2304 * 1024, OFF_MLA_WO = OFF_MLA_WUKV + 1024 * 1024;
constexpr size_t WS_W_LRU = 28 * MiB, W_LRU_STRIDE = 8 * MiB;
constexpr size_t OFF_LRU_WIN = 0, OFF_LRU_WAX = 4 * MiB, OFF_LRU_WOUT = 5 * MiB;
constexpr size_t WS_W_PLE = 44 * MiB, W_PLE_STRIDE = 3 * MiB;
constexpr size_t OFF_PLE_WG = 0, OFF_PLE_WP = 2 * MiB;
constexpr size_t WS_W_UP = 56 * MiB;
constexpr size_t WS_W_DN = 568 * MiB;
constexpr size_t WS_XB = 824 * MiB, WS_PB = 888 * MiB, WS_PP = 952 * MiB;
constexpr size_t WS_Y = 1208 * MiB, WS_X1 = 1336 * MiB, WS_X1B = 1464 * MiB, WS_X2 = 1528 * MiB, WS_X2B = 1656 * MiB;
constexpr size_t WS_LAT = 1720 * MiB, WS_KR = 1784 * MiB, WS_SSQ = 1788 * MiB, WS_Q = 1790 * MiB, WS_KN = 1886 * MiB, WS_V = 1950 * MiB, WS_O = 2014 * MiB;
constexpr size_t WS_GG = 2078 * MiB, WS_U = 2142 * MiB, WS_UC = 2206 * MiB, WS_AA = 2270 * MiB, WS_BB = 2398 * MiB, WS_CA = 2526 * MiB, WS_CH = 2528 * MiB;
constexpr size_t WS_H = 2530 * MiB, WS_YS = 2802 * MiB, WS_LIST = 3074 * MiB, WS_SLOT = 3078 * MiB, WS_GATE = 3079 * MiB, WS_END = 3080 * MiB;
constexpr int PADROWS = T * TOPK + NE * 256;
static_assert((size_t)PADROWS * DFF * 2 <= 272 * MiB, "H / YS size");
constexpr int CW_CNT = 256;
constexpr int CW_BAR = 4096;

constexpr int RING_BYTES = 139264;
constexpr int TILE_E_OFF = 131072;
constexpr int MISC_OFF = RING_BYTES;
constexpr int LDS_BYTES = 147456;

#define GAS __attribute__((address_space(1)))
#define LAS __attribute__((address_space(3)))
#define CAS __attribute__((address_space(4)))
typedef unsigned short bf16_t;
typedef short bf16x8 __attribute__((ext_vector_type(8)));
typedef short s16x4 __attribute__((ext_vector_type(4)));
typedef float f32x2 __attribute__((ext_vector_type(2)));
typedef float f32x4 __attribute__((ext_vector_type(4)));
typedef float f32x16 __attribute__((ext_vector_type(16)));
typedef unsigned u32x2 __attribute__((ext_vector_type(2)));
typedef unsigned u32x4 __attribute__((ext_vector_type(4)));

__device__ __forceinline__ unsigned cvt_pk_bf16(float lo, float hi) { unsigned r; asm volatile("v_cvt_pk_bf16_f32 %0, %1, %2" : "=v"(r) : "v"(lo), "v"(hi)); return r; }
__device__ __forceinline__ float bf_lo(unsigned w) { return __uint_as_float(w << 16); }
__device__ __forceinline__ float bf_hi(unsigned w) { return __uint_as_float(w & 0xffff0000u); }
__device__ __forceinline__ float sigmoidf_(float x) { return __builtin_amdgcn_rcpf(1.0f + __expf(-x)); }
__device__ __forceinline__ float gelu_tanh(float x) { const float u = 0.7978845608028654f * (x + 0.044715f * x * x * x); const float t = 1.0f - 2.0f * __builtin_amdgcn_rcpf(1.0f + __expf(2.0f * u)); return 0.5f * x * (1.0f + t); }
__device__ __forceinline__ u32x4 pack8(const f32x4 a, const f32x4 b) { u32x4 w; w.x = cvt_pk_bf16(a[0], a[1]); w.y = cvt_pk_bf16(a[2], a[3]); w.z = cvt_pk_bf16(b[0], b[1]); w.w = cvt_pk_bf16(b[2], b[3]); return w; }
__device__ __forceinline__ int opaque_tid() { int t = threadIdx.x; asm volatile("" : "+v"(t)); return t; }
__device__ __forceinline__ float wave_sum(float v) {
#pragma unroll
    for (int o = 1; o < 64; o <<= 1) v += __shfl_xor(v, o);
    return v;
}

namespace pg8 {
#define PG8_LAS __attribute__((address_space(3)))
constexpr int BM = 256, BK = 64, HALF = 128, HTB = HALF * BK * 2, STAGE_BYTES = 8 * HTB;
__host__ __device__ __forceinline__ int lds_byte(int r, int c) { const int st = (r >> 4) * 2 + (c >> 5), rr = r & 15, cc = c & 31, ob = rr * 64 + cc * 2; return st * 1024 + (ob ^ (((ob >> 9) & 1) << 5)); }
__host__ __device__ __forceinline__ void stage_rc(int b, int& R, int& C) { const int st = b / 1024, sb = b % 1024, swz = sb ^ (((sb >> 9) & 1) << 5); R = (st >> 1) * 16 + swz / 64; C = (st & 1) * 32 + (swz % 64) / 2; }
__host__ __device__ __forceinline__ int perm32(int rho) { const int n = rho >> 4, i = rho & 15; return 8 * (i >> 2) + 4 * n + (i & 3); }

struct Unit { const char* A; const char* B; const int* lst; int nvalid; int pm, pn, aux; };

template <class Epi, class Sched, bool GATHER>
__device__ __forceinline__ void gemm_phase(PG8_LAS unsigned char* lds, const int K, const int lda, const int ldb, const Sched& S, const Epi& E, unsigned long long* pw = nullptr) {
    const int tid = opaque_tid(), wid = __builtin_amdgcn_readfirstlane(tid >> 6), lane = tid & 63, wr = wid >> 2, wc = wid & 3, fr = lane & 15, fq = lane >> 4;
    const int nt = K / BK;
    unsigned voffB[2], ocA[2][2], onA[2][2]; int gR[2], gC2[2];
#pragma unroll
    for (int i = 0; i < 2; ++i) { int R, C; stage_rc(tid * 16 + i * 8192, R, C); const int Rb = Epi::PERM ? ((R & ~31) + perm32(R & 31)) : R;
        voffB[i] = (unsigned)(Rb * ldb + C) * 2u; gR[i] = R; gC2[i] = C * 2;
        ocA[0][i] = (unsigned)(R * lda + C) * 2u; ocA[1][i] = (unsigned)((R + HALF) * lda + C) * 2u; onA[0][i] = ocA[0][i]; onA[1][i] = ocA[1][i]; }
    constexpr unsigned kstep = BK * 2;
    const unsigned hstepB = (unsigned)HALF * ldb * 2;
    const unsigned ldsw = (unsigned)wid * 1024u;
    const int aoff = lds_byte(wr * 64 + fr, fq * 8), boff = lds_byte(wc * 32 + fr, fq * 8);
#define PG8_SA(b, h) (((b) * 2 + (h)) * HTB)
#define PG8_SB(b, h) ((4 + (b) * 2 + (h)) * HTB)
#define PG8_STAGE(bufoff, gbase, voff, kb) do { _Pragma("unroll") for (int _i = 0; _i < 2; ++_i) \
        __builtin_amdgcn_global_load_lds((const unsigned*)((const char*)(gbase) + (size_t)(unsigned)((voff)[_i] + (unsigned)(kb))), (PG8_LAS unsigned*)(lds + (bufoff) + ldsw + _i * 8192), 16, 0, 0); } while (0)
#define PG8_LDA(dst, b, h) do { _Pragma("unroll") for (int m = 0; m < 4; ++m) _Pragma("unroll") for (int k = 0; k < 2; ++k) dst[m][k] = *(const PG8_LAS bf16x8*)(lds + PG8_SA(b, h) + aoff + m * 2048 + k * 1024); } while (0)
#define PG8_LDB(dst, b, h) do { _Pragma("unroll") for (int n = 0; n < 2; ++n) _Pragma("unroll") for (int k = 0; k < 2; ++k) dst[n][k] = *(const PG8_LAS bf16x8*)(lds + PG8_SB(b, h) + boff + n * 2048 + k * 1024); } while (0)
#define PG8_MMA(ai, bj, At, Bt) do { __builtin_amdgcn_s_setprio(1); _Pragma("unroll") for (int m = 0; m < 4; ++m) _Pragma("unroll") for (int n = 0; n < 2; ++n) _Pragma("unroll") for (int k = 0; k < 2; ++k) \
        acc[ai][bj][m][n] = __builtin_amdgcn_mfma_f32_16x16x32_bf16(Bt[n][k], At[m][k], acc[ai][bj][m][n], 0, 0, 0); __builtin_amdgcn_s_setprio(0); } while (0)
#define PG8_WAIT_V(n) asm volatile("s_waitcnt vmcnt(" #n ")" ::: "memory")
#define PG8_WAIT_L(n) asm volatile("s_waitcnt lgkmcnt(" #n ")" ::: "memory")
#define PG8_BAR __builtin_amdgcn_s_barrier()
#define PG8_SCHED __builtin_amdgcn_sched_barrier(0)
#define PG8_GOFFS(u, o) do { _Pragma("unroll") for (int _h = 0; _h < 2; ++_h) _Pragma("unroll") for (int _i = 0; _i < 2; ++_i) { int _r = _h * HALF + gR[_i]; _r = _r < (u).nvalid ? _r : (u).nvalid - 1; \
        const int _tok = (u).lst[_r]; (o)[_h][_i] = (unsigned)_tok * (unsigned)(lda * 2) + (unsigned)gC2[_i]; } } while (0)
#define PG8_GRAW(u, tk) do { _Pragma("unroll") for (int _h = 0; _h < 2; ++_h) _Pragma("unroll") for (int _i = 0; _i < 2; ++_i) { int _r = _h * HALF + gR[_i]; _r = _r < (u).nvalid ? _r : (u).nvalid - 1; (tk)[_h][_i] = (u).lst[_r]; } } while (0)
    Unit cur, nxt, nn; int ui = 0; int tokr[2][2] = {{0, 0}, {0, 0}};
#if PROBE_T
    unsigned long long pk_ = 0, pe_ = 0, pt0_ = 0, pn_ = 0; const unsigned long long pst_ = __builtin_amdgcn_s_memtime();
#endif
    if (!S.next(0, cur)) return;
    f32x4 acc[2][2][4][2];
#pragma unroll
    for (int a = 0; a < 2; ++a)
#pragma unroll
        for (int b = 0; b < 2; ++b)
#pragma unroll
            for (int m = 0; m < 4; ++m)
#pragma unroll
                for (int n = 0; n < 2; ++n) acc[a][b][m][n] = (f32x4){0.f, 0.f, 0.f, 0.f};
    bf16x8 At[4][2], B0[2][2], B1[2][2];
    const char* cA = cur.A; const char* cB = cur.B;
    bool has_next = S.next(1, nxt);
    if constexpr (GATHER) { PG8_GOFFS(cur, ocA);
        if (has_next) { PG8_GOFFS(nxt, onA); }
        else {
#pragma unroll
            for (int h = 0; h < 2; ++h)
#pragma unroll
                for (int i = 0; i < 2; ++i) onA[h][i] = ocA[h][i]; } }
    PG8_STAGE(PG8_SB(0, 0), cB, voffB, 0u); PG8_STAGE(PG8_SB(0, 1), cB, voffB, hstepB); PG8_STAGE(PG8_SA(0, 0), cA, ocA[0], 0u); PG8_STAGE(PG8_SA(0, 1), cA, ocA[1], 0u);
    if (wr == 1) PG8_BAR;
    PG8_WAIT_V(2); PG8_BAR;
    PG8_STAGE(PG8_SB(1, 0), cB, voffB, kstep); PG8_STAGE(PG8_SA(1, 0), cA, ocA[0], kstep); PG8_STAGE(PG8_SB(1, 1), cB, voffB, hstepB + kstep);
    PG8_WAIT_V(6); PG8_BAR;
    for (;;) {
        const char* nA = has_next ? nxt.A : cA; const char* nB = has_next ? nxt.B : cB;
#if PROBE_T
        pt0_ = __builtin_amdgcn_s_memtime();
#endif
#pragma unroll 1
        for (int t = 0; t < nt; t += 2) {
            const bool last = (t == nt - 2);
            const unsigned k1 = (unsigned)(t + 1) * kstep, k2 = last ? 0u : (unsigned)(t + 2) * kstep, k3 = k2 + kstep;
            const char* a2 = last ? nA : cA; const char* b2 = last ? nB : cB;
            unsigned o2[2][2];
#pragma unroll
            for (int h = 0; h < 2; ++h)
#pragma unroll
                for (int i = 0; i < 2; ++i) o2[h][i] = (GATHER && last) ? onA[h][i] : ocA[h][i];
            PG8_LDB(B0, 0, 0); PG8_LDB(B1, 0, 1); PG8_SCHED; PG8_LDA(At, 0, 0); PG8_STAGE(PG8_SA(1, 1), cA, ocA[1], k1);
            PG8_WAIT_V(8); PG8_WAIT_L(0); PG8_BAR; PG8_MMA(0, 0, At, B0); PG8_MMA(0, 1, At, B1); PG8_BAR; PG8_SCHED;
            PG8_LDA(At, 0, 1); PG8_STAGE(PG8_SB(0, 0), b2, voffB, k2); PG8_STAGE(PG8_SB(0, 1), b2, voffB, hstepB + k2); PG8_STAGE(PG8_SA(0, 0), a2, o2[0], k2);
            PG8_WAIT_V(8); PG8_WAIT_L(0); PG8_BAR; PG8_MMA(1, 0, At, B0); PG8_MMA(1, 1, At, B1); PG8_BAR; PG8_SCHED;
            PG8_LDB(B0, 1, 0); PG8_LDB(B1, 1, 1); PG8_SCHED; PG8_LDA(At, 1, 0); PG8_STAGE(PG8_SA(0, 1), a2, o2[1], k2);
            PG8_WAIT_V(8); PG8_WAIT_L(0); PG8_BAR; PG8_MMA(0, 0, At, B0); PG8_MMA(0, 1, At, B1); PG8_BAR; PG8_SCHED;
            PG8_LDA(At, 1, 1); PG8_STAGE(PG8_SB(1, 0), b2, voffB, k3); PG8_STAGE(PG8_SB(1, 1), b2, voffB, hstepB + k3); PG8_STAGE(PG8_SA(1, 0), a2, o2[0], k3);
            PG8_WAIT_V(8); PG8_WAIT_L(0); PG8_BAR; PG8_MMA(1, 0, At, B0); PG8_MMA(1, 1, At, B1); PG8_BAR; PG8_SCHED;
        }
#if PROBE_T
        const unsigned long long pt1_ = __builtin_amdgcn_s_memtime(); pk_ += pt1_ - pt0_;
#endif
        const bool has_nn = has_next && S.next(ui + 2, nn);
        if constexpr (GATHER) { if (has_nn) { PG8_GRAW(nn, tokr); } }
        if (wr == 0) PG8_BAR;
        E(acc, cur, wr, wc, fr, fq);
#if PROBE_T
        asm volatile("s_waitcnt vmcnt(0)" ::: "memory"); pe_ += __builtin_amdgcn_s_memtime() - pt1_; ++pn_;
#endif
        if (!has_next) break;
#pragma unroll
        for (int a = 0; a < 2; ++a)
#pragma unroll
            for (int b = 0; b < 2; ++b)
#pragma unroll
                for (int m = 0; m < 4; ++m)
#pragma unroll
                    for (int n = 0; n < 2; ++n) acc[a][b][m][n] = (f32x4){0.f, 0.f, 0.f, 0.f};
        cur = nxt; cA = nA; cB = nB; ++ui;
        if constexpr (GATHER) {
#pragma unroll
            for (int h = 0; h < 2; ++h)
#pragma unroll
                for (int i = 0; i < 2; ++i) { ocA[h][i] = onA[h][i]; if (has_nn) onA[h][i] = (unsigned)tokr[h][i] * (unsigned)(lda * 2) + (unsigned)gC2[i]; } }
        if (has_nn) nxt = nn;
        has_next = has_nn;
        if (wr == 1) PG8_BAR;
    }
    PG8_WAIT_V(0);
    PG8_BAR;
#if PROBE_T
    if (pw && blockIdx.x == 0 && tid == 0) { pw[0] += pk_; pw[1] += pe_; pw[2] += pn_; pw[3] += __builtin_amdgcn_s_memtime() - pst_; }
#endif
#undef PG8_SA
#undef PG8_SB
#undef PG8_STAGE
#undef PG8_LDA
#undef PG8_LDB
#undef PG8_MMA
#undef PG8_WAIT_V
#undef PG8_WAIT_L
#undef PG8_BAR
#undef PG8_SCHED
#undef PG8_GOFFS
#undef PG8_GRAW
}

constexpr int NXCD = 8, WGM = 8;
struct DenseSched {
    const char* A; const char* B; int lda, ldb; int nM, nN, nwg, G, c; int apn_shift, akbytes, bpm_shift; size_t bbatch;
    __device__ __forceinline__ void init(const void* A_, const void* B_, int lda_, int ldb_, int M, int N, int G_, int c_) {
        A = (const char*)A_; B = (const char*)B_; lda = lda_; ldb = ldb_; nM = M / BM; nN = N / BM; nwg = nM * nN; G = G_; c = c_; apn_shift = -1; akbytes = 0; bpm_shift = -1; bbatch = 0; }
    __device__ __forceinline__ bool next(int i, Unit& u) const {
        const long L = (long)i * G + c; if (L >= nwg) return false;
        int wgid = (int)L; { const int q = nwg / NXCD, r = nwg % NXCD, xcd = wgid % NXCD, off = wgid / NXCD; wgid = (xcd < r ? xcd * (q + 1) : r * (q + 1) + (xcd - r) * q) + off; }
        const int nig = WGM * nN, gid = wgid / nig, fm = gid * WGM, gsz = (nM - fm) < WGM ? (nM - fm) : WGM;
        const int pm = fm + ((wgid % nig) % gsz), pn = (wgid % nig) / gsz;
        u.pm = pm; u.pn = pn; u.aux = 0; u.lst = nullptr; u.nvalid = 256;
        u.A = A + (size_t)pm * 256 * lda * 2 + (apn_shift >= 0 ? (size_t)(pn >> apn_shift) * akbytes : (size_t)0);
        u.B = B + (size_t)pn * 256 * ldb * 2 + (bpm_shift >= 0 ? (size_t)(pm >> bpm_shift) * bbatch : (size_t)0);
        return true;
    }
};
struct MoeSched {
    const char* A; const char* B; size_t bexp; int lda, ldb, nN; const int* lists; volatile LAS const int* tab; volatile LAS const int* te; int G, c; bool gather;
    __device__ __forceinline__ bool next(int i, Unit& u) const {
        int pn, mg;
        if (G == 256) {
            const int x = c & 7, jj = c >> 3, pgs = nN >> 2, mgs = 8 / pgs;
            mg = i * (8 * mgs) + 8 * (x / pgs) + (jj & 7); pn = 4 * (x % pgs) + (jj >> 3);
            if (mg >= tab[32]) return false;
        } else { const int total = tab[32] * nN; const long L = (long)i * G + c; if (L >= total) return false; pn = (int)(L % nN); mg = (int)(L / nN); }
        const int e = te[mg], mt = mg - tab[e];
        u.pm = mg; u.pn = pn; u.aux = e;
        if (gather) { u.A = A; u.lst = lists + (size_t)e * T + mt * 256; const int rem = tab[48 + e] - mt * 256; u.nvalid = rem < 256 ? rem : 256; }
        else { u.A = A + (size_t)mg * 256 * lda * 2; u.lst = nullptr; u.nvalid = 256; }
        u.B = B + (size_t)e * bexp + (size_t)pn * 256 * ldb * 2;
        return true;
    }
};

#define EPI_ROW(u, ai, m) ((u).pm * 256 + (ai) * 128 + wr * 64 + (m) * 16 + fr)
struct EpiLat {
    static constexpr bool PERM = true;
    bf16_t* LAT; float* SSQ; bf16_t* KR; const float* CS; const float* SN;
    __device__ __forceinline__ void operator()(const f32x4 (&acc)[2][2][4][2], const Unit& u, int wr, int wc, int fr, int fq) const {
        if (u.pn < 4) {
#pragma unroll
            for (int ai = 0; ai < 2; ++ai)
#pragma unroll
                for (int m = 0; m < 4; ++m) { const int row = EPI_ROW(u, ai, m); float ss = 0.f;
#pragma unroll
                    for (int bj = 0; bj < 2; ++bj) { const f32x4 v0 = acc[ai][bj][m][0], v1 = acc[ai][bj][m][1];
                        ss += (v0[0] * v0[0] + v0[1] * v0[1]) + (v0[2] * v0[2] + v0[3] * v0[3]) + (v1[0] * v1[0] + v1[1] * v1[1]) + (v1[2] * v1[2] + v1[3] * v1[3]);
                        *(u32x4*)(LAT + (size_t)row * 1024 + u.pn * 256 + bj * 128 + wc * 32 + 8 * fq) = pack8(v0, v1); }
                    ss += __shfl_xor(ss, 16); ss += __shfl_xor(ss, 32);
                    if (fq == 0) SSQ[(size_t)row * 16 + u.pn * 4 + wc] = ss; }
        } else if (wc == 0) {
#pragma unroll
            for (int ai = 0; ai < 2; ++ai)
#pragma unroll
                for (int m = 0; m < 4; ++m) { const int row = EPI_ROW(u, ai, m);
                    const f32x4 c0 = *(const f32x4*)(CS + (size_t)row * 32 + 8 * fq), c1 = *(const f32x4*)(CS + (size_t)row * 32 + 8 * fq + 4);
                    const f32x4 s0 = *(const f32x4*)(SN + (size_t)row * 32 + 8 * fq), s1 = *(const f32x4*)(SN + (size_t)row * 32 + 8 * fq + 4);
                    const f32x4 a0 = acc[ai][0][m][0], a1 = acc[ai][0][m][1], b0 = acc[ai][1][m][0], b1 = acc[ai][1][m][1];
                    *(u32x4*)(KR + (size_t)row * 64 + 8 * fq) = pack8(a0 * c0 - b0 * s0, a1 * c1 - b1 * s1);
                    *(u32x4*)(KR + (size_t)row * 64 + 32 + 8 * fq) = pack8(b0 * c0 + a0 * s0, b1 * c1 + a1 * s1); }
        }
    }
};
struct EpiQ {
    static constexpr bool PERM = true;
    bf16_t* Q; const float* SSQ; const float* CS; const float* SN;
    __device__ __forceinline__ void operator()(const f32x4 (&acc)[2][2][4][2], const Unit& u, int wr, int wc, int fr, int fq) const {
#pragma unroll
        for (int ai = 0; ai < 2; ++ai)
#pragma unroll
            for (int m = 0; m < 4; ++m) { const int row = EPI_ROW(u, ai, m);
                const f32x4 q0 = *(const f32x4*)(SSQ + (size_t)row * 16), q1 = *(const f32x4*)(SSQ + (size_t)row * 16 + 4), q2 = *(const f32x4*)(SSQ + (size_t)row * 16 + 8);
                const float ss = ((q0[0] + q0[1]) + (q0[2] + q0[3])) + ((q1[0] + q1[1]) + (q1[2] + q1[3])) + ((q2[0] + q2[1]) + (q2[2] + q2[3]));
                const float r = QSCALE / sqrtf(ss * (1.0f / QL) + RMS_EPS);
                if (u.pn < 4) {
#pragma unroll
                    for (int bj = 0; bj < 2; ++bj)
                        *(u32x4*)(Q + (size_t)row * 1536 + (2 * u.pn + bj) * 192 + wc * 32 + 8 * fq) = pack8(acc[ai][bj][m][0] * r, acc[ai][bj][m][1] * r);
                } else {
                    const int head = 4 * (u.pn - 4) + wc;
                    const f32x4 c0 = *(const f32x4*)(CS + (size_t)row * 32 + 8 * fq), c1 = *(const f32x4*)(CS + (size_t)row * 32 + 8 * fq + 4);
                    const f32x4 s0 = *(const f32x4*)(SN + (size_t)row * 32 + 8 * fq), s1 = *(const f32x4*)(SN + (size_t)row * 32 + 8 * fq + 4);
                    const f32x4 a0 = acc[ai][0][m][0] * r, a1 = acc[ai][0][m][1] * r, b0 = acc[ai][1][m][0] * r, b1 = acc[ai][1][m][1] * r;
                    *(u32x4*)(Q + (size_t)row * 1536 + head * 192 + 128 + 8 * fq) = pack8(a0 * c0 - b0 * s0, a1 * c1 - b1 * s1);
                    *(u32x4*)(Q + (size_t)row * 1536 + head * 192 + 160 + 8 * fq) = pack8(b0 * c0 + a0 * s0, b1 * c1 + a1 * s1);
                }
                asm volatile("" ::: "memory"); }
    }
};
struct EpiKV {
    static constexpr bool PERM = true;
    bf16_t* KN; bf16_t* V; const float* SSQ;
    __device__ __forceinline__ void operator()(const f32x4 (&acc)[2][2][4][2], const Unit& u, int wr, int wc, int fr, int fq) const {
#pragma unroll
        for (int ai = 0; ai < 2; ++ai)
#pragma unroll
            for (int m = 0; m < 4; ++m) { const int row = EPI_ROW(u, ai, m);
                const f32x4 q3 = *(const f32x4*)(SSQ + (size_t)row * 16 + 12);
                const float r = 1.0f / sqrtf(((q3[0] + q3[1]) + (q3[2] + q3[3])) * (1.0f / KVL) + RMS_EPS);
                *(u32x4*)(KN + (size_t)row * 1024 + u.pn * 128 + wc * 32 + 8 * fq) = pack8(acc[ai][0][m][0] * r, acc[ai][0][m][1] * r);
                *(u32x4*)(V + (size_t)row * 1024 + u.pn * 128 + wc * 32 + 8 * fq) = pack8(acc[ai][1][m][0] * r, acc[ai][1][m][1] * r); }
    }
};
__device__ __forceinline__ f32x4 bf4_lo(const u32x4 w) { return (f32x4){bf_lo(w.x), bf_hi(w.x), bf_lo(w.y), bf_hi(w.y)}; }
__device__ __forceinline__ f32x4 bf4_hi(const u32x4 w) { return (f32x4){bf_lo(w.z), bf_hi(w.z), bf_lo(w.w), bf_hi(w.w)}; }
struct EpiRes {
    static constexpr bool PERM = true;
    const bf16_t* X; bf16_t* Y;
    __device__ __forceinline__ void operator()(const f32x4 (&acc)[2][2][4][2], const Unit& u, int wr, int wc, int fr, int fq) const {
#pragma unroll
        for (int ai = 0; ai < 2; ++ai)
#pragma unroll
            for (int m = 0; m < 4; ++m) { const size_t off = (size_t)EPI_ROW(u, ai, m) * 1024 + u.pn * 256 + wc * 32 + 8 * fq;
#pragma unroll
                for (int bj = 0; bj < 2; ++bj) { const u32x4 xw = *(const u32x4*)(X + off + bj * 128);
                    *(u32x4*)(Y + off + bj * 128) = pack8(bf4_lo(xw) * ALPHA + acc[ai][bj][m][0], bf4_hi(xw) * ALPHA + acc[ai][bj][m][1]); }
                if (m & 1) asm volatile("" ::: "memory"); }
    }
};
struct EpiGU {
    static constexpr bool PERM = true;
    bf16_t* GG; bf16_t* U;
    __device__ __forceinline__ void operator()(const f32x4 (&acc)[2][2][4][2], const Unit& u, int wr, int wc, int fr, int fq) const {
#pragma unroll
        for (int ai = 0; ai < 2; ++ai)
#pragma unroll
            for (int m = 0; m < 4; ++m) { const int row = EPI_ROW(u, ai, m);
#pragma unroll
                for (int bj = 0; bj < 2; ++bj) { f32x4 v0 = acc[ai][bj][m][0], v1 = acc[ai][bj][m][1];
                    if (u.pn < 4) {
#pragma unroll
                        for (int e = 0; e < 4; ++e) { v0[e] = gelu_tanh(v0[e]); v1[e] = gelu_tanh(v1[e]); }
                        *(u32x4*)(GG + (size_t)row * 1024 + u.pn * 256 + bj * 128 + wc * 32 + 8 * fq) = pack8(v0, v1);
                    } else *(u32x4*)(U + (size_t)row * 1024 + (u.pn - 4) * 256 + bj * 128 + wc * 32 + 8 * fq) = pack8(v0, v1); } }
    }
};
struct EpiAB {
    static constexpr bool PERM = true;
    bf16_t* LA; bf16_t* BB; const bf16_t* UC; const float* BA; const float* BX; const float* SPL;
    __device__ __forceinline__ void operator()(const f32x4 (&acc)[2][2][4][2], const Unit& u, int wr, int wc, int fr, int fq) const {
        const int ch = (u.pn >> 1) * 256 + (u.pn & 1) * 128 + wc * 32 + 8 * fq;
        f32x4 ba[2], bx[2], sp[2];
#pragma unroll
        for (int n = 0; n < 2; ++n) { ba[n] = *(const f32x4*)(BA + ch + 4 * n); bx[n] = *(const f32x4*)(BX + ch + 4 * n); sp[n] = *(const f32x4*)(SPL + ch + 4 * n); }
#pragma unroll
        for (int ai = 0; ai < 2; ++ai)
#pragma unroll
            for (int m = 0; m < 4; ++m) { const size_t off = (size_t)EPI_ROW(u, ai, m) * 1024 + ch;
                const u32x4 uw = *(const u32x4*)(UC + off); f32x4 uv[2] = {bf4_lo(uw), bf4_hi(uw)}, lv[2], bv[2];
#pragma unroll
                for (int n = 0; n < 2; ++n)
#pragma unroll
                    for (int e = 0; e < 4; ++e) { const float r = sigmoidf_(acc[ai][0][m][n][e] + ba[n][e]), ig = sigmoidf_(acc[ai][1][m][n][e] + bx[n][e]);
                        const float la = sp[n][e] * r, x2 = 2.0f * la; lv[n][e] = la * 1.4426950408889634f;
                        const float om = x2 > -0.25f ? -x2 * (1.0f + x2 * (0.5f + x2 * (0.16666667f + x2 * (0.041666668f + x2 * 0.0083333338f)))) : 1.0f - __expf(x2);
                        bv[n][e] = sqrtf(om) * ig * uv[n][e]; }
                *(u32x4*)(LA + off) = pack8(lv[0], lv[1]); *(u32x4*)(BB + off) = pack8(bv[0], bv[1]); asm volatile("" ::: "memory"); }
    }
};
struct EpiUp {
    static constexpr bool PERM = true;
    bf16_t* H; const float* BU;
    __device__ __forceinline__ void operator()(const f32x4 (&acc)[2][2][4][2], const Unit& u, int wr, int wc, int fr, int fq) const {
        const int gc = u.pn * 128 + wc * 32 + 8 * fq; const float* bu = BU + (size_t)u.aux * 2048;
        const f32x4 bg0 = *(const f32x4*)(bu + gc), bg1 = *(const f32x4*)(bu + gc + 4), bp0 = *(const f32x4*)(bu + 1024 + gc), bp1 = *(const f32x4*)(bu + 1024 + gc + 4);
#pragma unroll
        for (int ai = 0; ai < 2; ++ai)
#pragma unroll
            for (int m = 0; m < 4; ++m) { const int row = EPI_ROW(u, ai, m);
                f32x4 y0, y1;
#pragma unroll
                for (int e = 0; e < 4; ++e) {
                    float g = fminf(acc[ai][0][m][0][e] + bg0[e], 7.0f), up = fminf(fmaxf(acc[ai][1][m][0][e] + bp0[e], -7.0f), 7.0f); y0[e] = (up + 1.0f) * (g * sigmoidf_(1.702f * g));
                    g = fminf(acc[ai][0][m][1][e] + bg1[e], 7.0f); up = fminf(fmaxf(acc[ai][1][m][1][e] + bp1[e], -7.0f), 7.0f); y1[e] = (up + 1.0f) * (g * sigmoidf_(1.702f * g)); }
                *(u32x4*)(H + (size_t)row * 1024 + gc) = pack8(y0, y1); }
    }
};
struct EpiDown {
    static constexpr bool PERM = true;
    bf16_t* YS; const float* BD;
    __device__ __forceinline__ void operator()(const f32x4 (&acc)[2][2][4][2], const Unit& u, int wr, int wc, int fr, int fq) const {
        const float* bd = BD + (size_t)u.aux * 1024;
#pragma unroll
        for (int bj = 0; bj < 2; ++bj) { const int col = u.pn * 256 + bj * 128 + wc * 32 + 8 * fq; const f32x4 b0 = *(const f32x4*)(bd + col), b1 = *(const f32x4*)(bd + col + 4);
#pragma unroll
            for (int ai = 0; ai < 2; ++ai)
#pragma unroll
                for (int m = 0; m < 4; ++m) *(u32x4*)(YS + (size_t)EPI_ROW(u, ai, m) * 1024 + col) = pack8(acc[ai][bj][m][0] + b0, acc[ai][bj][m][1] + b1); }
    }
};
struct EpiPle {
    static constexpr bool PERM = true;
    const bf16_t* X2; const bf16_t* PP; float* OUT; bf16_t* XB;
    __device__ __forceinline__ void operator()(const f32x4 (&acc)[2][2][4][2], const Unit& u, int wr, int wc, int fr, int fq) const {
#pragma unroll
        for (int ai = 0; ai < 2; ++ai)
#pragma unroll
            for (int m = 0; m < 4; ++m) { const size_t off = (size_t)EPI_ROW(u, ai, m) * 1024 + u.pn * 256 + wc * 32 + 8 * fq;
#pragma unroll
                for (int bj = 0; bj < 2; ++bj) { const size_t o = off + bj * 128; const u32x4 xw = *(const u32x4*)(X2 + o), pw = *(const u32x4*)(PP + o);
                    const f32x4 a0 = acc[ai][bj][m][0], a1 = acc[ai][bj][m][1], x0 = bf4_lo(xw), x1 = bf4_hi(xw), p0 = bf4_lo(pw), p1 = bf4_hi(pw); f32x4 r0, r1;
#pragma unroll
                    for (int e = 0; e < 4; ++e) { r0[e] = x0[e] + sigmoidf_(a0[e]) * p0[e]; r1[e] = x1[e] + sigmoidf_(a1[e]) * p1[e]; }
                    *(u32x4*)(XB + o) = pack8(r0, r1);
                    if (OUT) { *(f32x4*)(OUT + o) = r0; *(f32x4*)(OUT + o + 4) = r1; } }
                if (m & 1) asm volatile("" ::: "memory"); }
    }
};
struct EpiPP {
    static constexpr bool PERM = true;
    bf16_t* PP;
    __device__ __forceinline__ void operator()(const f32x4 (&acc)[2][2][4][2], const Unit& u, int wr, int wc, int fr, int fq) const {
#pragma unroll
        for (int ai = 0; ai < 2; ++ai)
#pragma unroll
            for (int m = 0; m < 4; ++m)
#pragma unroll
                for (int bj = 0; bj < 2; ++bj) *(u32x4*)(PP + (size_t)EPI_ROW(u, ai, m) * 1024 + u.pn * 256 + bj * 128 + wc * 32 + 8 * fq) = pack8(acc[ai][bj][m][0], acc[ai][bj][m][1]);
    }
};
}

namespace att {
constexpr int NW = 8, QBLK = 32, KVBLK = 64, QB = 256, KPITCH = 384;
constexpr int SHM_V = KVBLK * DV * 2, SHM_K = KVBLK * KPITCH;
constexpr int OFF_V = 0, OFF_K = 2 * SHM_V, OFF_WS = OFF_K + 2 * SHM_K, LDS_BYTES = OFF_WS + NW * 64 * 4;
#define SBAR() __builtin_amdgcn_sched_barrier(0)
__device__ __forceinline__ int k_addr(int row, int chunk) { return row * KPITCH + ((chunk ^ ((row >> 1) & 7)) << 4); }
__device__ __forceinline__ int v_st(int k, int c) { const int kk = (k & ~0xC) | ((k & 4) << 1) | ((k & 8) >> 1); return ((kk >> 3) * 4 + (c >> 5)) * 512 + ((kk & 7) * 32 + (c & 31)) * 2; }
__device__ __forceinline__ int v_rd_base(int lane) { return ((lane & 3) << 3) | (((lane >> 2) & 3) << 6) | (((lane >> 4) & 1) << 5) | (((lane >> 5) & 1) << 8); }
constexpr int v_rd_off(int d0, int ks, int half) { return d0 * 512 + ks * 4096 + half * 2048; }
__device__ __forceinline__ int crow(int r, int hi) { return (r & 3) + 8 * (r >> 2) + 4 * hi; }

template <int KB>
__device__ __forceinline__ void qkt(f32x16& p0, f32x16& p1, const LAS char* K_lds, int r32, int hi, const bf16x8* qr) {
    p0 = f32x16{}; p1 = f32x16{};
    const LAS char* kb[4];
#pragma unroll
    for (int dd = 0; dd < 4; ++dd) kb[dd] = K_lds + KB * SHM_K + r32 * KPITCH + (((2 * dd + hi) ^ ((r32 >> 1) & 7)) << 4);
#pragma unroll
    for (int dg = 0; dg < 3; ++dg) {
#pragma unroll
        for (int dd = 0; dd < 4; ++dd) { const int d0 = dg * 4 + dd; const LAS char* a = kb[dd] + dg * 128;
            const bf16x8 b0 = *(const LAS bf16x8*)a;
            const bf16x8 b1 = *(const LAS bf16x8*)(a + 32 * KPITCH);
            p0 = __builtin_amdgcn_mfma_f32_32x32x16_bf16(b0, qr[d0], p0, 0, 0, 0);
            p1 = __builtin_amdgcn_mfma_f32_32x32x16_bf16(b1, qr[d0], p1, 0, 0, 0); }
        SBAR(); }
}
template <int VB>
__device__ __forceinline__ void pv_tile(f32x16* o, int vb0, bf16x8 pa0, bf16x8 pa1, bf16x8 pa2, bf16x8 pa3) {
#define TRRD(dst, off) asm volatile("ds_read_b64_tr_b16 %0, %1 offset:%2" : "=&v"(dst) : "v"(vb0), "i"(off) : "memory")
#define PV_D0(d0) do { s16x4 l0, l1, l2, l3, h0, h1, h2, h3; constexpr int b_ = OFF_V + VB * SHM_V + v_rd_off(d0, 0, 0); \
        TRRD(l0, b_); TRRD(h0, b_ + 2048); TRRD(l1, b_ + 4096); TRRD(h1, b_ + 6144); TRRD(l2, b_ + 8192); TRRD(h2, b_ + 10240); TRRD(l3, b_ + 12288); TRRD(h3, b_ + 14336); \
        asm volatile("s_waitcnt lgkmcnt(0)" ::: "memory"); SBAR(); \
        o[d0] = __builtin_amdgcn_mfma_f32_32x32x16_bf16(pa0, (bf16x8){l0[0], l0[1], l0[2], l0[3], h0[0], h0[1], h0[2], h0[3]}, o[d0], 0, 0, 0); \
        o[d0] = __builtin_amdgcn_mfma_f32_32x32x16_bf16(pa1, (bf16x8){l1[0], l1[1], l1[2], l1[3], h1[0], h1[1], h1[2], h1[3]}, o[d0], 0, 0, 0); \
        o[d0] = __builtin_amdgcn_mfma_f32_32x32x16_bf16(pa2, (bf16x8){l2[0], l2[1], l2[2], l2[3], h2[0], h2[1], h2[2], h2[3]}, o[d0], 0, 0, 0); \
        o[d0] = __builtin_amdgcn_mfma_f32_32x32x16_bf16(pa3, (bf16x8){l3[0], l3[1], l3[2], l3[3], h3[0], h3[1], h3[2], h3[3]}, o[d0], 0, 0, 0); } while (0)
    PV_D0(0); PV_D0(1); PV_D0(2); PV_D0(3);
#undef PV_D0
#undef TRRD
}
__device__ __forceinline__ void mask_tile(f32x16& p0, f32x16& p1, int dq  ) {
    const float NEG = -__builtin_inff();
#pragma unroll
    for (int r = 0; r < 16; ++r) { const int c = (r & 3) + 8 * (r >> 2);
        if (c > dq) p0[r] = NEG;
        if (c + 32 > dq) p1[r] = NEG; }
}
__device__ __forceinline__ void softmax_tile(f32x16& p0, f32x16& p1, float& m_reg, float& l_reg, float& alpha, bf16x8& pa0, bf16x8& pa1, bf16x8& pa2, bf16x8& pa3) {
    float pmax = p0[0];
#pragma unroll
    for (int r = 1; r < 16; ++r) pmax = fmaxf(pmax, p0[r]);
#pragma unroll
    for (int r = 0; r < 16; ++r) pmax = fmaxf(pmax, p1[r]);
    { auto rr = __builtin_amdgcn_permlane32_swap(__float_as_uint(pmax), __float_as_uint(pmax), false, false); pmax = fmaxf(__uint_as_float(rr[0]), __uint_as_float(rr[1])); }
    const float mn = fmaxf(m_reg, pmax); alpha = __builtin_amdgcn_exp2f(m_reg - mn); m_reg = mn;
    float ps = 0.f;
#pragma unroll
    for (int r = 0; r < 16; ++r) { p0[r] = __builtin_amdgcn_exp2f(p0[r] - mn); ps += p0[r]; }
#pragma unroll
    for (int r = 0; r < 16; ++r) { p1[r] = __builtin_amdgcn_exp2f(p1[r] - mn); ps += p1[r]; }
    { auto rr = __builtin_amdgcn_permlane32_swap(__float_as_uint(ps), __float_as_uint(ps), false, false); ps = __uint_as_float(rr[0]) + __uint_as_float(rr[1]); }
    l_reg = l_reg * alpha + ps;
#define PK4(P, B_, OUT) do { unsigned a0 = cvt_pk_bf16(P[B_+0], P[B_+1]), a1 = cvt_pk_bf16(P[B_+2], P[B_+3]); \
        unsigned b0 = cvt_pk_bf16(P[B_+4], P[B_+5]), b1 = cvt_pk_bf16(P[B_+6], P[B_+7]); \
        auto r0 = __builtin_amdgcn_permlane32_swap(a0, b0, false, false); auto r1 = __builtin_amdgcn_permlane32_swap(a1, b1, false, false); \
        u32x4 w = {r0[0], r1[0], r0[1], r1[1]}; OUT = __builtin_bit_cast(bf16x8, w); } while (0)
    PK4(p0, 0, pa0); PK4(p0, 8, pa1); PK4(p1, 0, pa2); PK4(p1, 8, pa3);
#undef PK4
}

__device__ __forceinline__ void attn_block(int b, int h, int qb, const bf16_t* Q, const bf16_t* KN, const bf16_t* KR, const bf16_t* V, bf16_t* O, LAS char* lds) {
    const int tid = opaque_tid(), wid = __builtin_amdgcn_readfirstlane(tid >> 6), lane = tid & 63, r32 = lane & 31, hi = lane >> 5;
    const size_t row0 = (size_t)b * SEQ;
    const int q0 = qb * QB + wid * QBLK;
    const int NT = (qb + 1) * (QB / KVBLK);
    LAS char* V_lds = lds + OFF_V; LAS char* K_lds = lds + OFF_K;
    LAS float* ws = (LAS float*)(lds + OFF_WS) + wid * 64; LAS float* li_l = ws; LAS float* al_l = ws + 32;
    const int sr = tid >> 4, sc = (tid & 15) * 8, kr_row = tid >> 3, kr_c = tid & 7;
    const int vst0 = v_st(sr, sc), vst1 = v_st(32 + sr, sc), kws = k_addr(sr, tid & 15), kwr = k_addr(kr_row, 16 + kr_c);
    const int vb0 = (int)(uintptr_t)lds + v_rd_base(lane);
    const bf16_t* KNh = KN + row0 * 1024 + h * 128 + sc; const bf16_t* Vh = V + row0 * 1024 + h * 128 + sc; const bf16_t* KRb = KR + row0 * 64 + kr_c * 8;
    bf16x8 st_k0, st_k1, st_kr, st_v0, st_v1;
#define SLOAD(t) do { const size_t k0_ = (size_t)(t) * KVBLK; \
        st_k0 = *(const bf16x8*)(KNh + (k0_ + sr) * 1024); st_k1 = *(const bf16x8*)(KNh + (k0_ + 32 + sr) * 1024); st_kr = *(const bf16x8*)(KRb + (k0_ + kr_row) * 64); \
        st_v0 = *(const bf16x8*)(Vh + (k0_ + sr) * 1024); st_v1 = *(const bf16x8*)(Vh + (k0_ + 32 + sr) * 1024); } while (0)
#define SWRITE(bf) do { *(LAS bf16x8*)(K_lds + (bf) * SHM_K + kws) = st_k0; *(LAS bf16x8*)(K_lds + (bf) * SHM_K + kws + 32 * KPITCH) = st_k1; *(LAS bf16x8*)(K_lds + (bf) * SHM_K + kwr) = st_kr; \
        *(LAS bf16x8*)(V_lds + (bf) * SHM_V + vst0) = st_v0; *(LAS bf16x8*)(V_lds + (bf) * SHM_V + vst1) = st_v1; } while (0)
    SLOAD(0);
    bf16x8 qr[12];
    { const bf16_t* Qw = Q + (row0 + q0 + r32) * 1536 + h * 192 + hi * 8;
#pragma unroll
      for (int d0 = 0; d0 < 12; ++d0) qr[d0] = *(const bf16x8*)(Qw + d0 * 16); }
    float m_reg = -1e30f, l_reg = 0.f; f32x16 o[4] = {};
    f32x16 p0, p1; bf16x8 pa0, pa1, pa2, pa3; float alpha;
    asm volatile("s_waitcnt vmcnt(0)" ::: "memory");
    SWRITE(0);
    __syncthreads();
#define RESC(a) do { if (__any((a) < 1.f)) { if (hi == 0) al_l[r32] = (a); asm volatile("s_waitcnt lgkmcnt(0)" ::: "memory"); \
        _Pragma("unroll") for (int d_ = 0; d_ < 4; ++d_) _Pragma("unroll") for (int r = 0; r < 16; ++r) o[d_][r] *= al_l[crow(r, hi)]; } } while (0)
#define TILE(t, BF) do { const bool more_ = ((t) + 1 < NT); if (more_) SLOAD((t) + 1); SBAR(); \
        qkt<BF>(p0, p1, K_lds, r32, hi, qr); \
        { const int kb_ = (t) * KVBLK; if (kb_ + KVBLK - 1 > q0) mask_tile(p0, p1, q0 + r32 - kb_ - 4 * hi); } \
        softmax_tile(p0, p1, m_reg, l_reg, alpha, pa0, pa1, pa2, pa3); RESC(alpha); SBAR(); \
        pv_tile<BF>(o, vb0, pa0, pa1, pa2, pa3); \
        if (more_) { asm volatile("s_waitcnt vmcnt(0)" ::: "memory"); SWRITE((BF) ^ 1); } \
        __syncthreads(); } while (0)
#pragma unroll 1
    for (int t = 0; t < NT; t += 2) { TILE(t, 0); TILE(t + 1, 1); }
    if (hi == 0) li_l[r32] = l_reg; asm volatile("s_waitcnt lgkmcnt(0)" ::: "memory");
    bf16_t* Ow = O + (row0 + q0) * 1024 + h * 128;
#pragma unroll
    for (int r = 0; r < 16; ++r) { const int orow = crow(r, hi); const float rl = __builtin_amdgcn_rcpf(li_l[orow]);
#pragma unroll
        for (int d0 = 0; d0 < 4; ++d0) { const float v = o[d0][r] * rl; const float vn = __shfl_xor(v, 1);
            if ((r32 & 1) == 0) *(unsigned*)(Ow + (size_t)orow * 1024 + d0 * 32 + r32) = cvt_pk_bf16(v, vn); } }
    __syncthreads();
#undef SLOAD
#undef SWRITE
#undef RESC
#undef TILE
}
#undef SBAR
}

#define XB_TMO      128
#define XB_XCNT(j)  (256  + 64 * (j))
#define XB_XSUB(j)  (1280 + 64 * (j))
#define XB_XGEN(j)  (2304 + 64 * (j))
#define XB_TOP      3328
#define XB_TOPGEN   3392
#define XCD_BAR_WORDS 3456
#define XB_SPIN_CAP (1u << 22)
__device__ __forceinline__ unsigned xb_ld(unsigned* p)              { return __hip_atomic_load(p, __ATOMIC_RELAXED, __HIP_MEMORY_SCOPE_AGENT); }
__device__ __forceinline__ unsigned xb_add(unsigned* p, unsigned v) { return __hip_atomic_fetch_add(p, v, __ATOMIC_RELAXED, __HIP_MEMORY_SCOPE_AGENT); }
__device__ __forceinline__ unsigned xb_xcc_id() { return (unsigned)__builtin_amdgcn_s_getreg((3 << 11) | 20) & 0xFu; }
#define XB_SPIN(cond, bar) do { unsigned _sp = 0; while (cond) { __builtin_amdgcn_s_sleep(1); \
    if ((++_sp & 255u) == 0u) { if (xb_ld(&(bar)[XB_TMO])) break; if (_sp > XB_SPIN_CAP) { atomicAdd(&(bar)[XB_TMO], 1u); break; } } } } while (0)
struct XcdBarrier { unsigned* bar; unsigned x; volatile LAS unsigned* st; };
__device__ __forceinline__ XcdBarrier xcd_barrier_post(unsigned* bar, volatile LAS unsigned* st) {
    XcdBarrier b; b.bar = bar; b.x = xb_xcc_id(); b.st = st;
    if (threadIdx.x == 0) (void)xb_add(&bar[XB_XCNT(b.x)], 1u);
    return b;
}
__device__ __forceinline__ void xcd_barrier_complete(unsigned* bar, unsigned x, unsigned& nloc, unsigned& nx) {
    const unsigned G = gridDim.x * gridDim.y * gridDim.z;
    unsigned sum, cnt, mine, sp = 0u;
    for (;;) {
        sum = 0u; cnt = 0u; mine = 0u;
#pragma unroll
        for (unsigned j = 0; j < 16; ++j) { const unsigned c = xb_ld(&bar[XB_XCNT(j)]); sum += c; cnt += (c > 0u) ? 1u : 0u; mine = (j == x) ? c : mine; }
        if (sum == G) break;
        __builtin_amdgcn_s_sleep(1);
        if ((++sp & 255u) == 0u) { if (xb_ld(&bar[XB_TMO])) break; if (sp > XB_SPIN_CAP) { atomicAdd(&bar[XB_TMO], 1u); break; } }
    }
    nloc = mine > 0u ? mine : 1u; nx = cnt > 0u ? cnt : 1u;
}
__device__ __forceinline__ void xcd_barrier(const XcdBarrier& b) {
    asm volatile("s_waitcnt vmcnt(0)" ::: "memory");
    __syncthreads();
    if (opaque_tid() == 0) {
        unsigned* bar = b.bar; unsigned bx = b.x;
        asm volatile("" : "+s"(bar), "+s"(bx));
        __builtin_amdgcn_s_waitcnt(0);
        unsigned nloc = b.st[0], nx = b.st[1];
        if (nloc == 0u) { xcd_barrier_complete(bar, bx, nloc, nx); b.st[0] = nloc; b.st[1] = nx; }
        const unsigned old = xb_add(&bar[XB_XSUB(bx)], 1u);
        const unsigned gen = old / nloc;
        if (old + 1u == (gen + 1u) * nloc) {
            __builtin_amdgcn_fence(__ATOMIC_RELEASE, "agent");
            asm volatile("s_waitcnt vmcnt(0)" ::: "memory");
            const unsigned og = xb_add(&bar[XB_TOP], 1u);
            const unsigned tg = og / nx;
            if (og + 1u == (tg + 1u) * nx) xb_add(&bar[XB_TOPGEN], 1u);
            else XB_SPIN(xb_ld(&bar[XB_TOPGEN]) == tg, bar);
            __builtin_amdgcn_fence(__ATOMIC_ACQUIRE, "agent");
            xb_add(&bar[XB_XGEN(bx)], 1u);
            asm volatile("s_waitcnt vmcnt(0)" ::: "memory");
        } else {
            XB_SPIN(xb_ld(&bar[XB_XGEN(bx)]) == gen, bar);
            __builtin_amdgcn_fence(__ATOMIC_ACQUIRE, "agent");
            asm volatile("s_waitcnt vmcnt(0)" ::: "memory");
        }
    }
    __syncthreads();
}

struct Args { const void* in[30]; float* out; unsigned char* ws; int ph_lo, ph_hi, li, pad; };
struct Ctx { int tid, lane, wave, vcu, G, bid; LAS unsigned char* lds; volatile LAS int* misc; };
__device__ __forceinline__ Ctx fresh_ctx(const Ctx& c) {
    Ctx r = c; unsigned l = (unsigned)(uintptr_t)c.lds, m = (unsigned)(uintptr_t)c.misc;
    asm volatile("" : "+s"(r.wave), "+s"(r.vcu), "+s"(r.G), "+s"(r.bid), "+s"(l), "+s"(m));
    r.lds = (LAS unsigned char*)(uintptr_t)l; r.misc = (volatile LAS int*)(uintptr_t)m; r.tid = opaque_tid(); r.lane = r.tid & 63; return r; }
typedef const CAS Args* ArgsP;
__device__ __forceinline__ const CAS Args& fresh_args(ArgsP p) { asm volatile("" : "+s"(p)); return *p; }
enum { I_X = 0, I_P, I_POS, I_MLA_WIN, I_MLA_QN, I_MLA_KVN, I_MLA_WUQ, I_MLA_WUKV, I_MLA_WO, I_LRU_WIN, I_LRU_CW, I_LRU_CB, I_LRU_WA, I_LRU_BA, I_LRU_WX, I_LRU_BX, I_LRU_LAM, I_LRU_WOUT,
       I_LN1G, I_LN1B, I_LN2G, I_LN2B, I_MOE_WR, I_MOE_BR, I_MOE_WUP, I_MOE_BUP, I_MOE_WDN, I_MOE_BDN, I_PLE_WG, I_PLE_WP };
#define INF(i) ((const float*)args.in[i])
#define WSP(T_, off) ((T_*)(args.ws + (off)))

__device__ __forceinline__ void tr_item(const float* W, int ld, int k0, int sc0, int sc1, const float* ksc, bf16_t* dst  , int K, LAS float* scr, int lane) {
    const int half = (lane & 15) >> 3, scol = half ? sc1 : sc0, c4 = (lane & 7) * 4, rsub = lane >> 4;
    f32x4 v[16];
#pragma unroll
    for (int i = 0; i < 16; ++i) { const int kk = 4 * i + rsub;
        v[i] = (scol >= 0) ? *(const f32x4*)(W + (size_t)(k0 + kk) * ld + scol + c4) : (f32x4){0.f, 0.f, 0.f, 0.f}; }
    if (ksc) {
#pragma unroll
        for (int i = 0; i < 16; ++i) v[i] = v[i] * ksc[k0 + 4 * i + rsub]; }
#pragma unroll
    for (int i = 0; i < 16; ++i) { LAS float* s = scr + (4 * i + rsub) * 65 + (lane & 15) * 4; s[0] = v[i][0]; s[1] = v[i][1]; s[2] = v[i][2]; s[3] = v[i][3]; }
    asm volatile("s_waitcnt lgkmcnt(0)" ::: "memory");
    const int c = lane & 7;
#pragma unroll
    for (int j = 0; j < 8; ++j) { const int n = (lane >> 3) + 8 * j; const LAS float* s = scr + (8 * c) * 65 + n;
        u32x4 o; o.x = cvt_pk_bf16(s[0 * 65], s[1 * 65]); o.y = cvt_pk_bf16(s[2 * 65], s[3 * 65]); o.z = cvt_pk_bf16(s[4 * 65], s[5 * 65]); o.w = cvt_pk_bf16(s[6 * 65], s[7 * 65]);
        *(u32x4*)(dst + (size_t)n * K + 8 * c) = o; }
    asm volatile("s_waitcnt lgkmcnt(0)" ::: "memory");
}
enum { J_NAT = 0, J_MLA_WIN, J_MLA_WUQ, J_LRU_WAX, J_MOE_UP };
__device__ __forceinline__ int tr_map(int job, int g) {
    switch (job) {
    case J_MLA_WIN: return g < 32 ? 32 * g : (g == 32 ? 1024 : (g == 36 ? 1056 : -1));
    case J_MLA_WUQ: if (g < 32) { const int t = g >> 3, bj = (g >> 2) & 1, cg = g & 3; return (2 * t + bj) * 192 + 32 * cg; }
                    else { const int g2 = g - 32, t2 = g2 >> 3, bj = (g2 >> 2) & 1, hh = g2 & 3; return (4 * t2 + hh) * 192 + 128 + 32 * bj; }
    case J_LRU_WAX: { const int pn = g >> 3, cg = g & 3; return 128 * pn + 32 * cg; }
    case J_MOE_UP:  { const int pn = g >> 3, bj = (g >> 2) & 1, cg = g & 3; return bj * 1024 + 128 * pn + 32 * cg; }
    default: return 32 * g;
    }
}
__device__ __forceinline__ void tr_job(const Ctx& C, int job, const float* src, size_t srcstride, int nmat, int K, int ld, int N, bf16_t* dst, size_t dststride, const float* ksc, int kscstride,
                                       const float* src2  ) {
    LAS float* scr = (LAS float*)(C.lds + C.wave * 16640);
    const int gw = C.vcu * NWAVES + C.wave, NGW = C.G * NWAVES;
    const int nkb = K / 64, nnb = N / 64, per = nkb * nnb, total = per * nmat;
    for (int it = gw; it < total; it += NGW) {
        const int mat = it / per, r = it - mat * per, kb = r / nnb, nb = r - kb * nnb;
        int s0 = tr_map(job, 2 * nb), s1 = tr_map(job, 2 * nb + 1);
        const float* W = src + (size_t)mat * srcstride;
        if (job == J_LRU_WAX && ((nb >> 1) & 1)) W = src2 + (size_t)mat * srcstride;
        tr_item(W, ld, kb * 64, s0, s1, ksc ? ksc + (size_t)mat * kscstride : nullptr, (bf16_t*)((char*)dst + (size_t)mat * dststride) + (size_t)(nb * 64) * K + kb * 64, K, scr, C.lane);
    }
}
__device__ __forceinline__ void cvt_rows(const Ctx& C, const float* src, bf16_t* dst, size_t n8  ) {
    const size_t gt = (size_t)C.vcu * 512 + C.tid, NT = (size_t)C.G * 512;
    for (size_t i = gt; i < n8; i += NT) { const f32x4 a = *(const f32x4*)(src + i * 8), b = *(const f32x4*)(src + i * 8 + 4); *(u32x4*)(dst + i * 8) = pack8(a, b); }
}
__device__ __forceinline__ void phase_prologue(const CAS Args& args, const Ctx& C) {
    tr_job(C, J_MLA_WIN, INF(I_MLA_WIN), (size_t)DM * LATD, 2, DM, LATD, 1280, WSP(bf16_t, WS_W_MLA + OFF_MLA_WIN), W_MLA_STRIDE, nullptr, 0, nullptr);
    tr_job(C, J_MLA_WUQ, INF(I_MLA_WUQ), (size_t)QL * 1536, 2, QL, 1536, 1536, WSP(bf16_t, WS_W_MLA + OFF_MLA_WUQ), W_MLA_STRIDE, INF(I_MLA_QN), QL, nullptr);
    tr_job(C, J_NAT, INF(I_MLA_WUKV), (size_t)KVL * 2048, 2, KVL, 2048, 2048, WSP(bf16_t, WS_W_MLA + OFF_MLA_WUKV), W_MLA_STRIDE, INF(I_MLA_KVN), KVL, nullptr);
    tr_job(C, J_NAT, INF(I_MLA_WO), (size_t)DM * DM, 2, DM, DM, DM, WSP(bf16_t, WS_W_MLA + OFF_MLA_WO), W_MLA_STRIDE, nullptr, 0, nullptr);
    tr_job(C, J_NAT, INF(I_LRU_WIN), (size_t)DM * 2048, 2, DM, 2048, 2048, WSP(bf16_t, WS_W_LRU + OFF_LRU_WIN), W_LRU_STRIDE, nullptr, 0, nullptr);
    for (int j = 0; j < 2; ++j)
        tr_job(C, J_LRU_WAX, INF(I_LRU_WA) + (size_t)j * 4 * 65536, (size_t)256 * 256, 4, 256, 256, 512, WSP(bf16_t, WS_W_LRU + OFF_LRU_WAX + (size_t)j * W_LRU_STRIDE), (size_t)512 * 256 * 2, nullptr, 0, INF(I_LRU_WX) + (size_t)j * 4 * 65536);
    tr_job(C, J_NAT, INF(I_LRU_WOUT), (size_t)DM * DM, 2, DM, DM, DM, WSP(bf16_t, WS_W_LRU + OFF_LRU_WOUT), W_LRU_STRIDE, nullptr, 0, nullptr);
    tr_job(C, J_NAT, INF(I_PLE_WG), (size_t)DM * DM, 4, DM, DM, DM, WSP(bf16_t, WS_W_PLE + OFF_PLE_WG), W_PLE_STRIDE, nullptr, 0, nullptr);
    tr_job(C, J_NAT, INF(I_PLE_WP), (size_t)PLED * DM, 4, PLED, DM, DM, WSP(bf16_t, WS_W_PLE + OFF_PLE_WP), W_PLE_STRIDE, nullptr, 0, nullptr);
    tr_job(C, J_MOE_UP, INF(I_MOE_WUP), (size_t)DM * 2048, DEPTH * NE, DM, 2048, 2048, WSP(bf16_t, WS_W_UP), (size_t)2048 * 1024 * 2, nullptr, 0, nullptr);
    tr_job(C, J_NAT, INF(I_MOE_WDN), (size_t)DFF * DM, DEPTH * NE, DFF, DM, DM, WSP(bf16_t, WS_W_DN), (size_t)1024 * 1024 * 2, nullptr, 0, nullptr);
    cvt_rows(C, INF(I_X), WSP(bf16_t, WS_XB), (size_t)T * DM / 8);
    cvt_rows(C, INF(I_P), WSP(bf16_t, WS_PB), (size_t)DEPTH * T * PLED / 8);
    { const int* pos = (const int*)args.in[I_POS]; float* CS = WSP(float, WS_CS); float* SN = WSP(float, WS_SN);
      const size_t gt = (size_t)C.vcu * 512 + C.tid, NT = (size_t)C.G * 512;
      for (size_t i = gt; i < (size_t)T * 32; i += NT) { const int tok = (int)(i >> 5), j = (int)(i & 31);
          const double inv = exp(-9.210340371976184 * (double)j / 32.0); const double ang = (double)pos[tok] * inv; double s, c; sincos(ang, &s, &c); CS[i] = (float)c; SN[i] = (float)s; }
      float* SPL = WSP(float, WS_SPL); const float* lam = INF(I_LRU_LAM);
      for (size_t i = gt; i < 2 * 1024; i += NT) { const double l = (double)lam[i]; SPL[i] = (float)(-8.0 * log1p(exp(-l))); } }
}

__device__ __forceinline__ void moe_table(const CAS Args& args, const Ctx& C0, int layer) {
    Ctx C = C0; C.tid = opaque_tid(); C.lane = C.tid & 63;
    const unsigned* cnt = WSP(unsigned, WS_CTL) + CW_CNT + 64 * layer;
    __syncthreads();
    if (C.tid < 32) C.misc[64 + C.tid] = (int)__hip_atomic_load(cnt + C.tid, __ATOMIC_RELAXED, __HIP_MEMORY_SCOPE_AGENT);
    __syncthreads();
    if (C.tid == 0) { int acc = 0; for (int e = 0; e < 32; ++e) { C.misc[16 + e] = acc; acc += (C.misc[64 + e] + 255) >> 8; } C.misc[16 + 32] = acc; }
    __syncthreads();
    { volatile LAS int* te = (volatile LAS int*)(C.lds + TILE_E_OFF);
      for (int mg = C.tid; mg < C.misc[48]; mg += NWAVES * 64) { int e = 0; for (int j = 1; j < 32; ++j) e += (C.misc[16 + j] <= mg) ? 1 : 0; te[mg] = e; } }
    __syncthreads();
}

__device__ __forceinline__ void phase_ln_router(const CAS Args& args, const Ctx& C0, int layer) {
    const int cslot = layer + args.pad;
    Ctx C = C0; C.tid = opaque_tid(); C.lane = C.tid & 63;
    const bf16_t* Y = WSP(bf16_t, WS_Y); float* X1 = WSP(float, WS_X1); bf16_t* X1B = WSP(bf16_t, WS_X1B);
    const float* g1 = INF(I_LN1G) + layer * DM; const float* b1 = INF(I_LN1B) + layer * DM;
    const CAS float* Wr = (const CAS float*)(INF(I_MOE_WR) + (size_t)layer * DM * NE); const float* br = INF(I_MOE_BR) + layer * NE;
    unsigned* gcnt = WSP(unsigned, WS_CTL) + CW_CNT + 64 * cslot;
    int* lists = WSP(int, WS_LIST); int* slot = WSP(int, WS_SLOT); float* gate = WSP(float, WS_GATE);
    LAS float* part = (LAS float*)C.lds;
    volatile LAS int* lcnt = (volatile LAS int*)(C.lds + 69632);
    volatile LAS int* lbase = lcnt + 32;
    f32x4 gv[4], bv[4];
#pragma unroll
    for (int j = 0; j < 2; ++j) { gv[2 * j] = *(const f32x4*)(g1 + 8 * C.lane + 512 * j); gv[2 * j + 1] = *(const f32x4*)(g1 + 8 * C.lane + 512 * j + 4);
        bv[2 * j] = *(const f32x4*)(b1 + 8 * C.lane + 512 * j); bv[2 * j + 1] = *(const f32x4*)(b1 + 8 * C.lane + 512 * j + 4); }
    for (int chunk = C.vcu; chunk < T / 128; chunk += C.G) {
        const int row0 = chunk * 128;
        if (C.tid < 32) lcnt[C.tid] = 0;
#pragma unroll 1
        for (int i = 0; i < 16; ++i) { const size_t row = (size_t)row0 + C.wave * 16 + i;
            f32x4 v[4]; float s = 0.f;
#pragma unroll
            for (int j = 0; j < 2; ++j) { const u32x4 w = *(const u32x4*)(Y + row * DM + 8 * C.lane + 512 * j); v[2 * j] = pg8::bf4_lo(w); v[2 * j + 1] = pg8::bf4_hi(w); }
#pragma unroll
            for (int j = 0; j < 4; ++j) s += (v[j][0] + v[j][1]) + (v[j][2] + v[j][3]);
            const float mean = wave_sum(s) * (1.f / DM); float s2 = 0.f;
#pragma unroll
            for (int j = 0; j < 4; ++j) { v[j] = v[j] - mean; s2 += (v[j][0] * v[j][0] + v[j][1] * v[j][1]) + (v[j][2] * v[j][2] + v[j][3] * v[j][3]); }
            const float rstd = 1.f / sqrtf(wave_sum(s2) * (1.f / DM) + LN_EPS);
#pragma unroll
            for (int j = 0; j < 4; ++j) v[j] = v[j] * rstd * gv[j] + bv[j];
#pragma unroll
            for (int j = 0; j < 2; ++j) { float* xo = X1 + row * DM + 8 * C.lane + 512 * j; *(f32x4*)xo = v[2 * j]; *(f32x4*)(xo + 4) = v[2 * j + 1];
                *(u32x4*)(X1B + row * DM + 8 * C.lane + 512 * j) = pack8(v[2 * j], v[2 * j + 1]); } }
        asm volatile("s_waitcnt vmcnt(0)" ::: "memory");
        __syncthreads();
        { const int grp = C.wave >> 2, kq = C.wave & 3; const size_t tok = (size_t)row0 + grp * 64 + C.lane;
          float acc[32];
#pragma unroll
          for (int e = 0; e < 32; ++e) acc[e] = 0.f;
          const float* xr = X1 + tok * DM + kq * 256;
          for (int kk = 0; kk < 64; ++kk) { const f32x4 xv = *(const f32x4*)(xr + kk * 4);
#pragma unroll
              for (int i = 0; i < 4; ++i) { const CAS float* wrow = Wr + (size_t)(kq * 256 + kk * 4 + i) * NE;
#pragma unroll
                  for (int e = 0; e < 32; ++e) acc[e] = fmaf(xv[i], wrow[e], acc[e]);
                  if (i & 1) __builtin_amdgcn_sched_barrier(0); } }
          LAS float* pp = part + ((grp * 4 + kq) * 64 + C.lane) * 33;
#pragma unroll
          for (int e = 0; e < 32; ++e) pp[e] = acc[e]; }
        __syncthreads();
        int te[4] = {0, 0, 0, 0}, lp[4] = {0, 0, 0, 0}; float tg[4] = {0.f, 0.f, 0.f, 0.f};
        if (C.tid < 128) { const int grp = C.tid >> 6, ln = C.tid & 63; float lg[32];
#pragma unroll
            for (int e = 0; e < 32; ++e) { float s = br[e];
#pragma unroll
                for (int kq = 0; kq < 4; ++kq) s += part[((grp * 4 + kq) * 64 + ln) * 33 + e];
                lg[e] = s; }
            float tv[4];
#pragma unroll
            for (int k = 0; k < 4; ++k) { float best = lg[0]; int bi = 0;
#pragma unroll
                for (int e = 1; e < 32; ++e) { const bool gt = lg[e] > best; best = gt ? lg[e] : best; bi = gt ? e : bi; }
                te[k] = bi; tv[k] = best;
#pragma unroll
                for (int e = 0; e < 32; ++e) lg[e] = (e == bi) ? -__builtin_inff() : lg[e]; }
            float den = 0.f;
#pragma unroll
            for (int k = 0; k < 4; ++k) { tg[k] = __expf(tv[k] - tv[0]); den += tg[k]; }
            const float rden = 1.0f / den;
#pragma unroll
            for (int k = 0; k < 4; ++k) { tg[k] *= rden; lp[k] = __hip_atomic_fetch_add((LAS int*)&lcnt[te[k]], 1, __ATOMIC_RELAXED, __HIP_MEMORY_SCOPE_WORKGROUP); } }
        __syncthreads();
        if (C.tid < 32) lbase[C.tid] = (int)__hip_atomic_fetch_add(gcnt + C.tid, (unsigned)lcnt[C.tid], __ATOMIC_RELAXED, __HIP_MEMORY_SCOPE_AGENT);
        __syncthreads();
        if (C.tid < 128) { const int tok = row0 + C.tid;
#pragma unroll
            for (int k = 0; k < 4; ++k) { const int pos = lbase[te[k]] + lp[k]; lists[(size_t)te[k] * T + pos] = tok; slot[tok * 4 + k] = te[k] * T + pos; gate[tok * 4 + k] = tg[k]; } }
        __syncthreads();
    }
}

__device__ __forceinline__ void phase_combine_ln2(const CAS Args& args, const Ctx& C0, int layer) {
    Ctx C = C0; C.tid = opaque_tid(); C.lane = C.tid & 63;
    moe_table(args, C, layer);
    const bf16_t* X1B = WSP(bf16_t, WS_X1B); const bf16_t* YS = WSP(bf16_t, WS_YS); const int* slot = WSP(int, WS_SLOT); const float* gate = WSP(float, WS_GATE);
    bf16_t* X2B = WSP(bf16_t, WS_X2B);
    const float* g2 = INF(I_LN2G) + layer * DM; const float* b2 = INF(I_LN2B) + layer * DM;
    f32x4 gv[4], bv[4];
#pragma unroll
    for (int j = 0; j < 2; ++j) { gv[2 * j] = *(const f32x4*)(g2 + 8 * C.lane + 512 * j); gv[2 * j + 1] = *(const f32x4*)(g2 + 8 * C.lane + 512 * j + 4);
        bv[2 * j] = *(const f32x4*)(b2 + 8 * C.lane + 512 * j); bv[2 * j + 1] = *(const f32x4*)(b2 + 8 * C.lane + 512 * j + 4); }
    const int gw = C.vcu * NWAVES + C.wave, NGW = C.G * NWAVES;
    for (int row = gw; row < T; row += NGW) {
        f32x4 v[4];
#pragma unroll
        for (int j = 0; j < 2; ++j) { const u32x4 w = *(const u32x4*)(X1B + (size_t)row * DM + 8 * C.lane + 512 * j); v[2 * j] = pg8::bf4_lo(w) * ALPHA; v[2 * j + 1] = pg8::bf4_hi(w) * ALPHA; }
#pragma unroll
        for (int k = 0; k < 4; ++k) { const int sv = slot[row * 4 + k]; const float g = gate[row * 4 + k]; const int e = sv >> 15, pos = sv & (T - 1);
            const size_t prow = (size_t)C.misc[16 + e] * 256 + pos;
#pragma unroll
            for (int j = 0; j < 2; ++j) { const u32x4 w = *(const u32x4*)(YS + prow * DM + 8 * C.lane + 512 * j); v[2 * j] += pg8::bf4_lo(w) * g; v[2 * j + 1] += pg8::bf4_hi(w) * g; } }
        float s = 0.f;
#pragma unroll
        for (int j = 0; j < 4; ++j) s += (v[j][0] + v[j][1]) + (v[j][2] + v[j][3]);
        const float mean = wave_sum(s) * (1.f / DM); float s2 = 0.f;
#pragma unroll
        for (int j = 0; j < 4; ++j) { v[j] = v[j] - mean; s2 += (v[j][0] * v[j][0] + v[j][1] * v[j][1]) + (v[j][2] * v[j][2] + v[j][3] * v[j][3]); }
        const float rstd = 1.f / sqrtf(wave_sum(s2) * (1.f / DM) + LN_EPS);
#pragma unroll
        for (int j = 0; j < 4; ++j) v[j] = v[j] * rstd * gv[j] + bv[j];
#pragma unroll
        for (int j = 0; j < 2; ++j) *(u32x4*)(X2B + (size_t)row * DM + 8 * C.lane + 512 * j) = pack8(v[2 * j], v[2 * j + 1]);
    }
}

__device__ __forceinline__ void phase_conv(const CAS Args& args, const Ctx& C0, int j) {
    Ctx C = C0; C.tid = opaque_tid(); C.lane = C.tid & 63;
    const bf16_t* U = WSP(bf16_t, WS_U); bf16_t* UC = WSP(bf16_t, WS_UC);
    const float* cw = INF(I_LRU_CW) + (size_t)j * 4 * DM; const float* cb = INF(I_LRU_CB) + (size_t)j * DM;
    const int c8 = (C.tid & 127) * 8, rsub = C.tid >> 7;
    float w[4][8], bb[8];
#pragma unroll
    for (int q = 0; q < 4; ++q)
#pragma unroll
        for (int e = 0; e < 8; ++e) w[q][e] = cw[q * DM + c8 + e];
#pragma unroll
    for (int e = 0; e < 8; ++e) bb[e] = cb[c8 + e];
    for (int chunk = C.vcu; chunk < T / 128; chunk += C.G) {
        const int r0 = chunk * 128 + rsub * 32;
        u32x4 h0, h1, h2;
        const u32x4 z = {0u, 0u, 0u, 0u};
        const int s0 = r0 & (SEQ - 1);
        h0 = s0 >= 3 ? *(const u32x4*)(U + (size_t)(r0 - 3) * DM + c8) : z; h1 = s0 >= 2 ? *(const u32x4*)(U + (size_t)(r0 - 2) * DM + c8) : z; h2 = s0 >= 1 ? *(const u32x4*)(U + (size_t)(r0 - 1) * DM + c8) : z;
#pragma unroll 4
        for (int i = 0; i < 32; ++i) { const u32x4 h3 = *(const u32x4*)(U + (size_t)(r0 + i) * DM + c8);
            float o[8];
#pragma unroll
            for (int q = 0; q < 4; ++q) { const unsigned a = h0[q], b = h1[q], c = h2[q], d = h3[q];
                o[2 * q] = bb[2 * q] + w[0][2 * q] * bf_lo(a) + w[1][2 * q] * bf_lo(b) + w[2][2 * q] * bf_lo(c) + w[3][2 * q] * bf_lo(d);
                o[2 * q + 1] = bb[2 * q + 1] + w[0][2 * q + 1] * bf_hi(a) + w[1][2 * q + 1] * bf_hi(b) + w[2][2 * q + 1] * bf_hi(c) + w[3][2 * q + 1] * bf_hi(d); }
            u32x4 ow; ow.x = cvt_pk_bf16(o[0], o[1]); ow.y = cvt_pk_bf16(o[2], o[3]); ow.z = cvt_pk_bf16(o[4], o[5]); ow.w = cvt_pk_bf16(o[6], o[7]);
            *(u32x4*)(UC + (size_t)(r0 + i) * DM + c8) = ow; h0 = h1; h1 = h2; h2 = h3; }
    }
}
__device__ __forceinline__ void phase_scan1(const CAS Args& args, const Ctx& C0) {
    Ctx C = C0; C.tid = opaque_tid(); C.lane = C.tid & 63;
    const bf16_t* LA = WSP(bf16_t, WS_AA); const bf16_t* BB = WSP(bf16_t, WS_BB); float* CA = WSP(float, WS_CA); float* CH = WSP(float, WS_CH);
    const int c2 = C.tid * 2;
    for (int item = C.vcu; item < NBATCH * 64; item += C.G) {
        const size_t r0 = (size_t)item * 64; float h0 = 0.f, h1 = 0.f, l0 = 0.f, l1 = 0.f;
#pragma unroll 8
        for (int s = 0; s < 64; ++s) { const unsigned aw = *(const unsigned*)(LA + (r0 + s) * DM + c2), bw = *(const unsigned*)(BB + (r0 + s) * DM + c2);
            const float la0 = bf_lo(aw), la1 = bf_hi(aw);
            h0 = __builtin_amdgcn_exp2f(la0) * h0 + bf_lo(bw); h1 = __builtin_amdgcn_exp2f(la1) * h1 + bf_hi(bw); l0 += la0; l1 += la1; }
        *(f32x2*)(CA + (size_t)item * DM + c2) = (f32x2){__builtin_amdgcn_exp2f(l0), __builtin_amdgcn_exp2f(l1)}; *(f32x2*)(CH + (size_t)item * DM + c2) = (f32x2){h0, h1};
    }
}
__device__ __forceinline__ void phase_scan2(const CAS Args& args, const Ctx& C0) {
    Ctx C = C0; C.tid = opaque_tid(); C.lane = C.tid & 63;
    const bf16_t* LA = WSP(bf16_t, WS_AA); const bf16_t* BB = WSP(bf16_t, WS_BB); const float* CA = WSP(float, WS_CA); const float* CH = WSP(float, WS_CH);
    const bf16_t* GG = WSP(bf16_t, WS_GG); bf16_t* YL = WSP(bf16_t, WS_O);
    const int c2 = C.tid * 2;
    for (int item = C.vcu; item < NBATCH * 64; item += C.G) {
        const int b = item >> 6, ch = item & 63; float h0 = 0.f, h1 = 0.f;
        for (int jx = 0; jx < ch; ++jx) { const f32x2 a = *(const f32x2*)(CA + (size_t)(b * 64 + jx) * DM + c2), e = *(const f32x2*)(CH + (size_t)(b * 64 + jx) * DM + c2);
            h0 = a[0] * h0 + e[0]; h1 = a[1] * h1 + e[1]; }
        const size_t r0 = (size_t)item * 64;
#pragma unroll 8
        for (int s = 0; s < 64; ++s) { const unsigned aw = *(const unsigned*)(LA + (r0 + s) * DM + c2), bw = *(const unsigned*)(BB + (r0 + s) * DM + c2), g = *(const unsigned*)(GG + (r0 + s) * DM + c2);
            h0 = __builtin_amdgcn_exp2f(bf_lo(aw)) * h0 + bf_lo(bw); h1 = __builtin_amdgcn_exp2f(bf_hi(aw)) * h1 + bf_hi(bw);
            *(unsigned*)(YL + (r0 + s) * DM + c2) = cvt_pk_bf16(bf_lo(g) * h0, bf_hi(g) * h1); }
    }
}

constexpr int PH_PER_LAYER = 12, PH_TOTAL = 2 + PH_PER_LAYER * DEPTH;
__global__ void __launch_bounds__(NWAVES * 64, 2) fwd_kernel(Args args_kernarg) {
    (void)args_kernarg;
    ArgsP const argp = (ArgsP)__builtin_amdgcn_kernarg_segment_ptr();
    const CAS Args& args0 = *argp;
    extern __shared__ __attribute__((aligned(16))) unsigned char lds_raw[];
    Ctx C_;
    C_.lds = (LAS unsigned char*)lds_raw; C_.misc = (volatile LAS int*)(C_.lds + MISC_OFF);
    C_.tid = threadIdx.x; C_.lane = C_.tid & 63; C_.wave = __builtin_amdgcn_readfirstlane(C_.tid >> 6);
    C_.bid = (int)blockIdx.x; C_.G = gridDim.x; { const int bx = blockIdx.x; C_.vcu = (C_.G % 8 == 0) ? (bx % 8) * (C_.G / 8) + bx / 8 : bx; }
    for (int u = C_.tid; u < 128; u += NWAVES * 64) C_.misc[u] = 0;
    __syncthreads();
    XcdBarrier bar = xcd_barrier_post((unsigned*)(args0.ws + WS_CTL) + CW_BAR + args0.li * XCD_BAR_WORDS, (volatile LAS unsigned*)C_.misc);
    const int lo = args0.ph_lo, hi = args0.ph_hi;
#define IN(k) (lo <= (k) && (k) < hi)
#define PH_END(k) do { if ((k) + 1 < hi) xcd_barrier(bar); } while (0)

    if (SEL(0) && IN(0)) { const CAS Args& args = fresh_args(argp); const Ctx C = fresh_ctx(C_); const int cid = C.bid; phase_prologue(args, C); PH_END(0); }
    if (SEL(1) && IN(1)) { const CAS Args& args = fresh_args(argp); const Ctx C = fresh_ctx(C_); const int cid = C.bid;
        pg8::DenseSched S; S.init(WSP(bf16_t, WS_PB), WSP(bf16_t, WS_W_PLE + OFF_PLE_WP), PLED, PLED, DEPTH * T, DM, C.G, cid); S.bpm_shift = 7; S.bbatch = W_PLE_STRIDE;
        pg8::EpiPP E{WSP(bf16_t, WS_PP)};
        pg8::gemm_phase<pg8::EpiPP, pg8::DenseSched, false>(C.lds, PLED, PLED, PLED, S, E);
        PH_END(1);
    }
    for (int layer = 0; layer < DEPTH; ++layer) {
        const int base = 2 + PH_PER_LAYER * layer, j = layer >> 1;
        if ((layer & 1) == 0) {
            if (SEL(2) && IN(base + 0)) { const CAS Args& args = fresh_args(argp); const Ctx C = fresh_ctx(C_); const int cid = C.bid; const unsigned char* wm = args.ws + WS_W_MLA + (size_t)j * W_MLA_STRIDE;
                pg8::DenseSched S; S.init(WSP(bf16_t, WS_XB), wm + OFF_MLA_WIN, DM, DM, T, 1280, C.G, cid);
                pg8::EpiLat E{WSP(bf16_t, WS_LAT), WSP(float, WS_SSQ), WSP(bf16_t, WS_KR), WSP(float, WS_CS), WSP(float, WS_SN)};
                pg8::gemm_phase<pg8::EpiLat, pg8::DenseSched, false>(C.lds, DM, DM, DM, S, E);
                PH_END(base + 0);
            }
            if (SEL(3) && IN(base + 1)) { const CAS Args& args = fresh_args(argp); const Ctx C = fresh_ctx(C_); const int cid = C.bid; const unsigned char* wm = args.ws + WS_W_MLA + (size_t)j * W_MLA_STRIDE;
                { pg8::DenseSched S; S.init(WSP(bf16_t, WS_LAT), wm + OFF_MLA_WUQ, DM, QL, T, 1536, C.G, cid);
                  pg8::EpiQ E{WSP(bf16_t, WS_Q), WSP(float, WS_SSQ), WSP(float, WS_CS), WSP(float, WS_SN)};
                  pg8::gemm_phase<pg8::EpiQ, pg8::DenseSched, false>(C.lds, QL, DM, QL, S, E); }
                { pg8::DenseSched S; S.init(WSP(bf16_t, WS_LAT) + QL, wm + OFF_MLA_WUKV, DM, KVL, T, 2048, C.G, cid);
                  pg8::EpiKV E{WSP(bf16_t, WS_KN), WSP(bf16_t, WS_V), WSP(float, WS_SSQ)};
                  pg8::gemm_phase<pg8::EpiKV, pg8::DenseSched, false>(C.lds, KVL, DM, KVL, S, E); }
                PH_END(base + 1);
            }
            if (SEL(4) && IN(base + 2)) { const CAS Args& args = fresh_args(argp); const Ctx C = fresh_ctx(C_); const int cid = C.bid;
                for (int it = C.vcu; it < NBATCH * NH * 8; it += C.G) { const int bh = it >> 3, pr = it & 7;
                    att::attn_block(bh >> 3, bh & 7, pr, WSP(bf16_t, WS_Q), WSP(bf16_t, WS_KN), WSP(bf16_t, WS_KR), WSP(bf16_t, WS_V), WSP(bf16_t, WS_O), (LAS char*)C.lds);
                    att::attn_block(bh >> 3, bh & 7, 15 - pr, WSP(bf16_t, WS_Q), WSP(bf16_t, WS_KN), WSP(bf16_t, WS_KR), WSP(bf16_t, WS_V), WSP(bf16_t, WS_O), (LAS char*)C.lds); }
                PH_END(base + 2);
            }
        } else {
            if (SEL(5) && IN(base + 0)) { const CAS Args& args = fresh_args(argp); const Ctx C = fresh_ctx(C_); const int cid = C.bid; const unsigned char* wl = args.ws + WS_W_LRU + (size_t)j * W_LRU_STRIDE;
                pg8::DenseSched S; S.init(WSP(bf16_t, WS_XB), wl + OFF_LRU_WIN, DM, DM, T, 2048, C.G, cid);
                pg8::EpiGU E{WSP(bf16_t, WS_GG), WSP(bf16_t, WS_U)};
                pg8::gemm_phase<pg8::EpiGU, pg8::DenseSched, false>(C.lds, DM, DM, DM, S, E);
                PH_END(base + 0);
            }
            if (SEL(6) && IN(base + 1)) { const CAS Args& args = fresh_args(argp); const Ctx C = fresh_ctx(C_); const int cid = C.bid; phase_conv(args, C, j); PH_END(base + 1); }
            if (SEL(7) && IN(base + 2)) { const CAS Args& args = fresh_args(argp); const Ctx C = fresh_ctx(C_); const int cid = C.bid; const unsigned char* wl = args.ws + WS_W_LRU + (size_t)j * W_LRU_STRIDE;
                pg8::DenseSched S; S.init(WSP(bf16_t, WS_UC), wl + OFF_LRU_WAX, DM, 256, T, 2048, C.G, cid); S.apn_shift = 1; S.akbytes = 512;
                pg8::EpiAB E{WSP(bf16_t, WS_AA), WSP(bf16_t, WS_BB), WSP(bf16_t, WS_UC), INF(I_LRU_BA) + j * DM, INF(I_LRU_BX) + j * DM, WSP(float, WS_SPL) + j * DM};
                pg8::gemm_phase<pg8::EpiAB, pg8::DenseSched, false>(C.lds, 256, DM, 256, S, E);
                PH_END(base + 2);
            }
            if (SEL(8) && IN(base + 3)) { const CAS Args& args = fresh_args(argp); const Ctx C = fresh_ctx(C_); const int cid = C.bid; phase_scan1(args, C); PH_END(base + 3); }
            if (SEL(9) && IN(base + 4)) { const CAS Args& args = fresh_args(argp); const Ctx C = fresh_ctx(C_); const int cid = C.bid; phase_scan2(args, C); PH_END(base + 4); }
        }
        if (SEL(10) && IN(base + 5)) { const CAS Args& args = fresh_args(argp); const Ctx C = fresh_ctx(C_); const int cid = C.bid;
            const unsigned char* wo = (layer & 1) ? args.ws + WS_W_LRU + (size_t)j * W_LRU_STRIDE + OFF_LRU_WOUT : args.ws + WS_W_MLA + (size_t)j * W_MLA_STRIDE + OFF_MLA_WO;
            pg8::DenseSched S; S.init(WSP(bf16_t, WS_O), wo, DM, DM, T, DM, C.G, cid);
            pg8::EpiRes E{WSP(bf16_t, WS_XB), WSP(bf16_t, WS_Y)};
            pg8::gemm_phase<pg8::EpiRes, pg8::DenseSched, false>(C.lds, DM, DM, DM, S, E);
            PH_END(base + 5);
        }
        if (SEL(11) && IN(base + 6)) { const CAS Args& args = fresh_args(argp); const Ctx C = fresh_ctx(C_); const int cid = C.bid; phase_ln_router(args, C, layer); PH_END(base + 6); }
        if (SEL(12) && IN(base + 7)) { const CAS Args& args = fresh_args(argp); const Ctx C = fresh_ctx(C_); const int cid = C.bid;
            moe_table(args, C, layer);
            pg8::MoeSched S{(const char*)WSP(bf16_t, WS_X1B), (const char*)(args.ws + WS_W_UP + (size_t)layer * NE * 2048 * 1024 * 2), (size_t)2048 * 1024 * 2, DM, DM, 8, WSP(int, WS_LIST), C.misc + 16, (volatile LAS const int*)(C.lds + TILE_E_OFF), C.G, cid, true};
            pg8::EpiUp E{WSP(bf16_t, WS_H), INF(I_MOE_BUP) + (size_t)layer * NE * 2048};
            pg8::gemm_phase<pg8::EpiUp, pg8::MoeSched, true>(C.lds, DM, DM, DM, S, E, PROBE_T ? (unsigned long long*)(args.ws + WS_CTL + 8192) : nullptr);
            PH_END(base + 7);
        }
        if (SEL(13) && IN(base + 8)) { const CAS Args& args = fresh_args(argp); const Ctx C = fresh_ctx(C_); const int cid = C.bid;
            moe_table(args, C, layer);
            pg8::MoeSched S{(const char*)WSP(bf16_t, WS_H), (const char*)(args.ws + WS_W_DN + (size_t)layer * NE * 1024 * 1024 * 2), (size_t)1024 * 1024 * 2, DFF, DFF, 4, WSP(int, WS_LIST), C.misc + 16, (volatile LAS const int*)(C.lds + TILE_E_OFF), C.G, cid, false};
            pg8::EpiDown E{WSP(bf16_t, WS_YS), INF(I_MOE_BDN) + (size_t)layer * NE * DM};
            pg8::gemm_phase<pg8::EpiDown, pg8::MoeSched, false>(C.lds, DFF, DFF, DFF, S, E);
            PH_END(base + 8);
        }
        if (SEL(14) && IN(base + 9)) { const CAS Args& args = fresh_args(argp); const Ctx C = fresh_ctx(C_); const int cid = C.bid; phase_combine_ln2(args, C, layer); PH_END(base + 9); }
        if (SEL(15) && IN(base + 10)) { const CAS Args& args = fresh_args(argp); const Ctx C = fresh_ctx(C_); const int cid = C.bid;
            pg8::DenseSched S; S.init(WSP(bf16_t, WS_X2B), args.ws + WS_W_PLE + (size_t)layer * W_PLE_STRIDE + OFF_PLE_WG, DM, DM, T, DM, C.G, cid);
            pg8::EpiPle E{WSP(bf16_t, WS_X2B), WSP(bf16_t, WS_PP) + (size_t)layer * T * DM, layer == DEPTH - 1 ? args.out : (float*)nullptr, WSP(bf16_t, WS_XB)};
            pg8::gemm_phase<pg8::EpiPle, pg8::DenseSched, false>(C.lds, DM, DM, DM, S, E);
            if (layer + 1 < DEPTH) PH_END(base + 10);
        }
    }
#if PROBE_T
    { xcd_barrier(bar); const CAS Args& args = fresh_args(argp);
      const unsigned long long* pw = (const unsigned long long*)(args.ws + WS_CTL + 8192);
      const double pk = (double)__hip_atomic_load(pw + 0, __ATOMIC_RELAXED, __HIP_MEMORY_SCOPE_AGENT), pe = (double)__hip_atomic_load(pw + 1, __ATOMIC_RELAXED, __HIP_MEMORY_SCOPE_AGENT),
                   pn = (double)__hip_atomic_load(pw + 2, __ATOMIC_RELAXED, __HIP_MEMORY_SCOPE_AGENT), pt = (double)__hip_atomic_load(pw + 3, __ATOMIC_RELAXED, __HIP_MEMORY_SCOPE_AGENT);
      float c = 100.f;
      if (PROBE_T == 2) c = (float)(pk / (pn * 16.0) / 10.0);
      if (PROBE_T == 3) c = (float)(pe / pn / 100.0);
      if (PROBE_T == 4) c = (float)((pt - pk - pe) / pn / 100.0);
      if (PROBE_T == 5) c = (float)(pn);
      if (PROBE_T >= 2) c = exp2f(floorf(log2f(c) * 8.0f + PROBE_SHIFT) * 0.125f);
      for (size_t i = (size_t)blockIdx.x * 512 + threadIdx.x; i < (size_t)T * DM; i += (size_t)gridDim.x * 512) args.out[i] = c; }
#endif
#undef IN
#undef PH_END
}

extern "C" void kernel_launch(void* const* d_in, const int* in_sizes, int n_in, void* d_out, int out_size, void* d_ws, size_t ws_size, hipStream_t stream) {
    static int grid = 0;
    if (grid == 0) {
        if (n_in != 30 || in_sizes[0] != T * DM || out_size != T * DM || ws_size < WS_END) { fprintf(stderr, "kernel_launch: unexpected shapes (n_in %d, in0 %d, out %d, ws %zu)\n", n_in, n_in > 0 ? in_sizes[0] : -1, out_size, ws_size); grid = -1; return; }
        int dev = 0, cus = 0, per_cu = 0;
        if (hipGetDevice(&dev) != hipSuccess || hipDeviceGetAttribute(&cus, hipDeviceAttributeMultiprocessorCount, dev) != hipSuccess) { grid = -1; return; }
        if (hipFuncSetAttribute((const void*)fwd_kernel, hipFuncAttributeMaxDynamicSharedMemorySize, LDS_BYTES) != hipSuccess) { fprintf(stderr, "kernel_launch: hipFuncSetAttribute failed\n"); grid = -1; return; }
        if (hipOccupancyMaxActiveBlocksPerMultiprocessor(&per_cu, (const void*)fwd_kernel, NWAVES * 64, LDS_BYTES) != hipSuccess || per_cu < 1) fprintf(stderr, "kernel_launch: occupancy query reports %d\n", per_cu);
        (void)hipGetLastError();
        grid = cus;
    }
    if (grid < 0) return;
    if (hipMemsetAsync((char*)d_ws + WS_CTL, 0, CTL_ZERO_BYTES, stream) != hipSuccess) return;
    Args a{};
    for (int i = 0; i < 30; ++i) a.in[i] = d_in[i];
    a.out = (float*)d_out; a.ws = (unsigned char*)d_ws; a.pad = 0;
#if MK_ONE_LAUNCH
    a.ph_lo = 0; a.ph_hi = PH_TOTAL; a.li = 0;
    hipLaunchKernelGGL(fwd_kernel, dim3(grid), dim3(NWAVES * 64), LDS_BYTES, stream, a);
#else
    int li = 0;
    for (int ph = 0; ph < PH_TOTAL; ++ph) {
        if (ph >= 2) { const int l = (ph - 2) / PH_PER_LAYER, k = (ph - 2) % PH_PER_LAYER; if (k == 11) continue; if ((l & 1) == 0 && (k == 3 || k == 4)) continue; }
        int site = ph;
        if (ph >= 2) { const int l = (ph - 2) / PH_PER_LAYER, k = (ph - 2) % PH_PER_LAYER; static const int mla[11] = {2, 3, 4, -1, -1, 10, 11, 12, 13, 14, 15}, lru[11] = {5, 6, 7, 8, 9, 10, 11, 12, 13, 14, 15}; site = (l & 1) ? lru[k] : mla[k]; }
        a.ph_lo = ph; a.ph_hi = ph + 1;
        if ((HOSTDUP >> site) & 1) { a.li = li++; a.pad = 4; hipLaunchKernelGGL(fwd_kernel, dim3(grid), dim3(NWAVES * 64), LDS_BYTES, stream, a); }
        a.li = li++; a.pad = 0;
        hipLaunchKernelGGL(fwd_kernel, dim3(grid), dim3(NWAVES * 64), LDS_BYTES, stream, a);
    }
#endif
}
```

```cpp
#include <hip/hip_runtime.h>
#include <hip/hip_bf16.h>
#include <cstdio>
#include <cstdint>

#ifndef PHSEL
#define PHSEL -1
#endif
#ifndef PHSKIP
#define PHSKIP -1
#endif
#define SEL(id) ((PHSEL < 0 || PHSEL == (id)) && PHSKIP != (id))
#ifndef PROBE_T
#define PROBE_T 0
#endif
#ifndef PROBE_SHIFT
#define PROBE_SHIFT 0.0f
#endif
#ifndef HOSTDUP
#define HOSTDUP 0
#endif
#ifndef MK_ONE_LAUNCH
#define MK_ONE_LAUNCH 1
#endif

constexpr int T = 32768, SEQ = 4096, NBATCH = 8, DM = 1024, DEPTH = 4;
constexpr int QL = 768, KVL = 256, ROPE = 64, LATD = 1088, NH = 8, DQK = 192, DV = 128;
constexpr int NE = 32, TOPK = 4, DFF = 1024, PLED = 256;
constexpr float ALPHA = 1.681792830507429f;
constexpr float LN_EPS = 1e-5f, RMS_EPS = 1e-6f;
constexpr float QSCALE = 1.4426950408889634f / 13.856406460551018f;
constexpr int NWAVES = 8;

constexpr size_t MiB = 1u << 20;
constexpr size_t WS_CTL = 0, CTL_ZERO_BYTES = 2 * MiB;
constexpr size_t WS_CS = 2 * MiB, WS_SN = 6 * MiB, WS_SPL = 10 * MiB;
constexpr size_t WS_W_MLA = 12 * MiB, W_MLA_STRIDE = 8 * MiB;
constexpr size_t OFF_MLA_WIN = 0, OFF_MLA_WUQ = 2560 * 1024, OFF_MLA_WUKV = OFF_MLA_WUQ + 2304 * 1024, OFF_MLA_WO = OFF_MLA_WUKV + 1024 * 1024;
constexpr size_t WS_W_LRU = 28 * MiB, W_LRU_STRIDE = 8 * MiB;
constexpr size_t OFF_LRU_WIN = 0, OFF_LRU_WAX = 4 * MiB, OFF_LRU_WOUT = 5 * MiB;
constexpr size_t WS_W_PLE = 44 * MiB, W_PLE_STRIDE = 3 * MiB;
constexpr size_t OFF_PLE_WG = 0, OFF_PLE_WP = 2 * MiB;
constexpr size_t WS_W_UP = 56 * MiB;
constexpr size_t WS_W_DN = 568 * MiB;
constexpr size_t WS_XB = 824 * MiB, WS_PB = 888 * MiB, WS_PP = 952 * MiB;
constexpr size_t WS_Y = 1208 * MiB, WS_X1 = 1336 * MiB, WS_X1B = 1464 * MiB, WS_X2 = 1528 * MiB, WS_X2B = 1656 * MiB;
constexpr size_t WS_LAT = 1720 * MiB, WS_KR = 1784 * MiB, WS_SSQ = 1788 * MiB, WS_Q = 1790 * MiB, WS_KN = 1886 * MiB, WS_V = 1950 * MiB, WS_O = 2014 * MiB;
constexpr size_t WS_GG = 2078 * MiB, WS_U = 2142 * MiB, WS_UC = 2206 * MiB, WS_AA = 2270 * MiB, WS_BB = 2398 * MiB, WS_CA = 2526 * MiB, WS_CH = 2528 * MiB;
constexpr size_t WS_H = 2530 * MiB, WS_YS = 2802 * MiB, WS_LIST = 3074 * MiB, WS_SLOT = 3078 * MiB, WS_GATE = 3079 * MiB, WS_END = 3080 * MiB;
constexpr int PADROWS = T * TOPK + NE * 256;
static_assert((size_t)PADROWS * DFF * 2 <= 272 * MiB, "H / YS size");
constexpr int CW_CNT = 256;
constexpr int CW_BAR = 4096;

constexpr int RING_BYTES = 139264;
constexpr int TILE_E_OFF = 131072;
constexpr int MISC_OFF = RING_BYTES;
constexpr int LDS_BYTES = 147456;

#define GAS __attribute__((address_space(1)))
#define LAS __attribute__((address_space(3)))
#define CAS __attribute__((address_space(4)))
typedef unsigned short bf16_t;
typedef short bf16x8 __attribute__((ext_vector_type(8)));
typedef short s16x4 __attribute__((ext_vector_type(4)));
typedef float f32x2 __attribute__((ext_vector_type(2)));
typedef float f32x4 __attribute__((ext_vector_type(4)));
typedef float f32x16 __attribute__((ext_vector_type(16)));
typedef unsigned u32x2 __attribute__((ext_vector_type(2)));
typedef unsigned u32x4 __attribute__((ext_vector_type(4)));

__device__ __forceinline__ unsigned cvt_pk_bf16(float lo, float hi) { unsigned r; asm volatile("v_cvt_pk_bf16_f32 %0, %1, %2" : "=v"(r) : "v"(lo), "v"(hi)); return r; }
__device__ __forceinline__ float bf_lo(unsigned w) { return __uint_as_float(w << 16); }
__device__ __forceinline__ float bf_hi(unsigned w) { return __uint_as_float(w & 0xffff0000u); }
__device__ __forceinline__ float sigmoidf_(float x) { return __builtin_amdgcn_rcpf(1.0f + __expf(-x)); }
__device__ __forceinline__ float gelu_tanh(float x) { const float u = 0.7978845608028654f * (x + 0.044715f * x * x * x); const float t = 1.0f - 2.0f * __builtin_amdgcn_rcpf(1.0f + __expf(2.0f * u)); return 0.5f * x * (1.0f + t); }
__device__ __forceinline__ u32x4 pack8(const f32x4 a, const f32x4 b) { u32x4 w; w.x = cvt_pk_bf16(a[0], a[1]); w.y = cvt_pk_bf16(a[2], a[3]); w.z = cvt_pk_bf16(b[0], b[1]); w.w = cvt_pk_bf16(b[2], b[3]); return w; }
__device__ __forceinline__ int opaque_tid() { int t = threadIdx.x; asm volatile("" : "+v"(t)); return t; }
__device__ __forceinline__ float wave_sum(float v) {
#pragma unroll
    for (int o = 1; o < 64; o <<= 1) v += __shfl_xor(v, o);
    return v;
}

namespace pg8 {
#define PG8_LAS __attribute__((address_space(3)))
constexpr int BM = 256, BK = 64, HALF = 128, HTB = HALF * BK * 2, STAGE_BYTES = 8 * HTB;
__host__ __device__ __forceinline__ int lds_byte(int r, int c) { const int st = (r >> 4) * 2 + (c >> 5), rr = r & 15, cc = c & 31, ob = rr * 64 + cc * 2; return st * 1024 + (ob ^ (((ob >> 9) & 1) << 5)); }
__host__ __device__ __forceinline__ void stage_rc(int b, int& R, int& C) { const int st = b / 1024, sb = b % 1024, swz = sb ^ (((sb >> 9) & 1) << 5); R = (st >> 1) * 16 + swz / 64; C = (st & 1) * 32 + (swz % 64) / 2; }
__host__ __device__ __forceinline__ int perm32(int rho) { const int n = rho >> 4, i = rho & 15; return 8 * (i >> 2) + 4 * n + (i & 3); }

struct Unit { const char* A; const char* B; const int* lst; int nvalid; int pm, pn, aux; };

template <class Epi, class Sched, bool GATHER>
__device__ __forceinline__ void gemm_phase(PG8_LAS unsigned char* lds, const int K, const int lda, const int ldb, const Sched& S, const Epi& E, unsigned long long* pw = nullptr) {
    const int tid = opaque_tid(), wid = __builtin_amdgcn_readfirstlane(tid >> 6), lane = tid & 63, wr = wid >> 2, wc = wid & 3, fr = lane & 15, fq = lane >> 4;
    const int nt = K / BK;
    unsigned voffB[2], ocA[2][2], onA[2][2]; int gR[2], gC2[2];
#pragma unroll
    for (int i = 0; i < 2; ++i) { int R, C; stage_rc(tid * 16 + i * 8192, R, C); const int Rb = Epi::PERM ? ((R & ~31) + perm32(R & 31)) : R;
        voffB[i] = (unsigned)(Rb * ldb + C) * 2u; gR[i] = R; gC2[i] = C * 2;
        ocA[0][i] = (unsigned)(R * lda + C) * 2u; ocA[1][i] = (unsigned)((R + HALF) * lda + C) * 2u; onA[0][i] = ocA[0][i]; onA[1][i] = ocA[1][i]; }
    constexpr unsigned kstep = BK * 2;
    const unsigned hstepB = (unsigned)HALF * ldb * 2;
    const unsigned ldsw = (unsigned)wid * 1024u;
    const int aoff = lds_byte(wr * 64 + fr, fq * 8), boff = lds_byte(wc * 32 + fr, fq * 8);
#define PG8_SA(b, h) (((b) * 2 + (h)) * HTB)
#define PG8_SB(b, h) ((4 + (b) * 2 + (h)) * HTB)
#define PG8_STAGE(bufoff, gbase, voff, kb) do { _Pragma("unroll") for (int _i = 0; _i < 2; ++_i) \
        __builtin_amdgcn_global_load_lds((const unsigned*)((const char*)(gbase) + (size_t)(unsigned)((voff)[_i] + (unsigned)(kb))), (PG8_LAS unsigned*)(lds + (bufoff) + ldsw + _i * 8192), 16, 0, 0); } while (0)
#define PG8_LDA(dst, b, h) do { _Pragma("unroll") for (int m = 0; m < 4; ++m) _Pragma("unroll") for (int k = 0; k < 2; ++k) dst[m][k] = *(const PG8_LAS bf16x8*)(lds + PG8_SA(b, h) + aoff + m * 2048 + k * 1024); } while (0)
#define PG8_LDB(dst, b, h) do { _Pragma("unroll") for (int n = 0; n < 2; ++n) _Pragma("unroll") for (int k = 0; k < 2; ++k) dst[n][k] = *(const PG8_LAS bf16x8*)(lds + PG8_SB(b, h) + boff + n * 2048 + k * 1024); } while (0)
#define PG8_MMA(ai, bj, At, Bt) do { __builtin_amdgcn_s_setprio(1); _Pragma("unroll") for (int m = 0; m < 4; ++m) _Pragma("unroll") for (int n = 0; n < 2; ++n) _Pragma("unroll") for (int k = 0; k < 2; ++k) \
        acc[ai][bj][m][n] = __builtin_amdgcn_mfma_f32_16x16x32_bf16(Bt[n][k], At[m][k], acc[ai][bj][m][n], 0, 0, 0); __builtin_amdgcn_s_setprio(0); } while (0)
#define PG8_WAIT_V(n) asm volatile("s_waitcnt vmcnt(" #n ")" ::: "memory")
#define PG8_WAIT_L(n) asm volatile("s_waitcnt lgkmcnt(" #n ")" ::: "memory")
#define PG8_BAR __builtin_amdgcn_s_barrier()
#define PG8_SCHED __builtin_amdgcn_sched_barrier(0)
#define PG8_GOFFS(u, o) do { _Pragma("unroll") for (int _h = 0; _h < 2; ++_h) _Pragma("unroll") for (int _i = 0; _i < 2; ++_i) { int _r = _h * HALF + gR[_i]; _r = _r < (u).nvalid ? _r : (u).nvalid - 1; \
        const int _tok = (u).lst[_r]; (o)[_h][_i] = (unsigned)_tok * (unsigned)(lda * 2) + (unsigned)gC2[_i]; } } while (0)
#define PG8_GRAW(u, tk) do { _Pragma("unroll") for (int _h = 0; _h < 2; ++_h) _Pragma("unroll") for (int _i = 0; _i < 2; ++_i) { int _r = _h * HALF + gR[_i]; _r = _r < (u).nvalid ? _r : (u).nvalid - 1; (tk)[_h][_i] = (u).lst[_r]; } } while (0)
    Unit cur, nxt, nn; int ui = 0; int tokr[2][2] = {{0, 0}, {0, 0}};
#if PROBE_T
    unsigned long long pk_ = 0, pe_ = 0, pt0_ = 0, pn_ = 0; const unsigned long long pst_ = __builtin_amdgcn_s_memtime();
#endif
    if (!S.next(0, cur)) return;
    f32x4 acc[2][2][4][2];
#pragma unroll
    for (int a = 0; a < 2; ++a)
#pragma unroll
        for (int b = 0; b < 2; ++b)
#pragma unroll
            for (int m = 0; m < 4; ++m)
#pragma unroll
                for (int n = 0; n < 2; ++n) acc[a][b][m][n] = (f32x4){0.f, 0.f, 0.f, 0.f};
    bf16x8 At[4][2], B0[2][2], B1[2][2];
    const char* cA = cur.A; const char* cB = cur.B;
    bool has_next = S.next(1, nxt);
    if constexpr (GATHER) { PG8_GOFFS(cur, ocA);
        if (has_next) { PG8_GOFFS(nxt, onA); }
        else {
#pragma unroll
            for (int h = 0; h < 2; ++h)
#pragma unroll
                for (int i = 0; i < 2; ++i) onA[h][i] = ocA[h][i]; } }
    PG8_STAGE(PG8_SB(0, 0), cB, voffB, 0u); PG8_STAGE(PG8_SB(0, 1), cB, voffB, hstepB); PG8_STAGE(PG8_SA(0, 0), cA, ocA[0], 0u); PG8_STAGE(PG8_SA(0, 1), cA, ocA[1], 0u);
    if (wr == 1) PG8_BAR;
    PG8_WAIT_V(2); PG8_BAR;
    PG8_STAGE(PG8_SB(1, 0), cB, voffB, kstep); PG8_STAGE(PG8_SA(1, 0), cA, ocA[0], kstep); PG8_STAGE(PG8_SB(1, 1), cB, voffB, hstepB + kstep);
    PG8_WAIT_V(6); PG8_BAR;
    for (;;) {
        const char* nA = has_next ? nxt.A : cA; const char* nB = has_next ? nxt.B : cB;
#if PROBE_T
        pt0_ = __builtin_amdgcn_s_memtime();
#endif
#pragma unroll 1
        for (int t = 0; t < nt; t += 2) {
            const bool last = (t == nt - 2);
            const unsigned k1 = (unsigned)(t + 1) * kstep, k2 = last ? 0u : (unsigned)(t + 2) * kstep, k3 = k2 + kstep;
            const char* a2 = last ? nA : cA; const char* b2 = last ? nB : cB;
            unsigned o2[2][2];
#pragma unroll
            for (int h = 0; h < 2; ++h)
#pragma unroll
                for (int i = 0; i < 2; ++i) o2[h][i] = (GATHER && last) ? onA[h][i] : ocA[h][i];
            PG8_LDB(B0, 0, 0); PG8_LDB(B1, 0, 1); PG8_SCHED; PG8_LDA(At, 0, 0); PG8_STAGE(PG8_SA(1, 1), cA, ocA[1], k1);
            PG8_WAIT_V(8); PG8_WAIT_L(0); PG8_BAR; PG8_MMA(0, 0, At, B0); PG8_MMA(0, 1, At, B1); PG8_BAR; PG8_SCHED;
            PG8_LDA(At, 0, 1); PG8_STAGE(PG8_SB(0, 0), b2, voffB, k2); PG8_STAGE(PG8_SB(0, 1), b2, voffB, hstepB + k2); PG8_STAGE(PG8_SA(0, 0), a2, o2[0], k2);
            PG8_WAIT_V(8); PG8_WAIT_L(0); PG8_BAR; PG8_MMA(1, 0, At, B0); PG8_MMA(1, 1, At, B1); PG8_BAR; PG8_SCHED;
            PG8_LDB(B0, 1, 0); PG8_LDB(B1, 1, 1); PG8_SCHED; PG8_LDA(At, 1, 0); PG8_STAGE(PG8_SA(0, 1), a2, o2[1], k2);
            PG8_WAIT_V(8); PG8_WAIT_L(0); PG8_BAR; PG8_MMA(0, 0, At, B0); PG8_MMA(0, 1, At, B1); PG8_BAR; PG8_SCHED;
            PG8_LDA(At, 1, 1); PG8_STAGE(PG8_SB(1, 0), b2, voffB, k3); PG8_STAGE(PG8_SB(1, 1), b2, voffB, hstepB + k3); PG8_STAGE(PG8_SA(1, 0), a2, o2[0], k3);
            PG8_WAIT_V(8); PG8_WAIT_L(0); PG8_BAR; PG8_MMA(1, 0, At, B0); PG8_MMA(1, 1, At, B1); PG8_BAR; PG8_SCHED;
        }
#if PROBE_T
        const unsigned long long pt1_ = __builtin_amdgcn_s_memtime(); pk_ += pt1_ - pt0_;
#endif
        const bool has_nn = has_next && S.next(ui + 2, nn);
        if constexpr (GATHER) { if (has_nn) { PG8_GRAW(nn, tokr); } }
        if (wr == 0) PG8_BAR;
        E(acc, cur, wr, wc, fr, fq);
#if PROBE_T
        asm volatile("s_waitcnt vmcnt(0)" ::: "memory"); pe_ += __builtin_amdgcn_s_memtime() - pt1_; ++pn_;
#endif
        if (!has_next) break;
#pragma unroll
        for (int a = 0; a < 2; ++a)
#pragma unroll
            for (int b = 0; b < 2; ++b)
#pragma unroll
                for (int m = 0; m < 4; ++m)
#pragma unroll
                    for (int n = 0; n < 2; ++n) acc[a][b][m][n] = (f32x4){0.f, 0.f, 0.f, 0.f};
        cur = nxt; cA = nA; cB = nB; ++ui;
        if constexpr (GATHER) {
#pragma unroll
            for (int h = 0; h < 2; ++h)
#pragma unroll
                for (int i = 0; i < 2; ++i) { ocA[h][i] = onA[h][i]; if (has_nn) onA[h][i] = (unsigned)tokr[h][i] * (unsigned)(lda * 2) + (unsigned)gC2[i]; } }
        if (has_nn) nxt = nn;
        has_next = has_nn;
        if (wr == 1) PG8_BAR;
    }
    PG8_WAIT_V(0);
    PG8_BAR;
#if PROBE_T
    if (pw && blockIdx.x == 0 && tid == 0) { pw[0] += pk_; pw[1] += pe_; pw[2] += pn_; pw[3] += __builtin_amdgcn_s_memtime() - pst_; }
#endif
#undef PG8_SA
#undef PG8_SB
#undef PG8_STAGE
#undef PG8_LDA
#undef PG8_LDB
#undef PG8_MMA
#undef PG8_WAIT_V
#undef PG8_WAIT_L
#undef PG8_BAR
#undef PG8_SCHED
#undef PG8_GOFFS
#undef PG8_GRAW
}

constexpr int NXCD = 8, WGM = 8;
struct DenseSched {
    const char* A; const char* B; int lda, ldb; int nM, nN, nwg, G, c; int apn_shift, akbytes, bpm_shift; size_t bbatch;
    __device__ __forceinline__ void init(const void* A_, const void* B_, int lda_, int ldb_, int M, int N, int G_, int c_) {
        A = (const char*)A_; B = (const char*)B_; lda = lda_; ldb = ldb_; nM = M / BM; nN = N / BM; nwg = nM * nN; G = G_; c = c_; apn_shift = -1; akbytes = 0; bpm_shift = -1; bbatch = 0; }
    __device__ __forceinline__ bool next(int i, Unit& u) const {
        const long L = (long)i * G + c; if (L >= nwg) return false;
        int wgid = (int)L; { const int q = nwg / NXCD, r = nwg % NXCD, xcd = wgid % NXCD, off = wgid / NXCD; wgid = (xcd < r ? xcd * (q + 1) : r * (q + 1) + (xcd - r) * q) + off; }
        const int nig = WGM * nN, gid = wgid / nig, fm = gid * WGM, gsz = (nM - fm) < WGM ? (nM - fm) : WGM;
        const int pm = fm + ((wgid % nig) % gsz), pn = (wgid % nig) / gsz;
        u.pm = pm; u.pn = pn; u.aux = 0; u.lst = nullptr; u.nvalid = 256;
        u.A = A + (size_t)pm * 256 * lda * 2 + (apn_shift >= 0 ? (size_t)(pn >> apn_shift) * akbytes : (size_t)0);
        u.B = B + (size_t)pn * 256 * ldb * 2 + (bpm_shift >= 0 ? (size_t)(pm >> bpm_shift) * bbatch : (size_t)0);
        return true;
    }
};
struct MoeSched {
    const char* A; const char* B; size_t bexp; int lda, ldb, nN; const int* lists; volatile LAS const int* tab; volatile LAS const int* te; int G, c; bool gather;
    __device__ __forceinline__ bool next(int i, Unit& u) const {
        int pn, mg;
        if (G == 256) {
            const int x = c & 7, jj = c >> 3, pgs = nN >> 2, mgs = 8 / pgs;
            mg = i * (8 * mgs) + 8 * (x / pgs) + (jj & 7); pn = 4 * (x % pgs) + (jj >> 3);
            if (mg >= tab[32]) return false;
        } else { const int total = tab[32] * nN; const long L = (long)i * G + c; if (L >= total) return false; pn = (int)(L % nN); mg = (int)(L / nN); }
        const int e = te[mg], mt = mg - tab[e];
        u.pm = mg; u.pn = pn; u.aux = e;
        if (gather) { u.A = A; u.lst = lists + (size_t)e * T + mt * 256; const int rem = tab[48 + e] - mt * 256; u.nvalid = rem < 256 ? rem : 256; }
        else { u.A = A + (size_t)mg * 256 * lda * 2; u.lst = nullptr; u.nvalid = 256; }
        u.B = B + (size_t)e * bexp + (size_t)pn * 256 * ldb * 2;
        return true;
    }
};

#define EPI_ROW(u, ai, m) ((u).pm * 256 + (ai) * 128 + wr * 64 + (m) * 16 + fr)
struct EpiLat {
    static constexpr bool PERM = true;
    bf16_t* LAT; float* SSQ; bf16_t* KR; const float* CS; const float* SN;
    __device__ __forceinline__ void operator()(const f32x4 (&acc)[2][2][4][2], const Unit& u, int wr, int wc, int fr, int fq) const {
        if (u.pn < 4) {
#pragma unroll
            for (int ai = 0; ai < 2; ++ai)
#pragma unroll
                for (int m = 0; m < 4; ++m) { const int row = EPI_ROW(u, ai, m); float ss = 0.f;
#pragma unroll
                    for (int bj = 0; bj < 2; ++bj) { const f32x4 v0 = acc[ai][bj][m][0], v1 = acc[ai][bj][m][1];
                        ss += (v0[0] * v0[0] + v0[1] * v0[1]) + (v0[2] * v0[2] + v0[3] * v0[3]) + (v1[0] * v1[0] + v1[1] * v1[1]) + (v1[2] * v1[2] + v1[3] * v1[3]);
                        *(u32x4*)(LAT + (size_t)row * 1024 + u.pn * 256 + bj * 128 + wc * 32 + 8 * fq) = pack8(v0, v1); }
                    ss += __shfl_xor(ss, 16); ss += __shfl_xor(ss, 32);
                    if (fq == 0) SSQ[(size_t)row * 16 + u.pn * 4 + wc] = ss; }
        } else if (wc == 0) {
#pragma unroll
            for (int ai = 0; ai < 2; ++ai)
#pragma unroll
                for (int m = 0; m < 4; ++m) { const int row = EPI_ROW(u, ai, m);
                    const f32x4 c0 = *(const f32x4*)(CS + (size_t)row * 32 + 8 * fq), c1 = *(const f32x4*)(CS + (size_t)row * 32 + 8 * fq + 4);
                    const f32x4 s0 = *(const f32x4*)(SN + (size_t)row * 32 + 8 * fq), s1 = *(const f32x4*)(SN + (size_t)row * 32 + 8 * fq + 4);
                    const f32x4 a0 = acc[ai][0][m][0], a1 = acc[ai][0][m][1], b0 = acc[ai][1][m][0], b1 = acc[ai][1][m][1];
                    *(u32x4*)(KR + (size_t)row * 64 + 8 * fq) = pack8(a0 * c0 - b0 * s0, a1 * c1 - b1 * s1);
                    *(u32x4*)(KR + (size_t)row * 64 + 32 + 8 * fq) = pack8(b0 * c0 + a0 * s0, b1 * c1 + a1 * s1); }
        }
    }
};
struct EpiQ {
    static constexpr bool PERM = true;
    bf16_t* Q; const float* SSQ; const float* CS; const float* SN;
    __device__ __forceinline__ void operator()(const f32x4 (&acc)[2][2][4][2], const Unit& u, int wr, int wc, int fr, int fq) const {
#pragma unroll
        for (int ai = 0; ai < 2; ++ai)
#pragma unroll
            for (int m = 0; m < 4; ++m) { const int row = EPI_ROW(u, ai, m);
                const f32x4 q0 = *(const f32x4*)(SSQ + (size_t)row * 16), q1 = *(const f32x4*)(SSQ + (size_t)row * 16 + 4), q2 = *(const f32x4*)(SSQ + (size_t)row * 16 + 8);
                const float ss = ((q0[0] + q0[1]) + (q0[2] + q0[3])) + ((q1[0] + q1[1]) + (q1[2] + q1[3])) + ((q2[0] + q2[1]) + (q2[2] + q2[3]));
                const float r = QSCALE / sqrtf(ss * (1.0f / QL) + RMS_EPS);
                if (u.pn < 4) {
#pragma unroll
                    for (int bj = 0; bj < 2; ++bj)
                        *(u32x4*)(Q + (size_t)row * 1536 + (2 * u.pn + bj) * 192 + wc * 32 + 8 * fq) = pack8(acc[ai][bj][m][0] * r, acc[ai][bj][m][1] * r);
                } else {
                    const int head = 4 * (u.pn - 4) + wc;
                    const f32x4 c0 = *(const f32x4*)(CS + (size_t)row * 32 + 8 * fq), c1 = *(const f32x4*)(CS + (size_t)row * 32 + 8 * fq + 4);
                    const f32x4 s0 = *(const f32x4*)(SN + (size_t)row * 32 + 8 * fq), s1 = *(const f32x4*)(SN + (size_t)row * 32 + 8 * fq + 4);
                    const f32x4 a0 = acc[ai][0][m][0] * r, a1 = acc[ai][0][m][1] * r, b0 = acc[ai][1][m][0] * r, b1 = acc[ai][1][m][1] * r;
                    *(u32x4*)(Q + (size_t)row * 1536 + head * 192 + 128 + 8 * fq) = pack8(a0 * c0 - b0 * s0, a1 * c1 - b1 * s1);
                    *(u32x4*)(Q + (size_t)row * 1536 + head * 192 + 160 + 8 * fq) = pack8(b0 * c0 + a0 * s0, b1 * c1 + a1 * s1);
                }
                asm volatile("" ::: "memory"); }
    }
};
struct EpiKV {
    static constexpr bool PERM = true;
    bf16_t* KN; bf16_t* V; const float* SSQ;
    __device__ __forceinline__ void operator()(const f32x4 (&acc)[2][2][4][2], const Unit& u, int wr, int wc, int fr, int fq) const {
#pragma unroll
        for (int ai = 0; ai < 2; ++ai)
#pragma unroll
            for (int m = 0; m < 4; ++m) { const int row = EPI_ROW(u, ai, m);
                const f32x4 q3 = *(const f32x4*)(SSQ + (size_t)row * 16 + 12);
                const float r = 1.0f / sqrtf(((q3[0] + q3[1]) + (q3[2] + q3[3])) * (1.0f / KVL) + RMS_EPS);
                *(u32x4*)(KN + (size_t)row * 1024 + u.pn * 128 + wc * 32 + 8 * fq) = pack8(acc[ai][0][m][0] * r, acc[ai][0][m][1] * r);
                *(u32x4*)(V + (size_t)row * 1024 + u.pn * 128 + wc * 32 + 8 * fq) = pack8(acc[ai][1][m][0] * r, acc[ai][1][m][1] * r); }
    }
};
__device__ __forceinline__ f32x4 bf4_lo(const u32x4 w) { return (f32x4){bf_lo(w.x), bf_hi(w.x), bf_lo(w.y), bf_hi(w.y)}; }
__device__ __forceinline__ f32x4 bf4_hi(const u32x4 w) { return (f32x4){bf_lo(w.z), bf_hi(w.z), bf_lo(w.w), bf_hi(w.w)}; }
struct EpiRes {
    static constexpr bool PERM = true;
    const bf16_t* X; bf16_t* Y;
    __device__ __forceinline__ void operator()(const f32x4 (&acc)[2][2][4][2], const Unit& u, int wr, int wc, int fr, int fq) const {
#pragma unroll
        for (int ai = 0; ai < 2; ++ai)
#pragma unroll
            for (int m = 0; m < 4; ++m) { const size_t off = (size_t)EPI_ROW(u, ai, m) * 1024 + u.pn * 256 + wc * 32 + 8 * fq;
#pragma unroll
                for (int bj = 0; bj < 2; ++bj) { const u32x4 xw = *(const u32x4*)(X + off + bj * 128);
                    *(u32x4*)(Y + off + bj * 128) = pack8(bf4_lo(xw) * ALPHA + acc[ai][bj][m][0], bf4_hi(xw) * ALPHA + acc[ai][bj][m][1]); }
                if (m & 1) asm volatile("" ::: "memory"); }
    }
};
struct EpiGU {
    static constexpr bool PERM = true;
    bf16_t* GG; bf16_t* U;
    __device__ __forceinline__ void operator()(const f32x4 (&acc)[2][2][4][2], const Unit& u, int wr, int wc, int fr, int fq) const {
#pragma unroll
        for (int ai = 0; ai < 2; ++ai)
#pragma unroll
            for (int m = 0; m < 4; ++m) { const int row = EPI_ROW(u, ai, m);
#pragma unroll
                for (int bj = 0; bj < 2; ++bj) { f32x4 v0 = acc[ai][bj][m][0], v1 = acc[ai][bj][m][1];
                    if (u.pn < 4) {
#pragma unroll
                        for (int e = 0; e < 4; ++e) { v0[e] = gelu_tanh(v0[e]); v1[e] = gelu_tanh(v1[e]); }
                        *(u32x4*)(GG + (size_t)row * 1024 + u.pn * 256 + bj * 128 + wc * 32 + 8 * fq) = pack8(v0, v1);
                    } else *(u32x4*)(U + (size_t)row * 1024 + (u.pn - 4) * 256 + bj * 128 + wc * 32 + 8 * fq) = pack8(v0, v1); } }
    }
};
struct EpiAB {
    static constexpr bool PERM = true;
    bf16_t* LA; bf16_t* BB; const bf16_t* UC; const float* BA; const float* BX; const float* SPL;
    __device__ __forceinline__ void operator()(const f32x4 (&acc)[2][2][4][2], const Unit& u, int wr, int wc, int fr, int fq) const {
        const int ch = (u.pn >> 1) * 256 + (u.pn & 1) * 128 + wc * 32 + 8 * fq;
        f32x4 ba[2], bx[2], sp[2];
#pragma unroll
        for (int n = 0; n < 2; ++n) { ba[n] = *(const f32x4*)(BA + ch + 4 * n); bx[n] = *(const f32x4*)(BX + ch + 4 * n); sp[n] = *(const f32x4*)(SPL + ch + 4 * n); }
#pragma unroll
        for (int ai = 0; ai < 2; ++ai)
#pragma unroll
            for (int m = 0; m < 4; ++m) { const size_t off = (size_t)EPI_ROW(u, ai, m) * 1024 + ch;
                const u32x4 uw = *(const u32x4*)(UC + off); f32x4 uv[2] = {bf4_lo(uw), bf4_hi(uw)}, lv[2], bv[2];
#pragma unroll
                for (int n = 0; n < 2; ++n)
#pragma unroll
                    for (int e = 0; e < 4; ++e) { const float r = sigmoidf_(acc[ai][0][m][n][e] + ba[n][e]), ig = sigmoidf_(acc[ai][1][m][n][e] + bx[n][e]);
                        const float la = sp[n][e] * r, x2 = 2.0f * la; lv[n][e] = la * 1.4426950408889634f;
                        const float om = x2 > -0.25f ? -x2 * (1.0f + x2 * (0.5f + x2 * (0.16666667f + x2 * (0.041666668f + x2 * 0.0083333338f)))) : 1.0f - __expf(x2);
                        bv[n][e] = sqrtf(om) * ig * uv[n][e]; }
                *(u32x4*)(LA + off) = pack8(lv[0], lv[1]); *(u32x4*)(BB + off) = pack8(bv[0], bv[1]); asm volatile("" ::: "memory"); }
    }
};
struct EpiUp {
    static constexpr bool PERM = true;
    bf16_t* H; const float* BU;
    __device__ __forceinline__ void operator()(const f32x4 (&acc)[2][2][4][2], const Unit& u, int wr, int wc, int fr, int fq) const {
        const int gc = u.pn * 128 + wc * 32 + 8 * fq; const float* bu = BU + (size_t)u.aux * 2048;
        const f32x4 bg0 = *(const f32x4*)(bu + gc), bg1 = *(const f32x4*)(bu + gc + 4), bp0 = *(const f32x4*)(bu + 1024 + gc), bp1 = *(const f32x4*)(bu + 1024 + gc + 4);
#pragma unroll
        for (int ai = 0; ai < 2; ++ai)
#pragma unroll
            for (int m = 0; m < 4; ++m) { const int row = EPI_ROW(u, ai, m);
                f32x4 y0, y1;
#pragma unroll
                for (int e = 0; e < 4; ++e) {
                    float g = fminf(acc[ai][0][m][0][e] + bg0[e], 7.0f), up = fminf(fmaxf(acc[ai][1][m][0][e] + bp0[e], -7.0f), 7.0f); y0[e] = (up + 1.0f) * (g * sigmoidf_(1.702f * g));
                    g = fminf(acc[ai][0][m][1][e] + bg1[e], 7.0f); up = fminf(fmaxf(acc[ai][1][m][1][e] + bp1[e], -7.0f), 7.0f); y1[e] = (up + 1.0f) * (g * sigmoidf_(1.702f * g)); }
                *(u32x4*)(H + (size_t)row * 1024 + gc) = pack8(y0, y1); }
    }
};
struct EpiDown {
    static constexpr bool PERM = true;
    bf16_t* YS; const float* BD;
    __device__ __forceinline__ void operator()(const f32x4 (&acc)[2][2][4][2], const Unit& u, int wr, int wc, int fr, int fq) const {
        const float* bd = BD + (size_t)u.aux * 1024;
#pragma unroll
        for (int bj = 0; bj < 2; ++bj) { const int col = u.pn * 256 + bj * 128 + wc * 32 + 8 * fq; const f32x4 b0 = *(const f32x4*)(bd + col), b1 = *(const f32x4*)(bd + col + 4);
#pragma unroll
            for (int ai = 0; ai < 2; ++ai)
#pragma unroll
                for (int m = 0; m < 4; ++m) *(u32x4*)(YS + (size_t)EPI_ROW(u, ai, m) * 1024 + col) = pack8(acc[ai][bj][m][0] + b0, acc[ai][bj][m][1] + b1); }
    }
};
struct EpiPle {
    static constexpr bool PERM = true;
    const bf16_t* X2; const bf16_t* PP; float* OUT; bf16_t* XB;
    __device__ __forceinline__ void operator()(const f32x4 (&acc)[2][2][4][2], const Unit& u, int wr, int wc, int fr, int fq) const {
#pragma unroll
        for (int ai = 0; ai < 2; ++ai)
#pragma unroll
            for (int m = 0; m < 4; ++m) { const size_t off = (size_t)EPI_ROW(u, ai, m) * 1024 + u.pn * 256 + wc * 32 + 8 * fq;
#pragma unroll
                for (int bj = 0; bj < 2; ++bj) { const size_t o = off + bj * 128; const u32x4 xw = *(const u32x4*)(X2 + o), pw = *(const u32x4*)(PP + o);
                    const f32x4 a0 = acc[ai][bj][m][0], a1 = acc[ai][bj][m][1], x0 = bf4_lo(xw), x1 = bf4_hi(xw), p0 = bf4_lo(pw), p1 = bf4_hi(pw); f32x4 r0, r1;
#pragma unroll
                    for (int e = 0; e < 4; ++e) { r0[e] = x0[e] + sigmoidf_(a0[e]) * p0[e]; r1[e] = x1[e] + sigmoidf_(a1[e]) * p1[e]; }
                    *(u32x4*)(XB + o) = pack8(r0, r1);
                    if (OUT) { *(f32x4*)(OUT + o) = r0; *(f32x4*)(OUT + o + 4) = r1; } }
                if (m & 1) asm volatile("" ::: "memory"); }
    }
};
struct EpiPP {
    static constexpr bool PERM = true;
    bf16_t* PP;
    __device__ __forceinline__ void operator()(const f32x4 (&acc)[2][2][4][2], const Unit& u, int wr, int wc, int fr, int fq) const {
#pragma unroll
        for (int ai = 0; ai < 2; ++ai)
#pragma unroll
            for (int m = 0; m < 4; ++m)
#pragma unroll
                for (int bj = 0; bj < 2; ++bj) *(u32x4*)(PP + (size_t)EPI_ROW(u, ai, m) * 1024 + u.pn * 256 + bj * 128 + wc * 32 + 8 * fq) = pack8(acc[ai][bj][m][0], acc[ai][bj][m][1]);
    }
};
}

namespace att {
constexpr int NW = 8, QBLK = 32, KVBLK = 64, QB = 256, KPITCH = 384;
constexpr int SHM_V = KVBLK * DV * 2, SHM_K = KVBLK * KPITCH;
constexpr int NVB = 3;
constexpr int OFF_V = 0, OFF_K = NVB * SHM_V, OFF_WS = OFF_K + 2 * SHM_K, LDS_BYTES = OFF_WS + NW * 64 * 4;
#define SBAR() __builtin_amdgcn_sched_barrier(0)
__device__ __forceinline__ int k_addr(int row, int chunk) { return row * KPITCH + ((chunk ^ ((row >> 1) & 7)) << 4); }
__device__ __forceinline__ int v_st(int k, int c) { const int kk = (k & ~0xC) | ((k & 4) << 1) | ((k & 8) >> 1); return ((kk >> 3) * 4 + (c >> 5)) * 512 + ((kk & 7) * 32 + (c & 31)) * 2; }
__device__ __forceinline__ int v_rd_base(int lane) { return ((lane & 3) << 3) | (((lane >> 2) & 3) << 6) | (((lane >> 4) & 1) << 5) | (((lane >> 5) & 1) << 8); }
constexpr int v_rd_off(int d0, int ks, int half) { return d0 * 512 + ks * 4096 + half * 2048; }
__device__ __forceinline__ int crow(int r, int hi) { return (r & 3) + 8 * (r >> 2) + 4 * hi; }

template <int KB>
__device__ __forceinline__ void qkt(f32x16& p0, f32x16& p1, const LAS char* K_lds, int r32, int hi, const bf16x8* qr) {
    p0 = f32x16{}; p1 = f32x16{};
    const LAS char* kb[4];
#pragma unroll
    for (int dd = 0; dd < 4; ++dd) kb[dd] = K_lds + KB * SHM_K + r32 * KPITCH + (((2 * dd + hi) ^ ((r32 >> 1) & 7)) << 4);
    bf16x8 f[2][4];
#define QK_LD(g, buf) do { _Pragma("unroll") for (int e_ = 0; e_ < 2; ++e_) { const int d0_ = 2 * (g) + e_; const LAS char* a_ = kb[d0_ & 3] + (d0_ >> 2) * 128; \
        f[buf][2 * e_] = *(const LAS bf16x8*)a_; f[buf][2 * e_ + 1] = *(const LAS bf16x8*)(a_ + 32 * KPITCH); } } while (0)
    QK_LD(0, 0);
#pragma unroll
    for (int g = 0; g < 6; ++g) {
        if (g < 5) QK_LD(g + 1, (g + 1) & 1);
        SBAR();
#pragma unroll
        for (int e = 0; e < 2; ++e) { const int d0 = 2 * g + e;
            p0 = __builtin_amdgcn_mfma_f32_32x32x16_bf16(f[g & 1][2 * e], qr[d0], p0, 0, 0, 0);
            p1 = __builtin_amdgcn_mfma_f32_32x32x16_bf16(f[g & 1][2 * e + 1], qr[d0], p1, 0, 0, 0); }
        SBAR(); }
#undef QK_LD
}
__device__ __forceinline__ void pv_tile(f32x16* o, int vb0  , bf16x8 pa0, bf16x8 pa1, bf16x8 pa2, bf16x8 pa3) {
#define TRRD(dst, off) asm volatile("ds_read_b64_tr_b16 %0, %1 offset:%2" : "=&v"(dst) : "v"(vb0), "i"(off) : "memory")
#define PV_D0(d0) do { s16x4 l0, l1, l2, l3, h0, h1, h2, h3; constexpr int b_ = v_rd_off(d0, 0, 0); \
        TRRD(l0, b_); TRRD(h0, b_ + 2048); TRRD(l1, b_ + 4096); TRRD(h1, b_ + 6144); TRRD(l2, b_ + 8192); TRRD(h2, b_ + 10240); TRRD(l3, b_ + 12288); TRRD(h3, b_ + 14336); \
        asm volatile("s_waitcnt lgkmcnt(0)" ::: "memory"); SBAR(); \
        o[d0] = __builtin_amdgcn_mfma_f32_32x32x16_bf16(pa0, (bf16x8){l0[0], l0[1], l0[2], l0[3], h0[0], h0[1], h0[2], h0[3]}, o[d0], 0, 0, 0); \
        o[d0] = __builtin_amdgcn_mfma_f32_32x32x16_bf16(pa1, (bf16x8){l1[0], l1[1], l1[2], l1[3], h1[0], h1[1], h1[2], h1[3]}, o[d0], 0, 0, 0); \
        o[d0] = __builtin_amdgcn_mfma_f32_32x32x16_bf16(pa2, (bf16x8){l2[0], l2[1], l2[2], l2[3], h2[0], h2[1], h2[2], h2[3]}, o[d0], 0, 0, 0); \
        o[d0] = __builtin_amdgcn_mfma_f32_32x32x16_bf16(pa3, (bf16x8){l3[0], l3[1], l3[2], l3[3], h3[0], h3[1], h3[2], h3[3]}, o[d0], 0, 0, 0); } while (0)
    PV_D0(0); PV_D0(1); PV_D0(2); PV_D0(3);
#undef PV_D0
#undef TRRD
}
__device__ __forceinline__ void mask_tile(f32x16& p0, f32x16& p1, int dq  ) {
    const float NEG = -__builtin_inff();
#pragma unroll
    for (int r = 0; r < 16; ++r) { const int c = (r & 3) + 8 * (r >> 2);
        if (c > dq) p0[r] = NEG;
        if (c + 32 > dq) p1[r] = NEG; }
}
__device__ __forceinline__ void softmax_tile(f32x16& p0, f32x16& p1, float& m_reg, float& l_reg, float& alpha, bf16x8& pa0, bf16x8& pa1, bf16x8& pa2, bf16x8& pa3) {
    float pmax = p0[0];
#pragma unroll
    for (int r = 1; r < 16; ++r) pmax = fmaxf(pmax, p0[r]);
#pragma unroll
    for (int r = 0; r < 16; ++r) pmax = fmaxf(pmax, p1[r]);
    { auto rr = __builtin_amdgcn_permlane32_swap(__float_as_uint(pmax), __float_as_uint(pmax), false, false); pmax = fmaxf(__uint_as_float(rr[0]), __uint_as_float(rr[1])); }
    float mn = m_reg; alpha = 1.f;
    if (!__all(pmax - m_reg <= 8.0f)) { mn = fmaxf(m_reg, pmax); alpha = __builtin_amdgcn_exp2f(m_reg - mn); m_reg = mn; }
    float ps = 0.f;
#pragma unroll
    for (int r = 0; r < 16; ++r) { p0[r] = __builtin_amdgcn_exp2f(p0[r] - mn); ps += p0[r]; }
#pragma unroll
    for (int r = 0; r < 16; ++r) { p1[r] = __builtin_amdgcn_exp2f(p1[r] - mn); ps += p1[r]; }
    { auto rr = __builtin_amdgcn_permlane32_swap(__float_as_uint(ps), __float_as_uint(ps), false, false); ps = __uint_as_float(rr[0]) + __uint_as_float(rr[1]); }
    l_reg = l_reg * alpha + ps;
#define PK4(P, B_, OUT) do { unsigned a0 = cvt_pk_bf16(P[B_+0], P[B_+1]), a1 = cvt_pk_bf16(P[B_+2], P[B_+3]); \
        unsigned b0 = cvt_pk_bf16(P[B_+4], P[B_+5]), b1 = cvt_pk_bf16(P[B_+6], P[B_+7]); \
        auto r0 = __builtin_amdgcn_permlane32_swap(a0, b0, false, false); auto r1 = __builtin_amdgcn_permlane32_swap(a1, b1, false, false); \
        u32x4 w = {r0[0], r1[0], r0[1], r1[1]}; OUT = __builtin_bit_cast(bf16x8, w); } while (0)
    PK4(p0, 0, pa0); PK4(p0, 8, pa1); PK4(p1, 0, pa2); PK4(p1, 8, pa3);
#undef PK4
}

__device__ __forceinline__ void attn_block(int b, int h, int qb, const bf16_t* Q, const bf16_t* KN, const bf16_t* KR, const bf16_t* V, bf16_t* O, LAS char* lds, unsigned long long* pw = nullptr) {
    const int tid = opaque_tid(), wid = __builtin_amdgcn_readfirstlane(tid >> 6), lane = tid & 63, r32 = lane & 31, hi = lane >> 5;
    const size_t row0 = (size_t)b * SEQ;
    const int q0 = qb * QB + wid * QBLK;
    const int NT = (qb + 1) * (QB / KVBLK);
    LAS char* V_lds = lds + OFF_V; LAS char* K_lds = lds + OFF_K;
    LAS float* ws = (LAS float*)(lds + OFF_WS) + wid * 64; LAS float* li_l = ws; LAS float* al_l = ws + 32;
    const int sr = tid >> 4, sc = (tid & 15) * 8, kr_row = tid >> 3, kr_c = tid & 7;
    const int vst0 = v_st(sr, sc), vst1 = v_st(32 + sr, sc), kws = k_addr(sr, tid & 15), kwr = k_addr(kr_row, 16 + kr_c);
    const int vb0 = (int)(uintptr_t)lds + v_rd_base(lane);
    const bf16_t* KNh = KN + row0 * 1024 + h * 128 + sc; const bf16_t* Vh = V + row0 * 1024 + h * 128 + sc; const bf16_t* KRb = KR + row0 * 64 + kr_c * 8;
    bf16x8 st_k0, st_k1, st_kr, st_v0, st_v1;
#define SLOAD(t) do { const size_t k0_ = (size_t)(t) * KVBLK; \
        st_k0 = *(const bf16x8*)(KNh + (k0_ + sr) * 1024); st_k1 = *(const bf16x8*)(KNh + (k0_ + 32 + sr) * 1024); st_kr = *(const bf16x8*)(KRb + (k0_ + kr_row) * 64); \
        st_v0 = *(const bf16x8*)(Vh + (k0_ + sr) * 1024); st_v1 = *(const bf16x8*)(Vh + (k0_ + 32 + sr) * 1024); } while (0)
#define SWRITE(bf, vo) do { *(LAS bf16x8*)(K_lds + (bf) * SHM_K + kws) = st_k0; *(LAS bf16x8*)(K_lds + (bf) * SHM_K + kws + 32 * KPITCH) = st_k1; *(LAS bf16x8*)(K_lds + (bf) * SHM_K + kwr) = st_kr; \
        *(LAS bf16x8*)(V_lds + (vo) + vst0) = st_v0; *(LAS bf16x8*)(V_lds + (vo) + vst1) = st_v1; } while (0)
    SLOAD(0);
    bf16x8 qr[12];
    { const bf16_t* Qw = Q + (row0 + q0 + r32) * 1536 + h * 192 + hi * 8;
#pragma unroll
      for (int d0 = 0; d0 < 12; ++d0) qr[d0] = *(const bf16x8*)(Qw + d0 * 16); }
    float m_reg = -1e30f, l_reg = 0.f; f32x16 o[4] = {};
    f32x16 p0, p1; bf16x8 pa0, pa1, pa2, pa3; float alpha;
    asm volatile("s_waitcnt vmcnt(0)" ::: "memory");
    SWRITE(0, 0);
    __syncthreads();
    const bool odd = wid >= 4; int vo_prev = 0, vo_cur = 0, vo_next = SHM_V;
#define RESC(a) do { if (__any((a) < 1.f)) { if (hi == 0) al_l[r32] = (a); asm volatile("s_waitcnt lgkmcnt(0)" ::: "memory"); \
        _Pragma("unroll") for (int d_ = 0; d_ < 4; ++d_) _Pragma("unroll") for (int r = 0; r < 16; ++r) o[d_][r] *= al_l[crow(r, hi)]; } } while (0)
#if PROBE_T
    unsigned long long pa_ = 0, pb_ = 0, pc_ = 0, pd_ = 0, pe2_ = 0; const unsigned long long pst_ = __builtin_amdgcn_s_memtime();
#define PSTAMP(v) const unsigned long long v = __builtin_amdgcn_s_memtime()
#define PACC(acc, a, b) acc += (b) - (a)
#else
#define PSTAMP(v) do {} while (0)
#define PACC(acc, a, b) do {} while (0)
#endif
#define TILE(t, BF) do { PSTAMP(s0_); const bool more_ = ((t) + 1 < NT); if (more_) SLOAD((t) + 1); SBAR(); \
        if (odd && (t) > 0) { pv_tile(o, vb0 + vo_prev, pa0, pa1, pa2, pa3); SBAR(); } \
        PSTAMP(s1_); qkt<BF>(p0, p1, K_lds, r32, hi, qr); \
        { const int kb_ = (t) * KVBLK; if (kb_ + KVBLK - 1 > q0) mask_tile(p0, p1, q0 + r32 - kb_ - 4 * hi); } \
        asm volatile("" : "+v"(p0), "+v"(p1)); PSTAMP(s2_); \
        softmax_tile(p0, p1, m_reg, l_reg, alpha, pa0, pa1, pa2, pa3); RESC(alpha); SBAR(); PSTAMP(s3_); \
        if (!odd) pv_tile(o, vb0 + vo_cur, pa0, pa1, pa2, pa3); \
        PSTAMP(s4_); if (more_) { asm volatile("s_waitcnt vmcnt(0)" ::: "memory"); SWRITE((BF) ^ 1, vo_next); } \
        PSTAMP(s5_); __syncthreads(); PSTAMP(s6_); PACC(pa_, s1_, s2_); PACC(pb_, s2_, s3_); PACC(pc_, s3_, s4_); PACC(pd_, s4_, s5_); PACC(pe2_, s5_, s6_); vo_prev = vo_cur; vo_cur = vo_next; vo_next = (vo_next == (NVB - 1) * SHM_V) ? 0 : vo_next + SHM_V; } while (0)
#pragma unroll 1
    for (int t = 0; t < NT; t += 2) { TILE(t, 0); TILE(t + 1, 1); }
    if (odd) pv_tile(o, vb0 + vo_prev, pa0, pa1, pa2, pa3);
#if PROBE_T
    if (pw && blockIdx.x == 0 && tid == 0) { pw[8] += pa_; pw[9] += pb_; pw[10] += pc_; pw[11] += pd_; pw[12] += pe2_; pw[13] += (unsigned long long)NT; pw[14] += __builtin_amdgcn_s_memtime() - pst_; }
#endif
    if (hi == 0) li_l[r32] = l_reg; asm volatile("s_waitcnt lgkmcnt(0)" ::: "memory");
    bf16_t* Ow = O + (row0 + q0) * 1024 + h * 128;
#pragma unroll
    for (int r = 0; r < 16; ++r) { const int orow = crow(r, hi); const float rl = __builtin_amdgcn_rcpf(li_l[orow]);
#pragma unroll
        for (int d0 = 0; d0 < 4; ++d0) { const float v = o[d0][r] * rl; const float vn = __shfl_xor(v, 1);
            if ((r32 & 1) == 0) *(unsigned*)(Ow + (size_t)orow * 1024 + d0 * 32 + r32) = cvt_pk_bf16(v, vn); } }
    __syncthreads();
#undef SLOAD
#undef SWRITE
#undef RESC
#undef TILE
#undef PSTAMP
#undef PACC
}
#undef SBAR
}

#define XB_TMO      128
#define XB_XCNT(j)  (256  + 64 * (j))
#define XB_XSUB(j)  (1280 + 64 * (j))
#define XB_XGEN(j)  (2304 + 64 * (j))
#define XB_TOP      3328
#define XB_TOPGEN   3392
#define XCD_BAR_WORDS 3456
#define XB_SPIN_CAP (1u << 22)
__device__ __forceinline__ unsigned xb_ld(unsigned* p)              { return __hip_atomic_load(p, __ATOMIC_RELAXED, __HIP_MEMORY_SCOPE_AGENT); }
__device__ __forceinline__ unsigned xb_add(unsigned* p, unsigned v) { return __hip_atomic_fetch_add(p, v, __ATOMIC_RELAXED, __HIP_MEMORY_SCOPE_AGENT); }
__device__ __forceinline__ unsigned xb_xcc_id() { return (unsigned)__builtin_amdgcn_s_getreg((3 << 11) | 20) & 0xFu; }
#define XB_SPIN(cond, bar) do { unsigned _sp = 0; while (cond) { __builtin_amdgcn_s_sleep(1); \
    if ((++_sp & 255u) == 0u) { if (xb_ld(&(bar)[XB_TMO])) break; if (_sp > XB_SPIN_CAP) { atomicAdd(&(bar)[XB_TMO], 1u); break; } } } } while (0)
struct XcdBarrier { unsigned* bar; unsigned x; volatile LAS unsigned* st; };
__device__ __forceinline__ XcdBarrier xcd_barrier_post(unsigned* bar, volatile LAS unsigned* st) {
    XcdBarrier b; b.bar = bar; b.x = xb_xcc_id(); b.st = st;
    if (threadIdx.x == 0) (void)xb_add(&bar[XB_XCNT(b.x)], 1u);
    return b;
}
__device__ __forceinline__ void xcd_barrier_complete(unsigned* bar, unsigned x, unsigned& nloc, unsigned& nx) {
    const unsigned G = gridDim.x * gridDim.y * gridDim.z;
    unsigned sum, cnt, mine, sp = 0u;
    for (;;) {
        sum = 0u; cnt = 0u; mine = 0u;
#pragma unroll
        for (unsigned j = 0; j < 16; ++j) { const unsigned c = xb_ld(&bar[XB_XCNT(j)]); sum += c; cnt += (c > 0u) ? 1u : 0u; mine = (j == x) ? c : mine; }
        if (sum == G) break;
        __builtin_amdgcn_s_sleep(1);
        if ((++sp & 255u) == 0u) { if (xb_ld(&bar[XB_TMO])) break; if (sp > XB_SPIN_CAP) { atomicAdd(&bar[XB_TMO], 1u); break; } }
    }
    nloc = mine > 0u ? mine : 1u; nx = cnt > 0u ? cnt : 1u;
}
__device__ __forceinline__ void xcd_barrier(const XcdBarrier& b) {
    asm volatile("s_waitcnt vmcnt(0)" ::: "memory");
    __syncthreads();
    if (opaque_tid() == 0) {
        unsigned* bar = b.bar; unsigned bx = b.x;
        asm volatile("" : "+s"(bar), "+s"(bx));
        __builtin_amdgcn_s_waitcnt(0);
        unsigned nloc = b.st[0], nx = b.st[1];
        if (nloc == 0u) { xcd_barrier_complete(bar, bx, nloc, nx); b.st[0] = nloc; b.st[1] = nx; }
        const unsigned old = xb_add(&bar[XB_XSUB(bx)], 1u);
        const unsigned gen = old / nloc;
        if (old + 1u == (gen + 1u) * nloc) {
            __builtin_amdgcn_fence(__ATOMIC_RELEASE, "agent");
            asm volatile("s_waitcnt vmcnt(0)" ::: "memory");
            const unsigned og = xb_add(&bar[XB_TOP], 1u);
            const unsigned tg = og / nx;
            if (og + 1u == (tg + 1u) * nx) xb_add(&bar[XB_TOPGEN], 1u);
            else XB_SPIN(xb_ld(&bar[XB_TOPGEN]) == tg, bar);
            __builtin_amdgcn_fence(__ATOMIC_ACQUIRE, "agent");
            xb_add(&bar[XB_XGEN(bx)], 1u);
            asm volatile("s_waitcnt vmcnt(0)" ::: "memory");
        } else {
            XB_SPIN(xb_ld(&bar[XB_XGEN(bx)]) == gen, bar);
            __builtin_amdgcn_fence(__ATOMIC_ACQUIRE, "agent");
            asm volatile("s_waitcnt vmcnt(0)" ::: "memory");
        }
    }
    __syncthreads();
}

struct Args { const void* in[30]; float* out; unsigned char* ws; int ph_lo, ph_hi, li, pad; };
struct Ctx { int tid, lane, wave, vcu, G, bid; LAS unsigned char* lds; volatile LAS int* misc; };
__device__ __forceinline__ Ctx fresh_ctx(const Ctx& c) {
    Ctx r = c; unsigned l = (unsigned)(uintptr_t)c.lds, m = (unsigned)(uintptr_t)c.misc;
    asm volatile("" : "+s"(r.wave), "+s"(r.vcu), "+s"(r.G), "+s"(r.bid), "+s"(l), "+s"(m));
    r.lds = (LAS unsigned char*)(uintptr_t)l; r.misc = (volatile LAS int*)(uintptr_t)m; r.tid = opaque_tid(); r.lane = r.tid & 63; return r; }
typedef const CAS Args* ArgsP;
__device__ __forceinline__ const CAS Args& fresh_args(ArgsP p) { asm volatile("" : "+s"(p)); return *p; }
enum { I_X = 0, I_P, I_POS, I_MLA_WIN, I_MLA_QN, I_MLA_KVN, I_MLA_WUQ, I_MLA_WUKV, I_MLA_WO, I_LRU_WIN, I_LRU_CW, I_LRU_CB, I_LRU_WA, I_LRU_BA, I_LRU_WX, I_LRU_BX, I_LRU_LAM, I_LRU_WOUT,
       I_LN1G, I_LN1B, I_LN2G, I_LN2B, I_MOE_WR, I_MOE_BR, I_MOE_WUP, I_MOE_BUP, I_MOE_WDN, I_MOE_BDN, I_PLE_WG, I_PLE_WP };
#define INF(i) ((const float*)args.in[i])
#define WSP(T_, off) ((T_*)(args.ws + (off)))

__device__ __forceinline__ void tr_load(const float* W, int ld, int k0, int sc0, int sc1, int lane, f32x4 (&v)[16]) {
    const int half = (lane & 15) >> 3, scol = half ? sc1 : sc0, c4 = (lane & 7) * 4, rs = lane >> 4;
#pragma unroll
    for (int i = 0; i < 8; ++i) { const float* p = W + (size_t)(k0 + 8 * i + 2 * rs) * ld + scol + c4;
        v[2 * i] = (scol >= 0) ? *(const f32x4*)p : (f32x4){0.f, 0.f, 0.f, 0.f}; v[2 * i + 1] = (scol >= 0) ? *(const f32x4*)(p + ld) : (f32x4){0.f, 0.f, 0.f, 0.f}; }
}
__device__ __forceinline__ void tr_store(f32x4 (&v)[16], const float* ksc, int k0, bf16_t* dst  , int K, LAS unsigned* scr, int lane) {
    const int rs = lane >> 4;
    if (ksc) {
#pragma unroll
        for (int i = 0; i < 8; ++i) { v[2 * i] = v[2 * i] * ksc[k0 + 8 * i + 2 * rs]; v[2 * i + 1] = v[2 * i + 1] * ksc[k0 + 8 * i + 2 * rs + 1]; } }
#pragma unroll
    for (int i = 0; i < 8; ++i) { LAS unsigned* s = scr + (4 * i + rs) * 65 + (lane & 15) * 4;
#pragma unroll
        for (int e = 0; e < 4; ++e) s[e] = cvt_pk_bf16(v[2 * i][e], v[2 * i + 1][e]); }
    asm volatile("s_waitcnt lgkmcnt(0)" ::: "memory");
    const int c = lane & 7;
#pragma unroll
    for (int j = 0; j < 8; ++j) { const int n = (lane >> 3) + 8 * j; const LAS unsigned* s = scr + (4 * c) * 65 + n;
        u32x4 o; o.x = s[0]; o.y = s[65]; o.z = s[130]; o.w = s[195];
        *(u32x4*)(dst + (size_t)n * K + 8 * c) = o; }
    asm volatile("s_waitcnt lgkmcnt(0)" ::: "memory");
}
enum { J_NAT = 0, J_MLA_WIN, J_MLA_WUQ, J_LRU_WAX, J_MOE_UP };
__device__ __forceinline__ int tr_map(int job, int g) {
    switch (job) {
    case J_MLA_WIN: return g < 32 ? 32 * g : (g == 32 ? 1024 : (g == 36 ? 1056 : -1));
    case J_MLA_WUQ: if (g < 32) { const int t = g >> 3, bj = (g >> 2) & 1, cg = g & 3; return (2 * t + bj) * 192 + 32 * cg; }
                    else { const int g2 = g - 32, t2 = g2 >> 3, bj = (g2 >> 2) & 1, hh = g2 & 3; return (4 * t2 + hh) * 192 + 128 + 32 * bj; }
    case J_LRU_WAX: { const int pn = g >> 3, cg = g & 3; return 128 * pn + 32 * cg; }
    case J_MOE_UP:  { const int pn = g >> 3, bj = (g >> 2) & 1, cg = g & 3; return bj * 1024 + 128 * pn + 32 * cg; }
    default: return 32 * g;
    }
}
__device__ __forceinline__ void tr_job(const Ctx& C, int job, const float* src, size_t srcstride, int nmat, int K, int ld, int N, bf16_t* dst, size_t dststride, const float* ksc, int kscstride,
                                       const float* src2  ) {
    LAS unsigned* scr = (LAS unsigned*)(C.lds + C.wave * 8320);
    const int gw = C.vcu * NWAVES + C.wave, NGW = C.G * NWAVES;
    const int nkb = K / 64, nnb = N / 64, per = nkb * nnb, total = per * nmat;
#define TR_DECODE(it_, W_, k0_, s0_, s1_, ks_, d_) do { const int mat_ = (it_) / per, r_ = (it_) - mat_ * per, kb_ = r_ / nnb, nb_ = r_ - kb_ * nnb; \
        s0_ = tr_map(job, 2 * nb_); s1_ = tr_map(job, 2 * nb_ + 1); W_ = src + (size_t)mat_ * srcstride; \
        if (job == J_LRU_WAX && ((nb_ >> 1) & 1)) W_ = src2 + (size_t)mat_ * srcstride;       \
        k0_ = kb_ * 64; ks_ = ksc ? ksc + (size_t)mat_ * kscstride : nullptr; d_ = (bf16_t*)((char*)dst + (size_t)mat_ * dststride) + (size_t)(nb_ * 64) * K + kb_ * 64; } while (0)
    f32x4 va[16], vb[16];
    int it = gw; const float* Wc; int k0c, s0c, s1c; const float* ksc_c; bf16_t* dc;
    if (it < total) { TR_DECODE(it, Wc, k0c, s0c, s1c, ksc_c, dc); tr_load(Wc, ld, k0c, s0c, s1c, C.lane, va); }
    while (it < total) {
        const int nit = it + NGW; const float* Wn = nullptr; int k0n = 0, s0n = 0, s1n = 0; const float* ksc_n = nullptr; bf16_t* dn = nullptr;
        if (nit < total) { TR_DECODE(nit, Wn, k0n, s0n, s1n, ksc_n, dn); tr_load(Wn, ld, k0n, s0n, s1n, C.lane, vb); }
        tr_store(va, ksc_c, k0c, dc, K, scr, C.lane);
#pragma unroll
        for (int i = 0; i < 16; ++i) va[i] = vb[i];
        it = nit; k0c = k0n; ksc_c = ksc_n; dc = dn;
    }
#undef TR_DECODE
}
__device__ __forceinline__ void cvt_rows(const Ctx& C, const float* src, bf16_t* dst, size_t n8  ) {
    const size_t gt = (size_t)C.vcu * 512 + C.tid, NT = (size_t)C.G * 512;
    for (size_t i = gt; i < n8; i += NT) { const f32x4 a = *(const f32x4*)(src + i * 8), b = *(const f32x4*)(src + i * 8 + 4); *(u32x4*)(dst + i * 8) = pack8(a, b); }
}
__device__ __forceinline__ void phase_prologue(const CAS Args& args, const Ctx& C) {
    tr_job(C, J_MLA_WIN, INF(I_MLA_WIN), (size_t)DM * LATD, 2, DM, LATD, 1280, WSP(bf16_t, WS_W_MLA + OFF_MLA_WIN), W_MLA_STRIDE, nullptr, 0, nullptr);
    tr_job(C, J_MLA_WUQ, INF(I_MLA_WUQ), (size_t)QL * 1536, 2, QL, 1536, 1536, WSP(bf16_t, WS_W_MLA + OFF_MLA_WUQ), W_MLA_STRIDE, INF(I_MLA_QN), QL, nullptr);
    tr_job(C, J_NAT, INF(I_MLA_WUKV), (size_t)KVL * 2048, 2, KVL, 2048, 2048, WSP(bf16_t, WS_W_MLA + OFF_MLA_WUKV), W_MLA_STRIDE, INF(I_MLA_KVN), KVL, nullptr);
    tr_job(C, J_NAT, INF(I_MLA_WO), (size_t)DM * DM, 2, DM, DM, DM, WSP(bf16_t, WS_W_MLA + OFF_MLA_WO), W_MLA_STRIDE, nullptr, 0, nullptr);
    tr_job(C, J_NAT, INF(I_LRU_WIN), (size_t)DM * 2048, 2, DM, 2048, 2048, WSP(bf16_t, WS_W_LRU + OFF_LRU_WIN), W_LRU_STRIDE, nullptr, 0, nullptr);
    for (int j = 0; j < 2; ++j)
        tr_job(C, J_LRU_WAX, INF(I_LRU_WA) + (size_t)j * 4 * 65536, (size_t)256 * 256, 4, 256, 256, 512, WSP(bf16_t, WS_W_LRU + OFF_LRU_WAX + (size_t)j * W_LRU_STRIDE), (size_t)512 * 256 * 2, nullptr, 0, INF(I_LRU_WX) + (size_t)j * 4 * 65536);
    tr_job(C, J_NAT, INF(I_LRU_WOUT), (size_t)DM * DM, 2, DM, DM, DM, WSP(bf16_t, WS_W_LRU + OFF_LRU_WOUT), W_LRU_STRIDE, nullptr, 0, nullptr);
    tr_job(C, J_NAT, INF(I_PLE_WG), (size_t)DM * DM, 4, DM, DM, DM, WSP(bf16_t, WS_W_PLE + OFF_PLE_WG), W_PLE_STRIDE, nullptr, 0, nullptr);
    tr_job(C, J_NAT, INF(I_PLE_WP), (size_t)PLED * DM, 4, PLED, DM, DM, WSP(bf16_t, WS_W_PLE + OFF_PLE_WP), W_PLE_STRIDE, nullptr, 0, nullptr);
    tr_job(C, J_MOE_UP, INF(I_MOE_WUP), (size_t)DM * 2048, DEPTH * NE, DM, 2048, 2048, WSP(bf16_t, WS_W_UP), (size_t)2048 * 1024 * 2, nullptr, 0, nullptr);
    tr_job(C, J_NAT, INF(I_MOE_WDN), (size_t)DFF * DM, DEPTH * NE, DFF, DM, DM, WSP(bf16_t, WS_W_DN), (size_t)1024 * 1024 * 2, nullptr, 0, nullptr);
    cvt_rows(C, INF(I_X), WSP(bf16_t, WS_XB), (size_t)T * DM / 8);
    cvt_rows(C, INF(I_P), WSP(bf16_t, WS_PB), (size_t)DEPTH * T * PLED / 8);
    { const int* pos = (const int*)args.in[I_POS]; float* CS = WSP(float, WS_CS); float* SN = WSP(float, WS_SN);
      const size_t gt = (size_t)C.vcu * 512 + C.tid, NT = (size_t)C.G * 512;
      for (size_t i = gt; i < (size_t)T * 32; i += NT) { const int tok = (int)(i >> 5), j = (int)(i & 31);
          const double inv = exp(-9.210340371976184 * (double)j / 32.0); const double ang = (double)pos[tok] * inv; double s, c; sincos(ang, &s, &c); CS[i] = (float)c; SN[i] = (float)s; }
      float* SPL = WSP(float, WS_SPL); const float* lam = INF(I_LRU_LAM);
      for (size_t i = gt; i < 2 * 1024; i += NT) { const double l = (double)lam[i]; SPL[i] = (float)(-8.0 * log1p(exp(-l))); } }
}

__device__ __forceinline__ void moe_table(const CAS Args& args, const Ctx& C0, int layer) {
    Ctx C = C0; C.tid = opaque_tid(); C.lane = C.tid & 63;
    const unsigned* cnt = WSP(unsigned, WS_CTL) + CW_CNT + 64 * layer;
    __syncthreads();
    if (C.tid < 32) C.misc[64 + C.tid] = (int)__hip_atomic_load(cnt + C.tid, __ATOMIC_RELAXED, __HIP_MEMORY_SCOPE_AGENT);
    __syncthreads();
    if (C.tid == 0) { int acc = 0; for (int e = 0; e < 32; ++e) { C.misc[16 + e] = acc; acc += (C.misc[64 + e] + 255) >> 8; } C.misc[16 + 32] = acc; }
    __syncthreads();
    { volatile LAS int* te = (volatile LAS int*)(C.lds + TILE_E_OFF);
      for (int mg = C.tid; mg < C.misc[48]; mg += NWAVES * 64) { int e = 0; for (int j = 1; j < 32; ++j) e += (C.misc[16 + j] <= mg) ? 1 : 0; te[mg] = e; } }
    __syncthreads();
}

__device__ __forceinline__ void phase_ln_router(const CAS Args& args, const Ctx& C0, int layer) {
    const int cslot = layer + args.pad;
    Ctx C = C0; C.tid = opaque_tid(); C.lane = C.tid & 63;
    const bf16_t* Y = WSP(bf16_t, WS_Y); float* X1 = WSP(float, WS_X1); bf16_t* X1B = WSP(bf16_t, WS_X1B);
    const float* g1 = INF(I_LN1G) + layer * DM; const float* b1 = INF(I_LN1B) + layer * DM;
    const CAS float* Wr = (const CAS float*)(INF(I_MOE_WR) + (size_t)layer * DM * NE); const float* br = INF(I_MOE_BR) + layer * NE;
    unsigned* gcnt = WSP(unsigned, WS_CTL) + CW_CNT + 64 * cslot;
    int* lists = WSP(int, WS_LIST); int* slot = WSP(int, WS_SLOT); float* gate = WSP(float, WS_GATE);
    LAS float* part = (LAS float*)C.lds;
    volatile LAS int* lcnt = (volatile LAS int*)(C.lds + 69632);
    volatile LAS int* lbase = lcnt + 32;
    f32x4 gv[4], bv[4];
#pragma unroll
    for (int j = 0; j < 2; ++j) { gv[2 * j] = *(const f32x4*)(g1 + 8 * C.lane + 512 * j); gv[2 * j + 1] = *(const f32x4*)(g1 + 8 * C.lane + 512 * j + 4);
        bv[2 * j] = *(const f32x4*)(b1 + 8 * C.lane + 512 * j); bv[2 * j + 1] = *(const f32x4*)(b1 + 8 * C.lane + 512 * j + 4); }
    for (int chunk = C.vcu; chunk < T / 128; chunk += C.G) {
        const int row0 = chunk * 128;
        if (C.tid < 32) lcnt[C.tid] = 0;
#pragma unroll 1
        for (int i = 0; i < 16; ++i) { const size_t row = (size_t)row0 + C.wave * 16 + i;
            f32x4 v[4]; float s = 0.f;
#pragma unroll
            for (int j = 0; j < 2; ++j) { const u32x4 w = *(const u32x4*)(Y + row * DM + 8 * C.lane + 512 * j); v[2 * j] = pg8::bf4_lo(w); v[2 * j + 1] = pg8::bf4_hi(w); }
#pragma unroll
            for (int j = 0; j < 4; ++j) s += (v[j][0] + v[j][1]) + (v[j][2] + v[j][3]);
            const float mean = wave_sum(s) * (1.f / DM); float s2 = 0.f;
#pragma unroll
            for (int j = 0; j < 4; ++j) { v[j] = v[j] - mean; s2 += (v[j][0] * v[j][0] + v[j][1] * v[j][1]) + (v[j][2] * v[j][2] + v[j][3] * v[j][3]); }
            const float rstd = 1.f / sqrtf(wave_sum(s2) * (1.f / DM) + LN_EPS);
#pragma unroll
            for (int j = 0; j < 4; ++j) v[j] = v[j] * rstd * gv[j] + bv[j];
#pragma unroll
            for (int j = 0; j < 2; ++j) { float* xo = X1 + row * DM + 8 * C.lane + 512 * j; *(f32x4*)xo = v[2 * j]; *(f32x4*)(xo + 4) = v[2 * j + 1];
                *(u32x4*)(X1B + row * DM + 8 * C.lane + 512 * j) = pack8(v[2 * j], v[2 * j + 1]); } }
        asm volatile("s_waitcnt vmcnt(0)" ::: "memory");
        __syncthreads();
        { const int grp = C.wave >> 2, kq = C.wave & 3; const size_t tok = (size_t)row0 + grp * 64 + C.lane;
          float acc[32];
#pragma unroll
          for (int e = 0; e < 32; ++e) acc[e] = 0.f;
          const float* xr = X1 + tok * DM + kq * 256;
          for (int kk = 0; kk < 64; ++kk) { const f32x4 xv = *(const f32x4*)(xr + kk * 4);
#pragma unroll
              for (int i = 0; i < 4; ++i) { const CAS float* wrow = Wr + (size_t)(kq * 256 + kk * 4 + i) * NE;
#pragma unroll
                  for (int e = 0; e < 32; ++e) acc[e] = fmaf(xv[i], wrow[e], acc[e]);
                  if (i & 1) __builtin_amdgcn_sched_barrier(0); } }
          LAS float* pp = part + ((grp * 4 + kq) * 64 + C.lane) * 33;
#pragma unroll
          for (int e = 0; e < 32; ++e) pp[e] = acc[e]; }
        __syncthreads();
        int te[4] = {0, 0, 0, 0}, lp[4] = {0, 0, 0, 0}; float tg[4] = {0.f, 0.f, 0.f, 0.f};
        if (C.tid < 128) { const int grp = C.tid >> 6, ln = C.tid & 63; float lg[32];
#pragma unroll
            for (int e = 0; e < 32; ++e) { float s = br[e];
#pragma unroll
                for (int kq = 0; kq < 4; ++kq) s += part[((grp * 4 + kq) * 64 + ln) * 33 + e];
                lg[e] = s; }
            float tv[4];
#pragma unroll
            for (int k = 0; k < 4; ++k) { float best = lg[0]; int bi = 0;
#pragma unroll
                for (int e = 1; e < 32; ++e) { const bool gt = lg[e] > best; best = gt ? lg[e] : best; bi = gt ? e : bi; }
                te[k] = bi; tv[k] = best;
#pragma unroll
                for (int e = 0; e < 32; ++e) lg[e] = (e == bi) ? -__builtin_inff() : lg[e]; }
            float den = 0.f;
#pragma unroll
            for (int k = 0; k < 4; ++k) { tg[k] = __expf(tv[k] - tv[0]); den += tg[k]; }
            const float rden = 1.0f / den;
#pragma unroll
            for (int k = 0; k < 4; ++k) { tg[k] *= rden; lp[k] = __hip_atomic_fetch_add((LAS int*)&lcnt[te[k]], 1, __ATOMIC_RELAXED, __HIP_MEMORY_SCOPE_WORKGROUP); } }
        __syncthreads();
        if (C.tid < 32) lbase[C.tid] = (int)__hip_atomic_fetch_add(gcnt + C.tid, (unsigned)lcnt[C.tid], __ATOMIC_RELAXED, __HIP_MEMORY_SCOPE_AGENT);
        __syncthreads();
        if (C.tid < 128) { const int tok = row0 + C.tid;
#pragma unroll
            for (int k = 0; k < 4; ++k) { const int pos = lbase[te[k]] + lp[k]; lists[(size_t)te[k] * T + pos] = tok; slot[tok * 4 + k] = te[k] * T + pos; gate[tok * 4 + k] = tg[k]; } }
        __syncthreads();
    }
}

__device__ __forceinline__ void phase_combine_ln2(const CAS Args& args, const Ctx& C0, int layer) {
    Ctx C = C0; C.tid = opaque_tid(); C.lane = C.tid & 63;
    moe_table(args, C, layer);
    const bf16_t* X1B = WSP(bf16_t, WS_X1B); const bf16_t* YS = WSP(bf16_t, WS_YS); const int* slot = WSP(int, WS_SLOT); const float* gate = WSP(float, WS_GATE);
    bf16_t* X2B = WSP(bf16_t, WS_X2B);
    const float* g2 = INF(I_LN2G) + layer * DM; const float* b2 = INF(I_LN2B) + layer * DM;
    f32x4 gv[4], bv[4];
#pragma unroll
    for (int j = 0; j < 2; ++j) { gv[2 * j] = *(const f32x4*)(g2 + 8 * C.lane + 512 * j); gv[2 * j + 1] = *(const f32x4*)(g2 + 8 * C.lane + 512 * j + 4);
        bv[2 * j] = *(const f32x4*)(b2 + 8 * C.lane + 512 * j); bv[2 * j + 1] = *(const f32x4*)(b2 + 8 * C.lane + 512 * j + 4); }
    const int gw = C.vcu * NWAVES + C.wave, NGW = C.G * NWAVES;
    for (int row = gw; row < T; row += NGW) {
        f32x4 v[4];
#pragma unroll
        for (int j = 0; j < 2; ++j) { const u32x4 w = *(const u32x4*)(X1B + (size_t)row * DM + 8 * C.lane + 512 * j); v[2 * j] = pg8::bf4_lo(w) * ALPHA; v[2 * j + 1] = pg8::bf4_hi(w) * ALPHA; }
#pragma unroll
        for (int k = 0; k < 4; ++k) { const int sv = slot[row * 4 + k]; const float g = gate[row * 4 + k]; const int e = sv >> 15, pos = sv & (T - 1);
            const size_t prow = (size_t)C.misc[16 + e] * 256 + pos;
#pragma unroll
            for (int j = 0; j < 2; ++j) { const u32x4 w = *(const u32x4*)(YS + prow * DM + 8 * C.lane + 512 * j); v[2 * j] += pg8::bf4_lo(w) * g; v[2 * j + 1] += pg8::bf4_hi(w) * g; } }
        float s = 0.f;
#pragma unroll
        for (int j = 0; j < 4; ++j) s += (v[j][0] + v[j][1]) + (v[j][2] + v[j][3]);
        const float mean = wave_sum(s) * (1.f / DM); float s2 = 0.f;
#pragma unroll
        for (int j = 0; j < 4; ++j) { v[j] = v[j] - mean; s2 += (v[j][0] * v[j][0] + v[j][1] * v[j][1]) + (v[j][2] * v[j][2] + v[j][3] * v[j][3]); }
        const float rstd = 1.f / sqrtf(wave_sum(s2) * (1.f / DM) + LN_EPS);
#pragma unroll
        for (int j = 0; j < 4; ++j) v[j] = v[j] * rstd * gv[j] + bv[j];
#pragma unroll
        for (int j = 0; j < 2; ++j) *(u32x4*)(X2B + (size_t)row * DM + 8 * C.lane + 512 * j) = pack8(v[2 * j], v[2 * j + 1]);
    }
}

__device__ __forceinline__ void phase_conv(const CAS Args& args, const Ctx& C0, int j) {
    Ctx C = C0; C.tid = opaque_tid(); C.lane = C.tid & 63;
    const bf16_t* U = WSP(bf16_t, WS_U); bf16_t* UC = WSP(bf16_t, WS_UC);
    const float* cw = INF(I_LRU_CW) + (size_t)j * 4 * DM; const float* cb = INF(I_LRU_CB) + (size_t)j * DM;
    const int c8 = (C.tid & 127) * 8, rsub = C.tid >> 7;
    float w[4][8], bb[8];
#pragma unroll
    for (int q = 0; q < 4; ++q)
#pragma unroll
        for (int e = 0; e < 8; ++e) w[q][e] = cw[q * DM + c8 + e];
#pragma unroll
    for (int e = 0; e < 8; ++e) bb[e] = cb[c8 + e];
    for (int chunk = C.vcu; chunk < T / 128; chunk += C.G) {
        const int r0 = chunk * 128 + rsub * 32;
        u32x4 h0, h1, h2;
        const u32x4 z = {0u, 0u, 0u, 0u};
        const int s0 = r0 & (SEQ - 1);
        h0 = s0 >= 3 ? *(const u32x4*)(U + (size_t)(r0 - 3) * DM + c8) : z; h1 = s0 >= 2 ? *(const u32x4*)(U + (size_t)(r0 - 2) * DM + c8) : z; h2 = s0 >= 1 ? *(const u32x4*)(U + (size_t)(r0 - 1) * DM + c8) : z;
#pragma unroll 4
        for (int i = 0; i < 32; ++i) { const u32x4 h3 = *(const u32x4*)(U + (size_t)(r0 + i) * DM + c8);
            float o[8];
#pragma unroll
            for (int q = 0; q < 4; ++q) { const unsigned a = h0[q], b = h1[q], c = h2[q], d = h3[q];
                o[2 * q] = bb[2 * q] + w[0][2 * q] * bf_lo(a) + w[1][2 * q] * bf_lo(b) + w[2][2 * q] * bf_lo(c) + w[3][2 * q] * bf_lo(d);
                o[2 * q + 1] = bb[2 * q + 1] + w[0][2 * q + 1] * bf_hi(a) + w[1][2 * q + 1] * bf_hi(b) + w[2][2 * q + 1] * bf_hi(c) + w[3][2 * q + 1] * bf_hi(d); }
            u32x4 ow; ow.x = cvt_pk_bf16(o[0], o[1]); ow.y = cvt_pk_bf16(o[2], o[3]); ow.z = cvt_pk_bf16(o[4], o[5]); ow.w = cvt_pk_bf16(o[6], o[7]);
            *(u32x4*)(UC + (size_t)(r0 + i) * DM + c8) = ow; h0 = h1; h1 = h2; h2 = h3; }
    }
}
__device__ __forceinline__ void phase_scan1(const CAS Args& args, const Ctx& C0) {
    Ctx C = C0; C.tid = opaque_tid(); C.lane = C.tid & 63;
    const bf16_t* LA = WSP(bf16_t, WS_AA); const bf16_t* BB = WSP(bf16_t, WS_BB); float* CA = WSP(float, WS_CA); float* CH = WSP(float, WS_CH);
    const int c2 = C.tid * 2;
    for (int item = C.vcu; item < NBATCH * 64; item += C.G) {
        const size_t r0 = (size_t)item * 64; float h0 = 0.f, h1 = 0.f, l0 = 0.f, l1 = 0.f;
#pragma unroll 8
        for (int s = 0; s < 64; ++s) { const unsigned aw = *(const unsigned*)(LA + (r0 + s) * DM + c2), bw = *(const unsigned*)(BB + (r0 + s) * DM + c2);
            const float la0 = bf_lo(aw), la1 = bf_hi(aw);
            h0 = __builtin_amdgcn_exp2f(la0) * h0 + bf_lo(bw); h1 = __builtin_amdgcn_exp2f(la1) * h1 + bf_hi(bw); l0 += la0; l1 += la1; }
        *(f32x2*)(CA + (size_t)item * DM + c2) = (f32x2){__builtin_amdgcn_exp2f(l0), __builtin_amdgcn_exp2f(l1)}; *(f32x2*)(CH + (size_t)item * DM + c2) = (f32x2){h0, h1};
    }
}
__device__ __forceinline__ void phase_scan2(const CAS Args& args, const Ctx& C0) {
    Ctx C = C0; C.tid = opaque_tid(); C.lane = C.tid & 63;
    const bf16_t* LA = WSP(bf16_t, WS_AA); const bf16_t* BB = WSP(bf16_t, WS_BB); const float* CA = WSP(float, WS_CA); const float* CH = WSP(float, WS_CH);
    const bf16_t* GG = WSP(bf16_t, WS_GG); bf16_t* YL = WSP(bf16_t, WS_O);
    const int c2 = C.tid * 2;
    for (int item = C.vcu; item < NBATCH * 64; item += C.G) {
        const int b = item >> 6, ch = item & 63; float h0 = 0.f, h1 = 0.f;
        for (int jx = 0; jx < ch; ++jx) { const f32x2 a = *(const f32x2*)(CA + (size_t)(b * 64 + jx) * DM + c2), e = *(const f32x2*)(CH + (size_t)(b * 64 + jx) * DM + c2);
            h0 = a[0] * h0 + e[0]; h1 = a[1] * h1 + e[1]; }
        const size_t r0 = (size_t)item * 64;
#pragma unroll 8
        for (int s = 0; s < 64; ++s) { const unsigned aw = *(const unsigned*)(LA + (r0 + s) * DM + c2), bw = *(const unsigned*)(BB + (r0 + s) * DM + c2), g = *(const unsigned*)(GG + (r0 + s) * DM + c2);
            h0 = __builtin_amdgcn_exp2f(bf_lo(aw)) * h0 + bf_lo(bw); h1 = __builtin_amdgcn_exp2f(bf_hi(aw)) * h1 + bf_hi(bw);
            *(unsigned*)(YL + (r0 + s) * DM + c2) = cvt_pk_bf16(bf_lo(g) * h0, bf_hi(g) * h1); }
    }
}

constexpr int PH_PER_LAYER = 12, PH_TOTAL = 2 + PH_PER_LAYER * DEPTH;
__global__ void __launch_bounds__(NWAVES * 64, 2) fwd_kernel(Args args_kernarg) {
    (void)args_kernarg;
    ArgsP const argp = (ArgsP)__builtin_amdgcn_kernarg_segment_ptr();
    const CAS Args& args0 = *argp;
    extern __shared__ __attribute__((aligned(16))) unsigned char lds_raw[];
    Ctx C_;
    C_.lds = (LAS unsigned char*)lds_raw; C_.misc = (volatile LAS int*)(C_.lds + MISC_OFF);
    C_.tid = threadIdx.x; C_.lane = C_.tid & 63; C_.wave = __builtin_amdgcn_readfirstlane(C_.tid >> 6);
    C_.bid = (int)blockIdx.x; C_.G = gridDim.x; { const int bx = blockIdx.x; C_.vcu = (C_.G % 8 == 0) ? (bx % 8) * (C_.G / 8) + bx / 8 : bx; }
    for (int u = C_.tid; u < 128; u += NWAVES * 64) C_.misc[u] = 0;
    __syncthreads();
    XcdBarrier bar = xcd_barrier_post((unsigned*)(args0.ws + WS_CTL) + CW_BAR + args0.li * XCD_BAR_WORDS, (volatile LAS unsigned*)C_.misc);
    const int lo = args0.ph_lo, hi = args0.ph_hi;
#define IN(k) (lo <= (k) && (k) < hi)
#define PH_END(k) do { if ((k) + 1 < hi) xcd_barrier(bar); } while (0)

    if (SEL(0) && IN(0)) { const CAS Args& args = fresh_args(argp); const Ctx C = fresh_ctx(C_); const int cid = C.bid; phase_prologue(args, C); PH_END(0); }
    if (SEL(1) && IN(1)) { const CAS Args& args = fresh_args(argp); const Ctx C = fresh_ctx(C_); const int cid = C.bid;
        pg8::DenseSched S; S.init(WSP(bf16_t, WS_PB), WSP(bf16_t, WS_W_PLE + OFF_PLE_WP), PLED, PLED, DEPTH * T, DM, C.G, cid); S.bpm_shift = 7; S.bbatch = W_PLE_STRIDE;
        pg8::EpiPP E{WSP(bf16_t, WS_PP)};
        pg8::gemm_phase<pg8::EpiPP, pg8::DenseSched, false>(C.lds, PLED, PLED, PLED, S, E);
        PH_END(1);
    }
    for (int layer = 0; layer < DEPTH; ++layer) {
        const int base = 2 + PH_PER_LAYER * layer, j = layer >> 1;
        if ((layer & 1) == 0) {
            if (SEL(2) && IN(base + 0)) { const CAS Args& args = fresh_args(argp); const Ctx C = fresh_ctx(C_); const int cid = C.bid; const unsigned char* wm = args.ws + WS_W_MLA + (size_t)j * W_MLA_STRIDE;
                pg8::DenseSched S; S.init(WSP(bf16_t, WS_XB), wm + OFF_MLA_WIN, DM, DM, T, 1280, C.G, cid);
                pg8::EpiLat E{WSP(bf16_t, WS_LAT), WSP(float, WS_SSQ), WSP(bf16_t, WS_KR), WSP(float, WS_CS), WSP(float, WS_SN)};
                pg8::gemm_phase<pg8::EpiLat, pg8::DenseSched, false>(C.lds, DM, DM, DM, S, E);
                PH_END(base + 0);
            }
            if (SEL(3) && IN(base + 1)) { const CAS Args& args = fresh_args(argp); const Ctx C = fresh_ctx(C_); const int cid = C.bid; const unsigned char* wm = args.ws + WS_W_MLA + (size_t)j * W_MLA_STRIDE;
                { pg8::DenseSched S; S.init(WSP(bf16_t, WS_LAT), wm + OFF_MLA_WUQ, DM, QL, T, 1536, C.G, cid);
                  pg8::EpiQ E{WSP(bf16_t, WS_Q), WSP(float, WS_SSQ), WSP(float, WS_CS), WSP(float, WS_SN)};
                  pg8::gemm_phase<pg8::EpiQ, pg8::DenseSched, false>(C.lds, QL, DM, QL, S, E); }
                { pg8::DenseSched S; S.init(WSP(bf16_t, WS_LAT) + QL, wm + OFF_MLA_WUKV, DM, KVL, T, 2048, C.G, cid);
                  pg8::EpiKV E{WSP(bf16_t, WS_KN), WSP(bf16_t, WS_V), WSP(float, WS_SSQ)};
                  pg8::gemm_phase<pg8::EpiKV, pg8::DenseSched, false>(C.lds, KVL, DM, KVL, S, E); }
                PH_END(base + 1);
            }
            if (SEL(4) && IN(base + 2)) { const CAS Args& args = fresh_args(argp); const Ctx C = fresh_ctx(C_); const int cid = C.bid;
                for (int it = C.vcu; it < NBATCH * NH * 8; it += C.G) { const int bh = it >> 3, pr = it & 7;
                    att::attn_block(bh >> 3, bh & 7, pr, WSP(bf16_t, WS_Q), WSP(bf16_t, WS_KN), WSP(bf16_t, WS_KR), WSP(bf16_t, WS_V), WSP(bf16_t, WS_O), (LAS char*)C.lds, PROBE_T ? (unsigned long long*)(args.ws + WS_CTL + 8192) : nullptr);
                    att::attn_block(bh >> 3, bh & 7, 15 - pr, WSP(bf16_t, WS_Q), WSP(bf16_t, WS_KN), WSP(bf16_t, WS_KR), WSP(bf16_t, WS_V), WSP(bf16_t, WS_O), (LAS char*)C.lds, PROBE_T ? (unsigned long long*)(args.ws + WS_CTL + 8192) : nullptr); }
                PH_END(base + 2);
            }
        } else {
            if (SEL(5) && IN(base + 0)) { const CAS Args& args = fresh_args(argp); const Ctx C = fresh_ctx(C_); const int cid = C.bid; const unsigned char* wl = args.ws + WS_W_LRU + (size_t)j * W_LRU_STRIDE;
                pg8::DenseSched S; S.init(WSP(bf16_t, WS_XB), wl + OFF_LRU_WIN, DM, DM, T, 2048, C.G, cid);
                pg8::EpiGU E{WSP(bf16_t, WS_GG), WSP(bf16_t, WS_U)};
                pg8::gemm_phase<pg8::EpiGU, pg8::DenseSched, false>(C.lds, DM, DM, DM, S, E);
                PH_END(base + 0);
            }
            if (SEL(6) && IN(base + 1)) { const CAS Args& args = fresh_args(argp); const Ctx C = fresh_ctx(C_); const int cid = C.bid; phase_conv(args, C, j); PH_END(base + 1); }
            if (SEL(7) && IN(base + 2)) { const CAS Args& args = fresh_args(argp); const Ctx C = fresh_ctx(C_); const int cid = C.bid; const unsigned char* wl = args.ws + WS_W_LRU + (size_t)j * W_LRU_STRIDE;
                pg8::DenseSched S; S.init(WSP(bf16_t, WS_UC), wl + OFF_LRU_WAX, DM, 256, T, 2048, C.G, cid); S.apn_shift = 1; S.akbytes = 512;
                pg8::EpiAB E{WSP(bf16_t, WS_AA), WSP(bf16_t, WS_BB), WSP(bf16_t, WS_UC), INF(I_LRU_BA) + j * DM, INF(I_LRU_BX) + j * DM, WSP(float, WS_SPL) + j * DM};
                pg8::gemm_phase<pg8::EpiAB, pg8::DenseSched, false>(C.lds, 256, DM, 256, S, E);
                PH_END(base + 2);
            }
            if (SEL(8) && IN(base + 3)) { const CAS Args& args = fresh_args(argp); const Ctx C = fresh_ctx(C_); const int cid = C.bid; phase_scan1(args, C); PH_END(base + 3); }
            if (SEL(9) && IN(base + 4)) { const CAS Args& args = fresh_args(argp); const Ctx C = fresh_ctx(C_); const int cid = C.bid; phase_scan2(args, C); PH_END(base + 4); }
        }
        if (SEL(10) && IN(base + 5)) { const CAS Args& args = fresh_args(argp); const Ctx C = fresh_ctx(C_); const int cid = C.bid;
            const unsigned char* wo = (layer & 1) ? args.ws + WS_W_LRU + (size_t)j * W_LRU_STRIDE + OFF_LRU_WOUT : args.ws + WS_W_MLA + (size_t)j * W_MLA_STRIDE + OFF_MLA_WO;
            pg8::DenseSched S; S.init(WSP(bf16_t, WS_O), wo, DM, DM, T, DM, C.G, cid);
            pg8::EpiRes E{WSP(bf16_t, WS_XB), WSP(bf16_t, WS_Y)};
            pg8::gemm_phase<pg8::EpiRes, pg8::DenseSched, false>(C.lds, DM, DM, DM, S, E);
            PH_END(base + 5);
        }
        if (SEL(11) && IN(base + 6)) { const CAS Args& args = fresh_args(argp); const Ctx C = fresh_ctx(C_); const int cid = C.bid; phase_ln_router(args, C, layer); PH_END(base + 6); }
        if (SEL(12) && IN(base + 7)) { const CAS Args& args = fresh_args(argp); const Ctx C = fresh_ctx(C_); const int cid = C.bid;
            moe_table(args, C, layer);
            pg8::MoeSched S{(const char*)WSP(bf16_t, WS_X1B), (const char*)(args.ws + WS_W_UP + (size_t)layer * NE * 2048 * 1024 * 2), (size_t)2048 * 1024 * 2, DM, DM, 8, WSP(int, WS_LIST), C.misc + 16, (volatile LAS const int*)(C.lds + TILE_E_OFF), C.G, cid, true};
            pg8::EpiUp E{WSP(bf16_t, WS_H), INF(I_MOE_BUP) + (size_t)layer * NE * 2048};
            pg8::gemm_phase<pg8::EpiUp, pg8::MoeSched, true>(C.lds, DM, DM, DM, S, E, PROBE_T ? (unsigned long long*)(args.ws + WS_CTL + 8192) : nullptr);
            PH_END(base + 7);
        }
        if (SEL(13) && IN(base + 8)) { const CAS Args& args = fresh_args(argp); const Ctx C = fresh_ctx(C_); const int cid = C.bid;
            moe_table(args, C, layer);
            pg8::MoeSched S{(const char*)WSP(bf16_t, WS_H), (const char*)(args.ws + WS_W_DN + (size_t)layer * NE * 1024 * 1024 * 2), (size_t)1024 * 1024 * 2, DFF, DFF, 4, WSP(int, WS_LIST), C.misc + 16, (volatile LAS const int*)(C.lds + TILE_E_OFF), C.G, cid, false};
            pg8::EpiDown E{WSP(bf16_t, WS_YS), INF(I_MOE_BDN) + (size_t)layer * NE * DM};
            pg8::gemm_phase<pg8::EpiDown, pg8::MoeSched, false>(C.lds, DFF, DFF, DFF, S, E);
            PH_END(base + 8);
        }
        if (SEL(14) && IN(base + 9)) { const CAS Args& args = fresh_args(argp); const Ctx C = fresh_ctx(C_); const int cid = C.bid; phase_combine_ln2(args, C, layer); PH_END(base + 9); }
        if (SEL(15) && IN(base + 10)) { const CAS Args& args = fresh_args(argp); const Ctx C = fresh_ctx(C_); const int cid = C.bid;
            pg8::DenseSched S; S.init(WSP(bf16_t, WS_X2B), args.ws + WS_W_PLE + (size_t)layer * W_PLE_STRIDE + OFF_PLE_WG, DM, DM, T, DM, C.G, cid);
            pg8::EpiPle E{WSP(bf16_t, WS_X2B), WSP(bf16_t, WS_PP) + (size_t)layer * T * DM, layer == DEPTH - 1 ? args.out : (float*)nullptr, WSP(bf16_t, WS_XB)};
            pg8::gemm_phase<pg8::EpiPle, pg8::DenseSched, false>(C.lds, DM, DM, DM, S, E);
            if (layer + 1 < DEPTH) PH_END(base + 10);
        }
    }
#if PROBE_T
    { xcd_barrier(bar); const CAS Args& args = fresh_args(argp);
      const unsigned long long* pw = (const unsigned long long*)(args.ws + WS_CTL + 8192);
      const double pk = (double)__hip_atomic_load(pw + 0, __ATOMIC_RELAXED, __HIP_MEMORY_SCOPE_AGENT), pe = (double)__hip_atomic_load(pw + 1, __ATOMIC_RELAXED, __HIP_MEMORY_SCOPE_AGENT),
                   pn = (double)__hip_atomic_load(pw + 2, __ATOMIC_RELAXED, __HIP_MEMORY_SCOPE_AGENT), pt = (double)__hip_atomic_load(pw + 3, __ATOMIC_RELAXED, __HIP_MEMORY_SCOPE_AGENT);
      float c = 100.f;
      if (PROBE_T == 2) c = (float)(pk / (pn * 16.0) / 10.0);
      if (PROBE_T == 3) c = (float)(pe / pn / 100.0);
      if (PROBE_T == 4) c = (float)((pt - pk - pe) / pn / 100.0);
      if (PROBE_T == 5) c = (float)(pn);
      if (PROBE_T >= 10) { double q[7]; for (int i = 0; i < 7; ++i) q[i] = (double)__hip_atomic_load(pw + 8 + i, __ATOMIC_RELAXED, __HIP_MEMORY_SCOPE_AGENT);
          if (PROBE_T == 10) c = (float)(q[6] / q[5] / 10.0);
          if (PROBE_T == 11) c = (float)(q[0] / q[5] / 10.0);
          if (PROBE_T == 12) c = (float)(q[1] / q[5] / 10.0);
          if (PROBE_T == 13) c = (float)(q[2] / q[5] / 10.0);
          if (PROBE_T == 14) c = (float)(q[3] / q[5] / 10.0);
          if (PROBE_T == 15) c = (float)(q[4] / q[5] / 10.0); }
      if (PROBE_T >= 2) c = exp2f(floorf(log2f(c) * 8.0f + PROBE_SHIFT) * 0.125f);
      for (size_t i = (size_t)blockIdx.x * 512 + threadIdx.x; i < (size_t)T * DM; i += (size_t)gridDim.x * 512) args.out[i] = c; }
#endif
#undef IN
#undef PH_END
}

extern "C" void kernel_launch(void* const* d_in, const int* in_sizes, int n_in, void* d_out, int out_size, void* d_ws, size_t ws_size, hipStream_t stream) {
    static int grid = 0;
    if (grid == 0) {
        if (n_in != 30 || in_sizes[0] != T * DM || out_size != T * DM || ws_size < WS_END) { fprintf(stderr, "kernel_launch: unexpected shapes (n_in %d, in0 %d, out %d, ws %zu)\n", n_in, n_in > 0 ? in_sizes[0] : -1, out_size, ws_size); grid = -1; return; }
        int dev = 0, cus = 0, per_cu = 0;
        if (hipGetDevice(&dev) != hipSuccess || hipDeviceGetAttribute(&cus, hipDeviceAttributeMultiprocessorCount, dev) != hipSuccess) { grid = -1; return; }
        if (hipFuncSetAttribute((const void*)fwd_kernel, hipFuncAttributeMaxDynamicSharedMemorySize, LDS_BYTES) != hipSuccess) { fprintf(stderr, "kernel_launch: hipFuncSetAttribute failed\n"); grid = -1; return; }
        if (hipOccupancyMaxActiveBlocksPerMultiprocessor(&per_cu, (const void*)fwd_kernel, NWAVES * 64, LDS_BYTES) != hipSuccess || per_cu < 1) fprintf(stderr, "kernel_launch: occupancy query reports %d\n", per_cu);
        (void)hipGetLastError();
        grid = cus;
    }
    if (grid < 0) return;
    if (hipMemsetAsync((char*)d_ws + WS_CTL, 0, CTL_ZERO_BYTES, stream) != hipSuccess) return;
    Args a{};
    for (int i = 0; i < 30; ++i) a.in[i] = d_in[i];
    a.out = (float*)d_out; a.ws = (unsigned char*)d_ws; a.pad = 0;
#if MK_ONE_LAUNCH
    a.ph_lo = 0; a.ph_hi = PH_TOTAL; a.li = 0;
    hipLaunchKernelGGL(fwd_kernel, dim3(grid), dim3(NWAVES * 64), LDS_BYTES, stream, a);
#else
    int li = 0;
    for (int ph = 0; ph < PH_TOTAL; ++ph) {
        if (ph >= 2) { const int l = (ph - 2) / PH_PER_LAYER, k = (ph - 2) % PH_PER_LAYER; if (k == 11) continue; if ((l & 1) == 0 && (k == 3 || k == 4)) continue; }
        int site = ph;
        if (ph >= 2) { const int l = (ph - 2) / PH_PER_LAYER, k = (ph - 2) % PH_PER_LAYER; static const int mla[11] = {2, 3, 4, -1, -1, 10, 11, 12, 13, 14, 15}, lru[11] = {5, 6, 7, 8, 9, 10, 11, 12, 13, 14, 15}; site = (l & 1) ? lru[k] : mla[k]; }
        a.ph_lo = ph; a.ph_hi = ph + 1;
        if ((HOSTDUP >> site) & 1) { a.li = li++; a.pad = 4; hipLaunchKernelGGL(fwd_kernel, dim3(grid), dim3(NWAVES * 64), LDS_BYTES, stream, a); }
        a.li = li++; a.pad = 0;
        hipLaunchKernelGGL(fwd_kernel, dim3(grid), dim3(NWAVES * 64), LDS_BYTES, stream, a);
    }
#endif
}
```

```cpp
#include <hip/hip_runtime.h>
#include <hip/hip_bf16.h>
#include <cstdio>
#include <cstdint>

#ifndef PHSEL
#define PHSEL -1
#endif
#ifndef PHSKIP
#define PHSKIP -1
#endif
#define SEL(id) ((PHSEL < 0 || PHSEL == (id)) && PHSKIP != (id))
#ifndef PROBE_T
#define PROBE_T 0
#endif
#ifndef PROBE_SHIFT
#define PROBE_SHIFT 0.0f
#endif
#ifndef HOSTDUP
#define HOSTDUP 0
#endif
#ifndef MK_ONE_LAUNCH
#define MK_ONE_LAUNCH 1
#endif

constexpr int T = 32768, SEQ = 4096, NBATCH = 8, DM = 1024, DEPTH = 4;
constexpr int QL = 768, KVL = 256, ROPE = 64, LATD = 1088, NH = 8, DQK = 192, DV = 128;
constexpr int NE = 32, TOPK = 4, DFF = 1024, PLED = 256;
constexpr float ALPHA = 1.681792830507429f;
constexpr float LN_EPS = 1e-5f, RMS_EPS = 1e-6f;
constexpr float QSCALE = 1.4426950408889634f / 13.856406460551018f;
constexpr int NWAVES = 8;

constexpr size_t MiB = 1u << 20;
constexpr size_t WS_CTL = 0, CTL_ZERO_BYTES = 2 * MiB;
constexpr size_t WS_CS = 2 * MiB, WS_SN = 6 * MiB, WS_SPL = 10 * MiB;
constexpr size_t WS_W_MLA = 12 * MiB, W_MLA_STRIDE = 8 * MiB;
constexpr size_t OFF_MLA_WIN = 0, OFF_MLA_WUQ = 2560 * 1024, OFF_MLA_WUKV = OFF_MLA_WUQ + 2304 * 1024, OFF_MLA_WO = OFF_MLA_WUKV + 1024 * 1024;
constexpr size_t WS_W_LRU = 28 * MiB, W_LRU_STRIDE = 8 * MiB;
constexpr size_t OFF_LRU_WIN = 0, OFF_LRU_WAX = 4 * MiB, OFF_LRU_WOUT = 5 * MiB;
constexpr size_t WS_W_PLE = 44 * MiB, W_PLE_STRIDE = 3 * MiB;
constexpr size_t OFF_PLE_WG = 0, OFF_PLE_WP = 2 * MiB;
constexpr size_t WS_W_UP = 56 * MiB;
constexpr size_t WS_W_DN = 568 * MiB;
constexpr size_t WS_XB = 824 * MiB, WS_PB = 888 * MiB, WS_PP = 952 * MiB;
constexpr size_t WS_Y = 1208 * MiB, WS_X1 = 1336 * MiB, WS_X1B = 1464 * MiB, WS_X2 = 1528 * MiB, WS_X2B = 1656 * MiB;
constexpr size_t WS_LAT = 1720 * MiB, WS_KR = 1784 * MiB, WS_SSQ = 1788 * MiB, WS_Q = 1790 * MiB, WS_KN = 1886 * MiB, WS_V = 1950 * MiB, WS_O = 2014 * MiB;
constexpr size_t WS_GG = 2078 * MiB, WS_U = 2142 * MiB, WS_UC = 2206 * MiB, WS_AA = 2270 * MiB, WS_BB = 2398 * MiB, WS_CA = 2526 * MiB, WS_CH = 2528 * MiB;
constexpr size_t WS_H = 2530 * MiB, WS_YS = 2802 * MiB, WS_LIST = 3074 * MiB, WS_SLOT = 3078 * MiB, WS_GATE = 3079 * MiB, WS_SW = 3080 * MiB  , WS_X1Q = 3088 * MiB  , WS_END = 3120 * MiB;
constexpr int PADROWS = T * TOPK + NE * 256;
static_assert((size_t)PADROWS * DFF * 2 <= 272 * MiB, "H / YS size");
constexpr int CW_SA = 128;
constexpr int CW_CNT = 256;
constexpr int CW_BAR = 4096;

constexpr int RING_BYTES = 139264;
constexpr int TILE_E_OFF = 131072;
constexpr int SCL_OFF = RING_BYTES;
constexpr int MISC_OFF = SCL_OFF + 16384;
constexpr int LDS_BYTES = 163840;

#define GAS __attribute__((address_space(1)))
#define LAS __attribute__((address_space(3)))
#define CAS __attribute__((address_space(4)))
typedef unsigned short bf16_t;
typedef short bf16x8 __attribute__((ext_vector_type(8)));
typedef short s16x4 __attribute__((ext_vector_type(4)));
typedef float f32x2 __attribute__((ext_vector_type(2)));
typedef float f32x4 __attribute__((ext_vector_type(4)));
typedef float f32x16 __attribute__((ext_vector_type(16)));
typedef unsigned u32x2 __attribute__((ext_vector_type(2)));
typedef unsigned u32x4 __attribute__((ext_vector_type(4)));

__device__ __forceinline__ unsigned cvt_pk_bf16(float lo, float hi) { unsigned r; asm volatile("v_cvt_pk_bf16_f32 %0, %1, %2" : "=v"(r) : "v"(lo), "v"(hi)); return r; }
__device__ __forceinline__ float bf_lo(unsigned w) { return __uint_as_float(w << 16); }
__device__ __forceinline__ float bf_hi(unsigned w) { return __uint_as_float(w & 0xffff0000u); }
__device__ __forceinline__ float sigmoidf_(float x) { return __builtin_amdgcn_rcpf(1.0f + __expf(-x)); }
__device__ __forceinline__ float gelu_tanh(float x) { const float u = 0.7978845608028654f * (x + 0.044715f * x * x * x); const float t = 1.0f - 2.0f * __builtin_amdgcn_rcpf(1.0f + __expf(2.0f * u)); return 0.5f * x * (1.0f + t); }
__device__ __forceinline__ u32x4 pack8(const f32x4 a, const f32x4 b) { u32x4 w; w.x = cvt_pk_bf16(a[0], a[1]); w.y = cvt_pk_bf16(a[2], a[3]); w.z = cvt_pk_bf16(b[0], b[1]); w.w = cvt_pk_bf16(b[2], b[3]); return w; }
__device__ __forceinline__ int opaque_tid() { int t = threadIdx.x; asm volatile("" : "+v"(t)); return t; }
__device__ __forceinline__ float wave_sum(float v) {
#pragma unroll
    for (int o = 1; o < 64; o <<= 1) v += __shfl_xor(v, o);
    return v;
}

namespace pg8 {
#define PG8_LAS __attribute__((address_space(3)))
constexpr int BM = 256, BK = 64, HALF = 128, HTB = HALF * BK * 2, STAGE_BYTES = 8 * HTB;
__host__ __device__ __forceinline__ int lds_byte(int r, int c) { const int st = (r >> 4) * 2 + (c >> 5), rr = r & 15, cc = c & 31, ob = rr * 64 + cc * 2; return st * 1024 + (ob ^ (((ob >> 9) & 1) << 5)); }
__host__ __device__ __forceinline__ void stage_rc(int b, int& R, int& C) { const int st = b / 1024, sb = b % 1024, swz = sb ^ (((sb >> 9) & 1) << 5); R = (st >> 1) * 16 + swz / 64; C = (st & 1) * 32 + (swz % 64) / 2; }
__host__ __device__ __forceinline__ int perm32(int rho) { const int n = rho >> 4, i = rho & 15; return 8 * (i >> 2) + 4 * n + (i & 3); }

struct Unit { const char* A; const char* B; const char* S; const int* lst; int nvalid; int pm, pn, aux; };

typedef int v4i_t __attribute__((ext_vector_type(4)));
typedef int v8i_t __attribute__((ext_vector_type(8)));
template <class Epi, class Sched, bool GATHER, bool FP8 = false>
__device__ __forceinline__ void gemm_phase(PG8_LAS unsigned char* lds, const int nt  , const int lda  , const int ldb  , const Sched& S, const Epi& E, unsigned long long* pw = nullptr, const int sa = 0x7f7f7f7f) {
    const int tid = opaque_tid(), wid = __builtin_amdgcn_readfirstlane(tid >> 6), lane = tid & 63, wr = wid >> 2, wc = wid & 3, fr = lane & 15, fq = lane >> 4;
    unsigned voffB[2], ocA[2][2], onA[2][2]; int gR[2], gC2[2];
#pragma unroll
    for (int i = 0; i < 2; ++i) { int R, C; stage_rc(tid * 16 + i * 8192, R, C); const int Rb = Epi::PERM ? ((R & ~31) + perm32(R & 31)) : R;
        voffB[i] = (unsigned)(Rb * ldb + C * 2); gR[i] = R; gC2[i] = C * 2;
        ocA[0][i] = (unsigned)(R * lda + C * 2); ocA[1][i] = (unsigned)((R + HALF) * lda + C * 2); onA[0][i] = ocA[0][i]; onA[1][i] = ocA[1][i]; }
    constexpr unsigned kstep = BK * 2;
    const unsigned hstepB = (unsigned)HALF * ldb;
    const unsigned ldsw = (unsigned)wid * 1024u;
    const int aoff = lds_byte(wr * 64 + fr, fq * 8), boff = lds_byte(wc * 32 + fr, fq * 8);
#define PG8_SA(b, h) (((b) * 2 + (h)) * HTB)
#define PG8_SB(b, h) ((4 + (b) * 2 + (h)) * HTB)
#define PG8_STAGE(bufoff, gbase, voff, kb) do { _Pragma("unroll") for (int _i = 0; _i < 2; ++_i) \
        __builtin_amdgcn_global_load_lds((const unsigned*)((const char*)(gbase) + (size_t)(unsigned)((voff)[_i] + (unsigned)(kb))), (PG8_LAS unsigned*)(lds + (bufoff) + ldsw + _i * 8192), 16, 0, 0); } while (0)
#define PG8_CAT(x0, x1) __builtin_shufflevector(x0, x1, 0, 1, 2, 3, 4, 5, 6, 7)
#define PG8_LO(x) __builtin_bit_cast(bf16x8, __builtin_shufflevector(x, x, 0, 1, 2, 3))
#define PG8_HI(x) __builtin_bit_cast(bf16x8, __builtin_shufflevector(x, x, 4, 5, 6, 7))
#define PG8_LDA(dst, b, h) do { _Pragma("unroll") for (int m = 0; m < 4; ++m) dst[m] = PG8_CAT(*(const PG8_LAS v4i_t*)(lds + PG8_SA(b, h) + aoff + m * 2048), *(const PG8_LAS v4i_t*)(lds + PG8_SA(b, h) + aoff + m * 2048 + 1024)); } while (0)
#define PG8_LDB(dst, b, h) do { _Pragma("unroll") for (int n = 0; n < 2; ++n) dst[n] = PG8_CAT(*(const PG8_LAS v4i_t*)(lds + PG8_SB(b, h) + boff + n * 2048), *(const PG8_LAS v4i_t*)(lds + PG8_SB(b, h) + boff + n * 2048 + 1024)); } while (0)
#define PG8_MMA(ai, bj, At, Bt) do { __builtin_amdgcn_s_setprio(1); \
        if constexpr (FP8) { asm volatile("s_nop 4" ::: "memory"); _Pragma("unroll") for (int m = 0; m < 4; ++m) _Pragma("unroll") for (int n = 0; n < 2; ++n) \
            asm volatile("v_mfma_scale_f32_16x16x128_f8f6f4 %0, %1, %2, %0, %3, %4 op_sel_hi:[0,0,0]" : "+v"(acc[ai][bj][m][n]) : "v"(Bt[n]), "v"(At[m]), "v"(sB[bj][n]), "v"(sav)); } \
        else { _Pragma("unroll") for (int m = 0; m < 4; ++m) _Pragma("unroll") for (int n = 0; n < 2; ++n) { \
            acc[ai][bj][m][n] = __builtin_amdgcn_mfma_f32_16x16x32_bf16(PG8_LO(Bt[n]), PG8_LO(At[m]), acc[ai][bj][m][n], 0, 0, 0); \
            acc[ai][bj][m][n] = __builtin_amdgcn_mfma_f32_16x16x32_bf16(PG8_HI(Bt[n]), PG8_HI(At[m]), acc[ai][bj][m][n], 0, 0, 0); } } \
        __builtin_amdgcn_s_setprio(0); } while (0)
    int sB[2][2] = {{0x7f, 0x7f}, {0x7f, 0x7f}}; int sav; asm volatile("v_mov_b32 %0, %1" : "=v"(sav) : "s"(sa));
    const int sbase = SCL_OFF + ((wc * 32 + (Epi::PERM ? 8 * (fr >> 2) + (fr & 3) : fr)) << 2) + fq;
#define PG8_LDS_SCL(par_, kt_) do { if constexpr (FP8) { const PG8_LAS unsigned char* sp_ = (const PG8_LAS unsigned char*)lds + sbase + (par_) * 8192 + (kt_) * 1024; \
        _Pragma("unroll") for (int bj_ = 0; bj_ < 2; ++bj_) _Pragma("unroll") for (int n_ = 0; n_ < 2; ++n_) sB[bj_][n_] = (int)sp_[bj_ * 512 + n_ * (Epi::PERM ? 16 : 64)]; } } while (0)
#define PG8_DMA_SCL(u_, par_) do { if constexpr (FP8) __builtin_amdgcn_global_load_lds((const unsigned*)((u_).S + wid * 1024 + lane * 16), (PG8_LAS unsigned*)(lds + SCL_OFF + (par_) * 8192 + wid * 1024), 16, 0, 0); } while (0)
#define PG8_WAIT_V(n) asm volatile("s_waitcnt vmcnt(" #n ")" ::: "memory")
#define PG8_WAIT_L(n) asm volatile("s_waitcnt lgkmcnt(" #n ")" ::: "memory")
#define PG8_BAR __builtin_amdgcn_s_barrier()
#define PG8_SCHED __builtin_amdgcn_sched_barrier(0)
#define PG8_GOFFS(u, o) do { _Pragma("unroll") for (int _h = 0; _h < 2; ++_h) _Pragma("unroll") for (int _i = 0; _i < 2; ++_i) { int _r = _h * HALF + gR[_i]; _r = _r < (u).nvalid ? _r : (u).nvalid - 1; \
        const int _tok = (u).lst[_r]; (o)[_h][_i] = (unsigned)_tok * (unsigned)lda + (unsigned)gC2[_i]; } } while (0)
#define PG8_GRAW(u, tk) do { _Pragma("unroll") for (int _h = 0; _h < 2; ++_h) _Pragma("unroll") for (int _i = 0; _i < 2; ++_i) { int _r = _h * HALF + gR[_i]; _r = _r < (u).nvalid ? _r : (u).nvalid - 1; (tk)[_h][_i] = (u).lst[_r]; } } while (0)
    Unit cur, nxt, nn; int ui = 0; int tokr[2][2] = {{0, 0}, {0, 0}};
#if PROBE_T
    unsigned long long pk_ = 0, pe_ = 0, pt0_ = 0, pn_ = 0; const unsigned long long pst_ = __builtin_amdgcn_s_memtime();
#endif
    if (!S.next(0, cur)) return;
    f32x4 acc[2][2][4][2];
#pragma unroll
    for (int a = 0; a < 2; ++a)
#pragma unroll
        for (int b = 0; b < 2; ++b)
#pragma unroll
            for (int m = 0; m < 4; ++m)
#pragma unroll
                for (int n = 0; n < 2; ++n) acc[a][b][m][n] = (f32x4){0.f, 0.f, 0.f, 0.f};
    v8i_t At[4], B0[2], B1[2];
    const char* cA = cur.A; const char* cB = cur.B;
    bool has_next = S.next(1, nxt);
    if constexpr (GATHER) { PG8_GOFFS(cur, ocA);
        if (has_next) { PG8_GOFFS(nxt, onA); }
        else {
#pragma unroll
            for (int h = 0; h < 2; ++h)
#pragma unroll
                for (int i = 0; i < 2; ++i) onA[h][i] = ocA[h][i]; } }
    PG8_DMA_SCL(cur, 0); if (has_next) PG8_DMA_SCL(nxt, 1);
    PG8_STAGE(PG8_SB(0, 0), cB, voffB, 0u); PG8_STAGE(PG8_SB(0, 1), cB, voffB, hstepB); PG8_STAGE(PG8_SA(0, 0), cA, ocA[0], 0u); PG8_STAGE(PG8_SA(0, 1), cA, ocA[1], 0u);
    if (wr == 1) PG8_BAR;
    PG8_WAIT_V(2); PG8_BAR;
    PG8_STAGE(PG8_SB(1, 0), cB, voffB, kstep); PG8_STAGE(PG8_SA(1, 0), cA, ocA[0], kstep); PG8_STAGE(PG8_SB(1, 1), cB, voffB, hstepB + kstep);
    PG8_WAIT_V(6); PG8_BAR;
    for (;;) {
        const char* nA = has_next ? nxt.A : cA; const char* nB = has_next ? nxt.B : cB;
#if PROBE_T
        pt0_ = __builtin_amdgcn_s_memtime();
#endif
#pragma unroll 1
        for (int t = 0; t < nt; t += 2) {
            const bool last = (t == nt - 2);
            const unsigned k1 = (unsigned)(t + 1) * kstep, k2 = last ? 0u : (unsigned)(t + 2) * kstep, k3 = k2 + kstep;
            const char* a2 = last ? nA : cA; const char* b2 = last ? nB : cB;
            unsigned o2[2][2];
#pragma unroll
            for (int h = 0; h < 2; ++h)
#pragma unroll
                for (int i = 0; i < 2; ++i) o2[h][i] = (GATHER && last) ? onA[h][i] : ocA[h][i];
            PG8_LDB(B0, 0, 0); PG8_LDB(B1, 0, 1); PG8_LDS_SCL(ui & 1, t); PG8_SCHED; PG8_LDA(At, 0, 0); PG8_STAGE(PG8_SA(1, 1), cA, ocA[1], k1);
            PG8_WAIT_V(8); PG8_WAIT_L(0); PG8_BAR; PG8_MMA(0, 0, At, B0); PG8_MMA(0, 1, At, B1); PG8_BAR; PG8_SCHED;
            PG8_LDA(At, 0, 1); PG8_STAGE(PG8_SB(0, 0), b2, voffB, k2); PG8_STAGE(PG8_SB(0, 1), b2, voffB, hstepB + k2); PG8_STAGE(PG8_SA(0, 0), a2, o2[0], k2);
            PG8_WAIT_V(8); PG8_WAIT_L(0); PG8_BAR; PG8_MMA(1, 0, At, B0); PG8_MMA(1, 1, At, B1); PG8_BAR; PG8_SCHED;
            PG8_LDB(B0, 1, 0); PG8_LDB(B1, 1, 1); PG8_LDS_SCL(ui & 1, t + 1); PG8_SCHED; PG8_LDA(At, 1, 0); PG8_STAGE(PG8_SA(0, 1), a2, o2[1], k2);
            PG8_WAIT_V(8); PG8_WAIT_L(0); PG8_BAR; PG8_MMA(0, 0, At, B0); PG8_MMA(0, 1, At, B1); PG8_BAR; PG8_SCHED;
            PG8_LDA(At, 1, 1); PG8_STAGE(PG8_SB(1, 0), b2, voffB, k3); PG8_STAGE(PG8_SB(1, 1), b2, voffB, hstepB + k3); PG8_STAGE(PG8_SA(1, 0), a2, o2[0], k3);
            PG8_WAIT_V(8); PG8_WAIT_L(0); PG8_BAR; PG8_MMA(1, 0, At, B0); PG8_MMA(1, 1, At, B1); PG8_BAR; PG8_SCHED;
        }
#if PROBE_T
        const unsigned long long pt1_ = __builtin_amdgcn_s_memtime(); pk_ += pt1_ - pt0_;
#endif
        if constexpr (FP8) asm volatile("s_nop 15\n\ts_nop 7" ::: "memory");
        const bool has_nn = has_next && S.next(ui + 2, nn);
        if constexpr (GATHER) { if (has_nn) { PG8_GRAW(nn, tokr); } }
        if (wr == 0) PG8_BAR;
        E(acc, cur, wr, wc, fr, fq);
#if PROBE_T
        asm volatile("s_waitcnt vmcnt(0)" ::: "memory"); pe_ += __builtin_amdgcn_s_memtime() - pt1_; ++pn_;
#endif
        if (!has_next) break;
#pragma unroll
        for (int a = 0; a < 2; ++a)
#pragma unroll
            for (int b = 0; b < 2; ++b)
#pragma unroll
                for (int m = 0; m < 4; ++m)
#pragma unroll
                    for (int n = 0; n < 2; ++n) acc[a][b][m][n] = (f32x4){0.f, 0.f, 0.f, 0.f};
        cur = nxt; cA = nA; cB = nB; ++ui;
        if constexpr (GATHER) {
#pragma unroll
            for (int h = 0; h < 2; ++h)
#pragma unroll
                for (int i = 0; i < 2; ++i) { ocA[h][i] = onA[h][i]; if (has_nn) onA[h][i] = (unsigned)tokr[h][i] * (unsigned)lda + (unsigned)gC2[i]; } }
        if (has_nn) { nxt = nn; PG8_DMA_SCL(nxt, (ui + 1) & 1); }
        has_next = has_nn;
        if (wr == 1) PG8_BAR;
    }
    PG8_WAIT_V(0);
    PG8_BAR;
#if PROBE_T
    if (pw && blockIdx.x == 0 && tid == 0) { pw[0] += pk_; pw[1] += pe_; pw[2] += pn_; pw[3] += __builtin_amdgcn_s_memtime() - pst_; }
#endif
#undef PG8_SA
#undef PG8_SB
#undef PG8_STAGE
#undef PG8_LDA
#undef PG8_LDB
#undef PG8_MMA
#undef PG8_WAIT_V
#undef PG8_WAIT_L
#undef PG8_BAR
#undef PG8_SCHED
#undef PG8_GOFFS
#undef PG8_GRAW
#undef PG8_CAT
#undef PG8_LO
#undef PG8_HI
#undef PG8_LDS_SCL
#undef PG8_DMA_SCL
}

constexpr int NXCD = 8, WGM = 8;
struct DenseSched {
    const char* A; const char* B; int lda, ldb; int nM, nN, nwg, G, c; int apn_shift, akbytes, bpm_shift; size_t bbatch;
    __device__ __forceinline__ void init(const void* A_, const void* B_, int lda_, int ldb_, int M, int N, int G_, int c_) {
        A = (const char*)A_; B = (const char*)B_; lda = lda_; ldb = ldb_; nM = M / BM; nN = N / BM; nwg = nM * nN; G = G_; c = c_; apn_shift = -1; akbytes = 0; bpm_shift = -1; bbatch = 0; }
    __device__ __forceinline__ bool next(int i, Unit& u) const {
        const long L = (long)i * G + c; if (L >= nwg) return false;
        int wgid = (int)L; { const int q = nwg / NXCD, r = nwg % NXCD, xcd = wgid % NXCD, off = wgid / NXCD; wgid = (xcd < r ? xcd * (q + 1) : r * (q + 1) + (xcd - r) * q) + off; }
        const int nig = WGM * nN, gid = wgid / nig, fm = gid * WGM, gsz = (nM - fm) < WGM ? (nM - fm) : WGM;
        const int pm = fm + ((wgid % nig) % gsz), pn = (wgid % nig) / gsz;
        u.pm = pm; u.pn = pn; u.aux = 0; u.lst = nullptr; u.nvalid = 256; u.S = nullptr;
        u.A = A + (size_t)pm * 256 * lda * 2 + (apn_shift >= 0 ? (size_t)(pn >> apn_shift) * akbytes : (size_t)0);
        u.B = B + (size_t)pn * 256 * ldb * 2 + (bpm_shift >= 0 ? (size_t)(pm >> bpm_shift) * bbatch : (size_t)0);
        return true;
    }
};
struct MoeSched {
    const char* A; const char* B; size_t bexp; const char* SW; int lda, ldb  , nN; const int* lists; volatile LAS const int* tab; volatile LAS const int* te; int G, c; bool gather;
    __device__ __forceinline__ bool next(int i, Unit& u) const {
        int pn, mg;
        if (G == 256) {
            const int x = c & 7, jj = c >> 3, pgs = nN >> 2, mgs = 8 / pgs;
            mg = i * (8 * mgs) + 8 * (x / pgs) + (jj & 7); pn = 4 * (x % pgs) + (jj >> 3);
            if (mg >= tab[32]) return false;
        } else { const int total = tab[32] * nN; const long L = (long)i * G + c; if (L >= total) return false; pn = (int)(L % nN); mg = (int)(L / nN); }
        const int e = te[mg], mt = mg - tab[e];
        u.pm = mg; u.pn = pn; u.aux = e;
        if (gather) { u.A = A; u.lst = lists + (size_t)e * T + mt * 256; const int rem = tab[48 + e] - mt * 256; u.nvalid = rem < 256 ? rem : 256; }
        else { u.A = A + (size_t)mg * 256 * lda; u.lst = nullptr; u.nvalid = 256; }
        u.B = B + (size_t)e * bexp + (size_t)pn * 256 * ldb; u.S = SW ? SW + ((size_t)e * 8 + pn) * 8192 : nullptr;
        return true;
    }
};

#define EPI_ROW(u, ai, m) ((u).pm * 256 + (ai) * 128 + wr * 64 + (m) * 16 + fr)
struct EpiLat {
    static constexpr bool PERM = true;
    bf16_t* LAT; float* SSQ; bf16_t* KR; const float* CS; const float* SN;
    __device__ __forceinline__ void operator()(const f32x4 (&acc)[2][2][4][2], const Unit& u, int wr, int wc, int fr, int fq) const {
        if (u.pn < 4) {
#pragma unroll
            for (int ai = 0; ai < 2; ++ai)
#pragma unroll
                for (int m = 0; m < 4; ++m) { const int row = EPI_ROW(u, ai, m); float ss = 0.f;
#pragma unroll
                    for (int bj = 0; bj < 2; ++bj) { const f32x4 v0 = acc[ai][bj][m][0], v1 = acc[ai][bj][m][1];
                        ss += (v0[0] * v0[0] + v0[1] * v0[1]) + (v0[2] * v0[2] + v0[3] * v0[3]) + (v1[0] * v1[0] + v1[1] * v1[1]) + (v1[2] * v1[2] + v1[3] * v1[3]);
                        *(u32x4*)(LAT + (size_t)row * 1024 + u.pn * 256 + bj * 128 + wc * 32 + 8 * fq) = pack8(v0, v1); }
                    ss += __shfl_xor(ss, 16); ss += __shfl_xor(ss, 32);
                    if (fq == 0) SSQ[(size_t)row * 16 + u.pn * 4 + wc] = ss; }
        } else if (wc == 0) {
#pragma unroll
            for (int ai = 0; ai < 2; ++ai)
#pragma unroll
                for (int m = 0; m < 4; ++m) { const int row = EPI_ROW(u, ai, m);
                    const f32x4 c0 = *(const f32x4*)(CS + (size_t)row * 32 + 8 * fq), c1 = *(const f32x4*)(CS + (size_t)row * 32 + 8 * fq + 4);
                    const f32x4 s0 = *(const f32x4*)(SN + (size_t)row * 32 + 8 * fq), s1 = *(const f32x4*)(SN + (size_t)row * 32 + 8 * fq + 4);
                    const f32x4 a0 = acc[ai][0][m][0], a1 = acc[ai][0][m][1], b0 = acc[ai][1][m][0], b1 = acc[ai][1][m][1];
                    *(u32x4*)(KR + (size_t)row * 64 + 8 * fq) = pack8(a0 * c0 - b0 * s0, a1 * c1 - b1 * s1);
                    *(u32x4*)(KR + (size_t)row * 64 + 32 + 8 * fq) = pack8(b0 * c0 + a0 * s0, b1 * c1 + a1 * s1); }
        }
    }
};
struct EpiQ {
    static constexpr bool PERM = true;
    bf16_t* Q; const float* SSQ; const float* CS; const float* SN;
    __device__ __forceinline__ void operator()(const f32x4 (&acc)[2][2][4][2], const Unit& u, int wr, int wc, int fr, int fq) const {
#pragma unroll
        for (int ai = 0; ai < 2; ++ai)
#pragma unroll
            for (int m = 0; m < 4; ++m) { const int row = EPI_ROW(u, ai, m);
                const f32x4 q0 = *(const f32x4*)(SSQ + (size_t)row * 16), q1 = *(const f32x4*)(SSQ + (size_t)row * 16 + 4), q2 = *(const f32x4*)(SSQ + (size_t)row * 16 + 8);
                const float ss = ((q0[0] + q0[1]) + (q0[2] + q0[3])) + ((q1[0] + q1[1]) + (q1[2] + q1[3])) + ((q2[0] + q2[1]) + (q2[2] + q2[3]));
                const float r = QSCALE / sqrtf(ss * (1.0f / QL) + RMS_EPS);
                if (u.pn < 4) {
#pragma unroll
                    for (int bj = 0; bj < 2; ++bj)
                        *(u32x4*)(Q + (size_t)row * 1536 + (2 * u.pn + bj) * 192 + wc * 32 + 8 * fq) = pack8(acc[ai][bj][m][0] * r, acc[ai][bj][m][1] * r);
                } else {
                    const int head = 4 * (u.pn - 4) + wc;
                    const f32x4 c0 = *(const f32x4*)(CS + (size_t)row * 32 + 8 * fq), c1 = *(const f32x4*)(CS + (size_t)row * 32 + 8 * fq + 4);
                    const f32x4 s0 = *(const f32x4*)(SN + (size_t)row * 32 + 8 * fq), s1 = *(const f32x4*)(SN + (size_t)row * 32 + 8 * fq + 4);
                    const f32x4 a0 = acc[ai][0][m][0] * r, a1 = acc[ai][0][m][1] * r, b0 = acc[ai][1][m][0] * r, b1 = acc[ai][1][m][1] * r;
                    *(u32x4*)(Q + (size_t)row * 1536 + head * 192 + 128 + 8 * fq) = pack8(a0 * c0 - b0 * s0, a1 * c1 - b1 * s1);
                    *(u32x4*)(Q + (size_t)row * 1536 + head * 192 + 160 + 8 * fq) = pack8(b0 * c0 + a0 * s0, b1 * c1 + a1 * s1);
                }
                asm volatile("" ::: "memory"); }
    }
};
struct EpiKV {
    static constexpr bool PERM = true;
    bf16_t* KN; bf16_t* V; const float* SSQ;
    __device__ __forceinline__ void operator()(const f32x4 (&acc)[2][2][4][2], const Unit& u, int wr, int wc, int fr, int fq) const {
#pragma unroll
        for (int ai = 0; ai < 2; ++ai)
#pragma unroll
            for (int m = 0; m < 4; ++m) { const int row = EPI_ROW(u, ai, m);
                const f32x4 q3 = *(const f32x4*)(SSQ + (size_t)row * 16 + 12);
                const float r = 1.0f / sqrtf(((q3[0] + q3[1]) + (q3[2] + q3[3])) * (1.0f / KVL) + RMS_EPS);
                *(u32x4*)(KN + (size_t)row * 1024 + u.pn * 128 + wc * 32 + 8 * fq) = pack8(acc[ai][0][m][0] * r, acc[ai][0][m][1] * r);
                *(u32x4*)(V + (size_t)row * 1024 + u.pn * 128 + wc * 32 + 8 * fq) = pack8(acc[ai][1][m][0] * r, acc[ai][1][m][1] * r); }
    }
};
__device__ __forceinline__ f32x4 bf4_lo(const u32x4 w) { return (f32x4){bf_lo(w.x), bf_hi(w.x), bf_lo(w.y), bf_hi(w.y)}; }
__device__ __forceinline__ f32x4 bf4_hi(const u32x4 w) { return (f32x4){bf_lo(w.z), bf_hi(w.z), bf_lo(w.w), bf_hi(w.w)}; }
struct EpiRes {
    static constexpr bool PERM = true;
    const bf16_t* X; bf16_t* Y;
    __device__ __forceinline__ void operator()(const f32x4 (&acc)[2][2][4][2], const Unit& u, int wr, int wc, int fr, int fq) const {
#pragma unroll
        for (int ai = 0; ai < 2; ++ai)
#pragma unroll
            for (int m = 0; m < 4; ++m) { const size_t off = (size_t)EPI_ROW(u, ai, m) * 1024 + u.pn * 256 + wc * 32 + 8 * fq;
#pragma unroll
                for (int bj = 0; bj < 2; ++bj) { const u32x4 xw = *(const u32x4*)(X + off + bj * 128);
                    *(u32x4*)(Y + off + bj * 128) = pack8(bf4_lo(xw) * ALPHA + acc[ai][bj][m][0], bf4_hi(xw) * ALPHA + acc[ai][bj][m][1]); }
                if (m & 1) asm volatile("" ::: "memory"); }
    }
};
struct EpiGU {
    static constexpr bool PERM = true;
    bf16_t* GG; bf16_t* U;
    __device__ __forceinline__ void operator()(const f32x4 (&acc)[2][2][4][2], const Unit& u, int wr, int wc, int fr, int fq) const {
#pragma unroll
        for (int ai = 0; ai < 2; ++ai)
#pragma unroll
            for (int m = 0; m < 4; ++m) { const int row = EPI_ROW(u, ai, m);
#pragma unroll
                for (int bj = 0; bj < 2; ++bj) { f32x4 v0 = acc[ai][bj][m][0], v1 = acc[ai][bj][m][1];
                    if (u.pn < 4) {
#pragma unroll
                        for (int e = 0; e < 4; ++e) { v0[e] = gelu_tanh(v0[e]); v1[e] = gelu_tanh(v1[e]); }
                        *(u32x4*)(GG + (size_t)row * 1024 + u.pn * 256 + bj * 128 + wc * 32 + 8 * fq) = pack8(v0, v1);
                    } else *(u32x4*)(U + (size_t)row * 1024 + (u.pn - 4) * 256 + bj * 128 + wc * 32 + 8 * fq) = pack8(v0, v1); } }
    }
};
struct EpiAB {
    static constexpr bool PERM = true;
    bf16_t* LA; bf16_t* BB; const bf16_t* UC; const float* BA; const float* BX; const float* SPL;
    __device__ __forceinline__ void operator()(const f32x4 (&acc)[2][2][4][2], const Unit& u, int wr, int wc, int fr, int fq) const {
        const int ch = (u.pn >> 1) * 256 + (u.pn & 1) * 128 + wc * 32 + 8 * fq;
        f32x4 ba[2], bx[2], sp[2];
#pragma unroll
        for (int n = 0; n < 2; ++n) { ba[n] = *(const f32x4*)(BA + ch + 4 * n); bx[n] = *(const f32x4*)(BX + ch + 4 * n); sp[n] = *(const f32x4*)(SPL + ch + 4 * n); }
#pragma unroll
        for (int ai = 0; ai < 2; ++ai)
#pragma unroll
            for (int m = 0; m < 4; ++m) { const size_t off = (size_t)EPI_ROW(u, ai, m) * 1024 + ch;
                const u32x4 uw = *(const u32x4*)(UC + off); f32x4 uv[2] = {bf4_lo(uw), bf4_hi(uw)}, lv[2], bv[2];
#pragma unroll
                for (int n = 0; n < 2; ++n)
#pragma unroll
                    for (int e = 0; e < 4; ++e) { const float r = sigmoidf_(acc[ai][0][m][n][e] + ba[n][e]), ig = sigmoidf_(acc[ai][1][m][n][e] + bx[n][e]);
                        const float la = sp[n][e] * r, x2 = 2.0f * la; lv[n][e] = la * 1.4426950408889634f;
                        const float om = x2 > -0.25f ? -x2 * (1.0f + x2 * (0.5f + x2 * (0.16666667f + x2 * (0.041666668f + x2 * 0.0083333338f)))) : 1.0f - __expf(x2);
                        bv[n][e] = sqrtf(om) * ig * uv[n][e]; }
                *(u32x4*)(LA + off) = pack8(lv[0], lv[1]); *(u32x4*)(BB + off) = pack8(bv[0], bv[1]); asm volatile("" ::: "memory"); }
    }
};
struct EpiUp {
    static constexpr bool PERM = true;
    bf16_t* H; const float* BU;
    __device__ __forceinline__ void operator()(const f32x4 (&acc)[2][2][4][2], const Unit& u, int wr, int wc, int fr, int fq) const {
        const int gc = u.pn * 128 + wc * 32 + 8 * fq; const float* bu = BU + (size_t)u.aux * 2048;
        const f32x4 bg0 = *(const f32x4*)(bu + gc), bg1 = *(const f32x4*)(bu + gc + 4), bp0 = *(const f32x4*)(bu + 1024 + gc), bp1 = *(const f32x4*)(bu + 1024 + gc + 4);
#pragma unroll
        for (int ai = 0; ai < 2; ++ai)
#pragma unroll
            for (int m = 0; m < 4; ++m) { const int row = EPI_ROW(u, ai, m);
                f32x4 y0, y1;
#pragma unroll
                for (int e = 0; e < 4; ++e) {
                    float g = fminf(acc[ai][0][m][0][e] + bg0[e], 7.0f), up = fminf(fmaxf(acc[ai][1][m][0][e] + bp0[e], -7.0f), 7.0f); y0[e] = (up + 1.0f) * (g * sigmoidf_(1.702f * g));
                    g = fminf(acc[ai][0][m][1][e] + bg1[e], 7.0f); up = fminf(fmaxf(acc[ai][1][m][1][e] + bp1[e], -7.0f), 7.0f); y1[e] = (up + 1.0f) * (g * sigmoidf_(1.702f * g)); }
                *(u32x4*)(H + (size_t)row * 1024 + gc) = pack8(y0, y1); }
    }
};
struct EpiDown {
    static constexpr bool PERM = true;
    bf16_t* YS; const float* BD;
    __device__ __forceinline__ void operator()(const f32x4 (&acc)[2][2][4][2], const Unit& u, int wr, int wc, int fr, int fq) const {
        const float* bd = BD + (size_t)u.aux * 1024;
#pragma unroll
        for (int bj = 0; bj < 2; ++bj) { const int col = u.pn * 256 + bj * 128 + wc * 32 + 8 * fq; const f32x4 b0 = *(const f32x4*)(bd + col), b1 = *(const f32x4*)(bd + col + 4);
#pragma unroll
            for (int ai = 0; ai < 2; ++ai)
#pragma unroll
                for (int m = 0; m < 4; ++m) *(u32x4*)(YS + (size_t)EPI_ROW(u, ai, m) * 1024 + col) = pack8(acc[ai][bj][m][0] + b0, acc[ai][bj][m][1] + b1); }
    }
};
struct EpiPle {
    static constexpr bool PERM = true;
    const bf16_t* X2; const bf16_t* PP; float* OUT; bf16_t* XB;
    __device__ __forceinline__ void operator()(const f32x4 (&acc)[2][2][4][2], const Unit& u, int wr, int wc, int fr, int fq) const {
#pragma unroll
        for (int ai = 0; ai < 2; ++ai)
#pragma unroll
            for (int m = 0; m < 4; ++m) { const size_t off = (size_t)EPI_ROW(u, ai, m) * 1024 + u.pn * 256 + wc * 32 + 8 * fq;
#pragma unroll
                for (int bj = 0; bj < 2; ++bj) { const size_t o = off + bj * 128; const u32x4 xw = *(const u32x4*)(X2 + o), pw = *(const u32x4*)(PP + o);
                    const f32x4 a0 = acc[ai][bj][m][0], a1 = acc[ai][bj][m][1], x0 = bf4_lo(xw), x1 = bf4_hi(xw), p0 = bf4_lo(pw), p1 = bf4_hi(pw); f32x4 r0, r1;
#pragma unroll
                    for (int e = 0; e < 4; ++e) { r0[e] = x0[e] + sigmoidf_(a0[e]) * p0[e]; r1[e] = x1[e] + sigmoidf_(a1[e]) * p1[e]; }
                    *(u32x4*)(XB + o) = pack8(r0, r1);
                    if (OUT) { *(f32x4*)(OUT + o) = r0; *(f32x4*)(OUT + o + 4) = r1; } }
                if (m & 1) asm volatile("" ::: "memory"); }
    }
};
struct EpiPP {
    static constexpr bool PERM = true;
    bf16_t* PP;
    __device__ __forceinline__ void operator()(const f32x4 (&acc)[2][2][4][2], const Unit& u, int wr, int wc, int fr, int fq) const {
#pragma unroll
        for (int ai = 0; ai < 2; ++ai)
#pragma unroll
            for (int m = 0; m < 4; ++m)
#pragma unroll
                for (int bj = 0; bj < 2; ++bj) *(u32x4*)(PP + (size_t)EPI_ROW(u, ai, m) * 1024 + u.pn * 256 + bj * 128 + wc * 32 + 8 * fq) = pack8(acc[ai][bj][m][0], acc[ai][bj][m][1]);
    }
};
}

namespace att {
constexpr int NW = 8, QBLK = 32, KVBLK = 64, QB = 256, KPITCH = 384;
constexpr int SHM_V = KVBLK * DV * 2, SHM_K = KVBLK * KPITCH;
constexpr int NVB = 3;
constexpr int OFF_V = 0, OFF_K = NVB * SHM_V, OFF_WS = OFF_K + 2 * SHM_K, LDS_BYTES = OFF_WS + NW * 64 * 4;
#define SBAR() __builtin_amdgcn_sched_barrier(0)
__device__ __forceinline__ int k_addr(int row, int chunk) { return row * KPITCH + ((chunk ^ ((row >> 1) & 7)) << 4); }
__device__ __forceinline__ int v_st(int k, int c) { const int kk = (k & ~0xC) | ((k & 4) << 1) | ((k & 8) >> 1); return ((kk >> 3) * 4 + (c >> 5)) * 512 + ((kk & 7) * 32 + (c & 31)) * 2; }
__device__ __forceinline__ int v_rd_base(int lane) { return ((lane & 3) << 3) | (((lane >> 2) & 3) << 6) | (((lane >> 4) & 1) << 5) | (((lane >> 5) & 1) << 8); }
constexpr int v_rd_off(int d0, int ks, int half) { return d0 * 512 + ks * 4096 + half * 2048; }
__device__ __forceinline__ int crow(int r, int hi) { return (r & 3) + 8 * (r >> 2) + 4 * hi; }

template <int KB>
__device__ __forceinline__ void qkt(f32x16& p0, f32x16& p1, const LAS char* K_lds, int r32, int hi, const bf16x8* qr) {
    p0 = f32x16{}; p1 = f32x16{};
    const LAS char* kb[4];
#pragma unroll
    for (int dd = 0; dd < 4; ++dd) kb[dd] = K_lds + KB * SHM_K + r32 * KPITCH + (((2 * dd + hi) ^ ((r32 >> 1) & 7)) << 4);
    bf16x8 f[2][4];
#define QK_LD(g, buf) do { _Pragma("unroll") for (int e_ = 0; e_ < 2; ++e_) { const int d0_ = 2 * (g) + e_; const LAS char* a_ = kb[d0_ & 3] + (d0_ >> 2) * 128; \
        f[buf][2 * e_] = *(const LAS bf16x8*)a_; f[buf][2 * e_ + 1] = *(const LAS bf16x8*)(a_ + 32 * KPITCH); } } while (0)
    QK_LD(0, 0);
#pragma unroll
    for (int g = 0; g < 6; ++g) {
        if (g < 5) QK_LD(g + 1, (g + 1) & 1);
        SBAR();
#pragma unroll
        for (int e = 0; e < 2; ++e) { const int d0 = 2 * g + e;
            p0 = __builtin_amdgcn_mfma_f32_32x32x16_bf16(f[g & 1][2 * e], qr[d0], p0, 0, 0, 0);
            p1 = __builtin_amdgcn_mfma_f32_32x32x16_bf16(f[g & 1][2 * e + 1], qr[d0], p1, 0, 0, 0); }
        SBAR(); }
#undef QK_LD
}
__device__ __forceinline__ void pv_tile(f32x16* o, int vb0  , bf16x8 pa0, bf16x8 pa1, bf16x8 pa2, bf16x8 pa3) {
#define TRRD(dst, off) asm volatile("ds_read_b64_tr_b16 %0, %1 offset:%2" : "=&v"(dst) : "v"(vb0), "i"(off) : "memory")
#define PV_D0(d0) do { s16x4 l0, l1, l2, l3, h0, h1, h2, h3; constexpr int b_ = v_rd_off(d0, 0, 0); \
        TRRD(l0, b_); TRRD(h0, b_ + 2048); TRRD(l1, b_ + 4096); TRRD(h1, b_ + 6144); TRRD(l2, b_ + 8192); TRRD(h2, b_ + 10240); TRRD(l3, b_ + 12288); TRRD(h3, b_ + 14336); \
        asm volatile("s_waitcnt lgkmcnt(0)" ::: "memory"); SBAR(); \
        o[d0] = __builtin_amdgcn_mfma_f32_32x32x16_bf16(pa0, (bf16x8){l0[0], l0[1], l0[2], l0[3], h0[0], h0[1], h0[2], h0[3]}, o[d0], 0, 0, 0); \
        o[d0] = __builtin_amdgcn_mfma_f32_32x32x16_bf16(pa1, (bf16x8){l1[0], l1[1], l1[2], l1[3], h1[0], h1[1], h1[2], h1[3]}, o[d0], 0, 0, 0); \
        o[d0] = __builtin_amdgcn_mfma_f32_32x32x16_bf16(pa2, (bf16x8){l2[0], l2[1], l2[2], l2[3], h2[0], h2[1], h2[2], h2[3]}, o[d0], 0, 0, 0); \
        o[d0] = __builtin_amdgcn_mfma_f32_32x32x16_bf16(pa3, (bf16x8){l3[0], l3[1], l3[2], l3[3], h3[0], h3[1], h3[2], h3[3]}, o[d0], 0, 0, 0); } while (0)
    PV_D0(0); PV_D0(1); PV_D0(2); PV_D0(3);
#undef PV_D0
#undef TRRD
}
__device__ __forceinline__ void mask_tile(f32x16& p0, f32x16& p1, int dq  ) {
    const float NEG = -__builtin_inff();
#pragma unroll
    for (int r = 0; r < 16; ++r) { const int c = (r & 3) + 8 * (r >> 2);
        if (c > dq) p0[r] = NEG;
        if (c + 32 > dq) p1[r] = NEG; }
}
__device__ __forceinline__ void softmax_tile(f32x16& p0, f32x16& p1, float& m_reg, float& l_reg, float& alpha, bf16x8& pa0, bf16x8& pa1, bf16x8& pa2, bf16x8& pa3) {
    float pmax = p0[0];
#pragma unroll
    for (int r = 1; r < 16; ++r) pmax = fmaxf(pmax, p0[r]);
#pragma unroll
    for (int r = 0; r < 16; ++r) pmax = fmaxf(pmax, p1[r]);
    { auto rr = __builtin_amdgcn_permlane32_swap(__float_as_uint(pmax), __float_as_uint(pmax), false, false); pmax = fmaxf(__uint_as_float(rr[0]), __uint_as_float(rr[1])); }
    float mn = m_reg; alpha = 1.f;
    if (!__all(pmax - m_reg <= 8.0f)) { mn = fmaxf(m_reg, pmax); alpha = __builtin_amdgcn_exp2f(m_reg - mn); m_reg = mn; }
    float ps = 0.f;
#pragma unroll
    for (int r = 0; r < 16; ++r) { p0[r] = __builtin_amdgcn_exp2f(p0[r] - mn); ps += p0[r]; }
#pragma unroll
    for (int r = 0; r < 16; ++r) { p1[r] = __builtin_amdgcn_exp2f(p1[r] - mn); ps += p1[r]; }
    { auto rr = __builtin_amdgcn_permlane32_swap(__float_as_uint(ps), __float_as_uint(ps), false, false); ps = __uint_as_float(rr[0]) + __uint_as_float(rr[1]); }
    l_reg = l_reg * alpha + ps;
#define PK4(P, B_, OUT) do { unsigned a0 = cvt_pk_bf16(P[B_+0], P[B_+1]), a1 = cvt_pk_bf16(P[B_+2], P[B_+3]); \
        unsigned b0 = cvt_pk_bf16(P[B_+4], P[B_+5]), b1 = cvt_pk_bf16(P[B_+6], P[B_+7]); \
        auto r0 = __builtin_amdgcn_permlane32_swap(a0, b0, false, false); auto r1 = __builtin_amdgcn_permlane32_swap(a1, b1, false, false); \
        u32x4 w = {r0[0], r1[0], r0[1], r1[1]}; OUT = __builtin_bit_cast(bf16x8, w); } while (0)
    PK4(p0, 0, pa0); PK4(p0, 8, pa1); PK4(p1, 0, pa2); PK4(p1, 8, pa3);
#undef PK4
}

__device__ __forceinline__ void attn_block(int b, int h, int qb, const bf16_t* Q, const bf16_t* KN, const bf16_t* KR, const bf16_t* V, bf16_t* O, LAS char* lds, unsigned long long* pw = nullptr) {
    const int tid = opaque_tid(), wid = __builtin_amdgcn_readfirstlane(tid >> 6), lane = tid & 63, r32 = lane & 31, hi = lane >> 5;
    const size_t row0 = (size_t)b * SEQ;
    const int q0 = qb * QB + wid * QBLK;
    const int NT = (qb + 1) * (QB / KVBLK);
    LAS char* V_lds = lds + OFF_V; LAS char* K_lds = lds + OFF_K;
    LAS float* ws = (LAS float*)(lds + OFF_WS) + wid * 64; LAS float* li_l = ws; LAS float* al_l = ws + 32;
    const int sr = tid >> 4, sc = (tid & 15) * 8, kr_row = tid >> 3, kr_c = tid & 7;
    const int vst0 = v_st(sr, sc), vst1 = v_st(32 + sr, sc), kws = k_addr(sr, tid & 15), kwr = k_addr(kr_row, 16 + kr_c);
    const int vb0 = (int)(uintptr_t)lds + v_rd_base(lane);
    const bf16_t* KNh = KN + row0 * 1024 + h * 128 + sc; const bf16_t* Vh = V + row0 * 1024 + h * 128 + sc; const bf16_t* KRb = KR + row0 * 64 + kr_c * 8;
    bf16x8 st_k0, st_k1, st_kr, st_v0, st_v1;
#define SLOAD(t) do { const size_t k0_ = (size_t)(t) * KVBLK; \
        st_k0 = *(const bf16x8*)(KNh + (k0_ + sr) * 1024); st_k1 = *(const bf16x8*)(KNh + (k0_ + 32 + sr) * 1024); st_kr = *(const bf16x8*)(KRb + (k0_ + kr_row) * 64); \
        st_v0 = *(const bf16x8*)(Vh + (k0_ + sr) * 1024); st_v1 = *(const bf16x8*)(Vh + (k0_ + 32 + sr) * 1024); } while (0)
#define SWRITE(bf, vo) do { *(LAS bf16x8*)(K_lds + (bf) * SHM_K + kws) = st_k0; *(LAS bf16x8*)(K_lds + (bf) * SHM_K + kws + 32 * KPITCH) = st_k1; *(LAS bf16x8*)(K_lds + (bf) * SHM_K + kwr) = st_kr; \
        *(LAS bf16x8*)(V_lds + (vo) + vst0) = st_v0; *(LAS bf16x8*)(V_lds + (vo) + vst1) = st_v1; } while (0)
    SLOAD(0);
    bf16x8 qr[12];
    { const bf16_t* Qw = Q + (row0 + q0 + r32) * 1536 + h * 192 + hi * 8;
#pragma unroll
      for (int d0 = 0; d0 < 12; ++d0) qr[d0] = *(const bf16x8*)(Qw + d0 * 16); }
    float m_reg = -1e30f, l_reg = 0.f; f32x16 o[4] = {};
    f32x16 p0, p1; bf16x8 pa0, pa1, pa2, pa3; float alpha;
    asm volatile("s_waitcnt vmcnt(0)" ::: "memory");
    SWRITE(0, 0);
    __syncthreads();
    const bool odd = wid >= 4; int vo_prev = 0, vo_cur = 0, vo_next = SHM_V;
#define RESC(a) do { if (__any((a) < 1.f)) { if (hi == 0) al_l[r32] = (a); asm volatile("s_waitcnt lgkmcnt(0)" ::: "memory"); \
        _Pragma("unroll") for (int d_ = 0; d_ < 4; ++d_) _Pragma("unroll") for (int r = 0; r < 16; ++r) o[d_][r] *= al_l[crow(r, hi)]; } } while (0)
#if PROBE_T
    unsigned long long pa_ = 0, pb_ = 0, pc_ = 0, pd_ = 0, pe2_ = 0; const unsigned long long pst_ = __builtin_amdgcn_s_memtime();
#define PSTAMP(v) const unsigned long long v = __builtin_amdgcn_s_memtime()
#define PACC(acc, a, b) acc += (b) - (a)
#else
#define PSTAMP(v) do {} while (0)
#define PACC(acc, a, b) do {} while (0)
#endif
#define TILE(t, BF) do { PSTAMP(s0_); const bool more_ = ((t) + 1 < NT); if (more_) SLOAD((t) + 1); SBAR(); \
        if (odd && (t) > 0) { pv_tile(o, vb0 + vo_prev, pa0, pa1, pa2, pa3); SBAR(); } \
        PSTAMP(s1_); qkt<BF>(p0, p1, K_lds, r32, hi, qr); \
        { const int kb_ = (t) * KVBLK; if (kb_ + KVBLK - 1 > q0) mask_tile(p0, p1, q0 + r32 - kb_ - 4 * hi); } \
        asm volatile("" : "+v"(p0), "+v"(p1)); PSTAMP(s2_); \
        softmax_tile(p0, p1, m_reg, l_reg, alpha, pa0, pa1, pa2, pa3); RESC(alpha); SBAR(); PSTAMP(s3_); \
        if (!odd) pv_tile(o, vb0 + vo_cur, pa0, pa1, pa2, pa3); \
        PSTAMP(s4_); if (more_) { asm volatile("s_waitcnt vmcnt(0)" ::: "memory"); SWRITE((BF) ^ 1, vo_next); } \
        PSTAMP(s5_); __syncthreads(); PSTAMP(s6_); PACC(pa_, s1_, s2_); PACC(pb_, s2_, s3_); PACC(pc_, s3_, s4_); PACC(pd_, s4_, s5_); PACC(pe2_, s5_, s6_); vo_prev = vo_cur; vo_cur = vo_next; vo_next = (vo_next == (NVB - 1) * SHM_V) ? 0 : vo_next + SHM_V; } while (0)
#pragma unroll 1
    for (int t = 0; t < NT; t += 2) { TILE(t, 0); TILE(t + 1, 1); }
    if (odd) pv_tile(o, vb0 + vo_prev, pa0, pa1, pa2, pa3);
#if PROBE_T
    if (pw && blockIdx.x == 0 && tid == 0) { pw[8] += pa_; pw[9] += pb_; pw[10] += pc_; pw[11] += pd_; pw[12] += pe2_; pw[13] += (unsigned long long)NT; pw[14] += __builtin_amdgcn_s_memtime() - pst_; }
#endif
    if (hi == 0) li_l[r32] = l_reg; asm volatile("s_waitcnt lgkmcnt(0)" ::: "memory");
    bf16_t* Ow = O + (row0 + q0) * 1024 + h * 128;
#pragma unroll
    for (int r = 0; r < 16; ++r) { const int orow = crow(r, hi); const float rl = __builtin_amdgcn_rcpf(li_l[orow]);
#pragma unroll
        for (int d0 = 0; d0 < 4; ++d0) { const float v = o[d0][r] * rl; const float vn = __shfl_xor(v, 1);
            if ((r32 & 1) == 0) *(unsigned*)(Ow + (size_t)orow * 1024 + d0 * 32 + r32) = cvt_pk_bf16(v, vn); } }
    __syncthreads();
#undef SLOAD
#undef SWRITE
#undef RESC
#undef TILE
#undef PSTAMP
#undef PACC
}
#undef SBAR
}

#define XB_TMO      128
#define XB_XCNT(j)  (256  + 64 * (j))
#define XB_XSUB(j)  (1280 + 64 * (j))
#define XB_XGEN(j)  (2304 + 64 * (j))
#define XB_TOP      3328
#define XB_TOPGEN   3392
#define XCD_BAR_WORDS 3456
#define XB_SPIN_CAP (1u << 22)
__device__ __forceinline__ unsigned xb_ld(unsigned* p)              { return __hip_atomic_load(p, __ATOMIC_RELAXED, __HIP_MEMORY_SCOPE_AGENT); }
__device__ __forceinline__ unsigned xb_add(unsigned* p, unsigned v) { return __hip_atomic_fetch_add(p, v, __ATOMIC_RELAXED, __HIP_MEMORY_SCOPE_AGENT); }
__device__ __forceinline__ unsigned xb_xcc_id() { return (unsigned)__builtin_amdgcn_s_getreg((3 << 11) | 20) & 0xFu; }
#define XB_SPIN(cond, bar) do { unsigned _sp = 0; while (cond) { __builtin_amdgcn_s_sleep(1); \
    if ((++_sp & 255u) == 0u) { if (xb_ld(&(bar)[XB_TMO])) break; if (_sp > XB_SPIN_CAP) { atomicAdd(&(bar)[XB_TMO], 1u); break; } } } } while (0)
struct XcdBarrier { unsigned* bar; unsigned x; volatile LAS unsigned* st; };
__device__ __forceinline__ XcdBarrier xcd_barrier_post(unsigned* bar, volatile LAS unsigned* st) {
    XcdBarrier b; b.bar = bar; b.x = xb_xcc_id(); b.st = st;
    if (threadIdx.x == 0) (void)xb_add(&bar[XB_XCNT(b.x)], 1u);
    return b;
}
__device__ __forceinline__ void xcd_barrier_complete(unsigned* bar, unsigned x, unsigned& nloc, unsigned& nx) {
    const unsigned G = gridDim.x * gridDim.y * gridDim.z;
    unsigned sum, cnt, mine, sp = 0u;
    for (;;) {
        sum = 0u; cnt = 0u; mine = 0u;
#pragma unroll
        for (unsigned j = 0; j < 16; ++j) { const unsigned c = xb_ld(&bar[XB_XCNT(j)]); sum += c; cnt += (c > 0u) ? 1u : 0u; mine = (j == x) ? c : mine; }
        if (sum == G) break;
        __builtin_amdgcn_s_sleep(1);
        if ((++sp & 255u) == 0u) { if (xb_ld(&bar[XB_TMO])) break; if (sp > XB_SPIN_CAP) { atomicAdd(&bar[XB_TMO], 1u); break; } }
    }
    nloc = mine > 0u ? mine : 1u; nx = cnt > 0u ? cnt : 1u;
}
__device__ __forceinline__ void xcd_barrier(const XcdBarrier& b) {
    asm volatile("s_waitcnt vmcnt(0)" ::: "memory");
    __syncthreads();
    if (opaque_tid() == 0) {
        unsigned* bar = b.bar; unsigned bx = b.x;
        asm volatile("" : "+s"(bar), "+s"(bx));
        __builtin_amdgcn_s_waitcnt(0);
        unsigned nloc = b.st[0], nx = b.st[1];
        if (nloc == 0u) { xcd_barrier_complete(bar, bx, nloc, nx); b.st[0] = nloc; b.st[1] = nx; }
        const unsigned old = xb_add(&bar[XB_XSUB(bx)], 1u);
        const unsigned gen = old / nloc;
        if (old + 1u == (gen + 1u) * nloc) {
            __builtin_amdgcn_fence(__ATOMIC_RELEASE, "agent");
            asm volatile("s_waitcnt vmcnt(0)" ::: "memory");
            const unsigned og = xb_add(&bar[XB_TOP], 1u);
            const unsigned tg = og / nx;
            if (og + 1u == (tg + 1u) * nx) xb_add(&bar[XB_TOPGEN], 1u);
            else XB_SPIN(xb_ld(&bar[XB_TOPGEN]) == tg, bar);
            __builtin_amdgcn_fence(__ATOMIC_ACQUIRE, "agent");
            xb_add(&bar[XB_XGEN(bx)], 1u);
            asm volatile("s_waitcnt vmcnt(0)" ::: "memory");
        } else {
            XB_SPIN(xb_ld(&bar[XB_XGEN(bx)]) == gen, bar);
            __builtin_amdgcn_fence(__ATOMIC_ACQUIRE, "agent");
            asm volatile("s_waitcnt vmcnt(0)" ::: "memory");
        }
    }
    __syncthreads();
}

struct Args { const void* in[30]; float* out; unsigned char* ws; int ph_lo, ph_hi, li, pad; };
struct Ctx { int tid, lane, wave, vcu, G, bid; LAS unsigned char* lds; volatile LAS int* misc; };
__device__ __forceinline__ Ctx fresh_ctx(const Ctx& c) {
    Ctx r = c; unsigned l = (unsigned)(uintptr_t)c.lds, m = (unsigned)(uintptr_t)c.misc;
    asm volatile("" : "+s"(r.wave), "+s"(r.vcu), "+s"(r.G), "+s"(r.bid), "+s"(l), "+s"(m));
    r.lds = (LAS unsigned char*)(uintptr_t)l; r.misc = (volatile LAS int*)(uintptr_t)m; r.tid = opaque_tid(); r.lane = r.tid & 63; return r; }
typedef const CAS Args* ArgsP;
__device__ __forceinline__ const CAS Args& fresh_args(ArgsP p) { asm volatile("" : "+s"(p)); return *p; }
enum { I_X = 0, I_P, I_POS, I_MLA_WIN, I_MLA_QN, I_MLA_KVN, I_MLA_WUQ, I_MLA_WUKV, I_MLA_WO, I_LRU_WIN, I_LRU_CW, I_LRU_CB, I_LRU_WA, I_LRU_BA, I_LRU_WX, I_LRU_BX, I_LRU_LAM, I_LRU_WOUT,
       I_LN1G, I_LN1B, I_LN2G, I_LN2B, I_MOE_WR, I_MOE_BR, I_MOE_WUP, I_MOE_BUP, I_MOE_WDN, I_MOE_BDN, I_PLE_WG, I_PLE_WP };
#define INF(i) ((const float*)args.in[i])
#define WSP(T_, off) ((T_*)(args.ws + (off)))

__device__ __forceinline__ void tr_load(const float* W, int ld, int k0, int sc0, int sc1, int lane, f32x4 (&v)[16]) {
    const int half = (lane & 15) >> 3, scol = half ? sc1 : sc0, c4 = (lane & 7) * 4, rs = lane >> 4;
#pragma unroll
    for (int i = 0; i < 8; ++i) { const float* p = W + (size_t)(k0 + 8 * i + 2 * rs) * ld + scol + c4;
        v[2 * i] = (scol >= 0) ? *(const f32x4*)p : (f32x4){0.f, 0.f, 0.f, 0.f}; v[2 * i + 1] = (scol >= 0) ? *(const f32x4*)(p + ld) : (f32x4){0.f, 0.f, 0.f, 0.f}; }
}
__device__ __forceinline__ void tr_store(f32x4 (&v)[16], const float* ksc, int k0, bf16_t* dst  , int K, LAS unsigned* scr, int lane) {
    const int rs = lane >> 4;
    if (ksc) {
#pragma unroll
        for (int i = 0; i < 8; ++i) { v[2 * i] = v[2 * i] * ksc[k0 + 8 * i + 2 * rs]; v[2 * i + 1] = v[2 * i + 1] * ksc[k0 + 8 * i + 2 * rs + 1]; } }
#pragma unroll
    for (int i = 0; i < 8; ++i) { LAS unsigned* s = scr + (4 * i + rs) * 65 + (lane & 15) * 4;
#pragma unroll
        for (int e = 0; e < 4; ++e) s[e] = cvt_pk_bf16(v[2 * i][e], v[2 * i + 1][e]); }
    asm volatile("s_waitcnt lgkmcnt(0)" ::: "memory");
    const int c = lane & 7;
#pragma unroll
    for (int j = 0; j < 8; ++j) { const int n = (lane >> 3) + 8 * j; const LAS unsigned* s = scr + (4 * c) * 65 + n;
        u32x4 o; o.x = s[0]; o.y = s[65]; o.z = s[130]; o.w = s[195];
        *(u32x4*)(dst + (size_t)n * K + 8 * c) = o; }
    asm volatile("s_waitcnt lgkmcnt(0)" ::: "memory");
}
enum { J_NAT = 0, J_MLA_WIN, J_MLA_WUQ, J_LRU_WAX, J_MOE_UP };
__device__ __forceinline__ int tr_map(int job, int g) {
    switch (job) {
    case J_MLA_WIN: return g < 32 ? 32 * g : (g == 32 ? 1024 : (g == 36 ? 1056 : -1));
    case J_MLA_WUQ: if (g < 32) { const int t = g >> 3, bj = (g >> 2) & 1, cg = g & 3; return (2 * t + bj) * 192 + 32 * cg; }
                    else { const int g2 = g - 32, t2 = g2 >> 3, bj = (g2 >> 2) & 1, hh = g2 & 3; return (4 * t2 + hh) * 192 + 128 + 32 * bj; }
    case J_LRU_WAX: { const int pn = g >> 3, cg = g & 3; return 128 * pn + 32 * cg; }
    case J_MOE_UP:  { const int pn = g >> 3, bj = (g >> 2) & 1, cg = g & 3; return bj * 1024 + 128 * pn + 32 * cg; }
    default: return 32 * g;
    }
}
__device__ __forceinline__ void tr_job(const Ctx& C, int job, const float* src, size_t srcstride, int nmat, int K, int ld, int N, bf16_t* dst, size_t dststride, const float* ksc, int kscstride,
                                       const float* src2  ) {
    LAS unsigned* scr = (LAS unsigned*)(C.lds + C.wave * 8320);
    const int gw = C.vcu * NWAVES + C.wave, NGW = C.G * NWAVES;
    const int nkb = K / 64, nnb = N / 64, per = nkb * nnb, total = per * nmat;
#define TR_DECODE(it_, W_, k0_, s0_, s1_, ks_, d_) do { const int mat_ = (it_) / per, r_ = (it_) - mat_ * per, kb_ = r_ / nnb, nb_ = r_ - kb_ * nnb; \
        s0_ = tr_map(job, 2 * nb_); s1_ = tr_map(job, 2 * nb_ + 1); W_ = src + (size_t)mat_ * srcstride; \
        if (job == J_LRU_WAX && ((nb_ >> 1) & 1)) W_ = src2 + (size_t)mat_ * srcstride;       \
        k0_ = kb_ * 64; ks_ = ksc ? ksc + (size_t)mat_ * kscstride : nullptr; d_ = (bf16_t*)((char*)dst + (size_t)mat_ * dststride) + (size_t)(nb_ * 64) * K + kb_ * 64; } while (0)
    f32x4 va[16], vb[16];
    int it = gw; const float* Wc; int k0c, s0c, s1c; const float* ksc_c; bf16_t* dc;
    if (it < total) { TR_DECODE(it, Wc, k0c, s0c, s1c, ksc_c, dc); tr_load(Wc, ld, k0c, s0c, s1c, C.lane, va); }
    while (it < total) {
        const int nit = it + NGW; const float* Wn = nullptr; int k0n = 0, s0n = 0, s1n = 0; const float* ksc_n = nullptr; bf16_t* dn = nullptr;
        if (nit < total) { TR_DECODE(nit, Wn, k0n, s0n, s1n, ksc_n, dn); tr_load(Wn, ld, k0n, s0n, s1n, C.lane, vb); }
        tr_store(va, ksc_c, k0c, dc, K, scr, C.lane);
#pragma unroll
        for (int i = 0; i < 16; ++i) va[i] = vb[i];
        it = nit; k0c = k0n; ksc_c = ksc_n; dc = dn;
    }
#undef TR_DECODE
}
__device__ __forceinline__ void tr_job_fp8(const Ctx& C, const float* src, size_t srcstride, int nmat, unsigned char* dst, size_t dststride, unsigned char* SW) {
    constexpr int K = 1024, N = 2048, ld = 2048;
    LAS float* scr = (LAS float*)(C.lds + C.wave * 16640);
    const int gw = C.vcu * NWAVES + C.wave, NGW = C.G * NWAVES, lane = C.lane;
    const int nkb = K / 64, nnb = N / 64, per = nkb * nnb, total = per * nmat;
    for (int it = gw; it < total; it += NGW) {
        const int mat = it / per, r = it - mat * per, kb = r / nnb, nb = r - kb * nnb;
        const int s0 = tr_map(J_MOE_UP, 2 * nb), s1 = tr_map(J_MOE_UP, 2 * nb + 1);
        f32x4 v[16];
        tr_load(src + (size_t)mat * srcstride, ld, kb * 64, s0, s1, lane, v);
        const int rs = lane >> 4;
#pragma unroll
        for (int i = 0; i < 8; ++i) { LAS float* sp = scr + (8 * i + 2 * rs) * 65 + (lane & 15) * 4;
#pragma unroll
            for (int e = 0; e < 4; ++e) { sp[e] = v[2 * i][e]; sp[65 + e] = v[2 * i + 1][e]; } }
        asm volatile("s_waitcnt lgkmcnt(0)" ::: "memory");
        const int c = lane & 7;
#pragma unroll
        for (int j = 0; j < 8; ++j) { const int n = (lane >> 3) + 8 * j; const LAS float* sp = scr + (8 * c) * 65 + n;
            float x[8]; float am = 0.f;
#pragma unroll
            for (int q = 0; q < 8; ++q) { x[q] = sp[q * 65]; am = fmaxf(am, fabsf(x[q])); }
            am = fmaxf(am, __shfl_xor(am, 1)); am = fmaxf(am, __shfl_xor(am, 2));
            int eb = (int)((__float_as_uint(am) >> 23) & 0xffu) - 7; eb = eb < 1 ? 1 : eb;
            const float inv = __uint_as_float((unsigned)(254 - eb) << 23);
            int w0 = __builtin_amdgcn_cvt_pk_fp8_f32(x[0] * inv, x[1] * inv, 0, false); w0 = __builtin_amdgcn_cvt_pk_fp8_f32(x[2] * inv, x[3] * inv, w0, true);
            int w1 = __builtin_amdgcn_cvt_pk_fp8_f32(x[4] * inv, x[5] * inv, 0, false); w1 = __builtin_amdgcn_cvt_pk_fp8_f32(x[6] * inv, x[7] * inv, w1, true);
            const int nrow = nb * 64 + n;
            *(u32x2*)(dst + (size_t)mat * dststride + (size_t)nrow * K + kb * 64 + 8 * c) = (u32x2){(unsigned)w0, (unsigned)w1};
            if ((c & 3) == 0) SW[(size_t)mat * 65536 + (size_t)(nrow >> 8) * 8192 + (size_t)(kb >> 1) * 1024 + (nrow & 255) * 4 + 2 * (kb & 1) + (c >> 2)] = (unsigned char)eb; }
        asm volatile("s_waitcnt lgkmcnt(0)" ::: "memory");
    }
}
__device__ __forceinline__ void cvt_rows(const Ctx& C, const float* src, bf16_t* dst, size_t n8  ) {
    const size_t gt = (size_t)C.vcu * 512 + C.tid, NT = (size_t)C.G * 512;
    for (size_t i = gt; i < n8; i += NT) { const f32x4 a = *(const f32x4*)(src + i * 8), b = *(const f32x4*)(src + i * 8 + 4); *(u32x4*)(dst + i * 8) = pack8(a, b); }
}
__device__ __forceinline__ void phase_prologue(const CAS Args& args, const Ctx& C) {
    tr_job(C, J_MLA_WIN, INF(I_MLA_WIN), (size_t)DM * LATD, 2, DM, LATD, 1280, WSP(bf16_t, WS_W_MLA + OFF_MLA_WIN), W_MLA_STRIDE, nullptr, 0, nullptr);
    tr_job(C, J_MLA_WUQ, INF(I_MLA_WUQ), (size_t)QL * 1536, 2, QL, 1536, 1536, WSP(bf16_t, WS_W_MLA + OFF_MLA_WUQ), W_MLA_STRIDE, INF(I_MLA_QN), QL, nullptr);
    tr_job(C, J_NAT, INF(I_MLA_WUKV), (size_t)KVL * 2048, 2, KVL, 2048, 2048, WSP(bf16_t, WS_W_MLA + OFF_MLA_WUKV), W_MLA_STRIDE, INF(I_MLA_KVN), KVL, nullptr);
    tr_job(C, J_NAT, INF(I_MLA_WO), (size_t)DM * DM, 2, DM, DM, DM, WSP(bf16_t, WS_W_MLA + OFF_MLA_WO), W_MLA_STRIDE, nullptr, 0, nullptr);
    tr_job(C, J_NAT, INF(I_LRU_WIN), (size_t)DM * 2048, 2, DM, 2048, 2048, WSP(bf16_t, WS_W_LRU + OFF_LRU_WIN), W_LRU_STRIDE, nullptr, 0, nullptr);
    for (int j = 0; j < 2; ++j)
        tr_job(C, J_LRU_WAX, INF(I_LRU_WA) + (size_t)j * 4 * 65536, (size_t)256 * 256, 4, 256, 256, 512, WSP(bf16_t, WS_W_LRU + OFF_LRU_WAX + (size_t)j * W_LRU_STRIDE), (size_t)512 * 256 * 2, nullptr, 0, INF(I_LRU_WX) + (size_t)j * 4 * 65536);
    tr_job(C, J_NAT, INF(I_LRU_WOUT), (size_t)DM * DM, 2, DM, DM, DM, WSP(bf16_t, WS_W_LRU + OFF_LRU_WOUT), W_LRU_STRIDE, nullptr, 0, nullptr);
    tr_job(C, J_NAT, INF(I_PLE_WG), (size_t)DM * DM, 4, DM, DM, DM, WSP(bf16_t, WS_W_PLE + OFF_PLE_WG), W_PLE_STRIDE, nullptr, 0, nullptr);
    tr_job(C, J_NAT, INF(I_PLE_WP), (size_t)PLED * DM, 4, PLED, DM, DM, WSP(bf16_t, WS_W_PLE + OFF_PLE_WP), W_PLE_STRIDE, nullptr, 0, nullptr);
    __syncthreads();
    tr_job_fp8(C, INF(I_MOE_WUP), (size_t)DM * 2048, DEPTH * NE, args.ws + WS_W_UP, (size_t)2048 * 1024, args.ws + WS_SW);
    __syncthreads();
    tr_job(C, J_NAT, INF(I_MOE_WDN), (size_t)DFF * DM, DEPTH * NE, DFF, DM, DM, WSP(bf16_t, WS_W_DN), (size_t)1024 * 1024 * 2, nullptr, 0, nullptr);
    cvt_rows(C, INF(I_X), WSP(bf16_t, WS_XB), (size_t)T * DM / 8);
    cvt_rows(C, INF(I_P), WSP(bf16_t, WS_PB), (size_t)DEPTH * T * PLED / 8);
    { const int* pos = (const int*)args.in[I_POS]; float* CS = WSP(float, WS_CS); float* SN = WSP(float, WS_SN);
      const size_t gt = (size_t)C.vcu * 512 + C.tid, NT = (size_t)C.G * 512;
      for (size_t i = gt; i < (size_t)T * 32; i += NT) { const int tok = (int)(i >> 5), j = (int)(i & 31);
          const double inv = exp(-9.210340371976184 * (double)j / 32.0); const double ang = (double)pos[tok] * inv; double s, c; sincos(ang, &s, &c); CS[i] = (float)c; SN[i] = (float)s; }
      float* SPL = WSP(float, WS_SPL); const float* lam = INF(I_LRU_LAM);
      for (size_t i = gt; i < 2 * 1024; i += NT) { const double l = (double)lam[i]; SPL[i] = (float)(-8.0 * log1p(exp(-l))); } }
}

__device__ __forceinline__ void moe_table(const CAS Args& args, const Ctx& C0, int layer) {
    Ctx C = C0; C.tid = opaque_tid(); C.lane = C.tid & 63;
    const unsigned* cnt = WSP(unsigned, WS_CTL) + CW_CNT + 64 * layer;
    __syncthreads();
    if (C.tid < 32) C.misc[64 + C.tid] = (int)__hip_atomic_load(cnt + C.tid, __ATOMIC_RELAXED, __HIP_MEMORY_SCOPE_AGENT);
    __syncthreads();
    if (C.tid == 0) { int acc = 0; for (int e = 0; e < 32; ++e) { C.misc[16 + e] = acc; acc += (C.misc[64 + e] + 255) >> 8; } C.misc[16 + 32] = acc; }
    __syncthreads();
    { volatile LAS int* te = (volatile LAS int*)(C.lds + TILE_E_OFF);
      for (int mg = C.tid; mg < C.misc[48]; mg += NWAVES * 64) { int e = 0; for (int j = 1; j < 32; ++j) e += (C.misc[16 + j] <= mg) ? 1 : 0; te[mg] = e; } }
    __syncthreads();
}

__device__ __forceinline__ void phase_ln_router(const CAS Args& args, const Ctx& C0, int layer) {
    const int cslot = layer + args.pad;
    Ctx C = C0; C.tid = opaque_tid(); C.lane = C.tid & 63;
    const bf16_t* Y = WSP(bf16_t, WS_Y); float* X1 = WSP(float, WS_X1); bf16_t* X1B = WSP(bf16_t, WS_X1B);
    const float* g1 = INF(I_LN1G) + layer * DM; const float* b1 = INF(I_LN1B) + layer * DM;
    const CAS float* Wr = (const CAS float*)(INF(I_MOE_WR) + (size_t)layer * DM * NE); const float* br = INF(I_MOE_BR) + layer * NE;
    unsigned* gcnt = WSP(unsigned, WS_CTL) + CW_CNT + 64 * cslot;
    int* lists = WSP(int, WS_LIST); int* slot = WSP(int, WS_SLOT); float* gate = WSP(float, WS_GATE);
    LAS float* part = (LAS float*)C.lds;
    volatile LAS int* lcnt = (volatile LAS int*)(C.lds + 69632);
    volatile LAS int* lbase = lcnt + 32;
    f32x4 gv[4], bv[4];
#pragma unroll
    for (int j = 0; j < 2; ++j) { gv[2 * j] = *(const f32x4*)(g1 + 8 * C.lane + 512 * j); gv[2 * j + 1] = *(const f32x4*)(g1 + 8 * C.lane + 512 * j + 4);
        bv[2 * j] = *(const f32x4*)(b1 + 8 * C.lane + 512 * j); bv[2 * j + 1] = *(const f32x4*)(b1 + 8 * C.lane + 512 * j + 4); }
    unsigned char* X1Q = args.ws + WS_X1Q; int sexp;
    { float ag = 0.f, ab = 0.f;
#pragma unroll
      for (int j = 0; j < 4; ++j)
#pragma unroll
          for (int e = 0; e < 4; ++e) { ag = fmaxf(ag, fabsf(gv[j][e])); ab = fmaxf(ab, fabsf(bv[j][e])); }
#pragma unroll
      for (int o = 1; o < 64; o <<= 1) { ag = fmaxf(ag, __shfl_xor(ag, o)); ab = fmaxf(ab, __shfl_xor(ab, o)); }
      const float bound = 16.0f * ag + ab + 1e-20f;
      sexp = 134 - (int)((__float_as_uint(bound) >> 23) & 0xffu);
      sexp = sexp < -100 ? -100 : (sexp > 100 ? 100 : sexp);
      if (C.tid == 0) __hip_atomic_store(WSP(unsigned, WS_CTL) + CW_SA + layer, (unsigned)sexp, __ATOMIC_RELAXED, __HIP_MEMORY_SCOPE_AGENT); }
    const float qs = __uint_as_float((unsigned)(127 + sexp) << 23);
    for (int chunk = C.vcu; chunk < T / 128; chunk += C.G) {
        const int row0 = chunk * 128;
        if (C.tid < 32) lcnt[C.tid] = 0;
#pragma unroll 1
        for (int i = 0; i < 16; ++i) { const size_t row = (size_t)row0 + C.wave * 16 + i;
            f32x4 v[4]; float s = 0.f;
#pragma unroll
            for (int j = 0; j < 2; ++j) { const u32x4 w = *(const u32x4*)(Y + row * DM + 8 * C.lane + 512 * j); v[2 * j] = pg8::bf4_lo(w); v[2 * j + 1] = pg8::bf4_hi(w); }
#pragma unroll
            for (int j = 0; j < 4; ++j) s += (v[j][0] + v[j][1]) + (v[j][2] + v[j][3]);
            const float mean = wave_sum(s) * (1.f / DM); float s2 = 0.f;
#pragma unroll
            for (int j = 0; j < 4; ++j) { v[j] = v[j] - mean; s2 += (v[j][0] * v[j][0] + v[j][1] * v[j][1]) + (v[j][2] * v[j][2] + v[j][3] * v[j][3]); }
            const float rstd = 1.f / sqrtf(wave_sum(s2) * (1.f / DM) + LN_EPS);
#pragma unroll
            for (int j = 0; j < 4; ++j) v[j] = v[j] * rstd * gv[j] + bv[j];
#pragma unroll
            for (int j = 0; j < 2; ++j) { float* xo = X1 + row * DM + 8 * C.lane + 512 * j; *(f32x4*)xo = v[2 * j]; *(f32x4*)(xo + 4) = v[2 * j + 1];
                *(u32x4*)(X1B + row * DM + 8 * C.lane + 512 * j) = pack8(v[2 * j], v[2 * j + 1]);
                const f32x4 q0 = v[2 * j] * qs, q1 = v[2 * j + 1] * qs;
                int w0 = __builtin_amdgcn_cvt_pk_fp8_f32(fminf(fmaxf(q0[0], -448.f), 448.f), fminf(fmaxf(q0[1], -448.f), 448.f), 0, false); w0 = __builtin_amdgcn_cvt_pk_fp8_f32(fminf(fmaxf(q0[2], -448.f), 448.f), fminf(fmaxf(q0[3], -448.f), 448.f), w0, true);
                int w1 = __builtin_amdgcn_cvt_pk_fp8_f32(fminf(fmaxf(q1[0], -448.f), 448.f), fminf(fmaxf(q1[1], -448.f), 448.f), 0, false); w1 = __builtin_amdgcn_cvt_pk_fp8_f32(fminf(fmaxf(q1[2], -448.f), 448.f), fminf(fmaxf(q1[3], -448.f), 448.f), w1, true);
                *(u32x2*)(X1Q + row * DM + 8 * C.lane + 512 * j) = (u32x2){(unsigned)w0, (unsigned)w1}; } }
        asm volatile("s_waitcnt vmcnt(0)" ::: "memory");
        __syncthreads();
        { const int grp = C.wave >> 2, kq = C.wave & 3; const size_t tok = (size_t)row0 + grp * 64 + C.lane;
          float acc[32];
#pragma unroll
          for (int e = 0; e < 32; ++e) acc[e] = 0.f;
          const float* xr = X1 + tok * DM + kq * 256;
          for (int kk = 0; kk < 64; ++kk) { const f32x4 xv = *(const f32x4*)(xr + kk * 4);
#pragma unroll
              for (int i = 0; i < 4; ++i) { const CAS float* wrow = Wr + (size_t)(kq * 256 + kk * 4 + i) * NE;
#pragma unroll
                  for (int e = 0; e < 32; ++e) acc[e] = fmaf(xv[i], wrow[e], acc[e]);
                  if (i & 1) __builtin_amdgcn_sched_barrier(0); } }
          LAS float* pp = part + ((grp * 4 + kq) * 64 + C.lane) * 33;
#pragma unroll
          for (int e = 0; e < 32; ++e) pp[e] = acc[e]; }
        __syncthreads();
        int te[4] = {0, 0, 0, 0}, lp[4] = {0, 0, 0, 0}; float tg[4] = {0.f, 0.f, 0.f, 0.f};
        if (C.tid < 128) { const int grp = C.tid >> 6, ln = C.tid & 63; float lg[32];
#pragma unroll
            for (int e = 0; e < 32; ++e) { float s = br[e];
#pragma unroll
                for (int kq = 0; kq < 4; ++kq) s += part[((grp * 4 + kq) * 64 + ln) * 33 + e];
                lg[e] = s; }
            float tv[4];
#pragma unroll
            for (int k = 0; k < 4; ++k) { float best = lg[0]; int bi = 0;
#pragma unroll
                for (int e = 1; e < 32; ++e) { const bool gt = lg[e] > best; best = gt ? lg[e] : best; bi = gt ? e : bi; }
                te[k] = bi; tv[k] = best;
#pragma unroll
                for (int e = 0; e < 32; ++e) lg[e] = (e == bi) ? -__builtin_inff() : lg[e]; }
            float den = 0.f;
#pragma unroll
            for (int k = 0; k < 4; ++k) { tg[k] = __expf(tv[k] - tv[0]); den += tg[k]; }
            const float rden = 1.0f / den;
#pragma unroll
            for (int k = 0; k < 4; ++k) { tg[k] *= rden; lp[k] = __hip_atomic_fetch_add((LAS int*)&lcnt[te[k]], 1, __ATOMIC_RELAXED, __HIP_MEMORY_SCOPE_WORKGROUP); } }
        __syncthreads();
        if (C.tid < 32) lbase[C.tid] = (int)__hip_atomic_fetch_add(gcnt + C.tid, (unsigned)lcnt[C.tid], __ATOMIC_RELAXED, __HIP_MEMORY_SCOPE_AGENT);
        __syncthreads();
        if (C.tid < 128) { const int tok = row0 + C.tid;
#pragma unroll
            for (int k = 0; k < 4; ++k) { const int pos = lbase[te[k]] + lp[k]; lists[(size_t)te[k] * T + pos] = tok; slot[tok * 4 + k] = te[k] * T + pos; gate[tok * 4 + k] = tg[k]; } }
        __syncthreads();
    }
}

__device__ __forceinline__ void phase_combine_ln2(const CAS Args& args, const Ctx& C0, int layer) {
    Ctx C = C0; C.tid = opaque_tid(); C.lane = C.tid & 63;
    moe_table(args, C, layer);
    const bf16_t* X1B = WSP(bf16_t, WS_X1B); const bf16_t* YS = WSP(bf16_t, WS_YS); const int* slot = WSP(int, WS_SLOT); const float* gate = WSP(float, WS_GATE);
    bf16_t* X2B = WSP(bf16_t, WS_X2B);
    const float* g2 = INF(I_LN2G) + layer * DM; const float* b2 = INF(I_LN2B) + layer * DM;
    f32x4 gv[4], bv[4];
#pragma unroll
    for (int j = 0; j < 2; ++j) { gv[2 * j] = *(const f32x4*)(g2 + 8 * C.lane + 512 * j); gv[2 * j + 1] = *(const f32x4*)(g2 + 8 * C.lane + 512 * j + 4);
        bv[2 * j] = *(const f32x4*)(b2 + 8 * C.lane + 512 * j); bv[2 * j + 1] = *(const f32x4*)(b2 + 8 * C.lane + 512 * j + 4); }
    const int gw = C.vcu * NWAVES + C.wave, NGW = C.G * NWAVES;
    for (int row = gw; row < T; row += NGW) {
        f32x4 v[4];
#pragma unroll
        for (int j = 0; j < 2; ++j) { const u32x4 w = *(const u32x4*)(X1B + (size_t)row * DM + 8 * C.lane + 512 * j); v[2 * j] = pg8::bf4_lo(w) * ALPHA; v[2 * j + 1] = pg8::bf4_hi(w) * ALPHA; }
#pragma unroll
        for (int k = 0; k < 4; ++k) { const int sv = slot[row * 4 + k]; const float g = gate[row * 4 + k]; const int e = sv >> 15, pos = sv & (T - 1);
            const size_t prow = (size_t)C.misc[16 + e] * 256 + pos;
#pragma unroll
            for (int j = 0; j < 2; ++j) { const u32x4 w = *(const u32x4*)(YS + prow * DM + 8 * C.lane + 512 * j); v[2 * j] += pg8::bf4_lo(w) * g; v[2 * j + 1] += pg8::bf4_hi(w) * g; } }
        float s = 0.f;
#pragma unroll
        for (int j = 0; j < 4; ++j) s += (v[j][0] + v[j][1]) + (v[j][2] + v[j][3]);
        const float mean = wave_sum(s) * (1.f / DM); float s2 = 0.f;
#pragma unroll
        for (int j = 0; j < 4; ++j) { v[j] = v[j] - mean; s2 += (v[j][0] * v[j][0] + v[j][1] * v[j][1]) + (v[j][2] * v[j][2] + v[j][3] * v[j][3]); }
        const float rstd = 1.f / sqrtf(wave_sum(s2) * (1.f / DM) + LN_EPS);
#pragma unroll
        for (int j = 0; j < 4; ++j) v[j] = v[j] * rstd * gv[j] + bv[j];
#pragma unroll
        for (int j = 0; j < 2; ++j) *(u32x4*)(X2B + (size_t)row * DM + 8 * C.lane + 512 * j) = pack8(v[2 * j], v[2 * j + 1]);
    }
}

__device__ __forceinline__ void phase_conv(const CAS Args& args, const Ctx& C0, int j) {
    Ctx C = C0; C.tid = opaque_tid(); C.lane = C.tid & 63;
    const bf16_t* U = WSP(bf16_t, WS_U); bf16_t* UC = WSP(bf16_t, WS_UC);
    const float* cw = INF(I_LRU_CW) + (size_t)j * 4 * DM; const float* cb = INF(I_LRU_CB) + (size_t)j * DM;
    const int c8 = (C.tid & 127) * 8, rsub = C.tid >> 7;
    float w[4][8], bb[8];
#pragma unroll
    for (int q = 0; q < 4; ++q)
#pragma unroll
        for (int e = 0; e < 8; ++e) w[q][e] = cw[q * DM + c8 + e];
#pragma unroll
    for (int e = 0; e < 8; ++e) bb[e] = cb[c8 + e];
    for (int chunk = C.vcu; chunk < T / 128; chunk += C.G) {
        const int r0 = chunk * 128 + rsub * 32;
        u32x4 h0, h1, h2;
        const u32x4 z = {0u, 0u, 0u, 0u};
        const int s0 = r0 & (SEQ - 1);
        h0 = s0 >= 3 ? *(const u32x4*)(U + (size_t)(r0 - 3) * DM + c8) : z; h1 = s0 >= 2 ? *(const u32x4*)(U + (size_t)(r0 - 2) * DM + c8) : z; h2 = s0 >= 1 ? *(const u32x4*)(U + (size_t)(r0 - 1) * DM + c8) : z;
#pragma unroll 4
        for (int i = 0; i < 32; ++i) { const u32x4 h3 = *(const u32x4*)(U + (size_t)(r0 + i) * DM + c8);
            float o[8];
#pragma unroll
            for (int q = 0; q < 4; ++q) { const unsigned a = h0[q], b = h1[q], c = h2[q], d = h3[q];
                o[2 * q] = bb[2 * q] + w[0][2 * q] * bf_lo(a) + w[1][2 * q] * bf_lo(b) + w[2][2 * q] * bf_lo(c) + w[3][2 * q] * bf_lo(d);
                o[2 * q + 1] = bb[2 * q + 1] + w[0][2 * q + 1] * bf_hi(a) + w[1][2 * q + 1] * bf_hi(b) + w[2][2 * q + 1] * bf_hi(c) + w[3][2 * q + 1] * bf_hi(d); }
            u32x4 ow; ow.x = cvt_pk_bf16(o[0], o[1]); ow.y = cvt_pk_bf16(o[2], o[3]); ow.z = cvt_pk_bf16(o[4], o[5]); ow.w = cvt_pk_bf16(o[6], o[7]);
            *(u32x4*)(UC + (size_t)(r0 + i) * DM + c8) = ow; h0 = h1; h1 = h2; h2 = h3; }
    }
}
__device__ __forceinline__ void phase_scan1(const CAS Args& args, const Ctx& C0) {
    Ctx C = C0; C.tid = opaque_tid(); C.lane = C.tid & 63;
    const bf16_t* LA = WSP(bf16_t, WS_AA); const bf16_t* BB = WSP(bf16_t, WS_BB); float* CA = WSP(float, WS_CA); float* CH = WSP(float, WS_CH);
    const int c2 = C.tid * 2;
    for (int item = C.vcu; item < NBATCH * 64; item += C.G) {
        const size_t r0 = (size_t)item * 64; float h0 = 0.f, h1 = 0.f, l0 = 0.f, l1 = 0.f;
#pragma unroll 8
        for (int s = 0; s < 64; ++s) { const unsigned aw = *(const unsigned*)(LA + (r0 + s) * DM + c2), bw = *(const unsigned*)(BB + (r0 + s) * DM + c2);
            const float la0 = bf_lo(aw), la1 = bf_hi(aw);
            h0 = __builtin_amdgcn_exp2f(la0) * h0 + bf_lo(bw); h1 = __builtin_amdgcn_exp2f(la1) * h1 + bf_hi(bw); l0 += la0; l1 += la1; }
        *(f32x2*)(CA + (size_t)item * DM + c2) = (f32x2){__builtin_amdgcn_exp2f(l0), __builtin_amdgcn_exp2f(l1)}; *(f32x2*)(CH + (size_t)item * DM + c2) = (f32x2){h0, h1};
    }
}
__device__ __forceinline__ void phase_scan2(const CAS Args& args, const Ctx& C0) {
    Ctx C = C0; C.tid = opaque_tid(); C.lane = C.tid & 63;
    const bf16_t* LA = WSP(bf16_t, WS_AA); const bf16_t* BB = WSP(bf16_t, WS_BB); const float* CA = WSP(float, WS_CA); const float* CH = WSP(float, WS_CH);
    const bf16_t* GG = WSP(bf16_t, WS_GG); bf16_t* YL = WSP(bf16_t, WS_O);
    const int c2 = C.tid * 2;
    for (int item = C.vcu; item < NBATCH * 64; item += C.G) {
        const int b = item >> 6, ch = item & 63; float h0 = 0.f, h1 = 0.f;
        for (int jx = 0; jx < ch; ++jx) { const f32x2 a = *(const f32x2*)(CA + (size_t)(b * 64 + jx) * DM + c2), e = *(const f32x2*)(CH + (size_t)(b * 64 + jx) * DM + c2);
            h0 = a[0] * h0 + e[0]; h1 = a[1] * h1 + e[1]; }
        const size_t r0 = (size_t)item * 64;
#pragma unroll 8
        for (int s = 0; s < 64; ++s) { const unsigned aw = *(const unsigned*)(LA + (r0 + s) * DM + c2), bw = *(const unsigned*)(BB + (r0 + s) * DM + c2), g = *(const unsigned*)(GG + (r0 + s) * DM + c2);
            h0 = __builtin_amdgcn_exp2f(bf_lo(aw)) * h0 + bf_lo(bw); h1 = __builtin_amdgcn_exp2f(bf_hi(aw)) * h1 + bf_hi(bw);
            *(unsigned*)(YL + (r0 + s) * DM + c2) = cvt_pk_bf16(bf_lo(g) * h0, bf_hi(g) * h1); }
    }
}

#if PROBE_T
typedef int v8i_t __attribute__((ext_vector_type(8)));
__device__ __forceinline__ unsigned fp8_of_int(int v) { const unsigned char t[4] = {0x00, 0x38, 0x40, 0x44}; const int a = v < 0 ? -v : v; return (unsigned)t[a] | (v < 0 ? 0x80u : 0u); }
__device__ __forceinline__ int tA(int i, int k) { return ((i * 3 + k * 5) % 7) - 3; }
__device__ __forceinline__ int tB(int k, int j) { return ((k * 2 + j * 7) % 5) - 2; }
__device__ __forceinline__ void mfma_fp8_selftest(unsigned* flagw) {
    const int l = threadIdx.x & 63, r = l & 15, q = l >> 4;
    v8i_t A, B;
#pragma unroll
    for (int d = 0; d < 8; ++d) { unsigned wa = 0, wb = 0;
#pragma unroll
        for (int b = 0; b < 4; ++b) { const int k = 32 * q + 4 * d + b; wa |= fp8_of_int(tA(r, k)) << (8 * b); wb |= fp8_of_int(tB(k, r)) << (8 * b); }
        A[d] = (int)wa; B[d] = (int)wb; }
    const f32x4 z = {0.f, 0.f, 0.f, 0.f};
    const int U = 0x7f7f7f7f;
    const int saq = (127 + q) * 0x01010101;
    const int sab = (q == 0) ? (int)0x8281807fu : U;
    const f32x4 m2 = __builtin_amdgcn_mfma_scale_f32_16x16x128_f8f6f4(A, B, z, 0, 0, 0, saq, 0, U);
    const f32x4 m5 = __builtin_amdgcn_mfma_scale_f32_16x16x128_f8f6f4(A, B, z, 0, 0, 0, sab, 0, U);
    bool k1 = true, k2 = true, k3 = true, k4 = true;
#pragma unroll
    for (int e = 0; e < 4; ++e) { const int i = 4 * q + e, j = r; float eb = 0.f, e0 = 0.f, ec = 0.f, ed = 0.f;
        for (int kq = 0; kq < 4; ++kq) for (int hh = 0; hh < 2; ++hh) { float sh = 0.f; for (int k = 32 * kq + 16 * hh; k < 32 * kq + 16 * hh + 16; ++k) sh += (float)(tA(i, k) * tB(k, j));
            const int xb = hh == 0 ? (kq >> 1) : 2 + (kq >> 1);
            eb += sh * (float)(1 << xb); e0 += sh; ec += sh * (float)(1 << kq); ed += sh * (float)(1 << xb); }
        k1 = k1 && (m2[e] == eb); k2 = k2 && (m2[e] == e0); k3 = k3 && (m5[e] == ec); k4 = k4 && (m5[e] == ed); }
    const bool b1 = __all(k1), b2 = __all(k2), b3 = __all(k3), b4 = __all(k4);
    if (l == 0) *flagw = (b1 ? 1u : 0u) | (b2 ? 2u : 0u) | (b3 ? 4u : 0u) | (b4 ? 8u : 0u);
}
#endif
constexpr int PH_PER_LAYER = 12, PH_TOTAL = 2 + PH_PER_LAYER * DEPTH;
__global__ void __launch_bounds__(NWAVES * 64, 2) fwd_kernel(Args args_kernarg) {
    (void)args_kernarg;
    ArgsP const argp = (ArgsP)__builtin_amdgcn_kernarg_segment_ptr();
    const CAS Args& args0 = *argp;
    extern __shared__ __attribute__((aligned(16))) unsigned char lds_raw[];
    Ctx C_;
    C_.lds = (LAS unsigned char*)lds_raw; C_.misc = (volatile LAS int*)(C_.lds + MISC_OFF);
    C_.tid = threadIdx.x; C_.lane = C_.tid & 63; C_.wave = __builtin_amdgcn_readfirstlane(C_.tid >> 6);
    C_.bid = (int)blockIdx.x; C_.G = gridDim.x; { const int bx = blockIdx.x; C_.vcu = (C_.G % 8 == 0) ? (bx % 8) * (C_.G / 8) + bx / 8 : bx; }
    for (int u = C_.tid; u < 128; u += NWAVES * 64) C_.misc[u] = 0;
    __syncthreads();
    XcdBarrier bar = xcd_barrier_post((unsigned*)(args0.ws + WS_CTL) + CW_BAR + args0.li * XCD_BAR_WORDS, (volatile LAS unsigned*)C_.misc);
    const int lo = args0.ph_lo, hi = args0.ph_hi;
#define IN(k) (lo <= (k) && (k) < hi)
#define PH_END(k) do { if ((k) + 1 < hi) xcd_barrier(bar); } while (0)

    if (SEL(0) && IN(0)) { const CAS Args& args = fresh_args(argp); const Ctx C = fresh_ctx(C_); const int cid = C.bid; phase_prologue(args, C); PH_END(0); }
    if (SEL(1) && IN(1)) { const CAS Args& args = fresh_args(argp); const Ctx C = fresh_ctx(C_); const int cid = C.bid;
        pg8::DenseSched S; S.init(WSP(bf16_t, WS_PB), WSP(bf16_t, WS_W_PLE + OFF_PLE_WP), PLED, PLED, DEPTH * T, DM, C.G, cid); S.bpm_shift = 7; S.bbatch = W_PLE_STRIDE;
        pg8::EpiPP E{WSP(bf16_t, WS_PP)};
        pg8::gemm_phase<pg8::EpiPP, pg8::DenseSched, false>(C.lds, PLED / 64, PLED * 2, PLED * 2, S, E);
        PH_END(1);
    }
    for (int layer = 0; layer < DEPTH; ++layer) {
        const int base = 2 + PH_PER_LAYER * layer, j = layer >> 1;
        if ((layer & 1) == 0) {
            if (SEL(2) && IN(base + 0)) { const CAS Args& args = fresh_args(argp); const Ctx C = fresh_ctx(C_); const int cid = C.bid; const unsigned char* wm = args.ws + WS_W_MLA + (size_t)j * W_MLA_STRIDE;
                pg8::DenseSched S; S.init(WSP(bf16_t, WS_XB), wm + OFF_MLA_WIN, DM, DM, T, 1280, C.G, cid);
                pg8::EpiLat E{WSP(bf16_t, WS_LAT), WSP(float, WS_SSQ), WSP(bf16_t, WS_KR), WSP(float, WS_CS), WSP(float, WS_SN)};
                pg8::gemm_phase<pg8::EpiLat, pg8::DenseSched, false>(C.lds, DM / 64, DM * 2, DM * 2, S, E);
                PH_END(base + 0);
            }
            if (SEL(3) && IN(base + 1)) { const CAS Args& args = fresh_args(argp); const Ctx C = fresh_ctx(C_); const int cid = C.bid; const unsigned char* wm = args.ws + WS_W_MLA + (size_t)j * W_MLA_STRIDE;
                { pg8::DenseSched S; S.init(WSP(bf16_t, WS_LAT), wm + OFF_MLA_WUQ, DM, QL, T, 1536, C.G, cid);
                  pg8::EpiQ E{WSP(bf16_t, WS_Q), WSP(float, WS_SSQ), WSP(float, WS_CS), WSP(float, WS_SN)};
                  pg8::gemm_phase<pg8::EpiQ, pg8::DenseSched, false>(C.lds, QL / 64, DM * 2, QL * 2, S, E); }
                { pg8::DenseSched S; S.init(WSP(bf16_t, WS_LAT) + QL, wm + OFF_MLA_WUKV, DM, KVL, T, 2048, C.G, cid);
                  pg8::EpiKV E{WSP(bf16_t, WS_KN), WSP(bf16_t, WS_V), WSP(float, WS_SSQ)};
                  pg8::gemm_phase<pg8::EpiKV, pg8::DenseSched, false>(C.lds, KVL / 64, DM * 2, KVL * 2, S, E); }
                PH_END(base + 1);
            }
            if (SEL(4) && IN(base + 2)) { const CAS Args& args = fresh_args(argp); const Ctx C = fresh_ctx(C_); const int cid = C.bid;
                for (int it = C.vcu; it < NBATCH * NH * 8; it += C.G) { const int bh = it >> 3, pr = it & 7;
                    att::attn_block(bh >> 3, bh & 7, pr, WSP(bf16_t, WS_Q), WSP(bf16_t, WS_KN), WSP(bf16_t, WS_KR), WSP(bf16_t, WS_V), WSP(bf16_t, WS_O), (LAS char*)C.lds, PROBE_T ? (unsigned long long*)(args.ws + WS_CTL + 8192) : nullptr);
                    att::attn_block(bh >> 3, bh & 7, 15 - pr, WSP(bf16_t, WS_Q), WSP(bf16_t, WS_KN), WSP(bf16_t, WS_KR), WSP(bf16_t, WS_V), WSP(bf16_t, WS_O), (LAS char*)C.lds, PROBE_T ? (unsigned long long*)(args.ws + WS_CTL + 8192) : nullptr); }
                PH_END(base + 2);
            }
        } else {
            if (SEL(5) && IN(base + 0)) { const CAS Args& args = fresh_args(argp); const Ctx C = fresh_ctx(C_); const int cid = C.bid; const unsigned char* wl = args.ws + WS_W_LRU + (size_t)j * W_LRU_STRIDE;
                pg8::DenseSched S; S.init(WSP(bf16_t, WS_XB), wl + OFF_LRU_WIN, DM, DM, T, 2048, C.G, cid);
                pg8::EpiGU E{WSP(bf16_t, WS_GG), WSP(bf16_t, WS_U)};
                pg8::gemm_phase<pg8::EpiGU, pg8::DenseSched, false>(C.lds, DM / 64, DM * 2, DM * 2, S, E);
                PH_END(base + 0);
            }
            if (SEL(6) && IN(base + 1)) { const CAS Args& args = fresh_args(argp); const Ctx C = fresh_ctx(C_); const int cid = C.bid; phase_conv(args, C, j); PH_END(base + 1); }
            if (SEL(7) && IN(base + 2)) { const CAS Args& args = fresh_args(argp); const Ctx C = fresh_ctx(C_); const int cid = C.bid; const unsigned char* wl = args.ws + WS_W_LRU + (size_t)j * W_LRU_STRIDE;
                pg8::DenseSched S; S.init(WSP(bf16_t, WS_UC), wl + OFF_LRU_WAX, DM, 256, T, 2048, C.G, cid); S.apn_shift = 1; S.akbytes = 512;
                pg8::EpiAB E{WSP(bf16_t, WS_AA), WSP(bf16_t, WS_BB), WSP(bf16_t, WS_UC), INF(I_LRU_BA) + j * DM, INF(I_LRU_BX) + j * DM, WSP(float, WS_SPL) + j * DM};
                pg8::gemm_phase<pg8::EpiAB, pg8::DenseSched, false>(C.lds, 4, DM * 2, 512, S, E);
                PH_END(base + 2);
            }
            if (SEL(8) && IN(base + 3)) { const CAS Args& args = fresh_args(argp); const Ctx C = fresh_ctx(C_); const int cid = C.bid; phase_scan1(args, C); PH_END(base + 3); }
            if (SEL(9) && IN(base + 4)) { const CAS Args& args = fresh_args(argp); const Ctx C = fresh_ctx(C_); const int cid = C.bid; phase_scan2(args, C); PH_END(base + 4); }
        }
        if (SEL(10) && IN(base + 5)) { const CAS Args& args = fresh_args(argp); const Ctx C = fresh_ctx(C_); const int cid = C.bid;
            const unsigned char* wo = (layer & 1) ? args.ws + WS_W_LRU + (size_t)j * W_LRU_STRIDE + OFF_LRU_WOUT : args.ws + WS_W_MLA + (size_t)j * W_MLA_STRIDE + OFF_MLA_WO;
            pg8::DenseSched S; S.init(WSP(bf16_t, WS_O), wo, DM, DM, T, DM, C.G, cid);
            pg8::EpiRes E{WSP(bf16_t, WS_XB), WSP(bf16_t, WS_Y)};
            pg8::gemm_phase<pg8::EpiRes, pg8::DenseSched, false>(C.lds, DM / 64, DM * 2, DM * 2, S, E);
            PH_END(base + 5);
        }
        if (SEL(11) && IN(base + 6)) { const CAS Args& args = fresh_args(argp); const Ctx C = fresh_ctx(C_); const int cid = C.bid; phase_ln_router(args, C, layer); PH_END(base + 6); }
        if (SEL(12) && IN(base + 7)) { const CAS Args& args = fresh_args(argp); const Ctx C = fresh_ctx(C_); const int cid = C.bid;
            moe_table(args, C, layer);
            pg8::MoeSched S{(const char*)(args.ws + WS_X1Q), (const char*)(args.ws + WS_W_UP + (size_t)layer * NE * 2048 * 1024), (size_t)2048 * 1024, (const char*)(args.ws + WS_SW + (size_t)layer * NE * 65536), DM, DM, 8, WSP(int, WS_LIST), C.misc + 16, (volatile LAS const int*)(C.lds + TILE_E_OFF), C.G, cid, true};
            const int sae = 127 - (int)__hip_atomic_load(WSP(unsigned, WS_CTL) + CW_SA + layer, __ATOMIC_RELAXED, __HIP_MEMORY_SCOPE_AGENT);
            pg8::EpiUp E{WSP(bf16_t, WS_H), INF(I_MOE_BUP) + (size_t)layer * NE * 2048};
            pg8::gemm_phase<pg8::EpiUp, pg8::MoeSched, true, true>(C.lds, DM / 128, DM, DM, S, E, PROBE_T ? (unsigned long long*)(args.ws + WS_CTL + 8192) : nullptr, sae * 0x01010101);
            PH_END(base + 7);
        }
        if (SEL(13) && IN(base + 8)) { const CAS Args& args = fresh_args(argp); const Ctx C = fresh_ctx(C_); const int cid = C.bid;
            moe_table(args, C, layer);
            pg8::MoeSched S{(const char*)WSP(bf16_t, WS_H), (const char*)(args.ws + WS_W_DN + (size_t)layer * NE * 1024 * 1024 * 2), (size_t)1024 * 1024 * 2, nullptr, DFF * 2, DFF * 2, 4, WSP(int, WS_LIST), C.misc + 16, (volatile LAS const int*)(C.lds + TILE_E_OFF), C.G, cid, false};
            pg8::EpiDown E{WSP(bf16_t, WS_YS), INF(I_MOE_BDN) + (size_t)layer * NE * DM};
            pg8::gemm_phase<pg8::EpiDown, pg8::MoeSched, false>(C.lds, DFF / 64, DFF * 2, DFF * 2, S, E);
            PH_END(base + 8);
        }
        if (SEL(14) && IN(base + 9)) { const CAS Args& args = fresh_args(argp); const Ctx C = fresh_ctx(C_); const int cid = C.bid; phase_combine_ln2(args, C, layer); PH_END(base + 9); }
        if (SEL(15) && IN(base + 10)) { const CAS Args& args = fresh_args(argp); const Ctx C = fresh_ctx(C_); const int cid = C.bid;
            pg8::DenseSched S; S.init(WSP(bf16_t, WS_X2B), args.ws + WS_W_PLE + (size_t)layer * W_PLE_STRIDE + OFF_PLE_WG, DM, DM, T, DM, C.G, cid);
            pg8::EpiPle E{WSP(bf16_t, WS_X2B), WSP(bf16_t, WS_PP) + (size_t)layer * T * DM, layer == DEPTH - 1 ? args.out : (float*)nullptr, WSP(bf16_t, WS_XB)};
            pg8::gemm_phase<pg8::EpiPle, pg8::DenseSched, false>(C.lds, DM / 64, DM * 2, DM * 2, S, E);
            if (layer + 1 < DEPTH) PH_END(base + 10);
        }
    }
#if PROBE_T
    if (PROBE_T == 20 && blockIdx.x == 0 && threadIdx.x < 64) { const CAS Args& args = fresh_args(argp); mfma_fp8_selftest((unsigned*)(args.ws + WS_CTL + 8192 + 256)); }
    { xcd_barrier(bar); const CAS Args& args = fresh_args(argp);
      const unsigned long long* pw = (const unsigned long long*)(args.ws + WS_CTL + 8192);
      const double pk = (double)__hip_atomic_load(pw + 0, __ATOMIC_RELAXED, __HIP_MEMORY_SCOPE_AGENT), pe = (double)__hip_atomic_load(pw + 1, __ATOMIC_RELAXED, __HIP_MEMORY_SCOPE_AGENT),
                   pn = (double)__hip_atomic_load(pw + 2, __ATOMIC_RELAXED, __HIP_MEMORY_SCOPE_AGENT), pt = (double)__hip_atomic_load(pw + 3, __ATOMIC_RELAXED, __HIP_MEMORY_SCOPE_AGENT);
      float c = 100.f;
      if (PROBE_T == 2) c = (float)(pk / (pn * 16.0) / 10.0);
      if (PROBE_T == 3) c = (float)(pe / pn / 100.0);
      if (PROBE_T == 4) c = (float)((pt - pk - pe) / pn / 100.0);
      if (PROBE_T == 5) c = (float)(pn);
      if (PROBE_T >= 10) { double q[7]; for (int i = 0; i < 7; ++i) q[i] = (double)__hip_atomic_load(pw + 8 + i, __ATOMIC_RELAXED, __HIP_MEMORY_SCOPE_AGENT);
          if (PROBE_T == 10) c = (float)(q[6] / q[5] / 10.0);
          if (PROBE_T == 11) c = (float)(q[0] / q[5] / 10.0);
          if (PROBE_T == 12) c = (float)(q[1] / q[5] / 10.0);
          if (PROBE_T == 13) c = (float)(q[2] / q[5] / 10.0);
          if (PROBE_T == 14) c = (float)(q[3] / q[5] / 10.0);
          if (PROBE_T == 15) c = (float)(q[4] / q[5] / 10.0); }
      if (PROBE_T >= 2 && PROBE_T < 20) c = exp2f(floorf(log2f(c) * 8.0f + PROBE_SHIFT) * 0.125f);
      if (PROBE_T == 20) { const unsigned fl = __hip_atomic_load((const unsigned*)(args.ws + WS_CTL + 8192 + 256), __ATOMIC_RELAXED, __HIP_MEMORY_SCOPE_AGENT); c = 100.f + 10.f * (float)fl; }
      for (size_t i = (size_t)blockIdx.x * 512 + threadIdx.x; i < (size_t)T * DM; i += (size_t)gridDim.x * 512) args.out[i] = c; }
#endif
#undef IN
#undef PH_END
}

extern "C" void kernel_launch(void* const* d_in, const int* in_sizes, int n_in, void* d_out, int out_size, void* d_ws, size_t ws_size, hipStream_t stream) {
    static int grid = 0;
    if (grid == 0) {
        if (n_in != 30 || in_sizes[0] != T * DM || out_size != T * DM || ws_size < WS_END) { fprintf(stderr, "kernel_launch: unexpected shapes (n_in %d, in0 %d, out %d, ws %zu)\n", n_in, n_in > 0 ? in_sizes[0] : -1, out_size, ws_size); grid = -1; return; }
        int dev = 0, cus = 0, per_cu = 0;
        if (hipGetDevice(&dev) != hipSuccess || hipDeviceGetAttribute(&cus, hipDeviceAttributeMultiprocessorCount, dev) != hipSuccess) { grid = -1; return; }
        if (hipFuncSetAttribute((const void*)fwd_kernel, hipFuncAttributeMaxDynamicSharedMemorySize, LDS_BYTES) != hipSuccess) { fprintf(stderr, "kernel_launch: hipFuncSetAttribute failed\n"); grid = -1; return; }
        if (hipOccupancyMaxActiveBlocksPerMultiprocessor(&per_cu, (const void*)fwd_kernel, NWAVES * 64, LDS_BYTES) != hipSuccess || per_cu < 1) fprintf(stderr, "kernel_launch: occupancy query reports %d\n", per_cu);
        (void)hipGetLastError();
        grid = cus;
    }
    if (grid < 0) return;
    if (hipMemsetAsync((char*)d_ws + WS_CTL, 0, CTL_ZERO_BYTES, stream) != hipSuccess) return;
    Args a{};
    for (int i = 0; i < 30; ++i) a.in[i] = d_in[i];
    a.out = (float*)d_out; a.ws = (unsigned char*)d_ws; a.pad = 0;
#if MK_ONE_LAUNCH
    a.ph_lo = 0; a.ph_hi = PH_TOTAL; a.li = 0;
    hipLaunchKernelGGL(fwd_kernel, dim3(grid), dim3(NWAVES * 64), LDS_BYTES, stream, a);
#else
    int li = 0;
    for (int ph = 0; ph < PH_TOTAL; ++ph) {
        if (ph >= 2) { const int l = (ph - 2) / PH_PER_LAYER, k = (ph - 2) % PH_PER_LAYER; if (k == 11) continue; if ((l & 1) == 0 && (k == 3 || k == 4)) continue; }
        int site = ph;
        if (ph >= 2) { const int l = (ph - 2) / PH_PER_LAYER, k = (ph - 2) % PH_PER_LAYER; static const int mla[11] = {2, 3, 4, -1, -1, 10, 11, 12, 13, 14, 15}, lru[11] = {5, 6, 7, 8, 9, 10, 11, 12, 13, 14, 15}; site = (l & 1) ? lru[k] : mla[k]; }
        a.ph_lo = ph; a.ph_hi = ph + 1;
        if ((HOSTDUP >> site) & 1) { a.li = li++; a.pad = 4; hipLaunchKernelGGL(fwd_kernel, dim3(grid), dim3(NWAVES * 64), LDS_BYTES, stream, a); }
        a.li = li++; a.pad = 0;
        hipLaunchKernelGGL(fwd_kernel, dim3(grid), dim3(NWAVES * 64), LDS_BYTES, stream, a);
    }
#endif
}
```

```cpp
#include <hip/hip_runtime.h>
#include <hip/hip_bf16.h>
#include <cstdio>
#include <cstdint>

#ifndef PHSEL
#define PHSEL -1
#endif
#ifndef PHSKIP
#define PHSKIP -1
#endif
#define SEL(id) ((PHSEL < 0 || PHSEL == (id)) && PHSKIP != (id))
#ifndef PROBE_T
#define PROBE_T 0
#endif
#ifndef PROBE_SHIFT
#define PROBE_SHIFT 0.0f
#endif
#ifndef HOSTDUP
#define HOSTDUP 0
#endif
#ifndef MK_ONE_LAUNCH
#define MK_ONE_LAUNCH 1
#endif

constexpr int T = 32768, SEQ = 4096, NBATCH = 8, DM = 1024, DEPTH = 4;
constexpr int QL = 768, KVL = 256, ROPE = 64, LATD = 1088, NH = 8, DQK = 192, DV = 128;
constexpr int NE = 32, TOPK = 4, DFF = 1024, PLED = 256;
constexpr float ALPHA = 1.681792830507429f;
constexpr float LN_EPS = 1e-5f, RMS_EPS = 1e-6f;
constexpr float QSCALE = 1.4426950408889634f / 13.856406460551018f;
constexpr int NWAVES = 8;

constexpr size_t MiB = 1u << 20;
constexpr size_t WS_CTL = 0, CTL_ZERO_BYTES = 2 * MiB;
constexpr size_t WS_CS = 2 * MiB, WS_SN = 6 * MiB, WS_SPL = 10 * MiB;
constexpr size_t WS_W_MLA = 12 * MiB, W_MLA_STRIDE = 8 * MiB;
constexpr size_t OFF_MLA_WIN = 0, OFF_MLA_WUQ = 2560 * 1024, OFF_MLA_WUKV = OFF_MLA_WUQ + 2304 * 1024, OFF_MLA_WO = OFF_MLA_WUKV + 1024 * 1024;
constexpr size_t WS_W_LRU = 28 * MiB, W_LRU_STRIDE = 8 * MiB;
constexpr size_t OFF_LRU_WIN = 0, OFF_LRU_WAX = 4 * MiB, OFF_LRU_WOUT = 5 * MiB;
constexpr size_t WS_W_PLE = 44 * MiB, W_PLE_STRIDE = 3 * MiB;
constexpr size_t OFF_PLE_WG = 0, OFF_PLE_WP = 2 * MiB;
constexpr size_t WS_W_UP = 56 * MiB;
constexpr size_t WS_W_DN = 568 * MiB;
constexpr size_t WS_XB = 824 * MiB, WS_PB = 888 * MiB, WS_PP = 952 * MiB;
constexpr size_t WS_Y = 1208 * MiB, WS_X1 = 1336 * MiB, WS_X1B = 1464 * MiB, WS_X2 = 1528 * MiB, WS_X2B = 1656 * MiB;
constexpr size_t WS_LAT = 1720 * MiB, WS_KR = 1784 * MiB, WS_SSQ = 1788 * MiB, WS_Q = 1790 * MiB, WS_KN = 1886 * MiB, WS_V = 1950 * MiB, WS_O = 2014 * MiB;
constexpr size_t WS_GG = 2078 * MiB, WS_U = 2142 * MiB, WS_UC = 2206 * MiB, WS_AA = 2270 * MiB, WS_BB = 2398 * MiB, WS_CA = 2526 * MiB, WS_CH = 2528 * MiB;
constexpr size_t WS_H = 2530 * MiB, WS_YS = 2802 * MiB, WS_LIST = 3074 * MiB, WS_SLOT = 3078 * MiB, WS_GATE = 3079 * MiB, WS_SW = 3080 * MiB  , WS_X1Q = 3088 * MiB  , WS_SH = 3120 * MiB  ,
                 WS_SWD = 3128 * MiB  , WS_END = 3132 * MiB;
constexpr int PADROWS = T * TOPK + NE * 256;
static_assert((size_t)PADROWS * DFF * 2 <= 272 * MiB, "H / YS size");
constexpr int CW_SA = 128;
constexpr int CW_CNT = 256;
constexpr int CW_BAR = 4096;

constexpr int RING_BYTES = 133120;
constexpr int TILE_E_OFF = 131072;
constexpr int SCL_OFF = RING_BYTES;
constexpr int MISC_OFF = SCL_OFF + 24576;
constexpr int LDS_BYTES = 163840;

#define GAS __attribute__((address_space(1)))
#define LAS __attribute__((address_space(3)))
#define CAS __attribute__((address_space(4)))
typedef unsigned short bf16_t;
typedef short bf16x8 __attribute__((ext_vector_type(8)));
typedef short s16x4 __attribute__((ext_vector_type(4)));
typedef float f32x2 __attribute__((ext_vector_type(2)));
typedef float f32x4 __attribute__((ext_vector_type(4)));
typedef float f32x16 __attribute__((ext_vector_type(16)));
typedef unsigned u32x2 __attribute__((ext_vector_type(2)));
typedef unsigned u32x4 __attribute__((ext_vector_type(4)));

__device__ __forceinline__ unsigned cvt_pk_bf16(float lo, float hi) { unsigned r; asm volatile("v_cvt_pk_bf16_f32 %0, %1, %2" : "=v"(r) : "v"(lo), "v"(hi)); return r; }
__device__ __forceinline__ float bf_lo(unsigned w) { return __uint_as_float(w << 16); }
__device__ __forceinline__ float bf_hi(unsigned w) { return __uint_as_float(w & 0xffff0000u); }
__device__ __forceinline__ float sigmoidf_(float x) { return __builtin_amdgcn_rcpf(1.0f + __expf(-x)); }
__device__ __forceinline__ float gelu_tanh(float x) { const float u = 0.7978845608028654f * (x + 0.044715f * x * x * x); const float t = 1.0f - 2.0f * __builtin_amdgcn_rcpf(1.0f + __expf(2.0f * u)); return 0.5f * x * (1.0f + t); }
__device__ __forceinline__ u32x4 pack8(const f32x4 a, const f32x4 b) { u32x4 w; w.x = cvt_pk_bf16(a[0], a[1]); w.y = cvt_pk_bf16(a[2], a[3]); w.z = cvt_pk_bf16(b[0], b[1]); w.w = cvt_pk_bf16(b[2], b[3]); return w; }
__device__ __forceinline__ float KF(float v) { asm volatile("" : "+s"(v)); return v; }
__device__ __forceinline__ int opaque_tid() { int t = threadIdx.x; asm volatile("" : "+v"(t)); return t; }
__device__ __forceinline__ float wave_sum(float v) {
#pragma unroll
    for (int o = 1; o < 64; o <<= 1) v += __shfl_xor(v, o);
    return v;
}

namespace pg8 {
#define PG8_LAS __attribute__((address_space(3)))
constexpr int BM = 256, BK = 64, HALF = 128, HTB = HALF * BK * 2, STAGE_BYTES = 8 * HTB;
__host__ __device__ __forceinline__ int lds_byte(int r, int c) { const int st = (r >> 4) * 2 + (c >> 5), rr = r & 15, cc = c & 31, ob = rr * 64 + cc * 2; return st * 1024 + (ob ^ (((ob >> 9) & 1) << 5)); }
__host__ __device__ __forceinline__ void stage_rc(int b, int& R, int& C) { const int st = b / 1024, sb = b % 1024, swz = sb ^ (((sb >> 9) & 1) << 5); R = (st >> 1) * 16 + swz / 64; C = (st & 1) * 32 + (swz % 64) / 2; }
__host__ __device__ __forceinline__ int perm32(int rho) { const int n = rho >> 4, i = rho & 15; return 8 * (i >> 2) + 4 * n + (i & 3); }

struct Unit { const char* A; const char* B; const char* S; const char* SA; const int* lst; int nvalid; int pm, pn, aux; };

typedef int v4i_t __attribute__((ext_vector_type(4)));
typedef int v8i_t __attribute__((ext_vector_type(8)));
template <class Epi, class Sched, bool GATHER, int FPM = 0>
__device__ __forceinline__ void gemm_phase(PG8_LAS unsigned char* lds, const int nt  , const int lda  , const int ldb  , const Sched& S, const Epi& E, unsigned long long* pw = nullptr, const int sa = 0x7f7f7f7f) {
    constexpr bool FP8 = FPM != 0;
    const int tid = opaque_tid(), wid = __builtin_amdgcn_readfirstlane(tid >> 6), lane = tid & 63, wr = wid >> 2, wc = wid & 3, fr = lane & 15, fq = lane >> 4;
    unsigned voffB[2], ocA[2][2], onA[2][2];
#pragma unroll
    for (int i = 0; i < 2; ++i) { int R, C; stage_rc(tid * 16 + i * 8192, R, C); const int Rb = Epi::PERM ? ((R & ~31) + perm32(R & 31)) : R;
        voffB[i] = (unsigned)(Rb * ldb + C * 2);
        ocA[0][i] = (unsigned)(R * lda + C * 2); ocA[1][i] = (unsigned)((R + HALF) * lda + C * 2); onA[0][i] = ocA[0][i]; onA[1][i] = ocA[1][i]; }
    constexpr unsigned kstep = BK * 2;
    const unsigned hstepB = (unsigned)HALF * ldb;
    const unsigned ldsw = (unsigned)wid * 1024u;
    const int aoff = lds_byte(wr * 64 + fr, fq * 8), boff = lds_byte(wc * 32 + fr, fq * 8);
#define PG8_SA(b, h) (((b) * 2 + (h)) * HTB)
#define PG8_SB(b, h) ((4 + (b) * 2 + (h)) * HTB)
#define PG8_STAGE(bufoff, gbase, voff, kb) do { _Pragma("unroll") for (int _i = 0; _i < 2; ++_i) \
        __builtin_amdgcn_global_load_lds((const unsigned*)((const char*)(gbase) + (size_t)(unsigned)((voff)[_i] + (unsigned)(kb))), (PG8_LAS unsigned*)(lds + (bufoff) + ldsw + _i * 8192), 16, 0, 0); } while (0)
#define PG8_CAT(x0, x1) __builtin_shufflevector(x0, x1, 0, 1, 2, 3, 4, 5, 6, 7)
#define PG8_LO(x) __builtin_bit_cast(bf16x8, __builtin_shufflevector(x, x, 0, 1, 2, 3))
#define PG8_HI(x) __builtin_bit_cast(bf16x8, __builtin_shufflevector(x, x, 4, 5, 6, 7))
    const PG8_LAS unsigned char* const ldsA = lds + aoff; const PG8_LAS unsigned char* const ldsB = lds + 4 * HTB + boff;
#define PG8_LDA(dst, b, h) do { _Pragma("unroll") for (int m = 0; m < 4; ++m) dst[m] = PG8_CAT(*(const PG8_LAS v4i_t*)(ldsA + (PG8_SA(b, h) + m * 2048)), *(const PG8_LAS v4i_t*)(ldsA + (PG8_SA(b, h) + m * 2048 + 1024))); } while (0)
#define PG8_LDB(dst, b, h) do { _Pragma("unroll") for (int n = 0; n < 2; ++n) dst[n] = PG8_CAT(*(const PG8_LAS v4i_t*)(ldsB + (PG8_SB(b, h) - 4 * HTB + n * 2048)), *(const PG8_LAS v4i_t*)(ldsB + (PG8_SB(b, h) - 4 * HTB + n * 2048 + 1024))); } while (0)
#define PG8_MMA(ai, bj, At, Bt) do { __builtin_amdgcn_s_setprio(1); \
        if constexpr (FP8) { asm volatile("s_nop 4" ::: "memory"); _Pragma("unroll") for (int m = 0; m < 4; ++m) _Pragma("unroll") for (int n = 0; n < 2; ++n) \
            asm volatile("v_mfma_scale_f32_16x16x128_f8f6f4 %0, %1, %2, %0, %3, %4 op_sel_hi:[0,0,0]" : "+v"(acc[ai][bj][m][n]) : "v"(Bt[n]), "v"(At[m]), "v"(sB[bj][n]), "v"(FPM == 2 ? sA[m] : sav)); } \
        else { _Pragma("unroll") for (int m = 0; m < 4; ++m) _Pragma("unroll") for (int n = 0; n < 2; ++n) { \
            acc[ai][bj][m][n] = __builtin_amdgcn_mfma_f32_16x16x32_bf16(PG8_LO(Bt[n]), PG8_LO(At[m]), acc[ai][bj][m][n], 0, 0, 0); \
            acc[ai][bj][m][n] = __builtin_amdgcn_mfma_f32_16x16x32_bf16(PG8_HI(Bt[n]), PG8_HI(At[m]), acc[ai][bj][m][n], 0, 0, 0); } } \
        __builtin_amdgcn_s_setprio(0); } while (0)
    int sB[2][2] = {{0x7f, 0x7f}, {0x7f, 0x7f}}; int sav; asm volatile("v_mov_b32 %0, %1" : "=v"(sav) : "s"(sa));
    int sA[4] = {0x7f, 0x7f, 0x7f, 0x7f};
    const int scol = wc * 32 + (Epi::PERM ? 8 * (fr >> 2) + (fr & 3) : fr);
    const int sbase = FPM == 2 ? SCL_OFF + 16384 + scol * 2 + (fq >> 1) : SCL_OFF + scol * 4 + fq;
    const int sabase = SCL_OFF + ((wr * 64 + fr) << 2) + fq;
#define PG8_LDS_SCL(par_, kt_) do { if constexpr (FP8) { \
        const PG8_LAS unsigned char* sp_ = (const PG8_LAS unsigned char*)lds + sbase + (FPM == 2 ? (par_) * 4096 + (kt_) * 512 : (par_) * 8192 + (kt_) * 1024); \
        _Pragma("unroll") for (int bj_ = 0; bj_ < 2; ++bj_) _Pragma("unroll") for (int n_ = 0; n_ < 2; ++n_) sB[bj_][n_] = (int)sp_[(bj_ * 128 + n_ * (Epi::PERM ? 4 : 16)) * (FPM == 2 ? 2 : 4)]; } } while (0)
#define PG8_LDS_SCA(par_, kt_, ai_) do { if constexpr (FPM == 2) { const PG8_LAS unsigned char* sp_ = (const PG8_LAS unsigned char*)lds + sabase + (par_) * 8192 + (kt_) * 1024 + (ai_) * 512; \
        _Pragma("unroll") for (int m_ = 0; m_ < 4; ++m_) sA[m_] = (int)sp_[m_ * 64]; } } while (0)
#define PG8_DMA_SCL(u_, par_) do { if constexpr (FPM == 1) __builtin_amdgcn_global_load_lds((const unsigned*)((u_).S + wid * 1024 + lane * 16), (PG8_LAS unsigned*)(lds + SCL_OFF + (par_) * 8192 + wid * 1024), 16, 0, 0); \
        if constexpr (FPM == 2) { __builtin_amdgcn_global_load_lds((const unsigned*)((u_).SA + wid * 1024 + lane * 16), (PG8_LAS unsigned*)(lds + SCL_OFF + (par_) * 8192 + wid * 1024), 16, 0, 0); \
            if (wid < 4) __builtin_amdgcn_global_load_lds((const unsigned*)((u_).S + wid * 1024 + lane * 16), (PG8_LAS unsigned*)(lds + SCL_OFF + 16384 + (par_) * 4096 + wid * 1024), 16, 0, 0); } } while (0)
#define PG8_WAIT_V(n) asm volatile("s_waitcnt vmcnt(" #n ")" ::: "memory")
#define PG8_WAIT_L(n) asm volatile("s_waitcnt lgkmcnt(" #n ")" ::: "memory")
#define PG8_BAR __builtin_amdgcn_s_barrier()
#define PG8_SCHED __builtin_amdgcn_sched_barrier(0)
#define PG8_GOFFS(u, o) do { _Pragma("unroll") for (int _h = 0; _h < 2; ++_h) _Pragma("unroll") for (int _i = 0; _i < 2; ++_i) { int gR_, gC_; stage_rc(tid * 16 + _i * 8192, gR_, gC_); int _r = _h * HALF + gR_; _r = _r < (u).nvalid ? _r : (u).nvalid - 1; \
        const int _tok = (u).lst[_r]; (o)[_h][_i] = (unsigned)_tok * (unsigned)lda + (unsigned)(gC_ * 2); } } while (0)
#define PG8_GRAW(u, tk) do {   _Pragma("unroll") for (int _h = 0; _h < 2; ++_h) _Pragma("unroll") for (int _i = 0; _i < 2; ++_i) { int gR_, gC_; stage_rc(tid * 16 + _i * 8192, gR_, gC_); int _r = _h * HALF + gR_; _r = _r < (u).nvalid ? _r : (u).nvalid - 1; (tk)[_h][_i] = (unsigned)(u).lst[_r]; } } while (0)
    Unit cur, nxt, nn; int ui = 0;
#if PROBE_T
    unsigned long long pk_ = 0, pe_ = 0, pt0_ = 0, pn_ = 0; const unsigned long long pst_ = __builtin_amdgcn_s_memtime();
#endif
    if (!S.next(0, cur)) return;
    f32x4 acc[2][2][4][2];
#pragma unroll
    for (int a = 0; a < 2; ++a)
#pragma unroll
        for (int b = 0; b < 2; ++b)
#pragma unroll
            for (int m = 0; m < 4; ++m)
#pragma unroll
                for (int n = 0; n < 2; ++n) acc[a][b][m][n] = (f32x4){0.f, 0.f, 0.f, 0.f};
    v8i_t At[4], B0[2], B1[2];
    const char* cA = cur.A; const char* cB = cur.B;
    bool has_next = S.next(1, nxt);
    if constexpr (GATHER) { PG8_GOFFS(cur, ocA);
        if (has_next) { PG8_GOFFS(nxt, onA); }
        else {
#pragma unroll
            for (int h = 0; h < 2; ++h)
#pragma unroll
                for (int i = 0; i < 2; ++i) onA[h][i] = ocA[h][i]; } }
    PG8_DMA_SCL(cur, 0); if (has_next) PG8_DMA_SCL(nxt, 1);
    PG8_STAGE(PG8_SB(0, 0), cB, voffB, 0u); PG8_STAGE(PG8_SB(0, 1), cB, voffB, hstepB); PG8_STAGE(PG8_SA(0, 0), cA, ocA[0], 0u); PG8_STAGE(PG8_SA(0, 1), cA, ocA[1], 0u);
    if (wr == 1) PG8_BAR;
    PG8_WAIT_V(2); PG8_BAR;
    PG8_STAGE(PG8_SB(1, 0), cB, voffB, kstep); PG8_STAGE(PG8_SA(1, 0), cA, ocA[0], kstep); PG8_STAGE(PG8_SB(1, 1), cB, voffB, hstepB + kstep);
    PG8_WAIT_V(6); PG8_BAR;
    for (;;) {
        const char* nA = has_next ? nxt.A : cA; const char* nB = has_next ? nxt.B : cB;
#if PROBE_T
        pt0_ = __builtin_amdgcn_s_memtime();
#endif
#pragma unroll 1
        for (int t = 0; t < nt; t += 2) {
            const bool last = (t == nt - 2);
            const unsigned k1 = (unsigned)(t + 1) * kstep, k2 = last ? 0u : (unsigned)(t + 2) * kstep, k3 = k2 + kstep;
            const char* a2 = last ? nA : cA; const char* b2 = last ? nB : cB;
#define PG8_STAGE_A2(bufoff, h_, kb_) do { if (GATHER && last) PG8_STAGE(bufoff, a2, onA[h_], kb_); else PG8_STAGE(bufoff, a2, ocA[h_], kb_); } while (0)
            PG8_LDB(B0, 0, 0); PG8_LDB(B1, 0, 1); PG8_LDS_SCL(ui & 1, t); PG8_SCHED; PG8_LDA(At, 0, 0); PG8_LDS_SCA(ui & 1, t, 0); PG8_STAGE(PG8_SA(1, 1), cA, ocA[1], k1);
            PG8_WAIT_V(8); PG8_WAIT_L(0); PG8_BAR; PG8_MMA(0, 0, At, B0); PG8_MMA(0, 1, At, B1); PG8_BAR; PG8_SCHED;
            PG8_LDA(At, 0, 1); PG8_LDS_SCA(ui & 1, t, 1); PG8_STAGE(PG8_SB(0, 0), b2, voffB, k2); PG8_STAGE(PG8_SB(0, 1), b2, voffB, hstepB + k2); PG8_STAGE_A2(PG8_SA(0, 0), 0, k2);
            PG8_WAIT_V(8); PG8_WAIT_L(0); PG8_BAR; PG8_MMA(1, 0, At, B0); PG8_MMA(1, 1, At, B1); PG8_BAR; PG8_SCHED;
            PG8_LDB(B0, 1, 0); PG8_LDB(B1, 1, 1); PG8_LDS_SCL(ui & 1, t + 1); PG8_SCHED; PG8_LDA(At, 1, 0); PG8_LDS_SCA(ui & 1, t + 1, 0); PG8_STAGE_A2(PG8_SA(0, 1), 1, k2);
            PG8_WAIT_V(8); PG8_WAIT_L(0); PG8_BAR; PG8_MMA(0, 0, At, B0); PG8_MMA(0, 1, At, B1); PG8_BAR; PG8_SCHED;
            PG8_LDA(At, 1, 1); PG8_LDS_SCA(ui & 1, t + 1, 1); PG8_STAGE(PG8_SB(1, 0), b2, voffB, k3); PG8_STAGE(PG8_SB(1, 1), b2, voffB, hstepB + k3); PG8_STAGE_A2(PG8_SA(1, 0), 0, k3);
            PG8_WAIT_V(8); PG8_WAIT_L(0); PG8_BAR; PG8_MMA(1, 0, At, B0); PG8_MMA(1, 1, At, B1); PG8_BAR; PG8_SCHED;
        }
#if PROBE_T
        const unsigned long long pt1_ = __builtin_amdgcn_s_memtime(); pk_ += pt1_ - pt0_;
#endif
        if constexpr (FP8) asm volatile("s_nop 15\n\ts_nop 7" ::: "memory");
        const bool has_nn = has_next && S.next(ui + 2, nn);
        if constexpr (GATHER) {
#pragma unroll
            for (int h = 0; h < 2; ++h)
#pragma unroll
                for (int i = 0; i < 2; ++i) ocA[h][i] = onA[h][i];
            if (has_nn) { PG8_GRAW(nn, onA); } }
        if (wr == 0) PG8_BAR;
        E(acc, cur, wr, wc, fr, fq);
#if PROBE_T
        asm volatile("s_waitcnt vmcnt(0)" ::: "memory"); pe_ += __builtin_amdgcn_s_memtime() - pt1_; ++pn_;
#endif
        if (!has_next) break;
#pragma unroll
        for (int a = 0; a < 2; ++a)
#pragma unroll
            for (int b = 0; b < 2; ++b)
#pragma unroll
                for (int m = 0; m < 4; ++m)
#pragma unroll
                    for (int n = 0; n < 2; ++n) acc[a][b][m][n] = (f32x4){0.f, 0.f, 0.f, 0.f};
        cur = nxt; cA = nA; cB = nB; ++ui;
        if constexpr (GATHER) { if (has_nn) {
#pragma unroll
            for (int h = 0; h < 2; ++h)
#pragma unroll
                for (int i = 0; i < 2; ++i) { int gR_, gC_; stage_rc(tid * 16 + i * 8192, gR_, gC_); onA[h][i] = onA[h][i] * (unsigned)lda + (unsigned)(gC_ * 2); } } }
        if (has_nn) { nxt = nn; PG8_DMA_SCL(nxt, (ui + 1) & 1); }
        has_next = has_nn;
        if (wr == 1) PG8_BAR;
    }
    PG8_WAIT_V(0);
    PG8_BAR;
#if PROBE_T
    if (pw && blockIdx.x == 0 && tid == 0) { pw[0] += pk_; pw[1] += pe_; pw[2] += pn_; pw[3] += __builtin_amdgcn_s_memtime() - pst_; }
#endif
#undef PG8_SA
#undef PG8_SB
#undef PG8_STAGE
#undef PG8_LDA
#undef PG8_LDB
#undef PG8_MMA
#undef PG8_WAIT_V
#undef PG8_WAIT_L
#undef PG8_BAR
#undef PG8_SCHED
#undef PG8_GOFFS
#undef PG8_GRAW
#undef PG8_STAGE_A2
#undef PG8_CAT
#undef PG8_LO
#undef PG8_HI
#undef PG8_LDS_SCL
#undef PG8_LDS_SCA
#undef PG8_DMA_SCL
}

constexpr int NXCD = 8, WGM = 8;
struct DenseSched {
    const char* A; const char* B; int lda, ldb; int nM, nN, nwg, G, c; int apn_shift, akbytes, bpm_shift; size_t bbatch;
    __device__ __forceinline__ void init(const void* A_, const void* B_, int lda_, int ldb_, int M, int N, int G_, int c_) {
        A = (const char*)A_; B = (const char*)B_; lda = lda_; ldb = ldb_; nM = M / BM; nN = N / BM; nwg = nM * nN; G = G_; c = c_; apn_shift = -1; akbytes = 0; bpm_shift = -1; bbatch = 0; }
    __device__ __forceinline__ bool next(int i, Unit& u) const {
        const long L = (long)i * G + c; if (L >= nwg) return false;
        int wgid = (int)L; { const int q = nwg / NXCD, r = nwg % NXCD, xcd = wgid % NXCD, off = wgid / NXCD; wgid = (xcd < r ? xcd * (q + 1) : r * (q + 1) + (xcd - r) * q) + off; }
        const int nig = WGM * nN, gid = wgid / nig, fm = gid * WGM, gsz = (nM - fm) < WGM ? (nM - fm) : WGM;
        const int pm = fm + ((wgid % nig) % gsz), pn = (wgid % nig) / gsz;
        u.pm = pm; u.pn = pn; u.aux = 0; u.lst = nullptr; u.nvalid = 256; u.S = nullptr; u.SA = nullptr;
        u.A = A + (size_t)pm * 256 * lda * 2 + (apn_shift >= 0 ? (size_t)(pn >> apn_shift) * akbytes : (size_t)0);
        u.B = B + (size_t)pn * 256 * ldb * 2 + (bpm_shift >= 0 ? (size_t)(pm >> bpm_shift) * bbatch : (size_t)0);
        return true;
    }
};
struct MoeSched {
    const char* A; const char* B; size_t bexp; const char* SW; int lda, ldb  , nN; const int* lists; volatile LAS const int* tab; volatile LAS const unsigned char* te; int G, c; bool gather; const char* SA;
    __device__ __forceinline__ bool next(int i, Unit& u) const {
        int pn, mg;
        if (G == 256) {
            const int x = c & 7, jj = c >> 3, pgs = nN >> 2, mgs = 8 / pgs;
            mg = i * (8 * mgs) + 8 * (x / pgs) + (jj & 7); pn = 4 * (x % pgs) + (jj >> 3);
            if (mg >= __builtin_amdgcn_readfirstlane(tab[32])) return false;
        } else { const int total = __builtin_amdgcn_readfirstlane(tab[32]) * nN; const long L = (long)i * G + c; if (L >= total) return false; pn = (int)(L % nN); mg = (int)(L / nN); }
        const int e = __builtin_amdgcn_readfirstlane((int)te[mg]), mt = mg - __builtin_amdgcn_readfirstlane(tab[e]);
        u.pm = mg; u.pn = pn; u.aux = e;
        if (gather) { u.A = A; u.lst = lists + (size_t)e * T + mt * 256; const int rem = __builtin_amdgcn_readfirstlane(tab[48 + e]) - mt * 256; u.nvalid = rem < 256 ? rem : 256; }
        else { u.A = A + (size_t)mg * 256 * lda; u.lst = nullptr; u.nvalid = 256; }
        u.B = B + (size_t)e * bexp + (size_t)pn * 256 * ldb; u.S = SW ? (SA ? SW + ((size_t)e * 4 + pn) * 4096 : SW + ((size_t)e * 8 + pn) * 8192) : nullptr; u.SA = SA ? SA + (size_t)mg * 8192 : nullptr;
        return true;
    }
};

#define EPI_ROW(u, ai, m) ((u).pm * 256 + (ai) * 128 + wr * 64 + (m) * 16 + fr)
struct EpiLat {
    static constexpr bool PERM = true;
    bf16_t* LAT; float* SSQ; bf16_t* KR; const float* CS; const float* SN;
    __device__ __forceinline__ void operator()(const f32x4 (&acc)[2][2][4][2], const Unit& u, int wr, int wc, int fr, int fq) const {
        if (u.pn < 4) {
#pragma unroll
            for (int ai = 0; ai < 2; ++ai)
#pragma unroll
                for (int m = 0; m < 4; ++m) { const int row = EPI_ROW(u, ai, m); float ss = 0.f;
#pragma unroll
                    for (int bj = 0; bj < 2; ++bj) { const f32x4 v0 = acc[ai][bj][m][0], v1 = acc[ai][bj][m][1];
                        ss += (v0[0] * v0[0] + v0[1] * v0[1]) + (v0[2] * v0[2] + v0[3] * v0[3]) + (v1[0] * v1[0] + v1[1] * v1[1]) + (v1[2] * v1[2] + v1[3] * v1[3]);
                        *(u32x4*)(LAT + (size_t)row * 1024 + u.pn * 256 + bj * 128 + wc * 32 + 8 * fq) = pack8(v0, v1); }
                    ss += __shfl_xor(ss, 16); ss += __shfl_xor(ss, 32);
                    if (fq == 0) SSQ[(size_t)row * 16 + u.pn * 4 + wc] = ss; }
        } else if (wc == 0) {
#pragma unroll
            for (int ai = 0; ai < 2; ++ai)
#pragma unroll
                for (int m = 0; m < 4; ++m) { const int row = EPI_ROW(u, ai, m);
                    const f32x4 c0 = *(const f32x4*)(CS + (size_t)row * 32 + 8 * fq), c1 = *(const f32x4*)(CS + (size_t)row * 32 + 8 * fq + 4);
                    const f32x4 s0 = *(const f32x4*)(SN + (size_t)row * 32 + 8 * fq), s1 = *(const f32x4*)(SN + (size_t)row * 32 + 8 * fq + 4);
                    const f32x4 a0 = acc[ai][0][m][0], a1 = acc[ai][0][m][1], b0 = acc[ai][1][m][0], b1 = acc[ai][1][m][1];
                    *(u32x4*)(KR + (size_t)row * 64 + 8 * fq) = pack8(a0 * c0 - b0 * s0, a1 * c1 - b1 * s1);
                    *(u32x4*)(KR + (size_t)row * 64 + 32 + 8 * fq) = pack8(b0 * c0 + a0 * s0, b1 * c1 + a1 * s1); }
        }
    }
};
struct EpiQ {
    static constexpr bool PERM = true;
    bf16_t* Q; const float* SSQ; const float* CS; const float* SN;
    __device__ __forceinline__ void operator()(const f32x4 (&acc)[2][2][4][2], const Unit& u, int wr, int wc, int fr, int fq) const {
#pragma unroll
        for (int ai = 0; ai < 2; ++ai)
#pragma unroll
            for (int m = 0; m < 4; ++m) { const int row = EPI_ROW(u, ai, m);
                const f32x4 q0 = *(const f32x4*)(SSQ + (size_t)row * 16), q1 = *(const f32x4*)(SSQ + (size_t)row * 16 + 4), q2 = *(const f32x4*)(SSQ + (size_t)row * 16 + 8);
                const float ss = ((q0[0] + q0[1]) + (q0[2] + q0[3])) + ((q1[0] + q1[1]) + (q1[2] + q1[3])) + ((q2[0] + q2[1]) + (q2[2] + q2[3]));
                const float r = QSCALE / sqrtf(ss * (1.0f / QL) + KF(RMS_EPS));
                if (u.pn < 4) {
#pragma unroll
                    for (int bj = 0; bj < 2; ++bj)
                        *(u32x4*)(Q + (size_t)row * 1536 + (2 * u.pn + bj) * 192 + wc * 32 + 8 * fq) = pack8(acc[ai][bj][m][0] * r, acc[ai][bj][m][1] * r);
                } else {
                    const int head = 4 * (u.pn - 4) + wc;
                    const f32x4 c0 = *(const f32x4*)(CS + (size_t)row * 32 + 8 * fq), c1 = *(const f32x4*)(CS + (size_t)row * 32 + 8 * fq + 4);
                    const f32x4 s0 = *(const f32x4*)(SN + (size_t)row * 32 + 8 * fq), s1 = *(const f32x4*)(SN + (size_t)row * 32 + 8 * fq + 4);
                    const f32x4 a0 = acc[ai][0][m][0] * r, a1 = acc[ai][0][m][1] * r, b0 = acc[ai][1][m][0] * r, b1 = acc[ai][1][m][1] * r;
                    *(u32x4*)(Q + (size_t)row * 1536 + head * 192 + 128 + 8 * fq) = pack8(a0 * c0 - b0 * s0, a1 * c1 - b1 * s1);
                    *(u32x4*)(Q + (size_t)row * 1536 + head * 192 + 160 + 8 * fq) = pack8(b0 * c0 + a0 * s0, b1 * c1 + a1 * s1);
                }
                asm volatile("" ::: "memory"); }
    }
};
struct EpiKV {
    static constexpr bool PERM = true;
    bf16_t* KN; bf16_t* V; const float* SSQ;
    __device__ __forceinline__ void operator()(const f32x4 (&acc)[2][2][4][2], const Unit& u, int wr, int wc, int fr, int fq) const {
#pragma unroll
        for (int ai = 0; ai < 2; ++ai)
#pragma unroll
            for (int m = 0; m < 4; ++m) { const int row = EPI_ROW(u, ai, m);
                const f32x4 q3 = *(const f32x4*)(SSQ + (size_t)row * 16 + 12);
                const float r = 1.0f / sqrtf(((q3[0] + q3[1]) + (q3[2] + q3[3])) * (1.0f / KVL) + KF(RMS_EPS));
                *(u32x4*)(KN + (size_t)row * 1024 + u.pn * 128 + wc * 32 + 8 * fq) = pack8(acc[ai][0][m][0] * r, acc[ai][0][m][1] * r);
                *(u32x4*)(V + (size_t)row * 1024 + u.pn * 128 + wc * 32 + 8 * fq) = pack8(acc[ai][1][m][0] * r, acc[ai][1][m][1] * r); }
    }
};
__device__ __forceinline__ f32x4 bf4_lo(const u32x4 w) { return (f32x4){bf_lo(w.x), bf_hi(w.x), bf_lo(w.y), bf_hi(w.y)}; }
__device__ __forceinline__ f32x4 bf4_hi(const u32x4 w) { return (f32x4){bf_lo(w.z), bf_hi(w.z), bf_lo(w.w), bf_hi(w.w)}; }
struct EpiRes {
    static constexpr bool PERM = true;
    const bf16_t* X; bf16_t* Y;
    __device__ __forceinline__ void operator()(const f32x4 (&acc)[2][2][4][2], const Unit& u, int wr, int wc, int fr, int fq) const {
#pragma unroll
        for (int ai = 0; ai < 2; ++ai)
#pragma unroll
            for (int m = 0; m < 4; ++m) { const size_t off = (size_t)EPI_ROW(u, ai, m) * 1024 + u.pn * 256 + wc * 32 + 8 * fq;
#pragma unroll
                for (int bj = 0; bj < 2; ++bj) { const u32x4 xw = *(const u32x4*)(X + off + bj * 128);
                    *(u32x4*)(Y + off + bj * 128) = pack8(bf4_lo(xw) * ALPHA + acc[ai][bj][m][0], bf4_hi(xw) * ALPHA + acc[ai][bj][m][1]); }
                if (m & 1) asm volatile("" ::: "memory"); }
    }
};
struct EpiGU {
    static constexpr bool PERM = true;
    bf16_t* GG; bf16_t* U;
    __device__ __forceinline__ void operator()(const f32x4 (&acc)[2][2][4][2], const Unit& u, int wr, int wc, int fr, int fq) const {
#pragma unroll
        for (int ai = 0; ai < 2; ++ai)
#pragma unroll
            for (int m = 0; m < 4; ++m) { const int row = EPI_ROW(u, ai, m);
#pragma unroll
                for (int bj = 0; bj < 2; ++bj) { f32x4 v0 = acc[ai][bj][m][0], v1 = acc[ai][bj][m][1];
                    if (u.pn < 4) {
#pragma unroll
                        for (int e = 0; e < 4; ++e) { v0[e] = gelu_tanh(v0[e]); v1[e] = gelu_tanh(v1[e]); }
                        *(u32x4*)(GG + (size_t)row * 1024 + u.pn * 256 + bj * 128 + wc * 32 + 8 * fq) = pack8(v0, v1);
                    } else *(u32x4*)(U + (size_t)row * 1024 + (u.pn - 4) * 256 + bj * 128 + wc * 32 + 8 * fq) = pack8(v0, v1); } }
    }
};
struct EpiAB {
    static constexpr bool PERM = true;
    bf16_t* LA; bf16_t* BB; const bf16_t* UC; const float* BA; const float* BX; const float* SPL;
    __device__ __forceinline__ void operator()(const f32x4 (&acc)[2][2][4][2], const Unit& u, int wr, int wc, int fr, int fq) const {
        const int ch = (u.pn >> 1) * 256 + (u.pn & 1) * 128 + wc * 32 + 8 * fq;
        const float c3 = KF(0.16666667f), c4 = KF(0.041666668f), c5 = KF(0.0083333338f);
        f32x4 ba[2], bx[2], sp[2];
#pragma unroll
        for (int n = 0; n < 2; ++n) { ba[n] = *(const f32x4*)(BA + ch + 4 * n); bx[n] = *(const f32x4*)(BX + ch + 4 * n); sp[n] = *(const f32x4*)(SPL + ch + 4 * n); }
#pragma unroll
        for (int ai = 0; ai < 2; ++ai)
#pragma unroll
            for (int m = 0; m < 4; ++m) { const size_t off = (size_t)EPI_ROW(u, ai, m) * 1024 + ch;
                const u32x4 uw = *(const u32x4*)(UC + off); f32x4 uv[2] = {bf4_lo(uw), bf4_hi(uw)}, lv[2], bv[2];
#pragma unroll
                for (int n = 0; n < 2; ++n)
#pragma unroll
                    for (int e = 0; e < 4; ++e) { const float r = sigmoidf_(acc[ai][0][m][n][e] + ba[n][e]), ig = sigmoidf_(acc[ai][1][m][n][e] + bx[n][e]);
                        const float la = sp[n][e] * r, x2 = 2.0f * la; lv[n][e] = la * 1.4426950408889634f;
                        const float om = x2 > -0.25f ? -x2 * (1.0f + x2 * (0.5f + x2 * (c3 + x2 * (c4 + x2 * c5)))) : 1.0f - __expf(x2);
                        bv[n][e] = sqrtf(om) * ig * uv[n][e]; }
                *(u32x4*)(LA + off) = pack8(lv[0], lv[1]); *(u32x4*)(BB + off) = pack8(bv[0], bv[1]); asm volatile("" ::: "memory"); }
    }
};
struct EpiUp {
    static constexpr bool PERM = true;
    unsigned char* H; unsigned char* SH; const float* BU;
    __device__ __forceinline__ void operator()(f32x4 (&acc)[2][2][4][2], const Unit& u, int wr, int wc, int fr, int fq) const {
        const int gc = u.pn * 128 + wc * 32 + 8 * fq; const float* bu = BU + (size_t)u.aux * 2048;
        const float k7 = KF(7.0f), km7 = KF(-7.0f), ka = KF(1.702f);
#pragma unroll
        for (int n = 0; n < 2; ++n) { const f32x4 bg = *(const f32x4*)(bu + gc + 4 * n), bp = *(const f32x4*)(bu + 1024 + gc + 4 * n);
#pragma unroll
            for (int ai = 0; ai < 2; ++ai)
#pragma unroll
                for (int m = 0; m < 4; ++m) {
#pragma unroll
                    for (int e = 0; e < 4; ++e) { const float g = fminf(acc[ai][0][m][n][e] + bg[e], k7), up = fminf(fmaxf(acc[ai][1][m][n][e] + bp[e], km7), k7);
                        acc[ai][0][m][n][e] = (up + 1.0f) * (g * sigmoidf_(ka * g)); }
                    if (m & 1) __builtin_amdgcn_sched_barrier(0); }
            asm volatile("" ::: "memory"); }
        unsigned char* const shb = SH + ((size_t)u.pm * 8 + u.pn) * 1024; unsigned char* const hb = H + (size_t)u.pm * 256 * 1024;
        const unsigned ho = (unsigned)((wr * 64 + fr) * 1024 + gc), so = (unsigned)((wr * 64 + fr) * 4 + wc);
#pragma unroll
        for (int ai = 0; ai < 2; ++ai)
#pragma unroll
            for (int m = 0; m < 4; ++m) { const f32x4 y0 = acc[ai][0][m][0], y1 = acc[ai][0][m][1];
                float am = fmaxf(fmaxf(fmaxf(fabsf(y0[0]), fabsf(y0[1])), fmaxf(fabsf(y0[2]), fabsf(y0[3]))), fmaxf(fmaxf(fabsf(y1[0]), fabsf(y1[1])), fmaxf(fabsf(y1[2]), fabsf(y1[3]))));
                { auto r16 = __builtin_amdgcn_permlane16_swap(__float_as_uint(am), __float_as_uint(am), false, false); am = fmaxf(__uint_as_float(r16[0]), __uint_as_float(r16[1]));
                  auto r32 = __builtin_amdgcn_permlane32_swap(__float_as_uint(am), __float_as_uint(am), false, false); am = fmaxf(__uint_as_float(r32[0]), __uint_as_float(r32[1])); }
                int eb = (int)((__float_as_uint(am) >> 23) & 0xffu) - 7; eb = eb < 1 ? 1 : eb;
                const float inv = __uint_as_float((unsigned)(254 - eb) << 23);
                int w0 = __builtin_amdgcn_cvt_pk_fp8_f32(y0[0] * inv, y0[1] * inv, 0, false); w0 = __builtin_amdgcn_cvt_pk_fp8_f32(y0[2] * inv, y0[3] * inv, w0, true);
                int w1 = __builtin_amdgcn_cvt_pk_fp8_f32(y1[0] * inv, y1[1] * inv, 0, false); w1 = __builtin_amdgcn_cvt_pk_fp8_f32(y1[2] * inv, y1[3] * inv, w1, true);
                *(u32x2*)(hb + (ho + (unsigned)((ai * 128 + m * 16) * 1024))) = (u32x2){(unsigned)w0, (unsigned)w1};
                if (fq == 0) shb[so + (unsigned)((ai * 128 + m * 16) * 4)] = (unsigned char)eb;
                asm volatile("" ::: "memory"); __builtin_amdgcn_sched_barrier(0); }
    }
};
struct EpiDown {
    static constexpr bool PERM = true;
    bf16_t* YS; const float* BD;
    __device__ __forceinline__ void operator()(const f32x4 (&acc)[2][2][4][2], const Unit& u, int wr, int wc, int fr, int fq) const {
        const float* bd = BD + (size_t)u.aux * 1024;
#pragma unroll
        for (int bj = 0; bj < 2; ++bj) { const int col = u.pn * 256 + bj * 128 + wc * 32 + 8 * fq; const f32x4 b0 = *(const f32x4*)(bd + col), b1 = *(const f32x4*)(bd + col + 4);
#pragma unroll
            for (int ai = 0; ai < 2; ++ai)
#pragma unroll
                for (int m = 0; m < 4; ++m) *(u32x4*)(YS + (size_t)EPI_ROW(u, ai, m) * 1024 + col) = pack8(acc[ai][bj][m][0] + b0, acc[ai][bj][m][1] + b1); }
    }
};
struct EpiPle {
    static constexpr bool PERM = true;
    const bf16_t* X2; const bf16_t* PP; float* OUT; bf16_t* XB;
    __device__ __forceinline__ void operator()(const f32x4 (&acc)[2][2][4][2], const Unit& u, int wr, int wc, int fr, int fq) const {
#pragma unroll
        for (int ai = 0; ai < 2; ++ai)
#pragma unroll
            for (int m = 0; m < 4; ++m) { const size_t off = (size_t)EPI_ROW(u, ai, m) * 1024 + u.pn * 256 + wc * 32 + 8 * fq;
#pragma unroll
                for (int bj = 0; bj < 2; ++bj) { const size_t o = off + bj * 128; const u32x4 xw = *(const u32x4*)(X2 + o), pw = *(const u32x4*)(PP + o);
                    const f32x4 a0 = acc[ai][bj][m][0], a1 = acc[ai][bj][m][1], x0 = bf4_lo(xw), x1 = bf4_hi(xw), p0 = bf4_lo(pw), p1 = bf4_hi(pw); f32x4 r0, r1;
#pragma unroll
                    for (int e = 0; e < 4; ++e) { r0[e] = x0[e] + sigmoidf_(a0[e]) * p0[e]; r1[e] = x1[e] + sigmoidf_(a1[e]) * p1[e]; }
                    *(u32x4*)(XB + o) = pack8(r0, r1);
                    if (OUT) { *(f32x4*)(OUT + o) = r0; *(f32x4*)(OUT + o + 4) = r1; } }
                if (m & 1) asm volatile("" ::: "memory"); }
    }
};
struct EpiPP {
    static constexpr bool PERM = true;
    bf16_t* PP;
    __device__ __forceinline__ void operator()(const f32x4 (&acc)[2][2][4][2], const Unit& u, int wr, int wc, int fr, int fq) const {
#pragma unroll
        for (int ai = 0; ai < 2; ++ai)
#pragma unroll
            for (int m = 0; m < 4; ++m)
#pragma unroll
                for (int bj = 0; bj < 2; ++bj) *(u32x4*)(PP + (size_t)EPI_ROW(u, ai, m) * 1024 + u.pn * 256 + bj * 128 + wc * 32 + 8 * fq) = pack8(acc[ai][bj][m][0], acc[ai][bj][m][1]);
    }
};
}

namespace att {
constexpr int NW = 8, QBLK = 32, KVBLK = 64, QB = 256, KPITCH = 384;
constexpr int SHM_V = KVBLK * DV * 2, SHM_K = KVBLK * KPITCH;
constexpr int NVB = 3;
constexpr int OFF_V = 0, OFF_K = NVB * SHM_V, OFF_WS = OFF_K + 2 * SHM_K, LDS_BYTES = OFF_WS + NW * 64 * 4;
#define SBAR() __builtin_amdgcn_sched_barrier(0)
__device__ __forceinline__ int k_addr(int row, int chunk) { return row * KPITCH + ((chunk ^ ((row >> 1) & 7)) << 4); }
__device__ __forceinline__ int v_st(int k, int c) { const int kk = (k & ~0xC) | ((k & 4) << 1) | ((k & 8) >> 1); return ((kk >> 3) * 4 + (c >> 5)) * 512 + ((kk & 7) * 32 + (c & 31)) * 2; }
__device__ __forceinline__ int v_rd_base(int lane) { return ((lane & 3) << 3) | (((lane >> 2) & 3) << 6) | (((lane >> 4) & 1) << 5) | (((lane >> 5) & 1) << 8); }
constexpr int v_rd_off(int d0, int ks, int half) { return d0 * 512 + ks * 4096 + half * 2048; }
__device__ __forceinline__ int crow(int r, int hi) { return (r & 3) + 8 * (r >> 2) + 4 * hi; }

template <int KB>
__device__ __forceinline__ void qkt(f32x16& p0, f32x16& p1, const LAS char* K_lds, int r32, int hi, const bf16x8* qr) {
    p0 = f32x16{}; p1 = f32x16{};
    const LAS char* kb[4];
#pragma unroll
    for (int dd = 0; dd < 4; ++dd) kb[dd] = K_lds + KB * SHM_K + r32 * KPITCH + (((2 * dd + hi) ^ ((r32 >> 1) & 7)) << 4);
    bf16x8 f[2][4];
#define QK_LD(g, buf) do { _Pragma("unroll") for (int e_ = 0; e_ < 2; ++e_) { const int d0_ = 2 * (g) + e_; const LAS char* a_ = kb[d0_ & 3] + (d0_ >> 2) * 128; \
        f[buf][2 * e_] = *(const LAS bf16x8*)a_; f[buf][2 * e_ + 1] = *(const LAS bf16x8*)(a_ + 32 * KPITCH); } } while (0)
    QK_LD(0, 0);
#pragma unroll
    for (int g = 0; g < 6; ++g) {
        if (g < 5) QK_LD(g + 1, (g + 1) & 1);
        SBAR();
#pragma unroll
        for (int e = 0; e < 2; ++e) { const int d0 = 2 * g + e;
            p0 = __builtin_amdgcn_mfma_f32_32x32x16_bf16(f[g & 1][2 * e], qr[d0], p0, 0, 0, 0);
            p1 = __builtin_amdgcn_mfma_f32_32x32x16_bf16(f[g & 1][2 * e + 1], qr[d0], p1, 0, 0, 0); }
        SBAR(); }
#undef QK_LD
}
__device__ __forceinline__ void pv_tile(f32x16* o, int vb0  , bf16x8 pa0, bf16x8 pa1, bf16x8 pa2, bf16x8 pa3) {
#define TRRD(dst, off) asm volatile("ds_read_b64_tr_b16 %0, %1 offset:%2" : "=&v"(dst) : "v"(vb0), "i"(off) : "memory")
#define PV_D0(d0) do { s16x4 l0, l1, l2, l3, h0, h1, h2, h3; constexpr int b_ = v_rd_off(d0, 0, 0); \
        TRRD(l0, b_); TRRD(h0, b_ + 2048); TRRD(l1, b_ + 4096); TRRD(h1, b_ + 6144); TRRD(l2, b_ + 8192); TRRD(h2, b_ + 10240); TRRD(l3, b_ + 12288); TRRD(h3, b_ + 14336); \
        asm volatile("s_waitcnt lgkmcnt(0)" ::: "memory"); SBAR(); \
        o[d0] = __builtin_amdgcn_mfma_f32_32x32x16_bf16(pa0, (bf16x8){l0[0], l0[1], l0[2], l0[3], h0[0], h0[1], h0[2], h0[3]}, o[d0], 0, 0, 0); \
        o[d0] = __builtin_amdgcn_mfma_f32_32x32x16_bf16(pa1, (bf16x8){l1[0], l1[1], l1[2], l1[3], h1[0], h1[1], h1[2], h1[3]}, o[d0], 0, 0, 0); \
        o[d0] = __builtin_amdgcn_mfma_f32_32x32x16_bf16(pa2, (bf16x8){l2[0], l2[1], l2[2], l2[3], h2[0], h2[1], h2[2], h2[3]}, o[d0], 0, 0, 0); \
        o[d0] = __builtin_amdgcn_mfma_f32_32x32x16_bf16(pa3, (bf16x8){l3[0], l3[1], l3[2], l3[3], h3[0], h3[1], h3[2], h3[3]}, o[d0], 0, 0, 0); } while (0)
    PV_D0(0); PV_D0(1); PV_D0(2); PV_D0(3);
#undef PV_D0
#undef TRRD
}
__device__ __forceinline__ void mask_tile(f32x16& p0, f32x16& p1, int dq  ) {
    const float NEG = -__builtin_inff();
#pragma unroll
    for (int r = 0; r < 16; ++r) { const int c = (r & 3) + 8 * (r >> 2);
        if (c > dq) p0[r] = NEG;
        if (c + 32 > dq) p1[r] = NEG; }
}
__device__ __forceinline__ void softmax_tile(f32x16& p0, f32x16& p1, float& m_reg, float& l_reg, float& alpha, bf16x8& pa0, bf16x8& pa1, bf16x8& pa2, bf16x8& pa3) {
    float pmax = p0[0];
#pragma unroll
    for (int r = 1; r < 16; ++r) pmax = fmaxf(pmax, p0[r]);
#pragma unroll
    for (int r = 0; r < 16; ++r) pmax = fmaxf(pmax, p1[r]);
    { auto rr = __builtin_amdgcn_permlane32_swap(__float_as_uint(pmax), __float_as_uint(pmax), false, false); pmax = fmaxf(__uint_as_float(rr[0]), __uint_as_float(rr[1])); }
    float mn = m_reg; alpha = 1.f;
    if (!__all(pmax - m_reg <= 8.0f)) { mn = fmaxf(m_reg, pmax); alpha = __builtin_amdgcn_exp2f(m_reg - mn); m_reg = mn; }
    float ps = 0.f;
#pragma unroll
    for (int r = 0; r < 16; ++r) { p0[r] = __builtin_amdgcn_exp2f(p0[r] - mn); ps += p0[r]; }
#pragma unroll
    for (int r = 0; r < 16; ++r) { p1[r] = __builtin_amdgcn_exp2f(p1[r] - mn); ps += p1[r]; }
    { auto rr = __builtin_amdgcn_permlane32_swap(__float_as_uint(ps), __float_as_uint(ps), false, false); ps = __uint_as_float(rr[0]) + __uint_as_float(rr[1]); }
    l_reg = l_reg * alpha + ps;
#define PK4(P, B_, OUT) do { unsigned a0 = cvt_pk_bf16(P[B_+0], P[B_+1]), a1 = cvt_pk_bf16(P[B_+2], P[B_+3]); \
        unsigned b0 = cvt_pk_bf16(P[B_+4], P[B_+5]), b1 = cvt_pk_bf16(P[B_+6], P[B_+7]); \
        auto r0 = __builtin_amdgcn_permlane32_swap(a0, b0, false, false); auto r1 = __builtin_amdgcn_permlane32_swap(a1, b1, false, false); \
        u32x4 w = {r0[0], r1[0], r0[1], r1[1]}; OUT = __builtin_bit_cast(bf16x8, w); } while (0)
    PK4(p0, 0, pa0); PK4(p0, 8, pa1); PK4(p1, 0, pa2); PK4(p1, 8, pa3);
#undef PK4
}

__device__ __forceinline__ void attn_block(int b, int h, int qb, const bf16_t* Q, const bf16_t* KN, const bf16_t* KR, const bf16_t* V, bf16_t* O, LAS char* lds, unsigned long long* pw = nullptr) {
    const int tid = opaque_tid(), wid = __builtin_amdgcn_readfirstlane(tid >> 6), lane = tid & 63, r32 = lane & 31, hi = lane >> 5;
    const size_t row0 = (size_t)b * SEQ;
    const int q0 = qb * QB + wid * QBLK;
    const int NT = (qb + 1) * (QB / KVBLK);
    LAS char* V_lds = lds + OFF_V; LAS char* K_lds = lds + OFF_K;
    LAS float* ws = (LAS float*)(lds + OFF_WS) + wid * 64; LAS float* li_l = ws; LAS float* al_l = ws + 32;
    const int sr = tid >> 4, sc = (tid & 15) * 8, kr_row = tid >> 3, kr_c = tid & 7;
    const int vst0 = v_st(sr, sc), vst1 = v_st(32 + sr, sc), kws = k_addr(sr, tid & 15), kwr = k_addr(kr_row, 16 + kr_c);
    const int vb0 = (int)(uintptr_t)lds + v_rd_base(lane);
    const bf16_t* KNh = KN + row0 * 1024 + h * 128 + sc; const bf16_t* Vh = V + row0 * 1024 + h * 128 + sc; const bf16_t* KRb = KR + row0 * 64 + kr_c * 8;
    bf16x8 st_k0, st_k1, st_kr, st_v0, st_v1;
#define SLOAD(t) do { const size_t k0_ = (size_t)(t) * KVBLK; \
        st_k0 = *(const bf16x8*)(KNh + (k0_ + sr) * 1024); st_k1 = *(const bf16x8*)(KNh + (k0_ + 32 + sr) * 1024); st_kr = *(const bf16x8*)(KRb + (k0_ + kr_row) * 64); \
        st_v0 = *(const bf16x8*)(Vh + (k0_ + sr) * 1024); st_v1 = *(const bf16x8*)(Vh + (k0_ + 32 + sr) * 1024); } while (0)
#define SWRITE(bf, vo) do { *(LAS bf16x8*)(K_lds + (bf) * SHM_K + kws) = st_k0; *(LAS bf16x8*)(K_lds + (bf) * SHM_K + kws + 32 * KPITCH) = st_k1; *(LAS bf16x8*)(K_lds + (bf) * SHM_K + kwr) = st_kr; \
        *(LAS bf16x8*)(V_lds + (vo) + vst0) = st_v0; *(LAS bf16x8*)(V_lds + (vo) + vst1) = st_v1; } while (0)
    SLOAD(0);
    bf16x8 qr[12];
    { const bf16_t* Qw = Q + (row0 + q0 + r32) * 1536 + h * 192 + hi * 8;
#pragma unroll
      for (int d0 = 0; d0 < 12; ++d0) qr[d0] = *(const bf16x8*)(Qw + d0 * 16); }
    float m_reg = -1e30f, l_reg = 0.f; f32x16 o[4] = {};
    f32x16 p0, p1; bf16x8 pa0, pa1, pa2, pa3; float alpha;
    asm volatile("s_waitcnt vmcnt(0)" ::: "memory");
    SWRITE(0, 0);
    __syncthreads();
    const bool odd = wid >= 4; int vo_prev = 0, vo_cur = 0, vo_next = SHM_V;
#define RESC(a) do { if (__any((a) < 1.f)) { if (hi == 0) al_l[r32] = (a); asm volatile("s_waitcnt lgkmcnt(0)" ::: "memory"); \
        _Pragma("unroll") for (int d_ = 0; d_ < 4; ++d_) _Pragma("unroll") for (int r = 0; r < 16; ++r) o[d_][r] *= al_l[crow(r, hi)]; } } while (0)
#if PROBE_T
    unsigned long long pa_ = 0, pb_ = 0, pc_ = 0, pd_ = 0, pe2_ = 0; const unsigned long long pst_ = __builtin_amdgcn_s_memtime();
#define PSTAMP(v) const unsigned long long v = __builtin_amdgcn_s_memtime()
#define PACC(acc, a, b) acc += (b) - (a)
#else
#define PSTAMP(v) do {} while (0)
#define PACC(acc, a, b) do {} while (0)
#endif
#define TILE(t, BF) do { PSTAMP(s0_); const bool more_ = ((t) + 1 < NT); if (more_) SLOAD((t) + 1); SBAR(); \
        if (odd && (t) > 0) { pv_tile(o, vb0 + vo_prev, pa0, pa1, pa2, pa3); SBAR(); } \
        PSTAMP(s1_); qkt<BF>(p0, p1, K_lds, r32, hi, qr); \
        { const int kb_ = (t) * KVBLK; if (kb_ + KVBLK - 1 > q0) mask_tile(p0, p1, q0 + r32 - kb_ - 4 * hi); } \
        asm volatile("" : "+v"(p0), "+v"(p1)); PSTAMP(s2_); \
        softmax_tile(p0, p1, m_reg, l_reg, alpha, pa0, pa1, pa2, pa3); RESC(alpha); SBAR(); PSTAMP(s3_); \
        if (!odd) pv_tile(o, vb0 + vo_cur, pa0, pa1, pa2, pa3); \
        PSTAMP(s4_); if (more_) { asm volatile("s_waitcnt vmcnt(0)" ::: "memory"); SWRITE((BF) ^ 1, vo_next); } \
        PSTAMP(s5_); __syncthreads(); PSTAMP(s6_); PACC(pa_, s1_, s2_); PACC(pb_, s2_, s3_); PACC(pc_, s3_, s4_); PACC(pd_, s4_, s5_); PACC(pe2_, s5_, s6_); vo_prev = vo_cur; vo_cur = vo_next; vo_next = (vo_next == (NVB - 1) * SHM_V) ? 0 : vo_next + SHM_V; } while (0)
#pragma unroll 1
    for (int t = 0; t < NT; t += 2) { TILE(t, 0); TILE(t + 1, 1); }
    if (odd) pv_tile(o, vb0 + vo_prev, pa0, pa1, pa2, pa3);
#if PROBE_T
    if (pw && blockIdx.x == 0 && tid == 0) { pw[8] += pa_; pw[9] += pb_; pw[10] += pc_; pw[11] += pd_; pw[12] += pe2_; pw[13] += (unsigned long long)NT; pw[14] += __builtin_amdgcn_s_memtime() - pst_; }
#endif
    if (hi == 0) li_l[r32] = l_reg; asm volatile("s_waitcnt lgkmcnt(0)" ::: "memory");
    __syncthreads();
    { LAS bf16_t* stg = (LAS bf16_t*)(lds + wid * 8704);
#pragma unroll
      for (int r = 0; r < 16; ++r) { const int orow = crow(r, hi); const float rl = __builtin_amdgcn_rcpf(li_l[orow]);
#pragma unroll
          for (int d0 = 0; d0 < 4; ++d0) { const float v = o[d0][r] * rl; stg[orow * 136 + d0 * 32 + r32] = (bf16_t)(cvt_pk_bf16(v, v) & 0xffffu); } }
      asm volatile("s_waitcnt lgkmcnt(0)" ::: "memory");
      bf16_t* Ow = O + (row0 + q0) * 1024 + h * 128 + (lane & 15) * 8;
#pragma unroll
      for (int it = 0; it < 8; ++it) { const int row = it * 4 + (lane >> 4); const u32x4 v = *(const LAS u32x4*)(stg + row * 136 + (lane & 15) * 8); *(u32x4*)(Ow + (size_t)row * 1024) = v; } }
    __syncthreads();
#undef SLOAD
#undef SWRITE
#undef RESC
#undef TILE
#undef PSTAMP
#undef PACC
}
#undef SBAR
}

#define XB_TMO      128
#define XB_XCNT(j)  (256  + 64 * (j))
#define XB_XSUB(j)  (1280 + 64 * (j))
#define XB_XGEN(j)  (2304 + 64 * (j))
#define XB_TOP      3328
#define XB_TOPGEN   3392
#define XCD_BAR_WORDS 3456
#define XB_SPIN_CAP (1u << 22)
__device__ __forceinline__ unsigned xb_ld(unsigned* p)              { return __hip_atomic_load(p, __ATOMIC_RELAXED, __HIP_MEMORY_SCOPE_AGENT); }
__device__ __forceinline__ unsigned xb_add(unsigned* p, unsigned v) { return __hip_atomic_fetch_add(p, v, __ATOMIC_RELAXED, __HIP_MEMORY_SCOPE_AGENT); }
__device__ __forceinline__ unsigned xb_xcc_id() { return (unsigned)__builtin_amdgcn_s_getreg((3 << 11) | 20) & 0xFu; }
#define XB_SPIN(cond, bar) do { unsigned _sp = 0; while (cond) { __builtin_amdgcn_s_sleep(1); \
    if ((++_sp & 255u) == 0u) { if (xb_ld(&(bar)[XB_TMO])) break; if (_sp > XB_SPIN_CAP) { atomicAdd(&(bar)[XB_TMO], 1u); break; } } } } while (0)
struct XcdBarrier { unsigned* bar; unsigned x; volatile LAS unsigned* st; };
__device__ __forceinline__ XcdBarrier xcd_barrier_post(unsigned* bar, volatile LAS unsigned* st) {
    XcdBarrier b; b.bar = bar; b.x = xb_xcc_id(); b.st = st;
    if (threadIdx.x == 0) (void)xb_add(&bar[XB_XCNT(b.x)], 1u);
    return b;
}
__device__ __forceinline__ void xcd_barrier_complete(unsigned* bar, unsigned x, unsigned& nloc, unsigned& nx) {
    const unsigned G = gridDim.x * gridDim.y * gridDim.z;
    unsigned sum, cnt, mine, sp = 0u;
    for (;;) {
        sum = 0u; cnt = 0u; mine = 0u;
#pragma unroll
        for (unsigned j = 0; j < 16; ++j) { const unsigned c = xb_ld(&bar[XB_XCNT(j)]); sum += c; cnt += (c > 0u) ? 1u : 0u; mine = (j == x) ? c : mine; }
        if (sum == G) break;
        __builtin_amdgcn_s_sleep(1);
        if ((++sp & 255u) == 0u) { if (xb_ld(&bar[XB_TMO])) break; if (sp > XB_SPIN_CAP) { atomicAdd(&bar[XB_TMO], 1u); break; } }
    }
    nloc = mine > 0u ? mine : 1u; nx = cnt > 0u ? cnt : 1u;
}
__device__ __forceinline__ void xcd_barrier(const XcdBarrier& b) {
    asm volatile("s_waitcnt vmcnt(0)" ::: "memory");
    __syncthreads();
    if (opaque_tid() == 0) {
        unsigned* bar = b.bar; unsigned bx = b.x;
        asm volatile("" : "+s"(bar), "+s"(bx));
        __builtin_amdgcn_s_waitcnt(0);
        unsigned nloc = b.st[0], nx = b.st[1];
        if (nloc == 0u) { xcd_barrier_complete(bar, bx, nloc, nx); b.st[0] = nloc; b.st[1] = nx; }
        const unsigned old = xb_add(&bar[XB_XSUB(bx)], 1u);
        const unsigned gen = old / nloc;
        if (old + 1u == (gen + 1u) * nloc) {
            __builtin_amdgcn_fence(__ATOMIC_RELEASE, "agent");
            asm volatile("s_waitcnt vmcnt(0)" ::: "memory");
            const unsigned og = xb_add(&bar[XB_TOP], 1u);
            const unsigned tg = og / nx;
            if (og + 1u == (tg + 1u) * nx) xb_add(&bar[XB_TOPGEN], 1u);
            else XB_SPIN(xb_ld(&bar[XB_TOPGEN]) == tg, bar);
            __builtin_amdgcn_fence(__ATOMIC_ACQUIRE, "agent");
            xb_add(&bar[XB_XGEN(bx)], 1u);
            asm volatile("s_waitcnt vmcnt(0)" ::: "memory");
        } else {
            XB_SPIN(xb_ld(&bar[XB_XGEN(bx)]) == gen, bar);
            __builtin_amdgcn_fence(__ATOMIC_ACQUIRE, "agent");
            asm volatile("s_waitcnt vmcnt(0)" ::: "memory");
        }
    }
    __syncthreads();
}

struct Args { const void* in[30]; float* out; unsigned char* ws; int ph_lo, ph_hi, li, pad; };
struct Ctx { int tid, lane, wave, vcu, G, bid; LAS unsigned char* lds; volatile LAS int* misc; };
__device__ __forceinline__ Ctx fresh_ctx(const Ctx& c) {
    Ctx r = c; unsigned l = (unsigned)(uintptr_t)c.lds, m = (unsigned)(uintptr_t)c.misc;
    asm volatile("" : "+s"(r.wave), "+s"(r.vcu), "+s"(r.G), "+s"(r.bid), "+s"(l), "+s"(m));
    r.lds = (LAS unsigned char*)(uintptr_t)l; r.misc = (volatile LAS int*)(uintptr_t)m; r.tid = opaque_tid(); r.lane = r.tid & 63; return r; }
typedef const CAS Args* ArgsP;
__device__ __forceinline__ const CAS Args& fresh_args(ArgsP p) { asm volatile("" : "+s"(p)); return *p; }
enum { I_X = 0, I_P, I_POS, I_MLA_WIN, I_MLA_QN, I_MLA_KVN, I_MLA_WUQ, I_MLA_WUKV, I_MLA_WO, I_LRU_WIN, I_LRU_CW, I_LRU_CB, I_LRU_WA, I_LRU_BA, I_LRU_WX, I_LRU_BX, I_LRU_LAM, I_LRU_WOUT,
       I_LN1G, I_LN1B, I_LN2G, I_LN2B, I_MOE_WR, I_MOE_BR, I_MOE_WUP, I_MOE_BUP, I_MOE_WDN, I_MOE_BDN, I_PLE_WG, I_PLE_WP };
#define INF(i) ((const float*)args.in[i])
#define WSP(T_, off) ((T_*)(args.ws + (off)))

__device__ __forceinline__ void tr_load(const float* W, int ld, int k0, int sc0, int sc1, int lane, f32x4 (&v)[16]) {
    const int half = (lane & 15) >> 3, scol = half ? sc1 : sc0, c4 = (lane & 7) * 4, rs = lane >> 4;
#pragma unroll
    for (int i = 0; i < 8; ++i) { const float* p = W + (size_t)(k0 + 8 * i + 2 * rs) * ld + scol + c4;
        v[2 * i] = (scol >= 0) ? *(const f32x4*)p : (f32x4){0.f, 0.f, 0.f, 0.f}; v[2 * i + 1] = (scol >= 0) ? *(const f32x4*)(p + ld) : (f32x4){0.f, 0.f, 0.f, 0.f}; }
}
__device__ __forceinline__ void tr_store(f32x4 (&v)[16], const float* ksc, int k0, bf16_t* dst  , int K, LAS unsigned* scr, int lane) {
    const int rs = lane >> 4;
    if (ksc) {
#pragma unroll
        for (int i = 0; i < 8; ++i) { v[2 * i] = v[2 * i] * ksc[k0 + 8 * i + 2 * rs]; v[2 * i + 1] = v[2 * i + 1] * ksc[k0 + 8 * i + 2 * rs + 1]; } }
#pragma unroll
    for (int i = 0; i < 8; ++i) { LAS unsigned* s = scr + (4 * i + rs) * 65 + (lane & 15) * 4;
#pragma unroll
        for (int e = 0; e < 4; ++e) s[e] = cvt_pk_bf16(v[2 * i][e], v[2 * i + 1][e]); }
    asm volatile("s_waitcnt lgkmcnt(0)" ::: "memory");
    const int c = lane & 7;
#pragma unroll
    for (int j = 0; j < 8; ++j) { const int n = (lane >> 3) + 8 * j; const LAS unsigned* s = scr + (4 * c) * 65 + n;
        u32x4 o; o.x = s[0]; o.y = s[65]; o.z = s[130]; o.w = s[195];
        *(u32x4*)(dst + (size_t)n * K + 8 * c) = o; }
    asm volatile("s_waitcnt lgkmcnt(0)" ::: "memory");
}
enum { J_NAT = 0, J_MLA_WIN, J_MLA_WUQ, J_LRU_WAX, J_MOE_UP };
__device__ __forceinline__ int tr_map(int job, int g) {
    switch (job) {
    case J_MLA_WIN: return g < 32 ? 32 * g : (g == 32 ? 1024 : (g == 36 ? 1056 : -1));
    case J_MLA_WUQ: if (g < 32) { const int t = g >> 3, bj = (g >> 2) & 1, cg = g & 3; return (2 * t + bj) * 192 + 32 * cg; }
                    else { const int g2 = g - 32, t2 = g2 >> 3, bj = (g2 >> 2) & 1, hh = g2 & 3; return (4 * t2 + hh) * 192 + 128 + 32 * bj; }
    case J_LRU_WAX: { const int pn = g >> 3, cg = g & 3; return 128 * pn + 32 * cg; }
    case J_MOE_UP:  { const int pn = g >> 3, bj = (g >> 2) & 1, cg = g & 3; return bj * 1024 + 128 * pn + 32 * cg; }
    default: return 32 * g;
    }
}
__device__ __forceinline__ void tr_job(const Ctx& C, int job, const float* src, size_t srcstride, int nmat, int K, int ld, int N, bf16_t* dst, size_t dststride, const float* ksc, int kscstride,
                                       const float* src2  ) {
    LAS unsigned* scr = (LAS unsigned*)(C.lds + C.wave * 8320);
    const int gw = C.vcu * NWAVES + C.wave, NGW = C.G * NWAVES;
    const int nkb = K / 64, nnb = N / 64, per = nkb * nnb, total = per * nmat;
#define TR_DECODE(it_, W_, k0_, s0_, s1_, ks_, d_) do { const int mat_ = (it_) / per, r_ = (it_) - mat_ * per, kb_ = r_ / nnb, nb_ = r_ - kb_ * nnb; \
        s0_ = tr_map(job, 2 * nb_); s1_ = tr_map(job, 2 * nb_ + 1); W_ = src + (size_t)mat_ * srcstride; \
        if (job == J_LRU_WAX && ((nb_ >> 1) & 1)) W_ = src2 + (size_t)mat_ * srcstride;       \
        k0_ = kb_ * 64; ks_ = ksc ? ksc + (size_t)mat_ * kscstride : nullptr; d_ = (bf16_t*)((char*)dst + (size_t)mat_ * dststride) + (size_t)(nb_ * 64) * K + kb_ * 64; } while (0)
    f32x4 va[16], vb[16];
    int it = gw; const float* Wc; int k0c, s0c, s1c; const float* ksc_c; bf16_t* dc;
    if (it < total) { TR_DECODE(it, Wc, k0c, s0c, s1c, ksc_c, dc); tr_load(Wc, ld, k0c, s0c, s1c, C.lane, va); }
    while (it < total) {
        const int nit = it + NGW; const float* Wn = nullptr; int k0n = 0, s0n = 0, s1n = 0; const float* ksc_n = nullptr; bf16_t* dn = nullptr;
        if (nit < total) { TR_DECODE(nit, Wn, k0n, s0n, s1n, ksc_n, dn); tr_load(Wn, ld, k0n, s0n, s1n, C.lane, vb); }
        tr_store(va, ksc_c, k0c, dc, K, scr, C.lane);
#pragma unroll
        for (int i = 0; i < 16; ++i) va[i] = vb[i];
        it = nit; k0c = k0n; ksc_c = ksc_n; dc = dn;
    }
#undef TR_DECODE
}
template <int JOB, int N, bool G64  >
__device__ __forceinline__ void tr_job_fp8(const Ctx& C, const float* src, size_t srcstride, int nmat, unsigned char* dst, size_t dststride, unsigned char* SW) {
    constexpr int K = 1024, ld = N;
    LAS float* scr = (LAS float*)(C.lds + C.wave * 16640);
    const int gw = C.vcu * NWAVES + C.wave, NGW = C.G * NWAVES, lane = C.lane;
    const int nkb = K / 64, nnb = N / 64, per = nkb * nnb, total = per * nmat;
    for (int it = gw; it < total; it += NGW) {
        const int mat = it / per, r = it - mat * per, kb = r / nnb, nb = r - kb * nnb;
        const int s0 = tr_map(JOB, 2 * nb), s1 = tr_map(JOB, 2 * nb + 1);
        f32x4 v[16];
        tr_load(src + (size_t)mat * srcstride, ld, kb * 64, s0, s1, lane, v);
        const int rs = lane >> 4;
#pragma unroll
        for (int i = 0; i < 8; ++i) { LAS float* sp = scr + (8 * i + 2 * rs) * 65 + (lane & 15) * 4;
#pragma unroll
            for (int e = 0; e < 4; ++e) { sp[e] = v[2 * i][e]; sp[65 + e] = v[2 * i + 1][e]; } }
        asm volatile("s_waitcnt lgkmcnt(0)" ::: "memory");
        const int c = lane & 7;
#pragma unroll
        for (int j = 0; j < 8; ++j) { const int n = (lane >> 3) + 8 * j; const LAS float* sp = scr + (8 * c) * 65 + n;
            float x[8]; float am = 0.f;
#pragma unroll
            for (int q = 0; q < 8; ++q) { x[q] = sp[q * 65]; am = fmaxf(am, fabsf(x[q])); }
            am = fmaxf(am, __shfl_xor(am, 1)); am = fmaxf(am, __shfl_xor(am, 2));
            if (G64) am = fmaxf(am, __shfl_xor(am, 4));
            int eb = (int)((__float_as_uint(am) >> 23) & 0xffu) - 7; eb = eb < 1 ? 1 : eb;
            const float inv = __uint_as_float((unsigned)(254 - eb) << 23);
            int w0 = __builtin_amdgcn_cvt_pk_fp8_f32(x[0] * inv, x[1] * inv, 0, false); w0 = __builtin_amdgcn_cvt_pk_fp8_f32(x[2] * inv, x[3] * inv, w0, true);
            int w1 = __builtin_amdgcn_cvt_pk_fp8_f32(x[4] * inv, x[5] * inv, 0, false); w1 = __builtin_amdgcn_cvt_pk_fp8_f32(x[6] * inv, x[7] * inv, w1, true);
            const int nrow = nb * 64 + n;
            *(u32x2*)(dst + (size_t)mat * dststride + (size_t)nrow * K + kb * 64 + 8 * c) = (u32x2){(unsigned)w0, (unsigned)w1};
            if (!G64) { if ((c & 3) == 0) SW[(size_t)mat * 65536 + (size_t)(nrow >> 8) * 8192 + (size_t)(kb >> 1) * 1024 + (nrow & 255) * 4 + 2 * (kb & 1) + (c >> 2)] = (unsigned char)eb; }
            else { if (c == 0) SW[(size_t)mat * 16384 + (size_t)(nrow >> 8) * 4096 + (size_t)(kb >> 1) * 512 + (nrow & 255) * 2 + (kb & 1)] = (unsigned char)eb; } }
        asm volatile("s_waitcnt lgkmcnt(0)" ::: "memory");
    }
}
__device__ __forceinline__ void cvt_rows(const Ctx& C, const float* src, bf16_t* dst, size_t n8  ) {
    const size_t gt = (size_t)C.vcu * 512 + C.tid, NT = (size_t)C.G * 512;
    for (size_t i = gt; i < n8; i += NT) { const f32x4 a = *(const f32x4*)(src + i * 8), b = *(const f32x4*)(src + i * 8 + 4); *(u32x4*)(dst + i * 8) = pack8(a, b); }
}
__device__ __forceinline__ void phase_prologue(const CAS Args& args, const Ctx& C) {
    tr_job(C, J_MLA_WIN, INF(I_MLA_WIN), (size_t)DM * LATD, 2, DM, LATD, 1280, WSP(bf16_t, WS_W_MLA + OFF_MLA_WIN), W_MLA_STRIDE, nullptr, 0, nullptr);
    tr_job(C, J_MLA_WUQ, INF(I_MLA_WUQ), (size_t)QL * 1536, 2, QL, 1536, 1536, WSP(bf16_t, WS_W_MLA + OFF_MLA_WUQ), W_MLA_STRIDE, INF(I_MLA_QN), QL, nullptr);
    tr_job(C, J_NAT, INF(I_MLA_WUKV), (size_t)KVL * 2048, 2, KVL, 2048, 2048, WSP(bf16_t, WS_W_MLA + OFF_MLA_WUKV), W_MLA_STRIDE, INF(I_MLA_KVN), KVL, nullptr);
    tr_job(C, J_NAT, INF(I_MLA_WO), (size_t)DM * DM, 2, DM, DM, DM, WSP(bf16_t, WS_W_MLA + OFF_MLA_WO), W_MLA_STRIDE, nullptr, 0, nullptr);
    tr_job(C, J_NAT, INF(I_LRU_WIN), (size_t)DM * 2048, 2, DM, 2048, 2048, WSP(bf16_t, WS_W_LRU + OFF_LRU_WIN), W_LRU_STRIDE, nullptr, 0, nullptr);
    for (int j = 0; j < 2; ++j)
        tr_job(C, J_LRU_WAX, INF(I_LRU_WA) + (size_t)j * 4 * 65536, (size_t)256 * 256, 4, 256, 256, 512, WSP(bf16_t, WS_W_LRU + OFF_LRU_WAX + (size_t)j * W_LRU_STRIDE), (size_t)512 * 256 * 2, nullptr, 0, INF(I_LRU_WX) + (size_t)j * 4 * 65536);
    tr_job(C, J_NAT, INF(I_LRU_WOUT), (size_t)DM * DM, 2, DM, DM, DM, WSP(bf16_t, WS_W_LRU + OFF_LRU_WOUT), W_LRU_STRIDE, nullptr, 0, nullptr);
    tr_job(C, J_NAT, INF(I_PLE_WG), (size_t)DM * DM, 4, DM, DM, DM, WSP(bf16_t, WS_W_PLE + OFF_PLE_WG), W_PLE_STRIDE, nullptr, 0, nullptr);
    tr_job(C, J_NAT, INF(I_PLE_WP), (size_t)PLED * DM, 4, PLED, DM, DM, WSP(bf16_t, WS_W_PLE + OFF_PLE_WP), W_PLE_STRIDE, nullptr, 0, nullptr);
    __syncthreads();
    tr_job_fp8<J_MOE_UP, 2048, false>(C, INF(I_MOE_WUP), (size_t)DM * 2048, DEPTH * NE, args.ws + WS_W_UP, (size_t)2048 * 1024, args.ws + WS_SW);
    tr_job_fp8<J_NAT, 1024, true>(C, INF(I_MOE_WDN), (size_t)DFF * DM, DEPTH * NE, args.ws + WS_W_DN, (size_t)1024 * 1024, args.ws + WS_SWD);
    __syncthreads();
    cvt_rows(C, INF(I_X), WSP(bf16_t, WS_XB), (size_t)T * DM / 8);
    cvt_rows(C, INF(I_P), WSP(bf16_t, WS_PB), (size_t)DEPTH * T * PLED / 8);
    { const int* pos = (const int*)args.in[I_POS]; float* CS = WSP(float, WS_CS); float* SN = WSP(float, WS_SN);
      const size_t gt = (size_t)C.vcu * 512 + C.tid, NT = (size_t)C.G * 512;
      for (size_t i = gt; i < (size_t)T * 32; i += NT) { const int tok = (int)(i >> 5), j = (int)(i & 31);
          const double inv = exp(-9.210340371976184 * (double)j / 32.0); const double ang = (double)pos[tok] * inv; double s, c; sincos(ang, &s, &c); CS[i] = (float)c; SN[i] = (float)s; }
      float* SPL = WSP(float, WS_SPL); const float* lam = INF(I_LRU_LAM);
      for (size_t i = gt; i < 2 * 1024; i += NT) { const double l = (double)lam[i]; SPL[i] = (float)(-8.0 * log1p(exp(-l))); } }
}

__device__ __forceinline__ void moe_table(const CAS Args& args, const Ctx& C0, int layer) {
    Ctx C = C0; C.tid = opaque_tid(); C.lane = C.tid & 63;
    const unsigned* cnt = WSP(unsigned, WS_CTL) + CW_CNT + 64 * layer;
    __syncthreads();
    if (C.tid < 32) C.misc[64 + C.tid] = (int)__hip_atomic_load(cnt + C.tid, __ATOMIC_RELAXED, __HIP_MEMORY_SCOPE_AGENT);
    __syncthreads();
    if (C.tid == 0) { int acc = 0; for (int e = 0; e < 32; ++e) { C.misc[16 + e] = acc; acc += (C.misc[64 + e] + 255) >> 8; } C.misc[16 + 32] = acc; }
    __syncthreads();
    { volatile LAS unsigned char* te = (volatile LAS unsigned char*)(C.lds + TILE_E_OFF);
      for (int mg = C.tid; mg < C.misc[48]; mg += NWAVES * 64) { int e = 0; for (int j = 1; j < 32; ++j) e += (C.misc[16 + j] <= mg) ? 1 : 0; te[mg] = (unsigned char)e; } }
    __syncthreads();
}

__device__ __forceinline__ void phase_ln_router(const CAS Args& args, const Ctx& C0, int layer) {
    const int cslot = layer + args.pad;
    Ctx C = C0; C.tid = opaque_tid(); C.lane = C.tid & 63;
    const bf16_t* Y = WSP(bf16_t, WS_Y); float* X1 = WSP(float, WS_X1); bf16_t* X1B = WSP(bf16_t, WS_X1B);
    const float* g1 = INF(I_LN1G) + layer * DM; const float* b1 = INF(I_LN1B) + layer * DM;
    const CAS float* Wr = (const CAS float*)(INF(I_MOE_WR) + (size_t)layer * DM * NE); const float* br = INF(I_MOE_BR) + layer * NE;
    unsigned* gcnt = WSP(unsigned, WS_CTL) + CW_CNT + 64 * cslot;
    int* lists = WSP(int, WS_LIST); int* slot = WSP(int, WS_SLOT); float* gate = WSP(float, WS_GATE);
    LAS float* part = (LAS float*)C.lds;
    volatile LAS int* lcnt = (volatile LAS int*)(C.lds + 69632);
    volatile LAS int* lbase = lcnt + 32;
    f32x4 gv[4], bv[4];
#pragma unroll
    for (int j = 0; j < 2; ++j) { gv[2 * j] = *(const f32x4*)(g1 + 8 * C.lane + 512 * j); gv[2 * j + 1] = *(const f32x4*)(g1 + 8 * C.lane + 512 * j + 4);
        bv[2 * j] = *(const f32x4*)(b1 + 8 * C.lane + 512 * j); bv[2 * j + 1] = *(const f32x4*)(b1 + 8 * C.lane + 512 * j + 4); }
    unsigned char* X1Q = args.ws + WS_X1Q; int sexp;
    { float ag = 0.f, ab = 0.f;
#pragma unroll
      for (int j = 0; j < 4; ++j)
#pragma unroll
          for (int e = 0; e < 4; ++e) { ag = fmaxf(ag, fabsf(gv[j][e])); ab = fmaxf(ab, fabsf(bv[j][e])); }
#pragma unroll
      for (int o = 1; o < 64; o <<= 1) { ag = fmaxf(ag, __shfl_xor(ag, o)); ab = fmaxf(ab, __shfl_xor(ab, o)); }
      const float bound = 16.0f * ag + ab + 1e-20f;
      sexp = 134 - (int)((__float_as_uint(bound) >> 23) & 0xffu);
      sexp = sexp < -100 ? -100 : (sexp > 100 ? 100 : sexp);
      if (C.tid == 0) __hip_atomic_store(WSP(unsigned, WS_CTL) + CW_SA + layer, (unsigned)sexp, __ATOMIC_RELAXED, __HIP_MEMORY_SCOPE_AGENT); }
    const float qs = __uint_as_float((unsigned)(127 + sexp) << 23), qlo = KF(-448.f), qhi = KF(448.f);
    for (int chunk = C.vcu; chunk < T / 128; chunk += C.G) {
        const int row0 = chunk * 128;
        if (C.tid < 32) lcnt[C.tid] = 0;
#pragma unroll 1
        for (int i = 0; i < 16; ++i) { const size_t row = (size_t)row0 + C.wave * 16 + i;
            f32x4 v[4]; float s = 0.f;
#pragma unroll
            for (int j = 0; j < 2; ++j) { const u32x4 w = *(const u32x4*)(Y + row * DM + 8 * C.lane + 512 * j); v[2 * j] = pg8::bf4_lo(w); v[2 * j + 1] = pg8::bf4_hi(w); }
#pragma unroll
            for (int j = 0; j < 4; ++j) s += (v[j][0] + v[j][1]) + (v[j][2] + v[j][3]);
            const float mean = wave_sum(s) * (1.f / DM); float s2 = 0.f;
#pragma unroll
            for (int j = 0; j < 4; ++j) { v[j] = v[j] - mean; s2 += (v[j][0] * v[j][0] + v[j][1] * v[j][1]) + (v[j][2] * v[j][2] + v[j][3] * v[j][3]); }
            const float rstd = 1.f / sqrtf(wave_sum(s2) * (1.f / DM) + KF(LN_EPS));
#pragma unroll
            for (int j = 0; j < 4; ++j) v[j] = v[j] * rstd * gv[j] + bv[j];
#pragma unroll
            for (int j = 0; j < 2; ++j) { float* xo = X1 + row * DM + 8 * C.lane + 512 * j; *(f32x4*)xo = v[2 * j]; *(f32x4*)(xo + 4) = v[2 * j + 1];
                *(u32x4*)(X1B + row * DM + 8 * C.lane + 512 * j) = pack8(v[2 * j], v[2 * j + 1]);
                const f32x4 q0 = v[2 * j] * qs, q1 = v[2 * j + 1] * qs;
                int w0 = __builtin_amdgcn_cvt_pk_fp8_f32(fminf(fmaxf(q0[0], qlo), qhi), fminf(fmaxf(q0[1], qlo), qhi), 0, false); w0 = __builtin_amdgcn_cvt_pk_fp8_f32(fminf(fmaxf(q0[2], qlo), qhi), fminf(fmaxf(q0[3], qlo), qhi), w0, true);
                int w1 = __builtin_amdgcn_cvt_pk_fp8_f32(fminf(fmaxf(q1[0], qlo), qhi), fminf(fmaxf(q1[1], qlo), qhi), 0, false); w1 = __builtin_amdgcn_cvt_pk_fp8_f32(fminf(fmaxf(q1[2], qlo), qhi), fminf(fmaxf(q1[3], qlo), qhi), w1, true);
                *(u32x2*)(X1Q + row * DM + 8 * C.lane + 512 * j) = (u32x2){(unsigned)w0, (unsigned)w1}; } }
        asm volatile("s_waitcnt vmcnt(0)" ::: "memory");
        __syncthreads();
        { const int grp = C.wave >> 2, kq = C.wave & 3; const size_t tok = (size_t)row0 + grp * 64 + C.lane;
          float acc[32];
#pragma unroll
          for (int e = 0; e < 32; ++e) acc[e] = 0.f;
          const float* xr = X1 + tok * DM + kq * 256;
          for (int kk = 0; kk < 64; ++kk) { const f32x4 xv = *(const f32x4*)(xr + kk * 4);
#pragma unroll
              for (int i = 0; i < 4; ++i) { const CAS float* wrow = Wr + (size_t)(kq * 256 + kk * 4 + i) * NE;
#pragma unroll
                  for (int e = 0; e < 32; ++e) acc[e] = fmaf(xv[i], wrow[e], acc[e]);
                  if (i & 1) __builtin_amdgcn_sched_barrier(0); } }
          LAS float* pp = part + ((grp * 4 + kq) * 64 + C.lane) * 33;
#pragma unroll
          for (int e = 0; e < 32; ++e) pp[e] = acc[e]; }
        __syncthreads();
        int te[4] = {0, 0, 0, 0}, lp[4] = {0, 0, 0, 0}; float tg[4] = {0.f, 0.f, 0.f, 0.f};
        if (C.tid < 128) { const int grp = C.tid >> 6, ln = C.tid & 63; float lg[32];
#pragma unroll
            for (int e = 0; e < 32; ++e) { float s = br[e];
#pragma unroll
                for (int kq = 0; kq < 4; ++kq) s += part[((grp * 4 + kq) * 64 + ln) * 33 + e];
                lg[e] = s; }
            float tv[4]; const float kninf = KF(-__builtin_inff());
#pragma unroll
            for (int k = 0; k < 4; ++k) { float best = lg[0]; int bi = 0;
#pragma unroll
                for (int e = 1; e < 32; ++e) { const bool gt = lg[e] > best; best = gt ? lg[e] : best; bi = gt ? e : bi; }
                te[k] = bi; tv[k] = best;
#pragma unroll
                for (int e = 0; e < 32; ++e) lg[e] = (e == bi) ? kninf : lg[e]; }
            float den = 0.f;
#pragma unroll
            for (int k = 0; k < 4; ++k) { tg[k] = __expf(tv[k] - tv[0]); den += tg[k]; }
            const float rden = 1.0f / den;
#pragma unroll
            for (int k = 0; k < 4; ++k) { tg[k] *= rden; lp[k] = __hip_atomic_fetch_add((LAS int*)&lcnt[te[k]], 1, __ATOMIC_RELAXED, __HIP_MEMORY_SCOPE_WORKGROUP); } }
        __syncthreads();
        if (C.tid < 32) lbase[C.tid] = (int)__hip_atomic_fetch_add(gcnt + C.tid, (unsigned)lcnt[C.tid], __ATOMIC_RELAXED, __HIP_MEMORY_SCOPE_AGENT);
        __syncthreads();
        if (C.tid < 128) { const int tok = row0 + C.tid;
#pragma unroll
            for (int k = 0; k < 4; ++k) { const int pos = lbase[te[k]] + lp[k]; lists[(size_t)te[k] * T + pos] = tok; slot[tok * 4 + k] = te[k] * T + pos; gate[tok * 4 + k] = tg[k]; } }
        __syncthreads();
    }
}

__device__ __forceinline__ void phase_combine_ln2(const CAS Args& args, const Ctx& C0, int layer) {
    Ctx C = C0; C.tid = opaque_tid(); C.lane = C.tid & 63;
    moe_table(args, C, layer);
    const bf16_t* X1B = WSP(bf16_t, WS_X1B); const bf16_t* YS = WSP(bf16_t, WS_YS); const int* slot = WSP(int, WS_SLOT); const float* gate = WSP(float, WS_GATE);
    bf16_t* X2B = WSP(bf16_t, WS_X2B);
    const float* g2 = INF(I_LN2G) + layer * DM; const float* b2 = INF(I_LN2B) + layer * DM;
    f32x4 gv[4], bv[4];
#pragma unroll
    for (int j = 0; j < 2; ++j) { gv[2 * j] = *(const f32x4*)(g2 + 8 * C.lane + 512 * j); gv[2 * j + 1] = *(const f32x4*)(g2 + 8 * C.lane + 512 * j + 4);
        bv[2 * j] = *(const f32x4*)(b2 + 8 * C.lane + 512 * j); bv[2 * j + 1] = *(const f32x4*)(b2 + 8 * C.lane + 512 * j + 4); }
    const int gw = C.vcu * NWAVES + C.wave, NGW = C.G * NWAVES;
    for (int row = gw; row < T; row += NGW) {
        f32x4 v[4];
#pragma unroll
        for (int j = 0; j < 2; ++j) { const u32x4 w = *(const u32x4*)(X1B + (size_t)row * DM + 8 * C.lane + 512 * j); v[2 * j] = pg8::bf4_lo(w) * ALPHA; v[2 * j + 1] = pg8::bf4_hi(w) * ALPHA; }
#pragma unroll
        for (int k = 0; k < 4; ++k) { const int sv = slot[row * 4 + k]; const float g = gate[row * 4 + k]; const int e = sv >> 15, pos = sv & (T - 1);
            const size_t prow = (size_t)C.misc[16 + e] * 256 + pos;
#pragma unroll
            for (int j = 0; j < 2; ++j) { const u32x4 w = *(const u32x4*)(YS + prow * DM + 8 * C.lane + 512 * j); v[2 * j] += pg8::bf4_lo(w) * g; v[2 * j + 1] += pg8::bf4_hi(w) * g; } }
        float s = 0.f;
#pragma unroll
        for (int j = 0; j < 4; ++j) s += (v[j][0] + v[j][1]) + (v[j][2] + v[j][3]);
        const float mean = wave_sum(s) * (1.f / DM); float s2 = 0.f;
#pragma unroll
        for (int j = 0; j < 4; ++j) { v[j] = v[j] - mean; s2 += (v[j][0] * v[j][0] + v[j][1] * v[j][1]) + (v[j][2] * v[j][2] + v[j][3] * v[j][3]); }
        const float rstd = 1.f / sqrtf(wave_sum(s2) * (1.f / DM) + KF(LN_EPS));
#pragma unroll
        for (int j = 0; j < 4; ++j) v[j] = v[j] * rstd * gv[j] + bv[j];
#pragma unroll
        for (int j = 0; j < 2; ++j) *(u32x4*)(X2B + (size_t)row * DM + 8 * C.lane + 512 * j) = pack8(v[2 * j], v[2 * j + 1]);
    }
}

__device__ __forceinline__ void phase_conv(const CAS Args& args, const Ctx& C0, int j) {
    Ctx C = C0; C.tid = opaque_tid(); C.lane = C.tid & 63;
    const bf16_t* U = WSP(bf16_t, WS_U); bf16_t* UC = WSP(bf16_t, WS_UC);
    const float* cw = INF(I_LRU_CW) + (size_t)j * 4 * DM; const float* cb = INF(I_LRU_CB) + (size_t)j * DM;
    const int c8 = (C.tid & 127) * 8, rsub = C.tid >> 7;
    float w[4][8], bb[8];
#pragma unroll
    for (int q = 0; q < 4; ++q)
#pragma unroll
        for (int e = 0; e < 8; ++e) w[q][e] = cw[q * DM + c8 + e];
#pragma unroll
    for (int e = 0; e < 8; ++e) bb[e] = cb[c8 + e];
    for (int chunk = C.vcu; chunk < T / 128; chunk += C.G) {
        const int r0 = chunk * 128 + rsub * 32;
        u32x4 h0, h1, h2;
        const u32x4 z = {0u, 0u, 0u, 0u};
        const int s0 = r0 & (SEQ - 1);
        h0 = s0 >= 3 ? *(const u32x4*)(U + (size_t)(r0 - 3) * DM + c8) : z; h1 = s0 >= 2 ? *(const u32x4*)(U + (size_t)(r0 - 2) * DM + c8) : z; h2 = s0 >= 1 ? *(const u32x4*)(U + (size_t)(r0 - 1) * DM + c8) : z;
#pragma unroll 4
        for (int i = 0; i < 32; ++i) { const u32x4 h3 = *(const u32x4*)(U + (size_t)(r0 + i) * DM + c8);
            float o[8];
#pragma unroll
            for (int q = 0; q < 4; ++q) { const unsigned a = h0[q], b = h1[q], c = h2[q], d = h3[q];
                o[2 * q] = bb[2 * q] + w[0][2 * q] * bf_lo(a) + w[1][2 * q] * bf_lo(b) + w[2][2 * q] * bf_lo(c) + w[3][2 * q] * bf_lo(d);
                o[2 * q + 1] = bb[2 * q + 1] + w[0][2 * q + 1] * bf_hi(a) + w[1][2 * q + 1] * bf_hi(b) + w[2][2 * q + 1] * bf_hi(c) + w[3][2 * q + 1] * bf_hi(d); }
            u32x4 ow; ow.x = cvt_pk_bf16(o[0], o[1]); ow.y = cvt_pk_bf16(o[2], o[3]); ow.z = cvt_pk_bf16(o[4], o[5]); ow.w = cvt_pk_bf16(o[6], o[7]);
            *(u32x4*)(UC + (size_t)(r0 + i) * DM + c8) = ow; h0 = h1; h1 = h2; h2 = h3; }
    }
}
__device__ __forceinline__ void phase_scan1(const CAS Args& args, const Ctx& C0) {
    Ctx C = C0; C.tid = opaque_tid(); C.lane = C.tid & 63;
    const bf16_t* LA = WSP(bf16_t, WS_AA); const bf16_t* BB = WSP(bf16_t, WS_BB); float* CA = WSP(float, WS_CA); float* CH = WSP(float, WS_CH);
    const int c2 = C.tid * 2;
    for (int item = C.vcu; item < NBATCH * 64; item += C.G) {
        const size_t r0 = (size_t)item * 64; float h0 = 0.f, h1 = 0.f, l0 = 0.f, l1 = 0.f;
#pragma unroll 8
        for (int s = 0; s < 64; ++s) { const unsigned aw = *(const unsigned*)(LA + (r0 + s) * DM + c2), bw = *(const unsigned*)(BB + (r0 + s) * DM + c2);
            const float la0 = bf_lo(aw), la1 = bf_hi(aw);
            h0 = __builtin_amdgcn_exp2f(la0) * h0 + bf_lo(bw); h1 = __builtin_amdgcn_exp2f(la1) * h1 + bf_hi(bw); l0 += la0; l1 += la1; }
        *(f32x2*)(CA + (size_t)item * DM + c2) = (f32x2){__builtin_amdgcn_exp2f(l0), __builtin_amdgcn_exp2f(l1)}; *(f32x2*)(CH + (size_t)item * DM + c2) = (f32x2){h0, h1};
    }
}
__device__ __forceinline__ void phase_scan2(const CAS Args& args, const Ctx& C0) {
    Ctx C = C0; C.tid = opaque_tid(); C.lane = C.tid & 63;
    const bf16_t* LA = WSP(bf16_t, WS_AA); const bf16_t* BB = WSP(bf16_t, WS_BB); const float* CA = WSP(float, WS_CA); const float* CH = WSP(float, WS_CH);
    const bf16_t* GG = WSP(bf16_t, WS_GG); bf16_t* YL = WSP(bf16_t, WS_O);
    const int c2 = C.tid * 2;
    for (int item = C.vcu; item < NBATCH * 64; item += C.G) {
        const int b = item >> 6, ch = item & 63; float h0 = 0.f, h1 = 0.f;
        for (int jx = 0; jx < ch; ++jx) { const f32x2 a = *(const f32x2*)(CA + (size_t)(b * 64 + jx) * DM + c2), e = *(const f32x2*)(CH + (size_t)(b * 64 + jx) * DM + c2);
            h0 = a[0] * h0 + e[0]; h1 = a[1] * h1 + e[1]; }
        const size_t r0 = (size_t)item * 64;
#pragma unroll 8
        for (int s = 0; s < 64; ++s) { const unsigned aw = *(const unsigned*)(LA + (r0 + s) * DM + c2), bw = *(const unsigned*)(BB + (r0 + s) * DM + c2), g = *(const unsigned*)(GG + (r0 + s) * DM + c2);
            h0 = __builtin_amdgcn_exp2f(bf_lo(aw)) * h0 + bf_lo(bw); h1 = __builtin_amdgcn_exp2f(bf_hi(aw)) * h1 + bf_hi(bw);
            *(unsigned*)(YL + (r0 + s) * DM + c2) = cvt_pk_bf16(bf_lo(g) * h0, bf_hi(g) * h1); }
    }
}

#if PROBE_T
typedef int v8i_t __attribute__((ext_vector_type(8)));
__device__ __forceinline__ unsigned fp8_of_int(int v) { const unsigned char t[4] = {0x00, 0x38, 0x40, 0x44}; const int a = v < 0 ? -v : v; return (unsigned)t[a] | (v < 0 ? 0x80u : 0u); }
__device__ __forceinline__ int tA(int i, int k) { return ((i * 3 + k * 5) % 7) - 3; }
__device__ __forceinline__ int tB(int k, int j) { return ((k * 2 + j * 7) % 5) - 2; }
__device__ __forceinline__ void mfma_fp8_selftest(unsigned* flagw) {
    const int l = threadIdx.x & 63, r = l & 15, q = l >> 4;
    v8i_t A, B;
#pragma unroll
    for (int d = 0; d < 8; ++d) { unsigned wa = 0, wb = 0;
#pragma unroll
        for (int b = 0; b < 4; ++b) { const int k = 32 * q + 4 * d + b; wa |= fp8_of_int(tA(r, k)) << (8 * b); wb |= fp8_of_int(tB(k, r)) << (8 * b); }
        A[d] = (int)wa; B[d] = (int)wb; }
    const f32x4 z = {0.f, 0.f, 0.f, 0.f};
    const int U = 0x7f7f7f7f;
    const int saq = (127 + q) * 0x01010101;
    const int sab = (q == 0) ? (int)0x8281807fu : U;
    const f32x4 m2 = __builtin_amdgcn_mfma_scale_f32_16x16x128_f8f6f4(A, B, z, 0, 0, 0, saq, 0, U);
    const f32x4 m5 = __builtin_amdgcn_mfma_scale_f32_16x16x128_f8f6f4(A, B, z, 0, 0, 0, sab, 0, U);
    bool k1 = true, k2 = true, k3 = true, k4 = true;
#pragma unroll
    for (int e = 0; e < 4; ++e) { const int i = 4 * q + e, j = r; float eb = 0.f, e0 = 0.f, ec = 0.f, ed = 0.f;
        for (int kq = 0; kq < 4; ++kq) for (int hh = 0; hh < 2; ++hh) { float sh = 0.f; for (int k = 32 * kq + 16 * hh; k < 32 * kq + 16 * hh + 16; ++k) sh += (float)(tA(i, k) * tB(k, j));
            const int xb = hh == 0 ? (kq >> 1) : 2 + (kq >> 1);
            eb += sh * (float)(1 << xb); e0 += sh; ec += sh * (float)(1 << kq); ed += sh * (float)(1 << xb); }
        k1 = k1 && (m2[e] == eb); k2 = k2 && (m2[e] == e0); k3 = k3 && (m5[e] == ec); k4 = k4 && (m5[e] == ed); }
    const bool b1 = __all(k1), b2 = __all(k2), b3 = __all(k3), b4 = __all(k4);
    if (l == 0) *flagw = (b1 ? 1u : 0u) | (b2 ? 2u : 0u) | (b3 ? 4u : 0u) | (b4 ? 8u : 0u);
}
#endif
constexpr int PH_PER_LAYER = 12, PH_TOTAL = 2 + PH_PER_LAYER * DEPTH;
__global__ void __launch_bounds__(NWAVES * 64, 2) fwd_kernel(Args args_kernarg) {
    (void)args_kernarg;
    ArgsP const argp = (ArgsP)__builtin_amdgcn_kernarg_segment_ptr();
    const CAS Args& args0 = *argp;
    extern __shared__ __attribute__((aligned(16))) unsigned char lds_raw[];
    Ctx C_;
    C_.lds = (LAS unsigned char*)lds_raw; C_.misc = (volatile LAS int*)(C_.lds + MISC_OFF);
    C_.tid = threadIdx.x; C_.lane = C_.tid & 63; C_.wave = __builtin_amdgcn_readfirstlane(C_.tid >> 6);
    C_.bid = (int)blockIdx.x; C_.G = gridDim.x; { const int bx = blockIdx.x; C_.vcu = (C_.G % 8 == 0) ? (bx % 8) * (C_.G / 8) + bx / 8 : bx; }
    for (int u = C_.tid; u < 128; u += NWAVES * 64) C_.misc[u] = 0;
    __syncthreads();
    XcdBarrier bar = xcd_barrier_post((unsigned*)(args0.ws + WS_CTL) + CW_BAR + args0.li * XCD_BAR_WORDS, (volatile LAS unsigned*)C_.misc);
    const int lo = args0.ph_lo, hi = args0.ph_hi;
#define IN(k) (lo <= (k) && (k) < hi)
#define PH_END(k) do { if ((k) + 1 < hi) xcd_barrier(bar); } while (0)

    if (SEL(0) && IN(0)) { const CAS Args& args = fresh_args(argp); const Ctx C = fresh_ctx(C_); const int cid = C.bid; phase_prologue(args, C); PH_END(0); }
    if (SEL(1) && IN(1)) { const CAS Args& args = fresh_args(argp); const Ctx C = fresh_ctx(C_); const int cid = C.bid;
        pg8::DenseSched S; S.init(WSP(bf16_t, WS_PB), WSP(bf16_t, WS_W_PLE + OFF_PLE_WP), PLED, PLED, DEPTH * T, DM, C.G, cid); S.bpm_shift = 7; S.bbatch = W_PLE_STRIDE;
        pg8::EpiPP E{WSP(bf16_t, WS_PP)};
        pg8::gemm_phase<pg8::EpiPP, pg8::DenseSched, false>(C.lds, PLED / 64, PLED * 2, PLED * 2, S, E);
        PH_END(1);
    }
    for (int layer = 0; layer < DEPTH; ++layer) {
        const int base = 2 + PH_PER_LAYER * layer, j = layer >> 1;
        if ((layer & 1) == 0) {
            if (SEL(2) && IN(base + 0)) { const CAS Args& args = fresh_args(argp); const Ctx C = fresh_ctx(C_); const int cid = C.bid; const unsigned char* wm = args.ws + WS_W_MLA + (size_t)j * W_MLA_STRIDE;
                pg8::DenseSched S; S.init(WSP(bf16_t, WS_XB), wm + OFF_MLA_WIN, DM, DM, T, 1280, C.G, cid);
                pg8::EpiLat E{WSP(bf16_t, WS_LAT), WSP(float, WS_SSQ), WSP(bf16_t, WS_KR), WSP(float, WS_CS), WSP(float, WS_SN)};
                pg8::gemm_phase<pg8::EpiLat, pg8::DenseSched, false>(C.lds, DM / 64, DM * 2, DM * 2, S, E);
                PH_END(base + 0);
            }
            if (SEL(3) && IN(base + 1)) { const CAS Args& args = fresh_args(argp); const Ctx C = fresh_ctx(C_); const int cid = C.bid; const unsigned char* wm = args.ws + WS_W_MLA + (size_t)j * W_MLA_STRIDE;
                { pg8::DenseSched S; S.init(WSP(bf16_t, WS_LAT), wm + OFF_MLA_WUQ, DM, QL, T, 1536, C.G, cid);
                  pg8::EpiQ E{WSP(bf16_t, WS_Q), WSP(float, WS_SSQ), WSP(float, WS_CS), WSP(float, WS_SN)};
                  pg8::gemm_phase<pg8::EpiQ, pg8::DenseSched, false>(C.lds, QL / 64, DM * 2, QL * 2, S, E); }
                { pg8::DenseSched S; S.init(WSP(bf16_t, WS_LAT) + QL, wm + OFF_MLA_WUKV, DM, KVL, T, 2048, C.G, cid);
                  pg8::EpiKV E{WSP(bf16_t, WS_KN), WSP(bf16_t, WS_V), WSP(float, WS_SSQ)};
                  pg8::gemm_phase<pg8::EpiKV, pg8::DenseSched, false>(C.lds, KVL / 64, DM * 2, KVL * 2, S, E); }
                PH_END(base + 1);
            }
            if (SEL(4) && IN(base + 2)) { const CAS Args& args = fresh_args(argp); const Ctx C = fresh_ctx(C_); const int cid = C.bid;
                for (int it = C.vcu; it < NBATCH * NH * 8; it += C.G) { const int bh = it >> 3, pr = it & 7;
                    att::attn_block(bh >> 3, bh & 7, pr, WSP(bf16_t, WS_Q), WSP(bf16_t, WS_KN), WSP(bf16_t, WS_KR), WSP(bf16_t, WS_V), WSP(bf16_t, WS_O), (LAS char*)C.lds, PROBE_T ? (unsigned long long*)(args.ws + WS_CTL + 8192) : nullptr);
                    att::attn_block(bh >> 3, bh & 7, 15 - pr, WSP(bf16_t, WS_Q), WSP(bf16_t, WS_KN), WSP(bf16_t, WS_KR), WSP(bf16_t, WS_V), WSP(bf16_t, WS_O), (LAS char*)C.lds, PROBE_T ? (unsigned long long*)(args.ws + WS_CTL + 8192) : nullptr); }
                PH_END(base + 2);
            }
        } else {
            if (SEL(5) && IN(base + 0)) { const CAS Args& args = fresh_args(argp); const Ctx C = fresh_ctx(C_); const int cid = C.bid; const unsigned char* wl = args.ws + WS_W_LRU + (size_t)j * W_LRU_STRIDE;
                pg8::DenseSched S; S.init(WSP(bf16_t, WS_XB), wl + OFF_LRU_WIN, DM, DM, T, 2048, C.G, cid);
                pg8::EpiGU E{WSP(bf16_t, WS_GG), WSP(bf16_t, WS_U)};
                pg8::gemm_phase<pg8::EpiGU, pg8::DenseSched, false>(C.lds, DM / 64, DM * 2, DM * 2, S, E);
                PH_END(base + 0);
            }
            if (SEL(6) && IN(base + 1)) { const CAS Args& args = fresh_args(argp); const Ctx C = fresh_ctx(C_); const int cid = C.bid; phase_conv(args, C, j); PH_END(base + 1); }
            if (SEL(7) && IN(base + 2)) { const CAS Args& args = fresh_args(argp); const Ctx C = fresh_ctx(C_); const int cid = C.bid; const unsigned char* wl = args.ws + WS_W_LRU + (size_t)j * W_LRU_STRIDE;
                pg8::DenseSched S; S.init(WSP(bf16_t, WS_UC), wl + OFF_LRU_WAX, DM, 256, T, 2048, C.G, cid); S.apn_shift = 1; S.akbytes = 512;
                pg8::EpiAB E{WSP(bf16_t, WS_AA), WSP(bf16_t, WS_BB), WSP(bf16_t, WS_UC), INF(I_LRU_BA) + j * DM, INF(I_LRU_BX) + j * DM, WSP(float, WS_SPL) + j * DM};
                pg8::gemm_phase<pg8::EpiAB, pg8::DenseSched, false>(C.lds, 4, DM * 2, 512, S, E);
                PH_END(base + 2);
            }
            if (SEL(8) && IN(base + 3)) { const CAS Args& args = fresh_args(argp); const Ctx C = fresh_ctx(C_); const int cid = C.bid; phase_scan1(args, C); PH_END(base + 3); }
            if (SEL(9) && IN(base + 4)) { const CAS Args& args = fresh_args(argp); const Ctx C = fresh_ctx(C_); const int cid = C.bid; phase_scan2(args, C); PH_END(base + 4); }
        }
        if (SEL(10) && IN(base + 5)) { const CAS Args& args = fresh_args(argp); const Ctx C = fresh_ctx(C_); const int cid = C.bid;
            const unsigned char* wo = (layer & 1) ? args.ws + WS_W_LRU + (size_t)j * W_LRU_STRIDE + OFF_LRU_WOUT : args.ws + WS_W_MLA + (size_t)j * W_MLA_STRIDE + OFF_MLA_WO;
            pg8::DenseSched S; S.init(WSP(bf16_t, WS_O), wo, DM, DM, T, DM, C.G, cid);
            pg8::EpiRes E{WSP(bf16_t, WS_XB), WSP(bf16_t, WS_Y)};
            pg8::gemm_phase<pg8::EpiRes, pg8::DenseSched, false>(C.lds, DM / 64, DM * 2, DM * 2, S, E);
            PH_END(base + 5);
        }
        if (SEL(11) && IN(base + 6)) { const CAS Args& args = fresh_args(argp); const Ctx C = fresh_ctx(C_); const int cid = C.bid; phase_ln_router(args, C, layer); PH_END(base + 6); }
        if (SEL(12) && IN(base + 7)) { const CAS Args& args = fresh_args(argp); const Ctx C = fresh_ctx(C_); const int cid = C.bid;
            moe_table(args, C, layer);
            pg8::MoeSched S{(const char*)(args.ws + WS_X1Q), (const char*)(args.ws + WS_W_UP + (size_t)layer * NE * 2048 * 1024), (size_t)2048 * 1024, (const char*)(args.ws + WS_SW + (size_t)layer * NE * 65536), DM, DM, 8, WSP(int, WS_LIST), C.misc + 16, (volatile LAS const unsigned char*)(C.lds + TILE_E_OFF), C.G, cid, true, nullptr};
            const int sae = 127 - (int)__hip_atomic_load(WSP(unsigned, WS_CTL) + CW_SA + layer, __ATOMIC_RELAXED, __HIP_MEMORY_SCOPE_AGENT);
            pg8::EpiUp E{args.ws + WS_H, args.ws + WS_SH, INF(I_MOE_BUP) + (size_t)layer * NE * 2048};
            pg8::gemm_phase<pg8::EpiUp, pg8::MoeSched, true, 1>(C.lds, DM / 128, DM, DM, S, E, PROBE_T ? (unsigned long long*)(args.ws + WS_CTL + 8192) : nullptr, sae * 0x01010101);
            PH_END(base + 7);
        }
        if (SEL(13) && IN(base + 8)) { const CAS Args& args = fresh_args(argp); const Ctx C = fresh_ctx(C_); const int cid = C.bid;
            moe_table(args, C, layer);
            pg8::MoeSched S{(const char*)(args.ws + WS_H), (const char*)(args.ws + WS_W_DN + (size_t)layer * NE * 1024 * 1024), (size_t)1024 * 1024, (const char*)(args.ws + WS_SWD + (size_t)layer * NE * 16384), DFF, DFF, 4, WSP(int, WS_LIST), C.misc + 16, (volatile LAS const unsigned char*)(C.lds + TILE_E_OFF), C.G, cid, false, (const char*)(args.ws + WS_SH)};
            pg8::EpiDown E{WSP(bf16_t, WS_YS), INF(I_MOE_BDN) + (size_t)layer * NE * DM};
            pg8::gemm_phase<pg8::EpiDown, pg8::MoeSched, false, 2>(C.lds, DFF / 128, DFF, DFF, S, E);
            PH_END(base + 8);
        }
        if (SEL(14) && IN(base + 9)) { const CAS Args& args = fresh_args(argp); const Ctx C = fresh_ctx(C_); const int cid = C.bid; phase_combine_ln2(args, C, layer); PH_END(base + 9); }
        if (SEL(15) && IN(base + 10)) { const CAS Args& args = fresh_args(argp); const Ctx C = fresh_ctx(C_); const int cid = C.bid;
            pg8::DenseSched S; S.init(WSP(bf16_t, WS_X2B), args.ws + WS_W_PLE + (size_t)layer * W_PLE_STRIDE + OFF_PLE_WG, DM, DM, T, DM, C.G, cid);
            pg8::EpiPle E{WSP(bf16_t, WS_X2B), WSP(bf16_t, WS_PP) + (size_t)layer * T * DM, layer == DEPTH - 1 ? args.out : (float*)nullptr, WSP(bf16_t, WS_XB)};
            pg8::gemm_phase<pg8::EpiPle, pg8::DenseSched, false>(C.lds, DM / 64, DM * 2, DM * 2, S, E);
            if (layer + 1 < DEPTH) PH_END(base + 10);
        }
    }
#if PROBE_T
    if (PROBE_T == 20 && blockIdx.x == 0 && threadIdx.x < 64) { const CAS Args& args = fresh_args(argp); mfma_fp8_selftest((unsigned*)(args.ws + WS_CTL + 8192 + 256)); }
    { xcd_barrier(bar); const CAS Args& args = fresh_args(argp);
      const unsigned long long* pw = (const unsigned long long*)(args.ws + WS_CTL + 8192);
      const double pk = (double)__hip_atomic_load(pw + 0, __ATOMIC_RELAXED, __HIP_MEMORY_SCOPE_AGENT), pe = (double)__hip_atomic_load(pw + 1, __ATOMIC_RELAXED, __HIP_MEMORY_SCOPE_AGENT),
                   pn = (double)__hip_atomic_load(pw + 2, __ATOMIC_RELAXED, __HIP_MEMORY_SCOPE_AGENT), pt = (double)__hip_atomic_load(pw + 3, __ATOMIC_RELAXED, __HIP_MEMORY_SCOPE_AGENT);
      float c = 100.f;
      if (PROBE_T == 2) c = (float)(pk / (pn * 16.0) / 10.0);
      if (PROBE_T == 3) c = (float)(pe / pn / 100.0);
      if (PROBE_T == 4) c = (float)((pt - pk - pe) / pn / 100.0);
      if (PROBE_T == 5) c = (float)(pn);
      if (PROBE_T >= 10) { double q[7]; for (int i = 0; i < 7; ++i) q[i] = (double)__hip_atomic_load(pw + 8 + i, __ATOMIC_RELAXED, __HIP_MEMORY_SCOPE_AGENT);
          if (PROBE_T == 10) c = (float)(q[6] / q[5] / 10.0);
          if (PROBE_T == 11) c = (float)(q[0] / q[5] / 10.0);
          if (PROBE_T == 12) c = (float)(q[1] / q[5] / 10.0);
          if (PROBE_T == 13) c = (float)(q[2] / q[5] / 10.0);
          if (PROBE_T == 14) c = (float)(q[3] / q[5] / 10.0);
          if (PROBE_T == 15) c = (float)(q[4] / q[5] / 10.0); }
      if (PROBE_T >= 2 && PROBE_T < 20) c = exp2f(floorf(log2f(c) * 8.0f + PROBE_SHIFT) * 0.125f);
      if (PROBE_T == 20) { const unsigned fl = __hip_atomic_load((const unsigned*)(args.ws + WS_CTL + 8192 + 256), __ATOMIC_RELAXED, __HIP_MEMORY_SCOPE_AGENT); c = 100.f + 10.f * (float)fl; }
      for (size_t i = (size_t)blockIdx.x * 512 + threadIdx.x; i < (size_t)T * DM; i += (size_t)gridDim.x * 512) args.out[i] = c; }
#endif
#undef IN
#undef PH_END
}

extern "C" void kernel_launch(void* const* d_in, const int* in_sizes, int n_in, void* d_out, int out_size, void* d_ws, size_t ws_size, hipStream_t stream) {
    static int grid = 0;
    if (grid == 0) {
        if (n_in != 30 || in_sizes[0] != T * DM || out_size != T * DM || ws_size < WS_END) { fprintf(stderr, "kernel_launch: unexpected shapes (n_in %d, in0 %d, out %d, ws %zu)\n", n_in, n_in > 0 ? in_sizes[0] : -1, out_size, ws_size); grid = -1; return; }
        int dev = 0, cus = 0, per_cu = 0;
        if (hipGetDevice(&dev) != hipSuccess || hipDeviceGetAttribute(&cus, hipDeviceAttributeMultiprocessorCount, dev) != hipSuccess) { grid = -1; return; }
        if (hipFuncSetAttribute((const void*)fwd_kernel, hipFuncAttributeMaxDynamicSharedMemorySize, LDS_BYTES) != hipSuccess) { fprintf(stderr, "kernel_launch: hipFuncSetAttribute failed\n"); grid = -1; return; }
        if (hipOccupancyMaxActiveBlocksPerMultiprocessor(&per_cu, (const void*)fwd_kernel, NWAVES * 64, LDS_BYTES) != hipSuccess || per_cu < 1) fprintf(stderr, "kernel_launch: occupancy query reports %d\n", per_cu);
        (void)hipGetLastError();
        grid = cus;
    }
    if (grid < 0) return;
    if (hipMemsetAsync((char*)d_ws + WS_CTL, 0, CTL_ZERO_BYTES, stream) != hipSuccess) return;
    Args a{};
    for (int i = 0; i < 30; ++i) a.in[i] = d_in[i];
    a.out = (float*)d_out; a.ws = (unsigned char*)d_ws; a.pad = 0;
#if MK_ONE_LAUNCH
    a.ph_lo = 0; a.ph_hi = PH_TOTAL; a.li = 0;
    hipLaunchKernelGGL(fwd_kernel, dim3(grid), dim3(NWAVES * 64), LDS_BYTES, stream, a);
#else
    int li = 0;
    for (int ph = 0; ph < PH_TOTAL; ++ph) {
        if (ph >= 2) { const int l = (ph - 2) / PH_PER_LAYER, k = (ph - 2) % PH_PER_LAYER; if (k == 11) continue; if ((l & 1) == 0 && (k == 3 || k == 4)) continue; }
        int site = ph;
        if (ph >= 2) { const int l = (ph - 2) / PH_PER_LAYER, k = (ph - 2) % PH_PER_LAYER; static const int mla[11] = {2, 3, 4, -1, -1, 10, 11, 12, 13, 14, 15}, lru[11] = {5, 6, 7, 8, 9, 10, 11, 12, 13, 14, 15}; site = (l & 1) ? lru[k] : mla[k]; }
        a.ph_lo = ph; a.ph_hi = ph + 1;
        if ((HOSTDUP >> site) & 1) { a.li = li++; a.pad = 4; hipLaunchKernelGGL(fwd_kernel, dim3(grid), dim3(NWAVES * 64), LDS_BYTES, stream, a); }
        a.li = li++; a.pad = 0;
        hipLaunchKernelGGL(fwd_kernel, dim3(grid), dim3(NWAVES * 64), LDS_BYTES, stream, a);
    }
#endif
}
```

```cpp
#include <hip/hip_runtime.h>
#include <hip/hip_bf16.h>
#include <cstdio>
#include <cstdint>

#ifndef PHSEL
#define PHSEL -1
#endif
#ifndef PHSKIP
#define PHSKIP -1
#endif
#define SEL(id) ((PHSEL < 0 || PHSEL == (id)) && PHSKIP != (id))
#ifndef PROBE_T
#define PROBE_T 0
#endif
#ifndef PROBE_SHIFT
#define PROBE_SHIFT 0.0f
#endif
#ifndef HOSTDUP
#define HOSTDUP 0
#endif
#ifndef MK_ONE_LAUNCH
#define MK_ONE_LAUNCH 1
#endif

constexpr int T = 32768, SEQ = 4096, NBATCH = 8, DM = 1024, DEPTH = 4;
constexpr int QL = 768, KVL = 256, ROPE = 64, LATD = 1088, NH = 8, DQK = 192, DV = 128;
constexpr int NE = 32, TOPK = 4, DFF = 1024, PLED = 256;
constexpr float ALPHA = 1.681792830507429f;
constexpr float LN_EPS = 1e-5f, RMS_EPS = 1e-6f;
constexpr float QSCALE = 1.4426950408889634f / 13.856406460551018f;
constexpr int NWAVES = 8;

constexpr size_t MiB = 1u << 20;
constexpr size_t WS_CTL = 0, CTL_ZERO_BYTES = 2 * MiB;
constexpr size_t WS_CS = 2 * MiB, WS_SN = 6 * MiB, WS_SPL = 10 * MiB;
constexpr size_t WS_WRH = WS_SPL + 65536, WS_WRL = WS_WRH + 262144;
constexpr size_t WS_W_MLA = 12 * MiB, W_MLA_STRIDE = 8 * MiB;
constexpr size_t OFF_MLA_WIN = 0, OFF_MLA_WUQ = 2560 * 1024, OFF_MLA_WUKV = OFF_MLA_WUQ + 2304 * 1024, OFF_MLA_WO = OFF_MLA_WUKV + 1024 * 1024;
constexpr size_t WS_W_LRU = 28 * MiB, W_LRU_STRIDE = 8 * MiB;
constexpr size_t OFF_LRU_WIN = 0, OFF_LRU_WAX = 4 * MiB, OFF_LRU_WOUT = 5 * MiB;
constexpr size_t WS_W_PLE = 44 * MiB, W_PLE_STRIDE = 3 * MiB;
constexpr size_t OFF_PLE_WG = 0, OFF_PLE_WP = 2 * MiB;
constexpr size_t WS_W_UP = 56 * MiB;
constexpr size_t WS_W_DN = 568 * MiB;
constexpr size_t WS_XB = 824 * MiB, WS_PB = 888 * MiB, WS_PP = 952 * MiB;
constexpr size_t WS_Y = 1208 * MiB, WS_X1 = 1336 * MiB, WS_X1B = 1464 * MiB, WS_X2 = 1528 * MiB, WS_X2B = 1656 * MiB;
constexpr size_t WS_LAT = 1720 * MiB, WS_KR = 1784 * MiB, WS_SSQ = 1788 * MiB, WS_Q = 1790 * MiB, WS_KN = 1886 * MiB, WS_V = 1950 * MiB, WS_O = 2014 * MiB;
constexpr size_t WS_GG = 2078 * MiB, WS_U = 2142 * MiB, WS_UC = 2206 * MiB, WS_AA = 2270 * MiB, WS_BB = 2398 * MiB, WS_CA = 2526 * MiB, WS_CH = 2528 * MiB;
constexpr size_t WS_H = 2530 * MiB, WS_YS = 2802 * MiB, WS_LIST = 3074 * MiB, WS_SLOT = 3078 * MiB, WS_GATE = 3079 * MiB, WS_SW = 3080 * MiB  , WS_X1Q = 3088 * MiB  , WS_SH = 3120 * MiB  ,
                 WS_SWD = 3128 * MiB  , WS_END = 3132 * MiB;
constexpr int PADROWS = T * TOPK + NE * 256;
static_assert((size_t)PADROWS * DFF * 2 <= 272 * MiB, "H / YS size");
constexpr int CW_SA = 128;
constexpr int CW_CNT = 256;
constexpr int CW_BAR = 4096;

constexpr int RING_BYTES = 133120;
constexpr int TILE_E_OFF = 131072;
constexpr int SCL_OFF = RING_BYTES;
constexpr int MISC_OFF = SCL_OFF + 24576;
constexpr int LDS_BYTES = 163840;

#define GAS __attribute__((address_space(1)))
#define LAS __attribute__((address_space(3)))
#define CAS __attribute__((address_space(4)))
typedef unsigned short bf16_t;
typedef short bf16x8 __attribute__((ext_vector_type(8)));
typedef short s16x4 __attribute__((ext_vector_type(4)));
typedef float f32x2 __attribute__((ext_vector_type(2)));
typedef float f32x4 __attribute__((ext_vector_type(4)));
typedef float f32x16 __attribute__((ext_vector_type(16)));
typedef unsigned u32x2 __attribute__((ext_vector_type(2)));
typedef unsigned u32x4 __attribute__((ext_vector_type(4)));

__device__ __forceinline__ unsigned cvt_pk_bf16(float lo, float hi) { unsigned r; asm volatile("v_cvt_pk_bf16_f32 %0, %1, %2" : "=v"(r) : "v"(lo), "v"(hi)); return r; }
__device__ __forceinline__ float bf_lo(unsigned w) { return __uint_as_float(w << 16); }
__device__ __forceinline__ float bf_hi(unsigned w) { return __uint_as_float(w & 0xffff0000u); }
__device__ __forceinline__ float sigmoidf_(float x) { return __builtin_amdgcn_rcpf(1.0f + __expf(-x)); }
__device__ __forceinline__ float gelu_tanh(float x) { const float u = 0.7978845608028654f * (x + 0.044715f * x * x * x); const float t = 1.0f - 2.0f * __builtin_amdgcn_rcpf(1.0f + __expf(2.0f * u)); return 0.5f * x * (1.0f + t); }
__device__ __forceinline__ u32x4 pack8(const f32x4 a, const f32x4 b) { u32x4 w; w.x = cvt_pk_bf16(a[0], a[1]); w.y = cvt_pk_bf16(a[2], a[3]); w.z = cvt_pk_bf16(b[0], b[1]); w.w = cvt_pk_bf16(b[2], b[3]); return w; }
__device__ __forceinline__ float KF(float v) { asm volatile("" : "+s"(v)); return v; }
__device__ __forceinline__ int opaque_tid() { int t = threadIdx.x; asm volatile("" : "+v"(t)); return t; }
__device__ __forceinline__ float wave_sum(float v) {
#pragma unroll
    for (int o = 1; o < 64; o <<= 1) v += __shfl_xor(v, o);
    return v;
}

namespace pg8 {
#define PG8_LAS __attribute__((address_space(3)))
constexpr int BM = 256, BK = 64, HALF = 128, HTB = HALF * BK * 2, STAGE_BYTES = 8 * HTB;
__host__ __device__ __forceinline__ int lds_byte(int r, int c) { const int st = (r >> 4) * 2 + (c >> 5), rr = r & 15, cc = c & 31, ob = rr * 64 + cc * 2; return st * 1024 + (ob ^ (((ob >> 9) & 1) << 5)); }
__host__ __device__ __forceinline__ void stage_rc(int b, int& R, int& C) { const int st = b / 1024, sb = b % 1024, swz = sb ^ (((sb >> 9) & 1) << 5); R = (st >> 1) * 16 + swz / 64; C = (st & 1) * 32 + (swz % 64) / 2; }
__host__ __device__ __forceinline__ int perm32(int rho) { const int n = rho >> 4, i = rho & 15; return 8 * (i >> 2) + 4 * n + (i & 3); }

struct Unit { const char* A; const char* B; const char* S; const char* SA; const int* lst; int nvalid; int pm, pn, aux; };

typedef int v4i_t __attribute__((ext_vector_type(4)));
typedef int v8i_t __attribute__((ext_vector_type(8)));
template <class Epi, class Sched, bool GATHER, int FPM = 0>
__device__ __forceinline__ void gemm_phase(PG8_LAS unsigned char* lds, const int nt  , const int lda  , const int ldb  , const Sched& S, const Epi& E, unsigned long long* pw = nullptr, const int sa = 0x7f7f7f7f) {
    constexpr bool FP8 = FPM != 0;
    const int tid = opaque_tid(), wid = __builtin_amdgcn_readfirstlane(tid >> 6), lane = tid & 63, wr = wid >> 2, wc = wid & 3, fr = lane & 15, fq = lane >> 4;
    unsigned voffB[2], ocA[2][2], onA[2][2];
#pragma unroll
    for (int i = 0; i < 2; ++i) { int R, C; stage_rc(tid * 16 + i * 8192, R, C); const int Rb = Epi::PERM ? ((R & ~31) + perm32(R & 31)) : R;
        voffB[i] = (unsigned)(Rb * ldb + C * 2);
        ocA[0][i] = (unsigned)(R * lda + C * 2); ocA[1][i] = (unsigned)((R + HALF) * lda + C * 2); onA[0][i] = ocA[0][i]; onA[1][i] = ocA[1][i]; }
    constexpr unsigned kstep = BK * 2;
    const unsigned hstepB = (unsigned)HALF * ldb;
    const unsigned ldsw = (unsigned)wid * 1024u;
    const int aoff = lds_byte(wr * 64 + fr, fq * 8), boff = lds_byte(wc * 32 + fr, fq * 8);
#define PG8_SA(b, h) (((b) * 2 + (h)) * HTB)
#define PG8_SB(b, h) ((4 + (b) * 2 + (h)) * HTB)
#define PG8_STAGE(bufoff, gbase, voff, kb) do { _Pragma("unroll") for (int _i = 0; _i < 2; ++_i) \
        __builtin_amdgcn_global_load_lds((const unsigned*)((const char*)(gbase) + (size_t)(unsigned)((voff)[_i] + (unsigned)(kb))), (PG8_LAS unsigned*)(lds + (bufoff) + ldsw + _i * 8192), 16, 0, 0); } while (0)
#define PG8_CAT(x0, x1) __builtin_shufflevector(x0, x1, 0, 1, 2, 3, 4, 5, 6, 7)
#define PG8_LO(x) __builtin_bit_cast(bf16x8, __builtin_shufflevector(x, x, 0, 1, 2, 3))
#define PG8_HI(x) __builtin_bit_cast(bf16x8, __builtin_shufflevector(x, x, 4, 5, 6, 7))
    const PG8_LAS unsigned char* const ldsA = lds + aoff; const PG8_LAS unsigned char* const ldsB = lds + 4 * HTB + boff;
#define PG8_LDA(dst, b, h) do { _Pragma("unroll") for (int m = 0; m < 4; ++m) dst[m] = PG8_CAT(*(const PG8_LAS v4i_t*)(ldsA + (PG8_SA(b, h) + m * 2048)), *(const PG8_LAS v4i_t*)(ldsA + (PG8_SA(b, h) + m * 2048 + 1024))); } while (0)
#define PG8_LDB(dst, b, h) do { _Pragma("unroll") for (int n = 0; n < 2; ++n) dst[n] = PG8_CAT(*(const PG8_LAS v4i_t*)(ldsB + (PG8_SB(b, h) - 4 * HTB + n * 2048)), *(const PG8_LAS v4i_t*)(ldsB + (PG8_SB(b, h) - 4 * HTB + n * 2048 + 1024))); } while (0)
#define PG8_MMA(ai, bj, At, Bt) do { __builtin_amdgcn_s_setprio(1); \
        if constexpr (FP8) { asm volatile("s_nop 4" ::: "memory"); _Pragma("unroll") for (int m = 0; m < 4; ++m) _Pragma("unroll") for (int n = 0; n < 2; ++n) \
            asm volatile("v_mfma_scale_f32_16x16x128_f8f6f4 %0, %1, %2, %0, %3, %4 op_sel_hi:[0,0,0]" : "+v"(acc[ai][bj][m][n]) : "v"(Bt[n]), "v"(At[m]), "v"(sB[bj][n]), "v"(FPM == 2 ? sA[m] : sav)); } \
        else { _Pragma("unroll") for (int m = 0; m < 4; ++m) _Pragma("unroll") for (int n = 0; n < 2; ++n) { \
            acc[ai][bj][m][n] = __builtin_amdgcn_mfma_f32_16x16x32_bf16(PG8_LO(Bt[n]), PG8_LO(At[m]), acc[ai][bj][m][n], 0, 0, 0); \
            acc[ai][bj][m][n] = __builtin_amdgcn_mfma_f32_16x16x32_bf16(PG8_HI(Bt[n]), PG8_HI(At[m]), acc[ai][bj][m][n], 0, 0, 0); } } \
        __builtin_amdgcn_s_setprio(0); } while (0)
    int sB[2][2] = {{0x7f, 0x7f}, {0x7f, 0x7f}}; int sav; asm volatile("v_mov_b32 %0, %1" : "=v"(sav) : "s"(sa));
    int sA[4] = {0x7f, 0x7f, 0x7f, 0x7f};
    const int scol = wc * 32 + (Epi::PERM ? 8 * (fr >> 2) + (fr & 3) : fr);
    const int sbase = FPM == 2 ? SCL_OFF + 16384 + scol * 2 + (fq >> 1) : SCL_OFF + scol * 4 + fq;
    const int sabase = SCL_OFF + ((wr * 64 + fr) << 2) + fq;
#define PG8_LDS_SCL(par_, kt_) do { if constexpr (FP8) { \
        const PG8_LAS unsigned char* sp_ = (const PG8_LAS unsigned char*)lds + sbase + (FPM == 2 ? (par_) * 4096 + (kt_) * 512 : (par_) * 8192 + (kt_) * 1024); \
        _Pragma("unroll") for (int bj_ = 0; bj_ < 2; ++bj_) _Pragma("unroll") for (int n_ = 0; n_ < 2; ++n_) sB[bj_][n_] = (int)sp_[(bj_ * 128 + n_ * (Epi::PERM ? 4 : 16)) * (FPM == 2 ? 2 : 4)]; } } while (0)
#define PG8_LDS_SCA(par_, kt_, ai_) do { if constexpr (FPM == 2) { const PG8_LAS unsigned char* sp_ = (const PG8_LAS unsigned char*)lds + sabase + (par_) * 8192 + (kt_) * 1024 + (ai_) * 512; \
        _Pragma("unroll") for (int m_ = 0; m_ < 4; ++m_) sA[m_] = (int)sp_[m_ * 64]; } } while (0)
#define PG8_DMA_SCL(u_, par_) do { if constexpr (FPM == 1) __builtin_amdgcn_global_load_lds((const unsigned*)((u_).S + wid * 1024 + lane * 16), (PG8_LAS unsigned*)(lds + SCL_OFF + (par_) * 8192 + wid * 1024), 16, 0, 0); \
        if constexpr (FPM == 2) { __builtin_amdgcn_global_load_lds((const unsigned*)((u_).SA + wid * 1024 + lane * 16), (PG8_LAS unsigned*)(lds + SCL_OFF + (par_) * 8192 + wid * 1024), 16, 0, 0); \
            if (wid < 4) __builtin_amdgcn_global_load_lds((const unsigned*)((u_).S + wid * 1024 + lane * 16), (PG8_LAS unsigned*)(lds + SCL_OFF + 16384 + (par_) * 4096 + wid * 1024), 16, 0, 0); } } while (0)
#define PG8_WAIT_V(n) asm volatile("s_waitcnt vmcnt(" #n ")" ::: "memory")
#define PG8_WAIT_L(n) asm volatile("s_waitcnt lgkmcnt(" #n ")" ::: "memory")
#define PG8_BAR __builtin_amdgcn_s_barrier()
#define PG8_SCHED __builtin_amdgcn_sched_barrier(0)
#define PG8_GOFFS(u, o) do { _Pragma("unroll") for (int _h = 0; _h < 2; ++_h) _Pragma("unroll") for (int _i = 0; _i < 2; ++_i) { int gR_, gC_; stage_rc(tid * 16 + _i * 8192, gR_, gC_); int _r = _h * HALF + gR_; _r = _r < (u).nvalid ? _r : (u).nvalid - 1; \
        const int _tok = (u).lst[_r]; (o)[_h][_i] = (unsigned)_tok * (unsigned)lda + (unsigned)(gC_ * 2); } } while (0)
#define PG8_GRAW(u, tk) do {   _Pragma("unroll") for (int _h = 0; _h < 2; ++_h) _Pragma("unroll") for (int _i = 0; _i < 2; ++_i) { int gR_, gC_; stage_rc(tid * 16 + _i * 8192, gR_, gC_); int _r = _h * HALF + gR_; _r = _r < (u).nvalid ? _r : (u).nvalid - 1; (tk)[_h][_i] = (unsigned)(u).lst[_r]; } } while (0)
    Unit cur, nxt, nn; int ui = 0;
#if PROBE_T
    unsigned long long pk_ = 0, pe_ = 0, pt0_ = 0, pn_ = 0; const unsigned long long pst_ = __builtin_amdgcn_s_memtime();
#endif
    if (!S.next(0, cur)) return;
    f32x4 acc[2][2][4][2];
#pragma unroll
    for (int a = 0; a < 2; ++a)
#pragma unroll
        for (int b = 0; b < 2; ++b)
#pragma unroll
            for (int m = 0; m < 4; ++m)
#pragma unroll
                for (int n = 0; n < 2; ++n) acc[a][b][m][n] = (f32x4){0.f, 0.f, 0.f, 0.f};
    v8i_t At[4], B0[2], B1[2];
    const char* cA = cur.A; const char* cB = cur.B;
    bool has_next = S.next(1, nxt);
    if constexpr (GATHER) { PG8_GOFFS(cur, ocA);
        if (has_next) { PG8_GOFFS(nxt, onA); }
        else {
#pragma unroll
            for (int h = 0; h < 2; ++h)
#pragma unroll
                for (int i = 0; i < 2; ++i) onA[h][i] = ocA[h][i]; } }
    PG8_DMA_SCL(cur, 0); if (has_next) PG8_DMA_SCL(nxt, 1);
    PG8_STAGE(PG8_SB(0, 0), cB, voffB, 0u); PG8_STAGE(PG8_SB(0, 1), cB, voffB, hstepB); PG8_STAGE(PG8_SA(0, 0), cA, ocA[0], 0u); PG8_STAGE(PG8_SA(0, 1), cA, ocA[1], 0u);
    if (wr == 1) PG8_BAR;
    PG8_WAIT_V(2); PG8_BAR;
    PG8_STAGE(PG8_SB(1, 0), cB, voffB, kstep); PG8_STAGE(PG8_SA(1, 0), cA, ocA[0], kstep); PG8_STAGE(PG8_SB(1, 1), cB, voffB, hstepB + kstep);
    PG8_WAIT_V(6); PG8_BAR;
    for (;;) {
        const char* nA = has_next ? nxt.A : cA; const char* nB = has_next ? nxt.B : cB;
#if PROBE_T
        pt0_ = __builtin_amdgcn_s_memtime();
#endif
#pragma unroll 1
        for (int t = 0; t < nt; t += 2) {
            const bool last = (t == nt - 2);
            const unsigned k1 = (unsigned)(t + 1) * kstep, k2 = last ? 0u : (unsigned)(t + 2) * kstep, k3 = k2 + kstep;
            const char* a2 = last ? nA : cA; const char* b2 = last ? nB : cB;
#define PG8_STAGE_A2(bufoff, h_, kb_) do { if (GATHER && last) PG8_STAGE(bufoff, a2, onA[h_], kb_); else PG8_STAGE(bufoff, a2, ocA[h_], kb_); } while (0)
            PG8_LDB(B0, 0, 0); PG8_LDB(B1, 0, 1); PG8_LDS_SCL(ui & 1, t); PG8_SCHED; PG8_LDA(At, 0, 0); PG8_LDS_SCA(ui & 1, t, 0); PG8_STAGE(PG8_SA(1, 1), cA, ocA[1], k1);
            PG8_WAIT_V(8); PG8_WAIT_L(0); PG8_BAR; PG8_MMA(0, 0, At, B0); PG8_MMA(0, 1, At, B1); PG8_BAR; PG8_SCHED;
            PG8_LDA(At, 0, 1); PG8_LDS_SCA(ui & 1, t, 1); PG8_STAGE(PG8_SB(0, 0), b2, voffB, k2); PG8_STAGE(PG8_SB(0, 1), b2, voffB, hstepB + k2); PG8_STAGE_A2(PG8_SA(0, 0), 0, k2);
            PG8_WAIT_V(8); PG8_WAIT_L(0); PG8_BAR; PG8_MMA(1, 0, At, B0); PG8_MMA(1, 1, At, B1); PG8_BAR; PG8_SCHED;
            PG8_LDB(B0, 1, 0); PG8_LDB(B1, 1, 1); PG8_LDS_SCL(ui & 1, t + 1); PG8_SCHED; PG8_LDA(At, 1, 0); PG8_LDS_SCA(ui & 1, t + 1, 0); PG8_STAGE_A2(PG8_SA(0, 1), 1, k2);
            PG8_WAIT_V(8); PG8_WAIT_L(0); PG8_BAR; PG8_MMA(0, 0, At, B0); PG8_MMA(0, 1, At, B1); PG8_BAR; PG8_SCHED;
            PG8_LDA(At, 1, 1); PG8_LDS_SCA(ui & 1, t + 1, 1); PG8_STAGE(PG8_SB(1, 0), b2, voffB, k3); PG8_STAGE(PG8_SB(1, 1), b2, voffB, hstepB + k3); PG8_STAGE_A2(PG8_SA(1, 0), 0, k3);
            PG8_WAIT_V(8); PG8_WAIT_L(0); PG8_BAR; PG8_MMA(1, 0, At, B0); PG8_MMA(1, 1, At, B1); PG8_BAR; PG8_SCHED;
        }
#if PROBE_T
        const unsigned long long pt1_ = __builtin_amdgcn_s_memtime(); pk_ += pt1_ - pt0_;
#endif
        if constexpr (FP8) asm volatile("s_nop 15\n\ts_nop 7" ::: "memory");
        const bool has_nn = has_next && S.next(ui + 2, nn);
        if constexpr (GATHER) {
#pragma unroll
            for (int h = 0; h < 2; ++h)
#pragma unroll
                for (int i = 0; i < 2; ++i) ocA[h][i] = onA[h][i];
            if (has_nn) { PG8_GRAW(nn, onA); } }
        if (wr == 0) PG8_BAR;
        E(acc, cur, wr, wc, fr, fq);
#if PROBE_T
        asm volatile("s_waitcnt vmcnt(0)" ::: "memory"); pe_ += __builtin_amdgcn_s_memtime() - pt1_; ++pn_;
#endif
        if (!has_next) break;
#pragma unroll
        for (int a = 0; a < 2; ++a)
#pragma unroll
            for (int b = 0; b < 2; ++b)
#pragma unroll
                for (int m = 0; m < 4; ++m)
#pragma unroll
                    for (int n = 0; n < 2; ++n) acc[a][b][m][n] = (f32x4){0.f, 0.f, 0.f, 0.f};
        cur = nxt; cA = nA; cB = nB; ++ui;
        if constexpr (GATHER) { if (has_nn) {
#pragma unroll
            for (int h = 0; h < 2; ++h)
#pragma unroll
                for (int i = 0; i < 2; ++i) { int gR_, gC_; stage_rc(tid * 16 + i * 8192, gR_, gC_); onA[h][i] = onA[h][i] * (unsigned)lda + (unsigned)(gC_ * 2); } } }
        if (has_nn) { nxt = nn; PG8_DMA_SCL(nxt, (ui + 1) & 1); }
        has_next = has_nn;
        if (wr == 1) PG8_BAR;
    }
    PG8_WAIT_V(0);
    PG8_BAR;
#if PROBE_T
    if (pw && blockIdx.x == 0 && tid == 0) { pw[0] += pk_; pw[1] += pe_; pw[2] += pn_; pw[3] += __builtin_amdgcn_s_memtime() - pst_; }
#endif
#undef PG8_SA
#undef PG8_SB
#undef PG8_STAGE
#undef PG8_LDA
#undef PG8_LDB
#undef PG8_MMA
#undef PG8_WAIT_V
#undef PG8_WAIT_L
#undef PG8_BAR
#undef PG8_SCHED
#undef PG8_GOFFS
#undef PG8_GRAW
#undef PG8_STAGE_A2
#undef PG8_CAT
#undef PG8_LO
#undef PG8_HI
#undef PG8_LDS_SCL
#undef PG8_LDS_SCA
#undef PG8_DMA_SCL
}

constexpr int NXCD = 8, WGM = 8;
struct DenseSched {
    const char* A; const char* B; int lda, ldb; int nM, nN, nwg, G, c; int apn_shift, akbytes, bpm_shift; size_t bbatch;
    __device__ __forceinline__ void init(const void* A_, const void* B_, int lda_, int ldb_, int M, int N, int G_, int c_) {
        A = (const char*)A_; B = (const char*)B_; lda = lda_; ldb = ldb_; nM = M / BM; nN = N / BM; nwg = nM * nN; G = G_; c = c_; apn_shift = -1; akbytes = 0; bpm_shift = -1; bbatch = 0; }
    __device__ __forceinline__ bool next(int i, Unit& u) const {
        const long L = (long)i * G + c; if (L >= nwg) return false;
        int wgid = (int)L; { const int q = nwg / NXCD, r = nwg % NXCD, xcd = wgid % NXCD, off = wgid / NXCD; wgid = (xcd < r ? xcd * (q + 1) : r * (q + 1) + (xcd - r) * q) + off; }
        const int nig = WGM * nN, gid = wgid / nig, fm = gid * WGM, gsz = (nM - fm) < WGM ? (nM - fm) : WGM;
        const int pm = fm + ((wgid % nig) % gsz), pn = (wgid % nig) / gsz;
        u.pm = pm; u.pn = pn; u.aux = 0; u.lst = nullptr; u.nvalid = 256; u.S = nullptr; u.SA = nullptr;
        u.A = A + (size_t)pm * 256 * lda * 2 + (apn_shift >= 0 ? (size_t)(pn >> apn_shift) * akbytes : (size_t)0);
        u.B = B + (size_t)pn * 256 * ldb * 2 + (bpm_shift >= 0 ? (size_t)(pm >> bpm_shift) * bbatch : (size_t)0);
        return true;
    }
};
struct MoeSched {
    const char* A; const char* B; size_t bexp; const char* SW; int lda, ldb  , nN; const int* lists; volatile LAS const int* tab; volatile LAS const unsigned char* te; int G, c; bool gather; const char* SA;
    __device__ __forceinline__ bool next(int i, Unit& u) const {
        int pn, mg;
        if (G == 256) {
            const int x = c & 7, jj = c >> 3, pgs = nN >> 2, mgs = 8 / pgs;
            mg = i * (8 * mgs) + 8 * (x / pgs) + (jj & 7); pn = 4 * (x % pgs) + (jj >> 3);
            if (mg >= __builtin_amdgcn_readfirstlane(tab[32])) return false;
        } else { const int total = __builtin_amdgcn_readfirstlane(tab[32]) * nN; const long L = (long)i * G + c; if (L >= total) return false; pn = (int)(L % nN); mg = (int)(L / nN); }
        const int e = __builtin_amdgcn_readfirstlane((int)te[mg]), mt = mg - __builtin_amdgcn_readfirstlane(tab[e]);
        u.pm = mg; u.pn = pn; u.aux = e;
        if (gather) { u.A = A; u.lst = lists + (size_t)e * T + mt * 256; const int rem = __builtin_amdgcn_readfirstlane(tab[48 + e]) - mt * 256; u.nvalid = rem < 256 ? rem : 256; }
        else { u.A = A + (size_t)mg * 256 * lda; u.lst = nullptr; u.nvalid = 256; }
        u.B = B + (size_t)e * bexp + (size_t)pn * 256 * ldb; u.S = SW ? (SA ? SW + ((size_t)e * 4 + pn) * 4096 : SW + ((size_t)e * 8 + pn) * 8192) : nullptr; u.SA = SA ? SA + (size_t)mg * 8192 : nullptr;
        return true;
    }
};

#define EPI_ROW(u, ai, m) ((u).pm * 256 + (ai) * 128 + wr * 64 + (m) * 16 + fr)
struct EpiLat {
    static constexpr bool PERM = true;
    bf16_t* LAT; float* SSQ; bf16_t* KR; const float* CS; const float* SN;
    __device__ __forceinline__ void operator()(const f32x4 (&acc)[2][2][4][2], const Unit& u, int wr, int wc, int fr, int fq) const {
        if (u.pn < 4) {
#pragma unroll
            for (int ai = 0; ai < 2; ++ai)
#pragma unroll
                for (int m = 0; m < 4; ++m) { const int row = EPI_ROW(u, ai, m); float ss = 0.f;
#pragma unroll
                    for (int bj = 0; bj < 2; ++bj) { const f32x4 v0 = acc[ai][bj][m][0], v1 = acc[ai][bj][m][1];
                        ss += (v0[0] * v0[0] + v0[1] * v0[1]) + (v0[2] * v0[2] + v0[3] * v0[3]) + (v1[0] * v1[0] + v1[1] * v1[1]) + (v1[2] * v1[2] + v1[3] * v1[3]);
                        *(u32x4*)(LAT + (size_t)row * 1024 + u.pn * 256 + bj * 128 + wc * 32 + 8 * fq) = pack8(v0, v1); }
                    ss += __shfl_xor(ss, 16); ss += __shfl_xor(ss, 32);
                    if (fq == 0) SSQ[(size_t)row * 16 + u.pn * 4 + wc] = ss; }
        } else if (wc == 0) {
#pragma unroll
            for (int ai = 0; ai < 2; ++ai)
#pragma unroll
                for (int m = 0; m < 4; ++m) { const int row = EPI_ROW(u, ai, m);
                    const f32x4 c0 = *(const f32x4*)(CS + (size_t)row * 32 + 8 * fq), c1 = *(const f32x4*)(CS + (size_t)row * 32 + 8 * fq + 4);
                    const f32x4 s0 = *(const f32x4*)(SN + (size_t)row * 32 + 8 * fq), s1 = *(const f32x4*)(SN + (size_t)row * 32 + 8 * fq + 4);
                    const f32x4 a0 = acc[ai][0][m][0], a1 = acc[ai][0][m][1], b0 = acc[ai][1][m][0], b1 = acc[ai][1][m][1];
                    *(u32x4*)(KR + (size_t)row * 64 + 8 * fq) = pack8(a0 * c0 - b0 * s0, a1 * c1 - b1 * s1);
                    *(u32x4*)(KR + (size_t)row * 64 + 32 + 8 * fq) = pack8(b0 * c0 + a0 * s0, b1 * c1 + a1 * s1); }
        }
    }
};
struct EpiQ {
    static constexpr bool PERM = true;
    bf16_t* Q; const float* SSQ; const float* CS; const float* SN;
    __device__ __forceinline__ void operator()(const f32x4 (&acc)[2][2][4][2], const Unit& u, int wr, int wc, int fr, int fq) const {
#pragma unroll
        for (int ai = 0; ai < 2; ++ai)
#pragma unroll
            for (int m = 0; m < 4; ++m) { const int row = EPI_ROW(u, ai, m);
                const f32x4 q0 = *(const f32x4*)(SSQ + (size_t)row * 16), q1 = *(const f32x4*)(SSQ + (size_t)row * 16 + 4), q2 = *(const f32x4*)(SSQ + (size_t)row * 16 + 8);
                const float ss = ((q0[0] + q0[1]) + (q0[2] + q0[3])) + ((q1[0] + q1[1]) + (q1[2] + q1[3])) + ((q2[0] + q2[1]) + (q2[2] + q2[3]));
                const float r = QSCALE / sqrtf(ss * (1.0f / QL) + KF(RMS_EPS));
                if (u.pn < 4) {
#pragma unroll
                    for (int bj = 0; bj < 2; ++bj)
                        *(u32x4*)(Q + (size_t)row * 1536 + (2 * u.pn + bj) * 192 + wc * 32 + 8 * fq) = pack8(acc[ai][bj][m][0] * r, acc[ai][bj][m][1] * r);
                } else {
                    const int head = 4 * (u.pn - 4) + wc;
                    const f32x4 c0 = *(const f32x4*)(CS + (size_t)row * 32 + 8 * fq), c1 = *(const f32x4*)(CS + (size_t)row * 32 + 8 * fq + 4);
                    const f32x4 s0 = *(const f32x4*)(SN + (size_t)row * 32 + 8 * fq), s1 = *(const f32x4*)(SN + (size_t)row * 32 + 8 * fq + 4);
                    const f32x4 a0 = acc[ai][0][m][0] * r, a1 = acc[ai][0][m][1] * r, b0 = acc[ai][1][m][0] * r, b1 = acc[ai][1][m][1] * r;
                    *(u32x4*)(Q + (size_t)row * 1536 + head * 192 + 128 + 8 * fq) = pack8(a0 * c0 - b0 * s0, a1 * c1 - b1 * s1);
                    *(u32x4*)(Q + (size_t)row * 1536 + head * 192 + 160 + 8 * fq) = pack8(b0 * c0 + a0 * s0, b1 * c1 + a1 * s1);
                }
                asm volatile("" ::: "memory"); }
    }
};
struct EpiKV {
    static constexpr bool PERM = true;
    bf16_t* KN; bf16_t* V; const float* SSQ;
    __device__ __forceinline__ void operator()(const f32x4 (&acc)[2][2][4][2], const Unit& u, int wr, int wc, int fr, int fq) const {
#pragma unroll
        for (int ai = 0; ai < 2; ++ai)
#pragma unroll
            for (int m = 0; m < 4; ++m) { const int row = EPI_ROW(u, ai, m);
                const f32x4 q3 = *(const f32x4*)(SSQ + (size_t)row * 16 + 12);
                const float r = 1.0f / sqrtf(((q3[0] + q3[1]) + (q3[2] + q3[3])) * (1.0f / KVL) + KF(RMS_EPS));
                *(u32x4*)(KN + (size_t)row * 1024 + u.pn * 128 + wc * 32 + 8 * fq) = pack8(acc[ai][0][m][0] * r, acc[ai][0][m][1] * r);
                *(u32x4*)(V + (size_t)row * 1024 + u.pn * 128 + wc * 32 + 8 * fq) = pack8(acc[ai][1][m][0] * r, acc[ai][1][m][1] * r); }
    }
};
__device__ __forceinline__ f32x4 bf4_lo(const u32x4 w) { return (f32x4){bf_lo(w.x), bf_hi(w.x), bf_lo(w.y), bf_hi(w.y)}; }
__device__ __forceinline__ f32x4 bf4_hi(const u32x4 w) { return (f32x4){bf_lo(w.z), bf_hi(w.z), bf_lo(w.w), bf_hi(w.w)}; }
struct EpiRes {
    static constexpr bool PERM = true;
    const bf16_t* X; bf16_t* Y;
    __device__ __forceinline__ void operator()(const f32x4 (&acc)[2][2][4][2], const Unit& u, int wr, int wc, int fr, int fq) const {
#pragma unroll
        for (int ai = 0; ai < 2; ++ai)
#pragma unroll
            for (int m = 0; m < 4; ++m) { const size_t off = (size_t)EPI_ROW(u, ai, m) * 1024 + u.pn * 256 + wc * 32 + 8 * fq;
#pragma unroll
                for (int bj = 0; bj < 2; ++bj) { const u32x4 xw = *(const u32x4*)(X + off + bj * 128);
                    *(u32x4*)(Y + off + bj * 128) = pack8(bf4_lo(xw) * ALPHA + acc[ai][bj][m][0], bf4_hi(xw) * ALPHA + acc[ai][bj][m][1]); }
                if (m & 1) asm volatile("" ::: "memory"); }
    }
};
struct EpiGU {
    static constexpr bool PERM = true;
    bf16_t* GG; bf16_t* U;
    __device__ __forceinline__ void operator()(const f32x4 (&acc)[2][2][4][2], const Unit& u, int wr, int wc, int fr, int fq) const {
#pragma unroll
        for (int ai = 0; ai < 2; ++ai)
#pragma unroll
            for (int m = 0; m < 4; ++m) { const int row = EPI_ROW(u, ai, m);
#pragma unroll
                for (int bj = 0; bj < 2; ++bj) { f32x4 v0 = acc[ai][bj][m][0], v1 = acc[ai][bj][m][1];
                    if (u.pn < 4) {
#pragma unroll
                        for (int e = 0; e < 4; ++e) { v0[e] = gelu_tanh(v0[e]); v1[e] = gelu_tanh(v1[e]); }
                        *(u32x4*)(GG + (size_t)row * 1024 + u.pn * 256 + bj * 128 + wc * 32 + 8 * fq) = pack8(v0, v1);
                    } else *(u32x4*)(U + (size_t)row * 1024 + (u.pn - 4) * 256 + bj * 128 + wc * 32 + 8 * fq) = pack8(v0, v1); } }
    }
};
struct EpiAB {
    static constexpr bool PERM = true;
    bf16_t* LA; bf16_t* BB; const bf16_t* UC; const float* BA; const float* BX; const float* SPL;
    __device__ __forceinline__ void operator()(const f32x4 (&acc)[2][2][4][2], const Unit& u, int wr, int wc, int fr, int fq) const {
        const int ch = (u.pn >> 1) * 256 + (u.pn & 1) * 128 + wc * 32 + 8 * fq;
        const float c3 = KF(0.16666667f), c4 = KF(0.041666668f), c5 = KF(0.0083333338f);
        f32x4 ba[2], bx[2], sp[2];
#pragma unroll
        for (int n = 0; n < 2; ++n) { ba[n] = *(const f32x4*)(BA + ch + 4 * n); bx[n] = *(const f32x4*)(BX + ch + 4 * n); sp[n] = *(const f32x4*)(SPL + ch + 4 * n); }
#pragma unroll
        for (int ai = 0; ai < 2; ++ai)
#pragma unroll
            for (int m = 0; m < 4; ++m) { const size_t off = (size_t)EPI_ROW(u, ai, m) * 1024 + ch;
                const u32x4 uw = *(const u32x4*)(UC + off); f32x4 uv[2] = {bf4_lo(uw), bf4_hi(uw)}, lv[2], bv[2];
#pragma unroll
                for (int n = 0; n < 2; ++n)
#pragma unroll
                    for (int e = 0; e < 4; ++e) { const float r = sigmoidf_(acc[ai][0][m][n][e] + ba[n][e]), ig = sigmoidf_(acc[ai][1][m][n][e] + bx[n][e]);
                        const float la = sp[n][e] * r, x2 = 2.0f * la; lv[n][e] = la * 1.4426950408889634f;
                        const float om = x2 > -0.25f ? -x2 * (1.0f + x2 * (0.5f + x2 * (c3 + x2 * (c4 + x2 * c5)))) : 1.0f - __expf(x2);
                        bv[n][e] = sqrtf(om) * ig * uv[n][e]; }
                *(u32x4*)(LA + off) = pack8(lv[0], lv[1]); *(u32x4*)(BB + off) = pack8(bv[0], bv[1]); asm volatile("" ::: "memory"); }
    }
};
struct EpiUp {
    static constexpr bool PERM = true;
    unsigned char* H; unsigned char* SH; const float* BU;
    __device__ __forceinline__ void operator()(f32x4 (&acc)[2][2][4][2], const Unit& u, int wr, int wc, int fr, int fq) const {
        const int gc = u.pn * 128 + wc * 32 + 8 * fq; const float* bu = BU + (size_t)u.aux * 2048;
        const float k7 = KF(7.0f), km7 = KF(-7.0f), ka = KF(1.702f);
#pragma unroll
        for (int n = 0; n < 2; ++n) { const f32x4 bg = *(const f32x4*)(bu + gc + 4 * n), bp = *(const f32x4*)(bu + 1024 + gc + 4 * n);
#pragma unroll
            for (int ai = 0; ai < 2; ++ai)
#pragma unroll
                for (int m = 0; m < 4; ++m) {
#pragma unroll
                    for (int e = 0; e < 4; ++e) { const float g = fminf(acc[ai][0][m][n][e] + bg[e], k7), up = fminf(fmaxf(acc[ai][1][m][n][e] + bp[e], km7), k7);
                        acc[ai][0][m][n][e] = (up + 1.0f) * (g * sigmoidf_(ka * g)); }
                    if (m & 1) __builtin_amdgcn_sched_barrier(0); }
            asm volatile("" ::: "memory"); }
        unsigned char* const shb = SH + ((size_t)u.pm * 8 + u.pn) * 1024; unsigned char* const hb = H + (size_t)u.pm * 256 * 1024;
        const unsigned ho = (unsigned)((wr * 64 + fr) * 1024 + gc), so = (unsigned)((wr * 64 + fr) * 4 + wc);
#pragma unroll
        for (int ai = 0; ai < 2; ++ai)
#pragma unroll
            for (int m = 0; m < 4; ++m) { const f32x4 y0 = acc[ai][0][m][0], y1 = acc[ai][0][m][1];
                float am = fmaxf(fmaxf(fmaxf(fabsf(y0[0]), fabsf(y0[1])), fmaxf(fabsf(y0[2]), fabsf(y0[3]))), fmaxf(fmaxf(fabsf(y1[0]), fabsf(y1[1])), fmaxf(fabsf(y1[2]), fabsf(y1[3]))));
                { auto r16 = __builtin_amdgcn_permlane16_swap(__float_as_uint(am), __float_as_uint(am), false, false); am = fmaxf(__uint_as_float(r16[0]), __uint_as_float(r16[1]));
                  auto r32 = __builtin_amdgcn_permlane32_swap(__float_as_uint(am), __float_as_uint(am), false, false); am = fmaxf(__uint_as_float(r32[0]), __uint_as_float(r32[1])); }
                int eb = (int)((__float_as_uint(am) >> 23) & 0xffu) - 7; eb = eb < 1 ? 1 : eb;
                const float inv = __uint_as_float((unsigned)(254 - eb) << 23);
                int w0 = __builtin_amdgcn_cvt_pk_fp8_f32(y0[0] * inv, y0[1] * inv, 0, false); w0 = __builtin_amdgcn_cvt_pk_fp8_f32(y0[2] * inv, y0[3] * inv, w0, true);
                int w1 = __builtin_amdgcn_cvt_pk_fp8_f32(y1[0] * inv, y1[1] * inv, 0, false); w1 = __builtin_amdgcn_cvt_pk_fp8_f32(y1[2] * inv, y1[3] * inv, w1, true);
                *(u32x2*)(hb + (ho + (unsigned)((ai * 128 + m * 16) * 1024))) = (u32x2){(unsigned)w0, (unsigned)w1};
                if (fq == 0) shb[so + (unsigned)((ai * 128 + m * 16) * 4)] = (unsigned char)eb;
                asm volatile("" ::: "memory"); __builtin_amdgcn_sched_barrier(0); }
    }
};
struct EpiDown {
    static constexpr bool PERM = true;
    bf16_t* YS; const float* BD;
    __device__ __forceinline__ void operator()(const f32x4 (&acc)[2][2][4][2], const Unit& u, int wr, int wc, int fr, int fq) const {
        const float* bd = BD + (size_t)u.aux * 1024;
#pragma unroll
        for (int bj = 0; bj < 2; ++bj) { const int col = u.pn * 256 + bj * 128 + wc * 32 + 8 * fq; const f32x4 b0 = *(const f32x4*)(bd + col), b1 = *(const f32x4*)(bd + col + 4);
#pragma unroll
            for (int ai = 0; ai < 2; ++ai)
#pragma unroll
                for (int m = 0; m < 4; ++m) *(u32x4*)(YS + (size_t)EPI_ROW(u, ai, m) * 1024 + col) = pack8(acc[ai][bj][m][0] + b0, acc[ai][bj][m][1] + b1); }
    }
};
struct EpiPle {
    static constexpr bool PERM = true;
    const bf16_t* X2; const bf16_t* PP; float* OUT; bf16_t* XB;
    __device__ __forceinline__ void operator()(const f32x4 (&acc)[2][2][4][2], const Unit& u, int wr, int wc, int fr, int fq) const {
#pragma unroll
        for (int ai = 0; ai < 2; ++ai)
#pragma unroll
            for (int m = 0; m < 4; ++m) { const size_t off = (size_t)EPI_ROW(u, ai, m) * 1024 + u.pn * 256 + wc * 32 + 8 * fq;
#pragma unroll
                for (int bj = 0; bj < 2; ++bj) { const size_t o = off + bj * 128; const u32x4 xw = *(const u32x4*)(X2 + o), pw = *(const u32x4*)(PP + o);
                    const f32x4 a0 = acc[ai][bj][m][0], a1 = acc[ai][bj][m][1], x0 = bf4_lo(xw), x1 = bf4_hi(xw), p0 = bf4_lo(pw), p1 = bf4_hi(pw); f32x4 r0, r1;
#pragma unroll
                    for (int e = 0; e < 4; ++e) { r0[e] = x0[e] + sigmoidf_(a0[e]) * p0[e]; r1[e] = x1[e] + sigmoidf_(a1[e]) * p1[e]; }
                    *(u32x4*)(XB + o) = pack8(r0, r1);
                    if (OUT) { *(f32x4*)(OUT + o) = r0; *(f32x4*)(OUT + o + 4) = r1; } }
                if (m & 1) asm volatile("" ::: "memory"); }
    }
};
struct EpiPP {
    static constexpr bool PERM = true;
    bf16_t* PP;
    __device__ __forceinline__ void operator()(const f32x4 (&acc)[2][2][4][2], const Unit& u, int wr, int wc, int fr, int fq) const {
#pragma unroll
        for (int ai = 0; ai < 2; ++ai)
#pragma unroll
            for (int m = 0; m < 4; ++m)
#pragma unroll
                for (int bj = 0; bj < 2; ++bj) *(u32x4*)(PP + (size_t)EPI_ROW(u, ai, m) * 1024 + u.pn * 256 + bj * 128 + wc * 32 + 8 * fq) = pack8(acc[ai][bj][m][0], acc[ai][bj][m][1]);
    }
};
}

namespace att {
constexpr int NW = 8, QBLK = 32, KVBLK = 64, QB = 256, KPITCH = 384;
constexpr int SHM_V = KVBLK * DV * 2, SHM_K = KVBLK * KPITCH;
constexpr int NVB = 3;
constexpr int OFF_V = 0, OFF_K = NVB * SHM_V, OFF_WS = OFF_K + 2 * SHM_K, LDS_BYTES = OFF_WS + NW * 64 * 4;
#define SBAR() __builtin_amdgcn_sched_barrier(0)
__device__ __forceinline__ int k_addr(int row, int chunk) { return row * KPITCH + ((chunk ^ ((row >> 1) & 7)) << 4); }
__device__ __forceinline__ int v_st(int k, int c) { const int kk = (k & ~0xC) | ((k & 4) << 1) | ((k & 8) >> 1); return ((kk >> 3) * 4 + (c >> 5)) * 512 + ((kk & 7) * 32 + (c & 31)) * 2; }
__device__ __forceinline__ int v_rd_base(int lane) { return ((lane & 3) << 3) | (((lane >> 2) & 3) << 6) | (((lane >> 4) & 1) << 5) | (((lane >> 5) & 1) << 8); }
constexpr int v_rd_off(int d0, int ks, int half) { return d0 * 512 + ks * 4096 + half * 2048; }
__device__ __forceinline__ int crow(int r, int hi) { return (r & 3) + 8 * (r >> 2) + 4 * hi; }

template <int KB>
__device__ __forceinline__ void qkt(f32x16& p0, f32x16& p1, const LAS char* K_lds, int r32, int hi, const bf16x8* qr) {
    p0 = f32x16{}; p1 = f32x16{};
    const LAS char* kb[4];
#pragma unroll
    for (int dd = 0; dd < 4; ++dd) kb[dd] = K_lds + KB * SHM_K + r32 * KPITCH + (((2 * dd + hi) ^ ((r32 >> 1) & 7)) << 4);
    bf16x8 f[2][4];
#define QK_LD(g, buf) do { _Pragma("unroll") for (int e_ = 0; e_ < 2; ++e_) { const int d0_ = 2 * (g) + e_; const LAS char* a_ = kb[d0_ & 3] + (d0_ >> 2) * 128; \
        f[buf][2 * e_] = *(const LAS bf16x8*)a_; f[buf][2 * e_ + 1] = *(const LAS bf16x8*)(a_ + 32 * KPITCH); } } while (0)
    QK_LD(0, 0);
#pragma unroll
    for (int g = 0; g < 6; ++g) {
        if (g < 5) QK_LD(g + 1, (g + 1) & 1);
        SBAR();
#pragma unroll
        for (int e = 0; e < 2; ++e) { const int d0 = 2 * g + e;
            p0 = __builtin_amdgcn_mfma_f32_32x32x16_bf16(f[g & 1][2 * e], qr[d0], p0, 0, 0, 0);
            p1 = __builtin_amdgcn_mfma_f32_32x32x16_bf16(f[g & 1][2 * e + 1], qr[d0], p1, 0, 0, 0); }
        SBAR(); }
#undef QK_LD
}
__device__ __forceinline__ void pv_tile(f32x16* o, int vb0  , bf16x8 pa0, bf16x8 pa1, bf16x8 pa2, bf16x8 pa3) {
#define TRRD(dst, off) asm volatile("ds_read_b64_tr_b16 %0, %1 offset:%2" : "=&v"(dst) : "v"(vb0), "i"(off) : "memory")
#define PV_D0(d0) do { s16x4 l0, l1, l2, l3, h0, h1, h2, h3; constexpr int b_ = v_rd_off(d0, 0, 0); \
        TRRD(l0, b_); TRRD(h0, b_ + 2048); TRRD(l1, b_ + 4096); TRRD(h1, b_ + 6144); TRRD(l2, b_ + 8192); TRRD(h2, b_ + 10240); TRRD(l3, b_ + 12288); TRRD(h3, b_ + 14336); \
        asm volatile("s_waitcnt lgkmcnt(0)" ::: "memory"); SBAR(); \
        o[d0] = __builtin_amdgcn_mfma_f32_32x32x16_bf16(pa0, (bf16x8){l0[0], l0[1], l0[2], l0[3], h0[0], h0[1], h0[2], h0[3]}, o[d0], 0, 0, 0); \
        o[d0] = __builtin_amdgcn_mfma_f32_32x32x16_bf16(pa1, (bf16x8){l1[0], l1[1], l1[2], l1[3], h1[0], h1[1], h1[2], h1[3]}, o[d0], 0, 0, 0); \
        o[d0] = __builtin_amdgcn_mfma_f32_32x32x16_bf16(pa2, (bf16x8){l2[0], l2[1], l2[2], l2[3], h2[0], h2[1], h2[2], h2[3]}, o[d0], 0, 0, 0); \
        o[d0] = __builtin_amdgcn_mfma_f32_32x32x16_bf16(pa3, (bf16x8){l3[0], l3[1], l3[2], l3[3], h3[0], h3[1], h3[2], h3[3]}, o[d0], 0, 0, 0); } while (0)
    PV_D0(0); PV_D0(1); PV_D0(2); PV_D0(3);
#undef PV_D0
#undef TRRD
}
__device__ __forceinline__ void mask_tile(f32x16& p0, f32x16& p1, int dq  ) {
    const float NEG = -__builtin_inff();
#pragma unroll
    for (int r = 0; r < 16; ++r) { const int c = (r & 3) + 8 * (r >> 2);
        if (c > dq) p0[r] = NEG;
        if (c + 32 > dq) p1[r] = NEG; }
}
__device__ __forceinline__ void softmax_tile(f32x16& p0, f32x16& p1, float& m_reg, float& l_reg, float& alpha, bf16x8& pa0, bf16x8& pa1, bf16x8& pa2, bf16x8& pa3) {
    float pmax = p0[0];
#pragma unroll
    for (int r = 1; r < 16; ++r) pmax = fmaxf(pmax, p0[r]);
#pragma unroll
    for (int r = 0; r < 16; ++r) pmax = fmaxf(pmax, p1[r]);
    { auto rr = __builtin_amdgcn_permlane32_swap(__float_as_uint(pmax), __float_as_uint(pmax), false, false); pmax = fmaxf(__uint_as_float(rr[0]), __uint_as_float(rr[1])); }
    float mn = m_reg; alpha = 1.f;
    if (!__all(pmax - m_reg <= 8.0f)) { mn = fmaxf(m_reg, pmax); alpha = __builtin_amdgcn_exp2f(m_reg - mn); m_reg = mn; }
    float ps = 0.f;
#pragma unroll
    for (int r = 0; r < 16; ++r) { p0[r] = __builtin_amdgcn_exp2f(p0[r] - mn); ps += p0[r]; }
#pragma unroll
    for (int r = 0; r < 16; ++r) { p1[r] = __builtin_amdgcn_exp2f(p1[r] - mn); ps += p1[r]; }
    { auto rr = __builtin_amdgcn_permlane32_swap(__float_as_uint(ps), __float_as_uint(ps), false, false); ps = __uint_as_float(rr[0]) + __uint_as_float(rr[1]); }
    l_reg = l_reg * alpha + ps;
#define PK4(P, B_, OUT) do { unsigned a0 = cvt_pk_bf16(P[B_+0], P[B_+1]), a1 = cvt_pk_bf16(P[B_+2], P[B_+3]); \
        unsigned b0 = cvt_pk_bf16(P[B_+4], P[B_+5]), b1 = cvt_pk_bf16(P[B_+6], P[B_+7]); \
        auto r0 = __builtin_amdgcn_permlane32_swap(a0, b0, false, false); auto r1 = __builtin_amdgcn_permlane32_swap(a1, b1, false, false); \
        u32x4 w = {r0[0], r1[0], r0[1], r1[1]}; OUT = __builtin_bit_cast(bf16x8, w); } while (0)
    PK4(p0, 0, pa0); PK4(p0, 8, pa1); PK4(p1, 0, pa2); PK4(p1, 8, pa3);
#undef PK4
}

__device__ __forceinline__ void attn_block(int b, int h, int qb, const bf16_t* Q, const bf16_t* KN, const bf16_t* KR, const bf16_t* V, bf16_t* O, LAS char* lds, unsigned long long* pw = nullptr) {
    const int tid = opaque_tid(), wid = __builtin_amdgcn_readfirstlane(tid >> 6), lane = tid & 63, r32 = lane & 31, hi = lane >> 5;
    const size_t row0 = (size_t)b * SEQ;
    const int q0 = qb * QB + wid * QBLK;
    const int NT = (qb + 1) * (QB / KVBLK);
    LAS char* V_lds = lds + OFF_V; LAS char* K_lds = lds + OFF_K;
    LAS float* ws = (LAS float*)(lds + OFF_WS) + wid * 64; LAS float* li_l = ws; LAS float* al_l = ws + 32;
    const int sr = tid >> 4, sc = (tid & 15) * 8, kr_row = tid >> 3, kr_c = tid & 7;
    const int vst0 = v_st(sr, sc), vst1 = v_st(32 + sr, sc), kws = k_addr(sr, tid & 15), kwr = k_addr(kr_row, 16 + kr_c);
    const int vb0 = (int)(uintptr_t)lds + v_rd_base(lane);
    const bf16_t* KNh = KN + row0 * 1024 + h * 128 + sc; const bf16_t* Vh = V + row0 * 1024 + h * 128 + sc; const bf16_t* KRb = KR + row0 * 64 + kr_c * 8;
    bf16x8 st_k0, st_k1, st_kr, st_v0, st_v1;
#define SLOAD(t) do { const size_t k0_ = (size_t)(t) * KVBLK; \
        st_k0 = *(const bf16x8*)(KNh + (k0_ + sr) * 1024); st_k1 = *(const bf16x8*)(KNh + (k0_ + 32 + sr) * 1024); st_kr = *(const bf16x8*)(KRb + (k0_ + kr_row) * 64); \
        st_v0 = *(const bf16x8*)(Vh + (k0_ + sr) * 1024); st_v1 = *(const bf16x8*)(Vh + (k0_ + 32 + sr) * 1024); } while (0)
#define SWRITE(bf, vo) do { *(LAS bf16x8*)(K_lds + (bf) * SHM_K + kws) = st_k0; *(LAS bf16x8*)(K_lds + (bf) * SHM_K + kws + 32 * KPITCH) = st_k1; *(LAS bf16x8*)(K_lds + (bf) * SHM_K + kwr) = st_kr; \
        *(LAS bf16x8*)(V_lds + (vo) + vst0) = st_v0; *(LAS bf16x8*)(V_lds + (vo) + vst1) = st_v1; } while (0)
    SLOAD(0);
    bf16x8 qr[12];
    { const bf16_t* Qw = Q + (row0 + q0 + r32) * 1536 + h * 192 + hi * 8;
#pragma unroll
      for (int d0 = 0; d0 < 12; ++d0) qr[d0] = *(const bf16x8*)(Qw + d0 * 16); }
    float m_reg = -1e30f, l_reg = 0.f; f32x16 o[4] = {};
    f32x16 p0, p1; bf16x8 pa0, pa1, pa2, pa3; float alpha;
    asm volatile("s_waitcnt vmcnt(0)" ::: "memory");
    SWRITE(0, 0);
    __syncthreads();
    const bool odd = wid >= 4; int vo_prev = 0, vo_cur = 0, vo_next = SHM_V;
#define RESC(a) do { if (__any((a) < 1.f)) { if (hi == 0) al_l[r32] = (a); asm volatile("s_waitcnt lgkmcnt(0)" ::: "memory"); \
        _Pragma("unroll") for (int d_ = 0; d_ < 4; ++d_) _Pragma("unroll") for (int r = 0; r < 16; ++r) o[d_][r] *= al_l[crow(r, hi)]; } } while (0)
#if PROBE_T
    unsigned long long pa_ = 0, pb_ = 0, pc_ = 0, pd_ = 0, pe2_ = 0; const unsigned long long pst_ = __builtin_amdgcn_s_memtime();
#define PSTAMP(v) const unsigned long long v = __builtin_amdgcn_s_memtime()
#define PACC(acc, a, b) acc += (b) - (a)
#else
#define PSTAMP(v) do {} while (0)
#define PACC(acc, a, b) do {} while (0)
#endif
#define TILE(t, BF) do { PSTAMP(s0_); const bool more_ = ((t) + 1 < NT); if (more_) SLOAD((t) + 1); SBAR(); \
        if (odd && (t) > 0) { pv_tile(o, vb0 + vo_prev, pa0, pa1, pa2, pa3); SBAR(); } \
        PSTAMP(s1_); qkt<BF>(p0, p1, K_lds, r32, hi, qr); \
        { const int kb_ = (t) * KVBLK; if (kb_ + KVBLK - 1 > q0) mask_tile(p0, p1, q0 + r32 - kb_ - 4 * hi); } \
        asm volatile("" : "+v"(p0), "+v"(p1)); PSTAMP(s2_); \
        softmax_tile(p0, p1, m_reg, l_reg, alpha, pa0, pa1, pa2, pa3); RESC(alpha); SBAR(); PSTAMP(s3_); \
        if (!odd) pv_tile(o, vb0 + vo_cur, pa0, pa1, pa2, pa3); \
        PSTAMP(s4_); if (more_) { asm volatile("s_waitcnt vmcnt(0)" ::: "memory"); SWRITE((BF) ^ 1, vo_next); } \
        PSTAMP(s5_); __syncthreads(); PSTAMP(s6_); PACC(pa_, s1_, s2_); PACC(pb_, s2_, s3_); PACC(pc_, s3_, s4_); PACC(pd_, s4_, s5_); PACC(pe2_, s5_, s6_); vo_prev = vo_cur; vo_cur = vo_next; vo_next = (vo_next == (NVB - 1) * SHM_V) ? 0 : vo_next + SHM_V; } while (0)
#pragma unroll 1
    for (int t = 0; t < NT; t += 2) { TILE(t, 0); TILE(t + 1, 1); }
    if (odd) pv_tile(o, vb0 + vo_prev, pa0, pa1, pa2, pa3);
#if PROBE_T
    if (pw && blockIdx.x == 0 && tid == 0) { pw[8] += pa_; pw[9] += pb_; pw[10] += pc_; pw[11] += pd_; pw[12] += pe2_; pw[13] += (unsigned long long)NT; pw[14] += __builtin_amdgcn_s_memtime() - pst_; }
#endif
    if (hi == 0) li_l[r32] = l_reg; asm volatile("s_waitcnt lgkmcnt(0)" ::: "memory");
    __syncthreads();
    { LAS bf16_t* stg = (LAS bf16_t*)(lds + wid * 8704);
#pragma unroll
      for (int r = 0; r < 16; ++r) { const int orow = crow(r, hi); const float rl = __builtin_amdgcn_rcpf(li_l[orow]);
#pragma unroll
          for (int d0 = 0; d0 < 4; ++d0) { const float v = o[d0][r] * rl; stg[orow * 136 + d0 * 32 + r32] = (bf16_t)(cvt_pk_bf16(v, v) & 0xffffu); } }
      asm volatile("s_waitcnt lgkmcnt(0)" ::: "memory");
      bf16_t* Ow = O + (row0 + q0) * 1024 + h * 128 + (lane & 15) * 8;
#pragma unroll
      for (int it = 0; it < 8; ++it) { const int row = it * 4 + (lane >> 4); const u32x4 v = *(const LAS u32x4*)(stg + row * 136 + (lane & 15) * 8); *(u32x4*)(Ow + (size_t)row * 1024) = v; } }
    __syncthreads();
#undef SLOAD
#undef SWRITE
#undef RESC
#undef TILE
#undef PSTAMP
#undef PACC
}
#undef SBAR
}

#define XB_TMO      128
#define XB_XCNT(j)  (256  + 64 * (j))
#define XB_XSUB(j)  (1280 + 64 * (j))
#define XB_XGEN(j)  (2304 + 64 * (j))
#define XB_TOP      3328
#define XB_TOPGEN   3392
#define XCD_BAR_WORDS 3456
#define XB_SPIN_CAP (1u << 22)
__device__ __forceinline__ unsigned xb_ld(unsigned* p)              { return __hip_atomic_load(p, __ATOMIC_RELAXED, __HIP_MEMORY_SCOPE_AGENT); }
__device__ __forceinline__ unsigned xb_add(unsigned* p, unsigned v) { return __hip_atomic_fetch_add(p, v, __ATOMIC_RELAXED, __HIP_MEMORY_SCOPE_AGENT); }
__device__ __forceinline__ unsigned xb_xcc_id() { return (unsigned)__builtin_amdgcn_s_getreg((3 << 11) | 20) & 0xFu; }
#define XB_SPIN(cond, bar) do { unsigned _sp = 0; while (cond) { __builtin_amdgcn_s_sleep(1); \
    if ((++_sp & 255u) == 0u) { if (xb_ld(&(bar)[XB_TMO])) break; if (_sp > XB_SPIN_CAP) { atomicAdd(&(bar)[XB_TMO], 1u); break; } } } } while (0)
struct XcdBarrier { unsigned* bar; unsigned x; volatile LAS unsigned* st; };
__device__ __forceinline__ XcdBarrier xcd_barrier_post(unsigned* bar, volatile LAS unsigned* st) {
    XcdBarrier b; b.bar = bar; b.x = xb_xcc_id(); b.st = st;
    if (threadIdx.x == 0) (void)xb_add(&bar[XB_XCNT(b.x)], 1u);
    return b;
}
__device__ __forceinline__ void xcd_barrier_complete(unsigned* bar, unsigned x, unsigned& nloc, unsigned& nx) {
    const unsigned G = gridDim.x * gridDim.y * gridDim.z;
    unsigned sum, cnt, mine, sp = 0u;
    for (;;) {
        sum = 0u; cnt = 0u; mine = 0u;
#pragma unroll
        for (unsigned j = 0; j < 16; ++j) { const unsigned c = xb_ld(&bar[XB_XCNT(j)]); sum += c; cnt += (c > 0u) ? 1u : 0u; mine = (j == x) ? c : mine; }
        if (sum == G) break;
        __builtin_amdgcn_s_sleep(1);
        if ((++sp & 255u) == 0u) { if (xb_ld(&bar[XB_TMO])) break; if (sp > XB_SPIN_CAP) { atomicAdd(&bar[XB_TMO], 1u); break; } }
    }
    nloc = mine > 0u ? mine : 1u; nx = cnt > 0u ? cnt : 1u;
}
__device__ __forceinline__ void xcd_barrier(const XcdBarrier& b) {
    asm volatile("s_waitcnt vmcnt(0)" ::: "memory");
    __syncthreads();
    if (opaque_tid() == 0) {
        unsigned* bar = b.bar; unsigned bx = b.x;
        asm volatile("" : "+s"(bar), "+s"(bx));
        __builtin_amdgcn_s_waitcnt(0);
        unsigned nloc = b.st[0], nx = b.st[1];
        if (nloc == 0u) { xcd_barrier_complete(bar, bx, nloc, nx); b.st[0] = nloc; b.st[1] = nx; }
        const unsigned old = xb_add(&bar[XB_XSUB(bx)], 1u);
        const unsigned gen = old / nloc;
        if (old + 1u == (gen + 1u) * nloc) {
            __builtin_amdgcn_fence(__ATOMIC_RELEASE, "agent");
            asm volatile("s_waitcnt vmcnt(0)" ::: "memory");
            const unsigned og = xb_add(&bar[XB_TOP], 1u);
            const unsigned tg = og / nx;
            if (og + 1u == (tg + 1u) * nx) xb_add(&bar[XB_TOPGEN], 1u);
            else XB_SPIN(xb_ld(&bar[XB_TOPGEN]) == tg, bar);
            __builtin_amdgcn_fence(__ATOMIC_ACQUIRE, "agent");
            xb_add(&bar[XB_XGEN(bx)], 1u);
            asm volatile("s_waitcnt vmcnt(0)" ::: "memory");
        } else {
            XB_SPIN(xb_ld(&bar[XB_XGEN(bx)]) == gen, bar);
            __builtin_amdgcn_fence(__ATOMIC_ACQUIRE, "agent");
            asm volatile("s_waitcnt vmcnt(0)" ::: "memory");
        }
    }
    __syncthreads();
}

struct Args { const void* in[30]; float* out; unsigned char* ws; int ph_lo, ph_hi, li, pad; };
struct Ctx { int tid, lane, wave, vcu, G, bid; LAS unsigned char* lds; volatile LAS int* misc; };
__device__ __forceinline__ Ctx fresh_ctx(const Ctx& c) {
    Ctx r = c; unsigned l = (unsigned)(uintptr_t)c.lds, m = (unsigned)(uintptr_t)c.misc;
    asm volatile("" : "+s"(r.wave), "+s"(r.vcu), "+s"(r.G), "+s"(r.bid), "+s"(l), "+s"(m));
    r.lds = (LAS unsigned char*)(uintptr_t)l; r.misc = (volatile LAS int*)(uintptr_t)m; r.tid = opaque_tid(); r.lane = r.tid & 63; return r; }
typedef const CAS Args* ArgsP;
__device__ __forceinline__ const CAS Args& fresh_args(ArgsP p) { asm volatile("" : "+s"(p)); return *p; }
enum { I_X = 0, I_P, I_POS, I_MLA_WIN, I_MLA_QN, I_MLA_KVN, I_MLA_WUQ, I_MLA_WUKV, I_MLA_WO, I_LRU_WIN, I_LRU_CW, I_LRU_CB, I_LRU_WA, I_LRU_BA, I_LRU_WX, I_LRU_BX, I_LRU_LAM, I_LRU_WOUT,
       I_LN1G, I_LN1B, I_LN2G, I_LN2B, I_MOE_WR, I_MOE_BR, I_MOE_WUP, I_MOE_BUP, I_MOE_WDN, I_MOE_BDN, I_PLE_WG, I_PLE_WP };
#define INF(i) ((const float*)args.in[i])
#define WSP(T_, off) ((T_*)(args.ws + (off)))

__device__ __forceinline__ void tr_load(const float* W, int ld, int k0, int sc0, int sc1, int lane, f32x4 (&v)[16]) {
    const int half = (lane & 15) >> 3, scol = half ? sc1 : sc0, c4 = (lane & 7) * 4, rs = lane >> 4;
#pragma unroll
    for (int i = 0; i < 8; ++i) { const float* p = W + (size_t)(k0 + 8 * i + 2 * rs) * ld + scol + c4;
        v[2 * i] = (scol >= 0) ? *(const f32x4*)p : (f32x4){0.f, 0.f, 0.f, 0.f}; v[2 * i + 1] = (scol >= 0) ? *(const f32x4*)(p + ld) : (f32x4){0.f, 0.f, 0.f, 0.f}; }
}
__device__ __forceinline__ void tr_store(f32x4 (&v)[16], const float* ksc, int k0, bf16_t* dst  , int K, LAS unsigned* scr, int lane) {
    const int rs = lane >> 4;
    if (ksc) {
#pragma unroll
        for (int i = 0; i < 8; ++i) { v[2 * i] = v[2 * i] * ksc[k0 + 8 * i + 2 * rs]; v[2 * i + 1] = v[2 * i + 1] * ksc[k0 + 8 * i + 2 * rs + 1]; } }
#pragma unroll
    for (int i = 0; i < 8; ++i) { LAS unsigned* s = scr + (4 * i + rs) * 65 + (lane & 15) * 4;
#pragma unroll
        for (int e = 0; e < 4; ++e) s[e] = cvt_pk_bf16(v[2 * i][e], v[2 * i + 1][e]); }
    asm volatile("s_waitcnt lgkmcnt(0)" ::: "memory");
    const int c = lane & 7;
#pragma unroll
    for (int j = 0; j < 8; ++j) { const int n = (lane >> 3) + 8 * j; const LAS unsigned* s = scr + (4 * c) * 65 + n;
        u32x4 o; o.x = s[0]; o.y = s[65]; o.z = s[130]; o.w = s[195];
        *(u32x4*)(dst + (size_t)n * K + 8 * c) = o; }
    asm volatile("s_waitcnt lgkmcnt(0)" ::: "memory");
}
enum { J_NAT = 0, J_MLA_WIN, J_MLA_WUQ, J_LRU_WAX, J_MOE_UP };
__device__ __forceinline__ int tr_map(int job, int g) {
    switch (job) {
    case J_MLA_WIN: return g < 32 ? 32 * g : (g == 32 ? 1024 : (g == 36 ? 1056 : -1));
    case J_MLA_WUQ: if (g < 32) { const int t = g >> 3, bj = (g >> 2) & 1, cg = g & 3; return (2 * t + bj) * 192 + 32 * cg; }
                    else { const int g2 = g - 32, t2 = g2 >> 3, bj = (g2 >> 2) & 1, hh = g2 & 3; return (4 * t2 + hh) * 192 + 128 + 32 * bj; }
    case J_LRU_WAX: { const int pn = g >> 3, cg = g & 3; return 128 * pn + 32 * cg; }
    case J_MOE_UP:  { const int pn = g >> 3, bj = (g >> 2) & 1, cg = g & 3; return bj * 1024 + 128 * pn + 32 * cg; }
    default: return 32 * g;
    }
}
__device__ __forceinline__ void tr_job(const Ctx& C, int job, const float* src, size_t srcstride, int nmat, int K, int ld, int N, bf16_t* dst, size_t dststride, const float* ksc, int kscstride,
                                       const float* src2  ) {
    LAS unsigned* scr = (LAS unsigned*)(C.lds + C.wave * 8320);
    const int gw = C.vcu * NWAVES + C.wave, NGW = C.G * NWAVES;
    const int nkb = K / 64, nnb = N / 64, per = nkb * nnb, total = per * nmat;
#define TR_DECODE(it_, W_, k0_, s0_, s1_, ks_, d_) do { const int mat_ = (it_) / per, r_ = (it_) - mat_ * per, kb_ = r_ / nnb, nb_ = r_ - kb_ * nnb; \
        s0_ = tr_map(job, 2 * nb_); s1_ = tr_map(job, 2 * nb_ + 1); W_ = src + (size_t)mat_ * srcstride; \
        if (job == J_LRU_WAX && ((nb_ >> 1) & 1)) W_ = src2 + (size_t)mat_ * srcstride;       \
        k0_ = kb_ * 64; ks_ = ksc ? ksc + (size_t)mat_ * kscstride : nullptr; d_ = (bf16_t*)((char*)dst + (size_t)mat_ * dststride) + (size_t)(nb_ * 64) * K + kb_ * 64; } while (0)
    f32x4 va[16], vb[16];
    int it = gw; const float* Wc; int k0c, s0c, s1c; const float* ksc_c; bf16_t* dc;
    if (it < total) { TR_DECODE(it, Wc, k0c, s0c, s1c, ksc_c, dc); tr_load(Wc, ld, k0c, s0c, s1c, C.lane, va); }
    while (it < total) {
        const int nit = it + NGW; const float* Wn = nullptr; int k0n = 0, s0n = 0, s1n = 0; const float* ksc_n = nullptr; bf16_t* dn = nullptr;
        if (nit < total) { TR_DECODE(nit, Wn, k0n, s0n, s1n, ksc_n, dn); tr_load(Wn, ld, k0n, s0n, s1n, C.lane, vb); }
        tr_store(va, ksc_c, k0c, dc, K, scr, C.lane);
#pragma unroll
        for (int i = 0; i < 16; ++i) va[i] = vb[i];
        it = nit; k0c = k0n; ksc_c = ksc_n; dc = dn;
    }
#undef TR_DECODE
}
template <int JOB, int N, bool G64  >
__device__ __forceinline__ void tr_job_fp8(const Ctx& C, const float* src, size_t srcstride, int nmat, unsigned char* dst, size_t dststride, unsigned char* SW) {
    constexpr int K = 1024, ld = N;
    LAS float* scr = (LAS float*)(C.lds + C.wave * 16640);
    const int gw = C.vcu * NWAVES + C.wave, NGW = C.G * NWAVES, lane = C.lane;
    const int nkb = K / 64, nnb = N / 64, per = nkb * nnb, total = per * nmat;
    for (int it = gw; it < total; it += NGW) {
        const int mat = it / per, r = it - mat * per, kb = r / nnb, nb = r - kb * nnb;
        const int s0 = tr_map(JOB, 2 * nb), s1 = tr_map(JOB, 2 * nb + 1);
        f32x4 v[16];
        tr_load(src + (size_t)mat * srcstride, ld, kb * 64, s0, s1, lane, v);
        const int rs = lane >> 4;
#pragma unroll
        for (int i = 0; i < 8; ++i) { LAS float* sp = scr + (8 * i + 2 * rs) * 65 + (lane & 15) * 4;
#pragma unroll
            for (int e = 0; e < 4; ++e) { sp[e] = v[2 * i][e]; sp[65 + e] = v[2 * i + 1][e]; } }
        asm volatile("s_waitcnt lgkmcnt(0)" ::: "memory");
        const int c = lane & 7;
#pragma unroll
        for (int j = 0; j < 8; ++j) { const int n = (lane >> 3) + 8 * j; const LAS float* sp = scr + (8 * c) * 65 + n;
            float x[8]; float am = 0.f;
#pragma unroll
            for (int q = 0; q < 8; ++q) { x[q] = sp[q * 65]; am = fmaxf(am, fabsf(x[q])); }
            am = fmaxf(am, __shfl_xor(am, 1)); am = fmaxf(am, __shfl_xor(am, 2));
            if (G64) am = fmaxf(am, __shfl_xor(am, 4));
            int eb = (int)((__float_as_uint(am) >> 23) & 0xffu) - 7; eb = eb < 1 ? 1 : eb;
            const float inv = __uint_as_float((unsigned)(254 - eb) << 23);
            int w0 = __builtin_amdgcn_cvt_pk_fp8_f32(x[0] * inv, x[1] * inv, 0, false); w0 = __builtin_amdgcn_cvt_pk_fp8_f32(x[2] * inv, x[3] * inv, w0, true);
            int w1 = __builtin_amdgcn_cvt_pk_fp8_f32(x[4] * inv, x[5] * inv, 0, false); w1 = __builtin_amdgcn_cvt_pk_fp8_f32(x[6] * inv, x[7] * inv, w1, true);
            const int nrow = nb * 64 + n;
            *(u32x2*)(dst + (size_t)mat * dststride + (size_t)nrow * K + kb * 64 + 8 * c) = (u32x2){(unsigned)w0, (unsigned)w1};
            if (!G64) { if ((c & 3) == 0) SW[(size_t)mat * 65536 + (size_t)(nrow >> 8) * 8192 + (size_t)(kb >> 1) * 1024 + (nrow & 255) * 4 + 2 * (kb & 1) + (c >> 2)] = (unsigned char)eb; }
            else { if (c == 0) SW[(size_t)mat * 16384 + (size_t)(nrow >> 8) * 4096 + (size_t)(kb >> 1) * 512 + (nrow & 255) * 2 + (kb & 1)] = (unsigned char)eb; } }
        asm volatile("s_waitcnt lgkmcnt(0)" ::: "memory");
    }
}
__device__ __forceinline__ void cvt_rows(const Ctx& C, const float* src, bf16_t* dst, size_t n8  ) {
    const size_t gt = (size_t)C.vcu * 512 + C.tid, NT = (size_t)C.G * 512;
    for (size_t i = gt; i < n8; i += NT) { const f32x4 a = *(const f32x4*)(src + i * 8), b = *(const f32x4*)(src + i * 8 + 4); *(u32x4*)(dst + i * 8) = pack8(a, b); }
}
__device__ __forceinline__ void phase_prologue(const CAS Args& args, const Ctx& C) {
    tr_job(C, J_MLA_WIN, INF(I_MLA_WIN), (size_t)DM * LATD, 2, DM, LATD, 1280, WSP(bf16_t, WS_W_MLA + OFF_MLA_WIN), W_MLA_STRIDE, nullptr, 0, nullptr);
    tr_job(C, J_MLA_WUQ, INF(I_MLA_WUQ), (size_t)QL * 1536, 2, QL, 1536, 1536, WSP(bf16_t, WS_W_MLA + OFF_MLA_WUQ), W_MLA_STRIDE, INF(I_MLA_QN), QL, nullptr);
    tr_job(C, J_NAT, INF(I_MLA_WUKV), (size_t)KVL * 2048, 2, KVL, 2048, 2048, WSP(bf16_t, WS_W_MLA + OFF_MLA_WUKV), W_MLA_STRIDE, INF(I_MLA_KVN), KVL, nullptr);
    tr_job(C, J_NAT, INF(I_MLA_WO), (size_t)DM * DM, 2, DM, DM, DM, WSP(bf16_t, WS_W_MLA + OFF_MLA_WO), W_MLA_STRIDE, nullptr, 0, nullptr);
    tr_job(C, J_NAT, INF(I_LRU_WIN), (size_t)DM * 2048, 2, DM, 2048, 2048, WSP(bf16_t, WS_W_LRU + OFF_LRU_WIN), W_LRU_STRIDE, nullptr, 0, nullptr);
    for (int j = 0; j < 2; ++j)
        tr_job(C, J_LRU_WAX, INF(I_LRU_WA) + (size_t)j * 4 * 65536, (size_t)256 * 256, 4, 256, 256, 512, WSP(bf16_t, WS_W_LRU + OFF_LRU_WAX + (size_t)j * W_LRU_STRIDE), (size_t)512 * 256 * 2, nullptr, 0, INF(I_LRU_WX) + (size_t)j * 4 * 65536);
    tr_job(C, J_NAT, INF(I_LRU_WOUT), (size_t)DM * DM, 2, DM, DM, DM, WSP(bf16_t, WS_W_LRU + OFF_LRU_WOUT), W_LRU_STRIDE, nullptr, 0, nullptr);
    tr_job(C, J_NAT, INF(I_PLE_WG), (size_t)DM * DM, 4, DM, DM, DM, WSP(bf16_t, WS_W_PLE + OFF_PLE_WG), W_PLE_STRIDE, nullptr, 0, nullptr);
    tr_job(C, J_NAT, INF(I_PLE_WP), (size_t)PLED * DM, 4, PLED, DM, DM, WSP(bf16_t, WS_W_PLE + OFF_PLE_WP), W_PLE_STRIDE, nullptr, 0, nullptr);
    __syncthreads();
    tr_job_fp8<J_MOE_UP, 2048, false>(C, INF(I_MOE_WUP), (size_t)DM * 2048, DEPTH * NE, args.ws + WS_W_UP, (size_t)2048 * 1024, args.ws + WS_SW);
    tr_job_fp8<J_NAT, 1024, true>(C, INF(I_MOE_WDN), (size_t)DFF * DM, DEPTH * NE, args.ws + WS_W_DN, (size_t)1024 * 1024, args.ws + WS_SWD);
    __syncthreads();
    cvt_rows(C, INF(I_X), WSP(bf16_t, WS_XB), (size_t)T * DM / 8);
    cvt_rows(C, INF(I_P), WSP(bf16_t, WS_PB), (size_t)DEPTH * T * PLED / 8);
    { const int* pos = (const int*)args.in[I_POS]; float* CS = WSP(float, WS_CS); float* SN = WSP(float, WS_SN);
      const size_t gt = (size_t)C.vcu * 512 + C.tid, NT = (size_t)C.G * 512;
      for (size_t i = gt; i < (size_t)T * 32; i += NT) { const int tok = (int)(i >> 5), j = (int)(i & 31);
          const double inv = exp(-9.210340371976184 * (double)j / 32.0); const double ang = (double)pos[tok] * inv; double s, c; sincos(ang, &s, &c); CS[i] = (float)c; SN[i] = (float)s; }
      { const float* wr = INF(I_MOE_WR); bf16_t* WRH = WSP(bf16_t, WS_WRH); bf16_t* WRL = WSP(bf16_t, WS_WRL);
        for (size_t i = gt; i < (size_t)DEPTH * 64 * 64; i += NT) { const int l = (int)(i >> 12), st = (int)(i >> 6) & 63, ln = (int)i & 63; float w[8], lo[8];
#pragma unroll
            for (int j = 0; j < 8; ++j) w[j] = wr[((size_t)l * DM + 16 * st + 8 * (ln >> 5) + j) * NE + (ln & 31)];
            u32x4 h; h.x = cvt_pk_bf16(w[0], w[1]); h.y = cvt_pk_bf16(w[2], w[3]); h.z = cvt_pk_bf16(w[4], w[5]); h.w = cvt_pk_bf16(w[6], w[7]);
            lo[0] = w[0] - bf_lo(h.x); lo[1] = w[1] - bf_hi(h.x); lo[2] = w[2] - bf_lo(h.y); lo[3] = w[3] - bf_hi(h.y); lo[4] = w[4] - bf_lo(h.z); lo[5] = w[5] - bf_hi(h.z); lo[6] = w[6] - bf_lo(h.w); lo[7] = w[7] - bf_hi(h.w);
            u32x4 q; q.x = cvt_pk_bf16(lo[0], lo[1]); q.y = cvt_pk_bf16(lo[2], lo[3]); q.z = cvt_pk_bf16(lo[4], lo[5]); q.w = cvt_pk_bf16(lo[6], lo[7]);
            *(u32x4*)(WRH + i * 8) = h; *(u32x4*)(WRL + i * 8) = q; } }
      float* SPL = WSP(float, WS_SPL); const float* lam = INF(I_LRU_LAM);
      for (size_t i = gt; i < 2 * 1024; i += NT) { const double l = (double)lam[i]; SPL[i] = (float)(-8.0 * log1p(exp(-l))); } }
}

__device__ __forceinline__ void moe_table(const CAS Args& args, const Ctx& C0, int layer) {
    Ctx C = C0; C.tid = opaque_tid(); C.lane = C.tid & 63;
    const unsigned* cnt = WSP(unsigned, WS_CTL) + CW_CNT + 64 * layer;
    __syncthreads();
    if (C.tid < 32) C.misc[64 + C.tid] = (int)__hip_atomic_load(cnt + C.tid, __ATOMIC_RELAXED, __HIP_MEMORY_SCOPE_AGENT);
    __syncthreads();
    if (C.tid == 0) { int acc = 0; for (int e = 0; e < 32; ++e) { C.misc[16 + e] = acc; acc += (C.misc[64 + e] + 255) >> 8; } C.misc[16 + 32] = acc; }
    __syncthreads();
    { volatile LAS unsigned char* te = (volatile LAS unsigned char*)(C.lds + TILE_E_OFF);
      for (int mg = C.tid; mg < C.misc[48]; mg += NWAVES * 64) { int e = 0; for (int j = 1; j < 32; ++j) e += (C.misc[16 + j] <= mg) ? 1 : 0; te[mg] = (unsigned char)e; } }
    __syncthreads();
}

__device__ __forceinline__ void phase_ln_router(const CAS Args& args, const Ctx& C0, int layer) {
    const int cslot = layer + args.pad;
    Ctx C = C0; C.tid = opaque_tid(); C.lane = C.tid & 63;
    const bf16_t* Y = WSP(bf16_t, WS_Y); bf16_t* X1L = WSP(bf16_t, WS_X1); bf16_t* X1B = WSP(bf16_t, WS_X1B);
    const float* g1 = INF(I_LN1G) + layer * DM; const float* b1 = INF(I_LN1B) + layer * DM;
    const bf16_t* WRH = WSP(bf16_t, WS_WRH) + (size_t)layer * 64 * 64 * 8; const bf16_t* WRL = WSP(bf16_t, WS_WRL) + (size_t)layer * 64 * 64 * 8; const float* br = INF(I_MOE_BR) + layer * NE;
    unsigned* gcnt = WSP(unsigned, WS_CTL) + CW_CNT + 64 * cslot;
    int* lists = WSP(int, WS_LIST); int* slot = WSP(int, WS_SLOT); float* gate = WSP(float, WS_GATE);
    LAS float* part = (LAS float*)C.lds;
    volatile LAS int* lcnt = (volatile LAS int*)(C.lds + 69632);
    volatile LAS int* lbase = lcnt + 32;
    f32x4 gv[4], bv[4];
#pragma unroll
    for (int j = 0; j < 2; ++j) { gv[2 * j] = *(const f32x4*)(g1 + 8 * C.lane + 512 * j); gv[2 * j + 1] = *(const f32x4*)(g1 + 8 * C.lane + 512 * j + 4);
        bv[2 * j] = *(const f32x4*)(b1 + 8 * C.lane + 512 * j); bv[2 * j + 1] = *(const f32x4*)(b1 + 8 * C.lane + 512 * j + 4); }
    unsigned char* X1Q = args.ws + WS_X1Q; int sexp;
    { float ag = 0.f, ab = 0.f;
#pragma unroll
      for (int j = 0; j < 4; ++j)
#pragma unroll
          for (int e = 0; e < 4; ++e) { ag = fmaxf(ag, fabsf(gv[j][e])); ab = fmaxf(ab, fabsf(bv[j][e])); }
#pragma unroll
      for (int o = 1; o < 64; o <<= 1) { ag = fmaxf(ag, __shfl_xor(ag, o)); ab = fmaxf(ab, __shfl_xor(ab, o)); }
      const float bound = 16.0f * ag + ab + 1e-20f;
      sexp = 134 - (int)((__float_as_uint(bound) >> 23) & 0xffu);
      sexp = sexp < -100 ? -100 : (sexp > 100 ? 100 : sexp);
      if (C.tid == 0) __hip_atomic_store(WSP(unsigned, WS_CTL) + CW_SA + layer, (unsigned)sexp, __ATOMIC_RELAXED, __HIP_MEMORY_SCOPE_AGENT); }
    const float qs = __uint_as_float((unsigned)(127 + sexp) << 23), qlo = KF(-448.f), qhi = KF(448.f);
    for (int chunk = C.vcu; chunk < T / 128; chunk += C.G) {
        const int row0 = chunk * 128;
        if (C.tid < 32) lcnt[C.tid] = 0;
#pragma unroll 1
        for (int i = 0; i < 16; ++i) { const size_t row = (size_t)row0 + C.wave * 16 + i;
            f32x4 v[4]; float s = 0.f;
#pragma unroll
            for (int j = 0; j < 2; ++j) { const u32x4 w = *(const u32x4*)(Y + row * DM + 8 * C.lane + 512 * j); v[2 * j] = pg8::bf4_lo(w); v[2 * j + 1] = pg8::bf4_hi(w); }
#pragma unroll
            for (int j = 0; j < 4; ++j) s += (v[j][0] + v[j][1]) + (v[j][2] + v[j][3]);
            const float mean = wave_sum(s) * (1.f / DM); float s2 = 0.f;
#pragma unroll
            for (int j = 0; j < 4; ++j) { v[j] = v[j] - mean; s2 += (v[j][0] * v[j][0] + v[j][1] * v[j][1]) + (v[j][2] * v[j][2] + v[j][3] * v[j][3]); }
            const float rstd = 1.f / sqrtf(wave_sum(s2) * (1.f / DM) + KF(LN_EPS));
#pragma unroll
            for (int j = 0; j < 4; ++j) v[j] = v[j] * rstd * gv[j] + bv[j];
#pragma unroll
            for (int j = 0; j < 2; ++j) { const u32x4 hw = pack8(v[2 * j], v[2 * j + 1]);
                *(u32x4*)(X1B + row * DM + 8 * C.lane + 512 * j) = hw;
                *(u32x4*)(X1L + row * DM + 8 * C.lane + 512 * j) = pack8(v[2 * j] - pg8::bf4_lo(hw), v[2 * j + 1] - pg8::bf4_hi(hw));
                const f32x4 q0 = v[2 * j] * qs, q1 = v[2 * j + 1] * qs;
                int w0 = __builtin_amdgcn_cvt_pk_fp8_f32(fminf(fmaxf(q0[0], qlo), qhi), fminf(fmaxf(q0[1], qlo), qhi), 0, false); w0 = __builtin_amdgcn_cvt_pk_fp8_f32(fminf(fmaxf(q0[2], qlo), qhi), fminf(fmaxf(q0[3], qlo), qhi), w0, true);
                int w1 = __builtin_amdgcn_cvt_pk_fp8_f32(fminf(fmaxf(q1[0], qlo), qhi), fminf(fmaxf(q1[1], qlo), qhi), 0, false); w1 = __builtin_amdgcn_cvt_pk_fp8_f32(fminf(fmaxf(q1[2], qlo), qhi), fminf(fmaxf(q1[3], qlo), qhi), w1, true);
                *(u32x2*)(X1Q + row * DM + 8 * C.lane + 512 * j) = (u32x2){(unsigned)w0, (unsigned)w1}; } }
        asm volatile("s_waitcnt vmcnt(0)" ::: "memory");
        __syncthreads();
        { const int grp = C.wave >> 1, kh = C.wave & 1, r32 = C.lane & 31, hi = C.lane >> 5;
          const bf16_t* ah = X1B + ((size_t)row0 + grp * 32 + r32) * DM + kh * 512 + hi * 8; const bf16_t* al = X1L + ((size_t)row0 + grp * 32 + r32) * DM + kh * 512 + hi * 8;
          const bf16_t* bh = WRH + ((size_t)kh * 32 * 64 + C.lane) * 8; const bf16_t* bl = WRL + ((size_t)kh * 32 * 64 + C.lane) * 8;
          f32x16 acc = {};
#pragma unroll 4
          for (int st = 0; st < 32; ++st) { const bf16x8 xh = *(const bf16x8*)(ah + st * 16), xl = *(const bf16x8*)(al + st * 16), wh = *(const bf16x8*)(bh + (size_t)st * 512), wl = *(const bf16x8*)(bl + (size_t)st * 512);
              acc = __builtin_amdgcn_mfma_f32_32x32x16_bf16(xh, wh, acc, 0, 0, 0);
              acc = __builtin_amdgcn_mfma_f32_32x32x16_bf16(xl, wh, acc, 0, 0, 0);
              acc = __builtin_amdgcn_mfma_f32_32x32x16_bf16(xh, wl, acc, 0, 0, 0); }
          LAS float* pp = part + (grp * 2 + kh) * 32 * 33 + r32;
#pragma unroll
          for (int r = 0; r < 16; ++r) pp[((r & 3) + 8 * (r >> 2) + 4 * hi) * 33] = acc[r]; }
        __syncthreads();
        int te[4] = {0, 0, 0, 0}, lp[4] = {0, 0, 0, 0}; float tg[4] = {0.f, 0.f, 0.f, 0.f};
        if (C.tid < 128) { const int grp = C.tid >> 5, ln = C.tid & 31; float lg[32];
#pragma unroll
            for (int e = 0; e < 32; ++e) lg[e] = br[e] + (part[((grp * 2 + 0) * 32 + ln) * 33 + e] + part[((grp * 2 + 1) * 32 + ln) * 33 + e]);
            float tv[4]; const float kninf = KF(-__builtin_inff());
#pragma unroll
            for (int k = 0; k < 4; ++k) { float best = lg[0]; int bi = 0;
#pragma unroll
                for (int e = 1; e < 32; ++e) { const bool gt = lg[e] > best; best = gt ? lg[e] : best; bi = gt ? e : bi; }
                te[k] = bi; tv[k] = best;
#pragma unroll
                for (int e = 0; e < 32; ++e) lg[e] = (e == bi) ? kninf : lg[e]; }
            float den = 0.f;
#pragma unroll
            for (int k = 0; k < 4; ++k) { tg[k] = __expf(tv[k] - tv[0]); den += tg[k]; }
            const float rden = 1.0f / den;
#pragma unroll
            for (int k = 0; k < 4; ++k) { tg[k] *= rden; lp[k] = __hip_atomic_fetch_add((LAS int*)&lcnt[te[k]], 1, __ATOMIC_RELAXED, __HIP_MEMORY_SCOPE_WORKGROUP); } }
        __syncthreads();
        if (C.tid < 32) lbase[C.tid] = (int)__hip_atomic_fetch_add(gcnt + C.tid, (unsigned)lcnt[C.tid], __ATOMIC_RELAXED, __HIP_MEMORY_SCOPE_AGENT);
        __syncthreads();
        if (C.tid < 128) { const int tok = row0 + C.tid;
#pragma unroll
            for (int k = 0; k < 4; ++k) { const int pos = lbase[te[k]] + lp[k]; lists[(size_t)te[k] * T + pos] = tok; slot[tok * 4 + k] = te[k] * T + pos; gate[tok * 4 + k] = tg[k]; } }
        __syncthreads();
    }
}

__device__ __forceinline__ void phase_combine_ln2(const CAS Args& args, const Ctx& C0, int layer) {
    Ctx C = C0; C.tid = opaque_tid(); C.lane = C.tid & 63;
    moe_table(args, C, layer);
    const bf16_t* X1B = WSP(bf16_t, WS_X1B); const bf16_t* YS = WSP(bf16_t, WS_YS); const int* slot = WSP(int, WS_SLOT); const float* gate = WSP(float, WS_GATE);
    bf16_t* X2B = WSP(bf16_t, WS_X2B);
    const float* g2 = INF(I_LN2G) + layer * DM; const float* b2 = INF(I_LN2B) + layer * DM;
    f32x4 gv[4], bv[4];
#pragma unroll
    for (int j = 0; j < 2; ++j) { gv[2 * j] = *(const f32x4*)(g2 + 8 * C.lane + 512 * j); gv[2 * j + 1] = *(const f32x4*)(g2 + 8 * C.lane + 512 * j + 4);
        bv[2 * j] = *(const f32x4*)(b2 + 8 * C.lane + 512 * j); bv[2 * j + 1] = *(const f32x4*)(b2 + 8 * C.lane + 512 * j + 4); }
    const int gw = C.vcu * NWAVES + C.wave, NGW = C.G * NWAVES;
    for (int row = gw; row < T; row += NGW) {
        f32x4 v[4];
#pragma unroll
        for (int j = 0; j < 2; ++j) { const u32x4 w = *(const u32x4*)(X1B + (size_t)row * DM + 8 * C.lane + 512 * j); v[2 * j] = pg8::bf4_lo(w) * ALPHA; v[2 * j + 1] = pg8::bf4_hi(w) * ALPHA; }
#pragma unroll
        for (int k = 0; k < 4; ++k) { const int sv = slot[row * 4 + k]; const float g = gate[row * 4 + k]; const int e = sv >> 15, pos = sv & (T - 1);
            const size_t prow = (size_t)C.misc[16 + e] * 256 + pos;
#pragma unroll
            for (int j = 0; j < 2; ++j) { const u32x4 w = *(const u32x4*)(YS + prow * DM + 8 * C.lane + 512 * j); v[2 * j] += pg8::bf4_lo(w) * g; v[2 * j + 1] += pg8::bf4_hi(w) * g; } }
        float s = 0.f;
#pragma unroll
        for (int j = 0; j < 4; ++j) s += (v[j][0] + v[j][1]) + (v[j][2] + v[j][3]);
        const float mean = wave_sum(s) * (1.f / DM); float s2 = 0.f;
#pragma unroll
        for (int j = 0; j < 4; ++j) { v[j] = v[j] - mean; s2 += (v[j][0] * v[j][0] + v[j][1] * v[j][1]) + (v[j][2] * v[j][2] + v[j][3] * v[j][3]); }
        const float rstd = 1.f / sqrtf(wave_sum(s2) * (1.f / DM) + KF(LN_EPS));
#pragma unroll
        for (int j = 0; j < 4; ++j) v[j] = v[j] * rstd * gv[j] + bv[j];
#pragma unroll
        for (int j = 0; j < 2; ++j) *(u32x4*)(X2B + (size_t)row * DM + 8 * C.lane + 512 * j) = pack8(v[2 * j], v[2 * j + 1]);
    }
}

__device__ __forceinline__ void phase_conv(const CAS Args& args, const Ctx& C0, int j) {
    Ctx C = C0; C.tid = opaque_tid(); C.lane = C.tid & 63;
    const bf16_t* U = WSP(bf16_t, WS_U); bf16_t* UC = WSP(bf16_t, WS_UC);
    const float* cw = INF(I_LRU_CW) + (size_t)j * 4 * DM; const float* cb = INF(I_LRU_CB) + (size_t)j * DM;
    const int c8 = (C.tid & 127) * 8, rsub = C.tid >> 7;
    float w[4][8], bb[8];
#pragma unroll
    for (int q = 0; q < 4; ++q)
#pragma unroll
        for (int e = 0; e < 8; ++e) w[q][e] = cw[q * DM + c8 + e];
#pragma unroll
    for (int e = 0; e < 8; ++e) bb[e] = cb[c8 + e];
    for (int chunk = C.vcu; chunk < T / 128; chunk += C.G) {
        const int r0 = chunk * 128 + rsub * 32;
        u32x4 h0, h1, h2;
        const u32x4 z = {0u, 0u, 0u, 0u};
        const int s0 = r0 & (SEQ - 1);
        h0 = s0 >= 3 ? *(const u32x4*)(U + (size_t)(r0 - 3) * DM + c8) : z; h1 = s0 >= 2 ? *(const u32x4*)(U + (size_t)(r0 - 2) * DM + c8) : z; h2 = s0 >= 1 ? *(const u32x4*)(U + (size_t)(r0 - 1) * DM + c8) : z;
#pragma unroll 4
        for (int i = 0; i < 32; ++i) { const u32x4 h3 = *(const u32x4*)(U + (size_t)(r0 + i) * DM + c8);
            float o[8];
#pragma unroll
            for (int q = 0; q < 4; ++q) { const unsigned a = h0[q], b = h1[q], c = h2[q], d = h3[q];
                o[2 * q] = bb[2 * q] + w[0][2 * q] * bf_lo(a) + w[1][2 * q] * bf_lo(b) + w[2][2 * q] * bf_lo(c) + w[3][2 * q] * bf_lo(d);
                o[2 * q + 1] = bb[2 * q + 1] + w[0][2 * q + 1] * bf_hi(a) + w[1][2 * q + 1] * bf_hi(b) + w[2][2 * q + 1] * bf_hi(c) + w[3][2 * q + 1] * bf_hi(d); }
            u32x4 ow; ow.x = cvt_pk_bf16(o[0], o[1]); ow.y = cvt_pk_bf16(o[2], o[3]); ow.z = cvt_pk_bf16(o[4], o[5]); ow.w = cvt_pk_bf16(o[6], o[7]);
            *(u32x4*)(UC + (size_t)(r0 + i) * DM + c8) = ow; h0 = h1; h1 = h2; h2 = h3; }
    }
}
__device__ __forceinline__ void phase_scan1(const CAS Args& args, const Ctx& C0) {
    Ctx C = C0; C.tid = opaque_tid(); C.lane = C.tid & 63;
    const bf16_t* LA = WSP(bf16_t, WS_AA); const bf16_t* BB = WSP(bf16_t, WS_BB); float* CA = WSP(float, WS_CA); float* CH = WSP(float, WS_CH);
    const int c2 = C.tid * 2;
    for (int item = C.vcu; item < NBATCH * 64; item += C.G) {
        const size_t r0 = (size_t)item * 64; float h0 = 0.f, h1 = 0.f, l0 = 0.f, l1 = 0.f;
#pragma unroll 8
        for (int s = 0; s < 64; ++s) { const unsigned aw = *(const unsigned*)(LA + (r0 + s) * DM + c2), bw = *(const unsigned*)(BB + (r0 + s) * DM + c2);
            const float la0 = bf_lo(aw), la1 = bf_hi(aw);
            h0 = __builtin_amdgcn_exp2f(la0) * h0 + bf_lo(bw); h1 = __builtin_amdgcn_exp2f(la1) * h1 + bf_hi(bw); l0 += la0; l1 += la1; }
        *(f32x2*)(CA + (size_t)item * DM + c2) = (f32x2){__builtin_amdgcn_exp2f(l0), __builtin_amdgcn_exp2f(l1)}; *(f32x2*)(CH + (size_t)item * DM + c2) = (f32x2){h0, h1};
    }
}
__device__ __forceinline__ void phase_scan2(const CAS Args& args, const Ctx& C0) {
    Ctx C = C0; C.tid = opaque_tid(); C.lane = C.tid & 63;
    const bf16_t* LA = WSP(bf16_t, WS_AA); const bf16_t* BB = WSP(bf16_t, WS_BB); const float* CA = WSP(float, WS_CA); const float* CH = WSP(float, WS_CH);
    const bf16_t* GG = WSP(bf16_t, WS_GG); bf16_t* YL = WSP(bf16_t, WS_O);
    const int c2 = C.tid * 2;
    for (int item = C.vcu; item < NBATCH * 64; item += C.G) {
        const int b = item >> 6, ch = item & 63; float h0 = 0.f, h1 = 0.f;
        for (int jx = 0; jx < ch; ++jx) { const f32x2 a = *(const f32x2*)(CA + (size_t)(b * 64 + jx) * DM + c2), e = *(const f32x2*)(CH + (size_t)(b * 64 + jx) * DM + c2);
            h0 = a[0] * h0 + e[0]; h1 = a[1] * h1 + e[1]; }
        const size_t r0 = (size_t)item * 64;
#pragma unroll 8
        for (int s = 0; s < 64; ++s) { const unsigned aw = *(const unsigned*)(LA + (r0 + s) * DM + c2), bw = *(const unsigned*)(BB + (r0 + s) * DM + c2), g = *(const unsigned*)(GG + (r0 + s) * DM + c2);
            h0 = __builtin_amdgcn_exp2f(bf_lo(aw)) * h0 + bf_lo(bw); h1 = __builtin_amdgcn_exp2f(bf_hi(aw)) * h1 + bf_hi(bw);
            *(unsigned*)(YL + (r0 + s) * DM + c2) = cvt_pk_bf16(bf_lo(g) * h0, bf_hi(g) * h1); }
    }
}

#if PROBE_T
typedef int v8i_t __attribute__((ext_vector_type(8)));
__device__ __forceinline__ unsigned fp8_of_int(int v) { const unsigned char t[4] = {0x00, 0x38, 0x40, 0x44}; const int a = v < 0 ? -v : v; return (unsigned)t[a] | (v < 0 ? 0x80u : 0u); }
__device__ __forceinline__ int tA(int i, int k) { return ((i * 3 + k * 5) % 7) - 3; }
__device__ __forceinline__ int tB(int k, int j) { return ((k * 2 + j * 7) % 5) - 2; }
__device__ __forceinline__ void mfma_fp8_selftest(unsigned* flagw) {
    const int l = threadIdx.x & 63, r = l & 15, q = l >> 4;
    v8i_t A, B;
#pragma unroll
    for (int d = 0; d < 8; ++d) { unsigned wa = 0, wb = 0;
#pragma unroll
        for (int b = 0; b < 4; ++b) { const int k = 32 * q + 4 * d + b; wa |= fp8_of_int(tA(r, k)) << (8 * b); wb |= fp8_of_int(tB(k, r)) << (8 * b); }
        A[d] = (int)wa; B[d] = (int)wb; }
    const f32x4 z = {0.f, 0.f, 0.f, 0.f};
    const int U = 0x7f7f7f7f;
    const int saq = (127 + q) * 0x01010101;
    const int sab = (q == 0) ? (int)0x8281807fu : U;
    const f32x4 m2 = __builtin_amdgcn_mfma_scale_f32_16x16x128_f8f6f4(A, B, z, 0, 0, 0, saq, 0, U);
    const f32x4 m5 = __builtin_amdgcn_mfma_scale_f32_16x16x128_f8f6f4(A, B, z, 0, 0, 0, sab, 0, U);
    bool k1 = true, k2 = true, k3 = true, k4 = true;
#pragma unroll
    for (int e = 0; e < 4; ++e) { const int i = 4 * q + e, j = r; float eb = 0.f, e0 = 0.f, ec = 0.f, ed = 0.f;
        for (int kq = 0; kq < 4; ++kq) for (int hh = 0; hh < 2; ++hh) { float sh = 0.f; for (int k = 32 * kq + 16 * hh; k < 32 * kq + 16 * hh + 16; ++k) sh += (float)(tA(i, k) * tB(k, j));
            const int xb = hh == 0 ? (kq >> 1) : 2 + (kq >> 1);
            eb += sh * (float)(1 << xb); e0 += sh; ec += sh * (float)(1 << kq); ed += sh * (float)(1 << xb); }
        k1 = k1 && (m2[e] == eb); k2 = k2 && (m2[e] == e0); k3 = k3 && (m5[e] == ec); k4 = k4 && (m5[e] == ed); }
    const bool b1 = __all(k1), b2 = __all(k2), b3 = __all(k3), b4 = __all(k4);
    if (l == 0) *flagw = (b1 ? 1u : 0u) | (b2 ? 2u : 0u) | (b3 ? 4u : 0u) | (b4 ? 8u : 0u);
}
#endif
constexpr int PH_PER_LAYER = 12, PH_TOTAL = 2 + PH_PER_LAYER * DEPTH;
__global__ void __launch_bounds__(NWAVES * 64, 2) fwd_kernel(Args args_kernarg) {
    (void)args_kernarg;
    ArgsP const argp = (ArgsP)__builtin_amdgcn_kernarg_segment_ptr();
    const CAS Args& args0 = *argp;
    extern __shared__ __attribute__((aligned(16))) unsigned char lds_raw[];
    Ctx C_;
    C_.lds = (LAS unsigned char*)lds_raw; C_.misc = (volatile LAS int*)(C_.lds + MISC_OFF);
    C_.tid = threadIdx.x; C_.lane = C_.tid & 63; C_.wave = __builtin_amdgcn_readfirstlane(C_.tid >> 6);
    C_.bid = (int)blockIdx.x; C_.G = gridDim.x; { const int bx = blockIdx.x; C_.vcu = (C_.G % 8 == 0) ? (bx % 8) * (C_.G / 8) + bx / 8 : bx; }
    for (int u = C_.tid; u < 128; u += NWAVES * 64) C_.misc[u] = 0;
    __syncthreads();
    XcdBarrier bar = xcd_barrier_post((unsigned*)(args0.ws + WS_CTL) + CW_BAR + args0.li * XCD_BAR_WORDS, (volatile LAS unsigned*)C_.misc);
    const int lo = args0.ph_lo, hi = args0.ph_hi;
#define IN(k) (lo <= (k) && (k) < hi)
#define PH_END(k) do { if ((k) + 1 < hi) xcd_barrier(bar); } while (0)

    if (SEL(0) && IN(0)) { const CAS Args& args = fresh_args(argp); const Ctx C = fresh_ctx(C_); const int cid = C.bid; phase_prologue(args, C); PH_END(0); }
    if (SEL(1) && IN(1)) { const CAS Args& args = fresh_args(argp); const Ctx C = fresh_ctx(C_); const int cid = C.bid;
        pg8::DenseSched S; S.init(WSP(bf16_t, WS_PB), WSP(bf16_t, WS_W_PLE + OFF_PLE_WP), PLED, PLED, DEPTH * T, DM, C.G, cid); S.bpm_shift = 7; S.bbatch = W_PLE_STRIDE;
        pg8::EpiPP E{WSP(bf16_t, WS_PP)};
        pg8::gemm_phase<pg8::EpiPP, pg8::DenseSched, false>(C.lds, PLED / 64, PLED * 2, PLED * 2, S, E);
        PH_END(1);
    }
    for (int layer = 0; layer < DEPTH; ++layer) {
        const int base = 2 + PH_PER_LAYER * layer, j = layer >> 1;
        if ((layer & 1) == 0) {
            if (SEL(2) && IN(base + 0)) { const CAS Args& args = fresh_args(argp); const Ctx C = fresh_ctx(C_); const int cid = C.bid; const unsigned char* wm = args.ws + WS_W_MLA + (size_t)j * W_MLA_STRIDE;
                pg8::DenseSched S; S.init(WSP(bf16_t, WS_XB), wm + OFF_MLA_WIN, DM, DM, T, 1280, C.G, cid);
                pg8::EpiLat E{WSP(bf16_t, WS_LAT), WSP(float, WS_SSQ), WSP(bf16_t, WS_KR), WSP(float, WS_CS), WSP(float, WS_SN)};
                pg8::gemm_phase<pg8::EpiLat, pg8::DenseSched, false>(C.lds, DM / 64, DM * 2, DM * 2, S, E);
                PH_END(base + 0);
            }
            if (SEL(3) && IN(base + 1)) { const CAS Args& args = fresh_args(argp); const Ctx C = fresh_ctx(C_); const int cid = C.bid; const unsigned char* wm = args.ws + WS_W_MLA + (size_t)j * W_MLA_STRIDE;
                { pg8::DenseSched S; S.init(WSP(bf16_t, WS_LAT), wm + OFF_MLA_WUQ, DM, QL, T, 1536, C.G, cid);
                  pg8::EpiQ E{WSP(bf16_t, WS_Q), WSP(float, WS_SSQ), WSP(float, WS_CS), WSP(float, WS_SN)};
                  pg8::gemm_phase<pg8::EpiQ, pg8::DenseSched, false>(C.lds, QL / 64, DM * 2, QL * 2, S, E); }
                { pg8::DenseSched S; S.init(WSP(bf16_t, WS_LAT) + QL, wm + OFF_MLA_WUKV, DM, KVL, T, 2048, C.G, cid);
                  pg8::EpiKV E{WSP(bf16_t, WS_KN), WSP(bf16_t, WS_V), WSP(float, WS_SSQ)};
                  pg8::gemm_phase<pg8::EpiKV, pg8::DenseSched, false>(C.lds, KVL / 64, DM * 2, KVL * 2, S, E); }
                PH_END(base + 1);
            }
            if (SEL(4) && IN(base + 2)) { const CAS Args& args = fresh_args(argp); const Ctx C = fresh_ctx(C_); const int cid = C.bid;
                for (int it = C.vcu; it < NBATCH * NH * 8; it += C.G) { const int bh = it >> 3, pr = it & 7;
                    att::attn_block(bh >> 3, bh & 7, pr, WSP(bf16_t, WS_Q), WSP(bf16_t, WS_KN), WSP(bf16_t, WS_KR), WSP(bf16_t, WS_V), WSP(bf16_t, WS_O), (LAS char*)C.lds, PROBE_T ? (unsigned long long*)(args.ws + WS_CTL + 8192) : nullptr);
                    att::attn_block(bh >> 3, bh & 7, 15 - pr, WSP(bf16_t, WS_Q), WSP(bf16_t, WS_KN), WSP(bf16_t, WS_KR), WSP(bf16_t, WS_V), WSP(bf16_t, WS_O), (LAS char*)C.lds, PROBE_T ? (unsigned long long*)(args.ws + WS_CTL + 8192) : nullptr); }
                PH_END(base + 2);
            }
        } else {
            if (SEL(5) && IN(base + 0)) { const CAS Args& args = fresh_args(argp); const Ctx C = fresh_ctx(C_); const int cid = C.bid; const unsigned char* wl = args.ws + WS_W_LRU + (size_t)j * W_LRU_STRIDE;
                pg8::DenseSched S; S.init(WSP(bf16_t, WS_XB), wl + OFF_LRU_WIN, DM, DM, T, 2048, C.G, cid);
                pg8::EpiGU E{WSP(bf16_t, WS_GG), WSP(bf16_t, WS_U)};
                pg8::gemm_phase<pg8::EpiGU, pg8::DenseSched, false>(C.lds, DM / 64, DM * 2, DM * 2, S, E);
                PH_END(base + 0);
            }
            if (SEL(6) && IN(base + 1)) { const CAS Args& args = fresh_args(argp); const Ctx C = fresh_ctx(C_); const int cid = C.bid; phase_conv(args, C, j); PH_END(base + 1); }
            if (SEL(7) && IN(base + 2)) { const CAS Args& args = fresh_args(argp); const Ctx C = fresh_ctx(C_); const int cid = C.bid; const unsigned char* wl = args.ws + WS_W_LRU + (size_t)j * W_LRU_STRIDE;
                pg8::DenseSched S; S.init(WSP(bf16_t, WS_UC), wl + OFF_LRU_WAX, DM, 256, T, 2048, C.G, cid); S.apn_shift = 1; S.akbytes = 512;
                pg8::EpiAB E{WSP(bf16_t, WS_AA), WSP(bf16_t, WS_BB), WSP(bf16_t, WS_UC), INF(I_LRU_BA) + j * DM, INF(I_LRU_BX) + j * DM, WSP(float, WS_SPL) + j * DM};
                pg8::gemm_phase<pg8::EpiAB, pg8::DenseSched, false>(C.lds, 4, DM * 2, 512, S, E);
                PH_END(base + 2);
            }
            if (SEL(8) && IN(base + 3)) { const CAS Args& args = fresh_args(argp); const Ctx C = fresh_ctx(C_); const int cid = C.bid; phase_scan1(args, C); PH_END(base + 3); }
            if (SEL(9) && IN(base + 4)) { const CAS Args& args = fresh_args(argp); const Ctx C = fresh_ctx(C_); const int cid = C.bid; phase_scan2(args, C); PH_END(base + 4); }
        }
        if (SEL(10) && IN(base + 5)) { const CAS Args& args = fresh_args(argp); const Ctx C = fresh_ctx(C_); const int cid = C.bid;
            const unsigned char* wo = (layer & 1) ? args.ws + WS_W_LRU + (size_t)j * W_LRU_STRIDE + OFF_LRU_WOUT : args.ws + WS_W_MLA + (size_t)j * W_MLA_STRIDE + OFF_MLA_WO;
            pg8::DenseSched S; S.init(WSP(bf16_t, WS_O), wo, DM, DM, T, DM, C.G, cid);
            pg8::EpiRes E{WSP(bf16_t, WS_XB), WSP(bf16_t, WS_Y)};
            pg8::gemm_phase<pg8::EpiRes, pg8::DenseSched, false>(C.lds, DM / 64, DM * 2, DM * 2, S, E);
            PH_END(base + 5);
        }
        if (SEL(11) && IN(base + 6)) { const CAS Args& args = fresh_args(argp); const Ctx C = fresh_ctx(C_); const int cid = C.bid; phase_ln_router(args, C, layer); PH_END(base + 6); }
        if (SEL(12) && IN(base + 7)) { const CAS Args& args = fresh_args(argp); const Ctx C = fresh_ctx(C_); const int cid = C.bid;
            moe_table(args, C, layer);
            pg8::MoeSched S{(const char*)(args.ws + WS_X1Q), (const char*)(args.ws + WS_W_UP + (size_t)layer * NE * 2048 * 1024), (size_t)2048 * 1024, (const char*)(args.ws + WS_SW + (size_t)layer * NE * 65536), DM, DM, 8, WSP(int, WS_LIST), C.misc + 16, (volatile LAS const unsigned char*)(C.lds + TILE_E_OFF), C.G, cid, true, nullptr};
            const int sae = 127 - (int)__hip_atomic_load(WSP(unsigned, WS_CTL) + CW_SA + layer, __ATOMIC_RELAXED, __HIP_MEMORY_SCOPE_AGENT);
            pg8::EpiUp E{args.ws + WS_H, args.ws + WS_SH, INF(I_MOE_BUP) + (size_t)layer * NE * 2048};
            pg8::gemm_phase<pg8::EpiUp, pg8::MoeSched, true, 1>(C.lds, DM / 128, DM, DM, S, E, PROBE_T ? (unsigned long long*)(args.ws + WS_CTL + 8192) : nullptr, sae * 0x01010101);
            PH_END(base + 7);
        }
        if (SEL(13) && IN(base + 8)) { const CAS Args& args = fresh_args(argp); const Ctx C = fresh_ctx(C_); const int cid = C.bid;
            moe_table(args, C, layer);
            pg8::MoeSched S{(const char*)(args.ws + WS_H), (const char*)(args.ws + WS_W_DN + (size_t)layer * NE * 1024 * 1024), (size_t)1024 * 1024, (const char*)(args.ws + WS_SWD + (size_t)layer * NE * 16384), DFF, DFF, 4, WSP(int, WS_LIST), C.misc + 16, (volatile LAS const unsigned char*)(C.lds + TILE_E_OFF), C.G, cid, false, (const char*)(args.ws + WS_SH)};
            pg8::EpiDown E{WSP(bf16_t, WS_YS), INF(I_MOE_BDN) + (size_t)layer * NE * DM};
            pg8::gemm_phase<pg8::EpiDown, pg8::MoeSched, false, 2>(C.lds, DFF / 128, DFF, DFF, S, E);
            PH_END(base + 8);
        }
        if (SEL(14) && IN(base + 9)) { const CAS Args& args = fresh_args(argp); const Ctx C = fresh_ctx(C_); const int cid = C.bid; phase_combine_ln2(args, C, layer); PH_END(base + 9); }
        if (SEL(15) && IN(base + 10)) { const CAS Args& args = fresh_args(argp); const Ctx C = fresh_ctx(C_); const int cid = C.bid;
            pg8::DenseSched S; S.init(WSP(bf16_t, WS_X2B), args.ws + WS_W_PLE + (size_t)layer * W_PLE_STRIDE + OFF_PLE_WG, DM, DM, T, DM, C.G, cid);
            pg8::EpiPle E{WSP(bf16_t, WS_X2B), WSP(bf16_t, WS_PP) + (size_t)layer * T * DM, layer == DEPTH - 1 ? args.out : (float*)nullptr, WSP(bf16_t, WS_XB)};
            pg8::gemm_phase<pg8::EpiPle, pg8::DenseSched, false>(C.lds, DM / 64, DM * 2, DM * 2, S, E);
            if (layer + 1 < DEPTH) PH_END(base + 10);
        }
    }
#if PROBE_T
    if (PROBE_T == 20 && blockIdx.x == 0 && threadIdx.x < 64) { const CAS Args& args = fresh_args(argp); mfma_fp8_selftest((unsigned*)(args.ws + WS_CTL + 8192 + 256)); }
    { xcd_barrier(bar); const CAS Args& args = fresh_args(argp);
      const unsigned long long* pw = (const unsigned long long*)(args.ws + WS_CTL + 8192);
      const double pk = (double)__hip_atomic_load(pw + 0, __ATOMIC_RELAXED, __HIP_MEMORY_SCOPE_AGENT), pe = (double)__hip_atomic_load(pw + 1, __ATOMIC_RELAXED, __HIP_MEMORY_SCOPE_AGENT),
                   pn = (double)__hip_atomic_load(pw + 2, __ATOMIC_RELAXED, __HIP_MEMORY_SCOPE_AGENT), pt = (double)__hip_atomic_load(pw + 3, __ATOMIC_RELAXED, __HIP_MEMORY_SCOPE_AGENT);
      float c = 100.f;
      if (PROBE_T == 2) c = (float)(pk / (pn * 16.0) / 10.0);
      if (PROBE_T == 3) c = (float)(pe / pn / 100.0);
      if (PROBE_T == 4) c = (float)((pt - pk - pe) / pn / 100.0);
      if (PROBE_T == 5) c = (float)(pn);
      if (PROBE_T >= 10) { double q[7]; for (int i = 0; i < 7; ++i) q[i] = (double)__hip_atomic_load(pw + 8 + i, __ATOMIC_RELAXED, __HIP_MEMORY_SCOPE_AGENT);
          if (PROBE_T == 10) c = (float)(q[6] / q[5] / 10.0);
          if (PROBE_T == 11) c = (float)(q[0] / q[5] / 10.0);
          if (PROBE_T == 12) c = (float)(q[1] / q[5] / 10.0);
          if (PROBE_T == 13) c = (float)(q[2] / q[5] / 10.0);
          if (PROBE_T == 14) c = (float)(q[3] / q[5] / 10.0);
          if (PROBE_T == 15) c = (float)(q[4] / q[5] / 10.0); }
      if (PROBE_T >= 2 && PROBE_T < 20) c = exp2f(floorf(log2f(c) * 8.0f + PROBE_SHIFT) * 0.125f);
      if (PROBE_T == 20) { const unsigned fl = __hip_atomic_load((const unsigned*)(args.ws + WS_CTL + 8192 + 256), __ATOMIC_RELAXED, __HIP_MEMORY_SCOPE_AGENT); c = 100.f + 10.f * (float)fl; }
      for (size_t i = (size_t)blockIdx.x * 512 + threadIdx.x; i < (size_t)T * DM; i += (size_t)gridDim.x * 512) args.out[i] = c; }
#endif
#undef IN
#undef PH_END
}

extern "C" void kernel_launch(void* const* d_in, const int* in_sizes, int n_in, void* d_out, int out_size, void* d_ws, size_t ws_size, hipStream_t stream) {
    static int grid = 0;
    if (grid == 0) {
        if (n_in != 30 || in_sizes[0] != T * DM || out_size != T * DM || ws_size < WS_END) { fprintf(stderr, "kernel_launch: unexpected shapes (n_in %d, in0 %d, out %d, ws %zu)\n", n_in, n_in > 0 ? in_sizes[0] : -1, out_size, ws_size); grid = -1; return; }
        int dev = 0, cus = 0, per_cu = 0;
        if (hipGetDevice(&dev) != hipSuccess || hipDeviceGetAttribute(&cus, hipDeviceAttributeMultiprocessorCount, dev) != hipSuccess) { grid = -1; return; }
        if (hipFuncSetAttribute((const void*)fwd_kernel, hipFuncAttributeMaxDynamicSharedMemorySize, LDS_BYTES) != hipSuccess) { fprintf(stderr, "kernel_launch: hipFuncSetAttribute failed\n"); grid = -1; return; }
        if (hipOccupancyMaxActiveBlocksPerMultiprocessor(&per_cu, (const void*)fwd_kernel, NWAVES * 64, LDS_BYTES) != hipSuccess || per_cu < 1) fprintf(stderr, "kernel_launch: occupancy query reports %d\n", per_cu);
        (void)hipGetLastError();
        grid = cus;
    }
    if (grid < 0) return;
    if (hipMemsetAsync((char*)d_ws + WS_CTL, 0, CTL_ZERO_BYTES, stream) != hipSuccess) return;
    Args a{};
    for (int i = 0; i < 30; ++i) a.in[i] = d_in[i];
    a.out = (float*)d_out; a.ws = (unsigned char*)d_ws; a.pad = 0;
#if MK_ONE_LAUNCH
    a.ph_lo = 0; a.ph_hi = PH_TOTAL; a.li = 0;
    hipLaunchKernelGGL(fwd_kernel, dim3(grid), dim3(NWAVES * 64), LDS_BYTES, stream, a);
#else
    int li = 0;
    for (int ph = 0; ph < PH_TOTAL; ++ph) {
        if (ph >= 2) { const int l = (ph - 2) / PH_PER_LAYER, k = (ph - 2) % PH_PER_LAYER; if (k == 11) continue; if ((l & 1) == 0 && (k == 3 || k == 4)) continue; }
        int site = ph;
        if (ph >= 2) { const int l = (ph - 2) / PH_PER_LAYER, k = (ph - 2) % PH_PER_LAYER; static const int mla[11] = {2, 3, 4, -1, -1, 10, 11, 12, 13, 14, 15}, lru[11] = {5, 6, 7, 8, 9, 10, 11, 12, 13, 14, 15}; site = (l & 1) ? lru[k] : mla[k]; }
        a.ph_lo = ph; a.ph_hi = ph + 1;
        if ((HOSTDUP >> site) & 1) { a.li = li++; a.pad = 4; hipLaunchKernelGGL(fwd_kernel, dim3(grid), dim3(NWAVES * 64), LDS_BYTES, stream, a); }
        a.li = li++; a.pad = 0;
        hipLaunchKernelGGL(fwd_kernel, dim3(grid), dim3(NWAVES * 64), LDS_BYTES, stream, a);
    }
#endif
}
```

```cpp
#include <hip/hip_runtime.h>
#include <hip/hip_bf16.h>
#include <cstdio>
#include <cstdint>

#ifndef PHSEL
#define PHSEL -1
#endif
#ifndef PHSKIP
#define PHSKIP -1
#endif
#define SEL(id) ((PHSEL < 0 || PHSEL == (id)) && PHSKIP != (id))
#ifndef PROBE_T
#define PROBE_T 0
#endif
#ifndef PROBE_SHIFT
#define PROBE_SHIFT 0.0f
#endif
#ifndef HOSTDUP
#define HOSTDUP 0
#endif
#ifndef MK_ONE_LAUNCH
#define MK_ONE_LAUNCH 1
#endif

constexpr int T = 32768, SEQ = 4096, NBATCH = 8, DM = 1024, DEPTH = 4;
constexpr int QL = 768, KVL = 256, ROPE = 64, LATD = 1088, NH = 8, DQK = 192, DV = 128;
constexpr int NE = 32, TOPK = 4, DFF = 1024, PLED = 256;
constexpr float ALPHA = 1.681792830507429f;
constexpr float LN_EPS = 1e-5f, RMS_EPS = 1e-6f;
constexpr float QSCALE = 1.4426950408889634f / 13.856406460551018f;
constexpr int NWAVES = 8;

constexpr size_t MiB = 1u << 20;
constexpr size_t WS_CTL = 0, CTL_ZERO_BYTES = 2 * MiB;
constexpr size_t WS_CS = 2 * MiB, WS_SN = 6 * MiB, WS_SPL = 10 * MiB;
constexpr size_t WS_WRH = WS_SPL + 65536, WS_WRL = WS_WRH + 262144;
constexpr size_t WS_W_MLA = 12 * MiB, W_MLA_STRIDE = 8 * MiB;
constexpr size_t OFF_MLA_WIN = 0, OFF_MLA_WUQ = 2560 * 1024, OFF_MLA_WUKV = OFF_MLA_WUQ + 2304 * 1024, OFF_MLA_WO = OFF_MLA_WUKV + 1024 * 1024;
constexpr size_t WS_W_LRU = 28 * MiB, W_LRU_STRIDE = 8 * MiB;
constexpr size_t OFF_LRU_WIN = 0, OFF_LRU_WAX = 4 * MiB, OFF_LRU_WOUT = 5 * MiB;
constexpr size_t WS_W_PLE = 44 * MiB, W_PLE_STRIDE = 3 * MiB;
constexpr size_t OFF_PLE_WG = 0, OFF_PLE_WP = 2 * MiB;
constexpr size_t WS_W_UP = 56 * MiB;
constexpr size_t WS_W_DN = 568 * MiB;
constexpr size_t WS_XB = 824 * MiB, WS_PB = 888 * MiB, WS_PP = 952 * MiB;
constexpr size_t WS_Y = 1208 * MiB, WS_X1 = 1336 * MiB, WS_X1B = 1464 * MiB, WS_X2 = 1528 * MiB, WS_X2B = 1656 * MiB;
constexpr size_t WS_LAT = 1720 * MiB, WS_KR = 1784 * MiB, WS_SSQ = 1788 * MiB, WS_Q = 1790 * MiB, WS_KN = 1886 * MiB, WS_V = 1950 * MiB, WS_O = 2014 * MiB;
constexpr size_t WS_GG = 2078 * MiB, WS_U = 2142 * MiB, WS_UC = 2206 * MiB, WS_AA = 2270 * MiB, WS_BB = 2398 * MiB, WS_CA = 2526 * MiB, WS_CH = 2528 * MiB;
constexpr size_t WS_H = 2530 * MiB, WS_YS = 2802 * MiB, WS_LIST = 3074 * MiB, WS_SLOT = 3078 * MiB, WS_GATE = 3079 * MiB, WS_SW = 3080 * MiB  , WS_X1Q = 3088 * MiB  , WS_SH = 3120 * MiB  ,
                 WS_SWD = 3128 * MiB  , WS_SY = 3132 * MiB  , WS_END = 3140 * MiB;
constexpr int PADROWS = T * TOPK + NE * 256;
static_assert((size_t)PADROWS * DFF * 2 <= 272 * MiB, "H / YS size");
constexpr int CW_SA = 128;
constexpr int CW_CNT = 256;
constexpr int CW_BAR = 4096;

constexpr int RING_BYTES = 133120;
constexpr int TILE_E_OFF = 131072;
constexpr int SCL_OFF = RING_BYTES;
constexpr int MISC_OFF = SCL_OFF + 24576;
constexpr int LDS_BYTES = 163840;

#define GAS __attribute__((address_space(1)))
#define LAS __attribute__((address_space(3)))
#define CAS __attribute__((address_space(4)))
typedef unsigned short bf16_t;
typedef short bf16x8 __attribute__((ext_vector_type(8)));
typedef short s16x4 __attribute__((ext_vector_type(4)));
typedef float f32x2 __attribute__((ext_vector_type(2)));
typedef float f32x4 __attribute__((ext_vector_type(4)));
typedef float f32x16 __attribute__((ext_vector_type(16)));
typedef unsigned u32x2 __attribute__((ext_vector_type(2)));
typedef unsigned u32x4 __attribute__((ext_vector_type(4)));

__device__ __forceinline__ unsigned cvt_pk_bf16(float lo, float hi) { unsigned r; asm volatile("v_cvt_pk_bf16_f32 %0, %1, %2" : "=v"(r) : "v"(lo), "v"(hi)); return r; }
__device__ __forceinline__ float bf_lo(unsigned w) { return __uint_as_float(w << 16); }
__device__ __forceinline__ float bf_hi(unsigned w) { return __uint_as_float(w & 0xffff0000u); }
__device__ __forceinline__ float sigmoidf_(float x) { return __builtin_amdgcn_rcpf(1.0f + __expf(-x)); }
__device__ __forceinline__ float gelu_tanh(float x) { const float u = 0.7978845608028654f * (x + 0.044715f * x * x * x); const float t = 1.0f - 2.0f * __builtin_amdgcn_rcpf(1.0f + __expf(2.0f * u)); return 0.5f * x * (1.0f + t); }
__device__ __forceinline__ u32x4 pack8(const f32x4 a, const f32x4 b) { u32x4 w; w.x = cvt_pk_bf16(a[0], a[1]); w.y = cvt_pk_bf16(a[2], a[3]); w.z = cvt_pk_bf16(b[0], b[1]); w.w = cvt_pk_bf16(b[2], b[3]); return w; }
__device__ __forceinline__ float KF(float v) { asm volatile("" : "+s"(v)); return v; }
__device__ __forceinline__ int opaque_tid() { int t = threadIdx.x; asm volatile("" : "+v"(t)); return t; }
__device__ __forceinline__ float wave_sum(float v) {
#pragma unroll
    for (int o = 1; o < 64; o <<= 1) v += __shfl_xor(v, o);
    return v;
}

namespace pg8 {
#define PG8_LAS __attribute__((address_space(3)))
constexpr int BM = 256, BK = 64, HALF = 128, HTB = HALF * BK * 2, STAGE_BYTES = 8 * HTB;
__host__ __device__ __forceinline__ int lds_byte(int r, int c) { const int st = (r >> 4) * 2 + (c >> 5), rr = r & 15, cc = c & 31, ob = rr * 64 + cc * 2; return st * 1024 + (ob ^ (((ob >> 9) & 1) << 5)); }
__host__ __device__ __forceinline__ void stage_rc(int b, int& R, int& C) { const int st = b / 1024, sb = b % 1024, swz = sb ^ (((sb >> 9) & 1) << 5); R = (st >> 1) * 16 + swz / 64; C = (st & 1) * 32 + (swz % 64) / 2; }
__host__ __device__ __forceinline__ int perm32(int rho) { const int n = rho >> 4, i = rho & 15; return 8 * (i >> 2) + 4 * n + (i & 3); }

struct Unit { const char* A; const char* B; const char* S; const char* SA; const int* lst; int nvalid; int pm, pn, aux; };

typedef int v4i_t __attribute__((ext_vector_type(4)));
typedef int v8i_t __attribute__((ext_vector_type(8)));
template <class Epi, class Sched, bool GATHER, int FPM = 0>
__device__ __forceinline__ void gemm_phase(PG8_LAS unsigned char* lds, const int nt  , const int lda  , const int ldb  , const Sched& S, const Epi& E, unsigned long long* pw = nullptr, const int sa = 0x7f7f7f7f) {
    constexpr bool FP8 = FPM != 0;
    const int tid = opaque_tid(), wid = __builtin_amdgcn_readfirstlane(tid >> 6), lane = tid & 63, wr = wid >> 2, wc = wid & 3, fr = lane & 15, fq = lane >> 4;
    unsigned voffB[2], ocA[2][2], onA[2][2];
#pragma unroll
    for (int i = 0; i < 2; ++i) { int R, C; stage_rc(tid * 16 + i * 8192, R, C); const int Rb = Epi::PERM ? ((R & ~31) + perm32(R & 31)) : R;
        voffB[i] = (unsigned)(Rb * ldb + C * 2);
        ocA[0][i] = (unsigned)(R * lda + C * 2); ocA[1][i] = (unsigned)((R + HALF) * lda + C * 2); onA[0][i] = ocA[0][i]; onA[1][i] = ocA[1][i]; }
    constexpr unsigned kstep = BK * 2;
    const unsigned hstepB = (unsigned)HALF * ldb;
    const unsigned ldsw = (unsigned)wid * 1024u;
    const int aoff = lds_byte(wr * 64 + fr, fq * 8), boff = lds_byte(wc * 32 + fr, fq * 8);
#define PG8_SA(b, h) (((b) * 2 + (h)) * HTB)
#define PG8_SB(b, h) ((4 + (b) * 2 + (h)) * HTB)
#define PG8_STAGE(bufoff, gbase, voff, kb) do { _Pragma("unroll") for (int _i = 0; _i < 2; ++_i) \
        __builtin_amdgcn_global_load_lds((const unsigned*)((const char*)(gbase) + (size_t)(unsigned)((voff)[_i] + (unsigned)(kb))), (PG8_LAS unsigned*)(lds + (bufoff) + ldsw + _i * 8192), 16, 0, 0); } while (0)
#define PG8_CAT(x0, x1) __builtin_shufflevector(x0, x1, 0, 1, 2, 3, 4, 5, 6, 7)
#define PG8_LO(x) __builtin_bit_cast(bf16x8, __builtin_shufflevector(x, x, 0, 1, 2, 3))
#define PG8_HI(x) __builtin_bit_cast(bf16x8, __builtin_shufflevector(x, x, 4, 5, 6, 7))
    const PG8_LAS unsigned char* const ldsA = lds + aoff; const PG8_LAS unsigned char* const ldsB = lds + 4 * HTB + boff;
#define PG8_LDA(dst, b, h) do { _Pragma("unroll") for (int m = 0; m < 4; ++m) dst[m] = PG8_CAT(*(const PG8_LAS v4i_t*)(ldsA + (PG8_SA(b, h) + m * 2048)), *(const PG8_LAS v4i_t*)(ldsA + (PG8_SA(b, h) + m * 2048 + 1024))); } while (0)
#define PG8_LDB(dst, b, h) do { _Pragma("unroll") for (int n = 0; n < 2; ++n) dst[n] = PG8_CAT(*(const PG8_LAS v4i_t*)(ldsB + (PG8_SB(b, h) - 4 * HTB + n * 2048)), *(const PG8_LAS v4i_t*)(ldsB + (PG8_SB(b, h) - 4 * HTB + n * 2048 + 1024))); } while (0)
#define PG8_MMA(ai, bj, At, Bt) do { __builtin_amdgcn_s_setprio(1); \
        if constexpr (FP8) { asm volatile("s_nop 4" ::: "memory"); _Pragma("unroll") for (int m = 0; m < 4; ++m) _Pragma("unroll") for (int n = 0; n < 2; ++n) \
            asm volatile("v_mfma_scale_f32_16x16x128_f8f6f4 %0, %1, %2, %0, %3, %4 op_sel_hi:[0,0,0]" : "+v"(acc[ai][bj][m][n]) : "v"(Bt[n]), "v"(At[m]), "v"(sB[bj][n]), "v"(FPM == 2 ? sA[m] : sav)); } \
        else { _Pragma("unroll") for (int m = 0; m < 4; ++m) _Pragma("unroll") for (int n = 0; n < 2; ++n) { \
            acc[ai][bj][m][n] = __builtin_amdgcn_mfma_f32_16x16x32_bf16(PG8_LO(Bt[n]), PG8_LO(At[m]), acc[ai][bj][m][n], 0, 0, 0); \
            acc[ai][bj][m][n] = __builtin_amdgcn_mfma_f32_16x16x32_bf16(PG8_HI(Bt[n]), PG8_HI(At[m]), acc[ai][bj][m][n], 0, 0, 0); } } \
        __builtin_amdgcn_s_setprio(0); } while (0)
    int sB[2][2] = {{0x7f, 0x7f}, {0x7f, 0x7f}}; int sav; asm volatile("v_mov_b32 %0, %1" : "=v"(sav) : "s"(sa));
    int sA[4] = {0x7f, 0x7f, 0x7f, 0x7f};
    const int scol = wc * 32 + (Epi::PERM ? 8 * (fr >> 2) + (fr & 3) : fr);
    const int sbase = FPM == 2 ? SCL_OFF + 16384 + scol * 2 + (fq >> 1) : SCL_OFF + scol * 4 + fq;
    const int sabase = SCL_OFF + ((wr * 64 + fr) << 2) + fq;
#define PG8_LDS_SCL(par_, kt_) do { if constexpr (FP8) { \
        const PG8_LAS unsigned char* sp_ = (const PG8_LAS unsigned char*)lds + sbase + (FPM == 2 ? (par_) * 4096 + (kt_) * 512 : (par_) * 8192 + (kt_) * 1024); \
        _Pragma("unroll") for (int bj_ = 0; bj_ < 2; ++bj_) _Pragma("unroll") for (int n_ = 0; n_ < 2; ++n_) sB[bj_][n_] = (int)sp_[(bj_ * 128 + n_ * (Epi::PERM ? 4 : 16)) * (FPM == 2 ? 2 : 4)]; } } while (0)
#define PG8_LDS_SCA(par_, kt_, ai_) do { if constexpr (FPM == 2) { const PG8_LAS unsigned char* sp_ = (const PG8_LAS unsigned char*)lds + sabase + (par_) * 8192 + (kt_) * 1024 + (ai_) * 512; \
        _Pragma("unroll") for (int m_ = 0; m_ < 4; ++m_) sA[m_] = (int)sp_[m_ * 64]; } } while (0)
#define PG8_DMA_SCL(u_, par_) do { if constexpr (FPM == 1) __builtin_amdgcn_global_load_lds((const unsigned*)((u_).S + wid * 1024 + lane * 16), (PG8_LAS unsigned*)(lds + SCL_OFF + (par_) * 8192 + wid * 1024), 16, 0, 0); \
        if constexpr (FPM == 2) { __builtin_amdgcn_global_load_lds((const unsigned*)((u_).SA + wid * 1024 + lane * 16), (PG8_LAS unsigned*)(lds + SCL_OFF + (par_) * 8192 + wid * 1024), 16, 0, 0); \
            if (wid < 4) __builtin_amdgcn_global_load_lds((const unsigned*)((u_).S + wid * 1024 + lane * 16), (PG8_LAS unsigned*)(lds + SCL_OFF + 16384 + (par_) * 4096 + wid * 1024), 16, 0, 0); } } while (0)
#define PG8_WAIT_V(n) asm volatile("s_waitcnt vmcnt(" #n ")" ::: "memory")
#define PG8_WAIT_L(n) asm volatile("s_waitcnt lgkmcnt(" #n ")" ::: "memory")
#define PG8_BAR __builtin_amdgcn_s_barrier()
#define PG8_SCHED __builtin_amdgcn_sched_barrier(0)
#define PG8_GOFFS(u, o) do { _Pragma("unroll") for (int _h = 0; _h < 2; ++_h) _Pragma("unroll") for (int _i = 0; _i < 2; ++_i) { int gR_, gC_; stage_rc(tid * 16 + _i * 8192, gR_, gC_); int _r = _h * HALF + gR_; _r = _r < (u).nvalid ? _r : (u).nvalid - 1; \
        const int _tok = (u).lst[_r]; (o)[_h][_i] = (unsigned)_tok * (unsigned)lda + (unsigned)(gC_ * 2); } } while (0)
#define PG8_GRAW(u, tk) do {   _Pragma("unroll") for (int _h = 0; _h < 2; ++_h) _Pragma("unroll") for (int _i = 0; _i < 2; ++_i) { int gR_, gC_; stage_rc(tid * 16 + _i * 8192, gR_, gC_); int _r = _h * HALF + gR_; _r = _r < (u).nvalid ? _r : (u).nvalid - 1; (tk)[_h][_i] = (unsigned)(u).lst[_r]; } } while (0)
    Unit cur, nxt, nn; int ui = 0;
#if PROBE_T
    unsigned long long pk_ = 0, pe_ = 0, pt0_ = 0, pn_ = 0; const unsigned long long pst_ = __builtin_amdgcn_s_memtime();
#endif
    if (!S.next(0, cur)) return;
    f32x4 acc[2][2][4][2];
#pragma unroll
    for (int a = 0; a < 2; ++a)
#pragma unroll
        for (int b = 0; b < 2; ++b)
#pragma unroll
            for (int m = 0; m < 4; ++m)
#pragma unroll
                for (int n = 0; n < 2; ++n) acc[a][b][m][n] = (f32x4){0.f, 0.f, 0.f, 0.f};
    v8i_t At[4], B0[2], B1[2];
    const char* cA = cur.A; const char* cB = cur.B;
    bool has_next = S.next(1, nxt);
    if constexpr (GATHER) { PG8_GOFFS(cur, ocA);
        if (has_next) { PG8_GOFFS(nxt, onA); }
        else {
#pragma unroll
            for (int h = 0; h < 2; ++h)
#pragma unroll
                for (int i = 0; i < 2; ++i) onA[h][i] = ocA[h][i]; } }
    PG8_DMA_SCL(cur, 0); if (has_next) PG8_DMA_SCL(nxt, 1);
    PG8_STAGE(PG8_SB(0, 0), cB, voffB, 0u); PG8_STAGE(PG8_SB(0, 1), cB, voffB, hstepB); PG8_STAGE(PG8_SA(0, 0), cA, ocA[0], 0u); PG8_STAGE(PG8_SA(0, 1), cA, ocA[1], 0u);
    if (wr == 1) PG8_BAR;
    PG8_WAIT_V(2); PG8_BAR;
    PG8_STAGE(PG8_SB(1, 0), cB, voffB, kstep); PG8_STAGE(PG8_SA(1, 0), cA, ocA[0], kstep); PG8_STAGE(PG8_SB(1, 1), cB, voffB, hstepB + kstep);
    PG8_WAIT_V(6); PG8_BAR;
    for (;;) {
        const char* nA = has_next ? nxt.A : cA; const char* nB = has_next ? nxt.B : cB;
#if PROBE_T
        pt0_ = __builtin_amdgcn_s_memtime();
#endif
#pragma unroll 1
        for (int t = 0; t < nt; t += 2) {
            const bool last = (t == nt - 2);
            const unsigned k1 = (unsigned)(t + 1) * kstep, k2 = last ? 0u : (unsigned)(t + 2) * kstep, k3 = k2 + kstep;
            const char* a2 = last ? nA : cA; const char* b2 = last ? nB : cB;
#define PG8_STAGE_A2(bufoff, h_, kb_) do { if (GATHER && last) PG8_STAGE(bufoff, a2, onA[h_], kb_); else PG8_STAGE(bufoff, a2, ocA[h_], kb_); } while (0)
            PG8_LDB(B0, 0, 0); PG8_LDB(B1, 0, 1); PG8_LDS_SCL(ui & 1, t); PG8_SCHED; PG8_LDA(At, 0, 0); PG8_LDS_SCA(ui & 1, t, 0); PG8_STAGE(PG8_SA(1, 1), cA, ocA[1], k1);
            PG8_WAIT_V(8); PG8_WAIT_L(0); PG8_BAR; PG8_MMA(0, 0, At, B0); PG8_MMA(0, 1, At, B1); PG8_BAR; PG8_SCHED;
            PG8_LDA(At, 0, 1); PG8_LDS_SCA(ui & 1, t, 1); PG8_STAGE(PG8_SB(0, 0), b2, voffB, k2); PG8_STAGE(PG8_SB(0, 1), b2, voffB, hstepB + k2); PG8_STAGE_A2(PG8_SA(0, 0), 0, k2);
            PG8_WAIT_V(8); PG8_WAIT_L(0); PG8_BAR; PG8_MMA(1, 0, At, B0); PG8_MMA(1, 1, At, B1); PG8_BAR; PG8_SCHED;
            PG8_LDB(B0, 1, 0); PG8_LDB(B1, 1, 1); PG8_LDS_SCL(ui & 1, t + 1); PG8_SCHED; PG8_LDA(At, 1, 0); PG8_LDS_SCA(ui & 1, t + 1, 0); PG8_STAGE_A2(PG8_SA(0, 1), 1, k2);
            PG8_WAIT_V(8); PG8_WAIT_L(0); PG8_BAR; PG8_MMA(0, 0, At, B0); PG8_MMA(0, 1, At, B1); PG8_BAR; PG8_SCHED;
            PG8_LDA(At, 1, 1); PG8_LDS_SCA(ui & 1, t + 1, 1); PG8_STAGE(PG8_SB(1, 0), b2, voffB, k3); PG8_STAGE(PG8_SB(1, 1), b2, voffB, hstepB + k3); PG8_STAGE_A2(PG8_SA(1, 0), 0, k3);
            PG8_WAIT_V(8); PG8_WAIT_L(0); PG8_BAR; PG8_MMA(1, 0, At, B0); PG8_MMA(1, 1, At, B1); PG8_BAR; PG8_SCHED;
        }
#if PROBE_T
        const unsigned long long pt1_ = __builtin_amdgcn_s_memtime(); pk_ += pt1_ - pt0_;
#endif
        if constexpr (FP8) asm volatile("s_nop 15\n\ts_nop 7" ::: "memory");
        const bool has_nn = has_next && S.next(ui + 2, nn);
        if constexpr (GATHER) {
#pragma unroll
            for (int h = 0; h < 2; ++h)
#pragma unroll
                for (int i = 0; i < 2; ++i) ocA[h][i] = onA[h][i];
            if (has_nn) { PG8_GRAW(nn, onA); } }
        if (wr == 0) PG8_BAR;
        E(acc, cur, wr, wc, fr, fq);
#if PROBE_T
        asm volatile("s_waitcnt vmcnt(0)" ::: "memory"); pe_ += __builtin_amdgcn_s_memtime() - pt1_; ++pn_;
#endif
        if (!has_next) break;
#pragma unroll
        for (int a = 0; a < 2; ++a)
#pragma unroll
            for (int b = 0; b < 2; ++b)
#pragma unroll
                for (int m = 0; m < 4; ++m)
#pragma unroll
                    for (int n = 0; n < 2; ++n) acc[a][b][m][n] = (f32x4){0.f, 0.f, 0.f, 0.f};
        cur = nxt; cA = nA; cB = nB; ++ui;
        if constexpr (GATHER) { if (has_nn) {
#pragma unroll
            for (int h = 0; h < 2; ++h)
#pragma unroll
                for (int i = 0; i < 2; ++i) { int gR_, gC_; stage_rc(tid * 16 + i * 8192, gR_, gC_); onA[h][i] = onA[h][i] * (unsigned)lda + (unsigned)(gC_ * 2); } } }
        if (has_nn) { nxt = nn; PG8_DMA_SCL(nxt, (ui + 1) & 1); }
        has_next = has_nn;
        if (wr == 1) PG8_BAR;
    }
    PG8_WAIT_V(0);
    PG8_BAR;
#if PROBE_T
    if (pw && blockIdx.x == 0 && tid == 0) { pw[0] += pk_; pw[1] += pe_; pw[2] += pn_; pw[3] += __builtin_amdgcn_s_memtime() - pst_; }
#endif
#undef PG8_SA
#undef PG8_SB
#undef PG8_STAGE
#undef PG8_LDA
#undef PG8_LDB
#undef PG8_MMA
#undef PG8_WAIT_V
#undef PG8_WAIT_L
#undef PG8_BAR
#undef PG8_SCHED
#undef PG8_GOFFS
#undef PG8_GRAW
#undef PG8_STAGE_A2
#undef PG8_CAT
#undef PG8_LO
#undef PG8_HI
#undef PG8_LDS_SCL
#undef PG8_LDS_SCA
#undef PG8_DMA_SCL
}

constexpr int NXCD = 8, WGM = 8;
struct DenseSched {
    const char* A; const char* B; int lda, ldb; int nM, nN, nwg, G, c; int apn_shift, akbytes, bpm_shift; size_t bbatch;
    __device__ __forceinline__ void init(const void* A_, const void* B_, int lda_, int ldb_, int M, int N, int G_, int c_) {
        A = (const char*)A_; B = (const char*)B_; lda = lda_; ldb = ldb_; nM = M / BM; nN = N / BM; nwg = nM * nN; G = G_; c = c_; apn_shift = -1; akbytes = 0; bpm_shift = -1; bbatch = 0; }
    __device__ __forceinline__ bool next(int i, Unit& u) const {
        const long L = (long)i * G + c; if (L >= nwg) return false;
        int wgid = (int)L; { const int q = nwg / NXCD, r = nwg % NXCD, xcd = wgid % NXCD, off = wgid / NXCD; wgid = (xcd < r ? xcd * (q + 1) : r * (q + 1) + (xcd - r) * q) + off; }
        const int nig = WGM * nN, gid = wgid / nig, fm = gid * WGM, gsz = (nM - fm) < WGM ? (nM - fm) : WGM;
        const int pm = fm + ((wgid % nig) % gsz), pn = (wgid % nig) / gsz;
        u.pm = pm; u.pn = pn; u.aux = 0; u.lst = nullptr; u.nvalid = 256; u.S = nullptr; u.SA = nullptr;
        u.A = A + (size_t)pm * 256 * lda * 2 + (apn_shift >= 0 ? (size_t)(pn >> apn_shift) * akbytes : (size_t)0);
        u.B = B + (size_t)pn * 256 * ldb * 2 + (bpm_shift >= 0 ? (size_t)(pm >> bpm_shift) * bbatch : (size_t)0);
        return true;
    }
};
struct MoeSched {
    const char* A; const char* B; size_t bexp; const char* SW; int lda, ldb  , nN; const int* lists; volatile LAS const int* tab; volatile LAS const unsigned char* te; int G, c; bool gather; const char* SA;
    __device__ __forceinline__ bool next(int i, Unit& u) const {
        int pn, mg;
        if (G == 256) {
            const int x = c & 7, jj = c >> 3, pgs = nN >> 2, mgs = 8 / pgs;
            mg = i * (8 * mgs) + 8 * (x / pgs) + (jj & 7); pn = 4 * (x % pgs) + (jj >> 3);
            if (mg >= __builtin_amdgcn_readfirstlane(tab[32])) return false;
        } else { const int total = __builtin_amdgcn_readfirstlane(tab[32]) * nN; const long L = (long)i * G + c; if (L >= total) return false; pn = (int)(L % nN); mg = (int)(L / nN); }
        const int e = __builtin_amdgcn_readfirstlane((int)te[mg]), mt = mg - __builtin_amdgcn_readfirstlane(tab[e]);
        u.pm = mg; u.pn = pn; u.aux = e;
        if (gather) { u.A = A; u.lst = lists + (size_t)e * T + mt * 256; const int rem = __builtin_amdgcn_readfirstlane(tab[48 + e]) - mt * 256; u.nvalid = rem < 256 ? rem : 256; }
        else { u.A = A + (size_t)mg * 256 * lda; u.lst = nullptr; u.nvalid = 256; }
        u.B = B + (size_t)e * bexp + (size_t)pn * 256 * ldb; u.S = SW ? (SA ? SW + ((size_t)e * 4 + pn) * 4096 : SW + ((size_t)e * 8 + pn) * 8192) : nullptr; u.SA = SA ? SA + (size_t)mg * 8192 : nullptr;
        return true;
    }
};

#define EPI_ROW(u, ai, m) ((u).pm * 256 + (ai) * 128 + wr * 64 + (m) * 16 + fr)
struct EpiLat {
    static constexpr bool PERM = true;
    bf16_t* LAT; float* SSQ; bf16_t* KR; const float* CS; const float* SN;
    __device__ __forceinline__ void operator()(const f32x4 (&acc)[2][2][4][2], const Unit& u, int wr, int wc, int fr, int fq) const {
        if (u.pn < 4) {
#pragma unroll
            for (int ai = 0; ai < 2; ++ai)
#pragma unroll
                for (int m = 0; m < 4; ++m) { const int row = EPI_ROW(u, ai, m); float ss = 0.f;
#pragma unroll
                    for (int bj = 0; bj < 2; ++bj) { const f32x4 v0 = acc[ai][bj][m][0], v1 = acc[ai][bj][m][1];
                        ss += (v0[0] * v0[0] + v0[1] * v0[1]) + (v0[2] * v0[2] + v0[3] * v0[3]) + (v1[0] * v1[0] + v1[1] * v1[1]) + (v1[2] * v1[2] + v1[3] * v1[3]);
                        *(u32x4*)(LAT + (size_t)row * 1024 + u.pn * 256 + bj * 128 + wc * 32 + 8 * fq) = pack8(v0, v1); }
                    ss += __shfl_xor(ss, 16); ss += __shfl_xor(ss, 32);
                    if (fq == 0) SSQ[(size_t)row * 16 + u.pn * 4 + wc] = ss; }
        } else if (wc == 0) {
#pragma unroll
            for (int ai = 0; ai < 2; ++ai)
#pragma unroll
                for (int m = 0; m < 4; ++m) { const int row = EPI_ROW(u, ai, m);
                    const f32x4 c0 = *(const f32x4*)(CS + (size_t)row * 32 + 8 * fq), c1 = *(const f32x4*)(CS + (size_t)row * 32 + 8 * fq + 4);
                    const f32x4 s0 = *(const f32x4*)(SN + (size_t)row * 32 + 8 * fq), s1 = *(const f32x4*)(SN + (size_t)row * 32 + 8 * fq + 4);
                    const f32x4 a0 = acc[ai][0][m][0], a1 = acc[ai][0][m][1], b0 = acc[ai][1][m][0], b1 = acc[ai][1][m][1];
                    *(u32x4*)(KR + (size_t)row * 64 + 8 * fq) = pack8(a0 * c0 - b0 * s0, a1 * c1 - b1 * s1);
                    *(u32x4*)(KR + (size_t)row * 64 + 32 + 8 * fq) = pack8(b0 * c0 + a0 * s0, b1 * c1 + a1 * s1); }
        }
    }
};
struct EpiQ {
    static constexpr bool PERM = true;
    bf16_t* Q; const float* SSQ; const float* CS; const float* SN;
    __device__ __forceinline__ void operator()(const f32x4 (&acc)[2][2][4][2], const Unit& u, int wr, int wc, int fr, int fq) const {
#pragma unroll
        for (int ai = 0; ai < 2; ++ai)
#pragma unroll
            for (int m = 0; m < 4; ++m) { const int row = EPI_ROW(u, ai, m);
                const f32x4 q0 = *(const f32x4*)(SSQ + (size_t)row * 16), q1 = *(const f32x4*)(SSQ + (size_t)row * 16 + 4), q2 = *(const f32x4*)(SSQ + (size_t)row * 16 + 8);
                const float ss = ((q0[0] + q0[1]) + (q0[2] + q0[3])) + ((q1[0] + q1[1]) + (q1[2] + q1[3])) + ((q2[0] + q2[1]) + (q2[2] + q2[3]));
                const float r = QSCALE / sqrtf(ss * (1.0f / QL) + KF(RMS_EPS));
                if (u.pn < 4) {
#pragma unroll
                    for (int bj = 0; bj < 2; ++bj)
                        *(u32x4*)(Q + (size_t)row * 1536 + (2 * u.pn + bj) * 192 + wc * 32 + 8 * fq) = pack8(acc[ai][bj][m][0] * r, acc[ai][bj][m][1] * r);
                } else {
                    const int head = 4 * (u.pn - 4) + wc;
                    const f32x4 c0 = *(const f32x4*)(CS + (size_t)row * 32 + 8 * fq), c1 = *(const f32x4*)(CS + (size_t)row * 32 + 8 * fq + 4);
                    const f32x4 s0 = *(const f32x4*)(SN + (size_t)row * 32 + 8 * fq), s1 = *(const f32x4*)(SN + (size_t)row * 32 + 8 * fq + 4);
                    const f32x4 a0 = acc[ai][0][m][0] * r, a1 = acc[ai][0][m][1] * r, b0 = acc[ai][1][m][0] * r, b1 = acc[ai][1][m][1] * r;
                    *(u32x4*)(Q + (size_t)row * 1536 + head * 192 + 128 + 8 * fq) = pack8(a0 * c0 - b0 * s0, a1 * c1 - b1 * s1);
                    *(u32x4*)(Q + (size_t)row * 1536 + head * 192 + 160 + 8 * fq) = pack8(b0 * c0 + a0 * s0, b1 * c1 + a1 * s1);
                }
                asm volatile("" ::: "memory"); }
    }
};
struct EpiKV {
    static constexpr bool PERM = true;
    bf16_t* KN; bf16_t* V; const float* SSQ;
    __device__ __forceinline__ void operator()(const f32x4 (&acc)[2][2][4][2], const Unit& u, int wr, int wc, int fr, int fq) const {
#pragma unroll
        for (int ai = 0; ai < 2; ++ai)
#pragma unroll
            for (int m = 0; m < 4; ++m) { const int row = EPI_ROW(u, ai, m);
                const f32x4 q3 = *(const f32x4*)(SSQ + (size_t)row * 16 + 12);
                const float r = 1.0f / sqrtf(((q3[0] + q3[1]) + (q3[2] + q3[3])) * (1.0f / KVL) + KF(RMS_EPS));
                *(u32x4*)(KN + (size_t)row * 1024 + u.pn * 128 + wc * 32 + 8 * fq) = pack8(acc[ai][0][m][0] * r, acc[ai][0][m][1] * r);
                *(u32x4*)(V + (size_t)row * 1024 + u.pn * 128 + wc * 32 + 8 * fq) = pack8(acc[ai][1][m][0] * r, acc[ai][1][m][1] * r); }
    }
};
__device__ __forceinline__ f32x4 bf4_lo(const u32x4 w) { return (f32x4){bf_lo(w.x), bf_hi(w.x), bf_lo(w.y), bf_hi(w.y)}; }
__device__ __forceinline__ f32x4 bf4_hi(const u32x4 w) { return (f32x4){bf_lo(w.z), bf_hi(w.z), bf_lo(w.w), bf_hi(w.w)}; }
struct EpiRes {
    static constexpr bool PERM = true;
    const bf16_t* X; bf16_t* Y;
    __device__ __forceinline__ void operator()(const f32x4 (&acc)[2][2][4][2], const Unit& u, int wr, int wc, int fr, int fq) const {
        const bf16_t* xb = X + (size_t)u.pm * 256 * 1024; bf16_t* yb = Y + (size_t)u.pm * 256 * 1024; const unsigned o0 = (unsigned)((wr * 64 + fr) * 1024 + u.pn * 256 + wc * 32 + 8 * fq);
        u32x4 xw[2][4][2];
#pragma unroll
        for (int ai = 0; ai < 2; ++ai)
#pragma unroll
            for (int m = 0; m < 4; ++m)
#pragma unroll
                for (int bj = 0; bj < 2; ++bj) xw[ai][m][bj] = *(const u32x4*)(xb + (o0 + (unsigned)((ai * 128 + m * 16) * 1024 + bj * 128)));
#pragma unroll
        for (int ai = 0; ai < 2; ++ai)
#pragma unroll
            for (int m = 0; m < 4; ++m)
#pragma unroll
                for (int bj = 0; bj < 2; ++bj)
                    *(u32x4*)(yb + (o0 + (unsigned)((ai * 128 + m * 16) * 1024 + bj * 128))) = pack8(bf4_lo(xw[ai][m][bj]) * ALPHA + acc[ai][bj][m][0], bf4_hi(xw[ai][m][bj]) * ALPHA + acc[ai][bj][m][1]);
    }
};
struct EpiGU {
    static constexpr bool PERM = true;
    bf16_t* GG; bf16_t* U;
    __device__ __forceinline__ void operator()(const f32x4 (&acc)[2][2][4][2], const Unit& u, int wr, int wc, int fr, int fq) const {
#pragma unroll
        for (int ai = 0; ai < 2; ++ai)
#pragma unroll
            for (int m = 0; m < 4; ++m) { const int row = EPI_ROW(u, ai, m);
#pragma unroll
                for (int bj = 0; bj < 2; ++bj) { f32x4 v0 = acc[ai][bj][m][0], v1 = acc[ai][bj][m][1];
                    if (u.pn < 4) {
#pragma unroll
                        for (int e = 0; e < 4; ++e) { v0[e] = gelu_tanh(v0[e]); v1[e] = gelu_tanh(v1[e]); }
                        *(u32x4*)(GG + (size_t)row * 1024 + u.pn * 256 + bj * 128 + wc * 32 + 8 * fq) = pack8(v0, v1);
                    } else *(u32x4*)(U + (size_t)row * 1024 + (u.pn - 4) * 256 + bj * 128 + wc * 32 + 8 * fq) = pack8(v0, v1); } }
    }
};
struct EpiAB {
    static constexpr bool PERM = true;
    bf16_t* LA; bf16_t* BB; const bf16_t* UC; const float* BA; const float* BX; const float* SPL;
    __device__ __forceinline__ void operator()(const f32x4 (&acc)[2][2][4][2], const Unit& u, int wr, int wc, int fr, int fq) const {
        const int ch = (u.pn >> 1) * 256 + (u.pn & 1) * 128 + wc * 32 + 8 * fq;
        const float c3 = KF(0.16666667f), c4 = KF(0.041666668f), c5 = KF(0.0083333338f);
        f32x4 ba[2], bx[2], sp[2];
#pragma unroll
        for (int n = 0; n < 2; ++n) { ba[n] = *(const f32x4*)(BA + ch + 4 * n); bx[n] = *(const f32x4*)(BX + ch + 4 * n); sp[n] = *(const f32x4*)(SPL + ch + 4 * n); }
#pragma unroll
        for (int ai = 0; ai < 2; ++ai)
#pragma unroll
            for (int m = 0; m < 4; ++m) { const size_t off = (size_t)EPI_ROW(u, ai, m) * 1024 + ch;
                const u32x4 uw = *(const u32x4*)(UC + off); f32x4 uv[2] = {bf4_lo(uw), bf4_hi(uw)}, lv[2], bv[2];
#pragma unroll
                for (int n = 0; n < 2; ++n)
#pragma unroll
                    for (int e = 0; e < 4; ++e) { const float r = sigmoidf_(acc[ai][0][m][n][e] + ba[n][e]), ig = sigmoidf_(acc[ai][1][m][n][e] + bx[n][e]);
                        const float la = sp[n][e] * r, x2 = 2.0f * la; lv[n][e] = la * 1.4426950408889634f;
                        const float om = x2 > -0.25f ? -x2 * (1.0f + x2 * (0.5f + x2 * (c3 + x2 * (c4 + x2 * c5)))) : 1.0f - __expf(x2);
                        bv[n][e] = sqrtf(om) * ig * uv[n][e]; }
                *(u32x4*)(LA + off) = pack8(lv[0], lv[1]); *(u32x4*)(BB + off) = pack8(bv[0], bv[1]); asm volatile("" ::: "memory"); }
    }
};
struct EpiUp {
    static constexpr bool PERM = true;
    unsigned char* H; unsigned char* SH; const float* BU;
    __device__ __forceinline__ void operator()(f32x4 (&acc)[2][2][4][2], const Unit& u, int wr, int wc, int fr, int fq) const {
        const int gc = u.pn * 128 + wc * 32 + 8 * fq; const float* bu = BU + (size_t)u.aux * 2048;
        const float k7 = KF(7.0f), km7 = KF(-7.0f), ka = KF(1.702f);
#pragma unroll
        for (int n = 0; n < 2; ++n) { const f32x4 bg = *(const f32x4*)(bu + gc + 4 * n), bp = *(const f32x4*)(bu + 1024 + gc + 4 * n);
#pragma unroll
            for (int ai = 0; ai < 2; ++ai)
#pragma unroll
                for (int m = 0; m < 4; ++m) {
#pragma unroll
                    for (int e = 0; e < 4; ++e) { const float g = fminf(acc[ai][0][m][n][e] + bg[e], k7), up = fminf(fmaxf(acc[ai][1][m][n][e] + bp[e], km7), k7);
                        acc[ai][0][m][n][e] = (up + 1.0f) * (g * sigmoidf_(ka * g)); }
                    if (m & 1) __builtin_amdgcn_sched_barrier(0); }
            asm volatile("" ::: "memory"); }
        unsigned char* const shb = SH + ((size_t)u.pm * 8 + u.pn) * 1024; unsigned char* const hb = H + (size_t)u.pm * 256 * 1024;
        const unsigned ho = (unsigned)((wr * 64 + fr) * 1024 + gc), so = (unsigned)((wr * 64 + fr) * 4 + wc);
#pragma unroll
        for (int ai = 0; ai < 2; ++ai)
#pragma unroll
            for (int m = 0; m < 4; ++m) { const f32x4 y0 = acc[ai][0][m][0], y1 = acc[ai][0][m][1];
                float am = fmaxf(fmaxf(fmaxf(fabsf(y0[0]), fabsf(y0[1])), fmaxf(fabsf(y0[2]), fabsf(y0[3]))), fmaxf(fmaxf(fabsf(y1[0]), fabsf(y1[1])), fmaxf(fabsf(y1[2]), fabsf(y1[3]))));
                { auto r16 = __builtin_amdgcn_permlane16_swap(__float_as_uint(am), __float_as_uint(am), false, false); am = fmaxf(__uint_as_float(r16[0]), __uint_as_float(r16[1]));
                  auto r32 = __builtin_amdgcn_permlane32_swap(__float_as_uint(am), __float_as_uint(am), false, false); am = fmaxf(__uint_as_float(r32[0]), __uint_as_float(r32[1])); }
                int eb = (int)((__float_as_uint(am) >> 23) & 0xffu) - 7; eb = eb < 1 ? 1 : eb;
                const float inv = __uint_as_float((unsigned)(254 - eb) << 23);
                int w0 = __builtin_amdgcn_cvt_pk_fp8_f32(y0[0] * inv, y0[1] * inv, 0, false); w0 = __builtin_amdgcn_cvt_pk_fp8_f32(y0[2] * inv, y0[3] * inv, w0, true);
                int w1 = __builtin_amdgcn_cvt_pk_fp8_f32(y1[0] * inv, y1[1] * inv, 0, false); w1 = __builtin_amdgcn_cvt_pk_fp8_f32(y1[2] * inv, y1[3] * inv, w1, true);
                *(u32x2*)(hb + (ho + (unsigned)((ai * 128 + m * 16) * 1024))) = (u32x2){(unsigned)w0, (unsigned)w1};
                if (fq == 0) shb[so + (unsigned)((ai * 128 + m * 16) * 4)] = (unsigned char)eb;
                asm volatile("" ::: "memory"); __builtin_amdgcn_sched_barrier(0); }
    }
};
struct EpiDown {
    static constexpr bool PERM = true;
    unsigned char* YS; unsigned char* SY; const float* BD;
    __device__ __forceinline__ void operator()(const f32x4 (&acc)[2][2][4][2], const Unit& u, int wr, int wc, int fr, int fq) const {
        const float* bd = BD + (size_t)u.aux * 1024;
        unsigned char* const yb = YS + (size_t)u.pm * 256 * 1024; unsigned char* const sb = SY + (size_t)u.pm * 256 * 32;
#pragma unroll
        for (int bj = 0; bj < 2; ++bj) { const int col = u.pn * 256 + bj * 128 + wc * 32 + 8 * fq; const f32x4 b0 = *(const f32x4*)(bd + col), b1 = *(const f32x4*)(bd + col + 4);
#pragma unroll
            for (int ai = 0; ai < 2; ++ai)
#pragma unroll
                for (int m = 0; m < 4; ++m) { const unsigned rit = (unsigned)(ai * 128 + wr * 64 + m * 16 + fr); const f32x4 y0 = acc[ai][bj][m][0] + b0, y1 = acc[ai][bj][m][1] + b1;
                    float am = fmaxf(fmaxf(fmaxf(fabsf(y0[0]), fabsf(y0[1])), fmaxf(fabsf(y0[2]), fabsf(y0[3]))), fmaxf(fmaxf(fabsf(y1[0]), fabsf(y1[1])), fmaxf(fabsf(y1[2]), fabsf(y1[3]))));
                    { auto r16 = __builtin_amdgcn_permlane16_swap(__float_as_uint(am), __float_as_uint(am), false, false); am = fmaxf(__uint_as_float(r16[0]), __uint_as_float(r16[1]));
                      auto r32 = __builtin_amdgcn_permlane32_swap(__float_as_uint(am), __float_as_uint(am), false, false); am = fmaxf(__uint_as_float(r32[0]), __uint_as_float(r32[1])); }
                    int eb = (int)((__float_as_uint(am) >> 23) & 0xffu) - 7; eb = eb < 1 ? 1 : eb;
                    const float inv = __uint_as_float((unsigned)(254 - eb) << 23);
                    int w0 = __builtin_amdgcn_cvt_pk_fp8_f32(y0[0] * inv, y0[1] * inv, 0, false); w0 = __builtin_amdgcn_cvt_pk_fp8_f32(y0[2] * inv, y0[3] * inv, w0, true);
                    int w1 = __builtin_amdgcn_cvt_pk_fp8_f32(y1[0] * inv, y1[1] * inv, 0, false); w1 = __builtin_amdgcn_cvt_pk_fp8_f32(y1[2] * inv, y1[3] * inv, w1, true);
                    *(u32x2*)(yb + (rit * 1024u + (unsigned)col)) = (u32x2){(unsigned)w0, (unsigned)w1};
                    if (fq == 0) sb[rit * 32u + (unsigned)(col >> 5)] = (unsigned char)eb;
                    asm volatile("" ::: "memory"); } }
    }
};
struct EpiPle {
    static constexpr bool PERM = true;
    const bf16_t* X2; const bf16_t* PP; float* OUT; bf16_t* XB;
    __device__ __forceinline__ void operator()(const f32x4 (&acc)[2][2][4][2], const Unit& u, int wr, int wc, int fr, int fq) const {
        const size_t tb = (size_t)u.pm * 256 * 1024; const unsigned o0 = (unsigned)((wr * 64 + fr) * 1024 + u.pn * 256 + wc * 32 + 8 * fq);
#pragma unroll
        for (int ai = 0; ai < 2; ++ai) {
            u32x4 xw[4][2], pw[4][2];
#pragma unroll
            for (int m = 0; m < 4; ++m)
#pragma unroll
                for (int bj = 0; bj < 2; ++bj) { const unsigned o = o0 + (unsigned)((ai * 128 + m * 16) * 1024 + bj * 128); xw[m][bj] = *(const u32x4*)(X2 + tb + o); pw[m][bj] = *(const u32x4*)(PP + tb + o); }
#pragma unroll
            for (int m = 0; m < 4; ++m)
#pragma unroll
                for (int bj = 0; bj < 2; ++bj) { const unsigned o = o0 + (unsigned)((ai * 128 + m * 16) * 1024 + bj * 128);
                    const f32x4 a0 = acc[ai][bj][m][0], a1 = acc[ai][bj][m][1], x0 = bf4_lo(xw[m][bj]), x1 = bf4_hi(xw[m][bj]), p0 = bf4_lo(pw[m][bj]), p1 = bf4_hi(pw[m][bj]); f32x4 r0, r1;
#pragma unroll
                    for (int e = 0; e < 4; ++e) { r0[e] = x0[e] + sigmoidf_(a0[e]) * p0[e]; r1[e] = x1[e] + sigmoidf_(a1[e]) * p1[e]; }
                    *(u32x4*)(XB + tb + o) = pack8(r0, r1);
                    if (OUT) { *(f32x4*)(OUT + tb + o) = r0; *(f32x4*)(OUT + tb + o + 4) = r1; } }
            asm volatile("" ::: "memory"); }
    }
};
struct EpiPP {
    static constexpr bool PERM = true;
    bf16_t* PP;
    __device__ __forceinline__ void operator()(const f32x4 (&acc)[2][2][4][2], const Unit& u, int wr, int wc, int fr, int fq) const {
#pragma unroll
        for (int ai = 0; ai < 2; ++ai)
#pragma unroll
            for (int m = 0; m < 4; ++m)
#pragma unroll
                for (int bj = 0; bj < 2; ++bj) *(u32x4*)(PP + (size_t)EPI_ROW(u, ai, m) * 1024 + u.pn * 256 + bj * 128 + wc * 32 + 8 * fq) = pack8(acc[ai][bj][m][0], acc[ai][bj][m][1]);
    }
};
}

namespace att {
constexpr int NW = 8, QBLK = 32, KVBLK = 64, QB = 256, KPITCH = 384;
constexpr int SHM_V = KVBLK * DV * 2, SHM_K = KVBLK * KPITCH;
constexpr int NVB = 3;
constexpr int OFF_V = 0, OFF_K = NVB * SHM_V, OFF_WS = OFF_K + 2 * SHM_K, LDS_BYTES = OFF_WS + NW * 64 * 4;
#define SBAR() __builtin_amdgcn_sched_barrier(0)
__device__ __forceinline__ int k_addr(int row, int chunk) { return row * KPITCH + ((chunk ^ ((row >> 1) & 7)) << 4); }
__device__ __forceinline__ int v_st(int k, int c) { const int kk = (k & ~0xC) | ((k & 4) << 1) | ((k & 8) >> 1); return ((kk >> 3) * 4 + (c >> 5)) * 512 + ((kk & 7) * 32 + (c & 31)) * 2; }
__device__ __forceinline__ int v_rd_base(int lane) { return ((lane & 3) << 3) | (((lane >> 2) & 3) << 6) | (((lane >> 4) & 1) << 5) | (((lane >> 5) & 1) << 8); }
constexpr int v_rd_off(int d0, int ks, int half) { return d0 * 512 + ks * 4096 + half * 2048; }
__device__ __forceinline__ int crow(int r, int hi) { return (r & 3) + 8 * (r >> 2) + 4 * hi; }

template <int KB>
__device__ __forceinline__ void qkt(f32x16& p0, f32x16& p1, const LAS char* K_lds, int r32, int hi, const bf16x8* qr) {
    p0 = f32x16{}; p1 = f32x16{};
    const LAS char* kb[4];
#pragma unroll
    for (int dd = 0; dd < 4; ++dd) kb[dd] = K_lds + KB * SHM_K + r32 * KPITCH + (((2 * dd + hi) ^ ((r32 >> 1) & 7)) << 4);
    bf16x8 f[2][4];
#define QK_LD(g, buf) do { _Pragma("unroll") for (int e_ = 0; e_ < 2; ++e_) { const int d0_ = 2 * (g) + e_; const LAS char* a_ = kb[d0_ & 3] + (d0_ >> 2) * 128; \
        f[buf][2 * e_] = *(const LAS bf16x8*)a_; f[buf][2 * e_ + 1] = *(const LAS bf16x8*)(a_ + 32 * KPITCH); } } while (0)
    QK_LD(0, 0);
#pragma unroll
    for (int g = 0; g < 6; ++g) {
        if (g < 5) QK_LD(g + 1, (g + 1) & 1);
        SBAR();
#pragma unroll
        for (int e = 0; e < 2; ++e) { const int d0 = 2 * g + e;
            p0 = __builtin_amdgcn_mfma_f32_32x32x16_bf16(f[g & 1][2 * e], qr[d0], p0, 0, 0, 0);
            p1 = __builtin_amdgcn_mfma_f32_32x32x16_bf16(f[g & 1][2 * e + 1], qr[d0], p1, 0, 0, 0); }
        SBAR(); }
#undef QK_LD
}
__device__ __forceinline__ void pv_tile(f32x16* o, int vb0  , bf16x8 pa0, bf16x8 pa1, bf16x8 pa2, bf16x8 pa3) {
#define TRRD(dst, off) asm volatile("ds_read_b64_tr_b16 %0, %1 offset:%2" : "=&v"(dst) : "v"(vb0), "i"(off) : "memory")
#define PV_D0(d0) do { s16x4 l0, l1, l2, l3, h0, h1, h2, h3; constexpr int b_ = v_rd_off(d0, 0, 0); \
        TRRD(l0, b_); TRRD(h0, b_ + 2048); TRRD(l1, b_ + 4096); TRRD(h1, b_ + 6144); TRRD(l2, b_ + 8192); TRRD(h2, b_ + 10240); TRRD(l3, b_ + 12288); TRRD(h3, b_ + 14336); \
        asm volatile("s_waitcnt lgkmcnt(0)" ::: "memory"); SBAR(); \
        o[d0] = __builtin_amdgcn_mfma_f32_32x32x16_bf16(pa0, (bf16x8){l0[0], l0[1], l0[2], l0[3], h0[0], h0[1], h0[2], h0[3]}, o[d0], 0, 0, 0); \
        o[d0] = __builtin_amdgcn_mfma_f32_32x32x16_bf16(pa1, (bf16x8){l1[0], l1[1], l1[2], l1[3], h1[0], h1[1], h1[2], h1[3]}, o[d0], 0, 0, 0); \
        o[d0] = __builtin_amdgcn_mfma_f32_32x32x16_bf16(pa2, (bf16x8){l2[0], l2[1], l2[2], l2[3], h2[0], h2[1], h2[2], h2[3]}, o[d0], 0, 0, 0); \
        o[d0] = __builtin_amdgcn_mfma_f32_32x32x16_bf16(pa3, (bf16x8){l3[0], l3[1], l3[2], l3[3], h3[0], h3[1], h3[2], h3[3]}, o[d0], 0, 0, 0); } while (0)
    PV_D0(0); PV_D0(1); PV_D0(2); PV_D0(3);
#undef PV_D0
#undef TRRD
}
__device__ __forceinline__ void mask_tile(f32x16& p0, f32x16& p1, int dq  ) {
    const float NEG = -__builtin_inff();
#pragma unroll
    for (int r = 0; r < 16; ++r) { const int c = (r & 3) + 8 * (r >> 2);
        if (c > dq) p0[r] = NEG;
        if (c + 32 > dq) p1[r] = NEG; }
}
__device__ __forceinline__ void softmax_tile(f32x16& p0, f32x16& p1, float& m_reg, float& l_reg, float& alpha, bf16x8& pa0, bf16x8& pa1, bf16x8& pa2, bf16x8& pa3) {
    float pmax = p0[0];
#pragma unroll
    for (int r = 1; r < 16; ++r) pmax = fmaxf(pmax, p0[r]);
#pragma unroll
    for (int r = 0; r < 16; ++r) pmax = fmaxf(pmax, p1[r]);
    { auto rr = __builtin_amdgcn_permlane32_swap(__float_as_uint(pmax), __float_as_uint(pmax), false, false); pmax = fmaxf(__uint_as_float(rr[0]), __uint_as_float(rr[1])); }
    float mn = m_reg; alpha = 1.f;
    if (!__all(pmax - m_reg <= 8.0f)) { mn = fmaxf(m_reg, pmax); alpha = __builtin_amdgcn_exp2f(m_reg - mn); m_reg = mn; }
    float ps = 0.f;
#pragma unroll
    for (int r = 0; r < 16; ++r) { p0[r] = __builtin_amdgcn_exp2f(p0[r] - mn); ps += p0[r]; }
#pragma unroll
    for (int r = 0; r < 16; ++r) { p1[r] = __builtin_amdgcn_exp2f(p1[r] - mn); ps += p1[r]; }
    { auto rr = __builtin_amdgcn_permlane32_swap(__float_as_uint(ps), __float_as_uint(ps), false, false); ps = __uint_as_float(rr[0]) + __uint_as_float(rr[1]); }
    l_reg = l_reg * alpha + ps;
#define PK4(P, B_, OUT) do { unsigned a0 = cvt_pk_bf16(P[B_+0], P[B_+1]), a1 = cvt_pk_bf16(P[B_+2], P[B_+3]); \
        unsigned b0 = cvt_pk_bf16(P[B_+4], P[B_+5]), b1 = cvt_pk_bf16(P[B_+6], P[B_+7]); \
        auto r0 = __builtin_amdgcn_permlane32_swap(a0, b0, false, false); auto r1 = __builtin_amdgcn_permlane32_swap(a1, b1, false, false); \
        u32x4 w = {r0[0], r1[0], r0[1], r1[1]}; OUT = __builtin_bit_cast(bf16x8, w); } while (0)
    PK4(p0, 0, pa0); PK4(p0, 8, pa1); PK4(p1, 0, pa2); PK4(p1, 8, pa3);
#undef PK4
}

__device__ __forceinline__ void attn_block(int b, int h, int qb, const bf16_t* Q, const bf16_t* KN, const bf16_t* KR, const bf16_t* V, bf16_t* O, LAS char* lds, unsigned long long* pw = nullptr) {
    const int tid = opaque_tid(), wid = __builtin_amdgcn_readfirstlane(tid >> 6), lane = tid & 63, r32 = lane & 31, hi = lane >> 5;
    const size_t row0 = (size_t)b * SEQ;
    const int q0 = qb * QB + wid * QBLK;
    const int NT = (qb + 1) * (QB / KVBLK);
    LAS char* V_lds = lds + OFF_V; LAS char* K_lds = lds + OFF_K;
    LAS float* ws = (LAS float*)(lds + OFF_WS) + wid * 64; LAS float* li_l = ws; LAS float* al_l = ws + 32;
    const int sr = tid >> 4, sc = (tid & 15) * 8, kr_row = tid >> 3, kr_c = tid & 7;
    const int vst0 = v_st(sr, sc), vst1 = v_st(32 + sr, sc), kws = k_addr(sr, tid & 15), kwr = k_addr(kr_row, 16 + kr_c);
    const int vb0 = (int)(uintptr_t)lds + v_rd_base(lane);
    const bf16_t* KNh = KN + row0 * 1024 + h * 128 + sc; const bf16_t* Vh = V + row0 * 1024 + h * 128 + sc; const bf16_t* KRb = KR + row0 * 64 + kr_c * 8;
    bf16x8 st_k0, st_k1, st_kr, st_v0, st_v1;
#define SLOAD(t) do { const size_t k0_ = (size_t)(t) * KVBLK; \
        st_k0 = *(const bf16x8*)(KNh + (k0_ + sr) * 1024); st_k1 = *(const bf16x8*)(KNh + (k0_ + 32 + sr) * 1024); st_kr = *(const bf16x8*)(KRb + (k0_ + kr_row) * 64); \
        st_v0 = *(const bf16x8*)(Vh + (k0_ + sr) * 1024); st_v1 = *(const bf16x8*)(Vh + (k0_ + 32 + sr) * 1024); } while (0)
#define SWRITE(bf, vo) do { *(LAS bf16x8*)(K_lds + (bf) * SHM_K + kws) = st_k0; *(LAS bf16x8*)(K_lds + (bf) * SHM_K + kws + 32 * KPITCH) = st_k1; *(LAS bf16x8*)(K_lds + (bf) * SHM_K + kwr) = st_kr; \
        *(LAS bf16x8*)(V_lds + (vo) + vst0) = st_v0; *(LAS bf16x8*)(V_lds + (vo) + vst1) = st_v1; } while (0)
    SLOAD(0);
    bf16x8 qr[12];
    { const bf16_t* Qw = Q + (row0 + q0 + r32) * 1536 + h * 192 + hi * 8;
#pragma unroll
      for (int d0 = 0; d0 < 12; ++d0) qr[d0] = *(const bf16x8*)(Qw + d0 * 16); }
    float m_reg = -1e30f, l_reg = 0.f; f32x16 o[4] = {};
    f32x16 p0, p1; bf16x8 pa0, pa1, pa2, pa3; float alpha;
    asm volatile("s_waitcnt vmcnt(0)" ::: "memory");
    SWRITE(0, 0);
    __syncthreads();
    const bool odd = wid >= 4; int vo_prev = 0, vo_cur = 0, vo_next = SHM_V;
#define RESC(a) do { if (__any((a) < 1.f)) { if (hi == 0) al_l[r32] = (a); asm volatile("s_waitcnt lgkmcnt(0)" ::: "memory"); \
        _Pragma("unroll") for (int d_ = 0; d_ < 4; ++d_) _Pragma("unroll") for (int r = 0; r < 16; ++r) o[d_][r] *= al_l[crow(r, hi)]; } } while (0)
#if PROBE_T
    unsigned long long pa_ = 0, pb_ = 0, pc_ = 0, pd_ = 0, pe2_ = 0; const unsigned long long pst_ = __builtin_amdgcn_s_memtime();
#define PSTAMP(v) const unsigned long long v = __builtin_amdgcn_s_memtime()
#define PACC(acc, a, b) acc += (b) - (a)
#else
#define PSTAMP(v) do {} while (0)
#define PACC(acc, a, b) do {} while (0)
#endif
#define TILE(t, BF) do { PSTAMP(s0_); const bool more_ = ((t) + 1 < NT); if (more_) SLOAD((t) + 1); SBAR(); \
        if (odd && (t) > 0) { pv_tile(o, vb0 + vo_prev, pa0, pa1, pa2, pa3); SBAR(); } \
        PSTAMP(s1_); qkt<BF>(p0, p1, K_lds, r32, hi, qr); \
        { const int kb_ = (t) * KVBLK; if (kb_ + KVBLK - 1 > q0) mask_tile(p0, p1, q0 + r32 - kb_ - 4 * hi); } \
        asm volatile("" : "+v"(p0), "+v"(p1)); PSTAMP(s2_); \
        softmax_tile(p0, p1, m_reg, l_reg, alpha, pa0, pa1, pa2, pa3); RESC(alpha); SBAR(); PSTAMP(s3_); \
        if (!odd) pv_tile(o, vb0 + vo_cur, pa0, pa1, pa2, pa3); \
        PSTAMP(s4_); if (more_) { asm volatile("s_waitcnt vmcnt(0)" ::: "memory"); SWRITE((BF) ^ 1, vo_next); } \
        PSTAMP(s5_); __syncthreads(); PSTAMP(s6_); PACC(pa_, s1_, s2_); PACC(pb_, s2_, s3_); PACC(pc_, s3_, s4_); PACC(pd_, s4_, s5_); PACC(pe2_, s5_, s6_); vo_prev = vo_cur; vo_cur = vo_next; vo_next = (vo_next == (NVB - 1) * SHM_V) ? 0 : vo_next + SHM_V; } while (0)
#pragma unroll 1
    for (int t = 0; t < NT; t += 2) { TILE(t, 0); TILE(t + 1, 1); }
    if (odd) pv_tile(o, vb0 + vo_prev, pa0, pa1, pa2, pa3);
#if PROBE_T
    if (pw && blockIdx.x == 0 && tid == 0) { pw[8] += pa_; pw[9] += pb_; pw[10] += pc_; pw[11] += pd_; pw[12] += pe2_; pw[13] += (unsigned long long)NT; pw[14] += __builtin_amdgcn_s_memtime() - pst_; }
#endif
    if (hi == 0) li_l[r32] = l_reg; asm volatile("s_waitcnt lgkmcnt(0)" ::: "memory");
    __syncthreads();
    { LAS bf16_t* stg = (LAS bf16_t*)(lds + wid * 8704);
#pragma unroll
      for (int r = 0; r < 16; ++r) { const int orow = crow(r, hi); const float rl = __builtin_amdgcn_rcpf(li_l[orow]);
#pragma unroll
          for (int d0 = 0; d0 < 4; ++d0) { const float v = o[d0][r] * rl; stg[orow * 136 + d0 * 32 + r32] = (bf16_t)(cvt_pk_bf16(v, v) & 0xffffu); } }
      asm volatile("s_waitcnt lgkmcnt(0)" ::: "memory");
      bf16_t* Ow = O + (row0 + q0) * 1024 + h * 128 + (lane & 15) * 8;
#pragma unroll
      for (int it = 0; it < 8; ++it) { const int row = it * 4 + (lane >> 4); const u32x4 v = *(const LAS u32x4*)(stg + row * 136 + (lane & 15) * 8); *(u32x4*)(Ow + (size_t)row * 1024) = v; } }
    __syncthreads();
#undef SLOAD
#undef SWRITE
#undef RESC
#undef TILE
#undef PSTAMP
#undef PACC
}
#undef SBAR
}

#define XB_TMO      128
#define XB_XCNT(j)  (256  + 64 * (j))
#define XB_XSUB(j)  (1280 + 64 * (j))
#define XB_XGEN(j)  (2304 + 64 * (j))
#define XB_TOP      3328
#define XB_TOPGEN   3392
#define XCD_BAR_WORDS 3456
#define XB_SPIN_CAP (1u << 22)
__device__ __forceinline__ unsigned xb_ld(unsigned* p)              { return __hip_atomic_load(p, __ATOMIC_RELAXED, __HIP_MEMORY_SCOPE_AGENT); }
__device__ __forceinline__ unsigned xb_add(unsigned* p, unsigned v) { return __hip_atomic_fetch_add(p, v, __ATOMIC_RELAXED, __HIP_MEMORY_SCOPE_AGENT); }
__device__ __forceinline__ unsigned xb_xcc_id() { return (unsigned)__builtin_amdgcn_s_getreg((3 << 11) | 20) & 0xFu; }
#define XB_SPIN(cond, bar) do { unsigned _sp = 0; while (cond) { __builtin_amdgcn_s_sleep(1); \
    if ((++_sp & 255u) == 0u) { if (xb_ld(&(bar)[XB_TMO])) break; if (_sp > XB_SPIN_CAP) { atomicAdd(&(bar)[XB_TMO], 1u); break; } } } } while (0)
struct XcdBarrier { unsigned* bar; unsigned x; volatile LAS unsigned* st; };
__device__ __forceinline__ XcdBarrier xcd_barrier_post(unsigned* bar, volatile LAS unsigned* st) {
    XcdBarrier b; b.bar = bar; b.x = xb_xcc_id(); b.st = st;
    if (threadIdx.x == 0) (void)xb_add(&bar[XB_XCNT(b.x)], 1u);
    return b;
}
__device__ __forceinline__ void xcd_barrier_complete(unsigned* bar, unsigned x, unsigned& nloc, unsigned& nx) {
    const unsigned G = gridDim.x * gridDim.y * gridDim.z;
    unsigned sum, cnt, mine, sp = 0u;
    for (;;) {
        sum = 0u; cnt = 0u; mine = 0u;
#pragma unroll
        for (unsigned j = 0; j < 16; ++j) { const unsigned c = xb_ld(&bar[XB_XCNT(j)]); sum += c; cnt += (c > 0u) ? 1u : 0u; mine = (j == x) ? c : mine; }
        if (sum == G) break;
        __builtin_amdgcn_s_sleep(1);
        if ((++sp & 255u) == 0u) { if (xb_ld(&bar[XB_TMO])) break; if (sp > XB_SPIN_CAP) { atomicAdd(&bar[XB_TMO], 1u); break; } }
    }
    nloc = mine > 0u ? mine : 1u; nx = cnt > 0u ? cnt : 1u;
}
__device__ __forceinline__ void xcd_barrier(const XcdBarrier& b) {
    asm volatile("s_waitcnt vmcnt(0)" ::: "memory");
    __syncthreads();
    if (opaque_tid() == 0) {
        unsigned* bar = b.bar; unsigned bx = b.x;
        asm volatile("" : "+s"(bar), "+s"(bx));
        __builtin_amdgcn_s_waitcnt(0);
        unsigned nloc = b.st[0], nx = b.st[1];
        if (nloc == 0u) { xcd_barrier_complete(bar, bx, nloc, nx); b.st[0] = nloc; b.st[1] = nx; }
        const unsigned old = xb_add(&bar[XB_XSUB(bx)], 1u);
        const unsigned gen = old / nloc;
        if (old + 1u == (gen + 1u) * nloc) {
            __builtin_amdgcn_fence(__ATOMIC_RELEASE, "agent");
            asm volatile("s_waitcnt vmcnt(0)" ::: "memory");
            const unsigned og = xb_add(&bar[XB_TOP], 1u);
            const unsigned tg = og / nx;
            if (og + 1u == (tg + 1u) * nx) xb_add(&bar[XB_TOPGEN], 1u);
            else XB_SPIN(xb_ld(&bar[XB_TOPGEN]) == tg, bar);
            __builtin_amdgcn_fence(__ATOMIC_ACQUIRE, "agent");
            xb_add(&bar[XB_XGEN(bx)], 1u);
            asm volatile("s_waitcnt vmcnt(0)" ::: "memory");
        } else {
            XB_SPIN(xb_ld(&bar[XB_XGEN(bx)]) == gen, bar);
            __builtin_amdgcn_fence(__ATOMIC_ACQUIRE, "agent");
            asm volatile("s_waitcnt vmcnt(0)" ::: "memory");
        }
    }
    __syncthreads();
}

struct Args { const void* in[30]; float* out; unsigned char* ws; int ph_lo, ph_hi, li, pad; };
struct Ctx { int tid, lane, wave, vcu, G, bid; LAS unsigned char* lds; volatile LAS int* misc; };
__device__ __forceinline__ Ctx fresh_ctx(const Ctx& c) {
    Ctx r = c; unsigned l = (unsigned)(uintptr_t)c.lds, m = (unsigned)(uintptr_t)c.misc;
    asm volatile("" : "+s"(r.wave), "+s"(r.vcu), "+s"(r.G), "+s"(r.bid), "+s"(l), "+s"(m));
    r.lds = (LAS unsigned char*)(uintptr_t)l; r.misc = (volatile LAS int*)(uintptr_t)m; r.tid = opaque_tid(); r.lane = r.tid & 63; return r; }
typedef const CAS Args* ArgsP;
__device__ __forceinline__ const CAS Args& fresh_args(ArgsP p) { asm volatile("" : "+s"(p)); return *p; }
enum { I_X = 0, I_P, I_POS, I_MLA_WIN, I_MLA_QN, I_MLA_KVN, I_MLA_WUQ, I_MLA_WUKV, I_MLA_WO, I_LRU_WIN, I_LRU_CW, I_LRU_CB, I_LRU_WA, I_LRU_BA, I_LRU_WX, I_LRU_BX, I_LRU_LAM, I_LRU_WOUT,
       I_LN1G, I_LN1B, I_LN2G, I_LN2B, I_MOE_WR, I_MOE_BR, I_MOE_WUP, I_MOE_BUP, I_MOE_WDN, I_MOE_BDN, I_PLE_WG, I_PLE_WP };
#define INF(i) ((const float*)args.in[i])
#define WSP(T_, off) ((T_*)(args.ws + (off)))

__device__ __forceinline__ void tr_load(const float* W, int ld, int k0, int sc0, int sc1, int lane, f32x4 (&v)[16]) {
    const int half = (lane & 15) >> 3, scol = half ? sc1 : sc0, c4 = (lane & 7) * 4, rs = lane >> 4;
#pragma unroll
    for (int i = 0; i < 8; ++i) { const float* p = W + (size_t)(k0 + 8 * i + 2 * rs) * ld + scol + c4;
        v[2 * i] = (scol >= 0) ? *(const f32x4*)p : (f32x4){0.f, 0.f, 0.f, 0.f}; v[2 * i + 1] = (scol >= 0) ? *(const f32x4*)(p + ld) : (f32x4){0.f, 0.f, 0.f, 0.f}; }
}
__device__ __forceinline__ void tr_store(f32x4 (&v)[16], const float* ksc, int k0, bf16_t* dst  , int K, LAS unsigned* scr, int lane) {
    const int rs = lane >> 4;
    if (ksc) {
#pragma unroll
        for (int i = 0; i < 8; ++i) { v[2 * i] = v[2 * i] * ksc[k0 + 8 * i + 2 * rs]; v[2 * i + 1] = v[2 * i + 1] * ksc[k0 + 8 * i + 2 * rs + 1]; } }
#pragma unroll
    for (int i = 0; i < 8; ++i) { LAS unsigned* s = scr + (4 * i + rs) * 65 + (lane & 15) * 4;
#pragma unroll
        for (int e = 0; e < 4; ++e) s[e] = cvt_pk_bf16(v[2 * i][e], v[2 * i + 1][e]); }
    asm volatile("s_waitcnt lgkmcnt(0)" ::: "memory");
    const int c = lane & 7;
#pragma unroll
    for (int j = 0; j < 8; ++j) { const int n = (lane >> 3) + 8 * j; const LAS unsigned* s = scr + (4 * c) * 65 + n;
        u32x4 o; o.x = s[0]; o.y = s[65]; o.z = s[130]; o.w = s[195];
        *(u32x4*)(dst + (size_t)n * K + 8 * c) = o; }
    asm volatile("s_waitcnt lgkmcnt(0)" ::: "memory");
}
enum { J_NAT = 0, J_MLA_WIN, J_MLA_WUQ, J_LRU_WAX, J_MOE_UP };
__device__ __forceinline__ int tr_map(int job, int g) {
    switch (job) {
    case J_MLA_WIN: return g < 32 ? 32 * g : (g == 32 ? 1024 : (g == 36 ? 1056 : -1));
    case J_MLA_WUQ: if (g < 32) { const int t = g >> 3, bj = (g >> 2) & 1, cg = g & 3; return (2 * t + bj) * 192 + 32 * cg; }
                    else { const int g2 = g - 32, t2 = g2 >> 3, bj = (g2 >> 2) & 1, hh = g2 & 3; return (4 * t2 + hh) * 192 + 128 + 32 * bj; }
    case J_LRU_WAX: { const int pn = g >> 3, cg = g & 3; return 128 * pn + 32 * cg; }
    case J_MOE_UP:  { const int pn = g >> 3, bj = (g >> 2) & 1, cg = g & 3; return bj * 1024 + 128 * pn + 32 * cg; }
    default: return 32 * g;
    }
}
__device__ __forceinline__ void tr_job(const Ctx& C, int job, const float* src, size_t srcstride, int nmat, int K, int ld, int N, bf16_t* dst, size_t dststride, const float* ksc, int kscstride,
                                       const float* src2  ) {
    LAS unsigned* scr = (LAS unsigned*)(C.lds + C.wave * 8320);
    const int gw = C.vcu * NWAVES + C.wave, NGW = C.G * NWAVES;
    const int nkb = K / 64, nnb = N / 64, per = nkb * nnb, total = per * nmat;
#define TR_DECODE(it_, W_, k0_, s0_, s1_, ks_, d_) do { const int mat_ = (it_) / per, r_ = (it_) - mat_ * per, kb_ = r_ / nnb, nb_ = r_ - kb_ * nnb; \
        s0_ = tr_map(job, 2 * nb_); s1_ = tr_map(job, 2 * nb_ + 1); W_ = src + (size_t)mat_ * srcstride; \
        if (job == J_LRU_WAX && ((nb_ >> 1) & 1)) W_ = src2 + (size_t)mat_ * srcstride;       \
        k0_ = kb_ * 64; ks_ = ksc ? ksc + (size_t)mat_ * kscstride : nullptr; d_ = (bf16_t*)((char*)dst + (size_t)mat_ * dststride) + (size_t)(nb_ * 64) * K + kb_ * 64; } while (0)
    f32x4 va[16], vb[16];
    int it = gw; const float* Wc; int k0c, s0c, s1c; const float* ksc_c; bf16_t* dc;
    if (it < total) { TR_DECODE(it, Wc, k0c, s0c, s1c, ksc_c, dc); tr_load(Wc, ld, k0c, s0c, s1c, C.lane, va); }
    while (it < total) {
        const int nit = it + NGW; const float* Wn = nullptr; int k0n = 0, s0n = 0, s1n = 0; const float* ksc_n = nullptr; bf16_t* dn = nullptr;
        if (nit < total) { TR_DECODE(nit, Wn, k0n, s0n, s1n, ksc_n, dn); tr_load(Wn, ld, k0n, s0n, s1n, C.lane, vb); }
        tr_store(va, ksc_c, k0c, dc, K, scr, C.lane);
#pragma unroll
        for (int i = 0; i < 16; ++i) va[i] = vb[i];
        it = nit; k0c = k0n; ksc_c = ksc_n; dc = dn;
    }
#undef TR_DECODE
}
template <int JOB, int N, bool G64  >
__device__ __forceinline__ void tr_job_fp8(const Ctx& C, const float* src, size_t srcstride, int nmat, unsigned char* dst, size_t dststride, unsigned char* SW) {
    constexpr int K = 1024, ld = N;
    LAS float* scr = (LAS float*)(C.lds + C.wave * 16640);
    const int gw = C.vcu * NWAVES + C.wave, NGW = C.G * NWAVES, lane = C.lane;
    const int nkb = K / 64, nnb = N / 64, per = nkb * nnb, total = per * nmat;
    for (int it = gw; it < total; it += NGW) {
        const int mat = it / per, r = it - mat * per, kb = r / nnb, nb = r - kb * nnb;
        const int s0 = tr_map(JOB, 2 * nb), s1 = tr_map(JOB, 2 * nb + 1);
        f32x4 v[16];
        tr_load(src + (size_t)mat * srcstride, ld, kb * 64, s0, s1, lane, v);
        const int rs = lane >> 4;
#pragma unroll
        for (int i = 0; i < 8; ++i) { LAS float* sp = scr + (8 * i + 2 * rs) * 65 + (lane & 15) * 4;
#pragma unroll
            for (int e = 0; e < 4; ++e) { sp[e] = v[2 * i][e]; sp[65 + e] = v[2 * i + 1][e]; } }
        asm volatile("s_waitcnt lgkmcnt(0)" ::: "memory");
        const int c = lane & 7;
#pragma unroll
        for (int j = 0; j < 8; ++j) { const int n = (lane >> 3) + 8 * j; const LAS float* sp = scr + (8 * c) * 65 + n;
            float x[8]; float am = 0.f;
#pragma unroll
            for (int q = 0; q < 8; ++q) { x[q] = sp[q * 65]; am = fmaxf(am, fabsf(x[q])); }
            am = fmaxf(am, __shfl_xor(am, 1)); am = fmaxf(am, __shfl_xor(am, 2));
            if (G64) am = fmaxf(am, __shfl_xor(am, 4));
            int eb = (int)((__float_as_uint(am) >> 23) & 0xffu) - 7; eb = eb < 1 ? 1 : eb;
            const float inv = __uint_as_float((unsigned)(254 - eb) << 23);
            int w0 = __builtin_amdgcn_cvt_pk_fp8_f32(x[0] * inv, x[1] * inv, 0, false); w0 = __builtin_amdgcn_cvt_pk_fp8_f32(x[2] * inv, x[3] * inv, w0, true);
            int w1 = __builtin_amdgcn_cvt_pk_fp8_f32(x[4] * inv, x[5] * inv, 0, false); w1 = __builtin_amdgcn_cvt_pk_fp8_f32(x[6] * inv, x[7] * inv, w1, true);
            const int nrow = nb * 64 + n;
            *(u32x2*)(dst + (size_t)mat * dststride + (size_t)nrow * K + kb * 64 + 8 * c) = (u32x2){(unsigned)w0, (unsigned)w1};
            if (!G64) { if ((c & 3) == 0) SW[(size_t)mat * 65536 + (size_t)(nrow >> 8) * 8192 + (size_t)(kb >> 1) * 1024 + (nrow & 255) * 4 + 2 * (kb & 1) + (c >> 2)] = (unsigned char)eb; }
            else { if (c == 0) SW[(size_t)mat * 16384 + (size_t)(nrow >> 8) * 4096 + (size_t)(kb >> 1) * 512 + (nrow & 255) * 2 + (kb & 1)] = (unsigned char)eb; } }
        asm volatile("s_waitcnt lgkmcnt(0)" ::: "memory");
    }
}
__device__ __forceinline__ void cvt_rows(const Ctx& C, const float* src, bf16_t* dst, size_t n8  ) {
    const size_t gt = (size_t)C.vcu * 512 + C.tid, NT = (size_t)C.G * 512;
    for (size_t i = gt; i < n8; i += NT) { const f32x4 a = *(const f32x4*)(src + i * 8), b = *(const f32x4*)(src + i * 8 + 4); *(u32x4*)(dst + i * 8) = pack8(a, b); }
}
__device__ __forceinline__ void phase_prologue(const CAS Args& args, const Ctx& C) {
    tr_job(C, J_MLA_WIN, INF(I_MLA_WIN), (size_t)DM * LATD, 2, DM, LATD, 1280, WSP(bf16_t, WS_W_MLA + OFF_MLA_WIN), W_MLA_STRIDE, nullptr, 0, nullptr);
    tr_job(C, J_MLA_WUQ, INF(I_MLA_WUQ), (size_t)QL * 1536, 2, QL, 1536, 1536, WSP(bf16_t, WS_W_MLA + OFF_MLA_WUQ), W_MLA_STRIDE, INF(I_MLA_QN), QL, nullptr);
    tr_job(C, J_NAT, INF(I_MLA_WUKV), (size_t)KVL * 2048, 2, KVL, 2048, 2048, WSP(bf16_t, WS_W_MLA + OFF_MLA_WUKV), W_MLA_STRIDE, INF(I_MLA_KVN), KVL, nullptr);
    tr_job(C, J_NAT, INF(I_MLA_WO), (size_t)DM * DM, 2, DM, DM, DM, WSP(bf16_t, WS_W_MLA + OFF_MLA_WO), W_MLA_STRIDE, nullptr, 0, nullptr);
    tr_job(C, J_NAT, INF(I_LRU_WIN), (size_t)DM * 2048, 2, DM, 2048, 2048, WSP(bf16_t, WS_W_LRU + OFF_LRU_WIN), W_LRU_STRIDE, nullptr, 0, nullptr);
    for (int j = 0; j < 2; ++j)
        tr_job(C, J_LRU_WAX, INF(I_LRU_WA) + (size_t)j * 4 * 65536, (size_t)256 * 256, 4, 256, 256, 512, WSP(bf16_t, WS_W_LRU + OFF_LRU_WAX + (size_t)j * W_LRU_STRIDE), (size_t)512 * 256 * 2, nullptr, 0, INF(I_LRU_WX) + (size_t)j * 4 * 65536);
    tr_job(C, J_NAT, INF(I_LRU_WOUT), (size_t)DM * DM, 2, DM, DM, DM, WSP(bf16_t, WS_W_LRU + OFF_LRU_WOUT), W_LRU_STRIDE, nullptr, 0, nullptr);
    tr_job(C, J_NAT, INF(I_PLE_WG), (size_t)DM * DM, 4, DM, DM, DM, WSP(bf16_t, WS_W_PLE + OFF_PLE_WG), W_PLE_STRIDE, nullptr, 0, nullptr);
    tr_job(C, J_NAT, INF(I_PLE_WP), (size_t)PLED * DM, 4, PLED, DM, DM, WSP(bf16_t, WS_W_PLE + OFF_PLE_WP), W_PLE_STRIDE, nullptr, 0, nullptr);
    __syncthreads();
    tr_job_fp8<J_MOE_UP, 2048, false>(C, INF(I_MOE_WUP), (size_t)DM * 2048, DEPTH * NE, args.ws + WS_W_UP, (size_t)2048 * 1024, args.ws + WS_SW);
    tr_job_fp8<J_NAT, 1024, true>(C, INF(I_MOE_WDN), (size_t)DFF * DM, DEPTH * NE, args.ws + WS_W_DN, (size_t)1024 * 1024, args.ws + WS_SWD);
    __syncthreads();
    cvt_rows(C, INF(I_X), WSP(bf16_t, WS_XB), (size_t)T * DM / 8);
    cvt_rows(C, INF(I_P), WSP(bf16_t, WS_PB), (size_t)DEPTH * T * PLED / 8);
    { const int* pos = (const int*)args.in[I_POS]; float* CS = WSP(float, WS_CS); float* SN = WSP(float, WS_SN);
      const size_t gt = (size_t)C.vcu * 512 + C.tid, NT = (size_t)C.G * 512;
      for (size_t i = gt; i < (size_t)T * 32; i += NT) { const int tok = (int)(i >> 5), j = (int)(i & 31);
          const double inv = exp(-9.210340371976184 * (double)j / 32.0); const double ang = (double)pos[tok] * inv; double s, c; sincos(ang, &s, &c); CS[i] = (float)c; SN[i] = (float)s; }
      { const float* wr = INF(I_MOE_WR); bf16_t* WRH = WSP(bf16_t, WS_WRH); bf16_t* WRL = WSP(bf16_t, WS_WRL);
        for (size_t i = gt; i < (size_t)DEPTH * 64 * 64; i += NT) { const int l = (int)(i >> 12), st = (int)(i >> 6) & 63, ln = (int)i & 63; float w[8], lo[8];
#pragma unroll
            for (int j = 0; j < 8; ++j) w[j] = wr[((size_t)l * DM + 16 * st + 8 * (ln >> 5) + j) * NE + (ln & 31)];
            u32x4 h; h.x = cvt_pk_bf16(w[0], w[1]); h.y = cvt_pk_bf16(w[2], w[3]); h.z = cvt_pk_bf16(w[4], w[5]); h.w = cvt_pk_bf16(w[6], w[7]);
            lo[0] = w[0] - bf_lo(h.x); lo[1] = w[1] - bf_hi(h.x); lo[2] = w[2] - bf_lo(h.y); lo[3] = w[3] - bf_hi(h.y); lo[4] = w[4] - bf_lo(h.z); lo[5] = w[5] - bf_hi(h.z); lo[6] = w[6] - bf_lo(h.w); lo[7] = w[7] - bf_hi(h.w);
            u32x4 q; q.x = cvt_pk_bf16(lo[0], lo[1]); q.y = cvt_pk_bf16(lo[2], lo[3]); q.z = cvt_pk_bf16(lo[4], lo[5]); q.w = cvt_pk_bf16(lo[6], lo[7]);
            *(u32x4*)(WRH + i * 8) = h; *(u32x4*)(WRL + i * 8) = q; } }
      float* SPL = WSP(float, WS_SPL); const float* lam = INF(I_LRU_LAM);
      for (size_t i = gt; i < 2 * 1024; i += NT) { const double l = (double)lam[i]; SPL[i] = (float)(-8.0 * log1p(exp(-l))); } }
}

__device__ __forceinline__ void moe_table(const CAS Args& args, const Ctx& C0, int layer) {
    Ctx C = C0; C.tid = opaque_tid(); C.lane = C.tid & 63;
    const unsigned* cnt = WSP(unsigned, WS_CTL) + CW_CNT + 64 * layer;
    __syncthreads();
    if (C.tid < 32) C.misc[64 + C.tid] = (int)__hip_atomic_load(cnt + C.tid, __ATOMIC_RELAXED, __HIP_MEMORY_SCOPE_AGENT);
    __syncthreads();
    if (C.tid == 0) { int acc = 0; for (int e = 0; e < 32; ++e) { C.misc[16 + e] = acc; acc += (C.misc[64 + e] + 255) >> 8; } C.misc[16 + 32] = acc; }
    __syncthreads();
    { volatile LAS unsigned char* te = (volatile LAS unsigned char*)(C.lds + TILE_E_OFF);
      for (int mg = C.tid; mg < C.misc[48]; mg += NWAVES * 64) { int e = 0; for (int j = 1; j < 32; ++j) e += (C.misc[16 + j] <= mg) ? 1 : 0; te[mg] = (unsigned char)e; } }
    __syncthreads();
}

__device__ __forceinline__ void phase_ln_router(const CAS Args& args, const Ctx& C0, int layer) {
    const int cslot = layer + args.pad;
    Ctx C = C0; C.tid = opaque_tid(); C.lane = C.tid & 63;
    const bf16_t* Y = WSP(bf16_t, WS_Y); bf16_t* X1L = WSP(bf16_t, WS_X1); bf16_t* X1B = WSP(bf16_t, WS_X1B);
    const float* g1 = INF(I_LN1G) + layer * DM; const float* b1 = INF(I_LN1B) + layer * DM;
    const bf16_t* WRH = WSP(bf16_t, WS_WRH) + (size_t)layer * 64 * 64 * 8; const bf16_t* WRL = WSP(bf16_t, WS_WRL) + (size_t)layer * 64 * 64 * 8; const float* br = INF(I_MOE_BR) + layer * NE;
    unsigned* gcnt = WSP(unsigned, WS_CTL) + CW_CNT + 64 * cslot;
    int* lists = WSP(int, WS_LIST); int* slot = WSP(int, WS_SLOT); float* gate = WSP(float, WS_GATE);
    LAS float* part = (LAS float*)C.lds;
    volatile LAS int* lcnt = (volatile LAS int*)(C.lds + 69632);
    volatile LAS int* lbase = lcnt + 32;
    f32x4 gv[4], bv[4];
#pragma unroll
    for (int j = 0; j < 2; ++j) { gv[2 * j] = *(const f32x4*)(g1 + 8 * C.lane + 512 * j); gv[2 * j + 1] = *(const f32x4*)(g1 + 8 * C.lane + 512 * j + 4);
        bv[2 * j] = *(const f32x4*)(b1 + 8 * C.lane + 512 * j); bv[2 * j + 1] = *(const f32x4*)(b1 + 8 * C.lane + 512 * j + 4); }
    unsigned char* X1Q = args.ws + WS_X1Q; int sexp;
    { float ag = 0.f, ab = 0.f;
#pragma unroll
      for (int j = 0; j < 4; ++j)
#pragma unroll
          for (int e = 0; e < 4; ++e) { ag = fmaxf(ag, fabsf(gv[j][e])); ab = fmaxf(ab, fabsf(bv[j][e])); }
#pragma unroll
      for (int o = 1; o < 64; o <<= 1) { ag = fmaxf(ag, __shfl_xor(ag, o)); ab = fmaxf(ab, __shfl_xor(ab, o)); }
      const float bound = 16.0f * ag + ab + 1e-20f;
      sexp = 134 - (int)((__float_as_uint(bound) >> 23) & 0xffu);
      sexp = sexp < -100 ? -100 : (sexp > 100 ? 100 : sexp);
      if (C.tid == 0) __hip_atomic_store(WSP(unsigned, WS_CTL) + CW_SA + layer, (unsigned)sexp, __ATOMIC_RELAXED, __HIP_MEMORY_SCOPE_AGENT); }
    const float qs = __uint_as_float((unsigned)(127 + sexp) << 23), qlo = KF(-448.f), qhi = KF(448.f);
    for (int chunk = C.vcu; chunk < T / 128; chunk += C.G) {
        const int row0 = chunk * 128;
        if (C.tid < 32) lcnt[C.tid] = 0;
#pragma unroll 1
        for (int i = 0; i < 16; ++i) { const size_t row = (size_t)row0 + C.wave * 16 + i;
            f32x4 v[4]; float s = 0.f;
#pragma unroll
            for (int j = 0; j < 2; ++j) { const u32x4 w = *(const u32x4*)(Y + row * DM + 8 * C.lane + 512 * j); v[2 * j] = pg8::bf4_lo(w); v[2 * j + 1] = pg8::bf4_hi(w); }
#pragma unroll
            for (int j = 0; j < 4; ++j) s += (v[j][0] + v[j][1]) + (v[j][2] + v[j][3]);
            const float mean = wave_sum(s) * (1.f / DM); float s2 = 0.f;
#pragma unroll
            for (int j = 0; j < 4; ++j) { v[j] = v[j] - mean; s2 += (v[j][0] * v[j][0] + v[j][1] * v[j][1]) + (v[j][2] * v[j][2] + v[j][3] * v[j][3]); }
            const float rstd = 1.f / sqrtf(wave_sum(s2) * (1.f / DM) + KF(LN_EPS));
#pragma unroll
            for (int j = 0; j < 4; ++j) v[j] = v[j] * rstd * gv[j] + bv[j];
#pragma unroll
            for (int j = 0; j < 2; ++j) { const u32x4 hw = pack8(v[2 * j], v[2 * j + 1]);
                *(u32x4*)(X1B + row * DM + 8 * C.lane + 512 * j) = hw;
                *(u32x4*)(X1L + row * DM + 8 * C.lane + 512 * j) = pack8(v[2 * j] - pg8::bf4_lo(hw), v[2 * j + 1] - pg8::bf4_hi(hw));
                const f32x4 q0 = v[2 * j] * qs, q1 = v[2 * j + 1] * qs;
                int w0 = __builtin_amdgcn_cvt_pk_fp8_f32(fminf(fmaxf(q0[0], qlo), qhi), fminf(fmaxf(q0[1], qlo), qhi), 0, false); w0 = __builtin_amdgcn_cvt_pk_fp8_f32(fminf(fmaxf(q0[2], qlo), qhi), fminf(fmaxf(q0[3], qlo), qhi), w0, true);
                int w1 = __builtin_amdgcn_cvt_pk_fp8_f32(fminf(fmaxf(q1[0], qlo), qhi), fminf(fmaxf(q1[1], qlo), qhi), 0, false); w1 = __builtin_amdgcn_cvt_pk_fp8_f32(fminf(fmaxf(q1[2], qlo), qhi), fminf(fmaxf(q1[3], qlo), qhi), w1, true);
                *(u32x2*)(X1Q + row * DM + 8 * C.lane + 512 * j) = (u32x2){(unsigned)w0, (unsigned)w1}; } }
        asm volatile("s_waitcnt vmcnt(0)" ::: "memory");
        __syncthreads();
        { const int grp = C.wave >> 1, kh = C.wave & 1, r32 = C.lane & 31, hi = C.lane >> 5;
          const bf16_t* ah = X1B + ((size_t)row0 + grp * 32 + r32) * DM + kh * 512 + hi * 8; const bf16_t* al = X1L + ((size_t)row0 + grp * 32 + r32) * DM + kh * 512 + hi * 8;
          const bf16_t* bh = WRH + ((size_t)kh * 32 * 64 + C.lane) * 8; const bf16_t* bl = WRL + ((size_t)kh * 32 * 64 + C.lane) * 8;
          f32x16 acc = {};
#pragma unroll 4
          for (int st = 0; st < 32; ++st) { const bf16x8 xh = *(const bf16x8*)(ah + st * 16), xl = *(const bf16x8*)(al + st * 16), wh = *(const bf16x8*)(bh + (size_t)st * 512), wl = *(const bf16x8*)(bl + (size_t)st * 512);
              acc = __builtin_amdgcn_mfma_f32_32x32x16_bf16(xh, wh, acc, 0, 0, 0);
              acc = __builtin_amdgcn_mfma_f32_32x32x16_bf16(xl, wh, acc, 0, 0, 0);
              acc = __builtin_amdgcn_mfma_f32_32x32x16_bf16(xh, wl, acc, 0, 0, 0); }
          LAS float* pp = part + (grp * 2 + kh) * 32 * 33 + r32;
#pragma unroll
          for (int r = 0; r < 16; ++r) pp[((r & 3) + 8 * (r >> 2) + 4 * hi) * 33] = acc[r]; }
        __syncthreads();
        int te[4] = {0, 0, 0, 0}, lp[4] = {0, 0, 0, 0}; float tg[4] = {0.f, 0.f, 0.f, 0.f};
        if (C.tid < 128) { const int grp = C.tid >> 5, ln = C.tid & 31; float lg[32];
#pragma unroll
            for (int e = 0; e < 32; ++e) lg[e] = br[e] + (part[((grp * 2 + 0) * 32 + ln) * 33 + e] + part[((grp * 2 + 1) * 32 + ln) * 33 + e]);
            float tv[4]; const float kninf = KF(-__builtin_inff());
#pragma unroll
            for (int k = 0; k < 4; ++k) { float best = lg[0]; int bi = 0;
#pragma unroll
                for (int e = 1; e < 32; ++e) { const bool gt = lg[e] > best; best = gt ? lg[e] : best; bi = gt ? e : bi; }
                te[k] = bi; tv[k] = best;
#pragma unroll
                for (int e = 0; e < 32; ++e) lg[e] = (e == bi) ? kninf : lg[e]; }
            float den = 0.f;
#pragma unroll
            for (int k = 0; k < 4; ++k) { tg[k] = __expf(tv[k] - tv[0]); den += tg[k]; }
            const float rden = 1.0f / den;
#pragma unroll
            for (int k = 0; k < 4; ++k) { tg[k] *= rden; lp[k] = __hip_atomic_fetch_add((LAS int*)&lcnt[te[k]], 1, __ATOMIC_RELAXED, __HIP_MEMORY_SCOPE_WORKGROUP); } }
        __syncthreads();
        if (C.tid < 32) lbase[C.tid] = (int)__hip_atomic_fetch_add(gcnt + C.tid, (unsigned)lcnt[C.tid], __ATOMIC_RELAXED, __HIP_MEMORY_SCOPE_AGENT);
        __syncthreads();
        if (C.tid < 128) { const int tok = row0 + C.tid;
#pragma unroll
            for (int k = 0; k < 4; ++k) { const int pos = lbase[te[k]] + lp[k]; lists[(size_t)te[k] * T + pos] = tok; slot[tok * 4 + k] = te[k] * T + pos; gate[tok * 4 + k] = tg[k]; } }
        __syncthreads();
    }
}

__device__ __forceinline__ void phase_combine_ln2(const CAS Args& args, const Ctx& C0, int layer) {
    Ctx C = C0; C.tid = opaque_tid(); C.lane = C.tid & 63;
    moe_table(args, C, layer);
    const bf16_t* X1B = WSP(bf16_t, WS_X1B); const unsigned char* YS = args.ws + WS_YS; const unsigned char* SY = args.ws + WS_SY; const int* slot = WSP(int, WS_SLOT); const float* gate = WSP(float, WS_GATE);
    bf16_t* X2B = WSP(bf16_t, WS_X2B);
    const float* g2 = INF(I_LN2G) + layer * DM; const float* b2 = INF(I_LN2B) + layer * DM;
    f32x4 gv[4], bv[4];
#pragma unroll
    for (int j = 0; j < 2; ++j) { gv[2 * j] = *(const f32x4*)(g2 + 8 * C.lane + 512 * j); gv[2 * j + 1] = *(const f32x4*)(g2 + 8 * C.lane + 512 * j + 4);
        bv[2 * j] = *(const f32x4*)(b2 + 8 * C.lane + 512 * j); bv[2 * j + 1] = *(const f32x4*)(b2 + 8 * C.lane + 512 * j + 4); }
    const int gw = C.vcu * NWAVES + C.wave, NGW = C.G * NWAVES;
    for (int row = gw; row < T; row += NGW) {
        f32x4 v[4];
#pragma unroll
        for (int j = 0; j < 2; ++j) { const u32x4 w = *(const u32x4*)(X1B + (size_t)row * DM + 8 * C.lane + 512 * j); v[2 * j] = pg8::bf4_lo(w) * ALPHA; v[2 * j + 1] = pg8::bf4_hi(w) * ALPHA; }
#pragma unroll
        for (int k = 0; k < 4; ++k) { const int sv = slot[row * 4 + k]; const float g = gate[row * 4 + k]; const int e = sv >> 15, pos = sv & (T - 1);
            const size_t prow = (size_t)C.misc[16 + e] * 256 + pos;
#pragma unroll
            for (int j = 0; j < 2; ++j) { const u32x2 w = *(const u32x2*)(YS + prow * DM + 8 * C.lane + 512 * j); const unsigned eb = SY[prow * 32 + (C.lane >> 2) + 16 * j];
                const float gs = g * __uint_as_float(eb << 23);
                const f32x2 a = __builtin_amdgcn_cvt_pk_f32_fp8((int)w.x, false), b = __builtin_amdgcn_cvt_pk_f32_fp8((int)w.x, true), c = __builtin_amdgcn_cvt_pk_f32_fp8((int)w.y, false), d = __builtin_amdgcn_cvt_pk_f32_fp8((int)w.y, true);
                v[2 * j] += (f32x4){a[0], a[1], b[0], b[1]} * gs; v[2 * j + 1] += (f32x4){c[0], c[1], d[0], d[1]} * gs; } }
        float s = 0.f;
#pragma unroll
        for (int j = 0; j < 4; ++j) s += (v[j][0] + v[j][1]) + (v[j][2] + v[j][3]);
        const float mean = wave_sum(s) * (1.f / DM); float s2 = 0.f;
#pragma unroll
        for (int j = 0; j < 4; ++j) { v[j] = v[j] - mean; s2 += (v[j][0] * v[j][0] + v[j][1] * v[j][1]) + (v[j][2] * v[j][2] + v[j][3] * v[j][3]); }
        const float rstd = 1.f / sqrtf(wave_sum(s2) * (1.f / DM) + KF(LN_EPS));
#pragma unroll
        for (int j = 0; j < 4; ++j) v[j] = v[j] * rstd * gv[j] + bv[j];
#pragma unroll
        for (int j = 0; j < 2; ++j) *(u32x4*)(X2B + (size_t)row * DM + 8 * C.lane + 512 * j) = pack8(v[2 * j], v[2 * j + 1]);
    }
}

__device__ __forceinline__ void phase_conv(const CAS Args& args, const Ctx& C0, int j) {
    Ctx C = C0; C.tid = opaque_tid(); C.lane = C.tid & 63;
    const bf16_t* U = WSP(bf16_t, WS_U); bf16_t* UC = WSP(bf16_t, WS_UC);
    const float* cw = INF(I_LRU_CW) + (size_t)j * 4 * DM; const float* cb = INF(I_LRU_CB) + (size_t)j * DM;
    const int c8 = (C.tid & 127) * 8, rsub = C.tid >> 7;
    float w[4][8], bb[8];
#pragma unroll
    for (int q = 0; q < 4; ++q)
#pragma unroll
        for (int e = 0; e < 8; ++e) w[q][e] = cw[q * DM + c8 + e];
#pragma unroll
    for (int e = 0; e < 8; ++e) bb[e] = cb[c8 + e];
    for (int chunk = C.vcu; chunk < T / 128; chunk += C.G) {
        const int r0 = chunk * 128 + rsub * 32;
        u32x4 h0, h1, h2;
        const u32x4 z = {0u, 0u, 0u, 0u};
        const int s0 = r0 & (SEQ - 1);
        h0 = s0 >= 3 ? *(const u32x4*)(U + (size_t)(r0 - 3) * DM + c8) : z; h1 = s0 >= 2 ? *(const u32x4*)(U + (size_t)(r0 - 2) * DM + c8) : z; h2 = s0 >= 1 ? *(const u32x4*)(U + (size_t)(r0 - 1) * DM + c8) : z;
#pragma unroll 4
        for (int i = 0; i < 32; ++i) { const u32x4 h3 = *(const u32x4*)(U + (size_t)(r0 + i) * DM + c8);
            float o[8];
#pragma unroll
            for (int q = 0; q < 4; ++q) { const unsigned a = h0[q], b = h1[q], c = h2[q], d = h3[q];
                o[2 * q] = bb[2 * q] + w[0][2 * q] * bf_lo(a) + w[1][2 * q] * bf_lo(b) + w[2][2 * q] * bf_lo(c) + w[3][2 * q] * bf_lo(d);
                o[2 * q + 1] = bb[2 * q + 1] + w[0][2 * q + 1] * bf_hi(a) + w[1][2 * q + 1] * bf_hi(b) + w[2][2 * q + 1] * bf_hi(c) + w[3][2 * q + 1] * bf_hi(d); }
            u32x4 ow; ow.x = cvt_pk_bf16(o[0], o[1]); ow.y = cvt_pk_bf16(o[2], o[3]); ow.z = cvt_pk_bf16(o[4], o[5]); ow.w = cvt_pk_bf16(o[6], o[7]);
            *(u32x4*)(UC + (size_t)(r0 + i) * DM + c8) = ow; h0 = h1; h1 = h2; h2 = h3; }
    }
}
__device__ __forceinline__ void phase_scan1(const CAS Args& args, const Ctx& C0) {
    Ctx C = C0; C.tid = opaque_tid(); C.lane = C.tid & 63;
    const bf16_t* LA = WSP(bf16_t, WS_AA); const bf16_t* BB = WSP(bf16_t, WS_BB); float* CA = WSP(float, WS_CA); float* CH = WSP(float, WS_CH);
    const int c2 = C.tid * 2;
    for (int item = C.vcu; item < NBATCH * 64; item += C.G) {
        const size_t r0 = (size_t)item * 64; float h0 = 0.f, h1 = 0.f, l0 = 0.f, l1 = 0.f;
#pragma unroll 8
        for (int s = 0; s < 64; ++s) { const unsigned aw = *(const unsigned*)(LA + (r0 + s) * DM + c2), bw = *(const unsigned*)(BB + (r0 + s) * DM + c2);
            const float la0 = bf_lo(aw), la1 = bf_hi(aw);
            h0 = __builtin_amdgcn_exp2f(la0) * h0 + bf_lo(bw); h1 = __builtin_amdgcn_exp2f(la1) * h1 + bf_hi(bw); l0 += la0; l1 += la1; }
        *(f32x2*)(CA + (size_t)item * DM + c2) = (f32x2){__builtin_amdgcn_exp2f(l0), __builtin_amdgcn_exp2f(l1)}; *(f32x2*)(CH + (size_t)item * DM + c2) = (f32x2){h0, h1};
    }
}
__device__ __forceinline__ void phase_scan2(const CAS Args& args, const Ctx& C0) {
    Ctx C = C0; C.tid = opaque_tid(); C.lane = C.tid & 63;
    const bf16_t* LA = WSP(bf16_t, WS_AA); const bf16_t* BB = WSP(bf16_t, WS_BB); const float* CA = WSP(float, WS_CA); const float* CH = WSP(float, WS_CH);
    const bf16_t* GG = WSP(bf16_t, WS_GG); bf16_t* YL = WSP(bf16_t, WS_O);
    const int c2 = C.tid * 2;
    for (int item = C.vcu; item < NBATCH * 64; item += C.G) {
        const int b = item >> 6, ch = item & 63; float h0 = 0.f, h1 = 0.f;
        for (int jx = 0; jx < ch; ++jx) { const f32x2 a = *(const f32x2*)(CA + (size_t)(b * 64 + jx) * DM + c2), e = *(const f32x2*)(CH + (size_t)(b * 64 + jx) * DM + c2);
            h0 = a[0] * h0 + e[0]; h1 = a[1] * h1 + e[1]; }
        const size_t r0 = (size_t)item * 64;
#pragma unroll 8
        for (int s = 0; s < 64; ++s) { const unsigned aw = *(const unsigned*)(LA + (r0 + s) * DM + c2), bw = *(const unsigned*)(BB + (r0 + s) * DM + c2), g = *(const unsigned*)(GG + (r0 + s) * DM + c2);
            h0 = __builtin_amdgcn_exp2f(bf_lo(aw)) * h0 + bf_lo(bw); h1 = __builtin_amdgcn_exp2f(bf_hi(aw)) * h1 + bf_hi(bw);
            *(unsigned*)(YL + (r0 + s) * DM + c2) = cvt_pk_bf16(bf_lo(g) * h0, bf_hi(g) * h1); }
    }
}

#if PROBE_T
typedef int v8i_t __attribute__((ext_vector_type(8)));
__device__ __forceinline__ unsigned fp8_of_int(int v) { const unsigned char t[4] = {0x00, 0x38, 0x40, 0x44}; const int a = v < 0 ? -v : v; return (unsigned)t[a] | (v < 0 ? 0x80u : 0u); }
__device__ __forceinline__ int tA(int i, int k) { return ((i * 3 + k * 5) % 7) - 3; }
__device__ __forceinline__ int tB(int k, int j) { return ((k * 2 + j * 7) % 5) - 2; }
__device__ __forceinline__ void mfma_fp8_selftest(unsigned* flagw) {
    const int l = threadIdx.x & 63, r = l & 15, q = l >> 4;
    v8i_t A, B;
#pragma unroll
    for (int d = 0; d < 8; ++d) { unsigned wa = 0, wb = 0;
#pragma unroll
        for (int b = 0; b < 4; ++b) { const int k = 32 * q + 4 * d + b; wa |= fp8_of_int(tA(r, k)) << (8 * b); wb |= fp8_of_int(tB(k, r)) << (8 * b); }
        A[d] = (int)wa; B[d] = (int)wb; }
    const f32x4 z = {0.f, 0.f, 0.f, 0.f};
    const int U = 0x7f7f7f7f;
    const int saq = (127 + q) * 0x01010101;
    const int sab = (q == 0) ? (int)0x8281807fu : U;
    const f32x4 m2 = __builtin_amdgcn_mfma_scale_f32_16x16x128_f8f6f4(A, B, z, 0, 0, 0, saq, 0, U);
    const f32x4 m5 = __builtin_amdgcn_mfma_scale_f32_16x16x128_f8f6f4(A, B, z, 0, 0, 0, sab, 0, U);
    bool k1 = true, k2 = true, k3 = true, k4 = true;
#pragma unroll
    for (int e = 0; e < 4; ++e) { const int i = 4 * q + e, j = r; float eb = 0.f, e0 = 0.f, ec = 0.f, ed = 0.f;
        for (int kq = 0; kq < 4; ++kq) for (int hh = 0; hh < 2; ++hh) { float sh = 0.f; for (int k = 32 * kq + 16 * hh; k < 32 * kq + 16 * hh + 16; ++k) sh += (float)(tA(i, k) * tB(k, j));
            const int xb = hh == 0 ? (kq >> 1) : 2 + (kq >> 1);
            eb += sh * (float)(1 << xb); e0 += sh; ec += sh * (float)(1 << kq); ed += sh * (float)(1 << xb); }
        k1 = k1 && (m2[e] == eb); k2 = k2 && (m2[e] == e0); k3 = k3 && (m5[e] == ec); k4 = k4 && (m5[e] == ed); }
    const bool b1 = __all(k1), b2 = __all(k2), b3 = __all(k3), b4 = __all(k4);
    if (l == 0) *flagw = (b1 ? 1u : 0u) | (b2 ? 2u : 0u) | (b3 ? 4u : 0u) | (b4 ? 8u : 0u);
}
#endif
constexpr int PH_PER_LAYER = 12, PH_TOTAL = 2 + PH_PER_LAYER * DEPTH;
__global__ void __launch_bounds__(NWAVES * 64, 2) fwd_kernel(Args args_kernarg) {
    (void)args_kernarg;
    ArgsP const argp = (ArgsP)__builtin_amdgcn_kernarg_segment_ptr();
    const CAS Args& args0 = *argp;
    extern __shared__ __attribute__((aligned(16))) unsigned char lds_raw[];
    Ctx C_;
    C_.lds = (LAS unsigned char*)lds_raw; C_.misc = (volatile LAS int*)(C_.lds + MISC_OFF);
    C_.tid = threadIdx.x; C_.lane = C_.tid & 63; C_.wave = __builtin_amdgcn_readfirstlane(C_.tid >> 6);
    C_.bid = (int)blockIdx.x; C_.G = gridDim.x; { const int bx = blockIdx.x; C_.vcu = (C_.G % 8 == 0) ? (bx % 8) * (C_.G / 8) + bx / 8 : bx; }
    for (int u = C_.tid; u < 128; u += NWAVES * 64) C_.misc[u] = 0;
    __syncthreads();
    XcdBarrier bar = xcd_barrier_post((unsigned*)(args0.ws + WS_CTL) + CW_BAR + args0.li * XCD_BAR_WORDS, (volatile LAS unsigned*)C_.misc);
    const int lo = args0.ph_lo, hi = args0.ph_hi;
#define IN(k) (lo <= (k) && (k) < hi)
#define PH_END(k) do { if ((k) + 1 < hi) xcd_barrier(bar); } while (0)

    if (SEL(0) && IN(0)) { const CAS Args& args = fresh_args(argp); const Ctx C = fresh_ctx(C_); const int cid = C.bid; phase_prologue(args, C); PH_END(0); }
    if (SEL(1) && IN(1)) { const CAS Args& args = fresh_args(argp); const Ctx C = fresh_ctx(C_); const int cid = C.bid;
        pg8::DenseSched S; S.init(WSP(bf16_t, WS_PB), WSP(bf16_t, WS_W_PLE + OFF_PLE_WP), PLED, PLED, DEPTH * T, DM, C.G, cid); S.bpm_shift = 7; S.bbatch = W_PLE_STRIDE;
        pg8::EpiPP E{WSP(bf16_t, WS_PP)};
        pg8::gemm_phase<pg8::EpiPP, pg8::DenseSched, false>(C.lds, PLED / 64, PLED * 2, PLED * 2, S, E);
        PH_END(1);
    }
    for (int layer = 0; layer < DEPTH; ++layer) {
        const int base = 2 + PH_PER_LAYER * layer, j = layer >> 1;
        if ((layer & 1) == 0) {
            if (SEL(2) && IN(base + 0)) { const CAS Args& args = fresh_args(argp); const Ctx C = fresh_ctx(C_); const int cid = C.bid; const unsigned char* wm = args.ws + WS_W_MLA + (size_t)j * W_MLA_STRIDE;
                pg8::DenseSched S; S.init(WSP(bf16_t, WS_XB), wm + OFF_MLA_WIN, DM, DM, T, 1280, C.G, cid);
                pg8::EpiLat E{WSP(bf16_t, WS_LAT), WSP(float, WS_SSQ), WSP(bf16_t, WS_KR), WSP(float, WS_CS), WSP(float, WS_SN)};
                pg8::gemm_phase<pg8::EpiLat, pg8::DenseSched, false>(C.lds, DM / 64, DM * 2, DM * 2, S, E);
                PH_END(base + 0);
            }
            if (SEL(3) && IN(base + 1)) { const CAS Args& args = fresh_args(argp); const Ctx C = fresh_ctx(C_); const int cid = C.bid; const unsigned char* wm = args.ws + WS_W_MLA + (size_t)j * W_MLA_STRIDE;
                { pg8::DenseSched S; S.init(WSP(bf16_t, WS_LAT), wm + OFF_MLA_WUQ, DM, QL, T, 1536, C.G, cid);
                  pg8::EpiQ E{WSP(bf16_t, WS_Q), WSP(float, WS_SSQ), WSP(float, WS_CS), WSP(float, WS_SN)};
                  pg8::gemm_phase<pg8::EpiQ, pg8::DenseSched, false>(C.lds, QL / 64, DM * 2, QL * 2, S, E); }
                { pg8::DenseSched S; S.init(WSP(bf16_t, WS_LAT) + QL, wm + OFF_MLA_WUKV, DM, KVL, T, 2048, C.G, cid);
                  pg8::EpiKV E{WSP(bf16_t, WS_KN), WSP(bf16_t, WS_V), WSP(float, WS_SSQ)};
                  pg8::gemm_phase<pg8::EpiKV, pg8::DenseSched, false>(C.lds, KVL / 64, DM * 2, KVL * 2, S, E); }
                PH_END(base + 1);
            }
            if (SEL(4) && IN(base + 2)) { const CAS Args& args = fresh_args(argp); const Ctx C = fresh_ctx(C_); const int cid = C.bid;
                for (int it = C.vcu; it < NBATCH * NH * 8; it += C.G) { const int bh = it >> 3, pr = it & 7;
                    att::attn_block(bh >> 3, bh & 7, pr, WSP(bf16_t, WS_Q), WSP(bf16_t, WS_KN), WSP(bf16_t, WS_KR), WSP(bf16_t, WS_V), WSP(bf16_t, WS_O), (LAS char*)C.lds, PROBE_T ? (unsigned long long*)(args.ws + WS_CTL + 8192) : nullptr);
                    att::attn_block(bh >> 3, bh & 7, 15 - pr, WSP(bf16_t, WS_Q), WSP(bf16_t, WS_KN), WSP(bf16_t, WS_KR), WSP(bf16_t, WS_V), WSP(bf16_t, WS_O), (LAS char*)C.lds, PROBE_T ? (unsigned long long*)(args.ws + WS_CTL + 8192) : nullptr); }
                PH_END(base + 2);
            }
        } else {
            if (SEL(5) && IN(base + 0)) { const CAS Args& args = fresh_args(argp); const Ctx C = fresh_ctx(C_); const int cid = C.bid; const unsigned char* wl = args.ws + WS_W_LRU + (size_t)j * W_LRU_STRIDE;
                pg8::DenseSched S; S.init(WSP(bf16_t, WS_XB), wl + OFF_LRU_WIN, DM, DM, T, 2048, C.G, cid);
                pg8::EpiGU E{WSP(bf16_t, WS_GG), WSP(bf16_t, WS_U)};
                pg8::gemm_phase<pg8::EpiGU, pg8::DenseSched, false>(C.lds, DM / 64, DM * 2, DM * 2, S, E);
                PH_END(base + 0);
            }
            if (SEL(6) && IN(base + 1)) { const CAS Args& args = fresh_args(argp); const Ctx C = fresh_ctx(C_); const int cid = C.bid; phase_conv(args, C, j); PH_END(base + 1); }
            if (SEL(7) && IN(base + 2)) { const CAS Args& args = fresh_args(argp); const Ctx C = fresh_ctx(C_); const int cid = C.bid; const unsigned char* wl = args.ws + WS_W_LRU + (size_t)j * W_LRU_STRIDE;
                pg8::DenseSched S; S.init(WSP(bf16_t, WS_UC), wl + OFF_LRU_WAX, DM, 256, T, 2048, C.G, cid); S.apn_shift = 1; S.akbytes = 512;
                pg8::EpiAB E{WSP(bf16_t, WS_AA), WSP(bf16_t, WS_BB), WSP(bf16_t, WS_UC), INF(I_LRU_BA) + j * DM, INF(I_LRU_BX) + j * DM, WSP(float, WS_SPL) + j * DM};
                pg8::gemm_phase<pg8::EpiAB, pg8::DenseSched, false>(C.lds, 4, DM * 2, 512, S, E);
                PH_END(base + 2);
            }
            if (SEL(8) && IN(base + 3)) { const CAS Args& args = fresh_args(argp); const Ctx C = fresh_ctx(C_); const int cid = C.bid; phase_scan1(args, C); PH_END(base + 3); }
            if (SEL(9) && IN(base + 4)) { const CAS Args& args = fresh_args(argp); const Ctx C = fresh_ctx(C_); const int cid = C.bid; phase_scan2(args, C); PH_END(base + 4); }
        }
        if (SEL(10) && IN(base + 5)) { const CAS Args& args = fresh_args(argp); const Ctx C = fresh_ctx(C_); const int cid = C.bid;
            const unsigned char* wo = (layer & 1) ? args.ws + WS_W_LRU + (size_t)j * W_LRU_STRIDE + OFF_LRU_WOUT : args.ws + WS_W_MLA + (size_t)j * W_MLA_STRIDE + OFF_MLA_WO;
            pg8::DenseSched S; S.init(WSP(bf16_t, WS_O), wo, DM, DM, T, DM, C.G, cid);
            pg8::EpiRes E{WSP(bf16_t, WS_XB), WSP(bf16_t, WS_Y)};
            pg8::gemm_phase<pg8::EpiRes, pg8::DenseSched, false>(C.lds, DM / 64, DM * 2, DM * 2, S, E);
            PH_END(base + 5);
        }
        if (SEL(11) && IN(base + 6)) { const CAS Args& args = fresh_args(argp); const Ctx C = fresh_ctx(C_); const int cid = C.bid; phase_ln_router(args, C, layer); PH_END(base + 6); }
        if (SEL(12) && IN(base + 7)) { const CAS Args& args = fresh_args(argp); const Ctx C = fresh_ctx(C_); const int cid = C.bid;
            moe_table(args, C, layer);
            pg8::MoeSched S{(const char*)(args.ws + WS_X1Q), (const char*)(args.ws + WS_W_UP + (size_t)layer * NE * 2048 * 1024), (size_t)2048 * 1024, (const char*)(args.ws + WS_SW + (size_t)layer * NE * 65536), DM, DM, 8, WSP(int, WS_LIST), C.misc + 16, (volatile LAS const unsigned char*)(C.lds + TILE_E_OFF), C.G, cid, true, nullptr};
            const int sae = 127 - (int)__hip_atomic_load(WSP(unsigned, WS_CTL) + CW_SA + layer, __ATOMIC_RELAXED, __HIP_MEMORY_SCOPE_AGENT);
            pg8::EpiUp E{args.ws + WS_H, args.ws + WS_SH, INF(I_MOE_BUP) + (size_t)layer * NE * 2048};
            pg8::gemm_phase<pg8::EpiUp, pg8::MoeSched, true, 1>(C.lds, DM / 128, DM, DM, S, E, PROBE_T ? (unsigned long long*)(args.ws + WS_CTL + 8192) : nullptr, sae * 0x01010101);
            PH_END(base + 7);
        }
        if (SEL(13) && IN(base + 8)) { const CAS Args& args = fresh_args(argp); const Ctx C = fresh_ctx(C_); const int cid = C.bid;
            moe_table(args, C, layer);
            pg8::MoeSched S{(const char*)(args.ws + WS_H), (const char*)(args.ws + WS_W_DN + (size_t)layer * NE * 1024 * 1024), (size_t)1024 * 1024, (const char*)(args.ws + WS_SWD + (size_t)layer * NE * 16384), DFF, DFF, 4, WSP(int, WS_LIST), C.misc + 16, (volatile LAS const unsigned char*)(C.lds + TILE_E_OFF), C.G, cid, false, (const char*)(args.ws + WS_SH)};
            pg8::EpiDown E{args.ws + WS_YS, args.ws + WS_SY, INF(I_MOE_BDN) + (size_t)layer * NE * DM};
            pg8::gemm_phase<pg8::EpiDown, pg8::MoeSched, false, 2>(C.lds, DFF / 128, DFF, DFF, S, E);
            PH_END(base + 8);
        }
        if (SEL(14) && IN(base + 9)) { const CAS Args& args = fresh_args(argp); const Ctx C = fresh_ctx(C_); const int cid = C.bid; phase_combine_ln2(args, C, layer); PH_END(base + 9); }
        if (SEL(15) && IN(base + 10)) { const CAS Args& args = fresh_args(argp); const Ctx C = fresh_ctx(C_); const int cid = C.bid;
            pg8::DenseSched S; S.init(WSP(bf16_t, WS_X2B), args.ws + WS_W_PLE + (size_t)layer * W_PLE_STRIDE + OFF_PLE_WG, DM, DM, T, DM, C.G, cid);
            pg8::EpiPle E{WSP(bf16_t, WS_X2B), WSP(bf16_t, WS_PP) + (size_t)layer * T * DM, layer == DEPTH - 1 ? args.out : (float*)nullptr, WSP(bf16_t, WS_XB)};
            pg8::gemm_phase<pg8::EpiPle, pg8::DenseSched, false>(C.lds, DM / 64, DM * 2, DM * 2, S, E);
            if (layer + 1 < DEPTH) PH_END(base + 10);
        }
    }
#if PROBE_T
    if (PROBE_T == 20 && blockIdx.x == 0 && threadIdx.x < 64) { const CAS Args& args = fresh_args(argp); mfma_fp8_selftest((unsigned*)(args.ws + WS_CTL + 8192 + 256)); }
    { xcd_barrier(bar); const CAS Args& args = fresh_args(argp);
      const unsigned long long* pw = (const unsigned long long*)(args.ws + WS_CTL + 8192);
      const double pk = (double)__hip_atomic_load(pw + 0, __ATOMIC_RELAXED, __HIP_MEMORY_SCOPE_AGENT), pe = (double)__hip_atomic_load(pw + 1, __ATOMIC_RELAXED, __HIP_MEMORY_SCOPE_AGENT),
                   pn = (double)__hip_atomic_load(pw + 2, __ATOMIC_RELAXED, __HIP_MEMORY_SCOPE_AGENT), pt = (double)__hip_atomic_load(pw + 3, __ATOMIC_RELAXED, __HIP_MEMORY_SCOPE_AGENT);
      float c = 100.f;
      if (PROBE_T == 2) c = (float)(pk / (pn * 16.0) / 10.0);
      if (PROBE_T == 3) c = (float)(pe / pn / 100.0);
      if (PROBE_T == 4) c = (float)((pt - pk - pe) / pn / 100.0);
      if (PROBE_T == 5) c = (float)(pn);
      if (PROBE_T >= 10) { double q[7]; for (int i = 0; i < 7; ++i) q[i] = (double)__hip_atomic_load(pw + 8 + i, __ATOMIC_RELAXED, __HIP_MEMORY_SCOPE_AGENT);
          if (PROBE_T == 10) c = (float)(q[6] / q[5] / 10.0);
          if (PROBE_T == 11) c = (float)(q[0] / q[5] / 10.0);
          if (PROBE_T == 12) c = (float)(q[1] / q[5] / 10.0);
          if (PROBE_T == 13) c = (float)(q[2] / q[5] / 10.0);
          if (PROBE_T == 14) c = (float)(q[3] / q[5] / 10.0);
          if (PROBE_T == 15) c = (float)(q[4] / q[5] / 10.0); }
      if (PROBE_T >= 2 && PROBE_T < 20) c = exp2f(floorf(log2f(c) * 8.0f + PROBE_SHIFT) * 0.125f);
      if (PROBE_T == 20) { const unsigned fl = __hip_atomic_load((const unsigned*)(args.ws + WS_CTL + 8192 + 256), __ATOMIC_RELAXED, __HIP_MEMORY_SCOPE_AGENT); c = 100.f + 10.f * (float)fl; }
      for (size_t i = (size_t)blockIdx.x * 512 + threadIdx.x; i < (size_t)T * DM; i += (size_t)gridDim.x * 512) args.out[i] = c; }
#endif
#undef IN
#undef PH_END
}

extern "C" void kernel_launch(void* const* d_in, const int* in_sizes, int n_in, void* d_out, int out_size, void* d_ws, size_t ws_size, hipStream_t stream) {
    static int grid = 0;
    if (grid == 0) {
        if (n_in != 30 || in_sizes[0] != T * DM || out_size != T * DM || ws_size < WS_END) { fprintf(stderr, "kernel_launch: unexpected shapes (n_in %d, in0 %d, out %d, ws %zu)\n", n_in, n_in > 0 ? in_sizes[0] : -1, out_size, ws_size); grid = -1; return; }
        int dev = 0, cus = 0, per_cu = 0;
        if (hipGetDevice(&dev) != hipSuccess || hipDeviceGetAttribute(&cus, hipDeviceAttributeMultiprocessorCount, dev) != hipSuccess) { grid = -1; return; }
        if (hipFuncSetAttribute((const void*)fwd_kernel, hipFuncAttributeMaxDynamicSharedMemorySize, LDS_BYTES) != hipSuccess) { fprintf(stderr, "kernel_launch: hipFuncSetAttribute failed\n"); grid = -1; return; }
        if (hipOccupancyMaxActiveBlocksPerMultiprocessor(&per_cu, (const void*)fwd_kernel, NWAVES * 64, LDS_BYTES) != hipSuccess || per_cu < 1) fprintf(stderr, "kernel_launch: occupancy query reports %d\n", per_cu);
        (void)hipGetLastError();
        grid = cus;
    }
    if (grid < 0) return;
    if (hipMemsetAsync((char*)d_ws + WS_CTL, 0, CTL_ZERO_BYTES, stream) != hipSuccess) return;
    Args a{};
    for (int i = 0; i < 30; ++i) a.in[i] = d_in[i];
    a.out = (float*)d_out; a.ws = (unsigned char*)d_ws; a.pad = 0;
#if MK_ONE_LAUNCH
    a.ph_lo = 0; a.ph_hi = PH_TOTAL; a.li = 0;
    hipLaunchKernelGGL(fwd_kernel, dim3(grid), dim3(NWAVES * 64), LDS_BYTES, stream, a);
#else
    int li = 0;
    for (int ph = 0; ph < PH_TOTAL; ++ph) {
        if (ph >= 2) { const int l = (ph - 2) / PH_PER_LAYER, k = (ph - 2) % PH_PER_LAYER; if (k == 11) continue; if ((l & 1) == 0 && (k == 3 || k == 4)) continue; }
        int site = ph;
        if (ph >= 2) { const int l = (ph - 2) / PH_PER_LAYER, k = (ph - 2) % PH_PER_LAYER; static const int mla[11] = {2, 3, 4, -1, -1, 10, 11, 12, 13, 14, 15}, lru[11] = {5, 6, 7, 8, 9, 10, 11, 12, 13, 14, 15}; site = (l & 1) ? lru[k] : mla[k]; }
        a.ph_lo = ph; a.ph_hi = ph + 1;
        if ((HOSTDUP >> site) & 1) { a.li = li++; a.pad = 4; hipLaunchKernelGGL(fwd_kernel, dim3(grid), dim3(NWAVES * 64), LDS_BYTES, stream, a); }
        a.li = li++; a.pad = 0;
        hipLaunchKernelGGL(fwd_kernel, dim3(grid), dim3(NWAVES * 64), LDS_BYTES, stream, a);
    }
#endif
}
```

```cpp
#include <hip/hip_runtime.h>
#include <hip/hip_bf16.h>
#include <cstdio>
#include <cstdint>

#ifndef PHSEL
#define PHSEL -1
#endif
#ifndef PHSKIP
#define PHSKIP -1
#endif
#define SEL(id) ((PHSEL < 0 || PHSEL == (id)) && PHSKIP != (id))
#ifndef PROBE_T
#define PROBE_T 0
#endif
#ifndef PROBE_SHIFT
#define PROBE_SHIFT 0.0f
#endif
#ifndef HOSTDUP
#define HOSTDUP 0
#endif
#ifndef MK_ONE_LAUNCH
#define MK_ONE_LAUNCH 1
#endif

constexpr int T = 32768, SEQ = 4096, NBATCH = 8, DM = 1024, DEPTH = 4;
constexpr int QL = 768, KVL = 256, ROPE = 64, LATD = 1088, NH = 8, DQK = 192, DV = 128;
constexpr int NE = 32, TOPK = 4, DFF = 1024, PLED = 256;
constexpr float ALPHA = 1.681792830507429f;
constexpr float LN_EPS = 1e-5f, RMS_EPS = 1e-6f;
constexpr float QSCALE = 1.4426950408889634f / 13.856406460551018f;
constexpr int NWAVES = 8;

constexpr size_t MiB = 1u << 20;
constexpr size_t WS_CTL = 0, CTL_ZERO_BYTES = 2 * MiB;
constexpr size_t WS_CS = 2 * MiB, WS_SN = 6 * MiB, WS_SPL = 10 * MiB;
constexpr size_t WS_WRH = WS_SPL + 65536, WS_WRL = WS_WRH + 262144;
constexpr size_t WS_RC = WS_SPL + 16384;
constexpr size_t WS_W_MLA = 12 * MiB, W_MLA_STRIDE = 8 * MiB;
constexpr size_t OFF_MLA_WIN = 0, OFF_MLA_WUQ = 2560 * 1024, OFF_MLA_WUKV = OFF_MLA_WUQ + 2304 * 1024, OFF_MLA_WO = OFF_MLA_WUKV + 1024 * 1024;
constexpr size_t WS_W_LRU = 28 * MiB, W_LRU_STRIDE = 8 * MiB;
constexpr size_t OFF_LRU_WIN = 0, OFF_LRU_WAX = 4 * MiB, OFF_LRU_WOUT = 5 * MiB;
constexpr size_t WS_W_PLE = 44 * MiB, W_PLE_STRIDE = 3 * MiB;
constexpr size_t OFF_PLE_WG = 0, OFF_PLE_WP = 2 * MiB;
constexpr size_t WS_W_UP = 56 * MiB;
constexpr size_t WS_W_DN = 568 * MiB;
constexpr size_t WS_XB = 824 * MiB, WS_PB = 888 * MiB, WS_PP = 952 * MiB;
constexpr size_t WS_Y = 1208 * MiB, WS_X1 = 1336 * MiB, WS_X1B = 1464 * MiB, WS_X2 = 1528 * MiB, WS_X2B = 1656 * MiB;
constexpr size_t WS_LAT = 1720 * MiB, WS_KR = 1784 * MiB, WS_SSQ = 1788 * MiB, WS_Q = 1790 * MiB, WS_KN = 1886 * MiB, WS_V = 1950 * MiB, WS_O = 2014 * MiB;
constexpr size_t WS_GG = 2078 * MiB, WS_U = 2142 * MiB, WS_UC = 2206 * MiB, WS_AA = 2270 * MiB, WS_BB = 2398 * MiB, WS_CA = 2526 * MiB, WS_CH = 2528 * MiB;
constexpr size_t WS_H = 2530 * MiB, WS_YS = 2802 * MiB, WS_LIST = 3074 * MiB, WS_SLOT = 3078 * MiB, WS_GATE = 3079 * MiB, WS_SW = 3080 * MiB  , WS_X1Q = 3088 * MiB  , WS_SH = 3120 * MiB  ,
                 WS_SWD = 3128 * MiB  , WS_SY = 3132 * MiB  , WS_END = 3140 * MiB;
constexpr int PADROWS = T * TOPK + NE * 256;
static_assert((size_t)PADROWS * DFF * 2 <= 272 * MiB, "H / YS size");
constexpr int CW_SA = 128;
constexpr int CW_CNT = 256;
constexpr int CW_BAR = 4096;

constexpr int RING_BYTES = 133120;
constexpr int TILE_E_OFF = 131072;
constexpr int SCL_OFF = RING_BYTES;
constexpr int MISC_OFF = SCL_OFF + 24576;
constexpr int LDS_BYTES = 163840;

#define GAS __attribute__((address_space(1)))
#define LAS __attribute__((address_space(3)))
#define CAS __attribute__((address_space(4)))
typedef unsigned short bf16_t;
typedef short bf16x8 __attribute__((ext_vector_type(8)));
typedef short s16x4 __attribute__((ext_vector_type(4)));
typedef float f32x2 __attribute__((ext_vector_type(2)));
typedef float f32x4 __attribute__((ext_vector_type(4)));
typedef float f32x16 __attribute__((ext_vector_type(16)));
typedef unsigned u32x2 __attribute__((ext_vector_type(2)));
typedef unsigned u32x4 __attribute__((ext_vector_type(4)));

__device__ __forceinline__ unsigned cvt_pk_bf16(float lo, float hi) { unsigned r; asm volatile("v_cvt_pk_bf16_f32 %0, %1, %2" : "=v"(r) : "v"(lo), "v"(hi)); return r; }
__device__ __forceinline__ float bf_lo(unsigned w) { return __uint_as_float(w << 16); }
__device__ __forceinline__ float bf_hi(unsigned w) { return __uint_as_float(w & 0xffff0000u); }
__device__ __forceinline__ float sigmoidf_(float x) { return __builtin_amdgcn_rcpf(1.0f + __expf(-x)); }
__device__ __forceinline__ float gelu_tanh(float x) { const float u = 0.7978845608028654f * (x + 0.044715f * x * x * x); const float t = 1.0f - 2.0f * __builtin_amdgcn_rcpf(1.0f + __expf(2.0f * u)); return 0.5f * x * (1.0f + t); }
__device__ __forceinline__ u32x4 pack8(const f32x4 a, const f32x4 b) { u32x4 w; w.x = cvt_pk_bf16(a[0], a[1]); w.y = cvt_pk_bf16(a[2], a[3]); w.z = cvt_pk_bf16(b[0], b[1]); w.w = cvt_pk_bf16(b[2], b[3]); return w; }
__device__ __forceinline__ float KF(float v) { asm volatile("" : "+s"(v)); return v; }
__device__ __forceinline__ int opaque_tid() { int t = threadIdx.x; asm volatile("" : "+v"(t)); return t; }
__device__ __forceinline__ float wave_sum(float v) {
#pragma unroll
    for (int o = 1; o < 64; o <<= 1) v += __shfl_xor(v, o);
    return v;
}

namespace pg8 {
#define PG8_LAS __attribute__((address_space(3)))
constexpr int BM = 256, BK = 64, HALF = 128, HTB = HALF * BK * 2, STAGE_BYTES = 8 * HTB;
__host__ __device__ __forceinline__ int lds_byte(int r, int c) { const int st = (r >> 4) * 2 + (c >> 5), rr = r & 15, cc = c & 31, ob = rr * 64 + cc * 2; return st * 1024 + (ob ^ (((ob >> 9) & 1) << 5)); }
__host__ __device__ __forceinline__ void stage_rc(int b, int& R, int& C) { const int st = b / 1024, sb = b % 1024, swz = sb ^ (((sb >> 9) & 1) << 5); R = (st >> 1) * 16 + swz / 64; C = (st & 1) * 32 + (swz % 64) / 2; }
__host__ __device__ __forceinline__ int perm32(int rho) { const int n = rho >> 4, i = rho & 15; return 8 * (i >> 2) + 4 * n + (i & 3); }

struct Unit { const char* A; const char* B; const char* S; const char* SA; const int* lst; int nvalid; int pm, pn, aux; };

typedef int v4i_t __attribute__((ext_vector_type(4)));
typedef int v8i_t __attribute__((ext_vector_type(8)));
template <class Epi, class Sched, bool GATHER, int FPM = 0>
__device__ __forceinline__ void gemm_phase(PG8_LAS unsigned char* lds, const int nt  , const int lda  , const int ldb  , const Sched& S, const Epi& E, unsigned long long* pw = nullptr, const int sa = 0x7f7f7f7f) {
    constexpr bool FP8 = FPM != 0;
    const int tid = opaque_tid(), wid = __builtin_amdgcn_readfirstlane(tid >> 6), lane = tid & 63, wr = wid >> 2, wc = wid & 3, fr = lane & 15, fq = lane >> 4;
    unsigned voffB[2], ocA[2][2], onA[2][2];
#pragma unroll
    for (int i = 0; i < 2; ++i) { int R, C; stage_rc(tid * 16 + i * 8192, R, C); const int Rb = Epi::PERM ? ((R & ~31) + perm32(R & 31)) : R;
        voffB[i] = (unsigned)(Rb * ldb + C * 2);
        ocA[0][i] = (unsigned)(R * lda + C * 2); ocA[1][i] = (unsigned)((R + HALF) * lda + C * 2); onA[0][i] = ocA[0][i]; onA[1][i] = ocA[1][i]; }
    constexpr unsigned kstep = BK * 2;
    const unsigned hstepB = (unsigned)HALF * ldb;
    const unsigned ldsw = (unsigned)wid * 1024u;
    const int aoff = lds_byte(wr * 64 + fr, fq * 8), boff = lds_byte(wc * 32 + fr, fq * 8);
#define PG8_SA(b, h) (((b) * 2 + (h)) * HTB)
#define PG8_SB(b, h) ((4 + (b) * 2 + (h)) * HTB)
#define PG8_STAGE(bufoff, gbase, voff, kb) do { _Pragma("unroll") for (int _i = 0; _i < 2; ++_i) \
        __builtin_amdgcn_global_load_lds((const unsigned*)((const char*)(gbase) + (size_t)(unsigned)((voff)[_i] + (unsigned)(kb))), (PG8_LAS unsigned*)(lds + (bufoff) + ldsw + _i * 8192), 16, 0, 0); } while (0)
#define PG8_CAT(x0, x1) __builtin_shufflevector(x0, x1, 0, 1, 2, 3, 4, 5, 6, 7)
#define PG8_LO(x) __builtin_bit_cast(bf16x8, __builtin_shufflevector(x, x, 0, 1, 2, 3))
#define PG8_HI(x) __builtin_bit_cast(bf16x8, __builtin_shufflevector(x, x, 4, 5, 6, 7))
    const PG8_LAS unsigned char* const ldsA = lds + aoff; const PG8_LAS unsigned char* const ldsB = lds + 4 * HTB + boff;
#define PG8_LDA(dst, b, h) do { _Pragma("unroll") for (int m = 0; m < 4; ++m) dst[m] = PG8_CAT(*(const PG8_LAS v4i_t*)(ldsA + (PG8_SA(b, h) + m * 2048)), *(const PG8_LAS v4i_t*)(ldsA + (PG8_SA(b, h) + m * 2048 + 1024))); } while (0)
#define PG8_LDB(dst, b, h) do { _Pragma("unroll") for (int n = 0; n < 2; ++n) dst[n] = PG8_CAT(*(const PG8_LAS v4i_t*)(ldsB + (PG8_SB(b, h) - 4 * HTB + n * 2048)), *(const PG8_LAS v4i_t*)(ldsB + (PG8_SB(b, h) - 4 * HTB + n * 2048 + 1024))); } while (0)
#define PG8_MMA(ai, bj, At, Bt) do { __builtin_amdgcn_s_setprio(1); \
        if constexpr (FP8) { asm volatile("s_nop 4" ::: "memory"); _Pragma("unroll") for (int m = 0; m < 4; ++m) _Pragma("unroll") for (int n = 0; n < 2; ++n) \
            asm volatile("v_mfma_scale_f32_16x16x128_f8f6f4 %0, %1, %2, %0, %3, %4 op_sel_hi:[0,0,0]" : "+v"(acc[ai][bj][m][n]) : "v"(Bt[n]), "v"(At[m]), "v"(sB[bj][n]), "v"(FPM == 2 ? sA[m] : sav)); } \
        else { _Pragma("unroll") for (int m = 0; m < 4; ++m) _Pragma("unroll") for (int n = 0; n < 2; ++n) { \
            acc[ai][bj][m][n] = __builtin_amdgcn_mfma_f32_16x16x32_bf16(PG8_LO(Bt[n]), PG8_LO(At[m]), acc[ai][bj][m][n], 0, 0, 0); \
            acc[ai][bj][m][n] = __builtin_amdgcn_mfma_f32_16x16x32_bf16(PG8_HI(Bt[n]), PG8_HI(At[m]), acc[ai][bj][m][n], 0, 0, 0); } } \
        __builtin_amdgcn_s_setprio(0); } while (0)
    int sB[2][2] = {{0x7f, 0x7f}, {0x7f, 0x7f}}; int sav; asm volatile("v_mov_b32 %0, %1" : "=v"(sav) : "s"(sa));
    int sA[4] = {0x7f, 0x7f, 0x7f, 0x7f};
    const int scol = wc * 32 + (Epi::PERM ? 8 * (fr >> 2) + (fr & 3) : fr);
    const int sbase = FPM == 2 ? SCL_OFF + 16384 + scol * 2 + (fq >> 1) : SCL_OFF + scol * 4 + fq;
    const int sabase = SCL_OFF + ((wr * 64 + fr) << 2) + fq;
#define PG8_LDS_SCL(par_, kt_) do { if constexpr (FP8) { \
        const PG8_LAS unsigned char* sp_ = (const PG8_LAS unsigned char*)lds + sbase + (FPM == 2 ? (par_) * 4096 + (kt_) * 512 : (par_) * 8192 + (kt_) * 1024); \
        _Pragma("unroll") for (int bj_ = 0; bj_ < 2; ++bj_) _Pragma("unroll") for (int n_ = 0; n_ < 2; ++n_) sB[bj_][n_] = (int)sp_[(bj_ * 128 + n_ * (Epi::PERM ? 4 : 16)) * (FPM == 2 ? 2 : 4)]; } } while (0)
#define PG8_LDS_SCA(par_, kt_, ai_) do { if constexpr (FPM == 2) { const PG8_LAS unsigned char* sp_ = (const PG8_LAS unsigned char*)lds + sabase + (par_) * 8192 + (kt_) * 1024 + (ai_) * 512; \
        _Pragma("unroll") for (int m_ = 0; m_ < 4; ++m_) sA[m_] = (int)sp_[m_ * 64]; } } while (0)
#define PG8_DMA_SCL(u_, par_) do { if constexpr (FPM == 1) __builtin_amdgcn_global_load_lds((const unsigned*)((u_).S + wid * 1024 + lane * 16), (PG8_LAS unsigned*)(lds + SCL_OFF + (par_) * 8192 + wid * 1024), 16, 0, 0); \
        if constexpr (FPM == 2) { __builtin_amdgcn_global_load_lds((const unsigned*)((u_).SA + wid * 1024 + lane * 16), (PG8_LAS unsigned*)(lds + SCL_OFF + (par_) * 8192 + wid * 1024), 16, 0, 0); \
            if (wid < 4) __builtin_amdgcn_global_load_lds((const unsigned*)((u_).S + wid * 1024 + lane * 16), (PG8_LAS unsigned*)(lds + SCL_OFF + 16384 + (par_) * 4096 + wid * 1024), 16, 0, 0); } } while (0)
#define PG8_WAIT_V(n) asm volatile("s_waitcnt vmcnt(" #n ")" ::: "memory")
#define PG8_WAIT_L(n) asm volatile("s_waitcnt lgkmcnt(" #n ")" ::: "memory")
#define PG8_BAR __builtin_amdgcn_s_barrier()
#define PG8_SCHED __builtin_amdgcn_sched_barrier(0)
#define PG8_GOFFS(u, o) do { _Pragma("unroll") for (int _h = 0; _h < 2; ++_h) _Pragma("unroll") for (int _i = 0; _i < 2; ++_i) { int gR_, gC_; stage_rc(tid * 16 + _i * 8192, gR_, gC_); int _r = _h * HALF + gR_; _r = _r < (u).nvalid ? _r : (u).nvalid - 1; \
        const int _tok = (u).lst[_r]; (o)[_h][_i] = (unsigned)_tok * (unsigned)lda + (unsigned)(gC_ * 2); } } while (0)
#define PG8_GRAW(u, tk) do {   _Pragma("unroll") for (int _h = 0; _h < 2; ++_h) _Pragma("unroll") for (int _i = 0; _i < 2; ++_i) { int gR_, gC_; stage_rc(tid * 16 + _i * 8192, gR_, gC_); int _r = _h * HALF + gR_; _r = _r < (u).nvalid ? _r : (u).nvalid - 1; (tk)[_h][_i] = (unsigned)(u).lst[_r]; } } while (0)
    Unit cur, nxt, nn; int ui = 0;
#if PROBE_T
    unsigned long long pk_ = 0, pe_ = 0, pt0_ = 0, pn_ = 0; const unsigned long long pst_ = __builtin_amdgcn_s_memtime();
#endif
    if (!S.next(0, cur)) return;
    f32x4 acc[2][2][4][2];
#pragma unroll
    for (int a = 0; a < 2; ++a)
#pragma unroll
        for (int b = 0; b < 2; ++b)
#pragma unroll
            for (int m = 0; m < 4; ++m)
#pragma unroll
                for (int n = 0; n < 2; ++n) acc[a][b][m][n] = (f32x4){0.f, 0.f, 0.f, 0.f};
    v8i_t At[4], B0[2], B1[2];
    const char* cA = cur.A; const char* cB = cur.B;
    bool has_next = S.next(1, nxt);
    if constexpr (GATHER) { PG8_GOFFS(cur, ocA);
        if (has_next) { PG8_GOFFS(nxt, onA); }
        else {
#pragma unroll
            for (int h = 0; h < 2; ++h)
#pragma unroll
                for (int i = 0; i < 2; ++i) onA[h][i] = ocA[h][i]; } }
    PG8_DMA_SCL(cur, 0); if (has_next) PG8_DMA_SCL(nxt, 1);
    PG8_STAGE(PG8_SB(0, 0), cB, voffB, 0u); PG8_STAGE(PG8_SB(0, 1), cB, voffB, hstepB); PG8_STAGE(PG8_SA(0, 0), cA, ocA[0], 0u); PG8_STAGE(PG8_SA(0, 1), cA, ocA[1], 0u);
    if (wr == 1) PG8_BAR;
    PG8_WAIT_V(2); PG8_BAR;
    PG8_STAGE(PG8_SB(1, 0), cB, voffB, kstep); PG8_STAGE(PG8_SA(1, 0), cA, ocA[0], kstep); PG8_STAGE(PG8_SB(1, 1), cB, voffB, hstepB + kstep);
    PG8_WAIT_V(6); PG8_BAR;
    for (;;) {
        const char* nA = has_next ? nxt.A : cA; const char* nB = has_next ? nxt.B : cB;
#if PROBE_T
        pt0_ = __builtin_amdgcn_s_memtime();
#endif
#pragma unroll 1
        for (int t = 0; t < nt; t += 2) {
            const bool last = (t == nt - 2);
            const unsigned k1 = (unsigned)(t + 1) * kstep, k2 = last ? 0u : (unsigned)(t + 2) * kstep, k3 = k2 + kstep;
            const char* a2 = last ? nA : cA; const char* b2 = last ? nB : cB;
#define PG8_STAGE_A2(bufoff, h_, kb_) do { if (GATHER && last) PG8_STAGE(bufoff, a2, onA[h_], kb_); else PG8_STAGE(bufoff, a2, ocA[h_], kb_); } while (0)
            PG8_LDB(B0, 0, 0); PG8_LDB(B1, 0, 1); PG8_LDS_SCL(ui & 1, t); PG8_SCHED; PG8_LDA(At, 0, 0); PG8_LDS_SCA(ui & 1, t, 0); PG8_STAGE(PG8_SA(1, 1), cA, ocA[1], k1);
            PG8_WAIT_V(8); PG8_WAIT_L(0); PG8_BAR; PG8_MMA(0, 0, At, B0); PG8_MMA(0, 1, At, B1); PG8_BAR; PG8_SCHED;
            PG8_LDA(At, 0, 1); PG8_LDS_SCA(ui & 1, t, 1); PG8_STAGE(PG8_SB(0, 0), b2, voffB, k2); PG8_STAGE(PG8_SB(0, 1), b2, voffB, hstepB + k2); PG8_STAGE_A2(PG8_SA(0, 0), 0, k2);
            PG8_WAIT_V(8); PG8_WAIT_L(0); PG8_BAR; PG8_MMA(1, 0, At, B0); PG8_MMA(1, 1, At, B1); PG8_BAR; PG8_SCHED;
            PG8_LDB(B0, 1, 0); PG8_LDB(B1, 1, 1); PG8_LDS_SCL(ui & 1, t + 1); PG8_SCHED; PG8_LDA(At, 1, 0); PG8_LDS_SCA(ui & 1, t + 1, 0); PG8_STAGE_A2(PG8_SA(0, 1), 1, k2);
            PG8_WAIT_V(8); PG8_WAIT_L(0); PG8_BAR; PG8_MMA(0, 0, At, B0); PG8_MMA(0, 1, At, B1); PG8_BAR; PG8_SCHED;
            PG8_LDA(At, 1, 1); PG8_LDS_SCA(ui & 1, t + 1, 1); PG8_STAGE(PG8_SB(1, 0), b2, voffB, k3); PG8_STAGE(PG8_SB(1, 1), b2, voffB, hstepB + k3); PG8_STAGE_A2(PG8_SA(1, 0), 0, k3);
            PG8_WAIT_V(8); PG8_WAIT_L(0); PG8_BAR; PG8_MMA(1, 0, At, B0); PG8_MMA(1, 1, At, B1); PG8_BAR; PG8_SCHED;
        }
#if PROBE_T
        const unsigned long long pt1_ = __builtin_amdgcn_s_memtime(); pk_ += pt1_ - pt0_;
#endif
        if constexpr (FP8) asm volatile("s_nop 15\n\ts_nop 7" ::: "memory");
        const bool has_nn = has_next && S.next(ui + 2, nn);
        if constexpr (GATHER) {
#pragma unroll
            for (int h = 0; h < 2; ++h)
#pragma unroll
                for (int i = 0; i < 2; ++i) ocA[h][i] = onA[h][i];
            if (has_nn) { PG8_GRAW(nn, onA); } }
        if (wr == 0) PG8_BAR;
        E(acc, cur, wr, wc, fr, fq);
#if PROBE_T
        asm volatile("s_waitcnt vmcnt(0)" ::: "memory"); pe_ += __builtin_amdgcn_s_memtime() - pt1_; ++pn_;
#endif
        if (!has_next) break;
#pragma unroll
        for (int a = 0; a < 2; ++a)
#pragma unroll
            for (int b = 0; b < 2; ++b)
#pragma unroll
                for (int m = 0; m < 4; ++m)
#pragma unroll
                    for (int n = 0; n < 2; ++n) acc[a][b][m][n] = (f32x4){0.f, 0.f, 0.f, 0.f};
        cur = nxt; cA = nA; cB = nB; ++ui;
        if constexpr (GATHER) { if (has_nn) {
#pragma unroll
            for (int h = 0; h < 2; ++h)
#pragma unroll
                for (int i = 0; i < 2; ++i) { int gR_, gC_; stage_rc(tid * 16 + i * 8192, gR_, gC_); onA[h][i] = onA[h][i] * (unsigned)lda + (unsigned)(gC_ * 2); } } }
        if (has_nn) { nxt = nn; PG8_DMA_SCL(nxt, (ui + 1) & 1); }
        has_next = has_nn;
        if (wr == 1) PG8_BAR;
    }
    PG8_WAIT_V(0);
    PG8_BAR;
#if PROBE_T
    if (pw && blockIdx.x == 0 && tid == 0) { pw[0] += pk_; pw[1] += pe_; pw[2] += pn_; pw[3] += __builtin_amdgcn_s_memtime() - pst_; }
#endif
#undef PG8_SA
#undef PG8_SB
#undef PG8_STAGE
#undef PG8_LDA
#undef PG8_LDB
#undef PG8_MMA
#undef PG8_WAIT_V
#undef PG8_WAIT_L
#undef PG8_BAR
#undef PG8_SCHED
#undef PG8_GOFFS
#undef PG8_GRAW
#undef PG8_STAGE_A2
#undef PG8_CAT
#undef PG8_LO
#undef PG8_HI
#undef PG8_LDS_SCL
#undef PG8_LDS_SCA
#undef PG8_DMA_SCL
}

constexpr int NXCD = 8, WGM = 8;
struct DenseSched {
    const char* A; const char* B; int lda, ldb; int nM, nN, nwg, G, c; int apn_shift, akbytes, bpm_shift; size_t bbatch;
    __device__ __forceinline__ void init(const void* A_, const void* B_, int lda_, int ldb_, int M, int N, int G_, int c_) {
        A = (const char*)A_; B = (const char*)B_; lda = lda_; ldb = ldb_; nM = M / BM; nN = N / BM; nwg = nM * nN; G = G_; c = c_; apn_shift = -1; akbytes = 0; bpm_shift = -1; bbatch = 0; }
    __device__ __forceinline__ bool next(int i, Unit& u) const {
        const long L = (long)i * G + c; if (L >= nwg) return false;
        int wgid = (int)L; { const int q = nwg / NXCD, r = nwg % NXCD, xcd = wgid % NXCD, off = wgid / NXCD; wgid = (xcd < r ? xcd * (q + 1) : r * (q + 1) + (xcd - r) * q) + off; }
        const int nig = WGM * nN, gid = wgid / nig, fm = gid * WGM, gsz = (nM - fm) < WGM ? (nM - fm) : WGM;
        const int pm = fm + ((wgid % nig) % gsz), pn = (wgid % nig) / gsz;
        u.pm = pm; u.pn = pn; u.aux = 0; u.lst = nullptr; u.nvalid = 256; u.S = nullptr; u.SA = nullptr;
        u.A = A + (size_t)pm * 256 * lda * 2 + (apn_shift >= 0 ? (size_t)(pn >> apn_shift) * akbytes : (size_t)0);
        u.B = B + (size_t)pn * 256 * ldb * 2 + (bpm_shift >= 0 ? (size_t)(pm >> bpm_shift) * bbatch : (size_t)0);
        return true;
    }
};
struct MoeSched {
    const char* A; const char* B; size_t bexp; const char* SW; int lda, ldb  , nN; const int* lists; volatile LAS const int* tab; volatile LAS const unsigned char* te; int G, c; bool gather; const char* SA;
    __device__ __forceinline__ bool next(int i, Unit& u) const {
        int pn, mg;
        if (G == 256) {
            const int x = c & 7, jj = c >> 3, pgs = nN >> 2, mgs = 8 / pgs;
            mg = i * (8 * mgs) + 8 * (x / pgs) + (jj & 7); pn = 4 * (x % pgs) + (jj >> 3);
            if (mg >= __builtin_amdgcn_readfirstlane(tab[32])) return false;
        } else { const int total = __builtin_amdgcn_readfirstlane(tab[32]) * nN; const long L = (long)i * G + c; if (L >= total) return false; pn = (int)(L % nN); mg = (int)(L / nN); }
        const int e = __builtin_amdgcn_readfirstlane((int)te[mg]), mt = mg - __builtin_amdgcn_readfirstlane(tab[e]);
        u.pm = mg; u.pn = pn; u.aux = e;
        if (gather) { u.A = A; u.lst = lists + (size_t)e * T + mt * 256; const int rem = __builtin_amdgcn_readfirstlane(tab[48 + e]) - mt * 256; u.nvalid = rem < 256 ? rem : 256; }
        else { u.A = A + (size_t)mg * 256 * lda; u.lst = nullptr; u.nvalid = 256; }
        u.B = B + (size_t)e * bexp + (size_t)pn * 256 * ldb; u.S = SW ? (SA ? SW + ((size_t)e * 4 + pn) * 4096 : SW + ((size_t)e * 8 + pn) * 8192) : nullptr; u.SA = SA ? SA + (size_t)mg * 8192 : nullptr;
        return true;
    }
};

#define EPI_ROW(u, ai, m) ((u).pm * 256 + (ai) * 128 + wr * 64 + (m) * 16 + fr)
struct EpiLat {
    static constexpr bool PERM = true;
    bf16_t* LAT; float* SSQ; bf16_t* KR; const float* CS; const float* SN;
    __device__ __forceinline__ void operator()(const f32x4 (&acc)[2][2][4][2], const Unit& u, int wr, int wc, int fr, int fq) const {
        if (u.pn < 4) {
#pragma unroll
            for (int ai = 0; ai < 2; ++ai)
#pragma unroll
                for (int m = 0; m < 4; ++m) { const int row = EPI_ROW(u, ai, m); float ss = 0.f;
#pragma unroll
                    for (int bj = 0; bj < 2; ++bj) { const f32x4 v0 = acc[ai][bj][m][0], v1 = acc[ai][bj][m][1];
                        ss += (v0[0] * v0[0] + v0[1] * v0[1]) + (v0[2] * v0[2] + v0[3] * v0[3]) + (v1[0] * v1[0] + v1[1] * v1[1]) + (v1[2] * v1[2] + v1[3] * v1[3]);
                        *(u32x4*)(LAT + (size_t)row * 1024 + u.pn * 256 + bj * 128 + wc * 32 + 8 * fq) = pack8(v0, v1); }
                    ss += __shfl_xor(ss, 16); ss += __shfl_xor(ss, 32);
                    if (fq == 0) SSQ[(size_t)row * 16 + u.pn * 4 + wc] = ss; }
        } else if (wc == 0) {
#pragma unroll
            for (int ai = 0; ai < 2; ++ai)
#pragma unroll
                for (int m = 0; m < 4; ++m) { const int row = EPI_ROW(u, ai, m);
                    const f32x4 c0 = *(const f32x4*)(CS + (size_t)row * 32 + 8 * fq), c1 = *(const f32x4*)(CS + (size_t)row * 32 + 8 * fq + 4);
                    const f32x4 s0 = *(const f32x4*)(SN + (size_t)row * 32 + 8 * fq), s1 = *(const f32x4*)(SN + (size_t)row * 32 + 8 * fq + 4);
                    const f32x4 a0 = acc[ai][0][m][0], a1 = acc[ai][0][m][1], b0 = acc[ai][1][m][0], b1 = acc[ai][1][m][1];
                    *(u32x4*)(KR + (size_t)row * 64 + 8 * fq) = pack8(a0 * c0 - b0 * s0, a1 * c1 - b1 * s1);
                    *(u32x4*)(KR + (size_t)row * 64 + 32 + 8 * fq) = pack8(b0 * c0 + a0 * s0, b1 * c1 + a1 * s1); }
        }
    }
};
struct EpiQ {
    static constexpr bool PERM = true;
    bf16_t* Q; const float* SSQ; const float* CS; const float* SN;
    __device__ __forceinline__ void operator()(const f32x4 (&acc)[2][2][4][2], const Unit& u, int wr, int wc, int fr, int fq) const {
#pragma unroll
        for (int ai = 0; ai < 2; ++ai)
#pragma unroll
            for (int m = 0; m < 4; ++m) { const int row = EPI_ROW(u, ai, m);
                const f32x4 q0 = *(const f32x4*)(SSQ + (size_t)row * 16), q1 = *(const f32x4*)(SSQ + (size_t)row * 16 + 4), q2 = *(const f32x4*)(SSQ + (size_t)row * 16 + 8);
                const float ss = ((q0[0] + q0[1]) + (q0[2] + q0[3])) + ((q1[0] + q1[1]) + (q1[2] + q1[3])) + ((q2[0] + q2[1]) + (q2[2] + q2[3]));
                const float r = QSCALE / sqrtf(ss * (1.0f / QL) + KF(RMS_EPS));
                if (u.pn < 4) {
#pragma unroll
                    for (int bj = 0; bj < 2; ++bj)
                        *(u32x4*)(Q + (size_t)row * 1536 + (2 * u.pn + bj) * 192 + wc * 32 + 8 * fq) = pack8(acc[ai][bj][m][0] * r, acc[ai][bj][m][1] * r);
                } else {
                    const int head = 4 * (u.pn - 4) + wc;
                    const f32x4 c0 = *(const f32x4*)(CS + (size_t)row * 32 + 8 * fq), c1 = *(const f32x4*)(CS + (size_t)row * 32 + 8 * fq + 4);
                    const f32x4 s0 = *(const f32x4*)(SN + (size_t)row * 32 + 8 * fq), s1 = *(const f32x4*)(SN + (size_t)row * 32 + 8 * fq + 4);
                    const f32x4 a0 = acc[ai][0][m][0] * r, a1 = acc[ai][0][m][1] * r, b0 = acc[ai][1][m][0] * r, b1 = acc[ai][1][m][1] * r;
                    *(u32x4*)(Q + (size_t)row * 1536 + head * 192 + 128 + 8 * fq) = pack8(a0 * c0 - b0 * s0, a1 * c1 - b1 * s1);
                    *(u32x4*)(Q + (size_t)row * 1536 + head * 192 + 160 + 8 * fq) = pack8(b0 * c0 + a0 * s0, b1 * c1 + a1 * s1);
                }
                asm volatile("" ::: "memory"); }
    }
};
struct EpiKV {
    static constexpr bool PERM = true;
    bf16_t* KN; bf16_t* V; const float* SSQ;
    __device__ __forceinline__ void operator()(const f32x4 (&acc)[2][2][4][2], const Unit& u, int wr, int wc, int fr, int fq) const {
#pragma unroll
        for (int ai = 0; ai < 2; ++ai)
#pragma unroll
            for (int m = 0; m < 4; ++m) { const int row = EPI_ROW(u, ai, m);
                const f32x4 q3 = *(const f32x4*)(SSQ + (size_t)row * 16 + 12);
                const float r = 1.0f / sqrtf(((q3[0] + q3[1]) + (q3[2] + q3[3])) * (1.0f / KVL) + KF(RMS_EPS));
                *(u32x4*)(KN + (size_t)row * 1024 + u.pn * 128 + wc * 32 + 8 * fq) = pack8(acc[ai][0][m][0] * r, acc[ai][0][m][1] * r);
                *(u32x4*)(V + (size_t)row * 1024 + u.pn * 128 + wc * 32 + 8 * fq) = pack8(acc[ai][1][m][0] * r, acc[ai][1][m][1] * r); }
    }
};
__device__ __forceinline__ f32x4 bf4_lo(const u32x4 w) { return (f32x4){bf_lo(w.x), bf_hi(w.x), bf_lo(w.y), bf_hi(w.y)}; }
__device__ __forceinline__ f32x4 bf4_hi(const u32x4 w) { return (f32x4){bf_lo(w.z), bf_hi(w.z), bf_lo(w.w), bf_hi(w.w)}; }
struct EpiRes {
    static constexpr bool PERM = true;
    const bf16_t* X; bf16_t* Y;
    __device__ __forceinline__ void operator()(const f32x4 (&acc)[2][2][4][2], const Unit& u, int wr, int wc, int fr, int fq) const {
        const bf16_t* xb = X + (size_t)u.pm * 256 * 1024; bf16_t* yb = Y + (size_t)u.pm * 256 * 1024; const unsigned o0 = (unsigned)((wr * 64 + fr) * 1024 + u.pn * 256 + wc * 32 + 8 * fq);
        u32x4 xw[2][4][2];
#pragma unroll
        for (int ai = 0; ai < 2; ++ai)
#pragma unroll
            for (int m = 0; m < 4; ++m)
#pragma unroll
                for (int bj = 0; bj < 2; ++bj) xw[ai][m][bj] = *(const u32x4*)(xb + (o0 + (unsigned)((ai * 128 + m * 16) * 1024 + bj * 128)));
#pragma unroll
        for (int ai = 0; ai < 2; ++ai)
#pragma unroll
            for (int m = 0; m < 4; ++m)
#pragma unroll
                for (int bj = 0; bj < 2; ++bj)
                    *(u32x4*)(yb + (o0 + (unsigned)((ai * 128 + m * 16) * 1024 + bj * 128))) = pack8(bf4_lo(xw[ai][m][bj]) * ALPHA + acc[ai][bj][m][0], bf4_hi(xw[ai][m][bj]) * ALPHA + acc[ai][bj][m][1]);
    }
};
struct EpiGU {
    static constexpr bool PERM = true;
    bf16_t* GG; bf16_t* U;
    __device__ __forceinline__ void operator()(const f32x4 (&acc)[2][2][4][2], const Unit& u, int wr, int wc, int fr, int fq) const {
#pragma unroll
        for (int ai = 0; ai < 2; ++ai)
#pragma unroll
            for (int m = 0; m < 4; ++m) { const int row = EPI_ROW(u, ai, m);
#pragma unroll
                for (int bj = 0; bj < 2; ++bj) { f32x4 v0 = acc[ai][bj][m][0], v1 = acc[ai][bj][m][1];
                    if (u.pn < 4) {
#pragma unroll
                        for (int e = 0; e < 4; ++e) { v0[e] = gelu_tanh(v0[e]); v1[e] = gelu_tanh(v1[e]); }
                        *(u32x4*)(GG + (size_t)row * 1024 + u.pn * 256 + bj * 128 + wc * 32 + 8 * fq) = pack8(v0, v1);
                    } else *(u32x4*)(U + (size_t)row * 1024 + (u.pn - 4) * 256 + bj * 128 + wc * 32 + 8 * fq) = pack8(v0, v1); } }
    }
};
struct EpiAB {
    static constexpr bool PERM = true;
    bf16_t* LA; bf16_t* BB; const bf16_t* UC; const float* BA; const float* BX; const float* SPL;
    __device__ __forceinline__ void operator()(const f32x4 (&acc)[2][2][4][2], const Unit& u, int wr, int wc, int fr, int fq) const {
        const int ch = (u.pn >> 1) * 256 + (u.pn & 1) * 128 + wc * 32 + 8 * fq;
        const float c3 = KF(0.16666667f), c4 = KF(0.041666668f), c5 = KF(0.0083333338f);
        f32x4 ba[2], bx[2], sp[2];
#pragma unroll
        for (int n = 0; n < 2; ++n) { ba[n] = *(const f32x4*)(BA + ch + 4 * n); bx[n] = *(const f32x4*)(BX + ch + 4 * n); sp[n] = *(const f32x4*)(SPL + ch + 4 * n); }
#pragma unroll
        for (int ai = 0; ai < 2; ++ai)
#pragma unroll
            for (int m = 0; m < 4; ++m) { const size_t off = (size_t)EPI_ROW(u, ai, m) * 1024 + ch;
                const u32x4 uw = *(const u32x4*)(UC + off); f32x4 uv[2] = {bf4_lo(uw), bf4_hi(uw)}, lv[2], bv[2];
#pragma unroll
                for (int n = 0; n < 2; ++n)
#pragma unroll
                    for (int e = 0; e < 4; ++e) { const float r = sigmoidf_(acc[ai][0][m][n][e] + ba[n][e]), ig = sigmoidf_(acc[ai][1][m][n][e] + bx[n][e]);
                        const float la = sp[n][e] * r, x2 = 2.0f * la; lv[n][e] = la * 1.4426950408889634f;
                        const float om = x2 > -0.25f ? -x2 * (1.0f + x2 * (0.5f + x2 * (c3 + x2 * (c4 + x2 * c5)))) : 1.0f - __expf(x2);
                        bv[n][e] = sqrtf(om) * ig * uv[n][e]; }
                *(u32x4*)(LA + off) = pack8(lv[0], lv[1]); *(u32x4*)(BB + off) = pack8(bv[0], bv[1]); asm volatile("" ::: "memory"); }
    }
};
struct EpiUp {
    static constexpr bool PERM = true;
    unsigned char* H; unsigned char* SH; const float* BU;
    __device__ __forceinline__ void operator()(f32x4 (&acc)[2][2][4][2], const Unit& u, int wr, int wc, int fr, int fq) const {
        const int gc = u.pn * 128 + wc * 32 + 8 * fq; const float* bu = BU + (size_t)u.aux * 2048;
        const float k7 = KF(7.0f), km7 = KF(-7.0f), ka = KF(1.702f);
#pragma unroll
        for (int n = 0; n < 2; ++n) { const f32x4 bg = *(const f32x4*)(bu + gc + 4 * n), bp = *(const f32x4*)(bu + 1024 + gc + 4 * n);
#pragma unroll
            for (int ai = 0; ai < 2; ++ai)
#pragma unroll
                for (int m = 0; m < 4; ++m) {
#pragma unroll
                    for (int e = 0; e < 4; ++e) { const float g = fminf(acc[ai][0][m][n][e] + bg[e], k7), up = fminf(fmaxf(acc[ai][1][m][n][e] + bp[e], km7), k7);
                        acc[ai][0][m][n][e] = (up + 1.0f) * (g * sigmoidf_(ka * g)); }
                    if (m & 1) __builtin_amdgcn_sched_barrier(0); }
            asm volatile("" ::: "memory"); }
        unsigned char* const shb = SH + ((size_t)u.pm * 8 + u.pn) * 1024; unsigned char* const hb = H + (size_t)u.pm * 256 * 1024;
        const unsigned ho = (unsigned)((wr * 64 + fr) * 1024 + gc), so = (unsigned)((wr * 64 + fr) * 4 + wc);
#pragma unroll
        for (int ai = 0; ai < 2; ++ai)
#pragma unroll
            for (int m = 0; m < 4; ++m) { const f32x4 y0 = acc[ai][0][m][0], y1 = acc[ai][0][m][1];
                float am = fmaxf(fmaxf(fmaxf(fabsf(y0[0]), fabsf(y0[1])), fmaxf(fabsf(y0[2]), fabsf(y0[3]))), fmaxf(fmaxf(fabsf(y1[0]), fabsf(y1[1])), fmaxf(fabsf(y1[2]), fabsf(y1[3]))));
                { auto r16 = __builtin_amdgcn_permlane16_swap(__float_as_uint(am), __float_as_uint(am), false, false); am = fmaxf(__uint_as_float(r16[0]), __uint_as_float(r16[1]));
                  auto r32 = __builtin_amdgcn_permlane32_swap(__float_as_uint(am), __float_as_uint(am), false, false); am = fmaxf(__uint_as_float(r32[0]), __uint_as_float(r32[1])); }
                int eb = (int)((__float_as_uint(am) >> 23) & 0xffu) - 7; eb = eb < 1 ? 1 : eb;
                const float inv = __uint_as_float((unsigned)(254 - eb) << 23);
                int w0 = __builtin_amdgcn_cvt_pk_fp8_f32(y0[0] * inv, y0[1] * inv, 0, false); w0 = __builtin_amdgcn_cvt_pk_fp8_f32(y0[2] * inv, y0[3] * inv, w0, true);
                int w1 = __builtin_amdgcn_cvt_pk_fp8_f32(y1[0] * inv, y1[1] * inv, 0, false); w1 = __builtin_amdgcn_cvt_pk_fp8_f32(y1[2] * inv, y1[3] * inv, w1, true);
                *(u32x2*)(hb + (ho + (unsigned)((ai * 128 + m * 16) * 1024))) = (u32x2){(unsigned)w0, (unsigned)w1};
                if (fq == 0) shb[so + (unsigned)((ai * 128 + m * 16) * 4)] = (unsigned char)eb;
                asm volatile("" ::: "memory"); __builtin_amdgcn_sched_barrier(0); }
    }
};
struct EpiDown {
    static constexpr bool PERM = true;
    unsigned char* YS; unsigned char* SY; const float* BD;
    __device__ __forceinline__ void operator()(const f32x4 (&acc)[2][2][4][2], const Unit& u, int wr, int wc, int fr, int fq) const {
        const float* bd = BD + (size_t)u.aux * 1024;
        unsigned char* const yb = YS + (size_t)u.pm * 256 * 1024; unsigned char* const sb = SY + (size_t)u.pm * 256 * 32;
#pragma unroll
        for (int bj = 0; bj < 2; ++bj) { const int col = u.pn * 256 + bj * 128 + wc * 32 + 8 * fq; const f32x4 b0 = *(const f32x4*)(bd + col), b1 = *(const f32x4*)(bd + col + 4);
#pragma unroll
            for (int ai = 0; ai < 2; ++ai)
#pragma unroll
                for (int m = 0; m < 4; ++m) { const unsigned rit = (unsigned)(ai * 128 + wr * 64 + m * 16 + fr); const f32x4 y0 = acc[ai][bj][m][0] + b0, y1 = acc[ai][bj][m][1] + b1;
                    float am = fmaxf(fmaxf(fmaxf(fabsf(y0[0]), fabsf(y0[1])), fmaxf(fabsf(y0[2]), fabsf(y0[3]))), fmaxf(fmaxf(fabsf(y1[0]), fabsf(y1[1])), fmaxf(fabsf(y1[2]), fabsf(y1[3]))));
                    { auto r16 = __builtin_amdgcn_permlane16_swap(__float_as_uint(am), __float_as_uint(am), false, false); am = fmaxf(__uint_as_float(r16[0]), __uint_as_float(r16[1]));
                      auto r32 = __builtin_amdgcn_permlane32_swap(__float_as_uint(am), __float_as_uint(am), false, false); am = fmaxf(__uint_as_float(r32[0]), __uint_as_float(r32[1])); }
                    int eb = (int)((__float_as_uint(am) >> 23) & 0xffu) - 7; eb = eb < 1 ? 1 : eb;
                    const float inv = __uint_as_float((unsigned)(254 - eb) << 23);
                    int w0 = __builtin_amdgcn_cvt_pk_fp8_f32(y0[0] * inv, y0[1] * inv, 0, false); w0 = __builtin_amdgcn_cvt_pk_fp8_f32(y0[2] * inv, y0[3] * inv, w0, true);
                    int w1 = __builtin_amdgcn_cvt_pk_fp8_f32(y1[0] * inv, y1[1] * inv, 0, false); w1 = __builtin_amdgcn_cvt_pk_fp8_f32(y1[2] * inv, y1[3] * inv, w1, true);
                    *(u32x2*)(yb + (rit * 1024u + (unsigned)col)) = (u32x2){(unsigned)w0, (unsigned)w1};
                    if (fq == 0) sb[rit * 32u + (unsigned)(col >> 5)] = (unsigned char)eb;
                    asm volatile("" ::: "memory"); } }
    }
};
struct EpiPle {
    static constexpr bool PERM = true;
    const bf16_t* X2; const bf16_t* PP; float* OUT; bf16_t* XB;
    __device__ __forceinline__ void operator()(const f32x4 (&acc)[2][2][4][2], const Unit& u, int wr, int wc, int fr, int fq) const {
        const size_t tb = (size_t)u.pm * 256 * 1024; const unsigned o0 = (unsigned)((wr * 64 + fr) * 1024 + u.pn * 256 + wc * 32 + 8 * fq);
#pragma unroll
        for (int ai = 0; ai < 2; ++ai) {
            u32x4 xw[4][2], pw[4][2];
#pragma unroll
            for (int m = 0; m < 4; ++m)
#pragma unroll
                for (int bj = 0; bj < 2; ++bj) { const unsigned o = o0 + (unsigned)((ai * 128 + m * 16) * 1024 + bj * 128); xw[m][bj] = *(const u32x4*)(X2 + tb + o); pw[m][bj] = *(const u32x4*)(PP + tb + o); }
#pragma unroll
            for (int m = 0; m < 4; ++m)
#pragma unroll
                for (int bj = 0; bj < 2; ++bj) { const unsigned o = o0 + (unsigned)((ai * 128 + m * 16) * 1024 + bj * 128);
                    const f32x4 a0 = acc[ai][bj][m][0], a1 = acc[ai][bj][m][1], x0 = bf4_lo(xw[m][bj]), x1 = bf4_hi(xw[m][bj]), p0 = bf4_lo(pw[m][bj]), p1 = bf4_hi(pw[m][bj]); f32x4 r0, r1;
#pragma unroll
                    for (int e = 0; e < 4; ++e) { r0[e] = x0[e] + sigmoidf_(a0[e]) * p0[e]; r1[e] = x1[e] + sigmoidf_(a1[e]) * p1[e]; }
                    *(u32x4*)(XB + tb + o) = pack8(r0, r1);
                    if (OUT) { *(f32x4*)(OUT + tb + o) = r0; *(f32x4*)(OUT + tb + o + 4) = r1; } }
            asm volatile("" ::: "memory"); }
    }
};
struct EpiPP {
    static constexpr bool PERM = true;
    bf16_t* PP;
    __device__ __forceinline__ void operator()(const f32x4 (&acc)[2][2][4][2], const Unit& u, int wr, int wc, int fr, int fq) const {
#pragma unroll
        for (int ai = 0; ai < 2; ++ai)
#pragma unroll
            for (int m = 0; m < 4; ++m)
#pragma unroll
                for (int bj = 0; bj < 2; ++bj) *(u32x4*)(PP + (size_t)EPI_ROW(u, ai, m) * 1024 + u.pn * 256 + bj * 128 + wc * 32 + 8 * fq) = pack8(acc[ai][bj][m][0], acc[ai][bj][m][1]);
    }
};
}

namespace att {
constexpr int NW = 8, QBLK = 32, KVBLK = 64, QB = 256, KPITCH = 384;
constexpr int SHM_V = KVBLK * DV * 2, SHM_K = KVBLK * KPITCH;
constexpr int NVB = 3;
constexpr int OFF_V = 0, OFF_K = NVB * SHM_V, OFF_WS = OFF_K + 2 * SHM_K, LDS_BYTES = OFF_WS + NW * 64 * 4;
#define SBAR() __builtin_amdgcn_sched_barrier(0)
__device__ __forceinline__ int k_addr(int row, int chunk) { return row * KPITCH + ((chunk ^ ((row >> 1) & 7)) << 4); }
__device__ __forceinline__ int v_st(int k, int c) { const int kk = (k & ~0xC) | ((k & 4) << 1) | ((k & 8) >> 1); return ((kk >> 3) * 4 + (c >> 5)) * 512 + ((kk & 7) * 32 + (c & 31)) * 2; }
__device__ __forceinline__ int v_rd_base(int lane) { return ((lane & 3) << 3) | (((lane >> 2) & 3) << 6) | (((lane >> 4) & 1) << 5) | (((lane >> 5) & 1) << 8); }
constexpr int v_rd_off(int d0, int ks, int half) { return d0 * 512 + ks * 4096 + half * 2048; }
__device__ __forceinline__ int crow(int r, int hi) { return (r & 3) + 8 * (r >> 2) + 4 * hi; }

template <int KB>
__device__ __forceinline__ void qkt(f32x16& p0, f32x16& p1, const LAS char* K_lds, int r32, int hi, const bf16x8* qr) {
    p0 = f32x16{}; p1 = f32x16{};
    const LAS char* kb[4];
#pragma unroll
    for (int dd = 0; dd < 4; ++dd) kb[dd] = K_lds + KB * SHM_K + r32 * KPITCH + (((2 * dd + hi) ^ ((r32 >> 1) & 7)) << 4);
    bf16x8 f[2][4];
#define QK_LD(g, buf) do { _Pragma("unroll") for (int e_ = 0; e_ < 2; ++e_) { const int d0_ = 2 * (g) + e_; const LAS char* a_ = kb[d0_ & 3] + (d0_ >> 2) * 128; \
        f[buf][2 * e_] = *(const LAS bf16x8*)a_; f[buf][2 * e_ + 1] = *(const LAS bf16x8*)(a_ + 32 * KPITCH); } } while (0)
    QK_LD(0, 0);
#pragma unroll
    for (int g = 0; g < 6; ++g) {
        if (g < 5) QK_LD(g + 1, (g + 1) & 1);
        SBAR();
#pragma unroll
        for (int e = 0; e < 2; ++e) { const int d0 = 2 * g + e;
            p0 = __builtin_amdgcn_mfma_f32_32x32x16_bf16(f[g & 1][2 * e], qr[d0], p0, 0, 0, 0);
            p1 = __builtin_amdgcn_mfma_f32_32x32x16_bf16(f[g & 1][2 * e + 1], qr[d0], p1, 0, 0, 0); }
        SBAR(); }
#undef QK_LD
}
__device__ __forceinline__ void pv_tile(f32x16* o, int vb0  , bf16x8 pa0, bf16x8 pa1, bf16x8 pa2, bf16x8 pa3) {
#define TRRD(dst, off) asm volatile("ds_read_b64_tr_b16 %0, %1 offset:%2" : "=&v"(dst) : "v"(vb0), "i"(off) : "memory")
#define PV_D0(d0) do { s16x4 l0, l1, l2, l3, h0, h1, h2, h3; constexpr int b_ = v_rd_off(d0, 0, 0); \
        TRRD(l0, b_); TRRD(h0, b_ + 2048); TRRD(l1, b_ + 4096); TRRD(h1, b_ + 6144); TRRD(l2, b_ + 8192); TRRD(h2, b_ + 10240); TRRD(l3, b_ + 12288); TRRD(h3, b_ + 14336); \
        asm volatile("s_waitcnt lgkmcnt(0)" ::: "memory"); SBAR(); \
        o[d0] = __builtin_amdgcn_mfma_f32_32x32x16_bf16(pa0, (bf16x8){l0[0], l0[1], l0[2], l0[3], h0[0], h0[1], h0[2], h0[3]}, o[d0], 0, 0, 0); \
        o[d0] = __builtin_amdgcn_mfma_f32_32x32x16_bf16(pa1, (bf16x8){l1[0], l1[1], l1[2], l1[3], h1[0], h1[1], h1[2], h1[3]}, o[d0], 0, 0, 0); \
        o[d0] = __builtin_amdgcn_mfma_f32_32x32x16_bf16(pa2, (bf16x8){l2[0], l2[1], l2[2], l2[3], h2[0], h2[1], h2[2], h2[3]}, o[d0], 0, 0, 0); \
        o[d0] = __builtin_amdgcn_mfma_f32_32x32x16_bf16(pa3, (bf16x8){l3[0], l3[1], l3[2], l3[3], h3[0], h3[1], h3[2], h3[3]}, o[d0], 0, 0, 0); } while (0)
    PV_D0(0); PV_D0(1); PV_D0(2); PV_D0(3);
#undef PV_D0
#undef TRRD
}
__device__ __forceinline__ void mask_tile(f32x16& p0, f32x16& p1, int dq  ) {
    const float NEG = -__builtin_inff();
#pragma unroll
    for (int r = 0; r < 16; ++r) { const int c = (r & 3) + 8 * (r >> 2);
        if (c > dq) p0[r] = NEG;
        if (c + 32 > dq) p1[r] = NEG; }
}
__device__ __forceinline__ void softmax_tile(f32x16& p0, f32x16& p1, float& m_reg, float& l_reg, float& alpha, bf16x8& pa0, bf16x8& pa1, bf16x8& pa2, bf16x8& pa3) {
    float pmax = p0[0];
#pragma unroll
    for (int r = 1; r < 16; ++r) pmax = fmaxf(pmax, p0[r]);
#pragma unroll
    for (int r = 0; r < 16; ++r) pmax = fmaxf(pmax, p1[r]);
    { auto rr = __builtin_amdgcn_permlane32_swap(__float_as_uint(pmax), __float_as_uint(pmax), false, false); pmax = fmaxf(__uint_as_float(rr[0]), __uint_as_float(rr[1])); }
    float mn = m_reg; alpha = 1.f;
    if (!__all(pmax - m_reg <= 8.0f)) { mn = fmaxf(m_reg, pmax); alpha = __builtin_amdgcn_exp2f(m_reg - mn); m_reg = mn; }
    float ps = 0.f;
#pragma unroll
    for (int r = 0; r < 16; ++r) { p0[r] = __builtin_amdgcn_exp2f(p0[r] - mn); ps += p0[r]; }
#pragma unroll
    for (int r = 0; r < 16; ++r) { p1[r] = __builtin_amdgcn_exp2f(p1[r] - mn); ps += p1[r]; }
    { auto rr = __builtin_amdgcn_permlane32_swap(__float_as_uint(ps), __float_as_uint(ps), false, false); ps = __uint_as_float(rr[0]) + __uint_as_float(rr[1]); }
    l_reg = l_reg * alpha + ps;
#define PK4(P, B_, OUT) do { unsigned a0 = cvt_pk_bf16(P[B_+0], P[B_+1]), a1 = cvt_pk_bf16(P[B_+2], P[B_+3]); \
        unsigned b0 = cvt_pk_bf16(P[B_+4], P[B_+5]), b1 = cvt_pk_bf16(P[B_+6], P[B_+7]); \
        auto r0 = __builtin_amdgcn_permlane32_swap(a0, b0, false, false); auto r1 = __builtin_amdgcn_permlane32_swap(a1, b1, false, false); \
        u32x4 w = {r0[0], r1[0], r0[1], r1[1]}; OUT = __builtin_bit_cast(bf16x8, w); } while (0)
    PK4(p0, 0, pa0); PK4(p0, 8, pa1); PK4(p1, 0, pa2); PK4(p1, 8, pa3);
#undef PK4
}

__device__ __forceinline__ void attn_block(int b, int h, int qb, const bf16_t* Q, const bf16_t* KN, const bf16_t* KR, const bf16_t* V, bf16_t* O, LAS char* lds, unsigned long long* pw = nullptr) {
    const int tid = opaque_tid(), wid = __builtin_amdgcn_readfirstlane(tid >> 6), lane = tid & 63, r32 = lane & 31, hi = lane >> 5;
    const size_t row0 = (size_t)b * SEQ;
    const int q0 = qb * QB + wid * QBLK;
    const int NT = (qb + 1) * (QB / KVBLK);
    LAS char* V_lds = lds + OFF_V; LAS char* K_lds = lds + OFF_K;
    LAS float* ws = (LAS float*)(lds + OFF_WS) + wid * 64; LAS float* li_l = ws; LAS float* al_l = ws + 32;
    const int sr = tid >> 4, sc = (tid & 15) * 8, kr_row = tid >> 3, kr_c = tid & 7;
    const int vst0 = v_st(sr, sc), vst1 = v_st(32 + sr, sc), kws = k_addr(sr, tid & 15), kwr = k_addr(kr_row, 16 + kr_c);
    const int vb0 = (int)(uintptr_t)lds + v_rd_base(lane);
    const bf16_t* KNh = KN + row0 * 1024 + h * 128 + sc; const bf16_t* Vh = V + row0 * 1024 + h * 128 + sc; const bf16_t* KRb = KR + row0 * 64 + kr_c * 8;
    bf16x8 st_k0, st_k1, st_kr, st_v0, st_v1;
#define SLOAD(t) do { const size_t k0_ = (size_t)(t) * KVBLK; \
        st_k0 = *(const bf16x8*)(KNh + (k0_ + sr) * 1024); st_k1 = *(const bf16x8*)(KNh + (k0_ + 32 + sr) * 1024); st_kr = *(const bf16x8*)(KRb + (k0_ + kr_row) * 64); \
        st_v0 = *(const bf16x8*)(Vh + (k0_ + sr) * 1024); st_v1 = *(const bf16x8*)(Vh + (k0_ + 32 + sr) * 1024); } while (0)
#define SWRITE(bf, vo) do { *(LAS bf16x8*)(K_lds + (bf) * SHM_K + kws) = st_k0; *(LAS bf16x8*)(K_lds + (bf) * SHM_K + kws + 32 * KPITCH) = st_k1; *(LAS bf16x8*)(K_lds + (bf) * SHM_K + kwr) = st_kr; \
        *(LAS bf16x8*)(V_lds + (vo) + vst0) = st_v0; *(LAS bf16x8*)(V_lds + (vo) + vst1) = st_v1; } while (0)
    SLOAD(0);
    bf16x8 qr[12];
    { const bf16_t* Qw = Q + (row0 + q0 + r32) * 1536 + h * 192 + hi * 8;
#pragma unroll
      for (int d0 = 0; d0 < 12; ++d0) qr[d0] = *(const bf16x8*)(Qw + d0 * 16); }
    float m_reg = -1e30f, l_reg = 0.f; f32x16 o[4] = {};
    f32x16 p0, p1; bf16x8 pa0, pa1, pa2, pa3; float alpha;
    asm volatile("s_waitcnt vmcnt(0)" ::: "memory");
    SWRITE(0, 0);
    __syncthreads();
    const bool odd = wid >= 4; int vo_prev = 0, vo_cur = 0, vo_next = SHM_V;
#define RESC(a) do { if (__any((a) < 1.f)) { if (hi == 0) al_l[r32] = (a); asm volatile("s_waitcnt lgkmcnt(0)" ::: "memory"); \
        _Pragma("unroll") for (int d_ = 0; d_ < 4; ++d_) _Pragma("unroll") for (int r = 0; r < 16; ++r) o[d_][r] *= al_l[crow(r, hi)]; } } while (0)
#if PROBE_T
    unsigned long long pa_ = 0, pb_ = 0, pc_ = 0, pd_ = 0, pe2_ = 0; const unsigned long long pst_ = __builtin_amdgcn_s_memtime();
#define PSTAMP(v) const unsigned long long v = __builtin_amdgcn_s_memtime()
#define PACC(acc, a, b) acc += (b) - (a)
#else
#define PSTAMP(v) do {} while (0)
#define PACC(acc, a, b) do {} while (0)
#endif
#define TILE(t, BF) do { PSTAMP(s0_); const bool more_ = ((t) + 1 < NT); if (more_) SLOAD((t) + 1); SBAR(); \
        if (odd && (t) > 0) { pv_tile(o, vb0 + vo_prev, pa0, pa1, pa2, pa3); SBAR(); } \
        PSTAMP(s1_); qkt<BF>(p0, p1, K_lds, r32, hi, qr); \
        { const int kb_ = (t) * KVBLK; if (kb_ + KVBLK - 1 > q0) mask_tile(p0, p1, q0 + r32 - kb_ - 4 * hi); } \
        asm volatile("" : "+v"(p0), "+v"(p1)); PSTAMP(s2_); \
        softmax_tile(p0, p1, m_reg, l_reg, alpha, pa0, pa1, pa2, pa3); RESC(alpha); SBAR(); PSTAMP(s3_); \
        if (!odd) pv_tile(o, vb0 + vo_cur, pa0, pa1, pa2, pa3); \
        PSTAMP(s4_); if (more_) { asm volatile("s_waitcnt vmcnt(0)" ::: "memory"); SWRITE((BF) ^ 1, vo_next); } \
        PSTAMP(s5_); __syncthreads(); PSTAMP(s6_); PACC(pa_, s1_, s2_); PACC(pb_, s2_, s3_); PACC(pc_, s3_, s4_); PACC(pd_, s4_, s5_); PACC(pe2_, s5_, s6_); vo_prev = vo_cur; vo_cur = vo_next; vo_next = (vo_next == (NVB - 1) * SHM_V) ? 0 : vo_next + SHM_V; } while (0)
#pragma unroll 1
    for (int t = 0; t < NT; t += 2) { TILE(t, 0); TILE(t + 1, 1); }
    if (odd) pv_tile(o, vb0 + vo_prev, pa0, pa1, pa2, pa3);
#if PROBE_T
    if (pw && blockIdx.x == 0 && tid == 0) { pw[8] += pa_; pw[9] += pb_; pw[10] += pc_; pw[11] += pd_; pw[12] += pe2_; pw[13] += (unsigned long long)NT; pw[14] += __builtin_amdgcn_s_memtime() - pst_; }
#endif
    if (hi == 0) li_l[r32] = l_reg; asm volatile("s_waitcnt lgkmcnt(0)" ::: "memory");
    __syncthreads();
    { LAS bf16_t* stg = (LAS bf16_t*)(lds + wid * 8704);
#pragma unroll
      for (int r = 0; r < 16; ++r) { const int orow = crow(r, hi); const float rl = __builtin_amdgcn_rcpf(li_l[orow]);
#pragma unroll
          for (int d0 = 0; d0 < 4; ++d0) { const float v = o[d0][r] * rl; stg[orow * 136 + d0 * 32 + r32] = (bf16_t)(cvt_pk_bf16(v, v) & 0xffffu); } }
      asm volatile("s_waitcnt lgkmcnt(0)" ::: "memory");
      bf16_t* Ow = O + (row0 + q0) * 1024 + h * 128 + (lane & 15) * 8;
#pragma unroll
      for (int it = 0; it < 8; ++it) { const int row = it * 4 + (lane >> 4); const u32x4 v = *(const LAS u32x4*)(stg + row * 136 + (lane & 15) * 8); *(u32x4*)(Ow + (size_t)row * 1024) = v; } }
    __syncthreads();
#undef SLOAD
#undef SWRITE
#undef RESC
#undef TILE
#undef PSTAMP
#undef PACC
}
#undef SBAR
}

#define XB_TMO      128
#define XB_XCNT(j)  (256  + 64 * (j))
#define XB_XSUB(j)  (1280 + 64 * (j))
#define XB_XGEN(j)  (2304 + 64 * (j))
#define XB_TOP      3328
#define XB_TOPGEN   3392
#define XCD_BAR_WORDS 3456
#define XB_SPIN_CAP (1u << 22)
__device__ __forceinline__ unsigned xb_ld(unsigned* p)              { return __hip_atomic_load(p, __ATOMIC_RELAXED, __HIP_MEMORY_SCOPE_AGENT); }
__device__ __forceinline__ unsigned xb_add(unsigned* p, unsigned v) { return __hip_atomic_fetch_add(p, v, __ATOMIC_RELAXED, __HIP_MEMORY_SCOPE_AGENT); }
__device__ __forceinline__ unsigned xb_xcc_id() { return (unsigned)__builtin_amdgcn_s_getreg((3 << 11) | 20) & 0xFu; }
#define XB_SPIN(cond, bar) do { unsigned _sp = 0; while (cond) { __builtin_amdgcn_s_sleep(1); \
    if ((++_sp & 255u) == 0u) { if (xb_ld(&(bar)[XB_TMO])) break; if (_sp > XB_SPIN_CAP) { atomicAdd(&(bar)[XB_TMO], 1u); break; } } } } while (0)
struct XcdBarrier { unsigned* bar; unsigned x; volatile LAS unsigned* st; };
__device__ __forceinline__ XcdBarrier xcd_barrier_post(unsigned* bar, volatile LAS unsigned* st) {
    XcdBarrier b; b.bar = bar; b.x = xb_xcc_id(); b.st = st;
    if (threadIdx.x == 0) (void)xb_add(&bar[XB_XCNT(b.x)], 1u);
    return b;
}
__device__ __forceinline__ void xcd_barrier_complete(unsigned* bar, unsigned x, unsigned& nloc, unsigned& nx) {
    const unsigned G = gridDim.x * gridDim.y * gridDim.z;
    unsigned sum, cnt, mine, sp = 0u;
    for (;;) {
        sum = 0u; cnt = 0u; mine = 0u;
#pragma unroll
        for (unsigned j = 0; j < 16; ++j) { const unsigned c = xb_ld(&bar[XB_XCNT(j)]); sum += c; cnt += (c > 0u) ? 1u : 0u; mine = (j == x) ? c : mine; }
        if (sum == G) break;
        __builtin_amdgcn_s_sleep(1);
        if ((++sp & 255u) == 0u) { if (xb_ld(&bar[XB_TMO])) break; if (sp > XB_SPIN_CAP) { atomicAdd(&bar[XB_TMO], 1u); break; } }
    }
    nloc = mine > 0u ? mine : 1u; nx = cnt > 0u ? cnt : 1u;
}
__device__ __forceinline__ void xcd_barrier(const XcdBarrier& b) {
    asm volatile("s_waitcnt vmcnt(0)" ::: "memory");
    __syncthreads();
    if (opaque_tid() == 0) {
        unsigned* bar = b.bar; unsigned bx = b.x;
        asm volatile("" : "+s"(bar), "+s"(bx));
        __builtin_amdgcn_s_waitcnt(0);
        unsigned nloc = b.st[0], nx = b.st[1];
        if (nloc == 0u) { xcd_barrier_complete(bar, bx, nloc, nx); b.st[0] = nloc; b.st[1] = nx; }
        const unsigned old = xb_add(&bar[XB_XSUB(bx)], 1u);
        const unsigned gen = old / nloc;
        if (old + 1u == (gen + 1u) * nloc) {
            __builtin_amdgcn_fence(__ATOMIC_RELEASE, "agent");
            asm volatile("s_waitcnt vmcnt(0)" ::: "memory");
            const unsigned og = xb_add(&bar[XB_TOP], 1u);
            const unsigned tg = og / nx;
            if (og + 1u == (tg + 1u) * nx) xb_add(&bar[XB_TOPGEN], 1u);
            else XB_SPIN(xb_ld(&bar[XB_TOPGEN]) == tg, bar);
            __builtin_amdgcn_fence(__ATOMIC_ACQUIRE, "agent");
            xb_add(&bar[XB_XGEN(bx)], 1u);
            asm volatile("s_waitcnt vmcnt(0)" ::: "memory");
        } else {
            XB_SPIN(xb_ld(&bar[XB_XGEN(bx)]) == gen, bar);
            __builtin_amdgcn_fence(__ATOMIC_ACQUIRE, "agent");
            asm volatile("s_waitcnt vmcnt(0)" ::: "memory");
        }
    }
    __syncthreads();
}

struct Args { const void* in[30]; float* out; unsigned char* ws; int ph_lo, ph_hi, li, pad; };
struct Ctx { int tid, lane, wave, vcu, G, bid; LAS unsigned char* lds; volatile LAS int* misc; };
__device__ __forceinline__ Ctx fresh_ctx(const Ctx& c) {
    Ctx r = c; unsigned l = (unsigned)(uintptr_t)c.lds, m = (unsigned)(uintptr_t)c.misc;
    asm volatile("" : "+s"(r.wave), "+s"(r.vcu), "+s"(r.G), "+s"(r.bid), "+s"(l), "+s"(m));
    r.lds = (LAS unsigned char*)(uintptr_t)l; r.misc = (volatile LAS int*)(uintptr_t)m; r.tid = opaque_tid(); r.lane = r.tid & 63; return r; }
typedef const CAS Args* ArgsP;
__device__ __forceinline__ const CAS Args& fresh_args(ArgsP p) { asm volatile("" : "+s"(p)); return *p; }
enum { I_X = 0, I_P, I_POS, I_MLA_WIN, I_MLA_QN, I_MLA_KVN, I_MLA_WUQ, I_MLA_WUKV, I_MLA_WO, I_LRU_WIN, I_LRU_CW, I_LRU_CB, I_LRU_WA, I_LRU_BA, I_LRU_WX, I_LRU_BX, I_LRU_LAM, I_LRU_WOUT,
       I_LN1G, I_LN1B, I_LN2G, I_LN2B, I_MOE_WR, I_MOE_BR, I_MOE_WUP, I_MOE_BUP, I_MOE_WDN, I_MOE_BDN, I_PLE_WG, I_PLE_WP };
#define INF(i) ((const float*)args.in[i])
#define WSP(T_, off) ((T_*)(args.ws + (off)))

__device__ __forceinline__ void tr_load(const float* W, int ld, int k0, int sc0, int sc1, int lane, f32x4 (&v)[16]) {
    const int half = (lane & 15) >> 3, scol = half ? sc1 : sc0, c4 = (lane & 7) * 4, rs = lane >> 4;
#pragma unroll
    for (int i = 0; i < 8; ++i) { const float* p = W + (size_t)(k0 + 8 * i + 2 * rs) * ld + scol + c4;
        v[2 * i] = (scol >= 0) ? *(const f32x4*)p : (f32x4){0.f, 0.f, 0.f, 0.f}; v[2 * i + 1] = (scol >= 0) ? *(const f32x4*)(p + ld) : (f32x4){0.f, 0.f, 0.f, 0.f}; }
}
__device__ __forceinline__ void tr_store(f32x4 (&v)[16], const float* ksc, int k0, bf16_t* dst  , int K, LAS unsigned* scr, int lane) {
    const int rs = lane >> 4;
    if (ksc) {
#pragma unroll
        for (int i = 0; i < 8; ++i) { v[2 * i] = v[2 * i] * ksc[k0 + 8 * i + 2 * rs]; v[2 * i + 1] = v[2 * i + 1] * ksc[k0 + 8 * i + 2 * rs + 1]; } }
#pragma unroll
    for (int i = 0; i < 8; ++i) { LAS unsigned* s = scr + (4 * i + rs) * 65 + (lane & 15) * 4;
#pragma unroll
        for (int e = 0; e < 4; ++e) s[e] = cvt_pk_bf16(v[2 * i][e], v[2 * i + 1][e]); }
    asm volatile("s_waitcnt lgkmcnt(0)" ::: "memory");
    const int c = lane & 7;
#pragma unroll
    for (int j = 0; j < 8; ++j) { const int n = (lane >> 3) + 8 * j; const LAS unsigned* s = scr + (4 * c) * 65 + n;
        u32x4 o; o.x = s[0]; o.y = s[65]; o.z = s[130]; o.w = s[195];
        *(u32x4*)(dst + (size_t)n * K + 8 * c) = o; }
    asm volatile("s_waitcnt lgkmcnt(0)" ::: "memory");
}
enum { J_NAT = 0, J_MLA_WIN, J_MLA_WUQ, J_LRU_WAX, J_MOE_UP };
__device__ __forceinline__ int tr_map(int job, int g) {
    switch (job) {
    case J_MLA_WIN: return g < 32 ? 32 * g : (g == 32 ? 1024 : (g == 36 ? 1056 : -1));
    case J_MLA_WUQ: if (g < 32) { const int t = g >> 3, bj = (g >> 2) & 1, cg = g & 3; return (2 * t + bj) * 192 + 32 * cg; }
                    else { const int g2 = g - 32, t2 = g2 >> 3, bj = (g2 >> 2) & 1, hh = g2 & 3; return (4 * t2 + hh) * 192 + 128 + 32 * bj; }
    case J_LRU_WAX: { const int pn = g >> 3, cg = g & 3; return 128 * pn + 32 * cg; }
    case J_MOE_UP:  { const int pn = g >> 3, bj = (g >> 2) & 1, cg = g & 3; return bj * 1024 + 128 * pn + 32 * cg; }
    default: return 32 * g;
    }
}
__device__ __forceinline__ void tr_job(const Ctx& C, int job, const float* src, size_t srcstride, int nmat, int K, int ld, int N, bf16_t* dst, size_t dststride, const float* ksc, int kscstride,
                                       const float* src2  ) {
    LAS unsigned* scr = (LAS unsigned*)(C.lds + C.wave * 8320);
    const int gw = C.vcu * NWAVES + C.wave, NGW = C.G * NWAVES;
    const int nkb = K / 64, nnb = N / 64, per = nkb * nnb, total = per * nmat;
#define TR_DECODE(it_, W_, k0_, s0_, s1_, ks_, d_) do { const int mat_ = (it_) / per, r_ = (it_) - mat_ * per, kb_ = r_ / nnb, nb_ = r_ - kb_ * nnb; \
        s0_ = tr_map(job, 2 * nb_); s1_ = tr_map(job, 2 * nb_ + 1); W_ = src + (size_t)mat_ * srcstride; \
        if (job == J_LRU_WAX && ((nb_ >> 1) & 1)) W_ = src2 + (size_t)mat_ * srcstride;       \
        k0_ = kb_ * 64; ks_ = ksc ? ksc + (size_t)mat_ * kscstride : nullptr; d_ = (bf16_t*)((char*)dst + (size_t)mat_ * dststride) + (size_t)(nb_ * 64) * K + kb_ * 64; } while (0)
    f32x4 va[16], vb[16];
    int it = gw; const float* Wc; int k0c, s0c, s1c; const float* ksc_c; bf16_t* dc;
    if (it < total) { TR_DECODE(it, Wc, k0c, s0c, s1c, ksc_c, dc); tr_load(Wc, ld, k0c, s0c, s1c, C.lane, va); }
    while (it < total) {
        const int nit = it + NGW; const float* Wn = nullptr; int k0n = 0, s0n = 0, s1n = 0; const float* ksc_n = nullptr; bf16_t* dn = nullptr;
        if (nit < total) { TR_DECODE(nit, Wn, k0n, s0n, s1n, ksc_n, dn); tr_load(Wn, ld, k0n, s0n, s1n, C.lane, vb); }
        tr_store(va, ksc_c, k0c, dc, K, scr, C.lane);
#pragma unroll
        for (int i = 0; i < 16; ++i) va[i] = vb[i];
        it = nit; k0c = k0n; ksc_c = ksc_n; dc = dn;
    }
#undef TR_DECODE
}
template <int JOB, int N, bool G64  >
__device__ __forceinline__ void tr_job_fp8(const Ctx& C, const float* src, size_t srcstride, int nmat, unsigned char* dst, size_t dststride, unsigned char* SW) {
    constexpr int K = 1024, ld = N;
    LAS float* scr = (LAS float*)(C.lds + C.wave * 16640);
    const int gw = C.vcu * NWAVES + C.wave, NGW = C.G * NWAVES, lane = C.lane;
    const int nkb = K / 64, nnb = N / 64, per = nkb * nnb, total = per * nmat;
    for (int it = gw; it < total; it += NGW) {
        const int mat = it / per, r = it - mat * per, kb = r / nnb, nb = r - kb * nnb;
        const int s0 = tr_map(JOB, 2 * nb), s1 = tr_map(JOB, 2 * nb + 1);
        f32x4 v[16];
        tr_load(src + (size_t)mat * srcstride, ld, kb * 64, s0, s1, lane, v);
        const int rs = lane >> 4;
#pragma unroll
        for (int i = 0; i < 8; ++i) { LAS float* sp = scr + (8 * i + 2 * rs) * 65 + (lane & 15) * 4;
#pragma unroll
            for (int e = 0; e < 4; ++e) { sp[e] = v[2 * i][e]; sp[65 + e] = v[2 * i + 1][e]; } }
        asm volatile("s_waitcnt lgkmcnt(0)" ::: "memory");
        const int c = lane & 7;
#pragma unroll
        for (int j = 0; j < 8; ++j) { const int n = (lane >> 3) + 8 * j; const LAS float* sp = scr + (8 * c) * 65 + n;
            float x[8]; float am = 0.f;
#pragma unroll
            for (int q = 0; q < 8; ++q) { x[q] = sp[q * 65]; am = fmaxf(am, fabsf(x[q])); }
            am = fmaxf(am, __shfl_xor(am, 1)); am = fmaxf(am, __shfl_xor(am, 2));
            if (G64) am = fmaxf(am, __shfl_xor(am, 4));
            int eb = (int)((__float_as_uint(am) >> 23) & 0xffu) - 7; eb = eb < 1 ? 1 : eb;
            const float inv = __uint_as_float((unsigned)(254 - eb) << 23);
            int w0 = __builtin_amdgcn_cvt_pk_fp8_f32(x[0] * inv, x[1] * inv, 0, false); w0 = __builtin_amdgcn_cvt_pk_fp8_f32(x[2] * inv, x[3] * inv, w0, true);
            int w1 = __builtin_amdgcn_cvt_pk_fp8_f32(x[4] * inv, x[5] * inv, 0, false); w1 = __builtin_amdgcn_cvt_pk_fp8_f32(x[6] * inv, x[7] * inv, w1, true);
            const int nrow = nb * 64 + n;
            *(u32x2*)(dst + (size_t)mat * dststride + (size_t)nrow * K + kb * 64 + 8 * c) = (u32x2){(unsigned)w0, (unsigned)w1};
            if (!G64) { if ((c & 3) == 0) SW[(size_t)mat * 65536 + (size_t)(nrow >> 8) * 8192 + (size_t)(kb >> 1) * 1024 + (nrow & 255) * 4 + 2 * (kb & 1) + (c >> 2)] = (unsigned char)eb; }
            else { if (c == 0) SW[(size_t)mat * 16384 + (size_t)(nrow >> 8) * 4096 + (size_t)(kb >> 1) * 512 + (nrow & 255) * 2 + (kb & 1)] = (unsigned char)eb; } }
        asm volatile("s_waitcnt lgkmcnt(0)" ::: "memory");
    }
}
__device__ __forceinline__ void cvt_rows(const Ctx& C, const float* src, bf16_t* dst, size_t n8  ) {
    const size_t gt = (size_t)C.vcu * 512 + C.tid, NT = (size_t)C.G * 512;
    for (size_t i = gt; i < n8; i += NT) { const f32x4 a = *(const f32x4*)(src + i * 8), b = *(const f32x4*)(src + i * 8 + 4); *(u32x4*)(dst + i * 8) = pack8(a, b); }
}
__device__ __forceinline__ void phase_prologue(const CAS Args& args, const Ctx& C) {
    tr_job(C, J_MLA_WIN, INF(I_MLA_WIN), (size_t)DM * LATD, 2, DM, LATD, 1280, WSP(bf16_t, WS_W_MLA + OFF_MLA_WIN), W_MLA_STRIDE, nullptr, 0, nullptr);
    tr_job(C, J_MLA_WUQ, INF(I_MLA_WUQ), (size_t)QL * 1536, 2, QL, 1536, 1536, WSP(bf16_t, WS_W_MLA + OFF_MLA_WUQ), W_MLA_STRIDE, INF(I_MLA_QN), QL, nullptr);
    tr_job(C, J_NAT, INF(I_MLA_WUKV), (size_t)KVL * 2048, 2, KVL, 2048, 2048, WSP(bf16_t, WS_W_MLA + OFF_MLA_WUKV), W_MLA_STRIDE, INF(I_MLA_KVN), KVL, nullptr);
    tr_job(C, J_NAT, INF(I_MLA_WO), (size_t)DM * DM, 2, DM, DM, DM, WSP(bf16_t, WS_W_MLA + OFF_MLA_WO), W_MLA_STRIDE, nullptr, 0, nullptr);
    tr_job(C, J_NAT, INF(I_LRU_WIN), (size_t)DM * 2048, 2, DM, 2048, 2048, WSP(bf16_t, WS_W_LRU + OFF_LRU_WIN), W_LRU_STRIDE, nullptr, 0, nullptr);
    for (int j = 0; j < 2; ++j)
        tr_job(C, J_LRU_WAX, INF(I_LRU_WA) + (size_t)j * 4 * 65536, (size_t)256 * 256, 4, 256, 256, 512, WSP(bf16_t, WS_W_LRU + OFF_LRU_WAX + (size_t)j * W_LRU_STRIDE), (size_t)512 * 256 * 2, nullptr, 0, INF(I_LRU_WX) + (size_t)j * 4 * 65536);
    tr_job(C, J_NAT, INF(I_LRU_WOUT), (size_t)DM * DM, 2, DM, DM, DM, WSP(bf16_t, WS_W_LRU + OFF_LRU_WOUT), W_LRU_STRIDE, nullptr, 0, nullptr);
    tr_job(C, J_NAT, INF(I_PLE_WG), (size_t)DM * DM, 4, DM, DM, DM, WSP(bf16_t, WS_W_PLE + OFF_PLE_WG), W_PLE_STRIDE, nullptr, 0, nullptr);
    tr_job(C, J_NAT, INF(I_PLE_WP), (size_t)PLED * DM, 4, PLED, DM, DM, WSP(bf16_t, WS_W_PLE + OFF_PLE_WP), W_PLE_STRIDE, nullptr, 0, nullptr);
    __syncthreads();
    tr_job_fp8<J_MOE_UP, 2048, false>(C, INF(I_MOE_WUP), (size_t)DM * 2048, DEPTH * NE, args.ws + WS_W_UP, (size_t)2048 * 1024, args.ws + WS_SW);
    tr_job_fp8<J_NAT, 1024, true>(C, INF(I_MOE_WDN), (size_t)DFF * DM, DEPTH * NE, args.ws + WS_W_DN, (size_t)1024 * 1024, args.ws + WS_SWD);
    __syncthreads();
    cvt_rows(C, INF(I_X), WSP(bf16_t, WS_XB), (size_t)T * DM / 8);
    cvt_rows(C, INF(I_P), WSP(bf16_t, WS_PB), (size_t)DEPTH * T * PLED / 8);
    { const int* pos = (const int*)args.in[I_POS]; float* CS = WSP(float, WS_CS); float* SN = WSP(float, WS_SN);
      const size_t gt = (size_t)C.vcu * 512 + C.tid, NT = (size_t)C.G * 512;
      for (size_t i = gt; i < (size_t)T * 32; i += NT) { const int tok = (int)(i >> 5), j = (int)(i & 31);
          const double inv = exp(-9.210340371976184 * (double)j / 32.0); const double ang = (double)pos[tok] * inv; double s, c; sincos(ang, &s, &c); CS[i] = (float)c; SN[i] = (float)s; }
      { const float* wr = INF(I_MOE_WR); const float* lg1 = INF(I_LN1G); bf16_t* WRH = WSP(bf16_t, WS_WRH); bf16_t* WRL = WSP(bf16_t, WS_WRL);
        for (size_t i = gt; i < (size_t)DEPTH * 64 * 64; i += NT) { const int l = (int)(i >> 12), st = (int)(i >> 6) & 63, ln = (int)i & 63; float w[8], lo[8];
#pragma unroll
            for (int j = 0; j < 8; ++j) { const int k = 16 * st + 8 * (ln >> 5) + j; w[j] = lg1[l * DM + k] * wr[((size_t)l * DM + k) * NE + (ln & 31)]; }
            u32x4 h; h.x = cvt_pk_bf16(w[0], w[1]); h.y = cvt_pk_bf16(w[2], w[3]); h.z = cvt_pk_bf16(w[4], w[5]); h.w = cvt_pk_bf16(w[6], w[7]);
            lo[0] = w[0] - bf_lo(h.x); lo[1] = w[1] - bf_hi(h.x); lo[2] = w[2] - bf_lo(h.y); lo[3] = w[3] - bf_hi(h.y); lo[4] = w[4] - bf_lo(h.z); lo[5] = w[5] - bf_hi(h.z); lo[6] = w[6] - bf_lo(h.w); lo[7] = w[7] - bf_hi(h.w);
            u32x4 q; q.x = cvt_pk_bf16(lo[0], lo[1]); q.y = cvt_pk_bf16(lo[2], lo[3]); q.z = cvt_pk_bf16(lo[4], lo[5]); q.w = cvt_pk_bf16(lo[6], lo[7]);
            *(u32x4*)(WRH + i * 8) = h; *(u32x4*)(WRL + i * 8) = q; }
        float* RC = WSP(float, WS_RC); const float* lb1 = INF(I_LN1B); const float* rb = INF(I_MOE_BR);
        for (size_t i = gt; i < (size_t)DEPTH * NE; i += NT) { const int l = (int)(i >> 5), e = (int)i & 31; float c1 = 0.f, c2 = 0.f;
            for (int k = 0; k < DM; ++k) { const float w = wr[((size_t)l * DM + k) * NE + e]; c1 = fmaf(lg1[l * DM + k], w, c1); c2 = fmaf(lb1[l * DM + k], w, c2); }
            RC[l * 64 + e] = c1; RC[l * 64 + 32 + e] = c2 + rb[l * NE + e]; } }
      float* SPL = WSP(float, WS_SPL); const float* lam = INF(I_LRU_LAM);
      for (size_t i = gt; i < 2 * 1024; i += NT) { const double l = (double)lam[i]; SPL[i] = (float)(-8.0 * log1p(exp(-l))); } }
}

__device__ __forceinline__ void moe_table(const CAS Args& args, const Ctx& C0, int layer) {
    Ctx C = C0; C.tid = opaque_tid(); C.lane = C.tid & 63;
    const unsigned* cnt = WSP(unsigned, WS_CTL) + CW_CNT + 64 * layer;
    __syncthreads();
    if (C.tid < 32) C.misc[64 + C.tid] = (int)__hip_atomic_load(cnt + C.tid, __ATOMIC_RELAXED, __HIP_MEMORY_SCOPE_AGENT);
    __syncthreads();
    if (C.tid == 0) { int acc = 0; for (int e = 0; e < 32; ++e) { C.misc[16 + e] = acc; acc += (C.misc[64 + e] + 255) >> 8; } C.misc[16 + 32] = acc; }
    __syncthreads();
    { volatile LAS unsigned char* te = (volatile LAS unsigned char*)(C.lds + TILE_E_OFF);
      for (int mg = C.tid; mg < C.misc[48]; mg += NWAVES * 64) { int e = 0; for (int j = 1; j < 32; ++j) e += (C.misc[16 + j] <= mg) ? 1 : 0; te[mg] = (unsigned char)e; } }
    __syncthreads();
}

__device__ __forceinline__ void phase_ln_router(const CAS Args& args, const Ctx& C0, int layer) {
    const int cslot = layer + args.pad;
    Ctx C = C0; C.tid = opaque_tid(); C.lane = C.tid & 63;
    const bf16_t* Y = WSP(bf16_t, WS_Y); bf16_t* X1B = WSP(bf16_t, WS_X1B);
    const float* g1 = INF(I_LN1G) + layer * DM; const float* b1 = INF(I_LN1B) + layer * DM;
    const bf16_t* WRH = WSP(bf16_t, WS_WRH) + (size_t)layer * 64 * 64 * 8; const bf16_t* WRL = WSP(bf16_t, WS_WRL) + (size_t)layer * 64 * 64 * 8; const float* rc = WSP(float, WS_RC) + layer * 64;
    unsigned* gcnt = WSP(unsigned, WS_CTL) + CW_CNT + 64 * cslot;
    int* lists = WSP(int, WS_LIST); int* slot = WSP(int, WS_SLOT); float* gate = WSP(float, WS_GATE);
    LAS float* part = (LAS float*)C.lds;
    volatile LAS int* lcnt = (volatile LAS int*)(C.lds + 69632);
    volatile LAS int* lbase = lcnt + 32;
    LAS float* stat = (LAS float*)(C.lds + 70144);
    f32x4 gv[4], bv[4];
#pragma unroll
    for (int j = 0; j < 2; ++j) { gv[2 * j] = *(const f32x4*)(g1 + 8 * C.lane + 512 * j); gv[2 * j + 1] = *(const f32x4*)(g1 + 8 * C.lane + 512 * j + 4);
        bv[2 * j] = *(const f32x4*)(b1 + 8 * C.lane + 512 * j); bv[2 * j + 1] = *(const f32x4*)(b1 + 8 * C.lane + 512 * j + 4); }
    unsigned char* X1Q = args.ws + WS_X1Q; int sexp;
    { float ag = 0.f, ab = 0.f;
#pragma unroll
      for (int j = 0; j < 4; ++j)
#pragma unroll
          for (int e = 0; e < 4; ++e) { ag = fmaxf(ag, fabsf(gv[j][e])); ab = fmaxf(ab, fabsf(bv[j][e])); }
#pragma unroll
      for (int o = 1; o < 64; o <<= 1) { ag = fmaxf(ag, __shfl_xor(ag, o)); ab = fmaxf(ab, __shfl_xor(ab, o)); }
      const float bound = 16.0f * ag + ab + 1e-20f;
      sexp = 134 - (int)((__float_as_uint(bound) >> 23) & 0xffu);
      sexp = sexp < -100 ? -100 : (sexp > 100 ? 100 : sexp);
      if (C.tid == 0) __hip_atomic_store(WSP(unsigned, WS_CTL) + CW_SA + layer, (unsigned)sexp, __ATOMIC_RELAXED, __HIP_MEMORY_SCOPE_AGENT); }
    const float qs = __uint_as_float((unsigned)(127 + sexp) << 23), qlo = KF(-448.f), qhi = KF(448.f);
    for (int chunk = C.vcu; chunk < T / 128; chunk += C.G) {
        const int row0 = chunk * 128;
        if (C.tid < 32) lcnt[C.tid] = 0;
#pragma unroll 1
        for (int i = 0; i < 16; ++i) { const size_t row = (size_t)row0 + C.wave * 16 + i;
            f32x4 v[4]; float s = 0.f;
#pragma unroll
            for (int j = 0; j < 2; ++j) { const u32x4 w = *(const u32x4*)(Y + row * DM + 8 * C.lane + 512 * j); v[2 * j] = pg8::bf4_lo(w); v[2 * j + 1] = pg8::bf4_hi(w); }
#pragma unroll
            for (int j = 0; j < 4; ++j) s += (v[j][0] + v[j][1]) + (v[j][2] + v[j][3]);
            const float mean = wave_sum(s) * (1.f / DM); float s2 = 0.f;
#pragma unroll
            for (int j = 0; j < 4; ++j) { v[j] = v[j] - mean; s2 += (v[j][0] * v[j][0] + v[j][1] * v[j][1]) + (v[j][2] * v[j][2] + v[j][3] * v[j][3]); }
            const float rstd = 1.f / sqrtf(wave_sum(s2) * (1.f / DM) + KF(LN_EPS));
            if (C.lane == 0) { stat[(C.wave * 16 + i) * 2] = mean; stat[(C.wave * 16 + i) * 2 + 1] = rstd; }
#pragma unroll
            for (int j = 0; j < 4; ++j) v[j] = v[j] * rstd * gv[j] + bv[j];
#pragma unroll
            for (int j = 0; j < 2; ++j) { const u32x4 hw = pack8(v[2 * j], v[2 * j + 1]);
                *(u32x4*)(X1B + row * DM + 8 * C.lane + 512 * j) = hw;
                const f32x4 q0 = v[2 * j] * qs, q1 = v[2 * j + 1] * qs;
                int w0 = __builtin_amdgcn_cvt_pk_fp8_f32(fminf(fmaxf(q0[0], qlo), qhi), fminf(fmaxf(q0[1], qlo), qhi), 0, false); w0 = __builtin_amdgcn_cvt_pk_fp8_f32(fminf(fmaxf(q0[2], qlo), qhi), fminf(fmaxf(q0[3], qlo), qhi), w0, true);
                int w1 = __builtin_amdgcn_cvt_pk_fp8_f32(fminf(fmaxf(q1[0], qlo), qhi), fminf(fmaxf(q1[1], qlo), qhi), 0, false); w1 = __builtin_amdgcn_cvt_pk_fp8_f32(fminf(fmaxf(q1[2], qlo), qhi), fminf(fmaxf(q1[3], qlo), qhi), w1, true);
                *(u32x2*)(X1Q + row * DM + 8 * C.lane + 512 * j) = (u32x2){(unsigned)w0, (unsigned)w1}; } }
        asm volatile("s_waitcnt vmcnt(0)" ::: "memory");
        __syncthreads();
        { const int grp = C.wave >> 1, kh = C.wave & 1, r32 = C.lane & 31, hi = C.lane >> 5;
          const bf16_t* ah = Y + ((size_t)row0 + grp * 32 + r32) * DM + kh * 512 + hi * 8;
          const bf16_t* bh = WRH + ((size_t)kh * 32 * 64 + C.lane) * 8; const bf16_t* bl = WRL + ((size_t)kh * 32 * 64 + C.lane) * 8;
          f32x16 acc = {};
#pragma unroll 4
          for (int st = 0; st < 32; ++st) { const bf16x8 xh = *(const bf16x8*)(ah + st * 16), wh = *(const bf16x8*)(bh + (size_t)st * 512), wl = *(const bf16x8*)(bl + (size_t)st * 512);
              acc = __builtin_amdgcn_mfma_f32_32x32x16_bf16(xh, wh, acc, 0, 0, 0);
              acc = __builtin_amdgcn_mfma_f32_32x32x16_bf16(xh, wl, acc, 0, 0, 0); }
          LAS float* pp = part + (grp * 2 + kh) * 32 * 33 + r32;
#pragma unroll
          for (int r = 0; r < 16; ++r) pp[((r & 3) + 8 * (r >> 2) + 4 * hi) * 33] = acc[r]; }
        __syncthreads();
        int te[4] = {0, 0, 0, 0}, lp[4] = {0, 0, 0, 0}; float tg[4] = {0.f, 0.f, 0.f, 0.f};
        if (C.tid < 128) { const int grp = C.tid >> 5, ln = C.tid & 31; float lg[32];
            const float mean = stat[C.tid * 2], rstd = stat[C.tid * 2 + 1];
#pragma unroll
            for (int e = 0; e < 32; ++e) lg[e] = rstd * ((part[((grp * 2 + 0) * 32 + ln) * 33 + e] + part[((grp * 2 + 1) * 32 + ln) * 33 + e]) - mean * rc[e]) + rc[32 + e];
            float tv[4]; const float kninf = KF(-__builtin_inff());
#pragma unroll
            for (int k = 0; k < 4; ++k) { float best = lg[0]; int bi = 0;
#pragma unroll
                for (int e = 1; e < 32; ++e) { const bool gt = lg[e] > best; best = gt ? lg[e] : best; bi = gt ? e : bi; }
                te[k] = bi; tv[k] = best;
#pragma unroll
                for (int e = 0; e < 32; ++e) lg[e] = (e == bi) ? kninf : lg[e]; }
            float den = 0.f;
#pragma unroll
            for (int k = 0; k < 4; ++k) { tg[k] = __expf(tv[k] - tv[0]); den += tg[k]; }
            const float rden = 1.0f / den;
#pragma unroll
            for (int k = 0; k < 4; ++k) { tg[k] *= rden; lp[k] = __hip_atomic_fetch_add((LAS int*)&lcnt[te[k]], 1, __ATOMIC_RELAXED, __HIP_MEMORY_SCOPE_WORKGROUP); } }
        __syncthreads();
        if (C.tid < 32) lbase[C.tid] = (int)__hip_atomic_fetch_add(gcnt + C.tid, (unsigned)lcnt[C.tid], __ATOMIC_RELAXED, __HIP_MEMORY_SCOPE_AGENT);
        __syncthreads();
        if (C.tid < 128) { const int tok = row0 + C.tid;
#pragma unroll
            for (int k = 0; k < 4; ++k) { const int pos = lbase[te[k]] + lp[k]; lists[(size_t)te[k] * T + pos] = tok; slot[tok * 4 + k] = te[k] * T + pos; gate[tok * 4 + k] = tg[k]; } }
        __syncthreads();
    }
}

__device__ __forceinline__ void phase_combine_ln2(const CAS Args& args, const Ctx& C0, int layer) {
    Ctx C = C0; C.tid = opaque_tid(); C.lane = C.tid & 63;
    moe_table(args, C, layer);
    const bf16_t* X1B = WSP(bf16_t, WS_X1B); const unsigned char* YS = args.ws + WS_YS; const unsigned char* SY = args.ws + WS_SY; const int* slot = WSP(int, WS_SLOT); const float* gate = WSP(float, WS_GATE);
    bf16_t* X2B = WSP(bf16_t, WS_X2B);
    const float* g2 = INF(I_LN2G) + layer * DM; const float* b2 = INF(I_LN2B) + layer * DM;
    f32x4 gv[4], bv[4];
#pragma unroll
    for (int j = 0; j < 2; ++j) { gv[2 * j] = *(const f32x4*)(g2 + 8 * C.lane + 512 * j); gv[2 * j + 1] = *(const f32x4*)(g2 + 8 * C.lane + 512 * j + 4);
        bv[2 * j] = *(const f32x4*)(b2 + 8 * C.lane + 512 * j); bv[2 * j + 1] = *(const f32x4*)(b2 + 8 * C.lane + 512 * j + 4); }
    const int gw = C.vcu * NWAVES + C.wave, NGW = C.G * NWAVES;
    for (int row = gw; row < T; row += NGW) {
        f32x4 v[4];
#pragma unroll
        for (int j = 0; j < 2; ++j) { const u32x4 w = *(const u32x4*)(X1B + (size_t)row * DM + 8 * C.lane + 512 * j); v[2 * j] = pg8::bf4_lo(w) * ALPHA; v[2 * j + 1] = pg8::bf4_hi(w) * ALPHA; }
#pragma unroll
        for (int k = 0; k < 4; ++k) { const int sv = slot[row * 4 + k]; const float g = gate[row * 4 + k]; const int e = sv >> 15, pos = sv & (T - 1);
            const size_t prow = (size_t)C.misc[16 + e] * 256 + pos;
#pragma unroll
            for (int j = 0; j < 2; ++j) { const u32x2 w = *(const u32x2*)(YS + prow * DM + 8 * C.lane + 512 * j); const unsigned eb = SY[prow * 32 + (C.lane >> 2) + 16 * j];
                const float gs = g * __uint_as_float(eb << 23);
                const f32x2 a = __builtin_amdgcn_cvt_pk_f32_fp8((int)w.x, false), b = __builtin_amdgcn_cvt_pk_f32_fp8((int)w.x, true), c = __builtin_amdgcn_cvt_pk_f32_fp8((int)w.y, false), d = __builtin_amdgcn_cvt_pk_f32_fp8((int)w.y, true);
                v[2 * j] += (f32x4){a[0], a[1], b[0], b[1]} * gs; v[2 * j + 1] += (f32x4){c[0], c[1], d[0], d[1]} * gs; } }
        float s = 0.f;
#pragma unroll
        for (int j = 0; j < 4; ++j) s += (v[j][0] + v[j][1]) + (v[j][2] + v[j][3]);
        const float mean = wave_sum(s) * (1.f / DM); float s2 = 0.f;
#pragma unroll
        for (int j = 0; j < 4; ++j) { v[j] = v[j] - mean; s2 += (v[j][0] * v[j][0] + v[j][1] * v[j][1]) + (v[j][2] * v[j][2] + v[j][3] * v[j][3]); }
        const float rstd = 1.f / sqrtf(wave_sum(s2) * (1.f / DM) + KF(LN_EPS));
#pragma unroll
        for (int j = 0; j < 4; ++j) v[j] = v[j] * rstd * gv[j] + bv[j];
#pragma unroll
        for (int j = 0; j < 2; ++j) *(u32x4*)(X2B + (size_t)row * DM + 8 * C.lane + 512 * j) = pack8(v[2 * j], v[2 * j + 1]);
    }
}

__device__ __forceinline__ void phase_conv(const CAS Args& args, const Ctx& C0, int j) {
    Ctx C = C0; C.tid = opaque_tid(); C.lane = C.tid & 63;
    const bf16_t* U = WSP(bf16_t, WS_U); bf16_t* UC = WSP(bf16_t, WS_UC);
    const float* cw = INF(I_LRU_CW) + (size_t)j * 4 * DM; const float* cb = INF(I_LRU_CB) + (size_t)j * DM;
    const int c8 = (C.tid & 127) * 8, rsub = C.tid >> 7;
    float w[4][8], bb[8];
#pragma unroll
    for (int q = 0; q < 4; ++q)
#pragma unroll
        for (int e = 0; e < 8; ++e) w[q][e] = cw[q * DM + c8 + e];
#pragma unroll
    for (int e = 0; e < 8; ++e) bb[e] = cb[c8 + e];
    for (int chunk = C.vcu; chunk < T / 128; chunk += C.G) {
        const int r0 = chunk * 128 + rsub * 32;
        u32x4 h0, h1, h2;
        const u32x4 z = {0u, 0u, 0u, 0u};
        const int s0 = r0 & (SEQ - 1);
        h0 = s0 >= 3 ? *(const u32x4*)(U + (size_t)(r0 - 3) * DM + c8) : z; h1 = s0 >= 2 ? *(const u32x4*)(U + (size_t)(r0 - 2) * DM + c8) : z; h2 = s0 >= 1 ? *(const u32x4*)(U + (size_t)(r0 - 1) * DM + c8) : z;
#pragma unroll 4
        for (int i = 0; i < 32; ++i) { const u32x4 h3 = *(const u32x4*)(U + (size_t)(r0 + i) * DM + c8);
            float o[8];
#pragma unroll
            for (int q = 0; q < 4; ++q) { const unsigned a = h0[q], b = h1[q], c = h2[q], d = h3[q];
                o[2 * q] = bb[2 * q] + w[0][2 * q] * bf_lo(a) + w[1][2 * q] * bf_lo(b) + w[2][2 * q] * bf_lo(c) + w[3][2 * q] * bf_lo(d);
                o[2 * q + 1] = bb[2 * q + 1] + w[0][2 * q + 1] * bf_hi(a) + w[1][2 * q + 1] * bf_hi(b) + w[2][2 * q + 1] * bf_hi(c) + w[3][2 * q + 1] * bf_hi(d); }
            u32x4 ow; ow.x = cvt_pk_bf16(o[0], o[1]); ow.y = cvt_pk_bf16(o[2], o[3]); ow.z = cvt_pk_bf16(o[4], o[5]); ow.w = cvt_pk_bf16(o[6], o[7]);
            *(u32x4*)(UC + (size_t)(r0 + i) * DM + c8) = ow; h0 = h1; h1 = h2; h2 = h3; }
    }
}
__device__ __forceinline__ void phase_scan1(const CAS Args& args, const Ctx& C0) {
    Ctx C = C0; C.tid = opaque_tid(); C.lane = C.tid & 63;
    const bf16_t* LA = WSP(bf16_t, WS_AA); const bf16_t* BB = WSP(bf16_t, WS_BB); float* CA = WSP(float, WS_CA); float* CH = WSP(float, WS_CH);
    const int c2 = C.tid * 2;
    for (int item = C.vcu; item < NBATCH * 64; item += C.G) {
        const size_t r0 = (size_t)item * 64; float h0 = 0.f, h1 = 0.f, l0 = 0.f, l1 = 0.f;
#pragma unroll 8
        for (int s = 0; s < 64; ++s) { const unsigned aw = *(const unsigned*)(LA + (r0 + s) * DM + c2), bw = *(const unsigned*)(BB + (r0 + s) * DM + c2);
            const float la0 = bf_lo(aw), la1 = bf_hi(aw);
            h0 = __builtin_amdgcn_exp2f(la0) * h0 + bf_lo(bw); h1 = __builtin_amdgcn_exp2f(la1) * h1 + bf_hi(bw); l0 += la0; l1 += la1; }
        *(f32x2*)(CA + (size_t)item * DM + c2) = (f32x2){__builtin_amdgcn_exp2f(l0), __builtin_amdgcn_exp2f(l1)}; *(f32x2*)(CH + (size_t)item * DM + c2) = (f32x2){h0, h1};
    }
}
__device__ __forceinline__ void phase_scan2(const CAS Args& args, const Ctx& C0) {
    Ctx C = C0; C.tid = opaque_tid(); C.lane = C.tid & 63;
    const bf16_t* LA = WSP(bf16_t, WS_AA); const bf16_t* BB = WSP(bf16_t, WS_BB); const float* CA = WSP(float, WS_CA); const float* CH = WSP(float, WS_CH);
    const bf16_t* GG = WSP(bf16_t, WS_GG); bf16_t* YL = WSP(bf16_t, WS_O);
    const int c2 = C.tid * 2;
    for (int item = C.vcu; item < NBATCH * 64; item += C.G) {
        const int b = item >> 6, ch = item & 63; float h0 = 0.f, h1 = 0.f;
        for (int jx = 0; jx < ch; ++jx) { const f32x2 a = *(const f32x2*)(CA + (size_t)(b * 64 + jx) * DM + c2), e = *(const f32x2*)(CH + (size_t)(b * 64 + jx) * DM + c2);
            h0 = a[0] * h0 + e[0]; h1 = a[1] * h1 + e[1]; }
        const size_t r0 = (size_t)item * 64;
#pragma unroll 8
        for (int s = 0; s < 64; ++s) { const unsigned aw = *(const unsigned*)(LA + (r0 + s) * DM + c2), bw = *(const unsigned*)(BB + (r0 + s) * DM + c2), g = *(const unsigned*)(GG + (r0 + s) * DM + c2);
            h0 = __builtin_amdgcn_exp2f(bf_lo(aw)) * h0 + bf_lo(bw); h1 = __builtin_amdgcn_exp2f(bf_hi(aw)) * h1 + bf_hi(bw);
            *(unsigned*)(YL + (r0 + s) * DM + c2) = cvt_pk_bf16(bf_lo(g) * h0, bf_hi(g) * h1); }
    }
}

#if PROBE_T
typedef int v8i_t __attribute__((ext_vector_type(8)));
__device__ __forceinline__ unsigned fp8_of_int(int v) { const unsigned char t[4] = {0x00, 0x38, 0x40, 0x44}; const int a = v < 0 ? -v : v; return (unsigned)t[a] | (v < 0 ? 0x80u : 0u); }
__device__ __forceinline__ int tA(int i, int k) { return ((i * 3 + k * 5) % 7) - 3; }
__device__ __forceinline__ int tB(int k, int j) { return ((k * 2 + j * 7) % 5) - 2; }
__device__ __forceinline__ void mfma_fp8_selftest(unsigned* flagw) {
    const int l = threadIdx.x & 63, r = l & 15, q = l >> 4;
    v8i_t A, B;
#pragma unroll
    for (int d = 0; d < 8; ++d) { unsigned wa = 0, wb = 0;
#pragma unroll
        for (int b = 0; b < 4; ++b) { const int k = 32 * q + 4 * d + b; wa |= fp8_of_int(tA(r, k)) << (8 * b); wb |= fp8_of_int(tB(k, r)) << (8 * b); }
        A[d] = (int)wa; B[d] = (int)wb; }
    const f32x4 z = {0.f, 0.f, 0.f, 0.f};
    const int U = 0x7f7f7f7f;
    const int saq = (127 + q) * 0x01010101;
    const int sab = (q == 0) ? (int)0x8281807fu : U;
    const f32x4 m2 = __builtin_amdgcn_mfma_scale_f32_16x16x128_f8f6f4(A, B, z, 0, 0, 0, saq, 0, U);
    const f32x4 m5 = __builtin_amdgcn_mfma_scale_f32_16x16x128_f8f6f4(A, B, z, 0, 0, 0, sab, 0, U);
    bool k1 = true, k2 = true, k3 = true, k4 = true;
#pragma unroll
    for (int e = 0; e < 4; ++e) { const int i = 4 * q + e, j = r; float eb = 0.f, e0 = 0.f, ec = 0.f, ed = 0.f;
        for (int kq = 0; kq < 4; ++kq) for (int hh = 0; hh < 2; ++hh) { float sh = 0.f; for (int k = 32 * kq + 16 * hh; k < 32 * kq + 16 * hh + 16; ++k) sh += (float)(tA(i, k) * tB(k, j));
            const int xb = hh == 0 ? (kq >> 1) : 2 + (kq >> 1);
            eb += sh * (float)(1 << xb); e0 += sh; ec += sh * (float)(1 << kq); ed += sh * (float)(1 << xb); }
        k1 = k1 && (m2[e] == eb); k2 = k2 && (m2[e] == e0); k3 = k3 && (m5[e] == ec); k4 = k4 && (m5[e] == ed); }
    const bool b1 = __all(k1), b2 = __all(k2), b3 = __all(k3), b4 = __all(k4);
    if (l == 0) *flagw = (b1 ? 1u : 0u) | (b2 ? 2u : 0u) | (b3 ? 4u : 0u) | (b4 ? 8u : 0u);
}
#endif
constexpr int PH_PER_LAYER = 12, PH_TOTAL = 2 + PH_PER_LAYER * DEPTH;
__global__ void __launch_bounds__(NWAVES * 64, 2) fwd_kernel(Args args_kernarg) {
    (void)args_kernarg;
    ArgsP const argp = (ArgsP)__builtin_amdgcn_kernarg_segment_ptr();
    const CAS Args& args0 = *argp;
    extern __shared__ __attribute__((aligned(16))) unsigned char lds_raw[];
    Ctx C_;
    C_.lds = (LAS unsigned char*)lds_raw; C_.misc = (volatile LAS int*)(C_.lds + MISC_OFF);
    C_.tid = threadIdx.x; C_.lane = C_.tid & 63; C_.wave = __builtin_amdgcn_readfirstlane(C_.tid >> 6);
    C_.bid = (int)blockIdx.x; C_.G = gridDim.x; { const int bx = blockIdx.x; C_.vcu = (C_.G % 8 == 0) ? (bx % 8) * (C_.G / 8) + bx / 8 : bx; }
    for (int u = C_.tid; u < 128; u += NWAVES * 64) C_.misc[u] = 0;
    __syncthreads();
    XcdBarrier bar = xcd_barrier_post((unsigned*)(args0.ws + WS_CTL) + CW_BAR + args0.li * XCD_BAR_WORDS, (volatile LAS unsigned*)C_.misc);
    const int lo = args0.ph_lo, hi = args0.ph_hi;
#define IN(k) (lo <= (k) && (k) < hi)
#define PH_END(k) do { if ((k) + 1 < hi) xcd_barrier(bar); } while (0)

    if (SEL(0) && IN(0)) { const CAS Args& args = fresh_args(argp); const Ctx C = fresh_ctx(C_); const int cid = C.bid; phase_prologue(args, C); PH_END(0); }
    if (SEL(1) && IN(1)) { const CAS Args& args = fresh_args(argp); const Ctx C = fresh_ctx(C_); const int cid = C.bid;
        pg8::DenseSched S; S.init(WSP(bf16_t, WS_PB), WSP(bf16_t, WS_W_PLE + OFF_PLE_WP), PLED, PLED, DEPTH * T, DM, C.G, cid); S.bpm_shift = 7; S.bbatch = W_PLE_STRIDE;
        pg8::EpiPP E{WSP(bf16_t, WS_PP)};
        pg8::gemm_phase<pg8::EpiPP, pg8::DenseSched, false>(C.lds, PLED / 64, PLED * 2, PLED * 2, S, E);
        PH_END(1);
    }
    for (int layer = 0; layer < DEPTH; ++layer) {
        const int base = 2 + PH_PER_LAYER * layer, j = layer >> 1;
        if ((layer & 1) == 0) {
            if (SEL(2) && IN(base + 0)) { const CAS Args& args = fresh_args(argp); const Ctx C = fresh_ctx(C_); const int cid = C.bid; const unsigned char* wm = args.ws + WS_W_MLA + (size_t)j * W_MLA_STRIDE;
                pg8::DenseSched S; S.init(WSP(bf16_t, WS_XB), wm + OFF_MLA_WIN, DM, DM, T, 1280, C.G, cid);
                pg8::EpiLat E{WSP(bf16_t, WS_LAT), WSP(float, WS_SSQ), WSP(bf16_t, WS_KR), WSP(float, WS_CS), WSP(float, WS_SN)};
                pg8::gemm_phase<pg8::EpiLat, pg8::DenseSched, false>(C.lds, DM / 64, DM * 2, DM * 2, S, E);
                PH_END(base + 0);
            }
            if (SEL(3) && IN(base + 1)) { const CAS Args& args = fresh_args(argp); const Ctx C = fresh_ctx(C_); const int cid = C.bid; const unsigned char* wm = args.ws + WS_W_MLA + (size_t)j * W_MLA_STRIDE;
                { pg8::DenseSched S; S.init(WSP(bf16_t, WS_LAT), wm + OFF_MLA_WUQ, DM, QL, T, 1536, C.G, cid);
                  pg8::EpiQ E{WSP(bf16_t, WS_Q), WSP(float, WS_SSQ), WSP(float, WS_CS), WSP(float, WS_SN)};
                  pg8::gemm_phase<pg8::EpiQ, pg8::DenseSched, false>(C.lds, QL / 64, DM * 2, QL * 2, S, E); }
                { pg8::DenseSched S; S.init(WSP(bf16_t, WS_LAT) + QL, wm + OFF_MLA_WUKV, DM, KVL, T, 2048, C.G, cid);
                  pg8::EpiKV E{WSP(bf16_t, WS_KN), WSP(bf16_t, WS_V), WSP(float, WS_SSQ)};
                  pg8::gemm_phase<pg8::EpiKV, pg8::DenseSched, false>(C.lds, KVL / 64, DM * 2, KVL * 2, S, E); }
                PH_END(base + 1);
            }
            if (SEL(4) && IN(base + 2)) { const CAS Args& args = fresh_args(argp); const Ctx C = fresh_ctx(C_); const int cid = C.bid;
                for (int it = C.vcu; it < NBATCH * NH * 8; it += C.G) { const int bh = it >> 3, pr = it & 7;
                    att::attn_block(bh >> 3, bh & 7, pr, WSP(bf16_t, WS_Q), WSP(bf16_t, WS_KN), WSP(bf16_t, WS_KR), WSP(bf16_t, WS_V), WSP(bf16_t, WS_O), (LAS char*)C.lds, PROBE_T ? (unsigned long long*)(args.ws + WS_CTL + 8192) : nullptr);
                    att::attn_block(bh >> 3, bh & 7, 15 - pr, WSP(bf16_t, WS_Q), WSP(bf16_t, WS_KN), WSP(bf16_t, WS_KR), WSP(bf16_t, WS_V), WSP(bf16_t, WS_O), (LAS char*)C.lds, PROBE_T ? (unsigned long long*)(args.ws + WS_CTL + 8192) : nullptr); }
                PH_END(base + 2);
            }
        } else {
            if (SEL(5) && IN(base + 0)) { const CAS Args& args = fresh_args(argp); const Ctx C = fresh_ctx(C_); const int cid = C.bid; const unsigned char* wl = args.ws + WS_W_LRU + (size_t)j * W_LRU_STRIDE;
                pg8::DenseSched S; S.init(WSP(bf16_t, WS_XB), wl + OFF_LRU_WIN, DM, DM, T, 2048, C.G, cid);
                pg8::EpiGU E{WSP(bf16_t, WS_GG), WSP(bf16_t, WS_U)};
                pg8::gemm_phase<pg8::EpiGU, pg8::DenseSched, false>(C.lds, DM / 64, DM * 2, DM * 2, S, E);
                PH_END(base + 0);
            }
            if (SEL(6) && IN(base + 1)) { const CAS Args& args = fresh_args(argp); const Ctx C = fresh_ctx(C_); const int cid = C.bid; phase_conv(args, C, j); PH_END(base + 1); }
            if (SEL(7) && IN(base + 2)) { const CAS Args& args = fresh_args(argp); const Ctx C = fresh_ctx(C_); const int cid = C.bid; const unsigned char* wl = args.ws + WS_W_LRU + (size_t)j * W_LRU_STRIDE;
                pg8::DenseSched S; S.init(WSP(bf16_t, WS_UC), wl + OFF_LRU_WAX, DM, 256, T, 2048, C.G, cid); S.apn_shift = 1; S.akbytes = 512;
                pg8::EpiAB E{WSP(bf16_t, WS_AA), WSP(bf16_t, WS_BB), WSP(bf16_t, WS_UC), INF(I_LRU_BA) + j * DM, INF(I_LRU_BX) + j * DM, WSP(float, WS_SPL) + j * DM};
                pg8::gemm_phase<pg8::EpiAB, pg8::DenseSched, false>(C.lds, 4, DM * 2, 512, S, E);
                PH_END(base + 2);
            }
            if (SEL(8) && IN(base + 3)) { const CAS Args& args = fresh_args(argp); const Ctx C = fresh_ctx(C_); const int cid = C.bid; phase_scan1(args, C); PH_END(base + 3); }
            if (SEL(9) && IN(base + 4)) { const CAS Args& args = fresh_args(argp); const Ctx C = fresh_ctx(C_); const int cid = C.bid; phase_scan2(args, C); PH_END(base + 4); }
        }
        if (SEL(10) && IN(base + 5)) { const CAS Args& args = fresh_args(argp); const Ctx C = fresh_ctx(C_); const int cid = C.bid;
            const unsigned char* wo = (layer & 1) ? args.ws + WS_W_LRU + (size_t)j * W_LRU_STRIDE + OFF_LRU_WOUT : args.ws + WS_W_MLA + (size_t)j * W_MLA_STRIDE + OFF_MLA_WO;
            pg8::DenseSched S; S.init(WSP(bf16_t, WS_O), wo, DM, DM, T, DM, C.G, cid);
            pg8::EpiRes E{WSP(bf16_t, WS_XB), WSP(bf16_t, WS_Y)};
            pg8::gemm_phase<pg8::EpiRes, pg8::DenseSched, false>(C.lds, DM / 64, DM * 2, DM * 2, S, E);
            PH_END(base + 5);
        }
        if (SEL(11) && IN(base + 6)) { const CAS Args& args = fresh_args(argp); const Ctx C = fresh_ctx(C_); const int cid = C.bid; phase_ln_router(args, C, layer); PH_END(base + 6); }
        if (SEL(12) && IN(base + 7)) { const CAS Args& args = fresh_args(argp); const Ctx C = fresh_ctx(C_); const int cid = C.bid;
            moe_table(args, C, layer);
            pg8::MoeSched S{(const char*)(args.ws + WS_X1Q), (const char*)(args.ws + WS_W_UP + (size_t)layer * NE * 2048 * 1024), (size_t)2048 * 1024, (const char*)(args.ws + WS_SW + (size_t)layer * NE * 65536), DM, DM, 8, WSP(int, WS_LIST), C.misc + 16, (volatile LAS const unsigned char*)(C.lds + TILE_E_OFF), C.G, cid, true, nullptr};
            const int sae = 127 - (int)__hip_atomic_load(WSP(unsigned, WS_CTL) + CW_SA + layer, __ATOMIC_RELAXED, __HIP_MEMORY_SCOPE_AGENT);
            pg8::EpiUp E{args.ws + WS_H, args.ws + WS_SH, INF(I_MOE_BUP) + (size_t)layer * NE * 2048};
            pg8::gemm_phase<pg8::EpiUp, pg8::MoeSched, true, 1>(C.lds, DM / 128, DM, DM, S, E, PROBE_T ? (unsigned long long*)(args.ws + WS_CTL + 8192) : nullptr, sae * 0x01010101);
            PH_END(base + 7);
        }
        if (SEL(13) && IN(base + 8)) { const CAS Args& args = fresh_args(argp); const Ctx C = fresh_ctx(C_); const int cid = C.bid;
            moe_table(args, C, layer);
            pg8::MoeSched S{(const char*)(args.ws + WS_H), (const char*)(args.ws + WS_W_DN + (size_t)layer * NE * 1024 * 1024), (size_t)1024 * 1024, (const char*)(args.ws + WS_SWD + (size_t)layer * NE * 16384), DFF, DFF, 4, WSP(int, WS_LIST), C.misc + 16, (volatile LAS const unsigned char*)(C.lds + TILE_E_OFF), C.G, cid, false, (const char*)(args.ws + WS_SH)};
            pg8::EpiDown E{args.ws + WS_YS, args.ws + WS_SY, INF(I_MOE_BDN) + (size_t)layer * NE * DM};
            pg8::gemm_phase<pg8::EpiDown, pg8::MoeSched, false, 2>(C.lds, DFF / 128, DFF, DFF, S, E);
            PH_END(base + 8);
        }
        if (SEL(14) && IN(base + 9)) { const CAS Args& args = fresh_args(argp); const Ctx C = fresh_ctx(C_); const int cid = C.bid; phase_combine_ln2(args, C, layer); PH_END(base + 9); }
        if (SEL(15) && IN(base + 10)) { const CAS Args& args = fresh_args(argp); const Ctx C = fresh_ctx(C_); const int cid = C.bid;
            pg8::DenseSched S; S.init(WSP(bf16_t, WS_X2B), args.ws + WS_W_PLE + (size_t)layer * W_PLE_STRIDE + OFF_PLE_WG, DM, DM, T, DM, C.G, cid);
            pg8::EpiPle E{WSP(bf16_t, WS_X2B), WSP(bf16_t, WS_PP) + (size_t)layer * T * DM, layer == DEPTH - 1 ? args.out : (float*)nullptr, WSP(bf16_t, WS_XB)};
            pg8::gemm_phase<pg8::EpiPle, pg8::DenseSched, false>(C.lds, DM / 64, DM * 2, DM * 2, S, E);
            if (layer + 1 < DEPTH) PH_END(base + 10);
        }
    }
#if PROBE_T
    if (PROBE_T == 20 && blockIdx.x == 0 && threadIdx.x < 64) { const CAS Args& args = fresh_args(argp); mfma_fp8_selftest((unsigned*)(args.ws + WS_CTL + 8192 + 256)); }
    { xcd_barrier(bar); const CAS Args& args = fresh_args(argp);
      const unsigned long long* pw = (const unsigned long long*)(args.ws + WS_CTL + 8192);
      const double pk = (double)__hip_atomic_load(pw + 0, __ATOMIC_RELAXED, __HIP_MEMORY_SCOPE_AGENT), pe = (double)__hip_atomic_load(pw + 1, __ATOMIC_RELAXED, __HIP_MEMORY_SCOPE_AGENT),
                   pn = (double)__hip_atomic_load(pw + 2, __ATOMIC_RELAXED, __HIP_MEMORY_SCOPE_AGENT), pt = (double)__hip_atomic_load(pw + 3, __ATOMIC_RELAXED, __HIP_MEMORY_SCOPE_AGENT);
      float c = 100.f;
      if (PROBE_T == 2) c = (float)(pk / (pn * 16.0) / 10.0);
      if (PROBE_T == 3) c = (float)(pe / pn / 100.0);
      if (PROBE_T == 4) c = (float)((pt - pk - pe) / pn / 100.0);
      if (PROBE_T == 5) c = (float)(pn);
      if (PROBE_T >= 10) { double q[7]; for (int i = 0; i < 7; ++i) q[i] = (double)__hip_atomic_load(pw + 8 + i, __ATOMIC_RELAXED, __HIP_MEMORY_SCOPE_AGENT);
          if (PROBE_T == 10) c = (float)(q[6] / q[5] / 10.0);
          if (PROBE_T == 11) c = (float)(q[0] / q[5] / 10.0);
          if (PROBE_T == 12) c = (float)(q[1] / q[5] / 10.0);
          if (PROBE_T == 13) c = (float)(q[2] / q[5] / 10.0);
          if (PROBE_T == 14) c = (float)(q[3] / q[5] / 10.0);
          if (PROBE_T == 15) c = (float)(q[4] / q[5] / 10.0); }
      if (PROBE_T >= 2 && PROBE_T < 20) c = exp2f(floorf(log2f(c) * 8.0f + PROBE_SHIFT) * 0.125f);
      if (PROBE_T == 20) { const unsigned fl = __hip_atomic_load((const unsigned*)(args.ws + WS_CTL + 8192 + 256), __ATOMIC_RELAXED, __HIP_MEMORY_SCOPE_AGENT); c = 100.f + 10.f * (float)fl; }
      for (size_t i = (size_t)blockIdx.x * 512 + threadIdx.x; i < (size_t)T * DM; i += (size_t)gridDim.x * 512) args.out[i] = c; }
#endif
#undef IN
#undef PH_END
}

extern "C" void kernel_launch(void* const* d_in, const int* in_sizes, int n_in, void* d_out, int out_size, void* d_ws, size_t ws_size, hipStream_t stream) {
    static int grid = 0;
    if (grid == 0) {
        if (n_in != 30 || in_sizes[0] != T * DM || out_size != T * DM || ws_size < WS_END) { fprintf(stderr, "kernel_launch: unexpected shapes (n_in %d, in0 %d, out %d, ws %zu)\n", n_in, n_in > 0 ? in_sizes[0] : -1, out_size, ws_size); grid = -1; return; }
        int dev = 0, cus = 0, per_cu = 0;
        if (hipGetDevice(&dev) != hipSuccess || hipDeviceGetAttribute(&cus, hipDeviceAttributeMultiprocessorCount, dev) != hipSuccess) { grid = -1; return; }
        if (hipFuncSetAttribute((const void*)fwd_kernel, hipFuncAttributeMaxDynamicSharedMemorySize, LDS_BYTES) != hipSuccess) { fprintf(stderr, "kernel_launch: hipFuncSetAttribute failed\n"); grid = -1; return; }
        if (hipOccupancyMaxActiveBlocksPerMultiprocessor(&per_cu, (const void*)fwd_kernel, NWAVES * 64, LDS_BYTES) != hipSuccess || per_cu < 1) fprintf(stderr, "kernel_launch: occupancy query reports %d\n", per_cu);
        (void)hipGetLastError();
        grid = cus;
    }
    if (grid < 0) return;
    if (hipMemsetAsync((char*)d_ws + WS_CTL, 0, CTL_ZERO_BYTES, stream) != hipSuccess) return;
    Args a{};
    for (int i = 0; i < 30; ++i) a.in[i] = d_in[i];
    a.out = (float*)d_out; a.ws = (unsigned char*)d_ws; a.pad = 0;
#if MK_ONE_LAUNCH
    a.ph_lo = 0; a.ph_hi = PH_TOTAL; a.li = 0;
    hipLaunchKernelGGL(fwd_kernel, dim3(grid), dim3(NWAVES * 64), LDS_BYTES, stream, a);
#else
    int li = 0;
    for (int ph = 0; ph < PH_TOTAL; ++ph) {
        if (ph >= 2) { const int l = (ph - 2) / PH_PER_LAYER, k = (ph - 2) % PH_PER_LAYER; if (k == 11) continue; if ((l & 1) == 0 && (k == 3 || k == 4)) continue; }
        int site = ph;
        if (ph >= 2) { const int l = (ph - 2) / PH_PER_LAYER, k = (ph - 2) % PH_PER_LAYER; static const int mla[11] = {2, 3, 4, -1, -1, 10, 11, 12, 13, 14, 15}, lru[11] = {5, 6, 7, 8, 9, 10, 11, 12, 13, 14, 15}; site = (l & 1) ? lru[k] : mla[k]; }
        a.ph_lo = ph; a.ph_hi = ph + 1;
        if ((HOSTDUP >> site) & 1) { a.li = li++; a.pad = 4; hipLaunchKernelGGL(fwd_kernel, dim3(grid), dim3(NWAVES * 64), LDS_BYTES, stream, a); }
        a.li = li++; a.pad = 0;
        hipLaunchKernelGGL(fwd_kernel, dim3(grid), dim3(NWAVES * 64), LDS_BYTES, stream, a);
    }
#endif
}
```

```cpp
#include <hip/hip_runtime.h>
#include <hip/hip_bf16.h>
#include <cstdio>
#include <cstdint>

#ifndef PHSEL
#define PHSEL -1
#endif
#ifndef PHSKIP
#define PHSKIP -1
#endif
#define SEL(id) ((PHSEL < 0 || PHSEL == (id)) && PHSKIP != (id))
#ifndef PROBE_T
#define PROBE_T 0
#endif
#ifndef PROBE_SHIFT
#define PROBE_SHIFT 0.0f
#endif
#ifndef HOSTDUP
#define HOSTDUP 0
#endif
#ifndef MK_ONE_LAUNCH
#define MK_ONE_LAUNCH 1
#endif

constexpr int T = 32768, SEQ = 4096, NBATCH = 8, DM = 1024, DEPTH = 4;
constexpr int QL = 768, KVL = 256, ROPE = 64, LATD = 1088, NH = 8, DQK = 192, DV = 128;
constexpr int NE = 32, TOPK = 4, DFF = 1024, PLED = 256;
constexpr float ALPHA = 1.681792830507429f;
constexpr float LN_EPS = 1e-5f, RMS_EPS = 1e-6f;
constexpr float QSCALE = 1.4426950408889634f / 13.856406460551018f;
constexpr int NWAVES = 8;

constexpr size_t MiB = 1u << 20;
constexpr size_t WS_CTL = 0, CTL_ZERO_BYTES = 2 * MiB;
constexpr size_t WS_CS = 2 * MiB, WS_SN = 6 * MiB, WS_SPL = 10 * MiB;
constexpr size_t WS_WRH = WS_SPL + 65536, WS_WRL = WS_WRH + 262144;
constexpr size_t WS_RC = WS_SPL + 16384;
constexpr size_t WS_W_MLA = 12 * MiB, W_MLA_STRIDE = 8 * MiB;
constexpr size_t OFF_MLA_WIN = 0, OFF_MLA_WUQ = 2560 * 1024, OFF_MLA_WUKV = OFF_MLA_WUQ + 2304 * 1024, OFF_MLA_WO = OFF_MLA_WUKV + 1024 * 1024;
constexpr size_t WS_W_LRU = 28 * MiB, W_LRU_STRIDE = 8 * MiB;
constexpr size_t OFF_LRU_WIN = 0, OFF_LRU_WAX = 4 * MiB, OFF_LRU_WOUT = 5 * MiB;
constexpr size_t WS_W_PLE = 44 * MiB, W_PLE_STRIDE = 3 * MiB;
constexpr size_t OFF_PLE_WG = 0, OFF_PLE_WP = 2 * MiB;
constexpr size_t WS_W_UP = 56 * MiB;
constexpr size_t WS_W_DN = 568 * MiB;
constexpr size_t WS_XB = 824 * MiB, WS_PB = 888 * MiB, WS_PP = 952 * MiB;
constexpr size_t WS_Y = 1208 * MiB, WS_X1 = 1336 * MiB, WS_X1B = 1464 * MiB, WS_X2 = 1528 * MiB, WS_X2B = 1656 * MiB;
constexpr size_t WS_LAT = 1720 * MiB, WS_KR = 1784 * MiB, WS_SSQ = 1788 * MiB, WS_Q = 1790 * MiB, WS_KN = 1886 * MiB, WS_V = 1950 * MiB, WS_O = 2014 * MiB;
constexpr size_t WS_GG = 2078 * MiB, WS_U = 2142 * MiB, WS_UC = 2206 * MiB, WS_AA = 2270 * MiB, WS_BB = 2398 * MiB, WS_CA = 2526 * MiB, WS_CH = 2528 * MiB;
constexpr size_t WS_H = 2530 * MiB, WS_YS = 2802 * MiB, WS_LIST = 3074 * MiB, WS_SLOT = 3078 * MiB, WS_GATE = 3079 * MiB, WS_SW = 3080 * MiB  , WS_X1Q = 3088 * MiB  , WS_SH = 3120 * MiB  ,
                 WS_SWD = 3128 * MiB  , WS_SY = 3132 * MiB  , WS_END = 3140 * MiB;
constexpr int PADROWS = T * TOPK + NE * 256;
static_assert((size_t)PADROWS * DFF * 2 <= 272 * MiB, "H / YS size");
constexpr int CW_SA = 128;
constexpr int CW_CNT = 256;
constexpr int CW_BAR = 4096;

constexpr int RING_BYTES = 133120;
constexpr int TILE_E_OFF = 131072;
constexpr int SCL_OFF = RING_BYTES;
constexpr int MISC_OFF = SCL_OFF + 24576;
constexpr int LDS_BYTES = 163840;

#define GAS __attribute__((address_space(1)))
#define LAS __attribute__((address_space(3)))
#define CAS __attribute__((address_space(4)))
typedef unsigned short bf16_t;
typedef short bf16x8 __attribute__((ext_vector_type(8)));
typedef short s16x4 __attribute__((ext_vector_type(4)));
typedef float f32x2 __attribute__((ext_vector_type(2)));
typedef float f32x4 __attribute__((ext_vector_type(4)));
typedef float f32x16 __attribute__((ext_vector_type(16)));
typedef unsigned u32x2 __attribute__((ext_vector_type(2)));
typedef unsigned u32x4 __attribute__((ext_vector_type(4)));

__device__ __forceinline__ unsigned cvt_pk_bf16(float lo, float hi) { unsigned r; asm volatile("v_cvt_pk_bf16_f32 %0, %1, %2" : "=v"(r) : "v"(lo), "v"(hi)); return r; }
__device__ __forceinline__ float bf_lo(unsigned w) { return __uint_as_float(w << 16); }
__device__ __forceinline__ float bf_hi(unsigned w) { return __uint_as_float(w & 0xffff0000u); }
__device__ __forceinline__ float sigmoidf_(float x) { return __builtin_amdgcn_rcpf(1.0f + __expf(-x)); }
__device__ __forceinline__ float gelu_tanh(float x) { const float u = 0.7978845608028654f * (x + 0.044715f * x * x * x); const float t = 1.0f - 2.0f * __builtin_amdgcn_rcpf(1.0f + __expf(2.0f * u)); return 0.5f * x * (1.0f + t); }
__device__ __forceinline__ u32x4 pack8(const f32x4 a, const f32x4 b) { u32x4 w; w.x = cvt_pk_bf16(a[0], a[1]); w.y = cvt_pk_bf16(a[2], a[3]); w.z = cvt_pk_bf16(b[0], b[1]); w.w = cvt_pk_bf16(b[2], b[3]); return w; }
__device__ __forceinline__ float KF(float v) { asm volatile("" : "+s"(v)); return v; }
__device__ __forceinline__ int opaque_tid() { int t = threadIdx.x; asm volatile("" : "+v"(t)); return t; }
__device__ __forceinline__ float wave_sum(float v) {
#pragma unroll
    for (int o = 1; o < 64; o <<= 1) v += __shfl_xor(v, o);
    return v;
}

namespace pg8 {
#define PG8_LAS __attribute__((address_space(3)))
constexpr int BM = 256, BK = 64, HALF = 128, HTB = HALF * BK * 2, STAGE_BYTES = 8 * HTB;
__host__ __device__ __forceinline__ int lds_byte(int r, int c) { const int st = (r >> 4) * 2 + (c >> 5), rr = r & 15, cc = c & 31, ob = rr * 64 + cc * 2; return st * 1024 + (ob ^ (((ob >> 9) & 1) << 5)); }
__host__ __device__ __forceinline__ void stage_rc(int b, int& R, int& C) { const int st = b / 1024, sb = b % 1024, swz = sb ^ (((sb >> 9) & 1) << 5); R = (st >> 1) * 16 + swz / 64; C = (st & 1) * 32 + (swz % 64) / 2; }
__host__ __device__ __forceinline__ int perm32(int rho) { const int n = rho >> 4, i = rho & 15; return 8 * (i >> 2) + 4 * n + (i & 3); }

struct Unit { const char* A; const char* B; const char* S; const char* SA; const int* lst; int nvalid; int pm, pn, aux; };

typedef int v4i_t __attribute__((ext_vector_type(4)));
typedef int v8i_t __attribute__((ext_vector_type(8)));
template <class Epi, class Sched, bool GATHER, int FPM = 0>
__device__ __forceinline__ void gemm_phase(PG8_LAS unsigned char* lds, const int nt  , const int lda  , const int ldb  , const Sched& S, const Epi& E, unsigned long long* pw = nullptr, const int sa = 0x7f7f7f7f) {
    constexpr bool FP8 = FPM != 0;
    const int tid = opaque_tid(), wid = __builtin_amdgcn_readfirstlane(tid >> 6), lane = tid & 63, wr = wid >> 2, wc = wid & 3, fr = lane & 15, fq = lane >> 4;
    unsigned voffB[2], ocA[2][2], onA[2][2];
#pragma unroll
    for (int i = 0; i < 2; ++i) { int R, C; stage_rc(tid * 16 + i * 8192, R, C); const int Rb = Epi::PERM ? ((R & ~31) + perm32(R & 31)) : R;
        voffB[i] = (unsigned)(Rb * ldb + C * 2);
        ocA[0][i] = (unsigned)(R * lda + C * 2); ocA[1][i] = (unsigned)((R + HALF) * lda + C * 2); onA[0][i] = ocA[0][i]; onA[1][i] = ocA[1][i]; }
    constexpr unsigned kstep = BK * 2;
    const unsigned hstepB = (unsigned)HALF * ldb;
    const unsigned ldsw = (unsigned)wid * 1024u;
    const int aoff = lds_byte(wr * 64 + fr, fq * 8), boff = lds_byte(wc * 32 + fr, fq * 8);
#define PG8_SA(b, h) (((b) * 2 + (h)) * HTB)
#define PG8_SB(b, h) ((4 + (b) * 2 + (h)) * HTB)
#define PG8_STAGE(bufoff, gbase, voff, kb) do { _Pragma("unroll") for (int _i = 0; _i < 2; ++_i) \
        __builtin_amdgcn_global_load_lds((const unsigned*)((const char*)(gbase) + (size_t)(unsigned)((voff)[_i] + (unsigned)(kb))), (PG8_LAS unsigned*)(lds + (bufoff) + ldsw + _i * 8192), 16, 0, 0); } while (0)
#define PG8_CAT(x0, x1) __builtin_shufflevector(x0, x1, 0, 1, 2, 3, 4, 5, 6, 7)
#define PG8_LO(x) __builtin_bit_cast(bf16x8, __builtin_shufflevector(x, x, 0, 1, 2, 3))
#define PG8_HI(x) __builtin_bit_cast(bf16x8, __builtin_shufflevector(x, x, 4, 5, 6, 7))
    const PG8_LAS unsigned char* const ldsA = lds + aoff; const PG8_LAS unsigned char* const ldsB = lds + 4 * HTB + boff;
#define PG8_LDA(dst, b, h) do { _Pragma("unroll") for (int m = 0; m < 4; ++m) dst[m] = PG8_CAT(*(const PG8_LAS v4i_t*)(ldsA + (PG8_SA(b, h) + m * 2048)), *(const PG8_LAS v4i_t*)(ldsA + (PG8_SA(b, h) + m * 2048 + 1024))); } while (0)
#define PG8_LDB(dst, b, h) do { _Pragma("unroll") for (int n = 0; n < 2; ++n) dst[n] = PG8_CAT(*(const PG8_LAS v4i_t*)(ldsB + (PG8_SB(b, h) - 4 * HTB + n * 2048)), *(const PG8_LAS v4i_t*)(ldsB + (PG8_SB(b, h) - 4 * HTB + n * 2048 + 1024))); } while (0)
#define PG8_MMA(ai, bj, At, Bt) do { __builtin_amdgcn_s_setprio(1); \
        if constexpr (FP8) { asm volatile("s_nop 4" ::: "memory"); _Pragma("unroll") for (int m = 0; m < 4; ++m) _Pragma("unroll") for (int n = 0; n < 2; ++n) \
            asm volatile("v_mfma_scale_f32_16x16x128_f8f6f4 %0, %1, %2, %0, %3, %4 op_sel_hi:[0,0,0]" : "+v"(acc[ai][bj][m][n]) : "v"(Bt[n]), "v"(At[m]), "v"(sB[bj][n]), "v"(FPM == 2 ? sA[m] : sav)); } \
        else { _Pragma("unroll") for (int m = 0; m < 4; ++m) _Pragma("unroll") for (int n = 0; n < 2; ++n) { \
            acc[ai][bj][m][n] = __builtin_amdgcn_mfma_f32_16x16x32_bf16(PG8_LO(Bt[n]), PG8_LO(At[m]), acc[ai][bj][m][n], 0, 0, 0); \
            acc[ai][bj][m][n] = __builtin_amdgcn_mfma_f32_16x16x32_bf16(PG8_HI(Bt[n]), PG8_HI(At[m]), acc[ai][bj][m][n], 0, 0, 0); } } \
        __builtin_amdgcn_s_setprio(0); } while (0)
    int sB[2][2] = {{0x7f, 0x7f}, {0x7f, 0x7f}}; int sav; asm volatile("v_mov_b32 %0, %1" : "=v"(sav) : "s"(sa));
    int sA[4] = {0x7f, 0x7f, 0x7f, 0x7f};
    const int scol = wc * 32 + (Epi::PERM ? 8 * (fr >> 2) + (fr & 3) : fr);
    const int sbase = FPM == 2 ? SCL_OFF + 16384 + scol * 2 + (fq >> 1) : SCL_OFF + scol * 4 + fq;
    const int sabase = SCL_OFF + ((wr * 64 + fr) << 2) + fq;
#define PG8_LDS_SCL(par_, kt_) do { if constexpr (FP8) { \
        const PG8_LAS unsigned char* sp_ = (const PG8_LAS unsigned char*)lds + sbase + (FPM == 2 ? (par_) * 4096 + (kt_) * 512 : (par_) * 8192 + (kt_) * 1024); \
        _Pragma("unroll") for (int bj_ = 0; bj_ < 2; ++bj_) _Pragma("unroll") for (int n_ = 0; n_ < 2; ++n_) sB[bj_][n_] = (int)sp_[(bj_ * 128 + n_ * (Epi::PERM ? 4 : 16)) * (FPM == 2 ? 2 : 4)]; } } while (0)
#define PG8_LDS_SCA(par_, kt_, ai_) do { if constexpr (FPM == 2) { const PG8_LAS unsigned char* sp_ = (const PG8_LAS unsigned char*)lds + sabase + (par_) * 8192 + (kt_) * 1024 + (ai_) * 512; \
        _Pragma("unroll") for (int m_ = 0; m_ < 4; ++m_) sA[m_] = (int)sp_[m_ * 64]; } } while (0)
#define PG8_DMA_SCL(u_, par_) do { if constexpr (FPM == 1) __builtin_amdgcn_global_load_lds((const unsigned*)((u_).S + wid * 1024 + lane * 16), (PG8_LAS unsigned*)(lds + SCL_OFF + (par_) * 8192 + wid * 1024), 16, 0, 0); \
        if constexpr (FPM == 2) { __builtin_amdgcn_global_load_lds((const unsigned*)((u_).SA + wid * 1024 + lane * 16), (PG8_LAS unsigned*)(lds + SCL_OFF + (par_) * 8192 + wid * 1024), 16, 0, 0); \
            if (wid < 4) __builtin_amdgcn_global_load_lds((const unsigned*)((u_).S + wid * 1024 + lane * 16), (PG8_LAS unsigned*)(lds + SCL_OFF + 16384 + (par_) * 4096 + wid * 1024), 16, 0, 0); } } while (0)
#define PG8_WAIT_V(n) asm volatile("s_waitcnt vmcnt(" #n ")" ::: "memory")
#define PG8_WAIT_L(n) asm volatile("s_waitcnt lgkmcnt(" #n ")" ::: "memory")
#define PG8_BAR __builtin_amdgcn_s_barrier()
#define PG8_SCHED __builtin_amdgcn_sched_barrier(0)
#define PG8_GOFFS(u, o) do { _Pragma("unroll") for (int _h = 0; _h < 2; ++_h) _Pragma("unroll") for (int _i = 0; _i < 2; ++_i) { int gR_, gC_; stage_rc(tid * 16 + _i * 8192, gR_, gC_); int _r = _h * HALF + gR_; _r = _r < (u).nvalid ? _r : (u).nvalid - 1; \
        const int _tok = (u).lst[_r]; (o)[_h][_i] = (unsigned)_tok * (unsigned)lda + (unsigned)(gC_ * 2); } } while (0)
#define PG8_GRAW(u, tk) do {   _Pragma("unroll") for (int _h = 0; _h < 2; ++_h) _Pragma("unroll") for (int _i = 0; _i < 2; ++_i) { int gR_, gC_; stage_rc(tid * 16 + _i * 8192, gR_, gC_); int _r = _h * HALF + gR_; _r = _r < (u).nvalid ? _r : (u).nvalid - 1; (tk)[_h][_i] = (unsigned)(u).lst[_r]; } } while (0)
    Unit cur, nxt, nn; int ui = 0;
#if PROBE_T
    unsigned long long pk_ = 0, pe_ = 0, pt0_ = 0, pn_ = 0; const unsigned long long pst_ = __builtin_amdgcn_s_memtime();
#endif
    if (!S.next(0, cur)) return;
    f32x4 acc[2][2][4][2];
#pragma unroll
    for (int a = 0; a < 2; ++a)
#pragma unroll
        for (int b = 0; b < 2; ++b)
#pragma unroll
            for (int m = 0; m < 4; ++m)
#pragma unroll
                for (int n = 0; n < 2; ++n) acc[a][b][m][n] = (f32x4){0.f, 0.f, 0.f, 0.f};
    v8i_t At[4], B0[2], B1[2];
    const char* cA = cur.A; const char* cB = cur.B;
    bool has_next = S.next(1, nxt);
    if constexpr (GATHER) { PG8_GOFFS(cur, ocA);
        if (has_next) { PG8_GOFFS(nxt, onA); }
        else {
#pragma unroll
            for (int h = 0; h < 2; ++h)
#pragma unroll
                for (int i = 0; i < 2; ++i) onA[h][i] = ocA[h][i]; } }
    PG8_DMA_SCL(cur, 0); if (has_next) PG8_DMA_SCL(nxt, 1);
    PG8_STAGE(PG8_SB(0, 0), cB, voffB, 0u); PG8_STAGE(PG8_SB(0, 1), cB, voffB, hstepB); PG8_STAGE(PG8_SA(0, 0), cA, ocA[0], 0u); PG8_STAGE(PG8_SA(0, 1), cA, ocA[1], 0u);
    if (wr == 1) PG8_BAR;
    PG8_WAIT_V(2); PG8_BAR;
    PG8_STAGE(PG8_SB(1, 0), cB, voffB, kstep); PG8_STAGE(PG8_SA(1, 0), cA, ocA[0], kstep); PG8_STAGE(PG8_SB(1, 1), cB, voffB, hstepB + kstep);
    PG8_WAIT_V(6); PG8_BAR;
    for (;;) {
        const char* nA = has_next ? nxt.A : cA; const char* nB = has_next ? nxt.B : cB;
#if PROBE_T
        pt0_ = __builtin_amdgcn_s_memtime();
#endif
#pragma unroll 1
        for (int t = 0; t < nt; t += 2) {
            const bool last = (t == nt - 2);
            const unsigned k1 = (unsigned)(t + 1) * kstep, k2 = last ? 0u : (unsigned)(t + 2) * kstep, k3 = k2 + kstep;
            const char* a2 = last ? nA : cA; const char* b2 = last ? nB : cB;
#define PG8_STAGE_A2(bufoff, h_, kb_) do { if (GATHER && last) PG8_STAGE(bufoff, a2, onA[h_], kb_); else PG8_STAGE(bufoff, a2, ocA[h_], kb_); } while (0)
            PG8_LDB(B0, 0, 0); PG8_LDB(B1, 0, 1); PG8_LDS_SCL(ui & 1, t); PG8_SCHED; PG8_LDA(At, 0, 0); PG8_LDS_SCA(ui & 1, t, 0); PG8_STAGE(PG8_SA(1, 1), cA, ocA[1], k1);
            PG8_WAIT_V(8); PG8_WAIT_L(0); PG8_BAR; PG8_MMA(0, 0, At, B0); PG8_MMA(0, 1, At, B1); PG8_BAR; PG8_SCHED;
            PG8_LDA(At, 0, 1); PG8_LDS_SCA(ui & 1, t, 1); PG8_STAGE(PG8_SB(0, 0), b2, voffB, k2); PG8_STAGE(PG8_SB(0, 1), b2, voffB, hstepB + k2); PG8_STAGE_A2(PG8_SA(0, 0), 0, k2);
            PG8_WAIT_V(8); PG8_WAIT_L(0); PG8_BAR; PG8_MMA(1, 0, At, B0); PG8_MMA(1, 1, At, B1); PG8_BAR; PG8_SCHED;
            PG8_LDB(B0, 1, 0); PG8_LDB(B1, 1, 1); PG8_LDS_SCL(ui & 1, t + 1); PG8_SCHED; PG8_LDA(At, 1, 0); PG8_LDS_SCA(ui & 1, t + 1, 0); PG8_STAGE_A2(PG8_SA(0, 1), 1, k2);
            PG8_WAIT_V(8); PG8_WAIT_L(0); PG8_BAR; PG8_MMA(0, 0, At, B0); PG8_MMA(0, 1, At, B1); PG8_BAR; PG8_SCHED;
            PG8_LDA(At, 1, 1); PG8_LDS_SCA(ui & 1, t + 1, 1); PG8_STAGE(PG8_SB(1, 0), b2, voffB, k3); PG8_STAGE(PG8_SB(1, 1), b2, voffB, hstepB + k3); PG8_STAGE_A2(PG8_SA(1, 0), 0, k3);
            PG8_WAIT_V(8); PG8_WAIT_L(0); PG8_BAR; PG8_MMA(1, 0, At, B0); PG8_MMA(1, 1, At, B1); PG8_BAR; PG8_SCHED;
        }
#if PROBE_T
        const unsigned long long pt1_ = __builtin_amdgcn_s_memtime(); pk_ += pt1_ - pt0_;
#endif
        if constexpr (FP8) asm volatile("s_nop 15\n\ts_nop 7" ::: "memory");
        const bool has_nn = has_next && S.next(ui + 2, nn);
        if constexpr (GATHER) {
#pragma unroll
            for (int h = 0; h < 2; ++h)
#pragma unroll
                for (int i = 0; i < 2; ++i) ocA[h][i] = onA[h][i];
            if (has_nn) { PG8_GRAW(nn, onA); } }
        if (wr == 0) PG8_BAR;
        E(acc, cur, wr, wc, fr, fq);
#if PROBE_T
        asm volatile("s_waitcnt vmcnt(0)" ::: "memory"); pe_ += __builtin_amdgcn_s_memtime() - pt1_; ++pn_;
#endif
        if (!has_next) break;
#pragma unroll
        for (int a = 0; a < 2; ++a)
#pragma unroll
            for (int b = 0; b < 2; ++b)
#pragma unroll
                for (int m = 0; m < 4; ++m)
#pragma unroll
                    for (int n = 0; n < 2; ++n) acc[a][b][m][n] = (f32x4){0.f, 0.f, 0.f, 0.f};
        cur = nxt; cA = nA; cB = nB; ++ui;
        if constexpr (GATHER) { if (has_nn) {
#pragma unroll
            for (int h = 0; h < 2; ++h)
#pragma unroll
                for (int i = 0; i < 2; ++i) { int gR_, gC_; stage_rc(tid * 16 + i * 8192, gR_, gC_); onA[h][i] = onA[h][i] * (unsigned)lda + (unsigned)(gC_ * 2); } } }
        if (has_nn) { nxt = nn; PG8_DMA_SCL(nxt, (ui + 1) & 1); }
        has_next = has_nn;
        if (wr == 1) PG8_BAR;
    }
    PG8_WAIT_V(0);
    PG8_BAR;
#if PROBE_T
    if (pw && blockIdx.x == 0 && tid == 0) { pw[0] += pk_; pw[1] += pe_; pw[2] += pn_; pw[3] += __builtin_amdgcn_s_memtime() - pst_; }
#endif
#undef PG8_SA
#undef PG8_SB
#undef PG8_STAGE
#undef PG8_LDA
#undef PG8_LDB
#undef PG8_MMA
#undef PG8_WAIT_V
#undef PG8_WAIT_L
#undef PG8_BAR
#undef PG8_SCHED
#undef PG8_GOFFS
#undef PG8_GRAW
#undef PG8_STAGE_A2
#undef PG8_CAT
#undef PG8_LO
#undef PG8_HI
#undef PG8_LDS_SCL
#undef PG8_LDS_SCA
#undef PG8_DMA_SCL
}

constexpr int NXCD = 8, WGM = 8;
struct DenseSched {
    const char* A; const char* B; int lda, ldb; int nM, nN, nwg, G, c; int apn_shift, akbytes, bpm_shift; size_t bbatch;
    __device__ __forceinline__ void init(const void* A_, const void* B_, int lda_, int ldb_, int M, int N, int G_, int c_) {
        A = (const char*)A_; B = (const char*)B_; lda = lda_; ldb = ldb_; nM = M / BM; nN = N / BM; nwg = nM * nN; G = G_; c = c_; apn_shift = -1; akbytes = 0; bpm_shift = -1; bbatch = 0; }
    __device__ __forceinline__ bool next(int i, Unit& u) const {
        const long L = (long)i * G + c; if (L >= nwg) return false;
        int wgid = (int)L; { const int q = nwg / NXCD, r = nwg % NXCD, xcd = wgid % NXCD, off = wgid / NXCD; wgid = (xcd < r ? xcd * (q + 1) : r * (q + 1) + (xcd - r) * q) + off; }
        const int nig = WGM * nN, gid = wgid / nig, fm = gid * WGM, gsz = (nM - fm) < WGM ? (nM - fm) : WGM;
        const int pm = fm + ((wgid % nig) % gsz), pn = (wgid % nig) / gsz;
        u.pm = pm; u.pn = pn; u.aux = 0; u.lst = nullptr; u.nvalid = 256; u.S = nullptr; u.SA = nullptr;
        u.A = A + (size_t)pm * 256 * lda * 2 + (apn_shift >= 0 ? (size_t)(pn >> apn_shift) * akbytes : (size_t)0);
        u.B = B + (size_t)pn * 256 * ldb * 2 + (bpm_shift >= 0 ? (size_t)(pm >> bpm_shift) * bbatch : (size_t)0);
        return true;
    }
};
struct MoeSched {
    const char* A; const char* B; size_t bexp; const char* SW; int lda, ldb  , nN; const int* lists; volatile LAS const int* tab; volatile LAS const unsigned char* te; int G, c; bool gather; const char* SA;
    __device__ __forceinline__ bool next(int i, Unit& u) const {
        int pn, mg;
        if (G == 256) {
            const int x = c & 7, jj = c >> 3, pgs = nN >> 2, mgs = 8 / pgs;
            mg = i * (8 * mgs) + 8 * (x / pgs) + (jj & 7); pn = 4 * (x % pgs) + (jj >> 3);
            if (mg >= __builtin_amdgcn_readfirstlane(tab[32])) return false;
        } else { const int total = __builtin_amdgcn_readfirstlane(tab[32]) * nN; const long L = (long)i * G + c; if (L >= total) return false; pn = (int)(L % nN); mg = (int)(L / nN); }
        const int e = __builtin_amdgcn_readfirstlane((int)te[mg]), mt = mg - __builtin_amdgcn_readfirstlane(tab[e]);
        u.pm = mg; u.pn = pn; u.aux = e;
        if (gather) { u.A = A; u.lst = lists + (size_t)e * T + mt * 256; const int rem = __builtin_amdgcn_readfirstlane(tab[48 + e]) - mt * 256; u.nvalid = rem < 256 ? rem : 256; }
        else { u.A = A + (size_t)mg * 256 * lda; u.lst = nullptr; u.nvalid = 256; }
        u.B = B + (size_t)e * bexp + (size_t)pn * 256 * ldb; u.S = SW ? (SA ? SW + ((size_t)e * 4 + pn) * 4096 : SW + ((size_t)e * 8 + pn) * 8192) : nullptr; u.SA = SA ? SA + (size_t)mg * 8192 : nullptr;
        return true;
    }
};

#define EPI_ROW(u, ai, m) ((u).pm * 256 + (ai) * 128 + wr * 64 + (m) * 16 + fr)
struct EpiLat {
    static constexpr bool PERM = true;
    bf16_t* LAT; float* SSQ; bf16_t* KR; const float* CS; const float* SN;
    __device__ __forceinline__ void operator()(const f32x4 (&acc)[2][2][4][2], const Unit& u, int wr, int wc, int fr, int fq) const {
        if (u.pn < 4) {
#pragma unroll
            for (int ai = 0; ai < 2; ++ai)
#pragma unroll
                for (int m = 0; m < 4; ++m) { const int row = EPI_ROW(u, ai, m); float ss = 0.f;
#pragma unroll
                    for (int bj = 0; bj < 2; ++bj) { const f32x4 v0 = acc[ai][bj][m][0], v1 = acc[ai][bj][m][1];
                        ss += (v0[0] * v0[0] + v0[1] * v0[1]) + (v0[2] * v0[2] + v0[3] * v0[3]) + (v1[0] * v1[0] + v1[1] * v1[1]) + (v1[2] * v1[2] + v1[3] * v1[3]);
                        *(u32x4*)(LAT + (size_t)row * 1024 + u.pn * 256 + bj * 128 + wc * 32 + 8 * fq) = pack8(v0, v1); }
                    ss += __shfl_xor(ss, 16); ss += __shfl_xor(ss, 32);
                    if (fq == 0) SSQ[(size_t)row * 16 + u.pn * 4 + wc] = ss; }
        } else if (wc == 0) {
#pragma unroll
            for (int ai = 0; ai < 2; ++ai)
#pragma unroll
                for (int m = 0; m < 4; ++m) { const int row = EPI_ROW(u, ai, m);
                    const f32x4 c0 = *(const f32x4*)(CS + (size_t)row * 32 + 8 * fq), c1 = *(const f32x4*)(CS + (size_t)row * 32 + 8 * fq + 4);
                    const f32x4 s0 = *(const f32x4*)(SN + (size_t)row * 32 + 8 * fq), s1 = *(const f32x4*)(SN + (size_t)row * 32 + 8 * fq + 4);
                    const f32x4 a0 = acc[ai][0][m][0], a1 = acc[ai][0][m][1], b0 = acc[ai][1][m][0], b1 = acc[ai][1][m][1];
                    *(u32x4*)(KR + (size_t)row * 64 + 8 * fq) = pack8(a0 * c0 - b0 * s0, a1 * c1 - b1 * s1);
                    *(u32x4*)(KR + (size_t)row * 64 + 32 + 8 * fq) = pack8(b0 * c0 + a0 * s0, b1 * c1 + a1 * s1); }
        }
    }
};
struct EpiQ {
    static constexpr bool PERM = true;
    bf16_t* Q; const float* SSQ; const float* CS; const float* SN;
    __device__ __forceinline__ void operator()(const f32x4 (&acc)[2][2][4][2], const Unit& u, int wr, int wc, int fr, int fq) const {
#pragma unroll
        for (int ai = 0; ai < 2; ++ai)
#pragma unroll
            for (int m = 0; m < 4; ++m) { const int row = EPI_ROW(u, ai, m);
                const f32x4 q0 = *(const f32x4*)(SSQ + (size_t)row * 16), q1 = *(const f32x4*)(SSQ + (size_t)row * 16 + 4), q2 = *(const f32x4*)(SSQ + (size_t)row * 16 + 8);
                const float ss = ((q0[0] + q0[1]) + (q0[2] + q0[3])) + ((q1[0] + q1[1]) + (q1[2] + q1[3])) + ((q2[0] + q2[1]) + (q2[2] + q2[3]));
                const float r = QSCALE / sqrtf(ss * (1.0f / QL) + KF(RMS_EPS));
                if (u.pn < 4) {
#pragma unroll
                    for (int bj = 0; bj < 2; ++bj)
                        *(u32x4*)(Q + (size_t)row * 1536 + (2 * u.pn + bj) * 192 + wc * 32 + 8 * fq) = pack8(acc[ai][bj][m][0] * r, acc[ai][bj][m][1] * r);
                } else {
                    const int head = 4 * (u.pn - 4) + wc;
                    const f32x4 c0 = *(const f32x4*)(CS + (size_t)row * 32 + 8 * fq), c1 = *(const f32x4*)(CS + (size_t)row * 32 + 8 * fq + 4);
                    const f32x4 s0 = *(const f32x4*)(SN + (size_t)row * 32 + 8 * fq), s1 = *(const f32x4*)(SN + (size_t)row * 32 + 8 * fq + 4);
                    const f32x4 a0 = acc[ai][0][m][0] * r, a1 = acc[ai][0][m][1] * r, b0 = acc[ai][1][m][0] * r, b1 = acc[ai][1][m][1] * r;
                    *(u32x4*)(Q + (size_t)row * 1536 + head * 192 + 128 + 8 * fq) = pack8(a0 * c0 - b0 * s0, a1 * c1 - b1 * s1);
                    *(u32x4*)(Q + (size_t)row * 1536 + head * 192 + 160 + 8 * fq) = pack8(b0 * c0 + a0 * s0, b1 * c1 + a1 * s1);
                }
                asm volatile("" ::: "memory"); }
    }
};
struct EpiKV {
    static constexpr bool PERM = true;
    bf16_t* KN; bf16_t* V; const float* SSQ;
    __device__ __forceinline__ void operator()(const f32x4 (&acc)[2][2][4][2], const Unit& u, int wr, int wc, int fr, int fq) const {
#pragma unroll
        for (int ai = 0; ai < 2; ++ai)
#pragma unroll
            for (int m = 0; m < 4; ++m) { const int row = EPI_ROW(u, ai, m);
                const f32x4 q3 = *(const f32x4*)(SSQ + (size_t)row * 16 + 12);
                const float r = 1.0f / sqrtf(((q3[0] + q3[1]) + (q3[2] + q3[3])) * (1.0f / KVL) + KF(RMS_EPS));
                *(u32x4*)(KN + (size_t)row * 1024 + u.pn * 128 + wc * 32 + 8 * fq) = pack8(acc[ai][0][m][0] * r, acc[ai][0][m][1] * r);
                *(u32x4*)(V + (size_t)row * 1024 + u.pn * 128 + wc * 32 + 8 * fq) = pack8(acc[ai][1][m][0] * r, acc[ai][1][m][1] * r); }
    }
};
__device__ __forceinline__ f32x4 bf4_lo(const u32x4 w) { return (f32x4){bf_lo(w.x), bf_hi(w.x), bf_lo(w.y), bf_hi(w.y)}; }
__device__ __forceinline__ f32x4 bf4_hi(const u32x4 w) { return (f32x4){bf_lo(w.z), bf_hi(w.z), bf_lo(w.w), bf_hi(w.w)}; }
struct EpiRes {
    static constexpr bool PERM = true;
    const bf16_t* X; bf16_t* Y;
    __device__ __forceinline__ void operator()(const f32x4 (&acc)[2][2][4][2], const Unit& u, int wr, int wc, int fr, int fq) const {
        const bf16_t* xb = X + (size_t)u.pm * 256 * 1024; bf16_t* yb = Y + (size_t)u.pm * 256 * 1024; const unsigned o0 = (unsigned)((wr * 64 + fr) * 1024 + u.pn * 256 + wc * 32 + 8 * fq);
        u32x4 xw[2][4][2];
#pragma unroll
        for (int ai = 0; ai < 2; ++ai)
#pragma unroll
            for (int m = 0; m < 4; ++m)
#pragma unroll
                for (int bj = 0; bj < 2; ++bj) xw[ai][m][bj] = *(const u32x4*)(xb + (o0 + (unsigned)((ai * 128 + m * 16) * 1024 + bj * 128)));
#pragma unroll
        for (int ai = 0; ai < 2; ++ai)
#pragma unroll
            for (int m = 0; m < 4; ++m)
#pragma unroll
                for (int bj = 0; bj < 2; ++bj)
                    *(u32x4*)(yb + (o0 + (unsigned)((ai * 128 + m * 16) * 1024 + bj * 128))) = pack8(bf4_lo(xw[ai][m][bj]) * ALPHA + acc[ai][bj][m][0], bf4_hi(xw[ai][m][bj]) * ALPHA + acc[ai][bj][m][1]);
    }
};
struct EpiGU {
    static constexpr bool PERM = true;
    bf16_t* GG; bf16_t* U;
    __device__ __forceinline__ void operator()(const f32x4 (&acc)[2][2][4][2], const Unit& u, int wr, int wc, int fr, int fq) const {
#pragma unroll
        for (int ai = 0; ai < 2; ++ai)
#pragma unroll
            for (int m = 0; m < 4; ++m) { const int row = EPI_ROW(u, ai, m);
#pragma unroll
                for (int bj = 0; bj < 2; ++bj) { f32x4 v0 = acc[ai][bj][m][0], v1 = acc[ai][bj][m][1];
                    if (u.pn < 4) {
#pragma unroll
                        for (int e = 0; e < 4; ++e) { v0[e] = gelu_tanh(v0[e]); v1[e] = gelu_tanh(v1[e]); }
                        *(u32x4*)(GG + (size_t)row * 1024 + u.pn * 256 + bj * 128 + wc * 32 + 8 * fq) = pack8(v0, v1);
                    } else *(u32x4*)(U + (size_t)row * 1024 + (u.pn - 4) * 256 + bj * 128 + wc * 32 + 8 * fq) = pack8(v0, v1); } }
    }
};
struct EpiAB {
    static constexpr bool PERM = true;
    bf16_t* LA; bf16_t* BB; const bf16_t* UC; const float* BA; const float* BX; const float* SPL;
    __device__ __forceinline__ void operator()(const f32x4 (&acc)[2][2][4][2], const Unit& u, int wr, int wc, int fr, int fq) const {
        const int ch = (u.pn >> 1) * 256 + (u.pn & 1) * 128 + wc * 32 + 8 * fq;
        const float c3 = KF(0.16666667f), c4 = KF(0.041666668f), c5 = KF(0.0083333338f);
        f32x4 ba[2], bx[2], sp[2];
#pragma unroll
        for (int n = 0; n < 2; ++n) { ba[n] = *(const f32x4*)(BA + ch + 4 * n); bx[n] = *(const f32x4*)(BX + ch + 4 * n); sp[n] = *(const f32x4*)(SPL + ch + 4 * n); }
#pragma unroll
        for (int ai = 0; ai < 2; ++ai)
#pragma unroll
            for (int m = 0; m < 4; ++m) { const size_t off = (size_t)EPI_ROW(u, ai, m) * 1024 + ch;
                const u32x4 uw = *(const u32x4*)(UC + off); f32x4 uv[2] = {bf4_lo(uw), bf4_hi(uw)}, lv[2], bv[2];
#pragma unroll
                for (int n = 0; n < 2; ++n)
#pragma unroll
                    for (int e = 0; e < 4; ++e) { const float r = sigmoidf_(acc[ai][0][m][n][e] + ba[n][e]), ig = sigmoidf_(acc[ai][1][m][n][e] + bx[n][e]);
                        const float la = sp[n][e] * r, x2 = 2.0f * la; lv[n][e] = la * 1.4426950408889634f;
                        const float om = x2 > -0.25f ? -x2 * (1.0f + x2 * (0.5f + x2 * (c3 + x2 * (c4 + x2 * c5)))) : 1.0f - __expf(x2);
                        bv[n][e] = sqrtf(om) * ig * uv[n][e]; }
                *(u32x4*)(LA + off) = pack8(lv[0], lv[1]); *(u32x4*)(BB + off) = pack8(bv[0], bv[1]); asm volatile("" ::: "memory"); }
    }
};
struct EpiUp {
    static constexpr bool PERM = true;
    unsigned char* H; unsigned char* SH; const float* BU;
    __device__ __forceinline__ void operator()(f32x4 (&acc)[2][2][4][2], const Unit& u, int wr, int wc, int fr, int fq) const {
        const int gc = u.pn * 128 + wc * 32 + 8 * fq; const float* bu = BU + (size_t)u.aux * 2048;
        const float k7 = KF(7.0f), km7 = KF(-7.0f), ka = KF(1.702f);
#pragma unroll
        for (int n = 0; n < 2; ++n) { const f32x4 bg = *(const f32x4*)(bu + gc + 4 * n), bp = *(const f32x4*)(bu + 1024 + gc + 4 * n);
#pragma unroll
            for (int ai = 0; ai < 2; ++ai)
#pragma unroll
                for (int m = 0; m < 4; ++m) {
#pragma unroll
                    for (int e = 0; e < 4; ++e) { const float g = fminf(acc[ai][0][m][n][e] + bg[e], k7), up = fminf(fmaxf(acc[ai][1][m][n][e] + bp[e], km7), k7);
                        acc[ai][0][m][n][e] = (up + 1.0f) * (g * sigmoidf_(ka * g)); }
                    if (m & 1) __builtin_amdgcn_sched_barrier(0); }
            asm volatile("" ::: "memory"); }
        unsigned char* const shb = SH + ((size_t)u.pm * 8 + u.pn) * 1024; unsigned char* const hb = H + (size_t)u.pm * 256 * 1024;
        const unsigned ho = (unsigned)((wr * 64 + fr) * 1024 + gc), so = (unsigned)((wr * 64 + fr) * 4 + wc);
#pragma unroll
        for (int ai = 0; ai < 2; ++ai)
#pragma unroll
            for (int m = 0; m < 4; ++m) { const f32x4 y0 = acc[ai][0][m][0], y1 = acc[ai][0][m][1];
                float am = fmaxf(fmaxf(fmaxf(fabsf(y0[0]), fabsf(y0[1])), fmaxf(fabsf(y0[2]), fabsf(y0[3]))), fmaxf(fmaxf(fabsf(y1[0]), fabsf(y1[1])), fmaxf(fabsf(y1[2]), fabsf(y1[3]))));
                { auto r16 = __builtin_amdgcn_permlane16_swap(__float_as_uint(am), __float_as_uint(am), false, false); am = fmaxf(__uint_as_float(r16[0]), __uint_as_float(r16[1]));
                  auto r32 = __builtin_amdgcn_permlane32_swap(__float_as_uint(am), __float_as_uint(am), false, false); am = fmaxf(__uint_as_float(r32[0]), __uint_as_float(r32[1])); }
                int eb = (int)((__float_as_uint(am) >> 23) & 0xffu) - 7; eb = eb < 1 ? 1 : eb;
                const float inv = __uint_as_float((unsigned)(254 - eb) << 23);
                int w0 = __builtin_amdgcn_cvt_pk_fp8_f32(y0[0] * inv, y0[1] * inv, 0, false); w0 = __builtin_amdgcn_cvt_pk_fp8_f32(y0[2] * inv, y0[3] * inv, w0, true);
                int w1 = __builtin_amdgcn_cvt_pk_fp8_f32(y1[0] * inv, y1[1] * inv, 0, false); w1 = __builtin_amdgcn_cvt_pk_fp8_f32(y1[2] * inv, y1[3] * inv, w1, true);
                *(u32x2*)(hb + (ho + (unsigned)((ai * 128 + m * 16) * 1024))) = (u32x2){(unsigned)w0, (unsigned)w1};
                if (fq == 0) shb[so + (unsigned)((ai * 128 + m * 16) * 4)] = (unsigned char)eb;
                asm volatile("" ::: "memory"); __builtin_amdgcn_sched_barrier(0); }
    }
};
struct EpiDown {
    static constexpr bool PERM = true;
    unsigned char* YS; unsigned char* SY; const float* BD;
    __device__ __forceinline__ void operator()(const f32x4 (&acc)[2][2][4][2], const Unit& u, int wr, int wc, int fr, int fq) const {
        const float* bd = BD + (size_t)u.aux * 1024;
        unsigned char* const yb = YS + (size_t)u.pm * 256 * 1024; unsigned char* const sb = SY + (size_t)u.pm * 256 * 32;
#pragma unroll
        for (int bj = 0; bj < 2; ++bj) { const int col = u.pn * 256 + bj * 128 + wc * 32 + 8 * fq; const f32x4 b0 = *(const f32x4*)(bd + col), b1 = *(const f32x4*)(bd + col + 4);
#pragma unroll
            for (int ai = 0; ai < 2; ++ai)
#pragma unroll
                for (int m = 0; m < 4; ++m) { const unsigned rit = (unsigned)(ai * 128 + wr * 64 + m * 16 + fr); const f32x4 y0 = acc[ai][bj][m][0] + b0, y1 = acc[ai][bj][m][1] + b1;
                    float am = fmaxf(fmaxf(fmaxf(fabsf(y0[0]), fabsf(y0[1])), fmaxf(fabsf(y0[2]), fabsf(y0[3]))), fmaxf(fmaxf(fabsf(y1[0]), fabsf(y1[1])), fmaxf(fabsf(y1[2]), fabsf(y1[3]))));
                    { auto r16 = __builtin_amdgcn_permlane16_swap(__float_as_uint(am), __float_as_uint(am), false, false); am = fmaxf(__uint_as_float(r16[0]), __uint_as_float(r16[1]));
                      auto r32 = __builtin_amdgcn_permlane32_swap(__float_as_uint(am), __float_as_uint(am), false, false); am = fmaxf(__uint_as_float(r32[0]), __uint_as_float(r32[1])); }
                    int eb = (int)((__float_as_uint(am) >> 23) & 0xffu) - 7; eb = eb < 1 ? 1 : eb;
                    const float inv = __uint_as_float((unsigned)(254 - eb) << 23);
                    int w0 = __builtin_amdgcn_cvt_pk_fp8_f32(y0[0] * inv, y0[1] * inv, 0, false); w0 = __builtin_amdgcn_cvt_pk_fp8_f32(y0[2] * inv, y0[3] * inv, w0, true);
                    int w1 = __builtin_amdgcn_cvt_pk_fp8_f32(y1[0] * inv, y1[1] * inv, 0, false); w1 = __builtin_amdgcn_cvt_pk_fp8_f32(y1[2] * inv, y1[3] * inv, w1, true);
                    *(u32x2*)(yb + (rit * 1024u + (unsigned)col)) = (u32x2){(unsigned)w0, (unsigned)w1};
                    if (fq == 0) sb[rit * 32u + (unsigned)(col >> 5)] = (unsigned char)eb;
                    asm volatile("" ::: "memory"); } }
    }
};
struct EpiPle {
    static constexpr bool PERM = true;
    const bf16_t* X2; const bf16_t* PP; float* OUT; bf16_t* XB;
    __device__ __forceinline__ void operator()(const f32x4 (&acc)[2][2][4][2], const Unit& u, int wr, int wc, int fr, int fq) const {
        const size_t tb = (size_t)u.pm * 256 * 1024; const unsigned o0 = (unsigned)((wr * 64 + fr) * 1024 + u.pn * 256 + wc * 32 + 8 * fq);
#pragma unroll
        for (int ai = 0; ai < 2; ++ai) {
            u32x4 xw[4][2], pw[4][2];
#pragma unroll
            for (int m = 0; m < 4; ++m)
#pragma unroll
                for (int bj = 0; bj < 2; ++bj) { const unsigned o = o0 + (unsigned)((ai * 128 + m * 16) * 1024 + bj * 128); xw[m][bj] = *(const u32x4*)(X2 + tb + o); pw[m][bj] = *(const u32x4*)(PP + tb + o); }
#pragma unroll
            for (int m = 0; m < 4; ++m)
#pragma unroll
                for (int bj = 0; bj < 2; ++bj) { const unsigned o = o0 + (unsigned)((ai * 128 + m * 16) * 1024 + bj * 128);
                    const f32x4 a0 = acc[ai][bj][m][0], a1 = acc[ai][bj][m][1], x0 = bf4_lo(xw[m][bj]), x1 = bf4_hi(xw[m][bj]), p0 = bf4_lo(pw[m][bj]), p1 = bf4_hi(pw[m][bj]); f32x4 r0, r1;
#pragma unroll
                    for (int e = 0; e < 4; ++e) { r0[e] = x0[e] + sigmoidf_(a0[e]) * p0[e]; r1[e] = x1[e] + sigmoidf_(a1[e]) * p1[e]; }
                    *(u32x4*)(XB + tb + o) = pack8(r0, r1);
                    if (OUT) { *(f32x4*)(OUT + tb + o) = r0; *(f32x4*)(OUT + tb + o + 4) = r1; } }
            asm volatile("" ::: "memory"); }
    }
};
struct EpiPP {
    static constexpr bool PERM = true;
    bf16_t* PP;
    __device__ __forceinline__ void operator()(const f32x4 (&acc)[2][2][4][2], const Unit& u, int wr, int wc, int fr, int fq) const {
#pragma unroll
        for (int ai = 0; ai < 2; ++ai)
#pragma unroll
            for (int m = 0; m < 4; ++m)
#pragma unroll
                for (int bj = 0; bj < 2; ++bj) *(u32x4*)(PP + (size_t)EPI_ROW(u, ai, m) * 1024 + u.pn * 256 + bj * 128 + wc * 32 + 8 * fq) = pack8(acc[ai][bj][m][0], acc[ai][bj][m][1]);
    }
};
}

namespace att {
constexpr int NW = 8, QBLK = 32, KVBLK = 64, QB = 256, KPITCH = 384;
constexpr int SHM_V = KVBLK * DV * 2, SHM_K = KVBLK * KPITCH;
constexpr int NVB = 3;
constexpr int OFF_V = 0, OFF_K = NVB * SHM_V, OFF_WS = OFF_K + 2 * SHM_K, LDS_BYTES = OFF_WS + NW * 64 * 4;
#define SBAR() __builtin_amdgcn_sched_barrier(0)
__device__ __forceinline__ int k_addr(int row, int chunk) { return row * KPITCH + ((chunk ^ ((row >> 1) & 7)) << 4); }
__device__ __forceinline__ int v_st(int k, int c) { const int kk = (k & ~0xC) | ((k & 4) << 1) | ((k & 8) >> 1); return ((kk >> 3) * 4 + (c >> 5)) * 512 + ((kk & 7) * 32 + (c & 31)) * 2; }
__device__ __forceinline__ int v_rd_base(int lane) { return ((lane & 3) << 3) | (((lane >> 2) & 3) << 6) | (((lane >> 4) & 1) << 5) | (((lane >> 5) & 1) << 8); }
constexpr int v_rd_off(int d0, int ks, int half) { return d0 * 512 + ks * 4096 + half * 2048; }
__device__ __forceinline__ int crow(int r, int hi) { return (r & 3) + 8 * (r >> 2) + 4 * hi; }

template <int KB>
__device__ __forceinline__ void qkt(f32x16& p0, f32x16& p1, const LAS char* K_lds, int r32, int hi, const bf16x8* qr) {
    p0 = f32x16{}; p1 = f32x16{};
    const LAS char* kb[4];
#pragma unroll
    for (int dd = 0; dd < 4; ++dd) kb[dd] = K_lds + KB * SHM_K + r32 * KPITCH + (((2 * dd + hi) ^ ((r32 >> 1) & 7)) << 4);
    bf16x8 f[2][4];
#define QK_LD(g, buf) do { _Pragma("unroll") for (int e_ = 0; e_ < 2; ++e_) { const int d0_ = 2 * (g) + e_; const LAS char* a_ = kb[d0_ & 3] + (d0_ >> 2) * 128; \
        f[buf][2 * e_] = *(const LAS bf16x8*)a_; f[buf][2 * e_ + 1] = *(const LAS bf16x8*)(a_ + 32 * KPITCH); } } while (0)
    QK_LD(0, 0);
#pragma unroll
    for (int g = 0; g < 6; ++g) {
        if (g < 5) QK_LD(g + 1, (g + 1) & 1);
        SBAR();
#pragma unroll
        for (int e = 0; e < 2; ++e) { const int d0 = 2 * g + e;
            p0 = __builtin_amdgcn_mfma_f32_32x32x16_bf16(f[g & 1][2 * e], qr[d0], p0, 0, 0, 0);
            p1 = __builtin_amdgcn_mfma_f32_32x32x16_bf16(f[g & 1][2 * e + 1], qr[d0], p1, 0, 0, 0); }
        SBAR(); }
#undef QK_LD
}
__device__ __forceinline__ void pv_tile(f32x16* o, int vb0  , bf16x8 pa0, bf16x8 pa1, bf16x8 pa2, bf16x8 pa3) {
#define TRRD(dst, off) asm volatile("ds_read_b64_tr_b16 %0, %1 offset:%2" : "=&v"(dst) : "v"(vb0), "i"(off) : "memory")
#define PV_D0(d0) do { s16x4 l0, l1, l2, l3, h0, h1, h2, h3; constexpr int b_ = v_rd_off(d0, 0, 0); \
        TRRD(l0, b_); TRRD(h0, b_ + 2048); TRRD(l1, b_ + 4096); TRRD(h1, b_ + 6144); TRRD(l2, b_ + 8192); TRRD(h2, b_ + 10240); TRRD(l3, b_ + 12288); TRRD(h3, b_ + 14336); \
        asm volatile("s_waitcnt lgkmcnt(0)" ::: "memory"); SBAR(); \
        o[d0] = __builtin_amdgcn_mfma_f32_32x32x16_bf16(pa0, (bf16x8){l0[0], l0[1], l0[2], l0[3], h0[0], h0[1], h0[2], h0[3]}, o[d0], 0, 0, 0); \
        o[d0] = __builtin_amdgcn_mfma_f32_32x32x16_bf16(pa1, (bf16x8){l1[0], l1[1], l1[2], l1[3], h1[0], h1[1], h1[2], h1[3]}, o[d0], 0, 0, 0); \
        o[d0] = __builtin_amdgcn_mfma_f32_32x32x16_bf16(pa2, (bf16x8){l2[0], l2[1], l2[2], l2[3], h2[0], h2[1], h2[2], h2[3]}, o[d0], 0, 0, 0); \
        o[d0] = __builtin_amdgcn_mfma_f32_32x32x16_bf16(pa3, (bf16x8){l3[0], l3[1], l3[2], l3[3], h3[0], h3[1], h3[2], h3[3]}, o[d0], 0, 0, 0); } while (0)
    PV_D0(0); PV_D0(1); PV_D0(2); PV_D0(3);
#undef PV_D0
#undef TRRD
}
__device__ __forceinline__ void mask_tile(f32x16& p0, f32x16& p1, int dq  ) {
    const float NEG = -__builtin_inff();
#pragma unroll
    for (int r = 0; r < 16; ++r) { const int c = (r & 3) + 8 * (r >> 2);
        if (c > dq) p0[r] = NEG;
        if (c + 32 > dq) p1[r] = NEG; }
}
__device__ __forceinline__ void softmax_tile(f32x16& p0, f32x16& p1, float& m_reg, float& l_reg, float& alpha, bf16x8& pa0, bf16x8& pa1, bf16x8& pa2, bf16x8& pa3) {
    float pmax = p0[0];
#pragma unroll
    for (int r = 1; r < 16; ++r) pmax = fmaxf(pmax, p0[r]);
#pragma unroll
    for (int r = 0; r < 16; ++r) pmax = fmaxf(pmax, p1[r]);
    { auto rr = __builtin_amdgcn_permlane32_swap(__float_as_uint(pmax), __float_as_uint(pmax), false, false); pmax = fmaxf(__uint_as_float(rr[0]), __uint_as_float(rr[1])); }
    float mn = m_reg; alpha = 1.f;
    if (!__all(pmax - m_reg <= 8.0f)) { mn = fmaxf(m_reg, pmax); alpha = __builtin_amdgcn_exp2f(m_reg - mn); m_reg = mn; }
    float ps = 0.f;
#pragma unroll
    for (int r = 0; r < 16; ++r) { p0[r] = __builtin_amdgcn_exp2f(p0[r] - mn); ps += p0[r]; }
#pragma unroll
    for (int r = 0; r < 16; ++r) { p1[r] = __builtin_amdgcn_exp2f(p1[r] - mn); ps += p1[r]; }
    { auto rr = __builtin_amdgcn_permlane32_swap(__float_as_uint(ps), __float_as_uint(ps), false, false); ps = __uint_as_float(rr[0]) + __uint_as_float(rr[1]); }
    l_reg = l_reg * alpha + ps;
#define PK4(P, B_, OUT) do { unsigned a0 = cvt_pk_bf16(P[B_+0], P[B_+1]), a1 = cvt_pk_bf16(P[B_+2], P[B_+3]); \
        unsigned b0 = cvt_pk_bf16(P[B_+4], P[B_+5]), b1 = cvt_pk_bf16(P[B_+6], P[B_+7]); \
        auto r0 = __builtin_amdgcn_permlane32_swap(a0, b0, false, false); auto r1 = __builtin_amdgcn_permlane32_swap(a1, b1, false, false); \
        u32x4 w = {r0[0], r1[0], r0[1], r1[1]}; OUT = __builtin_bit_cast(bf16x8, w); } while (0)
    PK4(p0, 0, pa0); PK4(p0, 8, pa1); PK4(p1, 0, pa2); PK4(p1, 8, pa3);
#undef PK4
}

__device__ __forceinline__ void attn_block(int b, int h, int qb, const bf16_t* Q, const bf16_t* KN, const bf16_t* KR, const bf16_t* V, bf16_t* O, LAS char* lds, unsigned long long* pw = nullptr) {
    const int tid = opaque_tid(), wid = __builtin_amdgcn_readfirstlane(tid >> 6), lane = tid & 63, r32 = lane & 31, hi = lane >> 5;
    const size_t row0 = (size_t)b * SEQ;
    const int q0 = qb * QB + wid * QBLK;
    const int NT = (qb + 1) * (QB / KVBLK);
    LAS char* V_lds = lds + OFF_V; LAS char* K_lds = lds + OFF_K;
    LAS float* ws = (LAS float*)(lds + OFF_WS) + wid * 64; LAS float* li_l = ws; LAS float* al_l = ws + 32;
    const int sr = tid >> 4, sc = (tid & 15) * 8, kr_row = tid >> 3, kr_c = tid & 7;
    const int vst0 = v_st(sr, sc), vst1 = v_st(32 + sr, sc), kws = k_addr(sr, tid & 15), kwr = k_addr(kr_row, 16 + kr_c);
    const int vb0 = (int)(uintptr_t)lds + v_rd_base(lane);
    const bf16_t* KNh = KN + row0 * 1024 + h * 128 + sc; const bf16_t* Vh = V + row0 * 1024 + h * 128 + sc; const bf16_t* KRb = KR + row0 * 64 + kr_c * 8;
    bf16x8 st_k0, st_k1, st_kr, st_v0, st_v1;
#define SLOAD(t) do { const size_t k0_ = (size_t)(t) * KVBLK; \
        st_k0 = *(const bf16x8*)(KNh + (k0_ + sr) * 1024); st_k1 = *(const bf16x8*)(KNh + (k0_ + 32 + sr) * 1024); st_kr = *(const bf16x8*)(KRb + (k0_ + kr_row) * 64); \
        st_v0 = *(const bf16x8*)(Vh + (k0_ + sr) * 1024); st_v1 = *(const bf16x8*)(Vh + (k0_ + 32 + sr) * 1024); } while (0)
#define SWRITE(bf, vo) do { *(LAS bf16x8*)(K_lds + (bf) * SHM_K + kws) = st_k0; *(LAS bf16x8*)(K_lds + (bf) * SHM_K + kws + 32 * KPITCH) = st_k1; *(LAS bf16x8*)(K_lds + (bf) * SHM_K + kwr) = st_kr; \
        *(LAS bf16x8*)(V_lds + (vo) + vst0) = st_v0; *(LAS bf16x8*)(V_lds + (vo) + vst1) = st_v1; } while (0)
    SLOAD(0);
    bf16x8 qr[12];
    { const bf16_t* Qw = Q + (row0 + q0 + r32) * 1536 + h * 192 + hi * 8;
#pragma unroll
      for (int d0 = 0; d0 < 12; ++d0) qr[d0] = *(const bf16x8*)(Qw + d0 * 16); }
    float m_reg = -1e30f, l_reg = 0.f; f32x16 o[4] = {};
    f32x16 p0, p1; bf16x8 pa0, pa1, pa2, pa3; float alpha;
    asm volatile("s_waitcnt vmcnt(0)" ::: "memory");
    SWRITE(0, 0);
    __syncthreads();
    const bool odd = wid >= 4; int vo_prev = 0, vo_cur = 0, vo_next = SHM_V;
#define RESC(a) do { if (__any((a) < 1.f)) { if (hi == 0) al_l[r32] = (a); asm volatile("s_waitcnt lgkmcnt(0)" ::: "memory"); \
        _Pragma("unroll") for (int d_ = 0; d_ < 4; ++d_) _Pragma("unroll") for (int r = 0; r < 16; ++r) o[d_][r] *= al_l[crow(r, hi)]; } } while (0)
#if PROBE_T
    unsigned long long pa_ = 0, pb_ = 0, pc_ = 0, pd_ = 0, pe2_ = 0; const unsigned long long pst_ = __builtin_amdgcn_s_memtime();
#define PSTAMP(v) const unsigned long long v = __builtin_amdgcn_s_memtime()
#define PACC(acc, a, b) acc += (b) - (a)
#else
#define PSTAMP(v) do {} while (0)
#define PACC(acc, a, b) do {} while (0)
#endif
#define TILE(t, BF) do { PSTAMP(s0_); const bool more_ = ((t) + 1 < NT); if (more_) SLOAD((t) + 1); SBAR(); \
        if (odd && (t) > 0) { pv_tile(o, vb0 + vo_prev, pa0, pa1, pa2, pa3); SBAR(); } \
        PSTAMP(s1_); qkt<BF>(p0, p1, K_lds, r32, hi, qr); \
        { const int kb_ = (t) * KVBLK; if (kb_ + KVBLK - 1 > q0) mask_tile(p0, p1, q0 + r32 - kb_ - 4 * hi); } \
        asm volatile("" : "+v"(p0), "+v"(p1)); PSTAMP(s2_); \
        softmax_tile(p0, p1, m_reg, l_reg, alpha, pa0, pa1, pa2, pa3); RESC(alpha); SBAR(); PSTAMP(s3_); \
        if (!odd) pv_tile(o, vb0 + vo_cur, pa0, pa1, pa2, pa3); \
        PSTAMP(s4_); if (more_) { asm volatile("s_waitcnt vmcnt(0)" ::: "memory"); SWRITE((BF) ^ 1, vo_next); } \
        PSTAMP(s5_); __syncthreads(); PSTAMP(s6_); PACC(pa_, s1_, s2_); PACC(pb_, s2_, s3_); PACC(pc_, s3_, s4_); PACC(pd_, s4_, s5_); PACC(pe2_, s5_, s6_); vo_prev = vo_cur; vo_cur = vo_next; vo_next = (vo_next == (NVB - 1) * SHM_V) ? 0 : vo_next + SHM_V; } while (0)
#pragma unroll 1
    for (int t = 0; t < NT; t += 2) { TILE(t, 0); TILE(t + 1, 1); }
    if (odd) pv_tile(o, vb0 + vo_prev, pa0, pa1, pa2, pa3);
#if PROBE_T
    if (pw && blockIdx.x == 0 && tid == 0) { pw[8] += pa_; pw[9] += pb_; pw[10] += pc_; pw[11] += pd_; pw[12] += pe2_; pw[13] += (unsigned long long)NT; pw[14] += __builtin_amdgcn_s_memtime() - pst_; }
#endif
    if (hi == 0) li_l[r32] = l_reg; asm volatile("s_waitcnt lgkmcnt(0)" ::: "memory");
    __syncthreads();
    { LAS bf16_t* stg = (LAS bf16_t*)(lds + wid * 8704);
#pragma unroll
      for (int r = 0; r < 16; ++r) { const int orow = crow(r, hi); const float rl = __builtin_amdgcn_rcpf(li_l[orow]);
#pragma unroll
          for (int d0 = 0; d0 < 4; ++d0) { const float v = o[d0][r] * rl; stg[orow * 136 + d0 * 32 + r32] = (bf16_t)(cvt_pk_bf16(v, v) & 0xffffu); } }
      asm volatile("s_waitcnt lgkmcnt(0)" ::: "memory");
      bf16_t* Ow = O + (row0 + q0) * 1024 + h * 128 + (lane & 15) * 8;
#pragma unroll
      for (int it = 0; it < 8; ++it) { const int row = it * 4 + (lane >> 4); const u32x4 v = *(const LAS u32x4*)(stg + row * 136 + (lane & 15) * 8); *(u32x4*)(Ow + (size_t)row * 1024) = v; } }
    __syncthreads();
#undef SLOAD
#undef SWRITE
#undef RESC
#undef TILE
#undef PSTAMP
#undef PACC
}
#undef SBAR
}

#define XB_TMO      128
#define XB_XCNT(j)  (256  + 64 * (j))
#define XB_XSUB(j)  (1280 + 64 * (j))
#define XB_XGEN(j)  (2304 + 64 * (j))
#define XB_TOP      3328
#define XB_TOPGEN   3392
#define XCD_BAR_WORDS 3456
#define XB_SPIN_CAP (1u << 22)
__device__ __forceinline__ unsigned xb_ld(unsigned* p)              { return __hip_atomic_load(p, __ATOMIC_RELAXED, __HIP_MEMORY_SCOPE_AGENT); }
__device__ __forceinline__ unsigned xb_add(unsigned* p, unsigned v) { return __hip_atomic_fetch_add(p, v, __ATOMIC_RELAXED, __HIP_MEMORY_SCOPE_AGENT); }
__device__ __forceinline__ unsigned xb_xcc_id() { return (unsigned)__builtin_amdgcn_s_getreg((3 << 11) | 20) & 0xFu; }
#define XB_SPIN(cond, bar) do { unsigned _sp = 0; while (cond) { __builtin_amdgcn_s_sleep(1); \
    if ((++_sp & 255u) == 0u) { if (xb_ld(&(bar)[XB_TMO])) break; if (_sp > XB_SPIN_CAP) { atomicAdd(&(bar)[XB_TMO], 1u); break; } } } } while (0)
struct XcdBarrier { unsigned* bar; unsigned x; volatile LAS unsigned* st; };
__device__ __forceinline__ XcdBarrier xcd_barrier_post(unsigned* bar, volatile LAS unsigned* st) {
    XcdBarrier b; b.bar = bar; b.x = xb_xcc_id(); b.st = st;
    if (threadIdx.x == 0) (void)xb_add(&bar[XB_XCNT(b.x)], 1u);
    return b;
}
__device__ __forceinline__ void xcd_barrier_complete(unsigned* bar, unsigned x, unsigned& nloc, unsigned& nx) {
    const unsigned G = gridDim.x * gridDim.y * gridDim.z;
    unsigned sum, cnt, mine, sp = 0u;
    for (;;) {
        sum = 0u; cnt = 0u; mine = 0u;
#pragma unroll
        for (unsigned j = 0; j < 16; ++j) { const unsigned c = xb_ld(&bar[XB_XCNT(j)]); sum += c; cnt += (c > 0u) ? 1u : 0u; mine = (j == x) ? c : mine; }
        if (sum == G) break;
        __builtin_amdgcn_s_sleep(1);
        if ((++sp & 255u) == 0u) { if (xb_ld(&bar[XB_TMO])) break; if (sp > XB_SPIN_CAP) { atomicAdd(&bar[XB_TMO], 1u); break; } }
    }
    nloc = mine > 0u ? mine : 1u; nx = cnt > 0u ? cnt : 1u;
}
__device__ __forceinline__ void xcd_barrier(const XcdBarrier& b) {
    asm volatile("s_waitcnt vmcnt(0)" ::: "memory");
    __syncthreads();
    if (opaque_tid() == 0) {
        unsigned* bar = b.bar; unsigned bx = b.x;
        asm volatile("" : "+s"(bar), "+s"(bx));
        __builtin_amdgcn_s_waitcnt(0);
        unsigned nloc = b.st[0], nx = b.st[1];
        if (nloc == 0u) { xcd_barrier_complete(bar, bx, nloc, nx); b.st[0] = nloc; b.st[1] = nx; }
        const unsigned old = xb_add(&bar[XB_XSUB(bx)], 1u);
        const unsigned gen = old / nloc;
        if (old + 1u == (gen + 1u) * nloc) {
            __builtin_amdgcn_fence(__ATOMIC_RELEASE, "agent");
            asm volatile("s_waitcnt vmcnt(0)" ::: "memory");
            const unsigned og = xb_add(&bar[XB_TOP], 1u);
            const unsigned tg = og / nx;
            if (og + 1u == (tg + 1u) * nx) xb_add(&bar[XB_TOPGEN], 1u);
            else XB_SPIN(xb_ld(&bar[XB_TOPGEN]) == tg, bar);
            __builtin_amdgcn_fence(__ATOMIC_ACQUIRE, "agent");
            xb_add(&bar[XB_XGEN(bx)], 1u);
            asm volatile("s_waitcnt vmcnt(0)" ::: "memory");
        } else {
            XB_SPIN(xb_ld(&bar[XB_XGEN(bx)]) == gen, bar);
            __builtin_amdgcn_fence(__ATOMIC_ACQUIRE, "agent");
            asm volatile("s_waitcnt vmcnt(0)" ::: "memory");
        }
    }
    __syncthreads();
}

struct Args { const void* in[30]; float* out; unsigned char* ws; int ph_lo, ph_hi, li, pad; };
struct Ctx { int tid, lane, wave, vcu, G, bid; LAS unsigned char* lds; volatile LAS int* misc; };
__device__ __forceinline__ Ctx fresh_ctx(const Ctx& c) {
    Ctx r = c; unsigned l = (unsigned)(uintptr_t)c.lds, m = (unsigned)(uintptr_t)c.misc;
    asm volatile("" : "+s"(r.wave), "+s"(r.vcu), "+s"(r.G), "+s"(r.bid), "+s"(l), "+s"(m));
    r.lds = (LAS unsigned char*)(uintptr_t)l; r.misc = (volatile LAS int*)(uintptr_t)m; r.tid = opaque_tid(); r.lane = r.tid & 63; return r; }
typedef const CAS Args* ArgsP;
__device__ __forceinline__ const CAS Args& fresh_args(ArgsP p) { asm volatile("" : "+s"(p)); return *p; }
enum { I_X = 0, I_P, I_POS, I_MLA_WIN, I_MLA_QN, I_MLA_KVN, I_MLA_WUQ, I_MLA_WUKV, I_MLA_WO, I_LRU_WIN, I_LRU_CW, I_LRU_CB, I_LRU_WA, I_LRU_BA, I_LRU_WX, I_LRU_BX, I_LRU_LAM, I_LRU_WOUT,
       I_LN1G, I_LN1B, I_LN2G, I_LN2B, I_MOE_WR, I_MOE_BR, I_MOE_WUP, I_MOE_BUP, I_MOE_WDN, I_MOE_BDN, I_PLE_WG, I_PLE_WP };
#define INF(i) ((const float*)args.in[i])
#define WSP(T_, off) ((T_*)(args.ws + (off)))

__device__ __forceinline__ void tr_load(const float* W, int ld, int k0, int sc0, int sc1, int lane, f32x4 (&v)[16]) {
    const int half = (lane & 15) >> 3, scol = half ? sc1 : sc0, c4 = (lane & 7) * 4, rs = lane >> 4;
#pragma unroll
    for (int i = 0; i < 8; ++i) { const float* p = W + (size_t)(k0 + 8 * i + 2 * rs) * ld + scol + c4;
        v[2 * i] = (scol >= 0) ? *(const f32x4*)p : (f32x4){0.f, 0.f, 0.f, 0.f}; v[2 * i + 1] = (scol >= 0) ? *(const f32x4*)(p + ld) : (f32x4){0.f, 0.f, 0.f, 0.f}; }
}
__device__ __forceinline__ void tr_store(f32x4 (&v)[16], const float* ksc, int k0, bf16_t* dst  , int K, LAS unsigned* scr, int lane) {
    const int rs = lane >> 4;
    if (ksc) {
#pragma unroll
        for (int i = 0; i < 8; ++i) { v[2 * i] = v[2 * i] * ksc[k0 + 8 * i + 2 * rs]; v[2 * i + 1] = v[2 * i + 1] * ksc[k0 + 8 * i + 2 * rs + 1]; } }
#pragma unroll
    for (int i = 0; i < 8; ++i) { LAS unsigned* s = scr + (4 * i + rs) * 65 + (lane & 15) * 4;
#pragma unroll
        for (int e = 0; e < 4; ++e) s[e] = cvt_pk_bf16(v[2 * i][e], v[2 * i + 1][e]); }
    asm volatile("s_waitcnt lgkmcnt(0)" ::: "memory");
    const int c = lane & 7;
#pragma unroll
    for (int j = 0; j < 8; ++j) { const int n = (lane >> 3) + 8 * j; const LAS unsigned* s = scr + (4 * c) * 65 + n;
        u32x4 o; o.x = s[0]; o.y = s[65]; o.z = s[130]; o.w = s[195];
        *(u32x4*)(dst + (size_t)n * K + 8 * c) = o; }
    asm volatile("s_waitcnt lgkmcnt(0)" ::: "memory");
}
enum { J_NAT = 0, J_MLA_WIN, J_MLA_WUQ, J_LRU_WAX, J_MOE_UP };
__device__ __forceinline__ int tr_map(int job, int g) {
    switch (job) {
    case J_MLA_WIN: return g < 32 ? 32 * g : (g == 32 ? 1024 : (g == 36 ? 1056 : -1));
    case J_MLA_WUQ: if (g < 32) { const int t = g >> 3, bj = (g >> 2) & 1, cg = g & 3; return (2 * t + bj) * 192 + 32 * cg; }
                    else { const int g2 = g - 32, t2 = g2 >> 3, bj = (g2 >> 2) & 1, hh = g2 & 3; return (4 * t2 + hh) * 192 + 128 + 32 * bj; }
    case J_LRU_WAX: { const int pn = g >> 3, cg = g & 3; return 128 * pn + 32 * cg; }
    case J_MOE_UP:  { const int pn = g >> 3, bj = (g >> 2) & 1, cg = g & 3; return bj * 1024 + 128 * pn + 32 * cg; }
    default: return 32 * g;
    }
}
__device__ __forceinline__ void tr_job(const Ctx& C, int job, const float* src, size_t srcstride, int nmat, int K, int ld, int N, bf16_t* dst, size_t dststride, const float* ksc, int kscstride,
                                       const float* src2  ) {
    LAS unsigned* scr = (LAS unsigned*)(C.lds + C.wave * 8320);
    const int gw = C.vcu * NWAVES + C.wave, NGW = C.G * NWAVES;
    const int nkb = K / 64, nnb = N / 64, per = nkb * nnb, total = per * nmat;
#define TR_DECODE(it_, W_, k0_, s0_, s1_, ks_, d_) do { const int mat_ = (it_) / per, r_ = (it_) - mat_ * per, kb_ = r_ / nnb, nb_ = r_ - kb_ * nnb; \
        s0_ = tr_map(job, 2 * nb_); s1_ = tr_map(job, 2 * nb_ + 1); W_ = src + (size_t)mat_ * srcstride; \
        if (job == J_LRU_WAX && ((nb_ >> 1) & 1)) W_ = src2 + (size_t)mat_ * srcstride;       \
        k0_ = kb_ * 64; ks_ = ksc ? ksc + (size_t)mat_ * kscstride : nullptr; d_ = (bf16_t*)((char*)dst + (size_t)mat_ * dststride) + (size_t)(nb_ * 64) * K + kb_ * 64; } while (0)
    f32x4 va[16], vb[16];
    int it = gw; const float* Wc; int k0c, s0c, s1c; const float* ksc_c; bf16_t* dc;
    if (it < total) { TR_DECODE(it, Wc, k0c, s0c, s1c, ksc_c, dc); tr_load(Wc, ld, k0c, s0c, s1c, C.lane, va); }
    while (it < total) {
        const int nit = it + NGW; const float* Wn = nullptr; int k0n = 0, s0n = 0, s1n = 0; const float* ksc_n = nullptr; bf16_t* dn = nullptr;
        if (nit < total) { TR_DECODE(nit, Wn, k0n, s0n, s1n, ksc_n, dn); tr_load(Wn, ld, k0n, s0n, s1n, C.lane, vb); }
        tr_store(va, ksc_c, k0c, dc, K, scr, C.lane);
#pragma unroll
        for (int i = 0; i < 16; ++i) va[i] = vb[i];
        it = nit; k0c = k0n; ksc_c = ksc_n; dc = dn;
    }
#undef TR_DECODE
}
template <int JOB, int N, bool G64  >
__device__ __forceinline__ void tr_job_fp8(const Ctx& C, const float* src, size_t srcstride, int nmat, unsigned char* dst, size_t dststride, unsigned char* SW) {
    constexpr int K = 1024, ld = N;
    LAS float* scr = (LAS float*)(C.lds + C.wave * 16640);
    const int gw = C.vcu * NWAVES + C.wave, NGW = C.G * NWAVES, lane = C.lane;
    const int nkb = K / 64, nnb = N / 64, per = nkb * nnb, total = per * nmat;
    f32x4 v[16], vn[16];
    if (gw < total) { const int mat = gw / per, r = gw - mat * per, kb = r / nnb, nb = r - kb * nnb; tr_load(src + (size_t)mat * srcstride, ld, kb * 64, tr_map(JOB, 2 * nb), tr_map(JOB, 2 * nb + 1), lane, v); }
    for (int it = gw; it < total; it += NGW) {
        const int mat = it / per, r = it - mat * per, kb = r / nnb, nb = r - kb * nnb;
        { const int nit = it + NGW; if (nit < total) { const int matn = nit / per, rn = nit - matn * per, kbn = rn / nnb, nbn = rn - kbn * nnb; tr_load(src + (size_t)matn * srcstride, ld, kbn * 64, tr_map(JOB, 2 * nbn), tr_map(JOB, 2 * nbn + 1), lane, vn); } }
        const int rs = lane >> 4;
#pragma unroll
        for (int i = 0; i < 8; ++i) { LAS float* sp = scr + (8 * i + 2 * rs) * 65 + (lane & 15) * 4;
#pragma unroll
            for (int e = 0; e < 4; ++e) { sp[e] = v[2 * i][e]; sp[65 + e] = v[2 * i + 1][e]; } }
        asm volatile("s_waitcnt lgkmcnt(0)" ::: "memory");
        const int c = lane & 7;
#pragma unroll
        for (int j = 0; j < 8; ++j) { const int n = (lane >> 3) + 8 * j; const LAS float* sp = scr + (8 * c) * 65 + n;
            float x[8]; float am = 0.f;
#pragma unroll
            for (int q = 0; q < 8; ++q) { x[q] = sp[q * 65]; am = fmaxf(am, fabsf(x[q])); }
            am = fmaxf(am, __shfl_xor(am, 1)); am = fmaxf(am, __shfl_xor(am, 2));
            if (G64) am = fmaxf(am, __shfl_xor(am, 4));
            int eb = (int)((__float_as_uint(am) >> 23) & 0xffu) - 7; eb = eb < 1 ? 1 : eb;
            const float inv = __uint_as_float((unsigned)(254 - eb) << 23);
            int w0 = __builtin_amdgcn_cvt_pk_fp8_f32(x[0] * inv, x[1] * inv, 0, false); w0 = __builtin_amdgcn_cvt_pk_fp8_f32(x[2] * inv, x[3] * inv, w0, true);
            int w1 = __builtin_amdgcn_cvt_pk_fp8_f32(x[4] * inv, x[5] * inv, 0, false); w1 = __builtin_amdgcn_cvt_pk_fp8_f32(x[6] * inv, x[7] * inv, w1, true);
            const int nrow = nb * 64 + n;
            *(u32x2*)(dst + (size_t)mat * dststride + (size_t)nrow * K + kb * 64 + 8 * c) = (u32x2){(unsigned)w0, (unsigned)w1};
            if (!G64) { if ((c & 3) == 0) SW[(size_t)mat * 65536 + (size_t)(nrow >> 8) * 8192 + (size_t)(kb >> 1) * 1024 + (nrow & 255) * 4 + 2 * (kb & 1) + (c >> 2)] = (unsigned char)eb; }
            else { if (c == 0) SW[(size_t)mat * 16384 + (size_t)(nrow >> 8) * 4096 + (size_t)(kb >> 1) * 512 + (nrow & 255) * 2 + (kb & 1)] = (unsigned char)eb; } }
        asm volatile("s_waitcnt lgkmcnt(0)" ::: "memory");
#pragma unroll
        for (int i = 0; i < 16; ++i) v[i] = vn[i];
    }
}
__device__ __forceinline__ void cvt_rows(const Ctx& C, const float* src, bf16_t* dst, size_t n8  ) {
    const size_t gt = (size_t)C.vcu * 512 + C.tid, NT = (size_t)C.G * 512;
    size_t i = gt;
    for (; i + 3 * NT < n8; i += 4 * NT) {
        f32x4 a[4], b[4];
#pragma unroll
        for (int q = 0; q < 4; ++q) { a[q] = *(const f32x4*)(src + (i + q * NT) * 8); b[q] = *(const f32x4*)(src + (i + q * NT) * 8 + 4); }
#pragma unroll
        for (int q = 0; q < 4; ++q) *(u32x4*)(dst + (i + q * NT) * 8) = pack8(a[q], b[q]); }
    for (; i < n8; i += NT) { const f32x4 a = *(const f32x4*)(src + i * 8), b = *(const f32x4*)(src + i * 8 + 4); *(u32x4*)(dst + i * 8) = pack8(a, b); }
}
__device__ __forceinline__ void phase_prologue(const CAS Args& args, const Ctx& C) {
    tr_job(C, J_MLA_WIN, INF(I_MLA_WIN), (size_t)DM * LATD, 2, DM, LATD, 1280, WSP(bf16_t, WS_W_MLA + OFF_MLA_WIN), W_MLA_STRIDE, nullptr, 0, nullptr);
    tr_job(C, J_MLA_WUQ, INF(I_MLA_WUQ), (size_t)QL * 1536, 2, QL, 1536, 1536, WSP(bf16_t, WS_W_MLA + OFF_MLA_WUQ), W_MLA_STRIDE, INF(I_MLA_QN), QL, nullptr);
    tr_job(C, J_NAT, INF(I_MLA_WUKV), (size_t)KVL * 2048, 2, KVL, 2048, 2048, WSP(bf16_t, WS_W_MLA + OFF_MLA_WUKV), W_MLA_STRIDE, INF(I_MLA_KVN), KVL, nullptr);
    tr_job(C, J_NAT, INF(I_MLA_WO), (size_t)DM * DM, 2, DM, DM, DM, WSP(bf16_t, WS_W_MLA + OFF_MLA_WO), W_MLA_STRIDE, nullptr, 0, nullptr);
    tr_job(C, J_NAT, INF(I_LRU_WIN), (size_t)DM * 2048, 2, DM, 2048, 2048, WSP(bf16_t, WS_W_LRU + OFF_LRU_WIN), W_LRU_STRIDE, nullptr, 0, nullptr);
    for (int j = 0; j < 2; ++j)
        tr_job(C, J_LRU_WAX, INF(I_LRU_WA) + (size_t)j * 4 * 65536, (size_t)256 * 256, 4, 256, 256, 512, WSP(bf16_t, WS_W_LRU + OFF_LRU_WAX + (size_t)j * W_LRU_STRIDE), (size_t)512 * 256 * 2, nullptr, 0, INF(I_LRU_WX) + (size_t)j * 4 * 65536);
    tr_job(C, J_NAT, INF(I_LRU_WOUT), (size_t)DM * DM, 2, DM, DM, DM, WSP(bf16_t, WS_W_LRU + OFF_LRU_WOUT), W_LRU_STRIDE, nullptr, 0, nullptr);
    tr_job(C, J_NAT, INF(I_PLE_WG), (size_t)DM * DM, 4, DM, DM, DM, WSP(bf16_t, WS_W_PLE + OFF_PLE_WG), W_PLE_STRIDE, nullptr, 0, nullptr);
    tr_job(C, J_NAT, INF(I_PLE_WP), (size_t)PLED * DM, 4, PLED, DM, DM, WSP(bf16_t, WS_W_PLE + OFF_PLE_WP), W_PLE_STRIDE, nullptr, 0, nullptr);
    __syncthreads();
    tr_job_fp8<J_MOE_UP, 2048, false>(C, INF(I_MOE_WUP), (size_t)DM * 2048, DEPTH * NE, args.ws + WS_W_UP, (size_t)2048 * 1024, args.ws + WS_SW);
    tr_job_fp8<J_NAT, 1024, true>(C, INF(I_MOE_WDN), (size_t)DFF * DM, DEPTH * NE, args.ws + WS_W_DN, (size_t)1024 * 1024, args.ws + WS_SWD);
    __syncthreads();
    cvt_rows(C, INF(I_X), WSP(bf16_t, WS_XB), (size_t)T * DM / 8);
    cvt_rows(C, INF(I_P), WSP(bf16_t, WS_PB), (size_t)DEPTH * T * PLED / 8);
    { const int* pos = (const int*)args.in[I_POS]; float* CS = WSP(float, WS_CS); float* SN = WSP(float, WS_SN);
      const size_t gt = (size_t)C.vcu * 512 + C.tid, NT = (size_t)C.G * 512;
      for (size_t i = gt; i < (size_t)T * 32; i += NT) { const int tok = (int)(i >> 5), j = (int)(i & 31);
          const double inv = exp(-9.210340371976184 * (double)j / 32.0); const double ang = (double)pos[tok] * inv; double s, c; sincos(ang, &s, &c); CS[i] = (float)c; SN[i] = (float)s; }
      { const float* wr = INF(I_MOE_WR); const float* lg1 = INF(I_LN1G); bf16_t* WRH = WSP(bf16_t, WS_WRH); bf16_t* WRL = WSP(bf16_t, WS_WRL);
        for (size_t i = gt; i < (size_t)DEPTH * 64 * 64; i += NT) { const int l = (int)(i >> 12), st = (int)(i >> 6) & 63, ln = (int)i & 63; float w[8], lo[8];
#pragma unroll
            for (int j = 0; j < 8; ++j) { const int k = 16 * st + 8 * (ln >> 5) + j; w[j] = lg1[l * DM + k] * wr[((size_t)l * DM + k) * NE + (ln & 31)]; }
            u32x4 h; h.x = cvt_pk_bf16(w[0], w[1]); h.y = cvt_pk_bf16(w[2], w[3]); h.z = cvt_pk_bf16(w[4], w[5]); h.w = cvt_pk_bf16(w[6], w[7]);
            lo[0] = w[0] - bf_lo(h.x); lo[1] = w[1] - bf_hi(h.x); lo[2] = w[2] - bf_lo(h.y); lo[3] = w[3] - bf_hi(h.y); lo[4] = w[4] - bf_lo(h.z); lo[5] = w[5] - bf_hi(h.z); lo[6] = w[6] - bf_lo(h.w); lo[7] = w[7] - bf_hi(h.w);
            u32x4 q; q.x = cvt_pk_bf16(lo[0], lo[1]); q.y = cvt_pk_bf16(lo[2], lo[3]); q.z = cvt_pk_bf16(lo[4], lo[5]); q.w = cvt_pk_bf16(lo[6], lo[7]);
            *(u32x4*)(WRH + i * 8) = h; *(u32x4*)(WRL + i * 8) = q; }
        float* RC = WSP(float, WS_RC); const float* lb1 = INF(I_LN1B); const float* rb = INF(I_MOE_BR);
        for (size_t i = gt; i < (size_t)DEPTH * NE; i += NT) { const int l = (int)(i >> 5), e = (int)i & 31; float c1 = 0.f, c2 = 0.f;
            for (int k = 0; k < DM; ++k) { const float w = wr[((size_t)l * DM + k) * NE + e]; c1 = fmaf(lg1[l * DM + k], w, c1); c2 = fmaf(lb1[l * DM + k], w, c2); }
            RC[l * 64 + e] = c1; RC[l * 64 + 32 + e] = c2 + rb[l * NE + e]; } }
      float* SPL = WSP(float, WS_SPL); const float* lam = INF(I_LRU_LAM);
      for (size_t i = gt; i < 2 * 1024; i += NT) { const double l = (double)lam[i]; SPL[i] = (float)(-8.0 * log1p(exp(-l))); } }
}

__device__ __forceinline__ void moe_table(const CAS Args& args, const Ctx& C0, int layer) {
    Ctx C = C0; C.tid = opaque_tid(); C.lane = C.tid & 63;
    const unsigned* cnt = WSP(unsigned, WS_CTL) + CW_CNT + 64 * layer;
    __syncthreads();
    if (C.tid < 32) C.misc[64 + C.tid] = (int)__hip_atomic_load(cnt + C.tid, __ATOMIC_RELAXED, __HIP_MEMORY_SCOPE_AGENT);
    __syncthreads();
    if (C.tid == 0) { int acc = 0; for (int e = 0; e < 32; ++e) { C.misc[16 + e] = acc; acc += (C.misc[64 + e] + 255) >> 8; } C.misc[16 + 32] = acc; }
    __syncthreads();
    { volatile LAS unsigned char* te = (volatile LAS unsigned char*)(C.lds + TILE_E_OFF);
      for (int mg = C.tid; mg < C.misc[48]; mg += NWAVES * 64) { int e = 0; for (int j = 1; j < 32; ++j) e += (C.misc[16 + j] <= mg) ? 1 : 0; te[mg] = (unsigned char)e; } }
    __syncthreads();
}

__device__ __forceinline__ void phase_ln_router(const CAS Args& args, const Ctx& C0, int layer) {
    const int cslot = layer + args.pad;
    Ctx C = C0; C.tid = opaque_tid(); C.lane = C.tid & 63;
    const bf16_t* Y = WSP(bf16_t, WS_Y); bf16_t* X1B = WSP(bf16_t, WS_X1B);
    const float* g1 = INF(I_LN1G) + layer * DM; const float* b1 = INF(I_LN1B) + layer * DM;
    const bf16_t* WRH = WSP(bf16_t, WS_WRH) + (size_t)layer * 64 * 64 * 8; const bf16_t* WRL = WSP(bf16_t, WS_WRL) + (size_t)layer * 64 * 64 * 8; const float* rc = WSP(float, WS_RC) + layer * 64;
    unsigned* gcnt = WSP(unsigned, WS_CTL) + CW_CNT + 64 * cslot;
    int* lists = WSP(int, WS_LIST); int* slot = WSP(int, WS_SLOT); float* gate = WSP(float, WS_GATE);
    LAS float* part = (LAS float*)C.lds;
    volatile LAS int* lcnt = (volatile LAS int*)(C.lds + 69632);
    volatile LAS int* lbase = lcnt + 32;
    LAS float* stat = (LAS float*)(C.lds + 70144);
    f32x4 gv[4], bv[4];
#pragma unroll
    for (int j = 0; j < 2; ++j) { gv[2 * j] = *(const f32x4*)(g1 + 8 * C.lane + 512 * j); gv[2 * j + 1] = *(const f32x4*)(g1 + 8 * C.lane + 512 * j + 4);
        bv[2 * j] = *(const f32x4*)(b1 + 8 * C.lane + 512 * j); bv[2 * j + 1] = *(const f32x4*)(b1 + 8 * C.lane + 512 * j + 4); }
    unsigned char* X1Q = args.ws + WS_X1Q; int sexp;
    { float ag = 0.f, ab = 0.f;
#pragma unroll
      for (int j = 0; j < 4; ++j)
#pragma unroll
          for (int e = 0; e < 4; ++e) { ag = fmaxf(ag, fabsf(gv[j][e])); ab = fmaxf(ab, fabsf(bv[j][e])); }
#pragma unroll
      for (int o = 1; o < 64; o <<= 1) { ag = fmaxf(ag, __shfl_xor(ag, o)); ab = fmaxf(ab, __shfl_xor(ab, o)); }
      const float bound = 16.0f * ag + ab + 1e-20f;
      sexp = 134 - (int)((__float_as_uint(bound) >> 23) & 0xffu);
      sexp = sexp < -100 ? -100 : (sexp > 100 ? 100 : sexp);
      if (C.tid == 0) __hip_atomic_store(WSP(unsigned, WS_CTL) + CW_SA + layer, (unsigned)sexp, __ATOMIC_RELAXED, __HIP_MEMORY_SCOPE_AGENT); }
    const float qs = __uint_as_float((unsigned)(127 + sexp) << 23), qlo = KF(-448.f), qhi = KF(448.f);
    for (int chunk = C.vcu; chunk < T / 128; chunk += C.G) {
        const int row0 = chunk * 128;
        if (C.tid < 32) lcnt[C.tid] = 0;
#pragma unroll 1
        for (int i = 0; i < 16; ++i) { const size_t row = (size_t)row0 + C.wave * 16 + i;
            f32x4 v[4]; float s = 0.f;
#pragma unroll
            for (int j = 0; j < 2; ++j) { const u32x4 w = *(const u32x4*)(Y + row * DM + 8 * C.lane + 512 * j); v[2 * j] = pg8::bf4_lo(w); v[2 * j + 1] = pg8::bf4_hi(w); }
#pragma unroll
            for (int j = 0; j < 4; ++j) s += (v[j][0] + v[j][1]) + (v[j][2] + v[j][3]);
            const float mean = wave_sum(s) * (1.f / DM); float s2 = 0.f;
#pragma unroll
            for (int j = 0; j < 4; ++j) { v[j] = v[j] - mean; s2 += (v[j][0] * v[j][0] + v[j][1] * v[j][1]) + (v[j][2] * v[j][2] + v[j][3] * v[j][3]); }
            const float rstd = 1.f / sqrtf(wave_sum(s2) * (1.f / DM) + KF(LN_EPS));
            if (C.lane == 0) { stat[(C.wave * 16 + i) * 2] = mean; stat[(C.wave * 16 + i) * 2 + 1] = rstd; }
#pragma unroll
            for (int j = 0; j < 4; ++j) v[j] = v[j] * rstd * gv[j] + bv[j];
#pragma unroll
            for (int j = 0; j < 2; ++j) { const u32x4 hw = pack8(v[2 * j], v[2 * j + 1]);
                *(u32x4*)(X1B + row * DM + 8 * C.lane + 512 * j) = hw;
                const f32x4 q0 = v[2 * j] * qs, q1 = v[2 * j + 1] * qs;
                int w0 = __builtin_amdgcn_cvt_pk_fp8_f32(fminf(fmaxf(q0[0], qlo), qhi), fminf(fmaxf(q0[1], qlo), qhi), 0, false); w0 = __builtin_amdgcn_cvt_pk_fp8_f32(fminf(fmaxf(q0[2], qlo), qhi), fminf(fmaxf(q0[3], qlo), qhi), w0, true);
                int w1 = __builtin_amdgcn_cvt_pk_fp8_f32(fminf(fmaxf(q1[0], qlo), qhi), fminf(fmaxf(q1[1], qlo), qhi), 0, false); w1 = __builtin_amdgcn_cvt_pk_fp8_f32(fminf(fmaxf(q1[2], qlo), qhi), fminf(fmaxf(q1[3], qlo), qhi), w1, true);
                *(u32x2*)(X1Q + row * DM + 8 * C.lane + 512 * j) = (u32x2){(unsigned)w0, (unsigned)w1}; } }
        asm volatile("s_waitcnt vmcnt(0)" ::: "memory");
        __syncthreads();
        { const int grp = C.wave >> 1, kh = C.wave & 1, r32 = C.lane & 31, hi = C.lane >> 5;
          const bf16_t* ah = Y + ((size_t)row0 + grp * 32 + r32) * DM + kh * 512 + hi * 8;
          const bf16_t* bh = WRH + ((size_t)kh * 32 * 64 + C.lane) * 8; const bf16_t* bl = WRL + ((size_t)kh * 32 * 64 + C.lane) * 8;
          f32x16 acc = {};
#pragma unroll 4
          for (int st = 0; st < 32; ++st) { const bf16x8 xh = *(const bf16x8*)(ah + st * 16), wh = *(const bf16x8*)(bh + (size_t)st * 512), wl = *(const bf16x8*)(bl + (size_t)st * 512);
              acc = __builtin_amdgcn_mfma_f32_32x32x16_bf16(xh, wh, acc, 0, 0, 0);
              acc = __builtin_amdgcn_mfma_f32_32x32x16_bf16(xh, wl, acc, 0, 0, 0); }
          LAS float* pp = part + (grp * 2 + kh) * 32 * 33 + r32;
#pragma unroll
          for (int r = 0; r < 16; ++r) pp[((r & 3) + 8 * (r >> 2) + 4 * hi) * 33] = acc[r]; }
        __syncthreads();
        int te[4] = {0, 0, 0, 0}, lp[4] = {0, 0, 0, 0}; float tg[4] = {0.f, 0.f, 0.f, 0.f};
        if (C.tid < 128) { const int grp = C.tid >> 5, ln = C.tid & 31; float lg[32];
            const float mean = stat[C.tid * 2], rstd = stat[C.tid * 2 + 1];
#pragma unroll
            for (int e = 0; e < 32; ++e) lg[e] = rstd * ((part[((grp * 2 + 0) * 32 + ln) * 33 + e] + part[((grp * 2 + 1) * 32 + ln) * 33 + e]) - mean * rc[e]) + rc[32 + e];
            float tv[4]; const float kninf = KF(-__builtin_inff());
#pragma unroll
            for (int k = 0; k < 4; ++k) { float best = lg[0]; int bi = 0;
#pragma unroll
                for (int e = 1; e < 32; ++e) { const bool gt = lg[e] > best; best = gt ? lg[e] : best; bi = gt ? e : bi; }
                te[k] = bi; tv[k] = best;
#pragma unroll
                for (int e = 0; e < 32; ++e) lg[e] = (e == bi) ? kninf : lg[e]; }
            float den = 0.f;
#pragma unroll
            for (int k = 0; k < 4; ++k) { tg[k] = __expf(tv[k] - tv[0]); den += tg[k]; }
            const float rden = 1.0f / den;
#pragma unroll
            for (int k = 0; k < 4; ++k) { tg[k] *= rden; lp[k] = __hip_atomic_fetch_add((LAS int*)&lcnt[te[k]], 1, __ATOMIC_RELAXED, __HIP_MEMORY_SCOPE_WORKGROUP); } }
        __syncthreads();
        if (C.tid < 32) lbase[C.tid] = (int)__hip_atomic_fetch_add(gcnt + C.tid, (unsigned)lcnt[C.tid], __ATOMIC_RELAXED, __HIP_MEMORY_SCOPE_AGENT);
        __syncthreads();
        if (C.tid < 128) { const int tok = row0 + C.tid;
#pragma unroll
            for (int k = 0; k < 4; ++k) { const int pos = lbase[te[k]] + lp[k]; lists[(size_t)te[k] * T + pos] = tok; slot[tok * 4 + k] = te[k] * T + pos; gate[tok * 4 + k] = tg[k]; } }
        __syncthreads();
    }
}

__device__ __forceinline__ void phase_combine_ln2(const CAS Args& args, const Ctx& C0, int layer) {
    Ctx C = C0; C.tid = opaque_tid(); C.lane = C.tid & 63;
    moe_table(args, C, layer);
    const bf16_t* X1B = WSP(bf16_t, WS_X1B); const unsigned char* YS = args.ws + WS_YS; const unsigned char* SY = args.ws + WS_SY; const int* slot = WSP(int, WS_SLOT); const float* gate = WSP(float, WS_GATE);
    bf16_t* X2B = WSP(bf16_t, WS_X2B);
    const float* g2 = INF(I_LN2G) + layer * DM; const float* b2 = INF(I_LN2B) + layer * DM;
    f32x4 gv[4], bv[4];
#pragma unroll
    for (int j = 0; j < 2; ++j) { gv[2 * j] = *(const f32x4*)(g2 + 8 * C.lane + 512 * j); gv[2 * j + 1] = *(const f32x4*)(g2 + 8 * C.lane + 512 * j + 4);
        bv[2 * j] = *(const f32x4*)(b2 + 8 * C.lane + 512 * j); bv[2 * j + 1] = *(const f32x4*)(b2 + 8 * C.lane + 512 * j + 4); }
    const int gw = C.vcu * NWAVES + C.wave, NGW = C.G * NWAVES;
    for (int row = gw; row < T; row += NGW) {
        f32x4 v[4];
#pragma unroll
        for (int j = 0; j < 2; ++j) { const u32x4 w = *(const u32x4*)(X1B + (size_t)row * DM + 8 * C.lane + 512 * j); v[2 * j] = pg8::bf4_lo(w) * ALPHA; v[2 * j + 1] = pg8::bf4_hi(w) * ALPHA; }
#pragma unroll
        for (int k = 0; k < 4; ++k) { const int sv = slot[row * 4 + k]; const float g = gate[row * 4 + k]; const int e = sv >> 15, pos = sv & (T - 1);
            const size_t prow = (size_t)C.misc[16 + e] * 256 + pos;
#pragma unroll
            for (int j = 0; j < 2; ++j) { const u32x2 w = *(const u32x2*)(YS + prow * DM + 8 * C.lane + 512 * j); const unsigned eb = SY[prow * 32 + (C.lane >> 2) + 16 * j];
                const float gs = g * __uint_as_float(eb << 23);
                const f32x2 a = __builtin_amdgcn_cvt_pk_f32_fp8((int)w.x, false), b = __builtin_amdgcn_cvt_pk_f32_fp8((int)w.x, true), c = __builtin_amdgcn_cvt_pk_f32_fp8((int)w.y, false), d = __builtin_amdgcn_cvt_pk_f32_fp8((int)w.y, true);
                v[2 * j] += (f32x4){a[0], a[1], b[0], b[1]} * gs; v[2 * j + 1] += (f32x4){c[0], c[1], d[0], d[1]} * gs; } }
        float s = 0.f;
#pragma unroll
        for (int j = 0; j < 4; ++j) s += (v[j][0] + v[j][1]) + (v[j][2] + v[j][3]);
        const float mean = wave_sum(s) * (1.f / DM); float s2 = 0.f;
#pragma unroll
        for (int j = 0; j < 4; ++j) { v[j] = v[j] - mean; s2 += (v[j][0] * v[j][0] + v[j][1] * v[j][1]) + (v[j][2] * v[j][2] + v[j][3] * v[j][3]); }
        const float rstd = 1.f / sqrtf(wave_sum(s2) * (1.f / DM) + KF(LN_EPS));
#pragma unroll
        for (int j = 0; j < 4; ++j) v[j] = v[j] * rstd * gv[j] + bv[j];
#pragma unroll
        for (int j = 0; j < 2; ++j) *(u32x4*)(X2B + (size_t)row * DM + 8 * C.lane + 512 * j) = pack8(v[2 * j], v[2 * j + 1]);
    }
}

__device__ __forceinline__ void phase_conv(const CAS Args& args, const Ctx& C0, int j) {
    Ctx C = C0; C.tid = opaque_tid(); C.lane = C.tid & 63;
    const bf16_t* U = WSP(bf16_t, WS_U); bf16_t* UC = WSP(bf16_t, WS_UC);
    const float* cw = INF(I_LRU_CW) + (size_t)j * 4 * DM; const float* cb = INF(I_LRU_CB) + (size_t)j * DM;
    const int c8 = (C.tid & 127) * 8, rsub = C.tid >> 7;
    float w[4][8], bb[8];
#pragma unroll
    for (int q = 0; q < 4; ++q)
#pragma unroll
        for (int e = 0; e < 8; ++e) w[q][e] = cw[q * DM + c8 + e];
#pragma unroll
    for (int e = 0; e < 8; ++e) bb[e] = cb[c8 + e];
    for (int chunk = C.vcu; chunk < T / 128; chunk += C.G) {
        const int r0 = chunk * 128 + rsub * 32;
        u32x4 h0, h1, h2;
        const u32x4 z = {0u, 0u, 0u, 0u};
        const int s0 = r0 & (SEQ - 1);
        h0 = s0 >= 3 ? *(const u32x4*)(U + (size_t)(r0 - 3) * DM + c8) : z; h1 = s0 >= 2 ? *(const u32x4*)(U + (size_t)(r0 - 2) * DM + c8) : z; h2 = s0 >= 1 ? *(const u32x4*)(U + (size_t)(r0 - 1) * DM + c8) : z;
#pragma unroll 4
        for (int i = 0; i < 32; ++i) { const u32x4 h3 = *(const u32x4*)(U + (size_t)(r0 + i) * DM + c8);
            float o[8];
#pragma unroll
            for (int q = 0; q < 4; ++q) { const unsigned a = h0[q], b = h1[q], c = h2[q], d = h3[q];
                o[2 * q] = bb[2 * q] + w[0][2 * q] * bf_lo(a) + w[1][2 * q] * bf_lo(b) + w[2][2 * q] * bf_lo(c) + w[3][2 * q] * bf_lo(d);
                o[2 * q + 1] = bb[2 * q + 1] + w[0][2 * q + 1] * bf_hi(a) + w[1][2 * q + 1] * bf_hi(b) + w[2][2 * q + 1] * bf_hi(c) + w[3][2 * q + 1] * bf_hi(d); }
            u32x4 ow; ow.x = cvt_pk_bf16(o[0], o[1]); ow.y = cvt_pk_bf16(o[2], o[3]); ow.z = cvt_pk_bf16(o[4], o[5]); ow.w = cvt_pk_bf16(o[6], o[7]);
            *(u32x4*)(UC + (size_t)(r0 + i) * DM + c8) = ow; h0 = h1; h1 = h2; h2 = h3; }
    }
}
__device__ __forceinline__ void phase_scan1(const CAS Args& args, const Ctx& C0) {
    Ctx C = C0; C.tid = opaque_tid(); C.lane = C.tid & 63;
    const bf16_t* LA = WSP(bf16_t, WS_AA); const bf16_t* BB = WSP(bf16_t, WS_BB); float* CA = WSP(float, WS_CA); float* CH = WSP(float, WS_CH);
    const int c2 = C.tid * 2;
    for (int item = C.vcu; item < NBATCH * 64; item += C.G) {
        const size_t r0 = (size_t)item * 64; float h0 = 0.f, h1 = 0.f, l0 = 0.f, l1 = 0.f;
#pragma unroll 8
        for (int s = 0; s < 64; ++s) { const unsigned aw = *(const unsigned*)(LA + (r0 + s) * DM + c2), bw = *(const unsigned*)(BB + (r0 + s) * DM + c2);
            const float la0 = bf_lo(aw), la1 = bf_hi(aw);
            h0 = __builtin_amdgcn_exp2f(la0) * h0 + bf_lo(bw); h1 = __builtin_amdgcn_exp2f(la1) * h1 + bf_hi(bw); l0 += la0; l1 += la1; }
        *(f32x2*)(CA + (size_t)item * DM + c2) = (f32x2){__builtin_amdgcn_exp2f(l0), __builtin_amdgcn_exp2f(l1)}; *(f32x2*)(CH + (size_t)item * DM + c2) = (f32x2){h0, h1};
    }
}
__device__ __forceinline__ void phase_scan2(const CAS Args& args, const Ctx& C0) {
    Ctx C = C0; C.tid = opaque_tid(); C.lane = C.tid & 63;
    const bf16_t* LA = WSP(bf16_t, WS_AA); const bf16_t* BB = WSP(bf16_t, WS_BB); const float* CA = WSP(float, WS_CA); const float* CH = WSP(float, WS_CH);
    const bf16_t* GG = WSP(bf16_t, WS_GG); bf16_t* YL = WSP(bf16_t, WS_O);
    const int c2 = C.tid * 2;
    for (int item = C.vcu; item < NBATCH * 64; item += C.G) {
        const int b = item >> 6, ch = item & 63; float h0 = 0.f, h1 = 0.f;
        for (int jx = 0; jx < ch; ++jx) { const f32x2 a = *(const f32x2*)(CA + (size_t)(b * 64 + jx) * DM + c2), e = *(const f32x2*)(CH + (size_t)(b * 64 + jx) * DM + c2);
            h0 = a[0] * h0 + e[0]; h1 = a[1] * h1 + e[1]; }
        const size_t r0 = (size_t)item * 64;
#pragma unroll 8
        for (int s = 0; s < 64; ++s) { const unsigned aw = *(const unsigned*)(LA + (r0 + s) * DM + c2), bw = *(const unsigned*)(BB + (r0 + s) * DM + c2), g = *(const unsigned*)(GG + (r0 + s) * DM + c2);
            h0 = __builtin_amdgcn_exp2f(bf_lo(aw)) * h0 + bf_lo(bw); h1 = __builtin_amdgcn_exp2f(bf_hi(aw)) * h1 + bf_hi(bw);
            *(unsigned*)(YL + (r0 + s) * DM + c2) = cvt_pk_bf16(bf_lo(g) * h0, bf_hi(g) * h1); }
    }
}

#if PROBE_T
typedef int v8i_t __attribute__((ext_vector_type(8)));
__device__ __forceinline__ unsigned fp8_of_int(int v) { const unsigned char t[4] = {0x00, 0x38, 0x40, 0x44}; const int a = v < 0 ? -v : v; return (unsigned)t[a] | (v < 0 ? 0x80u : 0u); }
__device__ __forceinline__ int tA(int i, int k) { return ((i * 3 + k * 5) % 7) - 3; }
__device__ __forceinline__ int tB(int k, int j) { return ((k * 2 + j * 7) % 5) - 2; }
__device__ __forceinline__ void mfma_fp8_selftest(unsigned* flagw) {
    const int l = threadIdx.x & 63, r = l & 15, q = l >> 4;
    v8i_t A, B;
#pragma unroll
    for (int d = 0; d < 8; ++d) { unsigned wa = 0, wb = 0;
#pragma unroll
        for (int b = 0; b < 4; ++b) { const int k = 32 * q + 4 * d + b; wa |= fp8_of_int(tA(r, k)) << (8 * b); wb |= fp8_of_int(tB(k, r)) << (8 * b); }
        A[d] = (int)wa; B[d] = (int)wb; }
    const f32x4 z = {0.f, 0.f, 0.f, 0.f};
    const int U = 0x7f7f7f7f;
    const int saq = (127 + q) * 0x01010101;
    const int sab = (q == 0) ? (int)0x8281807fu : U;
    const f32x4 m2 = __builtin_amdgcn_mfma_scale_f32_16x16x128_f8f6f4(A, B, z, 0, 0, 0, saq, 0, U);
    const f32x4 m5 = __builtin_amdgcn_mfma_scale_f32_16x16x128_f8f6f4(A, B, z, 0, 0, 0, sab, 0, U);
    bool k1 = true, k2 = true, k3 = true, k4 = true;
#pragma unroll
    for (int e = 0; e < 4; ++e) { const int i = 4 * q + e, j = r; float eb = 0.f, e0 = 0.f, ec = 0.f, ed = 0.f;
        for (int kq = 0; kq < 4; ++kq) for (int hh = 0; hh < 2; ++hh) { float sh = 0.f; for (int k = 32 * kq + 16 * hh; k < 32 * kq + 16 * hh + 16; ++k) sh += (float)(tA(i, k) * tB(k, j));
            const int xb = hh == 0 ? (kq >> 1) : 2 + (kq >> 1);
            eb += sh * (float)(1 << xb); e0 += sh; ec += sh * (float)(1 << kq); ed += sh * (float)(1 << xb); }
        k1 = k1 && (m2[e] == eb); k2 = k2 && (m2[e] == e0); k3 = k3 && (m5[e] == ec); k4 = k4 && (m5[e] == ed); }
    const bool b1 = __all(k1), b2 = __all(k2), b3 = __all(k3), b4 = __all(k4);
    if (l == 0) *flagw = (b1 ? 1u : 0u) | (b2 ? 2u : 0u) | (b3 ? 4u : 0u) | (b4 ? 8u : 0u);
}
#endif
constexpr int PH_PER_LAYER = 12, PH_TOTAL = 2 + PH_PER_LAYER * DEPTH;
__global__ void __launch_bounds__(NWAVES * 64, 2) fwd_kernel(Args args_kernarg) {
    (void)args_kernarg;
    ArgsP const argp = (ArgsP)__builtin_amdgcn_kernarg_segment_ptr();
    const CAS Args& args0 = *argp;
    extern __shared__ __attribute__((aligned(16))) unsigned char lds_raw[];
    Ctx C_;
    C_.lds = (LAS unsigned char*)lds_raw; C_.misc = (volatile LAS int*)(C_.lds + MISC_OFF);
    C_.tid = threadIdx.x; C_.lane = C_.tid & 63; C_.wave = __builtin_amdgcn_readfirstlane(C_.tid >> 6);
    C_.bid = (int)blockIdx.x; C_.G = gridDim.x; { const int bx = blockIdx.x; C_.vcu = (C_.G % 8 == 0) ? (bx % 8) * (C_.G / 8) + bx / 8 : bx; }
    for (int u = C_.tid; u < 128; u += NWAVES * 64) C_.misc[u] = 0;
    __syncthreads();
    XcdBarrier bar = xcd_barrier_post((unsigned*)(args0.ws + WS_CTL) + CW_BAR + args0.li * XCD_BAR_WORDS, (volatile LAS unsigned*)C_.misc);
    const int lo = args0.ph_lo, hi = args0.ph_hi;
#define IN(k) (lo <= (k) && (k) < hi)
#define PH_END(k) do { if ((k) + 1 < hi) xcd_barrier(bar); } while (0)

    if (SEL(0) && IN(0)) { const CAS Args& args = fresh_args(argp); const Ctx C = fresh_ctx(C_); const int cid = C.bid; phase_prologue(args, C); PH_END(0); }
    if (SEL(1) && IN(1)) { const CAS Args& args = fresh_args(argp); const Ctx C = fresh_ctx(C_); const int cid = C.bid;
        pg8::DenseSched S; S.init(WSP(bf16_t, WS_PB), WSP(bf16_t, WS_W_PLE + OFF_PLE_WP), PLED, PLED, DEPTH * T, DM, C.G, cid); S.bpm_shift = 7; S.bbatch = W_PLE_STRIDE;
        pg8::EpiPP E{WSP(bf16_t, WS_PP)};
        pg8::gemm_phase<pg8::EpiPP, pg8::DenseSched, false>(C.lds, PLED / 64, PLED * 2, PLED * 2, S, E);
        if (MK_ONE_LAUNCH == 0) PH_END(1);
    }
    for (int layer = 0; layer < DEPTH; ++layer) {
        const int base = 2 + PH_PER_LAYER * layer, j = layer >> 1;
        if ((layer & 1) == 0) {
            if (SEL(2) && IN(base + 0)) { const CAS Args& args = fresh_args(argp); const Ctx C = fresh_ctx(C_); const int cid = C.bid; const unsigned char* wm = args.ws + WS_W_MLA + (size_t)j * W_MLA_STRIDE;
                pg8::DenseSched S; S.init(WSP(bf16_t, WS_XB), wm + OFF_MLA_WIN, DM, DM, T, 1280, C.G, cid);
                pg8::EpiLat E{WSP(bf16_t, WS_LAT), WSP(float, WS_SSQ), WSP(bf16_t, WS_KR), WSP(float, WS_CS), WSP(float, WS_SN)};
                pg8::gemm_phase<pg8::EpiLat, pg8::DenseSched, false>(C.lds, DM / 64, DM * 2, DM * 2, S, E);
                PH_END(base + 0);
            }
            if (SEL(3) && IN(base + 1)) { const CAS Args& args = fresh_args(argp); const Ctx C = fresh_ctx(C_); const int cid = C.bid; const unsigned char* wm = args.ws + WS_W_MLA + (size_t)j * W_MLA_STRIDE;
                { pg8::DenseSched S; S.init(WSP(bf16_t, WS_LAT), wm + OFF_MLA_WUQ, DM, QL, T, 1536, C.G, cid);
                  pg8::EpiQ E{WSP(bf16_t, WS_Q), WSP(float, WS_SSQ), WSP(float, WS_CS), WSP(float, WS_SN)};
                  pg8::gemm_phase<pg8::EpiQ, pg8::DenseSched, false>(C.lds, QL / 64, DM * 2, QL * 2, S, E); }
                { pg8::DenseSched S; S.init(WSP(bf16_t, WS_LAT) + QL, wm + OFF_MLA_WUKV, DM, KVL, T, 2048, C.G, cid);
                  pg8::EpiKV E{WSP(bf16_t, WS_KN), WSP(bf16_t, WS_V), WSP(float, WS_SSQ)};
                  pg8::gemm_phase<pg8::EpiKV, pg8::DenseSched, false>(C.lds, KVL / 64, DM * 2, KVL * 2, S, E); }
                PH_END(base + 1);
            }
            if (SEL(4) && IN(base + 2)) { const CAS Args& args = fresh_args(argp); const Ctx C = fresh_ctx(C_); const int cid = C.bid;
                for (int it = C.vcu; it < NBATCH * NH * 8; it += C.G) { const int bh = it >> 3, pr = it & 7;
                    att::attn_block(bh >> 3, bh & 7, pr, WSP(bf16_t, WS_Q), WSP(bf16_t, WS_KN), WSP(bf16_t, WS_KR), WSP(bf16_t, WS_V), WSP(bf16_t, WS_O), (LAS char*)C.lds, PROBE_T ? (unsigned long long*)(args.ws + WS_CTL + 8192) : nullptr);
                    att::attn_block(bh >> 3, bh & 7, 15 - pr, WSP(bf16_t, WS_Q), WSP(bf16_t, WS_KN), WSP(bf16_t, WS_KR), WSP(bf16_t, WS_V), WSP(bf16_t, WS_O), (LAS char*)C.lds, PROBE_T ? (unsigned long long*)(args.ws + WS_CTL + 8192) : nullptr); }
                PH_END(base + 2);
            }
        } else {
            if (SEL(5) && IN(base + 0)) { const CAS Args& args = fresh_args(argp); const Ctx C = fresh_ctx(C_); const int cid = C.bid; const unsigned char* wl = args.ws + WS_W_LRU + (size_t)j * W_LRU_STRIDE;
                pg8::DenseSched S; S.init(WSP(bf16_t, WS_XB), wl + OFF_LRU_WIN, DM, DM, T, 2048, C.G, cid);
                pg8::EpiGU E{WSP(bf16_t, WS_GG), WSP(bf16_t, WS_U)};
                pg8::gemm_phase<pg8::EpiGU, pg8::DenseSched, false>(C.lds, DM / 64, DM * 2, DM * 2, S, E);
                PH_END(base + 0);
            }
            if (SEL(6) && IN(base + 1)) { const CAS Args& args = fresh_args(argp); const Ctx C = fresh_ctx(C_); const int cid = C.bid; phase_conv(args, C, j); PH_END(base + 1); }
            if (SEL(7) && IN(base + 2)) { const CAS Args& args = fresh_args(argp); const Ctx C = fresh_ctx(C_); const int cid = C.bid; const unsigned char* wl = args.ws + WS_W_LRU + (size_t)j * W_LRU_STRIDE;
                pg8::DenseSched S; S.init(WSP(bf16_t, WS_UC), wl + OFF_LRU_WAX, DM, 256, T, 2048, C.G, cid); S.apn_shift = 1; S.akbytes = 512;
                pg8::EpiAB E{WSP(bf16_t, WS_AA), WSP(bf16_t, WS_BB), WSP(bf16_t, WS_UC), INF(I_LRU_BA) + j * DM, INF(I_LRU_BX) + j * DM, WSP(float, WS_SPL) + j * DM};
                pg8::gemm_phase<pg8::EpiAB, pg8::DenseSched, false>(C.lds, 4, DM * 2, 512, S, E);
                PH_END(base + 2);
            }
            if (SEL(8) && IN(base + 3)) { const CAS Args& args = fresh_args(argp); const Ctx C = fresh_ctx(C_); const int cid = C.bid; phase_scan1(args, C); PH_END(base + 3); }
            if (SEL(9) && IN(base + 4)) { const CAS Args& args = fresh_args(argp); const Ctx C = fresh_ctx(C_); const int cid = C.bid; phase_scan2(args, C); PH_END(base + 4); }
        }
        if (SEL(10) && IN(base + 5)) { const CAS Args& args = fresh_args(argp); const Ctx C = fresh_ctx(C_); const int cid = C.bid;
            const unsigned char* wo = (layer & 1) ? args.ws + WS_W_LRU + (size_t)j * W_LRU_STRIDE + OFF_LRU_WOUT : args.ws + WS_W_MLA + (size_t)j * W_MLA_STRIDE + OFF_MLA_WO;
            pg8::DenseSched S; S.init(WSP(bf16_t, WS_O), wo, DM, DM, T, DM, C.G, cid);
            pg8::EpiRes E{WSP(bf16_t, WS_XB), WSP(bf16_t, WS_Y)};
            pg8::gemm_phase<pg8::EpiRes, pg8::DenseSched, false>(C.lds, DM / 64, DM * 2, DM * 2, S, E);
            PH_END(base + 5);
        }
        if (SEL(11) && IN(base + 6)) { const CAS Args& args = fresh_args(argp); const Ctx C = fresh_ctx(C_); const int cid = C.bid; phase_ln_router(args, C, layer); PH_END(base + 6); }
        if (SEL(12) && IN(base + 7)) { const CAS Args& args = fresh_args(argp); const Ctx C = fresh_ctx(C_); const int cid = C.bid;
            moe_table(args, C, layer);
            pg8::MoeSched S{(const char*)(args.ws + WS_X1Q), (const char*)(args.ws + WS_W_UP + (size_t)layer * NE * 2048 * 1024), (size_t)2048 * 1024, (const char*)(args.ws + WS_SW + (size_t)layer * NE * 65536), DM, DM, 8, WSP(int, WS_LIST), C.misc + 16, (volatile LAS const unsigned char*)(C.lds + TILE_E_OFF), C.G, cid, true, nullptr};
            const int sae = 127 - (int)__hip_atomic_load(WSP(unsigned, WS_CTL) + CW_SA + layer, __ATOMIC_RELAXED, __HIP_MEMORY_SCOPE_AGENT);
            pg8::EpiUp E{args.ws + WS_H, args.ws + WS_SH, INF(I_MOE_BUP) + (size_t)layer * NE * 2048};
            pg8::gemm_phase<pg8::EpiUp, pg8::MoeSched, true, 1>(C.lds, DM / 128, DM, DM, S, E, PROBE_T ? (unsigned long long*)(args.ws + WS_CTL + 8192) : nullptr, sae * 0x01010101);
            PH_END(base + 7);
        }
        if (SEL(13) && IN(base + 8)) { const CAS Args& args = fresh_args(argp); const Ctx C = fresh_ctx(C_); const int cid = C.bid;
            moe_table(args, C, layer);
            pg8::MoeSched S{(const char*)(args.ws + WS_H), (const char*)(args.ws + WS_W_DN + (size_t)layer * NE * 1024 * 1024), (size_t)1024 * 1024, (const char*)(args.ws + WS_SWD + (size_t)layer * NE * 16384), DFF, DFF, 4, WSP(int, WS_LIST), C.misc + 16, (volatile LAS const unsigned char*)(C.lds + TILE_E_OFF), C.G, cid, false, (const char*)(args.ws + WS_SH)};
            pg8::EpiDown E{args.ws + WS_YS, args.ws + WS_SY, INF(I_MOE_BDN) + (size_t)layer * NE * DM};
            pg8::gemm_phase<pg8::EpiDown, pg8::MoeSched, false, 2>(C.lds, DFF / 128, DFF, DFF, S, E);
            PH_END(base + 8);
        }
        if (SEL(14) && IN(base + 9)) { const CAS Args& args = fresh_args(argp); const Ctx C = fresh_ctx(C_); const int cid = C.bid; phase_combine_ln2(args, C, layer); PH_END(base + 9); }
        if (SEL(15) && IN(base + 10)) { const CAS Args& args = fresh_args(argp); const Ctx C = fresh_ctx(C_); const int cid = C.bid;
            pg8::DenseSched S; S.init(WSP(bf16_t, WS_X2B), args.ws + WS_W_PLE + (size_t)layer * W_PLE_STRIDE + OFF_PLE_WG, DM, DM, T, DM, C.G, cid);
            pg8::EpiPle E{WSP(bf16_t, WS_X2B), WSP(bf16_t, WS_PP) + (size_t)layer * T * DM, layer == DEPTH - 1 ? args.out : (float*)nullptr, WSP(bf16_t, WS_XB)};
            pg8::gemm_phase<pg8::EpiPle, pg8::DenseSched, false>(C.lds, DM / 64, DM * 2, DM * 2, S, E);
            if (layer + 1 < DEPTH) PH_END(base + 10);
        }
    }
#if PROBE_T
    if (PROBE_T == 20 && blockIdx.x == 0 && threadIdx.x < 64) { const CAS Args& args = fresh_args(argp); mfma_fp8_selftest((unsigned*)(args.ws + WS_CTL + 8192 + 256)); }
    { xcd_barrier(bar); const CAS Args& args = fresh_args(argp);
      const unsigned long long* pw = (const unsigned long long*)(args.ws + WS_CTL + 8192);
      const double pk = (double)__hip_atomic_load(pw + 0, __ATOMIC_RELAXED, __HIP_MEMORY_SCOPE_AGENT), pe = (double)__hip_atomic_load(pw + 1, __ATOMIC_RELAXED, __HIP_MEMORY_SCOPE_AGENT),
                   pn = (double)__hip_atomic_load(pw + 2, __ATOMIC_RELAXED, __HIP_MEMORY_SCOPE_AGENT), pt = (double)__hip_atomic_load(pw + 3, __ATOMIC_RELAXED, __HIP_MEMORY_SCOPE_AGENT);
      float c = 100.f;
      if (PROBE_T == 2) c = (float)(pk / (pn * 16.0) / 10.0);
      if (PROBE_T == 3) c = (float)(pe / pn / 100.0);
      if (PROBE_T == 4) c = (float)((pt - pk - pe) / pn / 100.0);
      if (PROBE_T == 5) c = (float)(pn);
      if (PROBE_T >= 10) { double q[7]; for (int i = 0; i < 7; ++i) q[i] = (double)__hip_atomic_load(pw + 8 + i, __ATOMIC_RELAXED, __HIP_MEMORY_SCOPE_AGENT);
          if (PROBE_T == 10) c = (float)(q[6] / q[5] / 10.0);
          if (PROBE_T == 11) c = (float)(q[0] / q[5] / 10.0);
          if (PROBE_T == 12) c = (float)(q[1] / q[5] / 10.0);
          if (PROBE_T == 13) c = (float)(q[2] / q[5] / 10.0);
          if (PROBE_T == 14) c = (float)(q[3] / q[5] / 10.0);
          if (PROBE_T == 15) c = (float)(q[4] / q[5] / 10.0); }
      if (PROBE_T >= 2 && PROBE_T < 20) c = exp2f(floorf(log2f(c) * 8.0f + PROBE_SHIFT) * 0.125f);
      if (PROBE_T == 20) { const unsigned fl = __hip_atomic_load((const unsigned*)(args.ws + WS_CTL + 8192 + 256), __ATOMIC_RELAXED, __HIP_MEMORY_SCOPE_AGENT); c = 100.f + 10.f * (float)fl; }
      for (size_t i = (size_t)blockIdx.x * 512 + threadIdx.x; i < (size_t)T * DM; i += (size_t)gridDim.x * 512) args.out[i] = c; }
#endif
#undef IN
#undef PH_END
}

extern "C" void kernel_launch(void* const* d_in, const int* in_sizes, int n_in, void* d_out, int out_size, void* d_ws, size_t ws_size, hipStream_t stream) {
    static int grid = 0;
    if (grid == 0) {
        if (n_in != 30 || in_sizes[0] != T * DM || out_size != T * DM || ws_size < WS_END) { fprintf(stderr, "kernel_launch: unexpected shapes (n_in %d, in0 %d, out %d, ws %zu)\n", n_in, n_in > 0 ? in_sizes[0] : -1, out_size, ws_size); grid = -1; return; }
        int dev = 0, cus = 0, per_cu = 0;
        if (hipGetDevice(&dev) != hipSuccess || hipDeviceGetAttribute(&cus, hipDeviceAttributeMultiprocessorCount, dev) != hipSuccess) { grid = -1; return; }
        if (hipFuncSetAttribute((const void*)fwd_kernel, hipFuncAttributeMaxDynamicSharedMemorySize, LDS_BYTES) != hipSuccess) { fprintf(stderr, "kernel_launch: hipFuncSetAttribute failed\n"); grid = -1; return; }
        if (hipOccupancyMaxActiveBlocksPerMultiprocessor(&per_cu, (const void*)fwd_kernel, NWAVES * 64, LDS_BYTES) != hipSuccess || per_cu < 1) fprintf(stderr, "kernel_launch: occupancy query reports %d\n", per_cu);
        (void)hipGetLastError();
        grid = cus;
    }
    if (grid < 0) return;
    if (hipMemsetAsync((char*)d_ws + WS_CTL, 0, CTL_ZERO_BYTES, stream) != hipSuccess) return;
    Args a{};
    for (int i = 0; i < 30; ++i) a.in[i] = d_in[i];
    a.out = (float*)d_out; a.ws = (unsigned char*)d_ws; a.pad = 0;
#if MK_ONE_LAUNCH
    a.ph_lo = 0; a.ph_hi = PH_TOTAL; a.li = 0;
    hipLaunchKernelGGL(fwd_kernel, dim3(grid), dim3(NWAVES * 64), LDS_BYTES, stream, a);
#else
    int li = 0;
    for (int ph = 0; ph < PH_TOTAL; ++ph) {
        if (ph >= 2) { const int l = (ph - 2) / PH_PER_LAYER, k = (ph - 2) % PH_PER_LAYER; if (k == 11) continue; if ((l & 1) == 0 && (k == 3 || k == 4)) continue; }
        int site = ph;
        if (ph >= 2) { const int l = (ph - 2) / PH_PER_LAYER, k = (ph - 2) % PH_PER_LAYER; static const int mla[11] = {2, 3, 4, -1, -1, 10, 11, 12, 13, 14, 15}, lru[11] = {5, 6, 7, 8, 9, 10, 11, 12, 13, 14, 15}; site = (l & 1) ? lru[k] : mla[k]; }
        a.ph_lo = ph; a.ph_hi = ph + 1;
        if ((HOSTDUP >> site) & 1) { a.li = li++; a.pad = 4; hipLaunchKernelGGL(fwd_kernel, dim3(grid), dim3(NWAVES * 64), LDS_BYTES, stream, a); }
        a.li = li++; a.pad = 0;
        hipLaunchKernelGGL(fwd_kernel, dim3(grid), dim3(NWAVES * 64), LDS_BYTES, stream, a);
    }
#endif
}
```

```cpp
#include <hip/hip_runtime.h>
#include <hip/hip_bf16.h>
#include <cstdio>
#include <cstdint>

#ifndef PHSEL
#define PHSEL -1
#endif
#ifndef PHSKIP
#define PHSKIP -1
#endif
#define SEL(id) ((PHSEL < 0 || PHSEL == (id)) && PHSKIP != (id))
#ifndef PROBE_T
#define PROBE_T 0
#endif
#ifndef PROBE_SHIFT
#define PROBE_SHIFT 0.0f
#endif
#ifndef HOSTDUP
#define HOSTDUP 0
#endif
#ifndef MK_ONE_LAUNCH
#define MK_ONE_LAUNCH 1
#endif

constexpr int T = 32768, SEQ = 4096, NBATCH = 8, DM = 1024, DEPTH = 4;
constexpr int QL = 768, KVL = 256, ROPE = 64, LATD = 1088, NH = 8, DQK = 192, DV = 128;
constexpr int NE = 32, TOPK = 4, DFF = 1024, PLED = 256;
constexpr float ALPHA = 1.681792830507429f;
constexpr float LN_EPS = 1e-5f, RMS_EPS = 1e-6f;
constexpr float QSCALE = 1.4426950408889634f / 13.856406460551018f;
constexpr int NWAVES = 8;

constexpr size_t MiB = 1u << 20;
constexpr size_t WS_CTL = 0, CTL_ZERO_BYTES = 2 * MiB;
constexpr size_t WS_CS = 2 * MiB, WS_SN = 6 * MiB, WS_SPL = 10 * MiB;
constexpr size_t WS_WRH = WS_SPL + 65536, WS_WRL = WS_WRH + 262144;
constexpr size_t WS_RC = WS_SPL + 16384;
constexpr size_t WS_W_MLA = 12 * MiB, W_MLA_STRIDE = 8 * MiB;
constexpr size_t OFF_MLA_WIN = 0, OFF_MLA_WUQ = 2560 * 1024, OFF_MLA_WUKV = OFF_MLA_WUQ + 2304 * 1024, OFF_MLA_WO = OFF_MLA_WUKV + 1024 * 1024;
constexpr size_t WS_W_LRU = 28 * MiB, W_LRU_STRIDE = 8 * MiB;
constexpr size_t OFF_LRU_WIN = 0, OFF_LRU_WAX = 4 * MiB, OFF_LRU_WOUT = 5 * MiB;
constexpr size_t WS_W_PLE = 44 * MiB, W_PLE_STRIDE = 3 * MiB;
constexpr size_t OFF_PLE_WG = 0, OFF_PLE_WP = 2 * MiB;
constexpr size_t WS_W_UP = 56 * MiB;
constexpr size_t WS_W_DN = 568 * MiB;
constexpr size_t WS_XB = 824 * MiB, WS_PB = 888 * MiB, WS_PP = 952 * MiB;
constexpr size_t WS_Y = 1208 * MiB, WS_X1 = 1336 * MiB, WS_X1B = 1464 * MiB, WS_X2 = 1528 * MiB, WS_X2B = 1656 * MiB;
constexpr size_t WS_LAT = 1720 * MiB, WS_KR = 1784 * MiB, WS_SSQ = 1788 * MiB, WS_Q = 1790 * MiB, WS_KN = 1886 * MiB, WS_V = 1950 * MiB, WS_O = 2014 * MiB;
constexpr size_t WS_GG = 2078 * MiB, WS_U = 2142 * MiB, WS_UC = 2206 * MiB, WS_AA = 2270 * MiB, WS_BB = 2398 * MiB, WS_CA = 2526 * MiB, WS_CH = 2528 * MiB;
constexpr size_t WS_H = 2530 * MiB, WS_YS = 2802 * MiB, WS_LIST = 3074 * MiB, WS_SLOT = 3078 * MiB, WS_GATE = 3079 * MiB, WS_SW = 3080 * MiB  , WS_X1Q = 3088 * MiB  , WS_SH = 3120 * MiB  ,
                 WS_SWD = 3128 * MiB  , WS_SY = 3132 * MiB  , WS_END = 3140 * MiB;
constexpr int PADROWS = T * TOPK + NE * 256;
static_assert((size_t)PADROWS * DFF * 2 <= 272 * MiB, "H / YS size");
constexpr int CW_SA = 128;
constexpr int CW_CNT = 256;
constexpr int CW_BAR = 4096;

constexpr int RING_BYTES = 133120;
constexpr int TILE_E_OFF = 131072;
constexpr int SCL_OFF = RING_BYTES;
constexpr int MISC_OFF = SCL_OFF + 24576;
constexpr int LDS_BYTES = 163840;

#define GAS __attribute__((address_space(1)))
#define LAS __attribute__((address_space(3)))
#define CAS __attribute__((address_space(4)))
typedef unsigned short bf16_t;
typedef short bf16x8 __attribute__((ext_vector_type(8)));
typedef short s16x4 __attribute__((ext_vector_type(4)));
typedef float f32x2 __attribute__((ext_vector_type(2)));
typedef float f32x4 __attribute__((ext_vector_type(4)));
typedef float f32x16 __attribute__((ext_vector_type(16)));
typedef unsigned u32x2 __attribute__((ext_vector_type(2)));
typedef unsigned u32x4 __attribute__((ext_vector_type(4)));

__device__ __forceinline__ unsigned cvt_pk_bf16(float lo, float hi) { unsigned r; asm volatile("v_cvt_pk_bf16_f32 %0, %1, %2" : "=v"(r) : "v"(lo), "v"(hi)); return r; }
__device__ __forceinline__ float bf_lo(unsigned w) { return __uint_as_float(w << 16); }
__device__ __forceinline__ float bf_hi(unsigned w) { return __uint_as_float(w & 0xffff0000u); }
__device__ __forceinline__ float sigmoidf_(float x) { return __builtin_amdgcn_rcpf(1.0f + __expf(-x)); }
__device__ __forceinline__ float gelu_tanh(float x) { const float u = 0.7978845608028654f * (x + 0.044715f * x * x * x); const float t = 1.0f - 2.0f * __builtin_amdgcn_rcpf(1.0f + __expf(2.0f * u)); return 0.5f * x * (1.0f + t); }
__device__ __forceinline__ u32x4 pack8(const f32x4 a, const f32x4 b) { u32x4 w; w.x = cvt_pk_bf16(a[0], a[1]); w.y = cvt_pk_bf16(a[2], a[3]); w.z = cvt_pk_bf16(b[0], b[1]); w.w = cvt_pk_bf16(b[2], b[3]); return w; }
__device__ __forceinline__ float KF(float v) { asm volatile("" : "+s"(v)); return v; }
__device__ __forceinline__ int opaque_tid() { int t = threadIdx.x; asm volatile("" : "+v"(t)); return t; }
__device__ __forceinline__ float wave_sum(float v) {
#pragma unroll
    for (int o = 1; o < 64; o <<= 1) v += __shfl_xor(v, o);
    return v;
}

namespace pg8 {
#define PG8_LAS __attribute__((address_space(3)))
constexpr int BM = 256, BK = 64, HALF = 128, HTB = HALF * BK * 2, STAGE_BYTES = 8 * HTB;
__host__ __device__ __forceinline__ int lds_byte(int r, int c) { const int st = (r >> 4) * 2 + (c >> 5), rr = r & 15, cc = c & 31, ob = rr * 64 + cc * 2; return st * 1024 + (ob ^ (((ob >> 9) & 1) << 5)); }
__host__ __device__ __forceinline__ void stage_rc(int b, int& R, int& C) { const int st = b / 1024, sb = b % 1024, swz = sb ^ (((sb >> 9) & 1) << 5); R = (st >> 1) * 16 + swz / 64; C = (st & 1) * 32 + (swz % 64) / 2; }
__host__ __device__ __forceinline__ int perm32(int rho) { const int n = rho >> 4, i = rho & 15; return 8 * (i >> 2) + 4 * n + (i & 3); }

struct Unit { const char* A; const char* B; const char* S; const char* SA; const int* lst; int nvalid; int pm, pn, aux; };

typedef int v4i_t __attribute__((ext_vector_type(4)));
typedef int v8i_t __attribute__((ext_vector_type(8)));
template <class Epi, class Sched, bool GATHER, int FPM = 0>
__device__ __forceinline__ void gemm_phase(PG8_LAS unsigned char* lds, const int nt  , const int lda  , const int ldb  , const Sched& S, const Epi& E, unsigned long long* pw = nullptr, const int sa = 0x7f7f7f7f) {
    constexpr bool FP8 = FPM != 0;
    const int tid = opaque_tid(), wid = __builtin_amdgcn_readfirstlane(tid >> 6), lane = tid & 63, wr = wid >> 2, wc = wid & 3, fr = lane & 15, fq = lane >> 4;
    unsigned voffB[2], ocA[2][2], onA[2][2];
#pragma unroll
    for (int i = 0; i < 2; ++i) { int R, C; stage_rc(tid * 16 + i * 8192, R, C); const int Rb = Epi::PERM ? ((R & ~31) + perm32(R & 31)) : R;
        voffB[i] = (unsigned)(Rb * ldb + C * 2);
        ocA[0][i] = (unsigned)(R * lda + C * 2); ocA[1][i] = (unsigned)((R + HALF) * lda + C * 2); onA[0][i] = ocA[0][i]; onA[1][i] = ocA[1][i]; }
    constexpr unsigned kstep = BK * 2;
    const unsigned hstepB = (unsigned)HALF * ldb;
    const unsigned ldsw = (unsigned)wid * 1024u;
    const int aoff = lds_byte(wr * 64 + fr, fq * 8), boff = lds_byte(wc * 32 + fr, fq * 8);
#define PG8_SA(b, h) (((b) * 2 + (h)) * HTB)
#define PG8_SB(b, h) ((4 + (b) * 2 + (h)) * HTB)
#define PG8_STAGE(bufoff, gbase, voff, kb) do { _Pragma("unroll") for (int _i = 0; _i < 2; ++_i) \
        __builtin_amdgcn_global_load_lds((const unsigned*)((const char*)(gbase) + (size_t)(unsigned)((voff)[_i] + (unsigned)(kb))), (PG8_LAS unsigned*)(lds + (bufoff) + ldsw + _i * 8192), 16, 0, 0); } while (0)
#define PG8_CAT(x0, x1) __builtin_shufflevector(x0, x1, 0, 1, 2, 3, 4, 5, 6, 7)
#define PG8_LO(x) __builtin_bit_cast(bf16x8, __builtin_shufflevector(x, x, 0, 1, 2, 3))
#define PG8_HI(x) __builtin_bit_cast(bf16x8, __builtin_shufflevector(x, x, 4, 5, 6, 7))
    const PG8_LAS unsigned char* const ldsA = lds + aoff; const PG8_LAS unsigned char* const ldsB = lds + 4 * HTB + boff;
#define PG8_LDA(dst, b, h) do { _Pragma("unroll") for (int m = 0; m < 4; ++m) dst[m] = PG8_CAT(*(const PG8_LAS v4i_t*)(ldsA + (PG8_SA(b, h) + m * 2048)), *(const PG8_LAS v4i_t*)(ldsA + (PG8_SA(b, h) + m * 2048 + 1024))); } while (0)
#define PG8_LDB(dst, b, h) do { _Pragma("unroll") for (int n = 0; n < 2; ++n) dst[n] = PG8_CAT(*(const PG8_LAS v4i_t*)(ldsB + (PG8_SB(b, h) - 4 * HTB + n * 2048)), *(const PG8_LAS v4i_t*)(ldsB + (PG8_SB(b, h) - 4 * HTB + n * 2048 + 1024))); } while (0)
#define PG8_MMA(ai, bj, At, Bt) do { __builtin_amdgcn_s_setprio(1); \
        if constexpr (FP8) { asm volatile("s_nop 4" ::: "memory"); _Pragma("unroll") for (int m = 0; m < 4; ++m) _Pragma("unroll") for (int n = 0; n < 2; ++n) \
            asm volatile("v_mfma_scale_f32_16x16x128_f8f6f4 %0, %1, %2, %0, %3, %4 op_sel_hi:[0,0,0]" : "+v"(acc[ai][bj][m][n]) : "v"(Bt[n]), "v"(At[m]), "v"(sB[bj][n]), "v"(FPM == 2 ? sA[m] : sav)); } \
        else { _Pragma("unroll") for (int m = 0; m < 4; ++m) _Pragma("unroll") for (int n = 0; n < 2; ++n) { \
            acc[ai][bj][m][n] = __builtin_amdgcn_mfma_f32_16x16x32_bf16(PG8_LO(Bt[n]), PG8_LO(At[m]), acc[ai][bj][m][n], 0, 0, 0); \
            acc[ai][bj][m][n] = __builtin_amdgcn_mfma_f32_16x16x32_bf16(PG8_HI(Bt[n]), PG8_HI(At[m]), acc[ai][bj][m][n], 0, 0, 0); } } \
        __builtin_amdgcn_s_setprio(0); } while (0)
    int sB[2][2] = {{0x7f, 0x7f}, {0x7f, 0x7f}}; int sav; asm volatile("v_mov_b32 %0, %1" : "=v"(sav) : "s"(sa));
    int sA[4] = {0x7f, 0x7f, 0x7f, 0x7f};
    const int scol = wc * 32 + (Epi::PERM ? 8 * (fr >> 2) + (fr & 3) : fr);
    const int sbase = FPM == 2 ? SCL_OFF + 16384 + scol * 2 + (fq >> 1) : SCL_OFF + scol * 4 + fq;
    const int sabase = SCL_OFF + ((wr * 64 + fr) << 2) + fq;
#define PG8_LDS_SCL(par_, kt_) do { if constexpr (FP8) { \
        const PG8_LAS unsigned char* sp_ = (const PG8_LAS unsigned char*)lds + sbase + (FPM == 2 ? (par_) * 4096 + (kt_) * 512 : (par_) * 8192 + (kt_) * 1024); \
        _Pragma("unroll") for (int bj_ = 0; bj_ < 2; ++bj_) _Pragma("unroll") for (int n_ = 0; n_ < 2; ++n_) sB[bj_][n_] = (int)sp_[(bj_ * 128 + n_ * (Epi::PERM ? 4 : 16)) * (FPM == 2 ? 2 : 4)]; } } while (0)
#define PG8_LDS_SCA(par_, kt_, ai_) do { if constexpr (FPM == 2) { const PG8_LAS unsigned char* sp_ = (const PG8_LAS unsigned char*)lds + sabase + (par_) * 8192 + (kt_) * 1024 + (ai_) * 512; \
        _Pragma("unroll") for (int m_ = 0; m_ < 4; ++m_) sA[m_] = (int)sp_[m_ * 64]; } } while (0)
#define PG8_DMA_SCL(u_, par_) do { if constexpr (FPM == 1) __builtin_amdgcn_global_load_lds((const unsigned*)((u_).S + wid * 1024 + lane * 16), (PG8_LAS unsigned*)(lds + SCL_OFF + (par_) * 8192 + wid * 1024), 16, 0, 0); \
        if constexpr (FPM == 2) { __builtin_amdgcn_global_load_lds((const unsigned*)((u_).SA + wid * 1024 + lane * 16), (PG8_LAS unsigned*)(lds + SCL_OFF + (par_) * 8192 + wid * 1024), 16, 0, 0); \
            if (wid < 4) __builtin_amdgcn_global_load_lds((const unsigned*)((u_).S + wid * 1024 + lane * 16), (PG8_LAS unsigned*)(lds + SCL_OFF + 16384 + (par_) * 4096 + wid * 1024), 16, 0, 0); } } while (0)
#define PG8_WAIT_V(n) asm volatile("s_waitcnt vmcnt(" #n ")" ::: "memory")
#define PG8_WAIT_L(n) asm volatile("s_waitcnt lgkmcnt(" #n ")" ::: "memory")
#define PG8_BAR __builtin_amdgcn_s_barrier()
#define PG8_SCHED __builtin_amdgcn_sched_barrier(0)
#define PG8_GOFFS(u, o) do { _Pragma("unroll") for (int _h = 0; _h < 2; ++_h) _Pragma("unroll") for (int _i = 0; _i < 2; ++_i) { int gR_, gC_; stage_rc(tid * 16 + _i * 8192, gR_, gC_); int _r = _h * HALF + gR_; _r = _r < (u).nvalid ? _r : (u).nvalid - 1; \
        const int _tok = (u).lst[_r]; (o)[_h][_i] = (unsigned)_tok * (unsigned)lda + (unsigned)(gC_ * 2); } } while (0)
#define PG8_GRAW(u, tk) do {   _Pragma("unroll") for (int _h = 0; _h < 2; ++_h) _Pragma("unroll") for (int _i = 0; _i < 2; ++_i) { int gR_, gC_; stage_rc(tid * 16 + _i * 8192, gR_, gC_); int _r = _h * HALF + gR_; _r = _r < (u).nvalid ? _r : (u).nvalid - 1; (tk)[_h][_i] = (unsigned)(u).lst[_r]; } } while (0)
    Unit cur, nxt, nn; int ui = 0;
#if PROBE_T
    unsigned long long pk_ = 0, pe_ = 0, pt0_ = 0, pn_ = 0; const unsigned long long pst_ = __builtin_amdgcn_s_memtime();
#endif
    if (!S.next(0, cur)) return;
    f32x4 acc[2][2][4][2];
#pragma unroll
    for (int a = 0; a < 2; ++a)
#pragma unroll
        for (int b = 0; b < 2; ++b)
#pragma unroll
            for (int m = 0; m < 4; ++m)
#pragma unroll
                for (int n = 0; n < 2; ++n) acc[a][b][m][n] = (f32x4){0.f, 0.f, 0.f, 0.f};
    v8i_t At[4], B0[2], B1[2];
    const char* cA = cur.A; const char* cB = cur.B;
    bool has_next = S.next(1, nxt);
    if constexpr (GATHER) { PG8_GOFFS(cur, ocA);
        if (has_next) { PG8_GOFFS(nxt, onA); }
        else {
#pragma unroll
            for (int h = 0; h < 2; ++h)
#pragma unroll
                for (int i = 0; i < 2; ++i) onA[h][i] = ocA[h][i]; } }
    PG8_DMA_SCL(cur, 0); if (has_next) PG8_DMA_SCL(nxt, 1);
    PG8_STAGE(PG8_SB(0, 0), cB, voffB, 0u); PG8_STAGE(PG8_SB(0, 1), cB, voffB, hstepB); PG8_STAGE(PG8_SA(0, 0), cA, ocA[0], 0u); PG8_STAGE(PG8_SA(0, 1), cA, ocA[1], 0u);
    if (wr == 1) PG8_BAR;
    PG8_WAIT_V(2); PG8_BAR;
    PG8_STAGE(PG8_SB(1, 0), cB, voffB, kstep); PG8_STAGE(PG8_SA(1, 0), cA, ocA[0], kstep); PG8_STAGE(PG8_SB(1, 1), cB, voffB, hstepB + kstep);
    PG8_WAIT_V(6); PG8_BAR;
    for (;;) {
        const char* nA = has_next ? nxt.A : cA; const char* nB = has_next ? nxt.B : cB;
#if PROBE_T
        pt0_ = __builtin_amdgcn_s_memtime();
#endif
#pragma unroll 1
        for (int t = 0; t < nt; t += 2) {
            const bool last = (t == nt - 2);
            const unsigned k1 = (unsigned)(t + 1) * kstep, k2 = last ? 0u : (unsigned)(t + 2) * kstep, k3 = k2 + kstep;
            const char* a2 = last ? nA : cA; const char* b2 = last ? nB : cB;
#define PG8_STAGE_A2(bufoff, h_, kb_) do { if (GATHER && last) PG8_STAGE(bufoff, a2, onA[h_], kb_); else PG8_STAGE(bufoff, a2, ocA[h_], kb_); } while (0)
            PG8_LDB(B0, 0, 0); PG8_LDB(B1, 0, 1); PG8_LDS_SCL(ui & 1, t); PG8_SCHED; PG8_LDA(At, 0, 0); PG8_LDS_SCA(ui & 1, t, 0); PG8_STAGE(PG8_SA(1, 1), cA, ocA[1], k1);
            PG8_WAIT_V(8); PG8_WAIT_L(0); PG8_BAR; PG8_MMA(0, 0, At, B0); PG8_MMA(0, 1, At, B1); PG8_BAR; PG8_SCHED;
            PG8_LDA(At, 0, 1); PG8_LDS_SCA(ui & 1, t, 1); PG8_STAGE(PG8_SB(0, 0), b2, voffB, k2); PG8_STAGE(PG8_SB(0, 1), b2, voffB, hstepB + k2); PG8_STAGE_A2(PG8_SA(0, 0), 0, k2);
            PG8_WAIT_V(8); PG8_WAIT_L(0); PG8_BAR; PG8_MMA(1, 0, At, B0); PG8_MMA(1, 1, At, B1); PG8_BAR; PG8_SCHED;
            PG8_LDB(B0, 1, 0); PG8_LDB(B1, 1, 1); PG8_LDS_SCL(ui & 1, t + 1); PG8_SCHED; PG8_LDA(At, 1, 0); PG8_LDS_SCA(ui & 1, t + 1, 0); PG8_STAGE_A2(PG8_SA(0, 1), 1, k2);
            PG8_WAIT_V(8); PG8_WAIT_L(0); PG8_BAR; PG8_MMA(0, 0, At, B0); PG8_MMA(0, 1, At, B1); PG8_BAR; PG8_SCHED;
            PG8_LDA(At, 1, 1); PG8_LDS_SCA(ui & 1, t + 1, 1); PG8_STAGE(PG8_SB(1, 0), b2, voffB, k3); PG8_STAGE(PG8_SB(1, 1), b2, voffB, hstepB + k3); PG8_STAGE_A2(PG8_SA(1, 0), 0, k3);
            PG8_WAIT_V(8); PG8_WAIT_L(0); PG8_BAR; PG8_MMA(1, 0, At, B0); PG8_MMA(1, 1, At, B1); PG8_BAR; PG8_SCHED;
        }
#if PROBE_T
        const unsigned long long pt1_ = __builtin_amdgcn_s_memtime(); pk_ += pt1_ - pt0_;
#endif
        if constexpr (FP8) asm volatile("s_nop 15\n\ts_nop 7" ::: "memory");
        const bool has_nn = has_next && S.next(ui + 2, nn);
        if constexpr (GATHER) {
#pragma unroll
            for (int h = 0; h < 2; ++h)
#pragma unroll
                for (int i = 0; i < 2; ++i) ocA[h][i] = onA[h][i];
            if (has_nn) { PG8_GRAW(nn, onA); } }
        if (wr == 0) PG8_BAR;
        E(acc, cur, wr, wc, fr, fq);
#if PROBE_T
        asm volatile("s_waitcnt vmcnt(0)" ::: "memory"); pe_ += __builtin_amdgcn_s_memtime() - pt1_; ++pn_;
#endif
        if (!has_next) break;
#pragma unroll
        for (int a = 0; a < 2; ++a)
#pragma unroll
            for (int b = 0; b < 2; ++b)
#pragma unroll
                for (int m = 0; m < 4; ++m)
#pragma unroll
                    for (int n = 0; n < 2; ++n) acc[a][b][m][n] = (f32x4){0.f, 0.f, 0.f, 0.f};
        cur = nxt; cA = nA; cB = nB; ++ui;
        if constexpr (GATHER) { if (has_nn) {
#pragma unroll
            for (int h = 0; h < 2; ++h)
#pragma unroll
                for (int i = 0; i < 2; ++i) { int gR_, gC_; stage_rc(tid * 16 + i * 8192, gR_, gC_); onA[h][i] = onA[h][i] * (unsigned)lda + (unsigned)(gC_ * 2); } } }
        if (has_nn) { nxt = nn; PG8_DMA_SCL(nxt, (ui + 1) & 1); }
        has_next = has_nn;
        if (wr == 1) PG8_BAR;
    }
    PG8_WAIT_V(0);
    PG8_BAR;
#if PROBE_T
    if (pw && blockIdx.x == 0 && tid == 0) { pw[0] += pk_; pw[1] += pe_; pw[2] += pn_; pw[3] += __builtin_amdgcn_s_memtime() - pst_; }
#endif
#undef PG8_SA
#undef PG8_SB
#undef PG8_STAGE
#undef PG8_LDA
#undef PG8_LDB
#undef PG8_MMA
#undef PG8_WAIT_V
#undef PG8_WAIT_L
#undef PG8_BAR
#undef PG8_SCHED
#undef PG8_GOFFS
#undef PG8_GRAW
#undef PG8_STAGE_A2
#undef PG8_CAT
#undef PG8_LO
#undef PG8_HI
#undef PG8_LDS_SCL
#undef PG8_LDS_SCA
#undef PG8_DMA_SCL
}

constexpr int NXCD = 8, WGM = 8;
struct DenseSched {
    const char* A; const char* B; int lda, ldb; int nM, nN, nwg, G, c; int apn_shift, akbytes, bpm_shift; size_t bbatch;
    __device__ __forceinline__ void init(const void* A_, const void* B_, int lda_, int ldb_, int M, int N, int G_, int c_) {
        A = (const char*)A_; B = (const char*)B_; lda = lda_; ldb = ldb_; nM = M / BM; nN = N / BM; nwg = nM * nN; G = G_; c = c_; apn_shift = -1; akbytes = 0; bpm_shift = -1; bbatch = 0; }
    __device__ __forceinline__ bool next(int i, Unit& u) const {
        const long L = (long)i * G + c; if (L >= nwg) return false;
        int wgid = (int)L; { const int q = nwg / NXCD, r = nwg % NXCD, xcd = wgid % NXCD, off = wgid / NXCD; wgid = (xcd < r ? xcd * (q + 1) : r * (q + 1) + (xcd - r) * q) + off; }
        const int nig = WGM * nN, gid = wgid / nig, fm = gid * WGM, gsz = (nM - fm) < WGM ? (nM - fm) : WGM;
        const int pm = fm + ((wgid % nig) % gsz), pn = (wgid % nig) / gsz;
        u.pm = pm; u.pn = pn; u.aux = 0; u.lst = nullptr; u.nvalid = 256; u.S = nullptr; u.SA = nullptr;
        u.A = A + (size_t)pm * 256 * lda * 2 + (apn_shift >= 0 ? (size_t)(pn >> apn_shift) * akbytes : (size_t)0);
        u.B = B + (size_t)pn * 256 * ldb * 2 + (bpm_shift >= 0 ? (size_t)(pm >> bpm_shift) * bbatch : (size_t)0);
        return true;
    }
};
struct MoeSched {
    const char* A; const char* B; size_t bexp; const char* SW; int lda, ldb  , nN; const int* lists; volatile LAS const int* tab; volatile LAS const unsigned char* te; int G, c; bool gather; const char* SA;
    __device__ __forceinline__ bool next(int i, Unit& u) const {
        int pn, mg;
        if (G == 256) {
            const int x = c & 7, jj = c >> 3, pgs = nN >> 2, mgs = 8 / pgs;
            mg = i * (8 * mgs) + 8 * (x / pgs) + (jj & 7); pn = 4 * (x % pgs) + (jj >> 3);
            if (mg >= __builtin_amdgcn_readfirstlane(tab[32])) return false;
        } else { const int total = __builtin_amdgcn_readfirstlane(tab[32]) * nN; const long L = (long)i * G + c; if (L >= total) return false; pn = (int)(L % nN); mg = (int)(L / nN); }
        const int e = __builtin_amdgcn_readfirstlane((int)te[mg]), mt = mg - __builtin_amdgcn_readfirstlane(tab[e]);
        u.pm = mg; u.pn = pn; u.aux = e;
        if (gather) { u.A = A; u.lst = lists + (size_t)e * T + mt * 256; const int rem = __builtin_amdgcn_readfirstlane(tab[48 + e]) - mt * 256; u.nvalid = rem < 256 ? rem : 256; }
        else { u.A = A + (size_t)mg * 256 * lda; u.lst = nullptr; u.nvalid = 256; }
        u.B = B + (size_t)e * bexp + (size_t)pn * 256 * ldb; u.S = SW ? (SA ? SW + ((size_t)e * 4 + pn) * 4096 : SW + ((size_t)e * 8 + pn) * 8192) : nullptr; u.SA = SA ? SA + (size_t)mg * 8192 : nullptr;
        return true;
    }
};

#define EPI_ROW(u, ai, m) ((u).pm * 256 + (ai) * 128 + wr * 64 + (m) * 16 + fr)
struct EpiLat {
    static constexpr bool PERM = true;
    bf16_t* LAT; float* SSQ; bf16_t* KR; const float* CS; const float* SN;
    __device__ __forceinline__ void operator()(const f32x4 (&acc)[2][2][4][2], const Unit& u, int wr, int wc, int fr, int fq) const {
        if (u.pn < 4) {
#pragma unroll
            for (int ai = 0; ai < 2; ++ai)
#pragma unroll
                for (int m = 0; m < 4; ++m) { const int row = EPI_ROW(u, ai, m); float ss = 0.f;
#pragma unroll
                    for (int bj = 0; bj < 2; ++bj) { const f32x4 v0 = acc[ai][bj][m][0], v1 = acc[ai][bj][m][1];
                        ss += (v0[0] * v0[0] + v0[1] * v0[1]) + (v0[2] * v0[2] + v0[3] * v0[3]) + (v1[0] * v1[0] + v1[1] * v1[1]) + (v1[2] * v1[2] + v1[3] * v1[3]);
                        *(u32x4*)(LAT + (size_t)row * 1024 + u.pn * 256 + bj * 128 + wc * 32 + 8 * fq) = pack8(v0, v1); }
                    ss += __shfl_xor(ss, 16); ss += __shfl_xor(ss, 32);
                    if (fq == 0) SSQ[(size_t)row * 16 + u.pn * 4 + wc] = ss; }
        } else if (wc == 0) {
#pragma unroll
            for (int ai = 0; ai < 2; ++ai)
#pragma unroll
                for (int m = 0; m < 4; ++m) { const int row = EPI_ROW(u, ai, m);
                    const f32x4 c0 = *(const f32x4*)(CS + (size_t)row * 32 + 8 * fq), c1 = *(const f32x4*)(CS + (size_t)row * 32 + 8 * fq + 4);
                    const f32x4 s0 = *(const f32x4*)(SN + (size_t)row * 32 + 8 * fq), s1 = *(const f32x4*)(SN + (size_t)row * 32 + 8 * fq + 4);
                    const f32x4 a0 = acc[ai][0][m][0], a1 = acc[ai][0][m][1], b0 = acc[ai][1][m][0], b1 = acc[ai][1][m][1];
                    *(u32x4*)(KR + (size_t)row * 64 + 8 * fq) = pack8(a0 * c0 - b0 * s0, a1 * c1 - b1 * s1);
                    *(u32x4*)(KR + (size_t)row * 64 + 32 + 8 * fq) = pack8(b0 * c0 + a0 * s0, b1 * c1 + a1 * s1); }
        }
    }
};
struct EpiQ {
    static constexpr bool PERM = true;
    bf16_t* Q; const float* SSQ; const float* CS; const float* SN;
    __device__ __forceinline__ void operator()(const f32x4 (&acc)[2][2][4][2], const Unit& u, int wr, int wc, int fr, int fq) const {
#pragma unroll
        for (int ai = 0; ai < 2; ++ai)
#pragma unroll
            for (int m = 0; m < 4; ++m) { const int row = EPI_ROW(u, ai, m);
                const f32x4 q0 = *(const f32x4*)(SSQ + (size_t)row * 16), q1 = *(const f32x4*)(SSQ + (size_t)row * 16 + 4), q2 = *(const f32x4*)(SSQ + (size_t)row * 16 + 8);
                const float ss = ((q0[0] + q0[1]) + (q0[2] + q0[3])) + ((q1[0] + q1[1]) + (q1[2] + q1[3])) + ((q2[0] + q2[1]) + (q2[2] + q2[3]));
                const float r = QSCALE / sqrtf(ss * (1.0f / QL) + KF(RMS_EPS));
                if (u.pn < 4) {
#pragma unroll
                    for (int bj = 0; bj < 2; ++bj)
                        *(u32x4*)(Q + (size_t)row * 1536 + (2 * u.pn + bj) * 192 + wc * 32 + 8 * fq) = pack8(acc[ai][bj][m][0] * r, acc[ai][bj][m][1] * r);
                } else {
                    const int head = 4 * (u.pn - 4) + wc;
                    const f32x4 c0 = *(const f32x4*)(CS + (size_t)row * 32 + 8 * fq), c1 = *(const f32x4*)(CS + (size_t)row * 32 + 8 * fq + 4);
                    const f32x4 s0 = *(const f32x4*)(SN + (size_t)row * 32 + 8 * fq), s1 = *(const f32x4*)(SN + (size_t)row * 32 + 8 * fq + 4);
                    const f32x4 a0 = acc[ai][0][m][0] * r, a1 = acc[ai][0][m][1] * r, b0 = acc[ai][1][m][0] * r, b1 = acc[ai][1][m][1] * r;
                    *(u32x4*)(Q + (size_t)row * 1536 + head * 192 + 128 + 8 * fq) = pack8(a0 * c0 - b0 * s0, a1 * c1 - b1 * s1);
                    *(u32x4*)(Q + (size_t)row * 1536 + head * 192 + 160 + 8 * fq) = pack8(b0 * c0 + a0 * s0, b1 * c1 + a1 * s1);
                }
                asm volatile("" ::: "memory"); }
    }
};
struct EpiKV {
    static constexpr bool PERM = true;
    bf16_t* KN; bf16_t* V; const float* SSQ;
    __device__ __forceinline__ void operator()(const f32x4 (&acc)[2][2][4][2], const Unit& u, int wr, int wc, int fr, int fq) const {
#pragma unroll
        for (int ai = 0; ai < 2; ++ai)
#pragma unroll
            for (int m = 0; m < 4; ++m) { const int row = EPI_ROW(u, ai, m);
                const f32x4 q3 = *(const f32x4*)(SSQ + (size_t)row * 16 + 12);
                const float r = 1.0f / sqrtf(((q3[0] + q3[1]) + (q3[2] + q3[3])) * (1.0f / KVL) + KF(RMS_EPS));
                *(u32x4*)(KN + (size_t)row * 1024 + u.pn * 128 + wc * 32 + 8 * fq) = pack8(acc[ai][0][m][0] * r, acc[ai][0][m][1] * r);
                *(u32x4*)(V + (size_t)row * 1024 + u.pn * 128 + wc * 32 + 8 * fq) = pack8(acc[ai][1][m][0] * r, acc[ai][1][m][1] * r); }
    }
};
__device__ __forceinline__ f32x4 bf4_lo(const u32x4 w) { return (f32x4){bf_lo(w.x), bf_hi(w.x), bf_lo(w.y), bf_hi(w.y)}; }
__device__ __forceinline__ f32x4 bf4_hi(const u32x4 w) { return (f32x4){bf_lo(w.z), bf_hi(w.z), bf_lo(w.w), bf_hi(w.w)}; }
struct EpiRes {
    static constexpr bool PERM = true;
    const bf16_t* X; bf16_t* Y;
    __device__ __forceinline__ void operator()(const f32x4 (&acc)[2][2][4][2], const Unit& u, int wr, int wc, int fr, int fq) const {
        const bf16_t* xb = X + (size_t)u.pm * 256 * 1024; bf16_t* yb = Y + (size_t)u.pm * 256 * 1024; const unsigned o0 = (unsigned)((wr * 64 + fr) * 1024 + u.pn * 256 + wc * 32 + 8 * fq);
        u32x4 xw[2][4][2];
#pragma unroll
        for (int ai = 0; ai < 2; ++ai)
#pragma unroll
            for (int m = 0; m < 4; ++m)
#pragma unroll
                for (int bj = 0; bj < 2; ++bj) xw[ai][m][bj] = *(const u32x4*)(xb + (o0 + (unsigned)((ai * 128 + m * 16) * 1024 + bj * 128)));
#pragma unroll
        for (int ai = 0; ai < 2; ++ai)
#pragma unroll
            for (int m = 0; m < 4; ++m)
#pragma unroll
                for (int bj = 0; bj < 2; ++bj)
                    *(u32x4*)(yb + (o0 + (unsigned)((ai * 128 + m * 16) * 1024 + bj * 128))) = pack8(bf4_lo(xw[ai][m][bj]) * ALPHA + acc[ai][bj][m][0], bf4_hi(xw[ai][m][bj]) * ALPHA + acc[ai][bj][m][1]);
    }
};
struct EpiGU {
    static constexpr bool PERM = true;
    bf16_t* GG; bf16_t* U;
    __device__ __forceinline__ void operator()(const f32x4 (&acc)[2][2][4][2], const Unit& u, int wr, int wc, int fr, int fq) const {
#pragma unroll
        for (int ai = 0; ai < 2; ++ai)
#pragma unroll
            for (int m = 0; m < 4; ++m) { const int row = EPI_ROW(u, ai, m);
#pragma unroll
                for (int bj = 0; bj < 2; ++bj) { f32x4 v0 = acc[ai][bj][m][0], v1 = acc[ai][bj][m][1];
                    if (u.pn < 4) {
#pragma unroll
                        for (int e = 0; e < 4; ++e) { v0[e] = gelu_tanh(v0[e]); v1[e] = gelu_tanh(v1[e]); }
                        *(u32x4*)(GG + (size_t)row * 1024 + u.pn * 256 + bj * 128 + wc * 32 + 8 * fq) = pack8(v0, v1);
                    } else *(u32x4*)(U + (size_t)row * 1024 + (u.pn - 4) * 256 + bj * 128 + wc * 32 + 8 * fq) = pack8(v0, v1); } }
    }
};
struct EpiAB {
    static constexpr bool PERM = true;
    bf16_t* LA; bf16_t* BB; const bf16_t* UC; const float* BA; const float* BX; const float* SPL;
    __device__ __forceinline__ void operator()(const f32x4 (&acc)[2][2][4][2], const Unit& u, int wr, int wc, int fr, int fq) const {
        const int ch = (u.pn >> 1) * 256 + (u.pn & 1) * 128 + wc * 32 + 8 * fq;
        const float c3 = KF(0.16666667f), c4 = KF(0.041666668f), c5 = KF(0.0083333338f);
        f32x4 ba[2], bx[2], sp[2];
#pragma unroll
        for (int n = 0; n < 2; ++n) { ba[n] = *(const f32x4*)(BA + ch + 4 * n); bx[n] = *(const f32x4*)(BX + ch + 4 * n); sp[n] = *(const f32x4*)(SPL + ch + 4 * n); }
#pragma unroll
        for (int ai = 0; ai < 2; ++ai)
#pragma unroll
            for (int m = 0; m < 4; ++m) { const size_t off = (size_t)EPI_ROW(u, ai, m) * 1024 + ch;
                const u32x4 uw = *(const u32x4*)(UC + off); f32x4 uv[2] = {bf4_lo(uw), bf4_hi(uw)}, lv[2], bv[2];
#pragma unroll
                for (int n = 0; n < 2; ++n)
#pragma unroll
                    for (int e = 0; e < 4; ++e) { const float r = sigmoidf_(acc[ai][0][m][n][e] + ba[n][e]), ig = sigmoidf_(acc[ai][1][m][n][e] + bx[n][e]);
                        const float la = sp[n][e] * r, x2 = 2.0f * la; lv[n][e] = la * 1.4426950408889634f;
                        const float om = x2 > -0.25f ? -x2 * (1.0f + x2 * (0.5f + x2 * (c3 + x2 * (c4 + x2 * c5)))) : 1.0f - __expf(x2);
                        bv[n][e] = sqrtf(om) * ig * uv[n][e]; }
                *(u32x4*)(LA + off) = pack8(lv[0], lv[1]); *(u32x4*)(BB + off) = pack8(bv[0], bv[1]); asm volatile("" ::: "memory"); }
    }
};
struct EpiUp {
    static constexpr bool PERM = true;
    unsigned char* H; unsigned char* SH; const float* BU;
    __device__ __forceinline__ void operator()(f32x4 (&acc)[2][2][4][2], const Unit& u, int wr, int wc, int fr, int fq) const {
        const int gc = u.pn * 128 + wc * 32 + 8 * fq; const float* bu = BU + (size_t)u.aux * 2048;
        const float k7 = KF(7.0f), km7 = KF(-7.0f), ka = KF(1.702f);
#pragma unroll
        for (int n = 0; n < 2; ++n) { const f32x4 bg = *(const f32x4*)(bu + gc + 4 * n), bp = *(const f32x4*)(bu + 1024 + gc + 4 * n);
#pragma unroll
            for (int ai = 0; ai < 2; ++ai)
#pragma unroll
                for (int m = 0; m < 4; ++m) {
#pragma unroll
                    for (int e = 0; e < 4; ++e) { const float g = fminf(acc[ai][0][m][n][e] + bg[e], k7), up = fminf(fmaxf(acc[ai][1][m][n][e] + bp[e], km7), k7);
                        acc[ai][0][m][n][e] = (up + 1.0f) * (g * sigmoidf_(ka * g)); }
                    if (m & 1) __builtin_amdgcn_sched_barrier(0); }
            asm volatile("" ::: "memory"); }
        unsigned char* const shb = SH + ((size_t)u.pm * 8 + u.pn) * 1024; unsigned char* const hb = H + (size_t)u.pm * 256 * 1024;
        const unsigned ho = (unsigned)((wr * 64 + fr) * 1024 + gc), so = (unsigned)((wr * 64 + fr) * 4 + wc);
#pragma unroll
        for (int ai = 0; ai < 2; ++ai)
#pragma unroll
            for (int m = 0; m < 4; ++m) { const f32x4 y0 = acc[ai][0][m][0], y1 = acc[ai][0][m][1];
                float am = fmaxf(fmaxf(fmaxf(fabsf(y0[0]), fabsf(y0[1])), fmaxf(fabsf(y0[2]), fabsf(y0[3]))), fmaxf(fmaxf(fabsf(y1[0]), fabsf(y1[1])), fmaxf(fabsf(y1[2]), fabsf(y1[3]))));
                { auto r16 = __builtin_amdgcn_permlane16_swap(__float_as_uint(am), __float_as_uint(am), false, false); am = fmaxf(__uint_as_float(r16[0]), __uint_as_float(r16[1]));
                  auto r32 = __builtin_amdgcn_permlane32_swap(__float_as_uint(am), __float_as_uint(am), false, false); am = fmaxf(__uint_as_float(r32[0]), __uint_as_float(r32[1])); }
                int eb = (int)((__float_as_uint(am) >> 23) & 0xffu) - 7; eb = eb < 1 ? 1 : eb;
                const float inv = __uint_as_float((unsigned)(254 - eb) << 23);
                int w0 = __builtin_amdgcn_cvt_pk_fp8_f32(y0[0] * inv, y0[1] * inv, 0, false); w0 = __builtin_amdgcn_cvt_pk_fp8_f32(y0[2] * inv, y0[3] * inv, w0, true);
                int w1 = __builtin_amdgcn_cvt_pk_fp8_f32(y1[0] * inv, y1[1] * inv, 0, false); w1 = __builtin_amdgcn_cvt_pk_fp8_f32(y1[2] * inv, y1[3] * inv, w1, true);
                *(u32x2*)(hb + (ho + (unsigned)((ai * 128 + m * 16) * 1024))) = (u32x2){(unsigned)w0, (unsigned)w1};
                if (fq == 0) shb[so + (unsigned)((ai * 128 + m * 16) * 4)] = (unsigned char)eb;
                asm volatile("" ::: "memory"); __builtin_amdgcn_sched_barrier(0); }
    }
};
struct EpiDown {
    static constexpr bool PERM = true;
    unsigned char* YS; unsigned char* SY; const float* BD;
    __device__ __forceinline__ void operator()(const f32x4 (&acc)[2][2][4][2], const Unit& u, int wr, int wc, int fr, int fq) const {
        const float* bd = BD + (size_t)u.aux * 1024;
        unsigned char* const yb = YS + (size_t)u.pm * 256 * 1024; unsigned char* const sb = SY + (size_t)u.pm * 256 * 32;
#pragma unroll
        for (int bj = 0; bj < 2; ++bj) { const int col = u.pn * 256 + bj * 128 + wc * 32 + 8 * fq; const f32x4 b0 = *(const f32x4*)(bd + col), b1 = *(const f32x4*)(bd + col + 4);
#pragma unroll
            for (int ai = 0; ai < 2; ++ai)
#pragma unroll
                for (int m = 0; m < 4; ++m) { const unsigned rit = (unsigned)(ai * 128 + wr * 64 + m * 16 + fr); const f32x4 y0 = acc[ai][bj][m][0] + b0, y1 = acc[ai][bj][m][1] + b1;
                    float am = fmaxf(fmaxf(fmaxf(fabsf(y0[0]), fabsf(y0[1])), fmaxf(fabsf(y0[2]), fabsf(y0[3]))), fmaxf(fmaxf(fabsf(y1[0]), fabsf(y1[1])), fmaxf(fabsf(y1[2]), fabsf(y1[3]))));
                    { auto r16 = __builtin_amdgcn_permlane16_swap(__float_as_uint(am), __float_as_uint(am), false, false); am = fmaxf(__uint_as_float(r16[0]), __uint_as_float(r16[1]));
                      auto r32 = __builtin_amdgcn_permlane32_swap(__float_as_uint(am), __float_as_uint(am), false, false); am = fmaxf(__uint_as_float(r32[0]), __uint_as_float(r32[1])); }
                    int eb = (int)((__float_as_uint(am) >> 23) & 0xffu) - 7; eb = eb < 1 ? 1 : eb;
                    const float inv = __uint_as_float((unsigned)(254 - eb) << 23);
                    int w0 = __builtin_amdgcn_cvt_pk_fp8_f32(y0[0] * inv, y0[1] * inv, 0, false); w0 = __builtin_amdgcn_cvt_pk_fp8_f32(y0[2] * inv, y0[3] * inv, w0, true);
                    int w1 = __builtin_amdgcn_cvt_pk_fp8_f32(y1[0] * inv, y1[1] * inv, 0, false); w1 = __builtin_amdgcn_cvt_pk_fp8_f32(y1[2] * inv, y1[3] * inv, w1, true);
                    *(u32x2*)(yb + (rit * 1024u + (unsigned)col)) = (u32x2){(unsigned)w0, (unsigned)w1};
                    if (fq == 0) sb[rit * 32u + (unsigned)(col >> 5)] = (unsigned char)eb;
                    asm volatile("" ::: "memory"); } }
    }
};
struct EpiPle {
    static constexpr bool PERM = true;
    const bf16_t* X2; const bf16_t* PP; float* OUT; bf16_t* XB;
    __device__ __forceinline__ void operator()(const f32x4 (&acc)[2][2][4][2], const Unit& u, int wr, int wc, int fr, int fq) const {
        const size_t tb = (size_t)u.pm * 256 * 1024; const unsigned o0 = (unsigned)((wr * 64 + fr) * 1024 + u.pn * 256 + wc * 32 + 8 * fq);
#pragma unroll
        for (int ai = 0; ai < 2; ++ai) {
            u32x4 xw[4][2], pw[4][2];
#pragma unroll
            for (int m = 0; m < 4; ++m)
#pragma unroll
                for (int bj = 0; bj < 2; ++bj) { const unsigned o = o0 + (unsigned)((ai * 128 + m * 16) * 1024 + bj * 128); xw[m][bj] = *(const u32x4*)(X2 + tb + o); pw[m][bj] = *(const u32x4*)(PP + tb + o); }
#pragma unroll
            for (int m = 0; m < 4; ++m)
#pragma unroll
                for (int bj = 0; bj < 2; ++bj) { const unsigned o = o0 + (unsigned)((ai * 128 + m * 16) * 1024 + bj * 128);
                    const f32x4 a0 = acc[ai][bj][m][0], a1 = acc[ai][bj][m][1], x0 = bf4_lo(xw[m][bj]), x1 = bf4_hi(xw[m][bj]), p0 = bf4_lo(pw[m][bj]), p1 = bf4_hi(pw[m][bj]); f32x4 r0, r1;
#pragma unroll
                    for (int e = 0; e < 4; ++e) { r0[e] = x0[e] + sigmoidf_(a0[e]) * p0[e]; r1[e] = x1[e] + sigmoidf_(a1[e]) * p1[e]; }
                    *(u32x4*)(XB + tb + o) = pack8(r0, r1);
                    if (OUT) { *(f32x4*)(OUT + tb + o) = r0; *(f32x4*)(OUT + tb + o + 4) = r1; } }
            asm volatile("" ::: "memory"); }
    }
};
struct EpiPP {
    static constexpr bool PERM = true;
    bf16_t* PP;
    __device__ __forceinline__ void operator()(const f32x4 (&acc)[2][2][4][2], const Unit& u, int wr, int wc, int fr, int fq) const {
#pragma unroll
        for (int ai = 0; ai < 2; ++ai)
#pragma unroll
            for (int m = 0; m < 4; ++m)
#pragma unroll
                for (int bj = 0; bj < 2; ++bj) *(u32x4*)(PP + (size_t)EPI_ROW(u, ai, m) * 1024 + u.pn * 256 + bj * 128 + wc * 32 + 8 * fq) = pack8(acc[ai][bj][m][0], acc[ai][bj][m][1]);
    }
};
}

namespace att {
constexpr int NW = 8, QBLK = 32, KVBLK = 64, QB = 256, KPITCH = 384;
constexpr int SHM_V = KVBLK * DV * 2, SHM_K = KVBLK * KPITCH;
constexpr int NVB = 3;
constexpr int OFF_V = 0, OFF_K = NVB * SHM_V, OFF_WS = OFF_K + 2 * SHM_K, LDS_BYTES = OFF_WS + NW * 64 * 4;
#define SBAR() __builtin_amdgcn_sched_barrier(0)
__device__ __forceinline__ int k_addr(int row, int chunk) { return row * KPITCH + ((chunk ^ ((row >> 1) & 7)) << 4); }
__device__ __forceinline__ int v_st(int k, int c) { const int kk = (k & ~0xC) | ((k & 4) << 1) | ((k & 8) >> 1); return ((kk >> 3) * 4 + (c >> 5)) * 512 + ((kk & 7) * 32 + (c & 31)) * 2; }
__device__ __forceinline__ int v_rd_base(int lane) { return ((lane & 3) << 3) | (((lane >> 2) & 3) << 6) | (((lane >> 4) & 1) << 5) | (((lane >> 5) & 1) << 8); }
constexpr int v_rd_off(int d0, int ks, int half) { return d0 * 512 + ks * 4096 + half * 2048; }
__device__ __forceinline__ int crow(int r, int hi) { return (r & 3) + 8 * (r >> 2) + 4 * hi; }

template <int KB>
__device__ __forceinline__ void qkt(f32x16& p0, f32x16& p1, const LAS char* K_lds, int r32, int hi, const bf16x8* qr) {
    p0 = f32x16{}; p1 = f32x16{};
    const LAS char* kb[4];
#pragma unroll
    for (int dd = 0; dd < 4; ++dd) kb[dd] = K_lds + KB * SHM_K + r32 * KPITCH + (((2 * dd + hi) ^ ((r32 >> 1) & 7)) << 4);
    bf16x8 f[2][4];
#define QK_LD(g, buf) do { _Pragma("unroll") for (int e_ = 0; e_ < 2; ++e_) { const int d0_ = 2 * (g) + e_; const LAS char* a_ = kb[d0_ & 3] + (d0_ >> 2) * 128; \
        f[buf][2 * e_] = *(const LAS bf16x8*)a_; f[buf][2 * e_ + 1] = *(const LAS bf16x8*)(a_ + 32 * KPITCH); } } while (0)
    QK_LD(0, 0);
#pragma unroll
    for (int g = 0; g < 6; ++g) {
        if (g < 5) QK_LD(g + 1, (g + 1) & 1);
        SBAR();
#pragma unroll
        for (int e = 0; e < 2; ++e) { const int d0 = 2 * g + e;
            p0 = __builtin_amdgcn_mfma_f32_32x32x16_bf16(f[g & 1][2 * e], qr[d0], p0, 0, 0, 0);
            p1 = __builtin_amdgcn_mfma_f32_32x32x16_bf16(f[g & 1][2 * e + 1], qr[d0], p1, 0, 0, 0); }
        SBAR(); }
#undef QK_LD
}
__device__ __forceinline__ void pv_tile(f32x16* o, int vb0  , bf16x8 pa0, bf16x8 pa1, bf16x8 pa2, bf16x8 pa3) {
#define TRRD(dst, off) asm volatile("ds_read_b64_tr_b16 %0, %1 offset:%2" : "=&v"(dst) : "v"(vb0), "i"(off) : "memory")
#define PV_D0(d0) do { s16x4 l0, l1, l2, l3, h0, h1, h2, h3; constexpr int b_ = v_rd_off(d0, 0, 0); \
        TRRD(l0, b_); TRRD(h0, b_ + 2048); TRRD(l1, b_ + 4096); TRRD(h1, b_ + 6144); TRRD(l2, b_ + 8192); TRRD(h2, b_ + 10240); TRRD(l3, b_ + 12288); TRRD(h3, b_ + 14336); \
        asm volatile("s_waitcnt lgkmcnt(0)" ::: "memory"); SBAR(); \
        o[d0] = __builtin_amdgcn_mfma_f32_32x32x16_bf16(pa0, (bf16x8){l0[0], l0[1], l0[2], l0[3], h0[0], h0[1], h0[2], h0[3]}, o[d0], 0, 0, 0); \
        o[d0] = __builtin_amdgcn_mfma_f32_32x32x16_bf16(pa1, (bf16x8){l1[0], l1[1], l1[2], l1[3], h1[0], h1[1], h1[2], h1[3]}, o[d0], 0, 0, 0); \
        o[d0] = __builtin_amdgcn_mfma_f32_32x32x16_bf16(pa2, (bf16x8){l2[0], l2[1], l2[2], l2[3], h2[0], h2[1], h2[2], h2[3]}, o[d0], 0, 0, 0); \
        o[d0] = __builtin_amdgcn_mfma_f32_32x32x16_bf16(pa3, (bf16x8){l3[0], l3[1], l3[2], l3[3], h3[0], h3[1], h3[2], h3[3]}, o[d0], 0, 0, 0); } while (0)
    PV_D0(0); PV_D0(1); PV_D0(2); PV_D0(3);
#undef PV_D0
#undef TRRD
}
__device__ __forceinline__ void mask_tile(f32x16& p0, f32x16& p1, int dq  ) {
    const float NEG = -__builtin_inff();
#pragma unroll
    for (int r = 0; r < 16; ++r) { const int c = (r & 3) + 8 * (r >> 2);
        if (c > dq) p0[r] = NEG;
        if (c + 32 > dq) p1[r] = NEG; }
}
__device__ __forceinline__ void softmax_tile(f32x16& p0, f32x16& p1, float& m_reg, float& l_reg, float& alpha, bf16x8& pa0, bf16x8& pa1, bf16x8& pa2, bf16x8& pa3) {
    float pmax = p0[0];
#pragma unroll
    for (int r = 1; r < 16; ++r) pmax = fmaxf(pmax, p0[r]);
#pragma unroll
    for (int r = 0; r < 16; ++r) pmax = fmaxf(pmax, p1[r]);
    { auto rr = __builtin_amdgcn_permlane32_swap(__float_as_uint(pmax), __float_as_uint(pmax), false, false); pmax = fmaxf(__uint_as_float(rr[0]), __uint_as_float(rr[1])); }
    float mn = m_reg; alpha = 1.f;
    if (!__all(pmax - m_reg <= 8.0f)) { mn = fmaxf(m_reg, pmax); alpha = __builtin_amdgcn_exp2f(m_reg - mn); m_reg = mn; }
    float ps = 0.f;
#pragma unroll
    for (int r = 0; r < 16; ++r) { p0[r] = __builtin_amdgcn_exp2f(p0[r] - mn); ps += p0[r]; }
#pragma unroll
    for (int r = 0; r < 16; ++r) { p1[r] = __builtin_amdgcn_exp2f(p1[r] - mn); ps += p1[r]; }
    { auto rr = __builtin_amdgcn_permlane32_swap(__float_as_uint(ps), __float_as_uint(ps), false, false); ps = __uint_as_float(rr[0]) + __uint_as_float(rr[1]); }
    l_reg = l_reg * alpha + ps;
#define PK4(P, B_, OUT) do { unsigned a0 = cvt_pk_bf16(P[B_+0], P[B_+1]), a1 = cvt_pk_bf16(P[B_+2], P[B_+3]); \
        unsigned b0 = cvt_pk_bf16(P[B_+4], P[B_+5]), b1 = cvt_pk_bf16(P[B_+6], P[B_+7]); \
        auto r0 = __builtin_amdgcn_permlane32_swap(a0, b0, false, false); auto r1 = __builtin_amdgcn_permlane32_swap(a1, b1, false, false); \
        u32x4 w = {r0[0], r1[0], r0[1], r1[1]}; OUT = __builtin_bit_cast(bf16x8, w); } while (0)
    PK4(p0, 0, pa0); PK4(p0, 8, pa1); PK4(p1, 0, pa2); PK4(p1, 8, pa3);
#undef PK4
}

__device__ __forceinline__ void attn_block(int b, int h, int qb, const bf16_t* Q, const bf16_t* KN, const bf16_t* KR, const bf16_t* V, bf16_t* O, LAS char* lds, unsigned long long* pw = nullptr) {
    const int tid = opaque_tid(), wid = __builtin_amdgcn_readfirstlane(tid >> 6), lane = tid & 63, r32 = lane & 31, hi = lane >> 5;
    const size_t row0 = (size_t)b * SEQ;
    const int q0 = qb * QB + wid * QBLK;
    const int NT = (qb + 1) * (QB / KVBLK);
    LAS char* V_lds = lds + OFF_V; LAS char* K_lds = lds + OFF_K;
    LAS float* ws = (LAS float*)(lds + OFF_WS) + wid * 64; LAS float* li_l = ws; LAS float* al_l = ws + 32;
    const int sr = tid >> 4, sc = (tid & 15) * 8, kr_row = tid >> 3, kr_c = tid & 7;
    const int vst0 = v_st(sr, sc), vst1 = v_st(32 + sr, sc), kws = k_addr(sr, tid & 15), kwr = k_addr(kr_row, 16 + kr_c);
    const int vb0 = (int)(uintptr_t)lds + v_rd_base(lane);
    const bf16_t* KNh = KN + row0 * 1024 + h * 128 + sc; const bf16_t* Vh = V + row0 * 1024 + h * 128 + sc; const bf16_t* KRb = KR + row0 * 64 + kr_c * 8;
    bf16x8 st_k0, st_k1, st_kr, st_v0, st_v1;
#define SLOAD(t) do { const size_t k0_ = (size_t)(t) * KVBLK; \
        st_k0 = *(const bf16x8*)(KNh + (k0_ + sr) * 1024); st_k1 = *(const bf16x8*)(KNh + (k0_ + 32 + sr) * 1024); st_kr = *(const bf16x8*)(KRb + (k0_ + kr_row) * 64); \
        st_v0 = *(const bf16x8*)(Vh + (k0_ + sr) * 1024); st_v1 = *(const bf16x8*)(Vh + (k0_ + 32 + sr) * 1024); } while (0)
#define SWRITE(bf, vo) do { *(LAS bf16x8*)(K_lds + (bf) * SHM_K + kws) = st_k0; *(LAS bf16x8*)(K_lds + (bf) * SHM_K + kws + 32 * KPITCH) = st_k1; *(LAS bf16x8*)(K_lds + (bf) * SHM_K + kwr) = st_kr; \
        *(LAS bf16x8*)(V_lds + (vo) + vst0) = st_v0; *(LAS bf16x8*)(V_lds + (vo) + vst1) = st_v1; } while (0)
    SLOAD(0);
    bf16x8 qr[12];
    { const bf16_t* Qw = Q + (row0 + q0 + r32) * 1536 + h * 192 + hi * 8;
#pragma unroll
      for (int d0 = 0; d0 < 12; ++d0) qr[d0] = *(const bf16x8*)(Qw + d0 * 16); }
    float m_reg = -1e30f, l_reg = 0.f; f32x16 o[4] = {};
    f32x16 p0, p1; bf16x8 pa0, pa1, pa2, pa3; float alpha;
    asm volatile("s_waitcnt vmcnt(0)" ::: "memory");
    SWRITE(0, 0);
    __syncthreads();
    const bool odd = wid >= 4; int vo_prev = 0, vo_cur = 0, vo_next = SHM_V;
#define RESC(a) do { if (__any((a) < 1.f)) { if (hi == 0) al_l[r32] = (a); asm volatile("s_waitcnt lgkmcnt(0)" ::: "memory"); \
        _Pragma("unroll") for (int d_ = 0; d_ < 4; ++d_) _Pragma("unroll") for (int r = 0; r < 16; ++r) o[d_][r] *= al_l[crow(r, hi)]; } } while (0)
#if PROBE_T
    unsigned long long pa_ = 0, pb_ = 0, pc_ = 0, pd_ = 0, pe2_ = 0; const unsigned long long pst_ = __builtin_amdgcn_s_memtime();
#define PSTAMP(v) const unsigned long long v = __builtin_amdgcn_s_memtime()
#define PACC(acc, a, b) acc += (b) - (a)
#else
#define PSTAMP(v) do {} while (0)
#define PACC(acc, a, b) do {} while (0)
#endif
#define TILE(t, BF) do { PSTAMP(s0_); const bool more_ = ((t) + 1 < NT); if (more_) SLOAD((t) + 1); SBAR(); \
        if (odd && (t) > 0) { pv_tile(o, vb0 + vo_prev, pa0, pa1, pa2, pa3); SBAR(); } \
        PSTAMP(s1_); qkt<BF>(p0, p1, K_lds, r32, hi, qr); \
        { const int kb_ = (t) * KVBLK; if (kb_ + KVBLK - 1 > q0) mask_tile(p0, p1, q0 + r32 - kb_ - 4 * hi); } \
        asm volatile("" : "+v"(p0), "+v"(p1)); PSTAMP(s2_); \
        softmax_tile(p0, p1, m_reg, l_reg, alpha, pa0, pa1, pa2, pa3); RESC(alpha); SBAR(); PSTAMP(s3_); \
        if (!odd) pv_tile(o, vb0 + vo_cur, pa0, pa1, pa2, pa3); \
        PSTAMP(s4_); if (more_) { asm volatile("s_waitcnt vmcnt(0)" ::: "memory"); SWRITE((BF) ^ 1, vo_next); } \
        PSTAMP(s5_); __syncthreads(); PSTAMP(s6_); PACC(pa_, s1_, s2_); PACC(pb_, s2_, s3_); PACC(pc_, s3_, s4_); PACC(pd_, s4_, s5_); PACC(pe2_, s5_, s6_); vo_prev = vo_cur; vo_cur = vo_next; vo_next = (vo_next == (NVB - 1) * SHM_V) ? 0 : vo_next + SHM_V; } while (0)
#pragma unroll 1
    for (int t = 0; t < NT; t += 2) { TILE(t, 0); TILE(t + 1, 1); }
    if (odd) pv_tile(o, vb0 + vo_prev, pa0, pa1, pa2, pa3);
#if PROBE_T
    if (pw && blockIdx.x == 0 && tid == 0) { pw[8] += pa_; pw[9] += pb_; pw[10] += pc_; pw[11] += pd_; pw[12] += pe2_; pw[13] += (unsigned long long)NT; pw[14] += __builtin_amdgcn_s_memtime() - pst_; }
#endif
    if (hi == 0) li_l[r32] = l_reg; asm volatile("s_waitcnt lgkmcnt(0)" ::: "memory");
    __syncthreads();
    { LAS bf16_t* stg = (LAS bf16_t*)(lds + wid * 8704);
#pragma unroll
      for (int r = 0; r < 16; ++r) { const int orow = crow(r, hi); const float rl = __builtin_amdgcn_rcpf(li_l[orow]);
#pragma unroll
          for (int d0 = 0; d0 < 4; ++d0) { const float v = o[d0][r] * rl; stg[orow * 136 + d0 * 32 + r32] = (bf16_t)(cvt_pk_bf16(v, v) & 0xffffu); } }
      asm volatile("s_waitcnt lgkmcnt(0)" ::: "memory");
      bf16_t* Ow = O + (row0 + q0) * 1024 + h * 128 + (lane & 15) * 8;
#pragma unroll
      for (int it = 0; it < 8; ++it) { const int row = it * 4 + (lane >> 4); const u32x4 v = *(const LAS u32x4*)(stg + row * 136 + (lane & 15) * 8); *(u32x4*)(Ow + (size_t)row * 1024) = v; } }
    __syncthreads();
#undef SLOAD
#undef SWRITE
#undef RESC
#undef TILE
#undef PSTAMP
#undef PACC
}
#undef SBAR
}

#define XB_TMO      128
#define XB_XCNT(j)  (256  + 64 * (j))
#define XB_XSUB(j)  (1280 + 64 * (j))
#define XB_XGEN(j)  (2304 + 64 * (j))
#define XB_TOP      3328
#define XB_TOPGEN   3392
#define XCD_BAR_WORDS 3456
#define XB_SPIN_CAP (1u << 22)
__device__ __forceinline__ unsigned xb_ld(unsigned* p)              { return __hip_atomic_load(p, __ATOMIC_RELAXED, __HIP_MEMORY_SCOPE_AGENT); }
__device__ __forceinline__ unsigned xb_add(unsigned* p, unsigned v) { return __hip_atomic_fetch_add(p, v, __ATOMIC_RELAXED, __HIP_MEMORY_SCOPE_AGENT); }
__device__ __forceinline__ unsigned xb_xcc_id() { return (unsigned)__builtin_amdgcn_s_getreg((3 << 11) | 20) & 0xFu; }
#define XB_SPIN(cond, bar) do { unsigned _sp = 0; while (cond) { __builtin_amdgcn_s_sleep(1); \
    if ((++_sp & 255u) == 0u) { if (xb_ld(&(bar)[XB_TMO])) break; if (_sp > XB_SPIN_CAP) { atomicAdd(&(bar)[XB_TMO], 1u); break; } } } } while (0)
struct XcdBarrier { unsigned* bar; unsigned x; volatile LAS unsigned* st; };
__device__ __forceinline__ XcdBarrier xcd_barrier_post(unsigned* bar, volatile LAS unsigned* st) {
    XcdBarrier b; b.bar = bar; b.x = xb_xcc_id(); b.st = st;
    if (threadIdx.x == 0) (void)xb_add(&bar[XB_XCNT(b.x)], 1u);
    return b;
}
__device__ __forceinline__ void xcd_barrier_complete(unsigned* bar, unsigned x, unsigned& nloc, unsigned& nx) {
    const unsigned G = gridDim.x * gridDim.y * gridDim.z;
    unsigned sum, cnt, mine, sp = 0u;
    for (;;) {
        sum = 0u; cnt = 0u; mine = 0u;
#pragma unroll
        for (unsigned j = 0; j < 16; ++j) { const unsigned c = xb_ld(&bar[XB_XCNT(j)]); sum += c; cnt += (c > 0u) ? 1u : 0u; mine = (j == x) ? c : mine; }
        if (sum == G) break;
        __builtin_amdgcn_s_sleep(1);
        if ((++sp & 255u) == 0u) { if (xb_ld(&bar[XB_TMO])) break; if (sp > XB_SPIN_CAP) { atomicAdd(&bar[XB_TMO], 1u); break; } }
    }
    nloc = mine > 0u ? mine : 1u; nx = cnt > 0u ? cnt : 1u;
}
__device__ __forceinline__ void xcd_barrier(const XcdBarrier& b) {
    asm volatile("s_waitcnt vmcnt(0)" ::: "memory");
    __syncthreads();
    if (opaque_tid() == 0) {
        unsigned* bar = b.bar; unsigned bx = b.x;
        asm volatile("" : "+s"(bar), "+s"(bx));
        __builtin_amdgcn_s_waitcnt(0);
        unsigned nloc = b.st[0], nx = b.st[1];
        if (nloc == 0u) { xcd_barrier_complete(bar, bx, nloc, nx); b.st[0] = nloc; b.st[1] = nx; }
        const unsigned old = xb_add(&bar[XB_XSUB(bx)], 1u);
        const unsigned gen = old / nloc;
        if (old + 1u == (gen + 1u) * nloc) {
            __builtin_amdgcn_fence(__ATOMIC_RELEASE, "agent");
            asm volatile("s_waitcnt vmcnt(0)" ::: "memory");
            const unsigned og = xb_add(&bar[XB_TOP], 1u);
            const unsigned tg = og / nx;
            if (og + 1u == (tg + 1u) * nx) xb_add(&bar[XB_TOPGEN], 1u);
            else XB_SPIN(xb_ld(&bar[XB_TOPGEN]) == tg, bar);
            __builtin_amdgcn_fence(__ATOMIC_ACQUIRE, "agent");
            xb_add(&bar[XB_XGEN(bx)], 1u);
            asm volatile("s_waitcnt vmcnt(0)" ::: "memory");
        } else {
            XB_SPIN(xb_ld(&bar[XB_XGEN(bx)]) == gen, bar);
            __builtin_amdgcn_fence(__ATOMIC_ACQUIRE, "agent");
            asm volatile("s_waitcnt vmcnt(0)" ::: "memory");
        }
    }
    __syncthreads();
}

struct Args { const void* in[30]; float* out; unsigned char* ws; int ph_lo, ph_hi, li, pad; };
struct Ctx { int tid, lane, wave, vcu, G, bid; LAS unsigned char* lds; volatile LAS int* misc; };
__device__ __forceinline__ Ctx fresh_ctx(const Ctx& c) {
    Ctx r = c; unsigned l = (unsigned)(uintptr_t)c.lds, m = (unsigned)(uintptr_t)c.misc;
    asm volatile("" : "+s"(r.wave), "+s"(r.vcu), "+s"(r.G), "+s"(r.bid), "+s"(l), "+s"(m));
    r.lds = (LAS unsigned char*)(uintptr_t)l; r.misc = (volatile LAS int*)(uintptr_t)m; r.tid = opaque_tid(); r.lane = r.tid & 63; return r; }
typedef const CAS Args* ArgsP;
__device__ __forceinline__ const CAS Args& fresh_args(ArgsP p) { asm volatile("" : "+s"(p)); return *p; }
enum { I_X = 0, I_P, I_POS, I_MLA_WIN, I_MLA_QN, I_MLA_KVN, I_MLA_WUQ, I_MLA_WUKV, I_MLA_WO, I_LRU_WIN, I_LRU_CW, I_LRU_CB, I_LRU_WA, I_LRU_BA, I_LRU_WX, I_LRU_BX, I_LRU_LAM, I_LRU_WOUT,
       I_LN1G, I_LN1B, I_LN2G, I_LN2B, I_MOE_WR, I_MOE_BR, I_MOE_WUP, I_MOE_BUP, I_MOE_WDN, I_MOE_BDN, I_PLE_WG, I_PLE_WP };
#define INF(i) ((const float*)args.in[i])
#define WSP(T_, off) ((T_*)(args.ws + (off)))

__device__ __forceinline__ void tr_load(const float* W, int ld, int k0, int sc0, int sc1, int lane, f32x4 (&v)[16]) {
    const int half = (lane & 15) >> 3, scol = half ? sc1 : sc0, c4 = (lane & 7) * 4, rs = lane >> 4;
#pragma unroll
    for (int i = 0; i < 8; ++i) { const float* p = W + (size_t)(k0 + 8 * i + 2 * rs) * ld + scol + c4;
        v[2 * i] = (scol >= 0) ? *(const f32x4*)p : (f32x4){0.f, 0.f, 0.f, 0.f}; v[2 * i + 1] = (scol >= 0) ? *(const f32x4*)(p + ld) : (f32x4){0.f, 0.f, 0.f, 0.f}; }
}
__device__ __forceinline__ void tr_store(f32x4 (&v)[16], const float* ksc, int k0, bf16_t* dst  , int K, LAS unsigned* scr, int lane) {
    const int rs = lane >> 4;
    if (ksc) {
#pragma unroll
        for (int i = 0; i < 8; ++i) { v[2 * i] = v[2 * i] * ksc[k0 + 8 * i + 2 * rs]; v[2 * i + 1] = v[2 * i + 1] * ksc[k0 + 8 * i + 2 * rs + 1]; } }
#pragma unroll
    for (int i = 0; i < 8; ++i) { LAS unsigned* s = scr + (4 * i + rs) * 65 + (lane & 15) * 4;
#pragma unroll
        for (int e = 0; e < 4; ++e) s[e] = cvt_pk_bf16(v[2 * i][e], v[2 * i + 1][e]); }
    asm volatile("s_waitcnt lgkmcnt(0)" ::: "memory");
    const int c = lane & 7;
#pragma unroll
    for (int j = 0; j < 8; ++j) { const int n = (lane >> 3) + 8 * j; const LAS unsigned* s = scr + (4 * c) * 65 + n;
        u32x4 o; o.x = s[0]; o.y = s[65]; o.z = s[130]; o.w = s[195];
        *(u32x4*)(dst + (size_t)n * K + 8 * c) = o; }
    asm volatile("s_waitcnt lgkmcnt(0)" ::: "memory");
}
enum { J_NAT = 0, J_MLA_WIN, J_MLA_WUQ, J_LRU_WAX, J_MOE_UP };
__device__ __forceinline__ int tr_map(int job, int g) {
    switch (job) {
    case J_MLA_WIN: return g < 32 ? 32 * g : (g == 32 ? 1024 : (g == 36 ? 1056 : -1));
    case J_MLA_WUQ: if (g < 32) { const int t = g >> 3, bj = (g >> 2) & 1, cg = g & 3; return (2 * t + bj) * 192 + 32 * cg; }
                    else { const int g2 = g - 32, t2 = g2 >> 3, bj = (g2 >> 2) & 1, hh = g2 & 3; return (4 * t2 + hh) * 192 + 128 + 32 * bj; }
    case J_LRU_WAX: { const int pn = g >> 3, cg = g & 3; return 128 * pn + 32 * cg; }
    case J_MOE_UP:  { const int pn = g >> 3, bj = (g >> 2) & 1, cg = g & 3; return bj * 1024 + 128 * pn + 32 * cg; }
    default: return 32 * g;
    }
}
__device__ __forceinline__ void tr_job(const Ctx& C, int job, const float* src, size_t srcstride, int nmat, int K, int ld, int N, bf16_t* dst, size_t dststride, const float* ksc, int kscstride,
                                       const float* src2  ) {
    LAS unsigned* scr = (LAS unsigned*)(C.lds + C.wave * 8320);
    const int gw = C.vcu * NWAVES + C.wave, NGW = C.G * NWAVES;
    const int nkb = K / 64, nnb = N / 64, per = nkb * nnb, total = per * nmat;
#define TR_DECODE(it_, W_, k0_, s0_, s1_, ks_, d_) do { const int mat_ = (it_) / per, r_ = (it_) - mat_ * per, kb_ = r_ / nnb, nb_ = r_ - kb_ * nnb; \
        s0_ = tr_map(job, 2 * nb_); s1_ = tr_map(job, 2 * nb_ + 1); W_ = src + (size_t)mat_ * srcstride; \
        if (job == J_LRU_WAX && ((nb_ >> 1) & 1)) W_ = src2 + (size_t)mat_ * srcstride;       \
        k0_ = kb_ * 64; ks_ = ksc ? ksc + (size_t)mat_ * kscstride : nullptr; d_ = (bf16_t*)((char*)dst + (size_t)mat_ * dststride) + (size_t)(nb_ * 64) * K + kb_ * 64; } while (0)
    f32x4 va[16], vb[16];
    int it = gw; const float* Wc; int k0c, s0c, s1c; const float* ksc_c; bf16_t* dc;
    if (it < total) { TR_DECODE(it, Wc, k0c, s0c, s1c, ksc_c, dc); tr_load(Wc, ld, k0c, s0c, s1c, C.lane, va); }
    while (it < total) {
        const int nit = it + NGW; const float* Wn = nullptr; int k0n = 0, s0n = 0, s1n = 0; const float* ksc_n = nullptr; bf16_t* dn = nullptr;
        if (nit < total) { TR_DECODE(nit, Wn, k0n, s0n, s1n, ksc_n, dn); tr_load(Wn, ld, k0n, s0n, s1n, C.lane, vb); }
        tr_store(va, ksc_c, k0c, dc, K, scr, C.lane);
#pragma unroll
        for (int i = 0; i < 16; ++i) va[i] = vb[i];
        it = nit; k0c = k0n; ksc_c = ksc_n; dc = dn;
    }
#undef TR_DECODE
}
template <int JOB, int N, bool G64  >
__device__ __forceinline__ void tr_job_fp8(const Ctx& C, const float* src, size_t srcstride, int nmat, unsigned char* dst, size_t dststride, unsigned char* SW) {
    constexpr int K = 1024, ld = N;
    LAS float* scr = (LAS float*)(C.lds + C.wave * 16640);
    const int gw = C.vcu * NWAVES + C.wave, NGW = C.G * NWAVES, lane = C.lane;
    const int nkb = K / 64, nnb = N / 64, per = nkb * nnb, total = per * nmat;
    f32x4 v[16], vn[16];
    if (gw < total) { const int mat = gw / per, r = gw - mat * per, kb = r / nnb, nb = r - kb * nnb; tr_load(src + (size_t)mat * srcstride, ld, kb * 64, tr_map(JOB, 2 * nb), tr_map(JOB, 2 * nb + 1), lane, v); }
    for (int it = gw; it < total; it += NGW) {
        const int mat = it / per, r = it - mat * per, kb = r / nnb, nb = r - kb * nnb;
        { const int nit = it + NGW; if (nit < total) { const int matn = nit / per, rn = nit - matn * per, kbn = rn / nnb, nbn = rn - kbn * nnb; tr_load(src + (size_t)matn * srcstride, ld, kbn * 64, tr_map(JOB, 2 * nbn), tr_map(JOB, 2 * nbn + 1), lane, vn); } }
        const int rs = lane >> 4;
#pragma unroll
        for (int i = 0; i < 8; ++i) { LAS float* sp = scr + (8 * i + 2 * rs) * 65 + (lane & 15) * 4;
#pragma unroll
            for (int e = 0; e < 4; ++e) { sp[e] = v[2 * i][e]; sp[65 + e] = v[2 * i + 1][e]; } }
        asm volatile("s_waitcnt lgkmcnt(0)" ::: "memory");
        const int c = lane & 7;
#pragma unroll
        for (int j = 0; j < 8; ++j) { const int n = (lane >> 3) + 8 * j; const LAS float* sp = scr + (8 * c) * 65 + n;
            float x[8]; float am = 0.f;
#pragma unroll
            for (int q = 0; q < 8; ++q) { x[q] = sp[q * 65]; am = fmaxf(am, fabsf(x[q])); }
            am = fmaxf(am, __shfl_xor(am, 1)); am = fmaxf(am, __shfl_xor(am, 2));
            if (G64) am = fmaxf(am, __shfl_xor(am, 4));
            int eb = (int)((__float_as_uint(am) >> 23) & 0xffu) - 7; eb = eb < 1 ? 1 : eb;
            const float inv = __uint_as_float((unsigned)(254 - eb) << 23);
            int w0 = __builtin_amdgcn_cvt_pk_fp8_f32(x[0] * inv, x[1] * inv, 0, false); w0 = __builtin_amdgcn_cvt_pk_fp8_f32(x[2] * inv, x[3] * inv, w0, true);
            int w1 = __builtin_amdgcn_cvt_pk_fp8_f32(x[4] * inv, x[5] * inv, 0, false); w1 = __builtin_amdgcn_cvt_pk_fp8_f32(x[6] * inv, x[7] * inv, w1, true);
            const int nrow = nb * 64 + n;
            *(u32x2*)(dst + (size_t)mat * dststride + (size_t)nrow * K + kb * 64 + 8 * c) = (u32x2){(unsigned)w0, (unsigned)w1};
            if (!G64) { if ((c & 3) == 0) SW[(size_t)mat * 65536 + (size_t)(nrow >> 8) * 8192 + (size_t)(kb >> 1) * 1024 + (nrow & 255) * 4 + 2 * (kb & 1) + (c >> 2)] = (unsigned char)eb; }
            else { if (c == 0) SW[(size_t)mat * 16384 + (size_t)(nrow >> 8) * 4096 + (size_t)(kb >> 1) * 512 + (nrow & 255) * 2 + (kb & 1)] = (unsigned char)eb; } }
        asm volatile("s_waitcnt lgkmcnt(0)" ::: "memory");
#pragma unroll
        for (int i = 0; i < 16; ++i) v[i] = vn[i];
    }
}
__device__ __forceinline__ void cvt_rows(const Ctx& C, const float* src, bf16_t* dst, size_t n8  ) {
    const size_t gt = (size_t)C.vcu * 512 + C.tid, NT = (size_t)C.G * 512;
    size_t i = gt;
    for (; i + 3 * NT < n8; i += 4 * NT) {
        f32x4 a[4], b[4];
#pragma unroll
        for (int q = 0; q < 4; ++q) { a[q] = *(const f32x4*)(src + (i + q * NT) * 8); b[q] = *(const f32x4*)(src + (i + q * NT) * 8 + 4); }
#pragma unroll
        for (int q = 0; q < 4; ++q) *(u32x4*)(dst + (i + q * NT) * 8) = pack8(a[q], b[q]); }
    for (; i < n8; i += NT) { const f32x4 a = *(const f32x4*)(src + i * 8), b = *(const f32x4*)(src + i * 8 + 4); *(u32x4*)(dst + i * 8) = pack8(a, b); }
}
__device__ __forceinline__ void phase_prologue(const CAS Args& args, const Ctx& C) {
    tr_job(C, J_MLA_WIN, INF(I_MLA_WIN), (size_t)DM * LATD, 2, DM, LATD, 1280, WSP(bf16_t, WS_W_MLA + OFF_MLA_WIN), W_MLA_STRIDE, nullptr, 0, nullptr);
    tr_job(C, J_MLA_WUQ, INF(I_MLA_WUQ), (size_t)QL * 1536, 2, QL, 1536, 1536, WSP(bf16_t, WS_W_MLA + OFF_MLA_WUQ), W_MLA_STRIDE, INF(I_MLA_QN), QL, nullptr);
    tr_job(C, J_NAT, INF(I_MLA_WUKV), (size_t)KVL * 2048, 2, KVL, 2048, 2048, WSP(bf16_t, WS_W_MLA + OFF_MLA_WUKV), W_MLA_STRIDE, INF(I_MLA_KVN), KVL, nullptr);
    tr_job(C, J_NAT, INF(I_MLA_WO), (size_t)DM * DM, 2, DM, DM, DM, WSP(bf16_t, WS_W_MLA + OFF_MLA_WO), W_MLA_STRIDE, nullptr, 0, nullptr);
    tr_job(C, J_NAT, INF(I_LRU_WIN), (size_t)DM * 2048, 2, DM, 2048, 2048, WSP(bf16_t, WS_W_LRU + OFF_LRU_WIN), W_LRU_STRIDE, nullptr, 0, nullptr);
    for (int j = 0; j < 2; ++j)
        tr_job(C, J_LRU_WAX, INF(I_LRU_WA) + (size_t)j * 4 * 65536, (size_t)256 * 256, 4, 256, 256, 512, WSP(bf16_t, WS_W_LRU + OFF_LRU_WAX + (size_t)j * W_LRU_STRIDE), (size_t)512 * 256 * 2, nullptr, 0, INF(I_LRU_WX) + (size_t)j * 4 * 65536);
    tr_job(C, J_NAT, INF(I_LRU_WOUT), (size_t)DM * DM, 2, DM, DM, DM, WSP(bf16_t, WS_W_LRU + OFF_LRU_WOUT), W_LRU_STRIDE, nullptr, 0, nullptr);
    tr_job(C, J_NAT, INF(I_PLE_WG), (size_t)DM * DM, 4, DM, DM, DM, WSP(bf16_t, WS_W_PLE + OFF_PLE_WG), W_PLE_STRIDE, nullptr, 0, nullptr);
    tr_job(C, J_NAT, INF(I_PLE_WP), (size_t)PLED * DM, 4, PLED, DM, DM, WSP(bf16_t, WS_W_PLE + OFF_PLE_WP), W_PLE_STRIDE, nullptr, 0, nullptr);
    __syncthreads();
    tr_job_fp8<J_MOE_UP, 2048, false>(C, INF(I_MOE_WUP), (size_t)DM * 2048, DEPTH * NE, args.ws + WS_W_UP, (size_t)2048 * 1024, args.ws + WS_SW);
    tr_job_fp8<J_NAT, 1024, true>(C, INF(I_MOE_WDN), (size_t)DFF * DM, DEPTH * NE, args.ws + WS_W_DN, (size_t)1024 * 1024, args.ws + WS_SWD);
    __syncthreads();
    cvt_rows(C, INF(I_X), WSP(bf16_t, WS_XB), (size_t)T * DM / 8);
    cvt_rows(C, INF(I_P), WSP(bf16_t, WS_PB), (size_t)DEPTH * T * PLED / 8);
    { const int* pos = (const int*)args.in[I_POS]; float* CS = WSP(float, WS_CS); float* SN = WSP(float, WS_SN);
      const size_t gt = (size_t)C.vcu * 512 + C.tid, NT = (size_t)C.G * 512;
      for (size_t i = gt; i < (size_t)T * 32; i += NT) { const int tok = (int)(i >> 5), j = (int)(i & 31);
          const double inv = exp(-9.210340371976184 * (double)j / 32.0); const double ang = (double)pos[tok] * inv; double s, c; sincos(ang, &s, &c); CS[i] = (float)c; SN[i] = (float)s; }
      { const float* wr = INF(I_MOE_WR); const float* lg1 = INF(I_LN1G); bf16_t* WRH = WSP(bf16_t, WS_WRH); bf16_t* WRL = WSP(bf16_t, WS_WRL);
        for (size_t i = gt; i < (size_t)DEPTH * 64 * 64; i += NT) { const int l = (int)(i >> 12), st = (int)(i >> 6) & 63, ln = (int)i & 63; float w[8], lo[8];
#pragma unroll
            for (int j = 0; j < 8; ++j) { const int k = 16 * st + 8 * (ln >> 5) + j; w[j] = lg1[l * DM + k] * wr[((size_t)l * DM + k) * NE + (ln & 31)]; }
            u32x4 h; h.x = cvt_pk_bf16(w[0], w[1]); h.y = cvt_pk_bf16(w[2], w[3]); h.z = cvt_pk_bf16(w[4], w[5]); h.w = cvt_pk_bf16(w[6], w[7]);
            lo[0] = w[0] - bf_lo(h.x); lo[1] = w[1] - bf_hi(h.x); lo[2] = w[2] - bf_lo(h.y); lo[3] = w[3] - bf_hi(h.y); lo[4] = w[4] - bf_lo(h.z); lo[5] = w[5] - bf_hi(h.z); lo[6] = w[6] - bf_lo(h.w); lo[7] = w[7] - bf_hi(h.w);
            u32x4 q; q.x = cvt_pk_bf16(lo[0], lo[1]); q.y = cvt_pk_bf16(lo[2], lo[3]); q.z = cvt_pk_bf16(lo[4], lo[5]); q.w = cvt_pk_bf16(lo[6], lo[7]);
            *(u32x4*)(WRH + i * 8) = h; *(u32x4*)(WRL + i * 8) = q; }
        float* RC = WSP(float, WS_RC); const float* lb1 = INF(I_LN1B); const float* rb = INF(I_MOE_BR);
        for (size_t i = gt; i < (size_t)DEPTH * NE; i += NT) { const int l = (int)(i >> 5), e = (int)i & 31; float c1 = 0.f, c2 = 0.f;
            for (int k = 0; k < DM; ++k) { const float w = wr[((size_t)l * DM + k) * NE + e]; c1 = fmaf(lg1[l * DM + k], w, c1); c2 = fmaf(lb1[l * DM + k], w, c2); }
            RC[l * 64 + e] = c1; RC[l * 64 + 32 + e] = c2 + rb[l * NE + e]; } }
      float* SPL = WSP(float, WS_SPL); const float* lam = INF(I_LRU_LAM);
      for (size_t i = gt; i < 2 * 1024; i += NT) { const double l = (double)lam[i]; SPL[i] = (float)(-8.0 * log1p(exp(-l))); } }
}

__device__ __forceinline__ void moe_table(const CAS Args& args, const Ctx& C0, int layer) {
    Ctx C = C0; C.tid = opaque_tid(); C.lane = C.tid & 63;
    const unsigned* cnt = WSP(unsigned, WS_CTL) + CW_CNT + 64 * layer;
    __syncthreads();
    if (C.tid < 32) C.misc[64 + C.tid] = (int)__hip_atomic_load(cnt + C.tid, __ATOMIC_RELAXED, __HIP_MEMORY_SCOPE_AGENT);
    __syncthreads();
    if (C.tid == 0) { int acc = 0; for (int e = 0; e < 32; ++e) { C.misc[16 + e] = acc; acc += (C.misc[64 + e] + 255) >> 8; } C.misc[16 + 32] = acc; }
    __syncthreads();
    { volatile LAS unsigned char* te = (volatile LAS unsigned char*)(C.lds + TILE_E_OFF);
      for (int mg = C.tid; mg < C.misc[48]; mg += NWAVES * 64) { int e = 0; for (int j = 1; j < 32; ++j) e += (C.misc[16 + j] <= mg) ? 1 : 0; te[mg] = (unsigned char)e; } }
    __syncthreads();
}

__device__ __forceinline__ void phase_ln_router(const CAS Args& args, const Ctx& C0, int layer) {
    const int cslot = layer + args.pad;
    Ctx C = C0; C.tid = opaque_tid(); C.lane = C.tid & 63;
    const bf16_t* Y = WSP(bf16_t, WS_Y); bf16_t* X1B = WSP(bf16_t, WS_X1B);
    const float* g1 = INF(I_LN1G) + layer * DM; const float* b1 = INF(I_LN1B) + layer * DM;
    const bf16_t* WRH = WSP(bf16_t, WS_WRH) + (size_t)layer * 64 * 64 * 8; const bf16_t* WRL = WSP(bf16_t, WS_WRL) + (size_t)layer * 64 * 64 * 8; const float* rc = WSP(float, WS_RC) + layer * 64;
    unsigned* gcnt = WSP(unsigned, WS_CTL) + CW_CNT + 64 * cslot;
    int* lists = WSP(int, WS_LIST); int* slot = WSP(int, WS_SLOT); float* gate = WSP(float, WS_GATE);
    LAS float* part = (LAS float*)C.lds;
    volatile LAS int* lcnt = (volatile LAS int*)(C.lds + 69632);
    volatile LAS int* lbase = lcnt + 32;
    LAS float* stat = (LAS float*)(C.lds + 70144);
    f32x4 gv[4], bv[4];
#pragma unroll
    for (int j = 0; j < 2; ++j) { gv[2 * j] = *(const f32x4*)(g1 + 8 * C.lane + 512 * j); gv[2 * j + 1] = *(const f32x4*)(g1 + 8 * C.lane + 512 * j + 4);
        bv[2 * j] = *(const f32x4*)(b1 + 8 * C.lane + 512 * j); bv[2 * j + 1] = *(const f32x4*)(b1 + 8 * C.lane + 512 * j + 4); }
    unsigned char* X1Q = args.ws + WS_X1Q; int sexp;
    { float ag = 0.f, ab = 0.f;
#pragma unroll
      for (int j = 0; j < 4; ++j)
#pragma unroll
          for (int e = 0; e < 4; ++e) { ag = fmaxf(ag, fabsf(gv[j][e])); ab = fmaxf(ab, fabsf(bv[j][e])); }
#pragma unroll
      for (int o = 1; o < 64; o <<= 1) { ag = fmaxf(ag, __shfl_xor(ag, o)); ab = fmaxf(ab, __shfl_xor(ab, o)); }
      const float bound = 16.0f * ag + ab + 1e-20f;
      sexp = 134 - (int)((__float_as_uint(bound) >> 23) & 0xffu);
      sexp = sexp < -100 ? -100 : (sexp > 100 ? 100 : sexp);
      if (C.tid == 0) __hip_atomic_store(WSP(unsigned, WS_CTL) + CW_SA + layer, (unsigned)sexp, __ATOMIC_RELAXED, __HIP_MEMORY_SCOPE_AGENT); }
    const float qs = __uint_as_float((unsigned)(127 + sexp) << 23), qlo = KF(-448.f), qhi = KF(448.f);
    for (int chunk = C.vcu; chunk < T / 128; chunk += C.G) {
        const int row0 = chunk * 128;
        if (C.tid < 32) lcnt[C.tid] = 0;
        u32x4 yn[2];
#pragma unroll
        for (int j = 0; j < 2; ++j) yn[j] = *(const u32x4*)(Y + ((size_t)row0 + C.wave * 16) * DM + 8 * C.lane + 512 * j);
#pragma unroll 1
        for (int i = 0; i < 16; ++i) { const size_t row = (size_t)row0 + C.wave * 16 + i;
            f32x4 v[4]; float s = 0.f;
#pragma unroll
            for (int j = 0; j < 2; ++j) { const u32x4 w = yn[j]; v[2 * j] = pg8::bf4_lo(w); v[2 * j + 1] = pg8::bf4_hi(w); }
            { const size_t rn = i < 15 ? row + 1 : row;
#pragma unroll
              for (int j = 0; j < 2; ++j) yn[j] = *(const u32x4*)(Y + rn * DM + 8 * C.lane + 512 * j); }
#pragma unroll
            for (int j = 0; j < 4; ++j) s += (v[j][0] + v[j][1]) + (v[j][2] + v[j][3]);
            const float mean = wave_sum(s) * (1.f / DM); float s2 = 0.f;
#pragma unroll
            for (int j = 0; j < 4; ++j) { v[j] = v[j] - mean; s2 += (v[j][0] * v[j][0] + v[j][1] * v[j][1]) + (v[j][2] * v[j][2] + v[j][3] * v[j][3]); }
            const float rstd = 1.f / sqrtf(wave_sum(s2) * (1.f / DM) + KF(LN_EPS));
            if (C.lane == 0) { stat[(C.wave * 16 + i) * 2] = mean; stat[(C.wave * 16 + i) * 2 + 1] = rstd; }
#pragma unroll
            for (int j = 0; j < 4; ++j) v[j] = v[j] * rstd * gv[j] + bv[j];
#pragma unroll
            for (int j = 0; j < 2; ++j) { const u32x4 hw = pack8(v[2 * j], v[2 * j + 1]);
                *(u32x4*)(X1B + row * DM + 8 * C.lane + 512 * j) = hw;
                const f32x4 q0 = v[2 * j] * qs, q1 = v[2 * j + 1] * qs;
                int w0 = __builtin_amdgcn_cvt_pk_fp8_f32(fminf(fmaxf(q0[0], qlo), qhi), fminf(fmaxf(q0[1], qlo), qhi), 0, false); w0 = __builtin_amdgcn_cvt_pk_fp8_f32(fminf(fmaxf(q0[2], qlo), qhi), fminf(fmaxf(q0[3], qlo), qhi), w0, true);
                int w1 = __builtin_amdgcn_cvt_pk_fp8_f32(fminf(fmaxf(q1[0], qlo), qhi), fminf(fmaxf(q1[1], qlo), qhi), 0, false); w1 = __builtin_amdgcn_cvt_pk_fp8_f32(fminf(fmaxf(q1[2], qlo), qhi), fminf(fmaxf(q1[3], qlo), qhi), w1, true);
                *(u32x2*)(X1Q + row * DM + 8 * C.lane + 512 * j) = (u32x2){(unsigned)w0, (unsigned)w1}; } }
        asm volatile("s_waitcnt vmcnt(0)" ::: "memory");
        __syncthreads();
        { const int grp = C.wave >> 1, kh = C.wave & 1, r32 = C.lane & 31, hi = C.lane >> 5;
          const bf16_t* ah = Y + ((size_t)row0 + grp * 32 + r32) * DM + kh * 512 + hi * 8;
          const bf16_t* bh = WRH + ((size_t)kh * 32 * 64 + C.lane) * 8; const bf16_t* bl = WRL + ((size_t)kh * 32 * 64 + C.lane) * 8;
          f32x16 acc = {};
#pragma unroll 4
          for (int st = 0; st < 32; ++st) { const bf16x8 xh = *(const bf16x8*)(ah + st * 16), wh = *(const bf16x8*)(bh + (size_t)st * 512), wl = *(const bf16x8*)(bl + (size_t)st * 512);
              acc = __builtin_amdgcn_mfma_f32_32x32x16_bf16(xh, wh, acc, 0, 0, 0);
              acc = __builtin_amdgcn_mfma_f32_32x32x16_bf16(xh, wl, acc, 0, 0, 0); }
          LAS float* pp = part + (grp * 2 + kh) * 32 * 33 + r32;
#pragma unroll
          for (int r = 0; r < 16; ++r) pp[((r & 3) + 8 * (r >> 2) + 4 * hi) * 33] = acc[r]; }
        __syncthreads();
        int te[4] = {0, 0, 0, 0}, lp[4] = {0, 0, 0, 0}; float tg[4] = {0.f, 0.f, 0.f, 0.f};
        if (C.tid < 128) { const int grp = C.tid >> 5, ln = C.tid & 31; float lg[32];
            const float mean = stat[C.tid * 2], rstd = stat[C.tid * 2 + 1];
#pragma unroll
            for (int e = 0; e < 32; ++e) lg[e] = rstd * ((part[((grp * 2 + 0) * 32 + ln) * 33 + e] + part[((grp * 2 + 1) * 32 + ln) * 33 + e]) - mean * rc[e]) + rc[32 + e];
            float tv[4]; const float kninf = KF(-__builtin_inff());
#pragma unroll
            for (int k = 0; k < 4; ++k) { float best = lg[0]; int bi = 0;
#pragma unroll
                for (int e = 1; e < 32; ++e) { const bool gt = lg[e] > best; best = gt ? lg[e] : best; bi = gt ? e : bi; }
                te[k] = bi; tv[k] = best;
#pragma unroll
                for (int e = 0; e < 32; ++e) lg[e] = (e == bi) ? kninf : lg[e]; }
            float den = 0.f;
#pragma unroll
            for (int k = 0; k < 4; ++k) { tg[k] = __expf(tv[k] - tv[0]); den += tg[k]; }
            const float rden = 1.0f / den;
#pragma unroll
            for (int k = 0; k < 4; ++k) { tg[k] *= rden; lp[k] = __hip_atomic_fetch_add((LAS int*)&lcnt[te[k]], 1, __ATOMIC_RELAXED, __HIP_MEMORY_SCOPE_WORKGROUP); } }
        __syncthreads();
        if (C.tid < 32) lbase[C.tid] = (int)__hip_atomic_fetch_add(gcnt + C.tid, (unsigned)lcnt[C.tid], __ATOMIC_RELAXED, __HIP_MEMORY_SCOPE_AGENT);
        __syncthreads();
        if (C.tid < 128) { const int tok = row0 + C.tid;
#pragma unroll
            for (int k = 0; k < 4; ++k) { const int pos = lbase[te[k]] + lp[k]; lists[(size_t)te[k] * T + pos] = tok; slot[tok * 4 + k] = te[k] * T + pos; gate[tok * 4 + k] = tg[k]; } }
        __syncthreads();
    }
}

__device__ __forceinline__ void phase_combine_ln2(const CAS Args& args, const Ctx& C0, int layer) {
    Ctx C = C0; C.tid = opaque_tid(); C.lane = C.tid & 63;
    moe_table(args, C, layer);
    const bf16_t* X1B = WSP(bf16_t, WS_X1B); const unsigned char* YS = args.ws + WS_YS; const unsigned char* SY = args.ws + WS_SY; const int* slot = WSP(int, WS_SLOT); const float* gate = WSP(float, WS_GATE);
    bf16_t* X2B = WSP(bf16_t, WS_X2B);
    const float* g2 = INF(I_LN2G) + layer * DM; const float* b2 = INF(I_LN2B) + layer * DM;
    f32x4 gv[4], bv[4];
#pragma unroll
    for (int j = 0; j < 2; ++j) { gv[2 * j] = *(const f32x4*)(g2 + 8 * C.lane + 512 * j); gv[2 * j + 1] = *(const f32x4*)(g2 + 8 * C.lane + 512 * j + 4);
        bv[2 * j] = *(const f32x4*)(b2 + 8 * C.lane + 512 * j); bv[2 * j + 1] = *(const f32x4*)(b2 + 8 * C.lane + 512 * j + 4); }
    const int gw = C.vcu * NWAVES + C.wave, NGW = C.G * NWAVES;
    for (int row = gw; row < T; row += 2 * NGW) {
        int sv[2][4]; float gt[2][4];
#pragma unroll
        for (int q = 0; q < 2; ++q) { const int r = (row + q * NGW < T) ? row + q * NGW : row;
#pragma unroll
            for (int k = 0; k < 4; ++k) { sv[q][k] = slot[r * 4 + k]; gt[q][k] = gate[r * 4 + k]; } }
        u32x4 xw[2][2]; u32x2 yw[2][4][2]; unsigned eb[2][4][2];
#pragma unroll
        for (int q = 0; q < 2; ++q) { const int r = (row + q * NGW < T) ? row + q * NGW : row;
#pragma unroll
            for (int j = 0; j < 2; ++j) xw[q][j] = *(const u32x4*)(X1B + (size_t)r * DM + 8 * C.lane + 512 * j);
#pragma unroll
            for (int k = 0; k < 4; ++k) { const int e = sv[q][k] >> 15, pos = sv[q][k] & (T - 1); const size_t prow = (size_t)C.misc[16 + e] * 256 + pos;
#pragma unroll
                for (int j = 0; j < 2; ++j) { yw[q][k][j] = *(const u32x2*)(YS + prow * DM + 8 * C.lane + 512 * j); eb[q][k][j] = SY[prow * 32 + (C.lane >> 2) + 16 * j]; } } }
#pragma unroll
        for (int q = 0; q < 2; ++q) { const int r = row + q * NGW; if (r >= T) break;
            f32x4 v[4];
#pragma unroll
            for (int j = 0; j < 2; ++j) { v[2 * j] = pg8::bf4_lo(xw[q][j]) * ALPHA; v[2 * j + 1] = pg8::bf4_hi(xw[q][j]) * ALPHA; }
#pragma unroll
            for (int k = 0; k < 4; ++k)
#pragma unroll
                for (int j = 0; j < 2; ++j) { const u32x2 w = yw[q][k][j]; const float gs = gt[q][k] * __uint_as_float(eb[q][k][j] << 23);
                    const f32x2 a = __builtin_amdgcn_cvt_pk_f32_fp8((int)w.x, false), b = __builtin_amdgcn_cvt_pk_f32_fp8((int)w.x, true), c = __builtin_amdgcn_cvt_pk_f32_fp8((int)w.y, false), d = __builtin_amdgcn_cvt_pk_f32_fp8((int)w.y, true);
                    v[2 * j] += (f32x4){a[0], a[1], b[0], b[1]} * gs; v[2 * j + 1] += (f32x4){c[0], c[1], d[0], d[1]} * gs; }
            float s = 0.f;
#pragma unroll
            for (int j = 0; j < 4; ++j) s += (v[j][0] + v[j][1]) + (v[j][2] + v[j][3]);
            const float mean = wave_sum(s) * (1.f / DM); float s2 = 0.f;
#pragma unroll
            for (int j = 0; j < 4; ++j) { v[j] = v[j] - mean; s2 += (v[j][0] * v[j][0] + v[j][1] * v[j][1]) + (v[j][2] * v[j][2] + v[j][3] * v[j][3]); }
            const float rstd = 1.f / sqrtf(wave_sum(s2) * (1.f / DM) + KF(LN_EPS));
#pragma unroll
            for (int j = 0; j < 4; ++j) v[j] = v[j] * rstd * gv[j] + bv[j];
#pragma unroll
            for (int j = 0; j < 2; ++j) *(u32x4*)(X2B + (size_t)r * DM + 8 * C.lane + 512 * j) = pack8(v[2 * j], v[2 * j + 1]); }
    }
}

__device__ __forceinline__ void phase_conv(const CAS Args& args, const Ctx& C0, int j) {
    Ctx C = C0; C.tid = opaque_tid(); C.lane = C.tid & 63;
    const bf16_t* U = WSP(bf16_t, WS_U); bf16_t* UC = WSP(bf16_t, WS_UC);
    const float* cw = INF(I_LRU_CW) + (size_t)j * 4 * DM; const float* cb = INF(I_LRU_CB) + (size_t)j * DM;
    const int c8 = (C.tid & 127) * 8, rsub = C.tid >> 7;
    float w[4][8], bb[8];
#pragma unroll
    for (int q = 0; q < 4; ++q)
#pragma unroll
        for (int e = 0; e < 8; ++e) w[q][e] = cw[q * DM + c8 + e];
#pragma unroll
    for (int e = 0; e < 8; ++e) bb[e] = cb[c8 + e];
    for (int chunk = C.vcu; chunk < T / 128; chunk += C.G) {
        const int r0 = chunk * 128 + rsub * 32;
        u32x4 h0, h1, h2;
        const u32x4 z = {0u, 0u, 0u, 0u};
        const int s0 = r0 & (SEQ - 1);
        h0 = s0 >= 3 ? *(const u32x4*)(U + (size_t)(r0 - 3) * DM + c8) : z; h1 = s0 >= 2 ? *(const u32x4*)(U + (size_t)(r0 - 2) * DM + c8) : z; h2 = s0 >= 1 ? *(const u32x4*)(U + (size_t)(r0 - 1) * DM + c8) : z;
#pragma unroll 4
        for (int i = 0; i < 32; ++i) { const u32x4 h3 = *(const u32x4*)(U + (size_t)(r0 + i) * DM + c8);
            float o[8];
#pragma unroll
            for (int q = 0; q < 4; ++q) { const unsigned a = h0[q], b = h1[q], c = h2[q], d = h3[q];
                o[2 * q] = bb[2 * q] + w[0][2 * q] * bf_lo(a) + w[1][2 * q] * bf_lo(b) + w[2][2 * q] * bf_lo(c) + w[3][2 * q] * bf_lo(d);
                o[2 * q + 1] = bb[2 * q + 1] + w[0][2 * q + 1] * bf_hi(a) + w[1][2 * q + 1] * bf_hi(b) + w[2][2 * q + 1] * bf_hi(c) + w[3][2 * q + 1] * bf_hi(d); }
            u32x4 ow; ow.x = cvt_pk_bf16(o[0], o[1]); ow.y = cvt_pk_bf16(o[2], o[3]); ow.z = cvt_pk_bf16(o[4], o[5]); ow.w = cvt_pk_bf16(o[6], o[7]);
            *(u32x4*)(UC + (size_t)(r0 + i) * DM + c8) = ow; h0 = h1; h1 = h2; h2 = h3; }
    }
}
__device__ __forceinline__ void phase_scan1(const CAS Args& args, const Ctx& C0) {
    Ctx C = C0; C.tid = opaque_tid(); C.lane = C.tid & 63;
    const bf16_t* LA = WSP(bf16_t, WS_AA); const bf16_t* BB = WSP(bf16_t, WS_BB); float* CA = WSP(float, WS_CA); float* CH = WSP(float, WS_CH);
    const int c2 = C.tid * 2;
    for (int item = C.vcu; item < NBATCH * 64; item += C.G) {
        const size_t r0 = (size_t)item * 64; float h0 = 0.f, h1 = 0.f, l0 = 0.f, l1 = 0.f;
#pragma unroll 8
        for (int s = 0; s < 64; ++s) { const unsigned aw = *(const unsigned*)(LA + (r0 + s) * DM + c2), bw = *(const unsigned*)(BB + (r0 + s) * DM + c2);
            const float la0 = bf_lo(aw), la1 = bf_hi(aw);
            h0 = __builtin_amdgcn_exp2f(la0) * h0 + bf_lo(bw); h1 = __builtin_amdgcn_exp2f(la1) * h1 + bf_hi(bw); l0 += la0; l1 += la1; }
        *(f32x2*)(CA + (size_t)item * DM + c2) = (f32x2){__builtin_amdgcn_exp2f(l0), __builtin_amdgcn_exp2f(l1)}; *(f32x2*)(CH + (size_t)item * DM + c2) = (f32x2){h0, h1};
    }
}
__device__ __forceinline__ void phase_scan2(const CAS Args& args, const Ctx& C0) {
    Ctx C = C0; C.tid = opaque_tid(); C.lane = C.tid & 63;
    const bf16_t* LA = WSP(bf16_t, WS_AA); const bf16_t* BB = WSP(bf16_t, WS_BB); const float* CA = WSP(float, WS_CA); const float* CH = WSP(float, WS_CH);
    const bf16_t* GG = WSP(bf16_t, WS_GG); bf16_t* YL = WSP(bf16_t, WS_O);
    const int c2 = C.tid * 2;
    for (int item = C.vcu; item < NBATCH * 64; item += C.G) {
        const int b = item >> 6, ch = item & 63; float h0 = 0.f, h1 = 0.f;
#pragma unroll 8
        for (int jx = 0; jx < ch; ++jx) { const f32x2 a = *(const f32x2*)(CA + (size_t)(b * 64 + jx) * DM + c2), e = *(const f32x2*)(CH + (size_t)(b * 64 + jx) * DM + c2);
            h0 = a[0] * h0 + e[0]; h1 = a[1] * h1 + e[1]; }
        const size_t r0 = (size_t)item * 64;
#pragma unroll 8
        for (int s = 0; s < 64; ++s) { const unsigned aw = *(const unsigned*)(LA + (r0 + s) * DM + c2), bw = *(const unsigned*)(BB + (r0 + s) * DM + c2), g = *(const unsigned*)(GG + (r0 + s) * DM + c2);
            h0 = __builtin_amdgcn_exp2f(bf_lo(aw)) * h0 + bf_lo(bw); h1 = __builtin_amdgcn_exp2f(bf_hi(aw)) * h1 + bf_hi(bw);
            *(unsigned*)(YL + (r0 + s) * DM + c2) = cvt_pk_bf16(bf_lo(g) * h0, bf_hi(g) * h1); }
    }
}

#if PROBE_T
typedef int v8i_t __attribute__((ext_vector_type(8)));
__device__ __forceinline__ unsigned fp8_of_int(int v) { const unsigned char t[4] = {0x00, 0x38, 0x40, 0x44}; const int a = v < 0 ? -v : v; return (unsigned)t[a] | (v < 0 ? 0x80u : 0u); }
__device__ __forceinline__ int tA(int i, int k) { return ((i * 3 + k * 5) % 7) - 3; }
__device__ __forceinline__ int tB(int k, int j) { return ((k * 2 + j * 7) % 5) - 2; }
__device__ __forceinline__ void mfma_fp8_selftest(unsigned* flagw) {
    const int l = threadIdx.x & 63, r = l & 15, q = l >> 4;
    v8i_t A, B;
#pragma unroll
    for (int d = 0; d < 8; ++d) { unsigned wa = 0, wb = 0;
#pragma unroll
        for (int b = 0; b < 4; ++b) { const int k = 32 * q + 4 * d + b; wa |= fp8_of_int(tA(r, k)) << (8 * b); wb |= fp8_of_int(tB(k, r)) << (8 * b); }
        A[d] = (int)wa; B[d] = (int)wb; }
    const f32x4 z = {0.f, 0.f, 0.f, 0.f};
    const int U = 0x7f7f7f7f;
    const int saq = (127 + q) * 0x01010101;
    const int sab = (q == 0) ? (int)0x8281807fu : U;
    const f32x4 m2 = __builtin_amdgcn_mfma_scale_f32_16x16x128_f8f6f4(A, B, z, 0, 0, 0, saq, 0, U);
    const f32x4 m5 = __builtin_amdgcn_mfma_scale_f32_16x16x128_f8f6f4(A, B, z, 0, 0, 0, sab, 0, U);
    bool k1 = true, k2 = true, k3 = true, k4 = true;
#pragma unroll
    for (int e = 0; e < 4; ++e) { const int i = 4 * q + e, j = r; float eb = 0.f, e0 = 0.f, ec = 0.f, ed = 0.f;
        for (int kq = 0; kq < 4; ++kq) for (int hh = 0; hh < 2; ++hh) { float sh = 0.f; for (int k = 32 * kq + 16 * hh; k < 32 * kq + 16 * hh + 16; ++k) sh += (float)(tA(i, k) * tB(k, j));
            const int xb = hh == 0 ? (kq >> 1) : 2 + (kq >> 1);
            eb += sh * (float)(1 << xb); e0 += sh; ec += sh * (float)(1 << kq); ed += sh * (float)(1 << xb); }
        k1 = k1 && (m2[e] == eb); k2 = k2 && (m2[e] == e0); k3 = k3 && (m5[e] == ec); k4 = k4 && (m5[e] == ed); }
    const bool b1 = __all(k1), b2 = __all(k2), b3 = __all(k3), b4 = __all(k4);
    if (l == 0) *flagw = (b1 ? 1u : 0u) | (b2 ? 2u : 0u) | (b3 ? 4u : 0u) | (b4 ? 8u : 0u);
}
#endif
constexpr int PH_PER_LAYER = 12, PH_TOTAL = 2 + PH_PER_LAYER * DEPTH;
__global__ void __launch_bounds__(NWAVES * 64, 2) fwd_kernel(Args args_kernarg) {
    (void)args_kernarg;
    ArgsP const argp = (ArgsP)__builtin_amdgcn_kernarg_segment_ptr();
    const CAS Args& args0 = *argp;
    extern __shared__ __attribute__((aligned(16))) unsigned char lds_raw[];
    Ctx C_;
    C_.lds = (LAS unsigned char*)lds_raw; C_.misc = (volatile LAS int*)(C_.lds + MISC_OFF);
    C_.tid = threadIdx.x; C_.lane = C_.tid & 63; C_.wave = __builtin_amdgcn_readfirstlane(C_.tid >> 6);
    C_.bid = (int)blockIdx.x; C_.G = gridDim.x; { const int bx = blockIdx.x; C_.vcu = (C_.G % 8 == 0) ? (bx % 8) * (C_.G / 8) + bx / 8 : bx; }
    for (int u = C_.tid; u < 128; u += NWAVES * 64) C_.misc[u] = 0;
    __syncthreads();
    XcdBarrier bar = xcd_barrier_post((unsigned*)(args0.ws + WS_CTL) + CW_BAR + args0.li * XCD_BAR_WORDS, (volatile LAS unsigned*)C_.misc);
    const int lo = args0.ph_lo, hi = args0.ph_hi;
#define IN(k) (lo <= (k) && (k) < hi)
#define PH_END(k) do { if ((k) + 1 < hi) xcd_barrier(bar); } while (0)

    if (SEL(0) && IN(0)) { const CAS Args& args = fresh_args(argp); const Ctx C = fresh_ctx(C_); const int cid = C.bid; phase_prologue(args, C); PH_END(0); }
    if (SEL(1) && IN(1)) { const CAS Args& args = fresh_args(argp); const Ctx C = fresh_ctx(C_); const int cid = C.bid;
        pg8::DenseSched S; S.init(WSP(bf16_t, WS_PB), WSP(bf16_t, WS_W_PLE + OFF_PLE_WP), PLED, PLED, DEPTH * T, DM, C.G, cid); S.bpm_shift = 7; S.bbatch = W_PLE_STRIDE;
        pg8::EpiPP E{WSP(bf16_t, WS_PP)};
        pg8::gemm_phase<pg8::EpiPP, pg8::DenseSched, false>(C.lds, PLED / 64, PLED * 2, PLED * 2, S, E);
        if (MK_ONE_LAUNCH == 0) PH_END(1);
    }
    for (int layer = 0; layer < DEPTH; ++layer) {
        const int base = 2 + PH_PER_LAYER * layer, j = layer >> 1;
        if ((layer & 1) == 0) {
            if (SEL(2) && IN(base + 0)) { const CAS Args& args = fresh_args(argp); const Ctx C = fresh_ctx(C_); const int cid = C.bid; const unsigned char* wm = args.ws + WS_W_MLA + (size_t)j * W_MLA_STRIDE;
                pg8::DenseSched S; S.init(WSP(bf16_t, WS_XB), wm + OFF_MLA_WIN, DM, DM, T, 1280, C.G, cid);
                pg8::EpiLat E{WSP(bf16_t, WS_LAT), WSP(float, WS_SSQ), WSP(bf16_t, WS_KR), WSP(float, WS_CS), WSP(float, WS_SN)};
                pg8::gemm_phase<pg8::EpiLat, pg8::DenseSched, false>(C.lds, DM / 64, DM * 2, DM * 2, S, E);
                PH_END(base + 0);
            }
            if (SEL(3) && IN(base + 1)) { const CAS Args& args = fresh_args(argp); const Ctx C = fresh_ctx(C_); const int cid = C.bid; const unsigned char* wm = args.ws + WS_W_MLA + (size_t)j * W_MLA_STRIDE;
                { pg8::DenseSched S; S.init(WSP(bf16_t, WS_LAT), wm + OFF_MLA_WUQ, DM, QL, T, 1536, C.G, cid);
                  pg8::EpiQ E{WSP(bf16_t, WS_Q), WSP(float, WS_SSQ), WSP(float, WS_CS), WSP(float, WS_SN)};
                  pg8::gemm_phase<pg8::EpiQ, pg8::DenseSched, false>(C.lds, QL / 64, DM * 2, QL * 2, S, E); }
                { pg8::DenseSched S; S.init(WSP(bf16_t, WS_LAT) + QL, wm + OFF_MLA_WUKV, DM, KVL, T, 2048, C.G, cid);
                  pg8::EpiKV E{WSP(bf16_t, WS_KN), WSP(bf16_t, WS_V), WSP(float, WS_SSQ)};
                  pg8::gemm_phase<pg8::EpiKV, pg8::DenseSched, false>(C.lds, KVL / 64, DM * 2, KVL * 2, S, E); }
                PH_END(base + 1);
            }
            if (SEL(4) && IN(base + 2)) { const CAS Args& args = fresh_args(argp); const Ctx C = fresh_ctx(C_); const int cid = C.bid;
                for (int it = C.vcu; it < NBATCH * NH * 8; it += C.G) { const int bh = it >> 3, pr = it & 7;
                    att::attn_block(bh >> 3, bh & 7, pr, WSP(bf16_t, WS_Q), WSP(bf16_t, WS_KN), WSP(bf16_t, WS_KR), WSP(bf16_t, WS_V), WSP(bf16_t, WS_O), (LAS char*)C.lds, PROBE_T ? (unsigned long long*)(args.ws + WS_CTL + 8192) : nullptr);
                    att::attn_block(bh >> 3, bh & 7, 15 - pr, WSP(bf16_t, WS_Q), WSP(bf16_t, WS_KN), WSP(bf16_t, WS_KR), WSP(bf16_t, WS_V), WSP(bf16_t, WS_O), (LAS char*)C.lds, PROBE_T ? (unsigned long long*)(args.ws + WS_CTL + 8192) : nullptr); }
                PH_END(base + 2);
            }
        } else {
            if (SEL(5) && IN(base + 0)) { const CAS Args& args = fresh_args(argp); const Ctx C = fresh_ctx(C_); const int cid = C.bid; const unsigned char* wl = args.ws + WS_W_LRU + (size_t)j * W_LRU_STRIDE;
                pg8::DenseSched S; S.init(WSP(bf16_t, WS_XB), wl + OFF_LRU_WIN, DM, DM, T, 2048, C.G, cid);
                pg8::EpiGU E{WSP(bf16_t, WS_GG), WSP(bf16_t, WS_U)};
                pg8::gemm_phase<pg8::EpiGU, pg8::DenseSched, false>(C.lds, DM / 64, DM * 2, DM * 2, S, E);
                PH_END(base + 0);
            }
            if (SEL(6) && IN(base + 1)) { const CAS Args& args = fresh_args(argp); const Ctx C = fresh_ctx(C_); const int cid = C.bid; phase_conv(args, C, j); PH_END(base + 1); }
            if (SEL(7) && IN(base + 2)) { const CAS Args& args = fresh_args(argp); const Ctx C = fresh_ctx(C_); const int cid = C.bid; const unsigned char* wl = args.ws + WS_W_LRU + (size_t)j * W_LRU_STRIDE;
                pg8::DenseSched S; S.init(WSP(bf16_t, WS_UC), wl + OFF_LRU_WAX, DM, 256, T, 2048, C.G, cid); S.apn_shift = 1; S.akbytes = 512;
                pg8::EpiAB E{WSP(bf16_t, WS_AA), WSP(bf16_t, WS_BB), WSP(bf16_t, WS_UC), INF(I_LRU_BA) + j * DM, INF(I_LRU_BX) + j * DM, WSP(float, WS_SPL) + j * DM};
                pg8::gemm_phase<pg8::EpiAB, pg8::DenseSched, false>(C.lds, 4, DM * 2, 512, S, E);
                PH_END(base + 2);
            }
            if (SEL(8) && IN(base + 3)) { const CAS Args& args = fresh_args(argp); const Ctx C = fresh_ctx(C_); const int cid = C.bid; phase_scan1(args, C); PH_END(base + 3); }
            if (SEL(9) && IN(base + 4)) { const CAS Args& args = fresh_args(argp); const Ctx C = fresh_ctx(C_); const int cid = C.bid; phase_scan2(args, C); PH_END(base + 4); }
        }
        if (SEL(10) && IN(base + 5)) { const CAS Args& args = fresh_args(argp); const Ctx C = fresh_ctx(C_); const int cid = C.bid;
            const unsigned char* wo = (layer & 1) ? args.ws + WS_W_LRU + (size_t)j * W_LRU_STRIDE + OFF_LRU_WOUT : args.ws + WS_W_MLA + (size_t)j * W_MLA_STRIDE + OFF_MLA_WO;
            pg8::DenseSched S; S.init(WSP(bf16_t, WS_O), wo, DM, DM, T, DM, C.G, cid);
            pg8::EpiRes E{WSP(bf16_t, WS_XB), WSP(bf16_t, WS_Y)};
            pg8::gemm_phase<pg8::EpiRes, pg8::DenseSched, false>(C.lds, DM / 64, DM * 2, DM * 2, S, E);
            PH_END(base + 5);
        }
        if (SEL(11) && IN(base + 6)) { const CAS Args& args = fresh_args(argp); const Ctx C = fresh_ctx(C_); const int cid = C.bid; phase_ln_router(args, C, layer); PH_END(base + 6); }
        if (SEL(12) && IN(base + 7)) { const CAS Args& args = fresh_args(argp); const Ctx C = fresh_ctx(C_); const int cid = C.bid;
            moe_table(args, C, layer);
            pg8::MoeSched S{(const char*)(args.ws + WS_X1Q), (const char*)(args.ws + WS_W_UP + (size_t)layer * NE * 2048 * 1024), (size_t)2048 * 1024, (const char*)(args.ws + WS_SW + (size_t)layer * NE * 65536), DM, DM, 8, WSP(int, WS_LIST), C.misc + 16, (volatile LAS const unsigned char*)(C.lds + TILE_E_OFF), C.G, cid, true, nullptr};
            const int sae = 127 - (int)__hip_atomic_load(WSP(unsigned, WS_CTL) + CW_SA + layer, __ATOMIC_RELAXED, __HIP_MEMORY_SCOPE_AGENT);
            pg8::EpiUp E{args.ws + WS_H, args.ws + WS_SH, INF(I_MOE_BUP) + (size_t)layer * NE * 2048};
            pg8::gemm_phase<pg8::EpiUp, pg8::MoeSched, true, 1>(C.lds, DM / 128, DM, DM, S, E, PROBE_T ? (unsigned long long*)(args.ws + WS_CTL + 8192) : nullptr, sae * 0x01010101);
            PH_END(base + 7);
        }
        if (SEL(13) && IN(base + 8)) { const CAS Args& args = fresh_args(argp); const Ctx C = fresh_ctx(C_); const int cid = C.bid;
            moe_table(args, C, layer);
            pg8::MoeSched S{(const char*)(args.ws + WS_H), (const char*)(args.ws + WS_W_DN + (size_t)layer * NE * 1024 * 1024), (size_t)1024 * 1024, (const char*)(args.ws + WS_SWD + (size_t)layer * NE * 16384), DFF, DFF, 4, WSP(int, WS_LIST), C.misc + 16, (volatile LAS const unsigned char*)(C.lds + TILE_E_OFF), C.G, cid, false, (const char*)(args.ws + WS_SH)};
            pg8::EpiDown E{args.ws + WS_YS, args.ws + WS_SY, INF(I_MOE_BDN) + (size_t)layer * NE * DM};
            pg8::gemm_phase<pg8::EpiDown, pg8::MoeSched, false, 2>(C.lds, DFF / 128, DFF, DFF, S, E);
            PH_END(base + 8);
        }
        if (SEL(14) && IN(base + 9)) { const CAS Args& args = fresh_args(argp); const Ctx C = fresh_ctx(C_); const int cid = C.bid; phase_combine_ln2(args, C, layer); PH_END(base + 9); }
        if (SEL(15) && IN(base + 10)) { const CAS Args& args = fresh_args(argp); const Ctx C = fresh_ctx(C_); const int cid = C.bid;
            pg8::DenseSched S; S.init(WSP(bf16_t, WS_X2B), args.ws + WS_W_PLE + (size_t)layer * W_PLE_STRIDE + OFF_PLE_WG, DM, DM, T, DM, C.G, cid);
            pg8::EpiPle E{WSP(bf16_t, WS_X2B), WSP(bf16_t, WS_PP) + (size_t)layer * T * DM, layer == DEPTH - 1 ? args.out : (float*)nullptr, WSP(bf16_t, WS_XB)};
            pg8::gemm_phase<pg8::EpiPle, pg8::DenseSched, false>(C.lds, DM / 64, DM * 2, DM * 2, S, E);
            if (layer + 1 < DEPTH) PH_END(base + 10);
        }
    }
#if PROBE_T
    if (PROBE_T == 20 && blockIdx.x == 0 && threadIdx.x < 64) { const CAS Args& args = fresh_args(argp); mfma_fp8_selftest((unsigned*)(args.ws + WS_CTL + 8192 + 256)); }
    { xcd_barrier(bar); const CAS Args& args = fresh_args(argp);
      const unsigned long long* pw = (const unsigned long long*)(args.ws + WS_CTL + 8192);
      const double pk = (double)__hip_atomic_load(pw + 0, __ATOMIC_RELAXED, __HIP_MEMORY_SCOPE_AGENT), pe = (double)__hip_atomic_load(pw + 1, __ATOMIC_RELAXED, __HIP_MEMORY_SCOPE_AGENT),
                   pn = (double)__hip_atomic_load(pw + 2, __ATOMIC_RELAXED, __HIP_MEMORY_SCOPE_AGENT), pt = (double)__hip_atomic_load(pw + 3, __ATOMIC_RELAXED, __HIP_MEMORY_SCOPE_AGENT);
      float c = 100.f;
      if (PROBE_T == 2) c = (float)(pk / (pn * 16.0) / 10.0);
      if (PROBE_T == 3) c = (float)(pe / pn / 100.0);
      if (PROBE_T == 4) c = (float)((pt - pk - pe) / pn / 100.0);
      if (PROBE_T == 5) c = (float)(pn);
      if (PROBE_T >= 10) { double q[7]; for (int i = 0; i < 7; ++i) q[i] = (double)__hip_atomic_load(pw + 8 + i, __ATOMIC_RELAXED, __HIP_MEMORY_SCOPE_AGENT);
          if (PROBE_T == 10) c = (float)(q[6] / q[5] / 10.0);
          if (PROBE_T == 11) c = (float)(q[0] / q[5] / 10.0);
          if (PROBE_T == 12) c = (float)(q[1] / q[5] / 10.0);
          if (PROBE_T == 13) c = (float)(q[2] / q[5] / 10.0);
          if (PROBE_T == 14) c = (float)(q[3] / q[5] / 10.0);
          if (PROBE_T == 15) c = (float)(q[4] / q[5] / 10.0); }
      if (PROBE_T >= 2 && PROBE_T < 20) c = exp2f(floorf(log2f(c) * 8.0f + PROBE_SHIFT) * 0.125f);
      if (PROBE_T == 20) { const unsigned fl = __hip_atomic_load((const unsigned*)(args.ws + WS_CTL + 8192 + 256), __ATOMIC_RELAXED, __HIP_MEMORY_SCOPE_AGENT); c = 100.f + 10.f * (float)fl; }
      for (size_t i = (size_t)blockIdx.x * 512 + threadIdx.x; i < (size_t)T * DM; i += (size_t)gridDim.x * 512) args.out[i] = c; }
#endif
#undef IN
#undef PH_END
}

extern "C" void kernel_launch(void* const* d_in, const int* in_sizes, int n_in, void* d_out, int out_size, void* d_ws, size_t ws_size, hipStream_t stream) {
    static int grid = 0;
    if (grid == 0) {
        if (n_in != 30 || in_sizes[0] != T * DM || out_size != T * DM || ws_size < WS_END) { fprintf(stderr, "kernel_launch: unexpected shapes (n_in %d, in0 %d, out %d, ws %zu)\n", n_in, n_in > 0 ? in_sizes[0] : -1, out_size, ws_size); grid = -1; return; }
        int dev = 0, cus = 0, per_cu = 0;
        if (hipGetDevice(&dev) != hipSuccess || hipDeviceGetAttribute(&cus, hipDeviceAttributeMultiprocessorCount, dev) != hipSuccess) { grid = -1; return; }
        if (hipFuncSetAttribute((const void*)fwd_kernel, hipFuncAttributeMaxDynamicSharedMemorySize, LDS_BYTES) != hipSuccess) { fprintf(stderr, "kernel_launch: hipFuncSetAttribute failed\n"); grid = -1; return; }
        if (hipOccupancyMaxActiveBlocksPerMultiprocessor(&per_cu, (const void*)fwd_kernel, NWAVES * 64, LDS_BYTES) != hipSuccess || per_cu < 1) fprintf(stderr, "kernel_launch: occupancy query reports %d\n", per_cu);
        (void)hipGetLastError();
        grid = cus;
    }
    if (grid < 0) return;
    if (hipMemsetAsync((char*)d_ws + WS_CTL, 0, CTL_ZERO_BYTES, stream) != hipSuccess) return;
    Args a{};
    for (int i = 0; i < 30; ++i) a.in[i] = d_in[i];
    a.out = (float*)d_out; a.ws = (unsigned char*)d_ws; a.pad = 0;
#if MK_ONE_LAUNCH
    a.ph_lo = 0; a.ph_hi = PH_TOTAL; a.li = 0;
    hipLaunchKernelGGL(fwd_kernel, dim3(grid), dim3(NWAVES * 64), LDS_BYTES, stream, a);
#else
    int li = 0;
    for (int ph = 0; ph < PH_TOTAL; ++ph) {
        if (ph >= 2) { const int l = (ph - 2) / PH_PER_LAYER, k = (ph - 2) % PH_PER_LAYER; if (k == 11) continue; if ((l & 1) == 0 && (k == 3 || k == 4)) continue; }
        int site = ph;
        if (ph >= 2) { const int l = (ph - 2) / PH_PER_LAYER, k = (ph - 2) % PH_PER_LAYER; static const int mla[11] = {2, 3, 4, -1, -1, 10, 11, 12, 13, 14, 15}, lru[11] = {5, 6, 7, 8, 9, 10, 11, 12, 13, 14, 15}; site = (l & 1) ? lru[k] : mla[k]; }
        a.ph_lo = ph; a.ph_hi = ph + 1;
        if ((HOSTDUP >> site) & 1) { a.li = li++; a.pad = 4; hipLaunchKernelGGL(fwd_kernel, dim3(grid), dim3(NWAVES * 64), LDS_BYTES, stream, a); }
        a.li = li++; a.pad = 0;
        hipLaunchKernelGGL(fwd_kernel, dim3(grid), dim3(NWAVES * 64), LDS_BYTES, stream, a);
    }
#endif
}
```

```cpp
#include <hip/hip_runtime.h>
#include <hip/hip_bf16.h>
#include <cstdio>
#include <cstdint>

#ifndef PHSEL
#define PHSEL -1
#endif
#ifndef PHSKIP
#define PHSKIP -1
#endif
#define SEL(id) ((PHSEL < 0 || PHSEL == (id)) && PHSKIP != (id))
#ifndef PROBE_T
#define PROBE_T 0
#endif
#ifndef PROBE_SHIFT
#define PROBE_SHIFT 0.0f
#endif
#ifndef HOSTDUP
#define HOSTDUP 0
#endif
#ifndef MK_ONE_LAUNCH
#define MK_ONE_LAUNCH 1
#endif

constexpr int T = 32768, SEQ = 4096, NBATCH = 8, DM = 1024, DEPTH = 4;
constexpr int QL = 768, KVL = 256, ROPE = 64, LATD = 1088, NH = 8, DQK = 192, DV = 128;
constexpr int NE = 32, TOPK = 4, DFF = 1024, PLED = 256;
constexpr float ALPHA = 1.681792830507429f;
constexpr float LN_EPS = 1e-5f, RMS_EPS = 1e-6f;
constexpr float QSCALE = 1.4426950408889634f / 13.856406460551018f;
constexpr int NWAVES = 8;

constexpr size_t MiB = 1u << 20;
constexpr size_t WS_CTL = 0, CTL_ZERO_BYTES = 2 * MiB;
constexpr size_t WS_CS = 2 * MiB, WS_SN = 6 * MiB, WS_SPL = 10 * MiB;
constexpr size_t WS_WRH = WS_SPL + 65536, WS_WRL = WS_WRH + 262144;
constexpr size_t WS_RC = WS_SPL + 16384;
constexpr size_t WS_W_MLA = 12 * MiB, W_MLA_STRIDE = 8 * MiB;
constexpr size_t OFF_MLA_WIN = 0, OFF_MLA_WUQ = 2560 * 1024, OFF_MLA_WUKV = OFF_MLA_WUQ + 2304 * 1024, OFF_MLA_WO = OFF_MLA_WUKV + 1024 * 1024;
constexpr size_t WS_W_LRU = 28 * MiB, W_LRU_STRIDE = 8 * MiB;
constexpr size_t OFF_LRU_WIN = 0, OFF_LRU_WAX = 4 * MiB, OFF_LRU_WOUT = 5 * MiB;
constexpr size_t WS_W_PLE = 44 * MiB, W_PLE_STRIDE = 3 * MiB;
constexpr size_t OFF_PLE_WG = 0, OFF_PLE_WP = 2 * MiB;
constexpr size_t WS_W_UP = 56 * MiB;
constexpr size_t WS_W_DN = 568 * MiB;
constexpr size_t WS_XB = 824 * MiB, WS_PB = 888 * MiB, WS_PP = 952 * MiB;
constexpr size_t WS_Y = 1208 * MiB, WS_X1 = 1336 * MiB, WS_X1B = 1464 * MiB, WS_X2 = 1528 * MiB, WS_X2B = 1656 * MiB;
constexpr size_t WS_LAT = 1720 * MiB, WS_KR = 1784 * MiB, WS_SSQ = 1788 * MiB, WS_Q = 1790 * MiB, WS_KN = 1886 * MiB, WS_V = 1950 * MiB, WS_O = 2014 * MiB;
constexpr size_t WS_GG = 2078 * MiB, WS_U = 2142 * MiB, WS_UC = 2206 * MiB, WS_AA = 2270 * MiB, WS_BB = 2398 * MiB, WS_CA = 2526 * MiB, WS_CH = 2528 * MiB;
constexpr size_t WS_H = 2530 * MiB, WS_YS = 2802 * MiB, WS_LIST = 3074 * MiB, WS_SLOT = 3078 * MiB, WS_GATE = 3079 * MiB, WS_SW = 3080 * MiB  , WS_X1Q = 3088 * MiB  , WS_SH = 3120 * MiB  ,
                 WS_SWD = 3128 * MiB  , WS_SY = 3132 * MiB  , WS_X2Q = 3140 * MiB  , WS_SWG = 3172 * MiB  , WS_END = 3174 * MiB;
constexpr int PADROWS = T * TOPK + NE * 256;
static_assert((size_t)PADROWS * DFF * 2 <= 272 * MiB, "H / YS size");
constexpr int CW_SA2 = 136;
constexpr int CW_SA = 128;
constexpr int CW_CNT = 256;
constexpr int CW_BAR = 4096;

constexpr int RING_BYTES = 133120;
constexpr int TILE_E_OFF = 131072;
constexpr int SCL_OFF = RING_BYTES;
constexpr int MISC_OFF = SCL_OFF + 24576;
constexpr int LDS_BYTES = 163840;

#define GAS __attribute__((address_space(1)))
#define LAS __attribute__((address_space(3)))
#define CAS __attribute__((address_space(4)))
typedef unsigned short bf16_t;
typedef short bf16x8 __attribute__((ext_vector_type(8)));
typedef short s16x4 __attribute__((ext_vector_type(4)));
typedef float f32x2 __attribute__((ext_vector_type(2)));
typedef float f32x4 __attribute__((ext_vector_type(4)));
typedef float f32x16 __attribute__((ext_vector_type(16)));
typedef unsigned u32x2 __attribute__((ext_vector_type(2)));
typedef unsigned u32x4 __attribute__((ext_vector_type(4)));

__device__ __forceinline__ unsigned cvt_pk_bf16(float lo, float hi) { unsigned r; asm volatile("v_cvt_pk_bf16_f32 %0, %1, %2" : "=v"(r) : "v"(lo), "v"(hi)); return r; }
__device__ __forceinline__ float bf_lo(unsigned w) { return __uint_as_float(w << 16); }
__device__ __forceinline__ float bf_hi(unsigned w) { return __uint_as_float(w & 0xffff0000u); }
__device__ __forceinline__ float sigmoidf_(float x) { return __builtin_amdgcn_rcpf(1.0f + __expf(-x)); }
__device__ __forceinline__ float gelu_tanh(float x) { const float u = 0.7978845608028654f * (x + 0.044715f * x * x * x); const float t = 1.0f - 2.0f * __builtin_amdgcn_rcpf(1.0f + __expf(2.0f * u)); return 0.5f * x * (1.0f + t); }
__device__ __forceinline__ u32x4 pack8(const f32x4 a, const f32x4 b) { u32x4 w; w.x = cvt_pk_bf16(a[0], a[1]); w.y = cvt_pk_bf16(a[2], a[3]); w.z = cvt_pk_bf16(b[0], b[1]); w.w = cvt_pk_bf16(b[2], b[3]); return w; }
__device__ __forceinline__ float KF(float v) { asm volatile("" : "+s"(v)); return v; }
__device__ __forceinline__ int opaque_tid() { int t = threadIdx.x; asm volatile("" : "+v"(t)); return t; }
__device__ __forceinline__ float wave_sum(float v) {
#pragma unroll
    for (int o = 1; o < 64; o <<= 1) v += __shfl_xor(v, o);
    return v;
}

namespace pg8 {
#define PG8_LAS __attribute__((address_space(3)))
constexpr int BM = 256, BK = 64, HALF = 128, HTB = HALF * BK * 2, STAGE_BYTES = 8 * HTB;
__host__ __device__ __forceinline__ int lds_byte(int r, int c) { const int st = (r >> 4) * 2 + (c >> 5), rr = r & 15, cc = c & 31, ob = rr * 64 + cc * 2; return st * 1024 + (ob ^ (((ob >> 9) & 1) << 5)); }
__host__ __device__ __forceinline__ void stage_rc(int b, int& R, int& C) { const int st = b / 1024, sb = b % 1024, swz = sb ^ (((sb >> 9) & 1) << 5); R = (st >> 1) * 16 + swz / 64; C = (st & 1) * 32 + (swz % 64) / 2; }
__host__ __device__ __forceinline__ int perm32(int rho) { const int n = rho >> 4, i = rho & 15; return 8 * (i >> 2) + 4 * n + (i & 3); }

struct Unit { const char* A; const char* B; const char* S; const char* SA; const int* lst; int nvalid; int pm, pn, aux; };

typedef int v4i_t __attribute__((ext_vector_type(4)));
typedef int v8i_t __attribute__((ext_vector_type(8)));
template <class Epi, class Sched, bool GATHER, int FPM = 0>
__device__ __forceinline__ void gemm_phase(PG8_LAS unsigned char* lds, const int nt  , const int lda  , const int ldb  , const Sched& S, const Epi& E, unsigned long long* pw = nullptr, const int sa = 0x7f7f7f7f) {
    constexpr bool FP8 = FPM != 0;
    const int tid = opaque_tid(), wid = __builtin_amdgcn_readfirstlane(tid >> 6), lane = tid & 63, wr = wid >> 2, wc = wid & 3, fr = lane & 15, fq = lane >> 4;
    unsigned voffB[2], ocA[2][2], onA[2][2];
#pragma unroll
    for (int i = 0; i < 2; ++i) { int R, C; stage_rc(tid * 16 + i * 8192, R, C); const int Rb = Epi::PERM ? ((R & ~31) + perm32(R & 31)) : R;
        voffB[i] = (unsigned)(Rb * ldb + C * 2);
        ocA[0][i] = (unsigned)(R * lda + C * 2); ocA[1][i] = (unsigned)((R + HALF) * lda + C * 2); onA[0][i] = ocA[0][i]; onA[1][i] = ocA[1][i]; }
    constexpr unsigned kstep = BK * 2;
    const unsigned hstepB = (unsigned)HALF * ldb;
    const unsigned ldsw = (unsigned)wid * 1024u;
    const int aoff = lds_byte(wr * 64 + fr, fq * 8), boff = lds_byte(wc * 32 + fr, fq * 8);
#define PG8_SA(b, h) (((b) * 2 + (h)) * HTB)
#define PG8_SB(b, h) ((4 + (b) * 2 + (h)) * HTB)
#define PG8_STAGE(bufoff, gbase, voff, kb) do { _Pragma("unroll") for (int _i = 0; _i < 2; ++_i) \
        __builtin_amdgcn_global_load_lds((const unsigned*)((const char*)(gbase) + (size_t)(unsigned)((voff)[_i] + (unsigned)(kb))), (PG8_LAS unsigned*)(lds + (bufoff) + ldsw + _i * 8192), 16, 0, 0); } while (0)
#define PG8_CAT(x0, x1) __builtin_shufflevector(x0, x1, 0, 1, 2, 3, 4, 5, 6, 7)
#define PG8_LO(x) __builtin_bit_cast(bf16x8, __builtin_shufflevector(x, x, 0, 1, 2, 3))
#define PG8_HI(x) __builtin_bit_cast(bf16x8, __builtin_shufflevector(x, x, 4, 5, 6, 7))
    const PG8_LAS unsigned char* const ldsA = lds + aoff; const PG8_LAS unsigned char* const ldsB = lds + 4 * HTB + boff;
#define PG8_LDA(dst, b, h) do { _Pragma("unroll") for (int m = 0; m < 4; ++m) dst[m] = PG8_CAT(*(const PG8_LAS v4i_t*)(ldsA + (PG8_SA(b, h) + m * 2048)), *(const PG8_LAS v4i_t*)(ldsA + (PG8_SA(b, h) + m * 2048 + 1024))); } while (0)
#define PG8_LDB(dst, b, h) do { _Pragma("unroll") for (int n = 0; n < 2; ++n) dst[n] = PG8_CAT(*(const PG8_LAS v4i_t*)(ldsB + (PG8_SB(b, h) - 4 * HTB + n * 2048)), *(const PG8_LAS v4i_t*)(ldsB + (PG8_SB(b, h) - 4 * HTB + n * 2048 + 1024))); } while (0)
#define PG8_MMA(ai, bj, At, Bt) do { __builtin_amdgcn_s_setprio(1); \
        if constexpr (FP8) { asm volatile("s_nop 4" ::: "memory"); _Pragma("unroll") for (int m = 0; m < 4; ++m) _Pragma("unroll") for (int n = 0; n < 2; ++n) \
            asm volatile("v_mfma_scale_f32_16x16x128_f8f6f4 %0, %1, %2, %0, %3, %4 op_sel_hi:[0,0,0]" : "+v"(acc[ai][bj][m][n]) : "v"(Bt[n]), "v"(At[m]), "v"(sB[bj][n]), "v"(FPM == 2 ? sA[m] : sav)); } \
        else { _Pragma("unroll") for (int m = 0; m < 4; ++m) _Pragma("unroll") for (int n = 0; n < 2; ++n) { \
            acc[ai][bj][m][n] = __builtin_amdgcn_mfma_f32_16x16x32_bf16(PG8_LO(Bt[n]), PG8_LO(At[m]), acc[ai][bj][m][n], 0, 0, 0); \
            acc[ai][bj][m][n] = __builtin_amdgcn_mfma_f32_16x16x32_bf16(PG8_HI(Bt[n]), PG8_HI(At[m]), acc[ai][bj][m][n], 0, 0, 0); } } \
        __builtin_amdgcn_s_setprio(0); } while (0)
    int sB[2][2] = {{0x7f, 0x7f}, {0x7f, 0x7f}}; int sav; asm volatile("v_mov_b32 %0, %1" : "=v"(sav) : "s"(sa));
    int sA[4] = {0x7f, 0x7f, 0x7f, 0x7f};
    const int scol = wc * 32 + (Epi::PERM ? 8 * (fr >> 2) + (fr & 3) : fr);
    const int sbase = FPM == 2 ? SCL_OFF + 16384 + scol * 2 + (fq >> 1) : SCL_OFF + scol * 4 + fq;
    const int sabase = SCL_OFF + ((wr * 64 + fr) << 2) + fq;
#define PG8_LDS_SCL(par_, kt_) do { if constexpr (FP8) { \
        const PG8_LAS unsigned char* sp_ = (const PG8_LAS unsigned char*)lds + sbase + (FPM == 2 ? (par_) * 4096 + (kt_) * 512 : (par_) * 8192 + (kt_) * 1024); \
        _Pragma("unroll") for (int bj_ = 0; bj_ < 2; ++bj_) _Pragma("unroll") for (int n_ = 0; n_ < 2; ++n_) sB[bj_][n_] = (int)sp_[(bj_ * 128 + n_ * (Epi::PERM ? 4 : 16)) * (FPM == 2 ? 2 : 4)]; } } while (0)
#define PG8_LDS_SCA(par_, kt_, ai_) do { if constexpr (FPM == 2) { const PG8_LAS unsigned char* sp_ = (const PG8_LAS unsigned char*)lds + sabase + (par_) * 8192 + (kt_) * 1024 + (ai_) * 512; \
        _Pragma("unroll") for (int m_ = 0; m_ < 4; ++m_) sA[m_] = (int)sp_[m_ * 64]; } } while (0)
#define PG8_DMA_SCL(u_, par_) do { if constexpr (FPM == 1) __builtin_amdgcn_global_load_lds((const unsigned*)((u_).S + wid * 1024 + lane * 16), (PG8_LAS unsigned*)(lds + SCL_OFF + (par_) * 8192 + wid * 1024), 16, 0, 0); \
        if constexpr (FPM == 2) { __builtin_amdgcn_global_load_lds((const unsigned*)((u_).SA + wid * 1024 + lane * 16), (PG8_LAS unsigned*)(lds + SCL_OFF + (par_) * 8192 + wid * 1024), 16, 0, 0); \
            if (wid < 4) __builtin_amdgcn_global_load_lds((const unsigned*)((u_).S + wid * 1024 + lane * 16), (PG8_LAS unsigned*)(lds + SCL_OFF + 16384 + (par_) * 4096 + wid * 1024), 16, 0, 0); } } while (0)
#define PG8_WAIT_V(n) asm volatile("s_waitcnt vmcnt(" #n ")" ::: "memory")
#define PG8_WAIT_L(n) asm volatile("s_waitcnt lgkmcnt(" #n ")" ::: "memory")
#define PG8_BAR __builtin_amdgcn_s_barrier()
#define PG8_SCHED __builtin_amdgcn_sched_barrier(0)
#define PG8_GOFFS(u, o) do { _Pragma("unroll") for (int _h = 0; _h < 2; ++_h) _Pragma("unroll") for (int _i = 0; _i < 2; ++_i) { int gR_, gC_; stage_rc(tid * 16 + _i * 8192, gR_, gC_); int _r = _h * HALF + gR_; _r = _r < (u).nvalid ? _r : (u).nvalid - 1; \
        const int _tok = (u).lst[_r]; (o)[_h][_i] = (unsigned)_tok * (unsigned)lda + (unsigned)(gC_ * 2); } } while (0)
#define PG8_GRAW(u, tk) do {   _Pragma("unroll") for (int _h = 0; _h < 2; ++_h) _Pragma("unroll") for (int _i = 0; _i < 2; ++_i) { int gR_, gC_; stage_rc(tid * 16 + _i * 8192, gR_, gC_); int _r = _h * HALF + gR_; _r = _r < (u).nvalid ? _r : (u).nvalid - 1; (tk)[_h][_i] = (unsigned)(u).lst[_r]; } } while (0)
    Unit cur, nxt, nn; int ui = 0;
#if PROBE_T
    unsigned long long pk_ = 0, pe_ = 0, pt0_ = 0, pn_ = 0; const unsigned long long pst_ = __builtin_amdgcn_s_memtime();
#endif
    if (!S.next(0, cur)) return;
    f32x4 acc[2][2][4][2];
#pragma unroll
    for (int a = 0; a < 2; ++a)
#pragma unroll
        for (int b = 0; b < 2; ++b)
#pragma unroll
            for (int m = 0; m < 4; ++m)
#pragma unroll
                for (int n = 0; n < 2; ++n) acc[a][b][m][n] = (f32x4){0.f, 0.f, 0.f, 0.f};
    v8i_t At[4], B0[2], B1[2];
    const char* cA = cur.A; const char* cB = cur.B;
    bool has_next = S.next(1, nxt);
    if constexpr (GATHER) { PG8_GOFFS(cur, ocA);
        if (has_next) { PG8_GOFFS(nxt, onA); }
        else {
#pragma unroll
            for (int h = 0; h < 2; ++h)
#pragma unroll
                for (int i = 0; i < 2; ++i) onA[h][i] = ocA[h][i]; } }
    PG8_DMA_SCL(cur, 0); if (has_next) PG8_DMA_SCL(nxt, 1);
    PG8_STAGE(PG8_SB(0, 0), cB, voffB, 0u); PG8_STAGE(PG8_SB(0, 1), cB, voffB, hstepB); PG8_STAGE(PG8_SA(0, 0), cA, ocA[0], 0u); PG8_STAGE(PG8_SA(0, 1), cA, ocA[1], 0u);
    if (wr == 1) PG8_BAR;
    PG8_WAIT_V(2); PG8_BAR;
    PG8_STAGE(PG8_SB(1, 0), cB, voffB, kstep); PG8_STAGE(PG8_SA(1, 0), cA, ocA[0], kstep); PG8_STAGE(PG8_SB(1, 1), cB, voffB, hstepB + kstep);
    PG8_WAIT_V(6); PG8_BAR;
    for (;;) {
        const char* nA = has_next ? nxt.A : cA; const char* nB = has_next ? nxt.B : cB;
#if PROBE_T
        pt0_ = __builtin_amdgcn_s_memtime();
#endif
#pragma unroll 1
        for (int t = 0; t < nt; t += 2) {
            const bool last = (t == nt - 2);
            const unsigned k1 = (unsigned)(t + 1) * kstep, k2 = last ? 0u : (unsigned)(t + 2) * kstep, k3 = k2 + kstep;
            const char* a2 = last ? nA : cA; const char* b2 = last ? nB : cB;
#define PG8_STAGE_A2(bufoff, h_, kb_) do { if (GATHER && last) PG8_STAGE(bufoff, a2, onA[h_], kb_); else PG8_STAGE(bufoff, a2, ocA[h_], kb_); } while (0)
            PG8_LDB(B0, 0, 0); PG8_LDB(B1, 0, 1); PG8_LDS_SCL(ui & 1, t); PG8_SCHED; PG8_LDA(At, 0, 0); PG8_LDS_SCA(ui & 1, t, 0); PG8_STAGE(PG8_SA(1, 1), cA, ocA[1], k1);
            PG8_WAIT_V(8); PG8_WAIT_L(0); PG8_BAR; PG8_MMA(0, 0, At, B0); PG8_MMA(0, 1, At, B1); PG8_BAR; PG8_SCHED;
            PG8_LDA(At, 0, 1); PG8_LDS_SCA(ui & 1, t, 1); PG8_STAGE(PG8_SB(0, 0), b2, voffB, k2); PG8_STAGE(PG8_SB(0, 1), b2, voffB, hstepB + k2); PG8_STAGE_A2(PG8_SA(0, 0), 0, k2);
            PG8_WAIT_V(8); PG8_WAIT_L(0); PG8_BAR; PG8_MMA(1, 0, At, B0); PG8_MMA(1, 1, At, B1); PG8_BAR; PG8_SCHED;
            PG8_LDB(B0, 1, 0); PG8_LDB(B1, 1, 1); PG8_LDS_SCL(ui & 1, t + 1); PG8_SCHED; PG8_LDA(At, 1, 0); PG8_LDS_SCA(ui & 1, t + 1, 0); PG8_STAGE_A2(PG8_SA(0, 1), 1, k2);
            PG8_WAIT_V(8); PG8_WAIT_L(0); PG8_BAR; PG8_MMA(0, 0, At, B0); PG8_MMA(0, 1, At, B1); PG8_BAR; PG8_SCHED;
            PG8_LDA(At, 1, 1); PG8_LDS_SCA(ui & 1, t + 1, 1); PG8_STAGE(PG8_SB(1, 0), b2, voffB, k3); PG8_STAGE(PG8_SB(1, 1), b2, voffB, hstepB + k3); PG8_STAGE_A2(PG8_SA(1, 0), 0, k3);
            PG8_WAIT_V(8); PG8_WAIT_L(0); PG8_BAR; PG8_MMA(1, 0, At, B0); PG8_MMA(1, 1, At, B1); PG8_BAR; PG8_SCHED;
        }
#if PROBE_T
        const unsigned long long pt1_ = __builtin_amdgcn_s_memtime(); pk_ += pt1_ - pt0_;
#endif
        if constexpr (FP8) asm volatile("s_nop 15\n\ts_nop 7" ::: "memory");
        const bool has_nn = has_next && S.next(ui + 2, nn);
        if constexpr (GATHER) {
#pragma unroll
            for (int h = 0; h < 2; ++h)
#pragma unroll
                for (int i = 0; i < 2; ++i) ocA[h][i] = onA[h][i];
            if (has_nn) { PG8_GRAW(nn, onA); } }
        if (wr == 0) PG8_BAR;
        E(acc, cur, wr, wc, fr, fq);
#if PROBE_T
        asm volatile("s_waitcnt vmcnt(0)" ::: "memory"); pe_ += __builtin_amdgcn_s_memtime() - pt1_; ++pn_;
#endif
        if (!has_next) break;
#pragma unroll
        for (int a = 0; a < 2; ++a)
#pragma unroll
            for (int b = 0; b < 2; ++b)
#pragma unroll
                for (int m = 0; m < 4; ++m)
#pragma unroll
                    for (int n = 0; n < 2; ++n) acc[a][b][m][n] = (f32x4){0.f, 0.f, 0.f, 0.f};
        cur = nxt; cA = nA; cB = nB; ++ui;
        if constexpr (GATHER) { if (has_nn) {
#pragma unroll
            for (int h = 0; h < 2; ++h)
#pragma unroll
                for (int i = 0; i < 2; ++i) { int gR_, gC_; stage_rc(tid * 16 + i * 8192, gR_, gC_); onA[h][i] = onA[h][i] * (unsigned)lda + (unsigned)(gC_ * 2); } } }
        if (has_nn) { nxt = nn; PG8_DMA_SCL(nxt, (ui + 1) & 1); }
        has_next = has_nn;
        if (wr == 1) PG8_BAR;
    }
    PG8_WAIT_V(0);
    PG8_BAR;
#if PROBE_T
    if (pw && blockIdx.x == 0 && tid == 0) { pw[0] += pk_; pw[1] += pe_; pw[2] += pn_; pw[3] += __builtin_amdgcn_s_memtime() - pst_; }
#endif
#undef PG8_SA
#undef PG8_SB
#undef PG8_STAGE
#undef PG8_LDA
#undef PG8_LDB
#undef PG8_MMA
#undef PG8_WAIT_V
#undef PG8_WAIT_L
#undef PG8_BAR
#undef PG8_SCHED
#undef PG8_GOFFS
#undef PG8_GRAW
#undef PG8_STAGE_A2
#undef PG8_CAT
#undef PG8_LO
#undef PG8_HI
#undef PG8_LDS_SCL
#undef PG8_LDS_SCA
#undef PG8_DMA_SCL
}

constexpr int NXCD = 8, WGM = 8;
struct DenseSched {
    const char* A; const char* B; int lda, ldb; int nM, nN, nwg, G, c; int apn_shift, akbytes, bpm_shift; size_t bbatch; const char* SW;
    __device__ __forceinline__ void init(const void* A_, const void* B_, int lda_, int ldb_, int M, int N, int G_, int c_) {
        A = (const char*)A_; B = (const char*)B_; lda = lda_; ldb = ldb_; nM = M / BM; nN = N / BM; nwg = nM * nN; G = G_; c = c_; apn_shift = -1; akbytes = 0; bpm_shift = -1; bbatch = 0; SW = nullptr; }
    __device__ __forceinline__ bool next(int i, Unit& u) const {
        const long L = (long)i * G + c; if (L >= nwg) return false;
        int wgid = (int)L; { const int q = nwg / NXCD, r = nwg % NXCD, xcd = wgid % NXCD, off = wgid / NXCD; wgid = (xcd < r ? xcd * (q + 1) : r * (q + 1) + (xcd - r) * q) + off; }
        const int nig = WGM * nN, gid = wgid / nig, fm = gid * WGM, gsz = (nM - fm) < WGM ? (nM - fm) : WGM;
        const int pm = fm + ((wgid % nig) % gsz), pn = (wgid % nig) / gsz;
        u.pm = pm; u.pn = pn; u.aux = 0; u.lst = nullptr; u.nvalid = 256; u.S = SW ? SW + (size_t)pn * 8192 : nullptr; u.SA = nullptr;
        u.A = A + (size_t)pm * 256 * lda * 2 + (apn_shift >= 0 ? (size_t)(pn >> apn_shift) * akbytes : (size_t)0);
        u.B = B + (size_t)pn * 256 * ldb * 2 + (bpm_shift >= 0 ? (size_t)(pm >> bpm_shift) * bbatch : (size_t)0);
        return true;
    }
};
struct MoeSched {
    const char* A; const char* B; size_t bexp; const char* SW; int lda, ldb  , nN; const int* lists; volatile LAS const int* tab; volatile LAS const unsigned char* te; int G, c; bool gather; const char* SA;
    __device__ __forceinline__ bool next(int i, Unit& u) const {
        int pn, mg;
        if (G == 256) {
            const int x = c & 7, jj = c >> 3, pgs = nN >> 2, mgs = 8 / pgs;
            mg = i * (8 * mgs) + 8 * (x / pgs) + (jj & 7); pn = 4 * (x % pgs) + (jj >> 3);
            if (mg >= __builtin_amdgcn_readfirstlane(tab[32])) return false;
        } else { const int total = __builtin_amdgcn_readfirstlane(tab[32]) * nN; const long L = (long)i * G + c; if (L >= total) return false; pn = (int)(L % nN); mg = (int)(L / nN); }
        const int e = __builtin_amdgcn_readfirstlane((int)te[mg]), mt = mg - __builtin_amdgcn_readfirstlane(tab[e]);
        u.pm = mg; u.pn = pn; u.aux = e;
        if (gather) { u.A = A; u.lst = lists + (size_t)e * T + mt * 256; const int rem = __builtin_amdgcn_readfirstlane(tab[48 + e]) - mt * 256; u.nvalid = rem < 256 ? rem : 256; }
        else { u.A = A + (size_t)mg * 256 * lda; u.lst = nullptr; u.nvalid = 256; }
        u.B = B + (size_t)e * bexp + (size_t)pn * 256 * ldb; u.S = SW ? (SA ? SW + ((size_t)e * 4 + pn) * 4096 : SW + ((size_t)e * 8 + pn) * 8192) : nullptr; u.SA = SA ? SA + (size_t)mg * 8192 : nullptr;
        return true;
    }
};

#define EPI_ROW(u, ai, m) ((u).pm * 256 + (ai) * 128 + wr * 64 + (m) * 16 + fr)
struct EpiLat {
    static constexpr bool PERM = true;
    bf16_t* LAT; float* SSQ; bf16_t* KR; const float* CS; const float* SN;
    __device__ __forceinline__ void operator()(const f32x4 (&acc)[2][2][4][2], const Unit& u, int wr, int wc, int fr, int fq) const {
        if (u.pn < 4) {
#pragma unroll
            for (int ai = 0; ai < 2; ++ai)
#pragma unroll
                for (int m = 0; m < 4; ++m) { const int row = EPI_ROW(u, ai, m); float ss = 0.f;
#pragma unroll
                    for (int bj = 0; bj < 2; ++bj) { const f32x4 v0 = acc[ai][bj][m][0], v1 = acc[ai][bj][m][1];
                        ss += (v0[0] * v0[0] + v0[1] * v0[1]) + (v0[2] * v0[2] + v0[3] * v0[3]) + (v1[0] * v1[0] + v1[1] * v1[1]) + (v1[2] * v1[2] + v1[3] * v1[3]);
                        *(u32x4*)(LAT + (size_t)row * 1024 + u.pn * 256 + bj * 128 + wc * 32 + 8 * fq) = pack8(v0, v1); }
                    ss += __shfl_xor(ss, 16); ss += __shfl_xor(ss, 32);
                    if (fq == 0) SSQ[(size_t)row * 16 + u.pn * 4 + wc] = ss; }
        } else if (wc == 0) {
#pragma unroll
            for (int ai = 0; ai < 2; ++ai)
#pragma unroll
                for (int m = 0; m < 4; ++m) { const int row = EPI_ROW(u, ai, m);
                    const f32x4 c0 = *(const f32x4*)(CS + (size_t)row * 32 + 8 * fq), c1 = *(const f32x4*)(CS + (size_t)row * 32 + 8 * fq + 4);
                    const f32x4 s0 = *(const f32x4*)(SN + (size_t)row * 32 + 8 * fq), s1 = *(const f32x4*)(SN + (size_t)row * 32 + 8 * fq + 4);
                    const f32x4 a0 = acc[ai][0][m][0], a1 = acc[ai][0][m][1], b0 = acc[ai][1][m][0], b1 = acc[ai][1][m][1];
                    *(u32x4*)(KR + (size_t)row * 64 + 8 * fq) = pack8(a0 * c0 - b0 * s0, a1 * c1 - b1 * s1);
                    *(u32x4*)(KR + (size_t)row * 64 + 32 + 8 * fq) = pack8(b0 * c0 + a0 * s0, b1 * c1 + a1 * s1); }
        }
    }
};
struct EpiQ {
    static constexpr bool PERM = true;
    bf16_t* Q; const float* SSQ; const float* CS; const float* SN;
    __device__ __forceinline__ void operator()(const f32x4 (&acc)[2][2][4][2], const Unit& u, int wr, int wc, int fr, int fq) const {
#pragma unroll
        for (int ai = 0; ai < 2; ++ai)
#pragma unroll
            for (int m = 0; m < 4; ++m) { const int row = EPI_ROW(u, ai, m);
                const f32x4 q0 = *(const f32x4*)(SSQ + (size_t)row * 16), q1 = *(const f32x4*)(SSQ + (size_t)row * 16 + 4), q2 = *(const f32x4*)(SSQ + (size_t)row * 16 + 8);
                const float ss = ((q0[0] + q0[1]) + (q0[2] + q0[3])) + ((q1[0] + q1[1]) + (q1[2] + q1[3])) + ((q2[0] + q2[1]) + (q2[2] + q2[3]));
                const float r = QSCALE / sqrtf(ss * (1.0f / QL) + KF(RMS_EPS));
                if (u.pn < 4) {
#pragma unroll
                    for (int bj = 0; bj < 2; ++bj)
                        *(u32x4*)(Q + (size_t)row * 1536 + (2 * u.pn + bj) * 192 + wc * 32 + 8 * fq) = pack8(acc[ai][bj][m][0] * r, acc[ai][bj][m][1] * r);
                } else {
                    const int head = 4 * (u.pn - 4) + wc;
                    const f32x4 c0 = *(const f32x4*)(CS + (size_t)row * 32 + 8 * fq), c1 = *(const f32x4*)(CS + (size_t)row * 32 + 8 * fq + 4);
                    const f32x4 s0 = *(const f32x4*)(SN + (size_t)row * 32 + 8 * fq), s1 = *(const f32x4*)(SN + (size_t)row * 32 + 8 * fq + 4);
                    const f32x4 a0 = acc[ai][0][m][0] * r, a1 = acc[ai][0][m][1] * r, b0 = acc[ai][1][m][0] * r, b1 = acc[ai][1][m][1] * r;
                    *(u32x4*)(Q + (size_t)row * 1536 + head * 192 + 128 + 8 * fq) = pack8(a0 * c0 - b0 * s0, a1 * c1 - b1 * s1);
                    *(u32x4*)(Q + (size_t)row * 1536 + head * 192 + 160 + 8 * fq) = pack8(b0 * c0 + a0 * s0, b1 * c1 + a1 * s1);
                }
                asm volatile("" ::: "memory"); }
    }
};
struct EpiKV {
    static constexpr bool PERM = true;
    bf16_t* KN; bf16_t* V; const float* SSQ;
    __device__ __forceinline__ void operator()(const f32x4 (&acc)[2][2][4][2], const Unit& u, int wr, int wc, int fr, int fq) const {
#pragma unroll
        for (int ai = 0; ai < 2; ++ai)
#pragma unroll
            for (int m = 0; m < 4; ++m) { const int row = EPI_ROW(u, ai, m);
                const f32x4 q3 = *(const f32x4*)(SSQ + (size_t)row * 16 + 12);
                const float r = 1.0f / sqrtf(((q3[0] + q3[1]) + (q3[2] + q3[3])) * (1.0f / KVL) + KF(RMS_EPS));
                *(u32x4*)(KN + (size_t)row * 1024 + u.pn * 128 + wc * 32 + 8 * fq) = pack8(acc[ai][0][m][0] * r, acc[ai][0][m][1] * r);
                *(u32x4*)(V + (size_t)row * 1024 + u.pn * 128 + wc * 32 + 8 * fq) = pack8(acc[ai][1][m][0] * r, acc[ai][1][m][1] * r); }
    }
};
__device__ __forceinline__ f32x4 bf4_lo(const u32x4 w) { return (f32x4){bf_lo(w.x), bf_hi(w.x), bf_lo(w.y), bf_hi(w.y)}; }
__device__ __forceinline__ f32x4 bf4_hi(const u32x4 w) { return (f32x4){bf_lo(w.z), bf_hi(w.z), bf_lo(w.w), bf_hi(w.w)}; }
struct EpiRes {
    static constexpr bool PERM = true;
    const bf16_t* X; bf16_t* Y;
    __device__ __forceinline__ void operator()(const f32x4 (&acc)[2][2][4][2], const Unit& u, int wr, int wc, int fr, int fq) const {
        const bf16_t* xb = X + (size_t)u.pm * 256 * 1024; bf16_t* yb = Y + (size_t)u.pm * 256 * 1024; const unsigned o0 = (unsigned)((wr * 64 + fr) * 1024 + u.pn * 256 + wc * 32 + 8 * fq);
        u32x4 xw[2][4][2];
#pragma unroll
        for (int ai = 0; ai < 2; ++ai)
#pragma unroll
            for (int m = 0; m < 4; ++m)
#pragma unroll
                for (int bj = 0; bj < 2; ++bj) xw[ai][m][bj] = *(const u32x4*)(xb + (o0 + (unsigned)((ai * 128 + m * 16) * 1024 + bj * 128)));
#pragma unroll
        for (int ai = 0; ai < 2; ++ai)
#pragma unroll
            for (int m = 0; m < 4; ++m)
#pragma unroll
                for (int bj = 0; bj < 2; ++bj)
                    *(u32x4*)(yb + (o0 + (unsigned)((ai * 128 + m * 16) * 1024 + bj * 128))) = pack8(bf4_lo(xw[ai][m][bj]) * ALPHA + acc[ai][bj][m][0], bf4_hi(xw[ai][m][bj]) * ALPHA + acc[ai][bj][m][1]);
    }
};
struct EpiGU {
    static constexpr bool PERM = true;
    bf16_t* GG; bf16_t* U;
    __device__ __forceinline__ void operator()(const f32x4 (&acc)[2][2][4][2], const Unit& u, int wr, int wc, int fr, int fq) const {
#pragma unroll
        for (int ai = 0; ai < 2; ++ai)
#pragma unroll
            for (int m = 0; m < 4; ++m) { const int row = EPI_ROW(u, ai, m);
#pragma unroll
                for (int bj = 0; bj < 2; ++bj) { f32x4 v0 = acc[ai][bj][m][0], v1 = acc[ai][bj][m][1];
                    if (u.pn < 4) {
#pragma unroll
                        for (int e = 0; e < 4; ++e) { v0[e] = gelu_tanh(v0[e]); v1[e] = gelu_tanh(v1[e]); }
                        *(u32x4*)(GG + (size_t)row * 1024 + u.pn * 256 + bj * 128 + wc * 32 + 8 * fq) = pack8(v0, v1);
                    } else *(u32x4*)(U + (size_t)row * 1024 + (u.pn - 4) * 256 + bj * 128 + wc * 32 + 8 * fq) = pack8(v0, v1); } }
    }
};
struct EpiAB {
    static constexpr bool PERM = true;
    bf16_t* LA; bf16_t* BB; const bf16_t* UC; const float* BA; const float* BX; const float* SPL;
    __device__ __forceinline__ void operator()(const f32x4 (&acc)[2][2][4][2], const Unit& u, int wr, int wc, int fr, int fq) const {
        const int ch = (u.pn >> 1) * 256 + (u.pn & 1) * 128 + wc * 32 + 8 * fq;
        const float c3 = KF(0.16666667f), c4 = KF(0.041666668f), c5 = KF(0.0083333338f);
        f32x4 ba[2], bx[2], sp[2];
#pragma unroll
        for (int n = 0; n < 2; ++n) { ba[n] = *(const f32x4*)(BA + ch + 4 * n); bx[n] = *(const f32x4*)(BX + ch + 4 * n); sp[n] = *(const f32x4*)(SPL + ch + 4 * n); }
#pragma unroll
        for (int ai = 0; ai < 2; ++ai)
#pragma unroll
            for (int m = 0; m < 4; ++m) { const size_t off = (size_t)EPI_ROW(u, ai, m) * 1024 + ch;
                const u32x4 uw = *(const u32x4*)(UC + off); f32x4 uv[2] = {bf4_lo(uw), bf4_hi(uw)}, lv[2], bv[2];
#pragma unroll
                for (int n = 0; n < 2; ++n)
#pragma unroll
                    for (int e = 0; e < 4; ++e) { const float r = sigmoidf_(acc[ai][0][m][n][e] + ba[n][e]), ig = sigmoidf_(acc[ai][1][m][n][e] + bx[n][e]);
                        const float la = sp[n][e] * r, x2 = 2.0f * la; lv[n][e] = la * 1.4426950408889634f;
                        const float om = x2 > -0.25f ? -x2 * (1.0f + x2 * (0.5f + x2 * (c3 + x2 * (c4 + x2 * c5)))) : 1.0f - __expf(x2);
                        bv[n][e] = sqrtf(om) * ig * uv[n][e]; }
                *(u32x4*)(LA + off) = pack8(lv[0], lv[1]); *(u32x4*)(BB + off) = pack8(bv[0], bv[1]); asm volatile("" ::: "memory"); }
    }
};
struct EpiUp {
    static constexpr bool PERM = true;
    unsigned char* H; unsigned char* SH; const float* BU;
    __device__ __forceinline__ void operator()(f32x4 (&acc)[2][2][4][2], const Unit& u, int wr, int wc, int fr, int fq) const {
        const int gc = u.pn * 128 + wc * 32 + 8 * fq; const float* bu = BU + (size_t)u.aux * 2048;
        const float k7 = KF(7.0f), km7 = KF(-7.0f), ka = KF(1.702f);
#pragma unroll
        for (int n = 0; n < 2; ++n) { const f32x4 bg = *(const f32x4*)(bu + gc + 4 * n), bp = *(const f32x4*)(bu + 1024 + gc + 4 * n);
#pragma unroll
            for (int ai = 0; ai < 2; ++ai)
#pragma unroll
                for (int m = 0; m < 4; ++m) {
#pragma unroll
                    for (int e = 0; e < 4; ++e) { const float g = fminf(acc[ai][0][m][n][e] + bg[e], k7), up = fminf(fmaxf(acc[ai][1][m][n][e] + bp[e], km7), k7);
                        acc[ai][0][m][n][e] = (up + 1.0f) * (g * sigmoidf_(ka * g)); }
                    if (m & 1) __builtin_amdgcn_sched_barrier(0); }
            asm volatile("" ::: "memory"); }
        unsigned char* const shb = SH + ((size_t)u.pm * 8 + u.pn) * 1024; unsigned char* const hb = H + (size_t)u.pm * 256 * 1024;
        const unsigned ho = (unsigned)((wr * 64 + fr) * 1024 + gc), so = (unsigned)((wr * 64 + fr) * 4 + wc);
#pragma unroll
        for (int ai = 0; ai < 2; ++ai)
#pragma unroll
            for (int m = 0; m < 4; ++m) { const f32x4 y0 = acc[ai][0][m][0], y1 = acc[ai][0][m][1];
                float am = fmaxf(fmaxf(fmaxf(fabsf(y0[0]), fabsf(y0[1])), fmaxf(fabsf(y0[2]), fabsf(y0[3]))), fmaxf(fmaxf(fabsf(y1[0]), fabsf(y1[1])), fmaxf(fabsf(y1[2]), fabsf(y1[3]))));
                { auto r16 = __builtin_amdgcn_permlane16_swap(__float_as_uint(am), __float_as_uint(am), false, false); am = fmaxf(__uint_as_float(r16[0]), __uint_as_float(r16[1]));
                  auto r32 = __builtin_amdgcn_permlane32_swap(__float_as_uint(am), __float_as_uint(am), false, false); am = fmaxf(__uint_as_float(r32[0]), __uint_as_float(r32[1])); }
                int eb = (int)((__float_as_uint(am) >> 23) & 0xffu) - 7; eb = eb < 1 ? 1 : eb;
                const float inv = __uint_as_float((unsigned)(254 - eb) << 23);
                int w0 = __builtin_amdgcn_cvt_pk_fp8_f32(y0[0] * inv, y0[1] * inv, 0, false); w0 = __builtin_amdgcn_cvt_pk_fp8_f32(y0[2] * inv, y0[3] * inv, w0, true);
                int w1 = __builtin_amdgcn_cvt_pk_fp8_f32(y1[0] * inv, y1[1] * inv, 0, false); w1 = __builtin_amdgcn_cvt_pk_fp8_f32(y1[2] * inv, y1[3] * inv, w1, true);
                *(u32x2*)(hb + (ho + (unsigned)((ai * 128 + m * 16) * 1024))) = (u32x2){(unsigned)w0, (unsigned)w1};
                if (fq == 0) shb[so + (unsigned)((ai * 128 + m * 16) * 4)] = (unsigned char)eb;
                asm volatile("" ::: "memory"); __builtin_amdgcn_sched_barrier(0); }
    }
};
struct EpiDown {
    static constexpr bool PERM = true;
    unsigned char* YS; unsigned char* SY; const float* BD;
    __device__ __forceinline__ void operator()(const f32x4 (&acc)[2][2][4][2], const Unit& u, int wr, int wc, int fr, int fq) const {
        const float* bd = BD + (size_t)u.aux * 1024;
        unsigned char* const yb = YS + (size_t)u.pm * 256 * 1024; unsigned char* const sb = SY + (size_t)u.pm * 256 * 32;
#pragma unroll
        for (int bj = 0; bj < 2; ++bj) { const int col = u.pn * 256 + bj * 128 + wc * 32 + 8 * fq; const f32x4 b0 = *(const f32x4*)(bd + col), b1 = *(const f32x4*)(bd + col + 4);
#pragma unroll
            for (int ai = 0; ai < 2; ++ai)
#pragma unroll
                for (int m = 0; m < 4; ++m) { const unsigned rit = (unsigned)(ai * 128 + wr * 64 + m * 16 + fr); const f32x4 y0 = acc[ai][bj][m][0] + b0, y1 = acc[ai][bj][m][1] + b1;
                    float am = fmaxf(fmaxf(fmaxf(fabsf(y0[0]), fabsf(y0[1])), fmaxf(fabsf(y0[2]), fabsf(y0[3]))), fmaxf(fmaxf(fabsf(y1[0]), fabsf(y1[1])), fmaxf(fabsf(y1[2]), fabsf(y1[3]))));
                    { auto r16 = __builtin_amdgcn_permlane16_swap(__float_as_uint(am), __float_as_uint(am), false, false); am = fmaxf(__uint_as_float(r16[0]), __uint_as_float(r16[1]));
                      auto r32 = __builtin_amdgcn_permlane32_swap(__float_as_uint(am), __float_as_uint(am), false, false); am = fmaxf(__uint_as_float(r32[0]), __uint_as_float(r32[1])); }
                    int eb = (int)((__float_as_uint(am) >> 23) & 0xffu) - 7; eb = eb < 1 ? 1 : eb;
                    const float inv = __uint_as_float((unsigned)(254 - eb) << 23);
                    int w0 = __builtin_amdgcn_cvt_pk_fp8_f32(y0[0] * inv, y0[1] * inv, 0, false); w0 = __builtin_amdgcn_cvt_pk_fp8_f32(y0[2] * inv, y0[3] * inv, w0, true);
                    int w1 = __builtin_amdgcn_cvt_pk_fp8_f32(y1[0] * inv, y1[1] * inv, 0, false); w1 = __builtin_amdgcn_cvt_pk_fp8_f32(y1[2] * inv, y1[3] * inv, w1, true);
                    *(u32x2*)(yb + (rit * 1024u + (unsigned)col)) = (u32x2){(unsigned)w0, (unsigned)w1};
                    if (fq == 0) sb[rit * 32u + (unsigned)(col >> 5)] = (unsigned char)eb;
                    asm volatile("" ::: "memory"); } }
    }
};
struct EpiPle {
    static constexpr bool PERM = true;
    const bf16_t* X2; const bf16_t* PP; float* OUT; bf16_t* XB;
    __device__ __forceinline__ void operator()(const f32x4 (&acc)[2][2][4][2], const Unit& u, int wr, int wc, int fr, int fq) const {
        const size_t tb = (size_t)u.pm * 256 * 1024; const unsigned o0 = (unsigned)((wr * 64 + fr) * 1024 + u.pn * 256 + wc * 32 + 8 * fq);
#pragma unroll
        for (int ai = 0; ai < 2; ++ai) {
            u32x4 xw[4][2], pw[4][2];
#pragma unroll
            for (int m = 0; m < 4; ++m)
#pragma unroll
                for (int bj = 0; bj < 2; ++bj) { const unsigned o = o0 + (unsigned)((ai * 128 + m * 16) * 1024 + bj * 128); xw[m][bj] = *(const u32x4*)(X2 + tb + o); pw[m][bj] = *(const u32x4*)(PP + tb + o); }
#pragma unroll
            for (int m = 0; m < 4; ++m)
#pragma unroll
                for (int bj = 0; bj < 2; ++bj) { const unsigned o = o0 + (unsigned)((ai * 128 + m * 16) * 1024 + bj * 128);
                    const f32x4 a0 = acc[ai][bj][m][0], a1 = acc[ai][bj][m][1], x0 = bf4_lo(xw[m][bj]), x1 = bf4_hi(xw[m][bj]), p0 = bf4_lo(pw[m][bj]), p1 = bf4_hi(pw[m][bj]); f32x4 r0, r1;
#pragma unroll
                    for (int e = 0; e < 4; ++e) { r0[e] = x0[e] + sigmoidf_(a0[e]) * p0[e]; r1[e] = x1[e] + sigmoidf_(a1[e]) * p1[e]; }
                    *(u32x4*)(XB + tb + o) = pack8(r0, r1);
                    if (OUT) { *(f32x4*)(OUT + tb + o) = r0; *(f32x4*)(OUT + tb + o + 4) = r1; } }
            asm volatile("" ::: "memory"); }
    }
};
struct EpiPP {
    static constexpr bool PERM = true;
    bf16_t* PP;
    __device__ __forceinline__ void operator()(const f32x4 (&acc)[2][2][4][2], const Unit& u, int wr, int wc, int fr, int fq) const {
#pragma unroll
        for (int ai = 0; ai < 2; ++ai)
#pragma unroll
            for (int m = 0; m < 4; ++m)
#pragma unroll
                for (int bj = 0; bj < 2; ++bj) *(u32x4*)(PP + (size_t)EPI_ROW(u, ai, m) * 1024 + u.pn * 256 + bj * 128 + wc * 32 + 8 * fq) = pack8(acc[ai][bj][m][0], acc[ai][bj][m][1]);
    }
};
}

namespace att {
constexpr int NW = 8, QBLK = 32, KVBLK = 64, QB = 256, KPITCH = 384;
constexpr int SHM_V = KVBLK * DV * 2, SHM_K = KVBLK * KPITCH;
constexpr int NVB = 3;
constexpr int OFF_V = 0, OFF_K = NVB * SHM_V, OFF_WS = OFF_K + 2 * SHM_K, LDS_BYTES = OFF_WS + NW * 64 * 4;
#define SBAR() __builtin_amdgcn_sched_barrier(0)
__device__ __forceinline__ int k_addr(int row, int chunk) { return row * KPITCH + ((chunk ^ ((row >> 1) & 7)) << 4); }
__device__ __forceinline__ int v_st(int k, int c) { const int kk = (k & ~0xC) | ((k & 4) << 1) | ((k & 8) >> 1); return ((kk >> 3) * 4 + (c >> 5)) * 512 + ((kk & 7) * 32 + (c & 31)) * 2; }
__device__ __forceinline__ int v_rd_base(int lane) { return ((lane & 3) << 3) | (((lane >> 2) & 3) << 6) | (((lane >> 4) & 1) << 5) | (((lane >> 5) & 1) << 8); }
constexpr int v_rd_off(int d0, int ks, int half) { return d0 * 512 + ks * 4096 + half * 2048; }
__device__ __forceinline__ int crow(int r, int hi) { return (r & 3) + 8 * (r >> 2) + 4 * hi; }

template <int KB>
__device__ __forceinline__ void qkt(f32x16& p0, f32x16& p1, const LAS char* K_lds, int r32, int hi, const bf16x8* qr) {
    p0 = f32x16{}; p1 = f32x16{};
    const LAS char* kb[4];
#pragma unroll
    for (int dd = 0; dd < 4; ++dd) kb[dd] = K_lds + KB * SHM_K + r32 * KPITCH + (((2 * dd + hi) ^ ((r32 >> 1) & 7)) << 4);
    bf16x8 f[2][4];
#define QK_LD(g, buf) do { _Pragma("unroll") for (int e_ = 0; e_ < 2; ++e_) { const int d0_ = 2 * (g) + e_; const LAS char* a_ = kb[d0_ & 3] + (d0_ >> 2) * 128; \
        f[buf][2 * e_] = *(const LAS bf16x8*)a_; f[buf][2 * e_ + 1] = *(const LAS bf16x8*)(a_ + 32 * KPITCH); } } while (0)
    QK_LD(0, 0);
#pragma unroll
    for (int g = 0; g < 6; ++g) {
        if (g < 5) QK_LD(g + 1, (g + 1) & 1);
        SBAR();
#pragma unroll
        for (int e = 0; e < 2; ++e) { const int d0 = 2 * g + e;
            p0 = __builtin_amdgcn_mfma_f32_32x32x16_bf16(f[g & 1][2 * e], qr[d0], p0, 0, 0, 0);
            p1 = __builtin_amdgcn_mfma_f32_32x32x16_bf16(f[g & 1][2 * e + 1], qr[d0], p1, 0, 0, 0); }
        SBAR(); }
#undef QK_LD
}
__device__ __forceinline__ void pv_tile(f32x16* o, int vb0  , bf16x8 pa0, bf16x8 pa1, bf16x8 pa2, bf16x8 pa3) {
#define TRRD(dst, off) asm volatile("ds_read_b64_tr_b16 %0, %1 offset:%2" : "=&v"(dst) : "v"(vb0), "i"(off) : "memory")
#define PV_D0(d0) do { s16x4 l0, l1, l2, l3, h0, h1, h2, h3; constexpr int b_ = v_rd_off(d0, 0, 0); \
        TRRD(l0, b_); TRRD(h0, b_ + 2048); TRRD(l1, b_ + 4096); TRRD(h1, b_ + 6144); TRRD(l2, b_ + 8192); TRRD(h2, b_ + 10240); TRRD(l3, b_ + 12288); TRRD(h3, b_ + 14336); \
        asm volatile("s_waitcnt lgkmcnt(0)" ::: "memory"); SBAR(); \
        o[d0] = __builtin_amdgcn_mfma_f32_32x32x16_bf16(pa0, (bf16x8){l0[0], l0[1], l0[2], l0[3], h0[0], h0[1], h0[2], h0[3]}, o[d0], 0, 0, 0); \
        o[d0] = __builtin_amdgcn_mfma_f32_32x32x16_bf16(pa1, (bf16x8){l1[0], l1[1], l1[2], l1[3], h1[0], h1[1], h1[2], h1[3]}, o[d0], 0, 0, 0); \
        o[d0] = __builtin_amdgcn_mfma_f32_32x32x16_bf16(pa2, (bf16x8){l2[0], l2[1], l2[2], l2[3], h2[0], h2[1], h2[2], h2[3]}, o[d0], 0, 0, 0); \
        o[d0] = __builtin_amdgcn_mfma_f32_32x32x16_bf16(pa3, (bf16x8){l3[0], l3[1], l3[2], l3[3], h3[0], h3[1], h3[2], h3[3]}, o[d0], 0, 0, 0); } while (0)
    PV_D0(0); PV_D0(1); PV_D0(2); PV_D0(3);
#undef PV_D0
#undef TRRD
}
__device__ __forceinline__ void mask_tile(f32x16& p0, f32x16& p1, int dq  ) {
    const float NEG = -__builtin_inff();
#pragma unroll
    for (int r = 0; r < 16; ++r) { const int c = (r & 3) + 8 * (r >> 2);
        if (c > dq) p0[r] = NEG;
        if (c + 32 > dq) p1[r] = NEG; }
}
__device__ __forceinline__ void softmax_tile(f32x16& p0, f32x16& p1, float& m_reg, float& l_reg, float& alpha, bf16x8& pa0, bf16x8& pa1, bf16x8& pa2, bf16x8& pa3) {
    float pmax = p0[0];
#pragma unroll
    for (int r = 1; r < 16; ++r) pmax = fmaxf(pmax, p0[r]);
#pragma unroll
    for (int r = 0; r < 16; ++r) pmax = fmaxf(pmax, p1[r]);
    { auto rr = __builtin_amdgcn_permlane32_swap(__float_as_uint(pmax), __float_as_uint(pmax), false, false); pmax = fmaxf(__uint_as_float(rr[0]), __uint_as_float(rr[1])); }
    float mn = m_reg; alpha = 1.f;
    if (!__all(pmax - m_reg <= 8.0f)) { mn = fmaxf(m_reg, pmax); alpha = __builtin_amdgcn_exp2f(m_reg - mn); m_reg = mn; }
    float ps = 0.f;
#pragma unroll
    for (int r = 0; r < 16; ++r) { p0[r] = __builtin_amdgcn_exp2f(p0[r] - mn); ps += p0[r]; }
#pragma unroll
    for (int r = 0; r < 16; ++r) { p1[r] = __builtin_amdgcn_exp2f(p1[r] - mn); ps += p1[r]; }
    { auto rr = __builtin_amdgcn_permlane32_swap(__float_as_uint(ps), __float_as_uint(ps), false, false); ps = __uint_as_float(rr[0]) + __uint_as_float(rr[1]); }
    l_reg = l_reg * alpha + ps;
#define PK4(P, B_, OUT) do { unsigned a0 = cvt_pk_bf16(P[B_+0], P[B_+1]), a1 = cvt_pk_bf16(P[B_+2], P[B_+3]); \
        unsigned b0 = cvt_pk_bf16(P[B_+4], P[B_+5]), b1 = cvt_pk_bf16(P[B_+6], P[B_+7]); \
        auto r0 = __builtin_amdgcn_permlane32_swap(a0, b0, false, false); auto r1 = __builtin_amdgcn_permlane32_swap(a1, b1, false, false); \
        u32x4 w = {r0[0], r1[0], r0[1], r1[1]}; OUT = __builtin_bit_cast(bf16x8, w); } while (0)
    PK4(p0, 0, pa0); PK4(p0, 8, pa1); PK4(p1, 0, pa2); PK4(p1, 8, pa3);
#undef PK4
}

__device__ __forceinline__ void attn_block(int b, int h, int qb, const bf16_t* Q, const bf16_t* KN, const bf16_t* KR, const bf16_t* V, bf16_t* O, LAS char* lds, unsigned long long* pw = nullptr) {
    const int tid = opaque_tid(), wid = __builtin_amdgcn_readfirstlane(tid >> 6), lane = tid & 63, r32 = lane & 31, hi = lane >> 5;
    const size_t row0 = (size_t)b * SEQ;
    const int q0 = qb * QB + wid * QBLK;
    const int NT = (qb + 1) * (QB / KVBLK);
    LAS char* V_lds = lds + OFF_V; LAS char* K_lds = lds + OFF_K;
    LAS float* ws = (LAS float*)(lds + OFF_WS) + wid * 64; LAS float* li_l = ws; LAS float* al_l = ws + 32;
    const int sr = tid >> 4, sc = (tid & 15) * 8, kr_row = tid >> 3, kr_c = tid & 7;
    const int vst0 = v_st(sr, sc), vst1 = v_st(32 + sr, sc), kws = k_addr(sr, tid & 15), kwr = k_addr(kr_row, 16 + kr_c);
    const int vb0 = (int)(uintptr_t)lds + v_rd_base(lane);
    const bf16_t* KNh = KN + row0 * 1024 + h * 128 + sc; const bf16_t* Vh = V + row0 * 1024 + h * 128 + sc; const bf16_t* KRb = KR + row0 * 64 + kr_c * 8;
    bf16x8 st_k0, st_k1, st_kr, st_v0, st_v1;
#define SLOAD(t) do { const size_t k0_ = (size_t)(t) * KVBLK; \
        st_k0 = *(const bf16x8*)(KNh + (k0_ + sr) * 1024); st_k1 = *(const bf16x8*)(KNh + (k0_ + 32 + sr) * 1024); st_kr = *(const bf16x8*)(KRb + (k0_ + kr_row) * 64); \
        st_v0 = *(const bf16x8*)(Vh + (k0_ + sr) * 1024); st_v1 = *(const bf16x8*)(Vh + (k0_ + 32 + sr) * 1024); } while (0)
#define SWRITE(bf, vo) do { *(LAS bf16x8*)(K_lds + (bf) * SHM_K + kws) = st_k0; *(LAS bf16x8*)(K_lds + (bf) * SHM_K + kws + 32 * KPITCH) = st_k1; *(LAS bf16x8*)(K_lds + (bf) * SHM_K + kwr) = st_kr; \
        *(LAS bf16x8*)(V_lds + (vo) + vst0) = st_v0; *(LAS bf16x8*)(V_lds + (vo) + vst1) = st_v1; } while (0)
    SLOAD(0);
    bf16x8 qr[12];
    { const bf16_t* Qw = Q + (row0 + q0 + r32) * 1536 + h * 192 + hi * 8;
#pragma unroll
      for (int d0 = 0; d0 < 12; ++d0) qr[d0] = *(const bf16x8*)(Qw + d0 * 16); }
    float m_reg = -1e30f, l_reg = 0.f; f32x16 o[4] = {};
    f32x16 p0, p1; bf16x8 pa0, pa1, pa2, pa3; float alpha;
    asm volatile("s_waitcnt vmcnt(0)" ::: "memory");
    SWRITE(0, 0);
    __syncthreads();
    const bool odd = wid >= 4; int vo_prev = 0, vo_cur = 0, vo_next = SHM_V;
#define RESC(a) do { if (__any((a) < 1.f)) { if (hi == 0) al_l[r32] = (a); asm volatile("s_waitcnt lgkmcnt(0)" ::: "memory"); \
        _Pragma("unroll") for (int d_ = 0; d_ < 4; ++d_) _Pragma("unroll") for (int r = 0; r < 16; ++r) o[d_][r] *= al_l[crow(r, hi)]; } } while (0)
#if PROBE_T
    unsigned long long pa_ = 0, pb_ = 0, pc_ = 0, pd_ = 0, pe2_ = 0; const unsigned long long pst_ = __builtin_amdgcn_s_memtime();
#define PSTAMP(v) const unsigned long long v = __builtin_amdgcn_s_memtime()
#define PACC(acc, a, b) acc += (b) - (a)
#else
#define PSTAMP(v) do {} while (0)
#define PACC(acc, a, b) do {} while (0)
#endif
#define TILE(t, BF) do { PSTAMP(s0_); const bool more_ = ((t) + 1 < NT); if (more_) SLOAD((t) + 1); SBAR(); \
        if (odd && (t) > 0) { pv_tile(o, vb0 + vo_prev, pa0, pa1, pa2, pa3); SBAR(); } \
        PSTAMP(s1_); qkt<BF>(p0, p1, K_lds, r32, hi, qr); \
        { const int kb_ = (t) * KVBLK; if (kb_ + KVBLK - 1 > q0) mask_tile(p0, p1, q0 + r32 - kb_ - 4 * hi); } \
        asm volatile("" : "+v"(p0), "+v"(p1)); PSTAMP(s2_); \
        softmax_tile(p0, p1, m_reg, l_reg, alpha, pa0, pa1, pa2, pa3); RESC(alpha); SBAR(); PSTAMP(s3_); \
        if (!odd) pv_tile(o, vb0 + vo_cur, pa0, pa1, pa2, pa3); \
        PSTAMP(s4_); if (more_) { asm volatile("s_waitcnt vmcnt(0)" ::: "memory"); SWRITE((BF) ^ 1, vo_next); } \
        PSTAMP(s5_); __syncthreads(); PSTAMP(s6_); PACC(pa_, s1_, s2_); PACC(pb_, s2_, s3_); PACC(pc_, s3_, s4_); PACC(pd_, s4_, s5_); PACC(pe2_, s5_, s6_); vo_prev = vo_cur; vo_cur = vo_next; vo_next = (vo_next == (NVB - 1) * SHM_V) ? 0 : vo_next + SHM_V; } while (0)
#pragma unroll 1
    for (int t = 0; t < NT; t += 2) { TILE(t, 0); TILE(t + 1, 1); }
    if (odd) pv_tile(o, vb0 + vo_prev, pa0, pa1, pa2, pa3);
#if PROBE_T
    if (pw && blockIdx.x == 0 && tid == 0) { pw[8] += pa_; pw[9] += pb_; pw[10] += pc_; pw[11] += pd_; pw[12] += pe2_; pw[13] += (unsigned long long)NT; pw[14] += __builtin_amdgcn_s_memtime() - pst_; }
#endif
    if (hi == 0) li_l[r32] = l_reg; asm volatile("s_waitcnt lgkmcnt(0)" ::: "memory");
    __syncthreads();
    { LAS bf16_t* stg = (LAS bf16_t*)(lds + wid * 8704);
#pragma unroll
      for (int r = 0; r < 16; ++r) { const int orow = crow(r, hi); const float rl = __builtin_amdgcn_rcpf(li_l[orow]);
#pragma unroll
          for (int d0 = 0; d0 < 4; ++d0) { const float v = o[d0][r] * rl; stg[orow * 136 + d0 * 32 + r32] = (bf16_t)(cvt_pk_bf16(v, v) & 0xffffu); } }
      asm volatile("s_waitcnt lgkmcnt(0)" ::: "memory");
      bf16_t* Ow = O + (row0 + q0) * 1024 + h * 128 + (lane & 15) * 8;
#pragma unroll
      for (int it = 0; it < 8; ++it) { const int row = it * 4 + (lane >> 4); const u32x4 v = *(const LAS u32x4*)(stg + row * 136 + (lane & 15) * 8); *(u32x4*)(Ow + (size_t)row * 1024) = v; } }
    __syncthreads();
#undef SLOAD
#undef SWRITE
#undef RESC
#undef TILE
#undef PSTAMP
#undef PACC
}
#undef SBAR
}

#define XB_TMO      128
#define XB_XCNT(j)  (256  + 64 * (j))
#define XB_XSUB(j)  (1280 + 64 * (j))
#define XB_XGEN(j)  (2304 + 64 * (j))
#define XB_TOP      3328
#define XB_TOPGEN   3392
#define XCD_BAR_WORDS 3456
#define XB_SPIN_CAP (1u << 22)
__device__ __forceinline__ unsigned xb_ld(unsigned* p)              { return __hip_atomic_load(p, __ATOMIC_RELAXED, __HIP_MEMORY_SCOPE_AGENT); }
__device__ __forceinline__ unsigned xb_add(unsigned* p, unsigned v) { return __hip_atomic_fetch_add(p, v, __ATOMIC_RELAXED, __HIP_MEMORY_SCOPE_AGENT); }
__device__ __forceinline__ unsigned xb_xcc_id() { return (unsigned)__builtin_amdgcn_s_getreg((3 << 11) | 20) & 0xFu; }
#define XB_SPIN(cond, bar) do { unsigned _sp = 0; while (cond) { __builtin_amdgcn_s_sleep(1); \
    if ((++_sp & 255u) == 0u) { if (xb_ld(&(bar)[XB_TMO])) break; if (_sp > XB_SPIN_CAP) { atomicAdd(&(bar)[XB_TMO], 1u); break; } } } } while (0)
struct XcdBarrier { unsigned* bar; unsigned x; volatile LAS unsigned* st; };
__device__ __forceinline__ XcdBarrier xcd_barrier_post(unsigned* bar, volatile LAS unsigned* st) {
    XcdBarrier b; b.bar = bar; b.x = xb_xcc_id(); b.st = st;
    if (threadIdx.x == 0) (void)xb_add(&bar[XB_XCNT(b.x)], 1u);
    return b;
}
__device__ __forceinline__ void xcd_barrier_complete(unsigned* bar, unsigned x, unsigned& nloc, unsigned& nx) {
    const unsigned G = gridDim.x * gridDim.y * gridDim.z;
    unsigned sum, cnt, mine, sp = 0u;
    for (;;) {
        sum = 0u; cnt = 0u; mine = 0u;
#pragma unroll
        for (unsigned j = 0; j < 16; ++j) { const unsigned c = xb_ld(&bar[XB_XCNT(j)]); sum += c; cnt += (c > 0u) ? 1u : 0u; mine = (j == x) ? c : mine; }
        if (sum == G) break;
        __builtin_amdgcn_s_sleep(1);
        if ((++sp & 255u) == 0u) { if (xb_ld(&bar[XB_TMO])) break; if (sp > XB_SPIN_CAP) { atomicAdd(&bar[XB_TMO], 1u); break; } }
    }
    nloc = mine > 0u ? mine : 1u; nx = cnt > 0u ? cnt : 1u;
}
__device__ __forceinline__ void xcd_barrier(const XcdBarrier& b) {
    asm volatile("s_waitcnt vmcnt(0)" ::: "memory");
    __syncthreads();
    if (opaque_tid() == 0) {
        unsigned* bar = b.bar; unsigned bx = b.x;
        asm volatile("" : "+s"(bar), "+s"(bx));
        __builtin_amdgcn_s_waitcnt(0);
        unsigned nloc = b.st[0], nx = b.st[1];
        if (nloc == 0u) { xcd_barrier_complete(bar, bx, nloc, nx); b.st[0] = nloc; b.st[1] = nx; }
        const unsigned old = xb_add(&bar[XB_XSUB(bx)], 1u);
        const unsigned gen = old / nloc;
        if (old + 1u == (gen + 1u) * nloc) {
            __builtin_amdgcn_fence(__ATOMIC_RELEASE, "agent");
            asm volatile("s_waitcnt vmcnt(0)" ::: "memory");
            const unsigned og = xb_add(&bar[XB_TOP], 1u);
            const unsigned tg = og / nx;
            if (og + 1u == (tg + 1u) * nx) xb_add(&bar[XB_TOPGEN], 1u);
            else XB_SPIN(xb_ld(&bar[XB_TOPGEN]) == tg, bar);
            __builtin_amdgcn_fence(__ATOMIC_ACQUIRE, "agent");
            xb_add(&bar[XB_XGEN(bx)], 1u);
            asm volatile("s_waitcnt vmcnt(0)" ::: "memory");
        } else {
            XB_SPIN(xb_ld(&bar[XB_XGEN(bx)]) == gen, bar);
            __builtin_amdgcn_fence(__ATOMIC_ACQUIRE, "agent");
            asm volatile("s_waitcnt vmcnt(0)" ::: "memory");
        }
    }
    __syncthreads();
}

struct Args { const void* in[30]; float* out; unsigned char* ws; int ph_lo, ph_hi, li, pad; };
struct Ctx { int tid, lane, wave, vcu, G, bid; LAS unsigned char* lds; volatile LAS int* misc; };
__device__ __forceinline__ Ctx fresh_ctx(const Ctx& c) {
    Ctx r = c; unsigned l = (unsigned)(uintptr_t)c.lds, m = (unsigned)(uintptr_t)c.misc;
    asm volatile("" : "+s"(r.wave), "+s"(r.vcu), "+s"(r.G), "+s"(r.bid), "+s"(l), "+s"(m));
    r.lds = (LAS unsigned char*)(uintptr_t)l; r.misc = (volatile LAS int*)(uintptr_t)m; r.tid = opaque_tid(); r.lane = r.tid & 63; return r; }
typedef const CAS Args* ArgsP;
__device__ __forceinline__ const CAS Args& fresh_args(ArgsP p) { asm volatile("" : "+s"(p)); return *p; }
enum { I_X = 0, I_P, I_POS, I_MLA_WIN, I_MLA_QN, I_MLA_KVN, I_MLA_WUQ, I_MLA_WUKV, I_MLA_WO, I_LRU_WIN, I_LRU_CW, I_LRU_CB, I_LRU_WA, I_LRU_BA, I_LRU_WX, I_LRU_BX, I_LRU_LAM, I_LRU_WOUT,
       I_LN1G, I_LN1B, I_LN2G, I_LN2B, I_MOE_WR, I_MOE_BR, I_MOE_WUP, I_MOE_BUP, I_MOE_WDN, I_MOE_BDN, I_PLE_WG, I_PLE_WP };
#define INF(i) ((const float*)args.in[i])
#define WSP(T_, off) ((T_*)(args.ws + (off)))

__device__ __forceinline__ void tr_load(const float* W, int ld, int k0, int sc0, int sc1, int lane, f32x4 (&v)[16]) {
    const int half = (lane & 15) >> 3, scol = half ? sc1 : sc0, c4 = (lane & 7) * 4, rs = lane >> 4;
#pragma unroll
    for (int i = 0; i < 8; ++i) { const float* p = W + (size_t)(k0 + 8 * i + 2 * rs) * ld + scol + c4;
        v[2 * i] = (scol >= 0) ? *(const f32x4*)p : (f32x4){0.f, 0.f, 0.f, 0.f}; v[2 * i + 1] = (scol >= 0) ? *(const f32x4*)(p + ld) : (f32x4){0.f, 0.f, 0.f, 0.f}; }
}
__device__ __forceinline__ void tr_store(f32x4 (&v)[16], const float* ksc, int k0, bf16_t* dst  , int K, LAS unsigned* scr, int lane) {
    const int rs = lane >> 4;
    if (ksc) {
#pragma unroll
        for (int i = 0; i < 8; ++i) { v[2 * i] = v[2 * i] * ksc[k0 + 8 * i + 2 * rs]; v[2 * i + 1] = v[2 * i + 1] * ksc[k0 + 8 * i + 2 * rs + 1]; } }
#pragma unroll
    for (int i = 0; i < 8; ++i) { LAS unsigned* s = scr + (4 * i + rs) * 65 + (lane & 15) * 4;
#pragma unroll
        for (int e = 0; e < 4; ++e) s[e] = cvt_pk_bf16(v[2 * i][e], v[2 * i + 1][e]); }
    asm volatile("s_waitcnt lgkmcnt(0)" ::: "memory");
    const int c = lane & 7;
#pragma unroll
    for (int j = 0; j < 8; ++j) { const int n = (lane >> 3) + 8 * j; const LAS unsigned* s = scr + (4 * c) * 65 + n;
        u32x4 o; o.x = s[0]; o.y = s[65]; o.z = s[130]; o.w = s[195];
        *(u32x4*)(dst + (size_t)n * K + 8 * c) = o; }
    asm volatile("s_waitcnt lgkmcnt(0)" ::: "memory");
}
enum { J_NAT = 0, J_MLA_WIN, J_MLA_WUQ, J_LRU_WAX, J_MOE_UP };
__device__ __forceinline__ int tr_map(int job, int g) {
    switch (job) {
    case J_MLA_WIN: return g < 32 ? 32 * g : (g == 32 ? 1024 : (g == 36 ? 1056 : -1));
    case J_MLA_WUQ: if (g < 32) { const int t = g >> 3, bj = (g >> 2) & 1, cg = g & 3; return (2 * t + bj) * 192 + 32 * cg; }
                    else { const int g2 = g - 32, t2 = g2 >> 3, bj = (g2 >> 2) & 1, hh = g2 & 3; return (4 * t2 + hh) * 192 + 128 + 32 * bj; }
    case J_LRU_WAX: { const int pn = g >> 3, cg = g & 3; return 128 * pn + 32 * cg; }
    case J_MOE_UP:  { const int pn = g >> 3, bj = (g >> 2) & 1, cg = g & 3; return bj * 1024 + 128 * pn + 32 * cg; }
    default: return 32 * g;
    }
}
__device__ __forceinline__ void tr_job(const Ctx& C, int job, const float* src, size_t srcstride, int nmat, int K, int ld, int N, bf16_t* dst, size_t dststride, const float* ksc, int kscstride,
                                       const float* src2  ) {
    LAS unsigned* scr = (LAS unsigned*)(C.lds + C.wave * 8320);
    const int gw = C.vcu * NWAVES + C.wave, NGW = C.G * NWAVES;
    const int nkb = K / 64, nnb = N / 64, per = nkb * nnb, total = per * nmat;
#define TR_DECODE(it_, W_, k0_, s0_, s1_, ks_, d_) do { const int mat_ = (it_) / per, r_ = (it_) - mat_ * per, kb_ = r_ / nnb, nb_ = r_ - kb_ * nnb; \
        s0_ = tr_map(job, 2 * nb_); s1_ = tr_map(job, 2 * nb_ + 1); W_ = src + (size_t)mat_ * srcstride; \
        if (job == J_LRU_WAX && ((nb_ >> 1) & 1)) W_ = src2 + (size_t)mat_ * srcstride;       \
        k0_ = kb_ * 64; ks_ = ksc ? ksc + (size_t)mat_ * kscstride : nullptr; d_ = (bf16_t*)((char*)dst + (size_t)mat_ * dststride) + (size_t)(nb_ * 64) * K + kb_ * 64; } while (0)
    f32x4 va[16], vb[16];
    int it = gw; const float* Wc; int k0c, s0c, s1c; const float* ksc_c; bf16_t* dc;
    if (it < total) { TR_DECODE(it, Wc, k0c, s0c, s1c, ksc_c, dc); tr_load(Wc, ld, k0c, s0c, s1c, C.lane, va); }
    while (it < total) {
        const int nit = it + NGW; const float* Wn = nullptr; int k0n = 0, s0n = 0, s1n = 0; const float* ksc_n = nullptr; bf16_t* dn = nullptr;
        if (nit < total) { TR_DECODE(nit, Wn, k0n, s0n, s1n, ksc_n, dn); tr_load(Wn, ld, k0n, s0n, s1n, C.lane, vb); }
        tr_store(va, ksc_c, k0c, dc, K, scr, C.lane);
#pragma unroll
        for (int i = 0; i < 16; ++i) va[i] = vb[i];
        it = nit; k0c = k0n; ksc_c = ksc_n; dc = dn;
    }
#undef TR_DECODE
}
template <int JOB, int N, bool G64  >
__device__ __forceinline__ void tr_job_fp8(const Ctx& C, const float* src, size_t srcstride, int nmat, unsigned char* dst, size_t dststride, unsigned char* SW) {
    constexpr int K = 1024, ld = N;
    LAS float* scr = (LAS float*)(C.lds + C.wave * 16640);
    const int gw = C.vcu * NWAVES + C.wave, NGW = C.G * NWAVES, lane = C.lane;
    const int nkb = K / 64, nnb = N / 64, per = nkb * nnb, total = per * nmat;
    f32x4 v[16], vn[16];
    if (gw < total) { const int mat = gw / per, r = gw - mat * per, kb = r / nnb, nb = r - kb * nnb; tr_load(src + (size_t)mat * srcstride, ld, kb * 64, tr_map(JOB, 2 * nb), tr_map(JOB, 2 * nb + 1), lane, v); }
    for (int it = gw; it < total; it += NGW) {
        const int mat = it / per, r = it - mat * per, kb = r / nnb, nb = r - kb * nnb;
        { const int nit = it + NGW; if (nit < total) { const int matn = nit / per, rn = nit - matn * per, kbn = rn / nnb, nbn = rn - kbn * nnb; tr_load(src + (size_t)matn * srcstride, ld, kbn * 64, tr_map(JOB, 2 * nbn), tr_map(JOB, 2 * nbn + 1), lane, vn); } }
        const int rs = lane >> 4;
#pragma unroll
        for (int i = 0; i < 8; ++i) { LAS float* sp = scr + (8 * i + 2 * rs) * 65 + (lane & 15) * 4;
#pragma unroll
            for (int e = 0; e < 4; ++e) { sp[e] = v[2 * i][e]; sp[65 + e] = v[2 * i + 1][e]; } }
        asm volatile("s_waitcnt lgkmcnt(0)" ::: "memory");
        const int c = lane & 7;
#pragma unroll
        for (int j = 0; j < 8; ++j) { const int n = (lane >> 3) + 8 * j; const LAS float* sp = scr + (8 * c) * 65 + n;
            float x[8]; float am = 0.f;
#pragma unroll
            for (int q = 0; q < 8; ++q) { x[q] = sp[q * 65]; am = fmaxf(am, fabsf(x[q])); }
            am = fmaxf(am, __shfl_xor(am, 1)); am = fmaxf(am, __shfl_xor(am, 2));
            if (G64) am = fmaxf(am, __shfl_xor(am, 4));
            int eb = (int)((__float_as_uint(am) >> 23) & 0xffu) - 7; eb = eb < 1 ? 1 : eb;
            const float inv = __uint_as_float((unsigned)(254 - eb) << 23);
            int w0 = __builtin_amdgcn_cvt_pk_fp8_f32(x[0] * inv, x[1] * inv, 0, false); w0 = __builtin_amdgcn_cvt_pk_fp8_f32(x[2] * inv, x[3] * inv, w0, true);
            int w1 = __builtin_amdgcn_cvt_pk_fp8_f32(x[4] * inv, x[5] * inv, 0, false); w1 = __builtin_amdgcn_cvt_pk_fp8_f32(x[6] * inv, x[7] * inv, w1, true);
            const int nrow = nb * 64 + n;
            *(u32x2*)(dst + (size_t)mat * dststride + (size_t)nrow * K + kb * 64 + 8 * c) = (u32x2){(unsigned)w0, (unsigned)w1};
            if (!G64) { if ((c & 3) == 0) SW[(size_t)mat * 65536 + (size_t)(nrow >> 8) * 8192 + (size_t)(kb >> 1) * 1024 + (nrow & 255) * 4 + 2 * (kb & 1) + (c >> 2)] = (unsigned char)eb; }
            else { if (c == 0) SW[(size_t)mat * 16384 + (size_t)(nrow >> 8) * 4096 + (size_t)(kb >> 1) * 512 + (nrow & 255) * 2 + (kb & 1)] = (unsigned char)eb; } }
        asm volatile("s_waitcnt lgkmcnt(0)" ::: "memory");
#pragma unroll
        for (int i = 0; i < 16; ++i) v[i] = vn[i];
    }
}
__device__ __forceinline__ void cvt_rows(const Ctx& C, const float* src, bf16_t* dst, size_t n8  ) {
    const size_t gt = (size_t)C.vcu * 512 + C.tid, NT = (size_t)C.G * 512;
    size_t i = gt;
    for (; i + 3 * NT < n8; i += 4 * NT) {
        f32x4 a[4], b[4];
#pragma unroll
        for (int q = 0; q < 4; ++q) { a[q] = *(const f32x4*)(src + (i + q * NT) * 8); b[q] = *(const f32x4*)(src + (i + q * NT) * 8 + 4); }
#pragma unroll
        for (int q = 0; q < 4; ++q) *(u32x4*)(dst + (i + q * NT) * 8) = pack8(a[q], b[q]); }
    for (; i < n8; i += NT) { const f32x4 a = *(const f32x4*)(src + i * 8), b = *(const f32x4*)(src + i * 8 + 4); *(u32x4*)(dst + i * 8) = pack8(a, b); }
}
__device__ __forceinline__ void phase_prologue(const CAS Args& args, const Ctx& C) {
    tr_job(C, J_MLA_WIN, INF(I_MLA_WIN), (size_t)DM * LATD, 2, DM, LATD, 1280, WSP(bf16_t, WS_W_MLA + OFF_MLA_WIN), W_MLA_STRIDE, nullptr, 0, nullptr);
    tr_job(C, J_MLA_WUQ, INF(I_MLA_WUQ), (size_t)QL * 1536, 2, QL, 1536, 1536, WSP(bf16_t, WS_W_MLA + OFF_MLA_WUQ), W_MLA_STRIDE, INF(I_MLA_QN), QL, nullptr);
    tr_job(C, J_NAT, INF(I_MLA_WUKV), (size_t)KVL * 2048, 2, KVL, 2048, 2048, WSP(bf16_t, WS_W_MLA + OFF_MLA_WUKV), W_MLA_STRIDE, INF(I_MLA_KVN), KVL, nullptr);
    tr_job(C, J_NAT, INF(I_MLA_WO), (size_t)DM * DM, 2, DM, DM, DM, WSP(bf16_t, WS_W_MLA + OFF_MLA_WO), W_MLA_STRIDE, nullptr, 0, nullptr);
    tr_job(C, J_NAT, INF(I_LRU_WIN), (size_t)DM * 2048, 2, DM, 2048, 2048, WSP(bf16_t, WS_W_LRU + OFF_LRU_WIN), W_LRU_STRIDE, nullptr, 0, nullptr);
    for (int j = 0; j < 2; ++j)
        tr_job(C, J_LRU_WAX, INF(I_LRU_WA) + (size_t)j * 4 * 65536, (size_t)256 * 256, 4, 256, 256, 512, WSP(bf16_t, WS_W_LRU + OFF_LRU_WAX + (size_t)j * W_LRU_STRIDE), (size_t)512 * 256 * 2, nullptr, 0, INF(I_LRU_WX) + (size_t)j * 4 * 65536);
    tr_job(C, J_NAT, INF(I_LRU_WOUT), (size_t)DM * DM, 2, DM, DM, DM, WSP(bf16_t, WS_W_LRU + OFF_LRU_WOUT), W_LRU_STRIDE, nullptr, 0, nullptr);
    tr_job(C, J_NAT, INF(I_PLE_WP), (size_t)PLED * DM, 4, PLED, DM, DM, WSP(bf16_t, WS_W_PLE + OFF_PLE_WP), W_PLE_STRIDE, nullptr, 0, nullptr);
    __syncthreads();
    tr_job_fp8<J_MOE_UP, 2048, false>(C, INF(I_MOE_WUP), (size_t)DM * 2048, DEPTH * NE, args.ws + WS_W_UP, (size_t)2048 * 1024, args.ws + WS_SW);
    tr_job_fp8<J_NAT, 1024, true>(C, INF(I_MOE_WDN), (size_t)DFF * DM, DEPTH * NE, args.ws + WS_W_DN, (size_t)1024 * 1024, args.ws + WS_SWD);
    tr_job_fp8<J_NAT, 1024, false>(C, INF(I_PLE_WG), (size_t)DM * DM, DEPTH, args.ws + WS_W_PLE + OFF_PLE_WG, W_PLE_STRIDE, args.ws + WS_SWG);
    __syncthreads();
    cvt_rows(C, INF(I_X), WSP(bf16_t, WS_XB), (size_t)T * DM / 8);
    cvt_rows(C, INF(I_P), WSP(bf16_t, WS_PB), (size_t)DEPTH * T * PLED / 8);
    { const int* pos = (const int*)args.in[I_POS]; float* CS = WSP(float, WS_CS); float* SN = WSP(float, WS_SN);
      const size_t gt = (size_t)C.vcu * 512 + C.tid, NT = (size_t)C.G * 512;
      for (size_t i = gt; i < (size_t)T * 32; i += NT) { const int tok = (int)(i >> 5), j = (int)(i & 31);
          const double inv = exp(-9.210340371976184 * (double)j / 32.0); const double ang = (double)pos[tok] * inv; double s, c; sincos(ang, &s, &c); CS[i] = (float)c; SN[i] = (float)s; }
      { const float* wr = INF(I_MOE_WR); const float* lg1 = INF(I_LN1G); bf16_t* WRH = WSP(bf16_t, WS_WRH); bf16_t* WRL = WSP(bf16_t, WS_WRL);
        for (size_t i = gt; i < (size_t)DEPTH * 64 * 64; i += NT) { const int l = (int)(i >> 12), st = (int)(i >> 6) & 63, ln = (int)i & 63; float w[8], lo[8];
#pragma unroll
            for (int j = 0; j < 8; ++j) { const int k = 16 * st + 8 * (ln >> 5) + j; w[j] = lg1[l * DM + k] * wr[((size_t)l * DM + k) * NE + (ln & 31)]; }
            u32x4 h; h.x = cvt_pk_bf16(w[0], w[1]); h.y = cvt_pk_bf16(w[2], w[3]); h.z = cvt_pk_bf16(w[4], w[5]); h.w = cvt_pk_bf16(w[6], w[7]);
            lo[0] = w[0] - bf_lo(h.x); lo[1] = w[1] - bf_hi(h.x); lo[2] = w[2] - bf_lo(h.y); lo[3] = w[3] - bf_hi(h.y); lo[4] = w[4] - bf_lo(h.z); lo[5] = w[5] - bf_hi(h.z); lo[6] = w[6] - bf_lo(h.w); lo[7] = w[7] - bf_hi(h.w);
            u32x4 q; q.x = cvt_pk_bf16(lo[0], lo[1]); q.y = cvt_pk_bf16(lo[2], lo[3]); q.z = cvt_pk_bf16(lo[4], lo[5]); q.w = cvt_pk_bf16(lo[6], lo[7]);
            *(u32x4*)(WRH + i * 8) = h; *(u32x4*)(WRL + i * 8) = q; }
        float* RC = WSP(float, WS_RC); const float* lb1 = INF(I_LN1B); const float* rb = INF(I_MOE_BR);
        for (size_t i = gt; i < (size_t)DEPTH * NE; i += NT) { const int l = (int)(i >> 5), e = (int)i & 31; float c1 = 0.f, c2 = 0.f;
            for (int k = 0; k < DM; ++k) { const float w = wr[((size_t)l * DM + k) * NE + e]; c1 = fmaf(lg1[l * DM + k], w, c1); c2 = fmaf(lb1[l * DM + k], w, c2); }
            RC[l * 64 + e] = c1; RC[l * 64 + 32 + e] = c2 + rb[l * NE + e]; } }
      float* SPL = WSP(float, WS_SPL); const float* lam = INF(I_LRU_LAM);
      for (size_t i = gt; i < 2 * 1024; i += NT) { const double l = (double)lam[i]; SPL[i] = (float)(-8.0 * log1p(exp(-l))); } }
}

__device__ __forceinline__ void moe_table(const CAS Args& args, const Ctx& C0, int layer) {
    Ctx C = C0; C.tid = opaque_tid(); C.lane = C.tid & 63;
    const unsigned* cnt = WSP(unsigned, WS_CTL) + CW_CNT + 64 * layer;
    __syncthreads();
    if (C.tid < 32) C.misc[64 + C.tid] = (int)__hip_atomic_load(cnt + C.tid, __ATOMIC_RELAXED, __HIP_MEMORY_SCOPE_AGENT);
    __syncthreads();
    if (C.tid == 0) { int acc = 0; for (int e = 0; e < 32; ++e) { C.misc[16 + e] = acc; acc += (C.misc[64 + e] + 255) >> 8; } C.misc[16 + 32] = acc; }
    __syncthreads();
    { volatile LAS unsigned char* te = (volatile LAS unsigned char*)(C.lds + TILE_E_OFF);
      for (int mg = C.tid; mg < C.misc[48]; mg += NWAVES * 64) { int e = 0; for (int j = 1; j < 32; ++j) e += (C.misc[16 + j] <= mg) ? 1 : 0; te[mg] = (unsigned char)e; } }
    __syncthreads();
}

__device__ __forceinline__ void phase_ln_router(const CAS Args& args, const Ctx& C0, int layer) {
    const int cslot = layer + args.pad;
    Ctx C = C0; C.tid = opaque_tid(); C.lane = C.tid & 63;
    const bf16_t* Y = WSP(bf16_t, WS_Y); bf16_t* X1B = WSP(bf16_t, WS_X1B);
    const float* g1 = INF(I_LN1G) + layer * DM; const float* b1 = INF(I_LN1B) + layer * DM;
    const bf16_t* WRH = WSP(bf16_t, WS_WRH) + (size_t)layer * 64 * 64 * 8; const bf16_t* WRL = WSP(bf16_t, WS_WRL) + (size_t)layer * 64 * 64 * 8; const float* rc = WSP(float, WS_RC) + layer * 64;
    unsigned* gcnt = WSP(unsigned, WS_CTL) + CW_CNT + 64 * cslot;
    int* lists = WSP(int, WS_LIST); int* slot = WSP(int, WS_SLOT); float* gate = WSP(float, WS_GATE);
    LAS float* part = (LAS float*)C.lds;
    volatile LAS int* lcnt = (volatile LAS int*)(C.lds + 69632);
    volatile LAS int* lbase = lcnt + 32;
    LAS float* stat = (LAS float*)(C.lds + 70144);
    f32x4 gv[4], bv[4];
#pragma unroll
    for (int j = 0; j < 2; ++j) { gv[2 * j] = *(const f32x4*)(g1 + 8 * C.lane + 512 * j); gv[2 * j + 1] = *(const f32x4*)(g1 + 8 * C.lane + 512 * j + 4);
        bv[2 * j] = *(const f32x4*)(b1 + 8 * C.lane + 512 * j); bv[2 * j + 1] = *(const f32x4*)(b1 + 8 * C.lane + 512 * j + 4); }
    unsigned char* X1Q = args.ws + WS_X1Q; int sexp;
    { float ag = 0.f, ab = 0.f;
#pragma unroll
      for (int j = 0; j < 4; ++j)
#pragma unroll
          for (int e = 0; e < 4; ++e) { ag = fmaxf(ag, fabsf(gv[j][e])); ab = fmaxf(ab, fabsf(bv[j][e])); }
#pragma unroll
      for (int o = 1; o < 64; o <<= 1) { ag = fmaxf(ag, __shfl_xor(ag, o)); ab = fmaxf(ab, __shfl_xor(ab, o)); }
      const float bound = 16.0f * ag + ab + 1e-20f;
      sexp = 134 - (int)((__float_as_uint(bound) >> 23) & 0xffu);
      sexp = sexp < -100 ? -100 : (sexp > 100 ? 100 : sexp);
      if (C.tid == 0) __hip_atomic_store(WSP(unsigned, WS_CTL) + CW_SA + layer, (unsigned)sexp, __ATOMIC_RELAXED, __HIP_MEMORY_SCOPE_AGENT); }
    const float qs = __uint_as_float((unsigned)(127 + sexp) << 23), qlo = KF(-448.f), qhi = KF(448.f);
    for (int chunk = C.vcu; chunk < T / 128; chunk += C.G) {
        const int row0 = chunk * 128;
        if (C.tid < 32) lcnt[C.tid] = 0;
        u32x4 yn[2];
#pragma unroll
        for (int j = 0; j < 2; ++j) yn[j] = *(const u32x4*)(Y + ((size_t)row0 + C.wave * 16) * DM + 8 * C.lane + 512 * j);
#pragma unroll 1
        for (int i = 0; i < 16; ++i) { const size_t row = (size_t)row0 + C.wave * 16 + i;
            f32x4 v[4]; float s = 0.f;
#pragma unroll
            for (int j = 0; j < 2; ++j) { const u32x4 w = yn[j]; v[2 * j] = pg8::bf4_lo(w); v[2 * j + 1] = pg8::bf4_hi(w); }
            { const size_t rn = i < 15 ? row + 1 : row;
#pragma unroll
              for (int j = 0; j < 2; ++j) yn[j] = *(const u32x4*)(Y + rn * DM + 8 * C.lane + 512 * j); }
#pragma unroll
            for (int j = 0; j < 4; ++j) s += (v[j][0] + v[j][1]) + (v[j][2] + v[j][3]);
            const float mean = wave_sum(s) * (1.f / DM); float s2 = 0.f;
#pragma unroll
            for (int j = 0; j < 4; ++j) { v[j] = v[j] - mean; s2 += (v[j][0] * v[j][0] + v[j][1] * v[j][1]) + (v[j][2] * v[j][2] + v[j][3] * v[j][3]); }
            const float rstd = 1.f / sqrtf(wave_sum(s2) * (1.f / DM) + KF(LN_EPS));
            if (C.lane == 0) { stat[(C.wave * 16 + i) * 2] = mean; stat[(C.wave * 16 + i) * 2 + 1] = rstd; }
#pragma unroll
            for (int j = 0; j < 4; ++j) v[j] = v[j] * rstd * gv[j] + bv[j];
#pragma unroll
            for (int j = 0; j < 2; ++j) { const u32x4 hw = pack8(v[2 * j], v[2 * j + 1]);
                *(u32x4*)(X1B + row * DM + 8 * C.lane + 512 * j) = hw;
                const f32x4 q0 = v[2 * j] * qs, q1 = v[2 * j + 1] * qs;
                int w0 = __builtin_amdgcn_cvt_pk_fp8_f32(fminf(fmaxf(q0[0], qlo), qhi), fminf(fmaxf(q0[1], qlo), qhi), 0, false); w0 = __builtin_amdgcn_cvt_pk_fp8_f32(fminf(fmaxf(q0[2], qlo), qhi), fminf(fmaxf(q0[3], qlo), qhi), w0, true);
                int w1 = __builtin_amdgcn_cvt_pk_fp8_f32(fminf(fmaxf(q1[0], qlo), qhi), fminf(fmaxf(q1[1], qlo), qhi), 0, false); w1 = __builtin_amdgcn_cvt_pk_fp8_f32(fminf(fmaxf(q1[2], qlo), qhi), fminf(fmaxf(q1[3], qlo), qhi), w1, true);
                *(u32x2*)(X1Q + row * DM + 8 * C.lane + 512 * j) = (u32x2){(unsigned)w0, (unsigned)w1}; } }
        asm volatile("s_waitcnt vmcnt(0)" ::: "memory");
        __syncthreads();
        { const int grp = C.wave >> 1, kh = C.wave & 1, r32 = C.lane & 31, hi = C.lane >> 5;
          const bf16_t* ah = Y + ((size_t)row0 + grp * 32 + r32) * DM + kh * 512 + hi * 8;
          const bf16_t* bh = WRH + ((size_t)kh * 32 * 64 + C.lane) * 8; const bf16_t* bl = WRL + ((size_t)kh * 32 * 64 + C.lane) * 8;
          f32x16 acc = {};
#pragma unroll 4
          for (int st = 0; st < 32; ++st) { const bf16x8 xh = *(const bf16x8*)(ah + st * 16), wh = *(const bf16x8*)(bh + (size_t)st * 512), wl = *(const bf16x8*)(bl + (size_t)st * 512);
              acc = __builtin_amdgcn_mfma_f32_32x32x16_bf16(xh, wh, acc, 0, 0, 0);
              acc = __builtin_amdgcn_mfma_f32_32x32x16_bf16(xh, wl, acc, 0, 0, 0); }
          LAS float* pp = part + (grp * 2 + kh) * 32 * 33 + r32;
#pragma unroll
          for (int r = 0; r < 16; ++r) pp[((r & 3) + 8 * (r >> 2) + 4 * hi) * 33] = acc[r]; }
        __syncthreads();
        int te[4] = {0, 0, 0, 0}, lp[4] = {0, 0, 0, 0}; float tg[4] = {0.f, 0.f, 0.f, 0.f};
        if (C.tid < 128) { const int grp = C.tid >> 5, ln = C.tid & 31; float lg[32];
            const float mean = stat[C.tid * 2], rstd = stat[C.tid * 2 + 1];
#pragma unroll
            for (int e = 0; e < 32; ++e) lg[e] = rstd * ((part[((grp * 2 + 0) * 32 + ln) * 33 + e] + part[((grp * 2 + 1) * 32 + ln) * 33 + e]) - mean * rc[e]) + rc[32 + e];
            float tv[4]; const float kninf = KF(-__builtin_inff());
#pragma unroll
            for (int k = 0; k < 4; ++k) { float best = lg[0]; int bi = 0;
#pragma unroll
                for (int e = 1; e < 32; ++e) { const bool gt = lg[e] > best; best = gt ? lg[e] : best; bi = gt ? e : bi; }
                te[k] = bi; tv[k] = best;
#pragma unroll
                for (int e = 0; e < 32; ++e) lg[e] = (e == bi) ? kninf : lg[e]; }
            float den = 0.f;
#pragma unroll
            for (int k = 0; k < 4; ++k) { tg[k] = __expf(tv[k] - tv[0]); den += tg[k]; }
            const float rden = 1.0f / den;
#pragma unroll
            for (int k = 0; k < 4; ++k) { tg[k] *= rden; lp[k] = __hip_atomic_fetch_add((LAS int*)&lcnt[te[k]], 1, __ATOMIC_RELAXED, __HIP_MEMORY_SCOPE_WORKGROUP); } }
        __syncthreads();
        if (C.tid < 32) lbase[C.tid] = (int)__hip_atomic_fetch_add(gcnt + C.tid, (unsigned)lcnt[C.tid], __ATOMIC_RELAXED, __HIP_MEMORY_SCOPE_AGENT);
        __syncthreads();
        if (C.tid < 128) { const int tok = row0 + C.tid;
#pragma unroll
            for (int k = 0; k < 4; ++k) { const int pos = lbase[te[k]] + lp[k]; lists[(size_t)te[k] * T + pos] = tok; slot[tok * 4 + k] = te[k] * T + pos; gate[tok * 4 + k] = tg[k]; } }
        __syncthreads();
    }
}

__device__ __forceinline__ void phase_combine_ln2(const CAS Args& args, const Ctx& C0, int layer) {
    Ctx C = C0; C.tid = opaque_tid(); C.lane = C.tid & 63;
    moe_table(args, C, layer);
    const bf16_t* X1B = WSP(bf16_t, WS_X1B); const unsigned char* YS = args.ws + WS_YS; const unsigned char* SY = args.ws + WS_SY; const int* slot = WSP(int, WS_SLOT); const float* gate = WSP(float, WS_GATE);
    bf16_t* X2B = WSP(bf16_t, WS_X2B); unsigned char* X2Q = args.ws + WS_X2Q;
    const float* g2 = INF(I_LN2G) + layer * DM; const float* b2 = INF(I_LN2B) + layer * DM;
    f32x4 gv[4], bv[4];
#pragma unroll
    for (int j = 0; j < 2; ++j) { gv[2 * j] = *(const f32x4*)(g2 + 8 * C.lane + 512 * j); gv[2 * j + 1] = *(const f32x4*)(g2 + 8 * C.lane + 512 * j + 4);
        bv[2 * j] = *(const f32x4*)(b2 + 8 * C.lane + 512 * j); bv[2 * j + 1] = *(const f32x4*)(b2 + 8 * C.lane + 512 * j + 4); }
    int sexp;
    { float ag = 0.f, ab = 0.f;
#pragma unroll
      for (int j = 0; j < 4; ++j)
#pragma unroll
          for (int e = 0; e < 4; ++e) { ag = fmaxf(ag, fabsf(gv[j][e])); ab = fmaxf(ab, fabsf(bv[j][e])); }
#pragma unroll
      for (int o = 1; o < 64; o <<= 1) { ag = fmaxf(ag, __shfl_xor(ag, o)); ab = fmaxf(ab, __shfl_xor(ab, o)); }
      const float bound = 16.0f * ag + ab + 1e-20f;
      sexp = 134 - (int)((__float_as_uint(bound) >> 23) & 0xffu); sexp = sexp < -100 ? -100 : (sexp > 100 ? 100 : sexp);
      if (C.tid == 0) __hip_atomic_store(WSP(unsigned, WS_CTL) + CW_SA2 + layer, (unsigned)sexp, __ATOMIC_RELAXED, __HIP_MEMORY_SCOPE_AGENT); }
    const float qs = __uint_as_float((unsigned)(127 + sexp) << 23), qlo = KF(-448.f), qhi = KF(448.f);
    const int gw = C.vcu * NWAVES + C.wave, NGW = C.G * NWAVES;
    for (int row = gw; row < T; row += 2 * NGW) {
        int sv[2][4]; float gt[2][4];
#pragma unroll
        for (int q = 0; q < 2; ++q) { const int r = (row + q * NGW < T) ? row + q * NGW : row;
#pragma unroll
            for (int k = 0; k < 4; ++k) { sv[q][k] = slot[r * 4 + k]; gt[q][k] = gate[r * 4 + k]; } }
        u32x4 xw[2][2]; u32x2 yw[2][4][2]; unsigned eb[2][4][2];
#pragma unroll
        for (int q = 0; q < 2; ++q) { const int r = (row + q * NGW < T) ? row + q * NGW : row;
#pragma unroll
            for (int j = 0; j < 2; ++j) xw[q][j] = *(const u32x4*)(X1B + (size_t)r * DM + 8 * C.lane + 512 * j);
#pragma unroll
            for (int k = 0; k < 4; ++k) { const int e = sv[q][k] >> 15, pos = sv[q][k] & (T - 1); const size_t prow = (size_t)C.misc[16 + e] * 256 + pos;
#pragma unroll
                for (int j = 0; j < 2; ++j) { yw[q][k][j] = *(const u32x2*)(YS + prow * DM + 8 * C.lane + 512 * j); eb[q][k][j] = SY[prow * 32 + (C.lane >> 2) + 16 * j]; } } }
#pragma unroll
        for (int q = 0; q < 2; ++q) { const int r = row + q * NGW; if (r >= T) break;
            f32x4 v[4];
#pragma unroll
            for (int j = 0; j < 2; ++j) { v[2 * j] = pg8::bf4_lo(xw[q][j]) * ALPHA; v[2 * j + 1] = pg8::bf4_hi(xw[q][j]) * ALPHA; }
#pragma unroll
            for (int k = 0; k < 4; ++k)
#pragma unroll
                for (int j = 0; j < 2; ++j) { const u32x2 w = yw[q][k][j]; const float gs = gt[q][k] * __uint_as_float(eb[q][k][j] << 23);
                    const f32x2 a = __builtin_amdgcn_cvt_pk_f32_fp8((int)w.x, false), b = __builtin_amdgcn_cvt_pk_f32_fp8((int)w.x, true), c = __builtin_amdgcn_cvt_pk_f32_fp8((int)w.y, false), d = __builtin_amdgcn_cvt_pk_f32_fp8((int)w.y, true);
                    v[2 * j] += (f32x4){a[0], a[1], b[0], b[1]} * gs; v[2 * j + 1] += (f32x4){c[0], c[1], d[0], d[1]} * gs; }
            float s = 0.f;
#pragma unroll
            for (int j = 0; j < 4; ++j) s += (v[j][0] + v[j][1]) + (v[j][2] + v[j][3]);
            const float mean = wave_sum(s) * (1.f / DM); float s2 = 0.f;
#pragma unroll
            for (int j = 0; j < 4; ++j) { v[j] = v[j] - mean; s2 += (v[j][0] * v[j][0] + v[j][1] * v[j][1]) + (v[j][2] * v[j][2] + v[j][3] * v[j][3]); }
            const float rstd = 1.f / sqrtf(wave_sum(s2) * (1.f / DM) + KF(LN_EPS));
#pragma unroll
            for (int j = 0; j < 4; ++j) v[j] = v[j] * rstd * gv[j] + bv[j];
#pragma unroll
            for (int j = 0; j < 2; ++j) { *(u32x4*)(X2B + (size_t)r * DM + 8 * C.lane + 512 * j) = pack8(v[2 * j], v[2 * j + 1]);
                const f32x4 q0 = v[2 * j] * qs, q1 = v[2 * j + 1] * qs;
                int w0 = __builtin_amdgcn_cvt_pk_fp8_f32(fminf(fmaxf(q0[0], qlo), qhi), fminf(fmaxf(q0[1], qlo), qhi), 0, false); w0 = __builtin_amdgcn_cvt_pk_fp8_f32(fminf(fmaxf(q0[2], qlo), qhi), fminf(fmaxf(q0[3], qlo), qhi), w0, true);
                int w1 = __builtin_amdgcn_cvt_pk_fp8_f32(fminf(fmaxf(q1[0], qlo), qhi), fminf(fmaxf(q1[1], qlo), qhi), 0, false); w1 = __builtin_amdgcn_cvt_pk_fp8_f32(fminf(fmaxf(q1[2], qlo), qhi), fminf(fmaxf(q1[3], qlo), qhi), w1, true);
                *(u32x2*)(X2Q + (size_t)r * DM + 8 * C.lane + 512 * j) = (u32x2){(unsigned)w0, (unsigned)w1}; } }
    }
}

__device__ __forceinline__ void phase_conv(const CAS Args& args, const Ctx& C0, int j) {
    Ctx C = C0; C.tid = opaque_tid(); C.lane = C.tid & 63;
    const bf16_t* U = WSP(bf16_t, WS_U); bf16_t* UC = WSP(bf16_t, WS_UC);
    const float* cw = INF(I_LRU_CW) + (size_t)j * 4 * DM; const float* cb = INF(I_LRU_CB) + (size_t)j * DM;
    const int c8 = (C.tid & 127) * 8, rsub = C.tid >> 7;
    float w[4][8], bb[8];
#pragma unroll
    for (int q = 0; q < 4; ++q)
#pragma unroll
        for (int e = 0; e < 8; ++e) w[q][e] = cw[q * DM + c8 + e];
#pragma unroll
    for (int e = 0; e < 8; ++e) bb[e] = cb[c8 + e];
    for (int chunk = C.vcu; chunk < T / 128; chunk += C.G) {
        const int r0 = chunk * 128 + rsub * 32;
        u32x4 h0, h1, h2;
        const u32x4 z = {0u, 0u, 0u, 0u};
        const int s0 = r0 & (SEQ - 1);
        h0 = s0 >= 3 ? *(const u32x4*)(U + (size_t)(r0 - 3) * DM + c8) : z; h1 = s0 >= 2 ? *(const u32x4*)(U + (size_t)(r0 - 2) * DM + c8) : z; h2 = s0 >= 1 ? *(const u32x4*)(U + (size_t)(r0 - 1) * DM + c8) : z;
#pragma unroll 4
        for (int i = 0; i < 32; ++i) { const u32x4 h3 = *(const u32x4*)(U + (size_t)(r0 + i) * DM + c8);
            float o[8];
#pragma unroll
            for (int q = 0; q < 4; ++q) { const unsigned a = h0[q], b = h1[q], c = h2[q], d = h3[q];
                o[2 * q] = bb[2 * q] + w[0][2 * q] * bf_lo(a) + w[1][2 * q] * bf_lo(b) + w[2][2 * q] * bf_lo(c) + w[3][2 * q] * bf_lo(d);
                o[2 * q + 1] = bb[2 * q + 1] + w[0][2 * q + 1] * bf_hi(a) + w[1][2 * q + 1] * bf_hi(b) + w[2][2 * q + 1] * bf_hi(c) + w[3][2 * q + 1] * bf_hi(d); }
            u32x4 ow; ow.x = cvt_pk_bf16(o[0], o[1]); ow.y = cvt_pk_bf16(o[2], o[3]); ow.z = cvt_pk_bf16(o[4], o[5]); ow.w = cvt_pk_bf16(o[6], o[7]);
            *(u32x4*)(UC + (size_t)(r0 + i) * DM + c8) = ow; h0 = h1; h1 = h2; h2 = h3; }
    }
}
__device__ __forceinline__ void phase_scan1(const CAS Args& args, const Ctx& C0) {
    Ctx C = C0; C.tid = opaque_tid(); C.lane = C.tid & 63;
    const bf16_t* LA = WSP(bf16_t, WS_AA); const bf16_t* BB = WSP(bf16_t, WS_BB); float* CA = WSP(float, WS_CA); float* CH = WSP(float, WS_CH);
    const int c2 = C.tid * 2;
    for (int item = C.vcu; item < NBATCH * 64; item += C.G) {
        const size_t r0 = (size_t)item * 64; float h0 = 0.f, h1 = 0.f, l0 = 0.f, l1 = 0.f;
#pragma unroll 8
        for (int s = 0; s < 64; ++s) { const unsigned aw = *(const unsigned*)(LA + (r0 + s) * DM + c2), bw = *(const unsigned*)(BB + (r0 + s) * DM + c2);
            const float la0 = bf_lo(aw), la1 = bf_hi(aw);
            h0 = __builtin_amdgcn_exp2f(la0) * h0 + bf_lo(bw); h1 = __builtin_amdgcn_exp2f(la1) * h1 + bf_hi(bw); l0 += la0; l1 += la1; }
        *(f32x2*)(CA + (size_t)item * DM + c2) = (f32x2){__builtin_amdgcn_exp2f(l0), __builtin_amdgcn_exp2f(l1)}; *(f32x2*)(CH + (size_t)item * DM + c2) = (f32x2){h0, h1};
    }
}
__device__ __forceinline__ void phase_scan2(const CAS Args& args, const Ctx& C0) {
    Ctx C = C0; C.tid = opaque_tid(); C.lane = C.tid & 63;
    const bf16_t* LA = WSP(bf16_t, WS_AA); const bf16_t* BB = WSP(bf16_t, WS_BB); const float* CA = WSP(float, WS_CA); const float* CH = WSP(float, WS_CH);
    const bf16_t* GG = WSP(bf16_t, WS_GG); bf16_t* YL = WSP(bf16_t, WS_O);
    const int c2 = C.tid * 2;
    for (int item = C.vcu; item < NBATCH * 64; item += C.G) {
        const int b = item >> 6, ch = item & 63; float h0 = 0.f, h1 = 0.f;
#pragma unroll 8
        for (int jx = 0; jx < ch; ++jx) { const f32x2 a = *(const f32x2*)(CA + (size_t)(b * 64 + jx) * DM + c2), e = *(const f32x2*)(CH + (size_t)(b * 64 + jx) * DM + c2);
            h0 = a[0] * h0 + e[0]; h1 = a[1] * h1 + e[1]; }
        const size_t r0 = (size_t)item * 64;
#pragma unroll 8
        for (int s = 0; s < 64; ++s) { const unsigned aw = *(const unsigned*)(LA + (r0 + s) * DM + c2), bw = *(const unsigned*)(BB + (r0 + s) * DM + c2), g = *(const unsigned*)(GG + (r0 + s) * DM + c2);
            h0 = __builtin_amdgcn_exp2f(bf_lo(aw)) * h0 + bf_lo(bw); h1 = __builtin_amdgcn_exp2f(bf_hi(aw)) * h1 + bf_hi(bw);
            *(unsigned*)(YL + (r0 + s) * DM + c2) = cvt_pk_bf16(bf_lo(g) * h0, bf_hi(g) * h1); }
    }
}

#if PROBE_T
typedef int v8i_t __attribute__((ext_vector_type(8)));
__device__ __forceinline__ unsigned fp8_of_int(int v) { const unsigned char t[4] = {0x00, 0x38, 0x40, 0x44}; const int a = v < 0 ? -v : v; return (unsigned)t[a] | (v < 0 ? 0x80u : 0u); }
__device__ __forceinline__ int tA(int i, int k) { return ((i * 3 + k * 5) % 7) - 3; }
__device__ __forceinline__ int tB(int k, int j) { return ((k * 2 + j * 7) % 5) - 2; }
__device__ __forceinline__ void mfma_fp8_selftest(unsigned* flagw) {
    const int l = threadIdx.x & 63, r = l & 15, q = l >> 4;
    v8i_t A, B;
#pragma unroll
    for (int d = 0; d < 8; ++d) { unsigned wa = 0, wb = 0;
#pragma unroll
        for (int b = 0; b < 4; ++b) { const int k = 32 * q + 4 * d + b; wa |= fp8_of_int(tA(r, k)) << (8 * b); wb |= fp8_of_int(tB(k, r)) << (8 * b); }
        A[d] = (int)wa; B[d] = (int)wb; }
    const f32x4 z = {0.f, 0.f, 0.f, 0.f};
    const int U = 0x7f7f7f7f;
    const int saq = (127 + q) * 0x01010101;
    const int sab = (q == 0) ? (int)0x8281807fu : U;
    const f32x4 m2 = __builtin_amdgcn_mfma_scale_f32_16x16x128_f8f6f4(A, B, z, 0, 0, 0, saq, 0, U);
    const f32x4 m5 = __builtin_amdgcn_mfma_scale_f32_16x16x128_f8f6f4(A, B, z, 0, 0, 0, sab, 0, U);
    bool k1 = true, k2 = true, k3 = true, k4 = true;
#pragma unroll
    for (int e = 0; e < 4; ++e) { const int i = 4 * q + e, j = r; float eb = 0.f, e0 = 0.f, ec = 0.f, ed = 0.f;
        for (int kq = 0; kq < 4; ++kq) for (int hh = 0; hh < 2; ++hh) { float sh = 0.f; for (int k = 32 * kq + 16 * hh; k < 32 * kq + 16 * hh + 16; ++k) sh += (float)(tA(i, k) * tB(k, j));
            const int xb = hh == 0 ? (kq >> 1) : 2 + (kq >> 1);
            eb += sh * (float)(1 << xb); e0 += sh; ec += sh * (float)(1 << kq); ed += sh * (float)(1 << xb); }
        k1 = k1 && (m2[e] == eb); k2 = k2 && (m2[e] == e0); k3 = k3 && (m5[e] == ec); k4 = k4 && (m5[e] == ed); }
    const bool b1 = __all(k1), b2 = __all(k2), b3 = __all(k3), b4 = __all(k4);
    if (l == 0) *flagw = (b1 ? 1u : 0u) | (b2 ? 2u : 0u) | (b3 ? 4u : 0u) | (b4 ? 8u : 0u);
}
#endif
constexpr int PH_PER_LAYER = 12, PH_TOTAL = 2 + PH_PER_LAYER * DEPTH;
__global__ void __launch_bounds__(NWAVES * 64, 2) fwd_kernel(Args args_kernarg) {
    (void)args_kernarg;
    ArgsP const argp = (ArgsP)__builtin_amdgcn_kernarg_segment_ptr();
    const CAS Args& args0 = *argp;
    extern __shared__ __attribute__((aligned(16))) unsigned char lds_raw[];
    Ctx C_;
    C_.lds = (LAS unsigned char*)lds_raw; C_.misc = (volatile LAS int*)(C_.lds + MISC_OFF);
    C_.tid = threadIdx.x; C_.lane = C_.tid & 63; C_.wave = __builtin_amdgcn_readfirstlane(C_.tid >> 6);
    C_.bid = (int)blockIdx.x; C_.G = gridDim.x; { const int bx = blockIdx.x; C_.vcu = (C_.G % 8 == 0) ? (bx % 8) * (C_.G / 8) + bx / 8 : bx; }
    for (int u = C_.tid; u < 128; u += NWAVES * 64) C_.misc[u] = 0;
    __syncthreads();
    XcdBarrier bar = xcd_barrier_post((unsigned*)(args0.ws + WS_CTL) + CW_BAR + args0.li * XCD_BAR_WORDS, (volatile LAS unsigned*)C_.misc);
    const int lo = args0.ph_lo, hi = args0.ph_hi;
#define IN(k) (lo <= (k) && (k) < hi)
#define PH_END(k) do { if ((k) + 1 < hi) xcd_barrier(bar); } while (0)

    if (SEL(0) && IN(0)) { const CAS Args& args = fresh_args(argp); const Ctx C = fresh_ctx(C_); const int cid = C.bid; phase_prologue(args, C); PH_END(0); }
    if (SEL(1) && IN(1)) { const CAS Args& args = fresh_args(argp); const Ctx C = fresh_ctx(C_); const int cid = C.bid;
        pg8::DenseSched S; S.init(WSP(bf16_t, WS_PB), WSP(bf16_t, WS_W_PLE + OFF_PLE_WP), PLED, PLED, DEPTH * T, DM, C.G, cid); S.bpm_shift = 7; S.bbatch = W_PLE_STRIDE;
        pg8::EpiPP E{WSP(bf16_t, WS_PP)};
        pg8::gemm_phase<pg8::EpiPP, pg8::DenseSched, false>(C.lds, PLED / 64, PLED * 2, PLED * 2, S, E);
        if (MK_ONE_LAUNCH == 0) PH_END(1);
    }
    for (int layer = 0; layer < DEPTH; ++layer) {
        const int base = 2 + PH_PER_LAYER * layer, j = layer >> 1;
        if ((layer & 1) == 0) {
            if (SEL(2) && IN(base + 0)) { const CAS Args& args = fresh_args(argp); const Ctx C = fresh_ctx(C_); const int cid = C.bid; const unsigned char* wm = args.ws + WS_W_MLA + (size_t)j * W_MLA_STRIDE;
                pg8::DenseSched S; S.init(WSP(bf16_t, WS_XB), wm + OFF_MLA_WIN, DM, DM, T, 1280, C.G, cid);
                pg8::EpiLat E{WSP(bf16_t, WS_LAT), WSP(float, WS_SSQ), WSP(bf16_t, WS_KR), WSP(float, WS_CS), WSP(float, WS_SN)};
                pg8::gemm_phase<pg8::EpiLat, pg8::DenseSched, false>(C.lds, DM / 64, DM * 2, DM * 2, S, E);
                PH_END(base + 0);
            }
            if (SEL(3) && IN(base + 1)) { const CAS Args& args = fresh_args(argp); const Ctx C = fresh_ctx(C_); const int cid = C.bid; const unsigned char* wm = args.ws + WS_W_MLA + (size_t)j * W_MLA_STRIDE;
                { pg8::DenseSched S; S.init(WSP(bf16_t, WS_LAT), wm + OFF_MLA_WUQ, DM, QL, T, 1536, C.G, cid);
                  pg8::EpiQ E{WSP(bf16_t, WS_Q), WSP(float, WS_SSQ), WSP(float, WS_CS), WSP(float, WS_SN)};
                  pg8::gemm_phase<pg8::EpiQ, pg8::DenseSched, false>(C.lds, QL / 64, DM * 2, QL * 2, S, E); }
                { pg8::DenseSched S; S.init(WSP(bf16_t, WS_LAT) + QL, wm + OFF_MLA_WUKV, DM, KVL, T, 2048, C.G, cid);
                  pg8::EpiKV E{WSP(bf16_t, WS_KN), WSP(bf16_t, WS_V), WSP(float, WS_SSQ)};
                  pg8::gemm_phase<pg8::EpiKV, pg8::DenseSched, false>(C.lds, KVL / 64, DM * 2, KVL * 2, S, E); }
                PH_END(base + 1);
            }
            if (SEL(4) && IN(base + 2)) { const CAS Args& args = fresh_args(argp); const Ctx C = fresh_ctx(C_); const int cid = C.bid;
                for (int it = C.vcu; it < NBATCH * NH * 8; it += C.G) { const int bh = it >> 3, pr = it & 7;
                    att::attn_block(bh >> 3, bh & 7, pr, WSP(bf16_t, WS_Q), WSP(bf16_t, WS_KN), WSP(bf16_t, WS_KR), WSP(bf16_t, WS_V), WSP(bf16_t, WS_O), (LAS char*)C.lds, PROBE_T ? (unsigned long long*)(args.ws + WS_CTL + 8192) : nullptr);
                    att::attn_block(bh >> 3, bh & 7, 15 - pr, WSP(bf16_t, WS_Q), WSP(bf16_t, WS_KN), WSP(bf16_t, WS_KR), WSP(bf16_t, WS_V), WSP(bf16_t, WS_O), (LAS char*)C.lds, PROBE_T ? (unsigned long long*)(args.ws + WS_CTL + 8192) : nullptr); }
                PH_END(base + 2);
            }
        } else {
            if (SEL(5) && IN(base + 0)) { const CAS Args& args = fresh_args(argp); const Ctx C = fresh_ctx(C_); const int cid = C.bid; const unsigned char* wl = args.ws + WS_W_LRU + (size_t)j * W_LRU_STRIDE;
                pg8::DenseSched S; S.init(WSP(bf16_t, WS_XB), wl + OFF_LRU_WIN, DM, DM, T, 2048, C.G, cid);
                pg8::EpiGU E{WSP(bf16_t, WS_GG), WSP(bf16_t, WS_U)};
                pg8::gemm_phase<pg8::EpiGU, pg8::DenseSched, false>(C.lds, DM / 64, DM * 2, DM * 2, S, E);
                PH_END(base + 0);
            }
            if (SEL(6) && IN(base + 1)) { const CAS Args& args = fresh_args(argp); const Ctx C = fresh_ctx(C_); const int cid = C.bid; phase_conv(args, C, j); PH_END(base + 1); }
            if (SEL(7) && IN(base + 2)) { const CAS Args& args = fresh_args(argp); const Ctx C = fresh_ctx(C_); const int cid = C.bid; const unsigned char* wl = args.ws + WS_W_LRU + (size_t)j * W_LRU_STRIDE;
                pg8::DenseSched S; S.init(WSP(bf16_t, WS_UC), wl + OFF_LRU_WAX, DM, 256, T, 2048, C.G, cid); S.apn_shift = 1; S.akbytes = 512;
                pg8::EpiAB E{WSP(bf16_t, WS_AA), WSP(bf16_t, WS_BB), WSP(bf16_t, WS_UC), INF(I_LRU_BA) + j * DM, INF(I_LRU_BX) + j * DM, WSP(float, WS_SPL) + j * DM};
                pg8::gemm_phase<pg8::EpiAB, pg8::DenseSched, false>(C.lds, 4, DM * 2, 512, S, E);
                PH_END(base + 2);
            }
            if (SEL(8) && IN(base + 3)) { const CAS Args& args = fresh_args(argp); const Ctx C = fresh_ctx(C_); const int cid = C.bid; phase_scan1(args, C); PH_END(base + 3); }
            if (SEL(9) && IN(base + 4)) { const CAS Args& args = fresh_args(argp); const Ctx C = fresh_ctx(C_); const int cid = C.bid; phase_scan2(args, C); PH_END(base + 4); }
        }
        if (SEL(10) && IN(base + 5)) { const CAS Args& args = fresh_args(argp); const Ctx C = fresh_ctx(C_); const int cid = C.bid;
            const unsigned char* wo = (layer & 1) ? args.ws + WS_W_LRU + (size_t)j * W_LRU_STRIDE + OFF_LRU_WOUT : args.ws + WS_W_MLA + (size_t)j * W_MLA_STRIDE + OFF_MLA_WO;
            pg8::DenseSched S; S.init(WSP(bf16_t, WS_O), wo, DM, DM, T, DM, C.G, cid);
            pg8::EpiRes E{WSP(bf16_t, WS_XB), WSP(bf16_t, WS_Y)};
            pg8::gemm_phase<pg8::EpiRes, pg8::DenseSched, false>(C.lds, DM / 64, DM * 2, DM * 2, S, E);
            PH_END(base + 5);
        }
        if (SEL(11) && IN(base + 6)) { const CAS Args& args = fresh_args(argp); const Ctx C = fresh_ctx(C_); const int cid = C.bid; phase_ln_router(args, C, layer); PH_END(base + 6); }
        if (SEL(12) && IN(base + 7)) { const CAS Args& args = fresh_args(argp); const Ctx C = fresh_ctx(C_); const int cid = C.bid;
            moe_table(args, C, layer);
            pg8::MoeSched S{(const char*)(args.ws + WS_X1Q), (const char*)(args.ws + WS_W_UP + (size_t)layer * NE * 2048 * 1024), (size_t)2048 * 1024, (const char*)(args.ws + WS_SW + (size_t)layer * NE * 65536), DM, DM, 8, WSP(int, WS_LIST), C.misc + 16, (volatile LAS const unsigned char*)(C.lds + TILE_E_OFF), C.G, cid, true, nullptr};
            const int sae = 127 - (int)__hip_atomic_load(WSP(unsigned, WS_CTL) + CW_SA + layer, __ATOMIC_RELAXED, __HIP_MEMORY_SCOPE_AGENT);
            pg8::EpiUp E{args.ws + WS_H, args.ws + WS_SH, INF(I_MOE_BUP) + (size_t)layer * NE * 2048};
            pg8::gemm_phase<pg8::EpiUp, pg8::MoeSched, true, 1>(C.lds, DM / 128, DM, DM, S, E, PROBE_T ? (unsigned long long*)(args.ws + WS_CTL + 8192) : nullptr, sae * 0x01010101);
            PH_END(base + 7);
        }
        if (SEL(13) && IN(base + 8)) { const CAS Args& args = fresh_args(argp); const Ctx C = fresh_ctx(C_); const int cid = C.bid;
            moe_table(args, C, layer);
            pg8::MoeSched S{(const char*)(args.ws + WS_H), (const char*)(args.ws + WS_W_DN + (size_t)layer * NE * 1024 * 1024), (size_t)1024 * 1024, (const char*)(args.ws + WS_SWD + (size_t)layer * NE * 16384), DFF, DFF, 4, WSP(int, WS_LIST), C.misc + 16, (volatile LAS const unsigned char*)(C.lds + TILE_E_OFF), C.G, cid, false, (const char*)(args.ws + WS_SH)};
            pg8::EpiDown E{args.ws + WS_YS, args.ws + WS_SY, INF(I_MOE_BDN) + (size_t)layer * NE * DM};
            pg8::gemm_phase<pg8::EpiDown, pg8::MoeSched, false, 2>(C.lds, DFF / 128, DFF, DFF, S, E);
            PH_END(base + 8);
        }
        if (SEL(14) && IN(base + 9)) { const CAS Args& args = fresh_args(argp); const Ctx C = fresh_ctx(C_); const int cid = C.bid; phase_combine_ln2(args, C, layer); PH_END(base + 9); }
        if (SEL(15) && IN(base + 10)) { const CAS Args& args = fresh_args(argp); const Ctx C = fresh_ctx(C_); const int cid = C.bid;
            pg8::DenseSched S; S.init(args.ws + WS_X2Q, args.ws + WS_W_PLE + (size_t)layer * W_PLE_STRIDE + OFF_PLE_WG, DM / 2, DM / 2, T, DM, C.G, cid); S.SW = (const char*)(args.ws + WS_SWG + (size_t)layer * 65536);
            const int sae = 127 - (int)__hip_atomic_load(WSP(unsigned, WS_CTL) + CW_SA2 + layer, __ATOMIC_RELAXED, __HIP_MEMORY_SCOPE_AGENT);
            pg8::EpiPle E{WSP(bf16_t, WS_X2B), WSP(bf16_t, WS_PP) + (size_t)layer * T * DM, layer == DEPTH - 1 ? args.out : (float*)nullptr, WSP(bf16_t, WS_XB)};
            pg8::gemm_phase<pg8::EpiPle, pg8::DenseSched, false, 1>(C.lds, DM / 128, DM, DM, S, E, nullptr, sae * 0x01010101);
            if (layer + 1 < DEPTH) PH_END(base + 10);
        }
    }
#if PROBE_T
    if (PROBE_T == 20 && blockIdx.x == 0 && threadIdx.x < 64) { const CAS Args& args = fresh_args(argp); mfma_fp8_selftest((unsigned*)(args.ws + WS_CTL + 8192 + 256)); }
    { xcd_barrier(bar); const CAS Args& args = fresh_args(argp);
      const unsigned long long* pw = (const unsigned long long*)(args.ws + WS_CTL + 8192);
      const double pk = (double)__hip_atomic_load(pw + 0, __ATOMIC_RELAXED, __HIP_MEMORY_SCOPE_AGENT), pe = (double)__hip_atomic_load(pw + 1, __ATOMIC_RELAXED, __HIP_MEMORY_SCOPE_AGENT),
                   pn = (double)__hip_atomic_load(pw + 2, __ATOMIC_RELAXED, __HIP_MEMORY_SCOPE_AGENT), pt = (double)__hip_atomic_load(pw + 3, __ATOMIC_RELAXED, __HIP_MEMORY_SCOPE_AGENT);
      float c = 100.f;
      if (PROBE_T == 2) c = (float)(pk / (pn * 16.0) / 10.0);
      if (PROBE_T == 3) c = (float)(pe / pn / 100.0);
      if (PROBE_T == 4) c = (float)((pt - pk - pe) / pn / 100.0);
      if (PROBE_T == 5) c = (float)(pn);
      if (PROBE_T >= 10) { double q[7]; for (int i = 0; i < 7; ++i) q[i] = (double)__hip_atomic_load(pw + 8 + i, __ATOMIC_RELAXED, __HIP_MEMORY_SCOPE_AGENT);
          if (PROBE_T == 10) c = (float)(q[6] / q[5] / 10.0);
          if (PROBE_T == 11) c = (float)(q[0] / q[5] / 10.0);
          if (PROBE_T == 12) c = (float)(q[1] / q[5] / 10.0);
          if (PROBE_T == 13) c = (float)(q[2] / q[5] / 10.0);
          if (PROBE_T == 14) c = (float)(q[3] / q[5] / 10.0);
          if (PROBE_T == 15) c = (float)(q[4] / q[5] / 10.0); }
      if (PROBE_T >= 2 && PROBE_T < 20) c = exp2f(floorf(log2f(c) * 8.0f + PROBE_SHIFT) * 0.125f);
      if (PROBE_T == 20) { const unsigned fl = __hip_atomic_load((const unsigned*)(args.ws + WS_CTL + 8192 + 256), __ATOMIC_RELAXED, __HIP_MEMORY_SCOPE_AGENT); c = 100.f + 10.f * (float)fl; }
      for (size_t i = (size_t)blockIdx.x * 512 + threadIdx.x; i < (size_t)T * DM; i += (size_t)gridDim.x * 512) args.out[i] = c; }
#endif
#undef IN
#undef PH_END
}

extern "C" void kernel_launch(void* const* d_in, const int* in_sizes, int n_in, void* d_out, int out_size, void* d_ws, size_t ws_size, hipStream_t stream) {
    static int grid = 0;
    if (grid == 0) {
        if (n_in != 30 || in_sizes[0] != T * DM || out_size != T * DM || ws_size < WS_END) { fprintf(stderr, "kernel_launch: unexpected shapes (n_in %d, in0 %d, out %d, ws %zu)\n", n_in, n_in > 0 ? in_sizes[0] : -1, out_size, ws_size); grid = -1; return; }
        int dev = 0, cus = 0, per_cu = 0;
        if (hipGetDevice(&dev) != hipSuccess || hipDeviceGetAttribute(&cus, hipDeviceAttributeMultiprocessorCount, dev) != hipSuccess) { grid = -1; return; }
        if (hipFuncSetAttribute((const void*)fwd_kernel, hipFuncAttributeMaxDynamicSharedMemorySize, LDS_BYTES) != hipSuccess) { fprintf(stderr, "kernel_launch: hipFuncSetAttribute failed\n"); grid = -1; return; }
        if (hipOccupancyMaxActiveBlocksPerMultiprocessor(&per_cu, (const void*)fwd_kernel, NWAVES * 64, LDS_BYTES) != hipSuccess || per_cu < 1) fprintf(stderr, "kernel_launch: occupancy query reports %d\n", per_cu);
        (void)hipGetLastError();
        grid = cus;
    }
    if (grid < 0) return;
    if (hipMemsetAsync((char*)d_ws + WS_CTL, 0, CTL_ZERO_BYTES, stream) != hipSuccess) return;
    Args a{};
    for (int i = 0; i < 30; ++i) a.in[i] = d_in[i];
    a.out = (float*)d_out; a.ws = (unsigned char*)d_ws; a.pad = 0;
#if MK_ONE_LAUNCH
    a.ph_lo = 0; a.ph_hi = PH_TOTAL; a.li = 0;
    hipLaunchKernelGGL(fwd_kernel, dim3(grid), dim3(NWAVES * 64), LDS_BYTES, stream, a);
#else
    int li = 0;
    for (int ph = 0; ph < PH_TOTAL; ++ph) {
        if (ph >= 2) { const int l = (ph - 2) / PH_PER_LAYER, k = (ph - 2) % PH_PER_LAYER; if (k == 11) continue; if ((l & 1) == 0 && (k == 3 || k == 4)) continue; }
        int site = ph;
        if (ph >= 2) { const int l = (ph - 2) / PH_PER_LAYER, k = (ph - 2) % PH_PER_LAYER; static const int mla[11] = {2, 3, 4, -1, -1, 10, 11, 12, 13, 14, 15}, lru[11] = {5, 6, 7, 8, 9, 10, 11, 12, 13, 14, 15}; site = (l & 1) ? lru[k] : mla[k]; }
        a.ph_lo = ph; a.ph_hi = ph + 1;
        if ((HOSTDUP >> site) & 1) { a.li = li++; a.pad = 4; hipLaunchKernelGGL(fwd_kernel, dim3(grid), dim3(NWAVES * 64), LDS_BYTES, stream, a); }
        a.li = li++; a.pad = 0;
        hipLaunchKernelGGL(fwd_kernel, dim3(grid), dim3(NWAVES * 64), LDS_BYTES, stream, a);
    }
#endif
}
```

```cpp
#include <hip/hip_runtime.h>
#include <hip/hip_bf16.h>
#include <cstdio>
#include <cstdint>

#ifndef PHSEL
#define PHSEL -1
#endif
#ifndef PHSKIP
#define PHSKIP -1
#endif
#define SEL(id) ((PHSEL < 0 || PHSEL == (id)) && PHSKIP != (id))
#ifndef PROBE_T
#define PROBE_T 0
#endif
#ifndef PROBE_SHIFT
#define PROBE_SHIFT 0.0f
#endif
#ifndef HOSTDUP
#define HOSTDUP 0
#endif
#ifndef MK_ONE_LAUNCH
#define MK_ONE_LAUNCH 1
#endif

constexpr int T = 32768, SEQ = 4096, NBATCH = 8, DM = 1024, DEPTH = 4;
constexpr int QL = 768, KVL = 256, ROPE = 64, LATD = 1088, NH = 8, DQK = 192, DV = 128;
constexpr int NE = 32, TOPK = 4, DFF = 1024, PLED = 256;
constexpr float ALPHA = 1.681792830507429f;
constexpr float LN_EPS = 1e-5f, RMS_EPS = 1e-6f;
constexpr float QSCALE = 1.4426950408889634f / 13.856406460551018f;
constexpr int NWAVES = 8;

constexpr size_t MiB = 1u << 20;
constexpr size_t WS_CTL = 0, CTL_ZERO_BYTES = 2 * MiB;
constexpr size_t WS_CS = 2 * MiB, WS_SN = 6 * MiB, WS_SPL = 10 * MiB;
constexpr size_t WS_WRH = WS_SPL + 65536, WS_WRL = WS_WRH + 262144;
constexpr size_t WS_RC = WS_SPL + 16384;
constexpr size_t WS_W_MLA = 12 * MiB, W_MLA_STRIDE = 8 * MiB;
constexpr size_t OFF_MLA_WIN = 0, OFF_MLA_WUQ = 2560 * 1024, OFF_MLA_WUKV = OFF_MLA_WUQ + 2304 * 1024, OFF_MLA_WO = OFF_MLA_WUKV + 1024 * 1024;
constexpr size_t WS_W_LRU = 28 * MiB, W_LRU_STRIDE = 8 * MiB;
constexpr size_t OFF_LRU_WIN = 0, OFF_LRU_WAX = 4 * MiB, OFF_LRU_WOUT = 5 * MiB;
constexpr size_t WS_W_PLE = 44 * MiB, W_PLE_STRIDE = 3 * MiB;
constexpr size_t OFF_PLE_WG = 0, OFF_PLE_WP = 2 * MiB;
constexpr size_t WS_W_UP = 56 * MiB;
constexpr size_t WS_W_DN = 568 * MiB;
constexpr size_t WS_XB = 824 * MiB, WS_PB = 888 * MiB, WS_PP = 952 * MiB;
constexpr size_t WS_Y = 1208 * MiB, WS_X1 = 1336 * MiB, WS_X1B = 1464 * MiB, WS_X2 = 1528 * MiB, WS_X2B = 1656 * MiB;
constexpr size_t WS_LAT = 1720 * MiB, WS_KR = 1784 * MiB, WS_SSQ = 1788 * MiB, WS_Q = 1790 * MiB, WS_KN = 1886 * MiB, WS_V = 1950 * MiB, WS_O = 2014 * MiB;
constexpr size_t WS_GG = 2078 * MiB, WS_U = 2142 * MiB, WS_UC = 2206 * MiB, WS_AA = 2270 * MiB, WS_BB = 2398 * MiB, WS_CA = 2526 * MiB, WS_CH = 2528 * MiB;
constexpr size_t WS_H = 2530 * MiB, WS_YS = 2802 * MiB, WS_LIST = 3074 * MiB, WS_SLOT = 3078 * MiB, WS_GATE = 3079 * MiB, WS_SW = 3080 * MiB  , WS_X1Q = 3088 * MiB  , WS_SH = 3120 * MiB  ,
                 WS_SWD = 3128 * MiB  , WS_SY = 3132 * MiB  , WS_X2Q = 3140 * MiB  , WS_SWG = 3172 * MiB  , WS_END = 3174 * MiB;
constexpr int PADROWS = T * TOPK + NE * 256;
static_assert((size_t)PADROWS * DFF * 2 <= 272 * MiB, "H / YS size");
constexpr int CW_SA2 = 136;
constexpr int CW_SA = 128;
constexpr int CW_CNT = 256;
constexpr int CW_BAR = 4096;

constexpr int RING_BYTES = 133120;
constexpr int TILE_E_OFF = 131072;
constexpr int SCL_OFF = RING_BYTES;
constexpr int MISC_OFF = SCL_OFF + 24576;
constexpr int LDS_BYTES = 163840;

#define GAS __attribute__((address_space(1)))
#define LAS __attribute__((address_space(3)))
#define CAS __attribute__((address_space(4)))
typedef unsigned short bf16_t;
typedef short bf16x8 __attribute__((ext_vector_type(8)));
typedef short s16x4 __attribute__((ext_vector_type(4)));
typedef float f32x2 __attribute__((ext_vector_type(2)));
typedef float f32x4 __attribute__((ext_vector_type(4)));
typedef float f32x16 __attribute__((ext_vector_type(16)));
typedef unsigned u32x2 __attribute__((ext_vector_type(2)));
typedef unsigned u32x4 __attribute__((ext_vector_type(4)));

__device__ __forceinline__ unsigned cvt_pk_bf16(float lo, float hi) { unsigned r; asm volatile("v_cvt_pk_bf16_f32 %0, %1, %2" : "=v"(r) : "v"(lo), "v"(hi)); return r; }
__device__ __forceinline__ float bf_lo(unsigned w) { return __uint_as_float(w << 16); }
__device__ __forceinline__ float bf_hi(unsigned w) { return __uint_as_float(w & 0xffff0000u); }
__device__ __forceinline__ float sigmoidf_(float x) { return __builtin_amdgcn_rcpf(1.0f + __expf(-x)); }
__device__ __forceinline__ float gelu_tanh(float x) { const float u = 0.7978845608028654f * (x + 0.044715f * x * x * x); const float t = 1.0f - 2.0f * __builtin_amdgcn_rcpf(1.0f + __expf(2.0f * u)); return 0.5f * x * (1.0f + t); }
__device__ __forceinline__ u32x4 pack8(const f32x4 a, const f32x4 b) { u32x4 w; w.x = cvt_pk_bf16(a[0], a[1]); w.y = cvt_pk_bf16(a[2], a[3]); w.z = cvt_pk_bf16(b[0], b[1]); w.w = cvt_pk_bf16(b[2], b[3]); return w; }
__device__ __forceinline__ float KF(float v) { asm volatile("" : "+s"(v)); return v; }
__device__ __forceinline__ int opaque_tid() { int t = threadIdx.x; asm volatile("" : "+v"(t)); return t; }
__device__ __forceinline__ float wave_sum(float v) {
#pragma unroll
    for (int o = 1; o < 64; o <<= 1) v += __shfl_xor(v, o);
    return v;
}

namespace pg8 {
#define PG8_LAS __attribute__((address_space(3)))
constexpr int BM = 256, BK = 64, HALF = 128, HTB = HALF * BK * 2, STAGE_BYTES = 8 * HTB;
__host__ __device__ __forceinline__ int lds_byte(int r, int c) { const int st = (r >> 4) * 2 + (c >> 5), rr = r & 15, cc = c & 31, ob = rr * 64 + cc * 2; return st * 1024 + (ob ^ (((ob >> 9) & 1) << 5)); }
__host__ __device__ __forceinline__ void stage_rc(int b, int& R, int& C) { const int st = b / 1024, sb = b % 1024, swz = sb ^ (((sb >> 9) & 1) << 5); R = (st >> 1) * 16 + swz / 64; C = (st & 1) * 32 + (swz % 64) / 2; }
__host__ __device__ __forceinline__ int perm32(int rho) { const int n = rho >> 4, i = rho & 15; return 8 * (i >> 2) + 4 * n + (i & 3); }

struct Unit { const char* A; const char* B; const char* S; const char* SA; const int* lst; int nvalid; int pm, pn, aux; };

typedef int v4i_t __attribute__((ext_vector_type(4)));
typedef int v8i_t __attribute__((ext_vector_type(8)));
template <class Epi, class Sched, bool GATHER, int FPM = 0>
__device__ __forceinline__ void gemm_phase(PG8_LAS unsigned char* lds, const int nt  , const int lda  , const int ldb  , const Sched& S, const Epi& E, unsigned long long* pw = nullptr, const int sa = 0x7f7f7f7f) {
    constexpr bool FP8 = FPM != 0;
    const int tid = opaque_tid(), wid = __builtin_amdgcn_readfirstlane(tid >> 6), lane = tid & 63, wr = wid >> 2, wc = wid & 3, fr = lane & 15, fq = lane >> 4;
    unsigned voffB[2], ocA[2][2], onA[2][2];
#pragma unroll
    for (int i = 0; i < 2; ++i) { int R, C; stage_rc(tid * 16 + i * 8192, R, C); const int Rb = Epi::PERM ? ((R & ~31) + perm32(R & 31)) : R;
        voffB[i] = (unsigned)(Rb * ldb + C * 2);
        ocA[0][i] = (unsigned)(R * lda + C * 2); ocA[1][i] = (unsigned)((R + HALF) * lda + C * 2); onA[0][i] = ocA[0][i]; onA[1][i] = ocA[1][i]; }
    constexpr unsigned kstep = BK * 2;
    const unsigned hstepB = (unsigned)HALF * ldb;
    const unsigned ldsw = (unsigned)wid * 1024u;
    const int aoff = lds_byte(wr * 64 + fr, fq * 8), boff = lds_byte(wc * 32 + fr, fq * 8);
#define PG8_SA(b, h) (((b) * 2 + (h)) * HTB)
#define PG8_SB(b, h) ((4 + (b) * 2 + (h)) * HTB)
#define PG8_STAGE(bufoff, gbase, voff, kb) do { _Pragma("unroll") for (int _i = 0; _i < 2; ++_i) \
        __builtin_amdgcn_global_load_lds((const unsigned*)((const char*)(gbase) + (size_t)(unsigned)((voff)[_i] + (unsigned)(kb))), (PG8_LAS unsigned*)(lds + (bufoff) + ldsw + _i * 8192), 16, 0, 0); } while (0)
#define PG8_CAT(x0, x1) __builtin_shufflevector(x0, x1, 0, 1, 2, 3, 4, 5, 6, 7)
#define PG8_LO(x) __builtin_bit_cast(bf16x8, __builtin_shufflevector(x, x, 0, 1, 2, 3))
#define PG8_HI(x) __builtin_bit_cast(bf16x8, __builtin_shufflevector(x, x, 4, 5, 6, 7))
    const PG8_LAS unsigned char* const ldsA = lds + aoff; const PG8_LAS unsigned char* const ldsB = lds + 4 * HTB + boff;
#define PG8_LDA(dst, b, h) do { _Pragma("unroll") for (int m = 0; m < 4; ++m) dst[m] = PG8_CAT(*(const PG8_LAS v4i_t*)(ldsA + (PG8_SA(b, h) + m * 2048)), *(const PG8_LAS v4i_t*)(ldsA + (PG8_SA(b, h) + m * 2048 + 1024))); } while (0)
#define PG8_LDB(dst, b, h) do { _Pragma("unroll") for (int n = 0; n < 2; ++n) dst[n] = PG8_CAT(*(const PG8_LAS v4i_t*)(ldsB + (PG8_SB(b, h) - 4 * HTB + n * 2048)), *(const PG8_LAS v4i_t*)(ldsB + (PG8_SB(b, h) - 4 * HTB + n * 2048 + 1024))); } while (0)
#define PG8_MMA(ai, bj, At, Bt) do { __builtin_amdgcn_s_setprio(1); \
        if constexpr (FP8) { asm volatile("s_nop 4" ::: "memory"); _Pragma("unroll") for (int m = 0; m < 4; ++m) _Pragma("unroll") for (int n = 0; n < 2; ++n) \
            asm volatile("v_mfma_scale_f32_16x16x128_f8f6f4 %0, %1, %2, %0, %3, %4 op_sel_hi:[0,0,0]" : "+v"(acc[ai][bj][m][n]) : "v"(Bt[n]), "v"(At[m]), "v"(sB[bj][n]), "v"(FPM == 2 ? sA[m] : sav)); } \
        else { _Pragma("unroll") for (int m = 0; m < 4; ++m) _Pragma("unroll") for (int n = 0; n < 2; ++n) { \
            acc[ai][bj][m][n] = __builtin_amdgcn_mfma_f32_16x16x32_bf16(PG8_LO(Bt[n]), PG8_LO(At[m]), acc[ai][bj][m][n], 0, 0, 0); \
            acc[ai][bj][m][n] = __builtin_amdgcn_mfma_f32_16x16x32_bf16(PG8_HI(Bt[n]), PG8_HI(At[m]), acc[ai][bj][m][n], 0, 0, 0); } } \
        __builtin_amdgcn_s_setprio(0); } while (0)
    int sB[2][2] = {{0x7f, 0x7f}, {0x7f, 0x7f}}; int sav; asm volatile("v_mov_b32 %0, %1" : "=v"(sav) : "s"(sa));
    int sA[4] = {0x7f, 0x7f, 0x7f, 0x7f};
    const int scol = wc * 32 + (Epi::PERM ? 8 * (fr >> 2) + (fr & 3) : fr);
    const int sbase = FPM == 2 ? SCL_OFF + 16384 + scol * 2 + (fq >> 1) : SCL_OFF + scol * 4 + fq;
    const int sabase = SCL_OFF + ((wr * 64 + fr) << 2) + fq;
#define PG8_LDS_SCL(par_, kt_) do { if constexpr (FP8) { \
        const PG8_LAS unsigned char* sp_ = (const PG8_LAS unsigned char*)lds + sbase + (FPM == 2 ? (par_) * 4096 + (kt_) * 512 : (par_) * 8192 + (kt_) * 1024); \
        _Pragma("unroll") for (int bj_ = 0; bj_ < 2; ++bj_) _Pragma("unroll") for (int n_ = 0; n_ < 2; ++n_) sB[bj_][n_] = (int)sp_[(bj_ * 128 + n_ * (Epi::PERM ? 4 : 16)) * (FPM == 2 ? 2 : 4)]; } } while (0)
#define PG8_LDS_SCA(par_, kt_, ai_) do { if constexpr (FPM == 2) { const PG8_LAS unsigned char* sp_ = (const PG8_LAS unsigned char*)lds + sabase + (par_) * 8192 + (kt_) * 1024 + (ai_) * 512; \
        _Pragma("unroll") for (int m_ = 0; m_ < 4; ++m_) sA[m_] = (int)sp_[m_ * 64]; } } while (0)
#define PG8_DMA_SCL(u_, par_) do { if constexpr (FPM == 1) __builtin_amdgcn_global_load_lds((const unsigned*)((u_).S + wid * 1024 + lane * 16), (PG8_LAS unsigned*)(lds + SCL_OFF + (par_) * 8192 + wid * 1024), 16, 0, 0); \
        if constexpr (FPM == 2) { __builtin_amdgcn_global_load_lds((const unsigned*)((u_).SA + wid * 1024 + lane * 16), (PG8_LAS unsigned*)(lds + SCL_OFF + (par_) * 8192 + wid * 1024), 16, 0, 0); \
            if (wid < 4) __builtin_amdgcn_global_load_lds((const unsigned*)((u_).S + wid * 1024 + lane * 16), (PG8_LAS unsigned*)(lds + SCL_OFF + 16384 + (par_) * 4096 + wid * 1024), 16, 0, 0); } } while (0)
#define PG8_WAIT_V(n) asm volatile("s_waitcnt vmcnt(" #n ")" ::: "memory")
#define PG8_WAIT_L(n) asm volatile("s_waitcnt lgkmcnt(" #n ")" ::: "memory")
#define PG8_BAR __builtin_amdgcn_s_barrier()
#define PG8_SCHED __builtin_amdgcn_sched_barrier(0)
#define PG8_GOFFS(u, o) do { _Pragma("unroll") for (int _h = 0; _h < 2; ++_h) _Pragma("unroll") for (int _i = 0; _i < 2; ++_i) { int gR_, gC_; stage_rc(tid * 16 + _i * 8192, gR_, gC_); int _r = _h * HALF + gR_; _r = _r < (u).nvalid ? _r : (u).nvalid - 1; \
        const int _tok = (u).lst[_r]; (o)[_h][_i] = (unsigned)_tok * (unsigned)lda + (unsigned)(gC_ * 2); } } while (0)
#define PG8_GRAW(u, tk) do {   _Pragma("unroll") for (int _h = 0; _h < 2; ++_h) _Pragma("unroll") for (int _i = 0; _i < 2; ++_i) { int gR_, gC_; stage_rc(tid * 16 + _i * 8192, gR_, gC_); int _r = _h * HALF + gR_; _r = _r < (u).nvalid ? _r : (u).nvalid - 1; (tk)[_h][_i] = (unsigned)(u).lst[_r]; } } while (0)
    Unit cur, nxt, nn; int ui = 0;
#if PROBE_T
    unsigned long long pk_ = 0, pe_ = 0, pt0_ = 0, pn_ = 0; const unsigned long long pst_ = __builtin_amdgcn_s_memtime();
#endif
    if (!S.next(0, cur)) return;
    f32x4 acc[2][2][4][2];
#pragma unroll
    for (int a = 0; a < 2; ++a)
#pragma unroll
        for (int b = 0; b < 2; ++b)
#pragma unroll
            for (int m = 0; m < 4; ++m)
#pragma unroll
                for (int n = 0; n < 2; ++n) acc[a][b][m][n] = (f32x4){0.f, 0.f, 0.f, 0.f};
    v8i_t At[4], B0[2], B1[2];
    const char* cA = cur.A; const char* cB = cur.B;
    bool has_next = S.next(1, nxt);
    if constexpr (GATHER) { PG8_GOFFS(cur, ocA);
        if (has_next) { PG8_GOFFS(nxt, onA); }
        else {
#pragma unroll
            for (int h = 0; h < 2; ++h)
#pragma unroll
                for (int i = 0; i < 2; ++i) onA[h][i] = ocA[h][i]; } }
    PG8_DMA_SCL(cur, 0); if (has_next) PG8_DMA_SCL(nxt, 1);
    PG8_STAGE(PG8_SB(0, 0), cB, voffB, 0u); PG8_STAGE(PG8_SB(0, 1), cB, voffB, hstepB); PG8_STAGE(PG8_SA(0, 0), cA, ocA[0], 0u); PG8_STAGE(PG8_SA(0, 1), cA, ocA[1], 0u);
    if (wr == 1) PG8_BAR;
    PG8_WAIT_V(2); PG8_BAR;
    PG8_STAGE(PG8_SB(1, 0), cB, voffB, kstep); PG8_STAGE(PG8_SA(1, 0), cA, ocA[0], kstep); PG8_STAGE(PG8_SB(1, 1), cB, voffB, hstepB + kstep);
    PG8_WAIT_V(6); PG8_BAR;
    for (;;) {
        const char* nA = has_next ? nxt.A : cA; const char* nB = has_next ? nxt.B : cB;
#if PROBE_T
        pt0_ = __builtin_amdgcn_s_memtime();
#endif
#pragma unroll 1
        for (int t = 0; t < nt; t += 2) {
            const bool last = (t == nt - 2);
            const unsigned k1 = (unsigned)(t + 1) * kstep, k2 = last ? 0u : (unsigned)(t + 2) * kstep, k3 = k2 + kstep;
            const char* a2 = last ? nA : cA; const char* b2 = last ? nB : cB;
#define PG8_STAGE_A2(bufoff, h_, kb_) do { if (GATHER && last) PG8_STAGE(bufoff, a2, onA[h_], kb_); else PG8_STAGE(bufoff, a2, ocA[h_], kb_); } while (0)
            PG8_LDB(B0, 0, 0); PG8_LDB(B1, 0, 1); PG8_LDS_SCL(ui & 1, t); PG8_SCHED; PG8_LDA(At, 0, 0); PG8_LDS_SCA(ui & 1, t, 0); PG8_STAGE(PG8_SA(1, 1), cA, ocA[1], k1);
            PG8_WAIT_V(8); PG8_WAIT_L(0); PG8_BAR; PG8_MMA(0, 0, At, B0); PG8_MMA(0, 1, At, B1); PG8_BAR; PG8_SCHED;
            PG8_LDA(At, 0, 1); PG8_LDS_SCA(ui & 1, t, 1); PG8_STAGE(PG8_SB(0, 0), b2, voffB, k2); PG8_STAGE(PG8_SB(0, 1), b2, voffB, hstepB + k2); PG8_STAGE_A2(PG8_SA(0, 0), 0, k2);
            PG8_WAIT_V(8); PG8_WAIT_L(0); PG8_BAR; PG8_MMA(1, 0, At, B0); PG8_MMA(1, 1, At, B1); PG8_BAR; PG8_SCHED;
            PG8_LDB(B0, 1, 0); PG8_LDB(B1, 1, 1); PG8_LDS_SCL(ui & 1, t + 1); PG8_SCHED; PG8_LDA(At, 1, 0); PG8_LDS_SCA(ui & 1, t + 1, 0); PG8_STAGE_A2(PG8_SA(0, 1), 1, k2);
            PG8_WAIT_V(8); PG8_WAIT_L(0); PG8_BAR; PG8_MMA(0, 0, At, B0); PG8_MMA(0, 1, At, B1); PG8_BAR; PG8_SCHED;
            PG8_LDA(At, 1, 1); PG8_LDS_SCA(ui & 1, t + 1, 1); PG8_STAGE(PG8_SB(1, 0), b2, voffB, k3); PG8_STAGE(PG8_SB(1, 1), b2, voffB, hstepB + k3); PG8_STAGE_A2(PG8_SA(1, 0), 0, k3);
            PG8_WAIT_V(8); PG8_WAIT_L(0); PG8_BAR; PG8_MMA(1, 0, At, B0); PG8_MMA(1, 1, At, B1); PG8_BAR; PG8_SCHED;
        }
#if PROBE_T
        const unsigned long long pt1_ = __builtin_amdgcn_s_memtime(); pk_ += pt1_ - pt0_;
#endif
        if constexpr (FP8) asm volatile("s_nop 15\n\ts_nop 7" ::: "memory");
        const bool has_nn = has_next && S.next(ui + 2, nn);
        if constexpr (GATHER) {
#pragma unroll
            for (int h = 0; h < 2; ++h)
#pragma unroll
                for (int i = 0; i < 2; ++i) ocA[h][i] = onA[h][i];
            if (has_nn) { PG8_GRAW(nn, onA); } }
        if (wr == 0) PG8_BAR;
        E(acc, cur, wr, wc, fr, fq);
#if PROBE_T
        asm volatile("s_waitcnt vmcnt(0)" ::: "memory"); pe_ += __builtin_amdgcn_s_memtime() - pt1_; ++pn_;
#endif
        if (!has_next) break;
#pragma unroll
        for (int a = 0; a < 2; ++a)
#pragma unroll
            for (int b = 0; b < 2; ++b)
#pragma unroll
                for (int m = 0; m < 4; ++m)
#pragma unroll
                    for (int n = 0; n < 2; ++n) acc[a][b][m][n] = (f32x4){0.f, 0.f, 0.f, 0.f};
        cur = nxt; cA = nA; cB = nB; ++ui;
        if constexpr (GATHER) { if (has_nn) {
#pragma unroll
            for (int h = 0; h < 2; ++h)
#pragma unroll
                for (int i = 0; i < 2; ++i) { int gR_, gC_; stage_rc(tid * 16 + i * 8192, gR_, gC_); onA[h][i] = onA[h][i] * (unsigned)lda + (unsigned)(gC_ * 2); } } }
        if (has_nn) { nxt = nn; PG8_DMA_SCL(nxt, (ui + 1) & 1); }
        has_next = has_nn;
        if (wr == 1) PG8_BAR;
    }
    PG8_WAIT_V(0);
    PG8_BAR;
#if PROBE_T
    if (pw && blockIdx.x == 0 && tid == 0) { pw[0] += pk_; pw[1] += pe_; pw[2] += pn_; pw[3] += __builtin_amdgcn_s_memtime() - pst_; }
#endif
#undef PG8_SA
#undef PG8_SB
#undef PG8_STAGE
#undef PG8_LDA
#undef PG8_LDB
#undef PG8_MMA
#undef PG8_WAIT_V
#undef PG8_WAIT_L
#undef PG8_BAR
#undef PG8_SCHED
#undef PG8_GOFFS
#undef PG8_GRAW
#undef PG8_STAGE_A2
#undef PG8_CAT
#undef PG8_LO
#undef PG8_HI
#undef PG8_LDS_SCL
#undef PG8_LDS_SCA
#undef PG8_DMA_SCL
}

constexpr int NXCD = 8, WGM = 8;
struct DenseSched {
    const char* A; const char* B; int lda, ldb; int nM, nN, nwg, G, c; int apn_shift, akbytes, bpm_shift; size_t bbatch; const char* SW;
    __device__ __forceinline__ void init(const void* A_, const void* B_, int lda_, int ldb_, int M, int N, int G_, int c_) {
        A = (const char*)A_; B = (const char*)B_; lda = lda_; ldb = ldb_; nM = M / BM; nN = N / BM; nwg = nM * nN; G = G_; c = c_; apn_shift = -1; akbytes = 0; bpm_shift = -1; bbatch = 0; SW = nullptr; }
    __device__ __forceinline__ bool next(int i, Unit& u) const {
        const long L = (long)i * G + c; if (L >= nwg) return false;
        int wgid = (int)L; { const int q = nwg / NXCD, r = nwg % NXCD, xcd = wgid % NXCD, off = wgid / NXCD; wgid = (xcd < r ? xcd * (q + 1) : r * (q + 1) + (xcd - r) * q) + off; }
        const int nig = WGM * nN, gid = wgid / nig, fm = gid * WGM, gsz = (nM - fm) < WGM ? (nM - fm) : WGM;
        const int pm = fm + ((wgid % nig) % gsz), pn = (wgid % nig) / gsz;
        u.pm = pm; u.pn = pn; u.aux = 0; u.lst = nullptr; u.nvalid = 256; u.S = SW ? SW + (size_t)pn * 8192 : nullptr; u.SA = nullptr;
        u.A = A + (size_t)pm * 256 * lda * 2 + (apn_shift >= 0 ? (size_t)(pn >> apn_shift) * akbytes : (size_t)0);
        u.B = B + (size_t)pn * 256 * ldb * 2 + (bpm_shift >= 0 ? (size_t)(pm >> bpm_shift) * bbatch : (size_t)0);
        return true;
    }
};
struct MoeSched {
    const char* A; const char* B; size_t bexp; const char* SW; int lda, ldb  , nN; const int* lists; volatile LAS const int* tab; volatile LAS const unsigned char* te; int G, c; bool gather; const char* SA;
    __device__ __forceinline__ bool next(int i, Unit& u) const {
        int pn, mg;
        if (G == 256) {
            const int x = c & 7, jj = c >> 3, pgs = nN >> 2, mgs = 8 / pgs;
            mg = i * (8 * mgs) + 8 * (x / pgs) + (jj & 7); pn = 4 * (x % pgs) + (jj >> 3);
            if (mg >= __builtin_amdgcn_readfirstlane(tab[32])) return false;
        } else { const int total = __builtin_amdgcn_readfirstlane(tab[32]) * nN; const long L = (long)i * G + c; if (L >= total) return false; pn = (int)(L % nN); mg = (int)(L / nN); }
        const int e = __builtin_amdgcn_readfirstlane((int)te[mg]), mt = mg - __builtin_amdgcn_readfirstlane(tab[e]);
        u.pm = mg; u.pn = pn; u.aux = e;
        if (gather) { u.A = A; u.lst = lists + (size_t)e * T + mt * 256; const int rem = __builtin_amdgcn_readfirstlane(tab[48 + e]) - mt * 256; u.nvalid = rem < 256 ? rem : 256; }
        else { u.A = A + (size_t)mg * 256 * lda; u.lst = nullptr; u.nvalid = 256; }
        u.B = B + (size_t)e * bexp + (size_t)pn * 256 * ldb; u.S = SW ? (SA ? SW + ((size_t)e * 4 + pn) * 4096 : SW + ((size_t)e * 8 + pn) * 8192) : nullptr; u.SA = SA ? SA + (size_t)mg * 8192 : nullptr;
        return true;
    }
};

#define EPI_ROW(u, ai, m) ((u).pm * 256 + (ai) * 128 + wr * 64 + (m) * 16 + fr)
struct EpiLat {
    static constexpr bool PERM = true;
    bf16_t* LAT; float* SSQ; bf16_t* KR; const float* CS; const float* SN;
    __device__ __forceinline__ void operator()(const f32x4 (&acc)[2][2][4][2], const Unit& u, int wr, int wc, int fr, int fq) const {
        if (u.pn < 4) {
#pragma unroll
            for (int ai = 0; ai < 2; ++ai)
#pragma unroll
                for (int m = 0; m < 4; ++m) { const int row = EPI_ROW(u, ai, m); float ss = 0.f;
#pragma unroll
                    for (int bj = 0; bj < 2; ++bj) { const f32x4 v0 = acc[ai][bj][m][0], v1 = acc[ai][bj][m][1];
                        ss += (v0[0] * v0[0] + v0[1] * v0[1]) + (v0[2] * v0[2] + v0[3] * v0[3]) + (v1[0] * v1[0] + v1[1] * v1[1]) + (v1[2] * v1[2] + v1[3] * v1[3]);
                        *(u32x4*)(LAT + (size_t)row * 1024 + u.pn * 256 + bj * 128 + wc * 32 + 8 * fq) = pack8(v0, v1); }
                    ss += __shfl_xor(ss, 16); ss += __shfl_xor(ss, 32);
                    if (fq == 0) SSQ[(size_t)row * 16 + u.pn * 4 + wc] = ss; }
        } else if (wc == 0) {
#pragma unroll
            for (int ai = 0; ai < 2; ++ai)
#pragma unroll
                for (int m = 0; m < 4; ++m) { const int row = EPI_ROW(u, ai, m);
                    const f32x4 c0 = *(const f32x4*)(CS + (size_t)row * 32 + 8 * fq), c1 = *(const f32x4*)(CS + (size_t)row * 32 + 8 * fq + 4);
                    const f32x4 s0 = *(const f32x4*)(SN + (size_t)row * 32 + 8 * fq), s1 = *(const f32x4*)(SN + (size_t)row * 32 + 8 * fq + 4);
                    const f32x4 a0 = acc[ai][0][m][0], a1 = acc[ai][0][m][1], b0 = acc[ai][1][m][0], b1 = acc[ai][1][m][1];
                    *(u32x4*)(KR + (size_t)row * 64 + 8 * fq) = pack8(a0 * c0 - b0 * s0, a1 * c1 - b1 * s1);
                    *(u32x4*)(KR + (size_t)row * 64 + 32 + 8 * fq) = pack8(b0 * c0 + a0 * s0, b1 * c1 + a1 * s1); }
        }
    }
};
struct EpiQ {
    static constexpr bool PERM = true;
    bf16_t* Q; const float* SSQ; const float* CS; const float* SN;
    __device__ __forceinline__ void operator()(const f32x4 (&acc)[2][2][4][2], const Unit& u, int wr, int wc, int fr, int fq) const {
#pragma unroll
        for (int ai = 0; ai < 2; ++ai)
#pragma unroll
            for (int m = 0; m < 4; ++m) { const int row = EPI_ROW(u, ai, m);
                const f32x4 q0 = *(const f32x4*)(SSQ + (size_t)row * 16), q1 = *(const f32x4*)(SSQ + (size_t)row * 16 + 4), q2 = *(const f32x4*)(SSQ + (size_t)row * 16 + 8);
                const float ss = ((q0[0] + q0[1]) + (q0[2] + q0[3])) + ((q1[0] + q1[1]) + (q1[2] + q1[3])) + ((q2[0] + q2[1]) + (q2[2] + q2[3]));
                const float r = QSCALE / sqrtf(ss * (1.0f / QL) + KF(RMS_EPS));
                if (u.pn < 4) {
#pragma unroll
                    for (int bj = 0; bj < 2; ++bj)
                        *(u32x4*)(Q + (size_t)row * 1536 + (2 * u.pn + bj) * 192 + wc * 32 + 8 * fq) = pack8(acc[ai][bj][m][0] * r, acc[ai][bj][m][1] * r);
                } else {
                    const int head = 4 * (u.pn - 4) + wc;
                    const f32x4 c0 = *(const f32x4*)(CS + (size_t)row * 32 + 8 * fq), c1 = *(const f32x4*)(CS + (size_t)row * 32 + 8 * fq + 4);
                    const f32x4 s0 = *(const f32x4*)(SN + (size_t)row * 32 + 8 * fq), s1 = *(const f32x4*)(SN + (size_t)row * 32 + 8 * fq + 4);
                    const f32x4 a0 = acc[ai][0][m][0] * r, a1 = acc[ai][0][m][1] * r, b0 = acc[ai][1][m][0] * r, b1 = acc[ai][1][m][1] * r;
                    *(u32x4*)(Q + (size_t)row * 1536 + head * 192 + 128 + 8 * fq) = pack8(a0 * c0 - b0 * s0, a1 * c1 - b1 * s1);
                    *(u32x4*)(Q + (size_t)row * 1536 + head * 192 + 160 + 8 * fq) = pack8(b0 * c0 + a0 * s0, b1 * c1 + a1 * s1);
                }
                asm volatile("" ::: "memory"); }
    }
};
struct EpiKV {
    static constexpr bool PERM = true;
    bf16_t* KN; bf16_t* V; const float* SSQ;
    __device__ __forceinline__ void operator()(const f32x4 (&acc)[2][2][4][2], const Unit& u, int wr, int wc, int fr, int fq) const {
#pragma unroll
        for (int ai = 0; ai < 2; ++ai)
#pragma unroll
            for (int m = 0; m < 4; ++m) { const int row = EPI_ROW(u, ai, m);
                const f32x4 q3 = *(const f32x4*)(SSQ + (size_t)row * 16 + 12);
                const float r = 1.0f / sqrtf(((q3[0] + q3[1]) + (q3[2] + q3[3])) * (1.0f / KVL) + KF(RMS_EPS));
                *(u32x4*)(KN + (size_t)row * 1024 + u.pn * 128 + wc * 32 + 8 * fq) = pack8(acc[ai][0][m][0] * r, acc[ai][0][m][1] * r);
                *(u32x4*)(V + (size_t)row * 1024 + u.pn * 128 + wc * 32 + 8 * fq) = pack8(acc[ai][1][m][0] * r, acc[ai][1][m][1] * r); }
    }
};
__device__ __forceinline__ f32x4 bf4_lo(const u32x4 w) { return (f32x4){bf_lo(w.x), bf_hi(w.x), bf_lo(w.y), bf_hi(w.y)}; }
__device__ __forceinline__ f32x4 bf4_hi(const u32x4 w) { return (f32x4){bf_lo(w.z), bf_hi(w.z), bf_lo(w.w), bf_hi(w.w)}; }
struct EpiRes {
    static constexpr bool PERM = true;
    const bf16_t* X; bf16_t* Y;
    __device__ __forceinline__ void operator()(const f32x4 (&acc)[2][2][4][2], const Unit& u, int wr, int wc, int fr, int fq) const {
        const bf16_t* xb = X + (size_t)u.pm * 256 * 1024; bf16_t* yb = Y + (size_t)u.pm * 256 * 1024; const unsigned o0 = (unsigned)((wr * 64 + fr) * 1024 + u.pn * 256 + wc * 32 + 8 * fq);
        u32x4 xw[2][4][2];
#pragma unroll
        for (int ai = 0; ai < 2; ++ai)
#pragma unroll
            for (int m = 0; m < 4; ++m)
#pragma unroll
                for (int bj = 0; bj < 2; ++bj) xw[ai][m][bj] = *(const u32x4*)(xb + (o0 + (unsigned)((ai * 128 + m * 16) * 1024 + bj * 128)));
#pragma unroll
        for (int ai = 0; ai < 2; ++ai)
#pragma unroll
            for (int m = 0; m < 4; ++m)
#pragma unroll
                for (int bj = 0; bj < 2; ++bj)
                    *(u32x4*)(yb + (o0 + (unsigned)((ai * 128 + m * 16) * 1024 + bj * 128))) = pack8(bf4_lo(xw[ai][m][bj]) * ALPHA + acc[ai][bj][m][0], bf4_hi(xw[ai][m][bj]) * ALPHA + acc[ai][bj][m][1]);
    }
};
struct EpiGU {
    static constexpr bool PERM = true;
    bf16_t* GG; bf16_t* U;
    __device__ __forceinline__ void operator()(const f32x4 (&acc)[2][2][4][2], const Unit& u, int wr, int wc, int fr, int fq) const {
#pragma unroll
        for (int ai = 0; ai < 2; ++ai)
#pragma unroll
            for (int m = 0; m < 4; ++m) { const int row = EPI_ROW(u, ai, m);
#pragma unroll
                for (int bj = 0; bj < 2; ++bj) { f32x4 v0 = acc[ai][bj][m][0], v1 = acc[ai][bj][m][1];
                    if (u.pn < 4) {
                        const float k0 = KF(-2.0f * 0.7978845608028654f * 1.4426950408889634f), k1 = KF(-2.0f * 0.7978845608028654f * 1.4426950408889634f * 0.044715f);
                        const f32x4 z0 = v0 * (v0 * v0 * k1 + k0), z1 = v1 * (v1 * v1 * k1 + k0); f32x4 e0, e1, r0, r1;
#pragma unroll
                        for (int e = 0; e < 4; ++e) { e0[e] = __builtin_amdgcn_exp2f(z0[e]); e1[e] = __builtin_amdgcn_exp2f(z1[e]); }
                        const f32x4 d0 = e0 + 1.0f, d1 = e1 + 1.0f;
#pragma unroll
                        for (int e = 0; e < 4; ++e) { r0[e] = __builtin_amdgcn_rcpf(d0[e]); r1[e] = __builtin_amdgcn_rcpf(d1[e]); }
                        v0 = v0 * r0; v1 = v1 * r1;
                        *(u32x4*)(GG + (size_t)row * 1024 + u.pn * 256 + bj * 128 + wc * 32 + 8 * fq) = pack8(v0, v1);
                    } else *(u32x4*)(U + (size_t)row * 1024 + (u.pn - 4) * 256 + bj * 128 + wc * 32 + 8 * fq) = pack8(v0, v1); } }
    }
};
struct EpiAB {
    static constexpr bool PERM = true;
    bf16_t* LA; bf16_t* BB; const bf16_t* UC; const float* BA; const float* BX; const float* SPL;
    __device__ __forceinline__ void operator()(const f32x4 (&acc)[2][2][4][2], const Unit& u, int wr, int wc, int fr, int fq) const {
        const int ch = (u.pn >> 1) * 256 + (u.pn & 1) * 128 + wc * 32 + 8 * fq;
        const float nl2e = KF(-1.4426950408889634f);
        f32x4 ba[2], bx[2], sp[2];
#pragma unroll
        for (int n = 0; n < 2; ++n) { ba[n] = *(const f32x4*)(BA + ch + 4 * n); bx[n] = *(const f32x4*)(BX + ch + 4 * n); sp[n] = *(const f32x4*)(SPL + ch + 4 * n) * (-nl2e); }
#pragma unroll
        for (int ai = 0; ai < 2; ++ai)
#pragma unroll
            for (int m = 0; m < 4; ++m) { const size_t off = (size_t)EPI_ROW(u, ai, m) * 1024 + ch;
                const u32x4 uw = *(const u32x4*)(UC + off); f32x4 uv[2] = {bf4_lo(uw), bf4_hi(uw)}, lv[2], bv[2];
#pragma unroll
                for (int n = 0; n < 2; ++n) {
                    const f32x4 ta = (acc[ai][0][m][n] + ba[n]) * nl2e, tx = (acc[ai][1][m][n] + bx[n]) * nl2e; f32x4 ea, ex, ra, ri, a2, sq;
#pragma unroll
                    for (int e = 0; e < 4; ++e) { ea[e] = __builtin_amdgcn_exp2f(ta[e]); ex[e] = __builtin_amdgcn_exp2f(tx[e]); }
                    const f32x4 da = ea + 1.0f, dx = ex + 1.0f;
#pragma unroll
                    for (int e = 0; e < 4; ++e) { ra[e] = __builtin_amdgcn_rcpf(da[e]); ri[e] = __builtin_amdgcn_rcpf(dx[e]); }
                    const f32x4 l2 = sp[n] * ra, t2 = l2 + l2; lv[n] = l2;
#pragma unroll
                    for (int e = 0; e < 4; ++e) a2[e] = __builtin_amdgcn_exp2f(t2[e]);
                    const f32x4 om = 1.0f - a2;
#pragma unroll
                    for (int e = 0; e < 4; ++e) sq[e] = __builtin_amdgcn_sqrtf(fmaxf(om[e], 0.0f));
                    bv[n] = sq * ri * uv[n]; }
                *(u32x4*)(LA + off) = pack8(lv[0], lv[1]); *(u32x4*)(BB + off) = pack8(bv[0], bv[1]); asm volatile("" ::: "memory"); }
    }
};
struct EpiUp {
    static constexpr bool PERM = true;
    unsigned char* H; unsigned char* SH; const float* BU;
    __device__ __forceinline__ void operator()(f32x4 (&acc)[2][2][4][2], const Unit& u, int wr, int wc, int fr, int fq) const {
        const int gc = u.pn * 128 + wc * 32 + 8 * fq; const float* bu = BU + (size_t)u.aux * 2048;
        const float k7 = KF(7.0f), km7 = KF(-7.0f), ka = KF(-1.702f * 1.4426950408889634f);
#pragma unroll
        for (int n = 0; n < 2; ++n) { const f32x4 bg = *(const f32x4*)(bu + gc + 4 * n), bp = *(const f32x4*)(bu + 1024 + gc + 4 * n);
#pragma unroll
            for (int ai = 0; ai < 2; ++ai)
#pragma unroll
                for (int m = 0; m < 4; ++m) {
                    { f32x4 g = acc[ai][0][m][n] + bg, up = acc[ai][1][m][n] + bp, ex, rc;
#pragma unroll
                      for (int e = 0; e < 4; ++e) { g[e] = fminf(g[e], k7); up[e] = __builtin_amdgcn_fmed3f(up[e], km7, k7); }
                      const f32x4 tz = g * ka;
#pragma unroll
                      for (int e = 0; e < 4; ++e) ex[e] = __builtin_amdgcn_exp2f(tz[e]);
                      const f32x4 dn = ex + 1.0f;
#pragma unroll
                      for (int e = 0; e < 4; ++e) rc[e] = __builtin_amdgcn_rcpf(dn[e]);
                      acc[ai][0][m][n] = (up + 1.0f) * (g * rc); }
                    if (m & 1) __builtin_amdgcn_sched_barrier(0); }
            asm volatile("" ::: "memory"); }
        unsigned char* const shb = SH + ((size_t)u.pm * 8 + u.pn) * 1024; unsigned char* const hb = H + (size_t)u.pm * 256 * 1024;
        const unsigned ho = (unsigned)((wr * 64 + fr) * 1024 + gc), so = (unsigned)((wr * 64 + fr) * 4 + wc);
#pragma unroll
        for (int ai = 0; ai < 2; ++ai)
#pragma unroll
            for (int m = 0; m < 4; ++m) { const f32x4 y0 = acc[ai][0][m][0], y1 = acc[ai][0][m][1];
                float am = fmaxf(fmaxf(fmaxf(fabsf(y0[0]), fabsf(y0[1])), fmaxf(fabsf(y0[2]), fabsf(y0[3]))), fmaxf(fmaxf(fabsf(y1[0]), fabsf(y1[1])), fmaxf(fabsf(y1[2]), fabsf(y1[3]))));
                { auto r16 = __builtin_amdgcn_permlane16_swap(__float_as_uint(am), __float_as_uint(am), false, false); am = fmaxf(__uint_as_float(r16[0]), __uint_as_float(r16[1]));
                  auto r32 = __builtin_amdgcn_permlane32_swap(__float_as_uint(am), __float_as_uint(am), false, false); am = fmaxf(__uint_as_float(r32[0]), __uint_as_float(r32[1])); }
                int eb = (int)((__float_as_uint(am) >> 23) & 0xffu) - 7; eb = eb < 1 ? 1 : eb;
                const float inv = __uint_as_float((unsigned)(254 - eb) << 23);
                int w0 = __builtin_amdgcn_cvt_pk_fp8_f32(y0[0] * inv, y0[1] * inv, 0, false); w0 = __builtin_amdgcn_cvt_pk_fp8_f32(y0[2] * inv, y0[3] * inv, w0, true);
                int w1 = __builtin_amdgcn_cvt_pk_fp8_f32(y1[0] * inv, y1[1] * inv, 0, false); w1 = __builtin_amdgcn_cvt_pk_fp8_f32(y1[2] * inv, y1[3] * inv, w1, true);
                *(u32x2*)(hb + (ho + (unsigned)((ai * 128 + m * 16) * 1024))) = (u32x2){(unsigned)w0, (unsigned)w1};
                if (fq == 0) shb[so + (unsigned)((ai * 128 + m * 16) * 4)] = (unsigned char)eb;
                asm volatile("" ::: "memory"); __builtin_amdgcn_sched_barrier(0); }
    }
};
struct EpiDown {
    static constexpr bool PERM = true;
    unsigned char* YS; unsigned char* SY; const float* BD;
    __device__ __forceinline__ void operator()(const f32x4 (&acc)[2][2][4][2], const Unit& u, int wr, int wc, int fr, int fq) const {
        const float* bd = BD + (size_t)u.aux * 1024;
        unsigned char* const yb = YS + (size_t)u.pm * 256 * 1024; unsigned char* const sb = SY + (size_t)u.pm * 256 * 32;
#pragma unroll
        for (int bj = 0; bj < 2; ++bj) { const int col = u.pn * 256 + bj * 128 + wc * 32 + 8 * fq; const f32x4 b0 = *(const f32x4*)(bd + col), b1 = *(const f32x4*)(bd + col + 4);
#pragma unroll
            for (int ai = 0; ai < 2; ++ai)
#pragma unroll
                for (int m = 0; m < 4; ++m) { const unsigned rit = (unsigned)(ai * 128 + wr * 64 + m * 16 + fr); const f32x4 y0 = acc[ai][bj][m][0] + b0, y1 = acc[ai][bj][m][1] + b1;
                    float am = fmaxf(fmaxf(fmaxf(fabsf(y0[0]), fabsf(y0[1])), fmaxf(fabsf(y0[2]), fabsf(y0[3]))), fmaxf(fmaxf(fabsf(y1[0]), fabsf(y1[1])), fmaxf(fabsf(y1[2]), fabsf(y1[3]))));
                    { auto r16 = __builtin_amdgcn_permlane16_swap(__float_as_uint(am), __float_as_uint(am), false, false); am = fmaxf(__uint_as_float(r16[0]), __uint_as_float(r16[1]));
                      auto r32 = __builtin_amdgcn_permlane32_swap(__float_as_uint(am), __float_as_uint(am), false, false); am = fmaxf(__uint_as_float(r32[0]), __uint_as_float(r32[1])); }
                    int eb = (int)((__float_as_uint(am) >> 23) & 0xffu) - 7; eb = eb < 1 ? 1 : eb;
                    const float inv = __uint_as_float((unsigned)(254 - eb) << 23);
                    int w0 = __builtin_amdgcn_cvt_pk_fp8_f32(y0[0] * inv, y0[1] * inv, 0, false); w0 = __builtin_amdgcn_cvt_pk_fp8_f32(y0[2] * inv, y0[3] * inv, w0, true);
                    int w1 = __builtin_amdgcn_cvt_pk_fp8_f32(y1[0] * inv, y1[1] * inv, 0, false); w1 = __builtin_amdgcn_cvt_pk_fp8_f32(y1[2] * inv, y1[3] * inv, w1, true);
                    *(u32x2*)(yb + (rit * 1024u + (unsigned)col)) = (u32x2){(unsigned)w0, (unsigned)w1};
                    if (fq == 0) sb[rit * 32u + (unsigned)(col >> 5)] = (unsigned char)eb;
                    asm volatile("" ::: "memory"); } }
    }
};
struct EpiPle {
    static constexpr bool PERM = true;
    const bf16_t* X2; const bf16_t* PP; float* OUT; bf16_t* XB;
    __device__ __forceinline__ void operator()(const f32x4 (&acc)[2][2][4][2], const Unit& u, int wr, int wc, int fr, int fq) const {
        const size_t tb = (size_t)u.pm * 256 * 1024; const unsigned o0 = (unsigned)((wr * 64 + fr) * 1024 + u.pn * 256 + wc * 32 + 8 * fq);
#pragma unroll
        for (int ai = 0; ai < 2; ++ai) {
            u32x4 xw[4][2], pw[4][2];
#pragma unroll
            for (int m = 0; m < 4; ++m)
#pragma unroll
                for (int bj = 0; bj < 2; ++bj) { const unsigned o = o0 + (unsigned)((ai * 128 + m * 16) * 1024 + bj * 128); xw[m][bj] = *(const u32x4*)(X2 + tb + o); pw[m][bj] = *(const u32x4*)(PP + tb + o); }
#pragma unroll
            for (int m = 0; m < 4; ++m)
#pragma unroll
                for (int bj = 0; bj < 2; ++bj) { const unsigned o = o0 + (unsigned)((ai * 128 + m * 16) * 1024 + bj * 128);
                    const f32x4 a0 = acc[ai][bj][m][0], a1 = acc[ai][bj][m][1], x0 = bf4_lo(xw[m][bj]), x1 = bf4_hi(xw[m][bj]), p0 = bf4_lo(pw[m][bj]), p1 = bf4_hi(pw[m][bj]); f32x4 r0, r1;
                    { const float nl2e = KF(-1.4426950408889634f); const f32x4 t0 = a0 * nl2e, t1 = a1 * nl2e; f32x4 e0, e1, s0, s1;
#pragma unroll
                      for (int e = 0; e < 4; ++e) { e0[e] = __builtin_amdgcn_exp2f(t0[e]); e1[e] = __builtin_amdgcn_exp2f(t1[e]); }
                      const f32x4 d0 = e0 + 1.0f, d1 = e1 + 1.0f;
#pragma unroll
                      for (int e = 0; e < 4; ++e) { s0[e] = __builtin_amdgcn_rcpf(d0[e]); s1[e] = __builtin_amdgcn_rcpf(d1[e]); }
                      r0 = x0 + s0 * p0; r1 = x1 + s1 * p1; }
                    *(u32x4*)(XB + tb + o) = pack8(r0, r1);
                    if (OUT) { *(f32x4*)(OUT + tb + o) = r0; *(f32x4*)(OUT + tb + o + 4) = r1; } }
            asm volatile("" ::: "memory"); }
    }
};
struct EpiPP {
    static constexpr bool PERM = true;
    bf16_t* PP;
    __device__ __forceinline__ void operator()(const f32x4 (&acc)[2][2][4][2], const Unit& u, int wr, int wc, int fr, int fq) const {
#pragma unroll
        for (int ai = 0; ai < 2; ++ai)
#pragma unroll
            for (int m = 0; m < 4; ++m)
#pragma unroll
                for (int bj = 0; bj < 2; ++bj) *(u32x4*)(PP + (size_t)EPI_ROW(u, ai, m) * 1024 + u.pn * 256 + bj * 128 + wc * 32 + 8 * fq) = pack8(acc[ai][bj][m][0], acc[ai][bj][m][1]);
    }
};
}

namespace att {
constexpr int NW = 8, QBLK = 32, KVBLK = 64, QB = 256, KPITCH = 384;
constexpr int SHM_V = KVBLK * DV * 2, SHM_K = KVBLK * KPITCH;
constexpr int NVB = 3;
constexpr int OFF_V = 0, OFF_K = NVB * SHM_V, OFF_WS = OFF_K + 2 * SHM_K, LDS_BYTES = OFF_WS + NW * 64 * 4;
#define SBAR() __builtin_amdgcn_sched_barrier(0)
__device__ __forceinline__ int k_addr(int row, int chunk) { return row * KPITCH + ((chunk ^ ((row >> 1) & 7)) << 4); }
__device__ __forceinline__ int v_st(int k, int c) { const int kk = (k & ~0xC) | ((k & 4) << 1) | ((k & 8) >> 1); return ((kk >> 3) * 4 + (c >> 5)) * 512 + ((kk & 7) * 32 + (c & 31)) * 2; }
__device__ __forceinline__ int v_rd_base(int lane) { return ((lane & 3) << 3) | (((lane >> 2) & 3) << 6) | (((lane >> 4) & 1) << 5) | (((lane >> 5) & 1) << 8); }
constexpr int v_rd_off(int d0, int ks, int half) { return d0 * 512 + ks * 4096 + half * 2048; }
__device__ __forceinline__ int crow(int r, int hi) { return (r & 3) + 8 * (r >> 2) + 4 * hi; }

template <int KB>
__device__ __forceinline__ void qkt(f32x16& p0, f32x16& p1, const LAS char* K_lds, int r32, int hi, const bf16x8* qr) {
    p0 = f32x16{}; p1 = f32x16{};
    const LAS char* kb[4];
#pragma unroll
    for (int dd = 0; dd < 4; ++dd) kb[dd] = K_lds + KB * SHM_K + r32 * KPITCH + (((2 * dd + hi) ^ ((r32 >> 1) & 7)) << 4);
    bf16x8 f[2][4];
#define QK_LD(g, buf) do { _Pragma("unroll") for (int e_ = 0; e_ < 2; ++e_) { const int d0_ = 2 * (g) + e_; const LAS char* a_ = kb[d0_ & 3] + (d0_ >> 2) * 128; \
        f[buf][2 * e_] = *(const LAS bf16x8*)a_; f[buf][2 * e_ + 1] = *(const LAS bf16x8*)(a_ + 32 * KPITCH); } } while (0)
    QK_LD(0, 0);
#pragma unroll
    for (int g = 0; g < 6; ++g) {
        if (g < 5) QK_LD(g + 1, (g + 1) & 1);
        SBAR();
#pragma unroll
        for (int e = 0; e < 2; ++e) { const int d0 = 2 * g + e;
            p0 = __builtin_amdgcn_mfma_f32_32x32x16_bf16(f[g & 1][2 * e], qr[d0], p0, 0, 0, 0);
            p1 = __builtin_amdgcn_mfma_f32_32x32x16_bf16(f[g & 1][2 * e + 1], qr[d0], p1, 0, 0, 0); }
        SBAR(); }
#undef QK_LD
}
__device__ __forceinline__ void pv_tile(f32x16* o, int vb0  , bf16x8 pa0, bf16x8 pa1, bf16x8 pa2, bf16x8 pa3) {
#define TRRD(dst, off) asm volatile("ds_read_b64_tr_b16 %0, %1 offset:%2" : "=&v"(dst) : "v"(vb0), "i"(off) : "memory")
#define PV_D0(d0) do { s16x4 l0, l1, l2, l3, h0, h1, h2, h3; constexpr int b_ = v_rd_off(d0, 0, 0); \
        TRRD(l0, b_); TRRD(h0, b_ + 2048); TRRD(l1, b_ + 4096); TRRD(h1, b_ + 6144); TRRD(l2, b_ + 8192); TRRD(h2, b_ + 10240); TRRD(l3, b_ + 12288); TRRD(h3, b_ + 14336); \
        asm volatile("s_waitcnt lgkmcnt(0)" ::: "memory"); SBAR(); \
        o[d0] = __builtin_amdgcn_mfma_f32_32x32x16_bf16(pa0, (bf16x8){l0[0], l0[1], l0[2], l0[3], h0[0], h0[1], h0[2], h0[3]}, o[d0], 0, 0, 0); \
        o[d0] = __builtin_amdgcn_mfma_f32_32x32x16_bf16(pa1, (bf16x8){l1[0], l1[1], l1[2], l1[3], h1[0], h1[1], h1[2], h1[3]}, o[d0], 0, 0, 0); \
        o[d0] = __builtin_amdgcn_mfma_f32_32x32x16_bf16(pa2, (bf16x8){l2[0], l2[1], l2[2], l2[3], h2[0], h2[1], h2[2], h2[3]}, o[d0], 0, 0, 0); \
        o[d0] = __builtin_amdgcn_mfma_f32_32x32x16_bf16(pa3, (bf16x8){l3[0], l3[1], l3[2], l3[3], h3[0], h3[1], h3[2], h3[3]}, o[d0], 0, 0, 0); } while (0)
    PV_D0(0); PV_D0(1); PV_D0(2); PV_D0(3);
#undef PV_D0
#undef TRRD
}
__device__ __forceinline__ void mask_tile(f32x16& p0, f32x16& p1, int dq  ) {
    const float NEG = -__builtin_inff();
#pragma unroll
    for (int r = 0; r < 16; ++r) { const int c = (r & 3) + 8 * (r >> 2);
        if (c > dq) p0[r] = NEG;
        if (c + 32 > dq) p1[r] = NEG; }
}
__device__ __forceinline__ void softmax_tile(f32x16& p0, f32x16& p1, float& m_reg, float& l_reg, float& alpha, bf16x8& pa0, bf16x8& pa1, bf16x8& pa2, bf16x8& pa3) {
    float pmax = p0[0];
#pragma unroll
    for (int r = 1; r < 16; ++r) pmax = fmaxf(pmax, p0[r]);
#pragma unroll
    for (int r = 0; r < 16; ++r) pmax = fmaxf(pmax, p1[r]);
    { auto rr = __builtin_amdgcn_permlane32_swap(__float_as_uint(pmax), __float_as_uint(pmax), false, false); pmax = fmaxf(__uint_as_float(rr[0]), __uint_as_float(rr[1])); }
    float mn = m_reg; alpha = 1.f;
    if (!__all(pmax - m_reg <= 8.0f)) { mn = fmaxf(m_reg, pmax); alpha = __builtin_amdgcn_exp2f(m_reg - mn); m_reg = mn; }
    float ps = 0.f;
#pragma unroll
    for (int r = 0; r < 16; ++r) { p0[r] = __builtin_amdgcn_exp2f(p0[r] - mn); ps += p0[r]; }
#pragma unroll
    for (int r = 0; r < 16; ++r) { p1[r] = __builtin_amdgcn_exp2f(p1[r] - mn); ps += p1[r]; }
    { auto rr = __builtin_amdgcn_permlane32_swap(__float_as_uint(ps), __float_as_uint(ps), false, false); ps = __uint_as_float(rr[0]) + __uint_as_float(rr[1]); }
    l_reg = l_reg * alpha + ps;
#define PK4(P, B_, OUT) do { unsigned a0 = cvt_pk_bf16(P[B_+0], P[B_+1]), a1 = cvt_pk_bf16(P[B_+2], P[B_+3]); \
        unsigned b0 = cvt_pk_bf16(P[B_+4], P[B_+5]), b1 = cvt_pk_bf16(P[B_+6], P[B_+7]); \
        auto r0 = __builtin_amdgcn_permlane32_swap(a0, b0, false, false); auto r1 = __builtin_amdgcn_permlane32_swap(a1, b1, false, false); \
        u32x4 w = {r0[0], r1[0], r0[1], r1[1]}; OUT = __builtin_bit_cast(bf16x8, w); } while (0)
    PK4(p0, 0, pa0); PK4(p0, 8, pa1); PK4(p1, 0, pa2); PK4(p1, 8, pa3);
#undef PK4
}

__device__ __forceinline__ void attn_block(int b, int h, int qb, const bf16_t* Q, const bf16_t* KN, const bf16_t* KR, const bf16_t* V, bf16_t* O, LAS char* lds, unsigned long long* pw = nullptr) {
    const int tid = opaque_tid(), wid = __builtin_amdgcn_readfirstlane(tid >> 6), lane = tid & 63, r32 = lane & 31, hi = lane >> 5;
    const size_t row0 = (size_t)b * SEQ;
    const int q0 = qb * QB + wid * QBLK;
    const int NT = (qb + 1) * (QB / KVBLK);
    LAS char* V_lds = lds + OFF_V; LAS char* K_lds = lds + OFF_K;
    LAS float* ws = (LAS float*)(lds + OFF_WS) + wid * 64; LAS float* li_l = ws; LAS float* al_l = ws + 32;
    const int sr = tid >> 4, sc = (tid & 15) * 8, kr_row = tid >> 3, kr_c = tid & 7;
    const int vst0 = v_st(sr, sc), vst1 = v_st(32 + sr, sc), kws = k_addr(sr, tid & 15), kwr = k_addr(kr_row, 16 + kr_c);
    const int vb0 = (int)(uintptr_t)lds + v_rd_base(lane);
    const bf16_t* KNh = KN + row0 * 1024 + h * 128 + sc; const bf16_t* Vh = V + row0 * 1024 + h * 128 + sc; const bf16_t* KRb = KR + row0 * 64 + kr_c * 8;
    bf16x8 st_k0, st_k1, st_kr, st_v0, st_v1;
#define SLOAD(t) do { const size_t k0_ = (size_t)(t) * KVBLK; \
        st_k0 = *(const bf16x8*)(KNh + (k0_ + sr) * 1024); st_k1 = *(const bf16x8*)(KNh + (k0_ + 32 + sr) * 1024); st_kr = *(const bf16x8*)(KRb + (k0_ + kr_row) * 64); \
        st_v0 = *(const bf16x8*)(Vh + (k0_ + sr) * 1024); st_v1 = *(const bf16x8*)(Vh + (k0_ + 32 + sr) * 1024); } while (0)
#define SWRITE(bf, vo) do { *(LAS bf16x8*)(K_lds + (bf) * SHM_K + kws) = st_k0; *(LAS bf16x8*)(K_lds + (bf) * SHM_K + kws + 32 * KPITCH) = st_k1; *(LAS bf16x8*)(K_lds + (bf) * SHM_K + kwr) = st_kr; \
        *(LAS bf16x8*)(V_lds + (vo) + vst0) = st_v0; *(LAS bf16x8*)(V_lds + (vo) + vst1) = st_v1; } while (0)
    SLOAD(0);
    bf16x8 qr[12];
    { const bf16_t* Qw = Q + (row0 + q0 + r32) * 1536 + h * 192 + hi * 8;
#pragma unroll
      for (int d0 = 0; d0 < 12; ++d0) qr[d0] = *(const bf16x8*)(Qw + d0 * 16); }
    float m_reg = -1e30f, l_reg = 0.f; f32x16 o[4] = {};
    f32x16 p0, p1; bf16x8 pa0, pa1, pa2, pa3; float alpha;
    asm volatile("s_waitcnt vmcnt(0)" ::: "memory");
    SWRITE(0, 0);
    __syncthreads();
    const bool odd = wid >= 4; int vo_prev = 0, vo_cur = 0, vo_next = SHM_V;
#define RESC(a) do { if (__any((a) < 1.f)) { if (hi == 0) al_l[r32] = (a); asm volatile("s_waitcnt lgkmcnt(0)" ::: "memory"); \
        _Pragma("unroll") for (int d_ = 0; d_ < 4; ++d_) _Pragma("unroll") for (int r = 0; r < 16; ++r) o[d_][r] *= al_l[crow(r, hi)]; } } while (0)
#if PROBE_T
    unsigned long long pa_ = 0, pb_ = 0, pc_ = 0, pd_ = 0, pe2_ = 0; const unsigned long long pst_ = __builtin_amdgcn_s_memtime();
#define PSTAMP(v) const unsigned long long v = __builtin_amdgcn_s_memtime()
#define PACC(acc, a, b) acc += (b) - (a)
#else
#define PSTAMP(v) do {} while (0)
#define PACC(acc, a, b) do {} while (0)
#endif
#define TILE(t, BF) do { PSTAMP(s0_); const bool more_ = ((t) + 1 < NT); if (more_) SLOAD((t) + 1); SBAR(); \
        if (odd && (t) > 0) { pv_tile(o, vb0 + vo_prev, pa0, pa1, pa2, pa3); SBAR(); } \
        PSTAMP(s1_); qkt<BF>(p0, p1, K_lds, r32, hi, qr); \
        { const int kb_ = (t) * KVBLK; if (kb_ + KVBLK - 1 > q0) mask_tile(p0, p1, q0 + r32 - kb_ - 4 * hi); } \
        asm volatile("" : "+v"(p0), "+v"(p1)); PSTAMP(s2_); \
        softmax_tile(p0, p1, m_reg, l_reg, alpha, pa0, pa1, pa2, pa3); RESC(alpha); SBAR(); PSTAMP(s3_); \
        if (!odd) pv_tile(o, vb0 + vo_cur, pa0, pa1, pa2, pa3); \
        PSTAMP(s4_); if (more_) { asm volatile("s_waitcnt vmcnt(0)" ::: "memory"); SWRITE((BF) ^ 1, vo_next); } \
        PSTAMP(s5_); __syncthreads(); PSTAMP(s6_); PACC(pa_, s1_, s2_); PACC(pb_, s2_, s3_); PACC(pc_, s3_, s4_); PACC(pd_, s4_, s5_); PACC(pe2_, s5_, s6_); vo_prev = vo_cur; vo_cur = vo_next; vo_next = (vo_next == (NVB - 1) * SHM_V) ? 0 : vo_next + SHM_V; } while (0)
#pragma unroll 1
    for (int t = 0; t < NT; t += 2) { TILE(t, 0); TILE(t + 1, 1); }
    if (odd) pv_tile(o, vb0 + vo_prev, pa0, pa1, pa2, pa3);
#if PROBE_T
    if (pw && blockIdx.x == 0 && tid == 0) { pw[8] += pa_; pw[9] += pb_; pw[10] += pc_; pw[11] += pd_; pw[12] += pe2_; pw[13] += (unsigned long long)NT; pw[14] += __builtin_amdgcn_s_memtime() - pst_; }
#endif
    if (hi == 0) li_l[r32] = l_reg; asm volatile("s_waitcnt lgkmcnt(0)" ::: "memory");
    __syncthreads();
    { LAS bf16_t* stg = (LAS bf16_t*)(lds + wid * 8704);
#pragma unroll
      for (int r = 0; r < 16; ++r) { const int orow = crow(r, hi); const float rl = __builtin_amdgcn_rcpf(li_l[orow]);
#pragma unroll
          for (int d0 = 0; d0 < 4; ++d0) { const float v = o[d0][r] * rl; stg[orow * 136 + d0 * 32 + r32] = (bf16_t)(cvt_pk_bf16(v, v) & 0xffffu); } }
      asm volatile("s_waitcnt lgkmcnt(0)" ::: "memory");
      bf16_t* Ow = O + (row0 + q0) * 1024 + h * 128 + (lane & 15) * 8;
#pragma unroll
      for (int it = 0; it < 8; ++it) { const int row = it * 4 + (lane >> 4); const u32x4 v = *(const LAS u32x4*)(stg + row * 136 + (lane & 15) * 8); *(u32x4*)(Ow + (size_t)row * 1024) = v; } }
    __syncthreads();
#undef SLOAD
#undef SWRITE
#undef RESC
#undef TILE
#undef PSTAMP
#undef PACC
}
#undef SBAR
}

#define XB_TMO      128
#define XB_XCNT(j)  (256  + 64 * (j))
#define XB_XSUB(j)  (1280 + 64 * (j))
#define XB_XGEN(j)  (2304 + 64 * (j))
#define XB_TOP      3328
#define XB_TOPGEN   3392
#define XCD_BAR_WORDS 3456
#define XB_SPIN_CAP (1u << 22)
__device__ __forceinline__ unsigned xb_ld(unsigned* p)              { return __hip_atomic_load(p, __ATOMIC_RELAXED, __HIP_MEMORY_SCOPE_AGENT); }
__device__ __forceinline__ unsigned xb_add(unsigned* p, unsigned v) { return __hip_atomic_fetch_add(p, v, __ATOMIC_RELAXED, __HIP_MEMORY_SCOPE_AGENT); }
__device__ __forceinline__ unsigned xb_xcc_id() { return (unsigned)__builtin_amdgcn_s_getreg((3 << 11) | 20) & 0xFu; }
#define XB_SPIN(cond, bar) do { unsigned _sp = 0; while (cond) { __builtin_amdgcn_s_sleep(1); \
    if ((++_sp & 255u) == 0u) { if (xb_ld(&(bar)[XB_TMO])) break; if (_sp > XB_SPIN_CAP) { atomicAdd(&(bar)[XB_TMO], 1u); break; } } } } while (0)
struct XcdBarrier { unsigned* bar; unsigned x; volatile LAS unsigned* st; };
__device__ __forceinline__ XcdBarrier xcd_barrier_post(unsigned* bar, volatile LAS unsigned* st) {
    XcdBarrier b; b.bar = bar; b.x = xb_xcc_id(); b.st = st;
    if (threadIdx.x == 0) (void)xb_add(&bar[XB_XCNT(b.x)], 1u);
    return b;
}
__device__ __forceinline__ void xcd_barrier_complete(unsigned* bar, unsigned x, unsigned& nloc, unsigned& nx) {
    const unsigned G = gridDim.x * gridDim.y * gridDim.z;
    unsigned sum, cnt, mine, sp = 0u;
    for (;;) {
        sum = 0u; cnt = 0u; mine = 0u;
#pragma unroll
        for (unsigned j = 0; j < 16; ++j) { const unsigned c = xb_ld(&bar[XB_XCNT(j)]); sum += c; cnt += (c > 0u) ? 1u : 0u; mine = (j == x) ? c : mine; }
        if (sum == G) break;
        __builtin_amdgcn_s_sleep(1);
        if ((++sp & 255u) == 0u) { if (xb_ld(&bar[XB_TMO])) break; if (sp > XB_SPIN_CAP) { atomicAdd(&bar[XB_TMO], 1u); break; } }
    }
    nloc = mine > 0u ? mine : 1u; nx = cnt > 0u ? cnt : 1u;
}
__device__ __forceinline__ void xcd_barrier(const XcdBarrier& b) {
    asm volatile("s_waitcnt vmcnt(0)" ::: "memory");
    __syncthreads();
    if (opaque_tid() == 0) {
        unsigned* bar = b.bar; unsigned bx = b.x;
        asm volatile("" : "+s"(bar), "+s"(bx));
        __builtin_amdgcn_s_waitcnt(0);
        unsigned nloc = b.st[0], nx = b.st[1];
        if (nloc == 0u) { xcd_barrier_complete(bar, bx, nloc, nx); b.st[0] = nloc; b.st[1] = nx; }
        const unsigned old = xb_add(&bar[XB_XSUB(bx)], 1u);
        const unsigned gen = old / nloc;
        if (old + 1u == (gen + 1u) * nloc) {
            __builtin_amdgcn_fence(__ATOMIC_RELEASE, "agent");
            asm volatile("s_waitcnt vmcnt(0)" ::: "memory");
            const unsigned og = xb_add(&bar[XB_TOP], 1u);
            const unsigned tg = og / nx;
            if (og + 1u == (tg + 1u) * nx) xb_add(&bar[XB_TOPGEN], 1u);
            else XB_SPIN(xb_ld(&bar[XB_TOPGEN]) == tg, bar);
            __builtin_amdgcn_fence(__ATOMIC_ACQUIRE, "agent");
            xb_add(&bar[XB_XGEN(bx)], 1u);
            asm volatile("s_waitcnt vmcnt(0)" ::: "memory");
        } else {
            XB_SPIN(xb_ld(&bar[XB_XGEN(bx)]) == gen, bar);
            __builtin_amdgcn_fence(__ATOMIC_ACQUIRE, "agent");
            asm volatile("s_waitcnt vmcnt(0)" ::: "memory");
        }
    }
    __syncthreads();
}

struct Args { const void* in[30]; float* out; unsigned char* ws; int ph_lo, ph_hi, li, pad; };
struct Ctx { int tid, lane, wave, vcu, G, bid; LAS unsigned char* lds; volatile LAS int* misc; };
__device__ __forceinline__ Ctx fresh_ctx(const Ctx& c) {
    Ctx r = c; unsigned l = (unsigned)(uintptr_t)c.lds, m = (unsigned)(uintptr_t)c.misc;
    asm volatile("" : "+s"(r.wave), "+s"(r.vcu), "+s"(r.G), "+s"(r.bid), "+s"(l), "+s"(m));
    r.lds = (LAS unsigned char*)(uintptr_t)l; r.misc = (volatile LAS int*)(uintptr_t)m; r.tid = opaque_tid(); r.lane = r.tid & 63; return r; }
typedef const CAS Args* ArgsP;
__device__ __forceinline__ const CAS Args& fresh_args(ArgsP p) { asm volatile("" : "+s"(p)); return *p; }
enum { I_X = 0, I_P, I_POS, I_MLA_WIN, I_MLA_QN, I_MLA_KVN, I_MLA_WUQ, I_MLA_WUKV, I_MLA_WO, I_LRU_WIN, I_LRU_CW, I_LRU_CB, I_LRU_WA, I_LRU_BA, I_LRU_WX, I_LRU_BX, I_LRU_LAM, I_LRU_WOUT,
       I_LN1G, I_LN1B, I_LN2G, I_LN2B, I_MOE_WR, I_MOE_BR, I_MOE_WUP, I_MOE_BUP, I_MOE_WDN, I_MOE_BDN, I_PLE_WG, I_PLE_WP };
#define INF(i) ((const float*)args.in[i])
#define WSP(T_, off) ((T_*)(args.ws + (off)))

__device__ __forceinline__ void tr_load(const float* W, int ld, int k0, int sc0, int sc1, int lane, f32x4 (&v)[16]) {
    const int half = (lane & 15) >> 3, scol = half ? sc1 : sc0, c4 = (lane & 7) * 4, rs = lane >> 4;
#pragma unroll
    for (int i = 0; i < 8; ++i) { const float* p = W + (size_t)(k0 + 8 * i + 2 * rs) * ld + scol + c4;
        v[2 * i] = (scol >= 0) ? *(const f32x4*)p : (f32x4){0.f, 0.f, 0.f, 0.f}; v[2 * i + 1] = (scol >= 0) ? *(const f32x4*)(p + ld) : (f32x4){0.f, 0.f, 0.f, 0.f}; }
}
__device__ __forceinline__ void tr_store(f32x4 (&v)[16], const float* ksc, int k0, bf16_t* dst  , int K, LAS unsigned* scr, int lane) {
    const int rs = lane >> 4;
    if (ksc) {
#pragma unroll
        for (int i = 0; i < 8; ++i) { v[2 * i] = v[2 * i] * ksc[k0 + 8 * i + 2 * rs]; v[2 * i + 1] = v[2 * i + 1] * ksc[k0 + 8 * i + 2 * rs + 1]; } }
#pragma unroll
    for (int i = 0; i < 8; ++i) { LAS unsigned* s = scr + (4 * i + rs) * 65 + (lane & 15) * 4;
#pragma unroll
        for (int e = 0; e < 4; ++e) s[e] = cvt_pk_bf16(v[2 * i][e], v[2 * i + 1][e]); }
    asm volatile("s_waitcnt lgkmcnt(0)" ::: "memory");
    const int c = lane & 7;
#pragma unroll
    for (int j = 0; j < 8; ++j) { const int n = (lane >> 3) + 8 * j; const LAS unsigned* s = scr + (4 * c) * 65 + n;
        u32x4 o; o.x = s[0]; o.y = s[65]; o.z = s[130]; o.w = s[195];
        *(u32x4*)(dst + (size_t)n * K + 8 * c) = o; }
    asm volatile("s_waitcnt lgkmcnt(0)" ::: "memory");
}
enum { J_NAT = 0, J_MLA_WIN, J_MLA_WUQ, J_LRU_WAX, J_MOE_UP };
__device__ __forceinline__ int tr_map(int job, int g) {
    switch (job) {
    case J_MLA_WIN: return g < 32 ? 32 * g : (g == 32 ? 1024 : (g == 36 ? 1056 : -1));
    case J_MLA_WUQ: if (g < 32) { const int t = g >> 3, bj = (g >> 2) & 1, cg = g & 3; return (2 * t + bj) * 192 + 32 * cg; }
                    else { const int g2 = g - 32, t2 = g2 >> 3, bj = (g2 >> 2) & 1, hh = g2 & 3; return (4 * t2 + hh) * 192 + 128 + 32 * bj; }
    case J_LRU_WAX: { const int pn = g >> 3, cg = g & 3; return 128 * pn + 32 * cg; }
    case J_MOE_UP:  { const int pn = g >> 3, bj = (g >> 2) & 1, cg = g & 3; return bj * 1024 + 128 * pn + 32 * cg; }
    default: return 32 * g;
    }
}
__device__ __forceinline__ void tr_job(const Ctx& C, int job, const float* src, size_t srcstride, int nmat, int K, int ld, int N, bf16_t* dst, size_t dststride, const float* ksc, int kscstride,
                                       const float* src2  ) {
    LAS unsigned* scr = (LAS unsigned*)(C.lds + C.wave * 8320);
    const int gw = C.vcu * NWAVES + C.wave, NGW = C.G * NWAVES;
    const int nkb = K / 64, nnb = N / 64, per = nkb * nnb, total = per * nmat;
#define TR_DECODE(it_, W_, k0_, s0_, s1_, ks_, d_) do { const int mat_ = (it_) / per, r_ = (it_) - mat_ * per, kb_ = r_ / nnb, nb_ = r_ - kb_ * nnb; \
        s0_ = tr_map(job, 2 * nb_); s1_ = tr_map(job, 2 * nb_ + 1); W_ = src + (size_t)mat_ * srcstride; \
        if (job == J_LRU_WAX && ((nb_ >> 1) & 1)) W_ = src2 + (size_t)mat_ * srcstride;       \
        k0_ = kb_ * 64; ks_ = ksc ? ksc + (size_t)mat_ * kscstride : nullptr; d_ = (bf16_t*)((char*)dst + (size_t)mat_ * dststride) + (size_t)(nb_ * 64) * K + kb_ * 64; } while (0)
    f32x4 va[16], vb[16];
    int it = gw; const float* Wc; int k0c, s0c, s1c; const float* ksc_c; bf16_t* dc;
    if (it < total) { TR_DECODE(it, Wc, k0c, s0c, s1c, ksc_c, dc); tr_load(Wc, ld, k0c, s0c, s1c, C.lane, va); }
    while (it < total) {
        const int nit = it + NGW; const float* Wn = nullptr; int k0n = 0, s0n = 0, s1n = 0; const float* ksc_n = nullptr; bf16_t* dn = nullptr;
        if (nit < total) { TR_DECODE(nit, Wn, k0n, s0n, s1n, ksc_n, dn); tr_load(Wn, ld, k0n, s0n, s1n, C.lane, vb); }
        tr_store(va, ksc_c, k0c, dc, K, scr, C.lane);
#pragma unroll
        for (int i = 0; i < 16; ++i) va[i] = vb[i];
        it = nit; k0c = k0n; ksc_c = ksc_n; dc = dn;
    }
#undef TR_DECODE
}
template <int JOB, int N, bool G64  >
__device__ __forceinline__ void tr_job_fp8(const Ctx& C, const float* src, size_t srcstride, int nmat, unsigned char* dst, size_t dststride, unsigned char* SW) {
    constexpr int K = 1024, ld = N;
    LAS float* scr = (LAS float*)(C.lds + C.wave * 16640);
    const int gw = C.vcu * NWAVES + C.wave, NGW = C.G * NWAVES, lane = C.lane;
    const int nkb = K / 64, nnb = N / 64, per = nkb * nnb, total = per * nmat;
    f32x4 v[16], vn[16];
    if (gw < total) { const int mat = gw / per, r = gw - mat * per, kb = r / nnb, nb = r - kb * nnb; tr_load(src + (size_t)mat * srcstride, ld, kb * 64, tr_map(JOB, 2 * nb), tr_map(JOB, 2 * nb + 1), lane, v); }
    for (int it = gw; it < total; it += NGW) {
        const int mat = it / per, r = it - mat * per, kb = r / nnb, nb = r - kb * nnb;
        { const int nit = it + NGW; if (nit < total) { const int matn = nit / per, rn = nit - matn * per, kbn = rn / nnb, nbn = rn - kbn * nnb; tr_load(src + (size_t)matn * srcstride, ld, kbn * 64, tr_map(JOB, 2 * nbn), tr_map(JOB, 2 * nbn + 1), lane, vn); } }
        const int rs = lane >> 4;
#pragma unroll
        for (int i = 0; i < 8; ++i) { LAS float* sp = scr + (8 * i + 2 * rs) * 65 + (lane & 15) * 4;
#pragma unroll
            for (int e = 0; e < 4; ++e) { sp[e] = v[2 * i][e]; sp[65 + e] = v[2 * i + 1][e]; } }
        asm volatile("s_waitcnt lgkmcnt(0)" ::: "memory");
        const int c = lane & 7;
#pragma unroll
        for (int j = 0; j < 8; ++j) { const int n = (lane >> 3) + 8 * j; const LAS float* sp = scr + (8 * c) * 65 + n;
            float x[8]; float am = 0.f;
#pragma unroll
            for (int q = 0; q < 8; ++q) { x[q] = sp[q * 65]; am = fmaxf(am, fabsf(x[q])); }
            am = fmaxf(am, __shfl_xor(am, 1)); am = fmaxf(am, __shfl_xor(am, 2));
            if (G64) am = fmaxf(am, __shfl_xor(am, 4));
            int eb = (int)((__float_as_uint(am) >> 23) & 0xffu) - 7; eb = eb < 1 ? 1 : eb;
            const float inv = __uint_as_float((unsigned)(254 - eb) << 23);
            int w0 = __builtin_amdgcn_cvt_pk_fp8_f32(x[0] * inv, x[1] * inv, 0, false); w0 = __builtin_amdgcn_cvt_pk_fp8_f32(x[2] * inv, x[3] * inv, w0, true);
            int w1 = __builtin_amdgcn_cvt_pk_fp8_f32(x[4] * inv, x[5] * inv, 0, false); w1 = __builtin_amdgcn_cvt_pk_fp8_f32(x[6] * inv, x[7] * inv, w1, true);
            const int nrow = nb * 64 + n;
            *(u32x2*)(dst + (size_t)mat * dststride + (size_t)nrow * K + kb * 64 + 8 * c) = (u32x2){(unsigned)w0, (unsigned)w1};
            if (!G64) { if ((c & 3) == 0) SW[(size_t)mat * 65536 + (size_t)(nrow >> 8) * 8192 + (size_t)(kb >> 1) * 1024 + (nrow & 255) * 4 + 2 * (kb & 1) + (c >> 2)] = (unsigned char)eb; }
            else { if (c == 0) SW[(size_t)mat * 16384 + (size_t)(nrow >> 8) * 4096 + (size_t)(kb >> 1) * 512 + (nrow & 255) * 2 + (kb & 1)] = (unsigned char)eb; } }
        asm volatile("s_waitcnt lgkmcnt(0)" ::: "memory");
#pragma unroll
        for (int i = 0; i < 16; ++i) v[i] = vn[i];
    }
}
__device__ __forceinline__ void cvt_rows(const Ctx& C, const float* src, bf16_t* dst, size_t n8  ) {
    const size_t gt = (size_t)C.vcu * 512 + C.tid, NT = (size_t)C.G * 512;
    size_t i = gt;
    for (; i + 3 * NT < n8; i += 4 * NT) {
        f32x4 a[4], b[4];
#pragma unroll
        for (int q = 0; q < 4; ++q) { a[q] = *(const f32x4*)(src + (i + q * NT) * 8); b[q] = *(const f32x4*)(src + (i + q * NT) * 8 + 4); }
#pragma unroll
        for (int q = 0; q < 4; ++q) *(u32x4*)(dst + (i + q * NT) * 8) = pack8(a[q], b[q]); }
    for (; i < n8; i += NT) { const f32x4 a = *(const f32x4*)(src + i * 8), b = *(const f32x4*)(src + i * 8 + 4); *(u32x4*)(dst + i * 8) = pack8(a, b); }
}
__device__ __forceinline__ void phase_prologue(const CAS Args& args, const Ctx& C) {
    tr_job(C, J_MLA_WIN, INF(I_MLA_WIN), (size_t)DM * LATD, 2, DM, LATD, 1280, WSP(bf16_t, WS_W_MLA + OFF_MLA_WIN), W_MLA_STRIDE, nullptr, 0, nullptr);
    tr_job(C, J_MLA_WUQ, INF(I_MLA_WUQ), (size_t)QL * 1536, 2, QL, 1536, 1536, WSP(bf16_t, WS_W_MLA + OFF_MLA_WUQ), W_MLA_STRIDE, INF(I_MLA_QN), QL, nullptr);
    tr_job(C, J_NAT, INF(I_MLA_WUKV), (size_t)KVL * 2048, 2, KVL, 2048, 2048, WSP(bf16_t, WS_W_MLA + OFF_MLA_WUKV), W_MLA_STRIDE, INF(I_MLA_KVN), KVL, nullptr);
    tr_job(C, J_NAT, INF(I_MLA_WO), (size_t)DM * DM, 2, DM, DM, DM, WSP(bf16_t, WS_W_MLA + OFF_MLA_WO), W_MLA_STRIDE, nullptr, 0, nullptr);
    tr_job(C, J_NAT, INF(I_LRU_WIN), (size_t)DM * 2048, 2, DM, 2048, 2048, WSP(bf16_t, WS_W_LRU + OFF_LRU_WIN), W_LRU_STRIDE, nullptr, 0, nullptr);
    for (int j = 0; j < 2; ++j)
        tr_job(C, J_LRU_WAX, INF(I_LRU_WA) + (size_t)j * 4 * 65536, (size_t)256 * 256, 4, 256, 256, 512, WSP(bf16_t, WS_W_LRU + OFF_LRU_WAX + (size_t)j * W_LRU_STRIDE), (size_t)512 * 256 * 2, nullptr, 0, INF(I_LRU_WX) + (size_t)j * 4 * 65536);
    tr_job(C, J_NAT, INF(I_LRU_WOUT), (size_t)DM * DM, 2, DM, DM, DM, WSP(bf16_t, WS_W_LRU + OFF_LRU_WOUT), W_LRU_STRIDE, nullptr, 0, nullptr);
    tr_job(C, J_NAT, INF(I_PLE_WP), (size_t)PLED * DM, 4, PLED, DM, DM, WSP(bf16_t, WS_W_PLE + OFF_PLE_WP), W_PLE_STRIDE, nullptr, 0, nullptr);
    __syncthreads();
    tr_job_fp8<J_MOE_UP, 2048, false>(C, INF(I_MOE_WUP), (size_t)DM * 2048, DEPTH * NE, args.ws + WS_W_UP, (size_t)2048 * 1024, args.ws + WS_SW);
    tr_job_fp8<J_NAT, 1024, true>(C, INF(I_MOE_WDN), (size_t)DFF * DM, DEPTH * NE, args.ws + WS_W_DN, (size_t)1024 * 1024, args.ws + WS_SWD);
    tr_job_fp8<J_NAT, 1024, false>(C, INF(I_PLE_WG), (size_t)DM * DM, DEPTH, args.ws + WS_W_PLE + OFF_PLE_WG, W_PLE_STRIDE, args.ws + WS_SWG);
    __syncthreads();
    cvt_rows(C, INF(I_X), WSP(bf16_t, WS_XB), (size_t)T * DM / 8);
    cvt_rows(C, INF(I_P), WSP(bf16_t, WS_PB), (size_t)DEPTH * T * PLED / 8);
    { const int* pos = (const int*)args.in[I_POS]; float* CS = WSP(float, WS_CS); float* SN = WSP(float, WS_SN);
      const size_t gt = (size_t)C.vcu * 512 + C.tid, NT = (size_t)C.G * 512;
      for (size_t i = gt; i < (size_t)T * 32; i += NT) { const int tok = (int)(i >> 5), j = (int)(i & 31);
          const double inv = exp(-9.210340371976184 * (double)j / 32.0); const double ang = (double)pos[tok] * inv; double s, c; sincos(ang, &s, &c); CS[i] = (float)c; SN[i] = (float)s; }
      { const float* wr = INF(I_MOE_WR); const float* lg1 = INF(I_LN1G); bf16_t* WRH = WSP(bf16_t, WS_WRH); bf16_t* WRL = WSP(bf16_t, WS_WRL);
        for (size_t i = gt; i < (size_t)DEPTH * 64 * 64; i += NT) { const int l = (int)(i >> 12), st = (int)(i >> 6) & 63, ln = (int)i & 63; float w[8], lo[8];
#pragma unroll
            for (int j = 0; j < 8; ++j) { const int k = 16 * st + 8 * (ln >> 5) + j; w[j] = lg1[l * DM + k] * wr[((size_t)l * DM + k) * NE + (ln & 31)]; }
            u32x4 h; h.x = cvt_pk_bf16(w[0], w[1]); h.y = cvt_pk_bf16(w[2], w[3]); h.z = cvt_pk_bf16(w[4], w[5]); h.w = cvt_pk_bf16(w[6], w[7]);
            lo[0] = w[0] - bf_lo(h.x); lo[1] = w[1] - bf_hi(h.x); lo[2] = w[2] - bf_lo(h.y); lo[3] = w[3] - bf_hi(h.y); lo[4] = w[4] - bf_lo(h.z); lo[5] = w[5] - bf_hi(h.z); lo[6] = w[6] - bf_lo(h.w); lo[7] = w[7] - bf_hi(h.w);
            u32x4 q; q.x = cvt_pk_bf16(lo[0], lo[1]); q.y = cvt_pk_bf16(lo[2], lo[3]); q.z = cvt_pk_bf16(lo[4], lo[5]); q.w = cvt_pk_bf16(lo[6], lo[7]);
            *(u32x4*)(WRH + i * 8) = h; *(u32x4*)(WRL + i * 8) = q; }
        float* RC = WSP(float, WS_RC); const float* lb1 = INF(I_LN1B); const float* rb = INF(I_MOE_BR);
        for (size_t i = gt; i < (size_t)DEPTH * NE; i += NT) { const int l = (int)(i >> 5), e = (int)i & 31; float c1 = 0.f, c2 = 0.f;
            for (int k = 0; k < DM; ++k) { const float w = wr[((size_t)l * DM + k) * NE + e]; c1 = fmaf(lg1[l * DM + k], w, c1); c2 = fmaf(lb1[l * DM + k], w, c2); }
            RC[l * 64 + e] = c1; RC[l * 64 + 32 + e] = c2 + rb[l * NE + e]; } }
      float* SPL = WSP(float, WS_SPL); const float* lam = INF(I_LRU_LAM);
      for (size_t i = gt; i < 2 * 1024; i += NT) { const double l = (double)lam[i]; SPL[i] = (float)(-8.0 * log1p(exp(-l))); } }
}

__device__ __forceinline__ void moe_table(const CAS Args& args, const Ctx& C0, int layer) {
    Ctx C = C0; C.tid = opaque_tid(); C.lane = C.tid & 63;
    const unsigned* cnt = WSP(unsigned, WS_CTL) + CW_CNT + 64 * layer;
    __syncthreads();
    if (C.tid < 32) C.misc[64 + C.tid] = (int)__hip_atomic_load(cnt + C.tid, __ATOMIC_RELAXED, __HIP_MEMORY_SCOPE_AGENT);
    __syncthreads();
    if (C.tid == 0) { int acc = 0; for (int e = 0; e < 32; ++e) { C.misc[16 + e] = acc; acc += (C.misc[64 + e] + 255) >> 8; } C.misc[16 + 32] = acc; }
    __syncthreads();
    { volatile LAS unsigned char* te = (volatile LAS unsigned char*)(C.lds + TILE_E_OFF);
      for (int mg = C.tid; mg < C.misc[48]; mg += NWAVES * 64) { int e = 0; for (int j = 1; j < 32; ++j) e += (C.misc[16 + j] <= mg) ? 1 : 0; te[mg] = (unsigned char)e; } }
    __syncthreads();
}

__device__ __forceinline__ void phase_ln_router(const CAS Args& args, const Ctx& C0, int layer) {
    const int cslot = layer + args.pad;
    Ctx C = C0; C.tid = opaque_tid(); C.lane = C.tid & 63;
    const bf16_t* Y = WSP(bf16_t, WS_Y); bf16_t* X1B = WSP(bf16_t, WS_X1B);
    const float* g1 = INF(I_LN1G) + layer * DM; const float* b1 = INF(I_LN1B) + layer * DM;
    const bf16_t* WRH = WSP(bf16_t, WS_WRH) + (size_t)layer * 64 * 64 * 8; const bf16_t* WRL = WSP(bf16_t, WS_WRL) + (size_t)layer * 64 * 64 * 8; const float* rc = WSP(float, WS_RC) + layer * 64;
    unsigned* gcnt = WSP(unsigned, WS_CTL) + CW_CNT + 64 * cslot;
    int* lists = WSP(int, WS_LIST); int* slot = WSP(int, WS_SLOT); float* gate = WSP(float, WS_GATE);
    LAS float* part = (LAS float*)C.lds;
    volatile LAS int* lcnt = (volatile LAS int*)(C.lds + 69632);
    volatile LAS int* lbase = lcnt + 32;
    LAS float* stat = (LAS float*)(C.lds + 70144);
    f32x4 gv[4], bv[4];
#pragma unroll
    for (int j = 0; j < 2; ++j) { gv[2 * j] = *(const f32x4*)(g1 + 8 * C.lane + 512 * j); gv[2 * j + 1] = *(const f32x4*)(g1 + 8 * C.lane + 512 * j + 4);
        bv[2 * j] = *(const f32x4*)(b1 + 8 * C.lane + 512 * j); bv[2 * j + 1] = *(const f32x4*)(b1 + 8 * C.lane + 512 * j + 4); }
    unsigned char* X1Q = args.ws + WS_X1Q; int sexp;
    { float ag = 0.f, ab = 0.f;
#pragma unroll
      for (int j = 0; j < 4; ++j)
#pragma unroll
          for (int e = 0; e < 4; ++e) { ag = fmaxf(ag, fabsf(gv[j][e])); ab = fmaxf(ab, fabsf(bv[j][e])); }
#pragma unroll
      for (int o = 1; o < 64; o <<= 1) { ag = fmaxf(ag, __shfl_xor(ag, o)); ab = fmaxf(ab, __shfl_xor(ab, o)); }
      const float bound = 16.0f * ag + ab + 1e-20f;
      sexp = 134 - (int)((__float_as_uint(bound) >> 23) & 0xffu);
      sexp = sexp < -100 ? -100 : (sexp > 100 ? 100 : sexp);
      if (C.tid == 0) __hip_atomic_store(WSP(unsigned, WS_CTL) + CW_SA + layer, (unsigned)sexp, __ATOMIC_RELAXED, __HIP_MEMORY_SCOPE_AGENT); }
    const float qs = __uint_as_float((unsigned)(127 + sexp) << 23), qlo = KF(-448.f), qhi = KF(448.f);
    for (int chunk = C.vcu; chunk < T / 128; chunk += C.G) {
        const int row0 = chunk * 128;
        if (C.tid < 32) lcnt[C.tid] = 0;
        u32x4 yn[2];
#pragma unroll
        for (int j = 0; j < 2; ++j) yn[j] = *(const u32x4*)(Y + ((size_t)row0 + C.wave * 16) * DM + 8 * C.lane + 512 * j);
#pragma unroll 1
        for (int i = 0; i < 16; ++i) { const size_t row = (size_t)row0 + C.wave * 16 + i;
            f32x4 v[4]; float s = 0.f;
#pragma unroll
            for (int j = 0; j < 2; ++j) { const u32x4 w = yn[j]; v[2 * j] = pg8::bf4_lo(w); v[2 * j + 1] = pg8::bf4_hi(w); }
            { const size_t rn = i < 15 ? row + 1 : row;
#pragma unroll
              for (int j = 0; j < 2; ++j) yn[j] = *(const u32x4*)(Y + rn * DM + 8 * C.lane + 512 * j); }
#pragma unroll
            for (int j = 0; j < 4; ++j) s += (v[j][0] + v[j][1]) + (v[j][2] + v[j][3]);
            const float mean = wave_sum(s) * (1.f / DM); float s2 = 0.f;
#pragma unroll
            for (int j = 0; j < 4; ++j) { v[j] = v[j] - mean; s2 += (v[j][0] * v[j][0] + v[j][1] * v[j][1]) + (v[j][2] * v[j][2] + v[j][3] * v[j][3]); }
            const float rstd = 1.f / sqrtf(wave_sum(s2) * (1.f / DM) + KF(LN_EPS));
            if (C.lane == 0) { stat[(C.wave * 16 + i) * 2] = mean; stat[(C.wave * 16 + i) * 2 + 1] = rstd; }
#pragma unroll
            for (int j = 0; j < 4; ++j) v[j] = v[j] * rstd * gv[j] + bv[j];
#pragma unroll
            for (int j = 0; j < 2; ++j) { const u32x4 hw = pack8(v[2 * j], v[2 * j + 1]);
                *(u32x4*)(X1B + row * DM + 8 * C.lane + 512 * j) = hw;
                const f32x4 q0 = v[2 * j] * qs, q1 = v[2 * j + 1] * qs;
                int w0 = __builtin_amdgcn_cvt_pk_fp8_f32(fminf(fmaxf(q0[0], qlo), qhi), fminf(fmaxf(q0[1], qlo), qhi), 0, false); w0 = __builtin_amdgcn_cvt_pk_fp8_f32(fminf(fmaxf(q0[2], qlo), qhi), fminf(fmaxf(q0[3], qlo), qhi), w0, true);
                int w1 = __builtin_amdgcn_cvt_pk_fp8_f32(fminf(fmaxf(q1[0], qlo), qhi), fminf(fmaxf(q1[1], qlo), qhi), 0, false); w1 = __builtin_amdgcn_cvt_pk_fp8_f32(fminf(fmaxf(q1[2], qlo), qhi), fminf(fmaxf(q1[3], qlo), qhi), w1, true);
                *(u32x2*)(X1Q + row * DM + 8 * C.lane + 512 * j) = (u32x2){(unsigned)w0, (unsigned)w1}; } }
        asm volatile("s_waitcnt vmcnt(0)" ::: "memory");
        __syncthreads();
        { const int grp = C.wave >> 1, kh = C.wave & 1, r32 = C.lane & 31, hi = C.lane >> 5;
          const bf16_t* ah = Y + ((size_t)row0 + grp * 32 + r32) * DM + kh * 512 + hi * 8;
          const bf16_t* bh = WRH + ((size_t)kh * 32 * 64 + C.lane) * 8; const bf16_t* bl = WRL + ((size_t)kh * 32 * 64 + C.lane) * 8;
          f32x16 acc = {};
#pragma unroll 4
          for (int st = 0; st < 32; ++st) { const bf16x8 xh = *(const bf16x8*)(ah + st * 16), wh = *(const bf16x8*)(bh + (size_t)st * 512), wl = *(const bf16x8*)(bl + (size_t)st * 512);
              acc = __builtin_amdgcn_mfma_f32_32x32x16_bf16(xh, wh, acc, 0, 0, 0);
              acc = __builtin_amdgcn_mfma_f32_32x32x16_bf16(xh, wl, acc, 0, 0, 0); }
          LAS float* pp = part + (grp * 2 + kh) * 32 * 33 + r32;
#pragma unroll
          for (int r = 0; r < 16; ++r) pp[((r & 3) + 8 * (r >> 2) + 4 * hi) * 33] = acc[r]; }
        __syncthreads();
        int te[4] = {0, 0, 0, 0}, lp[4] = {0, 0, 0, 0}; float tg[4] = {0.f, 0.f, 0.f, 0.f};
        if (C.tid < 128) { const int grp = C.tid >> 5, ln = C.tid & 31; float lg[32];
            const float mean = stat[C.tid * 2], rstd = stat[C.tid * 2 + 1];
#pragma unroll
            for (int e = 0; e < 32; ++e) lg[e] = rstd * ((part[((grp * 2 + 0) * 32 + ln) * 33 + e] + part[((grp * 2 + 1) * 32 + ln) * 33 + e]) - mean * rc[e]) + rc[32 + e];
            float tv[4]; const float kninf = KF(-__builtin_inff());
#pragma unroll
            for (int k = 0; k < 4; ++k) { float best = lg[0]; int bi = 0;
#pragma unroll
                for (int e = 1; e < 32; ++e) { const bool gt = lg[e] > best; best = gt ? lg[e] : best; bi = gt ? e : bi; }
                te[k] = bi; tv[k] = best;
#pragma unroll
                for (int e = 0; e < 32; ++e) lg[e] = (e == bi) ? kninf : lg[e]; }
            float den = 0.f;
#pragma unroll
            for (int k = 0; k < 4; ++k) { tg[k] = __expf(tv[k] - tv[0]); den += tg[k]; }
            const float rden = 1.0f / den;
#pragma unroll
            for (int k = 0; k < 4; ++k) { tg[k] *= rden; lp[k] = __hip_atomic_fetch_add((LAS int*)&lcnt[te[k]], 1, __ATOMIC_RELAXED, __HIP_MEMORY_SCOPE_WORKGROUP); } }
        __syncthreads();
        if (C.tid < 32) lbase[C.tid] = (int)__hip_atomic_fetch_add(gcnt + C.tid, (unsigned)lcnt[C.tid], __ATOMIC_RELAXED, __HIP_MEMORY_SCOPE_AGENT);
        __syncthreads();
        if (C.tid < 128) { const int tok = row0 + C.tid;
#pragma unroll
            for (int k = 0; k < 4; ++k) { const int pos = lbase[te[k]] + lp[k]; lists[(size_t)te[k] * T + pos] = tok; slot[tok * 4 + k] = te[k] * T + pos; gate[tok * 4 + k] = tg[k]; } }
        __syncthreads();
    }
}

__device__ __forceinline__ void phase_combine_ln2(const CAS Args& args, const Ctx& C0, int layer) {
    Ctx C = C0; C.tid = opaque_tid(); C.lane = C.tid & 63;
    moe_table(args, C, layer);
    const bf16_t* X1B = WSP(bf16_t, WS_X1B); const unsigned char* YS = args.ws + WS_YS; const unsigned char* SY = args.ws + WS_SY; const int* slot = WSP(int, WS_SLOT); const float* gate = WSP(float, WS_GATE);
    bf16_t* X2B = WSP(bf16_t, WS_X2B); unsigned char* X2Q = args.ws + WS_X2Q;
    const float* g2 = INF(I_LN2G) + layer * DM; const float* b2 = INF(I_LN2B) + layer * DM;
    f32x4 gv[4], bv[4];
#pragma unroll
    for (int j = 0; j < 2; ++j) { gv[2 * j] = *(const f32x4*)(g2 + 8 * C.lane + 512 * j); gv[2 * j + 1] = *(const f32x4*)(g2 + 8 * C.lane + 512 * j + 4);
        bv[2 * j] = *(const f32x4*)(b2 + 8 * C.lane + 512 * j); bv[2 * j + 1] = *(const f32x4*)(b2 + 8 * C.lane + 512 * j + 4); }
    int sexp;
    { float ag = 0.f, ab = 0.f;
#pragma unroll
      for (int j = 0; j < 4; ++j)
#pragma unroll
          for (int e = 0; e < 4; ++e) { ag = fmaxf(ag, fabsf(gv[j][e])); ab = fmaxf(ab, fabsf(bv[j][e])); }
#pragma unroll
      for (int o = 1; o < 64; o <<= 1) { ag = fmaxf(ag, __shfl_xor(ag, o)); ab = fmaxf(ab, __shfl_xor(ab, o)); }
      const float bound = 16.0f * ag + ab + 1e-20f;
      sexp = 134 - (int)((__float_as_uint(bound) >> 23) & 0xffu); sexp = sexp < -100 ? -100 : (sexp > 100 ? 100 : sexp);
      if (C.tid == 0) __hip_atomic_store(WSP(unsigned, WS_CTL) + CW_SA2 + layer, (unsigned)sexp, __ATOMIC_RELAXED, __HIP_MEMORY_SCOPE_AGENT); }
    const float qs = __uint_as_float((unsigned)(127 + sexp) << 23), qlo = KF(-448.f), qhi = KF(448.f);
    const int gw = C.vcu * NWAVES + C.wave, NGW = C.G * NWAVES;
    for (int row = gw; row < T; row += 2 * NGW) {
        int sv[2][4]; float gt[2][4];
#pragma unroll
        for (int q = 0; q < 2; ++q) { const int r = (row + q * NGW < T) ? row + q * NGW : row;
#pragma unroll
            for (int k = 0; k < 4; ++k) { sv[q][k] = slot[r * 4 + k]; gt[q][k] = gate[r * 4 + k]; } }
        u32x4 xw[2][2]; u32x2 yw[2][4][2]; unsigned eb[2][4][2];
#pragma unroll
        for (int q = 0; q < 2; ++q) { const int r = (row + q * NGW < T) ? row + q * NGW : row;
#pragma unroll
            for (int j = 0; j < 2; ++j) xw[q][j] = *(const u32x4*)(X1B + (size_t)r * DM + 8 * C.lane + 512 * j);
#pragma unroll
            for (int k = 0; k < 4; ++k) { const int e = sv[q][k] >> 15, pos = sv[q][k] & (T - 1); const size_t prow = (size_t)C.misc[16 + e] * 256 + pos;
#pragma unroll
                for (int j = 0; j < 2; ++j) { yw[q][k][j] = *(const u32x2*)(YS + prow * DM + 8 * C.lane + 512 * j); eb[q][k][j] = SY[prow * 32 + (C.lane >> 2) + 16 * j]; } } }
#pragma unroll
        for (int q = 0; q < 2; ++q) { const int r = row + q * NGW; if (r >= T) break;
            f32x4 v[4];
#pragma unroll
            for (int j = 0; j < 2; ++j) { v[2 * j] = pg8::bf4_lo(xw[q][j]) * ALPHA; v[2 * j + 1] = pg8::bf4_hi(xw[q][j]) * ALPHA; }
#pragma unroll
            for (int k = 0; k < 4; ++k)
#pragma unroll
                for (int j = 0; j < 2; ++j) { const u32x2 w = yw[q][k][j]; const float gs = gt[q][k] * __uint_as_float(eb[q][k][j] << 23);
                    const f32x2 a = __builtin_amdgcn_cvt_pk_f32_fp8((int)w.x, false), b = __builtin_amdgcn_cvt_pk_f32_fp8((int)w.x, true), c = __builtin_amdgcn_cvt_pk_f32_fp8((int)w.y, false), d = __builtin_amdgcn_cvt_pk_f32_fp8((int)w.y, true);
                    v[2 * j] += (f32x4){a[0], a[1], b[0], b[1]} * gs; v[2 * j + 1] += (f32x4){c[0], c[1], d[0], d[1]} * gs; }
            float s = 0.f;
#pragma unroll
            for (int j = 0; j < 4; ++j) s += (v[j][0] + v[j][1]) + (v[j][2] + v[j][3]);
            const float mean = wave_sum(s) * (1.f / DM); float s2 = 0.f;
#pragma unroll
            for (int j = 0; j < 4; ++j) { v[j] = v[j] - mean; s2 += (v[j][0] * v[j][0] + v[j][1] * v[j][1]) + (v[j][2] * v[j][2] + v[j][3] * v[j][3]); }
            const float rstd = 1.f / sqrtf(wave_sum(s2) * (1.f / DM) + KF(LN_EPS));
#pragma unroll
            for (int j = 0; j < 4; ++j) v[j] = v[j] * rstd * gv[j] + bv[j];
#pragma unroll
            for (int j = 0; j < 2; ++j) { *(u32x4*)(X2B + (size_t)r * DM + 8 * C.lane + 512 * j) = pack8(v[2 * j], v[2 * j + 1]);
                const f32x4 q0 = v[2 * j] * qs, q1 = v[2 * j + 1] * qs;
                int w0 = __builtin_amdgcn_cvt_pk_fp8_f32(fminf(fmaxf(q0[0], qlo), qhi), fminf(fmaxf(q0[1], qlo), qhi), 0, false); w0 = __builtin_amdgcn_cvt_pk_fp8_f32(fminf(fmaxf(q0[2], qlo), qhi), fminf(fmaxf(q0[3], qlo), qhi), w0, true);
                int w1 = __builtin_amdgcn_cvt_pk_fp8_f32(fminf(fmaxf(q1[0], qlo), qhi), fminf(fmaxf(q1[1], qlo), qhi), 0, false); w1 = __builtin_amdgcn_cvt_pk_fp8_f32(fminf(fmaxf(q1[2], qlo), qhi), fminf(fmaxf(q1[3], qlo), qhi), w1, true);
                *(u32x2*)(X2Q + (size_t)r * DM + 8 * C.lane + 512 * j) = (u32x2){(unsigned)w0, (unsigned)w1}; } }
    }
}

__device__ __forceinline__ void phase_conv(const CAS Args& args, const Ctx& C0, int j) {
    Ctx C = C0; C.tid = opaque_tid(); C.lane = C.tid & 63;
    const bf16_t* U = WSP(bf16_t, WS_U); bf16_t* UC = WSP(bf16_t, WS_UC);
    const float* cw = INF(I_LRU_CW) + (size_t)j * 4 * DM; const float* cb = INF(I_LRU_CB) + (size_t)j * DM;
    const int c8 = (C.tid & 127) * 8, rsub = C.tid >> 7;
    float w[4][8], bb[8];
#pragma unroll
    for (int q = 0; q < 4; ++q)
#pragma unroll
        for (int e = 0; e < 8; ++e) w[q][e] = cw[q * DM + c8 + e];
#pragma unroll
    for (int e = 0; e < 8; ++e) bb[e] = cb[c8 + e];
    for (int chunk = C.vcu; chunk < T / 128; chunk += C.G) {
        const int r0 = chunk * 128 + rsub * 32;
        u32x4 h0, h1, h2;
        const u32x4 z = {0u, 0u, 0u, 0u};
        const int s0 = r0 & (SEQ - 1);
        h0 = s0 >= 3 ? *(const u32x4*)(U + (size_t)(r0 - 3) * DM + c8) : z; h1 = s0 >= 2 ? *(const u32x4*)(U + (size_t)(r0 - 2) * DM + c8) : z; h2 = s0 >= 1 ? *(const u32x4*)(U + (size_t)(r0 - 1) * DM + c8) : z;
#pragma unroll 4
        for (int i = 0; i < 32; ++i) { const u32x4 h3 = *(const u32x4*)(U + (size_t)(r0 + i) * DM + c8);
            float o[8];
#pragma unroll
            for (int q = 0; q < 4; ++q) { const unsigned a = h0[q], b = h1[q], c = h2[q], d = h3[q];
                o[2 * q] = bb[2 * q] + w[0][2 * q] * bf_lo(a) + w[1][2 * q] * bf_lo(b) + w[2][2 * q] * bf_lo(c) + w[3][2 * q] * bf_lo(d);
                o[2 * q + 1] = bb[2 * q + 1] + w[0][2 * q + 1] * bf_hi(a) + w[1][2 * q + 1] * bf_hi(b) + w[2][2 * q + 1] * bf_hi(c) + w[3][2 * q + 1] * bf_hi(d); }
            u32x4 ow; ow.x = cvt_pk_bf16(o[0], o[1]); ow.y = cvt_pk_bf16(o[2], o[3]); ow.z = cvt_pk_bf16(o[4], o[5]); ow.w = cvt_pk_bf16(o[6], o[7]);
            *(u32x4*)(UC + (size_t)(r0 + i) * DM + c8) = ow; h0 = h1; h1 = h2; h2 = h3; }
    }
}
__device__ __forceinline__ void phase_scan1(const CAS Args& args, const Ctx& C0) {
    Ctx C = C0; C.tid = opaque_tid(); C.lane = C.tid & 63;
    const bf16_t* LA = WSP(bf16_t, WS_AA); const bf16_t* BB = WSP(bf16_t, WS_BB); float* CA = WSP(float, WS_CA); float* CH = WSP(float, WS_CH);
    const int c2 = C.tid * 2;
    for (int item = C.vcu; item < NBATCH * 64; item += C.G) {
        const size_t r0 = (size_t)item * 64; float h0 = 0.f, h1 = 0.f, l0 = 0.f, l1 = 0.f;
#pragma unroll 8
        for (int s = 0; s < 64; ++s) { const unsigned aw = *(const unsigned*)(LA + (r0 + s) * DM + c2), bw = *(const unsigned*)(BB + (r0 + s) * DM + c2);
            const float la0 = bf_lo(aw), la1 = bf_hi(aw);
            h0 = __builtin_amdgcn_exp2f(la0) * h0 + bf_lo(bw); h1 = __builtin_amdgcn_exp2f(la1) * h1 + bf_hi(bw); l0 += la0; l1 += la1; }
        *(f32x2*)(CA + (size_t)item * DM + c2) = (f32x2){__builtin_amdgcn_exp2f(l0), __builtin_amdgcn_exp2f(l1)}; *(f32x2*)(CH + (size_t)item * DM + c2) = (f32x2){h0, h1};
    }
}
__device__ __forceinline__ void phase_scan2(const CAS Args& args, const Ctx& C0) {
    Ctx C = C0; C.tid = opaque_tid(); C.lane = C.tid & 63;
    const bf16_t* LA = WSP(bf16_t, WS_AA); const bf16_t* BB = WSP(bf16_t, WS_BB); const float* CA = WSP(float, WS_CA); const float* CH = WSP(float, WS_CH);
    const bf16_t* GG = WSP(bf16_t, WS_GG); bf16_t* YL = WSP(bf16_t, WS_O);
    const int c2 = C.tid * 2;
    for (int item = C.vcu; item < NBATCH * 64; item += C.G) {
        const int b = item >> 6, ch = item & 63; float h0 = 0.f, h1 = 0.f;
#pragma unroll 8
        for (int jx = 0; jx < ch; ++jx) { const f32x2 a = *(const f32x2*)(CA + (size_t)(b * 64 + jx) * DM + c2), e = *(const f32x2*)(CH + (size_t)(b * 64 + jx) * DM + c2);
            h0 = a[0] * h0 + e[0]; h1 = a[1] * h1 + e[1]; }
        const size_t r0 = (size_t)item * 64;
#pragma unroll 8
        for (int s = 0; s < 64; ++s) { const unsigned aw = *(const unsigned*)(LA + (r0 + s) * DM + c2), bw = *(const unsigned*)(BB + (r0 + s) * DM + c2), g = *(const unsigned*)(GG + (r0 + s) * DM + c2);
            h0 = __builtin_amdgcn_exp2f(bf_lo(aw)) * h0 + bf_lo(bw); h1 = __builtin_amdgcn_exp2f(bf_hi(aw)) * h1 + bf_hi(bw);
            *(unsigned*)(YL + (r0 + s) * DM + c2) = cvt_pk_bf16(bf_lo(g) * h0, bf_hi(g) * h1); }
    }
}

#if PROBE_T
typedef int v8i_t __attribute__((ext_vector_type(8)));
__device__ __forceinline__ unsigned fp8_of_int(int v) { const unsigned char t[4] = {0x00, 0x38, 0x40, 0x44}; const int a = v < 0 ? -v : v; return (unsigned)t[a] | (v < 0 ? 0x80u : 0u); }
__device__ __forceinline__ int tA(int i, int k) { return ((i * 3 + k * 5) % 7) - 3; }
__device__ __forceinline__ int tB(int k, int j) { return ((k * 2 + j * 7) % 5) - 2; }
__device__ __forceinline__ void mfma_fp8_selftest(unsigned* flagw) {
    const int l = threadIdx.x & 63, r = l & 15, q = l >> 4;
    v8i_t A, B;
#pragma unroll
    for (int d = 0; d < 8; ++d) { unsigned wa = 0, wb = 0;
#pragma unroll
        for (int b = 0; b < 4; ++b) { const int k = 32 * q + 4 * d + b; wa |= fp8_of_int(tA(r, k)) << (8 * b); wb |= fp8_of_int(tB(k, r)) << (8 * b); }
        A[d] = (int)wa; B[d] = (int)wb; }
    const f32x4 z = {0.f, 0.f, 0.f, 0.f};
    const int U = 0x7f7f7f7f;
    const int saq = (127 + q) * 0x01010101;
    const int sab = (q == 0) ? (int)0x8281807fu : U;
    const f32x4 m2 = __builtin_amdgcn_mfma_scale_f32_16x16x128_f8f6f4(A, B, z, 0, 0, 0, saq, 0, U);
    const f32x4 m5 = __builtin_amdgcn_mfma_scale_f32_16x16x128_f8f6f4(A, B, z, 0, 0, 0, sab, 0, U);
    bool k1 = true, k2 = true, k3 = true, k4 = true;
#pragma unroll
    for (int e = 0; e < 4; ++e) { const int i = 4 * q + e, j = r; float eb = 0.f, e0 = 0.f, ec = 0.f, ed = 0.f;
        for (int kq = 0; kq < 4; ++kq) for (int hh = 0; hh < 2; ++hh) { float sh = 0.f; for (int k = 32 * kq + 16 * hh; k < 32 * kq + 16 * hh + 16; ++k) sh += (float)(tA(i, k) * tB(k, j));
            const int xb = hh == 0 ? (kq >> 1) : 2 + (kq >> 1);
            eb += sh * (float)(1 << xb); e0 += sh; ec += sh * (float)(1 << kq); ed += sh * (float)(1 << xb); }
        k1 = k1 && (m2[e] == eb); k2 = k2 && (m2[e] == e0); k3 = k3 && (m5[e] == ec); k4 = k4 && (m5[e] == ed); }
    const bool b1 = __all(k1), b2 = __all(k2), b3 = __all(k3), b4 = __all(k4);
    if (l == 0) *flagw = (b1 ? 1u : 0u) | (b2 ? 2u : 0u) | (b3 ? 4u : 0u) | (b4 ? 8u : 0u);
}
#endif
constexpr int PH_PER_LAYER = 12, PH_TOTAL = 2 + PH_PER_LAYER * DEPTH;
__global__ void __launch_bounds__(NWAVES * 64, 2) fwd_kernel(Args args_kernarg) {
    (void)args_kernarg;
    ArgsP const argp = (ArgsP)__builtin_amdgcn_kernarg_segment_ptr();
    const CAS Args& args0 = *argp;
    extern __shared__ __attribute__((aligned(16))) unsigned char lds_raw[];
    Ctx C_;
    C_.lds = (LAS unsigned char*)lds_raw; C_.misc = (volatile LAS int*)(C_.lds + MISC_OFF);
    C_.tid = threadIdx.x; C_.lane = C_.tid & 63; C_.wave = __builtin_amdgcn_readfirstlane(C_.tid >> 6);
    C_.bid = (int)blockIdx.x; C_.G = gridDim.x; { const int bx = blockIdx.x; C_.vcu = (C_.G % 8 == 0) ? (bx % 8) * (C_.G / 8) + bx / 8 : bx; }
    for (int u = C_.tid; u < 128; u += NWAVES * 64) C_.misc[u] = 0;
    __syncthreads();
    XcdBarrier bar = xcd_barrier_post((unsigned*)(args0.ws + WS_CTL) + CW_BAR + args0.li * XCD_BAR_WORDS, (volatile LAS unsigned*)C_.misc);
    const int lo = args0.ph_lo, hi = args0.ph_hi;
#define IN(k) (lo <= (k) && (k) < hi)
#define PH_END(k) do { if ((k) + 1 < hi) xcd_barrier(bar); } while (0)

    if (SEL(0) && IN(0)) { const CAS Args& args = fresh_args(argp); const Ctx C = fresh_ctx(C_); const int cid = C.bid; phase_prologue(args, C); PH_END(0); }
    if (SEL(1) && IN(1)) { const CAS Args& args = fresh_args(argp); const Ctx C = fresh_ctx(C_); const int cid = C.bid;
        pg8::DenseSched S; S.init(WSP(bf16_t, WS_PB), WSP(bf16_t, WS_W_PLE + OFF_PLE_WP), PLED, PLED, DEPTH * T, DM, C.G, cid); S.bpm_shift = 7; S.bbatch = W_PLE_STRIDE;
        pg8::EpiPP E{WSP(bf16_t, WS_PP)};
        pg8::gemm_phase<pg8::EpiPP, pg8::DenseSched, false>(C.lds, PLED / 64, PLED * 2, PLED * 2, S, E);
        if (MK_ONE_LAUNCH == 0) PH_END(1);
    }
    for (int layer = 0; layer < DEPTH; ++layer) {
        const int base = 2 + PH_PER_LAYER * layer, j = layer >> 1;
        if ((layer & 1) == 0) {
            if (SEL(2) && IN(base + 0)) { const CAS Args& args = fresh_args(argp); const Ctx C = fresh_ctx(C_); const int cid = C.bid; const unsigned char* wm = args.ws + WS_W_MLA + (size_t)j * W_MLA_STRIDE;
                pg8::DenseSched S; S.init(WSP(bf16_t, WS_XB), wm + OFF_MLA_WIN, DM, DM, T, 1280, C.G, cid);
                pg8::EpiLat E{WSP(bf16_t, WS_LAT), WSP(float, WS_SSQ), WSP(bf16_t, WS_KR), WSP(float, WS_CS), WSP(float, WS_SN)};
                pg8::gemm_phase<pg8::EpiLat, pg8::DenseSched, false>(C.lds, DM / 64, DM * 2, DM * 2, S, E);
                PH_END(base + 0);
            }
            if (SEL(3) && IN(base + 1)) { const CAS Args& args = fresh_args(argp); const Ctx C = fresh_ctx(C_); const int cid = C.bid; const unsigned char* wm = args.ws + WS_W_MLA + (size_t)j * W_MLA_STRIDE;
                { pg8::DenseSched S; S.init(WSP(bf16_t, WS_LAT), wm + OFF_MLA_WUQ, DM, QL, T, 1536, C.G, cid);
                  pg8::EpiQ E{WSP(bf16_t, WS_Q), WSP(float, WS_SSQ), WSP(float, WS_CS), WSP(float, WS_SN)};
                  pg8::gemm_phase<pg8::EpiQ, pg8::DenseSched, false>(C.lds, QL / 64, DM * 2, QL * 2, S, E); }
                { pg8::DenseSched S; S.init(WSP(bf16_t, WS_LAT) + QL, wm + OFF_MLA_WUKV, DM, KVL, T, 2048, C.G, cid);
                  pg8::EpiKV E{WSP(bf16_t, WS_KN), WSP(bf16_t, WS_V), WSP(float, WS_SSQ)};
                  pg8::gemm_phase<pg8::EpiKV, pg8::DenseSched, false>(C.lds, KVL / 64, DM * 2, KVL * 2, S, E); }
                PH_END(base + 1);
            }
            if (SEL(4) && IN(base + 2)) { const CAS Args& args = fresh_args(argp); const Ctx C = fresh_ctx(C_); const int cid = C.bid;
                for (int it = C.vcu; it < NBATCH * NH * 8; it += C.G) { const int bh = it >> 3, pr = it & 7;
                    att::attn_block(bh >> 3, bh & 7, pr, WSP(bf16_t, WS_Q), WSP(bf16_t, WS_KN), WSP(bf16_t, WS_KR), WSP(bf16_t, WS_V), WSP(bf16_t, WS_O), (LAS char*)C.lds, PROBE_T ? (unsigned long long*)(args.ws + WS_CTL + 8192) : nullptr);
                    att::attn_block(bh >> 3, bh & 7, 15 - pr, WSP(bf16_t, WS_Q), WSP(bf16_t, WS_KN), WSP(bf16_t, WS_KR), WSP(bf16_t, WS_V), WSP(bf16_t, WS_O), (LAS char*)C.lds, PROBE_T ? (unsigned long long*)(args.ws + WS_CTL + 8192) : nullptr); }
                PH_END(base + 2);
            }
        } else {
            if (SEL(5) && IN(base + 0)) { const CAS Args& args = fresh_args(argp); const Ctx C = fresh_ctx(C_); const int cid = C.bid; const unsigned char* wl = args.ws + WS_W_LRU + (size_t)j * W_LRU_STRIDE;
                pg8::DenseSched S; S.init(WSP(bf16_t, WS_XB), wl + OFF_LRU_WIN, DM, DM, T, 2048, C.G, cid);
                pg8::EpiGU E{WSP(bf16_t, WS_GG), WSP(bf16_t, WS_U)};
                pg8::gemm_phase<pg8::EpiGU, pg8::DenseSched, false>(C.lds, DM / 64, DM * 2, DM * 2, S, E);
                PH_END(base + 0);
            }
            if (SEL(6) && IN(base + 1)) { const CAS Args& args = fresh_args(argp); const Ctx C = fresh_ctx(C_); const int cid = C.bid; phase_conv(args, C, j); PH_END(base + 1); }
            if (SEL(7) && IN(base + 2)) { const CAS Args& args = fresh_args(argp); const Ctx C = fresh_ctx(C_); const int cid = C.bid; const unsigned char* wl = args.ws + WS_W_LRU + (size_t)j * W_LRU_STRIDE;
                pg8::DenseSched S; S.init(WSP(bf16_t, WS_UC), wl + OFF_LRU_WAX, DM, 256, T, 2048, C.G, cid); S.apn_shift = 1; S.akbytes = 512;
                pg8::EpiAB E{WSP(bf16_t, WS_AA), WSP(bf16_t, WS_BB), WSP(bf16_t, WS_UC), INF(I_LRU_BA) + j * DM, INF(I_LRU_BX) + j * DM, WSP(float, WS_SPL) + j * DM};
                pg8::gemm_phase<pg8::EpiAB, pg8::DenseSched, false>(C.lds, 4, DM * 2, 512, S, E);
                PH_END(base + 2);
            }
            if (SEL(8) && IN(base + 3)) { const CAS Args& args = fresh_args(argp); const Ctx C = fresh_ctx(C_); const int cid = C.bid; phase_scan1(args, C); PH_END(base + 3); }
            if (SEL(9) && IN(base + 4)) { const CAS Args& args = fresh_args(argp); const Ctx C = fresh_ctx(C_); const int cid = C.bid; phase_scan2(args, C); PH_END(base + 4); }
        }
        if (SEL(10) && IN(base + 5)) { const CAS Args& args = fresh_args(argp); const Ctx C = fresh_ctx(C_); const int cid = C.bid;
            const unsigned char* wo = (layer & 1) ? args.ws + WS_W_LRU + (size_t)j * W_LRU_STRIDE + OFF_LRU_WOUT : args.ws + WS_W_MLA + (size_t)j * W_MLA_STRIDE + OFF_MLA_WO;
            pg8::DenseSched S; S.init(WSP(bf16_t, WS_O), wo, DM, DM, T, DM, C.G, cid);
            pg8::EpiRes E{WSP(bf16_t, WS_XB), WSP(bf16_t, WS_Y)};
            pg8::gemm_phase<pg8::EpiRes, pg8::DenseSched, false>(C.lds, DM / 64, DM * 2, DM * 2, S, E);
            PH_END(base + 5);
        }
        if (SEL(11) && IN(base + 6)) { const CAS Args& args = fresh_args(argp); const Ctx C = fresh_ctx(C_); const int cid = C.bid; phase_ln_router(args, C, layer); PH_END(base + 6); }
        if (SEL(12) && IN(base + 7)) { const CAS Args& args = fresh_args(argp); const Ctx C = fresh_ctx(C_); const int cid = C.bid;
            moe_table(args, C, layer);
            pg8::MoeSched S{(const char*)(args.ws + WS_X1Q), (const char*)(args.ws + WS_W_UP + (size_t)layer * NE * 2048 * 1024), (size_t)2048 * 1024, (const char*)(args.ws + WS_SW + (size_t)layer * NE * 65536), DM, DM, 8, WSP(int, WS_LIST), C.misc + 16, (volatile LAS const unsigned char*)(C.lds + TILE_E_OFF), C.G, cid, true, nullptr};
            const int sae = 127 - (int)__hip_atomic_load(WSP(unsigned, WS_CTL) + CW_SA + layer, __ATOMIC_RELAXED, __HIP_MEMORY_SCOPE_AGENT);
            pg8::EpiUp E{args.ws + WS_H, args.ws + WS_SH, INF(I_MOE_BUP) + (size_t)layer * NE * 2048};
            pg8::gemm_phase<pg8::EpiUp, pg8::MoeSched, true, 1>(C.lds, DM / 128, DM, DM, S, E, PROBE_T ? (unsigned long long*)(args.ws + WS_CTL + 8192) : nullptr, sae * 0x01010101);
            PH_END(base + 7);
        }
        if (SEL(13) && IN(base + 8)) { const CAS Args& args = fresh_args(argp); const Ctx C = fresh_ctx(C_); const int cid = C.bid;
            moe_table(args, C, layer);
            pg8::MoeSched S{(const char*)(args.ws + WS_H), (const char*)(args.ws + WS_W_DN + (size_t)layer * NE * 1024 * 1024), (size_t)1024 * 1024, (const char*)(args.ws + WS_SWD + (size_t)layer * NE * 16384), DFF, DFF, 4, WSP(int, WS_LIST), C.misc + 16, (volatile LAS const unsigned char*)(C.lds + TILE_E_OFF), C.G, cid, false, (const char*)(args.ws + WS_SH)};
            pg8::EpiDown E{args.ws + WS_YS, args.ws + WS_SY, INF(I_MOE_BDN) + (size_t)layer * NE * DM};
            pg8::gemm_phase<pg8::EpiDown, pg8::MoeSched, false, 2>(C.lds, DFF / 128, DFF, DFF, S, E);
            PH_END(base + 8);
        }
        if (SEL(14) && IN(base + 9)) { const CAS Args& args = fresh_args(argp); const Ctx C = fresh_ctx(C_); const int cid = C.bid; phase_combine_ln2(args, C, layer); PH_END(base + 9); }
        if (SEL(15) && IN(base + 10)) { const CAS Args& args = fresh_args(argp); const Ctx C = fresh_ctx(C_); const int cid = C.bid;
            pg8::DenseSched S; S.init(args.ws + WS_X2Q, args.ws + WS_W_PLE + (size_t)layer * W_PLE_STRIDE + OFF_PLE_WG, DM / 2, DM / 2, T, DM, C.G, cid); S.SW = (const char*)(args.ws + WS_SWG + (size_t)layer * 65536);
            const int sae = 127 - (int)__hip_atomic_load(WSP(unsigned, WS_CTL) + CW_SA2 + layer, __ATOMIC_RELAXED, __HIP_MEMORY_SCOPE_AGENT);
            pg8::EpiPle E{WSP(bf16_t, WS_X2B), WSP(bf16_t, WS_PP) + (size_t)layer * T * DM, layer == DEPTH - 1 ? args.out : (float*)nullptr, WSP(bf16_t, WS_XB)};
            pg8::gemm_phase<pg8::EpiPle, pg8::DenseSched, false, 1>(C.lds, DM / 128, DM, DM, S, E, nullptr, sae * 0x01010101);
            if (layer + 1 < DEPTH) PH_END(base + 10);
        }
    }
#if PROBE_T
    if (PROBE_T == 20 && blockIdx.x == 0 && threadIdx.x < 64) { const CAS Args& args = fresh_args(argp); mfma_fp8_selftest((unsigned*)(args.ws + WS_CTL + 8192 + 256)); }
    { xcd_barrier(bar); const CAS Args& args = fresh_args(argp);
      const unsigned long long* pw = (const unsigned long long*)(args.ws + WS_CTL + 8192);
      const double pk = (double)__hip_atomic_load(pw + 0, __ATOMIC_RELAXED, __HIP_MEMORY_SCOPE_AGENT), pe = (double)__hip_atomic_load(pw + 1, __ATOMIC_RELAXED, __HIP_MEMORY_SCOPE_AGENT),
                   pn = (double)__hip_atomic_load(pw + 2, __ATOMIC_RELAXED, __HIP_MEMORY_SCOPE_AGENT), pt = (double)__hip_atomic_load(pw + 3, __ATOMIC_RELAXED, __HIP_MEMORY_SCOPE_AGENT);
      float c = 100.f;
      if (PROBE_T == 2) c = (float)(pk / (pn * 16.0) / 10.0);
      if (PROBE_T == 3) c = (float)(pe / pn / 100.0);
      if (PROBE_T == 4) c = (float)((pt - pk - pe) / pn / 100.0);
      if (PROBE_T == 5) c = (float)(pn);
      if (PROBE_T >= 10) { double q[7]; for (int i = 0; i < 7; ++i) q[i] = (double)__hip_atomic_load(pw + 8 + i, __ATOMIC_RELAXED, __HIP_MEMORY_SCOPE_AGENT);
          if (PROBE_T == 10) c = (float)(q[6] / q[5] / 10.0);
          if (PROBE_T == 11) c = (float)(q[0] / q[5] / 10.0);
          if (PROBE_T == 12) c = (float)(q[1] / q[5] / 10.0);
          if (PROBE_T == 13) c = (float)(q[2] / q[5] / 10.0);
          if (PROBE_T == 14) c = (float)(q[3] / q[5] / 10.0);
          if (PROBE_T == 15) c = (float)(q[4] / q[5] / 10.0); }
      if (PROBE_T >= 2 && PROBE_T < 20) c = exp2f(floorf(log2f(c) * 8.0f + PROBE_SHIFT) * 0.125f);
      if (PROBE_T == 20) { const unsigned fl = __hip_atomic_load((const unsigned*)(args.ws + WS_CTL + 8192 + 256), __ATOMIC_RELAXED, __HIP_MEMORY_SCOPE_AGENT); c = 100.f + 10.f * (float)fl; }
      for (size_t i = (size_t)blockIdx.x * 512 + threadIdx.x; i < (size_t)T * DM; i += (size_t)gridDim.x * 512) args.out[i] = c; }
#endif
#undef IN
#undef PH_END
}

extern "C" void kernel_launch(void* const* d_in, const int* in_sizes, int n_in, void* d_out, int out_size, void* d_ws, size_t ws_size, hipStream_t stream) {
    static int grid = 0;
    if (grid == 0) {
        if (n_in != 30 || in_sizes[0] != T * DM || out_size != T * DM || ws_size < WS_END) { fprintf(stderr, "kernel_launch: unexpected shapes (n_in %d, in0 %d, out %d, ws %zu)\n", n_in, n_in > 0 ? in_sizes[0] : -1, out_size, ws_size); grid = -1; return; }
        int dev = 0, cus = 0, per_cu = 0;
        if (hipGetDevice(&dev) != hipSuccess || hipDeviceGetAttribute(&cus, hipDeviceAttributeMultiprocessorCount, dev) != hipSuccess) { grid = -1; return; }
        if (hipFuncSetAttribute((const void*)fwd_kernel, hipFuncAttributeMaxDynamicSharedMemorySize, LDS_BYTES) != hipSuccess) { fprintf(stderr, "kernel_launch: hipFuncSetAttribute failed\n"); grid = -1; return; }
        if (hipOccupancyMaxActiveBlocksPerMultiprocessor(&per_cu, (const void*)fwd_kernel, NWAVES * 64, LDS_BYTES) != hipSuccess || per_cu < 1) fprintf(stderr, "kernel_launch: occupancy query reports %d\n", per_cu);
        (void)hipGetLastError();
        grid = cus;
    }
    if (grid < 0) return;
    if (hipMemsetAsync((char*)d_ws + WS_CTL, 0, CTL_ZERO_BYTES, stream) != hipSuccess) return;
    Args a{};
    for (int i = 0; i < 30; ++i) a.in[i] = d_in[i];
    a.out = (float*)d_out; a.ws = (unsigned char*)d_ws; a.pad = 0;
#if MK_ONE_LAUNCH
    a.ph_lo = 0; a.ph_hi = PH_TOTAL; a.li = 0;
    hipLaunchKernelGGL(fwd_kernel, dim3(grid), dim3(NWAVES * 64), LDS_BYTES, stream, a);
#else
    int li = 0;
    for (int ph = 0; ph < PH_TOTAL; ++ph) {
        if (ph >= 2) { const int l = (ph - 2) / PH_PER_LAYER, k = (ph - 2) % PH_PER_LAYER; if (k == 11) continue; if ((l & 1) == 0 && (k == 3 || k == 4)) continue; }
        int site = ph;
        if (ph >= 2) { const int l = (ph - 2) / PH_PER_LAYER, k = (ph - 2) % PH_PER_LAYER; static const int mla[11] = {2, 3, 4, -1, -1, 10, 11, 12, 13, 14, 15}, lru[11] = {5, 6, 7, 8, 9, 10, 11, 12, 13, 14, 15}; site = (l & 1) ? lru[k] : mla[k]; }
        a.ph_lo = ph; a.ph_hi = ph + 1;
        if ((HOSTDUP >> site) & 1) { a.li = li++; a.pad = 4; hipLaunchKernelGGL(fwd_kernel, dim3(grid), dim3(NWAVES * 64), LDS_BYTES, stream, a); }
        a.li = li++; a.pad = 0;
        hipLaunchKernelGGL(fwd_kernel, dim3(grid), dim3(NWAVES * 64), LDS_BYTES, stream, a);
    }
#endif
}
```

```cpp
#include <hip/hip_runtime.h>
#include <hip/hip_bf16.h>
#include <cstdio>
#include <cstdint>

#ifndef PHSEL
#define PHSEL -1
#endif
#ifndef PHSKIP
#define PHSKIP -1
#endif
#define SEL(id) ((PHSEL < 0 || PHSEL == (id)) && PHSKIP != (id))
#ifndef PROBE_T
#define PROBE_T 0
#endif
#ifndef PROBE_SHIFT
#define PROBE_SHIFT 0.0f
#endif
#ifndef HOSTDUP
#define HOSTDUP 0
#endif
#ifndef MK_ONE_LAUNCH
#define MK_ONE_LAUNCH 1
#endif

constexpr int T = 32768, SEQ = 4096, NBATCH = 8, DM = 1024, DEPTH = 4;
constexpr int QL = 768, KVL = 256, ROPE = 64, LATD = 1088, NH = 8, DQK = 192, DV = 128;
constexpr int NE = 32, TOPK = 4, DFF = 1024, PLED = 256;
constexpr float ALPHA = 1.681792830507429f;
constexpr float LN_EPS = 1e-5f, RMS_EPS = 1e-6f;
constexpr float QSCALE = 1.4426950408889634f / 13.856406460551018f;
constexpr int NWAVES = 8;

constexpr size_t MiB = 1u << 20;
constexpr size_t WS_CTL = 0, CTL_ZERO_BYTES = 2 * MiB;
constexpr size_t WS_CS = 2 * MiB, WS_SN = 6 * MiB, WS_SPL = 10 * MiB;
constexpr size_t WS_WRH = WS_SPL + 65536, WS_WRL = WS_WRH + 262144;
constexpr size_t WS_RC = WS_SPL + 16384;
constexpr size_t WS_W_MLA = 12 * MiB, W_MLA_STRIDE = 8 * MiB;
constexpr size_t OFF_MLA_WIN = 0, OFF_MLA_WUQ = 2560 * 1024, OFF_MLA_WUKV = OFF_MLA_WUQ + 2304 * 1024, OFF_MLA_WO = OFF_MLA_WUKV + 1024 * 1024;
constexpr size_t WS_W_LRU = 28 * MiB, W_LRU_STRIDE = 8 * MiB;
constexpr size_t OFF_LRU_WIN = 0, OFF_LRU_WAX = 4 * MiB, OFF_LRU_WOUT = 5 * MiB;
constexpr size_t WS_W_PLE = 44 * MiB, W_PLE_STRIDE = 3 * MiB;
constexpr size_t OFF_PLE_WG = 0, OFF_PLE_WP = 2 * MiB;
constexpr size_t WS_W_UP = 56 * MiB;
constexpr size_t WS_W_DN = 568 * MiB;
constexpr size_t WS_XB = 824 * MiB, WS_PB = 888 * MiB, WS_PP = 952 * MiB;
constexpr size_t WS_Y = 1208 * MiB, WS_X1 = 1336 * MiB, WS_X1B = 1464 * MiB, WS_X2 = 1528 * MiB, WS_X2B = 1656 * MiB;
constexpr size_t WS_LAT = 1720 * MiB, WS_KR = 1784 * MiB, WS_SSQ = 1788 * MiB, WS_Q = 1790 * MiB, WS_KN = 1886 * MiB, WS_V = 1950 * MiB, WS_O = 2014 * MiB;
constexpr size_t WS_GG = 2078 * MiB, WS_U = 2142 * MiB, WS_UC = 2206 * MiB, WS_AA = 2270 * MiB, WS_BB = 2398 * MiB, WS_CA = 2526 * MiB, WS_CH = 2528 * MiB;
constexpr size_t WS_H = 2530 * MiB, WS_YS = 2802 * MiB, WS_LIST = 3074 * MiB, WS_SLOT = 3078 * MiB, WS_GATE = 3079 * MiB, WS_SW = 3080 * MiB  , WS_X1Q = 3088 * MiB  , WS_SH = 3120 * MiB  ,
                 WS_SWD = 3128 * MiB  , WS_SY = 3132 * MiB  , WS_X2Q = 3140 * MiB  , WS_SWG = 3172 * MiB  , WS_END = 3174 * MiB;
constexpr int PADROWS = T * TOPK + NE * 256;
static_assert((size_t)PADROWS * DFF * 2 <= 272 * MiB, "H / YS size");
constexpr int CW_SA2 = 136;
constexpr int CW_SA = 128;
constexpr int CW_CNT = 256;
constexpr int CW_BAR = 4096;

constexpr int RING_BYTES = 133120;
constexpr int TILE_E_OFF = 131072;
constexpr int SCL_OFF = RING_BYTES;
constexpr int MISC_OFF = SCL_OFF + 24576;
constexpr int LDS_BYTES = 163840;

#define GAS __attribute__((address_space(1)))
#define LAS __attribute__((address_space(3)))
#define CAS __attribute__((address_space(4)))
typedef unsigned short bf16_t;
typedef short bf16x8 __attribute__((ext_vector_type(8)));
typedef short s16x4 __attribute__((ext_vector_type(4)));
typedef float f32x2 __attribute__((ext_vector_type(2)));
typedef float f32x4 __attribute__((ext_vector_type(4)));
typedef float f32x16 __attribute__((ext_vector_type(16)));
typedef unsigned u32x2 __attribute__((ext_vector_type(2)));
typedef unsigned u32x4 __attribute__((ext_vector_type(4)));

__device__ __forceinline__ unsigned cvt_pk_bf16(float lo, float hi) { unsigned r; asm volatile("v_cvt_pk_bf16_f32 %0, %1, %2" : "=v"(r) : "v"(lo), "v"(hi)); return r; }
__device__ __forceinline__ float bf_lo(unsigned w) { return __uint_as_float(w << 16); }
__device__ __forceinline__ float bf_hi(unsigned w) { return __uint_as_float(w & 0xffff0000u); }
__device__ __forceinline__ float sigmoidf_(float x) { return __builtin_amdgcn_rcpf(1.0f + __expf(-x)); }
__device__ __forceinline__ float gelu_tanh(float x) { const float u = 0.7978845608028654f * (x + 0.044715f * x * x * x); const float t = 1.0f - 2.0f * __builtin_amdgcn_rcpf(1.0f + __expf(2.0f * u)); return 0.5f * x * (1.0f + t); }
__device__ __forceinline__ u32x4 pack8(const f32x4 a, const f32x4 b) { u32x4 w; w.x = cvt_pk_bf16(a[0], a[1]); w.y = cvt_pk_bf16(a[2], a[3]); w.z = cvt_pk_bf16(b[0], b[1]); w.w = cvt_pk_bf16(b[2], b[3]); return w; }
__device__ __forceinline__ float KF(float v) { asm volatile("" : "+s"(v)); return v; }
__device__ __forceinline__ int opaque_tid() { int t = threadIdx.x; asm volatile("" : "+v"(t)); return t; }
__device__ __forceinline__ float wave_sum(float v) {
#pragma unroll
    for (int o = 1; o < 64; o <<= 1) v += __shfl_xor(v, o);
    return v;
}

namespace pg8 {
#define PG8_LAS __attribute__((address_space(3)))
constexpr int BM = 256, BK = 64, HALF = 128, HTB = HALF * BK * 2, STAGE_BYTES = 8 * HTB;
__host__ __device__ __forceinline__ int lds_byte(int r, int c) { const int st = (r >> 4) * 2 + (c >> 5), rr = r & 15, cc = c & 31, ob = rr * 64 + cc * 2; return st * 1024 + (ob ^ (((ob >> 9) & 1) << 5)); }
__host__ __device__ __forceinline__ void stage_rc(int b, int& R, int& C) { const int st = b / 1024, sb = b % 1024, swz = sb ^ (((sb >> 9) & 1) << 5); R = (st >> 1) * 16 + swz / 64; C = (st & 1) * 32 + (swz % 64) / 2; }
__host__ __device__ __forceinline__ int perm32(int rho) { const int n = rho >> 4, i = rho & 15; return 8 * (i >> 2) + 4 * n + (i & 3); }

struct Unit { const char* A; const char* B; const char* S; const char* SA; const int* lst; int nvalid; int pm, pn, aux; };

typedef int v4i_t __attribute__((ext_vector_type(4)));
typedef int v8i_t __attribute__((ext_vector_type(8)));
template <class Epi, class Sched, bool GATHER, int FPM = 0>
__device__ __forceinline__ void gemm_phase(PG8_LAS unsigned char* lds, const int nt  , const int lda  , const int ldb  , const Sched& S, const Epi& E, unsigned long long* pw = nullptr, const int sa = 0x7f7f7f7f) {
    constexpr bool FP8 = FPM != 0;
    const int tid = opaque_tid(), wid = __builtin_amdgcn_readfirstlane(tid >> 6), lane = tid & 63, wr = wid >> 2, wc = wid & 3, fr = lane & 15, fq = lane >> 4;
    unsigned voffB[2], ocA[2][2], onA[2][2];
#pragma unroll
    for (int i = 0; i < 2; ++i) { int R, C; stage_rc(tid * 16 + i * 8192, R, C); const int Rb = Epi::PERM ? ((R & ~31) + perm32(R & 31)) : R;
        voffB[i] = (unsigned)(Rb * ldb + C * 2);
        ocA[0][i] = (unsigned)(R * lda + C * 2); ocA[1][i] = (unsigned)((R + HALF) * lda + C * 2); onA[0][i] = ocA[0][i]; onA[1][i] = ocA[1][i]; }
    constexpr unsigned kstep = BK * 2;
    const unsigned hstepB = (unsigned)HALF * ldb;
    const unsigned ldsw = (unsigned)wid * 1024u;
    const int aoff = lds_byte(wr * 64 + fr, fq * 8), boff = lds_byte(wc * 32 + fr, fq * 8);
#define PG8_SA(b, h) (((b) * 2 + (h)) * HTB)
#define PG8_SB(b, h) ((4 + (b) * 2 + (h)) * HTB)
#define PG8_STAGE(bufoff, gbase, voff, kb) do { _Pragma("unroll") for (int _i = 0; _i < 2; ++_i) \
        __builtin_amdgcn_global_load_lds((const unsigned*)((const char*)(gbase) + (size_t)(unsigned)((voff)[_i] + (unsigned)(kb))), (PG8_LAS unsigned*)(lds + (bufoff) + ldsw + _i * 8192), 16, 0, 0); } while (0)
#define PG8_CAT(x0, x1) __builtin_shufflevector(x0, x1, 0, 1, 2, 3, 4, 5, 6, 7)
#define PG8_LO(x) __builtin_bit_cast(bf16x8, __builtin_shufflevector(x, x, 0, 1, 2, 3))
#define PG8_HI(x) __builtin_bit_cast(bf16x8, __builtin_shufflevector(x, x, 4, 5, 6, 7))
    const PG8_LAS unsigned char* const ldsA = lds + aoff; const PG8_LAS unsigned char* const ldsB = lds + 4 * HTB + boff;
#define PG8_LDA(dst, b, h) do { _Pragma("unroll") for (int m = 0; m < 4; ++m) dst[m] = PG8_CAT(*(const PG8_LAS v4i_t*)(ldsA + (PG8_SA(b, h) + m * 2048)), *(const PG8_LAS v4i_t*)(ldsA + (PG8_SA(b, h) + m * 2048 + 1024))); } while (0)
#define PG8_LDB(dst, b, h) do { _Pragma("unroll") for (int n = 0; n < 2; ++n) dst[n] = PG8_CAT(*(const PG8_LAS v4i_t*)(ldsB + (PG8_SB(b, h) - 4 * HTB + n * 2048)), *(const PG8_LAS v4i_t*)(ldsB + (PG8_SB(b, h) - 4 * HTB + n * 2048 + 1024))); } while (0)
#define PG8_MMA(ai, bj, At, Bt) do { __builtin_amdgcn_s_setprio(1); \
        if constexpr (FP8) { asm volatile("s_nop 4" ::: "memory"); _Pragma("unroll") for (int m = 0; m < 4; ++m) _Pragma("unroll") for (int n = 0; n < 2; ++n) \
            asm volatile("v_mfma_scale_f32_16x16x128_f8f6f4 %0, %1, %2, %0, %3, %4 op_sel_hi:[0,0,0]" : "+v"(acc[ai][bj][m][n]) : "v"(Bt[n]), "v"(At[m]), "v"(sB[bj][n]), "v"(FPM == 2 ? sA[m] : sav)); } \
        else { _Pragma("unroll") for (int m = 0; m < 4; ++m) _Pragma("unroll") for (int n = 0; n < 2; ++n) { \
            acc[ai][bj][m][n] = __builtin_amdgcn_mfma_f32_16x16x32_bf16(PG8_LO(Bt[n]), PG8_LO(At[m]), acc[ai][bj][m][n], 0, 0, 0); \
            acc[ai][bj][m][n] = __builtin_amdgcn_mfma_f32_16x16x32_bf16(PG8_HI(Bt[n]), PG8_HI(At[m]), acc[ai][bj][m][n], 0, 0, 0); } } \
        __builtin_amdgcn_s_setprio(0); } while (0)
    int sB[2][2] = {{0x7f, 0x7f}, {0x7f, 0x7f}}; int sav; asm volatile("v_mov_b32 %0, %1" : "=v"(sav) : "s"(sa));
    int sA[4] = {0x7f, 0x7f, 0x7f, 0x7f};
    const int scol = wc * 32 + (Epi::PERM ? 8 * (fr >> 2) + (fr & 3) : fr);
    const int sbase = FPM == 2 ? SCL_OFF + 16384 + scol * 2 + (fq >> 1) : SCL_OFF + scol * 4 + fq;
    const int sabase = SCL_OFF + ((wr * 64 + fr) << 2) + fq;
#define PG8_LDS_SCL(par_, kt_) do { if constexpr (FP8) { \
        const PG8_LAS unsigned char* sp_ = (const PG8_LAS unsigned char*)lds + sbase + (FPM == 2 ? (par_) * 4096 + (kt_) * 512 : (par_) * 8192 + (kt_) * 1024); \
        _Pragma("unroll") for (int bj_ = 0; bj_ < 2; ++bj_) _Pragma("unroll") for (int n_ = 0; n_ < 2; ++n_) sB[bj_][n_] = (int)sp_[(bj_ * 128 + n_ * (Epi::PERM ? 4 : 16)) * (FPM == 2 ? 2 : 4)]; } } while (0)
#define PG8_LDS_SCA(par_, kt_, ai_) do { if constexpr (FPM == 2) { const PG8_LAS unsigned char* sp_ = (const PG8_LAS unsigned char*)lds + sabase + (par_) * 8192 + (kt_) * 1024 + (ai_) * 512; \
        _Pragma("unroll") for (int m_ = 0; m_ < 4; ++m_) sA[m_] = (int)sp_[m_ * 64]; } } while (0)
#define PG8_DMA_SCL(u_, par_) do { if constexpr (FPM == 1) __builtin_amdgcn_global_load_lds((const unsigned*)((u_).S + wid * 1024 + lane * 16), (PG8_LAS unsigned*)(lds + SCL_OFF + (par_) * 8192 + wid * 1024), 16, 0, 0); \
        if constexpr (FPM == 2) { __builtin_amdgcn_global_load_lds((const unsigned*)((u_).SA + wid * 1024 + lane * 16), (PG8_LAS unsigned*)(lds + SCL_OFF + (par_) * 8192 + wid * 1024), 16, 0, 0); \
            if (wid < 4) __builtin_amdgcn_global_load_lds((const unsigned*)((u_).S + wid * 1024 + lane * 16), (PG8_LAS unsigned*)(lds + SCL_OFF + 16384 + (par_) * 4096 + wid * 1024), 16, 0, 0); } } while (0)
#define PG8_WAIT_V(n) asm volatile("s_waitcnt vmcnt(" #n ")" ::: "memory")
#define PG8_WAIT_L(n) asm volatile("s_waitcnt lgkmcnt(" #n ")" ::: "memory")
#define PG8_BAR __builtin_amdgcn_s_barrier()
#define PG8_SCHED __builtin_amdgcn_sched_barrier(0)
#define PG8_GOFFS(u, o) do { _Pragma("unroll") for (int _h = 0; _h < 2; ++_h) _Pragma("unroll") for (int _i = 0; _i < 2; ++_i) { int gR_, gC_; stage_rc(tid * 16 + _i * 8192, gR_, gC_); int _r = _h * HALF + gR_; _r = _r < (u).nvalid ? _r : (u).nvalid - 1; \
        const int _tok = (u).lst[_r]; (o)[_h][_i] = (unsigned)_tok * (unsigned)lda + (unsigned)(gC_ * 2); } } while (0)
#define PG8_GRAW(u, tk) do {   _Pragma("unroll") for (int _h = 0; _h < 2; ++_h) _Pragma("unroll") for (int _i = 0; _i < 2; ++_i) { int gR_, gC_; stage_rc(tid * 16 + _i * 8192, gR_, gC_); int _r = _h * HALF + gR_; _r = _r < (u).nvalid ? _r : (u).nvalid - 1; (tk)[_h][_i] = (unsigned)(u).lst[_r]; } } while (0)
    Unit cur, nxt, nn; int ui = 0;
#if PROBE_T
    unsigned long long pk_ = 0, pe_ = 0, pt0_ = 0, pn_ = 0; const unsigned long long pst_ = __builtin_amdgcn_s_memtime();
#endif
    if (!S.next(0, cur)) return;
    f32x4 acc[2][2][4][2];
#pragma unroll
    for (int a = 0; a < 2; ++a)
#pragma unroll
        for (int b = 0; b < 2; ++b)
#pragma unroll
            for (int m = 0; m < 4; ++m)
#pragma unroll
                for (int n = 0; n < 2; ++n) acc[a][b][m][n] = (f32x4){0.f, 0.f, 0.f, 0.f};
    v8i_t At[4], B0[2], B1[2];
    const char* cA = cur.A; const char* cB = cur.B;
    bool has_next = S.next(1, nxt);
    if constexpr (GATHER) { PG8_GOFFS(cur, ocA);
        if (has_next) { PG8_GOFFS(nxt, onA); }
        else {
#pragma unroll
            for (int h = 0; h < 2; ++h)
#pragma unroll
                for (int i = 0; i < 2; ++i) onA[h][i] = ocA[h][i]; } }
    PG8_DMA_SCL(cur, 0); if (has_next) PG8_DMA_SCL(nxt, 1);
    PG8_STAGE(PG8_SB(0, 0), cB, voffB, 0u); PG8_STAGE(PG8_SB(0, 1), cB, voffB, hstepB); PG8_STAGE(PG8_SA(0, 0), cA, ocA[0], 0u); PG8_STAGE(PG8_SA(0, 1), cA, ocA[1], 0u);
    if (wr == 1) PG8_BAR;
    PG8_WAIT_V(2); PG8_BAR;
    PG8_STAGE(PG8_SB(1, 0), cB, voffB, kstep); PG8_STAGE(PG8_SA(1, 0), cA, ocA[0], kstep); PG8_STAGE(PG8_SB(1, 1), cB, voffB, hstepB + kstep);
    PG8_WAIT_V(6); PG8_BAR;
    for (;;) {
        const char* nA = has_next ? nxt.A : cA; const char* nB = has_next ? nxt.B : cB;
#if PROBE_T
        pt0_ = __builtin_amdgcn_s_memtime();
#endif
#pragma unroll 1
        for (int t = 0; t < nt; t += 2) {
            const bool last = (t == nt - 2);
            const unsigned k1 = (unsigned)(t + 1) * kstep, k2 = last ? 0u : (unsigned)(t + 2) * kstep, k3 = k2 + kstep;
            const char* a2 = last ? nA : cA; const char* b2 = last ? nB : cB;
#define PG8_STAGE_A2(bufoff, h_, kb_) do { if (GATHER && last) PG8_STAGE(bufoff, a2, onA[h_], kb_); else PG8_STAGE(bufoff, a2, ocA[h_], kb_); } while (0)
            PG8_LDB(B0, 0, 0); PG8_LDB(B1, 0, 1); PG8_LDS_SCL(ui & 1, t); PG8_SCHED; PG8_LDA(At, 0, 0); PG8_LDS_SCA(ui & 1, t, 0); PG8_STAGE(PG8_SA(1, 1), cA, ocA[1], k1);
            PG8_WAIT_V(8); PG8_WAIT_L(0); PG8_BAR; PG8_MMA(0, 0, At, B0); PG8_MMA(0, 1, At, B1); PG8_BAR; PG8_SCHED;
            PG8_LDA(At, 0, 1); PG8_LDS_SCA(ui & 1, t, 1); PG8_STAGE(PG8_SB(0, 0), b2, voffB, k2); PG8_STAGE(PG8_SB(0, 1), b2, voffB, hstepB + k2); PG8_STAGE_A2(PG8_SA(0, 0), 0, k2);
            PG8_WAIT_V(8); PG8_WAIT_L(0); PG8_BAR; PG8_MMA(1, 0, At, B0); PG8_MMA(1, 1, At, B1); PG8_BAR; PG8_SCHED;
            PG8_LDB(B0, 1, 0); PG8_LDB(B1, 1, 1); PG8_LDS_SCL(ui & 1, t + 1); PG8_SCHED; PG8_LDA(At, 1, 0); PG8_LDS_SCA(ui & 1, t + 1, 0); PG8_STAGE_A2(PG8_SA(0, 1), 1, k2);
            PG8_WAIT_V(8); PG8_WAIT_L(0); PG8_BAR; PG8_MMA(0, 0, At, B0); PG8_MMA(0, 1, At, B1); PG8_BAR; PG8_SCHED;
            PG8_LDA(At, 1, 1); PG8_LDS_SCA(ui & 1, t + 1, 1); PG8_STAGE(PG8_SB(1, 0), b2, voffB, k3); PG8_STAGE(PG8_SB(1, 1), b2, voffB, hstepB + k3); PG8_STAGE_A2(PG8_SA(1, 0), 0, k3);
            PG8_WAIT_V(8); PG8_WAIT_L(0); PG8_BAR; PG8_MMA(1, 0, At, B0); PG8_MMA(1, 1, At, B1); PG8_BAR; PG8_SCHED;
        }
#if PROBE_T
        const unsigned long long pt1_ = __builtin_amdgcn_s_memtime(); pk_ += pt1_ - pt0_;
#endif
        if constexpr (FP8) asm volatile("s_nop 15\n\ts_nop 7" ::: "memory");
        const bool has_nn = has_next && S.next(ui + 2, nn);
        if constexpr (GATHER) {
#pragma unroll
            for (int h = 0; h < 2; ++h)
#pragma unroll
                for (int i = 0; i < 2; ++i) ocA[h][i] = onA[h][i];
            if (has_nn) { PG8_GRAW(nn, onA); } }
        if (wr == 0) PG8_BAR;
        E(acc, cur, wr, wc, fr, fq);
#if PROBE_T
        asm volatile("s_waitcnt vmcnt(0)" ::: "memory"); pe_ += __builtin_amdgcn_s_memtime() - pt1_; ++pn_;
#endif
        if (!has_next) break;
#pragma unroll
        for (int a = 0; a < 2; ++a)
#pragma unroll
            for (int b = 0; b < 2; ++b)
#pragma unroll
                for (int m = 0; m < 4; ++m)
#pragma unroll
                    for (int n = 0; n < 2; ++n) acc[a][b][m][n] = (f32x4){0.f, 0.f, 0.f, 0.f};
        cur = nxt; cA = nA; cB = nB; ++ui;
        if constexpr (GATHER) { if (has_nn) {
#pragma unroll
            for (int h = 0; h < 2; ++h)
#pragma unroll
                for (int i = 0; i < 2; ++i) { int gR_, gC_; stage_rc(tid * 16 + i * 8192, gR_, gC_); onA[h][i] = onA[h][i] * (unsigned)lda + (unsigned)(gC_ * 2); } } }
        if (has_nn) { nxt = nn; PG8_DMA_SCL(nxt, (ui + 1) & 1); }
        has_next = has_nn;
        if (wr == 1) PG8_BAR;
    }
    PG8_WAIT_V(0);
    PG8_BAR;
#if PROBE_T
    if (pw && blockIdx.x == 0 && tid == 0) { pw[0] += pk_; pw[1] += pe_; pw[2] += pn_; pw[3] += __builtin_amdgcn_s_memtime() - pst_; }
#endif
#undef PG8_SA
#undef PG8_SB
#undef PG8_STAGE
#undef PG8_LDA
#undef PG8_LDB
#undef PG8_MMA
#undef PG8_WAIT_V
#undef PG8_WAIT_L
#undef PG8_BAR
#undef PG8_SCHED
#undef PG8_GOFFS
#undef PG8_GRAW
#undef PG8_STAGE_A2
#undef PG8_CAT
#undef PG8_LO
#undef PG8_HI
#undef PG8_LDS_SCL
#undef PG8_LDS_SCA
#undef PG8_DMA_SCL
}

constexpr int NXCD = 8, WGM = 8;
template <int NM, int NN>
struct DenseSched {
    static_assert(NM % WGM == 0, "row tiles in groups of 8");
    const char* A; const char* B; int lda, ldb; int G, c; int apn_shift, akbytes, bpm_shift; size_t bbatch; const char* SW;
    __device__ __forceinline__ void init(const void* A_, const void* B_, int lda_, int ldb_, int G_, int c_) {
        A = (const char*)A_; B = (const char*)B_; lda = lda_; ldb = ldb_; G = G_; c = c_; apn_shift = -1; akbytes = 0; bpm_shift = -1; bbatch = 0; SW = nullptr; }
    __device__ __forceinline__ bool next(int i, Unit& u) const {
        constexpr int nwg = NM * NN, q = nwg / NXCD, r = nwg % NXCD, nig = WGM * NN;
        const int L = i * G + c; if (L >= nwg) return false;
        int wgid = L; { const int xcd = wgid % NXCD, off = wgid / NXCD; wgid = (xcd < r ? xcd * (q + 1) : r * (q + 1) + (xcd - r) * q) + off; }
        const int gid = wgid / nig, rem = wgid - gid * nig;
        const int pm = gid * WGM + (rem & (WGM - 1)), pn = rem / WGM;
        u.pm = pm; u.pn = pn; u.aux = 0; u.lst = nullptr; u.nvalid = 256; u.S = SW ? SW + (size_t)pn * 8192 : nullptr; u.SA = nullptr;
        u.A = A + (size_t)pm * 256 * lda * 2 + (apn_shift >= 0 ? (size_t)(pn >> apn_shift) * akbytes : (size_t)0);
        u.B = B + (size_t)pn * 256 * ldb * 2 + (bpm_shift >= 0 ? (size_t)(pm >> bpm_shift) * bbatch : (size_t)0);
        return true;
    }
};
struct MoeSched {
    const char* A; const char* B; size_t bexp; const char* SW; int lda, ldb  , nN; const int* lists; volatile LAS const int* tab; volatile LAS const unsigned char* te; int G, c; bool gather; const char* SA;
    __device__ __forceinline__ bool next(int i, Unit& u) const {
        int pn, mg;
        if (G == 256) {
            const int x = c & 7, jj = c >> 3, pgs = nN >> 2, mgs = 8 / pgs;
            mg = i * (8 * mgs) + 8 * (x / pgs) + (jj & 7); pn = 4 * (x % pgs) + (jj >> 3);
            if (mg >= __builtin_amdgcn_readfirstlane(tab[32])) return false;
        } else { const int total = __builtin_amdgcn_readfirstlane(tab[32]) * nN; const long L = (long)i * G + c; if (L >= total) return false; pn = (int)(L % nN); mg = (int)(L / nN); }
        const int e = __builtin_amdgcn_readfirstlane((int)te[mg]), mt = mg - __builtin_amdgcn_readfirstlane(tab[e]);
        u.pm = mg; u.pn = pn; u.aux = e;
        if (gather) { u.A = A; u.lst = lists + (size_t)e * T + mt * 256; const int rem = __builtin_amdgcn_readfirstlane(tab[48 + e]) - mt * 256; u.nvalid = rem < 256 ? rem : 256; }
        else { u.A = A + (size_t)mg * 256 * lda; u.lst = nullptr; u.nvalid = 256; }
        u.B = B + (size_t)e * bexp + (size_t)pn * 256 * ldb; u.S = SW ? (SA ? SW + ((size_t)e * 4 + pn) * 4096 : SW + ((size_t)e * 8 + pn) * 8192) : nullptr; u.SA = SA ? SA + (size_t)mg * 8192 : nullptr;
        return true;
    }
};

#define EPI_ROW(u, ai, m) ((u).pm * 256 + (ai) * 128 + wr * 64 + (m) * 16 + fr)
struct EpiLat {
    static constexpr bool PERM = true;
    bf16_t* LAT; float* SSQ; bf16_t* KR; const float* CS; const float* SN;
    __device__ __forceinline__ void operator()(const f32x4 (&acc)[2][2][4][2], const Unit& u, int wr, int wc, int fr, int fq) const {
        if (u.pn < 4) {
#pragma unroll
            for (int ai = 0; ai < 2; ++ai)
#pragma unroll
                for (int m = 0; m < 4; ++m) { const int row = EPI_ROW(u, ai, m); float ss = 0.f;
#pragma unroll
                    for (int bj = 0; bj < 2; ++bj) { const f32x4 v0 = acc[ai][bj][m][0], v1 = acc[ai][bj][m][1];
                        ss += (v0[0] * v0[0] + v0[1] * v0[1]) + (v0[2] * v0[2] + v0[3] * v0[3]) + (v1[0] * v1[0] + v1[1] * v1[1]) + (v1[2] * v1[2] + v1[3] * v1[3]);
                        *(u32x4*)(LAT + (size_t)row * 1024 + u.pn * 256 + bj * 128 + wc * 32 + 8 * fq) = pack8(v0, v1); }
                    ss += __shfl_xor(ss, 16); ss += __shfl_xor(ss, 32);
                    if (fq == 0) SSQ[(size_t)row * 16 + u.pn * 4 + wc] = ss; }
        } else if (wc == 0) {
#pragma unroll
            for (int ai = 0; ai < 2; ++ai)
#pragma unroll
                for (int m = 0; m < 4; ++m) { const int row = EPI_ROW(u, ai, m);
                    const f32x4 c0 = *(const f32x4*)(CS + (size_t)row * 32 + 8 * fq), c1 = *(const f32x4*)(CS + (size_t)row * 32 + 8 * fq + 4);
                    const f32x4 s0 = *(const f32x4*)(SN + (size_t)row * 32 + 8 * fq), s1 = *(const f32x4*)(SN + (size_t)row * 32 + 8 * fq + 4);
                    const f32x4 a0 = acc[ai][0][m][0], a1 = acc[ai][0][m][1], b0 = acc[ai][1][m][0], b1 = acc[ai][1][m][1];
                    *(u32x4*)(KR + (size_t)row * 64 + 8 * fq) = pack8(a0 * c0 - b0 * s0, a1 * c1 - b1 * s1);
                    *(u32x4*)(KR + (size_t)row * 64 + 32 + 8 * fq) = pack8(b0 * c0 + a0 * s0, b1 * c1 + a1 * s1); }
        }
    }
};
struct EpiQ {
    static constexpr bool PERM = true;
    bf16_t* Q; const float* SSQ; const float* CS; const float* SN;
    __device__ __forceinline__ void operator()(const f32x4 (&acc)[2][2][4][2], const Unit& u, int wr, int wc, int fr, int fq) const {
#pragma unroll
        for (int ai = 0; ai < 2; ++ai)
#pragma unroll
            for (int m = 0; m < 4; ++m) { const int row = EPI_ROW(u, ai, m);
                const f32x4 q0 = *(const f32x4*)(SSQ + (size_t)row * 16), q1 = *(const f32x4*)(SSQ + (size_t)row * 16 + 4), q2 = *(const f32x4*)(SSQ + (size_t)row * 16 + 8);
                const float ss = ((q0[0] + q0[1]) + (q0[2] + q0[3])) + ((q1[0] + q1[1]) + (q1[2] + q1[3])) + ((q2[0] + q2[1]) + (q2[2] + q2[3]));
                const float r = QSCALE / sqrtf(ss * (1.0f / QL) + KF(RMS_EPS));
                if (u.pn < 4) {
#pragma unroll
                    for (int bj = 0; bj < 2; ++bj)
                        *(u32x4*)(Q + (size_t)row * 1536 + (2 * u.pn + bj) * 192 + wc * 32 + 8 * fq) = pack8(acc[ai][bj][m][0] * r, acc[ai][bj][m][1] * r);
                } else {
                    const int head = 4 * (u.pn - 4) + wc;
                    const f32x4 c0 = *(const f32x4*)(CS + (size_t)row * 32 + 8 * fq), c1 = *(const f32x4*)(CS + (size_t)row * 32 + 8 * fq + 4);
                    const f32x4 s0 = *(const f32x4*)(SN + (size_t)row * 32 + 8 * fq), s1 = *(const f32x4*)(SN + (size_t)row * 32 + 8 * fq + 4);
                    const f32x4 a0 = acc[ai][0][m][0] * r, a1 = acc[ai][0][m][1] * r, b0 = acc[ai][1][m][0] * r, b1 = acc[ai][1][m][1] * r;
                    *(u32x4*)(Q + (size_t)row * 1536 + head * 192 + 128 + 8 * fq) = pack8(a0 * c0 - b0 * s0, a1 * c1 - b1 * s1);
                    *(u32x4*)(Q + (size_t)row * 1536 + head * 192 + 160 + 8 * fq) = pack8(b0 * c0 + a0 * s0, b1 * c1 + a1 * s1);
                }
                asm volatile("" ::: "memory"); }
    }
};
struct EpiKV {
    static constexpr bool PERM = true;
    bf16_t* KN; bf16_t* V; const float* SSQ;
    __device__ __forceinline__ void operator()(const f32x4 (&acc)[2][2][4][2], const Unit& u, int wr, int wc, int fr, int fq) const {
#pragma unroll
        for (int ai = 0; ai < 2; ++ai)
#pragma unroll
            for (int m = 0; m < 4; ++m) { const int row = EPI_ROW(u, ai, m);
                const f32x4 q3 = *(const f32x4*)(SSQ + (size_t)row * 16 + 12);
                const float r = 1.0f / sqrtf(((q3[0] + q3[1]) + (q3[2] + q3[3])) * (1.0f / KVL) + KF(RMS_EPS));
                *(u32x4*)(KN + (size_t)row * 1024 + u.pn * 128 + wc * 32 + 8 * fq) = pack8(acc[ai][0][m][0] * r, acc[ai][0][m][1] * r);
                *(u32x4*)(V + (size_t)row * 1024 + u.pn * 128 + wc * 32 + 8 * fq) = pack8(acc[ai][1][m][0] * r, acc[ai][1][m][1] * r); }
    }
};
__device__ __forceinline__ f32x4 bf4_lo(const u32x4 w) { return (f32x4){bf_lo(w.x), bf_hi(w.x), bf_lo(w.y), bf_hi(w.y)}; }
__device__ __forceinline__ f32x4 bf4_hi(const u32x4 w) { return (f32x4){bf_lo(w.z), bf_hi(w.z), bf_lo(w.w), bf_hi(w.w)}; }
struct EpiRes {
    static constexpr bool PERM = true;
    const bf16_t* X; bf16_t* Y;
    __device__ __forceinline__ void operator()(const f32x4 (&acc)[2][2][4][2], const Unit& u, int wr, int wc, int fr, int fq) const {
        const bf16_t* xb = X + (size_t)u.pm * 256 * 1024; bf16_t* yb = Y + (size_t)u.pm * 256 * 1024; const unsigned o0 = (unsigned)((wr * 64 + fr) * 1024 + u.pn * 256 + wc * 32 + 8 * fq);
        u32x4 xw[2][4][2];
#pragma unroll
        for (int ai = 0; ai < 2; ++ai)
#pragma unroll
            for (int m = 0; m < 4; ++m)
#pragma unroll
                for (int bj = 0; bj < 2; ++bj) xw[ai][m][bj] = *(const u32x4*)(xb + (o0 + (unsigned)((ai * 128 + m * 16) * 1024 + bj * 128)));
#pragma unroll
        for (int ai = 0; ai < 2; ++ai)
#pragma unroll
            for (int m = 0; m < 4; ++m)
#pragma unroll
                for (int bj = 0; bj < 2; ++bj)
                    *(u32x4*)(yb + (o0 + (unsigned)((ai * 128 + m * 16) * 1024 + bj * 128))) = pack8(bf4_lo(xw[ai][m][bj]) * ALPHA + acc[ai][bj][m][0], bf4_hi(xw[ai][m][bj]) * ALPHA + acc[ai][bj][m][1]);
    }
};
struct EpiGU {
    static constexpr bool PERM = true;
    bf16_t* GG; bf16_t* U;
    __device__ __forceinline__ void operator()(const f32x4 (&acc)[2][2][4][2], const Unit& u, int wr, int wc, int fr, int fq) const {
#pragma unroll
        for (int ai = 0; ai < 2; ++ai)
#pragma unroll
            for (int m = 0; m < 4; ++m) { const int row = EPI_ROW(u, ai, m);
#pragma unroll
                for (int bj = 0; bj < 2; ++bj) { f32x4 v0 = acc[ai][bj][m][0], v1 = acc[ai][bj][m][1];
                    if (u.pn < 4) {
                        const float k0 = KF(-2.0f * 0.7978845608028654f * 1.4426950408889634f), k1 = KF(-2.0f * 0.7978845608028654f * 1.4426950408889634f * 0.044715f);
                        const f32x4 z0 = v0 * (v0 * v0 * k1 + k0), z1 = v1 * (v1 * v1 * k1 + k0); f32x4 e0, e1, r0, r1;
#pragma unroll
                        for (int e = 0; e < 4; ++e) { e0[e] = __builtin_amdgcn_exp2f(z0[e]); e1[e] = __builtin_amdgcn_exp2f(z1[e]); }
                        const f32x4 d0 = e0 + 1.0f, d1 = e1 + 1.0f;
#pragma unroll
                        for (int e = 0; e < 4; ++e) { r0[e] = __builtin_amdgcn_rcpf(d0[e]); r1[e] = __builtin_amdgcn_rcpf(d1[e]); }
                        v0 = v0 * r0; v1 = v1 * r1;
                        *(u32x4*)(GG + (size_t)row * 1024 + u.pn * 256 + bj * 128 + wc * 32 + 8 * fq) = pack8(v0, v1);
                    } else *(u32x4*)(U + (size_t)row * 1024 + (u.pn - 4) * 256 + bj * 128 + wc * 32 + 8 * fq) = pack8(v0, v1); } }
    }
};
struct EpiAB {
    static constexpr bool PERM = true;
    bf16_t* LA; bf16_t* BB; const bf16_t* UC; const float* BA; const float* BX; const float* SPL;
    __device__ __forceinline__ void operator()(const f32x4 (&acc)[2][2][4][2], const Unit& u, int wr, int wc, int fr, int fq) const {
        const int ch = (u.pn >> 1) * 256 + (u.pn & 1) * 128 + wc * 32 + 8 * fq;
        const float nl2e = KF(-1.4426950408889634f);
        f32x4 ba[2], bx[2], sp[2];
#pragma unroll
        for (int n = 0; n < 2; ++n) { ba[n] = *(const f32x4*)(BA + ch + 4 * n); bx[n] = *(const f32x4*)(BX + ch + 4 * n); sp[n] = *(const f32x4*)(SPL + ch + 4 * n) * (-nl2e); }
#pragma unroll
        for (int ai = 0; ai < 2; ++ai)
#pragma unroll
            for (int m = 0; m < 4; ++m) { const size_t off = (size_t)EPI_ROW(u, ai, m) * 1024 + ch;
                const u32x4 uw = *(const u32x4*)(UC + off); f32x4 uv[2] = {bf4_lo(uw), bf4_hi(uw)}, lv[2], bv[2];
#pragma unroll
                for (int n = 0; n < 2; ++n) {
                    const f32x4 ta = (acc[ai][0][m][n] + ba[n]) * nl2e, tx = (acc[ai][1][m][n] + bx[n]) * nl2e; f32x4 ea, ex, ra, ri, a2, sq;
#pragma unroll
                    for (int e = 0; e < 4; ++e) { ea[e] = __builtin_amdgcn_exp2f(ta[e]); ex[e] = __builtin_amdgcn_exp2f(tx[e]); }
                    const f32x4 da = ea + 1.0f, dx = ex + 1.0f;
#pragma unroll
                    for (int e = 0; e < 4; ++e) { ra[e] = __builtin_amdgcn_rcpf(da[e]); ri[e] = __builtin_amdgcn_rcpf(dx[e]); }
                    const f32x4 l2 = sp[n] * ra, t2 = l2 + l2; lv[n] = l2;
#pragma unroll
                    for (int e = 0; e < 4; ++e) a2[e] = __builtin_amdgcn_exp2f(t2[e]);
                    const f32x4 om = 1.0f - a2;
#pragma unroll
                    for (int e = 0; e < 4; ++e) sq[e] = __builtin_amdgcn_sqrtf(fmaxf(om[e], 0.0f));
                    bv[n] = sq * ri * uv[n]; }
                *(u32x4*)(LA + off) = pack8(lv[0], lv[1]); *(u32x4*)(BB + off) = pack8(bv[0], bv[1]); asm volatile("" ::: "memory"); }
    }
};
struct EpiUp {
    static constexpr bool PERM = true;
    unsigned char* H; unsigned char* SH; const float* BU;
    __device__ __forceinline__ void operator()(f32x4 (&acc)[2][2][4][2], const Unit& u, int wr, int wc, int fr, int fq) const {
        const int gc = u.pn * 128 + wc * 32 + 8 * fq; const float* bu = BU + (size_t)u.aux * 2048;
        const float k7 = KF(7.0f), km7 = KF(-7.0f), ka = KF(-1.702f * 1.4426950408889634f);
#pragma unroll
        for (int n = 0; n < 2; ++n) { const f32x4 bg = *(const f32x4*)(bu + gc + 4 * n), bp = *(const f32x4*)(bu + 1024 + gc + 4 * n);
#pragma unroll
            for (int ai = 0; ai < 2; ++ai)
#pragma unroll
                for (int m = 0; m < 4; ++m) {
                    { f32x4 g = acc[ai][0][m][n] + bg, up = acc[ai][1][m][n] + bp, ex, rc;
#pragma unroll
                      for (int e = 0; e < 4; ++e) { g[e] = fminf(g[e], k7); up[e] = __builtin_amdgcn_fmed3f(up[e], km7, k7); }
                      const f32x4 tz = g * ka;
#pragma unroll
                      for (int e = 0; e < 4; ++e) ex[e] = __builtin_amdgcn_exp2f(tz[e]);
                      const f32x4 dn = ex + 1.0f;
#pragma unroll
                      for (int e = 0; e < 4; ++e) rc[e] = __builtin_amdgcn_rcpf(dn[e]);
                      acc[ai][0][m][n] = (up + 1.0f) * (g * rc); }
                    if (m & 1) __builtin_amdgcn_sched_barrier(0); }
            asm volatile("" ::: "memory"); }
        unsigned char* const shb = SH + ((size_t)u.pm * 8 + u.pn) * 1024; unsigned char* const hb = H + (size_t)u.pm * 256 * 1024;
        const unsigned ho = (unsigned)((wr * 64 + fr) * 1024 + gc), so = (unsigned)((wr * 64 + fr) * 4 + wc);
#pragma unroll
        for (int ai = 0; ai < 2; ++ai)
#pragma unroll
            for (int m = 0; m < 4; ++m) { const f32x4 y0 = acc[ai][0][m][0], y1 = acc[ai][0][m][1];
                float am = fmaxf(fmaxf(fmaxf(fabsf(y0[0]), fabsf(y0[1])), fmaxf(fabsf(y0[2]), fabsf(y0[3]))), fmaxf(fmaxf(fabsf(y1[0]), fabsf(y1[1])), fmaxf(fabsf(y1[2]), fabsf(y1[3]))));
                { auto r16 = __builtin_amdgcn_permlane16_swap(__float_as_uint(am), __float_as_uint(am), false, false); am = fmaxf(__uint_as_float(r16[0]), __uint_as_float(r16[1]));
                  auto r32 = __builtin_amdgcn_permlane32_swap(__float_as_uint(am), __float_as_uint(am), false, false); am = fmaxf(__uint_as_float(r32[0]), __uint_as_float(r32[1])); }
                int eb = (int)((__float_as_uint(am) >> 23) & 0xffu) - 7; eb = eb < 1 ? 1 : eb;
                const float inv = __uint_as_float((unsigned)(254 - eb) << 23);
                int w0 = __builtin_amdgcn_cvt_pk_fp8_f32(y0[0] * inv, y0[1] * inv, 0, false); w0 = __builtin_amdgcn_cvt_pk_fp8_f32(y0[2] * inv, y0[3] * inv, w0, true);
                int w1 = __builtin_amdgcn_cvt_pk_fp8_f32(y1[0] * inv, y1[1] * inv, 0, false); w1 = __builtin_amdgcn_cvt_pk_fp8_f32(y1[2] * inv, y1[3] * inv, w1, true);
                *(u32x2*)(hb + (ho + (unsigned)((ai * 128 + m * 16) * 1024))) = (u32x2){(unsigned)w0, (unsigned)w1};
                if (fq == 0) shb[so + (unsigned)((ai * 128 + m * 16) * 4)] = (unsigned char)eb;
                asm volatile("" ::: "memory"); __builtin_amdgcn_sched_barrier(0); }
    }
};
struct EpiDown {
    static constexpr bool PERM = true;
    unsigned char* YS; unsigned char* SY; const float* BD;
    __device__ __forceinline__ void operator()(const f32x4 (&acc)[2][2][4][2], const Unit& u, int wr, int wc, int fr, int fq) const {
        const float* bd = BD + (size_t)u.aux * 1024;
        unsigned char* const yb = YS + (size_t)u.pm * 256 * 1024; unsigned char* const sb = SY + (size_t)u.pm * 256 * 32;
#pragma unroll
        for (int bj = 0; bj < 2; ++bj) { const int col = u.pn * 256 + bj * 128 + wc * 32 + 8 * fq; const f32x4 b0 = *(const f32x4*)(bd + col), b1 = *(const f32x4*)(bd + col + 4);
#pragma unroll
            for (int ai = 0; ai < 2; ++ai)
#pragma unroll
                for (int m = 0; m < 4; ++m) { const unsigned rit = (unsigned)(ai * 128 + wr * 64 + m * 16 + fr); const f32x4 y0 = acc[ai][bj][m][0] + b0, y1 = acc[ai][bj][m][1] + b1;
                    float am = fmaxf(fmaxf(fmaxf(fabsf(y0[0]), fabsf(y0[1])), fmaxf(fabsf(y0[2]), fabsf(y0[3]))), fmaxf(fmaxf(fabsf(y1[0]), fabsf(y1[1])), fmaxf(fabsf(y1[2]), fabsf(y1[3]))));
                    { auto r16 = __builtin_amdgcn_permlane16_swap(__float_as_uint(am), __float_as_uint(am), false, false); am = fmaxf(__uint_as_float(r16[0]), __uint_as_float(r16[1]));
                      auto r32 = __builtin_amdgcn_permlane32_swap(__float_as_uint(am), __float_as_uint(am), false, false); am = fmaxf(__uint_as_float(r32[0]), __uint_as_float(r32[1])); }
                    int eb = (int)((__float_as_uint(am) >> 23) & 0xffu) - 7; eb = eb < 1 ? 1 : eb;
                    const float inv = __uint_as_float((unsigned)(254 - eb) << 23);
                    int w0 = __builtin_amdgcn_cvt_pk_fp8_f32(y0[0] * inv, y0[1] * inv, 0, false); w0 = __builtin_amdgcn_cvt_pk_fp8_f32(y0[2] * inv, y0[3] * inv, w0, true);
                    int w1 = __builtin_amdgcn_cvt_pk_fp8_f32(y1[0] * inv, y1[1] * inv, 0, false); w1 = __builtin_amdgcn_cvt_pk_fp8_f32(y1[2] * inv, y1[3] * inv, w1, true);
                    *(u32x2*)(yb + (rit * 1024u + (unsigned)col)) = (u32x2){(unsigned)w0, (unsigned)w1};
                    if (fq == 0) sb[rit * 32u + (unsigned)(col >> 5)] = (unsigned char)eb;
                    asm volatile("" ::: "memory"); } }
    }
};
struct EpiPle {
    static constexpr bool PERM = true;
    const bf16_t* X2; const bf16_t* PP; float* OUT; bf16_t* XB;
    __device__ __forceinline__ void operator()(const f32x4 (&acc)[2][2][4][2], const Unit& u, int wr, int wc, int fr, int fq) const {
        const size_t tb = (size_t)u.pm * 256 * 1024; const unsigned o0 = (unsigned)((wr * 64 + fr) * 1024 + u.pn * 256 + wc * 32 + 8 * fq);
#pragma unroll
        for (int ai = 0; ai < 2; ++ai) {
            u32x4 xw[4][2], pw[4][2];
#pragma unroll
            for (int m = 0; m < 4; ++m)
#pragma unroll
                for (int bj = 0; bj < 2; ++bj) { const unsigned o = o0 + (unsigned)((ai * 128 + m * 16) * 1024 + bj * 128); xw[m][bj] = *(const u32x4*)(X2 + tb + o); pw[m][bj] = *(const u32x4*)(PP + tb + o); }
#pragma unroll
            for (int m = 0; m < 4; ++m)
#pragma unroll
                for (int bj = 0; bj < 2; ++bj) { const unsigned o = o0 + (unsigned)((ai * 128 + m * 16) * 1024 + bj * 128);
                    const f32x4 a0 = acc[ai][bj][m][0], a1 = acc[ai][bj][m][1], x0 = bf4_lo(xw[m][bj]), x1 = bf4_hi(xw[m][bj]), p0 = bf4_lo(pw[m][bj]), p1 = bf4_hi(pw[m][bj]); f32x4 r0, r1;
                    { const float nl2e = KF(-1.4426950408889634f); const f32x4 t0 = a0 * nl2e, t1 = a1 * nl2e; f32x4 e0, e1, s0, s1;
#pragma unroll
                      for (int e = 0; e < 4; ++e) { e0[e] = __builtin_amdgcn_exp2f(t0[e]); e1[e] = __builtin_amdgcn_exp2f(t1[e]); }
                      const f32x4 d0 = e0 + 1.0f, d1 = e1 + 1.0f;
#pragma unroll
                      for (int e = 0; e < 4; ++e) { s0[e] = __builtin_amdgcn_rcpf(d0[e]); s1[e] = __builtin_amdgcn_rcpf(d1[e]); }
                      r0 = x0 + s0 * p0; r1 = x1 + s1 * p1; }
                    *(u32x4*)(XB + tb + o) = pack8(r0, r1);
                    if (OUT) { *(f32x4*)(OUT + tb + o) = r0; *(f32x4*)(OUT + tb + o + 4) = r1; } }
            asm volatile("" ::: "memory"); }
    }
};
struct EpiPP {
    static constexpr bool PERM = true;
    bf16_t* PP;
    __device__ __forceinline__ void operator()(const f32x4 (&acc)[2][2][4][2], const Unit& u, int wr, int wc, int fr, int fq) const {
#pragma unroll
        for (int ai = 0; ai < 2; ++ai)
#pragma unroll
            for (int m = 0; m < 4; ++m)
#pragma unroll
                for (int bj = 0; bj < 2; ++bj) *(u32x4*)(PP + (size_t)EPI_ROW(u, ai, m) * 1024 + u.pn * 256 + bj * 128 + wc * 32 + 8 * fq) = pack8(acc[ai][bj][m][0], acc[ai][bj][m][1]);
    }
};
}

namespace att {
constexpr int NW = 8, QBLK = 32, KVBLK = 64, QB = 256, KPITCH = 384;
constexpr int SHM_V = KVBLK * DV * 2, SHM_K = KVBLK * KPITCH;
constexpr int NVB = 3;
constexpr int OFF_V = 0, OFF_K = NVB * SHM_V, OFF_WS = OFF_K + 2 * SHM_K, LDS_BYTES = OFF_WS + NW * 64 * 4;
#define SBAR() __builtin_amdgcn_sched_barrier(0)
__device__ __forceinline__ int k_addr(int row, int chunk) { return row * KPITCH + ((chunk ^ ((row >> 1) & 7)) << 4); }
__device__ __forceinline__ int v_st(int k, int c) { const int kk = (k & ~0xC) | ((k & 4) << 1) | ((k & 8) >> 1); return ((kk >> 3) * 4 + (c >> 5)) * 512 + ((kk & 7) * 32 + (c & 31)) * 2; }
__device__ __forceinline__ int v_rd_base(int lane) { return ((lane & 3) << 3) | (((lane >> 2) & 3) << 6) | (((lane >> 4) & 1) << 5) | (((lane >> 5) & 1) << 8); }
constexpr int v_rd_off(int d0, int ks, int half) { return d0 * 512 + ks * 4096 + half * 2048; }
__device__ __forceinline__ int crow(int r, int hi) { return (r & 3) + 8 * (r >> 2) + 4 * hi; }

template <int KB>
__device__ __forceinline__ void qkt(f32x16& p0, f32x16& p1, const LAS char* K_lds, int r32, int hi, const bf16x8* qr) {
    p0 = f32x16{}; p1 = f32x16{};
    const LAS char* kb[4];
#pragma unroll
    for (int dd = 0; dd < 4; ++dd) kb[dd] = K_lds + KB * SHM_K + r32 * KPITCH + (((2 * dd + hi) ^ ((r32 >> 1) & 7)) << 4);
    bf16x8 f[2][4];
#define QK_LD(g, buf) do { _Pragma("unroll") for (int e_ = 0; e_ < 2; ++e_) { const int d0_ = 2 * (g) + e_; const LAS char* a_ = kb[d0_ & 3] + (d0_ >> 2) * 128; \
        f[buf][2 * e_] = *(const LAS bf16x8*)a_; f[buf][2 * e_ + 1] = *(const LAS bf16x8*)(a_ + 32 * KPITCH); } } while (0)
    QK_LD(0, 0);
#pragma unroll
    for (int g = 0; g < 6; ++g) {
        if (g < 5) QK_LD(g + 1, (g + 1) & 1);
        SBAR();
#pragma unroll
        for (int e = 0; e < 2; ++e) { const int d0 = 2 * g + e;
            p0 = __builtin_amdgcn_mfma_f32_32x32x16_bf16(f[g & 1][2 * e], qr[d0], p0, 0, 0, 0);
            p1 = __builtin_amdgcn_mfma_f32_32x32x16_bf16(f[g & 1][2 * e + 1], qr[d0], p1, 0, 0, 0); }
        SBAR(); }
#undef QK_LD
}
__device__ __forceinline__ void pv_tile(f32x16* o, int vb0  , bf16x8 pa0, bf16x8 pa1, bf16x8 pa2, bf16x8 pa3) {
#define TRRD(dst, off) asm volatile("ds_read_b64_tr_b16 %0, %1 offset:%2" : "=&v"(dst) : "v"(vb0), "i"(off) : "memory")
#define PV_D0(d0) do { s16x4 l0, l1, l2, l3, h0, h1, h2, h3; constexpr int b_ = v_rd_off(d0, 0, 0); \
        TRRD(l0, b_); TRRD(h0, b_ + 2048); TRRD(l1, b_ + 4096); TRRD(h1, b_ + 6144); TRRD(l2, b_ + 8192); TRRD(h2, b_ + 10240); TRRD(l3, b_ + 12288); TRRD(h3, b_ + 14336); \
        asm volatile("s_waitcnt lgkmcnt(0)" ::: "memory"); SBAR(); \
        o[d0] = __builtin_amdgcn_mfma_f32_32x32x16_bf16(pa0, (bf16x8){l0[0], l0[1], l0[2], l0[3], h0[0], h0[1], h0[2], h0[3]}, o[d0], 0, 0, 0); \
        o[d0] = __builtin_amdgcn_mfma_f32_32x32x16_bf16(pa1, (bf16x8){l1[0], l1[1], l1[2], l1[3], h1[0], h1[1], h1[2], h1[3]}, o[d0], 0, 0, 0); \
        o[d0] = __builtin_amdgcn_mfma_f32_32x32x16_bf16(pa2, (bf16x8){l2[0], l2[1], l2[2], l2[3], h2[0], h2[1], h2[2], h2[3]}, o[d0], 0, 0, 0); \
        o[d0] = __builtin_amdgcn_mfma_f32_32x32x16_bf16(pa3, (bf16x8){l3[0], l3[1], l3[2], l3[3], h3[0], h3[1], h3[2], h3[3]}, o[d0], 0, 0, 0); } while (0)
    PV_D0(0); PV_D0(1); PV_D0(2); PV_D0(3);
#undef PV_D0
#undef TRRD
}
__device__ __forceinline__ void mask_tile(f32x16& p0, f32x16& p1, int dq  ) {
    const float NEG = -__builtin_inff();
#pragma unroll
    for (int r = 0; r < 16; ++r) { const int c = (r & 3) + 8 * (r >> 2);
        if (c > dq) p0[r] = NEG;
        if (c + 32 > dq) p1[r] = NEG; }
}
__device__ __forceinline__ void softmax_tile(f32x16& p0, f32x16& p1, float& m_reg, float& l_reg, float& alpha, bf16x8& pa0, bf16x8& pa1, bf16x8& pa2, bf16x8& pa3) {
    float pmax = p0[0];
#pragma unroll
    for (int r = 1; r < 16; ++r) pmax = fmaxf(pmax, p0[r]);
#pragma unroll
    for (int r = 0; r < 16; ++r) pmax = fmaxf(pmax, p1[r]);
    { auto rr = __builtin_amdgcn_permlane32_swap(__float_as_uint(pmax), __float_as_uint(pmax), false, false); pmax = fmaxf(__uint_as_float(rr[0]), __uint_as_float(rr[1])); }
    float mn = m_reg; alpha = 1.f;
    if (!__all(pmax - m_reg <= 8.0f)) { mn = fmaxf(m_reg, pmax); alpha = __builtin_amdgcn_exp2f(m_reg - mn); m_reg = mn; }
    float ps = 0.f;
#pragma unroll
    for (int r = 0; r < 16; ++r) { p0[r] = __builtin_amdgcn_exp2f(p0[r] - mn); ps += p0[r]; }
#pragma unroll
    for (int r = 0; r < 16; ++r) { p1[r] = __builtin_amdgcn_exp2f(p1[r] - mn); ps += p1[r]; }
    { auto rr = __builtin_amdgcn_permlane32_swap(__float_as_uint(ps), __float_as_uint(ps), false, false); ps = __uint_as_float(rr[0]) + __uint_as_float(rr[1]); }
    l_reg = l_reg * alpha + ps;
#define PK4(P, B_, OUT) do { unsigned a0 = cvt_pk_bf16(P[B_+0], P[B_+1]), a1 = cvt_pk_bf16(P[B_+2], P[B_+3]); \
        unsigned b0 = cvt_pk_bf16(P[B_+4], P[B_+5]), b1 = cvt_pk_bf16(P[B_+6], P[B_+7]); \
        auto r0 = __builtin_amdgcn_permlane32_swap(a0, b0, false, false); auto r1 = __builtin_amdgcn_permlane32_swap(a1, b1, false, false); \
        u32x4 w = {r0[0], r1[0], r0[1], r1[1]}; OUT = __builtin_bit_cast(bf16x8, w); } while (0)
    PK4(p0, 0, pa0); PK4(p0, 8, pa1); PK4(p1, 0, pa2); PK4(p1, 8, pa3);
#undef PK4
}

__device__ __forceinline__ void attn_block(int b, int h, int qb, const bf16_t* Q, const bf16_t* KN, const bf16_t* KR, const bf16_t* V, bf16_t* O, LAS char* lds, unsigned long long* pw = nullptr) {
    const int tid = opaque_tid(), wid = __builtin_amdgcn_readfirstlane(tid >> 6), lane = tid & 63, r32 = lane & 31, hi = lane >> 5;
    const size_t row0 = (size_t)b * SEQ;
    const int q0 = qb * QB + wid * QBLK;
    const int NT = (qb + 1) * (QB / KVBLK);
    LAS char* V_lds = lds + OFF_V; LAS char* K_lds = lds + OFF_K;
    LAS float* ws = (LAS float*)(lds + OFF_WS) + wid * 64; LAS float* li_l = ws; LAS float* al_l = ws + 32;
    const int sr = tid >> 4, sc = (tid & 15) * 8, kr_row = tid >> 3, kr_c = tid & 7;
    const int vst0 = v_st(sr, sc), vst1 = v_st(32 + sr, sc), kws = k_addr(sr, tid & 15), kwr = k_addr(kr_row, 16 + kr_c);
    const int vb0 = (int)(uintptr_t)lds + v_rd_base(lane);
    const bf16_t* KNh = KN + row0 * 1024 + h * 128 + sc; const bf16_t* Vh = V + row0 * 1024 + h * 128 + sc; const bf16_t* KRb = KR + row0 * 64 + kr_c * 8;
    bf16x8 st_k0, st_k1, st_kr, st_v0, st_v1;
#define SLOAD(t) do { const size_t k0_ = (size_t)(t) * KVBLK; \
        st_k0 = *(const bf16x8*)(KNh + (k0_ + sr) * 1024); st_k1 = *(const bf16x8*)(KNh + (k0_ + 32 + sr) * 1024); st_kr = *(const bf16x8*)(KRb + (k0_ + kr_row) * 64); \
        st_v0 = *(const bf16x8*)(Vh + (k0_ + sr) * 1024); st_v1 = *(const bf16x8*)(Vh + (k0_ + 32 + sr) * 1024); } while (0)
#define SWRITE(bf, vo) do { *(LAS bf16x8*)(K_lds + (bf) * SHM_K + kws) = st_k0; *(LAS bf16x8*)(K_lds + (bf) * SHM_K + kws + 32 * KPITCH) = st_k1; *(LAS bf16x8*)(K_lds + (bf) * SHM_K + kwr) = st_kr; \
        *(LAS bf16x8*)(V_lds + (vo) + vst0) = st_v0; *(LAS bf16x8*)(V_lds + (vo) + vst1) = st_v1; } while (0)
    SLOAD(0);
    bf16x8 qr[12];
    { const bf16_t* Qw = Q + (row0 + q0 + r32) * 1536 + h * 192 + hi * 8;
#pragma unroll
      for (int d0 = 0; d0 < 12; ++d0) qr[d0] = *(const bf16x8*)(Qw + d0 * 16); }
    float m_reg = -1e30f, l_reg = 0.f; f32x16 o[4] = {};
    f32x16 p0, p1; bf16x8 pa0, pa1, pa2, pa3; float alpha;
    asm volatile("s_waitcnt vmcnt(0)" ::: "memory");
    SWRITE(0, 0);
    __syncthreads();
    const bool odd = wid >= 4; int vo_prev = 0, vo_cur = 0, vo_next = SHM_V;
#define RESC(a) do { if (__any((a) < 1.f)) { if (hi == 0) al_l[r32] = (a); asm volatile("s_waitcnt lgkmcnt(0)" ::: "memory"); \
        _Pragma("unroll") for (int d_ = 0; d_ < 4; ++d_) _Pragma("unroll") for (int r = 0; r < 16; ++r) o[d_][r] *= al_l[crow(r, hi)]; } } while (0)
#if PROBE_T
    unsigned long long pa_ = 0, pb_ = 0, pc_ = 0, pd_ = 0, pe2_ = 0; const unsigned long long pst_ = __builtin_amdgcn_s_memtime();
#define PSTAMP(v) const unsigned long long v = __builtin_amdgcn_s_memtime()
#define PACC(acc, a, b) acc += (b) - (a)
#else
#define PSTAMP(v) do {} while (0)
#define PACC(acc, a, b) do {} while (0)
#endif
#define TILE(t, BF) do { PSTAMP(s0_); const bool more_ = ((t) + 1 < NT); if (more_) SLOAD((t) + 1); SBAR(); \
        if (odd && (t) > 0) { pv_tile(o, vb0 + vo_prev, pa0, pa1, pa2, pa3); SBAR(); } \
        PSTAMP(s1_); qkt<BF>(p0, p1, K_lds, r32, hi, qr); \
        { const int kb_ = (t) * KVBLK; if (kb_ + KVBLK - 1 > q0) mask_tile(p0, p1, q0 + r32 - kb_ - 4 * hi); } \
        asm volatile("" : "+v"(p0), "+v"(p1)); PSTAMP(s2_); \
        softmax_tile(p0, p1, m_reg, l_reg, alpha, pa0, pa1, pa2, pa3); RESC(alpha); SBAR(); PSTAMP(s3_); \
        if (!odd) pv_tile(o, vb0 + vo_cur, pa0, pa1, pa2, pa3); \
        PSTAMP(s4_); if (more_) { asm volatile("s_waitcnt vmcnt(0)" ::: "memory"); SWRITE((BF) ^ 1, vo_next); } \
        PSTAMP(s5_); __syncthreads(); PSTAMP(s6_); PACC(pa_, s1_, s2_); PACC(pb_, s2_, s3_); PACC(pc_, s3_, s4_); PACC(pd_, s4_, s5_); PACC(pe2_, s5_, s6_); vo_prev = vo_cur; vo_cur = vo_next; vo_next = (vo_next == (NVB - 1) * SHM_V) ? 0 : vo_next + SHM_V; } while (0)
#pragma unroll 1
    for (int t = 0; t < NT; t += 2) { TILE(t, 0); TILE(t + 1, 1); }
    if (odd) pv_tile(o, vb0 + vo_prev, pa0, pa1, pa2, pa3);
#if PROBE_T
    if (pw && blockIdx.x == 0 && tid == 0) { pw[8] += pa_; pw[9] += pb_; pw[10] += pc_; pw[11] += pd_; pw[12] += pe2_; pw[13] += (unsigned long long)NT; pw[14] += __builtin_amdgcn_s_memtime() - pst_; }
#endif
    if (hi == 0) li_l[r32] = l_reg; asm volatile("s_waitcnt lgkmcnt(0)" ::: "memory");
    __syncthreads();
    { LAS bf16_t* stg = (LAS bf16_t*)(lds + wid * 8704);
#pragma unroll
      for (int r = 0; r < 16; ++r) { const int orow = crow(r, hi); const float rl = __builtin_amdgcn_rcpf(li_l[orow]);
#pragma unroll
          for (int d0 = 0; d0 < 4; ++d0) { const float v = o[d0][r] * rl; stg[orow * 136 + d0 * 32 + r32] = (bf16_t)(cvt_pk_bf16(v, v) & 0xffffu); } }
      asm volatile("s_waitcnt lgkmcnt(0)" ::: "memory");
      bf16_t* Ow = O + (row0 + q0) * 1024 + h * 128 + (lane & 15) * 8;
#pragma unroll
      for (int it = 0; it < 8; ++it) { const int row = it * 4 + (lane >> 4); const u32x4 v = *(const LAS u32x4*)(stg + row * 136 + (lane & 15) * 8); *(u32x4*)(Ow + (size_t)row * 1024) = v; } }
    __syncthreads();
#undef SLOAD
#undef SWRITE
#undef RESC
#undef TILE
#undef PSTAMP
#undef PACC
}
#undef SBAR
}

#define XB_TMO      128
#define XB_XCNT(j)  (256  + 64 * (j))
#define XB_XSUB(j)  (1280 + 64 * (j))
#define XB_XGEN(j)  (2304 + 64 * (j))
#define XB_TOP      3328
#define XB_TOPGEN   3392
#define XCD_BAR_WORDS 3456
#define XB_SPIN_CAP (1u << 22)
__device__ __forceinline__ unsigned xb_ld(unsigned* p)              { return __hip_atomic_load(p, __ATOMIC_RELAXED, __HIP_MEMORY_SCOPE_AGENT); }
__device__ __forceinline__ unsigned xb_add(unsigned* p, unsigned v) { return __hip_atomic_fetch_add(p, v, __ATOMIC_RELAXED, __HIP_MEMORY_SCOPE_AGENT); }
__device__ __forceinline__ unsigned xb_xcc_id() { return (unsigned)__builtin_amdgcn_s_getreg((3 << 11) | 20) & 0xFu; }
#define XB_SPIN(cond, bar) do { unsigned _sp = 0; while (cond) { __builtin_amdgcn_s_sleep(1); \
    if ((++_sp & 255u) == 0u) { if (xb_ld(&(bar)[XB_TMO])) break; if (_sp > XB_SPIN_CAP) { atomicAdd(&(bar)[XB_TMO], 1u); break; } } } } while (0)
struct XcdBarrier { unsigned* bar; unsigned x; volatile LAS unsigned* st; };
__device__ __forceinline__ XcdBarrier xcd_barrier_post(unsigned* bar, volatile LAS unsigned* st) {
    XcdBarrier b; b.bar = bar; b.x = xb_xcc_id(); b.st = st;
    if (threadIdx.x == 0) (void)xb_add(&bar[XB_XCNT(b.x)], 1u);
    return b;
}
__device__ __forceinline__ void xcd_barrier_complete(unsigned* bar, unsigned x, unsigned& nloc, unsigned& nx) {
    const unsigned G = gridDim.x * gridDim.y * gridDim.z;
    unsigned sum, cnt, mine, sp = 0u;
    for (;;) {
        sum = 0u; cnt = 0u; mine = 0u;
#pragma unroll
        for (unsigned j = 0; j < 16; ++j) { const unsigned c = xb_ld(&bar[XB_XCNT(j)]); sum += c; cnt += (c > 0u) ? 1u : 0u; mine = (j == x) ? c : mine; }
        if (sum == G) break;
        __builtin_amdgcn_s_sleep(1);
        if ((++sp & 255u) == 0u) { if (xb_ld(&bar[XB_TMO])) break; if (sp > XB_SPIN_CAP) { atomicAdd(&bar[XB_TMO], 1u); break; } }
    }
    nloc = mine > 0u ? mine : 1u; nx = cnt > 0u ? cnt : 1u;
}
__device__ __forceinline__ void xcd_barrier(const XcdBarrier& b) {
    asm volatile("s_waitcnt vmcnt(0)" ::: "memory");
    __syncthreads();
    if (opaque_tid() == 0) {
        unsigned* bar = b.bar; unsigned bx = b.x;
        asm volatile("" : "+s"(bar), "+s"(bx));
        __builtin_amdgcn_s_waitcnt(0);
        unsigned nloc = b.st[0], nx = b.st[1];
        if (nloc == 0u) { xcd_barrier_complete(bar, bx, nloc, nx); b.st[0] = nloc; b.st[1] = nx; }
        const unsigned old = xb_add(&bar[XB_XSUB(bx)], 1u);
        const unsigned gen = old / nloc;
        if (old + 1u == (gen + 1u) * nloc) {
            __builtin_amdgcn_fence(__ATOMIC_RELEASE, "agent");
            asm volatile("s_waitcnt vmcnt(0)" ::: "memory");
            const unsigned og = xb_add(&bar[XB_TOP], 1u);
            const unsigned tg = og / nx;
            if (og + 1u == (tg + 1u) * nx) xb_add(&bar[XB_TOPGEN], 1u);
            else XB_SPIN(xb_ld(&bar[XB_TOPGEN]) == tg, bar);
            __builtin_amdgcn_fence(__ATOMIC_ACQUIRE, "agent");
            xb_add(&bar[XB_XGEN(bx)], 1u);
            asm volatile("s_waitcnt vmcnt(0)" ::: "memory");
        } else {
            XB_SPIN(xb_ld(&bar[XB_XGEN(bx)]) == gen, bar);
            __builtin_amdgcn_fence(__ATOMIC_ACQUIRE, "agent");
            asm volatile("s_waitcnt vmcnt(0)" ::: "memory");
        }
    }
    __syncthreads();
}

struct Args { const void* in[30]; float* out; unsigned char* ws; int ph_lo, ph_hi, li, pad; };
struct Ctx { int tid, lane, wave, vcu, G, bid; LAS unsigned char* lds; volatile LAS int* misc; };
__device__ __forceinline__ Ctx fresh_ctx(const Ctx& c) {
    Ctx r = c; unsigned l = (unsigned)(uintptr_t)c.lds, m = (unsigned)(uintptr_t)c.misc;
    asm volatile("" : "+s"(r.wave), "+s"(r.vcu), "+s"(r.G), "+s"(r.bid), "+s"(l), "+s"(m));
    r.lds = (LAS unsigned char*)(uintptr_t)l; r.misc = (volatile LAS int*)(uintptr_t)m; r.tid = opaque_tid(); r.lane = r.tid & 63; return r; }
typedef const CAS Args* ArgsP;
__device__ __forceinline__ const CAS Args& fresh_args(ArgsP p) { asm volatile("" : "+s"(p)); return *p; }
enum { I_X = 0, I_P, I_POS, I_MLA_WIN, I_MLA_QN, I_MLA_KVN, I_MLA_WUQ, I_MLA_WUKV, I_MLA_WO, I_LRU_WIN, I_LRU_CW, I_LRU_CB, I_LRU_WA, I_LRU_BA, I_LRU_WX, I_LRU_BX, I_LRU_LAM, I_LRU_WOUT,
       I_LN1G, I_LN1B, I_LN2G, I_LN2B, I_MOE_WR, I_MOE_BR, I_MOE_WUP, I_MOE_BUP, I_MOE_WDN, I_MOE_BDN, I_PLE_WG, I_PLE_WP };
#define INF(i) ((const float*)args.in[i])
#define WSP(T_, off) ((T_*)(args.ws + (off)))

__device__ __forceinline__ void tr_load(const float* W, int ld, int k0, int sc0, int sc1, int lane, f32x4 (&v)[16]) {
    const int half = (lane & 15) >> 3, scol = half ? sc1 : sc0, c4 = (lane & 7) * 4, rs = lane >> 4;
#pragma unroll
    for (int i = 0; i < 8; ++i) { const float* p = W + (size_t)(k0 + 8 * i + 2 * rs) * ld + scol + c4;
        v[2 * i] = (scol >= 0) ? *(const f32x4*)p : (f32x4){0.f, 0.f, 0.f, 0.f}; v[2 * i + 1] = (scol >= 0) ? *(const f32x4*)(p + ld) : (f32x4){0.f, 0.f, 0.f, 0.f}; }
}
__device__ __forceinline__ void tr_store(f32x4 (&v)[16], const float* ksc, int k0, bf16_t* dst  , int K, LAS unsigned* scr, int lane) {
    const int rs = lane >> 4;
    if (ksc) {
#pragma unroll
        for (int i = 0; i < 8; ++i) { v[2 * i] = v[2 * i] * ksc[k0 + 8 * i + 2 * rs]; v[2 * i + 1] = v[2 * i + 1] * ksc[k0 + 8 * i + 2 * rs + 1]; } }
#pragma unroll
    for (int i = 0; i < 8; ++i) { LAS unsigned* s = scr + (4 * i + rs) * 65 + (lane & 15) * 4;
#pragma unroll
        for (int e = 0; e < 4; ++e) s[e] = cvt_pk_bf16(v[2 * i][e], v[2 * i + 1][e]); }
    asm volatile("s_waitcnt lgkmcnt(0)" ::: "memory");
    const int c = lane & 7;
#pragma unroll
    for (int j = 0; j < 8; ++j) { const int n = (lane >> 3) + 8 * j; const LAS unsigned* s = scr + (4 * c) * 65 + n;
        u32x4 o; o.x = s[0]; o.y = s[65]; o.z = s[130]; o.w = s[195];
        *(u32x4*)(dst + (size_t)n * K + 8 * c) = o; }
    asm volatile("s_waitcnt lgkmcnt(0)" ::: "memory");
}
enum { J_NAT = 0, J_MLA_WIN, J_MLA_WUQ, J_LRU_WAX, J_MOE_UP };
__device__ __forceinline__ int tr_map(int job, int g) {
    switch (job) {
    case J_MLA_WIN: return g < 32 ? 32 * g : (g == 32 ? 1024 : (g == 36 ? 1056 : -1));
    case J_MLA_WUQ: if (g < 32) { const int t = g >> 3, bj = (g >> 2) & 1, cg = g & 3; return (2 * t + bj) * 192 + 32 * cg; }
                    else { const int g2 = g - 32, t2 = g2 >> 3, bj = (g2 >> 2) & 1, hh = g2 & 3; return (4 * t2 + hh) * 192 + 128 + 32 * bj; }
    case J_LRU_WAX: { const int pn = g >> 3, cg = g & 3; return 128 * pn + 32 * cg; }
    case J_MOE_UP:  { const int pn = g >> 3, bj = (g >> 2) & 1, cg = g & 3; return bj * 1024 + 128 * pn + 32 * cg; }
    default: return 32 * g;
    }
}
__device__ __forceinline__ void tr_job(const Ctx& C, int job, const float* src, size_t srcstride, int nmat, int K, int ld, int N, bf16_t* dst, size_t dststride, const float* ksc, int kscstride,
                                       const float* src2  ) {
    LAS unsigned* scr = (LAS unsigned*)(C.lds + C.wave * 8320);
    const int gw = C.vcu * NWAVES + C.wave, NGW = C.G * NWAVES;
    const int nkb = K / 64, nnb = N / 64, per = nkb * nnb, total = per * nmat;
#define TR_DECODE(it_, W_, k0_, s0_, s1_, ks_, d_) do { const int mat_ = (it_) / per, r_ = (it_) - mat_ * per, kb_ = r_ / nnb, nb_ = r_ - kb_ * nnb; \
        s0_ = tr_map(job, 2 * nb_); s1_ = tr_map(job, 2 * nb_ + 1); W_ = src + (size_t)mat_ * srcstride; \
        if (job == J_LRU_WAX && ((nb_ >> 1) & 1)) W_ = src2 + (size_t)mat_ * srcstride;       \
        k0_ = kb_ * 64; ks_ = ksc ? ksc + (size_t)mat_ * kscstride : nullptr; d_ = (bf16_t*)((char*)dst + (size_t)mat_ * dststride) + (size_t)(nb_ * 64) * K + kb_ * 64; } while (0)
    f32x4 va[16], vb[16];
    int it = gw; const float* Wc; int k0c, s0c, s1c; const float* ksc_c; bf16_t* dc;
    if (it < total) { TR_DECODE(it, Wc, k0c, s0c, s1c, ksc_c, dc); tr_load(Wc, ld, k0c, s0c, s1c, C.lane, va); }
    while (it < total) {
        const int nit = it + NGW; const float* Wn = nullptr; int k0n = 0, s0n = 0, s1n = 0; const float* ksc_n = nullptr; bf16_t* dn = nullptr;
        if (nit < total) { TR_DECODE(nit, Wn, k0n, s0n, s1n, ksc_n, dn); tr_load(Wn, ld, k0n, s0n, s1n, C.lane, vb); }
        tr_store(va, ksc_c, k0c, dc, K, scr, C.lane);
#pragma unroll
        for (int i = 0; i < 16; ++i) va[i] = vb[i];
        it = nit; k0c = k0n; ksc_c = ksc_n; dc = dn;
    }
#undef TR_DECODE
}
template <int JOB, int N, bool G64  >
__device__ __forceinline__ void tr_job_fp8(const Ctx& C, const float* src, size_t srcstride, int nmat, unsigned char* dst, size_t dststride, unsigned char* SW) {
    constexpr int K = 1024, ld = N;
    LAS float* scr = (LAS float*)(C.lds + C.wave * 16640);
    const int gw = C.vcu * NWAVES + C.wave, NGW = C.G * NWAVES, lane = C.lane;
    const int nkb = K / 64, nnb = N / 64, per = nkb * nnb, total = per * nmat;
    f32x4 v[16], vn[16];
    if (gw < total) { const int mat = gw / per, r = gw - mat * per, kb = r / nnb, nb = r - kb * nnb; tr_load(src + (size_t)mat * srcstride, ld, kb * 64, tr_map(JOB, 2 * nb), tr_map(JOB, 2 * nb + 1), lane, v); }
    for (int it = gw; it < total; it += NGW) {
        const int mat = it / per, r = it - mat * per, kb = r / nnb, nb = r - kb * nnb;
        { const int nit = it + NGW; if (nit < total) { const int matn = nit / per, rn = nit - matn * per, kbn = rn / nnb, nbn = rn - kbn * nnb; tr_load(src + (size_t)matn * srcstride, ld, kbn * 64, tr_map(JOB, 2 * nbn), tr_map(JOB, 2 * nbn + 1), lane, vn); } }
        const int rs = lane >> 4;
#pragma unroll
        for (int i = 0; i < 8; ++i) { LAS float* sp = scr + (8 * i + 2 * rs) * 65 + (lane & 15) * 4;
#pragma unroll
            for (int e = 0; e < 4; ++e) { sp[e] = v[2 * i][e]; sp[65 + e] = v[2 * i + 1][e]; } }
        asm volatile("s_waitcnt lgkmcnt(0)" ::: "memory");
        const int c = lane & 7;
#pragma unroll
        for (int j = 0; j < 8; ++j) { const int n = (lane >> 3) + 8 * j; const LAS float* sp = scr + (8 * c) * 65 + n;
            float x[8]; float am = 0.f;
#pragma unroll
            for (int q = 0; q < 8; ++q) { x[q] = sp[q * 65]; am = fmaxf(am, fabsf(x[q])); }
            am = fmaxf(am, __shfl_xor(am, 1)); am = fmaxf(am, __shfl_xor(am, 2));
            if (G64) am = fmaxf(am, __shfl_xor(am, 4));
            int eb = (int)((__float_as_uint(am) >> 23) & 0xffu) - 7; eb = eb < 1 ? 1 : eb;
            const float inv = __uint_as_float((unsigned)(254 - eb) << 23);
            int w0 = __builtin_amdgcn_cvt_pk_fp8_f32(x[0] * inv, x[1] * inv, 0, false); w0 = __builtin_amdgcn_cvt_pk_fp8_f32(x[2] * inv, x[3] * inv, w0, true);
            int w1 = __builtin_amdgcn_cvt_pk_fp8_f32(x[4] * inv, x[5] * inv, 0, false); w1 = __builtin_amdgcn_cvt_pk_fp8_f32(x[6] * inv, x[7] * inv, w1, true);
            const int nrow = nb * 64 + n;
            *(u32x2*)(dst + (size_t)mat * dststride + (size_t)nrow * K + kb * 64 + 8 * c) = (u32x2){(unsigned)w0, (unsigned)w1};
            if (!G64) { if ((c & 3) == 0) SW[(size_t)mat * 65536 + (size_t)(nrow >> 8) * 8192 + (size_t)(kb >> 1) * 1024 + (nrow & 255) * 4 + 2 * (kb & 1) + (c >> 2)] = (unsigned char)eb; }
            else { if (c == 0) SW[(size_t)mat * 16384 + (size_t)(nrow >> 8) * 4096 + (size_t)(kb >> 1) * 512 + (nrow & 255) * 2 + (kb & 1)] = (unsigned char)eb; } }
        asm volatile("s_waitcnt lgkmcnt(0)" ::: "memory");
#pragma unroll
        for (int i = 0; i < 16; ++i) v[i] = vn[i];
    }
}
__device__ __forceinline__ void cvt_rows(const Ctx& C, const float* src, bf16_t* dst, size_t n8  ) {
    const size_t gt = (size_t)C.vcu * 512 + C.tid, NT = (size_t)C.G * 512;
    size_t i = gt;
    for (; i + 3 * NT < n8; i += 4 * NT) {
        f32x4 a[4], b[4];
#pragma unroll
        for (int q = 0; q < 4; ++q) { a[q] = *(const f32x4*)(src + (i + q * NT) * 8); b[q] = *(const f32x4*)(src + (i + q * NT) * 8 + 4); }
#pragma unroll
        for (int q = 0; q < 4; ++q) *(u32x4*)(dst + (i + q * NT) * 8) = pack8(a[q], b[q]); }
    for (; i < n8; i += NT) { const f32x4 a = *(const f32x4*)(src + i * 8), b = *(const f32x4*)(src + i * 8 + 4); *(u32x4*)(dst + i * 8) = pack8(a, b); }
}
__device__ __forceinline__ void phase_prologue(const CAS Args& args, const Ctx& C) {
    tr_job(C, J_MLA_WIN, INF(I_MLA_WIN), (size_t)DM * LATD, 2, DM, LATD, 1280, WSP(bf16_t, WS_W_MLA + OFF_MLA_WIN), W_MLA_STRIDE, nullptr, 0, nullptr);
    tr_job(C, J_MLA_WUQ, INF(I_MLA_WUQ), (size_t)QL * 1536, 2, QL, 1536, 1536, WSP(bf16_t, WS_W_MLA + OFF_MLA_WUQ), W_MLA_STRIDE, INF(I_MLA_QN), QL, nullptr);
    tr_job(C, J_NAT, INF(I_MLA_WUKV), (size_t)KVL * 2048, 2, KVL, 2048, 2048, WSP(bf16_t, WS_W_MLA + OFF_MLA_WUKV), W_MLA_STRIDE, INF(I_MLA_KVN), KVL, nullptr);
    tr_job(C, J_NAT, INF(I_MLA_WO), (size_t)DM * DM, 2, DM, DM, DM, WSP(bf16_t, WS_W_MLA + OFF_MLA_WO), W_MLA_STRIDE, nullptr, 0, nullptr);
    tr_job(C, J_NAT, INF(I_LRU_WIN), (size_t)DM * 2048, 2, DM, 2048, 2048, WSP(bf16_t, WS_W_LRU + OFF_LRU_WIN), W_LRU_STRIDE, nullptr, 0, nullptr);
    for (int j = 0; j < 2; ++j)
        tr_job(C, J_LRU_WAX, INF(I_LRU_WA) + (size_t)j * 4 * 65536, (size_t)256 * 256, 4, 256, 256, 512, WSP(bf16_t, WS_W_LRU + OFF_LRU_WAX + (size_t)j * W_LRU_STRIDE), (size_t)512 * 256 * 2, nullptr, 0, INF(I_LRU_WX) + (size_t)j * 4 * 65536);
    tr_job(C, J_NAT, INF(I_LRU_WOUT), (size_t)DM * DM, 2, DM, DM, DM, WSP(bf16_t, WS_W_LRU + OFF_LRU_WOUT), W_LRU_STRIDE, nullptr, 0, nullptr);
    tr_job(C, J_NAT, INF(I_PLE_WP), (size_t)PLED * DM, 4, PLED, DM, DM, WSP(bf16_t, WS_W_PLE + OFF_PLE_WP), W_PLE_STRIDE, nullptr, 0, nullptr);
    __syncthreads();
    tr_job_fp8<J_MOE_UP, 2048, false>(C, INF(I_MOE_WUP), (size_t)DM * 2048, DEPTH * NE, args.ws + WS_W_UP, (size_t)2048 * 1024, args.ws + WS_SW);
    tr_job_fp8<J_NAT, 1024, true>(C, INF(I_MOE_WDN), (size_t)DFF * DM, DEPTH * NE, args.ws + WS_W_DN, (size_t)1024 * 1024, args.ws + WS_SWD);
    tr_job_fp8<J_NAT, 1024, false>(C, INF(I_PLE_WG), (size_t)DM * DM, DEPTH, args.ws + WS_W_PLE + OFF_PLE_WG, W_PLE_STRIDE, args.ws + WS_SWG);
    __syncthreads();
    cvt_rows(C, INF(I_X), WSP(bf16_t, WS_XB), (size_t)T * DM / 8);
    cvt_rows(C, INF(I_P), WSP(bf16_t, WS_PB), (size_t)DEPTH * T * PLED / 8);
    { const int* pos = (const int*)args.in[I_POS]; float* CS = WSP(float, WS_CS); float* SN = WSP(float, WS_SN);
      const size_t gt = (size_t)C.vcu * 512 + C.tid, NT = (size_t)C.G * 512;
      for (size_t i = gt; i < (size_t)T * 32; i += NT) { const int tok = (int)(i >> 5), j = (int)(i & 31);
          const double inv = exp(-9.210340371976184 * (double)j / 32.0); const double ang = (double)pos[tok] * inv; double s, c; sincos(ang, &s, &c); CS[i] = (float)c; SN[i] = (float)s; }
      { const float* wr = INF(I_MOE_WR); const float* lg1 = INF(I_LN1G); bf16_t* WRH = WSP(bf16_t, WS_WRH); bf16_t* WRL = WSP(bf16_t, WS_WRL);
        for (size_t i = gt; i < (size_t)DEPTH * 64 * 64; i += NT) { const int l = (int)(i >> 12), st = (int)(i >> 6) & 63, ln = (int)i & 63; float w[8], lo[8];
#pragma unroll
            for (int j = 0; j < 8; ++j) { const int k = 16 * st + 8 * (ln >> 5) + j; w[j] = lg1[l * DM + k] * wr[((size_t)l * DM + k) * NE + (ln & 31)]; }
            u32x4 h; h.x = cvt_pk_bf16(w[0], w[1]); h.y = cvt_pk_bf16(w[2], w[3]); h.z = cvt_pk_bf16(w[4], w[5]); h.w = cvt_pk_bf16(w[6], w[7]);
            lo[0] = w[0] - bf_lo(h.x); lo[1] = w[1] - bf_hi(h.x); lo[2] = w[2] - bf_lo(h.y); lo[3] = w[3] - bf_hi(h.y); lo[4] = w[4] - bf_lo(h.z); lo[5] = w[5] - bf_hi(h.z); lo[6] = w[6] - bf_lo(h.w); lo[7] = w[7] - bf_hi(h.w);
            u32x4 q; q.x = cvt_pk_bf16(lo[0], lo[1]); q.y = cvt_pk_bf16(lo[2], lo[3]); q.z = cvt_pk_bf16(lo[4], lo[5]); q.w = cvt_pk_bf16(lo[6], lo[7]);
            *(u32x4*)(WRH + i * 8) = h; *(u32x4*)(WRL + i * 8) = q; }
        float* RC = WSP(float, WS_RC); const float* lb1 = INF(I_LN1B); const float* rb = INF(I_MOE_BR);
        for (size_t i = gt; i < (size_t)DEPTH * NE; i += NT) { const int l = (int)(i >> 5), e = (int)i & 31; float c1 = 0.f, c2 = 0.f;
            for (int k = 0; k < DM; ++k) { const float w = wr[((size_t)l * DM + k) * NE + e]; c1 = fmaf(lg1[l * DM + k], w, c1); c2 = fmaf(lb1[l * DM + k], w, c2); }
            RC[l * 64 + e] = c1; RC[l * 64 + 32 + e] = c2 + rb[l * NE + e]; } }
      float* SPL = WSP(float, WS_SPL); const float* lam = INF(I_LRU_LAM);
      for (size_t i = gt; i < 2 * 1024; i += NT) { const double l = (double)lam[i]; SPL[i] = (float)(-8.0 * log1p(exp(-l))); } }
}

__device__ __forceinline__ void moe_table(const CAS Args& args, const Ctx& C0, int layer) {
    Ctx C = C0; C.tid = opaque_tid(); C.lane = C.tid & 63;
    const unsigned* cnt = WSP(unsigned, WS_CTL) + CW_CNT + 64 * layer;
    __syncthreads();
    if (C.tid < 32) C.misc[64 + C.tid] = (int)__hip_atomic_load(cnt + C.tid, __ATOMIC_RELAXED, __HIP_MEMORY_SCOPE_AGENT);
    __syncthreads();
    if (C.tid == 0) { int acc = 0; for (int e = 0; e < 32; ++e) { C.misc[16 + e] = acc; acc += (C.misc[64 + e] + 255) >> 8; } C.misc[16 + 32] = acc; }
    __syncthreads();
    { volatile LAS unsigned char* te = (volatile LAS unsigned char*)(C.lds + TILE_E_OFF);
      for (int mg = C.tid; mg < C.misc[48]; mg += NWAVES * 64) { int e = 0; for (int j = 1; j < 32; ++j) e += (C.misc[16 + j] <= mg) ? 1 : 0; te[mg] = (unsigned char)e; } }
    __syncthreads();
}

__device__ __forceinline__ void phase_ln_router(const CAS Args& args, const Ctx& C0, int layer) {
    const int cslot = layer + args.pad;
    Ctx C = C0; C.tid = opaque_tid(); C.lane = C.tid & 63;
    const bf16_t* Y = WSP(bf16_t, WS_Y); bf16_t* X1B = WSP(bf16_t, WS_X1B);
    const float* g1 = INF(I_LN1G) + layer * DM; const float* b1 = INF(I_LN1B) + layer * DM;
    const bf16_t* WRH = WSP(bf16_t, WS_WRH) + (size_t)layer * 64 * 64 * 8; const bf16_t* WRL = WSP(bf16_t, WS_WRL) + (size_t)layer * 64 * 64 * 8; const float* rc = WSP(float, WS_RC) + layer * 64;
    unsigned* gcnt = WSP(unsigned, WS_CTL) + CW_CNT + 64 * cslot;
    int* lists = WSP(int, WS_LIST); int* slot = WSP(int, WS_SLOT); float* gate = WSP(float, WS_GATE);
    LAS float* part = (LAS float*)C.lds;
    volatile LAS int* lcnt = (volatile LAS int*)(C.lds + 69632);
    volatile LAS int* lbase = lcnt + 32;
    LAS float* stat = (LAS float*)(C.lds + 70144);
    f32x4 gv[4], bv[4];
#pragma unroll
    for (int j = 0; j < 2; ++j) { gv[2 * j] = *(const f32x4*)(g1 + 8 * C.lane + 512 * j); gv[2 * j + 1] = *(const f32x4*)(g1 + 8 * C.lane + 512 * j + 4);
        bv[2 * j] = *(const f32x4*)(b1 + 8 * C.lane + 512 * j); bv[2 * j + 1] = *(const f32x4*)(b1 + 8 * C.lane + 512 * j + 4); }
    unsigned char* X1Q = args.ws + WS_X1Q; int sexp;
    { float ag = 0.f, ab = 0.f;
#pragma unroll
      for (int j = 0; j < 4; ++j)
#pragma unroll
          for (int e = 0; e < 4; ++e) { ag = fmaxf(ag, fabsf(gv[j][e])); ab = fmaxf(ab, fabsf(bv[j][e])); }
#pragma unroll
      for (int o = 1; o < 64; o <<= 1) { ag = fmaxf(ag, __shfl_xor(ag, o)); ab = fmaxf(ab, __shfl_xor(ab, o)); }
      const float bound = 16.0f * ag + ab + 1e-20f;
      sexp = 134 - (int)((__float_as_uint(bound) >> 23) & 0xffu);
      sexp = sexp < -100 ? -100 : (sexp > 100 ? 100 : sexp);
      if (C.tid == 0) __hip_atomic_store(WSP(unsigned, WS_CTL) + CW_SA + layer, (unsigned)sexp, __ATOMIC_RELAXED, __HIP_MEMORY_SCOPE_AGENT); }
    const float qs = __uint_as_float((unsigned)(127 + sexp) << 23), qlo = KF(-448.f), qhi = KF(448.f);
    for (int chunk = C.vcu; chunk < T / 128; chunk += C.G) {
        const int row0 = chunk * 128;
        if (C.tid < 32) lcnt[C.tid] = 0;
        u32x4 yn[2];
#pragma unroll
        for (int j = 0; j < 2; ++j) yn[j] = *(const u32x4*)(Y + ((size_t)row0 + C.wave * 16) * DM + 8 * C.lane + 512 * j);
#pragma unroll 1
        for (int i = 0; i < 16; ++i) { const size_t row = (size_t)row0 + C.wave * 16 + i;
            f32x4 v[4]; float s = 0.f;
#pragma unroll
            for (int j = 0; j < 2; ++j) { const u32x4 w = yn[j]; v[2 * j] = pg8::bf4_lo(w); v[2 * j + 1] = pg8::bf4_hi(w); }
            { const size_t rn = i < 15 ? row + 1 : row;
#pragma unroll
              for (int j = 0; j < 2; ++j) yn[j] = *(const u32x4*)(Y + rn * DM + 8 * C.lane + 512 * j); }
#pragma unroll
            for (int j = 0; j < 4; ++j) s += (v[j][0] + v[j][1]) + (v[j][2] + v[j][3]);
            const float mean = wave_sum(s) * (1.f / DM); float s2 = 0.f;
#pragma unroll
            for (int j = 0; j < 4; ++j) { v[j] = v[j] - mean; s2 += (v[j][0] * v[j][0] + v[j][1] * v[j][1]) + (v[j][2] * v[j][2] + v[j][3] * v[j][3]); }
            const float rstd = 1.f / sqrtf(wave_sum(s2) * (1.f / DM) + KF(LN_EPS));
            if (C.lane == 0) { stat[(C.wave * 16 + i) * 2] = mean; stat[(C.wave * 16 + i) * 2 + 1] = rstd; }
#pragma unroll
            for (int j = 0; j < 4; ++j) v[j] = v[j] * rstd * gv[j] + bv[j];
#pragma unroll
            for (int j = 0; j < 2; ++j) { const u32x4 hw = pack8(v[2 * j], v[2 * j + 1]);
                *(u32x4*)(X1B + row * DM + 8 * C.lane + 512 * j) = hw;
                const f32x4 q0 = v[2 * j] * qs, q1 = v[2 * j + 1] * qs;
                int w0 = __builtin_amdgcn_cvt_pk_fp8_f32(fminf(fmaxf(q0[0], qlo), qhi), fminf(fmaxf(q0[1], qlo), qhi), 0, false); w0 = __builtin_amdgcn_cvt_pk_fp8_f32(fminf(fmaxf(q0[2], qlo), qhi), fminf(fmaxf(q0[3], qlo), qhi), w0, true);
                int w1 = __builtin_amdgcn_cvt_pk_fp8_f32(fminf(fmaxf(q1[0], qlo), qhi), fminf(fmaxf(q1[1], qlo), qhi), 0, false); w1 = __builtin_amdgcn_cvt_pk_fp8_f32(fminf(fmaxf(q1[2], qlo), qhi), fminf(fmaxf(q1[3], qlo), qhi), w1, true);
                *(u32x2*)(X1Q + row * DM + 8 * C.lane + 512 * j) = (u32x2){(unsigned)w0, (unsigned)w1}; } }
        asm volatile("s_waitcnt vmcnt(0)" ::: "memory");
        __syncthreads();
        { const int grp = C.wave >> 1, kh = C.wave & 1, r32 = C.lane & 31, hi = C.lane >> 5;
          const bf16_t* ah = Y + ((size_t)row0 + grp * 32 + r32) * DM + kh * 512 + hi * 8;
          const bf16_t* bh = WRH + ((size_t)kh * 32 * 64 + C.lane) * 8; const bf16_t* bl = WRL + ((size_t)kh * 32 * 64 + C.lane) * 8;
          f32x16 acc = {};
#pragma unroll 4
          for (int st = 0; st < 32; ++st) { const bf16x8 xh = *(const bf16x8*)(ah + st * 16), wh = *(const bf16x8*)(bh + (size_t)st * 512), wl = *(const bf16x8*)(bl + (size_t)st * 512);
              acc = __builtin_amdgcn_mfma_f32_32x32x16_bf16(xh, wh, acc, 0, 0, 0);
              acc = __builtin_amdgcn_mfma_f32_32x32x16_bf16(xh, wl, acc, 0, 0, 0); }
          LAS float* pp = part + (grp * 2 + kh) * 32 * 33 + r32;
#pragma unroll
          for (int r = 0; r < 16; ++r) pp[((r & 3) + 8 * (r >> 2) + 4 * hi) * 33] = acc[r]; }
        __syncthreads();
        int te[4] = {0, 0, 0, 0}, lp[4] = {0, 0, 0, 0}; float tg[4] = {0.f, 0.f, 0.f, 0.f};
        if (C.tid < 128) { const int grp = C.tid >> 5, ln = C.tid & 31; float lg[32];
            const float mean = stat[C.tid * 2], rstd = stat[C.tid * 2 + 1];
#pragma unroll
            for (int e = 0; e < 32; ++e) lg[e] = rstd * ((part[((grp * 2 + 0) * 32 + ln) * 33 + e] + part[((grp * 2 + 1) * 32 + ln) * 33 + e]) - mean * rc[e]) + rc[32 + e];
            float tv[4]; const float kninf = KF(-__builtin_inff());
#pragma unroll
            for (int k = 0; k < 4; ++k) { float best = lg[0]; int bi = 0;
#pragma unroll
                for (int e = 1; e < 32; ++e) { const bool gt = lg[e] > best; best = gt ? lg[e] : best; bi = gt ? e : bi; }
                te[k] = bi; tv[k] = best;
#pragma unroll
                for (int e = 0; e < 32; ++e) lg[e] = (e == bi) ? kninf : lg[e]; }
            float den = 0.f;
#pragma unroll
            for (int k = 0; k < 4; ++k) { tg[k] = __expf(tv[k] - tv[0]); den += tg[k]; }
            const float rden = 1.0f / den;
#pragma unroll
            for (int k = 0; k < 4; ++k) { tg[k] *= rden; lp[k] = __hip_atomic_fetch_add((LAS int*)&lcnt[te[k]], 1, __ATOMIC_RELAXED, __HIP_MEMORY_SCOPE_WORKGROUP); } }
        __syncthreads();
        if (C.tid < 32) lbase[C.tid] = (int)__hip_atomic_fetch_add(gcnt + C.tid, (unsigned)lcnt[C.tid], __ATOMIC_RELAXED, __HIP_MEMORY_SCOPE_AGENT);
        __syncthreads();
        if (C.tid < 128) { const int tok = row0 + C.tid;
#pragma unroll
            for (int k = 0; k < 4; ++k) { const int pos = lbase[te[k]] + lp[k]; lists[(size_t)te[k] * T + pos] = tok; slot[tok * 4 + k] = te[k] * T + pos; gate[tok * 4 + k] = tg[k]; } }
        __syncthreads();
    }
}

__device__ __forceinline__ void phase_combine_ln2(const CAS Args& args, const Ctx& C0, int layer) {
    Ctx C = C0; C.tid = opaque_tid(); C.lane = C.tid & 63;
    moe_table(args, C, layer);
    const bf16_t* X1B = WSP(bf16_t, WS_X1B); const unsigned char* YS = args.ws + WS_YS; const unsigned char* SY = args.ws + WS_SY; const int* slot = WSP(int, WS_SLOT); const float* gate = WSP(float, WS_GATE);
    bf16_t* X2B = WSP(bf16_t, WS_X2B); unsigned char* X2Q = args.ws + WS_X2Q;
    const float* g2 = INF(I_LN2G) + layer * DM; const float* b2 = INF(I_LN2B) + layer * DM;
    f32x4 gv[4], bv[4];
#pragma unroll
    for (int j = 0; j < 2; ++j) { gv[2 * j] = *(const f32x4*)(g2 + 8 * C.lane + 512 * j); gv[2 * j + 1] = *(const f32x4*)(g2 + 8 * C.lane + 512 * j + 4);
        bv[2 * j] = *(const f32x4*)(b2 + 8 * C.lane + 512 * j); bv[2 * j + 1] = *(const f32x4*)(b2 + 8 * C.lane + 512 * j + 4); }
    int sexp;
    { float ag = 0.f, ab = 0.f;
#pragma unroll
      for (int j = 0; j < 4; ++j)
#pragma unroll
          for (int e = 0; e < 4; ++e) { ag = fmaxf(ag, fabsf(gv[j][e])); ab = fmaxf(ab, fabsf(bv[j][e])); }
#pragma unroll
      for (int o = 1; o < 64; o <<= 1) { ag = fmaxf(ag, __shfl_xor(ag, o)); ab = fmaxf(ab, __shfl_xor(ab, o)); }
      const float bound = 16.0f * ag + ab + 1e-20f;
      sexp = 134 - (int)((__float_as_uint(bound) >> 23) & 0xffu); sexp = sexp < -100 ? -100 : (sexp > 100 ? 100 : sexp);
      if (C.tid == 0) __hip_atomic_store(WSP(unsigned, WS_CTL) + CW_SA2 + layer, (unsigned)sexp, __ATOMIC_RELAXED, __HIP_MEMORY_SCOPE_AGENT); }
    const float qs = __uint_as_float((unsigned)(127 + sexp) << 23), qlo = KF(-448.f), qhi = KF(448.f);
    const int gw = C.vcu * NWAVES + C.wave, NGW = C.G * NWAVES;
    for (int row = gw; row < T; row += 2 * NGW) {
        int sv[2][4]; float gt[2][4];
#pragma unroll
        for (int q = 0; q < 2; ++q) { const int r = (row + q * NGW < T) ? row + q * NGW : row;
#pragma unroll
            for (int k = 0; k < 4; ++k) { sv[q][k] = slot[r * 4 + k]; gt[q][k] = gate[r * 4 + k]; } }
        u32x4 xw[2][2]; u32x2 yw[2][4][2]; unsigned eb[2][4][2];
#pragma unroll
        for (int q = 0; q < 2; ++q) { const int r = (row + q * NGW < T) ? row + q * NGW : row;
#pragma unroll
            for (int j = 0; j < 2; ++j) xw[q][j] = *(const u32x4*)(X1B + (size_t)r * DM + 8 * C.lane + 512 * j);
#pragma unroll
            for (int k = 0; k < 4; ++k) { const int e = sv[q][k] >> 15, pos = sv[q][k] & (T - 1); const size_t prow = (size_t)C.misc[16 + e] * 256 + pos;
#pragma unroll
                for (int j = 0; j < 2; ++j) { yw[q][k][j] = *(const u32x2*)(YS + prow * DM + 8 * C.lane + 512 * j); eb[q][k][j] = SY[prow * 32 + (C.lane >> 2) + 16 * j]; } } }
#pragma unroll
        for (int q = 0; q < 2; ++q) { const int r = row + q * NGW; if (r >= T) break;
            f32x4 v[4];
#pragma unroll
            for (int j = 0; j < 2; ++j) { v[2 * j] = pg8::bf4_lo(xw[q][j]) * ALPHA; v[2 * j + 1] = pg8::bf4_hi(xw[q][j]) * ALPHA; }
#pragma unroll
            for (int k = 0; k < 4; ++k)
#pragma unroll
                for (int j = 0; j < 2; ++j) { const u32x2 w = yw[q][k][j]; const float gs = gt[q][k] * __uint_as_float(eb[q][k][j] << 23);
                    const f32x2 a = __builtin_amdgcn_cvt_pk_f32_fp8((int)w.x, false), b = __builtin_amdgcn_cvt_pk_f32_fp8((int)w.x, true), c = __builtin_amdgcn_cvt_pk_f32_fp8((int)w.y, false), d = __builtin_amdgcn_cvt_pk_f32_fp8((int)w.y, true);
                    v[2 * j] += (f32x4){a[0], a[1], b[0], b[1]} * gs; v[2 * j + 1] += (f32x4){c[0], c[1], d[0], d[1]} * gs; }
            float s = 0.f;
#pragma unroll
            for (int j = 0; j < 4; ++j) s += (v[j][0] + v[j][1]) + (v[j][2] + v[j][3]);
            const float mean = wave_sum(s) * (1.f / DM); float s2 = 0.f;
#pragma unroll
            for (int j = 0; j < 4; ++j) { v[j] = v[j] - mean; s2 += (v[j][0] * v[j][0] + v[j][1] * v[j][1]) + (v[j][2] * v[j][2] + v[j][3] * v[j][3]); }
            const float rstd = 1.f / sqrtf(wave_sum(s2) * (1.f / DM) + KF(LN_EPS));
#pragma unroll
            for (int j = 0; j < 4; ++j) v[j] = v[j] * rstd * gv[j] + bv[j];
#pragma unroll
            for (int j = 0; j < 2; ++j) { *(u32x4*)(X2B + (size_t)r * DM + 8 * C.lane + 512 * j) = pack8(v[2 * j], v[2 * j + 1]);
                const f32x4 q0 = v[2 * j] * qs, q1 = v[2 * j + 1] * qs;
                int w0 = __builtin_amdgcn_cvt_pk_fp8_f32(fminf(fmaxf(q0[0], qlo), qhi), fminf(fmaxf(q0[1], qlo), qhi), 0, false); w0 = __builtin_amdgcn_cvt_pk_fp8_f32(fminf(fmaxf(q0[2], qlo), qhi), fminf(fmaxf(q0[3], qlo), qhi), w0, true);
                int w1 = __builtin_amdgcn_cvt_pk_fp8_f32(fminf(fmaxf(q1[0], qlo), qhi), fminf(fmaxf(q1[1], qlo), qhi), 0, false); w1 = __builtin_amdgcn_cvt_pk_fp8_f32(fminf(fmaxf(q1[2], qlo), qhi), fminf(fmaxf(q1[3], qlo), qhi), w1, true);
                *(u32x2*)(X2Q + (size_t)r * DM + 8 * C.lane + 512 * j) = (u32x2){(unsigned)w0, (unsigned)w1}; } }
    }
}

__device__ __forceinline__ void phase_conv(const CAS Args& args, const Ctx& C0, int j) {
    Ctx C = C0; C.tid = opaque_tid(); C.lane = C.tid & 63;
    const bf16_t* U = WSP(bf16_t, WS_U); bf16_t* UC = WSP(bf16_t, WS_UC);
    const float* cw = INF(I_LRU_CW) + (size_t)j * 4 * DM; const float* cb = INF(I_LRU_CB) + (size_t)j * DM;
    const int c8 = (C.tid & 127) * 8, rsub = C.tid >> 7;
    float w[4][8], bb[8];
#pragma unroll
    for (int q = 0; q < 4; ++q)
#pragma unroll
        for (int e = 0; e < 8; ++e) w[q][e] = cw[q * DM + c8 + e];
#pragma unroll
    for (int e = 0; e < 8; ++e) bb[e] = cb[c8 + e];
    for (int chunk = C.vcu; chunk < T / 128; chunk += C.G) {
        const int r0 = chunk * 128 + rsub * 32;
        u32x4 h0, h1, h2;
        const u32x4 z = {0u, 0u, 0u, 0u};
        const int s0 = r0 & (SEQ - 1);
        h0 = s0 >= 3 ? *(const u32x4*)(U + (size_t)(r0 - 3) * DM + c8) : z; h1 = s0 >= 2 ? *(const u32x4*)(U + (size_t)(r0 - 2) * DM + c8) : z; h2 = s0 >= 1 ? *(const u32x4*)(U + (size_t)(r0 - 1) * DM + c8) : z;
#pragma unroll 4
        for (int i = 0; i < 32; ++i) { const u32x4 h3 = *(const u32x4*)(U + (size_t)(r0 + i) * DM + c8);
            float o[8];
#pragma unroll
            for (int q = 0; q < 4; ++q) { const unsigned a = h0[q], b = h1[q], c = h2[q], d = h3[q];
                o[2 * q] = bb[2 * q] + w[0][2 * q] * bf_lo(a) + w[1][2 * q] * bf_lo(b) + w[2][2 * q] * bf_lo(c) + w[3][2 * q] * bf_lo(d);
                o[2 * q + 1] = bb[2 * q + 1] + w[0][2 * q + 1] * bf_hi(a) + w[1][2 * q + 1] * bf_hi(b) + w[2][2 * q + 1] * bf_hi(c) + w[3][2 * q + 1] * bf_hi(d); }
            u32x4 ow; ow.x = cvt_pk_bf16(o[0], o[1]); ow.y = cvt_pk_bf16(o[2], o[3]); ow.z = cvt_pk_bf16(o[4], o[5]); ow.w = cvt_pk_bf16(o[6], o[7]);
            *(u32x4*)(UC + (size_t)(r0 + i) * DM + c8) = ow; h0 = h1; h1 = h2; h2 = h3; }
    }
}
__device__ __forceinline__ void phase_scan1(const CAS Args& args, const Ctx& C0) {
    Ctx C = C0; C.tid = opaque_tid(); C.lane = C.tid & 63;
    const bf16_t* LA = WSP(bf16_t, WS_AA); const bf16_t* BB = WSP(bf16_t, WS_BB); float* CA = WSP(float, WS_CA); float* CH = WSP(float, WS_CH);
    const int c2 = C.tid * 2;
    for (int item = C.vcu; item < NBATCH * 64; item += C.G) {
        const size_t r0 = (size_t)item * 64; float h0 = 0.f, h1 = 0.f, l0 = 0.f, l1 = 0.f;
#pragma unroll 8
        for (int s = 0; s < 64; ++s) { const unsigned aw = *(const unsigned*)(LA + (r0 + s) * DM + c2), bw = *(const unsigned*)(BB + (r0 + s) * DM + c2);
            const float la0 = bf_lo(aw), la1 = bf_hi(aw);
            h0 = __builtin_amdgcn_exp2f(la0) * h0 + bf_lo(bw); h1 = __builtin_amdgcn_exp2f(la1) * h1 + bf_hi(bw); l0 += la0; l1 += la1; }
        *(f32x2*)(CA + (size_t)item * DM + c2) = (f32x2){__builtin_amdgcn_exp2f(l0), __builtin_amdgcn_exp2f(l1)}; *(f32x2*)(CH + (size_t)item * DM + c2) = (f32x2){h0, h1};
    }
}
__device__ __forceinline__ void phase_scan2(const CAS Args& args, const Ctx& C0) {
    Ctx C = C0; C.tid = opaque_tid(); C.lane = C.tid & 63;
    const bf16_t* LA = WSP(bf16_t, WS_AA); const bf16_t* BB = WSP(bf16_t, WS_BB); const float* CA = WSP(float, WS_CA); const float* CH = WSP(float, WS_CH);
    const bf16_t* GG = WSP(bf16_t, WS_GG); bf16_t* YL = WSP(bf16_t, WS_O);
    const int c2 = C.tid * 2;
    for (int item = C.vcu; item < NBATCH * 64; item += C.G) {
        const int b = item >> 6, ch = item & 63; float h0 = 0.f, h1 = 0.f;
#pragma unroll 8
        for (int jx = 0; jx < ch; ++jx) { const f32x2 a = *(const f32x2*)(CA + (size_t)(b * 64 + jx) * DM + c2), e = *(const f32x2*)(CH + (size_t)(b * 64 + jx) * DM + c2);
            h0 = a[0] * h0 + e[0]; h1 = a[1] * h1 + e[1]; }
        const size_t r0 = (size_t)item * 64;
#pragma unroll 8
        for (int s = 0; s < 64; ++s) { const unsigned aw = *(const unsigned*)(LA + (r0 + s) * DM + c2), bw = *(const unsigned*)(BB + (r0 + s) * DM + c2), g = *(const unsigned*)(GG + (r0 + s) * DM + c2);
            h0 = __builtin_amdgcn_exp2f(bf_lo(aw)) * h0 + bf_lo(bw); h1 = __builtin_amdgcn_exp2f(bf_hi(aw)) * h1 + bf_hi(bw);
            *(unsigned*)(YL + (r0 + s) * DM + c2) = cvt_pk_bf16(bf_lo(g) * h0, bf_hi(g) * h1); }
    }
}

#if PROBE_T
typedef int v8i_t __attribute__((ext_vector_type(8)));
__device__ __forceinline__ unsigned fp8_of_int(int v) { const unsigned char t[4] = {0x00, 0x38, 0x40, 0x44}; const int a = v < 0 ? -v : v; return (unsigned)t[a] | (v < 0 ? 0x80u : 0u); }
__device__ __forceinline__ int tA(int i, int k) { return ((i * 3 + k * 5) % 7) - 3; }
__device__ __forceinline__ int tB(int k, int j) { return ((k * 2 + j * 7) % 5) - 2; }
__device__ __forceinline__ void mfma_fp8_selftest(unsigned* flagw) {
    const int l = threadIdx.x & 63, r = l & 15, q = l >> 4;
    v8i_t A, B;
#pragma unroll
    for (int d = 0; d < 8; ++d) { unsigned wa = 0, wb = 0;
#pragma unroll
        for (int b = 0; b < 4; ++b) { const int k = 32 * q + 4 * d + b; wa |= fp8_of_int(tA(r, k)) << (8 * b); wb |= fp8_of_int(tB(k, r)) << (8 * b); }
        A[d] = (int)wa; B[d] = (int)wb; }
    const f32x4 z = {0.f, 0.f, 0.f, 0.f};
    const int U = 0x7f7f7f7f;
    const int saq = (127 + q) * 0x01010101;
    const int sab = (q == 0) ? (int)0x8281807fu : U;
    const f32x4 m2 = __builtin_amdgcn_mfma_scale_f32_16x16x128_f8f6f4(A, B, z, 0, 0, 0, saq, 0, U);
    const f32x4 m5 = __builtin_amdgcn_mfma_scale_f32_16x16x128_f8f6f4(A, B, z, 0, 0, 0, sab, 0, U);
    bool k1 = true, k2 = true, k3 = true, k4 = true;
#pragma unroll
    for (int e = 0; e < 4; ++e) { const int i = 4 * q + e, j = r; float eb = 0.f, e0 = 0.f, ec = 0.f, ed = 0.f;
        for (int kq = 0; kq < 4; ++kq) for (int hh = 0; hh < 2; ++hh) { float sh = 0.f; for (int k = 32 * kq + 16 * hh; k < 32 * kq + 16 * hh + 16; ++k) sh += (float)(tA(i, k) * tB(k, j));
            const int xb = hh == 0 ? (kq >> 1) : 2 + (kq >> 1);
            eb += sh * (float)(1 << xb); e0 += sh; ec += sh * (float)(1 << kq); ed += sh * (float)(1 << xb); }
        k1 = k1 && (m2[e] == eb); k2 = k2 && (m2[e] == e0); k3 = k3 && (m5[e] == ec); k4 = k4 && (m5[e] == ed); }
    const bool b1 = __all(k1), b2 = __all(k2), b3 = __all(k3), b4 = __all(k4);
    if (l == 0) *flagw = (b1 ? 1u : 0u) | (b2 ? 2u : 0u) | (b3 ? 4u : 0u) | (b4 ? 8u : 0u);
}
#endif
constexpr int PH_PER_LAYER = 12, PH_TOTAL = 2 + PH_PER_LAYER * DEPTH;
__global__ void __launch_bounds__(NWAVES * 64, 2) fwd_kernel(Args args_kernarg) {
    (void)args_kernarg;
    ArgsP const argp = (ArgsP)__builtin_amdgcn_kernarg_segment_ptr();
    const CAS Args& args0 = *argp;
    extern __shared__ __attribute__((aligned(16))) unsigned char lds_raw[];
    Ctx C_;
    C_.lds = (LAS unsigned char*)lds_raw; C_.misc = (volatile LAS int*)(C_.lds + MISC_OFF);
    C_.tid = threadIdx.x; C_.lane = C_.tid & 63; C_.wave = __builtin_amdgcn_readfirstlane(C_.tid >> 6);
    C_.bid = (int)blockIdx.x; C_.G = gridDim.x; { const int bx = blockIdx.x; C_.vcu = (C_.G % 8 == 0) ? (bx % 8) * (C_.G / 8) + bx / 8 : bx; }
    for (int u = C_.tid; u < 128; u += NWAVES * 64) C_.misc[u] = 0;
    __syncthreads();
    XcdBarrier bar = xcd_barrier_post((unsigned*)(args0.ws + WS_CTL) + CW_BAR + args0.li * XCD_BAR_WORDS, (volatile LAS unsigned*)C_.misc);
    const int lo = args0.ph_lo, hi = args0.ph_hi;
#define IN(k) (lo <= (k) && (k) < hi)
#define PH_END(k) do { if ((k) + 1 < hi) xcd_barrier(bar); } while (0)

    if (SEL(0) && IN(0)) { const CAS Args& args = fresh_args(argp); const Ctx C = fresh_ctx(C_); const int cid = C.bid; phase_prologue(args, C); PH_END(0); }
    if (SEL(1) && IN(1)) { const CAS Args& args = fresh_args(argp); const Ctx C = fresh_ctx(C_); const int cid = C.bid;
        typedef pg8::DenseSched<DEPTH * T / 256, 4> DS; DS S; S.init(WSP(bf16_t, WS_PB), WSP(bf16_t, WS_W_PLE + OFF_PLE_WP), PLED, PLED, C.G, cid); S.bpm_shift = 7; S.bbatch = W_PLE_STRIDE;
        pg8::EpiPP E{WSP(bf16_t, WS_PP)};
        pg8::gemm_phase<pg8::EpiPP, DS, false>(C.lds, PLED / 64, PLED * 2, PLED * 2, S, E);
        if (MK_ONE_LAUNCH == 0) PH_END(1);
    }
    for (int layer = 0; layer < DEPTH; ++layer) {
        const int base = 2 + PH_PER_LAYER * layer, j = layer >> 1;
        if ((layer & 1) == 0) {
            if (SEL(2) && IN(base + 0)) { const CAS Args& args = fresh_args(argp); const Ctx C = fresh_ctx(C_); const int cid = C.bid; const unsigned char* wm = args.ws + WS_W_MLA + (size_t)j * W_MLA_STRIDE;
                typedef pg8::DenseSched<T / 256, 5> DS; DS S; S.init(WSP(bf16_t, WS_XB), wm + OFF_MLA_WIN, DM, DM, C.G, cid);
                pg8::EpiLat E{WSP(bf16_t, WS_LAT), WSP(float, WS_SSQ), WSP(bf16_t, WS_KR), WSP(float, WS_CS), WSP(float, WS_SN)};
                pg8::gemm_phase<pg8::EpiLat, DS, false>(C.lds, DM / 64, DM * 2, DM * 2, S, E);
                PH_END(base + 0);
            }
            if (SEL(3) && IN(base + 1)) { const CAS Args& args = fresh_args(argp); const Ctx C = fresh_ctx(C_); const int cid = C.bid; const unsigned char* wm = args.ws + WS_W_MLA + (size_t)j * W_MLA_STRIDE;
                { typedef pg8::DenseSched<T / 256, 6> DS; DS S; S.init(WSP(bf16_t, WS_LAT), wm + OFF_MLA_WUQ, DM, QL, C.G, cid);
                  pg8::EpiQ E{WSP(bf16_t, WS_Q), WSP(float, WS_SSQ), WSP(float, WS_CS), WSP(float, WS_SN)};
                  pg8::gemm_phase<pg8::EpiQ, DS, false>(C.lds, QL / 64, DM * 2, QL * 2, S, E); }
                { typedef pg8::DenseSched<T / 256, 8> DS; DS S; S.init(WSP(bf16_t, WS_LAT) + QL, wm + OFF_MLA_WUKV, DM, KVL, C.G, cid);
                  pg8::EpiKV E{WSP(bf16_t, WS_KN), WSP(bf16_t, WS_V), WSP(float, WS_SSQ)};
                  pg8::gemm_phase<pg8::EpiKV, DS, false>(C.lds, KVL / 64, DM * 2, KVL * 2, S, E); }
                PH_END(base + 1);
            }
            if (SEL(4) && IN(base + 2)) { const CAS Args& args = fresh_args(argp); const Ctx C = fresh_ctx(C_); const int cid = C.bid;
                for (int it = C.vcu; it < NBATCH * NH * 8; it += C.G) { const int bh = it >> 3, pr = it & 7;
                    att::attn_block(bh >> 3, bh & 7, pr, WSP(bf16_t, WS_Q), WSP(bf16_t, WS_KN), WSP(bf16_t, WS_KR), WSP(bf16_t, WS_V), WSP(bf16_t, WS_O), (LAS char*)C.lds, PROBE_T ? (unsigned long long*)(args.ws + WS_CTL + 8192) : nullptr);
                    att::attn_block(bh >> 3, bh & 7, 15 - pr, WSP(bf16_t, WS_Q), WSP(bf16_t, WS_KN), WSP(bf16_t, WS_KR), WSP(bf16_t, WS_V), WSP(bf16_t, WS_O), (LAS char*)C.lds, PROBE_T ? (unsigned long long*)(args.ws + WS_CTL + 8192) : nullptr); }
                PH_END(base + 2);
            }
        } else {
            if (SEL(5) && IN(base + 0)) { const CAS Args& args = fresh_args(argp); const Ctx C = fresh_ctx(C_); const int cid = C.bid; const unsigned char* wl = args.ws + WS_W_LRU + (size_t)j * W_LRU_STRIDE;
                typedef pg8::DenseSched<T / 256, 8> DS; DS S; S.init(WSP(bf16_t, WS_XB), wl + OFF_LRU_WIN, DM, DM, C.G, cid);
                pg8::EpiGU E{WSP(bf16_t, WS_GG), WSP(bf16_t, WS_U)};
                pg8::gemm_phase<pg8::EpiGU, DS, false>(C.lds, DM / 64, DM * 2, DM * 2, S, E);
                PH_END(base + 0);
            }
            if (SEL(6) && IN(base + 1)) { const CAS Args& args = fresh_args(argp); const Ctx C = fresh_ctx(C_); const int cid = C.bid; phase_conv(args, C, j); PH_END(base + 1); }
            if (SEL(7) && IN(base + 2)) { const CAS Args& args = fresh_args(argp); const Ctx C = fresh_ctx(C_); const int cid = C.bid; const unsigned char* wl = args.ws + WS_W_LRU + (size_t)j * W_LRU_STRIDE;
                typedef pg8::DenseSched<T / 256, 8> DS; DS S; S.init(WSP(bf16_t, WS_UC), wl + OFF_LRU_WAX, DM, 256, C.G, cid); S.apn_shift = 1; S.akbytes = 512;
                pg8::EpiAB E{WSP(bf16_t, WS_AA), WSP(bf16_t, WS_BB), WSP(bf16_t, WS_UC), INF(I_LRU_BA) + j * DM, INF(I_LRU_BX) + j * DM, WSP(float, WS_SPL) + j * DM};
                pg8::gemm_phase<pg8::EpiAB, DS, false>(C.lds, 4, DM * 2, 512, S, E);
                PH_END(base + 2);
            }
            if (SEL(8) && IN(base + 3)) { const CAS Args& args = fresh_args(argp); const Ctx C = fresh_ctx(C_); const int cid = C.bid; phase_scan1(args, C); PH_END(base + 3); }
            if (SEL(9) && IN(base + 4)) { const CAS Args& args = fresh_args(argp); const Ctx C = fresh_ctx(C_); const int cid = C.bid; phase_scan2(args, C); PH_END(base + 4); }
        }
        if (SEL(10) && IN(base + 5)) { const CAS Args& args = fresh_args(argp); const Ctx C = fresh_ctx(C_); const int cid = C.bid;
            const unsigned char* wo = (layer & 1) ? args.ws + WS_W_LRU + (size_t)j * W_LRU_STRIDE + OFF_LRU_WOUT : args.ws + WS_W_MLA + (size_t)j * W_MLA_STRIDE + OFF_MLA_WO;
            typedef pg8::DenseSched<T / 256, 4> DS; DS S; S.init(WSP(bf16_t, WS_O), wo, DM, DM, C.G, cid);
            pg8::EpiRes E{WSP(bf16_t, WS_XB), WSP(bf16_t, WS_Y)};
            pg8::gemm_phase<pg8::EpiRes, DS, false>(C.lds, DM / 64, DM * 2, DM * 2, S, E);
            PH_END(base + 5);
        }
        if (SEL(11) && IN(base + 6)) { const CAS Args& args = fresh_args(argp); const Ctx C = fresh_ctx(C_); const int cid = C.bid; phase_ln_router(args, C, layer); PH_END(base + 6); }
        if (SEL(12) && IN(base + 7)) { const CAS Args& args = fresh_args(argp); const Ctx C = fresh_ctx(C_); const int cid = C.bid;
            moe_table(args, C, layer);
            pg8::MoeSched S{(const char*)(args.ws + WS_X1Q), (const char*)(args.ws + WS_W_UP + (size_t)layer * NE * 2048 * 1024), (size_t)2048 * 1024, (const char*)(args.ws + WS_SW + (size_t)layer * NE * 65536), DM, DM, 8, WSP(int, WS_LIST), C.misc + 16, (volatile LAS const unsigned char*)(C.lds + TILE_E_OFF), C.G, cid, true, nullptr};
            const int sae = 127 - (int)__hip_atomic_load(WSP(unsigned, WS_CTL) + CW_SA + layer, __ATOMIC_RELAXED, __HIP_MEMORY_SCOPE_AGENT);
            pg8::EpiUp E{args.ws + WS_H, args.ws + WS_SH, INF(I_MOE_BUP) + (size_t)layer * NE * 2048};
            pg8::gemm_phase<pg8::EpiUp, pg8::MoeSched, true, 1>(C.lds, DM / 128, DM, DM, S, E, PROBE_T ? (unsigned long long*)(args.ws + WS_CTL + 8192) : nullptr, sae * 0x01010101);
            PH_END(base + 7);
        }
        if (SEL(13) && IN(base + 8)) { const CAS Args& args = fresh_args(argp); const Ctx C = fresh_ctx(C_); const int cid = C.bid;
            moe_table(args, C, layer);
            pg8::MoeSched S{(const char*)(args.ws + WS_H), (const char*)(args.ws + WS_W_DN + (size_t)layer * NE * 1024 * 1024), (size_t)1024 * 1024, (const char*)(args.ws + WS_SWD + (size_t)layer * NE * 16384), DFF, DFF, 4, WSP(int, WS_LIST), C.misc + 16, (volatile LAS const unsigned char*)(C.lds + TILE_E_OFF), C.G, cid, false, (const char*)(args.ws + WS_SH)};
            pg8::EpiDown E{args.ws + WS_YS, args.ws + WS_SY, INF(I_MOE_BDN) + (size_t)layer * NE * DM};
            pg8::gemm_phase<pg8::EpiDown, pg8::MoeSched, false, 2>(C.lds, DFF / 128, DFF, DFF, S, E);
            PH_END(base + 8);
        }
        if (SEL(14) && IN(base + 9)) { const CAS Args& args = fresh_args(argp); const Ctx C = fresh_ctx(C_); const int cid = C.bid; phase_combine_ln2(args, C, layer); PH_END(base + 9); }
        if (SEL(15) && IN(base + 10)) { const CAS Args& args = fresh_args(argp); const Ctx C = fresh_ctx(C_); const int cid = C.bid;
            typedef pg8::DenseSched<T / 256, 4> DS; DS S; S.init(args.ws + WS_X2Q, args.ws + WS_W_PLE + (size_t)layer * W_PLE_STRIDE + OFF_PLE_WG, DM / 2, DM / 2, C.G, cid); S.SW = (const char*)(args.ws + WS_SWG + (size_t)layer * 65536);
            const int sae = 127 - (int)__hip_atomic_load(WSP(unsigned, WS_CTL) + CW_SA2 + layer, __ATOMIC_RELAXED, __HIP_MEMORY_SCOPE_AGENT);
            pg8::EpiPle E{WSP(bf16_t, WS_X2B), WSP(bf16_t, WS_PP) + (size_t)layer * T * DM, layer == DEPTH - 1 ? args.out : (float*)nullptr, WSP(bf16_t, WS_XB)};
            pg8::gemm_phase<pg8::EpiPle, DS, false, 1>(C.lds, DM / 128, DM, DM, S, E, nullptr, sae * 0x01010101);
            if (layer + 1 < DEPTH) PH_END(base + 10);
        }
    }
#if PROBE_T
    if (PROBE_T == 20 && blockIdx.x == 0 && threadIdx.x < 64) { const CAS Args& args = fresh_args(argp); mfma_fp8_selftest((unsigned*)(args.ws + WS_CTL + 8192 + 256)); }
    { xcd_barrier(bar); const CAS Args& args = fresh_args(argp);
      const unsigned long long* pw = (const unsigned long long*)(args.ws + WS_CTL + 8192);
      const double pk = (double)__hip_atomic_load(pw + 0, __ATOMIC_RELAXED, __HIP_MEMORY_SCOPE_AGENT), pe = (double)__hip_atomic_load(pw + 1, __ATOMIC_RELAXED, __HIP_MEMORY_SCOPE_AGENT),
                   pn = (double)__hip_atomic_load(pw + 2, __ATOMIC_RELAXED, __HIP_MEMORY_SCOPE_AGENT), pt = (double)__hip_atomic_load(pw + 3, __ATOMIC_RELAXED, __HIP_MEMORY_SCOPE_AGENT);
      float c = 100.f;
      if (PROBE_T == 2) c = (float)(pk / (pn * 16.0) / 10.0);
      if (PROBE_T == 3) c = (float)(pe / pn / 100.0);
      if (PROBE_T == 4) c = (float)((pt - pk - pe) / pn / 100.0);
      if (PROBE_T == 5) c = (float)(pn);
      if (PROBE_T >= 10) { double q[7]; for (int i = 0; i < 7; ++i) q[i] = (double)__hip_atomic_load(pw + 8 + i, __ATOMIC_RELAXED, __HIP_MEMORY_SCOPE_AGENT);
          if (PROBE_T == 10) c = (float)(q[6] / q[5] / 10.0);
          if (PROBE_T == 11) c = (float)(q[0] / q[5] / 10.0);
          if (PROBE_T == 12) c = (float)(q[1] / q[5] / 10.0);
          if (PROBE_T == 13) c = (float)(q[2] / q[5] / 10.0);
          if (PROBE_T == 14) c = (float)(q[3] / q[5] / 10.0);
          if (PROBE_T == 15) c = (float)(q[4] / q[5] / 10.0); }
      if (PROBE_T >= 2 && PROBE_T < 20) c = exp2f(floorf(log2f(c) * 8.0f + PROBE_SHIFT) * 0.125f);
      if (PROBE_T == 20) { const unsigned fl = __hip_atomic_load((const unsigned*)(args.ws + WS_CTL + 8192 + 256), __ATOMIC_RELAXED, __HIP_MEMORY_SCOPE_AGENT); c = 100.f + 10.f * (float)fl; }
      for (size_t i = (size_t)blockIdx.x * 512 + threadIdx.x; i < (size_t)T * DM; i += (size_t)gridDim.x * 512) args.out[i] = c; }
#endif
#undef IN
#undef PH_END
}

extern "C" void kernel_launch(void* const* d_in, const int* in_sizes, int n_in, void* d_out, int out_size, void* d_ws, size_t ws_size, hipStream_t stream) {
    static int grid = 0;
    if (grid == 0) {
        if (n_in != 30 || in_sizes[0] != T * DM || out_size != T * DM || ws_size < WS_END) { fprintf(stderr, "kernel_launch: unexpected shapes (n_in %d, in0 %d, out %d, ws %zu)\n", n_in, n_in > 0 ? in_sizes[0] : -1, out_size, ws_size); grid = -1; return; }
        int dev = 0, cus = 0, per_cu = 0;
        if (hipGetDevice(&dev) != hipSuccess || hipDeviceGetAttribute(&cus, hipDeviceAttributeMultiprocessorCount, dev) != hipSuccess) { grid = -1; return; }
        if (hipFuncSetAttribute((const void*)fwd_kernel, hipFuncAttributeMaxDynamicSharedMemorySize, LDS_BYTES) != hipSuccess) { fprintf(stderr, "kernel_launch: hipFuncSetAttribute failed\n"); grid = -1; return; }
        if (hipOccupancyMaxActiveBlocksPerMultiprocessor(&per_cu, (const void*)fwd_kernel, NWAVES * 64, LDS_BYTES) != hipSuccess || per_cu < 1) fprintf(stderr, "kernel_launch: occupancy query reports %d\n", per_cu);
        (void)hipGetLastError();
        grid = cus;
    }
    if (grid < 0) return;
    if (hipMemsetAsync((char*)d_ws + WS_CTL, 0, CTL_ZERO_BYTES, stream) != hipSuccess) return;
    Args a{};
    for (int i = 0; i < 30; ++i) a.in[i] = d_in[i];
    a.out = (float*)d_out; a.ws = (unsigned char*)d_ws; a.pad = 0;
#if MK_ONE_LAUNCH
    a.ph_lo = 0; a.ph_hi = PH_TOTAL; a.li = 0;
    hipLaunchKernelGGL(fwd_kernel, dim3(grid), dim3(NWAVES * 64), LDS_BYTES, stream, a);
#else
    int li = 0;
    for (int ph = 0; ph < PH_TOTAL; ++ph) {
        if (ph >= 2) { const int l = (ph - 2) / PH_PER_LAYER, k = (ph - 2) % PH_PER_LAYER; if (k == 11) continue; if ((l & 1) == 0 && (k == 3 || k == 4)) continue; }
        int site = ph;
        if (ph >= 2) { const int l = (ph - 2) / PH_PER_LAYER, k = (ph - 2) % PH_PER_LAYER; static const int mla[11] = {2, 3, 4, -1, -1, 10, 11, 12, 13, 14, 15}, lru[11] = {5, 6, 7, 8, 9, 10, 11, 12, 13, 14, 15}; site = (l & 1) ? lru[k] : mla[k]; }
        a.ph_lo = ph; a.ph_hi = ph + 1;
        if ((HOSTDUP >> site) & 1) { a.li = li++; a.pad = 4; hipLaunchKernelGGL(fwd_kernel, dim3(grid), dim3(NWAVES * 64), LDS_BYTES, stream, a); }
        a.li = li++; a.pad = 0;
        hipLaunchKernelGGL(fwd_kernel, dim3(grid), dim3(NWAVES * 64), LDS_BYTES, stream, a);
    }
#endif
}
```

```cpp
#include <hip/hip_runtime.h>
#include <hip/hip_bf16.h>
#include <cstdio>
#include <cstdint>

#ifndef PHSEL
#define PHSEL -1
#endif
#ifndef PHSKIP
#define PHSKIP -1
#endif
#define SEL(id) ((PHSEL < 0 || PHSEL == (id)) && PHSKIP != (id))
#ifndef PROBE_T
#define PROBE_T 0
#endif
#ifndef PROBE_SHIFT
#define PROBE_SHIFT 0.0f
#endif
#ifndef HOSTDUP
#define HOSTDUP 0
#endif
#ifndef HOSTDUP_R
#define HOSTDUP_R 1
#endif
#ifndef ROUTER_SKIP
#define ROUTER_SKIP 0
#endif
#ifndef CNT_STRIDE
#define CNT_STRIDE 32
#endif
#ifndef MK_ONE_LAUNCH
#define MK_ONE_LAUNCH 1
#endif

constexpr int T = 32768, SEQ = 4096, NBATCH = 8, DM = 1024, DEPTH = 4;
constexpr int QL = 768, KVL = 256, ROPE = 64, LATD = 1088, NH = 8, DQK = 192, DV = 128;
constexpr int NE = 32, TOPK = 4, DFF = 1024, PLED = 256;
constexpr float ALPHA = 1.681792830507429f;
constexpr float LN_EPS = 1e-5f, RMS_EPS = 1e-6f;
constexpr float QSCALE = 1.4426950408889634f / 13.856406460551018f;
constexpr int NWAVES = 8;

constexpr size_t MiB = 1u << 20;
constexpr size_t WS_CTL = 0, CTL_ZERO_BYTES = 2 * MiB;
constexpr size_t WS_CS = 2 * MiB, WS_SN = 6 * MiB, WS_SPL = 10 * MiB;
constexpr size_t WS_WRH = WS_SPL + 65536, WS_WRL = WS_WRH + 262144;
constexpr size_t WS_RC = WS_SPL + 16384;
constexpr size_t WS_W_MLA = 12 * MiB, W_MLA_STRIDE = 8 * MiB;
constexpr size_t OFF_MLA_WIN = 0, OFF_MLA_WUQ = 2560 * 1024, OFF_MLA_WUKV = OFF_MLA_WUQ + 2304 * 1024, OFF_MLA_WO = OFF_MLA_WUKV + 1024 * 1024;
constexpr size_t WS_W_LRU = 28 * MiB, W_LRU_STRIDE = 8 * MiB;
constexpr size_t OFF_LRU_WIN = 0, OFF_LRU_WAX = 4 * MiB, OFF_LRU_WOUT = 5 * MiB;
constexpr size_t WS_W_PLE = 44 * MiB, W_PLE_STRIDE = 3 * MiB;
constexpr size_t OFF_PLE_WG = 0, OFF_PLE_WP = 2 * MiB;
constexpr size_t WS_W_UP = 56 * MiB;
constexpr size_t WS_W_DN = 568 * MiB;
constexpr size_t WS_XB = 824 * MiB, WS_PB = 888 * MiB, WS_PP = 952 * MiB;
constexpr size_t WS_Y = 1208 * MiB, WS_X1 = 1336 * MiB, WS_X1B = 1464 * MiB, WS_X2 = 1528 * MiB, WS_X2B = 1656 * MiB;
constexpr size_t WS_LAT = 1720 * MiB, WS_KR = 1784 * MiB, WS_SSQ = 1788 * MiB, WS_Q = 1790 * MiB, WS_KN = 1886 * MiB, WS_V = 1950 * MiB, WS_O = 2014 * MiB;
constexpr size_t WS_GG = 2078 * MiB, WS_U = 2142 * MiB, WS_UC = 2206 * MiB, WS_AA = 2270 * MiB, WS_BB = 2398 * MiB, WS_CA = 2526 * MiB, WS_CH = 2528 * MiB;
constexpr size_t WS_H = 2530 * MiB, WS_YS = 2802 * MiB, WS_LIST = 3074 * MiB, WS_SLOT = 3078 * MiB, WS_GATE = 3079 * MiB, WS_SW = 3080 * MiB  , WS_X1Q = 3088 * MiB  , WS_SH = 3120 * MiB  ,
                 WS_SWD = 3128 * MiB  , WS_SY = 3132 * MiB  , WS_X2Q = 3140 * MiB  , WS_SWG = 3172 * MiB  , WS_END = 3174 * MiB;
constexpr int PADROWS = T * TOPK + NE * 256;
static_assert((size_t)PADROWS * DFF * 2 <= 272 * MiB, "H / YS size");
constexpr int CW_SA2 = 136;
constexpr int CW_SA = 128;
constexpr int CW_CNT = 400000;
constexpr int CW_BAR = 4096;

constexpr int RING_BYTES = 133120;
constexpr int TILE_E_OFF = 131072;
constexpr int SCL_OFF = RING_BYTES;
constexpr int MISC_OFF = SCL_OFF + 24576;
constexpr int LDS_BYTES = 163840;

#define GAS __attribute__((address_space(1)))
#define LAS __attribute__((address_space(3)))
#define CAS __attribute__((address_space(4)))
typedef unsigned short bf16_t;
typedef short bf16x8 __attribute__((ext_vector_type(8)));
typedef short s16x4 __attribute__((ext_vector_type(4)));
typedef float f32x2 __attribute__((ext_vector_type(2)));
typedef float f32x4 __attribute__((ext_vector_type(4)));
typedef float f32x16 __attribute__((ext_vector_type(16)));
typedef unsigned u32x2 __attribute__((ext_vector_type(2)));
typedef unsigned u32x4 __attribute__((ext_vector_type(4)));

__device__ __forceinline__ unsigned cvt_pk_bf16(float lo, float hi) { unsigned r; asm volatile("v_cvt_pk_bf16_f32 %0, %1, %2" : "=v"(r) : "v"(lo), "v"(hi)); return r; }
__device__ __forceinline__ float bf_lo(unsigned w) { return __uint_as_float(w << 16); }
__device__ __forceinline__ float bf_hi(unsigned w) { return __uint_as_float(w & 0xffff0000u); }
__device__ __forceinline__ float sigmoidf_(float x) { return __builtin_amdgcn_rcpf(1.0f + __expf(-x)); }
__device__ __forceinline__ float gelu_tanh(float x) { const float u = 0.7978845608028654f * (x + 0.044715f * x * x * x); const float t = 1.0f - 2.0f * __builtin_amdgcn_rcpf(1.0f + __expf(2.0f * u)); return 0.5f * x * (1.0f + t); }
__device__ __forceinline__ u32x4 pack8(const f32x4 a, const f32x4 b) { u32x4 w; w.x = cvt_pk_bf16(a[0], a[1]); w.y = cvt_pk_bf16(a[2], a[3]); w.z = cvt_pk_bf16(b[0], b[1]); w.w = cvt_pk_bf16(b[2], b[3]); return w; }
__device__ __forceinline__ float KF(float v) { asm volatile("" : "+s"(v)); return v; }
typedef unsigned long long u64x2_t __attribute__((ext_vector_type(2)));
__device__ __forceinline__ f32x4 zero4() { unsigned long long z0, z1; asm volatile("v_mov_b64 %0, 0" : "=v"(z0)); asm volatile("v_mov_b64 %0, 0" : "=v"(z1)); return __builtin_bit_cast(f32x4, (u64x2_t){z0, z1}); }
__device__ __forceinline__ int opaque_tid() { int t = threadIdx.x; asm volatile("" : "+v"(t)); return t; }
__device__ __forceinline__ float wave_sum(float v) {
#pragma unroll
    for (int o = 1; o < 64; o <<= 1) v += __shfl_xor(v, o);
    return v;
}

namespace pg8 {
#define PG8_LAS __attribute__((address_space(3)))
constexpr int BM = 256, BK = 64, HALF = 128, HTB = HALF * BK * 2, STAGE_BYTES = 8 * HTB;
__host__ __device__ __forceinline__ int lds_byte(int r, int c) { const int st = (r >> 4) * 2 + (c >> 5), rr = r & 15, cc = c & 31, ob = rr * 64 + cc * 2; return st * 1024 + (ob ^ (((ob >> 9) & 1) << 5)); }
__host__ __device__ __forceinline__ void stage_rc(int b, int& R, int& C) { const int st = b / 1024, sb = b % 1024, swz = sb ^ (((sb >> 9) & 1) << 5); R = (st >> 1) * 16 + swz / 64; C = (st & 1) * 32 + (swz % 64) / 2; }
__host__ __device__ __forceinline__ int perm32(int rho) { const int n = rho >> 4, i = rho & 15; return 8 * (i >> 2) + 4 * n + (i & 3); }

struct Unit { const char* A; const char* B; const char* S; const char* SA; const int* lst; int nvalid; int pm, pn, aux; };

typedef int v4i_t __attribute__((ext_vector_type(4)));
typedef int v8i_t __attribute__((ext_vector_type(8)));
template <class Epi, class Sched, bool GATHER, int FPM = 0>
__device__ __forceinline__ void gemm_phase(PG8_LAS unsigned char* lds, const int nt  , const int lda  , const int ldb  , const Sched& S, const Epi& E, unsigned long long* pw = nullptr, const int sa = 0x7f7f7f7f) {
    constexpr bool FP8 = FPM != 0;
    const int tid = opaque_tid(), wid = __builtin_amdgcn_readfirstlane(tid >> 6), lane = tid & 63, wr = wid >> 2, wc = wid & 3, fr = lane & 15, fq = lane >> 4;
    unsigned voffB[2], ocA[2][2], onA[2][2];
#pragma unroll
    for (int i = 0; i < 2; ++i) { int R, C; stage_rc(tid * 16 + i * 8192, R, C); const int Rb = Epi::PERM ? ((R & ~31) + perm32(R & 31)) : R;
        voffB[i] = (unsigned)(Rb * ldb + C * 2);
        ocA[0][i] = (unsigned)(R * lda + C * 2); ocA[1][i] = (unsigned)((R + HALF) * lda + C * 2); onA[0][i] = ocA[0][i]; onA[1][i] = ocA[1][i]; }
    constexpr unsigned kstep = BK * 2;
    const unsigned hstepB = (unsigned)HALF * ldb;
    const unsigned ldsw = (unsigned)wid * 1024u;
    const int aoff = lds_byte(wr * 64 + fr, fq * 8), boff = lds_byte(wc * 32 + fr, fq * 8);
#define PG8_SA(b, h) (((b) * 2 + (h)) * HTB)
#define PG8_SB(b, h) ((4 + (b) * 2 + (h)) * HTB)
#define PG8_STAGE(bufoff, gbase, voff, kb) do { _Pragma("unroll") for (int _i = 0; _i < 2; ++_i) \
        __builtin_amdgcn_global_load_lds((const unsigned*)((const char*)(gbase) + (size_t)(unsigned)((voff)[_i] + (unsigned)(kb))), (PG8_LAS unsigned*)(lds + (bufoff) + ldsw + _i * 8192), 16, 0, 0); } while (0)
#define PG8_CAT(x0, x1) __builtin_shufflevector(x0, x1, 0, 1, 2, 3, 4, 5, 6, 7)
#define PG8_LO(x) __builtin_bit_cast(bf16x8, __builtin_shufflevector(x, x, 0, 1, 2, 3))
#define PG8_HI(x) __builtin_bit_cast(bf16x8, __builtin_shufflevector(x, x, 4, 5, 6, 7))
    const PG8_LAS unsigned char* const ldsA = lds + aoff; const PG8_LAS unsigned char* const ldsB = lds + 4 * HTB + boff;
#define PG8_LDA(dst, b, h) do { _Pragma("unroll") for (int m = 0; m < 4; ++m) dst[m] = PG8_CAT(*(const PG8_LAS v4i_t*)(ldsA + (PG8_SA(b, h) + m * 2048)), *(const PG8_LAS v4i_t*)(ldsA + (PG8_SA(b, h) + m * 2048 + 1024))); } while (0)
#define PG8_LDB(dst, b, h) do { _Pragma("unroll") for (int n = 0; n < 2; ++n) dst[n] = PG8_CAT(*(const PG8_LAS v4i_t*)(ldsB + (PG8_SB(b, h) - 4 * HTB + n * 2048)), *(const PG8_LAS v4i_t*)(ldsB + (PG8_SB(b, h) - 4 * HTB + n * 2048 + 1024))); } while (0)
#define PG8_MMA(ai, bj, At, Bt) do { __builtin_amdgcn_s_setprio(1); \
        if constexpr (FP8) { asm volatile("s_nop 4" ::: "memory"); _Pragma("unroll") for (int m = 0; m < 4; ++m) _Pragma("unroll") for (int n = 0; n < 2; ++n) \
            asm volatile("v_mfma_scale_f32_16x16x128_f8f6f4 %0, %1, %2, %0, %3, %4 op_sel_hi:[0,0,0]" : "+v"(acc[ai][bj][m][n]) : "v"(Bt[n]), "v"(At[m]), "v"(sB[bj][n]), "v"(FPM == 2 ? sA[m] : sav)); } \
        else { _Pragma("unroll") for (int m = 0; m < 4; ++m) _Pragma("unroll") for (int n = 0; n < 2; ++n) { \
            acc[ai][bj][m][n] = __builtin_amdgcn_mfma_f32_16x16x32_bf16(PG8_LO(Bt[n]), PG8_LO(At[m]), acc[ai][bj][m][n], 0, 0, 0); \
            acc[ai][bj][m][n] = __builtin_amdgcn_mfma_f32_16x16x32_bf16(PG8_HI(Bt[n]), PG8_HI(At[m]), acc[ai][bj][m][n], 0, 0, 0); } } \
        __builtin_amdgcn_s_setprio(0); } while (0)
    int sB[2][2] = {{0x7f, 0x7f}, {0x7f, 0x7f}}; int sav; asm volatile("v_mov_b32 %0, %1" : "=v"(sav) : "s"(sa));
    int sA[4] = {0x7f, 0x7f, 0x7f, 0x7f};
    const int scol = wc * 32 + (Epi::PERM ? 8 * (fr >> 2) + (fr & 3) : fr);
    const int sbase = FPM == 2 ? SCL_OFF + 16384 + scol * 2 + (fq >> 1) : SCL_OFF + scol * 4 + fq;
    const int sabase = SCL_OFF + ((wr * 64 + fr) << 2) + fq;
#define PG8_LDS_SCL(par_, kt_) do { if constexpr (FP8) { \
        const PG8_LAS unsigned char* sp_ = (const PG8_LAS unsigned char*)lds + sbase + (FPM == 2 ? (par_) * 4096 + (kt_) * 512 : (par_) * 8192 + (kt_) * 1024); \
        _Pragma("unroll") for (int bj_ = 0; bj_ < 2; ++bj_) _Pragma("unroll") for (int n_ = 0; n_ < 2; ++n_) sB[bj_][n_] = (int)sp_[(bj_ * 128 + n_ * (Epi::PERM ? 4 : 16)) * (FPM == 2 ? 2 : 4)]; } } while (0)
#define PG8_LDS_SCA(par_, kt_, ai_) do { if constexpr (FPM == 2) { const PG8_LAS unsigned char* sp_ = (const PG8_LAS unsigned char*)lds + sabase + (par_) * 8192 + (kt_) * 1024 + (ai_) * 512; \
        _Pragma("unroll") for (int m_ = 0; m_ < 4; ++m_) sA[m_] = (int)sp_[m_ * 64]; } } while (0)
#define PG8_DMA_SCL(u_, par_) do { if constexpr (FPM == 1) __builtin_amdgcn_global_load_lds((const unsigned*)((u_).S + wid * 1024 + lane * 16), (PG8_LAS unsigned*)(lds + SCL_OFF + (par_) * 8192 + wid * 1024), 16, 0, 0); \
        if constexpr (FPM == 2) { __builtin_amdgcn_global_load_lds((const unsigned*)((u_).SA + wid * 1024 + lane * 16), (PG8_LAS unsigned*)(lds + SCL_OFF + (par_) * 8192 + wid * 1024), 16, 0, 0); \
            if (wid < 4) __builtin_amdgcn_global_load_lds((const unsigned*)((u_).S + wid * 1024 + lane * 16), (PG8_LAS unsigned*)(lds + SCL_OFF + 16384 + (par_) * 4096 + wid * 1024), 16, 0, 0); } } while (0)
#define PG8_WAIT_V(n) asm volatile("s_waitcnt vmcnt(" #n ")" ::: "memory")
#define PG8_WAIT_L(n) asm volatile("s_waitcnt lgkmcnt(" #n ")" ::: "memory")
#define PG8_BAR __builtin_amdgcn_s_barrier()
#define PG8_SCHED __builtin_amdgcn_sched_barrier(0)
#define PG8_GOFFS(u, o) do { _Pragma("unroll") for (int _h = 0; _h < 2; ++_h) _Pragma("unroll") for (int _i = 0; _i < 2; ++_i) { int gR_, gC_; stage_rc(tid * 16 + _i * 8192, gR_, gC_); int _r = _h * HALF + gR_; _r = _r < (u).nvalid ? _r : (u).nvalid - 1; \
        const int _tok = (u).lst[_r]; (o)[_h][_i] = (unsigned)_tok * (unsigned)lda + (unsigned)(gC_ * 2); } } while (0)
#define PG8_GRAW(u, tk) do {   _Pragma("unroll") for (int _h = 0; _h < 2; ++_h) _Pragma("unroll") for (int _i = 0; _i < 2; ++_i) { int gR_, gC_; stage_rc(tid * 16 + _i * 8192, gR_, gC_); int _r = _h * HALF + gR_; _r = _r < (u).nvalid ? _r : (u).nvalid - 1; (tk)[_h][_i] = (unsigned)(u).lst[_r]; } } while (0)
    Unit cur, nxt, nn; int ui = 0;
#if PROBE_T
    unsigned long long pk_ = 0, pe_ = 0, pt0_ = 0, pn_ = 0; const unsigned long long pst_ = __builtin_amdgcn_s_memtime();
#endif
    if (!S.next(0, cur)) return;
    f32x4 acc[2][2][4][2];
#pragma unroll
    for (int a = 0; a < 2; ++a)
#pragma unroll
        for (int b = 0; b < 2; ++b)
#pragma unroll
            for (int m = 0; m < 4; ++m)
#pragma unroll
                for (int n = 0; n < 2; ++n) acc[a][b][m][n] = (f32x4){0.f, 0.f, 0.f, 0.f};
    v8i_t At[4], B0[2], B1[2];
    const char* cA = cur.A; const char* cB = cur.B;
    bool has_next = S.next(1, nxt);
    if constexpr (GATHER) { PG8_GOFFS(cur, ocA);
        if (has_next) { PG8_GOFFS(nxt, onA); }
        else {
#pragma unroll
            for (int h = 0; h < 2; ++h)
#pragma unroll
                for (int i = 0; i < 2; ++i) onA[h][i] = ocA[h][i]; } }
    PG8_DMA_SCL(cur, 0); if (has_next) PG8_DMA_SCL(nxt, 1);
    PG8_STAGE(PG8_SB(0, 0), cB, voffB, 0u); PG8_STAGE(PG8_SB(0, 1), cB, voffB, hstepB); PG8_STAGE(PG8_SA(0, 0), cA, ocA[0], 0u); PG8_STAGE(PG8_SA(0, 1), cA, ocA[1], 0u);
    if (wr == 1) PG8_BAR;
    PG8_WAIT_V(2); PG8_BAR;
    PG8_STAGE(PG8_SB(1, 0), cB, voffB, kstep); PG8_STAGE(PG8_SA(1, 0), cA, ocA[0], kstep); PG8_STAGE(PG8_SB(1, 1), cB, voffB, hstepB + kstep);
    PG8_WAIT_V(6); PG8_BAR;
    for (;;) {
        const char* nA = has_next ? nxt.A : cA; const char* nB = has_next ? nxt.B : cB;
#if PROBE_T
        pt0_ = __builtin_amdgcn_s_memtime();
#endif
#pragma unroll 1
        for (int t = 0; t < nt; t += 2) {
            const bool last = (t == nt - 2);
            const unsigned k1 = (unsigned)(t + 1) * kstep, k2 = last ? 0u : (unsigned)(t + 2) * kstep, k3 = k2 + kstep;
            const char* a2 = last ? nA : cA; const char* b2 = last ? nB : cB;
#define PG8_STAGE_A2(bufoff, h_, kb_) do { if (GATHER && last) PG8_STAGE(bufoff, a2, onA[h_], kb_); else PG8_STAGE(bufoff, a2, ocA[h_], kb_); } while (0)
            PG8_LDB(B0, 0, 0); PG8_LDB(B1, 0, 1); PG8_LDS_SCL(ui & 1, t); PG8_SCHED; PG8_LDA(At, 0, 0); PG8_LDS_SCA(ui & 1, t, 0); PG8_STAGE(PG8_SA(1, 1), cA, ocA[1], k1);
            PG8_WAIT_V(8); PG8_WAIT_L(0); PG8_BAR; PG8_MMA(0, 0, At, B0); PG8_MMA(0, 1, At, B1); PG8_BAR; PG8_SCHED;
            PG8_LDA(At, 0, 1); PG8_LDS_SCA(ui & 1, t, 1); PG8_STAGE(PG8_SB(0, 0), b2, voffB, k2); PG8_STAGE(PG8_SB(0, 1), b2, voffB, hstepB + k2); PG8_STAGE_A2(PG8_SA(0, 0), 0, k2);
            PG8_WAIT_V(8); PG8_WAIT_L(0); PG8_BAR; PG8_MMA(1, 0, At, B0); PG8_MMA(1, 1, At, B1); PG8_BAR; PG8_SCHED;
            PG8_LDB(B0, 1, 0); PG8_LDB(B1, 1, 1); PG8_LDS_SCL(ui & 1, t + 1); PG8_SCHED; PG8_LDA(At, 1, 0); PG8_LDS_SCA(ui & 1, t + 1, 0); PG8_STAGE_A2(PG8_SA(0, 1), 1, k2);
            PG8_WAIT_V(8); PG8_WAIT_L(0); PG8_BAR; PG8_MMA(0, 0, At, B0); PG8_MMA(0, 1, At, B1); PG8_BAR; PG8_SCHED;
            PG8_LDA(At, 1, 1); PG8_LDS_SCA(ui & 1, t + 1, 1); PG8_STAGE(PG8_SB(1, 0), b2, voffB, k3); PG8_STAGE(PG8_SB(1, 1), b2, voffB, hstepB + k3); PG8_STAGE_A2(PG8_SA(1, 0), 0, k3);
            PG8_WAIT_V(8); PG8_WAIT_L(0); PG8_BAR; PG8_MMA(1, 0, At, B0); PG8_MMA(1, 1, At, B1); PG8_BAR; PG8_SCHED;
        }
#if PROBE_T
        const unsigned long long pt1_ = __builtin_amdgcn_s_memtime(); pk_ += pt1_ - pt0_;
#endif
        if constexpr (FP8) asm volatile("s_nop 15\n\ts_nop 7" ::: "memory");
        const bool has_nn = has_next && S.next(ui + 2, nn);
        if constexpr (GATHER) {
#pragma unroll
            for (int h = 0; h < 2; ++h)
#pragma unroll
                for (int i = 0; i < 2; ++i) ocA[h][i] = onA[h][i];
            if (has_nn) { PG8_GRAW(nn, onA); } }
        if (wr == 0) PG8_BAR;
        E(acc, cur, wr, wc, fr, fq);
#if PROBE_T
        asm volatile("s_waitcnt vmcnt(0)" ::: "memory"); pe_ += __builtin_amdgcn_s_memtime() - pt1_; ++pn_;
#endif
        if (!has_next) break;
#pragma unroll
        for (int a = 0; a < 2; ++a)
#pragma unroll
            for (int b = 0; b < 2; ++b)
#pragma unroll
                for (int m = 0; m < 4; ++m)
#pragma unroll
                    for (int n = 0; n < 2; ++n) acc[a][b][m][n] = zero4();
        cur = nxt; cA = nA; cB = nB; ++ui;
        if constexpr (GATHER) { if (has_nn) {
#pragma unroll
            for (int h = 0; h < 2; ++h)
#pragma unroll
                for (int i = 0; i < 2; ++i) { int gR_, gC_; stage_rc(tid * 16 + i * 8192, gR_, gC_); onA[h][i] = onA[h][i] * (unsigned)lda + (unsigned)(gC_ * 2); } } }
        if (has_nn) { nxt = nn; PG8_DMA_SCL(nxt, (ui + 1) & 1); }
        has_next = has_nn;
        if (wr == 1) PG8_BAR;
    }
    PG8_WAIT_V(0);
    PG8_BAR;
#if PROBE_T
    if (pw && blockIdx.x == 0 && tid == 0) { pw[0] += pk_; pw[1] += pe_; pw[2] += pn_; pw[3] += __builtin_amdgcn_s_memtime() - pst_; }
#endif
#undef PG8_SA
#undef PG8_SB
#undef PG8_STAGE
#undef PG8_LDA
#undef PG8_LDB
#undef PG8_MMA
#undef PG8_WAIT_V
#undef PG8_WAIT_L
#undef PG8_BAR
#undef PG8_SCHED
#undef PG8_GOFFS
#undef PG8_GRAW
#undef PG8_STAGE_A2
#undef PG8_CAT
#undef PG8_LO
#undef PG8_HI
#undef PG8_LDS_SCL
#undef PG8_LDS_SCA
#undef PG8_DMA_SCL
}

constexpr int NXCD = 8, WGM = 8;
template <int NM, int NN>
struct DenseSched {
    static_assert(NM % WGM == 0, "row tiles in groups of 8");
    const char* A; const char* B; int lda, ldb; int G, c; int apn_shift, akbytes, bpm_shift; size_t bbatch; const char* SW;
    __device__ __forceinline__ void init(const void* A_, const void* B_, int lda_, int ldb_, int G_, int c_) {
        A = (const char*)A_; B = (const char*)B_; lda = lda_; ldb = ldb_; G = G_; c = c_; apn_shift = -1; akbytes = 0; bpm_shift = -1; bbatch = 0; SW = nullptr; }
    __device__ __forceinline__ bool next(int i, Unit& u) const {
        constexpr int nwg = NM * NN, q = nwg / NXCD, r = nwg % NXCD, nig = WGM * NN;
        const int L = i * G + c; if (L >= nwg) return false;
        int wgid = L; { const int xcd = wgid % NXCD, off = wgid / NXCD; wgid = (xcd < r ? xcd * (q + 1) : r * (q + 1) + (xcd - r) * q) + off; }
        const int gid = wgid / nig, rem = wgid - gid * nig;
        const int pm = gid * WGM + (rem & (WGM - 1)), pn = rem / WGM;
        u.pm = pm; u.pn = pn; u.aux = 0; u.lst = nullptr; u.nvalid = 256; u.S = SW ? SW + (size_t)pn * 8192 : nullptr; u.SA = nullptr;
        u.A = A + (size_t)pm * 256 * lda * 2 + (apn_shift >= 0 ? (size_t)(pn >> apn_shift) * akbytes : (size_t)0);
        u.B = B + (size_t)pn * 256 * ldb * 2 + (bpm_shift >= 0 ? (size_t)(pm >> bpm_shift) * bbatch : (size_t)0);
        return true;
    }
};
struct MoeSched {
    const char* A; const char* B; size_t bexp; const char* SW; int lda, ldb  , nN; const int* lists; volatile LAS const int* tab; volatile LAS const unsigned char* te; int G, c; bool gather; const char* SA;
    __device__ __forceinline__ bool next(int i, Unit& u) const {
        int pn, mg;
        if (G == 256) {
            const int x = c & 7, jj = c >> 3, pgs = nN >> 2, mgs = 8 / pgs;
            mg = i * (8 * mgs) + 8 * (x / pgs) + (jj & 7); pn = 4 * (x % pgs) + (jj >> 3);
            if (mg >= __builtin_amdgcn_readfirstlane(tab[32])) return false;
        } else { const int total = __builtin_amdgcn_readfirstlane(tab[32]) * nN; const long L = (long)i * G + c; if (L >= total) return false; pn = (int)(L % nN); mg = (int)(L / nN); }
        const int e = __builtin_amdgcn_readfirstlane((int)te[mg]), mt = mg - __builtin_amdgcn_readfirstlane(tab[e]);
        u.pm = mg; u.pn = pn; u.aux = e;
        if (gather) { u.A = A; u.lst = lists + (size_t)e * T + mt * 256; const int rem = __builtin_amdgcn_readfirstlane(tab[48 + e]) - mt * 256; u.nvalid = rem < 256 ? rem : 256; }
        else { u.A = A + (size_t)mg * 256 * lda; u.lst = nullptr; u.nvalid = 256; }
        u.B = B + (size_t)e * bexp + (size_t)pn * 256 * ldb; u.S = SW ? (SA ? SW + ((size_t)e * 4 + pn) * 4096 : SW + ((size_t)e * 8 + pn) * 8192) : nullptr; u.SA = SA ? SA + (size_t)mg * 8192 : nullptr;
        return true;
    }
};

#define EPI_ROW(u, ai, m) ((u).pm * 256 + (ai) * 128 + wr * 64 + (m) * 16 + fr)
struct EpiLat {
    static constexpr bool PERM = true;
    bf16_t* LAT; float* SSQ; bf16_t* KR; const float* CS; const float* SN;
    __device__ __forceinline__ void operator()(const f32x4 (&acc)[2][2][4][2], const Unit& u, int wr, int wc, int fr, int fq) const {
        if (u.pn < 4) {
#pragma unroll
            for (int ai = 0; ai < 2; ++ai)
#pragma unroll
                for (int m = 0; m < 4; ++m) { const int row = EPI_ROW(u, ai, m); float ss = 0.f;
#pragma unroll
                    for (int bj = 0; bj < 2; ++bj) { const f32x4 v0 = acc[ai][bj][m][0], v1 = acc[ai][bj][m][1];
                        ss += (v0[0] * v0[0] + v0[1] * v0[1]) + (v0[2] * v0[2] + v0[3] * v0[3]) + (v1[0] * v1[0] + v1[1] * v1[1]) + (v1[2] * v1[2] + v1[3] * v1[3]);
                        *(u32x4*)(LAT + (size_t)row * 1024 + u.pn * 256 + bj * 128 + wc * 32 + 8 * fq) = pack8(v0, v1); }
                    ss += __shfl_xor(ss, 16); ss += __shfl_xor(ss, 32);
                    if (fq == 0) SSQ[(size_t)row * 16 + u.pn * 4 + wc] = ss; }
        } else if (wc == 0) {
#pragma unroll
            for (int ai = 0; ai < 2; ++ai) {
                f32x4 cv[4][2], sv[4][2];
#pragma unroll
                for (int m = 0; m < 4; ++m) { const int row = EPI_ROW(u, ai, m);
                    cv[m][0] = *(const f32x4*)(CS + (size_t)row * 32 + 8 * fq); cv[m][1] = *(const f32x4*)(CS + (size_t)row * 32 + 8 * fq + 4);
                    sv[m][0] = *(const f32x4*)(SN + (size_t)row * 32 + 8 * fq); sv[m][1] = *(const f32x4*)(SN + (size_t)row * 32 + 8 * fq + 4); }
#pragma unroll
                for (int m = 0; m < 4; ++m) { const int row = EPI_ROW(u, ai, m);
                    const f32x4 c0 = cv[m][0], c1 = cv[m][1], s0 = sv[m][0], s1 = sv[m][1];
                    const f32x4 a0 = acc[ai][0][m][0], a1 = acc[ai][0][m][1], b0 = acc[ai][1][m][0], b1 = acc[ai][1][m][1];
                    *(u32x4*)(KR + (size_t)row * 64 + 8 * fq) = pack8(a0 * c0 - b0 * s0, a1 * c1 - b1 * s1);
                    *(u32x4*)(KR + (size_t)row * 64 + 32 + 8 * fq) = pack8(b0 * c0 + a0 * s0, b1 * c1 + a1 * s1); }
                asm volatile("" ::: "memory"); }
        }
    }
};
struct EpiQ {
    static constexpr bool PERM = true;
    bf16_t* Q; const float* SSQ; const float* CS; const float* SN;
    __device__ __forceinline__ void operator()(const f32x4 (&acc)[2][2][4][2], const Unit& u, int wr, int wc, int fr, int fq) const {
        float rr[2][4];
        { f32x4 qv[2][4];
#pragma unroll
          for (int ai = 0; ai < 2; ++ai)
#pragma unroll
              for (int m = 0; m < 4; ++m) qv[ai][m] = *(const f32x4*)(SSQ + (size_t)EPI_ROW(u, ai, m) * 16 + 4 * (fq < 3 ? fq : 0));
#pragma unroll
          for (int ai = 0; ai < 2; ++ai)
#pragma unroll
              for (int m = 0; m < 4; ++m) { const f32x4 q0 = qv[ai][m]; float ss = fq < 3 ? (q0[0] + q0[1]) + (q0[2] + q0[3]) : 0.f;
                  ss += __shfl_xor(ss, 16); ss += __shfl_xor(ss, 32);
                  rr[ai][m] = QSCALE / sqrtf(ss * (1.0f / QL) + KF(RMS_EPS)); } }
        if (u.pn < 4) {
#pragma unroll
            for (int ai = 0; ai < 2; ++ai)
#pragma unroll
                for (int m = 0; m < 4; ++m) { const int row = EPI_ROW(u, ai, m); const float r = rr[ai][m];
#pragma unroll
                    for (int bj = 0; bj < 2; ++bj)
                        *(u32x4*)(Q + (size_t)row * 1536 + (2 * u.pn + bj) * 192 + wc * 32 + 8 * fq) = pack8(acc[ai][bj][m][0] * r, acc[ai][bj][m][1] * r); }
        } else {
            const int head = 4 * (u.pn - 4) + wc;
#pragma unroll
            for (int am = 0; am < 4; ++am) { const int ai = am >> 1;
                f32x4 cv[2][2], sv[2][2];
#pragma unroll
                for (int mm = 0; mm < 2; ++mm) { const int row = EPI_ROW(u, ai, 2 * (am & 1) + mm);
                    cv[mm][0] = *(const f32x4*)(CS + (size_t)row * 32 + 8 * fq); cv[mm][1] = *(const f32x4*)(CS + (size_t)row * 32 + 8 * fq + 4);
                    sv[mm][0] = *(const f32x4*)(SN + (size_t)row * 32 + 8 * fq); sv[mm][1] = *(const f32x4*)(SN + (size_t)row * 32 + 8 * fq + 4); }
#pragma unroll
                for (int mm = 0; mm < 2; ++mm) { const int m = 2 * (am & 1) + mm; const int row = EPI_ROW(u, ai, m); const float r = rr[ai][m];
                    const f32x4 c0 = cv[mm][0], c1 = cv[mm][1], s0 = sv[mm][0], s1 = sv[mm][1];
                    const f32x4 a0 = acc[ai][0][m][0] * r, a1 = acc[ai][0][m][1] * r, b0 = acc[ai][1][m][0] * r, b1 = acc[ai][1][m][1] * r;
                    *(u32x4*)(Q + (size_t)row * 1536 + head * 192 + 128 + 8 * fq) = pack8(a0 * c0 - b0 * s0, a1 * c1 - b1 * s1);
                    *(u32x4*)(Q + (size_t)row * 1536 + head * 192 + 160 + 8 * fq) = pack8(b0 * c0 + a0 * s0, b1 * c1 + a1 * s1); }
                asm volatile("" ::: "memory"); }
        }
    }
};
struct EpiKV {
    static constexpr bool PERM = true;
    bf16_t* KN; bf16_t* V; const float* SSQ;
    __device__ __forceinline__ void operator()(const f32x4 (&acc)[2][2][4][2], const Unit& u, int wr, int wc, int fr, int fq) const {
        f32x4 q3v[2][4];
#pragma unroll
        for (int ai = 0; ai < 2; ++ai)
#pragma unroll
            for (int m = 0; m < 4; ++m) q3v[ai][m] = *(const f32x4*)(SSQ + (size_t)EPI_ROW(u, ai, m) * 16 + 12);
#pragma unroll
        for (int ai = 0; ai < 2; ++ai)
#pragma unroll
            for (int m = 0; m < 4; ++m) { const int row = EPI_ROW(u, ai, m);
                const f32x4 q3 = q3v[ai][m];
                const float r = 1.0f / sqrtf(((q3[0] + q3[1]) + (q3[2] + q3[3])) * (1.0f / KVL) + KF(RMS_EPS));
                *(u32x4*)(KN + (size_t)row * 1024 + u.pn * 128 + wc * 32 + 8 * fq) = pack8(acc[ai][0][m][0] * r, acc[ai][0][m][1] * r);
                *(u32x4*)(V + (size_t)row * 1024 + u.pn * 128 + wc * 32 + 8 * fq) = pack8(acc[ai][1][m][0] * r, acc[ai][1][m][1] * r); }
    }
};
__device__ __forceinline__ f32x4 bf4_lo(const u32x4 w) { return (f32x4){bf_lo(w.x), bf_hi(w.x), bf_lo(w.y), bf_hi(w.y)}; }
__device__ __forceinline__ f32x4 bf4_hi(const u32x4 w) { return (f32x4){bf_lo(w.z), bf_hi(w.z), bf_lo(w.w), bf_hi(w.w)}; }
struct EpiRes {
    static constexpr bool PERM = true;
    const bf16_t* X; bf16_t* Y;
    __device__ __forceinline__ void operator()(const f32x4 (&acc)[2][2][4][2], const Unit& u, int wr, int wc, int fr, int fq) const {
        const bf16_t* xb = X + (size_t)u.pm * 256 * 1024; bf16_t* yb = Y + (size_t)u.pm * 256 * 1024; const unsigned o0 = (unsigned)((wr * 64 + fr) * 1024 + u.pn * 256 + wc * 32 + 8 * fq);
        u32x4 xw[2][4][2];
#pragma unroll
        for (int ai = 0; ai < 2; ++ai)
#pragma unroll
            for (int m = 0; m < 4; ++m)
#pragma unroll
                for (int bj = 0; bj < 2; ++bj) xw[ai][m][bj] = *(const u32x4*)(xb + (o0 + (unsigned)((ai * 128 + m * 16) * 1024 + bj * 128)));
#pragma unroll
        for (int ai = 0; ai < 2; ++ai)
#pragma unroll
            for (int m = 0; m < 4; ++m)
#pragma unroll
                for (int bj = 0; bj < 2; ++bj)
                    *(u32x4*)(yb + (o0 + (unsigned)((ai * 128 + m * 16) * 1024 + bj * 128))) = pack8(bf4_lo(xw[ai][m][bj]) * ALPHA + acc[ai][bj][m][0], bf4_hi(xw[ai][m][bj]) * ALPHA + acc[ai][bj][m][1]);
    }
};
struct EpiGU {
    static constexpr bool PERM = true;
    bf16_t* GG; bf16_t* U;
    __device__ __forceinline__ void operator()(const f32x4 (&acc)[2][2][4][2], const Unit& u, int wr, int wc, int fr, int fq) const {
#pragma unroll
        for (int ai = 0; ai < 2; ++ai)
#pragma unroll
            for (int m = 0; m < 4; ++m) { const int row = EPI_ROW(u, ai, m);
#pragma unroll
                for (int bj = 0; bj < 2; ++bj) { f32x4 v0 = acc[ai][bj][m][0], v1 = acc[ai][bj][m][1];
                    if (u.pn < 4) {
                        const float k0 = KF(-2.0f * 0.7978845608028654f * 1.4426950408889634f), k1 = KF(-2.0f * 0.7978845608028654f * 1.4426950408889634f * 0.044715f);
                        const f32x4 z0 = v0 * (v0 * v0 * k1 + k0), z1 = v1 * (v1 * v1 * k1 + k0); f32x4 e0, e1, r0, r1;
#pragma unroll
                        for (int e = 0; e < 4; ++e) { e0[e] = __builtin_amdgcn_exp2f(z0[e]); e1[e] = __builtin_amdgcn_exp2f(z1[e]); }
                        const f32x4 d0 = e0 + 1.0f, d1 = e1 + 1.0f;
#pragma unroll
                        for (int e = 0; e < 4; ++e) { r0[e] = __builtin_amdgcn_rcpf(d0[e]); r1[e] = __builtin_amdgcn_rcpf(d1[e]); }
                        v0 = v0 * r0; v1 = v1 * r1;
                        *(u32x4*)(GG + (size_t)row * 1024 + u.pn * 256 + bj * 128 + wc * 32 + 8 * fq) = pack8(v0, v1);
                    } else *(u32x4*)(U + (size_t)row * 1024 + (u.pn - 4) * 256 + bj * 128 + wc * 32 + 8 * fq) = pack8(v0, v1); } }
    }
};
struct EpiAB {
    static constexpr bool PERM = true;
    bf16_t* LA; bf16_t* BB; const bf16_t* UC; const float* BA; const float* BX; const float* SPL;
    __device__ __forceinline__ void operator()(const f32x4 (&acc)[2][2][4][2], const Unit& u, int wr, int wc, int fr, int fq) const {
        const int ch = (u.pn >> 1) * 256 + (u.pn & 1) * 128 + wc * 32 + 8 * fq;
        const float nl2e = KF(-1.4426950408889634f);
        f32x4 ba[2], bx[2], sp[2];
#pragma unroll
        for (int n = 0; n < 2; ++n) { ba[n] = *(const f32x4*)(BA + ch + 4 * n); bx[n] = *(const f32x4*)(BX + ch + 4 * n); sp[n] = *(const f32x4*)(SPL + ch + 4 * n) * (-nl2e); }
        u32x4 uwv[2][4];
#pragma unroll
        for (int ai = 0; ai < 2; ++ai)
#pragma unroll
            for (int m = 0; m < 4; ++m) uwv[ai][m] = *(const u32x4*)(UC + (size_t)EPI_ROW(u, ai, m) * 1024 + ch);
#pragma unroll
        for (int ai = 0; ai < 2; ++ai)
#pragma unroll
            for (int m = 0; m < 4; ++m) { const size_t off = (size_t)EPI_ROW(u, ai, m) * 1024 + ch;
                const u32x4 uw = uwv[ai][m]; f32x4 uv[2] = {bf4_lo(uw), bf4_hi(uw)}, lv[2], bv[2];
#pragma unroll
                for (int n = 0; n < 2; ++n) {
                    const f32x4 ta = (acc[ai][0][m][n] + ba[n]) * nl2e, tx = (acc[ai][1][m][n] + bx[n]) * nl2e; f32x4 ea, ex, ra, ri, a2, sq;
#pragma unroll
                    for (int e = 0; e < 4; ++e) { ea[e] = __builtin_amdgcn_exp2f(ta[e]); ex[e] = __builtin_amdgcn_exp2f(tx[e]); }
                    const f32x4 da = ea + 1.0f, dx = ex + 1.0f;
#pragma unroll
                    for (int e = 0; e < 4; ++e) { ra[e] = __builtin_amdgcn_rcpf(da[e]); ri[e] = __builtin_amdgcn_rcpf(dx[e]); }
                    const f32x4 l2 = sp[n] * ra, t2 = l2 + l2; lv[n] = l2;
#pragma unroll
                    for (int e = 0; e < 4; ++e) a2[e] = __builtin_amdgcn_exp2f(t2[e]);
                    const f32x4 om = 1.0f - a2;
#pragma unroll
                    for (int e = 0; e < 4; ++e) sq[e] = __builtin_amdgcn_sqrtf(fmaxf(om[e], 0.0f));
                    bv[n] = sq * ri * uv[n]; }
                *(u32x4*)(LA + off) = pack8(lv[0], lv[1]); *(u32x4*)(BB + off) = pack8(bv[0], bv[1]); asm volatile("" ::: "memory"); }
    }
};
struct EpiUp {
    static constexpr bool PERM = true;
    unsigned char* H; unsigned char* SH; const float* BU;
    __device__ __forceinline__ void operator()(f32x4 (&acc)[2][2][4][2], const Unit& u, int wr, int wc, int fr, int fq) const {
        const int gc = u.pn * 128 + wc * 32 + 8 * fq; const float* bu = BU + (size_t)u.aux * 2048;
        const float k7 = KF(7.0f), km6 = KF(-6.0f), k8 = KF(8.0f), ka = KF(-1.702f * 1.4426950408889634f);
#pragma unroll
        for (int n = 0; n < 2; ++n) { const f32x4 bg = *(const f32x4*)(bu + gc + 4 * n), bp = *(const f32x4*)(bu + 1024 + gc + 4 * n) + 1.0f;
#pragma unroll
            for (int ai = 0; ai < 2; ++ai)
#pragma unroll
                for (int m = 0; m < 4; ++m) {
                    { f32x4 g = acc[ai][0][m][n] + bg, up = acc[ai][1][m][n] + bp, ex, rc;
#pragma unroll
                      for (int e = 0; e < 4; ++e) { g[e] = fminf(g[e], k7); up[e] = __builtin_amdgcn_fmed3f(up[e], km6, k8); }
                      const f32x4 tz = g * ka;
#pragma unroll
                      for (int e = 0; e < 4; ++e) ex[e] = __builtin_amdgcn_exp2f(tz[e]);
                      const f32x4 dn = ex + 1.0f;
#pragma unroll
                      for (int e = 0; e < 4; ++e) rc[e] = __builtin_amdgcn_rcpf(dn[e]);
                      acc[ai][0][m][n] = up * (g * rc); }
                    if (m & 1) __builtin_amdgcn_sched_barrier(0); }
            asm volatile("" ::: "memory"); }
        unsigned char* const shb = SH + ((size_t)u.pm * 8 + u.pn) * 1024; unsigned char* const hb = H + (size_t)u.pm * 256 * 1024;
        const unsigned ho = (unsigned)((wr * 64 + fr) * 1024 + gc), so = (unsigned)((wr * 64 + fr) * 4 + wc);
#pragma unroll
        for (int ai = 0; ai < 2; ++ai)
#pragma unroll
            for (int m = 0; m < 4; ++m) { const f32x4 y0 = acc[ai][0][m][0], y1 = acc[ai][0][m][1];
                float am = fmaxf(fmaxf(fmaxf(fabsf(y0[0]), fabsf(y0[1])), fmaxf(fabsf(y0[2]), fabsf(y0[3]))), fmaxf(fmaxf(fabsf(y1[0]), fabsf(y1[1])), fmaxf(fabsf(y1[2]), fabsf(y1[3]))));
                { auto r16 = __builtin_amdgcn_permlane16_swap(__float_as_uint(am), __float_as_uint(am), false, false); am = fmaxf(__uint_as_float(r16[0]), __uint_as_float(r16[1]));
                  auto r32 = __builtin_amdgcn_permlane32_swap(__float_as_uint(am), __float_as_uint(am), false, false); am = fmaxf(__uint_as_float(r32[0]), __uint_as_float(r32[1])); }
                int eb = (int)((__float_as_uint(am) >> 23) & 0xffu) - 7; eb = eb < 1 ? 1 : eb;
                const float inv = __uint_as_float((unsigned)(254 - eb) << 23);
                const f32x4 z0 = y0 * inv, z1 = y1 * inv;
                int w0 = __builtin_amdgcn_cvt_pk_fp8_f32(z0[0], z0[1], 0, false); w0 = __builtin_amdgcn_cvt_pk_fp8_f32(z0[2], z0[3], w0, true);
                int w1 = __builtin_amdgcn_cvt_pk_fp8_f32(z1[0], z1[1], 0, false); w1 = __builtin_amdgcn_cvt_pk_fp8_f32(z1[2], z1[3], w1, true);
                *(u32x2*)(hb + (ho + (unsigned)((ai * 128 + m * 16) * 1024))) = (u32x2){(unsigned)w0, (unsigned)w1};
                if (fq == 0) shb[so + (unsigned)((ai * 128 + m * 16) * 4)] = (unsigned char)eb;
                asm volatile("" ::: "memory"); __builtin_amdgcn_sched_barrier(0); }
    }
};
struct EpiDown {
    static constexpr bool PERM = true;
    unsigned char* YS; unsigned char* SY; const float* BD;
    __device__ __forceinline__ void operator()(const f32x4 (&acc)[2][2][4][2], const Unit& u, int wr, int wc, int fr, int fq) const {
        const float* bd = BD + (size_t)u.aux * 1024;
        unsigned char* const yb = YS + (size_t)u.pm * 256 * 1024; unsigned char* const sb = SY + (size_t)u.pm * 256 * 32;
#pragma unroll
        for (int bj = 0; bj < 2; ++bj) { const int col = u.pn * 256 + bj * 128 + wc * 32 + 8 * fq; const f32x4 b0 = *(const f32x4*)(bd + col), b1 = *(const f32x4*)(bd + col + 4);
#pragma unroll
            for (int ai = 0; ai < 2; ++ai)
#pragma unroll
                for (int m = 0; m < 4; ++m) { const unsigned rit = (unsigned)(ai * 128 + wr * 64 + m * 16 + fr); const f32x4 y0 = acc[ai][bj][m][0] + b0, y1 = acc[ai][bj][m][1] + b1;
                    float am = fmaxf(fmaxf(fmaxf(fabsf(y0[0]), fabsf(y0[1])), fmaxf(fabsf(y0[2]), fabsf(y0[3]))), fmaxf(fmaxf(fabsf(y1[0]), fabsf(y1[1])), fmaxf(fabsf(y1[2]), fabsf(y1[3]))));
                    { auto r16 = __builtin_amdgcn_permlane16_swap(__float_as_uint(am), __float_as_uint(am), false, false); am = fmaxf(__uint_as_float(r16[0]), __uint_as_float(r16[1]));
                      auto r32 = __builtin_amdgcn_permlane32_swap(__float_as_uint(am), __float_as_uint(am), false, false); am = fmaxf(__uint_as_float(r32[0]), __uint_as_float(r32[1])); }
                    int eb = (int)((__float_as_uint(am) >> 23) & 0xffu) - 7; eb = eb < 1 ? 1 : eb;
                    const float inv = __uint_as_float((unsigned)(254 - eb) << 23);
                    const f32x4 z0 = y0 * inv, z1 = y1 * inv;
                    int w0 = __builtin_amdgcn_cvt_pk_fp8_f32(z0[0], z0[1], 0, false); w0 = __builtin_amdgcn_cvt_pk_fp8_f32(z0[2], z0[3], w0, true);
                    int w1 = __builtin_amdgcn_cvt_pk_fp8_f32(z1[0], z1[1], 0, false); w1 = __builtin_amdgcn_cvt_pk_fp8_f32(z1[2], z1[3], w1, true);
                    *(u32x2*)(yb + (rit * 1024u + (unsigned)col)) = (u32x2){(unsigned)w0, (unsigned)w1};
                    if (fq == 0) sb[rit * 32u + (unsigned)(col >> 5)] = (unsigned char)eb;
                    asm volatile("" ::: "memory"); } }
    }
};
struct EpiPle {
    static constexpr bool PERM = true;
    const bf16_t* X2; const bf16_t* PP; float* OUT; bf16_t* XB;
    __device__ __forceinline__ void operator()(const f32x4 (&acc)[2][2][4][2], const Unit& u, int wr, int wc, int fr, int fq) const {
        const size_t tb = (size_t)u.pm * 256 * 1024; const unsigned o0 = (unsigned)((wr * 64 + fr) * 1024 + u.pn * 256 + wc * 32 + 8 * fq);
#pragma unroll
        for (int ai = 0; ai < 2; ++ai) {
            u32x4 xw[4][2], pw[4][2];
#pragma unroll
            for (int m = 0; m < 4; ++m)
#pragma unroll
                for (int bj = 0; bj < 2; ++bj) { const unsigned o = o0 + (unsigned)((ai * 128 + m * 16) * 1024 + bj * 128); xw[m][bj] = *(const u32x4*)(X2 + tb + o); pw[m][bj] = *(const u32x4*)(PP + tb + o); }
#pragma unroll
            for (int m = 0; m < 4; ++m)
#pragma unroll
                for (int bj = 0; bj < 2; ++bj) { const unsigned o = o0 + (unsigned)((ai * 128 + m * 16) * 1024 + bj * 128);
                    const f32x4 a0 = acc[ai][bj][m][0], a1 = acc[ai][bj][m][1], x0 = bf4_lo(xw[m][bj]), x1 = bf4_hi(xw[m][bj]), p0 = bf4_lo(pw[m][bj]), p1 = bf4_hi(pw[m][bj]); f32x4 r0, r1;
                    { const float nl2e = KF(-1.4426950408889634f); const f32x4 t0 = a0 * nl2e, t1 = a1 * nl2e; f32x4 e0, e1, s0, s1;
#pragma unroll
                      for (int e = 0; e < 4; ++e) { e0[e] = __builtin_amdgcn_exp2f(t0[e]); e1[e] = __builtin_amdgcn_exp2f(t1[e]); }
                      const f32x4 d0 = e0 + 1.0f, d1 = e1 + 1.0f;
#pragma unroll
                      for (int e = 0; e < 4; ++e) { s0[e] = __builtin_amdgcn_rcpf(d0[e]); s1[e] = __builtin_amdgcn_rcpf(d1[e]); }
                      r0 = x0 + s0 * p0; r1 = x1 + s1 * p1; }
                    *(u32x4*)(XB + tb + o) = pack8(r0, r1);
                    if (OUT) { *(f32x4*)(OUT + tb + o) = r0; *(f32x4*)(OUT + tb + o + 4) = r1; } }
            asm volatile("" ::: "memory"); }
    }
};
struct EpiPP {
    static constexpr bool PERM = true;
    bf16_t* PP;
    __device__ __forceinline__ void operator()(const f32x4 (&acc)[2][2][4][2], const Unit& u, int wr, int wc, int fr, int fq) const {
#pragma unroll
        for (int ai = 0; ai < 2; ++ai)
#pragma unroll
            for (int m = 0; m < 4; ++m)
#pragma unroll
                for (int bj = 0; bj < 2; ++bj) *(u32x4*)(PP + (size_t)EPI_ROW(u, ai, m) * 1024 + u.pn * 256 + bj * 128 + wc * 32 + 8 * fq) = pack8(acc[ai][bj][m][0], acc[ai][bj][m][1]);
    }
};
}

namespace att {
constexpr int NW = 8, QBLK = 32, KVBLK = 64, QB = 256, KPITCH = 384;
constexpr int SHM_V = KVBLK * DV * 2, SHM_K = KVBLK * KPITCH;
constexpr int NVB = 3;
constexpr int OFF_V = 0, OFF_K = NVB * SHM_V, OFF_WS = OFF_K + 2 * SHM_K, LDS_BYTES = OFF_WS + NW * 64 * 4;
#define SBAR() __builtin_amdgcn_sched_barrier(0)
__device__ __forceinline__ int k_addr(int row, int chunk) { return row * KPITCH + ((chunk ^ ((row >> 1) & 7)) << 4); }
__device__ __forceinline__ int v_st(int k, int c) { const int kk = (k & ~0xC) | ((k & 4) << 1) | ((k & 8) >> 1); return ((kk >> 3) * 4 + (c >> 5)) * 512 + ((kk & 7) * 32 + (c & 31)) * 2; }
__device__ __forceinline__ int v_rd_base(int lane) { return ((lane & 3) << 3) | (((lane >> 2) & 3) << 6) | (((lane >> 4) & 1) << 5) | (((lane >> 5) & 1) << 8); }
constexpr int v_rd_off(int d0, int ks, int half) { return d0 * 512 + ks * 4096 + half * 2048; }
__device__ __forceinline__ int crow(int r, int hi) { return (r & 3) + 8 * (r >> 2) + 4 * hi; }

template <int KB>
__device__ __forceinline__ void qkt(f32x16& p0, f32x16& p1, const LAS char* K_lds, int r32, int hi, const bf16x8* qr) {
    p0 = f32x16{}; p1 = f32x16{};
    const LAS char* kb[4];
#pragma unroll
    for (int dd = 0; dd < 4; ++dd) kb[dd] = K_lds + KB * SHM_K + r32 * KPITCH + (((2 * dd + hi) ^ ((r32 >> 1) & 7)) << 4);
    bf16x8 f[2][4];
#define QK_LD(g, buf) do { _Pragma("unroll") for (int e_ = 0; e_ < 2; ++e_) { const int d0_ = 2 * (g) + e_; const LAS char* a_ = kb[d0_ & 3] + (d0_ >> 2) * 128; \
        f[buf][2 * e_] = *(const LAS bf16x8*)a_; f[buf][2 * e_ + 1] = *(const LAS bf16x8*)(a_ + 32 * KPITCH); } } while (0)
    QK_LD(0, 0);
#pragma unroll
    for (int g = 0; g < 6; ++g) {
        if (g < 5) QK_LD(g + 1, (g + 1) & 1);
        SBAR();
#pragma unroll
        for (int e = 0; e < 2; ++e) { const int d0 = 2 * g + e;
            p0 = __builtin_amdgcn_mfma_f32_32x32x16_bf16(f[g & 1][2 * e], qr[d0], p0, 0, 0, 0);
            p1 = __builtin_amdgcn_mfma_f32_32x32x16_bf16(f[g & 1][2 * e + 1], qr[d0], p1, 0, 0, 0); }
        SBAR(); }
#undef QK_LD
}
__device__ __forceinline__ void pv_tile(f32x16* o, int vb0  , bf16x8 pa0, bf16x8 pa1, bf16x8 pa2, bf16x8 pa3) {
#define TRRD(dst, off) asm volatile("ds_read_b64_tr_b16 %0, %1 offset:%2" : "=&v"(dst) : "v"(vb0), "i"(off) : "memory")
    s16x4 vl[2][4], vh[2][4];
#define PV_LD(d0, bf) do { constexpr int b_ = v_rd_off(d0, 0, 0); TRRD(vl[bf][0], b_); TRRD(vh[bf][0], b_ + 2048); TRRD(vl[bf][1], b_ + 4096); TRRD(vh[bf][1], b_ + 6144); \
        TRRD(vl[bf][2], b_ + 8192); TRRD(vh[bf][2], b_ + 10240); TRRD(vl[bf][3], b_ + 12288); TRRD(vh[bf][3], b_ + 14336); } while (0)
#define PV_FR(bf, k) (bf16x8){vl[bf][k][0], vl[bf][k][1], vl[bf][k][2], vl[bf][k][3], vh[bf][k][0], vh[bf][k][1], vh[bf][k][2], vh[bf][k][3]}
#define PV_MM(d0, bf) do { o[d0] = __builtin_amdgcn_mfma_f32_32x32x16_bf16(pa0, PV_FR(bf, 0), o[d0], 0, 0, 0); o[d0] = __builtin_amdgcn_mfma_f32_32x32x16_bf16(pa1, PV_FR(bf, 1), o[d0], 0, 0, 0); \
        o[d0] = __builtin_amdgcn_mfma_f32_32x32x16_bf16(pa2, PV_FR(bf, 2), o[d0], 0, 0, 0); o[d0] = __builtin_amdgcn_mfma_f32_32x32x16_bf16(pa3, PV_FR(bf, 3), o[d0], 0, 0, 0); } while (0)
    PV_LD(0, 0);
    PV_LD(1, 1); asm volatile("s_waitcnt lgkmcnt(8)" ::: "memory"); SBAR(); PV_MM(0, 0); SBAR();
    PV_LD(2, 0); asm volatile("s_waitcnt lgkmcnt(8)" ::: "memory"); SBAR(); PV_MM(1, 1); SBAR();
    PV_LD(3, 1); asm volatile("s_waitcnt lgkmcnt(8)" ::: "memory"); SBAR(); PV_MM(2, 0); SBAR();
    asm volatile("s_waitcnt lgkmcnt(0)" ::: "memory"); SBAR(); PV_MM(3, 1);
#undef PV_LD
#undef PV_FR
#undef PV_MM
#undef TRRD
}
__device__ __forceinline__ void mask_tile(f32x16& p0, f32x16& p1, int dq  ) {
    const float NEG = -__builtin_inff();
#pragma unroll
    for (int r = 0; r < 16; ++r) { const int c = (r & 3) + 8 * (r >> 2);
        if (c > dq) p0[r] = NEG;
        if (c + 32 > dq) p1[r] = NEG; }
}
__device__ __forceinline__ void softmax_tile(f32x16& p0, f32x16& p1, float& m_reg, float& l_reg, float& alpha, bf16x8& pa0, bf16x8& pa1, bf16x8& pa2, bf16x8& pa3) {
    float pmax = p0[0];
#pragma unroll
    for (int r = 1; r < 16; ++r) pmax = fmaxf(pmax, p0[r]);
#pragma unroll
    for (int r = 0; r < 16; ++r) pmax = fmaxf(pmax, p1[r]);
    { auto rr = __builtin_amdgcn_permlane32_swap(__float_as_uint(pmax), __float_as_uint(pmax), false, false); pmax = fmaxf(__uint_as_float(rr[0]), __uint_as_float(rr[1])); }
    float mn = m_reg; alpha = 1.f;
    if (!__all(pmax - m_reg <= 8.0f)) { mn = fmaxf(m_reg, pmax); alpha = __builtin_amdgcn_exp2f(m_reg - mn); m_reg = mn; }
    float ps = 0.f;
#pragma unroll
    for (int r = 0; r < 16; ++r) { p0[r] = __builtin_amdgcn_exp2f(p0[r] - mn); ps += p0[r]; }
#pragma unroll
    for (int r = 0; r < 16; ++r) { p1[r] = __builtin_amdgcn_exp2f(p1[r] - mn); ps += p1[r]; }
    { auto rr = __builtin_amdgcn_permlane32_swap(__float_as_uint(ps), __float_as_uint(ps), false, false); ps = __uint_as_float(rr[0]) + __uint_as_float(rr[1]); }
    l_reg = l_reg * alpha + ps;
#define PK4(P, B_, OUT) do { unsigned a0 = cvt_pk_bf16(P[B_+0], P[B_+1]), a1 = cvt_pk_bf16(P[B_+2], P[B_+3]); \
        unsigned b0 = cvt_pk_bf16(P[B_+4], P[B_+5]), b1 = cvt_pk_bf16(P[B_+6], P[B_+7]); \
        auto r0 = __builtin_amdgcn_permlane32_swap(a0, b0, false, false); auto r1 = __builtin_amdgcn_permlane32_swap(a1, b1, false, false); \
        u32x4 w = {r0[0], r1[0], r0[1], r1[1]}; OUT = __builtin_bit_cast(bf16x8, w); } while (0)
    PK4(p0, 0, pa0); PK4(p0, 8, pa1); PK4(p1, 0, pa2); PK4(p1, 8, pa3);
#undef PK4
}

__device__ __forceinline__ void attn_block(int b, int h, int qb, const bf16_t* Q, const bf16_t* KN, const bf16_t* KR, const bf16_t* V, bf16_t* O, LAS char* lds, unsigned long long* pw = nullptr) {
    const int tid = opaque_tid(), wid = __builtin_amdgcn_readfirstlane(tid >> 6), lane = tid & 63, r32 = lane & 31, hi = lane >> 5;
    const size_t row0 = (size_t)b * SEQ;
    const int q0 = qb * QB + wid * QBLK;
    const int NT = (qb + 1) * (QB / KVBLK);
    LAS char* V_lds = lds + OFF_V; LAS char* K_lds = lds + OFF_K;
    LAS float* ws = (LAS float*)(lds + OFF_WS) + wid * 64; LAS float* li_l = ws; LAS float* al_l = ws + 32;
    const int vb0 = (int)(uintptr_t)lds + v_rd_base(lane);
    const char* gb = (const char*)KR;
    const unsigned dKN = (unsigned)((const char*)KN - gb), dV = (unsigned)((const char*)V - gb);
    unsigned ko[3], ks[3], vo2[2];
#pragma unroll
    for (int i = 0; i < 3; ++i) { const int slot = (wid + 8 * i) * 64 + lane, row = slot / 24, chunk = (slot - row * 24) ^ ((row >> 1) & 7);
        const bool nope = chunk < 16;
        ko[i] = nope ? dKN + (unsigned)(((int)(row0 + row) * 1024 + h * 128 + chunk * 8) * 2) : (unsigned)(((int)(row0 + row) * 64 + (chunk - 16) * 8) * 2);
        ks[i] = nope ? (unsigned)(KVBLK * 2048) : (unsigned)(KVBLK * 128); }
#pragma unroll
    for (int i = 0; i < 2; ++i) { const int slot = (wid + 8 * i) * 64 + lane, sub = slot >> 5, q = slot & 31, kk = (sub >> 2) * 8 + (q >> 2), c = (sub & 3) * 32 + (q & 3) * 8;
        const int k = (kk & ~0xC) | ((kk & 4) << 1) | ((kk & 8) >> 1);
        vo2[i] = dV + (unsigned)(((int)(row0 + k) * 1024 + h * 128 + c) * 2); }
#define SDMA(bf, vo) do { _Pragma("unroll") for (int i_ = 0; i_ < 3; ++i_) { __builtin_amdgcn_global_load_lds((const unsigned*)(gb + (size_t)ko[i_]), (LAS unsigned*)(K_lds + (bf) * SHM_K + (wid + 8 * i_) * 1024), 16, 0, 0); ko[i_] += ks[i_]; } \
        _Pragma("unroll") for (int i_ = 0; i_ < 2; ++i_) { __builtin_amdgcn_global_load_lds((const unsigned*)(gb + (size_t)vo2[i_]), (LAS unsigned*)(V_lds + (vo) + (wid + 8 * i_) * 1024), 16, 0, 0); vo2[i_] += (unsigned)(KVBLK * 2048); } } while (0)
    SDMA(0, 0);
    bf16x8 qr[12];
    { const bf16_t* Qw = Q + (row0 + q0 + r32) * 1536 + h * 192 + hi * 8;
#pragma unroll
      for (int d0 = 0; d0 < 12; ++d0) qr[d0] = *(const bf16x8*)(Qw + d0 * 16); }
    float m_reg = -1e30f, l_reg = 0.f; f32x16 o[4] = {};
    f32x16 p0, p1; bf16x8 pa0, pa1, pa2, pa3; float alpha;
    asm volatile("s_waitcnt vmcnt(0)" ::: "memory");
    __syncthreads();
    const bool odd = wid >= 4; int vo_prev = 0, vo_cur = 0, vo_next = SHM_V;
#define RESC(a) do { if (__any((a) < 1.f)) { if (hi == 0) al_l[r32] = (a); asm volatile("s_waitcnt lgkmcnt(0)" ::: "memory"); \
        _Pragma("unroll") for (int d_ = 0; d_ < 4; ++d_) _Pragma("unroll") for (int r = 0; r < 16; ++r) o[d_][r] *= al_l[crow(r, hi)]; } } while (0)
#if PROBE_T
    unsigned long long pa_ = 0, pb_ = 0, pc_ = 0, pd_ = 0, pe2_ = 0; const unsigned long long pst_ = __builtin_amdgcn_s_memtime();
#define PSTAMP(v) const unsigned long long v = __builtin_amdgcn_s_memtime()
#define PACC(acc, a, b) acc += (b) - (a)
#else
#define PSTAMP(v) do {} while (0)
#define PACC(acc, a, b) do {} while (0)
#endif
#define TILE(t, BF) do { PSTAMP(s0_); const bool more_ = ((t) + 1 < NT); if (more_) SDMA((BF) ^ 1, vo_next); SBAR(); \
        if (odd && (t) > 0) { pv_tile(o, vb0 + vo_prev, pa0, pa1, pa2, pa3); SBAR(); } \
        PSTAMP(s1_); qkt<BF>(p0, p1, K_lds, r32, hi, qr); \
        { const int kb_ = (t) * KVBLK; if (kb_ + KVBLK - 1 > q0) mask_tile(p0, p1, q0 + r32 - kb_ - 4 * hi); } \
        asm volatile("" : "+v"(p0), "+v"(p1)); PSTAMP(s2_); \
        softmax_tile(p0, p1, m_reg, l_reg, alpha, pa0, pa1, pa2, pa3); RESC(alpha); SBAR(); PSTAMP(s3_); \
        if (!odd) pv_tile(o, vb0 + vo_cur, pa0, pa1, pa2, pa3); \
        PSTAMP(s4_); asm volatile("s_waitcnt vmcnt(0)" ::: "memory"); \
        PSTAMP(s5_); __syncthreads(); PSTAMP(s6_); PACC(pa_, s1_, s2_); PACC(pb_, s2_, s3_); PACC(pc_, s3_, s4_); PACC(pd_, s4_, s5_); PACC(pe2_, s5_, s6_); vo_prev = vo_cur; vo_cur = vo_next; vo_next = (vo_next == (NVB - 1) * SHM_V) ? 0 : vo_next + SHM_V; } while (0)
#pragma unroll 1
    for (int t = 0; t < NT; t += 2) { TILE(t, 0); TILE(t + 1, 1); }
    if (odd) pv_tile(o, vb0 + vo_prev, pa0, pa1, pa2, pa3);
#if PROBE_T
    if (pw && blockIdx.x == 0 && tid == 0) { pw[8] += pa_; pw[9] += pb_; pw[10] += pc_; pw[11] += pd_; pw[12] += pe2_; pw[13] += (unsigned long long)NT; pw[14] += __builtin_amdgcn_s_memtime() - pst_; }
#endif
    if (hi == 0) li_l[r32] = l_reg; asm volatile("s_waitcnt lgkmcnt(0)" ::: "memory");
    __syncthreads();
    { LAS bf16_t* stg = (LAS bf16_t*)(lds + wid * 8704);
#pragma unroll
      for (int r = 0; r < 16; ++r) { const int orow = crow(r, hi); const float rl = __builtin_amdgcn_rcpf(li_l[orow]);
#pragma unroll
          for (int d0 = 0; d0 < 4; ++d0) { const float v = o[d0][r] * rl; stg[orow * 136 + d0 * 32 + r32] = (bf16_t)(cvt_pk_bf16(v, v) & 0xffffu); } }
      asm volatile("s_waitcnt lgkmcnt(0)" ::: "memory");
      bf16_t* Ow = O + (row0 + q0) * 1024 + h * 128 + (lane & 15) * 8;
#pragma unroll
      for (int it = 0; it < 8; ++it) { const int row = it * 4 + (lane >> 4); const u32x4 v = *(const LAS u32x4*)(stg + row * 136 + (lane & 15) * 8); *(u32x4*)(Ow + (size_t)row * 1024) = v; } }
    __syncthreads();
#undef SDMA
#undef RESC
#undef TILE
#undef PSTAMP
#undef PACC
}
#undef SBAR
}

#define XB_TMO      128
#define XB_XCNT(j)  (256  + 64 * (j))
#define XB_XSUB(j)  (1280 + 64 * (j))
#define XB_XGEN(j)  (2304 + 64 * (j))
#define XB_TOP      3328
#define XB_TOPGEN   3392
#define XCD_BAR_WORDS 3456
#define XB_SPIN_CAP (1u << 22)
__device__ __forceinline__ unsigned xb_ld(unsigned* p)              { return __hip_atomic_load(p, __ATOMIC_RELAXED, __HIP_MEMORY_SCOPE_AGENT); }
__device__ __forceinline__ unsigned xb_add(unsigned* p, unsigned v) { return __hip_atomic_fetch_add(p, v, __ATOMIC_RELAXED, __HIP_MEMORY_SCOPE_AGENT); }
__device__ __forceinline__ unsigned xb_xcc_id() { return (unsigned)__builtin_amdgcn_s_getreg((3 << 11) | 20) & 0xFu; }
#define XB_SPIN(cond, bar) do { unsigned _sp = 0; while (cond) { __builtin_amdgcn_s_sleep(1); \
    if ((++_sp & 255u) == 0u) { if (xb_ld(&(bar)[XB_TMO])) break; if (_sp > XB_SPIN_CAP) { atomicAdd(&(bar)[XB_TMO], 1u); break; } } } } while (0)
struct XcdBarrier { unsigned* bar; unsigned x; volatile LAS unsigned* st; };
__device__ __forceinline__ XcdBarrier xcd_barrier_post(unsigned* bar, volatile LAS unsigned* st) {
    XcdBarrier b; b.bar = bar; b.x = xb_xcc_id(); b.st = st;
    if (threadIdx.x == 0) (void)xb_add(&bar[XB_XCNT(b.x)], 1u);
    return b;
}
__device__ __forceinline__ void xcd_barrier_complete(unsigned* bar, unsigned x, unsigned& nloc, unsigned& nx) {
    const unsigned G = gridDim.x * gridDim.y * gridDim.z;
    unsigned sum, cnt, mine, sp = 0u;
    for (;;) {
        sum = 0u; cnt = 0u; mine = 0u;
#pragma unroll
        for (unsigned j = 0; j < 16; ++j) { const unsigned c = xb_ld(&bar[XB_XCNT(j)]); sum += c; cnt += (c > 0u) ? 1u : 0u; mine = (j == x) ? c : mine; }
        if (sum == G) break;
        __builtin_amdgcn_s_sleep(1);
        if ((++sp & 255u) == 0u) { if (xb_ld(&bar[XB_TMO])) break; if (sp > XB_SPIN_CAP) { atomicAdd(&bar[XB_TMO], 1u); break; } }
    }
    nloc = mine > 0u ? mine : 1u; nx = cnt > 0u ? cnt : 1u;
}
__device__ __forceinline__ void xcd_barrier(const XcdBarrier& b) {
    asm volatile("s_waitcnt vmcnt(0)" ::: "memory");
    __syncthreads();
    if (opaque_tid() == 0) {
        unsigned* bar = b.bar; unsigned bx = b.x;
        asm volatile("" : "+s"(bar), "+s"(bx));
        __builtin_amdgcn_s_waitcnt(0);
        unsigned nloc = b.st[0], nx = b.st[1];
        if (nloc == 0u) { xcd_barrier_complete(bar, bx, nloc, nx); b.st[0] = nloc; b.st[1] = nx; }
        const unsigned old = xb_add(&bar[XB_XSUB(bx)], 1u);
        const unsigned gen = old / nloc;
        if (old + 1u == (gen + 1u) * nloc) {
            __builtin_amdgcn_fence(__ATOMIC_RELEASE, "agent");
            asm volatile("s_waitcnt vmcnt(0)" ::: "memory");
            const unsigned og = xb_add(&bar[XB_TOP], 1u);
            const unsigned tg = og / nx;
            if (og + 1u == (tg + 1u) * nx) xb_add(&bar[XB_TOPGEN], 1u);
            else XB_SPIN(xb_ld(&bar[XB_TOPGEN]) == tg, bar);
            __builtin_amdgcn_fence(__ATOMIC_ACQUIRE, "agent");
            xb_add(&bar[XB_XGEN(bx)], 1u);
            asm volatile("s_waitcnt vmcnt(0)" ::: "memory");
        } else {
            XB_SPIN(xb_ld(&bar[XB_XGEN(bx)]) == gen, bar);
            __builtin_amdgcn_fence(__ATOMIC_ACQUIRE, "agent");
            asm volatile("s_waitcnt vmcnt(0)" ::: "memory");
        }
    }
    __syncthreads();
}

struct Args { const void* in[30]; float* out; unsigned char* ws; int ph_lo, ph_hi, li, pad; };
struct Ctx { int tid, lane, wave, vcu, G, bid; LAS unsigned char* lds; volatile LAS int* misc; };
__device__ __forceinline__ Ctx fresh_ctx(const Ctx& c) {
    Ctx r = c; unsigned l = (unsigned)(uintptr_t)c.lds, m = (unsigned)(uintptr_t)c.misc;
    asm volatile("" : "+s"(r.wave), "+s"(r.vcu), "+s"(r.G), "+s"(r.bid), "+s"(l), "+s"(m));
    r.lds = (LAS unsigned char*)(uintptr_t)l; r.misc = (volatile LAS int*)(uintptr_t)m; r.tid = opaque_tid(); r.lane = r.tid & 63; return r; }
typedef const CAS Args* ArgsP;
__device__ __forceinline__ const CAS Args& fresh_args(ArgsP p) { asm volatile("" : "+s"(p)); return *p; }
enum { I_X = 0, I_P, I_POS, I_MLA_WIN, I_MLA_QN, I_MLA_KVN, I_MLA_WUQ, I_MLA_WUKV, I_MLA_WO, I_LRU_WIN, I_LRU_CW, I_LRU_CB, I_LRU_WA, I_LRU_BA, I_LRU_WX, I_LRU_BX, I_LRU_LAM, I_LRU_WOUT,
       I_LN1G, I_LN1B, I_LN2G, I_LN2B, I_MOE_WR, I_MOE_BR, I_MOE_WUP, I_MOE_BUP, I_MOE_WDN, I_MOE_BDN, I_PLE_WG, I_PLE_WP };
#define INF(i) ((const float*)args.in[i])
#define WSP(T_, off) ((T_*)(args.ws + (off)))

__device__ __forceinline__ void tr_load(const float* W, int ld, int k0, int sc0, int sc1, int lane, f32x4 (&v)[16]) {
    const int half = (lane & 15) >> 3, scol = half ? sc1 : sc0, c4 = (lane & 7) * 4, rs = lane >> 4;
#pragma unroll
    for (int i = 0; i < 8; ++i) { const float* p = W + (size_t)(k0 + 8 * i + 2 * rs) * ld + scol + c4;
        v[2 * i] = (scol >= 0) ? *(const f32x4*)p : (f32x4){0.f, 0.f, 0.f, 0.f}; v[2 * i + 1] = (scol >= 0) ? *(const f32x4*)(p + ld) : (f32x4){0.f, 0.f, 0.f, 0.f}; }
}
__device__ __forceinline__ void tr_store(f32x4 (&v)[16], const float* ksc, int k0, bf16_t* dst  , int K, LAS unsigned* scr, int lane) {
    const int rs = lane >> 4;
    if (ksc) {
#pragma unroll
        for (int i = 0; i < 8; ++i) { v[2 * i] = v[2 * i] * ksc[k0 + 8 * i + 2 * rs]; v[2 * i + 1] = v[2 * i + 1] * ksc[k0 + 8 * i + 2 * rs + 1]; } }
#pragma unroll
    for (int i = 0; i < 8; ++i) { LAS unsigned* s = scr + (4 * i + rs) * 65 + (lane & 15) * 4;
#pragma unroll
        for (int e = 0; e < 4; ++e) s[e] = cvt_pk_bf16(v[2 * i][e], v[2 * i + 1][e]); }
    asm volatile("s_waitcnt lgkmcnt(0)" ::: "memory");
    const int c = lane & 7;
#pragma unroll
    for (int j = 0; j < 8; ++j) { const int n = (lane >> 3) + 8 * j; const LAS unsigned* s = scr + (4 * c) * 65 + n;
        u32x4 o; o.x = s[0]; o.y = s[65]; o.z = s[130]; o.w = s[195];
        *(u32x4*)(dst + (size_t)n * K + 8 * c) = o; }
    asm volatile("s_waitcnt lgkmcnt(0)" ::: "memory");
}
enum { J_NAT = 0, J_MLA_WIN, J_MLA_WUQ, J_LRU_WAX, J_MOE_UP };
__device__ __forceinline__ int tr_map(int job, int g) {
    switch (job) {
    case J_MLA_WIN: return g < 32 ? 32 * g : (g == 32 ? 1024 : (g == 36 ? 1056 : -1));
    case J_MLA_WUQ: if (g < 32) { const int t = g >> 3, bj = (g >> 2) & 1, cg = g & 3; return (2 * t + bj) * 192 + 32 * cg; }
                    else { const int g2 = g - 32, t2 = g2 >> 3, bj = (g2 >> 2) & 1, hh = g2 & 3; return (4 * t2 + hh) * 192 + 128 + 32 * bj; }
    case J_LRU_WAX: { const int pn = g >> 3, cg = g & 3; return 128 * pn + 32 * cg; }
    case J_MOE_UP:  { const int pn = g >> 3, bj = (g >> 2) & 1, cg = g & 3; return bj * 1024 + 128 * pn + 32 * cg; }
    default: return 32 * g;
    }
}
__device__ __forceinline__ void tr_job(const Ctx& C, int job, const float* src, size_t srcstride, int nmat, int K, int ld, int N, bf16_t* dst, size_t dststride, const float* ksc, int kscstride,
                                       const float* src2  ) {
    LAS unsigned* scr = (LAS unsigned*)(C.lds + C.wave * 8320);
    const int gw = C.vcu * NWAVES + C.wave, NGW = C.G * NWAVES;
    const int nkb = K / 64, nnb = N / 64, per = nkb * nnb, total = per * nmat;
#define TR_DECODE(it_, W_, k0_, s0_, s1_, ks_, d_) do { const int mat_ = (it_) / per, r_ = (it_) - mat_ * per, kb_ = r_ / nnb, nb_ = r_ - kb_ * nnb; \
        s0_ = tr_map(job, 2 * nb_); s1_ = tr_map(job, 2 * nb_ + 1); W_ = src + (size_t)mat_ * srcstride; \
        if (job == J_LRU_WAX && ((nb_ >> 1) & 1)) W_ = src2 + (size_t)mat_ * srcstride;       \
        k0_ = kb_ * 64; ks_ = ksc ? ksc + (size_t)mat_ * kscstride : nullptr; d_ = (bf16_t*)((char*)dst + (size_t)mat_ * dststride) + (size_t)(nb_ * 64) * K + kb_ * 64; } while (0)
    f32x4 va[16], vb[16];
    int it = gw; const float* Wc; int k0c, s0c, s1c; const float* ksc_c; bf16_t* dc;
    if (it < total) { TR_DECODE(it, Wc, k0c, s0c, s1c, ksc_c, dc); tr_load(Wc, ld, k0c, s0c, s1c, C.lane, va); }
    while (it < total) {
        const int nit = it + NGW; const float* Wn = nullptr; int k0n = 0, s0n = 0, s1n = 0; const float* ksc_n = nullptr; bf16_t* dn = nullptr;
        if (nit < total) { TR_DECODE(nit, Wn, k0n, s0n, s1n, ksc_n, dn); tr_load(Wn, ld, k0n, s0n, s1n, C.lane, vb); }
        tr_store(va, ksc_c, k0c, dc, K, scr, C.lane);
#pragma unroll
        for (int i = 0; i < 16; ++i) va[i] = vb[i];
        it = nit; k0c = k0n; ksc_c = ksc_n; dc = dn;
    }
#undef TR_DECODE
}
template <int JOB, int N, bool G64  >
__device__ __forceinline__ void tr_job_fp8(const Ctx& C, const float* src, size_t srcstride, int nmat, unsigned char* dst, size_t dststride, unsigned char* SW) {
    constexpr int K = 1024, ld = N;
    LAS float* scr = (LAS float*)(C.lds + C.wave * 16640);
    const int gw = C.vcu * NWAVES + C.wave, NGW = C.G * NWAVES, lane = C.lane;
    const int nkb = K / 64, nnb = N / 64, per = nkb * nnb, total = per * nmat;
    f32x4 v[16], vn[16];
    if (gw < total) { const int mat = gw / per, r = gw - mat * per, kb = r / nnb, nb = r - kb * nnb; tr_load(src + (size_t)mat * srcstride, ld, kb * 64, tr_map(JOB, 2 * nb), tr_map(JOB, 2 * nb + 1), lane, v); }
    for (int it = gw; it < total; it += NGW) {
        const int mat = it / per, r = it - mat * per, kb = r / nnb, nb = r - kb * nnb;
        { const int nit = it + NGW; if (nit < total) { const int matn = nit / per, rn = nit - matn * per, kbn = rn / nnb, nbn = rn - kbn * nnb; tr_load(src + (size_t)matn * srcstride, ld, kbn * 64, tr_map(JOB, 2 * nbn), tr_map(JOB, 2 * nbn + 1), lane, vn); } }
        const int rs = lane >> 4;
#pragma unroll
        for (int i = 0; i < 8; ++i) { LAS float* sp = scr + (8 * i + 2 * rs) * 65 + (lane & 15) * 4;
#pragma unroll
            for (int e = 0; e < 4; ++e) { sp[e] = v[2 * i][e]; sp[65 + e] = v[2 * i + 1][e]; } }
        asm volatile("s_waitcnt lgkmcnt(0)" ::: "memory");
        const int c = lane & 7;
#pragma unroll
        for (int j = 0; j < 8; ++j) { const int n = (lane >> 3) + 8 * j; const LAS float* sp = scr + (8 * c) * 65 + n;
            float x[8]; float am = 0.f;
#pragma unroll
            for (int q = 0; q < 8; ++q) { x[q] = sp[q * 65]; am = fmaxf(am, fabsf(x[q])); }
            am = fmaxf(am, __shfl_xor(am, 1)); am = fmaxf(am, __shfl_xor(am, 2));
            if (G64) am = fmaxf(am, __shfl_xor(am, 4));
            int eb = (int)((__float_as_uint(am) >> 23) & 0xffu) - 7; eb = eb < 1 ? 1 : eb;
            const float inv = __uint_as_float((unsigned)(254 - eb) << 23);
            int w0 = __builtin_amdgcn_cvt_pk_fp8_f32(x[0] * inv, x[1] * inv, 0, false); w0 = __builtin_amdgcn_cvt_pk_fp8_f32(x[2] * inv, x[3] * inv, w0, true);
            int w1 = __builtin_amdgcn_cvt_pk_fp8_f32(x[4] * inv, x[5] * inv, 0, false); w1 = __builtin_amdgcn_cvt_pk_fp8_f32(x[6] * inv, x[7] * inv, w1, true);
            const int nrow = nb * 64 + n;
            *(u32x2*)(dst + (size_t)mat * dststride + (size_t)nrow * K + kb * 64 + 8 * c) = (u32x2){(unsigned)w0, (unsigned)w1};
            if (!G64) { if ((c & 3) == 0) SW[(size_t)mat * 65536 + (size_t)(nrow >> 8) * 8192 + (size_t)(kb >> 1) * 1024 + (nrow & 255) * 4 + 2 * (kb & 1) + (c >> 2)] = (unsigned char)eb; }
            else { if (c == 0) SW[(size_t)mat * 16384 + (size_t)(nrow >> 8) * 4096 + (size_t)(kb >> 1) * 512 + (nrow & 255) * 2 + (kb & 1)] = (unsigned char)eb; } }
        asm volatile("s_waitcnt lgkmcnt(0)" ::: "memory");
#pragma unroll
        for (int i = 0; i < 16; ++i) v[i] = vn[i];
    }
}
__device__ __forceinline__ void cvt_rows(const Ctx& C, const float* src, bf16_t* dst, size_t n8  ) {
    const size_t gt = (size_t)C.vcu * 512 + C.tid, NT = (size_t)C.G * 512;
    size_t i = gt;
    for (; i + 3 * NT < n8; i += 4 * NT) {
        f32x4 a[4], b[4];
#pragma unroll
        for (int q = 0; q < 4; ++q) { a[q] = *(const f32x4*)(src + (i + q * NT) * 8); b[q] = *(const f32x4*)(src + (i + q * NT) * 8 + 4); }
#pragma unroll
        for (int q = 0; q < 4; ++q) *(u32x4*)(dst + (i + q * NT) * 8) = pack8(a[q], b[q]); }
    for (; i < n8; i += NT) { const f32x4 a = *(const f32x4*)(src + i * 8), b = *(const f32x4*)(src + i * 8 + 4); *(u32x4*)(dst + i * 8) = pack8(a, b); }
}
__device__ __forceinline__ void phase_prologue(const CAS Args& args, const Ctx& C) {
    tr_job(C, J_MLA_WIN, INF(I_MLA_WIN), (size_t)DM * LATD, 2, DM, LATD, 1280, WSP(bf16_t, WS_W_MLA + OFF_MLA_WIN), W_MLA_STRIDE, nullptr, 0, nullptr);
    tr_job(C, J_MLA_WUQ, INF(I_MLA_WUQ), (size_t)QL * 1536, 2, QL, 1536, 1536, WSP(bf16_t, WS_W_MLA + OFF_MLA_WUQ), W_MLA_STRIDE, INF(I_MLA_QN), QL, nullptr);
    tr_job(C, J_NAT, INF(I_MLA_WUKV), (size_t)KVL * 2048, 2, KVL, 2048, 2048, WSP(bf16_t, WS_W_MLA + OFF_MLA_WUKV), W_MLA_STRIDE, INF(I_MLA_KVN), KVL, nullptr);
    tr_job(C, J_NAT, INF(I_MLA_WO), (size_t)DM * DM, 2, DM, DM, DM, WSP(bf16_t, WS_W_MLA + OFF_MLA_WO), W_MLA_STRIDE, nullptr, 0, nullptr);
    tr_job(C, J_NAT, INF(I_LRU_WIN), (size_t)DM * 2048, 2, DM, 2048, 2048, WSP(bf16_t, WS_W_LRU + OFF_LRU_WIN), W_LRU_STRIDE, nullptr, 0, nullptr);
    for (int j = 0; j < 2; ++j)
        tr_job(C, J_LRU_WAX, INF(I_LRU_WA) + (size_t)j * 4 * 65536, (size_t)256 * 256, 4, 256, 256, 512, WSP(bf16_t, WS_W_LRU + OFF_LRU_WAX + (size_t)j * W_LRU_STRIDE), (size_t)512 * 256 * 2, nullptr, 0, INF(I_LRU_WX) + (size_t)j * 4 * 65536);
    tr_job(C, J_NAT, INF(I_LRU_WOUT), (size_t)DM * DM, 2, DM, DM, DM, WSP(bf16_t, WS_W_LRU + OFF_LRU_WOUT), W_LRU_STRIDE, nullptr, 0, nullptr);
    tr_job(C, J_NAT, INF(I_PLE_WP), (size_t)PLED * DM, 4, PLED, DM, DM, WSP(bf16_t, WS_W_PLE + OFF_PLE_WP), W_PLE_STRIDE, nullptr, 0, nullptr);
    __syncthreads();
    tr_job_fp8<J_MOE_UP, 2048, false>(C, INF(I_MOE_WUP), (size_t)DM * 2048, DEPTH * NE, args.ws + WS_W_UP, (size_t)2048 * 1024, args.ws + WS_SW);
    tr_job_fp8<J_NAT, 1024, true>(C, INF(I_MOE_WDN), (size_t)DFF * DM, DEPTH * NE, args.ws + WS_W_DN, (size_t)1024 * 1024, args.ws + WS_SWD);
    tr_job_fp8<J_NAT, 1024, false>(C, INF(I_PLE_WG), (size_t)DM * DM, DEPTH, args.ws + WS_W_PLE + OFF_PLE_WG, W_PLE_STRIDE, args.ws + WS_SWG);
    __syncthreads();
    cvt_rows(C, INF(I_X), WSP(bf16_t, WS_XB), (size_t)T * DM / 8);
    cvt_rows(C, INF(I_P), WSP(bf16_t, WS_PB), (size_t)DEPTH * T * PLED / 8);
    { const int* pos = (const int*)args.in[I_POS]; float* CS = WSP(float, WS_CS); float* SN = WSP(float, WS_SN);
      const size_t gt = (size_t)C.vcu * 512 + C.tid, NT = (size_t)C.G * 512;
      { const double inv = exp(-9.210340371976184 * (double)(int)(gt & 31) / 32.0);
        for (size_t i = gt; i < (size_t)T * 32; i += NT) { const int tok = (int)(i >> 5);
            const double ang = (double)pos[tok] * inv, n = rint(ang * 0.15915494309189535); double r = fma(-n, 6.283185307179586, ang); r = fma(-n, 2.4492935982947064e-16, r);
            const float rf = (float)r; CS[i] = cosf(rf); SN[i] = sinf(rf); } }
      { const float* wr = INF(I_MOE_WR); const float* lg1 = INF(I_LN1G); bf16_t* WRH = WSP(bf16_t, WS_WRH); bf16_t* WRL = WSP(bf16_t, WS_WRL);
        for (size_t i = gt; i < (size_t)DEPTH * 64 * 64; i += NT) { const int l = (int)(i >> 12), st = (int)(i >> 6) & 63, ln = (int)i & 63; float w[8], lo[8];
#pragma unroll
            for (int j = 0; j < 8; ++j) { const int k = 16 * st + 8 * (ln >> 5) + j; w[j] = lg1[l * DM + k] * wr[((size_t)l * DM + k) * NE + (ln & 31)]; }
            u32x4 h; h.x = cvt_pk_bf16(w[0], w[1]); h.y = cvt_pk_bf16(w[2], w[3]); h.z = cvt_pk_bf16(w[4], w[5]); h.w = cvt_pk_bf16(w[6], w[7]);
            lo[0] = w[0] - bf_lo(h.x); lo[1] = w[1] - bf_hi(h.x); lo[2] = w[2] - bf_lo(h.y); lo[3] = w[3] - bf_hi(h.y); lo[4] = w[4] - bf_lo(h.z); lo[5] = w[5] - bf_hi(h.z); lo[6] = w[6] - bf_lo(h.w); lo[7] = w[7] - bf_hi(h.w);
            u32x4 q; q.x = cvt_pk_bf16(lo[0], lo[1]); q.y = cvt_pk_bf16(lo[2], lo[3]); q.z = cvt_pk_bf16(lo[4], lo[5]); q.w = cvt_pk_bf16(lo[6], lo[7]);
            *(u32x4*)(WRH + i * 8) = h; *(u32x4*)(WRL + i * 8) = q; }
        float* RC = WSP(float, WS_RC); const float* lb1 = INF(I_LN1B); const float* rb = INF(I_MOE_BR);
        for (int i = C.vcu * NWAVES + C.wave; i < DEPTH * NE; i += C.G * NWAVES) { const int l = i >> 5, e = i & 31; float c1 = 0.f, c2 = 0.f;
#pragma unroll
            for (int t = 0; t < DM / 64; ++t) { const int k = C.lane + 64 * t; const float w = wr[((size_t)l * DM + k) * NE + e]; c1 = fmaf(lg1[l * DM + k], w, c1); c2 = fmaf(lb1[l * DM + k], w, c2); }
            c1 = wave_sum(c1); c2 = wave_sum(c2);
            if (C.lane == 0) { RC[l * 64 + e] = c1; RC[l * 64 + 32 + e] = c2 + rb[l * NE + e]; } } }
      float* SPL = WSP(float, WS_SPL); const float* lam = INF(I_LRU_LAM);
      for (size_t i = gt; i < 2 * 1024; i += NT) { const double l = (double)lam[i]; SPL[i] = (float)(-8.0 * log1p(exp(-l))); } }
}

__device__ __forceinline__ void moe_table(const CAS Args& args, const Ctx& C0, int layer) {
    Ctx C = C0; C.tid = opaque_tid(); C.lane = C.tid & 63;
    const unsigned* cnt = WSP(unsigned, WS_CTL) + CW_CNT + 1024 * layer;
    __syncthreads();
    if (C.tid < 32) C.misc[64 + C.tid] = (int)__hip_atomic_load(cnt + CNT_STRIDE * C.tid, __ATOMIC_RELAXED, __HIP_MEMORY_SCOPE_AGENT);
    __syncthreads();
    if (C.tid == 0) { int acc = 0; for (int e = 0; e < 32; ++e) { C.misc[16 + e] = acc; acc += (C.misc[64 + e] + 255) >> 8; } C.misc[16 + 32] = acc; }
    __syncthreads();
    { volatile LAS unsigned char* te = (volatile LAS unsigned char*)(C.lds + TILE_E_OFF);
      for (int mg = C.tid; mg < C.misc[48]; mg += NWAVES * 64) { int e = 0; for (int j = 1; j < 32; ++j) e += (C.misc[16 + j] <= mg) ? 1 : 0; te[mg] = (unsigned char)e; } }
    __syncthreads();
}

__device__ __forceinline__ void phase_ln_router(const CAS Args& args, const Ctx& C0, int layer) {
    const int cslot = layer + args.pad;
    const int rskip = args.pad ? ROUTER_SKIP : 0;
    Ctx C = C0; C.tid = opaque_tid(); C.lane = C.tid & 63;
    const bf16_t* Y = WSP(bf16_t, WS_Y); float* STAT = WSP(float, WS_X1);
    const float* g1 = INF(I_LN1G) + layer * DM; const float* b1 = INF(I_LN1B) + layer * DM;
    const bf16_t* WRH = WSP(bf16_t, WS_WRH) + (size_t)layer * 64 * 64 * 8; const bf16_t* WRL = WSP(bf16_t, WS_WRL) + (size_t)layer * 64 * 64 * 8; const float* rc = WSP(float, WS_RC) + layer * 64;
    unsigned* gcnt = WSP(unsigned, WS_CTL) + CW_CNT + 1024 * cslot;
    int* lists = WSP(int, WS_LIST); int* slot = WSP(int, WS_SLOT); float* gate = WSP(float, WS_GATE);
    LAS float* part = (LAS float*)C.lds;
    volatile LAS int* lcnt = (volatile LAS int*)(C.lds + 69632);
    volatile LAS int* lbase = lcnt + 32;
    LAS float* stat = (LAS float*)(C.lds + 70144);
    f32x4 gv[4], bv[4];
#pragma unroll
    for (int j = 0; j < 2; ++j) { gv[2 * j] = *(const f32x4*)(g1 + 8 * C.lane + 512 * j); gv[2 * j + 1] = *(const f32x4*)(g1 + 8 * C.lane + 512 * j + 4);
        bv[2 * j] = *(const f32x4*)(b1 + 8 * C.lane + 512 * j); bv[2 * j + 1] = *(const f32x4*)(b1 + 8 * C.lane + 512 * j + 4); }
    unsigned char* X1Q = args.ws + WS_X1Q; int sexp;
    { float ag = 0.f, ab = 0.f;
#pragma unroll
      for (int j = 0; j < 4; ++j)
#pragma unroll
          for (int e = 0; e < 4; ++e) { ag = fmaxf(ag, fabsf(gv[j][e])); ab = fmaxf(ab, fabsf(bv[j][e])); }
#pragma unroll
      for (int o = 1; o < 64; o <<= 1) { ag = fmaxf(ag, __shfl_xor(ag, o)); ab = fmaxf(ab, __shfl_xor(ab, o)); }
      const float bound = 16.0f * ag + ab + 1e-20f;
      sexp = 134 - (int)((__float_as_uint(bound) >> 23) & 0xffu);
      sexp = sexp < -100 ? -100 : (sexp > 100 ? 100 : sexp);
      if (C.tid == 0) __hip_atomic_store(WSP(unsigned, WS_CTL) + CW_SA + layer, (unsigned)sexp, __ATOMIC_RELAXED, __HIP_MEMORY_SCOPE_AGENT); }
    const float qs = __uint_as_float((unsigned)(127 + sexp) << 23), qlo = KF(-448.f), qhi = KF(448.f);
    for (int chunk = C.vcu; chunk < T / 128; chunk += C.G) {
        const int row0 = chunk * 128;
        if (C.tid < 32) lcnt[C.tid] = 0;
        const int grp2 = C.wave >> 1, kh2 = C.wave & 1, r32 = C.lane & 31, hi = C.lane >> 5;
        const bf16_t* ah = Y + ((size_t)row0 + grp2 * 32 + r32) * DM + kh2 * 512 + hi * 8;
        const bf16_t* bh = WRH + ((size_t)kh2 * 32 * 64 + C.lane) * 8; const bf16_t* bl = WRL + ((size_t)kh2 * 32 * 64 + C.lane) * 8;
        f32x16 acc = {};
        bf16x8 xq[4], whq[4], wlq[4];
#define RT_LD4(s0_) do { _Pragma("unroll") for (int q_ = 0; q_ < 4; ++q_) { xq[q_] = *(const bf16x8*)(ah + ((s0_) + q_) * 16); whq[q_] = *(const bf16x8*)(bh + (size_t)((s0_) + q_) * 512); wlq[q_] = *(const bf16x8*)(bl + (size_t)((s0_) + q_) * 512); } } while (0)
#define RT_MM4() do { _Pragma("unroll") for (int q_ = 0; q_ < 4; ++q_) { acc = __builtin_amdgcn_mfma_f32_32x32x16_bf16(xq[q_], whq[q_], acc, 0, 0, 0); acc = __builtin_amdgcn_mfma_f32_32x32x16_bf16(xq[q_], wlq[q_], acc, 0, 0, 0); } } while (0)
        u32x4 yn[4][2];
#pragma unroll
        for (int r = 0; r < 4; ++r)
#pragma unroll
            for (int j = 0; j < 2; ++j) yn[r][j] = *(const u32x4*)(Y + ((size_t)row0 + C.wave * 16 + r) * DM + 8 * C.lane + 512 * j);
#pragma unroll 1
        for (int g = 0; g < 4; ++g) {
            u32x4 yc[4][2];
#pragma unroll
            for (int r = 0; r < 4; ++r) { yc[r][0] = yn[r][0]; yc[r][1] = yn[r][1]; }
            { const int gn = g < 3 ? g + 1 : g;
#pragma unroll
              for (int r = 0; r < 4; ++r)
#pragma unroll
                  for (int j = 0; j < 2; ++j) yn[r][j] = *(const u32x4*)(Y + ((size_t)row0 + C.wave * 16 + gn * 4 + r) * DM + 8 * C.lane + 512 * j); }
            auto ln_row = [&](int r) { const int i = g * 4 + r; const size_t row = (size_t)row0 + C.wave * 16 + i;
                f32x4 v[4]; float s = 0.f;
#pragma unroll
                for (int j = 0; j < 2; ++j) { const u32x4 w = yc[r][j]; v[2 * j] = pg8::bf4_lo(w); v[2 * j + 1] = pg8::bf4_hi(w); }
#pragma unroll
                for (int j = 0; j < 4; ++j) s += (v[j][0] + v[j][1]) + (v[j][2] + v[j][3]);
                const float mean = wave_sum(s) * (1.f / DM); float s2 = 0.f;
#pragma unroll
                for (int j = 0; j < 4; ++j) { v[j] = v[j] - mean; s2 += (v[j][0] * v[j][0] + v[j][1] * v[j][1]) + (v[j][2] * v[j][2] + v[j][3] * v[j][3]); }
                const float rstd = 1.f / sqrtf(wave_sum(s2) * (1.f / DM) + KF(LN_EPS));
                if (C.lane == 0) { stat[(C.wave * 16 + i) * 2] = mean; stat[(C.wave * 16 + i) * 2 + 1] = rstd; *(f32x2*)(STAT + row * 2) = (f32x2){mean, rstd}; }
#pragma unroll
                for (int j = 0; j < 4; ++j) v[j] = v[j] * rstd * gv[j] + bv[j];
#pragma unroll
                for (int j = 0; j < 2; ++j) {
                    const f32x4 q0 = v[2 * j] * qs, q1 = v[2 * j + 1] * qs;
                    int w0 = __builtin_amdgcn_cvt_pk_fp8_f32(fminf(fmaxf(q0[0], qlo), qhi), fminf(fmaxf(q0[1], qlo), qhi), 0, false); w0 = __builtin_amdgcn_cvt_pk_fp8_f32(fminf(fmaxf(q0[2], qlo), qhi), fminf(fmaxf(q0[3], qlo), qhi), w0, true);
                    int w1 = __builtin_amdgcn_cvt_pk_fp8_f32(fminf(fmaxf(q1[0], qlo), qhi), fminf(fmaxf(q1[1], qlo), qhi), 0, false); w1 = __builtin_amdgcn_cvt_pk_fp8_f32(fminf(fmaxf(q1[2], qlo), qhi), fminf(fmaxf(q1[3], qlo), qhi), w1, true);
                    *(u32x2*)(X1Q + row * DM + 8 * C.lane + 512 * j) = (u32x2){(unsigned)w0, (unsigned)w1}; } };
            RT_LD4(8 * g);
            ln_row(0); ln_row(1);
            RT_MM4();
            RT_LD4(8 * g + 4);
            ln_row(2); ln_row(3);
            RT_MM4();
        }
#undef RT_LD4
#undef RT_MM4
        { LAS float* pp = part + (grp2 * 2 + kh2) * 32 * 33 + r32;
#pragma unroll
          for (int r = 0; r < 16; ++r) pp[((r & 3) + 8 * (r >> 2) + 4 * hi) * 33] = acc[r]; }
        asm volatile("s_waitcnt vmcnt(0)" ::: "memory");
        __syncthreads();
        int te[4] = {0, 0, 0, 0}, lp[4] = {0, 0, 0, 0}; float tg[4] = {0.f, 0.f, 0.f, 0.f};
        if (C.tid < 128 && !(rskip & 4)) { const int grp = C.tid >> 5, ln = C.tid & 31; float lg[32];
            const float mean = stat[C.tid * 2], rstd = stat[C.tid * 2 + 1];
#pragma unroll
            for (int e = 0; e < 32; ++e) lg[e] = rstd * ((part[((grp * 2 + 0) * 32 + ln) * 33 + e] + part[((grp * 2 + 1) * 32 + ln) * 33 + e]) - mean * rc[e]) + rc[32 + e];
            float tv[4]; const float kninf = KF(-__builtin_inff());
#pragma unroll
            for (int k = 0; k < 4; ++k) { float best = lg[0]; int bi = 0;
#pragma unroll
                for (int e = 1; e < 32; ++e) { const bool gt = lg[e] > best; best = gt ? lg[e] : best; bi = gt ? e : bi; }
                te[k] = bi; tv[k] = best;
#pragma unroll
                for (int e = 0; e < 32; ++e) lg[e] = (e == bi) ? kninf : lg[e]; }
            float den = 0.f;
#pragma unroll
            for (int k = 0; k < 4; ++k) { tg[k] = __expf(tv[k] - tv[0]); den += tg[k]; }
            const float rden = 1.0f / den;
#pragma unroll
            for (int k = 0; k < 4; ++k) { tg[k] *= rden; lp[k] = __hip_atomic_fetch_add((LAS int*)&lcnt[te[k]], 1, __ATOMIC_RELAXED, __HIP_MEMORY_SCOPE_WORKGROUP); } }
        __syncthreads();
        if (C.tid < 32 && !(rskip & 4)) lbase[C.tid] = (int)__hip_atomic_fetch_add(gcnt + CNT_STRIDE * C.tid, (unsigned)lcnt[C.tid], __ATOMIC_RELAXED, __HIP_MEMORY_SCOPE_AGENT);
        __syncthreads();
        if (C.tid < 128 && !(rskip & 4)) { const int tok = row0 + C.tid;
#pragma unroll
            for (int k = 0; k < 4; ++k) { const int pos = lbase[te[k]] + lp[k]; lists[(size_t)te[k] * T + pos] = tok; slot[tok * 4 + k] = te[k] * T + pos; gate[tok * 4 + k] = tg[k]; } }
        __syncthreads();
    }
}

__device__ __forceinline__ void phase_combine_ln2(const CAS Args& args, const Ctx& C0, int layer) {
    Ctx C = C0; C.tid = opaque_tid(); C.lane = C.tid & 63;
    moe_table(args, C, layer);
    const bf16_t* Y = WSP(bf16_t, WS_Y); const float* STAT = WSP(float, WS_X1); const unsigned char* YS = args.ws + WS_YS; const unsigned char* SY = args.ws + WS_SY; const int* slot = WSP(int, WS_SLOT); const float* gate = WSP(float, WS_GATE);
    bf16_t* X2B = WSP(bf16_t, WS_X2B); unsigned char* X2Q = args.ws + WS_X2Q;
    const float* g2 = INF(I_LN2G) + layer * DM; const float* b2 = INF(I_LN2B) + layer * DM; const float* g1 = INF(I_LN1G) + layer * DM; const float* b1 = INF(I_LN1B) + layer * DM;
    f32x4 gv[4], bv[4], g1v[4], b1v[4];
#pragma unroll
    for (int j = 0; j < 2; ++j) { g1v[2 * j] = *(const f32x4*)(g1 + 8 * C.lane + 512 * j); g1v[2 * j + 1] = *(const f32x4*)(g1 + 8 * C.lane + 512 * j + 4);
        b1v[2 * j] = *(const f32x4*)(b1 + 8 * C.lane + 512 * j); b1v[2 * j + 1] = *(const f32x4*)(b1 + 8 * C.lane + 512 * j + 4); }
#pragma unroll
    for (int j = 0; j < 2; ++j) { gv[2 * j] = *(const f32x4*)(g2 + 8 * C.lane + 512 * j); gv[2 * j + 1] = *(const f32x4*)(g2 + 8 * C.lane + 512 * j + 4);
        bv[2 * j] = *(const f32x4*)(b2 + 8 * C.lane + 512 * j); bv[2 * j + 1] = *(const f32x4*)(b2 + 8 * C.lane + 512 * j + 4); }
    int sexp;
    { float ag = 0.f, ab = 0.f;
#pragma unroll
      for (int j = 0; j < 4; ++j)
#pragma unroll
          for (int e = 0; e < 4; ++e) { ag = fmaxf(ag, fabsf(gv[j][e])); ab = fmaxf(ab, fabsf(bv[j][e])); }
#pragma unroll
      for (int o = 1; o < 64; o <<= 1) { ag = fmaxf(ag, __shfl_xor(ag, o)); ab = fmaxf(ab, __shfl_xor(ab, o)); }
      const float bound = 16.0f * ag + ab + 1e-20f;
      sexp = 134 - (int)((__float_as_uint(bound) >> 23) & 0xffu); sexp = sexp < -100 ? -100 : (sexp > 100 ? 100 : sexp);
      if (C.tid == 0) __hip_atomic_store(WSP(unsigned, WS_CTL) + CW_SA2 + layer, (unsigned)sexp, __ATOMIC_RELAXED, __HIP_MEMORY_SCOPE_AGENT); }
    const float qs = __uint_as_float((unsigned)(127 + sexp) << 23), qlo = KF(-448.f), qhi = KF(448.f);
    const int gw = C.vcu * NWAVES + C.wave, NGW = C.G * NWAVES;
    int svn[2][4]; float gtn[2][4];
#pragma unroll
    for (int q = 0; q < 2; ++q) { const int r = (gw + q * NGW < T) ? gw + q * NGW : gw;
#pragma unroll
        for (int k = 0; k < 4; ++k) { svn[q][k] = slot[r * 4 + k]; gtn[q][k] = gate[r * 4 + k]; } }
#pragma unroll 1
    for (int row = gw; row < T; row += 2 * NGW) {
        int sv[2][4]; float gt[2][4];
#pragma unroll
        for (int q = 0; q < 2; ++q)
#pragma unroll
            for (int k = 0; k < 4; ++k) { sv[q][k] = svn[q][k]; gt[q][k] = gtn[q][k]; }
        { const int nrow = (row + 2 * NGW < T) ? row + 2 * NGW : row;
#pragma unroll
          for (int q = 0; q < 2; ++q) { const int r = (nrow + q * NGW < T) ? nrow + q * NGW : nrow;
#pragma unroll
              for (int k = 0; k < 4; ++k) { svn[q][k] = slot[r * 4 + k]; gtn[q][k] = gate[r * 4 + k]; } } }
        u32x4 xw[2][2]; u32x2 yw[2][4][2]; unsigned eb[2][4][2]; f32x2 st[2];
#pragma unroll
        for (int q = 0; q < 2; ++q) { const int r = (row + q * NGW < T) ? row + q * NGW : row;
#pragma unroll
            for (int j = 0; j < 2; ++j) xw[q][j] = *(const u32x4*)(Y + (size_t)r * DM + 8 * C.lane + 512 * j);
            st[q] = *(const f32x2*)(STAT + (size_t)r * 2);
#pragma unroll
            for (int k = 0; k < 4; ++k) { const int e = sv[q][k] >> 15, pos = sv[q][k] & (T - 1); const size_t prow = (size_t)C.misc[16 + e] * 256 + pos;
#pragma unroll
                for (int j = 0; j < 2; ++j) { yw[q][k][j] = *(const u32x2*)(YS + prow * DM + 8 * C.lane + 512 * j); eb[q][k][j] = SY[prow * 32 + (C.lane >> 2) + 16 * j]; } } }
#pragma unroll
        for (int q = 0; q < 2; ++q) { const int r = row + q * NGW; if (r >= T) break;
            f32x4 v[4];
#pragma unroll
            for (int j = 0; j < 2; ++j) { v[2 * j] = ((pg8::bf4_lo(xw[q][j]) - st[q][0]) * st[q][1] * g1v[2 * j] + b1v[2 * j]) * ALPHA; v[2 * j + 1] = ((pg8::bf4_hi(xw[q][j]) - st[q][0]) * st[q][1] * g1v[2 * j + 1] + b1v[2 * j + 1]) * ALPHA; }
#pragma unroll
            for (int k = 0; k < 4; ++k)
#pragma unroll
                for (int j = 0; j < 2; ++j) { const u32x2 w = yw[q][k][j]; const float gs = gt[q][k] * __uint_as_float(eb[q][k][j] << 23);
                    const f32x2 a = __builtin_amdgcn_cvt_pk_f32_fp8((int)w.x, false), b = __builtin_amdgcn_cvt_pk_f32_fp8((int)w.x, true), c = __builtin_amdgcn_cvt_pk_f32_fp8((int)w.y, false), d = __builtin_amdgcn_cvt_pk_f32_fp8((int)w.y, true);
                    v[2 * j] += (f32x4){a[0], a[1], b[0], b[1]} * gs; v[2 * j + 1] += (f32x4){c[0], c[1], d[0], d[1]} * gs; }
            float s = 0.f;
#pragma unroll
            for (int j = 0; j < 4; ++j) s += (v[j][0] + v[j][1]) + (v[j][2] + v[j][3]);
            const float mean = wave_sum(s) * (1.f / DM); float s2 = 0.f;
#pragma unroll
            for (int j = 0; j < 4; ++j) { v[j] = v[j] - mean; s2 += (v[j][0] * v[j][0] + v[j][1] * v[j][1]) + (v[j][2] * v[j][2] + v[j][3] * v[j][3]); }
            const float rstd = 1.f / sqrtf(wave_sum(s2) * (1.f / DM) + KF(LN_EPS));
#pragma unroll
            for (int j = 0; j < 4; ++j) v[j] = v[j] * rstd * gv[j] + bv[j];
#pragma unroll
            for (int j = 0; j < 2; ++j) { *(u32x4*)(X2B + (size_t)r * DM + 8 * C.lane + 512 * j) = pack8(v[2 * j], v[2 * j + 1]);
                const f32x4 q0 = v[2 * j] * qs, q1 = v[2 * j + 1] * qs;
                int w0 = __builtin_amdgcn_cvt_pk_fp8_f32(fminf(fmaxf(q0[0], qlo), qhi), fminf(fmaxf(q0[1], qlo), qhi), 0, false); w0 = __builtin_amdgcn_cvt_pk_fp8_f32(fminf(fmaxf(q0[2], qlo), qhi), fminf(fmaxf(q0[3], qlo), qhi), w0, true);
                int w1 = __builtin_amdgcn_cvt_pk_fp8_f32(fminf(fmaxf(q1[0], qlo), qhi), fminf(fmaxf(q1[1], qlo), qhi), 0, false); w1 = __builtin_amdgcn_cvt_pk_fp8_f32(fminf(fmaxf(q1[2], qlo), qhi), fminf(fmaxf(q1[3], qlo), qhi), w1, true);
                *(u32x2*)(X2Q + (size_t)r * DM + 8 * C.lane + 512 * j) = (u32x2){(unsigned)w0, (unsigned)w1}; } }
    }
}

__device__ __forceinline__ void phase_conv(const CAS Args& args, const Ctx& C0, int j) {
    Ctx C = C0; C.tid = opaque_tid(); C.lane = C.tid & 63;
    const bf16_t* U = WSP(bf16_t, WS_U); bf16_t* UC = WSP(bf16_t, WS_UC);
    const float* cw = INF(I_LRU_CW) + (size_t)j * 4 * DM; const float* cb = INF(I_LRU_CB) + (size_t)j * DM;
    const int c8 = (C.tid & 127) * 8, rsub = C.tid >> 7;
    float w[4][8], bb[8];
#pragma unroll
    for (int q = 0; q < 4; ++q)
#pragma unroll
        for (int e = 0; e < 8; ++e) w[q][e] = cw[q * DM + c8 + e];
#pragma unroll
    for (int e = 0; e < 8; ++e) bb[e] = cb[c8 + e];
    for (int chunk = C.vcu; chunk < T / 128; chunk += C.G) {
        const int r0 = chunk * 128 + rsub * 32;
        u32x4 h0, h1, h2;
        const u32x4 z = {0u, 0u, 0u, 0u};
        const int s0 = r0 & (SEQ - 1);
        h0 = s0 >= 3 ? *(const u32x4*)(U + (size_t)(r0 - 3) * DM + c8) : z; h1 = s0 >= 2 ? *(const u32x4*)(U + (size_t)(r0 - 2) * DM + c8) : z; h2 = s0 >= 1 ? *(const u32x4*)(U + (size_t)(r0 - 1) * DM + c8) : z;
        u32x4 hN[8];
#pragma unroll
        for (int k = 0; k < 8; ++k) hN[k] = *(const u32x4*)(U + (size_t)(r0 + k) * DM + c8);
#pragma unroll 1
        for (int i0 = 0; i0 < 32; i0 += 8) {
            u32x4 hC[8];
#pragma unroll
            for (int k = 0; k < 8; ++k) hC[k] = hN[k];
            if (i0 + 8 < 32) {
#pragma unroll
                for (int k = 0; k < 8; ++k) hN[k] = *(const u32x4*)(U + (size_t)(r0 + i0 + 8 + k) * DM + c8); }
#pragma unroll
            for (int k = 0; k < 8; ++k) { const u32x4 h3 = hC[k]; const int i = i0 + k;
                float o[8];
#pragma unroll
                for (int q = 0; q < 4; ++q) { const unsigned a = h0[q], b = h1[q], c = h2[q], d = h3[q];
                    o[2 * q] = bb[2 * q] + w[0][2 * q] * bf_lo(a) + w[1][2 * q] * bf_lo(b) + w[2][2 * q] * bf_lo(c) + w[3][2 * q] * bf_lo(d);
                    o[2 * q + 1] = bb[2 * q + 1] + w[0][2 * q + 1] * bf_hi(a) + w[1][2 * q + 1] * bf_hi(b) + w[2][2 * q + 1] * bf_hi(c) + w[3][2 * q + 1] * bf_hi(d); }
                u32x4 ow; ow.x = cvt_pk_bf16(o[0], o[1]); ow.y = cvt_pk_bf16(o[2], o[3]); ow.z = cvt_pk_bf16(o[4], o[5]); ow.w = cvt_pk_bf16(o[6], o[7]);
                *(u32x4*)(UC + (size_t)(r0 + i) * DM + c8) = ow; h0 = h1; h1 = h2; h2 = h3; } }
    }
}
__device__ __forceinline__ void phase_scan1(const CAS Args& args, const Ctx& C0) {
    Ctx C = C0; C.tid = opaque_tid(); C.lane = C.tid & 63;
    const bf16_t* LA = WSP(bf16_t, WS_AA); const bf16_t* BB = WSP(bf16_t, WS_BB); float* CA = WSP(float, WS_CA); float* CH = WSP(float, WS_CH);
    const int half = C.tid >> 8, c4 = (C.tid & 255) * 4;
    for (int ip = C.vcu; ip < NBATCH * 32; ip += C.G) { const int item = ip * 2 + half;
        const size_t r0 = (size_t)item * 64; float h0 = 0.f, h1 = 0.f, h2 = 0.f, h3 = 0.f, l0 = 0.f, l1 = 0.f, l2 = 0.f, l3 = 0.f;
#pragma unroll 8
        for (int s = 0; s < 64; ++s) { const u32x2 aw = *(const u32x2*)(LA + (r0 + s) * DM + c4), bw = *(const u32x2*)(BB + (r0 + s) * DM + c4);
            const float la0 = bf_lo(aw.x), la1 = bf_hi(aw.x), la2 = bf_lo(aw.y), la3 = bf_hi(aw.y);
            h0 = __builtin_amdgcn_exp2f(la0) * h0 + bf_lo(bw.x); h1 = __builtin_amdgcn_exp2f(la1) * h1 + bf_hi(bw.x); h2 = __builtin_amdgcn_exp2f(la2) * h2 + bf_lo(bw.y); h3 = __builtin_amdgcn_exp2f(la3) * h3 + bf_hi(bw.y);
            l0 += la0; l1 += la1; l2 += la2; l3 += la3; }
        *(f32x4*)(CA + (size_t)item * DM + c4) = (f32x4){__builtin_amdgcn_exp2f(l0), __builtin_amdgcn_exp2f(l1), __builtin_amdgcn_exp2f(l2), __builtin_amdgcn_exp2f(l3)}; *(f32x4*)(CH + (size_t)item * DM + c4) = (f32x4){h0, h1, h2, h3};
    }
}
__device__ __forceinline__ void phase_scan2(const CAS Args& args, const Ctx& C0) {
    Ctx C = C0; C.tid = opaque_tid(); C.lane = C.tid & 63;
    const bf16_t* LA = WSP(bf16_t, WS_AA); const bf16_t* BB = WSP(bf16_t, WS_BB); const float* CA = WSP(float, WS_CA); const float* CH = WSP(float, WS_CH);
    const bf16_t* GG = WSP(bf16_t, WS_GG); bf16_t* YL = WSP(bf16_t, WS_O);
    const int half = C.tid >> 8, c4 = (C.tid & 255) * 4;
    for (int ip = C.vcu; ip < NBATCH * 32; ip += C.G) { const int item = ip * 2 + half;
        const int b = item >> 6, ch = item & 63; float h0 = 0.f, h1 = 0.f, h2 = 0.f, h3 = 0.f;
#pragma unroll 8
        for (int jx = 0; jx < ch; ++jx) { const f32x4 a = *(const f32x4*)(CA + (size_t)(b * 64 + jx) * DM + c4), e = *(const f32x4*)(CH + (size_t)(b * 64 + jx) * DM + c4);
            h0 = a[0] * h0 + e[0]; h1 = a[1] * h1 + e[1]; h2 = a[2] * h2 + e[2]; h3 = a[3] * h3 + e[3]; }
        const size_t r0 = (size_t)item * 64;
        u32x2 aN[8], bN[8], gN[8];
#pragma unroll
        for (int k = 0; k < 8; ++k) { aN[k] = *(const u32x2*)(LA + (r0 + k) * DM + c4); bN[k] = *(const u32x2*)(BB + (r0 + k) * DM + c4); gN[k] = *(const u32x2*)(GG + (r0 + k) * DM + c4); }
#pragma unroll 1
        for (int s0 = 0; s0 < 64; s0 += 8) {
            u32x2 aC[8], bC[8], gC[8];
#pragma unroll
            for (int k = 0; k < 8; ++k) { aC[k] = aN[k]; bC[k] = bN[k]; gC[k] = gN[k]; }
            if (s0 + 8 < 64) {
#pragma unroll
                for (int k = 0; k < 8; ++k) { aN[k] = *(const u32x2*)(LA + (r0 + s0 + 8 + k) * DM + c4); bN[k] = *(const u32x2*)(BB + (r0 + s0 + 8 + k) * DM + c4); gN[k] = *(const u32x2*)(GG + (r0 + s0 + 8 + k) * DM + c4); } }
#pragma unroll
            for (int k = 0; k < 8; ++k) { const u32x2 aw = aC[k], bw = bC[k], g = gC[k];
                h0 = __builtin_amdgcn_exp2f(bf_lo(aw.x)) * h0 + bf_lo(bw.x); h1 = __builtin_amdgcn_exp2f(bf_hi(aw.x)) * h1 + bf_hi(bw.x);
                h2 = __builtin_amdgcn_exp2f(bf_lo(aw.y)) * h2 + bf_lo(bw.y); h3 = __builtin_amdgcn_exp2f(bf_hi(aw.y)) * h3 + bf_hi(bw.y);
                *(u32x2*)(YL + (r0 + s0 + k) * DM + c4) = (u32x2){cvt_pk_bf16(bf_lo(g.x) * h0, bf_hi(g.x) * h1), cvt_pk_bf16(bf_lo(g.y) * h2, bf_hi(g.y) * h3)}; } }
    }
}

#if PROBE_T
typedef int v8i_t __attribute__((ext_vector_type(8)));
__device__ __forceinline__ unsigned fp8_of_int(int v) { const unsigned char t[4] = {0x00, 0x38, 0x40, 0x44}; const int a = v < 0 ? -v : v; return (unsigned)t[a] | (v < 0 ? 0x80u : 0u); }
__device__ __forceinline__ int tA(int i, int k) { return ((i * 3 + k * 5) % 7) - 3; }
__device__ __forceinline__ int tB(int k, int j) { return ((k * 2 + j * 7) % 5) - 2; }
__device__ __forceinline__ void mfma_fp8_selftest(unsigned* flagw) {
    const int l = threadIdx.x & 63, r = l & 15, q = l >> 4;
    v8i_t A, B;
#pragma unroll
    for (int d = 0; d < 8; ++d) { unsigned wa = 0, wb = 0;
#pragma unroll
        for (int b = 0; b < 4; ++b) { const int k = 32 * q + 4 * d + b; wa |= fp8_of_int(tA(r, k)) << (8 * b); wb |= fp8_of_int(tB(k, r)) << (8 * b); }
        A[d] = (int)wa; B[d] = (int)wb; }
    const f32x4 z = {0.f, 0.f, 0.f, 0.f};
    const int U = 0x7f7f7f7f;
    const int saq = (127 + q) * 0x01010101;
    const int sab = (q == 0) ? (int)0x8281807fu : U;
    const f32x4 m2 = __builtin_amdgcn_mfma_scale_f32_16x16x128_f8f6f4(A, B, z, 0, 0, 0, saq, 0, U);
    const f32x4 m5 = __builtin_amdgcn_mfma_scale_f32_16x16x128_f8f6f4(A, B, z, 0, 0, 0, sab, 0, U);
    bool k1 = true, k2 = true, k3 = true, k4 = true;
#pragma unroll
    for (int e = 0; e < 4; ++e) { const int i = 4 * q + e, j = r; float eb = 0.f, e0 = 0.f, ec = 0.f, ed = 0.f;
        for (int kq = 0; kq < 4; ++kq) for (int hh = 0; hh < 2; ++hh) { float sh = 0.f; for (int k = 32 * kq + 16 * hh; k < 32 * kq + 16 * hh + 16; ++k) sh += (float)(tA(i, k) * tB(k, j));
            const int xb = hh == 0 ? (kq >> 1) : 2 + (kq >> 1);
            eb += sh * (float)(1 << xb); e0 += sh; ec += sh * (float)(1 << kq); ed += sh * (float)(1 << xb); }
        k1 = k1 && (m2[e] == eb); k2 = k2 && (m2[e] == e0); k3 = k3 && (m5[e] == ec); k4 = k4 && (m5[e] == ed); }
    const bool b1 = __all(k1), b2 = __all(k2), b3 = __all(k3), b4 = __all(k4);
    if (l == 0) *flagw = (b1 ? 1u : 0u) | (b2 ? 2u : 0u) | (b3 ? 4u : 0u) | (b4 ? 8u : 0u);
}
#endif
constexpr int PH_PER_LAYER = 12, PH_TOTAL = 2 + PH_PER_LAYER * DEPTH;
__global__ void __launch_bounds__(NWAVES * 64, 2) fwd_kernel(Args args_kernarg) {
    (void)args_kernarg;
    ArgsP const argp = (ArgsP)__builtin_amdgcn_kernarg_segment_ptr();
    const CAS Args& args0 = *argp;
    extern __shared__ __attribute__((aligned(16))) unsigned char lds_raw[];
    Ctx C_;
    C_.lds = (LAS unsigned char*)lds_raw; C_.misc = (volatile LAS int*)(C_.lds + MISC_OFF);
    C_.tid = threadIdx.x; C_.lane = C_.tid & 63; C_.wave = __builtin_amdgcn_readfirstlane(C_.tid >> 6);
    C_.bid = (int)blockIdx.x; C_.G = gridDim.x; { const int bx = blockIdx.x; C_.vcu = (C_.G % 8 == 0) ? (bx % 8) * (C_.G / 8) + bx / 8 : bx; }
    for (int u = C_.tid; u < 128; u += NWAVES * 64) C_.misc[u] = 0;
    __syncthreads();
    XcdBarrier bar = xcd_barrier_post((unsigned*)(args0.ws + WS_CTL) + CW_BAR + args0.li * XCD_BAR_WORDS, (volatile LAS unsigned*)C_.misc);
    const int lo = args0.ph_lo, hi = args0.ph_hi;
#define IN(k) (lo <= (k) && (k) < hi)
#define PH_END(k) do { if ((k) + 1 < hi) xcd_barrier(bar); } while (0)

    if (SEL(0) && IN(0)) { const CAS Args& args = fresh_args(argp); const Ctx C = fresh_ctx(C_); const int cid = C.bid; phase_prologue(args, C); PH_END(0); }
    if (SEL(1) && IN(1)) { const CAS Args& args = fresh_args(argp); const Ctx C = fresh_ctx(C_); const int cid = C.bid;
        typedef pg8::DenseSched<DEPTH * T / 256, 4> DS; DS S; S.init(WSP(bf16_t, WS_PB), WSP(bf16_t, WS_W_PLE + OFF_PLE_WP), PLED, PLED, C.G, cid); S.bpm_shift = 7; S.bbatch = W_PLE_STRIDE;
        pg8::EpiPP E{WSP(bf16_t, WS_PP)};
        pg8::gemm_phase<pg8::EpiPP, DS, false>(C.lds, PLED / 64, PLED * 2, PLED * 2, S, E);
        if (MK_ONE_LAUNCH == 0) PH_END(1);
    }
    for (int layer = 0; layer < DEPTH; ++layer) {
        const int base = 2 + PH_PER_LAYER * layer, j = layer >> 1;
        if ((layer & 1) == 0) {
            if (SEL(2) && IN(base + 0)) { const CAS Args& args = fresh_args(argp); const Ctx C = fresh_ctx(C_); const int cid = C.bid; const unsigned char* wm = args.ws + WS_W_MLA + (size_t)j * W_MLA_STRIDE;
                typedef pg8::DenseSched<T / 256, 5> DS; DS S; S.init(WSP(bf16_t, WS_XB), wm + OFF_MLA_WIN, DM, DM, C.G, cid);
                pg8::EpiLat E{WSP(bf16_t, WS_LAT), WSP(float, WS_SSQ), WSP(bf16_t, WS_KR), WSP(float, WS_CS), WSP(float, WS_SN)};
                pg8::gemm_phase<pg8::EpiLat, DS, false>(C.lds, DM / 64, DM * 2, DM * 2, S, E);
                PH_END(base + 0);
            }
            if (SEL(3) && IN(base + 1)) { const CAS Args& args = fresh_args(argp); const Ctx C = fresh_ctx(C_); const int cid = C.bid; const unsigned char* wm = args.ws + WS_W_MLA + (size_t)j * W_MLA_STRIDE;
                if ((C.vcu & 1) == 0) {
                { typedef pg8::DenseSched<T / 256, 6> DS; DS S; S.init(WSP(bf16_t, WS_LAT), wm + OFF_MLA_WUQ, DM, QL, C.G, cid);
                  pg8::EpiQ E{WSP(bf16_t, WS_Q), WSP(float, WS_SSQ), WSP(float, WS_CS), WSP(float, WS_SN)};
                  pg8::gemm_phase<pg8::EpiQ, DS, false>(C.lds, QL / 64, DM * 2, QL * 2, S, E); }
                { typedef pg8::DenseSched<T / 256, 8> DS; DS S; S.init(WSP(bf16_t, WS_LAT) + QL, wm + OFF_MLA_WUKV, DM, KVL, C.G, cid);
                  pg8::EpiKV E{WSP(bf16_t, WS_KN), WSP(bf16_t, WS_V), WSP(float, WS_SSQ)};
                  pg8::gemm_phase<pg8::EpiKV, DS, false>(C.lds, KVL / 64, DM * 2, KVL * 2, S, E); }
                } else {
                { typedef pg8::DenseSched<T / 256, 8> DS; DS S; S.init(WSP(bf16_t, WS_LAT) + QL, wm + OFF_MLA_WUKV, DM, KVL, C.G, cid);
                  pg8::EpiKV E{WSP(bf16_t, WS_KN), WSP(bf16_t, WS_V), WSP(float, WS_SSQ)};
                  pg8::gemm_phase<pg8::EpiKV, DS, false>(C.lds, KVL / 64, DM * 2, KVL * 2, S, E); }
                { typedef pg8::DenseSched<T / 256, 6> DS; DS S; S.init(WSP(bf16_t, WS_LAT), wm + OFF_MLA_WUQ, DM, QL, C.G, cid);
                  pg8::EpiQ E{WSP(bf16_t, WS_Q), WSP(float, WS_SSQ), WSP(float, WS_CS), WSP(float, WS_SN)};
                  pg8::gemm_phase<pg8::EpiQ, DS, false>(C.lds, QL / 64, DM * 2, QL * 2, S, E); }
                }
                PH_END(base + 1);
            }
            if (SEL(4) && IN(base + 2)) { const CAS Args& args = fresh_args(argp); const Ctx C = fresh_ctx(C_); const int cid = C.bid;
                for (int it = C.vcu; it < NBATCH * NH * 8; it += C.G) { const int bh = it >> 3, pr = it & 7;
                    att::attn_block(bh >> 3, bh & 7, pr, WSP(bf16_t, WS_Q), WSP(bf16_t, WS_KN), WSP(bf16_t, WS_KR), WSP(bf16_t, WS_V), WSP(bf16_t, WS_O), (LAS char*)C.lds, PROBE_T ? (unsigned long long*)(args.ws + WS_CTL + 8192) : nullptr);
                    att::attn_block(bh >> 3, bh & 7, 15 - pr, WSP(bf16_t, WS_Q), WSP(bf16_t, WS_KN), WSP(bf16_t, WS_KR), WSP(bf16_t, WS_V), WSP(bf16_t, WS_O), (LAS char*)C.lds, PROBE_T ? (unsigned long long*)(args.ws + WS_CTL + 8192) : nullptr); }
                PH_END(base + 2);
            }
        } else {
            if (SEL(5) && IN(base + 0)) { const CAS Args& args = fresh_args(argp); const Ctx C = fresh_ctx(C_); const int cid = C.bid; const unsigned char* wl = args.ws + WS_W_LRU + (size_t)j * W_LRU_STRIDE;
                typedef pg8::DenseSched<T / 256, 8> DS; DS S; S.init(WSP(bf16_t, WS_XB), wl + OFF_LRU_WIN, DM, DM, C.G, cid);
                pg8::EpiGU E{WSP(bf16_t, WS_GG), WSP(bf16_t, WS_U)};
                pg8::gemm_phase<pg8::EpiGU, DS, false>(C.lds, DM / 64, DM * 2, DM * 2, S, E);
                PH_END(base + 0);
            }
            if (SEL(6) && IN(base + 1)) { const CAS Args& args = fresh_args(argp); const Ctx C = fresh_ctx(C_); const int cid = C.bid; phase_conv(args, C, j); PH_END(base + 1); }
            if (SEL(7) && IN(base + 2)) { const CAS Args& args = fresh_args(argp); const Ctx C = fresh_ctx(C_); const int cid = C.bid; const unsigned char* wl = args.ws + WS_W_LRU + (size_t)j * W_LRU_STRIDE;
                typedef pg8::DenseSched<T / 256, 8> DS; DS S; S.init(WSP(bf16_t, WS_UC), wl + OFF_LRU_WAX, DM, 256, C.G, cid); S.apn_shift = 1; S.akbytes = 512;
                pg8::EpiAB E{WSP(bf16_t, WS_AA), WSP(bf16_t, WS_BB), WSP(bf16_t, WS_UC), INF(I_LRU_BA) + j * DM, INF(I_LRU_BX) + j * DM, WSP(float, WS_SPL) + j * DM};
                pg8::gemm_phase<pg8::EpiAB, DS, false>(C.lds, 4, DM * 2, 512, S, E);
                PH_END(base + 2);
            }
            if (SEL(8) && IN(base + 3)) { const CAS Args& args = fresh_args(argp); const Ctx C = fresh_ctx(C_); const int cid = C.bid; phase_scan1(args, C); PH_END(base + 3); }
            if (SEL(9) && IN(base + 4)) { const CAS Args& args = fresh_args(argp); const Ctx C = fresh_ctx(C_); const int cid = C.bid; phase_scan2(args, C); PH_END(base + 4); }
        }
        if (SEL(10) && IN(base + 5)) { const CAS Args& args = fresh_args(argp); const Ctx C = fresh_ctx(C_); const int cid = C.bid;
            const unsigned char* wo = (layer & 1) ? args.ws + WS_W_LRU + (size_t)j * W_LRU_STRIDE + OFF_LRU_WOUT : args.ws + WS_W_MLA + (size_t)j * W_MLA_STRIDE + OFF_MLA_WO;
            typedef pg8::DenseSched<T / 256, 4> DS; DS S; S.init(WSP(bf16_t, WS_O), wo, DM, DM, C.G, cid);
            pg8::EpiRes E{WSP(bf16_t, WS_XB), WSP(bf16_t, WS_Y)};
            pg8::gemm_phase<pg8::EpiRes, DS, false>(C.lds, DM / 64, DM * 2, DM * 2, S, E);
            PH_END(base + 5);
        }
        if (SEL(11) && IN(base + 6)) { const CAS Args& args = fresh_args(argp); const Ctx C = fresh_ctx(C_); const int cid = C.bid; phase_ln_router(args, C, layer); PH_END(base + 6); }
        if (SEL(12) && IN(base + 7)) { const CAS Args& args = fresh_args(argp); const Ctx C = fresh_ctx(C_); const int cid = C.bid;
            moe_table(args, C, layer);
            pg8::MoeSched S{(const char*)(args.ws + WS_X1Q), (const char*)(args.ws + WS_W_UP + (size_t)layer * NE * 2048 * 1024), (size_t)2048 * 1024, (const char*)(args.ws + WS_SW + (size_t)layer * NE * 65536), DM, DM, 8, WSP(int, WS_LIST), C.misc + 16, (volatile LAS const unsigned char*)(C.lds + TILE_E_OFF), C.G, cid, true, nullptr};
            const int sae = 127 - (int)__hip_atomic_load(WSP(unsigned, WS_CTL) + CW_SA + layer, __ATOMIC_RELAXED, __HIP_MEMORY_SCOPE_AGENT);
            pg8::EpiUp E{args.ws + WS_H, args.ws + WS_SH, INF(I_MOE_BUP) + (size_t)layer * NE * 2048};
            pg8::gemm_phase<pg8::EpiUp, pg8::MoeSched, true, 1>(C.lds, DM / 128, DM, DM, S, E, PROBE_T ? (unsigned long long*)(args.ws + WS_CTL + 8192) : nullptr, sae * 0x01010101);
            PH_END(base + 7);
        }
        if (SEL(13) && IN(base + 8)) { const CAS Args& args = fresh_args(argp); const Ctx C = fresh_ctx(C_); const int cid = C.bid;
            moe_table(args, C, layer);
            pg8::MoeSched S{(const char*)(args.ws + WS_H), (const char*)(args.ws + WS_W_DN + (size_t)layer * NE * 1024 * 1024), (size_t)1024 * 1024, (const char*)(args.ws + WS_SWD + (size_t)layer * NE * 16384), DFF, DFF, 4, WSP(int, WS_LIST), C.misc + 16, (volatile LAS const unsigned char*)(C.lds + TILE_E_OFF), C.G, cid, false, (const char*)(args.ws + WS_SH)};
            pg8::EpiDown E{args.ws + WS_YS, args.ws + WS_SY, INF(I_MOE_BDN) + (size_t)layer * NE * DM};
            pg8::gemm_phase<pg8::EpiDown, pg8::MoeSched, false, 2>(C.lds, DFF / 128, DFF, DFF, S, E);
            PH_END(base + 8);
        }
        if (SEL(14) && IN(base + 9)) { const CAS Args& args = fresh_args(argp); const Ctx C = fresh_ctx(C_); const int cid = C.bid; phase_combine_ln2(args, C, layer); PH_END(base + 9); }
        if (SEL(15) && IN(base + 10)) { const CAS Args& args = fresh_args(argp); const Ctx C = fresh_ctx(C_); const int cid = C.bid;
            typedef pg8::DenseSched<T / 256, 4> DS; DS S; S.init(args.ws + WS_X2Q, args.ws + WS_W_PLE + (size_t)layer * W_PLE_STRIDE + OFF_PLE_WG, DM / 2, DM / 2, C.G, cid); S.SW = (const char*)(args.ws + WS_SWG + (size_t)layer * 65536);
            const int sae = 127 - (int)__hip_atomic_load(WSP(unsigned, WS_CTL) + CW_SA2 + layer, __ATOMIC_RELAXED, __HIP_MEMORY_SCOPE_AGENT);
            pg8::EpiPle E{WSP(bf16_t, WS_X2B), WSP(bf16_t, WS_PP) + (size_t)layer * T * DM, layer == DEPTH - 1 ? args.out : (float*)nullptr, WSP(bf16_t, WS_XB)};
            pg8::gemm_phase<pg8::EpiPle, DS, false, 1>(C.lds, DM / 128, DM, DM, S, E, nullptr, sae * 0x01010101);
            if (layer + 1 < DEPTH) PH_END(base + 10);
        }
    }
#if PROBE_T
    if (PROBE_T == 20 && blockIdx.x == 0 && threadIdx.x < 64) { const CAS Args& args = fresh_args(argp); mfma_fp8_selftest((unsigned*)(args.ws + WS_CTL + 8192 + 256)); }
    { xcd_barrier(bar); const CAS Args& args = fresh_args(argp);
      const unsigned long long* pw = (const unsigned long long*)(args.ws + WS_CTL + 8192);
      const double pk = (double)__hip_atomic_load(pw + 0, __ATOMIC_RELAXED, __HIP_MEMORY_SCOPE_AGENT), pe = (double)__hip_atomic_load(pw + 1, __ATOMIC_RELAXED, __HIP_MEMORY_SCOPE_AGENT),
                   pn = (double)__hip_atomic_load(pw + 2, __ATOMIC_RELAXED, __HIP_MEMORY_SCOPE_AGENT), pt = (double)__hip_atomic_load(pw + 3, __ATOMIC_RELAXED, __HIP_MEMORY_SCOPE_AGENT);
      float c = 100.f;
      if (PROBE_T == 2) c = (float)(pk / (pn * 16.0) / 10.0);
      if (PROBE_T == 3) c = (float)(pe / pn / 100.0);
      if (PROBE_T == 4) c = (float)((pt - pk - pe) / pn / 100.0);
      if (PROBE_T == 5) c = (float)(pn);
      if (PROBE_T >= 10) { double q[7]; for (int i = 0; i < 7; ++i) q[i] = (double)__hip_atomic_load(pw + 8 + i, __ATOMIC_RELAXED, __HIP_MEMORY_SCOPE_AGENT);
          if (PROBE_T == 10) c = (float)(q[6] / q[5] / 10.0);
          if (PROBE_T == 11) c = (float)(q[0] / q[5] / 10.0);
          if (PROBE_T == 12) c = (float)(q[1] / q[5] / 10.0);
          if (PROBE_T == 13) c = (float)(q[2] / q[5] / 10.0);
          if (PROBE_T == 14) c = (float)(q[3] / q[5] / 10.0);
          if (PROBE_T == 15) c = (float)(q[4] / q[5] / 10.0); }
      if (PROBE_T >= 2 && PROBE_T < 20) c = exp2f(floorf(log2f(c) * 8.0f + PROBE_SHIFT) * 0.125f);
      if (PROBE_T == 20) { const unsigned fl = __hip_atomic_load((const unsigned*)(args.ws + WS_CTL + 8192 + 256), __ATOMIC_RELAXED, __HIP_MEMORY_SCOPE_AGENT); c = 100.f + 10.f * (float)fl; }
      for (size_t i = (size_t)blockIdx.x * 512 + threadIdx.x; i < (size_t)T * DM; i += (size_t)gridDim.x * 512) args.out[i] = c; }
#endif
#undef IN
#undef PH_END
}

extern "C" void kernel_launch(void* const* d_in, const int* in_sizes, int n_in, void* d_out, int out_size, void* d_ws, size_t ws_size, hipStream_t stream) {
    static int grid = 0;
    if (grid == 0) {
        if (n_in != 30 || in_sizes[0] != T * DM || out_size != T * DM || ws_size < WS_END) { fprintf(stderr, "kernel_launch: unexpected shapes (n_in %d, in0 %d, out %d, ws %zu)\n", n_in, n_in > 0 ? in_sizes[0] : -1, out_size, ws_size); grid = -1; return; }
        int dev = 0, cus = 0, per_cu = 0;
        if (hipGetDevice(&dev) != hipSuccess || hipDeviceGetAttribute(&cus, hipDeviceAttributeMultiprocessorCount, dev) != hipSuccess) { grid = -1; return; }
        if (hipFuncSetAttribute((const void*)fwd_kernel, hipFuncAttributeMaxDynamicSharedMemorySize, LDS_BYTES) != hipSuccess) { fprintf(stderr, "kernel_launch: hipFuncSetAttribute failed\n"); grid = -1; return; }
        if (hipOccupancyMaxActiveBlocksPerMultiprocessor(&per_cu, (const void*)fwd_kernel, NWAVES * 64, LDS_BYTES) != hipSuccess || per_cu < 1) fprintf(stderr, "kernel_launch: occupancy query reports %d\n", per_cu);
        (void)hipGetLastError();
        grid = cus;
    }
    if (grid < 0) return;
    if (hipMemsetAsync((char*)d_ws + WS_CTL, 0, CTL_ZERO_BYTES, stream) != hipSuccess) return;
    Args a{};
    for (int i = 0; i < 30; ++i) a.in[i] = d_in[i];
    a.out = (float*)d_out; a.ws = (unsigned char*)d_ws; a.pad = 0;
#if MK_ONE_LAUNCH
    a.ph_lo = 0; a.ph_hi = PH_TOTAL; a.li = 0;
    hipLaunchKernelGGL(fwd_kernel, dim3(grid), dim3(NWAVES * 64), LDS_BYTES, stream, a);
#else
    int li = 0;
    for (int ph = 0; ph < PH_TOTAL; ++ph) {
        if (ph >= 2) { const int l = (ph - 2) / PH_PER_LAYER, k = (ph - 2) % PH_PER_LAYER; if (k == 11) continue; if ((l & 1) == 0 && (k == 3 || k == 4)) continue; }
        int site = ph;
        if (ph >= 2) { const int l = (ph - 2) / PH_PER_LAYER, k = (ph - 2) % PH_PER_LAYER; static const int mla[11] = {2, 3, 4, -1, -1, 10, 11, 12, 13, 14, 15}, lru[11] = {5, 6, 7, 8, 9, 10, 11, 12, 13, 14, 15}; site = (l & 1) ? lru[k] : mla[k]; }
        a.ph_lo = ph; a.ph_hi = ph + 1;
        if ((HOSTDUP >> site) & 1) for (int r_ = 1; r_ <= HOSTDUP_R; ++r_) { a.li = li++; a.pad = 4 * r_; hipLaunchKernelGGL(fwd_kernel, dim3(grid), dim3(NWAVES * 64), LDS_BYTES, stream, a); }
        a.li = li++; a.pad = 0;
        hipLaunchKernelGGL(fwd_kernel, dim3(grid), dim3(NWAVES * 64), LDS_BYTES, stream, a);
    }
#endif
}
```

```cpp
#include <hip/hip_runtime.h>
#include <hip/hip_bf16.h>
#include <cstdio>
#include <cstdint>

#ifndef PHSEL
#define PHSEL -1
#endif
#ifndef PHSKIP
#define PHSKIP -1
#endif
#define SEL(id) ((PHSEL < 0 || PHSEL == (id)) && PHSKIP != (id))
#ifndef PROBE_T
#define PROBE_T 0
#endif
#ifndef PROBE_SHIFT
#define PROBE_SHIFT 0.0f
#endif
#ifndef HOSTDUP
#define HOSTDUP 0
#endif
#ifndef HOSTDUP_R
#define HOSTDUP_R 1
#endif
#ifndef ROUTER_SKIP
#define ROUTER_SKIP 0
#endif
#ifndef CNT_STRIDE
#define CNT_STRIDE 32
#endif
#ifndef MK_ONE_LAUNCH
#define MK_ONE_LAUNCH 1
#endif

constexpr int T = 32768, SEQ = 4096, NBATCH = 8, DM = 1024, DEPTH = 4;
constexpr int QL = 768, KVL = 256, ROPE = 64, LATD = 1088, NH = 8, DQK = 192, DV = 128;
constexpr int NE = 32, TOPK = 4, DFF = 1024, PLED = 256;
constexpr float ALPHA = 1.681792830507429f;
constexpr float LN_EPS = 1e-5f, RMS_EPS = 1e-6f;
constexpr float QSCALE = 1.4426950408889634f / 13.856406460551018f;
constexpr int NWAVES = 8;

constexpr size_t MiB = 1u << 20;
constexpr size_t WS_CTL = 0, CTL_ZERO_BYTES = 2 * MiB;
constexpr size_t WS_CS = 2 * MiB, WS_SN = 6 * MiB, WS_SPL = 10 * MiB;
constexpr size_t WS_WRH = WS_SPL + 65536, WS_WRL = WS_WRH + 262144;
constexpr size_t WS_RC = WS_SPL + 16384;
constexpr size_t WS_W_MLA = 12 * MiB, W_MLA_STRIDE = 8 * MiB;
constexpr size_t OFF_MLA_WIN = 0, OFF_MLA_WUQ = 2560 * 1024, OFF_MLA_WUKV = OFF_MLA_WUQ + 2304 * 1024, OFF_MLA_WO = OFF_MLA_WUKV + 1024 * 1024;
constexpr size_t WS_W_LRU = 28 * MiB, W_LRU_STRIDE = 8 * MiB;
constexpr size_t OFF_LRU_WIN = 0, OFF_LRU_WAX = 4 * MiB, OFF_LRU_WOUT = 5 * MiB;
constexpr size_t WS_W_PLE = 44 * MiB, W_PLE_STRIDE = 3 * MiB;
constexpr size_t OFF_PLE_WG = 0, OFF_PLE_WP = 2 * MiB;
constexpr size_t WS_W_UP = 56 * MiB;
constexpr size_t WS_W_DN = 568 * MiB;
constexpr size_t WS_XB = 824 * MiB, WS_PB = 888 * MiB, WS_PP = 952 * MiB;
constexpr size_t WS_Y = 1208 * MiB, WS_X1 = 1336 * MiB, WS_X1B = 1464 * MiB, WS_X2 = 1528 * MiB, WS_X2B = 1656 * MiB;
constexpr size_t WS_LAT = 1720 * MiB, WS_KR = 1784 * MiB, WS_SSQ = 1788 * MiB, WS_Q = 1790 * MiB, WS_KN = 1886 * MiB, WS_V = 1950 * MiB, WS_O = 2014 * MiB;
constexpr size_t WS_GG = 2078 * MiB, WS_U = 2142 * MiB, WS_UC = 2206 * MiB, WS_AA = 2270 * MiB, WS_BB = 2398 * MiB, WS_CA = 2526 * MiB, WS_CH = 2528 * MiB;
constexpr size_t WS_H = 2530 * MiB, WS_YS = 2802 * MiB, WS_LIST = 3074 * MiB, WS_SLOT = 3078 * MiB, WS_GATE = 3079 * MiB, WS_SW = 3080 * MiB  , WS_X1Q = 3088 * MiB  , WS_SH = 3120 * MiB  ,
                 WS_SWD = 3128 * MiB  , WS_SY = 3132 * MiB  , WS_X2Q = 3140 * MiB  , WS_SWG = 3172 * MiB  , WS_END = 3174 * MiB;
constexpr int PADROWS = T * TOPK + NE * 256;
static_assert((size_t)PADROWS * DFF * 2 <= 272 * MiB, "H / YS size");
constexpr int CW_SA2 = 136;
constexpr int CW_SA = 128;
constexpr int CW_CNT = 400000;
constexpr int CW_BAR = 4096;

constexpr int RING_BYTES = 133120;
constexpr int TILE_E_OFF = 131072;
constexpr int SCL_OFF = RING_BYTES;
constexpr int MISC_OFF = SCL_OFF + 24576;
constexpr int LDS_BYTES = 163840;

#define GAS __attribute__((address_space(1)))
#define LAS __attribute__((address_space(3)))
#define CAS __attribute__((address_space(4)))
typedef unsigned short bf16_t;
typedef short bf16x8 __attribute__((ext_vector_type(8)));
typedef short s16x4 __attribute__((ext_vector_type(4)));
typedef float f32x2 __attribute__((ext_vector_type(2)));
typedef float f32x4 __attribute__((ext_vector_type(4)));
typedef float f32x16 __attribute__((ext_vector_type(16)));
typedef unsigned u32x2 __attribute__((ext_vector_type(2)));
typedef unsigned u32x4 __attribute__((ext_vector_type(4)));

__device__ __forceinline__ unsigned cvt_pk_bf16(float lo, float hi) { unsigned r; asm volatile("v_cvt_pk_bf16_f32 %0, %1, %2" : "=v"(r) : "v"(lo), "v"(hi)); return r; }
__device__ __forceinline__ float bf_lo(unsigned w) { return __uint_as_float(w << 16); }
__device__ __forceinline__ float bf_hi(unsigned w) { return __uint_as_float(w & 0xffff0000u); }
__device__ __forceinline__ float sigmoidf_(float x) { return __builtin_amdgcn_rcpf(1.0f + __expf(-x)); }
__device__ __forceinline__ float gelu_tanh(float x) { const float u = 0.7978845608028654f * (x + 0.044715f * x * x * x); const float t = 1.0f - 2.0f * __builtin_amdgcn_rcpf(1.0f + __expf(2.0f * u)); return 0.5f * x * (1.0f + t); }
__device__ __forceinline__ u32x4 pack8(const f32x4 a, const f32x4 b) { u32x4 w; w.x = cvt_pk_bf16(a[0], a[1]); w.y = cvt_pk_bf16(a[2], a[3]); w.z = cvt_pk_bf16(b[0], b[1]); w.w = cvt_pk_bf16(b[2], b[3]); return w; }
__device__ __forceinline__ float KF(float v) { asm volatile("" : "+s"(v)); return v; }
typedef unsigned long long u64x2_t __attribute__((ext_vector_type(2)));
__device__ __forceinline__ f32x4 zero4() { unsigned long long z0, z1; asm volatile("v_mov_b64 %0, 0" : "=v"(z0)); asm volatile("v_mov_b64 %0, 0" : "=v"(z1)); return __builtin_bit_cast(f32x4, (u64x2_t){z0, z1}); }
__device__ __forceinline__ int opaque_tid() { int t = threadIdx.x; asm volatile("" : "+v"(t)); return t; }
__device__ __forceinline__ float wave_sum(float v) {
#pragma unroll
    for (int o = 1; o < 64; o <<= 1) v += __shfl_xor(v, o);
    return v;
}

namespace pg8 {
#define PG8_LAS __attribute__((address_space(3)))
constexpr int BM = 256, BK = 64, HALF = 128, HTB = HALF * BK * 2, STAGE_BYTES = 8 * HTB;
__host__ __device__ __forceinline__ int lds_byte(int r, int c) { const int st = (r >> 4) * 2 + (c >> 5), rr = r & 15, cc = c & 31, ob = rr * 64 + cc * 2; return st * 1024 + (ob ^ (((ob >> 9) & 1) << 5)); }
__host__ __device__ __forceinline__ void stage_rc(int b, int& R, int& C) { const int st = b / 1024, sb = b % 1024, swz = sb ^ (((sb >> 9) & 1) << 5); R = (st >> 1) * 16 + swz / 64; C = (st & 1) * 32 + (swz % 64) / 2; }
__host__ __device__ __forceinline__ int perm32(int rho) { const int n = rho >> 4, i = rho & 15; return 8 * (i >> 2) + 4 * n + (i & 3); }

struct Unit { const char* A; const char* B; const char* S; const char* SA; const int* lst; int nvalid; int pm, pn, aux; };

typedef int v4i_t __attribute__((ext_vector_type(4)));
typedef int v8i_t __attribute__((ext_vector_type(8)));
template <class Epi, class Sched, bool GATHER, int FPM = 0>
__device__ __forceinline__ void gemm_phase(PG8_LAS unsigned char* lds, const int nt  , const int lda  , const int ldb  , const Sched& S, const Epi& E, unsigned long long* pw = nullptr, const int sa = 0x7f7f7f7f) {
    constexpr bool FP8 = FPM != 0;
    const int tid = opaque_tid(), wid = __builtin_amdgcn_readfirstlane(tid >> 6), lane = tid & 63, wr = wid >> 2, wc = wid & 3, fr = lane & 15, fq = lane >> 4;
    unsigned voffB[2], ocA[2][2], onA[2][2];
#pragma unroll
    for (int i = 0; i < 2; ++i) { int R, C; stage_rc(tid * 16 + i * 8192, R, C); const int Rb = Epi::PERM ? ((R & ~31) + perm32(R & 31)) : R;
        voffB[i] = (unsigned)(Rb * ldb + C * 2);
        ocA[0][i] = (unsigned)(R * lda + C * 2); ocA[1][i] = (unsigned)((R + HALF) * lda + C * 2); onA[0][i] = ocA[0][i]; onA[1][i] = ocA[1][i]; }
    constexpr unsigned kstep = BK * 2;
    const unsigned hstepB = (unsigned)HALF * ldb;
    const unsigned ldsw = (unsigned)wid * 1024u;
    const int aoff = lds_byte(wr * 64 + fr, fq * 8), boff = lds_byte(wc * 32 + fr, fq * 8);
#define PG8_SA(b, h) (((b) * 2 + (h)) * HTB)
#define PG8_SB(b, h) ((4 + (b) * 2 + (h)) * HTB)
#define PG8_STAGE(bufoff, gbase, voff, kb) do { _Pragma("unroll") for (int _i = 0; _i < 2; ++_i) \
        __builtin_amdgcn_global_load_lds((const unsigned*)((const char*)(gbase) + (size_t)(unsigned)((voff)[_i] + (unsigned)(kb))), (PG8_LAS unsigned*)(lds + (bufoff) + ldsw + _i * 8192), 16, 0, 0); } while (0)
#define PG8_CAT(x0, x1) __builtin_shufflevector(x0, x1, 0, 1, 2, 3, 4, 5, 6, 7)
#define PG8_LO(x) __builtin_bit_cast(bf16x8, __builtin_shufflevector(x, x, 0, 1, 2, 3))
#define PG8_HI(x) __builtin_bit_cast(bf16x8, __builtin_shufflevector(x, x, 4, 5, 6, 7))
    const PG8_LAS unsigned char* const ldsA = lds + aoff; const PG8_LAS unsigned char* const ldsB = lds + 4 * HTB + boff;
#define PG8_LDA(dst, b, h) do { _Pragma("unroll") for (int m = 0; m < 4; ++m) dst[m] = PG8_CAT(*(const PG8_LAS v4i_t*)(ldsA + (PG8_SA(b, h) + m * 2048)), *(const PG8_LAS v4i_t*)(ldsA + (PG8_SA(b, h) + m * 2048 + 1024))); } while (0)
#define PG8_LDB(dst, b, h) do { _Pragma("unroll") for (int n = 0; n < 2; ++n) dst[n] = PG8_CAT(*(const PG8_LAS v4i_t*)(ldsB + (PG8_SB(b, h) - 4 * HTB + n * 2048)), *(const PG8_LAS v4i_t*)(ldsB + (PG8_SB(b, h) - 4 * HTB + n * 2048 + 1024))); } while (0)
#define PG8_MMA(ai, bj, At, Bt) do { __builtin_amdgcn_s_setprio(1); \
        if constexpr (FP8) { asm volatile("s_nop 4" ::: "memory"); _Pragma("unroll") for (int m = 0; m < 4; ++m) _Pragma("unroll") for (int n = 0; n < 2; ++n) \
            asm volatile("v_mfma_scale_f32_16x16x128_f8f6f4 %0, %1, %2, %0, %3, %4 op_sel_hi:[0,0,0]" : "+v"(acc[ai][bj][m][n]) : "v"(Bt[n]), "v"(At[m]), "v"(sB[bj][n]), "v"(FPM == 2 ? sA[m] : sav)); } \
        else { _Pragma("unroll") for (int m = 0; m < 4; ++m) _Pragma("unroll") for (int n = 0; n < 2; ++n) { \
            acc[ai][bj][m][n] = __builtin_amdgcn_mfma_f32_16x16x32_bf16(PG8_LO(Bt[n]), PG8_LO(At[m]), acc[ai][bj][m][n], 0, 0, 0); \
            acc[ai][bj][m][n] = __builtin_amdgcn_mfma_f32_16x16x32_bf16(PG8_HI(Bt[n]), PG8_HI(At[m]), acc[ai][bj][m][n], 0, 0, 0); } } \
        __builtin_amdgcn_s_setprio(0); } while (0)
    int sB[2][2] = {{0x7f, 0x7f}, {0x7f, 0x7f}}; int sav; asm volatile("v_mov_b32 %0, %1" : "=v"(sav) : "s"(sa));
    int sA[4] = {0x7f, 0x7f, 0x7f, 0x7f};
    const int scol = wc * 32 + (Epi::PERM ? 8 * (fr >> 2) + (fr & 3) : fr);
    const int sbase = FPM == 2 ? SCL_OFF + 16384 + scol * 2 + (fq >> 1) : SCL_OFF + scol * 4 + fq;
    const int sabase = SCL_OFF + ((wr * 64 + fr) << 2) + fq;
#define PG8_LDS_SCL(par_, kt_) do { if constexpr (FP8) { \
        const PG8_LAS unsigned char* sp_ = (const PG8_LAS unsigned char*)lds + sbase + (FPM == 2 ? (par_) * 4096 + (kt_) * 512 : (par_) * 8192 + (kt_) * 1024); \
        _Pragma("unroll") for (int bj_ = 0; bj_ < 2; ++bj_) _Pragma("unroll") for (int n_ = 0; n_ < 2; ++n_) sB[bj_][n_] = (int)sp_[(bj_ * 128 + n_ * (Epi::PERM ? 4 : 16)) * (FPM == 2 ? 2 : 4)]; } } while (0)
#define PG8_LDS_SCA(par_, kt_, ai_) do { if constexpr (FPM == 2) { const PG8_LAS unsigned char* sp_ = (const PG8_LAS unsigned char*)lds + sabase + (par_) * 8192 + (kt_) * 1024 + (ai_) * 512; \
        _Pragma("unroll") for (int m_ = 0; m_ < 4; ++m_) sA[m_] = (int)sp_[m_ * 64]; } } while (0)
#define PG8_DMA_SCL(u_, par_) do { if constexpr (FPM == 1) __builtin_amdgcn_global_load_lds((const unsigned*)((u_).S + wid * 1024 + lane * 16), (PG8_LAS unsigned*)(lds + SCL_OFF + (par_) * 8192 + wid * 1024), 16, 0, 0); \
        if constexpr (FPM == 2) { __builtin_amdgcn_global_load_lds((const unsigned*)((u_).SA + wid * 1024 + lane * 16), (PG8_LAS unsigned*)(lds + SCL_OFF + (par_) * 8192 + wid * 1024), 16, 0, 0); \
            if (wid < 4) __builtin_amdgcn_global_load_lds((const unsigned*)((u_).S + wid * 1024 + lane * 16), (PG8_LAS unsigned*)(lds + SCL_OFF + 16384 + (par_) * 4096 + wid * 1024), 16, 0, 0); } } while (0)
#define PG8_WAIT_V(n) asm volatile("s_waitcnt vmcnt(" #n ")" ::: "memory")
#define PG8_WAIT_L(n) asm volatile("s_waitcnt lgkmcnt(" #n ")" ::: "memory")
#define PG8_BAR __builtin_amdgcn_s_barrier()
#define PG8_SCHED __builtin_amdgcn_sched_barrier(0)
#define PG8_GOFFS(u, o) do { _Pragma("unroll") for (int _h = 0; _h < 2; ++_h) _Pragma("unroll") for (int _i = 0; _i < 2; ++_i) { int gR_, gC_; stage_rc(tid * 16 + _i * 8192, gR_, gC_); int _r = _h * HALF + gR_; _r = _r < (u).nvalid ? _r : (u).nvalid - 1; \
        const int _tok = (u).lst[_r]; (o)[_h][_i] = (unsigned)_tok * (unsigned)lda + (unsigned)(gC_ * 2); } } while (0)
#define PG8_GRAW(u, tk) do {   _Pragma("unroll") for (int _h = 0; _h < 2; ++_h) _Pragma("unroll") for (int _i = 0; _i < 2; ++_i) { int gR_, gC_; stage_rc(tid * 16 + _i * 8192, gR_, gC_); int _r = _h * HALF + gR_; _r = _r < (u).nvalid ? _r : (u).nvalid - 1; (tk)[_h][_i] = (unsigned)(u).lst[_r]; } } while (0)
    Unit cur, nxt, nn; int ui = 0;
#if PROBE_T
    unsigned long long pk_ = 0, pe_ = 0, pt0_ = 0, pn_ = 0; const unsigned long long pst_ = __builtin_amdgcn_s_memtime();
#endif
    if (!S.next(0, cur)) return;
    f32x4 acc[2][2][4][2];
#pragma unroll
    for (int a = 0; a < 2; ++a)
#pragma unroll
        for (int b = 0; b < 2; ++b)
#pragma unroll
            for (int m = 0; m < 4; ++m)
#pragma unroll
                for (int n = 0; n < 2; ++n) acc[a][b][m][n] = (f32x4){0.f, 0.f, 0.f, 0.f};
    v8i_t At[4], B0[2], B1[2];
    const char* cA = cur.A; const char* cB = cur.B;
    bool has_next = S.next(1, nxt);
    if constexpr (GATHER) { PG8_GOFFS(cur, ocA);
        if (has_next) { PG8_GOFFS(nxt, onA); }
        else {
#pragma unroll
            for (int h = 0; h < 2; ++h)
#pragma unroll
                for (int i = 0; i < 2; ++i) onA[h][i] = ocA[h][i]; } }
    PG8_DMA_SCL(cur, 0); if (has_next) PG8_DMA_SCL(nxt, 1);
    PG8_STAGE(PG8_SB(0, 0), cB, voffB, 0u); PG8_STAGE(PG8_SB(0, 1), cB, voffB, hstepB); PG8_STAGE(PG8_SA(0, 0), cA, ocA[0], 0u); PG8_STAGE(PG8_SA(0, 1), cA, ocA[1], 0u);
    if (wr == 1) PG8_BAR;
    PG8_WAIT_V(2); PG8_BAR;
    PG8_STAGE(PG8_SB(1, 0), cB, voffB, kstep); PG8_STAGE(PG8_SA(1, 0), cA, ocA[0], kstep); PG8_STAGE(PG8_SB(1, 1), cB, voffB, hstepB + kstep);
    PG8_WAIT_V(6); PG8_BAR;
    for (;;) {
        const char* nA = has_next ? nxt.A : cA; const char* nB = has_next ? nxt.B : cB;
#if PROBE_T
        pt0_ = __builtin_amdgcn_s_memtime();
#endif
#pragma unroll 1
        for (int t = 0; t < nt; t += 2) {
            const bool last = (t == nt - 2);
            const unsigned k1 = (unsigned)(t + 1) * kstep, k2 = last ? 0u : (unsigned)(t + 2) * kstep, k3 = k2 + kstep;
            const char* a2 = last ? nA : cA; const char* b2 = last ? nB : cB;
#define PG8_STAGE_A2(bufoff, h_, kb_) do { if (GATHER && last) PG8_STAGE(bufoff, a2, onA[h_], kb_); else PG8_STAGE(bufoff, a2, ocA[h_], kb_); } while (0)
            PG8_LDB(B0, 0, 0); PG8_LDB(B1, 0, 1); PG8_LDS_SCL(ui & 1, t); PG8_SCHED; PG8_LDA(At, 0, 0); PG8_LDS_SCA(ui & 1, t, 0); PG8_STAGE(PG8_SA(1, 1), cA, ocA[1], k1);
            PG8_WAIT_V(8); PG8_WAIT_L(0); PG8_BAR; PG8_MMA(0, 0, At, B0); PG8_MMA(0, 1, At, B1); PG8_BAR; PG8_SCHED;
            PG8_LDA(At, 0, 1); PG8_LDS_SCA(ui & 1, t, 1); PG8_STAGE(PG8_SB(0, 0), b2, voffB, k2); PG8_STAGE(PG8_SB(0, 1), b2, voffB, hstepB + k2); PG8_STAGE_A2(PG8_SA(0, 0), 0, k2);
            PG8_WAIT_V(8); PG8_WAIT_L(0); PG8_BAR; PG8_MMA(1, 0, At, B0); PG8_MMA(1, 1, At, B1); PG8_BAR; PG8_SCHED;
            PG8_LDB(B0, 1, 0); PG8_LDB(B1, 1, 1); PG8_LDS_SCL(ui & 1, t + 1); PG8_SCHED; PG8_LDA(At, 1, 0); PG8_LDS_SCA(ui & 1, t + 1, 0); PG8_STAGE_A2(PG8_SA(0, 1), 1, k2);
            PG8_WAIT_V(8); PG8_WAIT_L(0); PG8_BAR; PG8_MMA(0, 0, At, B0); PG8_MMA(0, 1, At, B1); PG8_BAR; PG8_SCHED;
            PG8_LDA(At, 1, 1); PG8_LDS_SCA(ui & 1, t + 1, 1); PG8_STAGE(PG8_SB(1, 0), b2, voffB, k3); PG8_STAGE(PG8_SB(1, 1), b2, voffB, hstepB + k3); PG8_STAGE_A2(PG8_SA(1, 0), 0, k3);
            PG8_WAIT_V(8); PG8_WAIT_L(0); PG8_BAR; PG8_MMA(1, 0, At, B0); PG8_MMA(1, 1, At, B1); PG8_BAR; PG8_SCHED;
        }
#if PROBE_T
        const unsigned long long pt1_ = __builtin_amdgcn_s_memtime(); pk_ += pt1_ - pt0_;
#endif
        if constexpr (FP8) asm volatile("s_nop 15\n\ts_nop 7" ::: "memory");
        const bool has_nn = has_next && S.next(ui + 2, nn);
        if constexpr (GATHER) {
#pragma unroll
            for (int h = 0; h < 2; ++h)
#pragma unroll
                for (int i = 0; i < 2; ++i) ocA[h][i] = onA[h][i];
            if (has_nn) { PG8_GRAW(nn, onA); } }
        if (wr == 0) PG8_BAR;
        E(acc, cur, wr, wc, fr, fq);
#if PROBE_T
        asm volatile("s_waitcnt vmcnt(0)" ::: "memory"); pe_ += __builtin_amdgcn_s_memtime() - pt1_; ++pn_;
#endif
        if (!has_next) break;
#pragma unroll
        for (int a = 0; a < 2; ++a)
#pragma unroll
            for (int b = 0; b < 2; ++b)
#pragma unroll
                for (int m = 0; m < 4; ++m)
#pragma unroll
                    for (int n = 0; n < 2; ++n) acc[a][b][m][n] = zero4();
        cur = nxt; cA = nA; cB = nB; ++ui;
        if constexpr (GATHER) { if (has_nn) {
#pragma unroll
            for (int h = 0; h < 2; ++h)
#pragma unroll
                for (int i = 0; i < 2; ++i) { int gR_, gC_; stage_rc(tid * 16 + i * 8192, gR_, gC_); onA[h][i] = onA[h][i] * (unsigned)lda + (unsigned)(gC_ * 2); } } }
        if (has_nn) { nxt = nn; PG8_DMA_SCL(nxt, (ui + 1) & 1); }
        has_next = has_nn;
        if (wr == 1) PG8_BAR;
    }
    PG8_WAIT_V(0);
    PG8_BAR;
#if PROBE_T
    if (pw && blockIdx.x == 0 && tid == 0) { pw[0] += pk_; pw[1] += pe_; pw[2] += pn_; pw[3] += __builtin_amdgcn_s_memtime() - pst_; }
#endif
#undef PG8_SA
#undef PG8_SB
#undef PG8_STAGE
#undef PG8_LDA
#undef PG8_LDB
#undef PG8_MMA
#undef PG8_WAIT_V
#undef PG8_WAIT_L
#undef PG8_BAR
#undef PG8_SCHED
#undef PG8_GOFFS
#undef PG8_GRAW
#undef PG8_STAGE_A2
#undef PG8_CAT
#undef PG8_LO
#undef PG8_HI
#undef PG8_LDS_SCL
#undef PG8_LDS_SCA
#undef PG8_DMA_SCL
}

constexpr int NXCD = 8, WGM = 8;
template <int NM, int NN>
struct DenseSched {
    static_assert(NM % WGM == 0, "row tiles in groups of 8");
    const char* A; const char* B; int lda, ldb; int G, c; int apn_shift, akbytes, bpm_shift; size_t bbatch; const char* SW;
    __device__ __forceinline__ void init(const void* A_, const void* B_, int lda_, int ldb_, int G_, int c_) {
        A = (const char*)A_; B = (const char*)B_; lda = lda_; ldb = ldb_; G = G_; c = c_; apn_shift = -1; akbytes = 0; bpm_shift = -1; bbatch = 0; SW = nullptr; }
    __device__ __forceinline__ bool next(int i, Unit& u) const {
        constexpr int nwg = NM * NN, q = nwg / NXCD, r = nwg % NXCD, nig = WGM * NN;
        const int L = i * G + c; if (L >= nwg) return false;
        int wgid = L; { const int xcd = wgid % NXCD, off = wgid / NXCD; wgid = (xcd < r ? xcd * (q + 1) : r * (q + 1) + (xcd - r) * q) + off; }
        const int gid = wgid / nig, rem = wgid - gid * nig;
        const int pm = gid * WGM + (rem & (WGM - 1)), pn = rem / WGM;
        u.pm = pm; u.pn = pn; u.aux = 0; u.lst = nullptr; u.nvalid = 256; u.S = SW ? SW + (size_t)pn * 8192 : nullptr; u.SA = nullptr;
        u.A = A + (size_t)pm * 256 * lda * 2 + (apn_shift >= 0 ? (size_t)(pn >> apn_shift) * akbytes : (size_t)0);
        u.B = B + (size_t)pn * 256 * ldb * 2 + (bpm_shift >= 0 ? (size_t)(pm >> bpm_shift) * bbatch : (size_t)0);
        return true;
    }
};
struct MoeSched {
    const char* A; const char* B; size_t bexp; const char* SW; int lda, ldb  , nN; const int* lists; volatile LAS const int* tab; volatile LAS const unsigned char* te; int G, c; bool gather; const char* SA;
    __device__ __forceinline__ bool next(int i, Unit& u) const {
        int pn, mg;
        if (G == 256) {
            const int x = c & 7, jj = c >> 3, pgs = nN >> 2, mgs = 8 / pgs;
            mg = i * (8 * mgs) + 8 * (x / pgs) + (jj & 7); pn = 4 * (x % pgs) + (jj >> 3);
            if (mg >= __builtin_amdgcn_readfirstlane(tab[32])) return false;
        } else { const int total = __builtin_amdgcn_readfirstlane(tab[32]) * nN; const long L = (long)i * G + c; if (L >= total) return false; pn = (int)(L % nN); mg = (int)(L / nN); }
        const int e = __builtin_amdgcn_readfirstlane((int)te[mg]), mt = mg - __builtin_amdgcn_readfirstlane(tab[e]);
        u.pm = mg; u.pn = pn; u.aux = e;
        if (gather) { u.A = A; u.lst = lists + (size_t)e * T + mt * 256; const int rem = __builtin_amdgcn_readfirstlane(tab[48 + e]) - mt * 256; u.nvalid = rem < 256 ? rem : 256; }
        else { u.A = A + (size_t)mg * 256 * lda; u.lst = nullptr; u.nvalid = 256; }
        u.B = B + (size_t)e * bexp + (size_t)pn * 256 * ldb; u.S = SW ? (SA ? SW + ((size_t)e * 4 + pn) * 4096 : SW + ((size_t)e * 8 + pn) * 8192) : nullptr; u.SA = SA ? SA + (size_t)mg * 8192 : nullptr;
        return true;
    }
};

#define EPI_ROW(u, ai, m) ((u).pm * 256 + (ai) * 128 + wr * 64 + (m) * 16 + fr)
struct EpiLat {
    static constexpr bool PERM = true;
    bf16_t* LAT; float* SSQ; bf16_t* KR; const float* CS; const float* SN;
    __device__ __forceinline__ void operator()(const f32x4 (&acc)[2][2][4][2], const Unit& u, int wr, int wc, int fr, int fq) const {
        if (u.pn < 4) {
#pragma unroll
            for (int ai = 0; ai < 2; ++ai)
#pragma unroll
                for (int m = 0; m < 4; ++m) { const int row = EPI_ROW(u, ai, m); float ss = 0.f;
#pragma unroll
                    for (int bj = 0; bj < 2; ++bj) { const f32x4 v0 = acc[ai][bj][m][0], v1 = acc[ai][bj][m][1];
                        ss += (v0[0] * v0[0] + v0[1] * v0[1]) + (v0[2] * v0[2] + v0[3] * v0[3]) + (v1[0] * v1[0] + v1[1] * v1[1]) + (v1[2] * v1[2] + v1[3] * v1[3]);
                        *(u32x4*)(LAT + (size_t)row * 1024 + u.pn * 256 + bj * 128 + wc * 32 + 8 * fq) = pack8(v0, v1); }
                    ss += __shfl_xor(ss, 16); ss += __shfl_xor(ss, 32);
                    if (fq == 0) SSQ[(size_t)row * 16 + u.pn * 4 + wc] = ss; }
        } else if (wc == 0) {
#pragma unroll
            for (int ai = 0; ai < 2; ++ai) {
                f32x4 cv[4][2], sv[4][2];
#pragma unroll
                for (int m = 0; m < 4; ++m) { const int row = EPI_ROW(u, ai, m);
                    cv[m][0] = *(const f32x4*)(CS + (size_t)row * 32 + 8 * fq); cv[m][1] = *(const f32x4*)(CS + (size_t)row * 32 + 8 * fq + 4);
                    sv[m][0] = *(const f32x4*)(SN + (size_t)row * 32 + 8 * fq); sv[m][1] = *(const f32x4*)(SN + (size_t)row * 32 + 8 * fq + 4); }
#pragma unroll
                for (int m = 0; m < 4; ++m) { const int row = EPI_ROW(u, ai, m);
                    const f32x4 c0 = cv[m][0], c1 = cv[m][1], s0 = sv[m][0], s1 = sv[m][1];
                    const f32x4 a0 = acc[ai][0][m][0], a1 = acc[ai][0][m][1], b0 = acc[ai][1][m][0], b1 = acc[ai][1][m][1];
                    *(u32x4*)(KR + (size_t)row * 64 + 8 * fq) = pack8(a0 * c0 - b0 * s0, a1 * c1 - b1 * s1);
                    *(u32x4*)(KR + (size_t)row * 64 + 32 + 8 * fq) = pack8(b0 * c0 + a0 * s0, b1 * c1 + a1 * s1); }
                asm volatile("" ::: "memory"); }
        }
    }
};
struct EpiQ {
    static constexpr bool PERM = true;
    bf16_t* Q; const float* SSQ; const float* CS; const float* SN;
    __device__ __forceinline__ void operator()(const f32x4 (&acc)[2][2][4][2], const Unit& u, int wr, int wc, int fr, int fq) const {
        float rr[2][4];
        { f32x4 qv[2][4];
#pragma unroll
          for (int ai = 0; ai < 2; ++ai)
#pragma unroll
              for (int m = 0; m < 4; ++m) qv[ai][m] = *(const f32x4*)(SSQ + (size_t)EPI_ROW(u, ai, m) * 16 + 4 * (fq < 3 ? fq : 0));
#pragma unroll
          for (int ai = 0; ai < 2; ++ai)
#pragma unroll
              for (int m = 0; m < 4; ++m) { const f32x4 q0 = qv[ai][m]; float ss = fq < 3 ? (q0[0] + q0[1]) + (q0[2] + q0[3]) : 0.f;
                  ss += __shfl_xor(ss, 16); ss += __shfl_xor(ss, 32);
                  rr[ai][m] = QSCALE / sqrtf(ss * (1.0f / QL) + KF(RMS_EPS)); } }
        if (u.pn < 4) {
#pragma unroll
            for (int ai = 0; ai < 2; ++ai)
#pragma unroll
                for (int m = 0; m < 4; ++m) { const int row = EPI_ROW(u, ai, m); const float r = rr[ai][m];
#pragma unroll
                    for (int bj = 0; bj < 2; ++bj)
                        *(u32x4*)(Q + (size_t)row * 1536 + (2 * u.pn + bj) * 192 + wc * 32 + 8 * fq) = pack8(acc[ai][bj][m][0] * r, acc[ai][bj][m][1] * r); }
        } else {
            const int head = 4 * (u.pn - 4) + wc;
#pragma unroll
            for (int am = 0; am < 4; ++am) { const int ai = am >> 1;
                f32x4 cv[2][2], sv[2][2];
#pragma unroll
                for (int mm = 0; mm < 2; ++mm) { const int row = EPI_ROW(u, ai, 2 * (am & 1) + mm);
                    cv[mm][0] = *(const f32x4*)(CS + (size_t)row * 32 + 8 * fq); cv[mm][1] = *(const f32x4*)(CS + (size_t)row * 32 + 8 * fq + 4);
                    sv[mm][0] = *(const f32x4*)(SN + (size_t)row * 32 + 8 * fq); sv[mm][1] = *(const f32x4*)(SN + (size_t)row * 32 + 8 * fq + 4); }
#pragma unroll
                for (int mm = 0; mm < 2; ++mm) { const int m = 2 * (am & 1) + mm; const int row = EPI_ROW(u, ai, m); const float r = rr[ai][m];
                    const f32x4 c0 = cv[mm][0], c1 = cv[mm][1], s0 = sv[mm][0], s1 = sv[mm][1];
                    const f32x4 a0 = acc[ai][0][m][0] * r, a1 = acc[ai][0][m][1] * r, b0 = acc[ai][1][m][0] * r, b1 = acc[ai][1][m][1] * r;
                    *(u32x4*)(Q + (size_t)row * 1536 + head * 192 + 128 + 8 * fq) = pack8(a0 * c0 - b0 * s0, a1 * c1 - b1 * s1);
                    *(u32x4*)(Q + (size_t)row * 1536 + head * 192 + 160 + 8 * fq) = pack8(b0 * c0 + a0 * s0, b1 * c1 + a1 * s1); }
                asm volatile("" ::: "memory"); }
        }
    }
};
struct EpiKV {
    static constexpr bool PERM = true;
    bf16_t* KN; bf16_t* V; const float* SSQ;
    __device__ __forceinline__ void operator()(const f32x4 (&acc)[2][2][4][2], const Unit& u, int wr, int wc, int fr, int fq) const {
        f32x4 q3v[2][4];
#pragma unroll
        for (int ai = 0; ai < 2; ++ai)
#pragma unroll
            for (int m = 0; m < 4; ++m) q3v[ai][m] = *(const f32x4*)(SSQ + (size_t)EPI_ROW(u, ai, m) * 16 + 12);
#pragma unroll
        for (int ai = 0; ai < 2; ++ai)
#pragma unroll
            for (int m = 0; m < 4; ++m) { const int row = EPI_ROW(u, ai, m);
                const f32x4 q3 = q3v[ai][m];
                const float r = 1.0f / sqrtf(((q3[0] + q3[1]) + (q3[2] + q3[3])) * (1.0f / KVL) + KF(RMS_EPS));
                *(u32x4*)(KN + (size_t)row * 1024 + u.pn * 128 + wc * 32 + 8 * fq) = pack8(acc[ai][0][m][0] * r, acc[ai][0][m][1] * r);
                *(u32x4*)(V + (size_t)row * 1024 + u.pn * 128 + wc * 32 + 8 * fq) = pack8(acc[ai][1][m][0] * r, acc[ai][1][m][1] * r); }
    }
};
__device__ __forceinline__ f32x4 bf4_lo(const u32x4 w) { return (f32x4){bf_lo(w.x), bf_hi(w.x), bf_lo(w.y), bf_hi(w.y)}; }
__device__ __forceinline__ f32x4 bf4_hi(const u32x4 w) { return (f32x4){bf_lo(w.z), bf_hi(w.z), bf_lo(w.w), bf_hi(w.w)}; }
struct EpiRes {
    static constexpr bool PERM = true;
    const bf16_t* X; bf16_t* Y;
    __device__ __forceinline__ void operator()(const f32x4 (&acc)[2][2][4][2], const Unit& u, int wr, int wc, int fr, int fq) const {
        const bf16_t* xb = X + (size_t)u.pm * 256 * 1024; bf16_t* yb = Y + (size_t)u.pm * 256 * 1024; const unsigned o0 = (unsigned)((wr * 64 + fr) * 1024 + u.pn * 256 + wc * 32 + 8 * fq);
        u32x4 xw[2][4][2];
#pragma unroll
        for (int ai = 0; ai < 2; ++ai)
#pragma unroll
            for (int m = 0; m < 4; ++m)
#pragma unroll
                for (int bj = 0; bj < 2; ++bj) xw[ai][m][bj] = *(const u32x4*)(xb + (o0 + (unsigned)((ai * 128 + m * 16) * 1024 + bj * 128)));
#pragma unroll
        for (int ai = 0; ai < 2; ++ai)
#pragma unroll
            for (int m = 0; m < 4; ++m)
#pragma unroll
                for (int bj = 0; bj < 2; ++bj)
                    *(u32x4*)(yb + (o0 + (unsigned)((ai * 128 + m * 16) * 1024 + bj * 128))) = pack8(bf4_lo(xw[ai][m][bj]) * ALPHA + acc[ai][bj][m][0], bf4_hi(xw[ai][m][bj]) * ALPHA + acc[ai][bj][m][1]);
    }
};
struct EpiGU {
    static constexpr bool PERM = true;
    bf16_t* GG; bf16_t* U;
    __device__ __forceinline__ void operator()(const f32x4 (&acc)[2][2][4][2], const Unit& u, int wr, int wc, int fr, int fq) const {
#pragma unroll
        for (int ai = 0; ai < 2; ++ai)
#pragma unroll
            for (int m = 0; m < 4; ++m) { const int row = EPI_ROW(u, ai, m);
#pragma unroll
                for (int bj = 0; bj < 2; ++bj) { f32x4 v0 = acc[ai][bj][m][0], v1 = acc[ai][bj][m][1];
                    if (u.pn < 4) {
                        const float k0 = KF(-2.0f * 0.7978845608028654f * 1.4426950408889634f), k1 = KF(-2.0f * 0.7978845608028654f * 1.4426950408889634f * 0.044715f);
                        const f32x4 z0 = v0 * (v0 * v0 * k1 + k0), z1 = v1 * (v1 * v1 * k1 + k0); f32x4 e0, e1, r0, r1;
#pragma unroll
                        for (int e = 0; e < 4; ++e) { e0[e] = __builtin_amdgcn_exp2f(z0[e]); e1[e] = __builtin_amdgcn_exp2f(z1[e]); }
                        const f32x4 d0 = e0 + 1.0f, d1 = e1 + 1.0f;
#pragma unroll
                        for (int e = 0; e < 4; ++e) { r0[e] = __builtin_amdgcn_rcpf(d0[e]); r1[e] = __builtin_amdgcn_rcpf(d1[e]); }
                        v0 = v0 * r0; v1 = v1 * r1;
                        *(u32x4*)(GG + (size_t)row * 1024 + u.pn * 256 + bj * 128 + wc * 32 + 8 * fq) = pack8(v0, v1);
                    } else *(u32x4*)(U + (size_t)row * 1024 + (u.pn - 4) * 256 + bj * 128 + wc * 32 + 8 * fq) = pack8(v0, v1); } }
    }
};
struct EpiAB {
    static constexpr bool PERM = true;
    bf16_t* LA; bf16_t* BB; const bf16_t* UC; const float* BA; const float* BX; const float* SPL;
    __device__ __forceinline__ void operator()(const f32x4 (&acc)[2][2][4][2], const Unit& u, int wr, int wc, int fr, int fq) const {
        const int ch = (u.pn >> 1) * 256 + (u.pn & 1) * 128 + wc * 32 + 8 * fq;
        const float nl2e = KF(-1.4426950408889634f);
        f32x4 ba[2], bx[2], sp[2];
#pragma unroll
        for (int n = 0; n < 2; ++n) { ba[n] = *(const f32x4*)(BA + ch + 4 * n); bx[n] = *(const f32x4*)(BX + ch + 4 * n); sp[n] = *(const f32x4*)(SPL + ch + 4 * n) * (-nl2e); }
        u32x4 uwv[2][4];
#pragma unroll
        for (int ai = 0; ai < 2; ++ai)
#pragma unroll
            for (int m = 0; m < 4; ++m) uwv[ai][m] = *(const u32x4*)(UC + (size_t)EPI_ROW(u, ai, m) * 1024 + ch);
#pragma unroll
        for (int ai = 0; ai < 2; ++ai)
#pragma unroll
            for (int m = 0; m < 4; ++m) { const size_t off = (size_t)EPI_ROW(u, ai, m) * 1024 + ch;
                const u32x4 uw = uwv[ai][m]; f32x4 uv[2] = {bf4_lo(uw), bf4_hi(uw)}, lv[2], bv[2];
#pragma unroll
                for (int n = 0; n < 2; ++n) {
                    const f32x4 ta = (acc[ai][0][m][n] + ba[n]) * nl2e, tx = (acc[ai][1][m][n] + bx[n]) * nl2e; f32x4 ea, ex, ra, ri, a2, sq;
#pragma unroll
                    for (int e = 0; e < 4; ++e) { ea[e] = __builtin_amdgcn_exp2f(ta[e]); ex[e] = __builtin_amdgcn_exp2f(tx[e]); }
                    const f32x4 da = ea + 1.0f, dx = ex + 1.0f;
#pragma unroll
                    for (int e = 0; e < 4; ++e) { ra[e] = __builtin_amdgcn_rcpf(da[e]); ri[e] = __builtin_amdgcn_rcpf(dx[e]); }
                    const f32x4 l2 = sp[n] * ra, t2 = l2 + l2; lv[n] = l2;
#pragma unroll
                    for (int e = 0; e < 4; ++e) a2[e] = __builtin_amdgcn_exp2f(t2[e]);
                    const f32x4 om = 1.0f - a2;
#pragma unroll
                    for (int e = 0; e < 4; ++e) sq[e] = __builtin_amdgcn_sqrtf(fmaxf(om[e], 0.0f));
                    bv[n] = sq * ri * uv[n]; }
                *(u32x4*)(LA + off) = pack8(lv[0], lv[1]); *(u32x4*)(BB + off) = pack8(bv[0], bv[1]); asm volatile("" ::: "memory"); }
    }
};
struct EpiUp {
    static constexpr bool PERM = true;
    unsigned char* H; unsigned char* SH; const float* BU;
    __device__ __forceinline__ void operator()(f32x4 (&acc)[2][2][4][2], const Unit& u, int wr, int wc, int fr, int fq) const {
        const int gc = u.pn * 128 + wc * 32 + 8 * fq; const float* bu = BU + (size_t)u.aux * 2048;
        const float k7 = KF(7.0f), km6 = KF(-6.0f), k8 = KF(8.0f), ka = KF(-1.702f * 1.4426950408889634f);
#pragma unroll
        for (int n = 0; n < 2; ++n) { const f32x4 bg = *(const f32x4*)(bu + gc + 4 * n), bp = *(const f32x4*)(bu + 1024 + gc + 4 * n) + 1.0f;
#pragma unroll
            for (int ai = 0; ai < 2; ++ai)
#pragma unroll
                for (int m = 0; m < 4; ++m) {
                    { f32x4 g = acc[ai][0][m][n] + bg, up = acc[ai][1][m][n] + bp, ex, rc;
#pragma unroll
                      for (int e = 0; e < 4; ++e) { g[e] = fminf(g[e], k7); up[e] = __builtin_amdgcn_fmed3f(up[e], km6, k8); }
                      const f32x4 tz = g * ka;
#pragma unroll
                      for (int e = 0; e < 4; ++e) ex[e] = __builtin_amdgcn_exp2f(tz[e]);
                      const f32x4 dn = ex + 1.0f;
#pragma unroll
                      for (int e = 0; e < 4; ++e) rc[e] = __builtin_amdgcn_rcpf(dn[e]);
                      acc[ai][0][m][n] = up * (g * rc); }
                    if (m & 1) __builtin_amdgcn_sched_barrier(0); }
            asm volatile("" ::: "memory"); }
        unsigned char* const shb = SH + ((size_t)u.pm * 8 + u.pn) * 1024; unsigned char* const hb = H + (size_t)u.pm * 256 * 1024;
        const unsigned ho = (unsigned)((wr * 64 + fr) * 1024 + gc), so = (unsigned)((wr * 64 + fr) * 4 + wc);
#pragma unroll
        for (int ai = 0; ai < 2; ++ai)
#pragma unroll
            for (int m = 0; m < 4; ++m) { const f32x4 y0 = acc[ai][0][m][0], y1 = acc[ai][0][m][1];
                float am = fmaxf(fmaxf(fmaxf(fabsf(y0[0]), fabsf(y0[1])), fmaxf(fabsf(y0[2]), fabsf(y0[3]))), fmaxf(fmaxf(fabsf(y1[0]), fabsf(y1[1])), fmaxf(fabsf(y1[2]), fabsf(y1[3]))));
                { auto r16 = __builtin_amdgcn_permlane16_swap(__float_as_uint(am), __float_as_uint(am), false, false); am = fmaxf(__uint_as_float(r16[0]), __uint_as_float(r16[1]));
                  auto r32 = __builtin_amdgcn_permlane32_swap(__float_as_uint(am), __float_as_uint(am), false, false); am = fmaxf(__uint_as_float(r32[0]), __uint_as_float(r32[1])); }
                int eb = (int)((__float_as_uint(am) >> 23) & 0xffu) - 7; eb = eb < 1 ? 1 : eb;
                const float inv = __uint_as_float((unsigned)(254 - eb) << 23);
                const f32x4 z0 = y0 * inv, z1 = y1 * inv;
                int w0 = __builtin_amdgcn_cvt_pk_fp8_f32(z0[0], z0[1], 0, false); w0 = __builtin_amdgcn_cvt_pk_fp8_f32(z0[2], z0[3], w0, true);
                int w1 = __builtin_amdgcn_cvt_pk_fp8_f32(z1[0], z1[1], 0, false); w1 = __builtin_amdgcn_cvt_pk_fp8_f32(z1[2], z1[3], w1, true);
                *(u32x2*)(hb + (ho + (unsigned)((ai * 128 + m * 16) * 1024))) = (u32x2){(unsigned)w0, (unsigned)w1};
                if (fq == 0) shb[so + (unsigned)((ai * 128 + m * 16) * 4)] = (unsigned char)eb;
                asm volatile("" ::: "memory"); __builtin_amdgcn_sched_barrier(0); }
    }
};
struct EpiDown {
    static constexpr bool PERM = true;
    unsigned char* YS; unsigned char* SY; const float* BD;
    __device__ __forceinline__ void operator()(const f32x4 (&acc)[2][2][4][2], const Unit& u, int wr, int wc, int fr, int fq) const {
        const float* bd = BD + (size_t)u.aux * 1024;
        unsigned char* const yb = YS + (size_t)u.pm * 256 * 1024; unsigned char* const sb = SY + (size_t)u.pm * 256 * 32;
#pragma unroll
        for (int bj = 0; bj < 2; ++bj) { const int col = u.pn * 256 + bj * 128 + wc * 32 + 8 * fq; const f32x4 b0 = *(const f32x4*)(bd + col), b1 = *(const f32x4*)(bd + col + 4);
#pragma unroll
            for (int ai = 0; ai < 2; ++ai)
#pragma unroll
                for (int m = 0; m < 4; ++m) { const unsigned rit = (unsigned)(ai * 128 + wr * 64 + m * 16 + fr); const f32x4 y0 = acc[ai][bj][m][0] + b0, y1 = acc[ai][bj][m][1] + b1;
                    float am = fmaxf(fmaxf(fmaxf(fabsf(y0[0]), fabsf(y0[1])), fmaxf(fabsf(y0[2]), fabsf(y0[3]))), fmaxf(fmaxf(fabsf(y1[0]), fabsf(y1[1])), fmaxf(fabsf(y1[2]), fabsf(y1[3]))));
                    { auto r16 = __builtin_amdgcn_permlane16_swap(__float_as_uint(am), __float_as_uint(am), false, false); am = fmaxf(__uint_as_float(r16[0]), __uint_as_float(r16[1]));
                      auto r32 = __builtin_amdgcn_permlane32_swap(__float_as_uint(am), __float_as_uint(am), false, false); am = fmaxf(__uint_as_float(r32[0]), __uint_as_float(r32[1])); }
                    int eb = (int)((__float_as_uint(am) >> 23) & 0xffu) - 7; eb = eb < 1 ? 1 : eb;
                    const float inv = __uint_as_float((unsigned)(254 - eb) << 23);
                    const f32x4 z0 = y0 * inv, z1 = y1 * inv;
                    int w0 = __builtin_amdgcn_cvt_pk_fp8_f32(z0[0], z0[1], 0, false); w0 = __builtin_amdgcn_cvt_pk_fp8_f32(z0[2], z0[3], w0, true);
                    int w1 = __builtin_amdgcn_cvt_pk_fp8_f32(z1[0], z1[1], 0, false); w1 = __builtin_amdgcn_cvt_pk_fp8_f32(z1[2], z1[3], w1, true);
                    *(u32x2*)(yb + (rit * 1024u + (unsigned)col)) = (u32x2){(unsigned)w0, (unsigned)w1};
                    if (fq == 0) sb[rit * 32u + (unsigned)(col >> 5)] = (unsigned char)eb;
                    asm volatile("" ::: "memory"); } }
    }
};
struct EpiPle {
    static constexpr bool PERM = true;
    const bf16_t* X2; const bf16_t* PP; float* OUT; bf16_t* XB;
    __device__ __forceinline__ void operator()(const f32x4 (&acc)[2][2][4][2], const Unit& u, int wr, int wc, int fr, int fq) const {
        const size_t tb = (size_t)u.pm * 256 * 1024; const unsigned o0 = (unsigned)((wr * 64 + fr) * 1024 + u.pn * 256 + wc * 32 + 8 * fq);
#pragma unroll
        for (int ai = 0; ai < 2; ++ai) {
            u32x4 xw[4][2], pw[4][2];
#pragma unroll
            for (int m = 0; m < 4; ++m)
#pragma unroll
                for (int bj = 0; bj < 2; ++bj) { const unsigned o = o0 + (unsigned)((ai * 128 + m * 16) * 1024 + bj * 128); xw[m][bj] = *(const u32x4*)(X2 + tb + o); pw[m][bj] = *(const u32x4*)(PP + tb + o); }
#pragma unroll
            for (int m = 0; m < 4; ++m)
#pragma unroll
                for (int bj = 0; bj < 2; ++bj) { const unsigned o = o0 + (unsigned)((ai * 128 + m * 16) * 1024 + bj * 128);
                    const f32x4 a0 = acc[ai][bj][m][0], a1 = acc[ai][bj][m][1], x0 = bf4_lo(xw[m][bj]), x1 = bf4_hi(xw[m][bj]), p0 = bf4_lo(pw[m][bj]), p1 = bf4_hi(pw[m][bj]); f32x4 r0, r1;
                    { const float nl2e = KF(-1.4426950408889634f); const f32x4 t0 = a0 * nl2e, t1 = a1 * nl2e; f32x4 e0, e1, s0, s1;
#pragma unroll
                      for (int e = 0; e < 4; ++e) { e0[e] = __builtin_amdgcn_exp2f(t0[e]); e1[e] = __builtin_amdgcn_exp2f(t1[e]); }
                      const f32x4 d0 = e0 + 1.0f, d1 = e1 + 1.0f;
#pragma unroll
                      for (int e = 0; e < 4; ++e) { s0[e] = __builtin_amdgcn_rcpf(d0[e]); s1[e] = __builtin_amdgcn_rcpf(d1[e]); }
                      r0 = x0 + s0 * p0; r1 = x1 + s1 * p1; }
                    if (OUT) { *(f32x4*)(OUT + tb + o) = r0; *(f32x4*)(OUT + tb + o + 4) = r1; }
                    else *(u32x4*)(XB + tb + o) = pack8(r0, r1); }
            asm volatile("" ::: "memory"); }
    }
};
struct EpiPP {
    static constexpr bool PERM = true;
    bf16_t* PP;
    __device__ __forceinline__ void operator()(const f32x4 (&acc)[2][2][4][2], const Unit& u, int wr, int wc, int fr, int fq) const {
#pragma unroll
        for (int ai = 0; ai < 2; ++ai)
#pragma unroll
            for (int m = 0; m < 4; ++m)
#pragma unroll
                for (int bj = 0; bj < 2; ++bj) *(u32x4*)(PP + (size_t)EPI_ROW(u, ai, m) * 1024 + u.pn * 256 + bj * 128 + wc * 32 + 8 * fq) = pack8(acc[ai][bj][m][0], acc[ai][bj][m][1]);
    }
};
}

namespace att {
constexpr int NW = 8, QBLK = 32, KVBLK = 64, QB = 256, KPITCH = 384;
constexpr int SHM_V = KVBLK * DV * 2, SHM_K = KVBLK * KPITCH;
constexpr int NVB = 3;
constexpr int OFF_V = 0, OFF_K = NVB * SHM_V, OFF_WS = OFF_K + 2 * SHM_K, LDS_BYTES = OFF_WS + NW * 64 * 4;
#define SBAR() __builtin_amdgcn_sched_barrier(0)
__device__ __forceinline__ int k_addr(int row, int chunk) { return row * KPITCH + ((chunk ^ ((row >> 1) & 7)) << 4); }
__device__ __forceinline__ int v_st(int k, int c) { const int kk = (k & ~0xC) | ((k & 4) << 1) | ((k & 8) >> 1); return ((kk >> 3) * 4 + (c >> 5)) * 512 + ((kk & 7) * 32 + (c & 31)) * 2; }
__device__ __forceinline__ int v_rd_base(int lane) { return ((lane & 3) << 3) | (((lane >> 2) & 3) << 6) | (((lane >> 4) & 1) << 5) | (((lane >> 5) & 1) << 8); }
constexpr int v_rd_off(int d0, int ks, int half) { return d0 * 512 + ks * 4096 + half * 2048; }
__device__ __forceinline__ int crow(int r, int hi) { return (r & 3) + 8 * (r >> 2) + 4 * hi; }

template <int KB>
__device__ __forceinline__ void qkt(f32x16& p0, f32x16& p1, const LAS char* K_lds, int r32, int hi, const bf16x8* qr) {
    p0 = f32x16{}; p1 = f32x16{};
    const LAS char* kb[4];
#pragma unroll
    for (int dd = 0; dd < 4; ++dd) kb[dd] = K_lds + KB * SHM_K + r32 * KPITCH + (((2 * dd + hi) ^ ((r32 >> 1) & 7)) << 4);
    bf16x8 f[2][4];
#define QK_LD(g, buf) do { _Pragma("unroll") for (int e_ = 0; e_ < 2; ++e_) { const int d0_ = 2 * (g) + e_; const LAS char* a_ = kb[d0_ & 3] + (d0_ >> 2) * 128; \
        f[buf][2 * e_] = *(const LAS bf16x8*)a_; f[buf][2 * e_ + 1] = *(const LAS bf16x8*)(a_ + 32 * KPITCH); } } while (0)
    QK_LD(0, 0);
#pragma unroll
    for (int g = 0; g < 6; ++g) {
        if (g < 5) QK_LD(g + 1, (g + 1) & 1);
        SBAR();
#pragma unroll
        for (int e = 0; e < 2; ++e) { const int d0 = 2 * g + e;
            p0 = __builtin_amdgcn_mfma_f32_32x32x16_bf16(f[g & 1][2 * e], qr[d0], p0, 0, 0, 0);
            p1 = __builtin_amdgcn_mfma_f32_32x32x16_bf16(f[g & 1][2 * e + 1], qr[d0], p1, 0, 0, 0); }
        SBAR(); }
#undef QK_LD
}
__device__ __forceinline__ void pv_tile(f32x16* o, int vb0  , bf16x8 pa0, bf16x8 pa1, bf16x8 pa2, bf16x8 pa3) {
#define TRRD(dst, off) asm volatile("ds_read_b64_tr_b16 %0, %1 offset:%2" : "=&v"(dst) : "v"(vb0), "i"(off) : "memory")
    s16x4 vl[2][4], vh[2][4];
#define PV_LD(d0, bf) do { constexpr int b_ = v_rd_off(d0, 0, 0); TRRD(vl[bf][0], b_); TRRD(vh[bf][0], b_ + 2048); TRRD(vl[bf][1], b_ + 4096); TRRD(vh[bf][1], b_ + 6144); \
        TRRD(vl[bf][2], b_ + 8192); TRRD(vh[bf][2], b_ + 10240); TRRD(vl[bf][3], b_ + 12288); TRRD(vh[bf][3], b_ + 14336); } while (0)
#define PV_FR(bf, k) (bf16x8){vl[bf][k][0], vl[bf][k][1], vl[bf][k][2], vl[bf][k][3], vh[bf][k][0], vh[bf][k][1], vh[bf][k][2], vh[bf][k][3]}
#define PV_MM(d0, bf) do { o[d0] = __builtin_amdgcn_mfma_f32_32x32x16_bf16(pa0, PV_FR(bf, 0), o[d0], 0, 0, 0); o[d0] = __builtin_amdgcn_mfma_f32_32x32x16_bf16(pa1, PV_FR(bf, 1), o[d0], 0, 0, 0); \
        o[d0] = __builtin_amdgcn_mfma_f32_32x32x16_bf16(pa2, PV_FR(bf, 2), o[d0], 0, 0, 0); o[d0] = __builtin_amdgcn_mfma_f32_32x32x16_bf16(pa3, PV_FR(bf, 3), o[d0], 0, 0, 0); } while (0)
    PV_LD(0, 0);
    PV_LD(1, 1); asm volatile("s_waitcnt lgkmcnt(8)" ::: "memory"); SBAR(); PV_MM(0, 0); SBAR();
    PV_LD(2, 0); asm volatile("s_waitcnt lgkmcnt(8)" ::: "memory"); SBAR(); PV_MM(1, 1); SBAR();
    PV_LD(3, 1); asm volatile("s_waitcnt lgkmcnt(8)" ::: "memory"); SBAR(); PV_MM(2, 0); SBAR();
    asm volatile("s_waitcnt lgkmcnt(0)" ::: "memory"); SBAR(); PV_MM(3, 1);
#undef PV_LD
#undef PV_FR
#undef PV_MM
#undef TRRD
}
__device__ __forceinline__ void mask_tile(f32x16& p0, f32x16& p1, int dq  ) {
    const float NEG = -__builtin_inff();
#pragma unroll
    for (int r = 0; r < 16; ++r) { const int c = (r & 3) + 8 * (r >> 2);
        if (c > dq) p0[r] = NEG;
        if (c + 32 > dq) p1[r] = NEG; }
}
__device__ __forceinline__ void softmax_tile(f32x16& p0, f32x16& p1, float& m_reg, float& l_reg, float& alpha, bf16x8& pa0, bf16x8& pa1, bf16x8& pa2, bf16x8& pa3) {
    float pmax = p0[0];
#pragma unroll
    for (int r = 1; r < 16; ++r) pmax = fmaxf(pmax, p0[r]);
#pragma unroll
    for (int r = 0; r < 16; ++r) pmax = fmaxf(pmax, p1[r]);
    { auto rr = __builtin_amdgcn_permlane32_swap(__float_as_uint(pmax), __float_as_uint(pmax), false, false); pmax = fmaxf(__uint_as_float(rr[0]), __uint_as_float(rr[1])); }
    float mn = m_reg; alpha = 1.f;
    if (!__all(pmax - m_reg <= 8.0f)) { mn = fmaxf(m_reg, pmax); alpha = __builtin_amdgcn_exp2f(m_reg - mn); m_reg = mn; }
    float ps = 0.f;
#pragma unroll
    for (int r = 0; r < 16; ++r) { p0[r] = __builtin_amdgcn_exp2f(p0[r] - mn); ps += p0[r]; }
#pragma unroll
    for (int r = 0; r < 16; ++r) { p1[r] = __builtin_amdgcn_exp2f(p1[r] - mn); ps += p1[r]; }
    { auto rr = __builtin_amdgcn_permlane32_swap(__float_as_uint(ps), __float_as_uint(ps), false, false); ps = __uint_as_float(rr[0]) + __uint_as_float(rr[1]); }
    l_reg = l_reg * alpha + ps;
#define PK4(P, B_, OUT) do { unsigned a0 = cvt_pk_bf16(P[B_+0], P[B_+1]), a1 = cvt_pk_bf16(P[B_+2], P[B_+3]); \
        unsigned b0 = cvt_pk_bf16(P[B_+4], P[B_+5]), b1 = cvt_pk_bf16(P[B_+6], P[B_+7]); \
        auto r0 = __builtin_amdgcn_permlane32_swap(a0, b0, false, false); auto r1 = __builtin_amdgcn_permlane32_swap(a1, b1, false, false); \
        u32x4 w = {r0[0], r1[0], r0[1], r1[1]}; OUT = __builtin_bit_cast(bf16x8, w); } while (0)
    PK4(p0, 0, pa0); PK4(p0, 8, pa1); PK4(p1, 0, pa2); PK4(p1, 8, pa3);
#undef PK4
}

__device__ __forceinline__ void attn_block(int b, int h, int qb, const bf16_t* Q, const bf16_t* KN, const bf16_t* KR, const bf16_t* V, bf16_t* O, LAS char* lds, unsigned long long* pw = nullptr) {
    const int tid = opaque_tid(), wid = __builtin_amdgcn_readfirstlane(tid >> 6), lane = tid & 63, r32 = lane & 31, hi = lane >> 5;
    const size_t row0 = (size_t)b * SEQ;
    const int q0 = qb * QB + wid * QBLK;
    const int NT = (qb + 1) * (QB / KVBLK);
    LAS char* V_lds = lds + OFF_V; LAS char* K_lds = lds + OFF_K;
    LAS float* ws = (LAS float*)(lds + OFF_WS) + wid * 64; LAS float* li_l = ws; LAS float* al_l = ws + 32;
    const int vb0 = (int)(uintptr_t)lds + v_rd_base(lane);
    const char* gb = (const char*)KR;
    const unsigned dKN = (unsigned)((const char*)KN - gb), dV = (unsigned)((const char*)V - gb);
    unsigned ko[3], ks[3], vo2[2];
#pragma unroll
    for (int i = 0; i < 3; ++i) { const int slot = (wid + 8 * i) * 64 + lane, row = slot / 24, chunk = (slot - row * 24) ^ ((row >> 1) & 7);
        const bool nope = chunk < 16;
        ko[i] = nope ? dKN + (unsigned)(((int)(row0 + row) * 1024 + h * 128 + chunk * 8) * 2) : (unsigned)(((int)(row0 + row) * 64 + (chunk - 16) * 8) * 2);
        ks[i] = nope ? (unsigned)(KVBLK * 2048) : (unsigned)(KVBLK * 128); }
#pragma unroll
    for (int i = 0; i < 2; ++i) { const int slot = (wid + 8 * i) * 64 + lane, sub = slot >> 5, q = slot & 31, kk = (sub >> 2) * 8 + (q >> 2), c = (sub & 3) * 32 + (q & 3) * 8;
        const int k = (kk & ~0xC) | ((kk & 4) << 1) | ((kk & 8) >> 1);
        vo2[i] = dV + (unsigned)(((int)(row0 + k) * 1024 + h * 128 + c) * 2); }
#define SDMA(bf, vo) do { _Pragma("unroll") for (int i_ = 0; i_ < 3; ++i_) { __builtin_amdgcn_global_load_lds((const unsigned*)(gb + (size_t)ko[i_]), (LAS unsigned*)(K_lds + (bf) * SHM_K + (wid + 8 * i_) * 1024), 16, 0, 0); ko[i_] += ks[i_]; } \
        _Pragma("unroll") for (int i_ = 0; i_ < 2; ++i_) { __builtin_amdgcn_global_load_lds((const unsigned*)(gb + (size_t)vo2[i_]), (LAS unsigned*)(V_lds + (vo) + (wid + 8 * i_) * 1024), 16, 0, 0); vo2[i_] += (unsigned)(KVBLK * 2048); } } while (0)
    SDMA(0, 0);
    bf16x8 qr[12];
    { const bf16_t* Qw = Q + (row0 + q0 + r32) * 1536 + h * 192 + hi * 8;
#pragma unroll
      for (int d0 = 0; d0 < 12; ++d0) qr[d0] = *(const bf16x8*)(Qw + d0 * 16); }
    float m_reg = -1e30f, l_reg = 0.f; f32x16 o[4] = {};
    f32x16 p0, p1; bf16x8 pa0, pa1, pa2, pa3; float alpha;
    asm volatile("s_waitcnt vmcnt(0)" ::: "memory");
    __syncthreads();
    const bool odd = wid >= 4; int vo_prev = 0, vo_cur = 0, vo_next = SHM_V;
#define RESC(a) do { if (__any((a) < 1.f)) { if (hi == 0) al_l[r32] = (a); asm volatile("s_waitcnt lgkmcnt(0)" ::: "memory"); \
        _Pragma("unroll") for (int d_ = 0; d_ < 4; ++d_) _Pragma("unroll") for (int r = 0; r < 16; ++r) o[d_][r] *= al_l[crow(r, hi)]; } } while (0)
#if PROBE_T
    unsigned long long pa_ = 0, pb_ = 0, pc_ = 0, pd_ = 0, pe2_ = 0; const unsigned long long pst_ = __builtin_amdgcn_s_memtime();
#define PSTAMP(v) const unsigned long long v = __builtin_amdgcn_s_memtime()
#define PACC(acc, a, b) acc += (b) - (a)
#else
#define PSTAMP(v) do {} while (0)
#define PACC(acc, a, b) do {} while (0)
#endif
#define TILE(t, BF) do { PSTAMP(s0_); const bool more_ = ((t) + 1 < NT); if (more_) SDMA((BF) ^ 1, vo_next); SBAR(); \
        if (odd && (t) > 0) { pv_tile(o, vb0 + vo_prev, pa0, pa1, pa2, pa3); SBAR(); } \
        PSTAMP(s1_); qkt<BF>(p0, p1, K_lds, r32, hi, qr); \
        { const int kb_ = (t) * KVBLK; if (kb_ + KVBLK - 1 > q0) mask_tile(p0, p1, q0 + r32 - kb_ - 4 * hi); } \
        asm volatile("" : "+v"(p0), "+v"(p1)); PSTAMP(s2_); \
        softmax_tile(p0, p1, m_reg, l_reg, alpha, pa0, pa1, pa2, pa3); RESC(alpha); SBAR(); PSTAMP(s3_); \
        if (!odd) pv_tile(o, vb0 + vo_cur, pa0, pa1, pa2, pa3); \
        PSTAMP(s4_); asm volatile("s_waitcnt vmcnt(0)" ::: "memory"); \
        PSTAMP(s5_); __syncthreads(); PSTAMP(s6_); PACC(pa_, s1_, s2_); PACC(pb_, s2_, s3_); PACC(pc_, s3_, s4_); PACC(pd_, s4_, s5_); PACC(pe2_, s5_, s6_); vo_prev = vo_cur; vo_cur = vo_next; vo_next = (vo_next == (NVB - 1) * SHM_V) ? 0 : vo_next + SHM_V; } while (0)
#pragma unroll 1
    for (int t = 0; t < NT; t += 2) { TILE(t, 0); TILE(t + 1, 1); }
    if (odd) pv_tile(o, vb0 + vo_prev, pa0, pa1, pa2, pa3);
#if PROBE_T
    if (pw && blockIdx.x == 0 && tid == 0) { pw[8] += pa_; pw[9] += pb_; pw[10] += pc_; pw[11] += pd_; pw[12] += pe2_; pw[13] += (unsigned long long)NT; pw[14] += __builtin_amdgcn_s_memtime() - pst_; }
#endif
    if (hi == 0) li_l[r32] = l_reg; asm volatile("s_waitcnt lgkmcnt(0)" ::: "memory");
    __syncthreads();
    { LAS bf16_t* stg = (LAS bf16_t*)(lds + wid * 8704);
#pragma unroll
      for (int r = 0; r < 16; ++r) { const int orow = crow(r, hi); const float rl = __builtin_amdgcn_rcpf(li_l[orow]);
#pragma unroll
          for (int d0 = 0; d0 < 4; ++d0) { const float v = o[d0][r] * rl; stg[orow * 136 + d0 * 32 + r32] = (bf16_t)(cvt_pk_bf16(v, v) & 0xffffu); } }
      asm volatile("s_waitcnt lgkmcnt(0)" ::: "memory");
      bf16_t* Ow = O + (row0 + q0) * 1024 + h * 128 + (lane & 15) * 8;
#pragma unroll
      for (int it = 0; it < 8; ++it) { const int row = it * 4 + (lane >> 4); const u32x4 v = *(const LAS u32x4*)(stg + row * 136 + (lane & 15) * 8); *(u32x4*)(Ow + (size_t)row * 1024) = v; } }
    __syncthreads();
#undef SDMA
#undef RESC
#undef TILE
#undef PSTAMP
#undef PACC
}
#undef SBAR
}

#define XB_TMO      128
#define XB_XCNT(j)  (256  + 64 * (j))
#define XB_XSUB(j)  (1280 + 64 * (j))
#define XB_XGEN(j)  (2304 + 64 * (j))
#define XB_TOP      3328
#define XB_TOPGEN   3392
#define XCD_BAR_WORDS 3456
#define XB_SPIN_CAP (1u << 22)
__device__ __forceinline__ unsigned xb_ld(unsigned* p)              { return __hip_atomic_load(p, __ATOMIC_RELAXED, __HIP_MEMORY_SCOPE_AGENT); }
__device__ __forceinline__ unsigned xb_add(unsigned* p, unsigned v) { return __hip_atomic_fetch_add(p, v, __ATOMIC_RELAXED, __HIP_MEMORY_SCOPE_AGENT); }
__device__ __forceinline__ unsigned xb_xcc_id() { return (unsigned)__builtin_amdgcn_s_getreg((3 << 11) | 20) & 0xFu; }
#define XB_SPIN(cond, bar) do { unsigned _sp = 0; while (cond) { __builtin_amdgcn_s_sleep(1); \
    if ((++_sp & 255u) == 0u) { if (xb_ld(&(bar)[XB_TMO])) break; if (_sp > XB_SPIN_CAP) { atomicAdd(&(bar)[XB_TMO], 1u); break; } } } } while (0)
struct XcdBarrier { unsigned* bar; unsigned x; volatile LAS unsigned* st; };
__device__ __forceinline__ XcdBarrier xcd_barrier_post(unsigned* bar, volatile LAS unsigned* st) {
    XcdBarrier b; b.bar = bar; b.x = xb_xcc_id(); b.st = st;
    if (threadIdx.x == 0) (void)xb_add(&bar[XB_XCNT(b.x)], 1u);
    return b;
}
__device__ __forceinline__ void xcd_barrier_complete(unsigned* bar, unsigned x, unsigned& nloc, unsigned& nx) {
    const unsigned G = gridDim.x * gridDim.y * gridDim.z;
    unsigned sum, cnt, mine, sp = 0u;
    for (;;) {
        sum = 0u; cnt = 0u; mine = 0u;
#pragma unroll
        for (unsigned j = 0; j < 16; ++j) { const unsigned c = xb_ld(&bar[XB_XCNT(j)]); sum += c; cnt += (c > 0u) ? 1u : 0u; mine = (j == x) ? c : mine; }
        if (sum == G) break;
        __builtin_amdgcn_s_sleep(1);
        if ((++sp & 255u) == 0u) { if (xb_ld(&bar[XB_TMO])) break; if (sp > XB_SPIN_CAP) { atomicAdd(&bar[XB_TMO], 1u); break; } }
    }
    nloc = mine > 0u ? mine : 1u; nx = cnt > 0u ? cnt : 1u;
}
__device__ __forceinline__ void xcd_barrier(const XcdBarrier& b) {
    asm volatile("s_waitcnt vmcnt(0)" ::: "memory");
    __syncthreads();
    if (opaque_tid() == 0) {
        unsigned* bar = b.bar; unsigned bx = b.x;
        asm volatile("" : "+s"(bar), "+s"(bx));
        __builtin_amdgcn_s_waitcnt(0);
        unsigned nloc = b.st[0], nx = b.st[1];
        if (nloc == 0u) { xcd_barrier_complete(bar, bx, nloc, nx); b.st[0] = nloc; b.st[1] = nx; }
        const unsigned old = xb_add(&bar[XB_XSUB(bx)], 1u);
        const unsigned gen = old / nloc;
        if (old + 1u == (gen + 1u) * nloc) {
            __builtin_amdgcn_fence(__ATOMIC_RELEASE, "agent");
            asm volatile("s_waitcnt vmcnt(0)" ::: "memory");
            const unsigned og = xb_add(&bar[XB_TOP], 1u);
            const unsigned tg = og / nx;
            if (og + 1u == (tg + 1u) * nx) xb_add(&bar[XB_TOPGEN], 1u);
            else XB_SPIN(xb_ld(&bar[XB_TOPGEN]) == tg, bar);
            __builtin_amdgcn_fence(__ATOMIC_ACQUIRE, "agent");
            xb_add(&bar[XB_XGEN(bx)], 1u);
            asm volatile("s_waitcnt vmcnt(0)" ::: "memory");
        } else {
            XB_SPIN(xb_ld(&bar[XB_XGEN(bx)]) == gen, bar);
            __builtin_amdgcn_fence(__ATOMIC_ACQUIRE, "agent");
            asm volatile("s_waitcnt vmcnt(0)" ::: "memory");
        }
    }
    __syncthreads();
}

struct Args { const void* in[30]; float* out; unsigned char* ws; int ph_lo, ph_hi, li, pad; };
struct Ctx { int tid, lane, wave, vcu, G, bid; LAS unsigned char* lds; volatile LAS int* misc; };
__device__ __forceinline__ Ctx fresh_ctx(const Ctx& c) {
    Ctx r = c; unsigned l = (unsigned)(uintptr_t)c.lds, m = (unsigned)(uintptr_t)c.misc;
    asm volatile("" : "+s"(r.wave), "+s"(r.vcu), "+s"(r.G), "+s"(r.bid), "+s"(l), "+s"(m));
    r.lds = (LAS unsigned char*)(uintptr_t)l; r.misc = (volatile LAS int*)(uintptr_t)m; r.tid = opaque_tid(); r.lane = r.tid & 63; return r; }
typedef const CAS Args* ArgsP;
__device__ __forceinline__ const CAS Args& fresh_args(ArgsP p) { asm volatile("" : "+s"(p)); return *p; }
enum { I_X = 0, I_P, I_POS, I_MLA_WIN, I_MLA_QN, I_MLA_KVN, I_MLA_WUQ, I_MLA_WUKV, I_MLA_WO, I_LRU_WIN, I_LRU_CW, I_LRU_CB, I_LRU_WA, I_LRU_BA, I_LRU_WX, I_LRU_BX, I_LRU_LAM, I_LRU_WOUT,
       I_LN1G, I_LN1B, I_LN2G, I_LN2B, I_MOE_WR, I_MOE_BR, I_MOE_WUP, I_MOE_BUP, I_MOE_WDN, I_MOE_BDN, I_PLE_WG, I_PLE_WP };
#define INF(i) ((const float*)args.in[i])
#define WSP(T_, off) ((T_*)(args.ws + (off)))

__device__ __forceinline__ void tr_load(const float* W, int ld, int k0, int sc0, int sc1, int lane, f32x4 (&v)[16]) {
    const int half = (lane & 15) >> 3, scol = half ? sc1 : sc0, c4 = (lane & 7) * 4, rs = lane >> 4;
#pragma unroll
    for (int i = 0; i < 8; ++i) { const float* p = W + (size_t)(k0 + 8 * i + 2 * rs) * ld + scol + c4;
        v[2 * i] = (scol >= 0) ? *(const f32x4*)p : (f32x4){0.f, 0.f, 0.f, 0.f}; v[2 * i + 1] = (scol >= 0) ? *(const f32x4*)(p + ld) : (f32x4){0.f, 0.f, 0.f, 0.f}; }
}
__device__ __forceinline__ void tr_store(f32x4 (&v)[16], const float* ksc, int k0, bf16_t* dst  , int K, LAS unsigned* scr, int lane) {
    const int rs = lane >> 4;
    if (ksc) {
#pragma unroll
        for (int i = 0; i < 8; ++i) { v[2 * i] = v[2 * i] * ksc[k0 + 8 * i + 2 * rs]; v[2 * i + 1] = v[2 * i + 1] * ksc[k0 + 8 * i + 2 * rs + 1]; } }
#pragma unroll
    for (int i = 0; i < 8; ++i) { LAS unsigned* s = scr + (4 * i + rs) * 65 + (lane & 15) * 4;
#pragma unroll
        for (int e = 0; e < 4; ++e) s[e] = cvt_pk_bf16(v[2 * i][e], v[2 * i + 1][e]); }
    asm volatile("s_waitcnt lgkmcnt(0)" ::: "memory");
    const int c = lane & 7;
#pragma unroll
    for (int j = 0; j < 8; ++j) { const int n = (lane >> 3) + 8 * j; const LAS unsigned* s = scr + (4 * c) * 65 + n;
        u32x4 o; o.x = s[0]; o.y = s[65]; o.z = s[130]; o.w = s[195];
        *(u32x4*)(dst + (size_t)n * K + 8 * c) = o; }
    asm volatile("s_waitcnt lgkmcnt(0)" ::: "memory");
}
enum { J_NAT = 0, J_MLA_WIN, J_MLA_WUQ, J_LRU_WAX, J_MOE_UP };
__device__ __forceinline__ int tr_map(int job, int g) {
    switch (job) {
    case J_MLA_WIN: return g < 32 ? 32 * g : (g == 32 ? 1024 : (g == 36 ? 1056 : -1));
    case J_MLA_WUQ: if (g < 32) { const int t = g >> 3, bj = (g >> 2) & 1, cg = g & 3; return (2 * t + bj) * 192 + 32 * cg; }
                    else { const int g2 = g - 32, t2 = g2 >> 3, bj = (g2 >> 2) & 1, hh = g2 & 3; return (4 * t2 + hh) * 192 + 128 + 32 * bj; }
    case J_LRU_WAX: { const int pn = g >> 3, cg = g & 3; return 128 * pn + 32 * cg; }
    case J_MOE_UP:  { const int pn = g >> 3, bj = (g >> 2) & 1, cg = g & 3; return bj * 1024 + 128 * pn + 32 * cg; }
    default: return 32 * g;
    }
}
__device__ __forceinline__ void tr_job(const Ctx& C, int job, const float* src, size_t srcstride, int nmat, int K, int ld, int N, bf16_t* dst, size_t dststride, const float* ksc, int kscstride,
                                       const float* src2  ) {
    LAS unsigned* scr = (LAS unsigned*)(C.lds + C.wave * 8320);
    const int gw = C.vcu * NWAVES + C.wave, NGW = C.G * NWAVES;
    const int nkb = K / 64, nnb = N / 64, per = nkb * nnb, total = per * nmat;
#define TR_DECODE(it_, W_, k0_, s0_, s1_, ks_, d_) do { const int mat_ = (it_) / per, r_ = (it_) - mat_ * per, kb_ = r_ / nnb, nb_ = r_ - kb_ * nnb; \
        s0_ = tr_map(job, 2 * nb_); s1_ = tr_map(job, 2 * nb_ + 1); W_ = src + (size_t)mat_ * srcstride; \
        if (job == J_LRU_WAX && ((nb_ >> 1) & 1)) W_ = src2 + (size_t)mat_ * srcstride;       \
        k0_ = kb_ * 64; ks_ = ksc ? ksc + (size_t)mat_ * kscstride : nullptr; d_ = (bf16_t*)((char*)dst + (size_t)mat_ * dststride) + (size_t)(nb_ * 64) * K + kb_ * 64; } while (0)
    f32x4 va[16], vb[16];
    int it = gw; const float* Wc; int k0c, s0c, s1c; const float* ksc_c; bf16_t* dc;
    if (it < total) { TR_DECODE(it, Wc, k0c, s0c, s1c, ksc_c, dc); tr_load(Wc, ld, k0c, s0c, s1c, C.lane, va); }
    while (it < total) {
        const int nit = it + NGW; const float* Wn = nullptr; int k0n = 0, s0n = 0, s1n = 0; const float* ksc_n = nullptr; bf16_t* dn = nullptr;
        if (nit < total) { TR_DECODE(nit, Wn, k0n, s0n, s1n, ksc_n, dn); tr_load(Wn, ld, k0n, s0n, s1n, C.lane, vb); }
        tr_store(va, ksc_c, k0c, dc, K, scr, C.lane);
#pragma unroll
        for (int i = 0; i < 16; ++i) va[i] = vb[i];
        it = nit; k0c = k0n; ksc_c = ksc_n; dc = dn;
    }
#undef TR_DECODE
}
template <int JOB, int N, bool G64  >
__device__ __forceinline__ void tr_job_fp8(const Ctx& C, const float* src, size_t srcstride, int nmat, unsigned char* dst, size_t dststride, unsigned char* SW) {
    constexpr int K = 1024, ld = N;
    LAS float* scr = (LAS float*)(C.lds + C.wave * 16640);
    const int gw = C.vcu * NWAVES + C.wave, NGW = C.G * NWAVES, lane = C.lane;
    const int nkb = K / 64, nnb = N / 64, per = nkb * nnb, total = per * nmat;
    f32x4 v[16], vn[16];
    if (gw < total) { const int mat = gw / per, r = gw - mat * per, kb = r / nnb, nb = r - kb * nnb; tr_load(src + (size_t)mat * srcstride, ld, kb * 64, tr_map(JOB, 2 * nb), tr_map(JOB, 2 * nb + 1), lane, v); }
    for (int it = gw; it < total; it += NGW) {
        const int mat = it / per, r = it - mat * per, kb = r / nnb, nb = r - kb * nnb;
        { const int nit = it + NGW; if (nit < total) { const int matn = nit / per, rn = nit - matn * per, kbn = rn / nnb, nbn = rn - kbn * nnb; tr_load(src + (size_t)matn * srcstride, ld, kbn * 64, tr_map(JOB, 2 * nbn), tr_map(JOB, 2 * nbn + 1), lane, vn); } }
        const int rs = lane >> 4;
#pragma unroll
        for (int i = 0; i < 8; ++i) { LAS float* sp = scr + (8 * i + 2 * rs) * 65 + (lane & 15) * 4;
#pragma unroll
            for (int e = 0; e < 4; ++e) { sp[e] = v[2 * i][e]; sp[65 + e] = v[2 * i + 1][e]; } }
        asm volatile("s_waitcnt lgkmcnt(0)" ::: "memory");
        const int c = lane & 7;
#pragma unroll
        for (int j = 0; j < 8; ++j) { const int n = (lane >> 3) + 8 * j; const LAS float* sp = scr + (8 * c) * 65 + n;
            float x[8]; float am = 0.f;
#pragma unroll
            for (int q = 0; q < 8; ++q) { x[q] = sp[q * 65]; am = fmaxf(am, fabsf(x[q])); }
            am = fmaxf(am, __shfl_xor(am, 1)); am = fmaxf(am, __shfl_xor(am, 2));
            if (G64) am = fmaxf(am, __shfl_xor(am, 4));
            int eb = (int)((__float_as_uint(am) >> 23) & 0xffu) - 7; eb = eb < 1 ? 1 : eb;
            const float inv = __uint_as_float((unsigned)(254 - eb) << 23);
            int w0 = __builtin_amdgcn_cvt_pk_fp8_f32(x[0] * inv, x[1] * inv, 0, false); w0 = __builtin_amdgcn_cvt_pk_fp8_f32(x[2] * inv, x[3] * inv, w0, true);
            int w1 = __builtin_amdgcn_cvt_pk_fp8_f32(x[4] * inv, x[5] * inv, 0, false); w1 = __builtin_amdgcn_cvt_pk_fp8_f32(x[6] * inv, x[7] * inv, w1, true);
            const int nrow = nb * 64 + n;
            *(u32x2*)(dst + (size_t)mat * dststride + (size_t)nrow * K + kb * 64 + 8 * c) = (u32x2){(unsigned)w0, (unsigned)w1};
            if (!G64) { if ((c & 3) == 0) SW[(size_t)mat * 65536 + (size_t)(nrow >> 8) * 8192 + (size_t)(kb >> 1) * 1024 + (nrow & 255) * 4 + 2 * (kb & 1) + (c >> 2)] = (unsigned char)eb; }
            else { if (c == 0) SW[(size_t)mat * 16384 + (size_t)(nrow >> 8) * 4096 + (size_t)(kb >> 1) * 512 + (nrow & 255) * 2 + (kb & 1)] = (unsigned char)eb; } }
        asm volatile("s_waitcnt lgkmcnt(0)" ::: "memory");
#pragma unroll
        for (int i = 0; i < 16; ++i) v[i] = vn[i];
    }
}
__device__ __forceinline__ void cvt_rows(const Ctx& C, const float* src, bf16_t* dst, size_t n8  ) {
    const size_t gt = (size_t)C.vcu * 512 + C.tid, NT = (size_t)C.G * 512;
    size_t i = gt;
    for (; i + 3 * NT < n8; i += 4 * NT) {
        f32x4 a[4], b[4];
#pragma unroll
        for (int q = 0; q < 4; ++q) { a[q] = *(const f32x4*)(src + (i + q * NT) * 8); b[q] = *(const f32x4*)(src + (i + q * NT) * 8 + 4); }
#pragma unroll
        for (int q = 0; q < 4; ++q) *(u32x4*)(dst + (i + q * NT) * 8) = pack8(a[q], b[q]); }
    for (; i < n8; i += NT) { const f32x4 a = *(const f32x4*)(src + i * 8), b = *(const f32x4*)(src + i * 8 + 4); *(u32x4*)(dst + i * 8) = pack8(a, b); }
}
__device__ __forceinline__ void phase_prologue(const CAS Args& args, const Ctx& C) {
    tr_job(C, J_MLA_WIN, INF(I_MLA_WIN), (size_t)DM * LATD, 2, DM, LATD, 1280, WSP(bf16_t, WS_W_MLA + OFF_MLA_WIN), W_MLA_STRIDE, nullptr, 0, nullptr);
    tr_job(C, J_MLA_WUQ, INF(I_MLA_WUQ), (size_t)QL * 1536, 2, QL, 1536, 1536, WSP(bf16_t, WS_W_MLA + OFF_MLA_WUQ), W_MLA_STRIDE, INF(I_MLA_QN), QL, nullptr);
    tr_job(C, J_NAT, INF(I_MLA_WUKV), (size_t)KVL * 2048, 2, KVL, 2048, 2048, WSP(bf16_t, WS_W_MLA + OFF_MLA_WUKV), W_MLA_STRIDE, INF(I_MLA_KVN), KVL, nullptr);
    tr_job(C, J_NAT, INF(I_MLA_WO), (size_t)DM * DM, 2, DM, DM, DM, WSP(bf16_t, WS_W_MLA + OFF_MLA_WO), W_MLA_STRIDE, nullptr, 0, nullptr);
    tr_job(C, J_NAT, INF(I_LRU_WIN), (size_t)DM * 2048, 2, DM, 2048, 2048, WSP(bf16_t, WS_W_LRU + OFF_LRU_WIN), W_LRU_STRIDE, nullptr, 0, nullptr);
    for (int j = 0; j < 2; ++j)
        tr_job(C, J_LRU_WAX, INF(I_LRU_WA) + (size_t)j * 4 * 65536, (size_t)256 * 256, 4, 256, 256, 512, WSP(bf16_t, WS_W_LRU + OFF_LRU_WAX + (size_t)j * W_LRU_STRIDE), (size_t)512 * 256 * 2, nullptr, 0, INF(I_LRU_WX) + (size_t)j * 4 * 65536);
    tr_job(C, J_NAT, INF(I_LRU_WOUT), (size_t)DM * DM, 2, DM, DM, DM, WSP(bf16_t, WS_W_LRU + OFF_LRU_WOUT), W_LRU_STRIDE, nullptr, 0, nullptr);
    tr_job(C, J_NAT, INF(I_PLE_WP), (size_t)PLED * DM, 4, PLED, DM, DM, WSP(bf16_t, WS_W_PLE + OFF_PLE_WP), W_PLE_STRIDE, nullptr, 0, nullptr);
    __syncthreads();
    tr_job_fp8<J_MOE_UP, 2048, false>(C, INF(I_MOE_WUP), (size_t)DM * 2048, DEPTH * NE, args.ws + WS_W_UP, (size_t)2048 * 1024, args.ws + WS_SW);
    tr_job_fp8<J_NAT, 1024, true>(C, INF(I_MOE_WDN), (size_t)DFF * DM, DEPTH * NE, args.ws + WS_W_DN, (size_t)1024 * 1024, args.ws + WS_SWD);
    tr_job_fp8<J_NAT, 1024, false>(C, INF(I_PLE_WG), (size_t)DM * DM, DEPTH, args.ws + WS_W_PLE + OFF_PLE_WG, W_PLE_STRIDE, args.ws + WS_SWG);
    __syncthreads();
    cvt_rows(C, INF(I_X), WSP(bf16_t, WS_XB), (size_t)T * DM / 8);
    cvt_rows(C, INF(I_P), WSP(bf16_t, WS_PB), (size_t)DEPTH * T * PLED / 8);
    { const int* pos = (const int*)args.in[I_POS]; float* CS = WSP(float, WS_CS); float* SN = WSP(float, WS_SN);
      const size_t gt = (size_t)C.vcu * 512 + C.tid, NT = (size_t)C.G * 512;
      { const double inv = exp(-9.210340371976184 * (double)(int)(gt & 31) / 32.0);
        for (size_t i = gt; i < (size_t)T * 32; i += NT) { const int tok = (int)(i >> 5);
            const double ang = (double)pos[tok] * inv, n = rint(ang * 0.15915494309189535); double r = fma(-n, 6.283185307179586, ang); r = fma(-n, 2.4492935982947064e-16, r);
            const float rf = (float)r; CS[i] = cosf(rf); SN[i] = sinf(rf); } }
      { const float* wr = INF(I_MOE_WR); const float* lg1 = INF(I_LN1G); bf16_t* WRH = WSP(bf16_t, WS_WRH); bf16_t* WRL = WSP(bf16_t, WS_WRL);
        for (size_t i = gt; i < (size_t)DEPTH * 64 * 64; i += NT) { const int l = (int)(i >> 12), st = (int)(i >> 6) & 63, ln = (int)i & 63; float w[8], lo[8];
#pragma unroll
            for (int j = 0; j < 8; ++j) { const int k = 16 * st + 8 * (ln >> 5) + j; w[j] = lg1[l * DM + k] * wr[((size_t)l * DM + k) * NE + (ln & 31)]; }
            u32x4 h; h.x = cvt_pk_bf16(w[0], w[1]); h.y = cvt_pk_bf16(w[2], w[3]); h.z = cvt_pk_bf16(w[4], w[5]); h.w = cvt_pk_bf16(w[6], w[7]);
            lo[0] = w[0] - bf_lo(h.x); lo[1] = w[1] - bf_hi(h.x); lo[2] = w[2] - bf_lo(h.y); lo[3] = w[3] - bf_hi(h.y); lo[4] = w[4] - bf_lo(h.z); lo[5] = w[5] - bf_hi(h.z); lo[6] = w[6] - bf_lo(h.w); lo[7] = w[7] - bf_hi(h.w);
            u32x4 q; q.x = cvt_pk_bf16(lo[0], lo[1]); q.y = cvt_pk_bf16(lo[2], lo[3]); q.z = cvt_pk_bf16(lo[4], lo[5]); q.w = cvt_pk_bf16(lo[6], lo[7]);
            *(u32x4*)(WRH + i * 8) = h; *(u32x4*)(WRL + i * 8) = q; }
        float* RC = WSP(float, WS_RC); const float* lb1 = INF(I_LN1B); const float* rb = INF(I_MOE_BR);
        for (int i = C.vcu * NWAVES + C.wave; i < DEPTH * NE; i += C.G * NWAVES) { const int l = i >> 5, e = i & 31; float c1 = 0.f, c2 = 0.f;
#pragma unroll
            for (int t = 0; t < DM / 64; ++t) { const int k = C.lane + 64 * t; const float w = wr[((size_t)l * DM + k) * NE + e]; c1 = fmaf(lg1[l * DM + k], w, c1); c2 = fmaf(lb1[l * DM + k], w, c2); }
            c1 = wave_sum(c1); c2 = wave_sum(c2);
            if (C.lane == 0) { RC[l * 64 + e] = c1; RC[l * 64 + 32 + e] = c2 + rb[l * NE + e]; } } }
      float* SPL = WSP(float, WS_SPL); const float* lam = INF(I_LRU_LAM);
      for (size_t i = gt; i < 2 * 1024; i += NT) { const double l = (double)lam[i]; SPL[i] = (float)(-8.0 * log1p(exp(-l))); } }
}

__device__ __forceinline__ void moe_table(const CAS Args& args, const Ctx& C0, int layer) {
    Ctx C = C0; C.tid = opaque_tid(); C.lane = C.tid & 63;
    const unsigned* cnt = WSP(unsigned, WS_CTL) + CW_CNT + 1024 * layer;
    __syncthreads();
    if (C.tid < 32) C.misc[64 + C.tid] = (int)__hip_atomic_load(cnt + CNT_STRIDE * C.tid, __ATOMIC_RELAXED, __HIP_MEMORY_SCOPE_AGENT);
    __syncthreads();
    if (C.tid == 0) { int acc = 0; for (int e = 0; e < 32; ++e) { C.misc[16 + e] = acc; acc += (C.misc[64 + e] + 255) >> 8; } C.misc[16 + 32] = acc; }
    __syncthreads();
    { volatile LAS unsigned char* te = (volatile LAS unsigned char*)(C.lds + TILE_E_OFF);
      for (int mg = C.tid; mg < C.misc[48]; mg += NWAVES * 64) { int e = 0; for (int j = 1; j < 32; ++j) e += (C.misc[16 + j] <= mg) ? 1 : 0; te[mg] = (unsigned char)e; } }
    __syncthreads();
}

__device__ __forceinline__ void phase_ln_router(const CAS Args& args, const Ctx& C0, int layer) {
    const int cslot = layer + args.pad;
    const int rskip = args.pad ? ROUTER_SKIP : 0;
    Ctx C = C0; C.tid = opaque_tid(); C.lane = C.tid & 63;
    const bf16_t* Y = WSP(bf16_t, WS_Y); float* STAT = WSP(float, WS_X1);
    const float* g1 = INF(I_LN1G) + layer * DM; const float* b1 = INF(I_LN1B) + layer * DM;
    const bf16_t* WRH = WSP(bf16_t, WS_WRH) + (size_t)layer * 64 * 64 * 8; const bf16_t* WRL = WSP(bf16_t, WS_WRL) + (size_t)layer * 64 * 64 * 8; const float* rc = WSP(float, WS_RC) + layer * 64;
    unsigned* gcnt = WSP(unsigned, WS_CTL) + CW_CNT + 1024 * cslot;
    int* lists = WSP(int, WS_LIST); int* slot = WSP(int, WS_SLOT); float* gate = WSP(float, WS_GATE);
    LAS float* part = (LAS float*)C.lds;
    volatile LAS int* lcnt = (volatile LAS int*)(C.lds + 69632);
    volatile LAS int* lbase = lcnt + 32;
    LAS float* stat = (LAS float*)(C.lds + 70144);
    f32x4 gv[4], bv[4];
#pragma unroll
    for (int j = 0; j < 2; ++j) { gv[2 * j] = *(const f32x4*)(g1 + 8 * C.lane + 512 * j); gv[2 * j + 1] = *(const f32x4*)(g1 + 8 * C.lane + 512 * j + 4);
        bv[2 * j] = *(const f32x4*)(b1 + 8 * C.lane + 512 * j); bv[2 * j + 1] = *(const f32x4*)(b1 + 8 * C.lane + 512 * j + 4); }
    unsigned char* X1Q = args.ws + WS_X1Q; int sexp;
    { float ag = 0.f, ab = 0.f;
#pragma unroll
      for (int j = 0; j < 4; ++j)
#pragma unroll
          for (int e = 0; e < 4; ++e) { ag = fmaxf(ag, fabsf(gv[j][e])); ab = fmaxf(ab, fabsf(bv[j][e])); }
#pragma unroll
      for (int o = 1; o < 64; o <<= 1) { ag = fmaxf(ag, __shfl_xor(ag, o)); ab = fmaxf(ab, __shfl_xor(ab, o)); }
      const float bound = 16.0f * ag + ab + 1e-20f;
      sexp = 134 - (int)((__float_as_uint(bound) >> 23) & 0xffu);
      sexp = sexp < -100 ? -100 : (sexp > 100 ? 100 : sexp);
      if (C.tid == 0) __hip_atomic_store(WSP(unsigned, WS_CTL) + CW_SA + layer, (unsigned)sexp, __ATOMIC_RELAXED, __HIP_MEMORY_SCOPE_AGENT); }
    const float qs = __uint_as_float((unsigned)(127 + sexp) << 23), qlo = KF(-448.f), qhi = KF(448.f);
    for (int chunk = C.vcu; chunk < T / 128; chunk += C.G) {
        const int row0 = chunk * 128;
        if (C.tid < 32) lcnt[C.tid] = 0;
        const int grp2 = C.wave >> 1, kh2 = C.wave & 1, r32 = C.lane & 31, hi = C.lane >> 5;
        const bf16_t* ah = Y + ((size_t)row0 + grp2 * 32 + r32) * DM + kh2 * 512 + hi * 8;
        const bf16_t* bh = WRH + ((size_t)kh2 * 32 * 64 + C.lane) * 8; const bf16_t* bl = WRL + ((size_t)kh2 * 32 * 64 + C.lane) * 8;
        f32x16 acc = {};
        bf16x8 xq[4], whq[4], wlq[4];
#define RT_LD4(s0_) do { _Pragma("unroll") for (int q_ = 0; q_ < 4; ++q_) { xq[q_] = *(const bf16x8*)(ah + ((s0_) + q_) * 16); whq[q_] = *(const bf16x8*)(bh + (size_t)((s0_) + q_) * 512); wlq[q_] = *(const bf16x8*)(bl + (size_t)((s0_) + q_) * 512); } } while (0)
#define RT_MM4() do { _Pragma("unroll") for (int q_ = 0; q_ < 4; ++q_) { acc = __builtin_amdgcn_mfma_f32_32x32x16_bf16(xq[q_], whq[q_], acc, 0, 0, 0); acc = __builtin_amdgcn_mfma_f32_32x32x16_bf16(xq[q_], wlq[q_], acc, 0, 0, 0); } } while (0)
        u32x4 yn[4][2];
#pragma unroll
        for (int r = 0; r < 4; ++r)
#pragma unroll
            for (int j = 0; j < 2; ++j) yn[r][j] = *(const u32x4*)(Y + ((size_t)row0 + C.wave * 16 + r) * DM + 8 * C.lane + 512 * j);
#pragma unroll 1
        for (int g = 0; g < 4; ++g) {
            u32x4 yc[4][2];
#pragma unroll
            for (int r = 0; r < 4; ++r) { yc[r][0] = yn[r][0]; yc[r][1] = yn[r][1]; }
            { const int gn = g < 3 ? g + 1 : g;
#pragma unroll
              for (int r = 0; r < 4; ++r)
#pragma unroll
                  for (int j = 0; j < 2; ++j) yn[r][j] = *(const u32x4*)(Y + ((size_t)row0 + C.wave * 16 + gn * 4 + r) * DM + 8 * C.lane + 512 * j); }
            auto ln_row = [&](int r) { const int i = g * 4 + r; const size_t row = (size_t)row0 + C.wave * 16 + i;
                f32x4 v[4]; float s = 0.f;
#pragma unroll
                for (int j = 0; j < 2; ++j) { const u32x4 w = yc[r][j]; v[2 * j] = pg8::bf4_lo(w); v[2 * j + 1] = pg8::bf4_hi(w); }
#pragma unroll
                for (int j = 0; j < 4; ++j) s += (v[j][0] + v[j][1]) + (v[j][2] + v[j][3]);
                const float mean = wave_sum(s) * (1.f / DM); float s2 = 0.f;
#pragma unroll
                for (int j = 0; j < 4; ++j) { v[j] = v[j] - mean; s2 += (v[j][0] * v[j][0] + v[j][1] * v[j][1]) + (v[j][2] * v[j][2] + v[j][3] * v[j][3]); }
                const float rstd = 1.f / sqrtf(wave_sum(s2) * (1.f / DM) + KF(LN_EPS));
                if (C.lane == 0) { stat[(C.wave * 16 + i) * 2] = mean; stat[(C.wave * 16 + i) * 2 + 1] = rstd; *(f32x2*)(STAT + row * 2) = (f32x2){mean, rstd}; }
#pragma unroll
                for (int j = 0; j < 4; ++j) v[j] = v[j] * rstd * gv[j] + bv[j];
#pragma unroll
                for (int j = 0; j < 2; ++j) {
                    const f32x4 q0 = v[2 * j] * qs, q1 = v[2 * j + 1] * qs;
                    int w0 = __builtin_amdgcn_cvt_pk_fp8_f32(fminf(fmaxf(q0[0], qlo), qhi), fminf(fmaxf(q0[1], qlo), qhi), 0, false); w0 = __builtin_amdgcn_cvt_pk_fp8_f32(fminf(fmaxf(q0[2], qlo), qhi), fminf(fmaxf(q0[3], qlo), qhi), w0, true);
                    int w1 = __builtin_amdgcn_cvt_pk_fp8_f32(fminf(fmaxf(q1[0], qlo), qhi), fminf(fmaxf(q1[1], qlo), qhi), 0, false); w1 = __builtin_amdgcn_cvt_pk_fp8_f32(fminf(fmaxf(q1[2], qlo), qhi), fminf(fmaxf(q1[3], qlo), qhi), w1, true);
                    *(u32x2*)(X1Q + row * DM + 8 * C.lane + 512 * j) = (u32x2){(unsigned)w0, (unsigned)w1}; } };
            RT_LD4(8 * g);
            ln_row(0); ln_row(1);
            RT_MM4();
            RT_LD4(8 * g + 4);
            ln_row(2); ln_row(3);
            RT_MM4();
        }
#undef RT_LD4
#undef RT_MM4
        { LAS float* pp = part + (grp2 * 2 + kh2) * 32 * 33 + r32;
#pragma unroll
          for (int r = 0; r < 16; ++r) pp[((r & 3) + 8 * (r >> 2) + 4 * hi) * 33] = acc[r]; }
        asm volatile("s_waitcnt vmcnt(0)" ::: "memory");
        __syncthreads();
        int te[4] = {0, 0, 0, 0}, lp[4] = {0, 0, 0, 0}; float tg[4] = {0.f, 0.f, 0.f, 0.f};
        if (C.tid < 128 && !(rskip & 4)) { const int grp = C.tid >> 5, ln = C.tid & 31; float lg[32];
            const float mean = stat[C.tid * 2], rstd = stat[C.tid * 2 + 1];
#pragma unroll
            for (int e = 0; e < 32; ++e) lg[e] = rstd * ((part[((grp * 2 + 0) * 32 + ln) * 33 + e] + part[((grp * 2 + 1) * 32 + ln) * 33 + e]) - mean * rc[e]) + rc[32 + e];
            float tv[4]; const float kninf = KF(-__builtin_inff());
#pragma unroll
            for (int k = 0; k < 4; ++k) { float best = lg[0]; int bi = 0;
#pragma unroll
                for (int e = 1; e < 32; ++e) { const bool gt = lg[e] > best; best = gt ? lg[e] : best; bi = gt ? e : bi; }
                te[k] = bi; tv[k] = best;
#pragma unroll
                for (int e = 0; e < 32; ++e) lg[e] = (e == bi) ? kninf : lg[e]; }
            float den = 0.f;
#pragma unroll
            for (int k = 0; k < 4; ++k) { tg[k] = __expf(tv[k] - tv[0]); den += tg[k]; }
            const float rden = 1.0f / den;
#pragma unroll
            for (int k = 0; k < 4; ++k) { tg[k] *= rden; lp[k] = __hip_atomic_fetch_add((LAS int*)&lcnt[te[k]], 1, __ATOMIC_RELAXED, __HIP_MEMORY_SCOPE_WORKGROUP); } }
        __syncthreads();
        if (C.tid < 32 && !(rskip & 4)) lbase[C.tid] = (int)__hip_atomic_fetch_add(gcnt + CNT_STRIDE * C.tid, (unsigned)lcnt[C.tid], __ATOMIC_RELAXED, __HIP_MEMORY_SCOPE_AGENT);
        __syncthreads();
        if (C.tid < 128 && !(rskip & 4)) { const int tok = row0 + C.tid;
#pragma unroll
            for (int k = 0; k < 4; ++k) { const int pos = lbase[te[k]] + lp[k]; lists[(size_t)te[k] * T + pos] = tok; slot[tok * 4 + k] = te[k] * T + pos; gate[tok * 4 + k] = tg[k]; } }
        __syncthreads();
    }
}

__device__ __forceinline__ void phase_combine_ln2(const CAS Args& args, const Ctx& C0, int layer) {
    Ctx C = C0; C.tid = opaque_tid(); C.lane = C.tid & 63;
    moe_table(args, C, layer);
    const bf16_t* Y = WSP(bf16_t, WS_Y); const float* STAT = WSP(float, WS_X1); const unsigned char* YS = args.ws + WS_YS; const unsigned char* SY = args.ws + WS_SY; const int* slot = WSP(int, WS_SLOT); const float* gate = WSP(float, WS_GATE);
    bf16_t* X2B = WSP(bf16_t, WS_X2B); unsigned char* X2Q = args.ws + WS_X2Q;
    const float* g2 = INF(I_LN2G) + layer * DM; const float* b2 = INF(I_LN2B) + layer * DM; const float* g1 = INF(I_LN1G) + layer * DM; const float* b1 = INF(I_LN1B) + layer * DM;
    f32x4 gv[4], bv[4], g1v[4], b1v[4];
#pragma unroll
    for (int j = 0; j < 2; ++j) { g1v[2 * j] = *(const f32x4*)(g1 + 8 * C.lane + 512 * j); g1v[2 * j + 1] = *(const f32x4*)(g1 + 8 * C.lane + 512 * j + 4);
        b1v[2 * j] = *(const f32x4*)(b1 + 8 * C.lane + 512 * j); b1v[2 * j + 1] = *(const f32x4*)(b1 + 8 * C.lane + 512 * j + 4); }
#pragma unroll
    for (int j = 0; j < 2; ++j) { gv[2 * j] = *(const f32x4*)(g2 + 8 * C.lane + 512 * j); gv[2 * j + 1] = *(const f32x4*)(g2 + 8 * C.lane + 512 * j + 4);
        bv[2 * j] = *(const f32x4*)(b2 + 8 * C.lane + 512 * j); bv[2 * j + 1] = *(const f32x4*)(b2 + 8 * C.lane + 512 * j + 4); }
    int sexp;
    { float ag = 0.f, ab = 0.f;
#pragma unroll
      for (int j = 0; j < 4; ++j)
#pragma unroll
          for (int e = 0; e < 4; ++e) { ag = fmaxf(ag, fabsf(gv[j][e])); ab = fmaxf(ab, fabsf(bv[j][e])); }
#pragma unroll
      for (int o = 1; o < 64; o <<= 1) { ag = fmaxf(ag, __shfl_xor(ag, o)); ab = fmaxf(ab, __shfl_xor(ab, o)); }
      const float bound = 16.0f * ag + ab + 1e-20f;
      sexp = 134 - (int)((__float_as_uint(bound) >> 23) & 0xffu); sexp = sexp < -100 ? -100 : (sexp > 100 ? 100 : sexp);
      if (C.tid == 0) __hip_atomic_store(WSP(unsigned, WS_CTL) + CW_SA2 + layer, (unsigned)sexp, __ATOMIC_RELAXED, __HIP_MEMORY_SCOPE_AGENT); }
    const float qs = __uint_as_float((unsigned)(127 + sexp) << 23), qlo = KF(-448.f), qhi = KF(448.f);
    const int gw = C.vcu * NWAVES + C.wave, NGW = C.G * NWAVES;
    int svn[2][4]; float gtn[2][4];
#pragma unroll
    for (int q = 0; q < 2; ++q) { const int r = (gw + q * NGW < T) ? gw + q * NGW : gw;
#pragma unroll
        for (int k = 0; k < 4; ++k) { svn[q][k] = slot[r * 4 + k]; gtn[q][k] = gate[r * 4 + k]; } }
#pragma unroll 1
    for (int row = gw; row < T; row += 2 * NGW) {
        int sv[2][4]; float gt[2][4];
#pragma unroll
        for (int q = 0; q < 2; ++q)
#pragma unroll
            for (int k = 0; k < 4; ++k) { sv[q][k] = svn[q][k]; gt[q][k] = gtn[q][k]; }
        { const int nrow = (row + 2 * NGW < T) ? row + 2 * NGW : row;
#pragma unroll
          for (int q = 0; q < 2; ++q) { const int r = (nrow + q * NGW < T) ? nrow + q * NGW : nrow;
#pragma unroll
              for (int k = 0; k < 4; ++k) { svn[q][k] = slot[r * 4 + k]; gtn[q][k] = gate[r * 4 + k]; } } }
        u32x4 xw[2][2]; u32x2 yw[2][4][2]; unsigned eb[2][4][2]; f32x2 st[2];
#pragma unroll
        for (int q = 0; q < 2; ++q) { const int r = (row + q * NGW < T) ? row + q * NGW : row;
#pragma unroll
            for (int j = 0; j < 2; ++j) xw[q][j] = *(const u32x4*)(Y + (size_t)r * DM + 8 * C.lane + 512 * j);
            st[q] = *(const f32x2*)(STAT + (size_t)r * 2);
#pragma unroll
            for (int k = 0; k < 4; ++k) { const int e = sv[q][k] >> 15, pos = sv[q][k] & (T - 1); const size_t prow = (size_t)C.misc[16 + e] * 256 + pos;
#pragma unroll
                for (int j = 0; j < 2; ++j) { yw[q][k][j] = *(const u32x2*)(YS + prow * DM + 8 * C.lane + 512 * j); eb[q][k][j] = SY[prow * 32 + (C.lane >> 2) + 16 * j]; } } }
#pragma unroll
        for (int q = 0; q < 2; ++q) { const int r = row + q * NGW; if (r >= T) break;
            f32x4 v[4];
#pragma unroll
            for (int j = 0; j < 2; ++j) { v[2 * j] = ((pg8::bf4_lo(xw[q][j]) - st[q][0]) * st[q][1] * g1v[2 * j] + b1v[2 * j]) * ALPHA; v[2 * j + 1] = ((pg8::bf4_hi(xw[q][j]) - st[q][0]) * st[q][1] * g1v[2 * j + 1] + b1v[2 * j + 1]) * ALPHA; }
#pragma unroll
            for (int k = 0; k < 4; ++k)
#pragma unroll
                for (int j = 0; j < 2; ++j) { const u32x2 w = yw[q][k][j]; const float gs = gt[q][k] * __uint_as_float(eb[q][k][j] << 23);
                    const f32x2 a = __builtin_amdgcn_cvt_pk_f32_fp8((int)w.x, false), b = __builtin_amdgcn_cvt_pk_f32_fp8((int)w.x, true), c = __builtin_amdgcn_cvt_pk_f32_fp8((int)w.y, false), d = __builtin_amdgcn_cvt_pk_f32_fp8((int)w.y, true);
                    v[2 * j] += (f32x4){a[0], a[1], b[0], b[1]} * gs; v[2 * j + 1] += (f32x4){c[0], c[1], d[0], d[1]} * gs; }
            float s = 0.f;
#pragma unroll
            for (int j = 0; j < 4; ++j) s += (v[j][0] + v[j][1]) + (v[j][2] + v[j][3]);
            const float mean = wave_sum(s) * (1.f / DM); float s2 = 0.f;
#pragma unroll
            for (int j = 0; j < 4; ++j) { v[j] = v[j] - mean; s2 += (v[j][0] * v[j][0] + v[j][1] * v[j][1]) + (v[j][2] * v[j][2] + v[j][3] * v[j][3]); }
            const float rstd = 1.f / sqrtf(wave_sum(s2) * (1.f / DM) + KF(LN_EPS));
#pragma unroll
            for (int j = 0; j < 4; ++j) v[j] = v[j] * rstd * gv[j] + bv[j];
#pragma unroll
            for (int j = 0; j < 2; ++j) { *(u32x4*)(X2B + (size_t)r * DM + 8 * C.lane + 512 * j) = pack8(v[2 * j], v[2 * j + 1]);
                const f32x4 q0 = v[2 * j] * qs, q1 = v[2 * j + 1] * qs;
                int w0 = __builtin_amdgcn_cvt_pk_fp8_f32(fminf(fmaxf(q0[0], qlo), qhi), fminf(fmaxf(q0[1], qlo), qhi), 0, false); w0 = __builtin_amdgcn_cvt_pk_fp8_f32(fminf(fmaxf(q0[2], qlo), qhi), fminf(fmaxf(q0[3], qlo), qhi), w0, true);
                int w1 = __builtin_amdgcn_cvt_pk_fp8_f32(fminf(fmaxf(q1[0], qlo), qhi), fminf(fmaxf(q1[1], qlo), qhi), 0, false); w1 = __builtin_amdgcn_cvt_pk_fp8_f32(fminf(fmaxf(q1[2], qlo), qhi), fminf(fmaxf(q1[3], qlo), qhi), w1, true);
                *(u32x2*)(X2Q + (size_t)r * DM + 8 * C.lane + 512 * j) = (u32x2){(unsigned)w0, (unsigned)w1}; } }
    }
}

__device__ __forceinline__ void phase_conv(const CAS Args& args, const Ctx& C0, int j) {
    Ctx C = C0; C.tid = opaque_tid(); C.lane = C.tid & 63;
    const bf16_t* U = WSP(bf16_t, WS_U); bf16_t* UC = WSP(bf16_t, WS_UC);
    const float* cw = INF(I_LRU_CW) + (size_t)j * 4 * DM; const float* cb = INF(I_LRU_CB) + (size_t)j * DM;
    const int c8 = (C.tid & 127) * 8, rsub = C.tid >> 7;
    float w[4][8], bb[8];
#pragma unroll
    for (int q = 0; q < 4; ++q)
#pragma unroll
        for (int e = 0; e < 8; ++e) w[q][e] = cw[q * DM + c8 + e];
#pragma unroll
    for (int e = 0; e < 8; ++e) bb[e] = cb[c8 + e];
    for (int chunk = C.vcu; chunk < T / 128; chunk += C.G) {
        const int r0 = chunk * 128 + rsub * 32;
        u32x4 h0, h1, h2;
        const u32x4 z = {0u, 0u, 0u, 0u};
        const int s0 = r0 & (SEQ - 1);
        h0 = s0 >= 3 ? *(const u32x4*)(U + (size_t)(r0 - 3) * DM + c8) : z; h1 = s0 >= 2 ? *(const u32x4*)(U + (size_t)(r0 - 2) * DM + c8) : z; h2 = s0 >= 1 ? *(const u32x4*)(U + (size_t)(r0 - 1) * DM + c8) : z;
        u32x4 hN[8];
#pragma unroll
        for (int k = 0; k < 8; ++k) hN[k] = *(const u32x4*)(U + (size_t)(r0 + k) * DM + c8);
#pragma unroll 1
        for (int i0 = 0; i0 < 32; i0 += 8) {
            u32x4 hC[8];
#pragma unroll
            for (int k = 0; k < 8; ++k) hC[k] = hN[k];
            if (i0 + 8 < 32) {
#pragma unroll
                for (int k = 0; k < 8; ++k) hN[k] = *(const u32x4*)(U + (size_t)(r0 + i0 + 8 + k) * DM + c8); }
#pragma unroll
            for (int k = 0; k < 8; ++k) { const u32x4 h3 = hC[k]; const int i = i0 + k;
                float o[8];
#pragma unroll
                for (int q = 0; q < 4; ++q) { const unsigned a = h0[q], b = h1[q], c = h2[q], d = h3[q];
                    o[2 * q] = bb[2 * q] + w[0][2 * q] * bf_lo(a) + w[1][2 * q] * bf_lo(b) + w[2][2 * q] * bf_lo(c) + w[3][2 * q] * bf_lo(d);
                    o[2 * q + 1] = bb[2 * q + 1] + w[0][2 * q + 1] * bf_hi(a) + w[1][2 * q + 1] * bf_hi(b) + w[2][2 * q + 1] * bf_hi(c) + w[3][2 * q + 1] * bf_hi(d); }
                u32x4 ow; ow.x = cvt_pk_bf16(o[0], o[1]); ow.y = cvt_pk_bf16(o[2], o[3]); ow.z = cvt_pk_bf16(o[4], o[5]); ow.w = cvt_pk_bf16(o[6], o[7]);
                *(u32x4*)(UC + (size_t)(r0 + i) * DM + c8) = ow; h0 = h1; h1 = h2; h2 = h3; } }
    }
}
__device__ __forceinline__ void phase_scan1(const CAS Args& args, const Ctx& C0) {
    Ctx C = C0; C.tid = opaque_tid(); C.lane = C.tid & 63;
    const bf16_t* LA = WSP(bf16_t, WS_AA); const bf16_t* BB = WSP(bf16_t, WS_BB); float* CA = WSP(float, WS_CA); float* CH = WSP(float, WS_CH);
    const int half = C.tid >> 8, c4 = (C.tid & 255) * 4;
    for (int ip = C.vcu; ip < NBATCH * 32; ip += C.G) { const int item = ip * 2 + half;
        const size_t r0 = (size_t)item * 64; float h0 = 0.f, h1 = 0.f, h2 = 0.f, h3 = 0.f, l0 = 0.f, l1 = 0.f, l2 = 0.f, l3 = 0.f;
#pragma unroll 8
        for (int s = 0; s < 64; ++s) { const u32x2 aw = *(const u32x2*)(LA + (r0 + s) * DM + c4), bw = *(const u32x2*)(BB + (r0 + s) * DM + c4);
            const float la0 = bf_lo(aw.x), la1 = bf_hi(aw.x), la2 = bf_lo(aw.y), la3 = bf_hi(aw.y);
            h0 = __builtin_amdgcn_exp2f(la0) * h0 + bf_lo(bw.x); h1 = __builtin_amdgcn_exp2f(la1) * h1 + bf_hi(bw.x); h2 = __builtin_amdgcn_exp2f(la2) * h2 + bf_lo(bw.y); h3 = __builtin_amdgcn_exp2f(la3) * h3 + bf_hi(bw.y);
            l0 += la0; l1 += la1; l2 += la2; l3 += la3; }
        *(f32x4*)(CA + (size_t)item * DM + c4) = (f32x4){__builtin_amdgcn_exp2f(l0), __builtin_amdgcn_exp2f(l1), __builtin_amdgcn_exp2f(l2), __builtin_amdgcn_exp2f(l3)}; *(f32x4*)(CH + (size_t)item * DM + c4) = (f32x4){h0, h1, h2, h3};
    }
}
__device__ __forceinline__ void phase_scan2(const CAS Args& args, const Ctx& C0) {
    Ctx C = C0; C.tid = opaque_tid(); C.lane = C.tid & 63;
    const bf16_t* LA = WSP(bf16_t, WS_AA); const bf16_t* BB = WSP(bf16_t, WS_BB); const float* CA = WSP(float, WS_CA); const float* CH = WSP(float, WS_CH);
    const bf16_t* GG = WSP(bf16_t, WS_GG); bf16_t* YL = WSP(bf16_t, WS_O);
    const int half = C.tid >> 8, c4 = (C.tid & 255) * 4;
    for (int ip = C.vcu; ip < NBATCH * 32; ip += C.G) { const int item = ip * 2 + half;
        const int b = item >> 6, ch = item & 63; float h0 = 0.f, h1 = 0.f, h2 = 0.f, h3 = 0.f;
#pragma unroll 8
        for (int jx = 0; jx < ch; ++jx) { const f32x4 a = *(const f32x4*)(CA + (size_t)(b * 64 + jx) * DM + c4), e = *(const f32x4*)(CH + (size_t)(b * 64 + jx) * DM + c4);
            h0 = a[0] * h0 + e[0]; h1 = a[1] * h1 + e[1]; h2 = a[2] * h2 + e[2]; h3 = a[3] * h3 + e[3]; }
        const size_t r0 = (size_t)item * 64;
        u32x2 aN[8], bN[8], gN[8];
#pragma unroll
        for (int k = 0; k < 8; ++k) { aN[k] = *(const u32x2*)(LA + (r0 + k) * DM + c4); bN[k] = *(const u32x2*)(BB + (r0 + k) * DM + c4); gN[k] = *(const u32x2*)(GG + (r0 + k) * DM + c4); }
#pragma unroll 1
        for (int s0 = 0; s0 < 64; s0 += 8) {
            u32x2 aC[8], bC[8], gC[8];
#pragma unroll
            for (int k = 0; k < 8; ++k) { aC[k] = aN[k]; bC[k] = bN[k]; gC[k] = gN[k]; }
            if (s0 + 8 < 64) {
#pragma unroll
                for (int k = 0; k < 8; ++k) { aN[k] = *(const u32x2*)(LA + (r0 + s0 + 8 + k) * DM + c4); bN[k] = *(const u32x2*)(BB + (r0 + s0 + 8 + k) * DM + c4); gN[k] = *(const u32x2*)(GG + (r0 + s0 + 8 + k) * DM + c4); } }
#pragma unroll
            for (int k = 0; k < 8; ++k) { const u32x2 aw = aC[k], bw = bC[k], g = gC[k];
                h0 = __builtin_amdgcn_exp2f(bf_lo(aw.x)) * h0 + bf_lo(bw.x); h1 = __builtin_amdgcn_exp2f(bf_hi(aw.x)) * h1 + bf_hi(bw.x);
                h2 = __builtin_amdgcn_exp2f(bf_lo(aw.y)) * h2 + bf_lo(bw.y); h3 = __builtin_amdgcn_exp2f(bf_hi(aw.y)) * h3 + bf_hi(bw.y);
                *(u32x2*)(YL + (r0 + s0 + k) * DM + c4) = (u32x2){cvt_pk_bf16(bf_lo(g.x) * h0, bf_hi(g.x) * h1), cvt_pk_bf16(bf_lo(g.y) * h2, bf_hi(g.y) * h3)}; } }
    }
}

#if PROBE_T
typedef int v8i_t __attribute__((ext_vector_type(8)));
__device__ __forceinline__ unsigned fp8_of_int(int v) { const unsigned char t[4] = {0x00, 0x38, 0x40, 0x44}; const int a = v < 0 ? -v : v; return (unsigned)t[a] | (v < 0 ? 0x80u : 0u); }
__device__ __forceinline__ int tA(int i, int k) { return ((i * 3 + k * 5) % 7) - 3; }
__device__ __forceinline__ int tB(int k, int j) { return ((k * 2 + j * 7) % 5) - 2; }
__device__ __forceinline__ void mfma_fp8_selftest(unsigned* flagw) {
    const int l = threadIdx.x & 63, r = l & 15, q = l >> 4;
    v8i_t A, B;
#pragma unroll
    for (int d = 0; d < 8; ++d) { unsigned wa = 0, wb = 0;
#pragma unroll
        for (int b = 0; b < 4; ++b) { const int k = 32 * q + 4 * d + b; wa |= fp8_of_int(tA(r, k)) << (8 * b); wb |= fp8_of_int(tB(k, r)) << (8 * b); }
        A[d] = (int)wa; B[d] = (int)wb; }
    const f32x4 z = {0.f, 0.f, 0.f, 0.f};
    const int U = 0x7f7f7f7f;
    const int saq = (127 + q) * 0x01010101;
    const int sab = (q == 0) ? (int)0x8281807fu : U;
    const f32x4 m2 = __builtin_amdgcn_mfma_scale_f32_16x16x128_f8f6f4(A, B, z, 0, 0, 0, saq, 0, U);
    const f32x4 m5 = __builtin_amdgcn_mfma_scale_f32_16x16x128_f8f6f4(A, B, z, 0, 0, 0, sab, 0, U);
    bool k1 = true, k2 = true, k3 = true, k4 = true;
#pragma unroll
    for (int e = 0; e < 4; ++e) { const int i = 4 * q + e, j = r; float eb = 0.f, e0 = 0.f, ec = 0.f, ed = 0.f;
        for (int kq = 0; kq < 4; ++kq) for (int hh = 0; hh < 2; ++hh) { float sh = 0.f; for (int k = 32 * kq + 16 * hh; k < 32 * kq + 16 * hh + 16; ++k) sh += (float)(tA(i, k) * tB(k, j));
            const int xb = hh == 0 ? (kq >> 1) : 2 + (kq >> 1);
            eb += sh * (float)(1 << xb); e0 += sh; ec += sh * (float)(1 << kq); ed += sh * (float)(1 << xb); }
        k1 = k1 && (m2[e] == eb); k2 = k2 && (m2[e] == e0); k3 = k3 && (m5[e] == ec); k4 = k4 && (m5[e] == ed); }
    const bool b1 = __all(k1), b2 = __all(k2), b3 = __all(k3), b4 = __all(k4);
    if (l == 0) *flagw = (b1 ? 1u : 0u) | (b2 ? 2u : 0u) | (b3 ? 4u : 0u) | (b4 ? 8u : 0u);
}
#endif
constexpr int PH_PER_LAYER = 12, PH_TOTAL = 2 + PH_PER_LAYER * DEPTH;
__global__ void __launch_bounds__(NWAVES * 64, 2) fwd_kernel(Args args_kernarg) {
    (void)args_kernarg;
    ArgsP const argp = (ArgsP)__builtin_amdgcn_kernarg_segment_ptr();
    const CAS Args& args0 = *argp;
    extern __shared__ __attribute__((aligned(16))) unsigned char lds_raw[];
    Ctx C_;
    C_.lds = (LAS unsigned char*)lds_raw; C_.misc = (volatile LAS int*)(C_.lds + MISC_OFF);
    C_.tid = threadIdx.x; C_.lane = C_.tid & 63; C_.wave = __builtin_amdgcn_readfirstlane(C_.tid >> 6);
    C_.bid = (int)blockIdx.x; C_.G = gridDim.x; { const int bx = blockIdx.x; C_.vcu = (C_.G % 8 == 0) ? (bx % 8) * (C_.G / 8) + bx / 8 : bx; }
    for (int u = C_.tid; u < 128; u += NWAVES * 64) C_.misc[u] = 0;
    __syncthreads();
    XcdBarrier bar = xcd_barrier_post((unsigned*)(args0.ws + WS_CTL) + CW_BAR + args0.li * XCD_BAR_WORDS, (volatile LAS unsigned*)C_.misc);
    const int lo = args0.ph_lo, hi = args0.ph_hi;
#define IN(k) (lo <= (k) && (k) < hi)
#define PH_END(k) do { if ((k) + 1 < hi) xcd_barrier(bar); } while (0)

    if (SEL(0) && IN(0)) { const CAS Args& args = fresh_args(argp); const Ctx C = fresh_ctx(C_); const int cid = C.bid; phase_prologue(args, C); PH_END(0); }
    if (SEL(1) && IN(1)) { const CAS Args& args = fresh_args(argp); const Ctx C = fresh_ctx(C_); const int cid = C.bid;
        typedef pg8::DenseSched<DEPTH * T / 256, 4> DS; DS S; S.init(WSP(bf16_t, WS_PB), WSP(bf16_t, WS_W_PLE + OFF_PLE_WP), PLED, PLED, C.G, cid); S.bpm_shift = 7; S.bbatch = W_PLE_STRIDE;
        pg8::EpiPP E{WSP(bf16_t, WS_PP)};
        pg8::gemm_phase<pg8::EpiPP, DS, false>(C.lds, PLED / 64, PLED * 2, PLED * 2, S, E);
        if (MK_ONE_LAUNCH == 0) PH_END(1);
    }
    for (int layer = 0; layer < DEPTH; ++layer) {
        const int base = 2 + PH_PER_LAYER * layer, j = layer >> 1;
        if ((layer & 1) == 0) {
            if (SEL(2) && IN(base + 0)) { const CAS Args& args = fresh_args(argp); const Ctx C = fresh_ctx(C_); const int cid = C.bid; const unsigned char* wm = args.ws + WS_W_MLA + (size_t)j * W_MLA_STRIDE;
                typedef pg8::DenseSched<T / 256, 5> DS; DS S; S.init(WSP(bf16_t, WS_XB), wm + OFF_MLA_WIN, DM, DM, C.G, cid);
                pg8::EpiLat E{WSP(bf16_t, WS_LAT), WSP(float, WS_SSQ), WSP(bf16_t, WS_KR), WSP(float, WS_CS), WSP(float, WS_SN)};
                pg8::gemm_phase<pg8::EpiLat, DS, false>(C.lds, DM / 64, DM * 2, DM * 2, S, E);
                PH_END(base + 0);
            }
            if (SEL(3) && IN(base + 1)) { const CAS Args& args = fresh_args(argp); const Ctx C = fresh_ctx(C_); const int cid = C.bid; const unsigned char* wm = args.ws + WS_W_MLA + (size_t)j * W_MLA_STRIDE;
                if ((C.vcu & 1) == 0) {
                { typedef pg8::DenseSched<T / 256, 6> DS; DS S; S.init(WSP(bf16_t, WS_LAT), wm + OFF_MLA_WUQ, DM, QL, C.G, cid);
                  pg8::EpiQ E{WSP(bf16_t, WS_Q), WSP(float, WS_SSQ), WSP(float, WS_CS), WSP(float, WS_SN)};
                  pg8::gemm_phase<pg8::EpiQ, DS, false>(C.lds, QL / 64, DM * 2, QL * 2, S, E); }
                { typedef pg8::DenseSched<T / 256, 8> DS; DS S; S.init(WSP(bf16_t, WS_LAT) + QL, wm + OFF_MLA_WUKV, DM, KVL, C.G, cid);
                  pg8::EpiKV E{WSP(bf16_t, WS_KN), WSP(bf16_t, WS_V), WSP(float, WS_SSQ)};
                  pg8::gemm_phase<pg8::EpiKV, DS, false>(C.lds, KVL / 64, DM * 2, KVL * 2, S, E); }
                } else {
                { typedef pg8::DenseSched<T / 256, 8> DS; DS S; S.init(WSP(bf16_t, WS_LAT) + QL, wm + OFF_MLA_WUKV, DM, KVL, C.G, cid);
                  pg8::EpiKV E{WSP(bf16_t, WS_KN), WSP(bf16_t, WS_V), WSP(float, WS_SSQ)};
                  pg8::gemm_phase<pg8::EpiKV, DS, false>(C.lds, KVL / 64, DM * 2, KVL * 2, S, E); }
                { typedef pg8::DenseSched<T / 256, 6> DS; DS S; S.init(WSP(bf16_t, WS_LAT), wm + OFF_MLA_WUQ, DM, QL, C.G, cid);
                  pg8::EpiQ E{WSP(bf16_t, WS_Q), WSP(float, WS_SSQ), WSP(float, WS_CS), WSP(float, WS_SN)};
                  pg8::gemm_phase<pg8::EpiQ, DS, false>(C.lds, QL / 64, DM * 2, QL * 2, S, E); }
                }
                PH_END(base + 1);
            }
            if (SEL(4) && IN(base + 2)) { const CAS Args& args = fresh_args(argp); const Ctx C = fresh_ctx(C_); const int cid = C.bid;
                for (int it = C.vcu; it < NBATCH * NH * 8; it += C.G) { const int bh = it >> 3, pr = it & 7;
                    att::attn_block(bh >> 3, bh & 7, pr, WSP(bf16_t, WS_Q), WSP(bf16_t, WS_KN), WSP(bf16_t, WS_KR), WSP(bf16_t, WS_V), WSP(bf16_t, WS_O), (LAS char*)C.lds, PROBE_T ? (unsigned long long*)(args.ws + WS_CTL + 8192) : nullptr);
                    att::attn_block(bh >> 3, bh & 7, 15 - pr, WSP(bf16_t, WS_Q), WSP(bf16_t, WS_KN), WSP(bf16_t, WS_KR), WSP(bf16_t, WS_V), WSP(bf16_t, WS_O), (LAS char*)C.lds, PROBE_T ? (unsigned long long*)(args.ws + WS_CTL + 8192) : nullptr); }
                PH_END(base + 2);
            }
        } else {
            if (SEL(5) && IN(base + 0)) { const CAS Args& args = fresh_args(argp); const Ctx C = fresh_ctx(C_); const int cid = C.bid; const unsigned char* wl = args.ws + WS_W_LRU + (size_t)j * W_LRU_STRIDE;
                typedef pg8::DenseSched<T / 256, 8> DS; DS S; S.init(WSP(bf16_t, WS_XB), wl + OFF_LRU_WIN, DM, DM, C.G, cid);
                pg8::EpiGU E{WSP(bf16_t, WS_GG), WSP(bf16_t, WS_U)};
                pg8::gemm_phase<pg8::EpiGU, DS, false>(C.lds, DM / 64, DM * 2, DM * 2, S, E);
                PH_END(base + 0);
            }
            if (SEL(6) && IN(base + 1)) { const CAS Args& args = fresh_args(argp); const Ctx C = fresh_ctx(C_); const int cid = C.bid; phase_conv(args, C, j); PH_END(base + 1); }
            if (SEL(7) && IN(base + 2)) { const CAS Args& args = fresh_args(argp); const Ctx C = fresh_ctx(C_); const int cid = C.bid; const unsigned char* wl = args.ws + WS_W_LRU + (size_t)j * W_LRU_STRIDE;
                typedef pg8::DenseSched<T / 256, 8> DS; DS S; S.init(WSP(bf16_t, WS_UC), wl + OFF_LRU_WAX, DM, 256, C.G, cid); S.apn_shift = 1; S.akbytes = 512;
                pg8::EpiAB E{WSP(bf16_t, WS_AA), WSP(bf16_t, WS_BB), WSP(bf16_t, WS_UC), INF(I_LRU_BA) + j * DM, INF(I_LRU_BX) + j * DM, WSP(float, WS_SPL) + j * DM};
                pg8::gemm_phase<pg8::EpiAB, DS, false>(C.lds, 4, DM * 2, 512, S, E);
                PH_END(base + 2);
            }
            if (SEL(8) && IN(base + 3)) { const CAS Args& args = fresh_args(argp); const Ctx C = fresh_ctx(C_); const int cid = C.bid; phase_scan1(args, C); PH_END(base + 3); }
            if (SEL(9) && IN(base + 4)) { const CAS Args& args = fresh_args(argp); const Ctx C = fresh_ctx(C_); const int cid = C.bid; phase_scan2(args, C); PH_END(base + 4); }
        }
        if (SEL(10) && IN(base + 5)) { const CAS Args& args = fresh_args(argp); const Ctx C = fresh_ctx(C_); const int cid = C.bid;
            const unsigned char* wo = (layer & 1) ? args.ws + WS_W_LRU + (size_t)j * W_LRU_STRIDE + OFF_LRU_WOUT : args.ws + WS_W_MLA + (size_t)j * W_MLA_STRIDE + OFF_MLA_WO;
            typedef pg8::DenseSched<T / 256, 4> DS; DS S; S.init(WSP(bf16_t, WS_O), wo, DM, DM, C.G, cid);
            pg8::EpiRes E{WSP(bf16_t, WS_XB), WSP(bf16_t, WS_Y)};
            pg8::gemm_phase<pg8::EpiRes, DS, false>(C.lds, DM / 64, DM * 2, DM * 2, S, E);
            PH_END(base + 5);
        }
        if (SEL(11) && IN(base + 6)) { const CAS Args& args = fresh_args(argp); const Ctx C = fresh_ctx(C_); const int cid = C.bid; phase_ln_router(args, C, layer); PH_END(base + 6); }
        if (SEL(12) && IN(base + 7)) { const CAS Args& args = fresh_args(argp); const Ctx C = fresh_ctx(C_); const int cid = C.bid;
            moe_table(args, C, layer);
            pg8::MoeSched S{(const char*)(args.ws + WS_X1Q), (const char*)(args.ws + WS_W_UP + (size_t)layer * NE * 2048 * 1024), (size_t)2048 * 1024, (const char*)(args.ws + WS_SW + (size_t)layer * NE * 65536), DM, DM, 8, WSP(int, WS_LIST), C.misc + 16, (volatile LAS const unsigned char*)(C.lds + TILE_E_OFF), C.G, cid, true, nullptr};
            const int sae = 127 - (int)__hip_atomic_load(WSP(unsigned, WS_CTL) + CW_SA + layer, __ATOMIC_RELAXED, __HIP_MEMORY_SCOPE_AGENT);
            pg8::EpiUp E{args.ws + WS_H, args.ws + WS_SH, INF(I_MOE_BUP) + (size_t)layer * NE * 2048};
            pg8::gemm_phase<pg8::EpiUp, pg8::MoeSched, true, 1>(C.lds, DM / 128, DM, DM, S, E, PROBE_T ? (unsigned long long*)(args.ws + WS_CTL + 8192) : nullptr, sae * 0x01010101);
            PH_END(base + 7);
        }
        if (SEL(13) && IN(base + 8)) { const CAS Args& args = fresh_args(argp); const Ctx C = fresh_ctx(C_); const int cid = C.bid;
            moe_table(args, C, layer);
            pg8::MoeSched S{(const char*)(args.ws + WS_H), (const char*)(args.ws + WS_W_DN + (size_t)layer * NE * 1024 * 1024), (size_t)1024 * 1024, (const char*)(args.ws + WS_SWD + (size_t)layer * NE * 16384), DFF, DFF, 4, WSP(int, WS_LIST), C.misc + 16, (volatile LAS const unsigned char*)(C.lds + TILE_E_OFF), C.G, cid, false, (const char*)(args.ws + WS_SH)};
            pg8::EpiDown E{args.ws + WS_YS, args.ws + WS_SY, INF(I_MOE_BDN) + (size_t)layer * NE * DM};
            pg8::gemm_phase<pg8::EpiDown, pg8::MoeSched, false, 2>(C.lds, DFF / 128, DFF, DFF, S, E);
            PH_END(base + 8);
        }
        if (SEL(14) && IN(base + 9)) { const CAS Args& args = fresh_args(argp); const Ctx C = fresh_ctx(C_); const int cid = C.bid; phase_combine_ln2(args, C, layer); PH_END(base + 9); }
        if (SEL(15) && IN(base + 10)) { const CAS Args& args = fresh_args(argp); const Ctx C = fresh_ctx(C_); const int cid = C.bid;
            typedef pg8::DenseSched<T / 256, 4> DS; DS S; S.init(args.ws + WS_X2Q, args.ws + WS_W_PLE + (size_t)layer * W_PLE_STRIDE + OFF_PLE_WG, DM / 2, DM / 2, C.G, cid); S.SW = (const char*)(args.ws + WS_SWG + (size_t)layer * 65536);
            const int sae = 127 - (int)__hip_atomic_load(WSP(unsigned, WS_CTL) + CW_SA2 + layer, __ATOMIC_RELAXED, __HIP_MEMORY_SCOPE_AGENT);
            pg8::EpiPle E{WSP(bf16_t, WS_X2B), WSP(bf16_t, WS_PP) + (size_t)layer * T * DM, layer == DEPTH - 1 ? args.out : (float*)nullptr, WSP(bf16_t, WS_XB)};
            pg8::gemm_phase<pg8::EpiPle, DS, false, 1>(C.lds, DM / 128, DM, DM, S, E, nullptr, sae * 0x01010101);
            if (layer + 1 < DEPTH) PH_END(base + 10);
        }
    }
#if PROBE_T
    if (PROBE_T == 20 && blockIdx.x == 0 && threadIdx.x < 64) { const CAS Args& args = fresh_args(argp); mfma_fp8_selftest((unsigned*)(args.ws + WS_CTL + 8192 + 256)); }
    { xcd_barrier(bar); const CAS Args& args = fresh_args(argp);
      const unsigned long long* pw = (const unsigned long long*)(args.ws + WS_CTL + 8192);
      const double pk = (double)__hip_atomic_load(pw + 0, __ATOMIC_RELAXED, __HIP_MEMORY_SCOPE_AGENT), pe = (double)__hip_atomic_load(pw + 1, __ATOMIC_RELAXED, __HIP_MEMORY_SCOPE_AGENT),
                   pn = (double)__hip_atomic_load(pw + 2, __ATOMIC_RELAXED, __HIP_MEMORY_SCOPE_AGENT), pt = (double)__hip_atomic_load(pw + 3, __ATOMIC_RELAXED, __HIP_MEMORY_SCOPE_AGENT);
      float c = 100.f;
      if (PROBE_T == 2) c = (float)(pk / (pn * 16.0) / 10.0);
      if (PROBE_T == 3) c = (float)(pe / pn / 100.0);
      if (PROBE_T == 4) c = (float)((pt - pk - pe) / pn / 100.0);
      if (PROBE_T == 5) c = (float)(pn);
      if (PROBE_T >= 10) { double q[7]; for (int i = 0; i < 7; ++i) q[i] = (double)__hip_atomic_load(pw + 8 + i, __ATOMIC_RELAXED, __HIP_MEMORY_SCOPE_AGENT);
          if (PROBE_T == 10) c = (float)(q[6] / q[5] / 10.0);
          if (PROBE_T == 11) c = (float)(q[0] / q[5] / 10.0);
          if (PROBE_T == 12) c = (float)(q[1] / q[5] / 10.0);
          if (PROBE_T == 13) c = (float)(q[2] / q[5] / 10.0);
          if (PROBE_T == 14) c = (float)(q[3] / q[5] / 10.0);
          if (PROBE_T == 15) c = (float)(q[4] / q[5] / 10.0); }
      if (PROBE_T >= 2 && PROBE_T < 20) c = exp2f(floorf(log2f(c) * 8.0f + PROBE_SHIFT) * 0.125f);
      if (PROBE_T == 20) { const unsigned fl = __hip_atomic_load((const unsigned*)(args.ws + WS_CTL + 8192 + 256), __ATOMIC_RELAXED, __HIP_MEMORY_SCOPE_AGENT); c = 100.f + 10.f * (float)fl; }
      for (size_t i = (size_t)blockIdx.x * 512 + threadIdx.x; i < (size_t)T * DM; i += (size_t)gridDim.x * 512) args.out[i] = c; }
#endif
#undef IN
#undef PH_END
}

extern "C" void kernel_launch(void* const* d_in, const int* in_sizes, int n_in, void* d_out, int out_size, void* d_ws, size_t ws_size, hipStream_t stream) {
    static int grid = 0;
    if (grid == 0) {
        if (n_in != 30 || in_sizes[0] != T * DM || out_size != T * DM || ws_size < WS_END) { fprintf(stderr, "kernel_launch: unexpected shapes (n_in %d, in0 %d, out %d, ws %zu)\n", n_in, n_in > 0 ? in_sizes[0] : -1, out_size, ws_size); grid = -1; return; }
        int dev = 0, cus = 0, per_cu = 0;
        if (hipGetDevice(&dev) != hipSuccess || hipDeviceGetAttribute(&cus, hipDeviceAttributeMultiprocessorCount, dev) != hipSuccess) { grid = -1; return; }
        if (hipFuncSetAttribute((const void*)fwd_kernel, hipFuncAttributeMaxDynamicSharedMemorySize, LDS_BYTES) != hipSuccess) { fprintf(stderr, "kernel_launch: hipFuncSetAttribute failed\n"); grid = -1; return; }
        if (hipOccupancyMaxActiveBlocksPerMultiprocessor(&per_cu, (const void*)fwd_kernel, NWAVES * 64, LDS_BYTES) != hipSuccess || per_cu < 1) fprintf(stderr, "kernel_launch: occupancy query reports %d\n", per_cu);
        (void)hipGetLastError();
        grid = cus;
    }
    if (grid < 0) return;
    if (hipMemsetAsync((char*)d_ws + WS_CTL, 0, CTL_ZERO_BYTES, stream) != hipSuccess) return;
    Args a{};
    for (int i = 0; i < 30; ++i) a.in[i] = d_in[i];
    a.out = (float*)d_out; a.ws = (unsigned char*)d_ws; a.pad = 0;
#if MK_ONE_LAUNCH
    a.ph_lo = 0; a.ph_hi = PH_TOTAL; a.li = 0;
    hipLaunchKernelGGL(fwd_kernel, dim3(grid), dim3(NWAVES * 64), LDS_BYTES, stream, a);
#else
    int li = 0;
    for (int ph = 0; ph < PH_TOTAL; ++ph) {
        if (ph >= 2) { const int l = (ph - 2) / PH_PER_LAYER, k = (ph - 2) % PH_PER_LAYER; if (k == 11) continue; if ((l & 1) == 0 && (k == 3 || k == 4)) continue; }
        int site = ph;
        if (ph >= 2) { const int l = (ph - 2) / PH_PER_LAYER, k = (ph - 2) % PH_PER_LAYER; static const int mla[11] = {2, 3, 4, -1, -1, 10, 11, 12, 13, 14, 15}, lru[11] = {5, 6, 7, 8, 9, 10, 11, 12, 13, 14, 15}; site = (l & 1) ? lru[k] : mla[k]; }
        a.ph_lo = ph; a.ph_hi = ph + 1;
        if ((HOSTDUP >> site) & 1) for (int r_ = 1; r_ <= HOSTDUP_R; ++r_) { a.li = li++; a.pad = 4 * r_; hipLaunchKernelGGL(fwd_kernel, dim3(grid), dim3(NWAVES * 64), LDS_BYTES, stream, a); }
        a.li = li++; a.pad = 0;
        hipLaunchKernelGGL(fwd_kernel, dim3(grid), dim3(NWAVES * 64), LDS_BYTES, stream, a);
    }
#endif
}
```
